# Optimizing an MI355X kernel written in HIP

```python
import jax
import jax.numpy as jnp
from jax import lax
import numpy as np

D_MODEL = 1024
BATCH = 4
SEQ = 8192
DEPTH = 4

GRID_W = 64
CTX_LEN = 256
HEAD_DIM = 64
N_NA_HEADS = 8
N_HG_HEADS = 8
NA_WIDTH = N_NA_HEADS * HEAD_DIM
HG_WIDTH = N_HG_HEADS * HEAD_DIM
N_EVEN_PARTS = 8
EVEN_IN_WIDTH = 3 * NA_WIDTH + 5 * HG_WIDTH
MIX_WIDTH = NA_WIDTH + HG_WIDTH
NA_WIN_ROWS = 8
NA_WIN_COLS = 16
HG_CHUNK = 64
FORGET_FLOOR = 1e-30
LRU_WIDTH = D_MODEL
LRU_BLOCKS = 16
LRU_BLOCK_DIM = LRU_WIDTH // LRU_BLOCKS
LRU_C = 8.0
CONV_W = 4
CONV_PAD_LEFT = 2
N_EXPERTS = 64
TOP_K = 6
EXPERT_HIDDEN = 256
SHARED_HIDDEN = 256
ROUTED_SCALE = 2.5
MOE_BLOCK = 128
N_EVEN = (DEPTH + 1) // 2
N_ODD = DEPTH // 2
DEEPNORM_ALPHA = (2 * DEPTH) ** 0.25
DEEPNORM_BETA = (8 * DEPTH) ** -0.25
LN_EPS = 1e-5
RMS_EPS = 1e-6

kernel_name = 'hybrid_na_hgrn2_rglru_moe_diffusion_trunk'


def layer_norm(x, g, b):
    x32 = x.astype(jnp.float32)
    mu = jnp.mean(x32, axis=-1, keepdims=True)
    var = jnp.mean(jnp.square(x32 - mu), axis=-1, keepdims=True)
    y = (x32 - mu) * lax.rsqrt(var + LN_EPS)
    return (y * g.astype(jnp.float32) + b.astype(jnp.float32)).astype(x.dtype)


def to_heads(t):
    b, n, _ = t.shape
    return t.reshape(b, n, -1, HEAD_DIM).transpose(0, 2, 1, 3)


def from_heads(t):
    b, h, n, d = t.shape
    return t.transpose(0, 2, 1, 3).reshape(b, n, h * d)


def neighbourhood_attention(q, k, v, k_ctx, v_ctx, rpb):
    b, h, n, dh = q.shape
    rows = n // GRID_W
    kr = min(NA_WIN_ROWS, rows)
    kc = NA_WIN_COLS
    q = q.reshape(b, h, rows, GRID_W, dh)
    k = k.reshape(b, h, rows, GRID_W, dh)
    v = v.reshape(b, h, rows, GRID_W, dh)
    col = jnp.arange(GRID_W)
    col_idx = jnp.clip(col - kc // 2, 0, GRID_W - kc)[:, None] + jnp.arange(kc)[None, :]
    col_bias_idx = col_idx - col[:, None] + (NA_WIN_COLS - 1)

    def one_row(r):
        r0 = jnp.clip(r - kr // 2, 0, rows - kr)
        k_band = lax.dynamic_slice_in_dim(k, r0, kr, axis=2)
        v_band = lax.dynamic_slice_in_dim(v, r0, kr, axis=2)
        k_win = k_band[:, :, :, col_idx, :]
        v_win = v_band[:, :, :, col_idx, :]
        q_r = lax.dynamic_index_in_dim(q, r, axis=2, keepdims=False)
        row_bias_idx = r0 + jnp.arange(kr) - r + (NA_WIN_ROWS - 1)
        bias = rpb[:, row_bias_idx[None, :, None], col_bias_idx[:, None, :]]
        s_loc = jnp.einsum('bhwd,bhrwkd->bhwrk', q_r, k_win) + bias[None]
        s_loc = s_loc.reshape(b, h, GRID_W, kr * kc)
        s_ctx = jnp.einsum('bhwd,bhcd->bhwc', q_r, k_ctx)
        p = jax.nn.softmax(jnp.concatenate([s_loc, s_ctx], axis=-1).astype(jnp.float32), axis=-1).astype(v.dtype)
        p_loc = p[..., :kr * kc].reshape(b, h, GRID_W, kr, kc)
        p_ctx = p[..., kr * kc:]
        return (jnp.einsum('bhwrk,bhrwkd->bhwd', p_loc, v_win)
                + jnp.einsum('bhwc,bhcd->bhwd', p_ctx, v_ctx))

    o = lax.map(one_row, jnp.arange(rows))
    return o.transpose(1, 2, 0, 3, 4).reshape(b, h, n, dh)


def context_attention(q, k, v):
    s = jnp.einsum('bhqd,bhkd->bhqk', q, k).astype(jnp.float32)
    p = jax.nn.softmax(s, axis=-1).astype(v.dtype)
    return jnp.einsum('bhqk,bhkd->bhqd', p, v)


def log_forget(z, lb):
    f = lb.astype(jnp.float32) + (1.0 - lb.astype(jnp.float32)) * jax.nn.sigmoid(z.astype(jnp.float32))
    return jnp.log(jnp.maximum(f, FORGET_FLOOR))


def hgrn2_chunk_scan(q, k, v, g, s0):
    b, h, n, dk = q.shape
    dv = v.shape[-1]
    nc = n // HG_CHUNK

    def chunks(t):
        return jnp.moveaxis(t.reshape(b, h, nc, HG_CHUNK, t.shape[-1]), 2, 0)

    causal = jnp.tril(jnp.ones((HG_CHUNK, HG_CHUNK), dtype=bool))[:, :, None]

    def step(state, blk):
        qb, kb, vb, gb = blk
        qb = qb.astype(jnp.float32)
        kb = kb.astype(jnp.float32)
        vb = vb.astype(jnp.float32)
        cum = jnp.cumsum(gb.astype(jnp.float32), axis=2)
        rel = cum[:, :, :, None, :] - cum[:, :, None, :, :]
        decay = jnp.where(causal, jnp.exp(jnp.minimum(rel, 0.0)), 0.0)
        scores = jnp.einsum('bhtk,bhsk,bhtsk->bhts', qb, kb, decay)
        out = (jnp.einsum('bhts,bhsv->bhtv', scores, vb)
               + jnp.einsum('bhtk,bhkv->bhtv', qb * jnp.exp(cum), state))
        tail = cum[:, :, -1:, :]
        new_state = (jnp.exp(tail[:, :, 0, :])[..., None] * state
                     + jnp.einsum('bhsk,bhsv->bhkv', kb * jnp.exp(tail - cum), vb))
        return new_state, out

    s_final, o = lax.scan(step, s0, (chunks(q), chunks(k), chunks(v), chunks(g)))
    o = jnp.moveaxis(o, 0, 2).reshape(b, h, n, dv)
    return o.astype(v.dtype), s_final


def hgrn2_direction(q, k, v, g, s0, reverse):
    if reverse:
        q, k, v, g = [jnp.flip(t, axis=2) for t in (q, k, v, g)]
    o, s = hgrn2_chunk_scan(q, k, v, g, s0)
    if reverse:
        o = jnp.flip(o, axis=2)
    return o, s


def hgrn2_readout(o, gate, norm_g):
    o32 = o.astype(jnp.float32)
    o32 = o32 * lax.rsqrt(jnp.mean(jnp.square(o32), axis=-1, keepdims=True) + RMS_EPS) * norm_g.astype(jnp.float32)
    return from_heads((o32 * jax.nn.silu(gate.astype(jnp.float32))).astype(gate.dtype))


def even_mixer(hx, hc, w_in, w_out, rpb, lb, norm_g, need_ctx):
    bsz = hx.shape[0]
    scale = HEAD_DIM ** -0.5
    qx, kx, vx, hq_x, ff_x, fb_x, hi_x, hg_x = [to_heads(t) for t in jnp.split(hx @ w_in, N_EVEN_PARTS, axis=-1)]
    qc, kc, vc, hq_c, ff_c, fb_c, hi_c, hg_c = [to_heads(t) for t in jnp.split(hc @ w_in, N_EVEN_PARTS, axis=-1)]
    na_x = neighbourhood_attention(qx * scale, kx, vx, kc, vc, rpb)
    hqx = jax.nn.silu(hq_x) * scale
    hqc = jax.nn.silu(hq_c) * scale
    o_x = 0.0
    o_c = 0.0
    for d, (fz_x, fz_c) in enumerate(((ff_x, ff_c), (fb_x, fb_c))):
        lb_d = lb[d].reshape(N_HG_HEADS, 1, HEAD_DIM)
        g_c = log_forget(fz_c, lb_d)
        g_x = log_forget(fz_x, lb_d)
        s0 = jnp.zeros((bsz, N_HG_HEADS, HEAD_DIM, HEAD_DIM), jnp.float32)
        oc_d, s_ctx = hgrn2_direction(hqc, -jnp.expm1(g_c), hi_c, g_c, s0, d == 1)
        ox_d, _ = hgrn2_direction(hqx, -jnp.expm1(g_x), hi_x, g_x, s_ctx, d == 1)
        o_x = o_x + ox_d
        o_c = o_c + oc_d
    out_x = jnp.concatenate([from_heads(na_x), hgrn2_readout(o_x, hg_x, norm_g)], axis=-1) @ w_out
    if not need_ctx:
        return out_x, None
    na_c = context_attention(qc * scale, kc, vc)
    out_c = jnp.concatenate([from_heads(na_c), hgrn2_readout(o_c, hg_c, norm_g)], axis=-1) @ w_out
    return out_x, out_c


def depthwise_conv(u, w, b):
    y = lax.conv_general_dilated(
        u, w[:, None, :].astype(u.dtype), window_strides=(1,),
        padding=[(CONV_PAD_LEFT, CONV_W - 1 - CONV_PAD_LEFT)],
        dimension_numbers=('NWC', 'WIO', 'NWC'), feature_group_count=u.shape[-1])
    return y + b


def linear_combine(e1, e2):
    a1, b1 = e1
    a2, b2 = e2
    return a1 * a2, a2 * b1 + b2


def rglru_scan(u, w_a, b_a, w_x, b_x, lam, h0, reverse):
    bsz, n, w = u.shape
    ub = u.reshape(bsz, n, LRU_BLOCKS, LRU_BLOCK_DIM)
    r = jax.nn.sigmoid((jnp.einsum('bnkd,kde->bnke', ub, w_a).reshape(bsz, n, w) + b_a).astype(jnp.float32))
    i = jax.nn.sigmoid((jnp.einsum('bnkd,kde->bnke', ub, w_x).reshape(bsz, n, w) + b_x).astype(jnp.float32))
    log_a = -LRU_C * r * jax.nn.softplus(-lam.astype(jnp.float32))
    a = jnp.exp(log_a)
    x_in = jnp.sqrt(-jnp.expm1(2.0 * log_a)) * i * u.astype(jnp.float32)
    first = n - 1 if reverse else 0
    last = 0 if reverse else n - 1
    x_in = x_in.at[:, first].add(a[:, first] * h0)
    _, hs = lax.associative_scan(linear_combine, (a, x_in), axis=1, reverse=reverse)
    return hs, hs[:, last]


def rglru_mixer(hx, hc, w_in, conv_w, conv_b, w_a, b_a, w_x, b_x, lam, w_out, need_ctx):
    y_x, u_x = jnp.split(hx @ w_in, 2, axis=-1)
    y_c, u_c = jnp.split(hc @ w_in, 2, axis=-1)
    u_x = depthwise_conv(u_x, conv_w, conv_b)
    u_c = depthwise_conv(u_c, conv_w, conv_b)
    h0 = jnp.zeros((hc.shape[0], LRU_WIDTH), jnp.float32)
    hs_x = 0.0
    hs_c = 0.0
    for d in range(2):
        h_c, h_c_final = rglru_scan(u_c, w_a[d], b_a[d], w_x[d], b_x[d], lam[d], h0, d == 1)
        h_x, _ = rglru_scan(u_x, w_a[d], b_a[d], w_x[d], b_x[d], lam[d], h_c_final, d == 1)
        hs_x = hs_x + h_x
        hs_c = hs_c + h_c
    out_x = (hs_x * jax.nn.gelu(y_x.astype(jnp.float32))).astype(hx.dtype) @ w_out
    if not need_ctx:
        return out_x, None
    out_c = (hs_c * jax.nn.gelu(y_c.astype(jnp.float32))).astype(hc.dtype) @ w_out
    return out_x, out_c


def moe(h, router_w, router_bias, w_gate, w_up, w_down, s_gate, s_up, s_down):
    t_count, d = h.shape
    scores = jax.nn.sigmoid((h @ router_w).astype(jnp.float32))
    _, idx = lax.top_k(scores + router_bias.astype(jnp.float32), TOP_K)
    sel = jnp.take_along_axis(scores, idx, axis=1)
    wts = sel / jnp.sum(sel, axis=-1, keepdims=True) * ROUTED_SCALE
    tk = t_count * TOP_K
    flat_e = idx.reshape(-1)
    flat_t = jnp.repeat(jnp.arange(t_count, dtype=jnp.int32), TOP_K)
    flat_w = wts.reshape(-1)
    order = jnp.argsort(flat_e)
    se = flat_e[order]
    counts = jnp.bincount(flat_e, length=N_EXPERTS)
    padded = (counts + MOE_BLOCK - 1) // MOE_BLOCK * MOE_BLOCK
    starts = jnp.cumsum(counts) - counts
    pends = jnp.cumsum(padded)
    pstarts = pends - padded
    dest = pstarts[se] + jnp.arange(tk) - starts[se]
    n_blocks = -(-tk // MOE_BLOCK) + N_EXPERTS
    n_slots = n_blocks * MOE_BLOCK
    slot_tok = jnp.full((n_slots,), t_count, jnp.int32).at[dest].set(flat_t[order])
    slot_w = jnp.zeros((n_slots,), jnp.float32).at[dest].set(flat_w[order])
    block_exp = jnp.clip(jnp.searchsorted(pends, jnp.arange(n_blocks) * MOE_BLOCK, side='right'), 0, N_EXPERTS - 1)
    h_pad = jnp.concatenate([h, jnp.zeros((1, d), h.dtype)], axis=0)

    def run_block(args):
        toks, e = args
        xb = h_pad[toks]
        return (jax.nn.silu(xb @ w_gate[e]) * (xb @ w_up[e])) @ w_down[e]

    out = lax.map(run_block, (slot_tok.reshape(n_blocks, MOE_BLOCK), block_exp))
    out = out.reshape(n_slots, d) * slot_w[:, None]
    routed = jax.ops.segment_sum(out, slot_tok, num_segments=t_count + 1)[:t_count]
    shared = (jax.nn.silu(h @ s_gate) * (h @ s_up)) @ s_down
    return (routed + shared).astype(h.dtype)


def setup_inputs(seed: int = 0) -> dict:
    key = jax.random.key(seed)
    ks = jax.random.split(key, 32)
    f32 = jnp.float32
    D = D_MODEL

    def nrm(k, shape, std):
        return jax.random.normal(k, shape, f32) * std

    u = jax.random.uniform(ks[20], (N_ODD, 2, LRU_WIDTH), f32, minval=0.9, maxval=0.999)
    a0 = u ** (1.0 / LRU_C)
    return {
        'x': nrm(ks[0], (BATCH, SEQ, D), 1.0),
        'c': nrm(ks[1], (BATCH, D), 1.0),
        'ctx': nrm(ks[2], (BATCH, CTX_LEN, D), 1.0),
        'c_ctx': nrm(ks[3], (D,), 1.0),
        'ada_w': nrm(ks[4], (DEPTH, D, 6 * D), 0.5 * D ** -0.5),
        'ada_b': nrm(ks[5], (DEPTH, 6 * D), 0.01),
        'ln_g': 1.0 + nrm(ks[6], (DEPTH, 2, D), 0.01),
        'ln_b': nrm(ks[7], (DEPTH, 2, D), 0.01),
        'ev_w_in': nrm(ks[8], (N_EVEN, D, EVEN_IN_WIDTH), D ** -0.5),
        'ev_w_out': nrm(ks[9], (N_EVEN, MIX_WIDTH, D), DEEPNORM_BETA * MIX_WIDTH ** -0.5),
        'na_rpb': nrm(ks[10], (N_EVEN, N_NA_HEADS, 2 * NA_WIN_ROWS - 1, 2 * NA_WIN_COLS - 1), 0.1),
        'hg_lb_raw': nrm(ks[11], (2, N_EVEN, HG_WIDTH), 0.5),
        'hg_norm_g': 1.0 + nrm(ks[12], (N_EVEN, HEAD_DIM), 0.01),
        'od_w_in': nrm(ks[13], (N_ODD, D, 2 * LRU_WIDTH), D ** -0.5),
        'od_conv_w': nrm(ks[14], (N_ODD, CONV_W, LRU_WIDTH), CONV_W ** -0.5),
        'od_conv_b': nrm(ks[15], (N_ODD, LRU_WIDTH), 0.01),
        'lru_w_a': nrm(ks[16], (N_ODD, 2, LRU_BLOCKS, LRU_BLOCK_DIM, LRU_BLOCK_DIM), LRU_BLOCK_DIM ** -0.5),
        'lru_b_a': nrm(ks[17], (N_ODD, 2, LRU_WIDTH), 0.01),
        'lru_w_x': nrm(ks[18], (N_ODD, 2, LRU_BLOCKS, LRU_BLOCK_DIM, LRU_BLOCK_DIM), LRU_BLOCK_DIM ** -0.5),
        'lru_b_x': nrm(ks[19], (N_ODD, 2, LRU_WIDTH), 0.01),
        'lru_lam': jnp.log(a0) - jnp.log1p(-a0),
        'od_w_out': nrm(ks[21], (N_ODD, LRU_WIDTH, D), DEEPNORM_BETA * LRU_WIDTH ** -0.5),
        'router_w': nrm(ks[22], (DEPTH, D, N_EXPERTS), D ** -0.5),
        'router_bias': nrm(ks[23], (DEPTH, N_EXPERTS), 0.01),
        'exp_w_gate': nrm(ks[24], (DEPTH, N_EXPERTS, D, EXPERT_HIDDEN), D ** -0.5),
        'exp_w_up': nrm(ks[25], (DEPTH, N_EXPERTS, D, EXPERT_HIDDEN), D ** -0.5),
        'exp_w_down': nrm(ks[26], (DEPTH, N_EXPERTS, EXPERT_HIDDEN, D), DEEPNORM_BETA * EXPERT_HIDDEN ** -0.5),
        'sh_w_gate': nrm(ks[27], (DEPTH, D, SHARED_HIDDEN), D ** -0.5),
        'sh_w_up': nrm(ks[28], (DEPTH, D, SHARED_HIDDEN), D ** -0.5),
        'sh_w_down': nrm(ks[29], (DEPTH, SHARED_HIDDEN, D), DEEPNORM_BETA * SHARED_HIDDEN ** -0.5),
    }


def reference(x, c, ctx, c_ctx, ada_w, ada_b, ln_g, ln_b, ev_w_in, ev_w_out, na_rpb, hg_lb_raw, hg_norm_g,
              od_w_in, od_conv_w, od_conv_b, lru_w_a, lru_b_a, lru_w_x, lru_b_x, lru_lam, od_w_out,
              router_w, router_bias, exp_w_gate, exp_w_up, exp_w_down, sh_w_gate, sh_w_up, sh_w_down):
    bsz, n, d = x.shape
    n_ctx_tok = ctx.shape[0] * ctx.shape[1]
    p_lb = jax.nn.softmax(hg_lb_raw.astype(jnp.float32), axis=1)
    hg_lb = jnp.cumsum(p_lb, axis=1) - p_lb[:, :1]
    silu_c = jax.nn.silu(c)
    silu_cc = jax.nn.silu(c_ctx)
    x_lat = x
    x_ctx = ctx
    for l in range(DEPTH):
        last = l == DEPTH - 1
        j = l // 2
        mod_x = jnp.split((silu_c @ ada_w[l] + ada_b[l])[:, None, :], 6, axis=-1)
        mod_c = jnp.split(silu_cc @ ada_w[l] + ada_b[l], 6, axis=-1)
        hx = x_lat * (1.0 + mod_x[1]) + mod_x[0]
        hc = x_ctx * (1.0 + mod_c[1]) + mod_c[0]
        if l % 2 == 0:
            ox, oc = even_mixer(hx, hc, ev_w_in[j], ev_w_out[j], na_rpb[j], hg_lb[:, j], hg_norm_g[j], not last)
        else:
            ox, oc = rglru_mixer(hx, hc, od_w_in[j], od_conv_w[j], od_conv_b[j], lru_w_a[j], lru_b_a[j],
                                 lru_w_x[j], lru_b_x[j], lru_lam[j], od_w_out[j], not last)
        x_lat = layer_norm(DEEPNORM_ALPHA * x_lat + mod_x[2] * ox, ln_g[l, 0], ln_b[l, 0])
        hx = x_lat * (1.0 + mod_x[4]) + mod_x[3]
        if last:
            y = moe(hx.reshape(-1, d), router_w[l], router_bias[l], exp_w_gate[l], exp_w_up[l], exp_w_down[l],
                    sh_w_gate[l], sh_w_up[l], sh_w_down[l])
        else:
            x_ctx = layer_norm(DEEPNORM_ALPHA * x_ctx + mod_c[2] * oc, ln_g[l, 0], ln_b[l, 0])
            hc = x_ctx * (1.0 + mod_c[4]) + mod_c[3]
            y_all = moe(jnp.concatenate([hc.reshape(-1, d), hx.reshape(-1, d)], axis=0), router_w[l],
                        router_bias[l], exp_w_gate[l], exp_w_up[l], exp_w_down[l],
                        sh_w_gate[l], sh_w_up[l], sh_w_down[l])
            x_ctx = layer_norm(DEEPNORM_ALPHA * x_ctx + mod_c[5] * y_all[:n_ctx_tok].reshape(x_ctx.shape),
                               ln_g[l, 1], ln_b[l, 1])
            y = y_all[n_ctx_tok:]
        x_lat = layer_norm(DEEPNORM_ALPHA * x_lat + mod_x[5] * y.reshape(bsz, n, d), ln_g[l, 1], ln_b[l, 1])
    return x_lat
```

```cpp
#include <hip/hip_runtime.h>
#include <cstdio>
#include <cstdint>

#ifndef PHM
#define PHM 0xFFFF
#endif
#ifndef MK_SPLIT
#define MK_SPLIT 1
#endif

typedef unsigned short bf16_t;
typedef short bf16x8 __attribute__((ext_vector_type(8)));
typedef short bf16x4 __attribute__((ext_vector_type(4)));
typedef float f32x4 __attribute__((ext_vector_type(4)));
typedef float f32x2 __attribute__((ext_vector_type(2)));
typedef unsigned u32x4 __attribute__((ext_vector_type(4)));
typedef unsigned u32x2 __attribute__((ext_vector_type(2)));
#define LAS __attribute__((address_space(3)))

constexpr int DM = 1024, NBAT = 4, SEQ = 8192, CTXL = 256;
constexpr int TC = NBAT * CTXL, TX = NBAT * SEQ, TT = TC + TX;
constexpr int NEXP = 64, TOPK = 6;
constexpr int CAP = TT;
constexpr int MOE_ROUTED_ROWS = 6 * TT + 64 * 256;
constexpr int MOE_ROWS = MOE_ROUTED_ROWS + TT;
constexpr int MOE_MAXTILES = MOE_ROWS / 256;
constexpr float ALPHA = 1.681792830507429f;
constexpr int HG_U = 128, HG_NU = (CTXL + SEQ) / HG_U;
constexpr int LRU_NT = (CTXL + SEQ) / 16;

constexpr size_t OFF_CTL = 0, CTL_BYTES = 65536;
constexpr size_t CTL_CNT = 16384, CTL_DBG = 20480;
constexpr size_t OFF_MODS = 65536;
constexpr size_t OFF_LBT = OFF_MODS + 4 * 5 * 6144 * 4;
constexpr size_t OFF_TOKE = 1u << 20;
constexpr size_t OFF_TOKP = OFF_TOKE + (size_t)TT * 32;
constexpr size_t OFF_TOKW = OFF_TOKP + (size_t)TT * 32;
constexpr size_t OFF_STOK = OFF_TOKW + (size_t)TT * 32;
constexpr size_t OFF_SW = OFF_STOK + (size_t)64 * CAP * 4;
constexpr size_t OFF_X = OFF_SW + (size_t)64 * CAP * 4;
constexpr size_t OFF_HB = OFF_X + (size_t)TT * DM * 4;
constexpr size_t OFF_WB = OFF_HB + (size_t)TT * DM * 2;
constexpr size_t WB_IN = 0, WB_OUT = WB_IN + (size_t)4096 * 1024 * 2, WB_RT = WB_OUT + (size_t)1024 * 1024 * 2, WB_GU = WB_RT + (size_t)64 * 1024 * 2,
                 WB_DN = WB_GU + (size_t)65 * 512 * 1024 * 2, WB_LRU = WB_DN + (size_t)65 * 1024 * 256 * 2, WB_END = WB_LRU + (size_t)2 * 2 * 16 * 64 * 64 * 2;
constexpr size_t OFF_R1 = OFF_WB + WB_END;
constexpr size_t R1_P = 0;
constexpr size_t R1_OF = R1_P + (size_t)TT * 4096 * 2;
constexpr size_t R1_SLOC = R1_OF + (size_t)TT * 512 * 4;
constexpr size_t R1_SST = R1_SLOC + (size_t)64 * HG_NU * 4096 * 4;
constexpr size_t R1_DL = R1_SST + (size_t)64 * HG_NU * 4096 * 4;
constexpr size_t R1_AG = R1_OF;
constexpr size_t R1_HST = R1_AG + (size_t)4 * 2 * LRU_NT * 2 * 1024 * 4;
constexpr size_t R1_H = 0;
constexpr size_t R1_Y = R1_H + (size_t)MOE_ROWS * 256 * 2;
constexpr size_t R1_MOE_END = R1_Y + (size_t)MOE_ROWS * 1024 * 2;
constexpr size_t R1_MIX_END = R1_DL + (size_t)64 * HG_NU * 64 * 4;
constexpr size_t WS_END = OFF_R1 + (R1_MOE_END > R1_MIX_END ? R1_MOE_END : R1_MIX_END);

constexpr int LDS_STAGE = 131072;
constexpr int LDS_MISC = LDS_STAGE;
constexpr int MISC_CNT = 64;
constexpr int MISC_TST = MISC_CNT + 66 * 4 + 8;
constexpr int MISC_HIST = 640;
constexpr int MISC_HBASE = 896;
constexpr int MISC_T2E = 1152;
constexpr int MISC_INP = 2304;
constexpr int LDS_BYTES = 147456;

#define XB_TMO      128
#define XB_XCNT(j)  (256  + 64 * (j))
#define XB_XSUB(j)  (1280 + 64 * (j))
#define XB_XGEN(j)  (2304 + 64 * (j))
#define XB_TOP      3328
#define XB_TOPGEN   3392
#define XCD_BAR_WORDS 3456
#define XB_SPIN_CAP (1u << 22)
__device__ __forceinline__ unsigned xb_ld(unsigned* p)              { return __hip_atomic_load(p, __ATOMIC_RELAXED, __HIP_MEMORY_SCOPE_AGENT); }
__device__ __forceinline__ unsigned xb_add(unsigned* p, unsigned v) { return __hip_atomic_fetch_add(p, v, __ATOMIC_RELAXED, __HIP_MEMORY_SCOPE_AGENT); }
__device__ __forceinline__ unsigned xb_xcc_id() { return (unsigned)__builtin_amdgcn_s_getreg((3 << 11) | 20) & 0xFu; }
#define XB_SPIN(cond, bar) do { unsigned _sp = 0; while (cond) { __builtin_amdgcn_s_sleep(1); \
    if ((++_sp & 255u) == 0u) { if (xb_ld(&(bar)[XB_TMO])) break; if (_sp > XB_SPIN_CAP) { atomicAdd(&(bar)[XB_TMO], 1u); break; } } } } while (0)
struct XcdBarrier { unsigned* bar; unsigned x; volatile LAS unsigned* st; };
__device__ __forceinline__ XcdBarrier xcd_barrier_post(unsigned* bar, volatile LAS unsigned* st) {
    XcdBarrier b; b.bar = bar; b.x = xb_xcc_id(); b.st = st;
    if (threadIdx.x == 0) (void)xb_add(&bar[XB_XCNT(b.x)], 1u);
    return b;
}
__device__ __forceinline__ void xcd_barrier_complete(unsigned* bar, unsigned x, unsigned& nloc, unsigned& nx) {
    const unsigned G = gridDim.x * gridDim.y * gridDim.z;
    unsigned sum, cnt, mine, sp = 0u;
    for (;;) {
        sum = 0u; cnt = 0u; mine = 0u;
#pragma unroll
        for (unsigned j = 0; j < 16; ++j) { const unsigned c = xb_ld(&bar[XB_XCNT(j)]); sum += c; cnt += (c > 0u) ? 1u : 0u; mine = (j == x) ? c : mine; }
        if (sum == G) break;
        __builtin_amdgcn_s_sleep(1);
        if ((++sp & 255u) == 0u) { if (xb_ld(&bar[XB_TMO])) break; if (sp > XB_SPIN_CAP) { atomicAdd(&bar[XB_TMO], 1u); break; } }
    }
    nloc = mine > 0u ? mine : 1u; nx = cnt > 0u ? cnt : 1u;
}
__device__ __forceinline__ void xcd_barrier(const XcdBarrier& b) {
    asm volatile("s_waitcnt vmcnt(0)" ::: "memory");
    __syncthreads();
    if (threadIdx.x == 0) {
        unsigned* bar = b.bar;
        __builtin_amdgcn_s_waitcnt(0);
        unsigned nloc = b.st[0], nx = b.st[1];
        if (nloc == 0u) { xcd_barrier_complete(bar, b.x, nloc, nx); b.st[0] = nloc; b.st[1] = nx; }
        const unsigned old = xb_add(&bar[XB_XSUB(b.x)], 1u);
        const unsigned gen = old / nloc;
        if (old + 1u == (gen + 1u) * nloc) {
            __builtin_amdgcn_fence(__ATOMIC_RELEASE, "agent");
            asm volatile("s_waitcnt vmcnt(0)" ::: "memory");
            const unsigned og = xb_add(&bar[XB_TOP], 1u);
            const unsigned tg = og / nx;
            if (og + 1u == (tg + 1u) * nx) xb_add(&bar[XB_TOPGEN], 1u);
            else XB_SPIN(xb_ld(&bar[XB_TOPGEN]) == tg, bar);
            __builtin_amdgcn_fence(__ATOMIC_ACQUIRE, "agent");
            xb_add(&bar[XB_XGEN(b.x)], 1u);
            asm volatile("s_waitcnt vmcnt(0)" ::: "memory");
        } else {
            XB_SPIN(xb_ld(&bar[XB_XGEN(b.x)]) == gen, bar);
            __builtin_amdgcn_fence(__ATOMIC_ACQUIRE, "agent");
            asm volatile("s_waitcnt vmcnt(0)" ::: "memory");
        }
    }
    __syncthreads();
}

__device__ __forceinline__ float bf2f(unsigned short b) { return __uint_as_float(((unsigned)b) << 16); }
__device__ __forceinline__ unsigned cvt_pk_bf16(float lo, float hi) { unsigned r; asm volatile("v_cvt_pk_bf16_f32 %0, %1, %2" : "=v"(r) : "v"(lo), "v"(hi)); return r; }
__device__ __forceinline__ unsigned short f2bf(float f) { return (unsigned short)(cvt_pk_bf16(f, 0.f) & 0xffffu); }
__device__ __forceinline__ float sigmoidf_(float x) { return __builtin_amdgcn_rcpf(1.0f + __expf(-x)); }
__device__ __forceinline__ float siluf_(float x) { return x * sigmoidf_(x); }
__device__ __forceinline__ float gelu_tanh_(float x) { return x * sigmoidf_(1.5957691216057308f * (x + 0.044715f * x * x * x)); }
__device__ __forceinline__ int slot_of_row(int r) { return r < TC ? 4 : ((r - TC) >> 13); }
template <int CTRL> __device__ __forceinline__ float dppf(float oldv, float src) {
    return __int_as_float(__builtin_amdgcn_update_dpp(__float_as_int(oldv), __float_as_int(src), CTRL, 0xf, 0xf, false));
}
__device__ __forceinline__ void unpack8(const u32x4 w, float (&o)[8]) {
    o[0] = __uint_as_float(w.x << 16); o[1] = __uint_as_float(w.x & 0xffff0000u); o[2] = __uint_as_float(w.y << 16); o[3] = __uint_as_float(w.y & 0xffff0000u);
    o[4] = __uint_as_float(w.z << 16); o[5] = __uint_as_float(w.z & 0xffff0000u); o[6] = __uint_as_float(w.w << 16); o[7] = __uint_as_float(w.w & 0xffff0000u);
}

namespace pg8 {
constexpr int BM = 256, BK = 64, HALF = 128, HTB = HALF * BK * 2, STAGE_BYTES = 8 * HTB, NXCD = 8, WGM = 8;
__device__ __forceinline__ int lds_byte(int r, int c) { const int st = (r >> 4) * 2 + (c >> 5), rr = r & 15, cc = c & 31, ob = rr * 64 + cc * 2; return st * 1024 + (ob ^ (((ob >> 9) & 1) << 5)); }
__device__ __forceinline__ void stage_rc(int b, int& R, int& C) { const int st = b / 1024, sb = b % 1024, swz = sb ^ (((sb >> 9) & 1) << 5); R = (st >> 1) * 16 + swz / 64; C = (st & 1) * 32 + (swz % 64) / 2; }
__device__ __forceinline__ int perm32(int rho) { const int n = rho >> 4, i = rho & 15; return 8 * (i >> 2) + 4 * n + (i & 3); }
struct Unit { int pm, pn, e, ti; };

struct StaticOrder {
    const char* A; const char* Bt; int K;
    int nM, nN, nwg, G, c;
    __device__ __forceinline__ void init(const void* A_, const void* Bt_, int M, int N, int K_, int G_, int c_) { A = (const char*)A_; Bt = (const char*)Bt_; K = K_; nM = M / BM; nN = N / BM; nwg = nM * nN; G = G_; c = c_; }
    __device__ __forceinline__ bool next(int i, Unit& u) const {
        const long L = (long)i * G + c; if (L >= nwg) return false;
        int wgid = (int)L; { const int q = nwg / NXCD, r = nwg % NXCD, xcd = wgid % NXCD, off = wgid / NXCD; wgid = (xcd < r ? xcd * (q + 1) : r * (q + 1) + (xcd - r) * q) + off; }
        const int nig = WGM * nN, gid = wgid / nig, fm = gid * WGM, gsz = (nM - fm) < WGM ? (nM - fm) : WGM;
        u.pm = fm + ((wgid % nig) % gsz); u.pn = (wgid % nig) / gsz; u.e = 0; u.ti = 0; return true;
    }
    static constexpr bool GATHER = false;
    __device__ __forceinline__ const char* abase(const Unit& u) const { return A + (size_t)u.pm * BM * K * 2; }
    __device__ __forceinline__ const char* bbase(const Unit& u) const { return Bt + (size_t)u.pn * BM * K * 2; }
};

template <class Epi, class Sched>
__device__ __forceinline__ void gemm_phase(LAS unsigned char* lds, const int K_, const Sched& S, const Epi& E) {
    int Kl_ = K_; asm volatile("" : "+s"(Kl_)); const int K = Kl_;
    int tid_ = threadIdx.x; asm volatile("" : "+v"(tid_));
    const int tid = tid_, wid = __builtin_amdgcn_readfirstlane(tid >> 6), lane = tid & 63, wr = wid >> 2, wc = wid & 3, fr = lane & 15, fq = lane >> 4;
    const int nt = K / BK;
    unsigned voffA[2], voffB[2];
#pragma unroll
    for (int i = 0; i < 2; ++i) { int R, C; stage_rc(tid * 16 + i * 8192, R, C); const int Rb = Epi::PERM ? ((R & ~31) + perm32(R & 31)) : R; voffA[i] = (unsigned)(R * K + C) * 2u; voffB[i] = (unsigned)(Rb * K + C) * 2u; }
    const size_t kstep = (size_t)(BK * 2);
    const size_t hstep = (size_t)HALF * K * 2;
    const unsigned ldsw = (unsigned)wid * 1024u;
    const int aoff = lds_byte(wr * 64 + fr, fq * 8), boff = lds_byte(wc * 32 + fr, fq * 8);
#define PG8_SA(b, h) (((b) * 2 + (h)) * HTB)
#define PG8_SB(b, h) ((4 + (b) * 2 + (h)) * HTB)
#define PG8_STAGE(bufoff, gbase, voff) do { _Pragma("unroll") for (int _i = 0; _i < 2; ++_i) \
        __builtin_amdgcn_global_load_lds((const unsigned*)((const char*)(gbase) + (voff)[_i]), (LAS unsigned*)(lds + (bufoff) + ldsw + _i * 8192), 16, 0, 0); } while (0)
#define PG8_STAGEA(bufoff, hh, kb, nx) do { if constexpr (Sched::GATHER) { unsigned _o[2]; _o[0] = (nx) ? vN[hh][0] : vC[hh][0]; _o[1] = (nx) ? vN[hh][1] : vC[hh][1]; PG8_STAGE(bufoff, cA + (kb), _o); } \
        else { PG8_STAGE(bufoff, ((nx) ? nA : cA) + (hh) * hstep + (kb), voffA); } } while (0)
#define PG8_LDA(dst, b, h) do { _Pragma("unroll") for (int m = 0; m < 4; ++m) _Pragma("unroll") for (int k = 0; k < 2; ++k) dst[m][k] = *(const LAS bf16x8*)(lds + PG8_SA(b, h) + aoff + m * 2048 + k * 1024); } while (0)
#define PG8_LDB(dst, b, h) do { _Pragma("unroll") for (int n = 0; n < 2; ++n) _Pragma("unroll") for (int k = 0; k < 2; ++k) dst[n][k] = *(const LAS bf16x8*)(lds + PG8_SB(b, h) + boff + n * 2048 + k * 1024); } while (0)
#define PG8_MMA(ai, bj, At, Bt) do { __builtin_amdgcn_s_setprio(1); _Pragma("unroll") for (int m = 0; m < 4; ++m) _Pragma("unroll") for (int n = 0; n < 2; ++n) _Pragma("unroll") for (int k = 0; k < 2; ++k) \
        acc[ai][bj][m][n] = __builtin_amdgcn_mfma_f32_16x16x32_bf16(Bt[n][k], At[m][k], acc[ai][bj][m][n], 0, 0, 0); __builtin_amdgcn_s_setprio(0); } while (0)
#define PG8_WAIT_V(n) asm volatile("s_waitcnt vmcnt(" #n ")" ::: "memory")
#define PG8_WAIT_L(n) asm volatile("s_waitcnt lgkmcnt(" #n ")" ::: "memory")
#define PG8_BAR __builtin_amdgcn_s_barrier()
#define PG8_SCHED __builtin_amdgcn_sched_barrier(0)
    Unit cur, nxt; int ui = 0;
    if (!S.next(0, cur)) return;
    f32x4 acc[2][2][4][2];
#pragma unroll
    for (int a = 0; a < 2; ++a)
#pragma unroll
        for (int b = 0; b < 2; ++b)
#pragma unroll
            for (int m = 0; m < 4; ++m)
#pragma unroll
                for (int n = 0; n < 2; ++n) acc[a][b][m][n] = (f32x4){0.f, 0.f, 0.f, 0.f};
    bf16x8 At[4][2], B0[2][2], B1[2][2];
    unsigned vC[2][2], vN[2][2];
    if constexpr (Sched::GATHER) S.aoff(cur, tid, vC);
    const char* cA = S.abase(cur);
    const char* cB = S.bbase(cur);
    const char* nA = cA;
    PG8_STAGE(PG8_SB(0, 0), cB, voffB); PG8_STAGEA(PG8_SA(0, 0), 0, 0, false); PG8_STAGE(PG8_SB(0, 1), cB + hstep, voffB); PG8_STAGEA(PG8_SA(0, 1), 1, 0, false);
    if (wr == 1) PG8_BAR;
    PG8_WAIT_V(4); PG8_BAR;
    PG8_STAGE(PG8_SB(1, 0), cB + kstep, voffB); PG8_STAGEA(PG8_SA(1, 0), 0, kstep, false); PG8_STAGE(PG8_SB(1, 1), cB + hstep + kstep, voffB);
    PG8_WAIT_V(6); PG8_BAR;
    for (;;) {
        const bool has_next = S.next(ui + 1, nxt);
        const char* nB = cB; nA = cA;
        if (has_next) { nB = S.bbase(nxt); nA = S.abase(nxt); if constexpr (Sched::GATHER) S.aoff(nxt, tid, vN); }
        else { if constexpr (Sched::GATHER) {
#pragma unroll
            for (int h = 0; h < 2; ++h)
#pragma unroll
                for (int i = 0; i < 2; ++i) vN[h][i] = vC[h][i]; } }
        for (int t = 0; t < nt; t += 2) {
            const bool last = (t == nt - 2);
            const size_t k1 = (size_t)(t + 1) * kstep, k2 = last ? 0 : (size_t)(t + 2) * kstep, k3 = k2 + kstep;
            const char* b2 = last ? nB : cB + (size_t)(t + 2) * kstep; const char* b3 = b2 + kstep;
            PG8_LDB(B0, 0, 0); PG8_SCHED; PG8_LDA(At, 0, 0); PG8_STAGEA(PG8_SA(1, 1), 1, k1, false);
            PG8_WAIT_L(8); PG8_BAR; PG8_WAIT_L(0); PG8_MMA(0, 0, At, B0); PG8_BAR; PG8_SCHED;
            PG8_LDB(B1, 0, 1); PG8_STAGE(PG8_SB(0, 0), b2, voffB);
            PG8_BAR; PG8_WAIT_L(0); PG8_MMA(0, 1, At, B1); PG8_BAR;
            PG8_LDA(At, 0, 1); PG8_STAGEA(PG8_SA(0, 0), 0, k2, last);
            PG8_BAR; PG8_WAIT_L(0); PG8_MMA(1, 0, At, B0); PG8_BAR; PG8_SCHED;
            PG8_STAGE(PG8_SB(0, 1), b2 + hstep, voffB);
            PG8_WAIT_V(6); PG8_BAR; PG8_MMA(1, 1, At, B1); PG8_BAR;
            PG8_LDB(B0, 1, 0); PG8_SCHED; PG8_LDA(At, 1, 0); PG8_STAGEA(PG8_SA(0, 1), 1, k2, last);
            PG8_WAIT_L(8); PG8_BAR; PG8_WAIT_L(0); PG8_MMA(0, 0, At, B0); PG8_BAR; PG8_SCHED;
            PG8_LDB(B1, 1, 1); PG8_STAGE(PG8_SB(1, 0), b3, voffB);
            PG8_BAR; PG8_WAIT_L(0); PG8_MMA(0, 1, At, B1); PG8_BAR;
            PG8_LDA(At, 1, 1); PG8_STAGEA(PG8_SA(1, 0), 0, k3, last);
            PG8_BAR; PG8_WAIT_L(0); PG8_MMA(1, 0, At, B0); PG8_BAR; PG8_SCHED;
            PG8_STAGE(PG8_SB(1, 1), b3 + hstep, voffB);
            PG8_WAIT_V(6); PG8_BAR; PG8_MMA(1, 1, At, B1); PG8_BAR;
        }
        E(acc, cur, wr, wc, fr, fq);
        if (!has_next) break;
#pragma unroll
        for (int a = 0; a < 2; ++a)
#pragma unroll
            for (int b = 0; b < 2; ++b)
#pragma unroll
                for (int m = 0; m < 4; ++m)
#pragma unroll
                    for (int n = 0; n < 2; ++n) acc[a][b][m][n] = (f32x4){0.f, 0.f, 0.f, 0.f};
        cur = nxt; cB = nB; cA = nA; ++ui;
        if constexpr (Sched::GATHER) {
#pragma unroll
            for (int h = 0; h < 2; ++h)
#pragma unroll
                for (int i = 0; i < 2; ++i) vC[h][i] = vN[h][i]; }
    }
    PG8_WAIT_V(0);
    if (wr == 0) PG8_BAR;
    PG8_BAR;
#undef PG8_SA
#undef PG8_SB
#undef PG8_STAGE
#undef PG8_STAGEA
#undef PG8_LDA
#undef PG8_LDB
#undef PG8_MMA
#undef PG8_WAIT_V
#undef PG8_WAIT_L
#undef PG8_BAR
#undef PG8_SCHED
}

struct EpiStoreBf16 {
    static constexpr bool PERM = true;
    bf16_t* O; int ldc;
    __device__ __forceinline__ void operator()(const f32x4 (&acc)[2][2][4][2], const Unit& u, int wr, int wc, int fr, int fq) const {
        const int row0 = u.pm * BM + wr * 64 + fr, col0 = u.pn * BM + wc * 32 + 8 * fq;
#pragma unroll
        for (int ai = 0; ai < 2; ++ai)
#pragma unroll
            for (int m = 0; m < 4; ++m) { bf16_t* rowp = O + (size_t)(row0 + ai * HALF + m * 16) * ldc + col0;
#pragma unroll
                for (int bj = 0; bj < 2; ++bj) { const f32x4 v0 = acc[ai][bj][m][0], v1 = acc[ai][bj][m][1];
                    u32x4 w; w.x = cvt_pk_bf16(v0[0], v0[1]); w.y = cvt_pk_bf16(v0[2], v0[3]); w.z = cvt_pk_bf16(v1[0], v1[1]); w.w = cvt_pk_bf16(v1[2], v1[3]);
                    *(u32x4*)(rowp + bj * HALF) = w; } }
    }
};
struct EpiResid {
    static constexpr bool PERM = false;
    float* X; const float* mods_l;
    __device__ __forceinline__ void operator()(const f32x4 (&acc)[2][2][4][2], const Unit& u, int wr, int wc, int fr, int fq) const {
        const int row0 = u.pm * BM + wr * 64 + fr, col0 = u.pn * BM + wc * 32 + 4 * fq;
        const float* m2 = mods_l + (size_t)(slot_of_row(u.pm * BM) * 6 + 2) * DM + col0;
        float* xb = X + (size_t)row0 * DM + col0;
#pragma unroll
        for (int bj = 0; bj < 2; ++bj)
#pragma unroll
            for (int n = 0; n < 2; ++n) { const f32x4 mv = *(const f32x4*)(m2 + bj * HALF + n * 16);
#pragma unroll
                for (int ai = 0; ai < 2; ++ai) {
#pragma unroll
                    for (int m = 0; m < 4; ++m) { float* p = xb + (size_t)(ai * HALF + m * 16) * DM + bj * HALF + n * 16; const f32x4 xv = *(const f32x4*)p; *(f32x4*)p = xv * ALPHA + mv * acc[ai][bj][m][n]; }
                    asm volatile("" ::: "memory"); } }
    }
};
struct EpiSwiglu {
    static constexpr bool PERM = true;
    bf16_t* H;
    __device__ __forceinline__ void operator()(const f32x4 (&acc)[2][2][4][2], const Unit& u, int wr, int wc, int fr, int fq) const {
        const int row0 = u.pm * BM + wr * 64 + fr, col0 = u.pn * HALF + wc * 32 + 8 * fq;
#pragma unroll
        for (int ai = 0; ai < 2; ++ai)
#pragma unroll
            for (int m = 0; m < 4; ++m) { bf16_t* rowp = H + (size_t)(row0 + ai * HALF + m * 16) * 256 + col0;
                float h[8];
#pragma unroll
                for (int n = 0; n < 2; ++n)
#pragma unroll
                    for (int j = 0; j < 4; ++j) h[n * 4 + j] = siluf_(acc[ai][0][m][n][j]) * acc[ai][1][m][n][j];
                u32x4 w; w.x = cvt_pk_bf16(h[0], h[1]); w.y = cvt_pk_bf16(h[2], h[3]); w.z = cvt_pk_bf16(h[4], h[5]); w.w = cvt_pk_bf16(h[6], h[7]);
                *(u32x4*)rowp = w; }
    }
};
struct EpiDown {
    static constexpr bool PERM = true;
    bf16_t* Y; const float* sw; const LAS int* cnt;
    __device__ __forceinline__ void operator()(const f32x4 (&acc)[2][2][4][2], const Unit& u, int wr, int wc, int fr, int fq) const {
        const int row0 = u.pm * BM + wr * 64 + fr, col0 = u.pn * BM + wc * 32 + 8 * fq;
        const int ce = (u.e < 64) ? cnt[u.e] : 0;
        const float* swe = sw + (size_t)(u.e < 64 ? u.e : 0) * CAP + u.ti * 256 + wr * 64 + fr;
        bf16_t* yb = Y + (size_t)row0 * DM + col0;
#pragma unroll
        for (int ai = 0; ai < 2; ++ai)
#pragma unroll
            for (int m = 0; m < 4; ++m) { const int rl = ai * HALF + m * 16, pos = u.ti * 256 + wr * 64 + fr + rl;
                float w = 1.0f; if (u.e < 64) w = (pos < ce) ? swe[rl] : 0.0f;
                bf16_t* rowp = yb + (size_t)rl * DM;
#pragma unroll
                for (int bj = 0; bj < 2; ++bj) { const f32x4 v0 = acc[ai][bj][m][0] * w, v1 = acc[ai][bj][m][1] * w;
                    u32x4 ww; ww.x = cvt_pk_bf16(v0[0], v0[1]); ww.y = cvt_pk_bf16(v0[2], v0[3]); ww.z = cvt_pk_bf16(v1[0], v1[1]); ww.w = cvt_pk_bf16(v1[2], v1[3]);
                    *(u32x4*)(rowp + bj * HALF) = ww; }
                asm volatile("" ::: "memory"); }
    }
};
struct MoeOrder {
    const LAS int* cnt; const LAS int* tst; const LAS unsigned char* t2e; int ntiles, npn, G, c;
    __device__ __forceinline__ bool next(int i, Unit& u) const {
        const int L = i * G + c; if (L >= ntiles * npn) return false;
        const int tau = L / npn; u.pm = tau; u.pn = L % npn; u.e = t2e[tau]; u.ti = tau - tst[u.e]; return true;
    }
};
struct MoeGU : MoeOrder {
    static constexpr bool GATHER = true;
    const char* A; const char* Bt; const int* stok;
    __device__ __forceinline__ const char* abase(const Unit&) const { return A; }
    __device__ __forceinline__ const char* bbase(const Unit& u) const { return Bt + ((size_t)u.e * 512 + (size_t)u.pn * 256) * 1024 * 2; }
    __device__ __forceinline__ void aoff(const Unit& u, int tid, unsigned (&off)[2][2]) const {
        const int ce = cnt[u.e];
#pragma unroll
        for (int i = 0; i < 2; ++i) { int R, C; stage_rc(tid * 16 + i * 8192, R, C);
#pragma unroll
            for (int h = 0; h < 2; ++h) { const int pos = u.ti * 256 + h * HALF + R; int tok;
                if (u.e == 64) tok = pos; else tok = (pos < ce) ? stok[(size_t)u.e * CAP + pos] : 0;
                off[h][i] = (unsigned)(tok * 1024 + C) * 2u; } }
    }
};
struct MoeDN : MoeOrder {
    static constexpr bool GATHER = false;
    const char* A; const char* Bt;
    __device__ __forceinline__ const char* abase(const Unit& u) const { return A + (size_t)u.pm * BM * 256 * 2; }
    __device__ __forceinline__ const char* bbase(const Unit& u) const { return Bt + ((size_t)u.e * 1024 + (size_t)u.pn * 256) * 256 * 2; }
};
}

struct Args { const float* in[30]; float* out; unsigned char* ws; int ph_lo, ph_hi; };

struct Frame {
    float* out; unsigned char* ws; LAS unsigned char* lds; int tid, lane, wave, G, wg;
    float* mods; float* X; bf16_t* HB; bf16_t* MIX; unsigned char* WB; unsigned char* R1;
};

__device__ __forceinline__ const float* inp(const Frame& F, int i) {
    const unsigned long long v = ((const LAS unsigned long long*)(F.lds + LDS_MISC + MISC_INP))[i];
    const unsigned lo = (unsigned)__builtin_amdgcn_readfirstlane((int)(unsigned)v), hi = (unsigned)__builtin_amdgcn_readfirstlane((int)(unsigned)(v >> 32));
    return (const float*)(((unsigned long long)hi << 32) | lo);
}
__device__ __forceinline__ Frame fresh(const Frame& F0) { Frame F = F0; int t = F0.tid; asm volatile("" : "+v"(t)); F.tid = t; F.lane = t & 63; return F; }

__device__ __forceinline__ void ph_mods(const Frame& F) {
    const float* c = inp(F, 1); const float* cc = inp(F, 3); const float* ada_w = inp(F, 4); const float* ada_b = inp(F, 5);
    LAS float* sv = (LAS float*)F.lds;
    LAS float* red = (LAS float*)(F.lds + 5 * 1024 * 4);
    for (int i = F.tid; i < 5 * 1024; i += 512) { const int s = i >> 10, k = i & 1023; const float v = (s < 4) ? c[s * 1024 + k] : cc[k]; sv[i] = siluf_(v); }
    __syncthreads();
    for (int task = F.wg; task < 4 * 48; task += F.G) {
        const int l = task / 48, cc0 = (task % 48) * 128;
        const int col = cc0 + (F.tid & 127), kg = F.tid >> 7;
        const float* w = ada_w + (size_t)l * 1024 * 6144 + col;
        float a0 = 0.f, a1 = 0.f, a2 = 0.f, a3 = 0.f, a4 = 0.f;
        for (int k = kg * 256; k < kg * 256 + 256; ++k) { const float wv = w[(size_t)k * 6144]; a0 += sv[k] * wv; a1 += sv[1024 + k] * wv; a2 += sv[2048 + k] * wv; a3 += sv[3072 + k] * wv; a4 += sv[4096 + k] * wv; }
        LAS float* r = red + (kg * 128 + (F.tid & 127)) * 5; r[0] = a0; r[1] = a1; r[2] = a2; r[3] = a3; r[4] = a4;
        __syncthreads();
        if (F.tid < 128) {
            const float b = ada_b[l * 6144 + col];
#pragma unroll
            for (int s = 0; s < 5; ++s) { const float v = ((red[(0 * 128 + F.tid) * 5 + s] + red[(1 * 128 + F.tid) * 5 + s]) + red[(2 * 128 + F.tid) * 5 + s]) + red[(3 * 128 + F.tid) * 5 + s];
                F.mods[(size_t)(l * 5 + s) * 6144 + col] = v + b; }
        }
        __syncthreads();
    }
    if (F.wg == F.G - 1) {
        const float* raw = inp(F, 11); float* lbt = (float*)(F.ws + OFF_LBT);
        for (int i = F.tid; i < 2 * 512; i += 512) { const int d = i >> 9, ch = i & 511; const float r0 = raw[(d * 2 + 0) * 512 + ch], r1 = raw[(d * 2 + 1) * 512 + ch];
            lbt[(0 * 2 + d) * 512 + ch] = 0.f; lbt[(1 * 2 + d) * 512 + ch] = sigmoidf_(r1 - r0); }
    }
}

__device__ __forceinline__ void ph_init_x(const Frame& F) {
    const float* x = inp(F, 0); const float* ctx = inp(F, 2);
    const int gw = F.wg * 8 + F.wave, nw = F.G * 8;
    for (int row = gw; row < TT; row += nw) {
        const float* src = row < TC ? ctx + (size_t)row * DM : x + (size_t)(row - TC) * DM;
        const float* m = F.mods + (size_t)(0 * 5 + slot_of_row(row)) * 6144;
#pragma unroll
        for (int hh = 0; hh < 2; ++hh) { const int k = hh * 512 + F.lane * 8;
            const f32x4 v0 = *(const f32x4*)(src + k), v1 = *(const f32x4*)(src + k + 4);
            *(f32x4*)(F.X + (size_t)row * DM + k) = v0; *(f32x4*)(F.X + (size_t)row * DM + k + 4) = v1;
            const f32x4 s0 = *(const f32x4*)(m + 1024 + k), s1 = *(const f32x4*)(m + 1024 + k + 4), b0 = *(const f32x4*)(m + k), b1 = *(const f32x4*)(m + k + 4);
            const f32x4 h0 = v0 * (s0 + 1.0f) + b0, h1 = v1 * (s1 + 1.0f) + b1;
            u32x4 w; w.x = cvt_pk_bf16(h0[0], h0[1]); w.y = cvt_pk_bf16(h0[2], h0[3]); w.z = cvt_pk_bf16(h1[0], h1[1]); w.w = cvt_pk_bf16(h1[2], h1[3]);
            *(u32x4*)(F.HB + (size_t)row * DM + k) = w; }
    }
}

__device__ __forceinline__ void cvt_tile(const Frame& F, const float* src, int sld, int k0, int n0, bf16_t* dst, int dld, int drow0, float scale) {
    LAS float* t = (LAS float*)F.lds;
    { const int i = F.tid >> 3, j0 = (F.tid & 7) * 8; const float* p = src + (size_t)(k0 + i) * sld + n0 + j0;
      const f32x4 a = *(const f32x4*)p, b = *(const f32x4*)(p + 4);
      LAS float* q = t + i * 65 + j0; q[0] = a[0]; q[1] = a[1]; q[2] = a[2]; q[3] = a[3]; q[4] = b[0]; q[5] = b[1]; q[6] = b[2]; q[7] = b[3]; }
    __syncthreads();
    { const int j = F.tid >> 3, i0 = (F.tid & 7) * 8; float v[8];
#pragma unroll
      for (int q = 0; q < 8; ++q) v[q] = t[(i0 + q) * 65 + j] * scale;
      u32x4 w; w.x = cvt_pk_bf16(v[0], v[1]); w.y = cvt_pk_bf16(v[2], v[3]); w.z = cvt_pk_bf16(v[4], v[5]); w.w = cvt_pk_bf16(v[6], v[7]);
      *(u32x4*)(dst + (size_t)(drow0 + j) * dld + k0 + i0) = w; }
    __syncthreads();
}
__device__ __forceinline__ void ph_convert(const Frame& F, int l) {
    const int j = l >> 1; const bool even = (l & 1) == 0;
    bf16_t* wIN = (bf16_t*)(F.WB + WB_IN); bf16_t* wOUT = (bf16_t*)(F.WB + WB_OUT); bf16_t* wRT = (bf16_t*)(F.WB + WB_RT);
    bf16_t* wGU = (bf16_t*)(F.WB + WB_GU); bf16_t* wDN = (bf16_t*)(F.WB + WB_DN); bf16_t* wLRU = (bf16_t*)(F.WB + WB_LRU);
    const int nIN = even ? 4096 : 2048;
    const int t_in = (nIN / 64) * 16, t_out = 256, t_rt = 16, t_gu = 65 * 2 * 64, t_dn = 65 * 64, t_lru = even ? 0 : 64;
    const int total = t_in + t_out + t_rt + t_gu + t_dn + t_lru;
    for (int task = F.wg; task < total; task += F.G) {
        int t = task;
        if (t < t_in) { const int nb = t >> 4, kb = t & 15; const float* src = even ? inp(F, 8) + (size_t)j * 1024 * 4096 : inp(F, 13) + (size_t)j * 1024 * 2048;
            cvt_tile(F, src, nIN, kb * 64, nb * 64, wIN, 1024, nb * 64, (even && nb < 8) ? 0.125f : 1.0f); continue; }
        t -= t_in;
        if (t < t_out) { const int nb = t >> 4, kb = t & 15; const float* src = even ? inp(F, 9) + (size_t)j * 1024 * 1024 : inp(F, 21) + (size_t)j * 1024 * 1024;
            cvt_tile(F, src, 1024, kb * 64, nb * 64, wOUT, 1024, nb * 64, 1.0f); continue; }
        t -= t_out;
        if (t < t_rt) { cvt_tile(F, inp(F, 22) + (size_t)l * 1024 * 64, 64, t * 64, 0, wRT, 1024, 0, 1.0f); continue; }
        t -= t_rt;
        if (t < t_gu) { const int e = t / 128, r = t % 128, which = r >> 6, q = r & 63, nb = q >> 4, kb = q & 15;
            const float* src = (e < 64) ? (which ? inp(F, 25) : inp(F, 24)) + ((size_t)l * 64 + e) * 1024 * 256 : (which ? inp(F, 28) : inp(F, 27)) + (size_t)l * 1024 * 256;
            const int n0 = nb * 64, drow0 = (n0 >> 7) * 256 + which * 128 + (n0 & 127);
            cvt_tile(F, src, 256, kb * 64, n0, wGU + (size_t)e * 512 * 1024, 1024, drow0, 1.0f); continue; }
        t -= t_gu;
        if (t < t_dn) { const int e = t >> 6, q = t & 63, nb = q >> 2, kb = q & 3;
            const float* src = (e < 64) ? inp(F, 26) + ((size_t)l * 64 + e) * 256 * 1024 : inp(F, 29) + (size_t)l * 256 * 1024;
            cvt_tile(F, src, 1024, kb * 64, nb * 64, wDN + (size_t)e * 1024 * 256, 256, nb * 64, 1.0f); continue; }
        t -= t_dn;
        { const int d = t >> 5, gt = (t >> 4) & 1, kb = t & 15;
          const float* src = (gt ? inp(F, 18) : inp(F, 16)) + (((size_t)j * 2 + d) * 16 + kb) * 4096;
          cvt_tile(F, src, 64, 0, 0, wLRU + (((size_t)d * 2 + gt) * 16 + kb) * 4096, 64, 0, 1.0f); }
    }
}

__device__ __forceinline__ void ph_attn(const Frame& F, int j) {
    const bf16_t* P = (const bf16_t*)(F.R1 + R1_P);
    LAS bf16_t* Ks = (LAS bf16_t*)F.lds;
    LAS bf16_t* Vt = (LAS bf16_t*)(F.lds + 9216);
    LAS float* rp_l = (LAS float*)(F.lds + 18432);
    const float* rpb = inp(F, 10) + (size_t)j * 8 * 465;
    const int g = F.lane >> 4, l15 = F.lane & 15;
    const int NLAT = NBAT * 8 * 64, NTASK = NLAT + NBAT * 8 * 2;
    for (int task = F.wg; task < NTASK; task += F.G) {
        const bool lat = task < NLAT;
        int b, h, rp = 0, half = 0;
        if (lat) { b = task >> 9; h = (task >> 6) & 7; rp = task & 63; } else { const int t2 = task - NLAT; b = t2 >> 4; h = (t2 >> 1) & 7; half = t2 & 1; }
        const int myr = 2 * rp + (F.wave >> 2), w0 = (F.wave & 3) * 16;
        const int r0 = min(max(myr - 4, 0), 120);
        const int rlo = min(max(2 * rp - 4, 0), 120), rhi = min(max(2 * rp + 1 - 4, 0), 120) + 7;
        const int nloc = lat ? (rhi - rlo + 1) : 0;
        const int qrow = lat ? (TC + b * SEQ + myr * 64 + w0 + l15) : (b * CTXL + half * 128 + F.wave * 16 + l15);
        bf16x8 qf[2];
        qf[0] = *(const bf16x8*)(P + (size_t)qrow * 4096 + h * 64 + g * 8);
        qf[1] = *(const bf16x8*)(P + (size_t)qrow * 4096 + h * 64 + 32 + g * 8);
        if (lat) for (int i = F.tid; i < 465; i += 512) rp_l[i] = rpb[h * 465 + i];
        f32x4 oacc[4];
#pragma unroll
        for (int dt = 0; dt < 4; ++dt) oacc[dt] = (f32x4){0.f, 0.f, 0.f, 0.f};
        float mrun = -1e30f, lrun = 0.f;
        const int wq = w0 + l15, c0 = min(max(wq - 8, 0), 48);
        for (int ch = 0; ch < nloc + 4; ++ch) {
            const bool loc = ch < nloc; const int kr = rlo + ch;
            { const int key = F.tid >> 3, ds = (F.tid & 7) * 8;
              const int krow = loc ? (TC + b * SEQ + kr * 64 + key) : (b * CTXL + (ch - nloc) * 64 + key);
              const u32x4 kv = *(const u32x4*)(P + (size_t)krow * 4096 + 512 + h * 64 + ds);
              const u32x4 vv = *(const u32x4*)(P + (size_t)krow * 4096 + 1024 + h * 64 + ds);
              __syncthreads();
              *(LAS u32x4*)(Ks + key * 72 + ds) = kv;
              Vt[(ds + 0) * 72 + key] = (bf16_t)(vv.x & 0xffff); Vt[(ds + 1) * 72 + key] = (bf16_t)(vv.x >> 16);
              Vt[(ds + 2) * 72 + key] = (bf16_t)(vv.y & 0xffff); Vt[(ds + 3) * 72 + key] = (bf16_t)(vv.y >> 16);
              Vt[(ds + 4) * 72 + key] = (bf16_t)(vv.z & 0xffff); Vt[(ds + 5) * 72 + key] = (bf16_t)(vv.z >> 16);
              Vt[(ds + 6) * 72 + key] = (bf16_t)(vv.w & 0xffff); Vt[(ds + 7) * 72 + key] = (bf16_t)(vv.w >> 16);
              __syncthreads(); }
            const bool mine = loc ? (kr >= r0 && kr < r0 + 8) : true;
            if (mine) {
                f32x4 s[4];
#pragma unroll
                for (int kb = 0; kb < 4; ++kb) { s[kb] = (f32x4){0.f, 0.f, 0.f, 0.f};
#pragma unroll
                    for (int ks = 0; ks < 2; ++ks) { const bf16x8 a = *(const LAS bf16x8*)(Ks + (kb * 16 + l15) * 72 + ks * 32 + g * 8);
                        s[kb] = __builtin_amdgcn_mfma_f32_16x16x32_bf16(a, qf[ks], s[kb], 0, 0, 0); } }
                if (loc) {
#pragma unroll
                    for (int kb = 0; kb < 4; ++kb)
#pragma unroll
                        for (int i = 0; i < 4; ++i) { const int kc = kb * 16 + 4 * g + i; const bool valid = (kc >= c0) && (kc < c0 + 16);
                            const int bi = (kr - myr + 7) * 31 + min(max(kc - wq + 15, 0), 30);
                            s[kb][i] = valid ? s[kb][i] + rp_l[bi] : -1e30f; }
                }
                float cm = -1e30f;
#pragma unroll
                for (int kb = 0; kb < 4; ++kb)
#pragma unroll
                    for (int i = 0; i < 4; ++i) cm = fmaxf(cm, s[kb][i]);
                cm = fmaxf(cm, __shfl_xor(cm, 16)); cm = fmaxf(cm, __shfl_xor(cm, 32));
                const float mn = fmaxf(mrun, cm), sc = __expf(mrun - mn);
                mrun = mn; lrun *= sc;
#pragma unroll
                for (int dt = 0; dt < 4; ++dt) oacc[dt] *= sc;
                float p[4][4];
#pragma unroll
                for (int kb = 0; kb < 4; ++kb)
#pragma unroll
                    for (int i = 0; i < 4; ++i) { p[kb][i] = __expf(s[kb][i] - mn); lrun += p[kb][i]; }
#pragma unroll
                for (int kp = 0; kp < 2; ++kp) {
                    u32x4 pw; pw.x = cvt_pk_bf16(p[2 * kp][0], p[2 * kp][1]); pw.y = cvt_pk_bf16(p[2 * kp][2], p[2 * kp][3]);
                    pw.z = cvt_pk_bf16(p[2 * kp + 1][0], p[2 * kp + 1][1]); pw.w = cvt_pk_bf16(p[2 * kp + 1][2], p[2 * kp + 1][3]);
                    bf16x8 pf; __builtin_memcpy(&pf, &pw, 16);
#pragma unroll
                    for (int dt = 0; dt < 4; ++dt) {
                        const u32x2 v0 = *(const LAS u32x2*)(Vt + (dt * 16 + l15) * 72 + (2 * kp) * 16 + 4 * g);
                        const u32x2 v1 = *(const LAS u32x2*)(Vt + (dt * 16 + l15) * 72 + (2 * kp + 1) * 16 + 4 * g);
                        u32x4 vw; vw.x = v0.x; vw.y = v0.y; vw.z = v1.x; vw.w = v1.y; bf16x8 vf; __builtin_memcpy(&vf, &vw, 16);
                        oacc[dt] = __builtin_amdgcn_mfma_f32_16x16x32_bf16(vf, pf, oacc[dt], 0, 0, 0);
                    }
                }
            }
        }
        float lt = lrun; lt += __shfl_xor(lt, 16); lt += __shfl_xor(lt, 32);
        const float inv = 1.0f / lt;
#pragma unroll
        for (int dt = 0; dt < 4; ++dt) { const f32x4 o = oacc[dt] * inv; u32x2 w; w.x = cvt_pk_bf16(o[0], o[1]); w.y = cvt_pk_bf16(o[2], o[3]);
            *(u32x2*)(F.MIX + (size_t)qrow * DM + h * 64 + dt * 16 + 4 * g) = w; }
        __syncthreads();
    }
}

__device__ __forceinline__ int hg_unit(int nb, int dir) { return dir == 0 ? nb : (nb < 2 ? 1 - nb : 2 + (HG_NU - 3 - (nb - 2))); }
__device__ __forceinline__ int hg_row(int b, int nb, int t) { return nb < 2 ? b * CTXL + nb * HG_U + t : TC + b * SEQ + (nb - 2) * HG_U + t; }
template <bool WITHQ>
__device__ __forceinline__ void hg_stage(const Frame& F, const bf16_t* P, const float* lb, int b, int h, int nb, int dir, int sb, LAS float* Fb, LAS float* Vb, LAS float* Qb, float (&dprod)[16]) {
    const int tk = F.lane & 15, cg = F.lane >> 4;
    const int pos = sb * 16 + tk, t = dir ? (HG_U - 1 - pos) : pos;
    const bf16_t* pr = P + (size_t)hg_row(b, nb, t) * 4096 + h * 64 + cg * 16;
    float z[16], v[16];
    { const u32x4 a = *(const u32x4*)(pr + (dir ? 2560 : 2048)), c = *(const u32x4*)(pr + (dir ? 2560 : 2048) + 8); float t0[8], t1[8]; unpack8(a, t0); unpack8(c, t1);
#pragma unroll
      for (int i = 0; i < 8; ++i) { z[i] = t0[i]; z[8 + i] = t1[i]; } }
    { const u32x4 a = *(const u32x4*)(pr + 3072), c = *(const u32x4*)(pr + 3072 + 8); float t0[8], t1[8]; unpack8(a, t0); unpack8(c, t1);
#pragma unroll
      for (int i = 0; i < 8; ++i) { v[i] = t0[i]; v[8 + i] = t1[i]; } }
#pragma unroll
    for (int q = 0; q < 4; ++q) { f32x4 fv, vv;
#pragma unroll
        for (int i = 0; i < 4; ++i) { const int c = q * 4 + i; const float lbv = lb[h * 64 + cg * 16 + c]; const float f = fmaxf(lbv + (1.0f - lbv) * sigmoidf_(z[c]), 1e-30f); fv[i] = f; vv[i] = v[c];
            float pr2 = f; pr2 *= dppf<0xB1>(pr2, pr2); pr2 *= dppf<0x4E>(pr2, pr2); pr2 *= dppf<0x141>(pr2, pr2); pr2 *= dppf<0x140>(pr2, pr2); dprod[c] *= pr2; }
        *(LAS f32x4*)(Fb + tk * 64 + cg * 16 + q * 4) = fv; *(LAS f32x4*)(Vb + tk * 64 + cg * 16 + q * 4) = vv; }
    if (WITHQ) {
        const u32x4 a = *(const u32x4*)(pr + 1536), c = *(const u32x4*)(pr + 1536 + 8); float t0[8], t1[8]; unpack8(a, t0); unpack8(c, t1);
#pragma unroll
        for (int q = 0; q < 2; ++q) { f32x4 x0, x1;
#pragma unroll
            for (int i = 0; i < 4; ++i) { x0[i] = siluf_(t0[q * 4 + i]) * 0.125f; x1[i] = siluf_(t1[q * 4 + i]) * 0.125f; }
            *(LAS f32x4*)(Qb + tk * 64 + cg * 16 + q * 4) = x0; *(LAS f32x4*)(Qb + tk * 64 + cg * 16 + 8 + q * 4) = x1; }
    }
}
__device__ __forceinline__ void ph_hg_a(const Frame& F, int j) {
    const bf16_t* P = (const bf16_t*)(F.R1 + R1_P);
    float* SLOC = (float*)(F.R1 + R1_SLOC); float* DL = (float*)(F.R1 + R1_DL);
    LAS float* Fb = (LAS float*)(F.lds + 32768 + F.wave * 12288); LAS float* Vb = Fb + 1024;
    const int gw = F.wg * 8 + F.wave, nw = F.G * 8;
    const int NT = NBAT * 8 * HG_NU * 2;
    for (int task = gw; task < NT; task += nw) {
        const int dir = task & 1, nb = (task >> 1) % HG_NU, bh = (task >> 1) / HG_NU, b = bh >> 3, h = bh & 7;
        const float* lb = (const float*)(F.ws + OFF_LBT) + (j * 2 + dir) * 512;
        float S[64];
#pragma unroll
        for (int k = 0; k < 64; ++k) S[k] = 0.f;
        float dprod[16];
#pragma unroll
        for (int c = 0; c < 16; ++c) dprod[c] = 1.0f;
        for (int sb = 0; sb < HG_U / 16; ++sb) {
            hg_stage<false>(F, P, lb, b, h, nb, dir, sb, Fb, Vb, nullptr, dprod);
            for (int t = 0; t < 16; ++t) {
                const float vv = Vb[t * 64 + F.lane];
#pragma unroll
                for (int k4 = 0; k4 < 16; ++k4) { const f32x4 f4 = *(const LAS f32x4*)(Fb + t * 64 + k4 * 4);
#pragma unroll
                    for (int i = 0; i < 4; ++i) S[k4 * 4 + i] = fmaf(f4[i], S[k4 * 4 + i] - vv, vv); }
            }
        }
        const int seq = bh * 2 + dir, u = hg_unit(nb, dir);
        float* so = SLOC + ((size_t)seq * HG_NU + u) * 4096;
#pragma unroll
        for (int k = 0; k < 64; ++k) so[k * 64 + F.lane] = S[k];
        if ((F.lane & 15) == 0) { float* dd = DL + ((size_t)seq * HG_NU + u) * 64 + (F.lane >> 4) * 16;
#pragma unroll
            for (int c = 0; c < 16; ++c) dd[c] = dprod[c]; }
    }
}
__device__ __forceinline__ void ph_hg_b(const Frame& F) {
    const float* SLOC = (const float*)(F.R1 + R1_SLOC); const float* DL = (const float*)(F.R1 + R1_DL); float* SST = (float*)(F.R1 + R1_SST);
    for (int idx = F.wg * 512 + F.tid; idx < 64 * 4096; idx += F.G * 512) {
        const int seq = idx >> 12, kv = idx & 4095, k = kv >> 6;
        float s = 0.f;
        for (int u = 0; u < HG_NU; ++u) { const size_t o = ((size_t)seq * HG_NU + u) * 4096 + kv; SST[o] = s; s = DL[((size_t)seq * HG_NU + u) * 64 + k] * s + SLOC[o]; }
    }
}
__device__ __forceinline__ void ph_hg_c(const Frame& F, int j) {
    const bf16_t* P = (const bf16_t*)(F.R1 + R1_P);
    const float* SST = (const float*)(F.R1 + R1_SST); float* OF = (float*)(F.R1 + R1_OF);
    const float* ng = inp(F, 12) + j * 64;
    LAS float* Fb = (LAS float*)(F.lds + 32768 + F.wave * 12288); LAS float* Vb = Fb + 1024; LAS float* Qb = Fb + 2048;
    const int gw = F.wg * 8 + F.wave, nw = F.G * 8;
    const int NT = NBAT * 8 * HG_NU;
    const float ngl = ng[F.lane];
    for (int task = gw; task < NT; task += nw) {
        const int nb = task % HG_NU, bh = task / HG_NU, b = bh >> 3, h = bh & 7;
        for (int dir = 0; dir < 2; ++dir) {
            const float* lb = (const float*)(F.ws + OFF_LBT) + (j * 2 + dir) * 512;
            const int seq = bh * 2 + dir, u = hg_unit(nb, dir);
            const float* ss = SST + ((size_t)seq * HG_NU + u) * 4096;
            float S[64];
#pragma unroll
            for (int k = 0; k < 64; ++k) S[k] = ss[k * 64 + F.lane];
            float dprod[16];
#pragma unroll
            for (int c = 0; c < 16; ++c) dprod[c] = 1.0f;
            for (int sb = 0; sb < HG_U / 16; ++sb) {
                hg_stage<true>(F, P, lb, b, h, nb, dir, sb, Fb, Vb, Qb, dprod);
                for (int t = 0; t < 16; ++t) {
                    const float vv = Vb[t * 64 + F.lane];
                    float o0 = 0.f, o1 = 0.f;
#pragma unroll
                    for (int k4 = 0; k4 < 16; ++k4) { const f32x4 f4 = *(const LAS f32x4*)(Fb + t * 64 + k4 * 4); const f32x4 q4 = *(const LAS f32x4*)(Qb + t * 64 + k4 * 4);
#pragma unroll
                        for (int i = 0; i < 4; ++i) { const float sn = fmaf(f4[i], S[k4 * 4 + i] - vv, vv); S[k4 * 4 + i] = sn; if (i & 1) o1 = fmaf(sn, q4[i], o1); else o0 = fmaf(sn, q4[i], o0); } }
                    const float o = o0 + o1;
                    const int pos = sb * 16 + t, tt = dir ? (HG_U - 1 - pos) : pos, row = hg_row(b, nb, tt);
                    if (dir == 0) OF[(size_t)row * 512 + h * 64 + F.lane] = o;
                    else {
                        const float tot = o + OF[(size_t)row * 512 + h * 64 + F.lane];
                        float sq = tot * tot;
                        sq += __shfl_xor(sq, 1); sq += __shfl_xor(sq, 2); sq += __shfl_xor(sq, 4); sq += __shfl_xor(sq, 8); sq += __shfl_xor(sq, 16); sq += __shfl_xor(sq, 32);
                        const float rs = rsqrtf(sq * (1.0f / 64.0f) + 1e-6f);
                        const float gt = bf2f(P[(size_t)row * 4096 + 3584 + h * 64 + F.lane]);
                        F.MIX[(size_t)row * DM + 512 + h * 64 + F.lane] = f2bf(tot * rs * ngl * siluf_(gt));
                    }
                }
            }
        }
    }
}

__device__ __forceinline__ int lru_nat(int so, int dir) { return dir == 0 ? so : (so < 16 ? 15 - so : 16 + (LRU_NT - 1 - so)); }
__device__ __forceinline__ int lru_row(int b, int nt, int t) { return nt < 16 ? b * CTXL + nt * 16 + t : TC + b * SEQ + (nt - 16) * 16 + t; }
__device__ __forceinline__ void lru_gates(const Frame& F, int jj, int b, int kb, int nt, LAS bf16_t* Wl, LAS float* ucb, float (&av)[2][4][4], float (&xv)[2][4][4]) {
    const bf16_t* P = (const bf16_t*)(F.R1 + R1_P);
    const int tk = F.lane & 15, g = F.lane >> 4;
    const float* cw = inp(F, 14) + (size_t)jj * 4 * 1024; const float* cb = inp(F, 15) + (size_t)jj * 1024;
    { const int len = nt < 16 ? CTXL : SEQ, tpos = (nt < 16 ? nt * 16 : (nt - 16) * 16) + tk;
      float acc[16];
#pragma unroll
      for (int c = 0; c < 16; ++c) acc[c] = cb[kb * 64 + g * 16 + c];
#pragma unroll
      for (int tap = 0; tap < 4; ++tap) { const int tp = tpos + tap - 2;
          if (tp >= 0 && tp < len) { const int row = (nt < 16 ? b * CTXL : TC + b * SEQ) + tp; const bf16_t* pr = P + (size_t)row * 2048 + 1024 + kb * 64 + g * 16;
              const u32x4 a = *(const u32x4*)pr, c2 = *(const u32x4*)(pr + 8); float t0[8], t1[8]; unpack8(a, t0); unpack8(c2, t1);
#pragma unroll
              for (int c = 0; c < 8; ++c) { acc[c] = fmaf(cw[tap * 1024 + kb * 64 + g * 16 + c], t0[c], acc[c]); acc[8 + c] = fmaf(cw[tap * 1024 + kb * 64 + g * 16 + 8 + c], t1[c], acc[8 + c]); } } }
#pragma unroll
      for (int q = 0; q < 4; ++q) *(LAS f32x4*)(ucb + tk * 64 + g * 16 + q * 4) = (f32x4){acc[q * 4], acc[q * 4 + 1], acc[q * 4 + 2], acc[q * 4 + 3]}; }
    bf16x8 bfr[2];
#pragma unroll
    for (int ks = 0; ks < 2; ++ks) { const f32x4 u0 = *(const LAS f32x4*)(ucb + tk * 64 + ks * 32 + g * 8), u1 = *(const LAS f32x4*)(ucb + tk * 64 + ks * 32 + g * 8 + 4);
        u32x4 w; w.x = cvt_pk_bf16(u0[0], u0[1]); w.y = cvt_pk_bf16(u0[2], u0[3]); w.z = cvt_pk_bf16(u1[0], u1[1]); w.w = cvt_pk_bf16(u1[2], u1[3]); __builtin_memcpy(&bfr[ks], &w, 16); }
    const float* b_a = inp(F, 17) + (size_t)jj * 2 * 1024; const float* b_x = inp(F, 19) + (size_t)jj * 2 * 1024; const float* lam = inp(F, 20) + (size_t)jj * 2 * 1024;
#pragma unroll
    for (int d = 0; d < 2; ++d)
#pragma unroll
        for (int et = 0; et < 4; ++et) {
            f32x4 ra = (f32x4){0.f, 0.f, 0.f, 0.f}, ri = (f32x4){0.f, 0.f, 0.f, 0.f};
#pragma unroll
            for (int ks = 0; ks < 2; ++ks) {
                const bf16x8 wa = *(const LAS bf16x8*)(Wl + ((d * 2 + 0) * 64 + et * 16 + tk) * 64 + ks * 32 + g * 8);
                const bf16x8 wx = *(const LAS bf16x8*)(Wl + ((d * 2 + 1) * 64 + et * 16 + tk) * 64 + ks * 32 + g * 8);
                ra = __builtin_amdgcn_mfma_f32_16x16x32_bf16(wa, bfr[ks], ra, 0, 0, 0);
                ri = __builtin_amdgcn_mfma_f32_16x16x32_bf16(wx, bfr[ks], ri, 0, 0, 0);
            }
#pragma unroll
            for (int i = 0; i < 4; ++i) { const int ch = kb * 64 + et * 16 + 4 * g + i;
                const float r = sigmoidf_(ra[i] + b_a[d * 1024 + ch]), ig = sigmoidf_(ri[i] + b_x[d * 1024 + ch]);
                const float lm = lam[d * 1024 + ch]; const float sp = log1pf(__expf(-lm));
                const float la = -8.0f * r * sp, a = __expf(la);
                const float u = ucb[tk * 64 + et * 16 + 4 * g + i];
                av[d][et][i] = a; xv[d][et][i] = sqrtf(fmaxf(-expm1f(2.0f * la), 0.f)) * ig * u; }
        }
}
template <int S> __device__ __forceinline__ void lru_step_f(float& a, float& x) { const float ap = dppf<0x110 + S>(1.0f, a), xp = dppf<0x110 + S>(0.0f, x); x = fmaf(a, xp, x); a = a * ap; }
template <int S> __device__ __forceinline__ void lru_step_b(float& a, float& x) { const float ap = dppf<0x100 + S>(1.0f, a), xp = dppf<0x100 + S>(0.0f, x); x = fmaf(a, xp, x); a = a * ap; }
template <bool FINAL>
__device__ __forceinline__ void ph_lru_ac(const Frame& F, int jj) {
    LAS bf16_t* Wl = (LAS bf16_t*)F.lds;
    LAS float* ucb = (LAS float*)(F.lds + 32768 + F.wave * 4096);
    const bf16_t* wsrc = (const bf16_t*)(F.WB + WB_LRU);
    float* AG = (float*)(F.R1 + R1_AG); const float* HST = (const float*)(F.R1 + R1_HST);
    const bf16_t* P = (const bf16_t*)(F.R1 + R1_P);
    const int tk = F.lane & 15, g = F.lane >> 4;
    const int NTASK = NBAT * 16 * 17;
    for (int task = F.wg; task < NTASK; task += F.G) {
        const int grp = task % 17, kb = (task / 17) & 15, b = task / (17 * 16);
        __syncthreads();
        for (int i = F.tid; i < 4 * 4096 / 8; i += 512) { const int mg = i >> 9, r = i & 511;
            *(LAS u32x4*)(Wl + mg * 4096 + r * 8) = *(const u32x4*)(wsrc + ((size_t)mg * 16 + kb) * 4096 + r * 8); }
        __syncthreads();
        const int ntiles = grp == 16 ? 16 : 32, nt0 = grp == 16 ? 0 : 16 + grp * 32;
        for (int ti = F.wave; ti < ntiles; ti += 8) {
            const int nt = nt0 + ti;
            float av[2][4][4], xv[2][4][4];
            lru_gates(F, jj, b, kb, nt, Wl, ucb, av, xv);
#pragma unroll
            for (int et = 0; et < 4; ++et)
#pragma unroll
                for (int i = 0; i < 4; ++i) {
                    lru_step_f<1>(av[0][et][i], xv[0][et][i]); lru_step_f<2>(av[0][et][i], xv[0][et][i]); lru_step_f<4>(av[0][et][i], xv[0][et][i]); lru_step_f<8>(av[0][et][i], xv[0][et][i]);
                    lru_step_b<1>(av[1][et][i], xv[1][et][i]); lru_step_b<2>(av[1][et][i], xv[1][et][i]); lru_step_b<4>(av[1][et][i], xv[1][et][i]); lru_step_b<8>(av[1][et][i], xv[1][et][i]);
                }
            if (!FINAL) {
#pragma unroll
                for (int d = 0; d < 2; ++d) if (tk == (d ? 0 : 15)) {
                    float* ag = AG + (((size_t)(b * 2 + d) * LRU_NT + nt) * 2) * 1024 + kb * 64;
#pragma unroll
                    for (int et = 0; et < 4; ++et) { *(f32x4*)(ag + et * 16 + 4 * g) = (f32x4){av[d][et][0], av[d][et][1], av[d][et][2], av[d][et][3]};
                        *(f32x4*)(ag + 1024 + et * 16 + 4 * g) = (f32x4){xv[d][et][0], xv[d][et][1], xv[d][et][2], xv[d][et][3]}; }
                }
            } else {
                const int row = lru_row(b, nt, tk);
#pragma unroll
                for (int et = 0; et < 4; ++et) {
                    const int ch = kb * 64 + et * 16 + 4 * g;
                    const f32x4 hf = *(const f32x4*)(HST + ((size_t)(b * 2 + 0) * LRU_NT + nt) * 1024 + ch);
                    const f32x4 hb = *(const f32x4*)(HST + ((size_t)(b * 2 + 1) * LRU_NT + nt) * 1024 + ch);
                    const u32x2 yw = *(const u32x2*)(P + (size_t)row * 2048 + ch);
                    const float y0 = __uint_as_float(yw.x << 16), y1 = __uint_as_float(yw.x & 0xffff0000u), y2 = __uint_as_float(yw.y << 16), y3 = __uint_as_float(yw.y & 0xffff0000u);
                    float o[4];
#pragma unroll
                    for (int i = 0; i < 4; ++i) o[i] = fmaf(av[0][et][i], hf[i], xv[0][et][i]) + fmaf(av[1][et][i], hb[i], xv[1][et][i]);
                    o[0] *= gelu_tanh_(y0); o[1] *= gelu_tanh_(y1); o[2] *= gelu_tanh_(y2); o[3] *= gelu_tanh_(y3);
                    u32x2 w; w.x = cvt_pk_bf16(o[0], o[1]); w.y = cvt_pk_bf16(o[2], o[3]);
                    *(u32x2*)(F.MIX + (size_t)row * DM + ch) = w;
                }
            }
        }
    }
    __syncthreads();
}
__device__ __forceinline__ void ph_lru_b(const Frame& F) {
    const float* AG = (const float*)(F.R1 + R1_AG); float* HST = (float*)(F.R1 + R1_HST);
    LAS float* sa = (LAS float*)F.lds; LAS float* sx = sa + 512;
    for (int task = F.wg; task < NBAT * 2 * 32; task += F.G) {
        const int cgp = task & 31, d = (task >> 5) & 1, b = task >> 6;
        const int ch = cgp * 32 + (F.tid & 31), seg = F.tid >> 5;
        const float* ag = AG + ((size_t)(b * 2 + d) * LRU_NT) * 2048 + ch;
        float A = 1.0f, Xv = 0.f;
        for (int i = 0; i < 33; ++i) { const int nt = lru_nat(seg * 33 + i, d); const float a = ag[(size_t)nt * 2048], x = ag[(size_t)nt * 2048 + 1024]; Xv = fmaf(a, Xv, x); A *= a; }
        __syncthreads();
        sa[F.tid] = A; sx[F.tid] = Xv;
        __syncthreads();
        float h = 0.f;
        for (int s2 = 0; s2 < seg; ++s2) h = fmaf(sa[s2 * 32 + (F.tid & 31)], h, sx[s2 * 32 + (F.tid & 31)]);
        float* hs = HST + ((size_t)(b * 2 + d) * LRU_NT) * 1024 + ch;
        for (int i = 0; i < 33; ++i) { const int nt = lru_nat(seg * 33 + i, d); hs[(size_t)nt * 1024] = h; const float a = ag[(size_t)nt * 2048], x = ag[(size_t)nt * 2048 + 1024]; h = fmaf(a, h, x); }
    }
    __syncthreads();
}

__device__ __forceinline__ void ph_ln_router(const Frame& F, int l) {
    const float* gam = inp(F, 6) + (size_t)(l * 2 + 0) * DM; const float* bet = inp(F, 7) + (size_t)(l * 2 + 0) * DM;
    const bf16_t* RW = (const bf16_t*)(F.WB + WB_RT);
    const float* rbias = inp(F, 23) + l * 64;
    LAS float* lg = (LAS float*)(F.lds + F.wave * 4096);
    LAS int* hist = (LAS int*)(F.lds + LDS_MISC + MISC_HIST); LAS int* hbase = (LAS int*)(F.lds + LDS_MISC + MISC_HBASE);
    int* tok_e = (int*)(F.ws + OFF_TOKE); int* tok_p = (int*)(F.ws + OFF_TOKP); float* tok_w = (float*)(F.ws + OFF_TOKW);
    int* stok = (int*)(F.ws + OFF_STOK); float* sw = (float*)(F.ws + OFF_SW);
    unsigned* gcnt = (unsigned*)(F.ws + OFF_CTL + CTL_CNT) + l * 64;
    const int tk = F.lane & 15, g = F.lane >> 4;
    if (F.tid < 64) hist[F.tid] = 0;
    __syncthreads();
    const int NTILE = TT / 16;
    for (int it = 0;; ++it) {
        const int tile = (it * F.G + F.wg) * 8 + F.wave;
        if ((it * F.G + F.wg) * 8 >= NTILE) break;
        if (tile < NTILE) {
            const int row = tile * 16 + tk; const int s = slot_of_row(tile * 16);
            const float* m = F.mods + (size_t)(l * 5 + s) * 6144;
            float* xr = F.X + (size_t)row * DM;
            float sum = 0.f, sq = 0.f;
            for (int ks = 0; ks < 32; ++ks) { const f32x4 a = *(const f32x4*)(xr + ks * 32 + g * 8), c = *(const f32x4*)(xr + ks * 32 + g * 8 + 4);
                sum += (a[0] + a[1]) + (a[2] + a[3]) + (c[0] + c[1]) + (c[2] + c[3]);
                sq += (a[0] * a[0] + a[1] * a[1]) + (a[2] * a[2] + a[3] * a[3]) + (c[0] * c[0] + c[1] * c[1]) + (c[2] * c[2] + c[3] * c[3]); }
            sum += __shfl_xor(sum, 16); sum += __shfl_xor(sum, 32); sq += __shfl_xor(sq, 16); sq += __shfl_xor(sq, 32);
            const float mean = sum * (1.0f / 1024.0f), var = fmaxf(sq * (1.0f / 1024.0f) - mean * mean, 0.f), rstd = rsqrtf(var + 1e-5f);
            f32x4 acc[4];
#pragma unroll
            for (int et = 0; et < 4; ++et) acc[et] = (f32x4){0.f, 0.f, 0.f, 0.f};
            for (int ks = 0; ks < 32; ++ks) { const int k = ks * 32 + g * 8;
                float v[8], gm[8], bt[8], m3[8], m4[8];
                *(f32x4*)&v[0] = *(const f32x4*)(xr + k); *(f32x4*)&v[4] = *(const f32x4*)(xr + k + 4);
                *(f32x4*)&gm[0] = *(const f32x4*)(gam + k); *(f32x4*)&gm[4] = *(const f32x4*)(gam + k + 4);
                *(f32x4*)&bt[0] = *(const f32x4*)(bet + k); *(f32x4*)&bt[4] = *(const f32x4*)(bet + k + 4);
                *(f32x4*)&m3[0] = *(const f32x4*)(m + 3 * 1024 + k); *(f32x4*)&m3[4] = *(const f32x4*)(m + 3 * 1024 + k + 4);
                *(f32x4*)&m4[0] = *(const f32x4*)(m + 4 * 1024 + k); *(f32x4*)&m4[4] = *(const f32x4*)(m + 4 * 1024 + k + 4);
                float hh[8];
#pragma unroll
                for (int q = 0; q < 8; ++q) { const float xn = (v[q] - mean) * rstd * gm[q] + bt[q]; v[q] = xn; hh[q] = xn * (1.0f + m4[q]) + m3[q]; }
                *(f32x4*)(xr + k) = *(f32x4*)&v[0]; *(f32x4*)(xr + k + 4) = *(f32x4*)&v[4];
                u32x4 w; w.x = cvt_pk_bf16(hh[0], hh[1]); w.y = cvt_pk_bf16(hh[2], hh[3]); w.z = cvt_pk_bf16(hh[4], hh[5]); w.w = cvt_pk_bf16(hh[6], hh[7]);
                *(u32x4*)(F.HB + (size_t)row * DM + k) = w;
                bf16x8 af; __builtin_memcpy(&af, &w, 16);
#pragma unroll
                for (int et = 0; et < 4; ++et) { const bf16x8 bf = *(const bf16x8*)(RW + (size_t)(et * 16 + tk) * 1024 + k); acc[et] = __builtin_amdgcn_mfma_f32_16x16x32_bf16(af, bf, acc[et], 0, 0, 0); }
            }
#pragma unroll
            for (int et = 0; et < 4; ++et)
#pragma unroll
                for (int i = 0; i < 4; ++i) lg[(4 * g + i) * 64 + et * 16 + tk] = acc[et][i];
            asm volatile("s_waitcnt lgkmcnt(0)" ::: "memory");
            if (F.lane < 16) {
                const int r2 = tile * 16 + F.lane;
                unsigned long long taken = 0ull; int se[6]; float ss[6]; float tot = 0.f;
#pragma unroll
                for (int q = 0; q < 6; ++q) { float best = -1e30f; int be = 0; float bs = 0.f;
                    for (int e = 0; e < 64; ++e) { const float sc = sigmoidf_(lg[F.lane * 64 + e]); const float key = sc + rbias[e];
                        if (!((taken >> e) & 1ull) && key > best) { best = key; be = e; bs = sc; } }
                    taken |= 1ull << be; se[q] = be; ss[q] = bs; tot += bs; }
                const float sc2 = 2.5f / tot;
#pragma unroll
                for (int q = 0; q < 6; ++q) { tok_e[r2 * 8 + q] = se[q]; tok_w[r2 * 8 + q] = ss[q] * sc2; tok_p[r2 * 8 + q] = __hip_atomic_fetch_add(hist + se[q], 1, __ATOMIC_RELAXED, __HIP_MEMORY_SCOPE_WORKGROUP); }
            }
        }
    }
    asm volatile("s_waitcnt vmcnt(0) lgkmcnt(0)" ::: "memory");
    __syncthreads();
    if (F.tid < 64) hbase[F.tid] = (int)__hip_atomic_fetch_add(gcnt + F.tid, (unsigned)hist[F.tid], __ATOMIC_RELAXED, __HIP_MEMORY_SCOPE_AGENT);
    __syncthreads();
    for (int it = 0;; ++it) {
        const int r0 = (it * F.G + F.wg) * 128;
        if (r0 >= TT) break;
        for (int i = F.tid; i < 128 * 6; i += 512) { const int row = r0 + i / 6, q = i % 6; const int e = tok_e[row * 8 + q]; const int pos = hbase[e] + tok_p[row * 8 + q];
            tok_p[row * 8 + q] = pos; stok[(size_t)e * CAP + pos] = row; sw[(size_t)e * CAP + pos] = tok_w[row * 8 + q]; }
    }
    __syncthreads();
}

__device__ __forceinline__ int moe_tables(const Frame& F, int l) {
    LAS int* cnt = (LAS int*)(F.lds + LDS_MISC + MISC_CNT); LAS int* tst = (LAS int*)(F.lds + LDS_MISC + MISC_TST); LAS unsigned char* t2e = (LAS unsigned char*)(F.lds + LDS_MISC + MISC_T2E);
    const unsigned* gcnt = (const unsigned*)(F.ws + OFF_CTL + CTL_CNT) + l * 64;
    __syncthreads();
    if (F.tid < 64) cnt[F.tid] = (int)__hip_atomic_load(gcnt + F.tid, __ATOMIC_RELAXED, __HIP_MEMORY_SCOPE_AGENT);
    if (F.tid == 64) cnt[64] = TT;
    __syncthreads();
    if (F.tid == 0) { int s = 0; for (int e = 0; e < 65; ++e) { tst[e] = s; s += (cnt[e] + 255) >> 8; } tst[65] = s; }
    __syncthreads();
    const int ntiles = tst[65];
    for (int t = F.tid; t < ntiles; t += 512) { int e = 0; for (int q = 0; q < 65; ++q) if (t >= tst[q]) e = q; else break; t2e[t] = (unsigned char)e; }
    __syncthreads();
    return ntiles;
}

__device__ __forceinline__ void ph_combine(const Frame& F, int l) {
    LAS int* tst = (LAS int*)(F.lds + LDS_MISC + MISC_TST);
    (void)moe_tables(F, l);
    const float* gam = inp(F, 6) + (size_t)(l * 2 + 1) * DM; const float* bet = inp(F, 7) + (size_t)(l * 2 + 1) * DM;
    const bf16_t* Y = (const bf16_t*)(F.R1 + R1_Y);
    const int* tok_e = (const int*)(F.ws + OFF_TOKE); const int* tok_p = (const int*)(F.ws + OFF_TOKP);
    const int gw = F.wg * 8 + F.wave, nw = F.G * 8;
    const bool lastl = (l == 3);
    for (int row = gw; row < TT; row += nw) {
        const int s = slot_of_row(row);
        const float* m = F.mods + (size_t)(l * 5 + s) * 6144;
        const float* mn = F.mods + (size_t)((lastl ? l : l + 1) * 5 + s) * 6144;
        int srow[7];
#pragma unroll
        for (int q = 0; q < 6; ++q) { const int e = tok_e[row * 8 + q]; srow[q] = tst[e] * 256 + tok_p[row * 8 + q]; }
        srow[6] = tst[64] * 256 + row;
        float v[16];
#pragma unroll
        for (int hh = 0; hh < 2; ++hh) { const int k = hh * 512 + F.lane * 8;
            float y[8];
#pragma unroll
            for (int q = 0; q < 8; ++q) y[q] = 0.f;
#pragma unroll
            for (int q = 0; q < 7; ++q) { const u32x4 w = *(const u32x4*)(Y + (size_t)srow[q] * DM + k); float t[8]; unpack8(w, t);
#pragma unroll
                for (int i = 0; i < 8; ++i) y[i] += t[i]; }
            const f32x4 x0 = *(const f32x4*)(F.X + (size_t)row * DM + k), x1 = *(const f32x4*)(F.X + (size_t)row * DM + k + 4);
            const f32x4 m50 = *(const f32x4*)(m + 5 * 1024 + k), m51 = *(const f32x4*)(m + 5 * 1024 + k + 4);
#pragma unroll
            for (int i = 0; i < 4; ++i) { v[hh * 8 + i] = ALPHA * x0[i] + m50[i] * y[i]; v[hh * 8 + 4 + i] = ALPHA * x1[i] + m51[i] * y[4 + i]; }
        }
        float sum = 0.f;
#pragma unroll
        for (int i = 0; i < 16; ++i) sum += v[i];
        sum += __shfl_xor(sum, 1); sum += __shfl_xor(sum, 2); sum += __shfl_xor(sum, 4); sum += __shfl_xor(sum, 8); sum += __shfl_xor(sum, 16); sum += __shfl_xor(sum, 32);
        const float mean = sum * (1.0f / 1024.0f);
        float sq = 0.f;
#pragma unroll
        for (int i = 0; i < 16; ++i) { const float d = v[i] - mean; sq += d * d; }
        sq += __shfl_xor(sq, 1); sq += __shfl_xor(sq, 2); sq += __shfl_xor(sq, 4); sq += __shfl_xor(sq, 8); sq += __shfl_xor(sq, 16); sq += __shfl_xor(sq, 32);
        const float rstd = rsqrtf(sq * (1.0f / 1024.0f) + 1e-5f);
#pragma unroll
        for (int hh = 0; hh < 2; ++hh) { const int k = hh * 512 + F.lane * 8;
            float gm[8], bt[8], xn[8];
            *(f32x4*)&gm[0] = *(const f32x4*)(gam + k); *(f32x4*)&gm[4] = *(const f32x4*)(gam + k + 4);
            *(f32x4*)&bt[0] = *(const f32x4*)(bet + k); *(f32x4*)&bt[4] = *(const f32x4*)(bet + k + 4);
#pragma unroll
            for (int i = 0; i < 8; ++i) xn[i] = (v[hh * 8 + i] - mean) * rstd * gm[i] + bt[i];
            if (lastl) { if (row >= TC) { float* o = F.out + (size_t)(row - TC) * DM + k; *(f32x4*)o = *(f32x4*)&xn[0]; *(f32x4*)(o + 4) = *(f32x4*)&xn[4]; } }
            else {
                *(f32x4*)(F.X + (size_t)row * DM + k) = *(f32x4*)&xn[0]; *(f32x4*)(F.X + (size_t)row * DM + k + 4) = *(f32x4*)&xn[4];
                float s1[8], b0[8];
                *(f32x4*)&s1[0] = *(const f32x4*)(mn + 1024 + k); *(f32x4*)&s1[4] = *(const f32x4*)(mn + 1024 + k + 4);
                *(f32x4*)&b0[0] = *(const f32x4*)(mn + k); *(f32x4*)&b0[4] = *(const f32x4*)(mn + k + 4);
                float hv[8];
#pragma unroll
                for (int i = 0; i < 8; ++i) hv[i] = xn[i] * (1.0f + s1[i]) + b0[i];
                u32x4 w; w.x = cvt_pk_bf16(hv[0], hv[1]); w.y = cvt_pk_bf16(hv[2], hv[3]); w.z = cvt_pk_bf16(hv[4], hv[5]); w.w = cvt_pk_bf16(hv[6], hv[7]);
                *(u32x4*)(F.HB + (size_t)row * DM + k) = w;
            }
        }
    }
}

constexpr int NPHASE = 2 + 4 * 10;
__global__ void __launch_bounds__(512, 2) mk_fwd(Args args) {
    extern __shared__ __attribute__((aligned(16))) unsigned char lds_raw[];
    Frame F;
    F.out = args.out; F.ws = args.ws; F.lds = (LAS unsigned char*)lds_raw;
    F.tid = threadIdx.x; F.lane = F.tid & 63; F.wave = __builtin_amdgcn_readfirstlane(F.tid >> 6); F.G = gridDim.x; F.wg = blockIdx.x;
    F.mods = (float*)(args.ws + OFF_MODS); F.X = (float*)(args.ws + OFF_X); F.HB = (bf16_t*)(args.ws + OFF_HB); F.MIX = F.HB;
    F.WB = args.ws + OFF_WB; F.R1 = args.ws + OFF_R1;
    volatile LAS unsigned* xbw = (volatile LAS unsigned*)(F.lds + LDS_MISC);
    if (F.tid < 4) xbw[F.tid] = 0u;
    if (F.tid < 30) ((LAS unsigned long long*)(F.lds + LDS_MISC + MISC_INP))[F.tid] = (unsigned long long)args.in[F.tid];
    __syncthreads();
    const int lo = args.ph_lo, hi = args.ph_hi;
    XcdBarrier bar; bar.bar = (unsigned*)(args.ws + OFF_CTL); bar.x = 0; bar.st = xbw;
    if (hi - lo > 1) bar = xcd_barrier_post((unsigned*)(args.ws + OFF_CTL), xbw);
#define IN(k) (lo <= (k) && (k) < hi)
#define SEAM(k) do { if (IN(k) && IN((k) + 1)) xcd_barrier(bar); } while (0)
    if ((PHM & 1) && IN(0)) { ph_mods(fresh(F)); } SEAM(0);
    if ((PHM & 2) && IN(1)) { ph_init_x(fresh(F)); }
    for (int l = 0; l < 4; ++l) {
        const int pb = 2 + l * 10, j = l >> 1; const bool even = (l & 1) == 0;
        float* mods_l = F.mods + (size_t)l * 5 * 6144;
        if ((PHM & 4) && IN(pb + 0)) { ph_convert(fresh(F), l); } SEAM(pb + 0);
        if ((PHM & 8) && IN(pb + 1)) {
            const int N = even ? 4096 : 2048;
            pg8::StaticOrder S; S.init(F.HB, F.WB + WB_IN, TT, N, 1024, F.G, F.wg);
            pg8::EpiStoreBf16 E{(bf16_t*)(F.R1 + R1_P), N};
            pg8::gemm_phase(F.lds, 1024, S, E);
        } SEAM(pb + 1);
        if (IN(pb + 2)) { if (even) { if (PHM & 16) ph_attn(fresh(F), j); if (PHM & 32) ph_hg_a(fresh(F), j); } else { if (PHM & 64) ph_lru_ac<false>(fresh(F), j); } } SEAM(pb + 2);
        if (IN(pb + 3)) { if (even) { if (PHM & 128) ph_hg_b(fresh(F)); } else { if (PHM & 256) ph_lru_b(fresh(F)); } } SEAM(pb + 3);
        if (IN(pb + 4)) { if (even) { if (PHM & 512) ph_hg_c(fresh(F), j); } else { if (PHM & 1024) ph_lru_ac<true>(fresh(F), j); } } SEAM(pb + 4);
        if ((PHM & 2048) && IN(pb + 5)) {
            pg8::StaticOrder S; S.init(F.MIX, F.WB + WB_OUT, TT, 1024, 1024, F.G, F.wg);
            pg8::EpiResid E{F.X, mods_l};
            pg8::gemm_phase(F.lds, 1024, S, E);
        } SEAM(pb + 5);
        if ((PHM & 4096) && IN(pb + 6)) { ph_ln_router(fresh(F), l); } SEAM(pb + 6);
        if ((PHM & 8192) && IN(pb + 7)) {
            const int ntiles = moe_tables(fresh(F), l);
            pg8::MoeGU S; S.cnt = (const LAS int*)(F.lds + LDS_MISC + MISC_CNT); S.tst = (const LAS int*)(F.lds + LDS_MISC + MISC_TST); S.t2e = (const LAS unsigned char*)(F.lds + LDS_MISC + MISC_T2E);
            S.ntiles = ntiles; S.npn = 2; S.G = F.G; S.c = F.wg; S.A = (const char*)F.HB; S.Bt = (const char*)(F.WB + WB_GU); S.stok = (const int*)(F.ws + OFF_STOK);
            pg8::EpiSwiglu E{(bf16_t*)(F.R1 + R1_H)};
            pg8::gemm_phase(F.lds, 1024, S, E);
        } SEAM(pb + 7);
        if ((PHM & 16384) && IN(pb + 8)) {
            const int ntiles = moe_tables(fresh(F), l);
            pg8::MoeDN S; S.cnt = (const LAS int*)(F.lds + LDS_MISC + MISC_CNT); S.tst = (const LAS int*)(F.lds + LDS_MISC + MISC_TST); S.t2e = (const LAS unsigned char*)(F.lds + LDS_MISC + MISC_T2E);
            S.ntiles = ntiles; S.npn = 4; S.G = F.G; S.c = F.wg; S.A = (const char*)(F.R1 + R1_H); S.Bt = (const char*)(F.WB + WB_DN);
            pg8::EpiDown E{(bf16_t*)(F.R1 + R1_Y), (const float*)(F.ws + OFF_SW), (const LAS int*)(F.lds + LDS_MISC + MISC_CNT)};
            pg8::gemm_phase(F.lds, 256, S, E);
        } SEAM(pb + 8);
        if ((PHM & 32768) && IN(pb + 9)) { ph_combine(fresh(F), l); } SEAM(pb + 9);
    }
#undef IN
#undef SEAM
}

extern "C" void kernel_launch(void* const* d_in, const int* in_sizes, int n_in, void* d_out, int out_size, void* d_ws, size_t ws_size, hipStream_t stream) {
    static int grid = 0;
    if (grid == 0) {
        if (n_in != 30 || out_size != TX * DM || ws_size < WS_END) { fprintf(stderr, "kernel_launch: unexpected problem (n_in %d out %d ws %zu need %zu)\n", n_in, out_size, ws_size, (size_t)WS_END); grid = -1; return; }
        int dev = 0, cus = 0, per_cu = 0;
        if (hipGetDevice(&dev) != hipSuccess || hipDeviceGetAttribute(&cus, hipDeviceAttributeMultiprocessorCount, dev) != hipSuccess) { grid = -1; return; }
        if (hipFuncSetAttribute((const void*)mk_fwd, hipFuncAttributeMaxDynamicSharedMemorySize, LDS_BYTES) != hipSuccess) { fprintf(stderr, "kernel_launch: hipFuncSetAttribute failed\n"); grid = -1; return; }
        if (hipOccupancyMaxActiveBlocksPerMultiprocessor(&per_cu, (const void*)mk_fwd, 512, LDS_BYTES) != hipSuccess || per_cu < 1) { fprintf(stderr, "kernel_launch: occupancy query says %d\n", per_cu); }
        (void)hipGetLastError();
        grid = cus;
    }
    if (grid < 0) return;
    (void)hipMemsetAsync((char*)d_ws + OFF_CTL, 0, CTL_BYTES, stream);
    Args a{};
    for (int i = 0; i < 30; ++i) a.in[i] = (const float*)d_in[i];
    a.out = (float*)d_out; a.ws = (unsigned char*)d_ws;
#if MK_SPLIT
    for (int p = 0; p < NPHASE; ++p) { a.ph_lo = p; a.ph_hi = p + 1; hipLaunchKernelGGL(mk_fwd, dim3(grid), dim3(512), LDS_BYTES, stream, a); }
#else
    a.ph_lo = 0; a.ph_hi = NPHASE;
    hipLaunchKernelGGL(mk_fwd, dim3(grid), dim3(512), LDS_BYTES, stream, a);
#endif
}
```

```cpp
#include <hip/hip_runtime.h>
#include <cstdio>
#include <cstdint>

#ifndef PHM
#define PHM 0xFFFF
#endif
#ifndef MK_SPLIT
#define MK_SPLIT 0
#endif

typedef unsigned short bf16_t;
typedef short bf16x8 __attribute__((ext_vector_type(8)));
typedef short bf16x4 __attribute__((ext_vector_type(4)));
typedef float f32x4 __attribute__((ext_vector_type(4)));
typedef float f32x2 __attribute__((ext_vector_type(2)));
typedef unsigned u32x4 __attribute__((ext_vector_type(4)));
typedef unsigned u32x2 __attribute__((ext_vector_type(2)));
#define LAS __attribute__((address_space(3)))

constexpr int DM = 1024, NBAT = 4, SEQ = 8192, CTXL = 256;
constexpr int TC = NBAT * CTXL, TX = NBAT * SEQ, TT = TC + TX;
constexpr int NEXP = 64, TOPK = 6;
constexpr int CAP = TT;
constexpr int MOE_ROUTED_ROWS = 6 * TT + 64 * 256;
constexpr int MOE_ROWS = MOE_ROUTED_ROWS + TT;
constexpr int MOE_MAXTILES = MOE_ROWS / 256;
constexpr float ALPHA = 1.681792830507429f;
constexpr int HG_U = 128, HG_NU = (CTXL + SEQ) / HG_U;
constexpr int LRU_NT = (CTXL + SEQ) / 16;

constexpr size_t OFF_CTL = 0, CTL_BYTES = 65536;
constexpr size_t CTL_CNT = 16384, CTL_DBG = 20480;
constexpr size_t OFF_MODS = 65536;
constexpr size_t OFF_LBT = OFF_MODS + 4 * 5 * 6144 * 4;
constexpr size_t OFF_TOKE = 1u << 20;
constexpr size_t OFF_TOKP = OFF_TOKE + (size_t)TT * 32;
constexpr size_t OFF_TOKW = OFF_TOKP + (size_t)TT * 32;
constexpr size_t OFF_STOK = OFF_TOKW + (size_t)TT * 32;
constexpr size_t OFF_SW = OFF_STOK + (size_t)64 * CAP * 4;
constexpr size_t OFF_X = OFF_SW + (size_t)64 * CAP * 4;
constexpr size_t OFF_HB = OFF_X + (size_t)TT * DM * 4;
constexpr size_t OFF_WB = OFF_HB + (size_t)TT * DM * 2;
constexpr size_t WB_IN = 0, WB_OUT = WB_IN + (size_t)4096 * 1024 * 2, WB_RT = WB_OUT + (size_t)1024 * 1024 * 2, WB_GU = WB_RT + (size_t)64 * 1024 * 2,
                 WB_DN = WB_GU + (size_t)65 * 512 * 1024 * 2, WB_LRU = WB_DN + (size_t)65 * 1024 * 256 * 2, WB_END = WB_LRU + (size_t)2 * 2 * 16 * 64 * 64 * 2;
constexpr size_t OFF_R1 = OFF_WB + WB_END;
constexpr size_t R1_P = 0;
constexpr size_t R1_OF = R1_P + (size_t)TT * 4096 * 2;
constexpr size_t R1_SLOC = R1_OF + (size_t)TT * 512 * 4;
constexpr size_t R1_SST = R1_SLOC + (size_t)64 * HG_NU * 4096 * 4;
constexpr size_t R1_DL = R1_SST + (size_t)64 * HG_NU * 4096 * 4;
constexpr size_t R1_AG = R1_OF;
constexpr size_t R1_HST = R1_AG + (size_t)4 * 2 * LRU_NT * 2 * 1024 * 4;
constexpr size_t R1_H = 0;
constexpr size_t R1_Y = R1_H + (size_t)MOE_ROWS * 256 * 2;
constexpr size_t R1_MOE_END = R1_Y + (size_t)MOE_ROWS * 1024 * 2;
constexpr size_t R1_MIX_END = R1_DL + (size_t)64 * HG_NU * 64 * 4;
constexpr size_t WS_END = OFF_R1 + (R1_MOE_END > R1_MIX_END ? R1_MOE_END : R1_MIX_END);

constexpr int LDS_STAGE = 131072;
constexpr int LDS_MISC = LDS_STAGE;
constexpr int MISC_CNT = 64;
constexpr int MISC_TST = MISC_CNT + 66 * 4 + 8;
constexpr int MISC_HIST = 640;
constexpr int MISC_HBASE = 896;
constexpr int MISC_T2E = 1152;
constexpr int MISC_INP = 2304;
constexpr int LDS_BYTES = 147456;

#define XB_TMO      128
#define XB_XCNT(j)  (256  + 64 * (j))
#define XB_XSUB(j)  (1280 + 64 * (j))
#define XB_XGEN(j)  (2304 + 64 * (j))
#define XB_TOP      3328
#define XB_TOPGEN   3392
#define XCD_BAR_WORDS 3456
#define XB_SPIN_CAP (1u << 22)
__device__ __forceinline__ unsigned xb_ld(unsigned* p)              { return __hip_atomic_load(p, __ATOMIC_RELAXED, __HIP_MEMORY_SCOPE_AGENT); }
__device__ __forceinline__ unsigned xb_add(unsigned* p, unsigned v) { return __hip_atomic_fetch_add(p, v, __ATOMIC_RELAXED, __HIP_MEMORY_SCOPE_AGENT); }
__device__ __forceinline__ unsigned xb_xcc_id() { return (unsigned)__builtin_amdgcn_s_getreg((3 << 11) | 20) & 0xFu; }
#define XB_SPIN(cond, bar) do { unsigned _sp = 0; while (cond) { __builtin_amdgcn_s_sleep(1); \
    if ((++_sp & 255u) == 0u) { if (xb_ld(&(bar)[XB_TMO])) break; if (_sp > XB_SPIN_CAP) { atomicAdd(&(bar)[XB_TMO], 1u); break; } } } } while (0)
struct XcdBarrier { unsigned* bar; unsigned x; volatile LAS unsigned* st; };
__device__ __forceinline__ XcdBarrier xcd_barrier_post(unsigned* bar, volatile LAS unsigned* st) {
    XcdBarrier b; b.bar = bar; b.x = xb_xcc_id(); b.st = st;
    if (threadIdx.x == 0) (void)xb_add(&bar[XB_XCNT(b.x)], 1u);
    return b;
}
__device__ __forceinline__ void xcd_barrier_complete(unsigned* bar, unsigned x, unsigned& nloc, unsigned& nx) {
    const unsigned G = gridDim.x * gridDim.y * gridDim.z;
    unsigned sum, cnt, mine, sp = 0u;
    for (;;) {
        sum = 0u; cnt = 0u; mine = 0u;
#pragma unroll
        for (unsigned j = 0; j < 16; ++j) { const unsigned c = xb_ld(&bar[XB_XCNT(j)]); sum += c; cnt += (c > 0u) ? 1u : 0u; mine = (j == x) ? c : mine; }
        if (sum == G) break;
        __builtin_amdgcn_s_sleep(1);
        if ((++sp & 255u) == 0u) { if (xb_ld(&bar[XB_TMO])) break; if (sp > XB_SPIN_CAP) { atomicAdd(&bar[XB_TMO], 1u); break; } }
    }
    nloc = mine > 0u ? mine : 1u; nx = cnt > 0u ? cnt : 1u;
}
__device__ __forceinline__ void xcd_barrier(const XcdBarrier& b) {
    asm volatile("s_waitcnt vmcnt(0)" ::: "memory");
    __syncthreads();
    if (threadIdx.x == 0) {
        unsigned* bar = b.bar;
        __builtin_amdgcn_s_waitcnt(0);
        unsigned nloc = b.st[0], nx = b.st[1];
        if (nloc == 0u) { xcd_barrier_complete(bar, b.x, nloc, nx); b.st[0] = nloc; b.st[1] = nx; }
        const unsigned old = xb_add(&bar[XB_XSUB(b.x)], 1u);
        const unsigned gen = old / nloc;
        if (old + 1u == (gen + 1u) * nloc) {
            __builtin_amdgcn_fence(__ATOMIC_RELEASE, "agent");
            asm volatile("s_waitcnt vmcnt(0)" ::: "memory");
            const unsigned og = xb_add(&bar[XB_TOP], 1u);
            const unsigned tg = og / nx;
            if (og + 1u == (tg + 1u) * nx) xb_add(&bar[XB_TOPGEN], 1u);
            else XB_SPIN(xb_ld(&bar[XB_TOPGEN]) == tg, bar);
            __builtin_amdgcn_fence(__ATOMIC_ACQUIRE, "agent");
            xb_add(&bar[XB_XGEN(b.x)], 1u);
            asm volatile("s_waitcnt vmcnt(0)" ::: "memory");
        } else {
            XB_SPIN(xb_ld(&bar[XB_XGEN(b.x)]) == gen, bar);
            __builtin_amdgcn_fence(__ATOMIC_ACQUIRE, "agent");
            asm volatile("s_waitcnt vmcnt(0)" ::: "memory");
        }
    }
    __syncthreads();
}

__device__ __forceinline__ float bf2f(unsigned short b) { return __uint_as_float(((unsigned)b) << 16); }
__device__ __forceinline__ unsigned cvt_pk_bf16(float lo, float hi) { unsigned r; asm volatile("v_cvt_pk_bf16_f32 %0, %1, %2" : "=v"(r) : "v"(lo), "v"(hi)); return r; }
__device__ __forceinline__ unsigned short f2bf(float f) { return (unsigned short)(cvt_pk_bf16(f, 0.f) & 0xffffu); }
__device__ __forceinline__ float sigmoidf_(float x) { return __builtin_amdgcn_rcpf(1.0f + __expf(-x)); }
__device__ __forceinline__ float siluf_(float x) { return x * sigmoidf_(x); }
__device__ __forceinline__ float gelu_tanh_(float x) { return x * sigmoidf_(1.5957691216057308f * (x + 0.044715f * x * x * x)); }
__device__ __forceinline__ int slot_of_row(int r) { return r < TC ? 4 : ((r - TC) >> 13); }
template <int CTRL> __device__ __forceinline__ float dppf(float oldv, float src) {
    return __int_as_float(__builtin_amdgcn_update_dpp(__float_as_int(oldv), __float_as_int(src), CTRL, 0xf, 0xf, false));
}
__device__ __forceinline__ void unpack8(const u32x4 w, float (&o)[8]) {
    o[0] = __uint_as_float(w.x << 16); o[1] = __uint_as_float(w.x & 0xffff0000u); o[2] = __uint_as_float(w.y << 16); o[3] = __uint_as_float(w.y & 0xffff0000u);
    o[4] = __uint_as_float(w.z << 16); o[5] = __uint_as_float(w.z & 0xffff0000u); o[6] = __uint_as_float(w.w << 16); o[7] = __uint_as_float(w.w & 0xffff0000u);
}

namespace pg8 {
constexpr int BM = 256, BK = 64, HALF = 128, HTB = HALF * BK * 2, STAGE_BYTES = 8 * HTB, NXCD = 8, WGM = 8;
__device__ __forceinline__ int lds_byte(int r, int c) { const int st = (r >> 4) * 2 + (c >> 5), rr = r & 15, cc = c & 31, ob = rr * 64 + cc * 2; return st * 1024 + (ob ^ (((ob >> 9) & 1) << 5)); }
__device__ __forceinline__ void stage_rc(int b, int& R, int& C) { const int st = b / 1024, sb = b % 1024, swz = sb ^ (((sb >> 9) & 1) << 5); R = (st >> 1) * 16 + swz / 64; C = (st & 1) * 32 + (swz % 64) / 2; }
__device__ __forceinline__ int perm32(int rho) { const int n = rho >> 4, i = rho & 15; return 8 * (i >> 2) + 4 * n + (i & 3); }
struct Unit { int pm, pn, e, ti; };

struct StaticOrder {
    const char* A; const char* Bt; int K;
    int nM, nN, nwg, G, c;
    __device__ __forceinline__ void init(const void* A_, const void* Bt_, int M, int N, int K_, int G_, int c_) { A = (const char*)A_; Bt = (const char*)Bt_; K = K_; nM = M / BM; nN = N / BM; nwg = nM * nN; G = G_; c = c_; }
    __device__ __forceinline__ bool next(int i, Unit& u) const {
        const long L = (long)i * G + c; if (L >= nwg) return false;
        int wgid = (int)L; { const int q = nwg / NXCD, r = nwg % NXCD, xcd = wgid % NXCD, off = wgid / NXCD; wgid = (xcd < r ? xcd * (q + 1) : r * (q + 1) + (xcd - r) * q) + off; }
        const int nig = WGM * nN, gid = wgid / nig, fm = gid * WGM, gsz = (nM - fm) < WGM ? (nM - fm) : WGM;
        u.pm = fm + ((wgid % nig) % gsz); u.pn = (wgid % nig) / gsz; u.e = 0; u.ti = 0; return true;
    }
    static constexpr bool GATHER = false;
    __device__ __forceinline__ const char* abase(const Unit& u) const { return A + (size_t)u.pm * BM * K * 2; }
    __device__ __forceinline__ const char* bbase(const Unit& u) const { return Bt + (size_t)u.pn * BM * K * 2; }
};

template <class Epi, class Sched>
__device__ __forceinline__ void gemm_phase(LAS unsigned char* lds, const int K_, const Sched& S, const Epi& E) {
    int Kl_ = K_; asm volatile("" : "+s"(Kl_)); const int K = Kl_;
    int tid_ = threadIdx.x; asm volatile("" : "+v"(tid_));
    const int tid = tid_, wid = __builtin_amdgcn_readfirstlane(tid >> 6), lane = tid & 63, wr = wid >> 2, wc = wid & 3, fr = lane & 15, fq = lane >> 4;
    const int nt = K / BK;
    unsigned voffA[2], voffB[2];
#pragma unroll
    for (int i = 0; i < 2; ++i) { int R, C; stage_rc(tid * 16 + i * 8192, R, C); const int Rb = Epi::PERM ? ((R & ~31) + perm32(R & 31)) : R; voffA[i] = (unsigned)(R * K + C) * 2u; voffB[i] = (unsigned)(Rb * K + C) * 2u; }
    const size_t kstep = (size_t)(BK * 2);
    const size_t hstep = (size_t)HALF * K * 2;
    const unsigned ldsw = (unsigned)wid * 1024u;
    const int aoff = lds_byte(wr * 64 + fr, fq * 8), boff = lds_byte(wc * 32 + fr, fq * 8);
#define PG8_SA(b, h) (((b) * 2 + (h)) * HTB)
#define PG8_SB(b, h) ((4 + (b) * 2 + (h)) * HTB)
#define PG8_STAGE(bufoff, gbase, voff) do { _Pragma("unroll") for (int _i = 0; _i < 2; ++_i) \
        __builtin_amdgcn_global_load_lds((const unsigned*)((const char*)(gbase) + (voff)[_i]), (LAS unsigned*)(lds + (bufoff) + ldsw + _i * 8192), 16, 0, 0); } while (0)
#define PG8_STAGEA(bufoff, hh, kb, nx) do { if constexpr (Sched::GATHER) { unsigned _o[2]; _o[0] = (nx) ? vN[hh][0] : vC[hh][0]; _o[1] = (nx) ? vN[hh][1] : vC[hh][1]; PG8_STAGE(bufoff, cA + (kb), _o); } \
        else { PG8_STAGE(bufoff, ((nx) ? nA : cA) + (hh) * hstep + (kb), voffA); } } while (0)
#define PG8_LDA(dst, b, h) do { _Pragma("unroll") for (int m = 0; m < 4; ++m) _Pragma("unroll") for (int k = 0; k < 2; ++k) dst[m][k] = *(const LAS bf16x8*)(lds + PG8_SA(b, h) + aoff + m * 2048 + k * 1024); } while (0)
#define PG8_LDB(dst, b, h) do { _Pragma("unroll") for (int n = 0; n < 2; ++n) _Pragma("unroll") for (int k = 0; k < 2; ++k) dst[n][k] = *(const LAS bf16x8*)(lds + PG8_SB(b, h) + boff + n * 2048 + k * 1024); } while (0)
#define PG8_MMA(ai, bj, At, Bt) do { __builtin_amdgcn_s_setprio(1); _Pragma("unroll") for (int m = 0; m < 4; ++m) _Pragma("unroll") for (int n = 0; n < 2; ++n) _Pragma("unroll") for (int k = 0; k < 2; ++k) \
        acc[ai][bj][m][n] = __builtin_amdgcn_mfma_f32_16x16x32_bf16(Bt[n][k], At[m][k], acc[ai][bj][m][n], 0, 0, 0); __builtin_amdgcn_s_setprio(0); } while (0)
#define PG8_WAIT_V(n) asm volatile("s_waitcnt vmcnt(" #n ")" ::: "memory")
#define PG8_WAIT_L(n) asm volatile("s_waitcnt lgkmcnt(" #n ")" ::: "memory")
#define PG8_BAR __builtin_amdgcn_s_barrier()
#define PG8_SCHED __builtin_amdgcn_sched_barrier(0)
    Unit cur, nxt; int ui = 0;
    if (!S.next(0, cur)) return;
    f32x4 acc[2][2][4][2];
#pragma unroll
    for (int a = 0; a < 2; ++a)
#pragma unroll
        for (int b = 0; b < 2; ++b)
#pragma unroll
            for (int m = 0; m < 4; ++m)
#pragma unroll
                for (int n = 0; n < 2; ++n) acc[a][b][m][n] = (f32x4){0.f, 0.f, 0.f, 0.f};
    bf16x8 At[4][2], B0[2][2], B1[2][2];
    unsigned vC[2][2], vN[2][2];
    if constexpr (Sched::GATHER) S.aoff(cur, tid, vC);
    const char* cA = S.abase(cur);
    const char* cB = S.bbase(cur);
    const char* nA = cA;
    PG8_STAGE(PG8_SB(0, 0), cB, voffB); PG8_STAGEA(PG8_SA(0, 0), 0, 0, false); PG8_STAGE(PG8_SB(0, 1), cB + hstep, voffB); PG8_STAGEA(PG8_SA(0, 1), 1, 0, false);
    if (wr == 1) PG8_BAR;
    PG8_WAIT_V(4); PG8_BAR;
    PG8_STAGE(PG8_SB(1, 0), cB + kstep, voffB); PG8_STAGEA(PG8_SA(1, 0), 0, kstep, false); PG8_STAGE(PG8_SB(1, 1), cB + hstep + kstep, voffB);
    PG8_WAIT_V(6); PG8_BAR;
    for (;;) {
        const bool has_next = S.next(ui + 1, nxt);
        const char* nB = cB; nA = cA;
        if (has_next) { nB = S.bbase(nxt); nA = S.abase(nxt); if constexpr (Sched::GATHER) S.aoff(nxt, tid, vN); }
        else { if constexpr (Sched::GATHER) {
#pragma unroll
            for (int h = 0; h < 2; ++h)
#pragma unroll
                for (int i = 0; i < 2; ++i) vN[h][i] = vC[h][i]; } }
        for (int t = 0; t < nt; t += 2) {
            const bool last = (t == nt - 2);
            const size_t k1 = (size_t)(t + 1) * kstep, k2 = last ? 0 : (size_t)(t + 2) * kstep, k3 = k2 + kstep;
            const char* b2 = last ? nB : cB + (size_t)(t + 2) * kstep; const char* b3 = b2 + kstep;
            PG8_LDB(B0, 0, 0); PG8_SCHED; PG8_LDA(At, 0, 0); PG8_STAGEA(PG8_SA(1, 1), 1, k1, false);
            PG8_WAIT_L(8); PG8_BAR; PG8_WAIT_L(0); PG8_MMA(0, 0, At, B0); PG8_BAR; PG8_SCHED;
            PG8_LDB(B1, 0, 1); PG8_STAGE(PG8_SB(0, 0), b2, voffB);
            PG8_BAR; PG8_WAIT_L(0); PG8_MMA(0, 1, At, B1); PG8_BAR;
            PG8_LDA(At, 0, 1); PG8_STAGEA(PG8_SA(0, 0), 0, k2, last);
            PG8_BAR; PG8_WAIT_L(0); PG8_MMA(1, 0, At, B0); PG8_BAR; PG8_SCHED;
            PG8_STAGE(PG8_SB(0, 1), b2 + hstep, voffB);
            PG8_WAIT_V(6); PG8_BAR; PG8_MMA(1, 1, At, B1); PG8_BAR;
            PG8_LDB(B0, 1, 0); PG8_SCHED; PG8_LDA(At, 1, 0); PG8_STAGEA(PG8_SA(0, 1), 1, k2, last);
            PG8_WAIT_L(8); PG8_BAR; PG8_WAIT_L(0); PG8_MMA(0, 0, At, B0); PG8_BAR; PG8_SCHED;
            PG8_LDB(B1, 1, 1); PG8_STAGE(PG8_SB(1, 0), b3, voffB);
            PG8_BAR; PG8_WAIT_L(0); PG8_MMA(0, 1, At, B1); PG8_BAR;
            PG8_LDA(At, 1, 1); PG8_STAGEA(PG8_SA(1, 0), 0, k3, last);
            PG8_BAR; PG8_WAIT_L(0); PG8_MMA(1, 0, At, B0); PG8_BAR; PG8_SCHED;
            PG8_STAGE(PG8_SB(1, 1), b3 + hstep, voffB);
            PG8_WAIT_V(6); PG8_BAR; PG8_MMA(1, 1, At, B1); PG8_BAR;
        }
        E(acc, cur, wr, wc, fr, fq);
        if (!has_next) break;
#pragma unroll
        for (int a = 0; a < 2; ++a)
#pragma unroll
            for (int b = 0; b < 2; ++b)
#pragma unroll
                for (int m = 0; m < 4; ++m)
#pragma unroll
                    for (int n = 0; n < 2; ++n) acc[a][b][m][n] = (f32x4){0.f, 0.f, 0.f, 0.f};
        cur = nxt; cB = nB; cA = nA; ++ui;
        if constexpr (Sched::GATHER) {
#pragma unroll
            for (int h = 0; h < 2; ++h)
#pragma unroll
                for (int i = 0; i < 2; ++i) vC[h][i] = vN[h][i]; }
    }
    PG8_WAIT_V(0);
    if (wr == 0) PG8_BAR;
    PG8_BAR;
#undef PG8_SA
#undef PG8_SB
#undef PG8_STAGE
#undef PG8_STAGEA
#undef PG8_LDA
#undef PG8_LDB
#undef PG8_MMA
#undef PG8_WAIT_V
#undef PG8_WAIT_L
#undef PG8_BAR
#undef PG8_SCHED
}

struct EpiStoreBf16 {
    static constexpr bool PERM = true;
    bf16_t* O; int ldc;
    __device__ __forceinline__ void operator()(const f32x4 (&acc)[2][2][4][2], const Unit& u, int wr, int wc, int fr, int fq) const {
        const int row0 = u.pm * BM + wr * 64 + fr, col0 = u.pn * BM + wc * 32 + 8 * fq;
#pragma unroll
        for (int ai = 0; ai < 2; ++ai)
#pragma unroll
            for (int m = 0; m < 4; ++m) { bf16_t* rowp = O + (size_t)(row0 + ai * HALF + m * 16) * ldc + col0;
#pragma unroll
                for (int bj = 0; bj < 2; ++bj) { const f32x4 v0 = acc[ai][bj][m][0], v1 = acc[ai][bj][m][1];
                    u32x4 w; w.x = cvt_pk_bf16(v0[0], v0[1]); w.y = cvt_pk_bf16(v0[2], v0[3]); w.z = cvt_pk_bf16(v1[0], v1[1]); w.w = cvt_pk_bf16(v1[2], v1[3]);
                    *(u32x4*)(rowp + bj * HALF) = w; } }
    }
};
struct EpiResid {
    static constexpr bool PERM = false;
    float* X; const float* mods_l;
    __device__ __forceinline__ void operator()(const f32x4 (&acc)[2][2][4][2], const Unit& u, int wr, int wc, int fr, int fq) const {
        const int row0 = u.pm * BM + wr * 64 + fr, col0 = u.pn * BM + wc * 32 + 4 * fq;
        const float* m2 = mods_l + (size_t)(slot_of_row(u.pm * BM) * 6 + 2) * DM + col0;
        float* xb = X + (size_t)row0 * DM + col0;
#pragma unroll
        for (int bj = 0; bj < 2; ++bj)
#pragma unroll
            for (int n = 0; n < 2; ++n) { const f32x4 mv = *(const f32x4*)(m2 + bj * HALF + n * 16);
#pragma unroll
                for (int ai = 0; ai < 2; ++ai) {
#pragma unroll
                    for (int m = 0; m < 4; ++m) { float* p = xb + (size_t)(ai * HALF + m * 16) * DM + bj * HALF + n * 16; const f32x4 xv = *(const f32x4*)p; *(f32x4*)p = xv * ALPHA + mv * acc[ai][bj][m][n]; }
                    asm volatile("" ::: "memory"); } }
    }
};
struct EpiSwiglu {
    static constexpr bool PERM = true;
    bf16_t* H;
    __device__ __forceinline__ void operator()(const f32x4 (&acc)[2][2][4][2], const Unit& u, int wr, int wc, int fr, int fq) const {
        const int row0 = u.pm * BM + wr * 64 + fr, col0 = u.pn * HALF + wc * 32 + 8 * fq;
#pragma unroll
        for (int ai = 0; ai < 2; ++ai)
#pragma unroll
            for (int m = 0; m < 4; ++m) { bf16_t* rowp = H + (size_t)(row0 + ai * HALF + m * 16) * 256 + col0;
                float h[8];
#pragma unroll
                for (int n = 0; n < 2; ++n)
#pragma unroll
                    for (int j = 0; j < 4; ++j) h[n * 4 + j] = siluf_(acc[ai][0][m][n][j]) * acc[ai][1][m][n][j];
                u32x4 w; w.x = cvt_pk_bf16(h[0], h[1]); w.y = cvt_pk_bf16(h[2], h[3]); w.z = cvt_pk_bf16(h[4], h[5]); w.w = cvt_pk_bf16(h[6], h[7]);
                *(u32x4*)rowp = w; }
    }
};
struct EpiDown {
    static constexpr bool PERM = true;
    bf16_t* Y; const float* sw; const LAS int* cnt;
    __device__ __forceinline__ void operator()(const f32x4 (&acc)[2][2][4][2], const Unit& u, int wr, int wc, int fr, int fq) const {
        const int row0 = u.pm * BM + wr * 64 + fr, col0 = u.pn * BM + wc * 32 + 8 * fq;
        const int ce = (u.e < 64) ? cnt[u.e] : 0;
        const float* swe = sw + (size_t)(u.e < 64 ? u.e : 0) * CAP + u.ti * 256 + wr * 64 + fr;
        bf16_t* yb = Y + (size_t)row0 * DM + col0;
#pragma unroll
        for (int ai = 0; ai < 2; ++ai)
#pragma unroll
            for (int m = 0; m < 4; ++m) { const int rl = ai * HALF + m * 16, pos = u.ti * 256 + wr * 64 + fr + rl;
                float w = 1.0f; if (u.e < 64) w = (pos < ce) ? swe[rl] : 0.0f;
                bf16_t* rowp = yb + (size_t)rl * DM;
#pragma unroll
                for (int bj = 0; bj < 2; ++bj) { const f32x4 v0 = acc[ai][bj][m][0] * w, v1 = acc[ai][bj][m][1] * w;
                    u32x4 ww; ww.x = cvt_pk_bf16(v0[0], v0[1]); ww.y = cvt_pk_bf16(v0[2], v0[3]); ww.z = cvt_pk_bf16(v1[0], v1[1]); ww.w = cvt_pk_bf16(v1[2], v1[3]);
                    *(u32x4*)(rowp + bj * HALF) = ww; }
                asm volatile("" ::: "memory"); }
    }
};
struct MoeOrder {
    const LAS int* cnt; const LAS int* tst; const LAS unsigned char* t2e; int ntiles, npn, G, c;
    __device__ __forceinline__ bool next(int i, Unit& u) const {
        const int L = i * G + c; if (L >= ntiles * npn) return false;
        const int tau = L / npn; u.pm = tau; u.pn = L % npn; u.e = t2e[tau]; u.ti = tau - tst[u.e]; return true;
    }
};
struct MoeGU : MoeOrder {
    static constexpr bool GATHER = true;
    const char* A; const char* Bt; const int* stok;
    __device__ __forceinline__ const char* abase(const Unit&) const { return A; }
    __device__ __forceinline__ const char* bbase(const Unit& u) const { return Bt + ((size_t)u.e * 512 + (size_t)u.pn * 256) * 1024 * 2; }
    __device__ __forceinline__ void aoff(const Unit& u, int tid, unsigned (&off)[2][2]) const {
        const int ce = cnt[u.e];
#pragma unroll
        for (int i = 0; i < 2; ++i) { int R, C; stage_rc(tid * 16 + i * 8192, R, C);
#pragma unroll
            for (int h = 0; h < 2; ++h) { const int pos = u.ti * 256 + h * HALF + R; int tok;
                if (u.e == 64) tok = pos; else tok = (pos < ce) ? stok[(size_t)u.e * CAP + pos] : 0;
                off[h][i] = (unsigned)(tok * 1024 + C) * 2u; } }
    }
};
struct MoeDN : MoeOrder {
    static constexpr bool GATHER = false;
    const char* A; const char* Bt;
    __device__ __forceinline__ const char* abase(const Unit& u) const { return A + (size_t)u.pm * BM * 256 * 2; }
    __device__ __forceinline__ const char* bbase(const Unit& u) const { return Bt + ((size_t)u.e * 1024 + (size_t)u.pn * 256) * 256 * 2; }
};
}

struct Args { const float* in[30]; float* out; unsigned char* ws; int ph_lo, ph_hi; };

struct Frame {
    float* out; unsigned char* ws; LAS unsigned char* lds; int tid, lane, wave, G, wg;
    float* mods; float* X; bf16_t* HB; bf16_t* MIX; unsigned char* WB; unsigned char* R1;
};

__device__ __forceinline__ const float* inp(const Frame& F, int i) {
    const unsigned long long v = ((const LAS unsigned long long*)(F.lds + LDS_MISC + MISC_INP))[i];
    const unsigned lo = (unsigned)__builtin_amdgcn_readfirstlane((int)(unsigned)v), hi = (unsigned)__builtin_amdgcn_readfirstlane((int)(unsigned)(v >> 32));
    return (const float*)(((unsigned long long)hi << 32) | lo);
}
__device__ __forceinline__ Frame fresh(const Frame& F0) { Frame F = F0; int t = F0.tid; asm volatile("" : "+v"(t)); F.tid = t; F.lane = t & 63; return F; }

__device__ __forceinline__ void ph_mods(const Frame& F) {
    const float* c = inp(F, 1); const float* cc = inp(F, 3); const float* ada_w = inp(F, 4); const float* ada_b = inp(F, 5);
    LAS float* sv = (LAS float*)F.lds;
    LAS float* red = (LAS float*)(F.lds + 5 * 1024 * 4);
    for (int i = F.tid; i < 5 * 1024; i += 512) { const int s = i >> 10, k = i & 1023; const float v = (s < 4) ? c[s * 1024 + k] : cc[k]; sv[i] = siluf_(v); }
    __syncthreads();
    for (int task = F.wg; task < 4 * 48; task += F.G) {
        const int l = task / 48, cc0 = (task % 48) * 128;
        const int col = cc0 + (F.tid & 127), kg = F.tid >> 7;
        const float* w = ada_w + (size_t)l * 1024 * 6144 + col;
        float a0 = 0.f, a1 = 0.f, a2 = 0.f, a3 = 0.f, a4 = 0.f;
        for (int k = kg * 256; k < kg * 256 + 256; ++k) { const float wv = w[(size_t)k * 6144]; a0 += sv[k] * wv; a1 += sv[1024 + k] * wv; a2 += sv[2048 + k] * wv; a3 += sv[3072 + k] * wv; a4 += sv[4096 + k] * wv; }
        LAS float* r = red + (kg * 128 + (F.tid & 127)) * 5; r[0] = a0; r[1] = a1; r[2] = a2; r[3] = a3; r[4] = a4;
        __syncthreads();
        if (F.tid < 128) {
            const float b = ada_b[l * 6144 + col];
#pragma unroll
            for (int s = 0; s < 5; ++s) { const float v = ((red[(0 * 128 + F.tid) * 5 + s] + red[(1 * 128 + F.tid) * 5 + s]) + red[(2 * 128 + F.tid) * 5 + s]) + red[(3 * 128 + F.tid) * 5 + s];
                F.mods[(size_t)(l * 5 + s) * 6144 + col] = v + b; }
        }
        __syncthreads();
    }
    if (F.wg == F.G - 1) {
        const float* raw = inp(F, 11); float* lbt = (float*)(F.ws + OFF_LBT);
        for (int i = F.tid; i < 2 * 512; i += 512) { const int d = i >> 9, ch = i & 511; const float r0 = raw[(d * 2 + 0) * 512 + ch], r1 = raw[(d * 2 + 1) * 512 + ch];
            lbt[(0 * 2 + d) * 512 + ch] = 0.f; lbt[(1 * 2 + d) * 512 + ch] = sigmoidf_(r1 - r0); }
    }
}

__device__ __forceinline__ void ph_init_x(const Frame& F) {
    const float* x = inp(F, 0); const float* ctx = inp(F, 2);
    const int gw = F.wg * 8 + F.wave, nw = F.G * 8;
    for (int row = gw; row < TT; row += nw) {
        const float* src = row < TC ? ctx + (size_t)row * DM : x + (size_t)(row - TC) * DM;
        const float* m = F.mods + (size_t)(0 * 5 + slot_of_row(row)) * 6144;
#pragma unroll
        for (int hh = 0; hh < 2; ++hh) { const int k = hh * 512 + F.lane * 8;
            const f32x4 v0 = *(const f32x4*)(src + k), v1 = *(const f32x4*)(src + k + 4);
            *(f32x4*)(F.X + (size_t)row * DM + k) = v0; *(f32x4*)(F.X + (size_t)row * DM + k + 4) = v1;
            const f32x4 s0 = *(const f32x4*)(m + 1024 + k), s1 = *(const f32x4*)(m + 1024 + k + 4), b0 = *(const f32x4*)(m + k), b1 = *(const f32x4*)(m + k + 4);
            const f32x4 h0 = v0 * (s0 + 1.0f) + b0, h1 = v1 * (s1 + 1.0f) + b1;
            u32x4 w; w.x = cvt_pk_bf16(h0[0], h0[1]); w.y = cvt_pk_bf16(h0[2], h0[3]); w.z = cvt_pk_bf16(h1[0], h1[1]); w.w = cvt_pk_bf16(h1[2], h1[3]);
            *(u32x4*)(F.HB + (size_t)row * DM + k) = w; }
    }
}

__device__ __forceinline__ void cvt_tile(const Frame& F, const float* src, int sld, int k0, int n0, bf16_t* dst, int dld, int drow0, float scale) {
    LAS float* t = (LAS float*)F.lds;
    { const int i = F.tid >> 3, j0 = (F.tid & 7) * 8; const float* p = src + (size_t)(k0 + i) * sld + n0 + j0;
      const f32x4 a = *(const f32x4*)p, b = *(const f32x4*)(p + 4);
      LAS float* q = t + i * 65 + j0; q[0] = a[0]; q[1] = a[1]; q[2] = a[2]; q[3] = a[3]; q[4] = b[0]; q[5] = b[1]; q[6] = b[2]; q[7] = b[3]; }
    __syncthreads();
    { const int j = F.tid >> 3, i0 = (F.tid & 7) * 8; float v[8];
#pragma unroll
      for (int q = 0; q < 8; ++q) v[q] = t[(i0 + q) * 65 + j] * scale;
      u32x4 w; w.x = cvt_pk_bf16(v[0], v[1]); w.y = cvt_pk_bf16(v[2], v[3]); w.z = cvt_pk_bf16(v[4], v[5]); w.w = cvt_pk_bf16(v[6], v[7]);
      *(u32x4*)(dst + (size_t)(drow0 + j) * dld + k0 + i0) = w; }
    __syncthreads();
}
__device__ __forceinline__ void ph_convert(const Frame& F, int l) {
    const int j = l >> 1; const bool even = (l & 1) == 0;
    bf16_t* wIN = (bf16_t*)(F.WB + WB_IN); bf16_t* wOUT = (bf16_t*)(F.WB + WB_OUT); bf16_t* wRT = (bf16_t*)(F.WB + WB_RT);
    bf16_t* wGU = (bf16_t*)(F.WB + WB_GU); bf16_t* wDN = (bf16_t*)(F.WB + WB_DN); bf16_t* wLRU = (bf16_t*)(F.WB + WB_LRU);
    const int nIN = even ? 4096 : 2048;
    const int t_in = (nIN / 64) * 16, t_out = 256, t_rt = 16, t_gu = 65 * 2 * 64, t_dn = 65 * 64, t_lru = even ? 0 : 64;
    const int total = t_in + t_out + t_rt + t_gu + t_dn + t_lru;
    for (int task = F.wg; task < total; task += F.G) {
        int t = task;
        if (t < t_in) { const int nb = t >> 4, kb = t & 15; const float* src = even ? inp(F, 8) + (size_t)j * 1024 * 4096 : inp(F, 13) + (size_t)j * 1024 * 2048;
            cvt_tile(F, src, nIN, kb * 64, nb * 64, wIN, 1024, nb * 64, (even && nb < 8) ? 0.125f : 1.0f); continue; }
        t -= t_in;
        if (t < t_out) { const int nb = t >> 4, kb = t & 15; const float* src = even ? inp(F, 9) + (size_t)j * 1024 * 1024 : inp(F, 21) + (size_t)j * 1024 * 1024;
            cvt_tile(F, src, 1024, kb * 64, nb * 64, wOUT, 1024, nb * 64, 1.0f); continue; }
        t -= t_out;
        if (t < t_rt) { cvt_tile(F, inp(F, 22) + (size_t)l * 1024 * 64, 64, t * 64, 0, wRT, 1024, 0, 1.0f); continue; }
        t -= t_rt;
        if (t < t_gu) { const int e = t / 128, r = t % 128, which = r >> 6, q = r & 63, nb = q >> 4, kb = q & 15;
            const float* src = (e < 64) ? (which ? inp(F, 25) : inp(F, 24)) + ((size_t)l * 64 + e) * 1024 * 256 : (which ? inp(F, 28) : inp(F, 27)) + (size_t)l * 1024 * 256;
            const int n0 = nb * 64, drow0 = (n0 >> 7) * 256 + which * 128 + (n0 & 127);
            cvt_tile(F, src, 256, kb * 64, n0, wGU + (size_t)e * 512 * 1024, 1024, drow0, 1.0f); continue; }
        t -= t_gu;
        if (t < t_dn) { const int e = t >> 6, q = t & 63, nb = q >> 2, kb = q & 3;
            const float* src = (e < 64) ? inp(F, 26) + ((size_t)l * 64 + e) * 256 * 1024 : inp(F, 29) + (size_t)l * 256 * 1024;
            cvt_tile(F, src, 1024, kb * 64, nb * 64, wDN + (size_t)e * 1024 * 256, 256, nb * 64, 1.0f); continue; }
        t -= t_dn;
        { const int d = t >> 5, gt = (t >> 4) & 1, kb = t & 15;
          const float* src = (gt ? inp(F, 18) : inp(F, 16)) + (((size_t)j * 2 + d) * 16 + kb) * 4096;
          cvt_tile(F, src, 64, 0, 0, wLRU + (((size_t)d * 2 + gt) * 16 + kb) * 4096, 64, 0, 1.0f); }
    }
}

__device__ __forceinline__ void ph_attn(const Frame& F, int j) {
    const bf16_t* P = (const bf16_t*)(F.R1 + R1_P);
    LAS bf16_t* Ks = (LAS bf16_t*)F.lds;
    LAS bf16_t* Vt = (LAS bf16_t*)(F.lds + 9216);
    LAS float* rp_l = (LAS float*)(F.lds + 18432);
    const float* rpb = inp(F, 10) + (size_t)j * 8 * 465;
    const int g = F.lane >> 4, l15 = F.lane & 15;
    const int NLAT = NBAT * 8 * 64, NTASK = NLAT + NBAT * 8 * 2;
    for (int task = F.wg; task < NTASK; task += F.G) {
        const bool lat = task < NLAT;
        int b, h, rp = 0, half = 0;
        if (lat) { b = task >> 9; h = (task >> 6) & 7; rp = task & 63; } else { const int t2 = task - NLAT; b = t2 >> 4; h = (t2 >> 1) & 7; half = t2 & 1; }
        const int myr = 2 * rp + (F.wave >> 2), w0 = (F.wave & 3) * 16;
        const int r0 = min(max(myr - 4, 0), 120);
        const int rlo = min(max(2 * rp - 4, 0), 120), rhi = min(max(2 * rp + 1 - 4, 0), 120) + 7;
        const int nloc = lat ? (rhi - rlo + 1) : 0;
        const int qrow = lat ? (TC + b * SEQ + myr * 64 + w0 + l15) : (b * CTXL + half * 128 + F.wave * 16 + l15);
        bf16x8 qf[2];
        qf[0] = *(const bf16x8*)(P + (size_t)qrow * 4096 + h * 64 + g * 8);
        qf[1] = *(const bf16x8*)(P + (size_t)qrow * 4096 + h * 64 + 32 + g * 8);
        if (lat) for (int i = F.tid; i < 465; i += 512) rp_l[i] = rpb[h * 465 + i];
        f32x4 oacc[4];
#pragma unroll
        for (int dt = 0; dt < 4; ++dt) oacc[dt] = (f32x4){0.f, 0.f, 0.f, 0.f};
        float mrun = -1e30f, lrun = 0.f;
        const int wq = w0 + l15, c0 = min(max(wq - 8, 0), 48);
        for (int ch = 0; ch < nloc + 4; ++ch) {
            const bool loc = ch < nloc; const int kr = rlo + ch;
            { const int key = F.tid >> 3, ds = (F.tid & 7) * 8;
              const int krow = loc ? (TC + b * SEQ + kr * 64 + key) : (b * CTXL + (ch - nloc) * 64 + key);
              const u32x4 kv = *(const u32x4*)(P + (size_t)krow * 4096 + 512 + h * 64 + ds);
              const u32x4 vv = *(const u32x4*)(P + (size_t)krow * 4096 + 1024 + h * 64 + ds);
              __syncthreads();
              *(LAS u32x4*)(Ks + key * 72 + ds) = kv;
              Vt[(ds + 0) * 72 + key] = (bf16_t)(vv.x & 0xffff); Vt[(ds + 1) * 72 + key] = (bf16_t)(vv.x >> 16);
              Vt[(ds + 2) * 72 + key] = (bf16_t)(vv.y & 0xffff); Vt[(ds + 3) * 72 + key] = (bf16_t)(vv.y >> 16);
              Vt[(ds + 4) * 72 + key] = (bf16_t)(vv.z & 0xffff); Vt[(ds + 5) * 72 + key] = (bf16_t)(vv.z >> 16);
              Vt[(ds + 6) * 72 + key] = (bf16_t)(vv.w & 0xffff); Vt[(ds + 7) * 72 + key] = (bf16_t)(vv.w >> 16);
              __syncthreads(); }
            const bool mine = loc ? (kr >= r0 && kr < r0 + 8) : true;
            if (mine) {
                f32x4 s[4];
#pragma unroll
                for (int kb = 0; kb < 4; ++kb) { s[kb] = (f32x4){0.f, 0.f, 0.f, 0.f};
#pragma unroll
                    for (int ks = 0; ks < 2; ++ks) { const bf16x8 a = *(const LAS bf16x8*)(Ks + (kb * 16 + l15) * 72 + ks * 32 + g * 8);
                        s[kb] = __builtin_amdgcn_mfma_f32_16x16x32_bf16(a, qf[ks], s[kb], 0, 0, 0); } }
                if (loc) {
#pragma unroll
                    for (int kb = 0; kb < 4; ++kb)
#pragma unroll
                        for (int i = 0; i < 4; ++i) { const int kc = kb * 16 + 4 * g + i; const bool valid = (kc >= c0) && (kc < c0 + 16);
                            const int bi = (kr - myr + 7) * 31 + min(max(kc - wq + 15, 0), 30);
                            s[kb][i] = valid ? s[kb][i] + rp_l[bi] : -1e30f; }
                }
                float cm = -1e30f;
#pragma unroll
                for (int kb = 0; kb < 4; ++kb)
#pragma unroll
                    for (int i = 0; i < 4; ++i) cm = fmaxf(cm, s[kb][i]);
                cm = fmaxf(cm, __shfl_xor(cm, 16)); cm = fmaxf(cm, __shfl_xor(cm, 32));
                const float mn = fmaxf(mrun, cm), sc = __expf(mrun - mn);
                mrun = mn; lrun *= sc;
#pragma unroll
                for (int dt = 0; dt < 4; ++dt) oacc[dt] *= sc;
                float p[4][4];
#pragma unroll
                for (int kb = 0; kb < 4; ++kb)
#pragma unroll
                    for (int i = 0; i < 4; ++i) { p[kb][i] = __expf(s[kb][i] - mn); lrun += p[kb][i]; }
#pragma unroll
                for (int kp = 0; kp < 2; ++kp) {
                    u32x4 pw; pw.x = cvt_pk_bf16(p[2 * kp][0], p[2 * kp][1]); pw.y = cvt_pk_bf16(p[2 * kp][2], p[2 * kp][3]);
                    pw.z = cvt_pk_bf16(p[2 * kp + 1][0], p[2 * kp + 1][1]); pw.w = cvt_pk_bf16(p[2 * kp + 1][2], p[2 * kp + 1][3]);
                    bf16x8 pf; __builtin_memcpy(&pf, &pw, 16);
#pragma unroll
                    for (int dt = 0; dt < 4; ++dt) {
                        const u32x2 v0 = *(const LAS u32x2*)(Vt + (dt * 16 + l15) * 72 + (2 * kp) * 16 + 4 * g);
                        const u32x2 v1 = *(const LAS u32x2*)(Vt + (dt * 16 + l15) * 72 + (2 * kp + 1) * 16 + 4 * g);
                        u32x4 vw; vw.x = v0.x; vw.y = v0.y; vw.z = v1.x; vw.w = v1.y; bf16x8 vf; __builtin_memcpy(&vf, &vw, 16);
                        oacc[dt] = __builtin_amdgcn_mfma_f32_16x16x32_bf16(vf, pf, oacc[dt], 0, 0, 0);
                    }
                }
            }
        }
        float lt = lrun; lt += __shfl_xor(lt, 16); lt += __shfl_xor(lt, 32);
        const float inv = 1.0f / lt;
#pragma unroll
        for (int dt = 0; dt < 4; ++dt) { const f32x4 o = oacc[dt] * inv; u32x2 w; w.x = cvt_pk_bf16(o[0], o[1]); w.y = cvt_pk_bf16(o[2], o[3]);
            *(u32x2*)(F.MIX + (size_t)qrow * DM + h * 64 + dt * 16 + 4 * g) = w; }
        __syncthreads();
    }
}

__device__ __forceinline__ int hg_unit(int nb, int dir) { return dir == 0 ? nb : (nb < 2 ? 1 - nb : 2 + (HG_NU - 3 - (nb - 2))); }
__device__ __forceinline__ int hg_row(int b, int nb, int t) { return nb < 2 ? b * CTXL + nb * HG_U + t : TC + b * SEQ + (nb - 2) * HG_U + t; }
template <bool WITHQ>
__device__ __forceinline__ void hg_stage(const Frame& F, const bf16_t* P, const float* lb, int b, int h, int nb, int dir, int sb, LAS float* Fb, LAS float* Vb, LAS float* Qb, float (&dprod)[16]) {
    const int tk = F.lane & 15, cg = F.lane >> 4;
    const int pos = sb * 16 + tk, t = dir ? (HG_U - 1 - pos) : pos;
    const bf16_t* pr = P + (size_t)hg_row(b, nb, t) * 4096 + h * 64 + cg * 16;
    float z[16], v[16];
    { const u32x4 a = *(const u32x4*)(pr + (dir ? 2560 : 2048)), c = *(const u32x4*)(pr + (dir ? 2560 : 2048) + 8); float t0[8], t1[8]; unpack8(a, t0); unpack8(c, t1);
#pragma unroll
      for (int i = 0; i < 8; ++i) { z[i] = t0[i]; z[8 + i] = t1[i]; } }
    { const u32x4 a = *(const u32x4*)(pr + 3072), c = *(const u32x4*)(pr + 3072 + 8); float t0[8], t1[8]; unpack8(a, t0); unpack8(c, t1);
#pragma unroll
      for (int i = 0; i < 8; ++i) { v[i] = t0[i]; v[8 + i] = t1[i]; } }
#pragma unroll
    for (int q = 0; q < 4; ++q) { f32x4 fv, vv;
#pragma unroll
        for (int i = 0; i < 4; ++i) { const int c = q * 4 + i; const float lbv = lb[h * 64 + cg * 16 + c]; const float f = fmaxf(lbv + (1.0f - lbv) * sigmoidf_(z[c]), 1e-30f); fv[i] = f; vv[i] = v[c];
            float pr2 = f; pr2 *= dppf<0xB1>(pr2, pr2); pr2 *= dppf<0x4E>(pr2, pr2); pr2 *= dppf<0x141>(pr2, pr2); pr2 *= dppf<0x140>(pr2, pr2); dprod[c] *= pr2; }
        *(LAS f32x4*)(Fb + tk * 64 + cg * 16 + q * 4) = fv; *(LAS f32x4*)(Vb + tk * 64 + cg * 16 + q * 4) = vv; }
    if (WITHQ) {
        const u32x4 a = *(const u32x4*)(pr + 1536), c = *(const u32x4*)(pr + 1536 + 8); float t0[8], t1[8]; unpack8(a, t0); unpack8(c, t1);
#pragma unroll
        for (int q = 0; q < 2; ++q) { f32x4 x0, x1;
#pragma unroll
            for (int i = 0; i < 4; ++i) { x0[i] = siluf_(t0[q * 4 + i]) * 0.125f; x1[i] = siluf_(t1[q * 4 + i]) * 0.125f; }
            *(LAS f32x4*)(Qb + tk * 64 + cg * 16 + q * 4) = x0; *(LAS f32x4*)(Qb + tk * 64 + cg * 16 + 8 + q * 4) = x1; }
    }
}
__device__ __forceinline__ void ph_hg_a(const Frame& F, int j) {
    const bf16_t* P = (const bf16_t*)(F.R1 + R1_P);
    float* SLOC = (float*)(F.R1 + R1_SLOC); float* DL = (float*)(F.R1 + R1_DL);
    LAS float* Fb = (LAS float*)(F.lds + 32768 + F.wave * 12288); LAS float* Vb = Fb + 1024;
    const int gw = F.wg * 8 + F.wave, nw = F.G * 8;
    const int NT = NBAT * 8 * HG_NU * 2;
    for (int task = gw; task < NT; task += nw) {
        const int dir = task & 1, nb = (task >> 1) % HG_NU, bh = (task >> 1) / HG_NU, b = bh >> 3, h = bh & 7;
        const float* lb = (const float*)(F.ws + OFF_LBT) + (j * 2 + dir) * 512;
        float S[64];
#pragma unroll
        for (int k = 0; k < 64; ++k) S[k] = 0.f;
        float dprod[16];
#pragma unroll
        for (int c = 0; c < 16; ++c) dprod[c] = 1.0f;
        for (int sb = 0; sb < HG_U / 16; ++sb) {
            hg_stage<false>(F, P, lb, b, h, nb, dir, sb, Fb, Vb, nullptr, dprod);
            for (int t = 0; t < 16; ++t) {
                const float vv = Vb[t * 64 + F.lane];
#pragma unroll
                for (int k4 = 0; k4 < 16; ++k4) { const f32x4 f4 = *(const LAS f32x4*)(Fb + t * 64 + k4 * 4);
#pragma unroll
                    for (int i = 0; i < 4; ++i) S[k4 * 4 + i] = fmaf(f4[i], S[k4 * 4 + i] - vv, vv); }
            }
        }
        const int seq = bh * 2 + dir, u = hg_unit(nb, dir);
        float* so = SLOC + ((size_t)seq * HG_NU + u) * 4096;
#pragma unroll
        for (int k = 0; k < 64; ++k) so[k * 64 + F.lane] = S[k];
        if ((F.lane & 15) == 0) { float* dd = DL + ((size_t)seq * HG_NU + u) * 64 + (F.lane >> 4) * 16;
#pragma unroll
            for (int c = 0; c < 16; ++c) dd[c] = dprod[c]; }
    }
}
__device__ __forceinline__ void ph_hg_b(const Frame& F) {
    const float* SLOC = (const float*)(F.R1 + R1_SLOC); const float* DL = (const float*)(F.R1 + R1_DL); float* SST = (float*)(F.R1 + R1_SST);
    for (int idx = F.wg * 512 + F.tid; idx < 64 * 4096; idx += F.G * 512) {
        const int seq = idx >> 12, kv = idx & 4095, k = kv >> 6;
        float s = 0.f;
        for (int u = 0; u < HG_NU; ++u) { const size_t o = ((size_t)seq * HG_NU + u) * 4096 + kv; SST[o] = s; s = DL[((size_t)seq * HG_NU + u) * 64 + k] * s + SLOC[o]; }
    }
}
__device__ __forceinline__ void ph_hg_c(const Frame& F, int j) {
    const bf16_t* P = (const bf16_t*)(F.R1 + R1_P);
    const float* SST = (const float*)(F.R1 + R1_SST); float* OF = (float*)(F.R1 + R1_OF);
    const float* ng = inp(F, 12) + j * 64;
    LAS float* Fb = (LAS float*)(F.lds + 32768 + F.wave * 12288); LAS float* Vb = Fb + 1024; LAS float* Qb = Fb + 2048;
    const int gw = F.wg * 8 + F.wave, nw = F.G * 8;
    const int NT = NBAT * 8 * HG_NU;
    const float ngl = ng[F.lane];
    for (int task = gw; task < NT; task += nw) {
        const int nb = task % HG_NU, bh = task / HG_NU, b = bh >> 3, h = bh & 7;
        for (int dir = 0; dir < 2; ++dir) {
            const float* lb = (const float*)(F.ws + OFF_LBT) + (j * 2 + dir) * 512;
            const int seq = bh * 2 + dir, u = hg_unit(nb, dir);
            const float* ss = SST + ((size_t)seq * HG_NU + u) * 4096;
            float S[64];
#pragma unroll
            for (int k = 0; k < 64; ++k) S[k] = ss[k * 64 + F.lane];
            float dprod[16];
#pragma unroll
            for (int c = 0; c < 16; ++c) dprod[c] = 1.0f;
            for (int sb = 0; sb < HG_U / 16; ++sb) {
                hg_stage<true>(F, P, lb, b, h, nb, dir, sb, Fb, Vb, Qb, dprod);
                for (int t = 0; t < 16; ++t) {
                    const float vv = Vb[t * 64 + F.lane];
                    float o0 = 0.f, o1 = 0.f;
#pragma unroll
                    for (int k4 = 0; k4 < 16; ++k4) { const f32x4 f4 = *(const LAS f32x4*)(Fb + t * 64 + k4 * 4); const f32x4 q4 = *(const LAS f32x4*)(Qb + t * 64 + k4 * 4);
#pragma unroll
                        for (int i = 0; i < 4; ++i) { const float sn = fmaf(f4[i], S[k4 * 4 + i] - vv, vv); S[k4 * 4 + i] = sn; if (i & 1) o1 = fmaf(sn, q4[i], o1); else o0 = fmaf(sn, q4[i], o0); } }
                    const float o = o0 + o1;
                    const int pos = sb * 16 + t, tt = dir ? (HG_U - 1 - pos) : pos, row = hg_row(b, nb, tt);
                    if (dir == 0) OF[(size_t)row * 512 + h * 64 + F.lane] = o;
                    else {
                        const float tot = o + OF[(size_t)row * 512 + h * 64 + F.lane];
                        float sq = tot * tot;
                        sq += __shfl_xor(sq, 1); sq += __shfl_xor(sq, 2); sq += __shfl_xor(sq, 4); sq += __shfl_xor(sq, 8); sq += __shfl_xor(sq, 16); sq += __shfl_xor(sq, 32);
                        const float rs = rsqrtf(sq * (1.0f / 64.0f) + 1e-6f);
                        const float gt = bf2f(P[(size_t)row * 4096 + 3584 + h * 64 + F.lane]);
                        F.MIX[(size_t)row * DM + 512 + h * 64 + F.lane] = f2bf(tot * rs * ngl * siluf_(gt));
                    }
                }
            }
        }
    }
}

__device__ __forceinline__ int lru_nat(int so, int dir) { return dir == 0 ? so : (so < 16 ? 15 - so : 16 + (LRU_NT - 1 - so)); }
__device__ __forceinline__ int lru_row(int b, int nt, int t) { return nt < 16 ? b * CTXL + nt * 16 + t : TC + b * SEQ + (nt - 16) * 16 + t; }
__device__ __forceinline__ void lru_gates(const Frame& F, int jj, int b, int kb, int nt, LAS bf16_t* Wl, LAS float* ucb, float (&av)[2][4][4], float (&xv)[2][4][4]) {
    const bf16_t* P = (const bf16_t*)(F.R1 + R1_P);
    const int tk = F.lane & 15, g = F.lane >> 4;
    const float* cw = inp(F, 14) + (size_t)jj * 4 * 1024; const float* cb = inp(F, 15) + (size_t)jj * 1024;
    { const int len = nt < 16 ? CTXL : SEQ, tpos = (nt < 16 ? nt * 16 : (nt - 16) * 16) + tk;
      float acc[16];
#pragma unroll
      for (int c = 0; c < 16; ++c) acc[c] = cb[kb * 64 + g * 16 + c];
#pragma unroll
      for (int tap = 0; tap < 4; ++tap) { const int tp = tpos + tap - 2;
          if (tp >= 0 && tp < len) { const int row = (nt < 16 ? b * CTXL : TC + b * SEQ) + tp; const bf16_t* pr = P + (size_t)row * 2048 + 1024 + kb * 64 + g * 16;
              const u32x4 a = *(const u32x4*)pr, c2 = *(const u32x4*)(pr + 8); float t0[8], t1[8]; unpack8(a, t0); unpack8(c2, t1);
#pragma unroll
              for (int c = 0; c < 8; ++c) { acc[c] = fmaf(cw[tap * 1024 + kb * 64 + g * 16 + c], t0[c], acc[c]); acc[8 + c] = fmaf(cw[tap * 1024 + kb * 64 + g * 16 + 8 + c], t1[c], acc[8 + c]); } } }
#pragma unroll
      for (int q = 0; q < 4; ++q) *(LAS f32x4*)(ucb + tk * 64 + g * 16 + q * 4) = (f32x4){acc[q * 4], acc[q * 4 + 1], acc[q * 4 + 2], acc[q * 4 + 3]}; }
    bf16x8 bfr[2];
#pragma unroll
    for (int ks = 0; ks < 2; ++ks) { const f32x4 u0 = *(const LAS f32x4*)(ucb + tk * 64 + ks * 32 + g * 8), u1 = *(const LAS f32x4*)(ucb + tk * 64 + ks * 32 + g * 8 + 4);
        u32x4 w; w.x = cvt_pk_bf16(u0[0], u0[1]); w.y = cvt_pk_bf16(u0[2], u0[3]); w.z = cvt_pk_bf16(u1[0], u1[1]); w.w = cvt_pk_bf16(u1[2], u1[3]); __builtin_memcpy(&bfr[ks], &w, 16); }
    const float* b_a = inp(F, 17) + (size_t)jj * 2 * 1024; const float* b_x = inp(F, 19) + (size_t)jj * 2 * 1024; const float* lam = inp(F, 20) + (size_t)jj * 2 * 1024;
#pragma unroll
    for (int d = 0; d < 2; ++d)
#pragma unroll
        for (int et = 0; et < 4; ++et) {
            f32x4 ra = (f32x4){0.f, 0.f, 0.f, 0.f}, ri = (f32x4){0.f, 0.f, 0.f, 0.f};
#pragma unroll
            for (int ks = 0; ks < 2; ++ks) {
                const bf16x8 wa = *(const LAS bf16x8*)(Wl + ((d * 2 + 0) * 64 + et * 16 + tk) * 64 + ks * 32 + g * 8);
                const bf16x8 wx = *(const LAS bf16x8*)(Wl + ((d * 2 + 1) * 64 + et * 16 + tk) * 64 + ks * 32 + g * 8);
                ra = __builtin_amdgcn_mfma_f32_16x16x32_bf16(wa, bfr[ks], ra, 0, 0, 0);
                ri = __builtin_amdgcn_mfma_f32_16x16x32_bf16(wx, bfr[ks], ri, 0, 0, 0);
            }
#pragma unroll
            for (int i = 0; i < 4; ++i) { const int ch = kb * 64 + et * 16 + 4 * g + i;
                const float r = sigmoidf_(ra[i] + b_a[d * 1024 + ch]), ig = sigmoidf_(ri[i] + b_x[d * 1024 + ch]);
                const float lm = lam[d * 1024 + ch]; const float sp = log1pf(__expf(-lm));
                const float la = -8.0f * r * sp, a = __expf(la);
                const float u = ucb[tk * 64 + et * 16 + 4 * g + i];
                av[d][et][i] = a; xv[d][et][i] = sqrtf(fmaxf(-expm1f(2.0f * la), 0.f)) * ig * u; }
        }
}
template <int S> __device__ __forceinline__ void lru_step_f(float& a, float& x) { const float ap = dppf<0x110 + S>(1.0f, a), xp = dppf<0x110 + S>(0.0f, x); x = fmaf(a, xp, x); a = a * ap; }
template <int S> __device__ __forceinline__ void lru_step_b(float& a, float& x) { const float ap = dppf<0x100 + S>(1.0f, a), xp = dppf<0x100 + S>(0.0f, x); x = fmaf(a, xp, x); a = a * ap; }
template <bool FINAL>
__device__ __forceinline__ void ph_lru_ac(const Frame& F, int jj) {
    LAS bf16_t* Wl = (LAS bf16_t*)F.lds;
    LAS float* ucb = (LAS float*)(F.lds + 32768 + F.wave * 4096);
    const bf16_t* wsrc = (const bf16_t*)(F.WB + WB_LRU);
    float* AG = (float*)(F.R1 + R1_AG); const float* HST = (const float*)(F.R1 + R1_HST);
    const bf16_t* P = (const bf16_t*)(F.R1 + R1_P);
    const int tk = F.lane & 15, g = F.lane >> 4;
    const int NTASK = NBAT * 16 * 17;
    for (int task = F.wg; task < NTASK; task += F.G) {
        const int grp = task % 17, kb = (task / 17) & 15, b = task / (17 * 16);
        __syncthreads();
        for (int i = F.tid; i < 4 * 4096 / 8; i += 512) { const int mg = i >> 9, r = i & 511;
            *(LAS u32x4*)(Wl + mg * 4096 + r * 8) = *(const u32x4*)(wsrc + ((size_t)mg * 16 + kb) * 4096 + r * 8); }
        __syncthreads();
        const int ntiles = grp == 16 ? 16 : 32, nt0 = grp == 16 ? 0 : 16 + grp * 32;
        for (int ti = F.wave; ti < ntiles; ti += 8) {
            const int nt = nt0 + ti;
            float av[2][4][4], xv[2][4][4];
            lru_gates(F, jj, b, kb, nt, Wl, ucb, av, xv);
#pragma unroll
            for (int et = 0; et < 4; ++et)
#pragma unroll
                for (int i = 0; i < 4; ++i) {
                    lru_step_f<1>(av[0][et][i], xv[0][et][i]); lru_step_f<2>(av[0][et][i], xv[0][et][i]); lru_step_f<4>(av[0][et][i], xv[0][et][i]); lru_step_f<8>(av[0][et][i], xv[0][et][i]);
                    lru_step_b<1>(av[1][et][i], xv[1][et][i]); lru_step_b<2>(av[1][et][i], xv[1][et][i]); lru_step_b<4>(av[1][et][i], xv[1][et][i]); lru_step_b<8>(av[1][et][i], xv[1][et][i]);
                }
            if (!FINAL) {
#pragma unroll
                for (int d = 0; d < 2; ++d) if (tk == (d ? 0 : 15)) {
                    float* ag = AG + (((size_t)(b * 2 + d) * LRU_NT + nt) * 2) * 1024 + kb * 64;
#pragma unroll
                    for (int et = 0; et < 4; ++et) { *(f32x4*)(ag + et * 16 + 4 * g) = (f32x4){av[d][et][0], av[d][et][1], av[d][et][2], av[d][et][3]};
                        *(f32x4*)(ag + 1024 + et * 16 + 4 * g) = (f32x4){xv[d][et][0], xv[d][et][1], xv[d][et][2], xv[d][et][3]}; }
                }
            } else {
                const int row = lru_row(b, nt, tk);
#pragma unroll
                for (int et = 0; et < 4; ++et) {
                    const int ch = kb * 64 + et * 16 + 4 * g;
                    const f32x4 hf = *(const f32x4*)(HST + ((size_t)(b * 2 + 0) * LRU_NT + nt) * 1024 + ch);
                    const f32x4 hb = *(const f32x4*)(HST + ((size_t)(b * 2 + 1) * LRU_NT + nt) * 1024 + ch);
                    const u32x2 yw = *(const u32x2*)(P + (size_t)row * 2048 + ch);
                    const float y0 = __uint_as_float(yw.x << 16), y1 = __uint_as_float(yw.x & 0xffff0000u), y2 = __uint_as_float(yw.y << 16), y3 = __uint_as_float(yw.y & 0xffff0000u);
                    float o[4];
#pragma unroll
                    for (int i = 0; i < 4; ++i) o[i] = fmaf(av[0][et][i], hf[i], xv[0][et][i]) + fmaf(av[1][et][i], hb[i], xv[1][et][i]);
                    o[0] *= gelu_tanh_(y0); o[1] *= gelu_tanh_(y1); o[2] *= gelu_tanh_(y2); o[3] *= gelu_tanh_(y3);
                    u32x2 w; w.x = cvt_pk_bf16(o[0], o[1]); w.y = cvt_pk_bf16(o[2], o[3]);
                    *(u32x2*)(F.MIX + (size_t)row * DM + ch) = w;
                }
            }
        }
    }
    __syncthreads();
}
__device__ __forceinline__ void ph_lru_b(const Frame& F) {
    const float* AG = (const float*)(F.R1 + R1_AG); float* HST = (float*)(F.R1 + R1_HST);
    LAS float* sa = (LAS float*)F.lds; LAS float* sx = sa + 512;
    for (int task = F.wg; task < NBAT * 2 * 32; task += F.G) {
        const int cgp = task & 31, d = (task >> 5) & 1, b = task >> 6;
        const int ch = cgp * 32 + (F.tid & 31), seg = F.tid >> 5;
        const float* ag = AG + ((size_t)(b * 2 + d) * LRU_NT) * 2048 + ch;
        float A = 1.0f, Xv = 0.f;
        for (int i = 0; i < 33; ++i) { const int nt = lru_nat(seg * 33 + i, d); const float a = ag[(size_t)nt * 2048], x = ag[(size_t)nt * 2048 + 1024]; Xv = fmaf(a, Xv, x); A *= a; }
        __syncthreads();
        sa[F.tid] = A; sx[F.tid] = Xv;
        __syncthreads();
        float h = 0.f;
        for (int s2 = 0; s2 < seg; ++s2) h = fmaf(sa[s2 * 32 + (F.tid & 31)], h, sx[s2 * 32 + (F.tid & 31)]);
        float* hs = HST + ((size_t)(b * 2 + d) * LRU_NT) * 1024 + ch;
        for (int i = 0; i < 33; ++i) { const int nt = lru_nat(seg * 33 + i, d); hs[(size_t)nt * 1024] = h; const float a = ag[(size_t)nt * 2048], x = ag[(size_t)nt * 2048 + 1024]; h = fmaf(a, h, x); }
    }
    __syncthreads();
}

__device__ __forceinline__ void ph_ln_router(const Frame& F, int l) {
    const float* gam = inp(F, 6) + (size_t)(l * 2 + 0) * DM; const float* bet = inp(F, 7) + (size_t)(l * 2 + 0) * DM;
    const bf16_t* RW = (const bf16_t*)(F.WB + WB_RT);
    const float* rbias = inp(F, 23) + l * 64;
    LAS float* lg = (LAS float*)(F.lds + F.wave * 4096);
    LAS int* hist = (LAS int*)(F.lds + LDS_MISC + MISC_HIST); LAS int* hbase = (LAS int*)(F.lds + LDS_MISC + MISC_HBASE);
    int* tok_e = (int*)(F.ws + OFF_TOKE); int* tok_p = (int*)(F.ws + OFF_TOKP); float* tok_w = (float*)(F.ws + OFF_TOKW);
    int* stok = (int*)(F.ws + OFF_STOK); float* sw = (float*)(F.ws + OFF_SW);
    unsigned* gcnt = (unsigned*)(F.ws + OFF_CTL + CTL_CNT) + l * 64;
    const int tk = F.lane & 15, g = F.lane >> 4;
    if (F.tid < 64) hist[F.tid] = 0;
    __syncthreads();
    const int NTILE = TT / 16;
    for (int it = 0;; ++it) {
        const int tile = (it * F.G + F.wg) * 8 + F.wave;
        if ((it * F.G + F.wg) * 8 >= NTILE) break;
        if (tile < NTILE) {
            const int row = tile * 16 + tk; const int s = slot_of_row(tile * 16);
            const float* m = F.mods + (size_t)(l * 5 + s) * 6144;
            float* xr = F.X + (size_t)row * DM;
            float sum = 0.f, sq = 0.f;
            for (int ks = 0; ks < 32; ++ks) { const f32x4 a = *(const f32x4*)(xr + ks * 32 + g * 8), c = *(const f32x4*)(xr + ks * 32 + g * 8 + 4);
                sum += (a[0] + a[1]) + (a[2] + a[3]) + (c[0] + c[1]) + (c[2] + c[3]);
                sq += (a[0] * a[0] + a[1] * a[1]) + (a[2] * a[2] + a[3] * a[3]) + (c[0] * c[0] + c[1] * c[1]) + (c[2] * c[2] + c[3] * c[3]); }
            sum += __shfl_xor(sum, 16); sum += __shfl_xor(sum, 32); sq += __shfl_xor(sq, 16); sq += __shfl_xor(sq, 32);
            const float mean = sum * (1.0f / 1024.0f), var = fmaxf(sq * (1.0f / 1024.0f) - mean * mean, 0.f), rstd = rsqrtf(var + 1e-5f);
            f32x4 acc[4];
#pragma unroll
            for (int et = 0; et < 4; ++et) acc[et] = (f32x4){0.f, 0.f, 0.f, 0.f};
            for (int ks = 0; ks < 32; ++ks) { const int k = ks * 32 + g * 8;
                float v[8], gm[8], bt[8], m3[8], m4[8];
                *(f32x4*)&v[0] = *(const f32x4*)(xr + k); *(f32x4*)&v[4] = *(const f32x4*)(xr + k + 4);
                *(f32x4*)&gm[0] = *(const f32x4*)(gam + k); *(f32x4*)&gm[4] = *(const f32x4*)(gam + k + 4);
                *(f32x4*)&bt[0] = *(const f32x4*)(bet + k); *(f32x4*)&bt[4] = *(const f32x4*)(bet + k + 4);
                *(f32x4*)&m3[0] = *(const f32x4*)(m + 3 * 1024 + k); *(f32x4*)&m3[4] = *(const f32x4*)(m + 3 * 1024 + k + 4);
                *(f32x4*)&m4[0] = *(const f32x4*)(m + 4 * 1024 + k); *(f32x4*)&m4[4] = *(const f32x4*)(m + 4 * 1024 + k + 4);
                float hh[8];
#pragma unroll
                for (int q = 0; q < 8; ++q) { const float xn = (v[q] - mean) * rstd * gm[q] + bt[q]; v[q] = xn; hh[q] = xn * (1.0f + m4[q]) + m3[q]; }
                *(f32x4*)(xr + k) = *(f32x4*)&v[0]; *(f32x4*)(xr + k + 4) = *(f32x4*)&v[4];
                u32x4 w; w.x = cvt_pk_bf16(hh[0], hh[1]); w.y = cvt_pk_bf16(hh[2], hh[3]); w.z = cvt_pk_bf16(hh[4], hh[5]); w.w = cvt_pk_bf16(hh[6], hh[7]);
                *(u32x4*)(F.HB + (size_t)row * DM + k) = w;
                bf16x8 af; __builtin_memcpy(&af, &w, 16);
#pragma unroll
                for (int et = 0; et < 4; ++et) { const bf16x8 bf = *(const bf16x8*)(RW + (size_t)(et * 16 + tk) * 1024 + k); acc[et] = __builtin_amdgcn_mfma_f32_16x16x32_bf16(af, bf, acc[et], 0, 0, 0); }
            }
#pragma unroll
            for (int et = 0; et < 4; ++et)
#pragma unroll
                for (int i = 0; i < 4; ++i) lg[(4 * g + i) * 64 + et * 16 + tk] = acc[et][i];
            asm volatile("s_waitcnt lgkmcnt(0)" ::: "memory");
            if (F.lane < 16) {
                const int r2 = tile * 16 + F.lane;
                unsigned long long taken = 0ull; int se[6]; float ss[6]; float tot = 0.f;
#pragma unroll
                for (int q = 0; q < 6; ++q) { float best = -1e30f; int be = 0; float bs = 0.f;
                    for (int e = 0; e < 64; ++e) { const float sc = sigmoidf_(lg[F.lane * 64 + e]); const float key = sc + rbias[e];
                        if (!((taken >> e) & 1ull) && key > best) { best = key; be = e; bs = sc; } }
                    taken |= 1ull << be; se[q] = be; ss[q] = bs; tot += bs; }
                const float sc2 = 2.5f / tot;
#pragma unroll
                for (int q = 0; q < 6; ++q) { tok_e[r2 * 8 + q] = se[q]; tok_w[r2 * 8 + q] = ss[q] * sc2; tok_p[r2 * 8 + q] = __hip_atomic_fetch_add(hist + se[q], 1, __ATOMIC_RELAXED, __HIP_MEMORY_SCOPE_WORKGROUP); }
            }
        }
    }
    asm volatile("s_waitcnt vmcnt(0) lgkmcnt(0)" ::: "memory");
    __syncthreads();
    if (F.tid < 64) hbase[F.tid] = (int)__hip_atomic_fetch_add(gcnt + F.tid, (unsigned)hist[F.tid], __ATOMIC_RELAXED, __HIP_MEMORY_SCOPE_AGENT);
    __syncthreads();
    for (int it = 0;; ++it) {
        const int r0 = (it * F.G + F.wg) * 128;
        if (r0 >= TT) break;
        for (int i = F.tid; i < 128 * 6; i += 512) { const int row = r0 + i / 6, q = i % 6; const int e = tok_e[row * 8 + q]; const int pos = hbase[e] + tok_p[row * 8 + q];
            tok_p[row * 8 + q] = pos; stok[(size_t)e * CAP + pos] = row; sw[(size_t)e * CAP + pos] = tok_w[row * 8 + q]; }
    }
    __syncthreads();
}

__device__ __forceinline__ int moe_tables(const Frame& F, int l) {
    LAS int* cnt = (LAS int*)(F.lds + LDS_MISC + MISC_CNT); LAS int* tst = (LAS int*)(F.lds + LDS_MISC + MISC_TST); LAS unsigned char* t2e = (LAS unsigned char*)(F.lds + LDS_MISC + MISC_T2E);
    const unsigned* gcnt = (const unsigned*)(F.ws + OFF_CTL + CTL_CNT) + l * 64;
    __syncthreads();
    if (F.tid < 64) cnt[F.tid] = (int)__hip_atomic_load(gcnt + F.tid, __ATOMIC_RELAXED, __HIP_MEMORY_SCOPE_AGENT);
    if (F.tid == 64) cnt[64] = TT;
    __syncthreads();
    if (F.tid == 0) { int s = 0; for (int e = 0; e < 65; ++e) { tst[e] = s; s += (cnt[e] + 255) >> 8; } tst[65] = s; }
    __syncthreads();
    const int ntiles = tst[65];
    for (int t = F.tid; t < ntiles; t += 512) { int e = 0; for (int q = 0; q < 65; ++q) if (t >= tst[q]) e = q; else break; t2e[t] = (unsigned char)e; }
    __syncthreads();
    return ntiles;
}

__device__ __forceinline__ void ph_combine(const Frame& F, int l) {
    LAS int* tst = (LAS int*)(F.lds + LDS_MISC + MISC_TST);
    (void)moe_tables(F, l);
    const float* gam = inp(F, 6) + (size_t)(l * 2 + 1) * DM; const float* bet = inp(F, 7) + (size_t)(l * 2 + 1) * DM;
    const bf16_t* Y = (const bf16_t*)(F.R1 + R1_Y);
    const int* tok_e = (const int*)(F.ws + OFF_TOKE); const int* tok_p = (const int*)(F.ws + OFF_TOKP);
    const int gw = F.wg * 8 + F.wave, nw = F.G * 8;
    const bool lastl = (l == 3);
    for (int row = gw; row < TT; row += nw) {
        const int s = slot_of_row(row);
        const float* m = F.mods + (size_t)(l * 5 + s) * 6144;
        const float* mn = F.mods + (size_t)((lastl ? l : l + 1) * 5 + s) * 6144;
        int srow[7];
#pragma unroll
        for (int q = 0; q < 6; ++q) { const int e = tok_e[row * 8 + q]; srow[q] = tst[e] * 256 + tok_p[row * 8 + q]; }
        srow[6] = tst[64] * 256 + row;
        float v[16];
#pragma unroll
        for (int hh = 0; hh < 2; ++hh) { const int k = hh * 512 + F.lane * 8;
            float y[8];
#pragma unroll
            for (int q = 0; q < 8; ++q) y[q] = 0.f;
#pragma unroll
            for (int q = 0; q < 7; ++q) { const u32x4 w = *(const u32x4*)(Y + (size_t)srow[q] * DM + k); float t[8]; unpack8(w, t);
#pragma unroll
                for (int i = 0; i < 8; ++i) y[i] += t[i]; }
            const f32x4 x0 = *(const f32x4*)(F.X + (size_t)row * DM + k), x1 = *(const f32x4*)(F.X + (size_t)row * DM + k + 4);
            const f32x4 m50 = *(const f32x4*)(m + 5 * 1024 + k), m51 = *(const f32x4*)(m + 5 * 1024 + k + 4);
#pragma unroll
            for (int i = 0; i < 4; ++i) { v[hh * 8 + i] = ALPHA * x0[i] + m50[i] * y[i]; v[hh * 8 + 4 + i] = ALPHA * x1[i] + m51[i] * y[4 + i]; }
        }
        float sum = 0.f;
#pragma unroll
        for (int i = 0; i < 16; ++i) sum += v[i];
        sum += __shfl_xor(sum, 1); sum += __shfl_xor(sum, 2); sum += __shfl_xor(sum, 4); sum += __shfl_xor(sum, 8); sum += __shfl_xor(sum, 16); sum += __shfl_xor(sum, 32);
        const float mean = sum * (1.0f / 1024.0f);
        float sq = 0.f;
#pragma unroll
        for (int i = 0; i < 16; ++i) { const float d = v[i] - mean; sq += d * d; }
        sq += __shfl_xor(sq, 1); sq += __shfl_xor(sq, 2); sq += __shfl_xor(sq, 4); sq += __shfl_xor(sq, 8); sq += __shfl_xor(sq, 16); sq += __shfl_xor(sq, 32);
        const float rstd = rsqrtf(sq * (1.0f / 1024.0f) + 1e-5f);
#pragma unroll
        for (int hh = 0; hh < 2; ++hh) { const int k = hh * 512 + F.lane * 8;
            float gm[8], bt[8], xn[8];
            *(f32x4*)&gm[0] = *(const f32x4*)(gam + k); *(f32x4*)&gm[4] = *(const f32x4*)(gam + k + 4);
            *(f32x4*)&bt[0] = *(const f32x4*)(bet + k); *(f32x4*)&bt[4] = *(const f32x4*)(bet + k + 4);
#pragma unroll
            for (int i = 0; i < 8; ++i) xn[i] = (v[hh * 8 + i] - mean) * rstd * gm[i] + bt[i];
            if (lastl) { if (row >= TC) { float* o = F.out + (size_t)(row - TC) * DM + k; *(f32x4*)o = *(f32x4*)&xn[0]; *(f32x4*)(o + 4) = *(f32x4*)&xn[4]; } }
            else {
                *(f32x4*)(F.X + (size_t)row * DM + k) = *(f32x4*)&xn[0]; *(f32x4*)(F.X + (size_t)row * DM + k + 4) = *(f32x4*)&xn[4];
                float s1[8], b0[8];
                *(f32x4*)&s1[0] = *(const f32x4*)(mn + 1024 + k); *(f32x4*)&s1[4] = *(const f32x4*)(mn + 1024 + k + 4);
                *(f32x4*)&b0[0] = *(const f32x4*)(mn + k); *(f32x4*)&b0[4] = *(const f32x4*)(mn + k + 4);
                float hv[8];
#pragma unroll
                for (int i = 0; i < 8; ++i) hv[i] = xn[i] * (1.0f + s1[i]) + b0[i];
                u32x4 w; w.x = cvt_pk_bf16(hv[0], hv[1]); w.y = cvt_pk_bf16(hv[2], hv[3]); w.z = cvt_pk_bf16(hv[4], hv[5]); w.w = cvt_pk_bf16(hv[6], hv[7]);
                *(u32x4*)(F.HB + (size_t)row * DM + k) = w;
            }
        }
    }
}

constexpr int NPHASE = 2 + 4 * 10;
__global__ void __launch_bounds__(512, 2) mk_fwd(Args args) {
    extern __shared__ __attribute__((aligned(16))) unsigned char lds_raw[];
    Frame F;
    F.out = args.out; F.ws = args.ws; F.lds = (LAS unsigned char*)lds_raw;
    F.tid = threadIdx.x; F.lane = F.tid & 63; F.wave = __builtin_amdgcn_readfirstlane(F.tid >> 6); F.G = gridDim.x; F.wg = blockIdx.x;
    F.mods = (float*)(args.ws + OFF_MODS); F.X = (float*)(args.ws + OFF_X); F.HB = (bf16_t*)(args.ws + OFF_HB); F.MIX = F.HB;
    F.WB = args.ws + OFF_WB; F.R1 = args.ws + OFF_R1;
    volatile LAS unsigned* xbw = (volatile LAS unsigned*)(F.lds + LDS_MISC);
    if (F.tid < 4) xbw[F.tid] = 0u;
    if (F.tid < 30) ((LAS unsigned long long*)(F.lds + LDS_MISC + MISC_INP))[F.tid] = (unsigned long long)args.in[F.tid];
    __syncthreads();
    const int lo = args.ph_lo, hi = args.ph_hi;
    XcdBarrier bar; bar.bar = (unsigned*)(args.ws + OFF_CTL); bar.x = 0; bar.st = xbw;
    if (hi - lo > 1) bar = xcd_barrier_post((unsigned*)(args.ws + OFF_CTL), xbw);
#define IN(k) (lo <= (k) && (k) < hi)
#define SEAM(k) do { if (IN(k) && IN((k) + 1)) xcd_barrier(bar); } while (0)
    if ((PHM & 1) && IN(0)) { ph_mods(fresh(F)); } SEAM(0);
    if ((PHM & 2) && IN(1)) { ph_init_x(fresh(F)); }
    for (int l = 0; l < 4; ++l) {
        const int pb = 2 + l * 10, j = l >> 1; const bool even = (l & 1) == 0;
        float* mods_l = F.mods + (size_t)l * 5 * 6144;
        if ((PHM & 4) && IN(pb + 0)) { ph_convert(fresh(F), l); } SEAM(pb + 0);
        if ((PHM & 8) && IN(pb + 1)) {
            const int N = even ? 4096 : 2048;
            pg8::StaticOrder S; S.init(F.HB, F.WB + WB_IN, TT, N, 1024, F.G, F.wg);
            pg8::EpiStoreBf16 E{(bf16_t*)(F.R1 + R1_P), N};
            pg8::gemm_phase(F.lds, 1024, S, E);
        } SEAM(pb + 1);
        if (IN(pb + 2)) { if (even) { if (PHM & 16) ph_attn(fresh(F), j); if (PHM & 32) ph_hg_a(fresh(F), j); } else { if (PHM & 64) ph_lru_ac<false>(fresh(F), j); } } SEAM(pb + 2);
        if (IN(pb + 3)) { if (even) { if (PHM & 128) ph_hg_b(fresh(F)); } else { if (PHM & 256) ph_lru_b(fresh(F)); } } SEAM(pb + 3);
        if (IN(pb + 4)) { if (even) { if (PHM & 512) ph_hg_c(fresh(F), j); } else { if (PHM & 1024) ph_lru_ac<true>(fresh(F), j); } } SEAM(pb + 4);
        if ((PHM & 2048) && IN(pb + 5)) {
            pg8::StaticOrder S; S.init(F.MIX, F.WB + WB_OUT, TT, 1024, 1024, F.G, F.wg);
            pg8::EpiResid E{F.X, mods_l};
            pg8::gemm_phase(F.lds, 1024, S, E);
        } SEAM(pb + 5);
        if ((PHM & 4096) && IN(pb + 6)) { ph_ln_router(fresh(F), l); } SEAM(pb + 6);
        if ((PHM & 8192) && IN(pb + 7)) {
            const int ntiles = moe_tables(fresh(F), l);
            pg8::MoeGU S; S.cnt = (const LAS int*)(F.lds + LDS_MISC + MISC_CNT); S.tst = (const LAS int*)(F.lds + LDS_MISC + MISC_TST); S.t2e = (const LAS unsigned char*)(F.lds + LDS_MISC + MISC_T2E);
            S.ntiles = ntiles; S.npn = 2; S.G = F.G; S.c = F.wg; S.A = (const char*)F.HB; S.Bt = (const char*)(F.WB + WB_GU); S.stok = (const int*)(F.ws + OFF_STOK);
            pg8::EpiSwiglu E{(bf16_t*)(F.R1 + R1_H)};
            pg8::gemm_phase(F.lds, 1024, S, E);
        } SEAM(pb + 7);
        if ((PHM & 16384) && IN(pb + 8)) {
            const int ntiles = moe_tables(fresh(F), l);
            pg8::MoeDN S; S.cnt = (const LAS int*)(F.lds + LDS_MISC + MISC_CNT); S.tst = (const LAS int*)(F.lds + LDS_MISC + MISC_TST); S.t2e = (const LAS unsigned char*)(F.lds + LDS_MISC + MISC_T2E);
            S.ntiles = ntiles; S.npn = 4; S.G = F.G; S.c = F.wg; S.A = (const char*)(F.R1 + R1_H); S.Bt = (const char*)(F.WB + WB_DN);
            pg8::EpiDown E{(bf16_t*)(F.R1 + R1_Y), (const float*)(F.ws + OFF_SW), (const LAS int*)(F.lds + LDS_MISC + MISC_CNT)};
            pg8::gemm_phase(F.lds, 256, S, E);
        } SEAM(pb + 8);
        if ((PHM & 32768) && IN(pb + 9)) { ph_combine(fresh(F), l); } SEAM(pb + 9);
    }
#undef IN
#undef SEAM
}

extern "C" void kernel_launch(void* const* d_in, const int* in_sizes, int n_in, void* d_out, int out_size, void* d_ws, size_t ws_size, hipStream_t stream) {
    static int grid = 0;
    if (grid == 0) {
        if (n_in != 30 || out_size != TX * DM || ws_size < WS_END) { fprintf(stderr, "kernel_launch: unexpected problem (n_in %d out %d ws %zu need %zu)\n", n_in, out_size, ws_size, (size_t)WS_END); grid = -1; return; }
        int dev = 0, cus = 0, per_cu = 0;
        if (hipGetDevice(&dev) != hipSuccess || hipDeviceGetAttribute(&cus, hipDeviceAttributeMultiprocessorCount, dev) != hipSuccess) { grid = -1; return; }
        if (hipFuncSetAttribute((const void*)mk_fwd, hipFuncAttributeMaxDynamicSharedMemorySize, LDS_BYTES) != hipSuccess) { fprintf(stderr, "kernel_launch: hipFuncSetAttribute failed\n"); grid = -1; return; }
        if (hipOccupancyMaxActiveBlocksPerMultiprocessor(&per_cu, (const void*)mk_fwd, 512, LDS_BYTES) != hipSuccess || per_cu < 1) { fprintf(stderr, "kernel_launch: occupancy query says %d\n", per_cu); }
        (void)hipGetLastError();
        grid = cus;
    }
    if (grid < 0) return;
    (void)hipMemsetAsync((char*)d_ws + OFF_CTL, 0, CTL_BYTES, stream);
    Args a{};
    for (int i = 0; i < 30; ++i) a.in[i] = (const float*)d_in[i];
    a.out = (float*)d_out; a.ws = (unsigned char*)d_ws;
#if MK_SPLIT
    for (int p = 0; p < NPHASE; ++p) { a.ph_lo = p; a.ph_hi = p + 1; hipLaunchKernelGGL(mk_fwd, dim3(grid), dim3(512), LDS_BYTES, stream, a); }
#else
    a.ph_lo = 0; a.ph_hi = NPHASE;
    hipLaunchKernelGGL(mk_fwd, dim3(grid), dim3(512), LDS_BYTES, stream, a);
#endif
}
```

```cpp
#include <hip/hip_runtime.h>
#include <cstdio>
#include <cstdint>

#ifndef PHM
#define PHM 0xFFFF
#endif
#ifndef REPM
#define REPM 0
#endif
#ifndef MK_SPLIT
#define MK_SPLIT 0
#endif

typedef unsigned short bf16_t;
typedef short bf16x8 __attribute__((ext_vector_type(8)));
typedef short bf16x4 __attribute__((ext_vector_type(4)));
typedef float f32x4 __attribute__((ext_vector_type(4)));
typedef float f32x2 __attribute__((ext_vector_type(2)));
typedef unsigned u32x4 __attribute__((ext_vector_type(4)));
typedef unsigned u32x2 __attribute__((ext_vector_type(2)));
#define LAS __attribute__((address_space(3)))

constexpr int DM = 1024, NBAT = 4, SEQ = 8192, CTXL = 256;
constexpr int TC = NBAT * CTXL, TX = NBAT * SEQ, TT = TC + TX;
constexpr int NEXP = 64, TOPK = 6;
constexpr int CAP = TT;
constexpr int MOE_ROUTED_ROWS = 6 * TT + 64 * 256;
constexpr int MOE_ROWS = MOE_ROUTED_ROWS + TT;
constexpr int MOE_MAXTILES = MOE_ROWS / 256;
constexpr float ALPHA = 1.681792830507429f;
constexpr int HG_U = 128, HG_NU = (CTXL + SEQ) / HG_U;
constexpr int LRU_NT = (CTXL + SEQ) / 16;

constexpr size_t OFF_CTL = 0, CTL_BYTES = 65536;
constexpr size_t CTL_CNT = 16384, CTL_DBG = 20480;
constexpr size_t OFF_MODS = 65536;
constexpr size_t OFF_LBT = OFF_MODS + 4 * 5 * 6144 * 4;
constexpr size_t OFF_STATS = OFF_LBT + 8192;
constexpr size_t OFF_AB = OFF_STATS + (size_t)TT * 8;
static_assert(OFF_AB + 4 * 5 * 2 * 1024 * 4 <= (1u << 20), "ctl map");
constexpr size_t OFF_TOKE = 1u << 20;
constexpr size_t OFF_TOKP = OFF_TOKE + (size_t)TT * 32;
constexpr size_t OFF_TOKW = OFF_TOKP + (size_t)TT * 32;
constexpr size_t OFF_STOK = OFF_TOKW + (size_t)TT * 32;
constexpr size_t OFF_SW = OFF_STOK + (size_t)64 * CAP * 4;
constexpr size_t OFF_X = OFF_SW + (size_t)64 * CAP * 4;
constexpr size_t OFF_HB = OFF_X + (size_t)TT * DM * 4;
constexpr size_t OFF_WB = OFF_HB + (size_t)TT * DM * 2;
constexpr size_t WB_IN = 0, WB_OUT = WB_IN + (size_t)4096 * 1024 * 2, WB_RT = WB_OUT + (size_t)1024 * 1024 * 2, WB_GU = WB_RT + (size_t)64 * 1024 * 2,
                 WB_DN = WB_GU + (size_t)65 * 512 * 1024 * 2, WB_LRU = WB_DN + (size_t)65 * 1024 * 256 * 2, WB_END = WB_LRU + (size_t)2 * 2 * 16 * 64 * 64 * 2;
constexpr size_t OFF_R1 = OFF_WB + WB_END;
constexpr size_t R1_P = 0;
constexpr size_t R1_OF = R1_P + (size_t)TT * 4096 * 2;
constexpr size_t R1_SLOC = R1_OF + (size_t)TT * 512 * 4;
constexpr size_t R1_SST = R1_SLOC + (size_t)64 * HG_NU * 4096 * 4;
constexpr size_t R1_DL = R1_SST + (size_t)64 * HG_NU * 4096 * 4;
constexpr size_t R1_AG = R1_OF;
constexpr size_t R1_HST = R1_AG + (size_t)4 * 2 * LRU_NT * 2 * 1024 * 4;
constexpr size_t R1_H = 0;
constexpr size_t R1_Y = R1_H + (size_t)MOE_ROWS * 256 * 2;
constexpr size_t R1_MOE_END = R1_Y + (size_t)MOE_ROWS * 1024 * 2;
constexpr size_t R1_MIX_END = R1_DL + (size_t)64 * HG_NU * 64 * 4;
constexpr size_t WS_END = OFF_R1 + (R1_MOE_END > R1_MIX_END ? R1_MOE_END : R1_MIX_END);

constexpr int LDS_STAGE = 131072;
constexpr int LDS_MISC = LDS_STAGE;
constexpr int MISC_CNT = 64;
constexpr int MISC_TST = MISC_CNT + 66 * 4 + 8;
constexpr int MISC_HIST = 640;
constexpr int MISC_HBASE = 896;
constexpr int MISC_T2E = 1152;
constexpr int MISC_INP = 2304;
constexpr int LDS_BYTES = 147456;

#define XB_TMO      128
#define XB_XCNT(j)  (256  + 64 * (j))
#define XB_XSUB(j)  (1280 + 64 * (j))
#define XB_XGEN(j)  (2304 + 64 * (j))
#define XB_TOP      3328
#define XB_TOPGEN   3392
#define XCD_BAR_WORDS 3456
#define XB_SPIN_CAP (1u << 22)
__device__ __forceinline__ unsigned xb_ld(unsigned* p)              { return __hip_atomic_load(p, __ATOMIC_RELAXED, __HIP_MEMORY_SCOPE_AGENT); }
__device__ __forceinline__ unsigned xb_add(unsigned* p, unsigned v) { return __hip_atomic_fetch_add(p, v, __ATOMIC_RELAXED, __HIP_MEMORY_SCOPE_AGENT); }
__device__ __forceinline__ unsigned xb_xcc_id() { return (unsigned)__builtin_amdgcn_s_getreg((3 << 11) | 20) & 0xFu; }
#define XB_SPIN(cond, bar) do { unsigned _sp = 0; while (cond) { __builtin_amdgcn_s_sleep(1); \
    if ((++_sp & 255u) == 0u) { if (xb_ld(&(bar)[XB_TMO])) break; if (_sp > XB_SPIN_CAP) { atomicAdd(&(bar)[XB_TMO], 1u); break; } } } } while (0)
struct XcdBarrier { unsigned* bar; unsigned x; volatile LAS unsigned* st; };
__device__ __forceinline__ XcdBarrier xcd_barrier_post(unsigned* bar, volatile LAS unsigned* st) {
    XcdBarrier b; b.bar = bar; b.x = xb_xcc_id(); b.st = st;
    if (threadIdx.x == 0) (void)xb_add(&bar[XB_XCNT(b.x)], 1u);
    return b;
}
__device__ __forceinline__ void xcd_barrier_complete(unsigned* bar, unsigned x, unsigned& nloc, unsigned& nx) {
    const unsigned G = gridDim.x * gridDim.y * gridDim.z;
    unsigned sum, cnt, mine, sp = 0u;
    for (;;) {
        sum = 0u; cnt = 0u; mine = 0u;
#pragma unroll
        for (unsigned j = 0; j < 16; ++j) { const unsigned c = xb_ld(&bar[XB_XCNT(j)]); sum += c; cnt += (c > 0u) ? 1u : 0u; mine = (j == x) ? c : mine; }
        if (sum == G) break;
        __builtin_amdgcn_s_sleep(1);
        if ((++sp & 255u) == 0u) { if (xb_ld(&bar[XB_TMO])) break; if (sp > XB_SPIN_CAP) { atomicAdd(&bar[XB_TMO], 1u); break; } }
    }
    nloc = mine > 0u ? mine : 1u; nx = cnt > 0u ? cnt : 1u;
}
__device__ __forceinline__ void xcd_barrier(const XcdBarrier& b) {
    asm volatile("s_waitcnt vmcnt(0)" ::: "memory");
    __syncthreads();
    if (threadIdx.x == 0) {
        unsigned* bar = b.bar;
        __builtin_amdgcn_s_waitcnt(0);
        unsigned nloc = b.st[0], nx = b.st[1];
        if (nloc == 0u) { xcd_barrier_complete(bar, b.x, nloc, nx); b.st[0] = nloc; b.st[1] = nx; }
        const unsigned old = xb_add(&bar[XB_XSUB(b.x)], 1u);
        const unsigned gen = old / nloc;
        if (old + 1u == (gen + 1u) * nloc) {
            __builtin_amdgcn_fence(__ATOMIC_RELEASE, "agent");
            asm volatile("s_waitcnt vmcnt(0)" ::: "memory");
            const unsigned og = xb_add(&bar[XB_TOP], 1u);
            const unsigned tg = og / nx;
            if (og + 1u == (tg + 1u) * nx) xb_add(&bar[XB_TOPGEN], 1u);
            else XB_SPIN(xb_ld(&bar[XB_TOPGEN]) == tg, bar);
            __builtin_amdgcn_fence(__ATOMIC_ACQUIRE, "agent");
            xb_add(&bar[XB_XGEN(b.x)], 1u);
            asm volatile("s_waitcnt vmcnt(0)" ::: "memory");
        } else {
            XB_SPIN(xb_ld(&bar[XB_XGEN(b.x)]) == gen, bar);
            __builtin_amdgcn_fence(__ATOMIC_ACQUIRE, "agent");
            asm volatile("s_waitcnt vmcnt(0)" ::: "memory");
        }
    }
    __syncthreads();
}

__device__ __forceinline__ float bf2f(unsigned short b) { return __uint_as_float(((unsigned)b) << 16); }
__device__ __forceinline__ unsigned cvt_pk_bf16(float lo, float hi) { unsigned r; asm volatile("v_cvt_pk_bf16_f32 %0, %1, %2" : "=v"(r) : "v"(lo), "v"(hi)); return r; }
__device__ __forceinline__ unsigned short f2bf(float f) { return (unsigned short)(cvt_pk_bf16(f, 0.f) & 0xffffu); }
__device__ __forceinline__ float sigmoidf_(float x) { return __builtin_amdgcn_rcpf(1.0f + __expf(-x)); }
__device__ __forceinline__ float siluf_(float x) { return x * sigmoidf_(x); }
__device__ __forceinline__ float gelu_tanh_(float x) { return x * sigmoidf_(1.5957691216057308f * (x + 0.044715f * x * x * x)); }
__device__ __forceinline__ int slot_of_row(int r) { return r < TC ? 4 : ((r - TC) >> 13); }
template <int CTRL> __device__ __forceinline__ float dppf(float oldv, float src) {
    return __int_as_float(__builtin_amdgcn_update_dpp(__float_as_int(oldv), __float_as_int(src), CTRL, 0xf, 0xf, false));
}
__device__ __forceinline__ void unpack8(const u32x4 w, float (&o)[8]) {
    o[0] = __uint_as_float(w.x << 16); o[1] = __uint_as_float(w.x & 0xffff0000u); o[2] = __uint_as_float(w.y << 16); o[3] = __uint_as_float(w.y & 0xffff0000u);
    o[4] = __uint_as_float(w.z << 16); o[5] = __uint_as_float(w.z & 0xffff0000u); o[6] = __uint_as_float(w.w << 16); o[7] = __uint_as_float(w.w & 0xffff0000u);
}

namespace pg8 {
constexpr int BM = 256, BK = 64, HALF = 128, HTB = HALF * BK * 2, STAGE_BYTES = 8 * HTB, NXCD = 8, WGM = 8;
__device__ __forceinline__ int lds_byte(int r, int c) { const int st = (r >> 4) * 2 + (c >> 5), rr = r & 15, cc = c & 31, ob = rr * 64 + cc * 2; return st * 1024 + (ob ^ (((ob >> 9) & 1) << 5)); }
__device__ __forceinline__ void stage_rc(int b, int& R, int& C) { const int st = b / 1024, sb = b % 1024, swz = sb ^ (((sb >> 9) & 1) << 5); R = (st >> 1) * 16 + swz / 64; C = (st & 1) * 32 + (swz % 64) / 2; }
__device__ __forceinline__ int perm32(int rho) { const int n = rho >> 4, i = rho & 15; return 8 * (i >> 2) + 4 * n + (i & 3); }
struct Unit { int pm, pn, e, ti; };

struct StaticOrder {
    const char* A; const char* Bt; int K;
    int nM, nN, nwg, G, c;
    __device__ __forceinline__ void init(const void* A_, const void* Bt_, int M, int N, int K_, int G_, int c_) { A = (const char*)A_; Bt = (const char*)Bt_; K = K_; nM = M / BM; nN = N / BM; nwg = nM * nN; G = G_; c = c_; }
    __device__ __forceinline__ bool next(int i, Unit& u) const {
        const long L = (long)i * G + c; if (L >= nwg) return false;
        int wgid = (int)L; { const int q = nwg / NXCD, r = nwg % NXCD, xcd = wgid % NXCD, off = wgid / NXCD; wgid = (xcd < r ? xcd * (q + 1) : r * (q + 1) + (xcd - r) * q) + off; }
        const int nig = WGM * nN, gid = wgid / nig, fm = gid * WGM, gsz = (nM - fm) < WGM ? (nM - fm) : WGM;
        u.pm = fm + ((wgid % nig) % gsz); u.pn = (wgid % nig) / gsz; u.e = 0; u.ti = 0; return true;
    }
    static constexpr bool GATHER = false;
    __device__ __forceinline__ const char* abase(const Unit& u) const { return A + (size_t)u.pm * BM * K * 2; }
    __device__ __forceinline__ const char* bbase(const Unit& u) const { return Bt + (size_t)u.pn * BM * K * 2; }
};

template <class Epi, class Sched>
__device__ __forceinline__ void gemm_phase(LAS unsigned char* lds, const int K_, const Sched& S, const Epi& E) {
    int Kl_ = K_; asm volatile("" : "+s"(Kl_)); const int K = Kl_;
    int tid_ = threadIdx.x; asm volatile("" : "+v"(tid_));
    const int tid = tid_, wid = __builtin_amdgcn_readfirstlane(tid >> 6), lane = tid & 63, wr = wid >> 2, wc = wid & 3, fr = lane & 15, fq = lane >> 4;
    const int nt = K / BK;
    unsigned voffA[2], voffB[2];
#pragma unroll
    for (int i = 0; i < 2; ++i) { int R, C; stage_rc(tid * 16 + i * 8192, R, C); const int Rb = Epi::PERM ? ((R & ~31) + perm32(R & 31)) : R; voffA[i] = (unsigned)(R * K + C) * 2u; voffB[i] = (unsigned)(Rb * K + C) * 2u; }
    const size_t kstep = (size_t)(BK * 2);
    const size_t hstep = (size_t)HALF * K * 2;
    const unsigned ldsw = (unsigned)wid * 1024u;
    const int aoff = lds_byte(wr * 64 + fr, fq * 8), boff = lds_byte(wc * 32 + fr, fq * 8);
#define PG8_SA(b, h) (((b) * 2 + (h)) * HTB)
#define PG8_SB(b, h) ((4 + (b) * 2 + (h)) * HTB)
#define PG8_STAGE(bufoff, gbase, voff) do { _Pragma("unroll") for (int _i = 0; _i < 2; ++_i) \
        __builtin_amdgcn_global_load_lds((const unsigned*)((const char*)(gbase) + (voff)[_i]), (LAS unsigned*)(lds + (bufoff) + ldsw + _i * 8192), 16, 0, 0); } while (0)
#define PG8_STAGEA(bufoff, hh, kb, nx) do { if constexpr (Sched::GATHER) { unsigned _o[2]; _o[0] = (nx) ? vN[hh][0] : vC[hh][0]; _o[1] = (nx) ? vN[hh][1] : vC[hh][1]; PG8_STAGE(bufoff, cA + (kb), _o); } \
        else { PG8_STAGE(bufoff, ((nx) ? nA : cA) + (hh) * hstep + (kb), voffA); } } while (0)
#define PG8_LDA(dst, b, h) do { _Pragma("unroll") for (int m = 0; m < 4; ++m) _Pragma("unroll") for (int k = 0; k < 2; ++k) dst[m][k] = *(const LAS bf16x8*)(lds + PG8_SA(b, h) + aoff + m * 2048 + k * 1024); } while (0)
#define PG8_LDB(dst, b, h) do { _Pragma("unroll") for (int n = 0; n < 2; ++n) _Pragma("unroll") for (int k = 0; k < 2; ++k) dst[n][k] = *(const LAS bf16x8*)(lds + PG8_SB(b, h) + boff + n * 2048 + k * 1024); } while (0)
#define PG8_MMA(ai, bj, At, Bt) do { __builtin_amdgcn_s_setprio(1); _Pragma("unroll") for (int m = 0; m < 4; ++m) _Pragma("unroll") for (int n = 0; n < 2; ++n) _Pragma("unroll") for (int k = 0; k < 2; ++k) \
        acc[ai][bj][m][n] = __builtin_amdgcn_mfma_f32_16x16x32_bf16(Bt[n][k], At[m][k], acc[ai][bj][m][n], 0, 0, 0); __builtin_amdgcn_s_setprio(0); } while (0)
#define PG8_WAIT_V(n) asm volatile("s_waitcnt vmcnt(" #n ")" ::: "memory")
#define PG8_WAIT_L(n) asm volatile("s_waitcnt lgkmcnt(" #n ")" ::: "memory")
#define PG8_BAR __builtin_amdgcn_s_barrier()
#define PG8_SCHED __builtin_amdgcn_sched_barrier(0)
    Unit cur, nxt; int ui = 0;
    if (!S.next(0, cur)) return;
    f32x4 acc[2][2][4][2];
#pragma unroll
    for (int a = 0; a < 2; ++a)
#pragma unroll
        for (int b = 0; b < 2; ++b)
#pragma unroll
            for (int m = 0; m < 4; ++m)
#pragma unroll
                for (int n = 0; n < 2; ++n) acc[a][b][m][n] = (f32x4){0.f, 0.f, 0.f, 0.f};
    bf16x8 At[4][2], B0[2][2], B1[2][2];
    unsigned vC[2][2], vN[2][2];
    if constexpr (Sched::GATHER) S.aoff(cur, tid, vC);
    const char* cA = S.abase(cur);
    const char* cB = S.bbase(cur);
    const char* nA = cA;
    PG8_STAGE(PG8_SB(0, 0), cB, voffB); PG8_STAGEA(PG8_SA(0, 0), 0, 0, false); PG8_STAGE(PG8_SB(0, 1), cB + hstep, voffB); PG8_STAGEA(PG8_SA(0, 1), 1, 0, false);
    if (wr == 1) PG8_BAR;
    PG8_WAIT_V(4); PG8_BAR;
    PG8_STAGE(PG8_SB(1, 0), cB + kstep, voffB); PG8_STAGEA(PG8_SA(1, 0), 0, kstep, false); PG8_STAGE(PG8_SB(1, 1), cB + hstep + kstep, voffB);
    PG8_WAIT_V(6); PG8_BAR;
    for (;;) {
        const bool has_next = S.next(ui + 1, nxt);
        const char* nB = cB; nA = cA;
        if (has_next) { nB = S.bbase(nxt); nA = S.abase(nxt); if constexpr (Sched::GATHER) S.aoff(nxt, tid, vN); }
        else { if constexpr (Sched::GATHER) {
#pragma unroll
            for (int h = 0; h < 2; ++h)
#pragma unroll
                for (int i = 0; i < 2; ++i) vN[h][i] = vC[h][i]; } }
        for (int t = 0; t < nt; t += 2) {
            const bool last = (t == nt - 2);
            const size_t k1 = (size_t)(t + 1) * kstep, k2 = last ? 0 : (size_t)(t + 2) * kstep, k3 = k2 + kstep;
            const char* b2 = last ? nB : cB + (size_t)(t + 2) * kstep; const char* b3 = b2 + kstep;
            PG8_LDB(B0, 0, 0); PG8_SCHED; PG8_LDA(At, 0, 0); PG8_STAGEA(PG8_SA(1, 1), 1, k1, false);
            PG8_WAIT_L(8); PG8_BAR; PG8_WAIT_L(0); PG8_MMA(0, 0, At, B0); PG8_BAR; PG8_SCHED;
            PG8_LDB(B1, 0, 1); PG8_STAGE(PG8_SB(0, 0), b2, voffB);
            PG8_BAR; PG8_WAIT_L(0); PG8_MMA(0, 1, At, B1); PG8_BAR;
            PG8_LDA(At, 0, 1); PG8_STAGEA(PG8_SA(0, 0), 0, k2, last);
            PG8_BAR; PG8_WAIT_L(0); PG8_MMA(1, 0, At, B0); PG8_BAR; PG8_SCHED;
            PG8_STAGE(PG8_SB(0, 1), b2 + hstep, voffB);
            PG8_WAIT_V(6); PG8_BAR; PG8_MMA(1, 1, At, B1); PG8_BAR;
            PG8_LDB(B0, 1, 0); PG8_SCHED; PG8_LDA(At, 1, 0); PG8_STAGEA(PG8_SA(0, 1), 1, k2, last);
            PG8_WAIT_L(8); PG8_BAR; PG8_WAIT_L(0); PG8_MMA(0, 0, At, B0); PG8_BAR; PG8_SCHED;
            PG8_LDB(B1, 1, 1); PG8_STAGE(PG8_SB(1, 0), b3, voffB);
            PG8_BAR; PG8_WAIT_L(0); PG8_MMA(0, 1, At, B1); PG8_BAR;
            PG8_LDA(At, 1, 1); PG8_STAGEA(PG8_SA(1, 0), 0, k3, last);
            PG8_BAR; PG8_WAIT_L(0); PG8_MMA(1, 0, At, B0); PG8_BAR; PG8_SCHED;
            PG8_STAGE(PG8_SB(1, 1), b3 + hstep, voffB);
            PG8_WAIT_V(6); PG8_BAR; PG8_MMA(1, 1, At, B1); PG8_BAR;
        }
        E(acc, cur, wr, wc, fr, fq);
        if (!has_next) break;
#pragma unroll
        for (int a = 0; a < 2; ++a)
#pragma unroll
            for (int b = 0; b < 2; ++b)
#pragma unroll
                for (int m = 0; m < 4; ++m)
#pragma unroll
                    for (int n = 0; n < 2; ++n) acc[a][b][m][n] = (f32x4){0.f, 0.f, 0.f, 0.f};
        cur = nxt; cB = nB; cA = nA; ++ui;
        if constexpr (Sched::GATHER) {
#pragma unroll
            for (int h = 0; h < 2; ++h)
#pragma unroll
                for (int i = 0; i < 2; ++i) vC[h][i] = vN[h][i]; }
    }
    PG8_WAIT_V(0);
    if (wr == 0) PG8_BAR;
    PG8_BAR;
#undef PG8_SA
#undef PG8_SB
#undef PG8_STAGE
#undef PG8_STAGEA
#undef PG8_LDA
#undef PG8_LDB
#undef PG8_MMA
#undef PG8_WAIT_V
#undef PG8_WAIT_L
#undef PG8_BAR
#undef PG8_SCHED
}

struct EpiStoreBf16 {
    static constexpr bool PERM = true;
    bf16_t* O; int ldc;
    __device__ __forceinline__ void operator()(const f32x4 (&acc)[2][2][4][2], const Unit& u, int wr, int wc, int fr, int fq) const {
        const int row0 = u.pm * BM + wr * 64 + fr, col0 = u.pn * BM + wc * 32 + 8 * fq;
#pragma unroll
        for (int ai = 0; ai < 2; ++ai)
#pragma unroll
            for (int m = 0; m < 4; ++m) { bf16_t* rowp = O + (size_t)(row0 + ai * HALF + m * 16) * ldc + col0;
#pragma unroll
                for (int bj = 0; bj < 2; ++bj) { const f32x4 v0 = acc[ai][bj][m][0], v1 = acc[ai][bj][m][1];
                    u32x4 w; w.x = cvt_pk_bf16(v0[0], v0[1]); w.y = cvt_pk_bf16(v0[2], v0[3]); w.z = cvt_pk_bf16(v1[0], v1[1]); w.w = cvt_pk_bf16(v1[2], v1[3]);
                    *(u32x4*)(rowp + bj * HALF) = w; } }
    }
};
struct EpiResid {
    static constexpr bool PERM = false;
    float* X; const float* mods_l;
    __device__ __forceinline__ void operator()(const f32x4 (&acc)[2][2][4][2], const Unit& u, int wr, int wc, int fr, int fq) const {
        const int row0 = u.pm * BM + wr * 64 + fr, col0 = u.pn * BM + wc * 32 + 4 * fq;
        const float* m2 = mods_l + (size_t)(slot_of_row(u.pm * BM) * 6 + 2) * DM + col0;
        float* xb = X + (size_t)row0 * DM + col0;
#pragma unroll
        for (int bj = 0; bj < 2; ++bj)
#pragma unroll
            for (int n = 0; n < 2; ++n) { const f32x4 mv = *(const f32x4*)(m2 + bj * HALF + n * 16);
#pragma unroll
                for (int ai = 0; ai < 2; ++ai) {
#pragma unroll
                    for (int m = 0; m < 4; ++m) { float* p = xb + (size_t)(ai * HALF + m * 16) * DM + bj * HALF + n * 16; const f32x4 xv = *(const f32x4*)p; *(f32x4*)p = xv * ALPHA + mv * acc[ai][bj][m][n]; }
                    asm volatile("" ::: "memory"); } }
    }
};
struct EpiSwiglu {
    static constexpr bool PERM = true;
    bf16_t* H;
    __device__ __forceinline__ void operator()(const f32x4 (&acc)[2][2][4][2], const Unit& u, int wr, int wc, int fr, int fq) const {
        const int row0 = u.pm * BM + wr * 64 + fr, col0 = u.pn * HALF + wc * 32 + 8 * fq;
#pragma unroll
        for (int ai = 0; ai < 2; ++ai)
#pragma unroll
            for (int m = 0; m < 4; ++m) { bf16_t* rowp = H + (size_t)(row0 + ai * HALF + m * 16) * 256 + col0;
                float h[8];
#pragma unroll
                for (int n = 0; n < 2; ++n)
#pragma unroll
                    for (int j = 0; j < 4; ++j) h[n * 4 + j] = siluf_(acc[ai][0][m][n][j]) * acc[ai][1][m][n][j];
                u32x4 w; w.x = cvt_pk_bf16(h[0], h[1]); w.y = cvt_pk_bf16(h[2], h[3]); w.z = cvt_pk_bf16(h[4], h[5]); w.w = cvt_pk_bf16(h[6], h[7]);
                *(u32x4*)rowp = w; }
    }
};
struct EpiDown {
    static constexpr bool PERM = true;
    bf16_t* Y; const float* sw; const LAS int* cnt;
    __device__ __forceinline__ void operator()(const f32x4 (&acc)[2][2][4][2], const Unit& u, int wr, int wc, int fr, int fq) const {
        const int row0 = u.pm * BM + wr * 64 + fr, col0 = u.pn * BM + wc * 32 + 8 * fq;
        const int ce = (u.e < 64) ? cnt[u.e] : 0;
        const float* swe = sw + (size_t)(u.e < 64 ? u.e : 0) * CAP + u.ti * 256 + wr * 64 + fr;
        bf16_t* yb = Y + (size_t)row0 * DM + col0;
#pragma unroll
        for (int ai = 0; ai < 2; ++ai)
#pragma unroll
            for (int m = 0; m < 4; ++m) { const int rl = ai * HALF + m * 16, pos = u.ti * 256 + wr * 64 + fr + rl;
                float w = 1.0f; if (u.e < 64) w = (pos < ce) ? swe[rl] : 0.0f;
                bf16_t* rowp = yb + (size_t)rl * DM;
#pragma unroll
                for (int bj = 0; bj < 2; ++bj) { const f32x4 v0 = acc[ai][bj][m][0] * w, v1 = acc[ai][bj][m][1] * w;
                    u32x4 ww; ww.x = cvt_pk_bf16(v0[0], v0[1]); ww.y = cvt_pk_bf16(v0[2], v0[3]); ww.z = cvt_pk_bf16(v1[0], v1[1]); ww.w = cvt_pk_bf16(v1[2], v1[3]);
                    *(u32x4*)(rowp + bj * HALF) = ww; }
                asm volatile("" ::: "memory"); }
    }
};
struct MoeOrder {
    const LAS int* cnt; const LAS int* tst; const LAS unsigned char* t2e; int ntiles, npn, G, c;
    __device__ __forceinline__ bool next(int i, Unit& u) const {
        const int L = i * G + c; if (L >= ntiles * npn) return false;
        const int tau = L / npn; u.pm = tau; u.pn = L % npn; u.e = t2e[tau]; u.ti = tau - tst[u.e]; return true;
    }
};
struct MoeGU : MoeOrder {
    static constexpr bool GATHER = true;
    const char* A; const char* Bt; const int* stok;
    __device__ __forceinline__ const char* abase(const Unit&) const { return A; }
    __device__ __forceinline__ const char* bbase(const Unit& u) const { return Bt + ((size_t)u.e * 512 + (size_t)u.pn * 256) * 1024 * 2; }
    __device__ __forceinline__ void aoff(const Unit& u, int tid, unsigned (&off)[2][2]) const {
        const int ce = cnt[u.e];
#pragma unroll
        for (int i = 0; i < 2; ++i) { int R, C; stage_rc(tid * 16 + i * 8192, R, C);
#pragma unroll
            for (int h = 0; h < 2; ++h) { const int pos = u.ti * 256 + h * HALF + R; int tok;
                if (u.e == 64) tok = pos; else tok = (pos < ce) ? stok[(size_t)u.e * CAP + pos] : 0;
                off[h][i] = (unsigned)(tok * 1024 + C) * 2u; } }
    }
};
struct MoeDN : MoeOrder {
    static constexpr bool GATHER = false;
    const char* A; const char* Bt;
    __device__ __forceinline__ const char* abase(const Unit& u) const { return A + (size_t)u.pm * BM * 256 * 2; }
    __device__ __forceinline__ const char* bbase(const Unit& u) const { return Bt + ((size_t)u.e * 1024 + (size_t)u.pn * 256) * 256 * 2; }
};
}

struct Args { const float* in[30]; float* out; unsigned char* ws; int ph_lo, ph_hi; };

struct Frame {
    float* out; unsigned char* ws; LAS unsigned char* lds; int tid, lane, wave, G, wg;
    float* mods; float* X; bf16_t* HB; bf16_t* MIX; unsigned char* WB; unsigned char* R1;
};

__device__ __forceinline__ const float* inp(const Frame& F, int i) {
    const unsigned long long v = ((const LAS unsigned long long*)(F.lds + LDS_MISC + MISC_INP))[i];
    const unsigned lo = (unsigned)__builtin_amdgcn_readfirstlane((int)(unsigned)v), hi = (unsigned)__builtin_amdgcn_readfirstlane((int)(unsigned)(v >> 32));
    return (const float*)(((unsigned long long)hi << 32) | lo);
}
__device__ __forceinline__ Frame fresh(const Frame& F0) { Frame F = F0; int t = F0.tid; asm volatile("" : "+v"(t)); F.tid = t; F.lane = t & 63; return F; }

__device__ __forceinline__ void ph_mods(const Frame& F) {
    const float* c = inp(F, 1); const float* cc = inp(F, 3); const float* ada_w = inp(F, 4); const float* ada_b = inp(F, 5);
    LAS float* sv = (LAS float*)F.lds;
    LAS float* red = (LAS float*)(F.lds + 5 * 1024 * 4);
    for (int i = F.tid; i < 5 * 1024; i += 512) { const int s = i >> 10, k = i & 1023; const float v = (s < 4) ? c[s * 1024 + k] : cc[k]; sv[i] = siluf_(v); }
    __syncthreads();
    for (int task = F.wg; task < 4 * 48; task += F.G) {
        const int l = task / 48, cc0 = (task % 48) * 128;
        const int col = cc0 + (F.tid & 127), kg = F.tid >> 7;
        const float* w = ada_w + (size_t)l * 1024 * 6144 + col;
        float a0 = 0.f, a1 = 0.f, a2 = 0.f, a3 = 0.f, a4 = 0.f;
        for (int k = kg * 256; k < kg * 256 + 256; ++k) { const float wv = w[(size_t)k * 6144]; a0 += sv[k] * wv; a1 += sv[1024 + k] * wv; a2 += sv[2048 + k] * wv; a3 += sv[3072 + k] * wv; a4 += sv[4096 + k] * wv; }
        LAS float* r = red + (kg * 128 + (F.tid & 127)) * 5; r[0] = a0; r[1] = a1; r[2] = a2; r[3] = a3; r[4] = a4;
        __syncthreads();
        if (F.tid < 128) {
            const float b = ada_b[l * 6144 + col];
#pragma unroll
            for (int s = 0; s < 5; ++s) { const float v = ((red[(0 * 128 + F.tid) * 5 + s] + red[(1 * 128 + F.tid) * 5 + s]) + red[(2 * 128 + F.tid) * 5 + s]) + red[(3 * 128 + F.tid) * 5 + s];
                F.mods[(size_t)(l * 5 + s) * 6144 + col] = v + b; }
        }
        __syncthreads();
    }
    if (F.wg == F.G - 1) {
        const float* raw = inp(F, 11); float* lbt = (float*)(F.ws + OFF_LBT);
        for (int i = F.tid; i < 2 * 512; i += 512) { const int d = i >> 9, ch = i & 511; const float r0 = raw[(d * 2 + 0) * 512 + ch], r1 = raw[(d * 2 + 1) * 512 + ch];
            lbt[(0 * 2 + d) * 512 + ch] = 0.f; lbt[(1 * 2 + d) * 512 + ch] = sigmoidf_(r1 - r0); }
    }
}

__device__ __forceinline__ void ph_init_x(const Frame& F) {
    const float* x = inp(F, 0); const float* ctx = inp(F, 2);
    { const float* lg_ = inp(F, 6); const float* lb_ = inp(F, 7); float* AB = (float*)(F.ws + OFF_AB);
      for (int i = F.wg * 512 + F.tid; i < 4 * 5 * 1024; i += F.G * 512) { const int k = i & 1023, ls = i >> 10, l = ls / 5;
          const float* m = F.mods + (size_t)ls * 6144; const float g0 = lg_[(l * 2) * 1024 + k], b0 = lb_[(l * 2) * 1024 + k], m3 = m[3 * 1024 + k], m4 = m[4 * 1024 + k];
          AB[(size_t)ls * 2048 + k] = g0 * (1.0f + m4); AB[(size_t)ls * 2048 + 1024 + k] = b0 * (1.0f + m4) + m3; } }
    const int gw = F.wg * 8 + F.wave, nw = F.G * 8;
    for (int row = gw; row < TT; row += nw) {
        const float* src = row < TC ? ctx + (size_t)row * DM : x + (size_t)(row - TC) * DM;
        const float* m = F.mods + (size_t)(0 * 5 + slot_of_row(row)) * 6144;
#pragma unroll
        for (int hh = 0; hh < 2; ++hh) { const int k = hh * 512 + F.lane * 8;
            const f32x4 v0 = *(const f32x4*)(src + k), v1 = *(const f32x4*)(src + k + 4);
            *(f32x4*)(F.X + (size_t)row * DM + k) = v0; *(f32x4*)(F.X + (size_t)row * DM + k + 4) = v1;
            const f32x4 s0 = *(const f32x4*)(m + 1024 + k), s1 = *(const f32x4*)(m + 1024 + k + 4), b0 = *(const f32x4*)(m + k), b1 = *(const f32x4*)(m + k + 4);
            const f32x4 h0 = v0 * (s0 + 1.0f) + b0, h1 = v1 * (s1 + 1.0f) + b1;
            u32x4 w; w.x = cvt_pk_bf16(h0[0], h0[1]); w.y = cvt_pk_bf16(h0[2], h0[3]); w.z = cvt_pk_bf16(h1[0], h1[1]); w.w = cvt_pk_bf16(h1[2], h1[3]);
            *(u32x4*)(F.HB + (size_t)row * DM + k) = w; }
    }
}

__device__ __forceinline__ void cvt_tile(const Frame& F, const float* src, int sld, int k0, int n0, bf16_t* dst, int dld, int drow0, float scale) {
    LAS float* t = (LAS float*)F.lds;
    { const int i = F.tid >> 3, j0 = (F.tid & 7) * 8; const float* p = src + (size_t)(k0 + i) * sld + n0 + j0;
      const f32x4 a = *(const f32x4*)p, b = *(const f32x4*)(p + 4);
      LAS float* q = t + i * 65 + j0; q[0] = a[0]; q[1] = a[1]; q[2] = a[2]; q[3] = a[3]; q[4] = b[0]; q[5] = b[1]; q[6] = b[2]; q[7] = b[3]; }
    __syncthreads();
    { const int j = F.tid >> 3, i0 = (F.tid & 7) * 8; float v[8];
#pragma unroll
      for (int q = 0; q < 8; ++q) v[q] = t[(i0 + q) * 65 + j] * scale;
      u32x4 w; w.x = cvt_pk_bf16(v[0], v[1]); w.y = cvt_pk_bf16(v[2], v[3]); w.z = cvt_pk_bf16(v[4], v[5]); w.w = cvt_pk_bf16(v[6], v[7]);
      *(u32x4*)(dst + (size_t)(drow0 + j) * dld + k0 + i0) = w; }
    __syncthreads();
}
__device__ __forceinline__ void ph_convert(const Frame& F, int l) {
    const int j = l >> 1; const bool even = (l & 1) == 0;
    bf16_t* wIN = (bf16_t*)(F.WB + WB_IN); bf16_t* wOUT = (bf16_t*)(F.WB + WB_OUT); bf16_t* wRT = (bf16_t*)(F.WB + WB_RT);
    bf16_t* wGU = (bf16_t*)(F.WB + WB_GU); bf16_t* wDN = (bf16_t*)(F.WB + WB_DN); bf16_t* wLRU = (bf16_t*)(F.WB + WB_LRU);
    const int nIN = even ? 4096 : 2048;
    const int t_in = (nIN / 64) * 16, t_out = 256, t_rt = 16, t_gu = 65 * 2 * 64, t_dn = 65 * 64, t_lru = even ? 0 : 64;
    const int total = t_in + t_out + t_rt + t_gu + t_dn + t_lru;
    for (int task = F.wg; task < total; task += F.G) {
        int t = task;
        if (t < t_in) { const int nb = t >> 4, kb = t & 15; const float* src = even ? inp(F, 8) + (size_t)j * 1024 * 4096 : inp(F, 13) + (size_t)j * 1024 * 2048;
            cvt_tile(F, src, nIN, kb * 64, nb * 64, wIN, 1024, nb * 64, (even && nb < 8) ? 0.125f : 1.0f); continue; }
        t -= t_in;
        if (t < t_out) { const int nb = t >> 4, kb = t & 15; const float* src = even ? inp(F, 9) + (size_t)j * 1024 * 1024 : inp(F, 21) + (size_t)j * 1024 * 1024;
            cvt_tile(F, src, 1024, kb * 64, nb * 64, wOUT, 1024, nb * 64, 1.0f); continue; }
        t -= t_out;
        if (t < t_rt) { cvt_tile(F, inp(F, 22) + (size_t)l * 1024 * 64, 64, t * 64, 0, wRT, 1024, 0, 1.0f); continue; }
        t -= t_rt;
        if (t < t_gu) { const int e = t / 128, r = t % 128, which = r >> 6, q = r & 63, nb = q >> 4, kb = q & 15;
            const float* src = (e < 64) ? (which ? inp(F, 25) : inp(F, 24)) + ((size_t)l * 64 + e) * 1024 * 256 : (which ? inp(F, 28) : inp(F, 27)) + (size_t)l * 1024 * 256;
            const int n0 = nb * 64, drow0 = (n0 >> 7) * 256 + which * 128 + (n0 & 127);
            cvt_tile(F, src, 256, kb * 64, n0, wGU + (size_t)e * 512 * 1024, 1024, drow0, 1.0f); continue; }
        t -= t_gu;
        if (t < t_dn) { const int e = t >> 6, q = t & 63, nb = q >> 2, kb = q & 3;
            const float* src = (e < 64) ? inp(F, 26) + ((size_t)l * 64 + e) * 256 * 1024 : inp(F, 29) + (size_t)l * 256 * 1024;
            cvt_tile(F, src, 1024, kb * 64, nb * 64, wDN + (size_t)e * 1024 * 256, 256, nb * 64, 1.0f); continue; }
        t -= t_dn;
        { const int d = t >> 5, gt = (t >> 4) & 1, kb = t & 15;
          const float* src = (gt ? inp(F, 18) : inp(F, 16)) + (((size_t)j * 2 + d) * 16 + kb) * 4096;
          cvt_tile(F, src, 64, 0, 0, wLRU + (((size_t)d * 2 + gt) * 16 + kb) * 4096, 64, 0, 1.0f); }
    }
}

__device__ __forceinline__ void ph_attn(const Frame& F, int j) {
    const bf16_t* P = (const bf16_t*)(F.R1 + R1_P);
    LAS bf16_t* Ks = (LAS bf16_t*)F.lds;
    LAS bf16_t* Vt = (LAS bf16_t*)(F.lds + 9216);
    LAS float* rp_l = (LAS float*)(F.lds + 18432);
    const float* rpb = inp(F, 10) + (size_t)j * 8 * 465;
    const int g = F.lane >> 4, l15 = F.lane & 15;
    const int NLAT = NBAT * 8 * 64, NTASK = NLAT + NBAT * 8 * 2;
    for (int task = F.wg; task < NTASK; task += F.G) {
        const bool lat = task < NLAT;
        int b, h, rp = 0, half = 0;
        if (lat) { b = task >> 9; h = (task >> 6) & 7; rp = task & 63; } else { const int t2 = task - NLAT; b = t2 >> 4; h = (t2 >> 1) & 7; half = t2 & 1; }
        const int myr = 2 * rp + (F.wave >> 2), w0 = (F.wave & 3) * 16;
        const int r0 = min(max(myr - 4, 0), 120);
        const int rlo = min(max(2 * rp - 4, 0), 120), rhi = min(max(2 * rp + 1 - 4, 0), 120) + 7;
        const int nloc = lat ? (rhi - rlo + 1) : 0;
        const int qrow = lat ? (TC + b * SEQ + myr * 64 + w0 + l15) : (b * CTXL + half * 128 + F.wave * 16 + l15);
        bf16x8 qf[2];
        qf[0] = *(const bf16x8*)(P + (size_t)qrow * 4096 + h * 64 + g * 8);
        qf[1] = *(const bf16x8*)(P + (size_t)qrow * 4096 + h * 64 + 32 + g * 8);
        if (lat) for (int i = F.tid; i < 465; i += 512) rp_l[i] = rpb[h * 465 + i];
        f32x4 oacc[4];
#pragma unroll
        for (int dt = 0; dt < 4; ++dt) oacc[dt] = (f32x4){0.f, 0.f, 0.f, 0.f};
        float mrun = -1e30f, lrun = 0.f;
        const int wq = w0 + l15, c0 = min(max(wq - 8, 0), 48);
        for (int ch = 0; ch < nloc + 4; ++ch) {
            const bool loc = ch < nloc; const int kr = rlo + ch;
            { const int key = F.tid >> 3, ds = (F.tid & 7) * 8;
              const int krow = loc ? (TC + b * SEQ + kr * 64 + key) : (b * CTXL + (ch - nloc) * 64 + key);
              const u32x4 kv = *(const u32x4*)(P + (size_t)krow * 4096 + 512 + h * 64 + ds);
              const u32x4 vv = *(const u32x4*)(P + (size_t)krow * 4096 + 1024 + h * 64 + ds);
              __syncthreads();
              *(LAS u32x4*)(Ks + key * 72 + ds) = kv;
              Vt[(ds + 0) * 72 + key] = (bf16_t)(vv.x & 0xffff); Vt[(ds + 1) * 72 + key] = (bf16_t)(vv.x >> 16);
              Vt[(ds + 2) * 72 + key] = (bf16_t)(vv.y & 0xffff); Vt[(ds + 3) * 72 + key] = (bf16_t)(vv.y >> 16);
              Vt[(ds + 4) * 72 + key] = (bf16_t)(vv.z & 0xffff); Vt[(ds + 5) * 72 + key] = (bf16_t)(vv.z >> 16);
              Vt[(ds + 6) * 72 + key] = (bf16_t)(vv.w & 0xffff); Vt[(ds + 7) * 72 + key] = (bf16_t)(vv.w >> 16);
              __syncthreads(); }
            const bool mine = loc ? (kr >= r0 && kr < r0 + 8) : true;
            if (mine) {
                f32x4 s[4];
#pragma unroll
                for (int kb = 0; kb < 4; ++kb) { s[kb] = (f32x4){0.f, 0.f, 0.f, 0.f};
#pragma unroll
                    for (int ks = 0; ks < 2; ++ks) { const bf16x8 a = *(const LAS bf16x8*)(Ks + (kb * 16 + l15) * 72 + ks * 32 + g * 8);
                        s[kb] = __builtin_amdgcn_mfma_f32_16x16x32_bf16(a, qf[ks], s[kb], 0, 0, 0); } }
                if (loc) {
#pragma unroll
                    for (int kb = 0; kb < 4; ++kb)
#pragma unroll
                        for (int i = 0; i < 4; ++i) { const int kc = kb * 16 + 4 * g + i; const bool valid = (kc >= c0) && (kc < c0 + 16);
                            const int bi = (kr - myr + 7) * 31 + min(max(kc - wq + 15, 0), 30);
                            s[kb][i] = valid ? s[kb][i] + rp_l[bi] : -1e30f; }
                }
                float cm = -1e30f;
#pragma unroll
                for (int kb = 0; kb < 4; ++kb)
#pragma unroll
                    for (int i = 0; i < 4; ++i) cm = fmaxf(cm, s[kb][i]);
                cm = fmaxf(cm, __shfl_xor(cm, 16)); cm = fmaxf(cm, __shfl_xor(cm, 32));
                const float mn = fmaxf(mrun, cm), sc = __expf(mrun - mn);
                mrun = mn; lrun *= sc;
#pragma unroll
                for (int dt = 0; dt < 4; ++dt) oacc[dt] *= sc;
                float p[4][4];
#pragma unroll
                for (int kb = 0; kb < 4; ++kb)
#pragma unroll
                    for (int i = 0; i < 4; ++i) { p[kb][i] = __expf(s[kb][i] - mn); lrun += p[kb][i]; }
#pragma unroll
                for (int kp = 0; kp < 2; ++kp) {
                    u32x4 pw; pw.x = cvt_pk_bf16(p[2 * kp][0], p[2 * kp][1]); pw.y = cvt_pk_bf16(p[2 * kp][2], p[2 * kp][3]);
                    pw.z = cvt_pk_bf16(p[2 * kp + 1][0], p[2 * kp + 1][1]); pw.w = cvt_pk_bf16(p[2 * kp + 1][2], p[2 * kp + 1][3]);
                    bf16x8 pf; __builtin_memcpy(&pf, &pw, 16);
#pragma unroll
                    for (int dt = 0; dt < 4; ++dt) {
                        const u32x2 v0 = *(const LAS u32x2*)(Vt + (dt * 16 + l15) * 72 + (2 * kp) * 16 + 4 * g);
                        const u32x2 v1 = *(const LAS u32x2*)(Vt + (dt * 16 + l15) * 72 + (2 * kp + 1) * 16 + 4 * g);
                        u32x4 vw; vw.x = v0.x; vw.y = v0.y; vw.z = v1.x; vw.w = v1.y; bf16x8 vf; __builtin_memcpy(&vf, &vw, 16);
                        oacc[dt] = __builtin_amdgcn_mfma_f32_16x16x32_bf16(vf, pf, oacc[dt], 0, 0, 0);
                    }
                }
            }
        }
        float lt = lrun; lt += __shfl_xor(lt, 16); lt += __shfl_xor(lt, 32);
        const float inv = 1.0f / lt;
#pragma unroll
        for (int dt = 0; dt < 4; ++dt) { const f32x4 o = oacc[dt] * inv; u32x2 w; w.x = cvt_pk_bf16(o[0], o[1]); w.y = cvt_pk_bf16(o[2], o[3]);
            *(u32x2*)(F.MIX + (size_t)qrow * DM + h * 64 + dt * 16 + 4 * g) = w; }
        __syncthreads();
    }
}

__device__ __forceinline__ int hg_unit(int nb, int dir) { return dir == 0 ? nb : (nb < 2 ? 1 - nb : 2 + (HG_NU - 3 - (nb - 2))); }
__device__ __forceinline__ int hg_row(int b, int nb, int t) { return nb < 2 ? b * CTXL + nb * HG_U + t : TC + b * SEQ + (nb - 2) * HG_U + t; }
template <int CTRL> __device__ __forceinline__ float dpp_add0(float x) { return x + dppf<CTRL>(0.0f, x); }
template <bool WITHO>
__device__ __forceinline__ void hg_pass(const Frame& F, const bf16_t* P, const float* lbh, int b, int h, int nb, int dir, f32x4 (&S)[4][4], float (&Gsum)[16],
                                        LAS bf16_t* Vl, LAS bf16_t* Kl, float* OF, const float (&ngv)[4]) {
    const int tau = F.lane & 15, g = F.lane >> 4;
    const unsigned vaddr = (unsigned)(size_t)Vl + (unsigned)((4 * g + (tau >> 2)) * 128 + (tau & 3) * 8);
    const unsigned kaddr = (unsigned)(size_t)Kl + (unsigned)((4 * g + (tau >> 2)) * 128 + (tau & 3) * 8);
    for (int ci = 0; ci < HG_U / 16; ++ci) {
        const int pos = ci * 16 + tau, t = dir ? (HG_U - 1 - pos) : pos, row = hg_row(b, nb, t);
        const bf16_t* pr = P + (size_t)row * 4096 + h * 64 + 4 * g;
        u32x2 zr[4], vr[4], qr[4];
#pragma unroll
        for (int m = 0; m < 4; ++m) { zr[m] = *(const u32x2*)(pr + (dir ? 2560 : 2048) + 16 * m); vr[m] = *(const u32x2*)(pr + 3072 + 16 * m); if (WITHO) qr[m] = *(const u32x2*)(pr + 1536 + 16 * m); }
        float kk[16], c[16];
#pragma unroll
        for (int m = 0; m < 4; ++m) { const float z0 = __uint_as_float(zr[m].x << 16), z1 = __uint_as_float(zr[m].x & 0xffff0000u), z2 = __uint_as_float(zr[m].y << 16), z3 = __uint_as_float(zr[m].y & 0xffff0000u);
            const float zz[4] = {z0, z1, z2, z3};
            const f32x4 lb4 = *(const f32x4*)(lbh + 16 * m + 4 * g);
#pragma unroll
            for (int i = 0; i < 4; ++i) { const float lb = lb4[i]; const float f = fmaxf(lb + (1.0f - lb) * sigmoidf_(zz[i]), 1e-30f); kk[m * 4 + i] = 1.0f - f; c[m * 4 + i] = __logf(f); } }
#pragma unroll
        for (int q = 0; q < 16; ++q) { c[q] = dpp_add0<0x111>(c[q]); c[q] = dpp_add0<0x112>(c[q]); c[q] = dpp_add0<0x114>(c[q]); c[q] = dpp_add0<0x118>(c[q]); }
        float G[16];
#pragma unroll
        for (int q = 0; q < 16; ++q) { G[q] = __shfl(c[q], (F.lane & 48) | 15); Gsum[q] += G[q]; }
#pragma unroll
        for (int m = 0; m < 4; ++m) { float kh[4];
#pragma unroll
            for (int i = 0; i < 4; ++i) kh[i] = kk[m * 4 + i] * __expf(G[m * 4 + i] - c[m * 4 + i]);
            u32x2 w; w.x = cvt_pk_bf16(kh[0], kh[1]); w.y = cvt_pk_bf16(kh[2], kh[3]);
            *(LAS u32x2*)(Kl + tau * 64 + 16 * m + 4 * g) = w; *(LAS u32x2*)(Vl + tau * 64 + 16 * m + 4 * g) = vr[m]; }
        float ofv[4][4], gtv[4][4]; int orow[4];
        if (WITHO) {
#pragma unroll
            for (int i = 0; i < 4; ++i) { const int p2 = ci * 16 + 4 * g + i, t2 = dir ? (HG_U - 1 - p2) : p2; orow[i] = hg_row(b, nb, t2); }
            if (dir) {
#pragma unroll
                for (int i = 0; i < 4; ++i)
#pragma unroll
                    for (int vt = 0; vt < 4; ++vt) { ofv[i][vt] = OF[(size_t)orow[i] * 512 + h * 64 + 16 * vt + tau]; gtv[i][vt] = bf2f(P[(size_t)orow[i] * 4096 + 3584 + h * 64 + 16 * vt + tau]); }
            }
        }
        asm volatile("s_waitcnt lgkmcnt(0)" ::: "memory");
        u32x2 vtr[4], ktr[4];
        asm volatile("ds_read_b64_tr_b16 %0, %8\n\tds_read_b64_tr_b16 %1, %8 offset:32\n\tds_read_b64_tr_b16 %2, %8 offset:64\n\tds_read_b64_tr_b16 %3, %8 offset:96\n\t"
                     "ds_read_b64_tr_b16 %4, %9\n\tds_read_b64_tr_b16 %5, %9 offset:32\n\tds_read_b64_tr_b16 %6, %9 offset:64\n\tds_read_b64_tr_b16 %7, %9 offset:96\n\ts_waitcnt lgkmcnt(0)"
                     : "=&v"(vtr[0]), "=&v"(vtr[1]), "=&v"(vtr[2]), "=&v"(vtr[3]), "=&v"(ktr[0]), "=&v"(ktr[1]), "=&v"(ktr[2]), "=&v"(ktr[3]) : "v"(vaddr), "v"(kaddr) : "memory");
        bf16x8 Vf[4], Kf[4];
#pragma unroll
        for (int q = 0; q < 4; ++q) { u32x4 w; w.x = vtr[q].x; w.y = vtr[q].y; w.z = 0u; w.w = 0u; __builtin_memcpy(&Vf[q], &w, 16); u32x4 w2; w2.x = ktr[q].x; w2.y = ktr[q].y; w2.z = 0u; w2.w = 0u; __builtin_memcpy(&Kf[q], &w2, 16); }
        if (WITHO) {
            float r[16];
#pragma unroll
            for (int q = 0; q < 16; ++q) r[q] = __shfl(c[q], (F.lane & 48) | 7);
            bf16x8 Ktf[2], Qtf[2], Qhf[2];
#pragma unroll
            for (int ks = 0; ks < 2; ++ks) { float kt_[8], qt_[8], qh_[8];
#pragma unroll
                for (int mm = 0; mm < 2; ++mm) { const int m = 2 * ks + mm;
                    const float q0 = __uint_as_float(qr[m].x << 16), q1 = __uint_as_float(qr[m].x & 0xffff0000u), q2 = __uint_as_float(qr[m].y << 16), q3 = __uint_as_float(qr[m].y & 0xffff0000u);
                    const float qq[4] = {q0, q1, q2, q3};
#pragma unroll
                    for (int i = 0; i < 4; ++i) { const int q = m * 4 + i; const float qv = siluf_(qq[i]) * 0.125f; const float d = fminf(fmaxf(c[q] - r[q], -80.0f), 80.0f);
                        qt_[mm * 4 + i] = qv * __expf(d); kt_[mm * 4 + i] = kk[q] * __expf(-d); qh_[mm * 4 + i] = qv * __expf(c[q]); } }
                u32x4 w; w.x = cvt_pk_bf16(kt_[0], kt_[1]); w.y = cvt_pk_bf16(kt_[2], kt_[3]); w.z = cvt_pk_bf16(kt_[4], kt_[5]); w.w = cvt_pk_bf16(kt_[6], kt_[7]); __builtin_memcpy(&Ktf[ks], &w, 16);
                w.x = cvt_pk_bf16(qt_[0], qt_[1]); w.y = cvt_pk_bf16(qt_[2], qt_[3]); w.z = cvt_pk_bf16(qt_[4], qt_[5]); w.w = cvt_pk_bf16(qt_[6], qt_[7]); __builtin_memcpy(&Qtf[ks], &w, 16);
                w.x = cvt_pk_bf16(qh_[0], qh_[1]); w.y = cvt_pk_bf16(qh_[2], qh_[3]); w.z = cvt_pk_bf16(qh_[4], qh_[5]); w.w = cvt_pk_bf16(qh_[6], qh_[7]); __builtin_memcpy(&Qhf[ks], &w, 16); }
            f32x4 AT = (f32x4){0.f, 0.f, 0.f, 0.f};
            AT = __builtin_amdgcn_mfma_f32_16x16x32_bf16(Ktf[0], Qtf[0], AT, 0, 0, 0); AT = __builtin_amdgcn_mfma_f32_16x16x32_bf16(Ktf[1], Qtf[1], AT, 0, 0, 0);
#pragma unroll
            for (int i = 0; i < 4; ++i) AT[i] = (4 * g + i <= tau) ? AT[i] : 0.0f;
            bf16x8 Af; { u32x4 w; w.x = cvt_pk_bf16(AT[0], AT[1]); w.y = cvt_pk_bf16(AT[2], AT[3]); w.z = 0u; w.w = 0u; __builtin_memcpy(&Af, &w, 16); }
            f32x4 o[4];
#pragma unroll
            for (int vt = 0; vt < 4; ++vt) { o[vt] = __builtin_amdgcn_mfma_f32_16x16x32_bf16(Af, Vf[vt], (f32x4){0.f, 0.f, 0.f, 0.f}, 0, 0, 0);
#pragma unroll
                for (int ks = 0; ks < 2; ++ks) { u32x4 w; w.x = cvt_pk_bf16(S[2 * ks][vt][0], S[2 * ks][vt][1]); w.y = cvt_pk_bf16(S[2 * ks][vt][2], S[2 * ks][vt][3]);
                    w.z = cvt_pk_bf16(S[2 * ks + 1][vt][0], S[2 * ks + 1][vt][1]); w.w = cvt_pk_bf16(S[2 * ks + 1][vt][2], S[2 * ks + 1][vt][3]); bf16x8 Sf; __builtin_memcpy(&Sf, &w, 16);
                    o[vt] = __builtin_amdgcn_mfma_f32_16x16x32_bf16(Qhf[ks], Sf, o[vt], 0, 0, 0); } }
            if (dir == 0) {
#pragma unroll
                for (int i = 0; i < 4; ++i)
#pragma unroll
                    for (int vt = 0; vt < 4; ++vt) OF[(size_t)orow[i] * 512 + h * 64 + 16 * vt + tau] = o[vt][i];
            } else {
#pragma unroll
                for (int i = 0; i < 4; ++i) { float tot[4]; float sq = 0.f;
#pragma unroll
                    for (int vt = 0; vt < 4; ++vt) { tot[vt] = o[vt][i] + ofv[i][vt]; sq = fmaf(tot[vt], tot[vt], sq); }
                    sq += dppf<0xB1>(sq, sq); sq += dppf<0x4E>(sq, sq); sq += dppf<0x141>(sq, sq); sq += dppf<0x140>(sq, sq);
                    const float rs = rsqrtf(sq * (1.0f / 64.0f) + 1e-6f);
#pragma unroll
                    for (int vt = 0; vt < 4; ++vt) F.MIX[(size_t)orow[i] * DM + 512 + h * 64 + 16 * vt + tau] = f2bf(tot[vt] * rs * ngv[vt] * siluf_(gtv[i][vt])); }
            }
        }
#pragma unroll
        for (int kt = 0; kt < 4; ++kt) { f32x4 eg;
#pragma unroll
            for (int i = 0; i < 4; ++i) eg[i] = __expf(G[kt * 4 + i]);
#pragma unroll
            for (int vt = 0; vt < 4; ++vt) S[kt][vt] = __builtin_amdgcn_mfma_f32_16x16x32_bf16(Kf[kt], Vf[vt], S[kt][vt] * eg, 0, 0, 0); }
    }
}
__device__ __forceinline__ void ph_hg_a(const Frame& F, int j) {
    const bf16_t* P = (const bf16_t*)(F.R1 + R1_P);
    float* SLOC = (float*)(F.R1 + R1_SLOC); float* DL = (float*)(F.R1 + R1_DL);
    LAS bf16_t* Vl = (LAS bf16_t*)(F.lds + 32768 + F.wave * 4096); LAS bf16_t* Kl = Vl + 1024;
    const int gw = F.wg * 8 + F.wave, nw = F.G * 8;
    const int NT = NBAT * 8 * HG_NU * 2;
    const float ngv[4] = {0.f, 0.f, 0.f, 0.f};
    for (int task = gw; task < NT; task += nw) {
        const int dir = task & 1, nb = (task >> 1) % HG_NU, bh = (task >> 1) / HG_NU, b = bh >> 3, h = bh & 7;
        const float* lbh = (const float*)(F.ws + OFF_LBT) + (j * 2 + dir) * 512 + h * 64;
        f32x4 S[4][4];
#pragma unroll
        for (int kt = 0; kt < 4; ++kt)
#pragma unroll
            for (int vt = 0; vt < 4; ++vt) S[kt][vt] = (f32x4){0.f, 0.f, 0.f, 0.f};
        float Gsum[16];
#pragma unroll
        for (int q = 0; q < 16; ++q) Gsum[q] = 0.f;
        hg_pass<false>(F, P, lbh, b, h, nb, dir, S, Gsum, Vl, Kl, nullptr, ngv);
        const int seq = bh * 2 + dir, u = hg_unit(nb, dir);
        float* so = SLOC + ((size_t)seq * HG_NU + u) * 4096;
#pragma unroll
        for (int kt = 0; kt < 4; ++kt)
#pragma unroll
            for (int vt = 0; vt < 4; ++vt)
#pragma unroll
                for (int i = 0; i < 4; ++i) so[((kt * 4 + vt) * 4 + i) * 64 + F.lane] = S[kt][vt][i];
        if ((F.lane & 15) == 0) { float* dd = DL + ((size_t)seq * HG_NU + u) * 64;
#pragma unroll
            for (int m = 0; m < 4; ++m)
#pragma unroll
                for (int i = 0; i < 4; ++i) dd[16 * m + 4 * (F.lane >> 4) + i] = __expf(Gsum[m * 4 + i]); }
    }
}
__device__ __forceinline__ void ph_hg_b(const Frame& F) {
    const float* SLOC = (const float*)(F.R1 + R1_SLOC); const float* DL = (const float*)(F.R1 + R1_DL); float* SST = (float*)(F.R1 + R1_SST);
    for (int idx = F.wg * 512 + F.tid; idx < 64 * 4096; idx += F.G * 512) {
        const int seq = idx >> 12, e = idx & 4095, ln = e & 63, reg = e >> 6, i = reg & 3, kt = reg >> 4, k = 16 * kt + 4 * (ln >> 4) + i;
        float s = 0.f;
#pragma unroll 6
        for (int u = 0; u < HG_NU; ++u) { const size_t o = ((size_t)seq * HG_NU + u) * 4096 + e; SST[o] = s; s = DL[((size_t)seq * HG_NU + u) * 64 + k] * s + SLOC[o]; }
    }
}
__device__ __forceinline__ void ph_hg_c(const Frame& F, int j) {
    const bf16_t* P = (const bf16_t*)(F.R1 + R1_P);
    const float* SST = (const float*)(F.R1 + R1_SST); float* OF = (float*)(F.R1 + R1_OF);
    const float* ng = inp(F, 12) + j * 64;
    LAS bf16_t* Vl = (LAS bf16_t*)(F.lds + 32768 + F.wave * 4096); LAS bf16_t* Kl = Vl + 1024;
    const int gw = F.wg * 8 + F.wave, nw = F.G * 8;
    const int NT = NBAT * 8 * HG_NU;
    float ngv[4];
#pragma unroll
    for (int vt = 0; vt < 4; ++vt) ngv[vt] = ng[16 * vt + (F.lane & 15)];
    for (int task = gw; task < NT; task += nw) {
        const int nb = task % HG_NU, bh = task / HG_NU, b = bh >> 3, h = bh & 7;
        for (int dir = 0; dir < 2; ++dir) {
            const float* lbh = (const float*)(F.ws + OFF_LBT) + (j * 2 + dir) * 512 + h * 64;
            const int seq = bh * 2 + dir, u = hg_unit(nb, dir);
            const float* ss = SST + ((size_t)seq * HG_NU + u) * 4096;
            f32x4 S[4][4];
#pragma unroll
            for (int kt = 0; kt < 4; ++kt)
#pragma unroll
                for (int vt = 0; vt < 4; ++vt)
#pragma unroll
                    for (int i = 0; i < 4; ++i) S[kt][vt][i] = ss[((kt * 4 + vt) * 4 + i) * 64 + F.lane];
            float Gsum[16];
#pragma unroll
            for (int q = 0; q < 16; ++q) Gsum[q] = 0.f;
            hg_pass<true>(F, P, lbh, b, h, nb, dir, S, Gsum, Vl, Kl, OF, ngv);
        }
    }
}

__device__ __forceinline__ int lru_nat(int so, int dir) { return dir == 0 ? so : (so < 16 ? 15 - so : 16 + (LRU_NT - 1 - so)); }
__device__ __forceinline__ int lru_row(int b, int nt, int t) { return nt < 16 ? b * CTXL + nt * 16 + t : TC + b * SEQ + (nt - 16) * 16 + t; }
__device__ __forceinline__ void lru_gates(const Frame& F, int b, int kb, int nt, LAS bf16_t* Wl, const LAS float* CT, LAS float* ucb, float (&av)[2][4][4], float (&xv)[2][4][4]) {
    const bf16_t* P = (const bf16_t*)(F.R1 + R1_P);
    const int tk = F.lane & 15, g = F.lane >> 4;
    { const int len = nt < 16 ? CTXL : SEQ, tpos = (nt < 16 ? nt * 16 : (nt - 16) * 16) + tk;
      float acc[16];
#pragma unroll
      for (int q = 0; q < 4; ++q) { const f32x4 c4 = *(const LAS f32x4*)(CT + 4 * 64 + g * 16 + q * 4); acc[q * 4] = c4[0]; acc[q * 4 + 1] = c4[1]; acc[q * 4 + 2] = c4[2]; acc[q * 4 + 3] = c4[3]; }
      const bf16_t* pbase = P + (size_t)((nt < 16 ? b * CTXL : TC + b * SEQ)) * 2048 + 1024 + kb * 64 + g * 16;
      u32x4 ra_[4], rb_[4];
#pragma unroll
      for (int tap = 0; tap < 4; ++tap) { const int tp = tpos + tap - 2; const bool ok = (tp >= 0 && tp < len); const bf16_t* pr = pbase + (size_t)(ok ? tp : tpos) * 2048;
          ra_[tap] = *(const u32x4*)pr; rb_[tap] = *(const u32x4*)(pr + 8); if (!ok) { ra_[tap] = (u32x4){0u, 0u, 0u, 0u}; rb_[tap] = (u32x4){0u, 0u, 0u, 0u}; } }
#pragma unroll
      for (int tap = 0; tap < 4; ++tap) { float t0[8], t1[8]; unpack8(ra_[tap], t0); unpack8(rb_[tap], t1);
#pragma unroll
          for (int q = 0; q < 2; ++q) { const f32x4 w0 = *(const LAS f32x4*)(CT + tap * 64 + g * 16 + q * 4), w1 = *(const LAS f32x4*)(CT + tap * 64 + g * 16 + 8 + q * 4);
#pragma unroll
              for (int i = 0; i < 4; ++i) { acc[q * 4 + i] = fmaf(w0[i], t0[q * 4 + i], acc[q * 4 + i]); acc[8 + q * 4 + i] = fmaf(w1[i], t1[q * 4 + i], acc[8 + q * 4 + i]); } } }
#pragma unroll
      for (int q = 0; q < 4; ++q) *(LAS f32x4*)(ucb + tk * 64 + g * 16 + q * 4) = (f32x4){acc[q * 4], acc[q * 4 + 1], acc[q * 4 + 2], acc[q * 4 + 3]}; }
    bf16x8 bfr[2];
#pragma unroll
    for (int ks = 0; ks < 2; ++ks) { const f32x4 u0 = *(const LAS f32x4*)(ucb + tk * 64 + ks * 32 + g * 8), u1 = *(const LAS f32x4*)(ucb + tk * 64 + ks * 32 + g * 8 + 4);
        u32x4 w; w.x = cvt_pk_bf16(u0[0], u0[1]); w.y = cvt_pk_bf16(u0[2], u0[3]); w.z = cvt_pk_bf16(u1[0], u1[1]); w.w = cvt_pk_bf16(u1[2], u1[3]); __builtin_memcpy(&bfr[ks], &w, 16); }
#pragma unroll
    for (int d = 0; d < 2; ++d)
#pragma unroll
        for (int et = 0; et < 4; ++et) {
            f32x4 ra = (f32x4){0.f, 0.f, 0.f, 0.f}, ri = (f32x4){0.f, 0.f, 0.f, 0.f};
#pragma unroll
            for (int ks = 0; ks < 2; ++ks) {
                const bf16x8 wa = *(const LAS bf16x8*)(Wl + ((d * 2 + 0) * 64 + et * 16 + tk) * 64 + ks * 32 + g * 8);
                const bf16x8 wx = *(const LAS bf16x8*)(Wl + ((d * 2 + 1) * 64 + et * 16 + tk) * 64 + ks * 32 + g * 8);
                ra = __builtin_amdgcn_mfma_f32_16x16x32_bf16(wa, bfr[ks], ra, 0, 0, 0);
                ri = __builtin_amdgcn_mfma_f32_16x16x32_bf16(wx, bfr[ks], ri, 0, 0, 0);
            }
            const f32x4 ba4 = *(const LAS f32x4*)(CT + (5 + 3 * d) * 64 + et * 16 + 4 * g), bx4 = *(const LAS f32x4*)(CT + (6 + 3 * d) * 64 + et * 16 + 4 * g), cs4 = *(const LAS f32x4*)(CT + (7 + 3 * d) * 64 + et * 16 + 4 * g);
            const f32x4 u4 = *(const LAS f32x4*)(ucb + tk * 64 + et * 16 + 4 * g);
#pragma unroll
            for (int i = 0; i < 4; ++i) {
                const float r = sigmoidf_(ra[i] + ba4[i]), ig = sigmoidf_(ri[i] + bx4[i]);
                const float a = __expf(cs4[i] * r);
                av[d][et][i] = a; xv[d][et][i] = sqrtf(fmaxf(1.0f - a * a, 0.f)) * ig * u4[i]; }
        }
}
template <int S> __device__ __forceinline__ void lru_step_f(float& a, float& x) { const float ap = dppf<0x110 + S>(1.0f, a), xp = dppf<0x110 + S>(0.0f, x); x = fmaf(a, xp, x); a = a * ap; }
template <int S> __device__ __forceinline__ void lru_step_b(float& a, float& x) { const float ap = dppf<0x100 + S>(1.0f, a), xp = dppf<0x100 + S>(0.0f, x); x = fmaf(a, xp, x); a = a * ap; }
template <bool FINAL>
__device__ __forceinline__ void ph_lru_ac(const Frame& F, int jj) {
    LAS bf16_t* Wl = (LAS bf16_t*)F.lds;
    LAS float* ucb = (LAS float*)(F.lds + 32768 + F.wave * 4096);
    LAS float* CT = (LAS float*)(F.lds + 65536);
    const bf16_t* wsrc = (const bf16_t*)(F.WB + WB_LRU);
    float* AG = (float*)(F.R1 + R1_AG); const float* HST = (const float*)(F.R1 + R1_HST);
    const bf16_t* P = (const bf16_t*)(F.R1 + R1_P);
    const float* cw = inp(F, 14) + (size_t)jj * 4 * 1024; const float* cb = inp(F, 15) + (size_t)jj * 1024;
    const float* b_a = inp(F, 17) + (size_t)jj * 2 * 1024; const float* b_x = inp(F, 19) + (size_t)jj * 2 * 1024; const float* lam = inp(F, 20) + (size_t)jj * 2 * 1024;
    const int tk = F.lane & 15, g = F.lane >> 4;
    const int NTASK = NBAT * 16 * 33;
    for (int task = F.wg; task < NTASK; task += F.G) {
        const int grp = task % 33, kb = (task / 33) & 15, b = task / (33 * 16);
        __syncthreads();
        for (int i = F.tid; i < 4 * 4096 / 8; i += 512) { const int mg = i >> 9, r = i & 511;
            *(LAS u32x4*)(Wl + mg * 4096 + r * 8) = *(const u32x4*)(wsrc + ((size_t)mg * 16 + kb) * 4096 + r * 8); }
        for (int i = F.tid; i < 11 * 64; i += 512) { const int kind = i >> 6, ch = kb * 64 + (i & 63); float v;
            if (kind < 4) v = cw[kind * 1024 + ch]; else if (kind == 4) v = cb[ch];
            else { const int d = (kind - 5) / 3, w = (kind - 5) % 3; v = (w == 0) ? b_a[d * 1024 + ch] : (w == 1) ? b_x[d * 1024 + ch] : -8.0f * log1pf(__expf(-lam[d * 1024 + ch])); }
            CT[i] = v; }
        __syncthreads();
        const int nt0 = grp * 16;
        for (int ti = F.wave; ti < 16; ti += 8) {
            const int nt = nt0 + ti;
            float av[2][4][4], xv[2][4][4];
            lru_gates(F, b, kb, nt, Wl, CT, ucb, av, xv);
#pragma unroll
            for (int et = 0; et < 4; ++et)
#pragma unroll
                for (int i = 0; i < 4; ++i) {
                    lru_step_f<1>(av[0][et][i], xv[0][et][i]); lru_step_f<2>(av[0][et][i], xv[0][et][i]); lru_step_f<4>(av[0][et][i], xv[0][et][i]); lru_step_f<8>(av[0][et][i], xv[0][et][i]);
                    lru_step_b<1>(av[1][et][i], xv[1][et][i]); lru_step_b<2>(av[1][et][i], xv[1][et][i]); lru_step_b<4>(av[1][et][i], xv[1][et][i]); lru_step_b<8>(av[1][et][i], xv[1][et][i]);
                }
            if (!FINAL) {
#pragma unroll
                for (int d = 0; d < 2; ++d) if (tk == (d ? 0 : 15)) {
                    float* ag = AG + (((size_t)(b * 2 + d) * LRU_NT + nt) * 2) * 1024 + kb * 64;
#pragma unroll
                    for (int et = 0; et < 4; ++et) { *(f32x4*)(ag + et * 16 + 4 * g) = (f32x4){av[d][et][0], av[d][et][1], av[d][et][2], av[d][et][3]};
                        *(f32x4*)(ag + 1024 + et * 16 + 4 * g) = (f32x4){xv[d][et][0], xv[d][et][1], xv[d][et][2], xv[d][et][3]}; }
                }
            } else {
                const int row = lru_row(b, nt, tk);
                f32x4 hf[4], hb[4]; u32x2 yw[4];
#pragma unroll
                for (int et = 0; et < 4; ++et) { const int ch = kb * 64 + et * 16 + 4 * g;
                    hf[et] = *(const f32x4*)(HST + ((size_t)(b * 2 + 0) * LRU_NT + nt) * 1024 + ch);
                    hb[et] = *(const f32x4*)(HST + ((size_t)(b * 2 + 1) * LRU_NT + nt) * 1024 + ch);
                    yw[et] = *(const u32x2*)(P + (size_t)row * 2048 + ch); }
#pragma unroll
                for (int et = 0; et < 4; ++et) {
                    const int ch = kb * 64 + et * 16 + 4 * g;
                    const float y0 = __uint_as_float(yw[et].x << 16), y1 = __uint_as_float(yw[et].x & 0xffff0000u), y2 = __uint_as_float(yw[et].y << 16), y3 = __uint_as_float(yw[et].y & 0xffff0000u);
                    float o[4];
#pragma unroll
                    for (int i = 0; i < 4; ++i) o[i] = fmaf(av[0][et][i], hf[et][i], xv[0][et][i]) + fmaf(av[1][et][i], hb[et][i], xv[1][et][i]);
                    o[0] *= gelu_tanh_(y0); o[1] *= gelu_tanh_(y1); o[2] *= gelu_tanh_(y2); o[3] *= gelu_tanh_(y3);
                    u32x2 w; w.x = cvt_pk_bf16(o[0], o[1]); w.y = cvt_pk_bf16(o[2], o[3]);
                    *(u32x2*)(F.MIX + (size_t)row * DM + ch) = w;
                }
            }
        }
    }
    __syncthreads();
}
__device__ __forceinline__ void ph_lru_b(const Frame& F) {
    const float* AG = (const float*)(F.R1 + R1_AG); float* HST = (float*)(F.R1 + R1_HST);
    LAS float* sa = (LAS float*)F.lds; LAS float* sx = sa + 512;
    for (int task = F.wg; task < NBAT * 2 * 32; task += F.G) {
        const int cgp = task & 31, d = (task >> 5) & 1, b = task >> 6;
        const int ch = cgp * 32 + (F.tid & 31), seg = F.tid >> 5;
        const float* ag = AG + ((size_t)(b * 2 + d) * LRU_NT) * 2048 + ch;
        float A = 1.0f, Xv = 0.f;
        for (int i = 0; i < 33; ++i) { const int nt = lru_nat(seg * 33 + i, d); const float a = ag[(size_t)nt * 2048], x = ag[(size_t)nt * 2048 + 1024]; Xv = fmaf(a, Xv, x); A *= a; }
        __syncthreads();
        sa[F.tid] = A; sx[F.tid] = Xv;
        __syncthreads();
        float h = 0.f;
        for (int s2 = 0; s2 < seg; ++s2) h = fmaf(sa[s2 * 32 + (F.tid & 31)], h, sx[s2 * 32 + (F.tid & 31)]);
        float* hs = HST + ((size_t)(b * 2 + d) * LRU_NT) * 1024 + ch;
        for (int i = 0; i < 33; ++i) { const int nt = lru_nat(seg * 33 + i, d); hs[(size_t)nt * 1024] = h; const float a = ag[(size_t)nt * 2048], x = ag[(size_t)nt * 2048 + 1024]; h = fmaf(a, h, x); }
    }
    __syncthreads();
}

__device__ __forceinline__ void topk_better(float& bk, int& be, float& bs, float ok, int oe, float os) { const bool t = (ok > bk) || (ok == bk && oe < be); bk = t ? ok : bk; be = t ? oe : be; bs = t ? os : bs; }
template <int CTRL> __device__ __forceinline__ void topk_step(float& bk, int& be, float& bs) {
    const float ok = dppf<CTRL>(bk, bk), os = dppf<CTRL>(bs, bs); const int oe = __builtin_amdgcn_update_dpp(be, be, CTRL, 0xf, 0xf, false); topk_better(bk, be, bs, ok, oe, os); }
__device__ __forceinline__ void ph_ln_router(const Frame& F, int l, bool dry = false) {
    const bf16_t* RW = (const bf16_t*)(F.WB + WB_RT);
    const float* rbias = inp(F, 23) + l * 64;
    LAS float* lg = (LAS float*)(F.lds + F.wave * 4096);
    LAS int* hist = (LAS int*)(F.lds + LDS_MISC + MISC_HIST); LAS int* hbase = (LAS int*)(F.lds + LDS_MISC + MISC_HBASE);
    int* tok_e = (int*)(F.ws + OFF_TOKE); int* tok_p = (int*)(F.ws + OFF_TOKP); float* tok_w = (float*)(F.ws + OFF_TOKW);
    int* stok = (int*)(F.ws + OFF_STOK); float* sw = (float*)(F.ws + OFF_SW);
    float* stats = (float*)(F.ws + OFF_STATS);
    unsigned* gcnt = (unsigned*)(F.ws + OFF_CTL + CTL_CNT) + l * 64;
    const int tk = F.lane & 15, g = F.lane >> 4;
    float rb[4];
#pragma unroll
    for (int q = 0; q < 4; ++q) rb[q] = rbias[tk + 16 * q];
    if (F.tid < 64) hist[F.tid] = 0;
    __syncthreads();
    const int NTILE = TT / 16;
    for (int it = 0;; ++it) {
        const int tile = (it * F.G + F.wg) * 8 + F.wave;
        if ((it * F.G + F.wg) * 8 >= NTILE) break;
        if (tile < NTILE) {
            const int row = tile * 16 + tk; const int s = slot_of_row(tile * 16);
            const float* ab = (const float*)(F.ws + OFF_AB) + (size_t)(l * 5 + s) * 2048;
            const float* xr = F.X + (size_t)row * DM;
            float sum = 0.f, sq = 0.f;
#pragma unroll 8
            for (int ks = 0; ks < 32; ++ks) { const f32x4 a = *(const f32x4*)(xr + ks * 32 + g * 8), c = *(const f32x4*)(xr + ks * 32 + g * 8 + 4);
                sum += (a[0] + a[1]) + (a[2] + a[3]) + (c[0] + c[1]) + (c[2] + c[3]);
                sq += (a[0] * a[0] + a[1] * a[1]) + (a[2] * a[2] + a[3] * a[3]) + (c[0] * c[0] + c[1] * c[1]) + (c[2] * c[2] + c[3] * c[3]); }
            sum += __shfl_xor(sum, 16); sum += __shfl_xor(sum, 32); sq += __shfl_xor(sq, 16); sq += __shfl_xor(sq, 32);
            const float mean = sum * (1.0f / 1024.0f), var = fmaxf(sq * (1.0f / 1024.0f) - mean * mean, 0.f), rstd = rsqrtf(var + 1e-5f);
            if (g == 0) *(f32x2*)(stats + (size_t)row * 2) = (f32x2){mean, rstd};
            f32x4 acc[4];
#pragma unroll
            for (int et = 0; et < 4; ++et) acc[et] = (f32x4){0.f, 0.f, 0.f, 0.f};
#pragma unroll 4
            for (int ks = 0; ks < 32; ++ks) { const int k = ks * 32 + g * 8;
                float v[8], a1[8], b1[8];
                *(f32x4*)&v[0] = *(const f32x4*)(xr + k); *(f32x4*)&v[4] = *(const f32x4*)(xr + k + 4);
                *(f32x4*)&a1[0] = *(const f32x4*)(ab + k); *(f32x4*)&a1[4] = *(const f32x4*)(ab + k + 4);
                *(f32x4*)&b1[0] = *(const f32x4*)(ab + 1024 + k); *(f32x4*)&b1[4] = *(const f32x4*)(ab + 1024 + k + 4);
                float hh[8];
#pragma unroll
                for (int q = 0; q < 8; ++q) hh[q] = (v[q] - mean) * rstd * a1[q] + b1[q];
                u32x4 w; w.x = cvt_pk_bf16(hh[0], hh[1]); w.y = cvt_pk_bf16(hh[2], hh[3]); w.z = cvt_pk_bf16(hh[4], hh[5]); w.w = cvt_pk_bf16(hh[6], hh[7]);
                *(u32x4*)(F.HB + (size_t)row * DM + k) = w;
                bf16x8 af; __builtin_memcpy(&af, &w, 16);
#pragma unroll
                for (int et = 0; et < 4; ++et) { const bf16x8 bf = *(const bf16x8*)(RW + (size_t)(et * 16 + tk) * 1024 + k); acc[et] = __builtin_amdgcn_mfma_f32_16x16x32_bf16(af, bf, acc[et], 0, 0, 0); }
            }
#pragma unroll
            for (int et = 0; et < 4; ++et)
#pragma unroll
                for (int i = 0; i < 4; ++i) lg[(4 * g + i) * 64 + et * 16 + tk] = acc[et][i];
            asm volatile("s_waitcnt lgkmcnt(0)" ::: "memory");
#pragma unroll 1
            for (int p = 0; p < 4; ++p) {
                const int t = p * 4 + g, r2 = tile * 16 + t;
                float sc[4], key[4];
#pragma unroll
                for (int q = 0; q < 4; ++q) { sc[q] = sigmoidf_(lg[t * 64 + tk + 16 * q]); key[q] = sc[q] + rb[q]; }
                unsigned taken = 0u; int se[6]; float ss[6]; float tot = 0.f;
#pragma unroll
                for (int sel = 0; sel < 6; ++sel) {
                    float bk = -1e30f, bs = 0.f; int be = 0;
#pragma unroll
                    for (int q = 0; q < 4; ++q) if (!((taken >> q) & 1u) && key[q] > bk) { bk = key[q]; be = tk + 16 * q; bs = sc[q]; }
                    topk_step<0xB1>(bk, be, bs); topk_step<0x4E>(bk, be, bs); topk_step<0x141>(bk, be, bs); topk_step<0x140>(bk, be, bs);
                    if ((be & 15) == tk) taken |= 1u << (be >> 4);
                    se[sel] = be; ss[sel] = bs; tot += bs;
                }
                const float sc2 = 2.5f / tot;
                if (tk < 6) {
                    int e = se[0]; float w = ss[0];
#pragma unroll
                    for (int q = 1; q < 6; ++q) if (tk == q) { e = se[q]; w = ss[q]; }
                    tok_e[r2 * 8 + tk] = e; tok_w[r2 * 8 + tk] = w * sc2; if (!dry) tok_p[r2 * 8 + tk] = __hip_atomic_fetch_add(hist + e, 1, __ATOMIC_RELAXED, __HIP_MEMORY_SCOPE_WORKGROUP);
                }
            }
        }
    }
    asm volatile("s_waitcnt vmcnt(0) lgkmcnt(0)" ::: "memory");
    __syncthreads();
    if (dry) return;
    if (F.tid < 64) hbase[F.tid] = (int)__hip_atomic_fetch_add(gcnt + F.tid, (unsigned)hist[F.tid], __ATOMIC_RELAXED, __HIP_MEMORY_SCOPE_AGENT);
    __syncthreads();
    for (int it = 0;; ++it) {
        const int r0 = (it * F.G + F.wg) * 128;
        if (r0 >= TT) break;
        for (int i = F.tid; i < 128 * 6; i += 512) { const int row = r0 + i / 6, q = i % 6; const int e = tok_e[row * 8 + q]; const int pos = hbase[e] + tok_p[row * 8 + q];
            tok_p[row * 8 + q] = pos; stok[(size_t)e * CAP + pos] = row; sw[(size_t)e * CAP + pos] = tok_w[row * 8 + q]; }
    }
    __syncthreads();
}

__device__ __forceinline__ int moe_tables(const Frame& F, int l) {
    LAS int* cnt = (LAS int*)(F.lds + LDS_MISC + MISC_CNT); LAS int* tst = (LAS int*)(F.lds + LDS_MISC + MISC_TST); LAS unsigned char* t2e = (LAS unsigned char*)(F.lds + LDS_MISC + MISC_T2E);
    const unsigned* gcnt = (const unsigned*)(F.ws + OFF_CTL + CTL_CNT) + l * 64;
    __syncthreads();
    if (F.tid < 64) cnt[F.tid] = (int)__hip_atomic_load(gcnt + F.tid, __ATOMIC_RELAXED, __HIP_MEMORY_SCOPE_AGENT);
    if (F.tid == 64) cnt[64] = TT;
    __syncthreads();
    if (F.tid == 0) { int s = 0; for (int e = 0; e < 65; ++e) { tst[e] = s; s += (cnt[e] + 255) >> 8; } tst[65] = s; }
    __syncthreads();
    const int ntiles = tst[65];
    for (int t = F.tid; t < ntiles; t += 512) { int e = 0; for (int q = 0; q < 65; ++q) if (t >= tst[q]) e = q; else break; t2e[t] = (unsigned char)e; }
    __syncthreads();
    return ntiles;
}

__device__ __forceinline__ void ph_combine(const Frame& F, int l, bool dry = false) {
    LAS int* tst = (LAS int*)(F.lds + LDS_MISC + MISC_TST);
    (void)moe_tables(F, l);
    const float* gam = inp(F, 6) + (size_t)(l * 2 + 1) * DM; const float* bet = inp(F, 7) + (size_t)(l * 2 + 1) * DM;
    const float* gam0 = inp(F, 6) + (size_t)(l * 2 + 0) * DM; const float* bet0 = inp(F, 7) + (size_t)(l * 2 + 0) * DM;
    const float* stats = (const float*)(F.ws + OFF_STATS);
    const bf16_t* Y = (const bf16_t*)(F.R1 + R1_Y);
    const int* tok_e = (const int*)(F.ws + OFF_TOKE); const int* tok_p = (const int*)(F.ws + OFF_TOKP);
    const int gw = F.wg * 8 + F.wave, nw = F.G * 8;
    const bool lastl = (l == 3);
    for (int row = gw; row < TT; row += nw) {
        const int s = slot_of_row(row);
        const float* m = F.mods + (size_t)(l * 5 + s) * 6144;
        const float* mn = F.mods + (size_t)((lastl ? l : l + 1) * 5 + s) * 6144;
        int srow[7];
#pragma unroll
        for (int q = 0; q < 6; ++q) { const int e = tok_e[row * 8 + q]; srow[q] = tst[e] * 256 + tok_p[row * 8 + q]; }
        srow[6] = tst[64] * 256 + row;
        float v[16];
#pragma unroll
        for (int hh = 0; hh < 2; ++hh) { const int k = hh * 512 + F.lane * 8;
            float y[8];
#pragma unroll
            for (int q = 0; q < 8; ++q) y[q] = 0.f;
#pragma unroll
            for (int q = 0; q < 7; ++q) { const u32x4 w = *(const u32x4*)(Y + (size_t)srow[q] * DM + k); float t[8]; unpack8(w, t);
#pragma unroll
                for (int i = 0; i < 8; ++i) y[i] += t[i]; }
            f32x4 x0 = *(const f32x4*)(F.X + (size_t)row * DM + k), x1 = *(const f32x4*)(F.X + (size_t)row * DM + k + 4);
            { const f32x2 st = *(const f32x2*)(stats + (size_t)row * 2); const f32x4 g0 = *(const f32x4*)(gam0 + k), g1 = *(const f32x4*)(gam0 + k + 4), b0 = *(const f32x4*)(bet0 + k), b1 = *(const f32x4*)(bet0 + k + 4);
              x0 = (x0 - st.x) * st.y * g0 + b0; x1 = (x1 - st.x) * st.y * g1 + b1; }
            const f32x4 m50 = *(const f32x4*)(m + 5 * 1024 + k), m51 = *(const f32x4*)(m + 5 * 1024 + k + 4);
#pragma unroll
            for (int i = 0; i < 4; ++i) { v[hh * 8 + i] = ALPHA * x0[i] + m50[i] * y[i]; v[hh * 8 + 4 + i] = ALPHA * x1[i] + m51[i] * y[4 + i]; }
        }
        float sum = 0.f;
#pragma unroll
        for (int i = 0; i < 16; ++i) sum += v[i];
        sum += __shfl_xor(sum, 1); sum += __shfl_xor(sum, 2); sum += __shfl_xor(sum, 4); sum += __shfl_xor(sum, 8); sum += __shfl_xor(sum, 16); sum += __shfl_xor(sum, 32);
        const float mean = sum * (1.0f / 1024.0f);
        float sq = 0.f;
#pragma unroll
        for (int i = 0; i < 16; ++i) { const float d = v[i] - mean; sq += d * d; }
        sq += __shfl_xor(sq, 1); sq += __shfl_xor(sq, 2); sq += __shfl_xor(sq, 4); sq += __shfl_xor(sq, 8); sq += __shfl_xor(sq, 16); sq += __shfl_xor(sq, 32);
        const float rstd = rsqrtf(sq * (1.0f / 1024.0f) + 1e-5f);
#pragma unroll
        for (int hh = 0; hh < 2; ++hh) { const int k = hh * 512 + F.lane * 8;
            float gm[8], bt[8], xn[8];
            *(f32x4*)&gm[0] = *(const f32x4*)(gam + k); *(f32x4*)&gm[4] = *(const f32x4*)(gam + k + 4);
            *(f32x4*)&bt[0] = *(const f32x4*)(bet + k); *(f32x4*)&bt[4] = *(const f32x4*)(bet + k + 4);
#pragma unroll
            for (int i = 0; i < 8; ++i) xn[i] = (v[hh * 8 + i] - mean) * rstd * gm[i] + bt[i];
            if (dry) { float acc_ = 0.f; for (int i = 0; i < 8; ++i) acc_ += xn[i]; asm volatile("" :: "v"(acc_)); }
            else if (lastl) { if (row >= TC) { float* o = F.out + (size_t)(row - TC) * DM + k; *(f32x4*)o = *(f32x4*)&xn[0]; *(f32x4*)(o + 4) = *(f32x4*)&xn[4]; } }
            else {
                *(f32x4*)(F.X + (size_t)row * DM + k) = *(f32x4*)&xn[0]; *(f32x4*)(F.X + (size_t)row * DM + k + 4) = *(f32x4*)&xn[4];
                float s1[8], b0[8];
                *(f32x4*)&s1[0] = *(const f32x4*)(mn + 1024 + k); *(f32x4*)&s1[4] = *(const f32x4*)(mn + 1024 + k + 4);
                *(f32x4*)&b0[0] = *(const f32x4*)(mn + k); *(f32x4*)&b0[4] = *(const f32x4*)(mn + k + 4);
                float hv[8];
#pragma unroll
                for (int i = 0; i < 8; ++i) hv[i] = xn[i] * (1.0f + s1[i]) + b0[i];
                u32x4 w; w.x = cvt_pk_bf16(hv[0], hv[1]); w.y = cvt_pk_bf16(hv[2], hv[3]); w.z = cvt_pk_bf16(hv[4], hv[5]); w.w = cvt_pk_bf16(hv[6], hv[7]);
                *(u32x4*)(F.HB + (size_t)row * DM + k) = w;
            }
        }
    }
}

constexpr int NPHASE = 2 + 4 * 10;
__global__ void __launch_bounds__(512, 2) mk_fwd(Args args) {
    extern __shared__ __attribute__((aligned(16))) unsigned char lds_raw[];
    Frame F;
    F.out = args.out; F.ws = args.ws; F.lds = (LAS unsigned char*)lds_raw;
    F.tid = threadIdx.x; F.lane = F.tid & 63; F.wave = __builtin_amdgcn_readfirstlane(F.tid >> 6); F.G = gridDim.x; F.wg = blockIdx.x;
    F.mods = (float*)(args.ws + OFF_MODS); F.X = (float*)(args.ws + OFF_X); F.HB = (bf16_t*)(args.ws + OFF_HB); F.MIX = F.HB;
    F.WB = args.ws + OFF_WB; F.R1 = args.ws + OFF_R1;
    volatile LAS unsigned* xbw = (volatile LAS unsigned*)(F.lds + LDS_MISC);
    if (F.tid < 4) xbw[F.tid] = 0u;
    if (F.tid < 30) ((LAS unsigned long long*)(F.lds + LDS_MISC + MISC_INP))[F.tid] = (unsigned long long)args.in[F.tid];
    __syncthreads();
    const int lo = args.ph_lo, hi = args.ph_hi;
    XcdBarrier bar; bar.bar = (unsigned*)(args.ws + OFF_CTL); bar.x = 0; bar.st = xbw;
    if (hi - lo > 1) bar = xcd_barrier_post((unsigned*)(args.ws + OFF_CTL), xbw);
#define IN(k) (lo <= (k) && (k) < hi)
#define SEAM(k) do { if (IN(k) && IN((k) + 1)) xcd_barrier(bar); } while (0)
    if ((PHM & 1) && IN(0)) { ph_mods(fresh(F)); } SEAM(0);
    if ((PHM & 2) && IN(1)) { ph_init_x(fresh(F)); }
    for (int l = 0; l < 4; ++l) {
        const int pb = 2 + l * 10, j = l >> 1; const bool even = (l & 1) == 0;
        float* mods_l = F.mods + (size_t)l * 5 * 6144;
        if ((PHM & 4) && IN(pb + 0)) { for (int rep = 0; rep < ((REPM & 4) ? 2 : 1); ++rep) { ph_convert(fresh(F), l); __syncthreads(); } } SEAM(pb + 0);
        if ((PHM & 8) && IN(pb + 1)) {
            const int N = even ? 4096 : 2048;
            pg8::StaticOrder S; S.init(F.HB, F.WB + WB_IN, TT, N, 1024, F.G, F.wg);
            pg8::EpiStoreBf16 E{(bf16_t*)(F.R1 + R1_P), N};
            for (int rep = 0; rep < ((REPM & 8) ? 2 : 1); ++rep) pg8::gemm_phase(F.lds, 1024, S, E);
        } SEAM(pb + 1);
        if (IN(pb + 2)) { if (even) { for (int rep = 0; rep < ((REPM & 16) ? 2 : 1); ++rep) ph_attn(fresh(F), j); for (int rep = 0; rep < ((REPM & 32) ? 2 : 1); ++rep) ph_hg_a(fresh(F), j); } else { for (int rep = 0; rep < ((REPM & 64) ? 2 : 1); ++rep) ph_lru_ac<false>(fresh(F), j); } } SEAM(pb + 2);
        if (IN(pb + 3)) { if (even) { for (int rep = 0; rep < ((REPM & 128) ? 2 : 1); ++rep) ph_hg_b(fresh(F)); } else { for (int rep = 0; rep < ((REPM & 256) ? 2 : 1); ++rep) ph_lru_b(fresh(F)); } } SEAM(pb + 3);
        if (IN(pb + 4)) { if (even) { for (int rep = 0; rep < ((REPM & 512) ? 2 : 1); ++rep) ph_hg_c(fresh(F), j); } else { for (int rep = 0; rep < ((REPM & 1024) ? 2 : 1); ++rep) ph_lru_ac<true>(fresh(F), j); } } SEAM(pb + 4);
        if ((PHM & 2048) && IN(pb + 5)) {
            pg8::StaticOrder S; S.init(F.MIX, F.WB + WB_OUT, TT, 1024, 1024, F.G, F.wg);
            pg8::EpiResid E{F.X, mods_l};
            pg8::gemm_phase(F.lds, 1024, S, E);
        } SEAM(pb + 5);
        if ((PHM & 4096) && IN(pb + 6)) { if (REPM & 4096) ph_ln_router(fresh(F), l, true); ph_ln_router(fresh(F), l); } SEAM(pb + 6);
        if ((PHM & 8192) && IN(pb + 7)) {
            const int ntiles = moe_tables(fresh(F), l);
            pg8::MoeGU S; S.cnt = (const LAS int*)(F.lds + LDS_MISC + MISC_CNT); S.tst = (const LAS int*)(F.lds + LDS_MISC + MISC_TST); S.t2e = (const LAS unsigned char*)(F.lds + LDS_MISC + MISC_T2E);
            S.ntiles = ntiles; S.npn = 2; S.G = F.G; S.c = F.wg; S.A = (const char*)F.HB; S.Bt = (const char*)(F.WB + WB_GU); S.stok = (const int*)(F.ws + OFF_STOK);
            pg8::EpiSwiglu E{(bf16_t*)(F.R1 + R1_H)};
            for (int rep = 0; rep < ((REPM & 8192) ? 2 : 1); ++rep) pg8::gemm_phase(F.lds, 1024, S, E);
        } SEAM(pb + 7);
        if ((PHM & 16384) && IN(pb + 8)) {
            const int ntiles = moe_tables(fresh(F), l);
            pg8::MoeDN S; S.cnt = (const LAS int*)(F.lds + LDS_MISC + MISC_CNT); S.tst = (const LAS int*)(F.lds + LDS_MISC + MISC_TST); S.t2e = (const LAS unsigned char*)(F.lds + LDS_MISC + MISC_T2E);
            S.ntiles = ntiles; S.npn = 4; S.G = F.G; S.c = F.wg; S.A = (const char*)(F.R1 + R1_H); S.Bt = (const char*)(F.WB + WB_DN);
            pg8::EpiDown E{(bf16_t*)(F.R1 + R1_Y), (const float*)(F.ws + OFF_SW), (const LAS int*)(F.lds + LDS_MISC + MISC_CNT)};
            for (int rep = 0; rep < ((REPM & 16384) ? 2 : 1); ++rep) pg8::gemm_phase(F.lds, 256, S, E);
        } SEAM(pb + 8);
        if ((PHM & 32768) && IN(pb + 9)) { if (REPM & 32768) ph_combine(fresh(F), l, true); ph_combine(fresh(F), l); } SEAM(pb + 9);
    }
#undef IN
#undef SEAM
}

extern "C" void kernel_launch(void* const* d_in, const int* in_sizes, int n_in, void* d_out, int out_size, void* d_ws, size_t ws_size, hipStream_t stream) {
    static int grid = 0;
    if (grid == 0) {
        if (n_in != 30 || out_size != TX * DM || ws_size < WS_END) { fprintf(stderr, "kernel_launch: unexpected problem (n_in %d out %d ws %zu need %zu)\n", n_in, out_size, ws_size, (size_t)WS_END); grid = -1; return; }
        int dev = 0, cus = 0, per_cu = 0;
        if (hipGetDevice(&dev) != hipSuccess || hipDeviceGetAttribute(&cus, hipDeviceAttributeMultiprocessorCount, dev) != hipSuccess) { grid = -1; return; }
        if (hipFuncSetAttribute((const void*)mk_fwd, hipFuncAttributeMaxDynamicSharedMemorySize, LDS_BYTES) != hipSuccess) { fprintf(stderr, "kernel_launch: hipFuncSetAttribute failed\n"); grid = -1; return; }
        if (hipOccupancyMaxActiveBlocksPerMultiprocessor(&per_cu, (const void*)mk_fwd, 512, LDS_BYTES) != hipSuccess || per_cu < 1) { fprintf(stderr, "kernel_launch: occupancy query says %d\n", per_cu); }
        (void)hipGetLastError();
        grid = cus;
    }
    if (grid < 0) return;
    (void)hipMemsetAsync((char*)d_ws + OFF_CTL, 0, CTL_BYTES, stream);
    Args a{};
    for (int i = 0; i < 30; ++i) a.in[i] = (const float*)d_in[i];
    a.out = (float*)d_out; a.ws = (unsigned char*)d_ws;
#if MK_SPLIT
    for (int p = 0; p < NPHASE; ++p) { a.ph_lo = p; a.ph_hi = p + 1; hipLaunchKernelGGL(mk_fwd, dim3(grid), dim3(512), LDS_BYTES, stream, a); }
#else
    a.ph_lo = 0; a.ph_hi = NPHASE;
    hipLaunchKernelGGL(mk_fwd, dim3(grid), dim3(512), LDS_BYTES, stream, a);
#endif
}
```

```cpp
#include <hip/hip_runtime.h>
#include <cstdio>
#include <cstdint>

#ifndef PHM
#define PHM 0xFFFF
#endif
#ifndef REPM
#define REPM 0
#endif
#ifndef MK_SPLIT
#define MK_SPLIT 0
#endif

typedef unsigned short bf16_t;
typedef short bf16x8 __attribute__((ext_vector_type(8)));
typedef short bf16x4 __attribute__((ext_vector_type(4)));
typedef float f32x4 __attribute__((ext_vector_type(4)));
typedef float f32x2 __attribute__((ext_vector_type(2)));
typedef unsigned u32x4 __attribute__((ext_vector_type(4)));
typedef unsigned u32x2 __attribute__((ext_vector_type(2)));
#define LAS __attribute__((address_space(3)))

constexpr int DM = 1024, NBAT = 4, SEQ = 8192, CTXL = 256;
constexpr int TC = NBAT * CTXL, TX = NBAT * SEQ, TT = TC + TX;
constexpr int NEXP = 64, TOPK = 6;
constexpr int CAP = TT;
constexpr int MOE_ROUTED_ROWS = 6 * TT + 64 * 256;
constexpr int MOE_ROWS = MOE_ROUTED_ROWS + TT;
constexpr int MOE_MAXTILES = MOE_ROWS / 256;
constexpr float ALPHA = 1.681792830507429f;
constexpr int HG_U = 128, HG_NU = (CTXL + SEQ) / HG_U;
constexpr int LRU_NT = (CTXL + SEQ) / 16;

constexpr size_t OFF_CTL = 0, CTL_BYTES = 65536;
constexpr size_t CTL_CNT = 16384, CTL_DBG = 20480;
constexpr size_t OFF_MODS = 65536;
constexpr size_t OFF_LBT = OFF_MODS + 4 * 5 * 6144 * 4;
constexpr size_t OFF_STATS = OFF_LBT + 8192;
constexpr size_t OFF_AB = OFF_STATS + (size_t)TT * 8;
static_assert(OFF_AB + 4 * 5 * 2 * 1024 * 4 <= (1u << 20), "ctl map");
constexpr size_t OFF_TOKE = 1u << 20;
constexpr size_t OFF_TOKP = OFF_TOKE + (size_t)TT * 32;
constexpr size_t OFF_TOKW = OFF_TOKP + (size_t)TT * 32;
constexpr size_t OFF_STOK = OFF_TOKW + (size_t)TT * 32;
constexpr size_t OFF_SW = OFF_STOK + (size_t)64 * CAP * 4;
constexpr size_t OFF_X = OFF_SW + (size_t)64 * CAP * 4;
constexpr size_t OFF_HB = OFF_X + (size_t)TT * DM * 4;
constexpr size_t OFF_WB = OFF_HB + (size_t)TT * DM * 2;
constexpr size_t WB_IN = 0, WB_OUT = WB_IN + (size_t)4096 * 1024 * 2, WB_RT = WB_OUT + (size_t)1024 * 1024 * 2, WB_GU = WB_RT + (size_t)64 * 1024 * 2,
                 WB_DN = WB_GU + (size_t)65 * 512 * 1024 * 2, WB_LRU = WB_DN + (size_t)65 * 1024 * 256 * 2, WB_END = WB_LRU + (size_t)2 * 2 * 16 * 64 * 64 * 2;
constexpr size_t OFF_R1 = OFF_WB + WB_END;
constexpr size_t R1_P = 0;
constexpr size_t R1_OF = R1_P + (size_t)TT * 4096 * 2;
constexpr size_t R1_SLOC = R1_OF + (size_t)TT * 512 * 4;
constexpr size_t R1_SST = R1_SLOC + (size_t)64 * HG_NU * 4096 * 4;
constexpr size_t R1_DL = R1_SST + (size_t)64 * HG_NU * 4096 * 4;
constexpr size_t R1_AG = R1_OF;
constexpr size_t R1_HST = R1_AG + (size_t)4 * 2 * LRU_NT * 2 * 1024 * 4;
constexpr size_t R1_H = 0;
constexpr size_t R1_Y = R1_H + (size_t)MOE_ROWS * 256 * 2;
constexpr size_t R1_MOE_END = R1_Y + (size_t)MOE_ROWS * 1024 * 2;
constexpr size_t R1_MIX_END = R1_DL + (size_t)64 * HG_NU * 64 * 4;
constexpr size_t WS_END = OFF_R1 + (R1_MOE_END > R1_MIX_END ? R1_MOE_END : R1_MIX_END);

constexpr int LDS_STAGE = 131072;
constexpr int LDS_MISC = LDS_STAGE;
constexpr int MISC_CNT = 64;
constexpr int MISC_TST = MISC_CNT + 66 * 4 + 8;
constexpr int MISC_HIST = 640;
constexpr int MISC_HBASE = 896;
constexpr int MISC_T2E = 1152;
constexpr int MISC_INP = 2304;
constexpr int LDS_BYTES = 147456;

#define XB_TMO      128
#define XB_XCNT(j)  (256  + 64 * (j))
#define XB_XSUB(j)  (1280 + 64 * (j))
#define XB_XGEN(j)  (2304 + 64 * (j))
#define XB_TOP      3328
#define XB_TOPGEN   3392
#define XCD_BAR_WORDS 3456
#define XB_SPIN_CAP (1u << 22)
__device__ __forceinline__ unsigned xb_ld(unsigned* p)              { return __hip_atomic_load(p, __ATOMIC_RELAXED, __HIP_MEMORY_SCOPE_AGENT); }
__device__ __forceinline__ unsigned xb_add(unsigned* p, unsigned v) { return __hip_atomic_fetch_add(p, v, __ATOMIC_RELAXED, __HIP_MEMORY_SCOPE_AGENT); }
__device__ __forceinline__ unsigned xb_xcc_id() { return (unsigned)__builtin_amdgcn_s_getreg((3 << 11) | 20) & 0xFu; }
#define XB_SPIN(cond, bar) do { unsigned _sp = 0; while (cond) { __builtin_amdgcn_s_sleep(1); \
    if ((++_sp & 255u) == 0u) { if (xb_ld(&(bar)[XB_TMO])) break; if (_sp > XB_SPIN_CAP) { atomicAdd(&(bar)[XB_TMO], 1u); break; } } } } while (0)
struct XcdBarrier { unsigned* bar; unsigned x; volatile LAS unsigned* st; };
__device__ __forceinline__ XcdBarrier xcd_barrier_post(unsigned* bar, volatile LAS unsigned* st) {
    XcdBarrier b; b.bar = bar; b.x = xb_xcc_id(); b.st = st;
    if (threadIdx.x == 0) (void)xb_add(&bar[XB_XCNT(b.x)], 1u);
    return b;
}
__device__ __forceinline__ void xcd_barrier_complete(unsigned* bar, unsigned x, unsigned& nloc, unsigned& nx) {
    const unsigned G = gridDim.x * gridDim.y * gridDim.z;
    unsigned sum, cnt, mine, sp = 0u;
    for (;;) {
        sum = 0u; cnt = 0u; mine = 0u;
#pragma unroll
        for (unsigned j = 0; j < 16; ++j) { const unsigned c = xb_ld(&bar[XB_XCNT(j)]); sum += c; cnt += (c > 0u) ? 1u : 0u; mine = (j == x) ? c : mine; }
        if (sum == G) break;
        __builtin_amdgcn_s_sleep(1);
        if ((++sp & 255u) == 0u) { if (xb_ld(&bar[XB_TMO])) break; if (sp > XB_SPIN_CAP) { atomicAdd(&bar[XB_TMO], 1u); break; } }
    }
    nloc = mine > 0u ? mine : 1u; nx = cnt > 0u ? cnt : 1u;
}
__device__ __forceinline__ void xcd_barrier(const XcdBarrier& b) {
    asm volatile("s_waitcnt vmcnt(0)" ::: "memory");
    __syncthreads();
    if (threadIdx.x == 0) {
        unsigned* bar = b.bar;
        __builtin_amdgcn_s_waitcnt(0);
        unsigned nloc = b.st[0], nx = b.st[1];
        if (nloc == 0u) { xcd_barrier_complete(bar, b.x, nloc, nx); b.st[0] = nloc; b.st[1] = nx; }
        const unsigned old = xb_add(&bar[XB_XSUB(b.x)], 1u);
        const unsigned gen = old / nloc;
        if (old + 1u == (gen + 1u) * nloc) {
            __builtin_amdgcn_fence(__ATOMIC_RELEASE, "agent");
            asm volatile("s_waitcnt vmcnt(0)" ::: "memory");
            const unsigned og = xb_add(&bar[XB_TOP], 1u);
            const unsigned tg = og / nx;
            if (og + 1u == (tg + 1u) * nx) xb_add(&bar[XB_TOPGEN], 1u);
            else XB_SPIN(xb_ld(&bar[XB_TOPGEN]) == tg, bar);
            __builtin_amdgcn_fence(__ATOMIC_ACQUIRE, "agent");
            xb_add(&bar[XB_XGEN(b.x)], 1u);
            asm volatile("s_waitcnt vmcnt(0)" ::: "memory");
        } else {
            XB_SPIN(xb_ld(&bar[XB_XGEN(b.x)]) == gen, bar);
            __builtin_amdgcn_fence(__ATOMIC_ACQUIRE, "agent");
            asm volatile("s_waitcnt vmcnt(0)" ::: "memory");
        }
    }
    __syncthreads();
}

__device__ __forceinline__ float bf2f(unsigned short b) { return __uint_as_float(((unsigned)b) << 16); }
__device__ __forceinline__ unsigned cvt_pk_bf16(float lo, float hi) { unsigned r; asm volatile("v_cvt_pk_bf16_f32 %0, %1, %2" : "=v"(r) : "v"(lo), "v"(hi)); return r; }
__device__ __forceinline__ unsigned short f2bf(float f) { return (unsigned short)(cvt_pk_bf16(f, 0.f) & 0xffffu); }
__device__ __forceinline__ float sigmoidf_(float x) { return __builtin_amdgcn_rcpf(1.0f + __expf(-x)); }
__device__ __forceinline__ float siluf_(float x) { return x * sigmoidf_(x); }
__device__ __forceinline__ float gelu_tanh_(float x) { return x * sigmoidf_(1.5957691216057308f * (x + 0.044715f * x * x * x)); }
__device__ __forceinline__ int slot_of_row(int r) { return r < TC ? 4 : ((r - TC) >> 13); }
template <int CTRL> __device__ __forceinline__ float dppf(float oldv, float src) {
    return __int_as_float(__builtin_amdgcn_update_dpp(__float_as_int(oldv), __float_as_int(src), CTRL, 0xf, 0xf, false));
}
__device__ __forceinline__ void unpack8(const u32x4 w, float (&o)[8]) {
    o[0] = __uint_as_float(w.x << 16); o[1] = __uint_as_float(w.x & 0xffff0000u); o[2] = __uint_as_float(w.y << 16); o[3] = __uint_as_float(w.y & 0xffff0000u);
    o[4] = __uint_as_float(w.z << 16); o[5] = __uint_as_float(w.z & 0xffff0000u); o[6] = __uint_as_float(w.w << 16); o[7] = __uint_as_float(w.w & 0xffff0000u);
}

namespace pg8 {
constexpr int BM = 256, BK = 64, HALF = 128, HTB = HALF * BK * 2, STAGE_BYTES = 8 * HTB, NXCD = 8, WGM = 8;
__device__ __forceinline__ int lds_byte(int r, int c) { const int st = (r >> 4) * 2 + (c >> 5), rr = r & 15, cc = c & 31, ob = rr * 64 + cc * 2; return st * 1024 + (ob ^ (((ob >> 9) & 1) << 5)); }
__device__ __forceinline__ void stage_rc(int b, int& R, int& C) { const int st = b / 1024, sb = b % 1024, swz = sb ^ (((sb >> 9) & 1) << 5); R = (st >> 1) * 16 + swz / 64; C = (st & 1) * 32 + (swz % 64) / 2; }
__device__ __forceinline__ int perm32(int rho) { const int n = rho >> 4, i = rho & 15; return 8 * (i >> 2) + 4 * n + (i & 3); }
struct Unit { int pm, pn, e, ti; };

struct StaticOrder {
    const char* A; const char* Bt; int K;
    int nM, nN, nwg, G, c;
    __device__ __forceinline__ void init(const void* A_, const void* Bt_, int M, int N, int K_, int G_, int c_) { A = (const char*)A_; Bt = (const char*)Bt_; K = K_; nM = M / BM; nN = N / BM; nwg = nM * nN; G = G_; c = c_; }
    __device__ __forceinline__ bool next(int i, Unit& u) const {
        const long L = (long)i * G + c; if (L >= nwg) return false;
        int wgid = (int)L; { const int q = nwg / NXCD, r = nwg % NXCD, xcd = wgid % NXCD, off = wgid / NXCD; wgid = (xcd < r ? xcd * (q + 1) : r * (q + 1) + (xcd - r) * q) + off; }
        const int nig = WGM * nN, gid = wgid / nig, fm = gid * WGM, gsz = (nM - fm) < WGM ? (nM - fm) : WGM;
        u.pm = fm + ((wgid % nig) % gsz); u.pn = (wgid % nig) / gsz; u.e = 0; u.ti = 0; return true;
    }
    static constexpr bool GATHER = false;
    __device__ __forceinline__ const char* abase(const Unit& u) const { return A + (size_t)u.pm * BM * K * 2; }
    __device__ __forceinline__ const char* bbase(const Unit& u) const { return Bt + (size_t)u.pn * BM * K * 2; }
};

template <class Epi, class Sched>
__device__ __forceinline__ void gemm_phase(LAS unsigned char* lds, const int K_, const Sched& S, const Epi& E, const int wave_) {
    int Kl_ = K_; asm volatile("" : "+s"(Kl_)); const int K = Kl_;
    int tid_ = wave_ * 64 + (int)__builtin_amdgcn_mbcnt_hi(~0u, __builtin_amdgcn_mbcnt_lo(~0u, 0u)); asm volatile("" : "+v"(tid_));
    const int tid = tid_, wid = __builtin_amdgcn_readfirstlane(tid >> 6), lane = tid & 63, wr = wid >> 2, wc = wid & 3, fr = lane & 15, fq = lane >> 4;
    const int nt = K / BK;
    unsigned voffA[2], voffB[2];
#pragma unroll
    for (int i = 0; i < 2; ++i) { int R, C; stage_rc(tid * 16 + i * 8192, R, C); const int Rb = Epi::PERM ? ((R & ~31) + perm32(R & 31)) : R; voffA[i] = (unsigned)(R * K + C) * 2u; voffB[i] = (unsigned)(Rb * K + C) * 2u; }
    const size_t kstep = (size_t)(BK * 2);
    const size_t hstep = (size_t)HALF * K * 2;
    const unsigned ldsw = (unsigned)wid * 1024u;
    const int aoff = lds_byte(wr * 64 + fr, fq * 8), boff = lds_byte(wc * 32 + fr, fq * 8);
#define PG8_SA(b, h) (((b) * 2 + (h)) * HTB)
#define PG8_SB(b, h) ((4 + (b) * 2 + (h)) * HTB)
#define PG8_STAGE(bufoff, gbase, voff) do { _Pragma("unroll") for (int _i = 0; _i < 2; ++_i) \
        __builtin_amdgcn_global_load_lds((const unsigned*)((const char*)(gbase) + (voff)[_i]), (LAS unsigned*)(lds + (bufoff) + ldsw + _i * 8192), 16, 0, 0); } while (0)
#define PG8_STAGEA(bufoff, hh, kb, nx) do { if constexpr (Sched::GATHER) { unsigned _o[2]; _o[0] = (nx) ? vN[hh][0] : vC[hh][0]; _o[1] = (nx) ? vN[hh][1] : vC[hh][1]; PG8_STAGE(bufoff, cA + (kb), _o); } \
        else { PG8_STAGE(bufoff, ((nx) ? nA : cA) + (hh) * hstep + (kb), voffA); } } while (0)
#define PG8_LDA(dst, b, h) do { _Pragma("unroll") for (int m = 0; m < 4; ++m) _Pragma("unroll") for (int k = 0; k < 2; ++k) dst[m][k] = *(const LAS bf16x8*)(lds + PG8_SA(b, h) + aoff + m * 2048 + k * 1024); } while (0)
#define PG8_LDB(dst, b, h) do { _Pragma("unroll") for (int n = 0; n < 2; ++n) _Pragma("unroll") for (int k = 0; k < 2; ++k) dst[n][k] = *(const LAS bf16x8*)(lds + PG8_SB(b, h) + boff + n * 2048 + k * 1024); } while (0)
#define PG8_MMA(ai, bj, At, Bt) do { __builtin_amdgcn_s_setprio(1); _Pragma("unroll") for (int m = 0; m < 4; ++m) _Pragma("unroll") for (int n = 0; n < 2; ++n) _Pragma("unroll") for (int k = 0; k < 2; ++k) \
        acc[ai][bj][m][n] = __builtin_amdgcn_mfma_f32_16x16x32_bf16(Bt[n][k], At[m][k], acc[ai][bj][m][n], 0, 0, 0); __builtin_amdgcn_s_setprio(0); } while (0)
#define PG8_WAIT_V(n) asm volatile("s_waitcnt vmcnt(" #n ")" ::: "memory")
#define PG8_WAIT_L(n) asm volatile("s_waitcnt lgkmcnt(" #n ")" ::: "memory")
#define PG8_BAR __builtin_amdgcn_s_barrier()
#define PG8_SCHED __builtin_amdgcn_sched_barrier(0)
    Unit cur, nxt; int ui = 0;
    if (!S.next(0, cur)) return;
    f32x4 acc[2][2][4][2];
#pragma unroll
    for (int a = 0; a < 2; ++a)
#pragma unroll
        for (int b = 0; b < 2; ++b)
#pragma unroll
            for (int m = 0; m < 4; ++m)
#pragma unroll
                for (int n = 0; n < 2; ++n) acc[a][b][m][n] = (f32x4){0.f, 0.f, 0.f, 0.f};
    bf16x8 At[4][2], B0[2][2], B1[2][2];
    unsigned vC[2][2], vN[2][2];
    if constexpr (Sched::GATHER) S.aoff(cur, tid, vC);
    const char* cA = S.abase(cur);
    const char* cB = S.bbase(cur);
    const char* nA = cA;
    PG8_STAGE(PG8_SB(0, 0), cB, voffB); PG8_STAGEA(PG8_SA(0, 0), 0, 0, false); PG8_STAGE(PG8_SB(0, 1), cB + hstep, voffB); PG8_STAGEA(PG8_SA(0, 1), 1, 0, false);
    if (wr == 1) PG8_BAR;
    PG8_WAIT_V(4); PG8_BAR;
    PG8_STAGE(PG8_SB(1, 0), cB + kstep, voffB); PG8_STAGEA(PG8_SA(1, 0), 0, kstep, false); PG8_STAGE(PG8_SB(1, 1), cB + hstep + kstep, voffB);
    PG8_WAIT_V(6); PG8_BAR;
    for (;;) {
        const bool has_next = S.next(ui + 1, nxt);
        const char* nB = cB; nA = cA;
        if (has_next) { nB = S.bbase(nxt); nA = S.abase(nxt); if constexpr (Sched::GATHER) S.aoff(nxt, tid, vN); }
        else { if constexpr (Sched::GATHER) {
#pragma unroll
            for (int h = 0; h < 2; ++h)
#pragma unroll
                for (int i = 0; i < 2; ++i) vN[h][i] = vC[h][i]; } }
        for (int t = 0; t < nt; t += 2) {
            const bool last = (t == nt - 2);
            const size_t k1 = (size_t)(t + 1) * kstep, k2 = last ? 0 : (size_t)(t + 2) * kstep, k3 = k2 + kstep;
            const char* b2 = last ? nB : cB + (size_t)(t + 2) * kstep; const char* b3 = b2 + kstep;
            PG8_LDB(B0, 0, 0); PG8_SCHED; PG8_LDA(At, 0, 0); PG8_STAGEA(PG8_SA(1, 1), 1, k1, false);
            PG8_WAIT_L(8); PG8_BAR; PG8_WAIT_L(0); PG8_MMA(0, 0, At, B0); PG8_BAR; PG8_SCHED;
            PG8_LDB(B1, 0, 1); PG8_STAGE(PG8_SB(0, 0), b2, voffB);
            PG8_BAR; PG8_WAIT_L(0); PG8_MMA(0, 1, At, B1); PG8_BAR;
            PG8_LDA(At, 0, 1); PG8_STAGEA(PG8_SA(0, 0), 0, k2, last);
            PG8_BAR; PG8_WAIT_L(0); PG8_MMA(1, 0, At, B0); PG8_BAR; PG8_SCHED;
            PG8_STAGE(PG8_SB(0, 1), b2 + hstep, voffB);
            PG8_WAIT_V(6); PG8_BAR; PG8_MMA(1, 1, At, B1); PG8_BAR;
            PG8_LDB(B0, 1, 0); PG8_SCHED; PG8_LDA(At, 1, 0); PG8_STAGEA(PG8_SA(0, 1), 1, k2, last);
            PG8_WAIT_L(8); PG8_BAR; PG8_WAIT_L(0); PG8_MMA(0, 0, At, B0); PG8_BAR; PG8_SCHED;
            PG8_LDB(B1, 1, 1); PG8_STAGE(PG8_SB(1, 0), b3, voffB);
            PG8_BAR; PG8_WAIT_L(0); PG8_MMA(0, 1, At, B1); PG8_BAR;
            PG8_LDA(At, 1, 1); PG8_STAGEA(PG8_SA(1, 0), 0, k3, last);
            PG8_BAR; PG8_WAIT_L(0); PG8_MMA(1, 0, At, B0); PG8_BAR; PG8_SCHED;
            PG8_STAGE(PG8_SB(1, 1), b3 + hstep, voffB);
            PG8_WAIT_V(6); PG8_BAR; PG8_MMA(1, 1, At, B1); PG8_BAR;
        }
        E(acc, cur, wr, wc, fr, fq);
        if (!has_next) break;
#pragma unroll
        for (int a = 0; a < 2; ++a)
#pragma unroll
            for (int b = 0; b < 2; ++b)
#pragma unroll
                for (int m = 0; m < 4; ++m)
#pragma unroll
                    for (int n = 0; n < 2; ++n) acc[a][b][m][n] = (f32x4){0.f, 0.f, 0.f, 0.f};
        cur = nxt; cB = nB; cA = nA; ++ui;
        if constexpr (Sched::GATHER) {
#pragma unroll
            for (int h = 0; h < 2; ++h)
#pragma unroll
                for (int i = 0; i < 2; ++i) vC[h][i] = vN[h][i]; }
    }
    PG8_WAIT_V(0);
    if (wr == 0) PG8_BAR;
    PG8_BAR;
#undef PG8_SA
#undef PG8_SB
#undef PG8_STAGE
#undef PG8_STAGEA
#undef PG8_LDA
#undef PG8_LDB
#undef PG8_MMA
#undef PG8_WAIT_V
#undef PG8_WAIT_L
#undef PG8_BAR
#undef PG8_SCHED
}

struct EpiStoreBf16 {
    static constexpr bool PERM = true;
    bf16_t* O; int ldc;
    __device__ __forceinline__ void operator()(const f32x4 (&acc)[2][2][4][2], const Unit& u, int wr, int wc, int fr, int fq) const {
        const int row0 = u.pm * BM + wr * 64 + fr, col0 = u.pn * BM + wc * 32 + 8 * fq;
#pragma unroll
        for (int ai = 0; ai < 2; ++ai)
#pragma unroll
            for (int m = 0; m < 4; ++m) { bf16_t* rowp = O + (size_t)(row0 + ai * HALF + m * 16) * ldc + col0;
#pragma unroll
                for (int bj = 0; bj < 2; ++bj) { const f32x4 v0 = acc[ai][bj][m][0], v1 = acc[ai][bj][m][1];
                    u32x4 w; w.x = cvt_pk_bf16(v0[0], v0[1]); w.y = cvt_pk_bf16(v0[2], v0[3]); w.z = cvt_pk_bf16(v1[0], v1[1]); w.w = cvt_pk_bf16(v1[2], v1[3]);
                    *(u32x4*)(rowp + bj * HALF) = w; } }
    }
};
struct EpiResid {
    static constexpr bool PERM = false;
    float* X; const float* mods_l;
    __device__ __forceinline__ void operator()(const f32x4 (&acc)[2][2][4][2], const Unit& u, int wr, int wc, int fr, int fq) const {
        const int row0 = u.pm * BM + wr * 64 + fr, col0 = u.pn * BM + wc * 32 + 4 * fq;
        const float* m2 = mods_l + (size_t)(slot_of_row(u.pm * BM) * 6 + 2) * DM + col0;
        float* xb = X + (size_t)row0 * DM + col0;
#pragma unroll
        for (int bj = 0; bj < 2; ++bj)
#pragma unroll
            for (int n = 0; n < 2; ++n) { const f32x4 mv = *(const f32x4*)(m2 + bj * HALF + n * 16);
#pragma unroll
                for (int ai = 0; ai < 2; ++ai) {
#pragma unroll
                    for (int m = 0; m < 4; ++m) { float* p = xb + (size_t)(ai * HALF + m * 16) * DM + bj * HALF + n * 16; const f32x4 xv = *(const f32x4*)p; *(f32x4*)p = xv * ALPHA + mv * acc[ai][bj][m][n]; }
                    asm volatile("" ::: "memory"); } }
    }
};
struct EpiSwiglu {
    static constexpr bool PERM = true;
    bf16_t* H;
    __device__ __forceinline__ void operator()(const f32x4 (&acc)[2][2][4][2], const Unit& u, int wr, int wc, int fr, int fq) const {
        const int row0 = u.pm * BM + wr * 64 + fr, col0 = u.pn * HALF + wc * 32 + 8 * fq;
#pragma unroll
        for (int ai = 0; ai < 2; ++ai)
#pragma unroll
            for (int m = 0; m < 4; ++m) { bf16_t* rowp = H + (size_t)(row0 + ai * HALF + m * 16) * 256 + col0;
                float h[8];
#pragma unroll
                for (int n = 0; n < 2; ++n)
#pragma unroll
                    for (int j = 0; j < 4; ++j) h[n * 4 + j] = siluf_(acc[ai][0][m][n][j]) * acc[ai][1][m][n][j];
                u32x4 w; w.x = cvt_pk_bf16(h[0], h[1]); w.y = cvt_pk_bf16(h[2], h[3]); w.z = cvt_pk_bf16(h[4], h[5]); w.w = cvt_pk_bf16(h[6], h[7]);
                *(u32x4*)rowp = w; }
    }
};
struct EpiDown {
    static constexpr bool PERM = true;
    bf16_t* Y; const float* sw; const LAS int* cnt;
    __device__ __forceinline__ void operator()(const f32x4 (&acc)[2][2][4][2], const Unit& u, int wr, int wc, int fr, int fq) const {
        const int row0 = u.pm * BM + wr * 64 + fr, col0 = u.pn * BM + wc * 32 + 8 * fq;
        const int ce = (u.e < 64) ? cnt[u.e] : 0;
        const float* swe = sw + (size_t)(u.e < 64 ? u.e : 0) * CAP + u.ti * 256 + wr * 64 + fr;
        bf16_t* yb = Y + (size_t)row0 * DM + col0;
#pragma unroll
        for (int ai = 0; ai < 2; ++ai)
#pragma unroll
            for (int m = 0; m < 4; ++m) { const int rl = ai * HALF + m * 16, pos = u.ti * 256 + wr * 64 + fr + rl;
                float w = 1.0f; if (u.e < 64) w = (pos < ce) ? swe[rl] : 0.0f;
                bf16_t* rowp = yb + (size_t)rl * DM;
#pragma unroll
                for (int bj = 0; bj < 2; ++bj) { const f32x4 v0 = acc[ai][bj][m][0] * w, v1 = acc[ai][bj][m][1] * w;
                    u32x4 ww; ww.x = cvt_pk_bf16(v0[0], v0[1]); ww.y = cvt_pk_bf16(v0[2], v0[3]); ww.z = cvt_pk_bf16(v1[0], v1[1]); ww.w = cvt_pk_bf16(v1[2], v1[3]);
                    *(u32x4*)(rowp + bj * HALF) = ww; }
                asm volatile("" ::: "memory"); }
    }
};
template <int NPN> struct MoeOrder {
    const LAS int* cnt; const LAS int* tst; const LAS unsigned char* t2e; int ntiles, G, c;
    __device__ __forceinline__ bool next(int i, Unit& u) const {
        const int L = i * G + c; if (L >= ntiles * NPN) return false;
        const int tau = L / NPN; u.pm = tau; u.pn = L % NPN; u.e = t2e[tau]; u.ti = tau - tst[u.e]; return true;
    }
};
struct MoeGU : MoeOrder<2> {
    static constexpr bool GATHER = true;
    const char* A; const char* Bt; const int* stok;
    __device__ __forceinline__ const char* abase(const Unit&) const { return A; }
    __device__ __forceinline__ const char* bbase(const Unit& u) const { return Bt + ((size_t)u.e * 512 + (size_t)u.pn * 256) * 1024 * 2; }
    __device__ __forceinline__ void aoff(const Unit& u, int tid, unsigned (&off)[2][2]) const {
        const int ce = cnt[u.e];
#pragma unroll
        for (int i = 0; i < 2; ++i) { int R, C; stage_rc(tid * 16 + i * 8192, R, C);
#pragma unroll
            for (int h = 0; h < 2; ++h) { const int pos = u.ti * 256 + h * HALF + R; int tok;
                if (u.e == 64) tok = pos; else tok = (pos < ce) ? stok[(size_t)u.e * CAP + pos] : 0;
                off[h][i] = (unsigned)(tok * 1024 + C) * 2u; } }
    }
};
struct MoeDN : MoeOrder<4> {
    static constexpr bool GATHER = false;
    const char* A; const char* Bt;
    __device__ __forceinline__ const char* abase(const Unit& u) const { return A + (size_t)u.pm * BM * 256 * 2; }
    __device__ __forceinline__ const char* bbase(const Unit& u) const { return Bt + ((size_t)u.e * 1024 + (size_t)u.pn * 256) * 256 * 2; }
};
}

struct Args { const float* in[30]; float* out; unsigned char* ws; int ph_lo, ph_hi; };

struct Frame {
    float* out; unsigned char* ws; LAS unsigned char* lds; int tid, lane, wave, G, wg;
    float* mods; float* X; bf16_t* HB; bf16_t* MIX; unsigned char* WB; unsigned char* R1;
};

__device__ __forceinline__ const float* inp(const Frame& F, int i) {
    const unsigned long long v = ((const LAS unsigned long long*)(F.lds + LDS_MISC + MISC_INP))[i];
    const unsigned lo = (unsigned)__builtin_amdgcn_readfirstlane((int)(unsigned)v), hi = (unsigned)__builtin_amdgcn_readfirstlane((int)(unsigned)(v >> 32));
    return (const float*)(((unsigned long long)hi << 32) | lo);
}
__device__ __forceinline__ int lane_id_() { return (int)__builtin_amdgcn_mbcnt_hi(~0u, __builtin_amdgcn_mbcnt_lo(~0u, 0u)); }
__device__ __forceinline__ Frame fresh(const Frame& F0) { Frame F = F0; int ln = lane_id_(); asm volatile("" : "+v"(ln)); F.lane = ln; F.tid = F0.wave * 64 + ln; return F; }

__device__ __forceinline__ void ph_mods(const Frame& F) {
    const float* c = inp(F, 1); const float* cc = inp(F, 3); const float* ada_w = inp(F, 4); const float* ada_b = inp(F, 5);
    LAS float* sv = (LAS float*)F.lds;
    LAS float* red = (LAS float*)(F.lds + 5 * 1024 * 4);
    for (int i = F.tid; i < 5 * 1024; i += 512) { const int s = i >> 10, k = i & 1023; const float v = (s < 4) ? c[s * 1024 + k] : cc[k]; sv[i] = siluf_(v); }
    __syncthreads();
    for (int task = F.wg; task < 4 * 48; task += F.G) {
        const int l = task / 48, cc0 = (task % 48) * 128;
        const int col = cc0 + (F.tid & 127), kg = F.tid >> 7;
        const float* w = ada_w + (size_t)l * 1024 * 6144 + col;
        float a0 = 0.f, a1 = 0.f, a2 = 0.f, a3 = 0.f, a4 = 0.f;
        for (int k = kg * 256; k < kg * 256 + 256; ++k) { const float wv = w[(size_t)k * 6144]; a0 += sv[k] * wv; a1 += sv[1024 + k] * wv; a2 += sv[2048 + k] * wv; a3 += sv[3072 + k] * wv; a4 += sv[4096 + k] * wv; }
        LAS float* r = red + (kg * 128 + (F.tid & 127)) * 5; r[0] = a0; r[1] = a1; r[2] = a2; r[3] = a3; r[4] = a4;
        __syncthreads();
        if (F.tid < 128) {
            const float b = ada_b[l * 6144 + col];
#pragma unroll
            for (int s = 0; s < 5; ++s) { const float v = ((red[(0 * 128 + F.tid) * 5 + s] + red[(1 * 128 + F.tid) * 5 + s]) + red[(2 * 128 + F.tid) * 5 + s]) + red[(3 * 128 + F.tid) * 5 + s];
                F.mods[(size_t)(l * 5 + s) * 6144 + col] = v + b; }
        }
        __syncthreads();
    }
    if (F.wg == F.G - 1) {
        const float* raw = inp(F, 11); float* lbt = (float*)(F.ws + OFF_LBT);
        for (int i = F.tid; i < 2 * 512; i += 512) { const int d = i >> 9, ch = i & 511; const float r0 = raw[(d * 2 + 0) * 512 + ch], r1 = raw[(d * 2 + 1) * 512 + ch];
            lbt[(0 * 2 + d) * 512 + ch] = 0.f; lbt[(1 * 2 + d) * 512 + ch] = sigmoidf_(r1 - r0); }
    }
}

__device__ __forceinline__ void ph_init_x(const Frame& F) {
    const float* x = inp(F, 0); const float* ctx = inp(F, 2);
    { const float* lg_ = inp(F, 6); const float* lb_ = inp(F, 7); float* AB = (float*)(F.ws + OFF_AB);
      for (int i = F.wg * 512 + F.tid; i < 4 * 5 * 1024; i += F.G * 512) { const int k = i & 1023, ls = i >> 10, l = ls / 5;
          const float* m = F.mods + (size_t)ls * 6144; const float g0 = lg_[(l * 2) * 1024 + k], b0 = lb_[(l * 2) * 1024 + k], m3 = m[3 * 1024 + k], m4 = m[4 * 1024 + k];
          AB[(size_t)ls * 2048 + k] = g0 * (1.0f + m4); AB[(size_t)ls * 2048 + 1024 + k] = b0 * (1.0f + m4) + m3; } }
    const int gw = F.wg * 8 + F.wave, nw = F.G * 8;
    for (int row = gw; row < TT; row += nw) {
        const float* src = row < TC ? ctx + (size_t)row * DM : x + (size_t)(row - TC) * DM;
        const float* m = F.mods + (size_t)(0 * 5 + slot_of_row(row)) * 6144;
#pragma unroll
        for (int hh = 0; hh < 2; ++hh) { const int k = hh * 512 + F.lane * 8;
            const f32x4 v0 = *(const f32x4*)(src + k), v1 = *(const f32x4*)(src + k + 4);
            *(f32x4*)(F.X + (size_t)row * DM + k) = v0; *(f32x4*)(F.X + (size_t)row * DM + k + 4) = v1;
            const f32x4 s0 = *(const f32x4*)(m + 1024 + k), s1 = *(const f32x4*)(m + 1024 + k + 4), b0 = *(const f32x4*)(m + k), b1 = *(const f32x4*)(m + k + 4);
            const f32x4 h0 = v0 * (s0 + 1.0f) + b0, h1 = v1 * (s1 + 1.0f) + b1;
            u32x4 w; w.x = cvt_pk_bf16(h0[0], h0[1]); w.y = cvt_pk_bf16(h0[2], h0[3]); w.z = cvt_pk_bf16(h1[0], h1[1]); w.w = cvt_pk_bf16(h1[2], h1[3]);
            *(u32x4*)(F.HB + (size_t)row * DM + k) = w; }
    }
}

__device__ __forceinline__ void cvt_tile(const Frame& F, const float* src, int sld, int k0, int n0, bf16_t* dst, int dld, int drow0, float scale) {
    LAS float* t = (LAS float*)F.lds;
    { const int i = F.tid >> 3, j0 = (F.tid & 7) * 8; const float* p = src + (size_t)(k0 + i) * sld + n0 + j0;
      const f32x4 a = *(const f32x4*)p, b = *(const f32x4*)(p + 4);
      LAS float* q = t + i * 65 + j0; q[0] = a[0]; q[1] = a[1]; q[2] = a[2]; q[3] = a[3]; q[4] = b[0]; q[5] = b[1]; q[6] = b[2]; q[7] = b[3]; }
    __syncthreads();
    { const int j = F.tid >> 3, i0 = (F.tid & 7) * 8; float v[8];
#pragma unroll
      for (int q = 0; q < 8; ++q) v[q] = t[(i0 + q) * 65 + j] * scale;
      u32x4 w; w.x = cvt_pk_bf16(v[0], v[1]); w.y = cvt_pk_bf16(v[2], v[3]); w.z = cvt_pk_bf16(v[4], v[5]); w.w = cvt_pk_bf16(v[6], v[7]);
      *(u32x4*)(dst + (size_t)(drow0 + j) * dld + k0 + i0) = w; }
    __syncthreads();
}
__device__ __forceinline__ void ph_convert(const Frame& F, int l) {
    const int j = l >> 1; const bool even = (l & 1) == 0;
    bf16_t* wIN = (bf16_t*)(F.WB + WB_IN); bf16_t* wOUT = (bf16_t*)(F.WB + WB_OUT); bf16_t* wRT = (bf16_t*)(F.WB + WB_RT);
    bf16_t* wGU = (bf16_t*)(F.WB + WB_GU); bf16_t* wDN = (bf16_t*)(F.WB + WB_DN); bf16_t* wLRU = (bf16_t*)(F.WB + WB_LRU);
    const int nIN = even ? 4096 : 2048;
    const int t_in = (nIN / 64) * 16, t_out = 256, t_rt = 16, t_gu = 65 * 2 * 64, t_dn = 65 * 64, t_lru = even ? 0 : 64;
    const int total = t_in + t_out + t_rt + t_gu + t_dn + t_lru;
    for (int task = F.wg; task < total; task += F.G) {
        int t = task;
        if (t < t_in) { const int nb = t >> 4, kb = t & 15; const float* src = even ? inp(F, 8) + (size_t)j * 1024 * 4096 : inp(F, 13) + (size_t)j * 1024 * 2048;
            cvt_tile(F, src, nIN, kb * 64, nb * 64, wIN, 1024, nb * 64, (even && nb < 8) ? 0.125f : 1.0f); continue; }
        t -= t_in;
        if (t < t_out) { const int nb = t >> 4, kb = t & 15; const float* src = even ? inp(F, 9) + (size_t)j * 1024 * 1024 : inp(F, 21) + (size_t)j * 1024 * 1024;
            cvt_tile(F, src, 1024, kb * 64, nb * 64, wOUT, 1024, nb * 64, 1.0f); continue; }
        t -= t_out;
        if (t < t_rt) { cvt_tile(F, inp(F, 22) + (size_t)l * 1024 * 64, 64, t * 64, 0, wRT, 1024, 0, 1.0f); continue; }
        t -= t_rt;
        if (t < t_gu) { const int e = t / 128, r = t % 128, which = r >> 6, q = r & 63, nb = q >> 4, kb = q & 15;
            const float* src = (e < 64) ? (which ? inp(F, 25) : inp(F, 24)) + ((size_t)l * 64 + e) * 1024 * 256 : (which ? inp(F, 28) : inp(F, 27)) + (size_t)l * 1024 * 256;
            const int n0 = nb * 64, drow0 = (n0 >> 7) * 256 + which * 128 + (n0 & 127);
            cvt_tile(F, src, 256, kb * 64, n0, wGU + (size_t)e * 512 * 1024, 1024, drow0, 1.0f); continue; }
        t -= t_gu;
        if (t < t_dn) { const int e = t >> 6, q = t & 63, nb = q >> 2, kb = q & 3;
            const float* src = (e < 64) ? inp(F, 26) + ((size_t)l * 64 + e) * 256 * 1024 : inp(F, 29) + (size_t)l * 256 * 1024;
            cvt_tile(F, src, 1024, kb * 64, nb * 64, wDN + (size_t)e * 1024 * 256, 256, nb * 64, 1.0f); continue; }
        t -= t_dn;
        { const int d = t >> 5, gt = (t >> 4) & 1, kb = t & 15;
          const float* src = (gt ? inp(F, 18) : inp(F, 16)) + (((size_t)j * 2 + d) * 16 + kb) * 4096;
          cvt_tile(F, src, 64, 0, 0, wLRU + (((size_t)d * 2 + gt) * 16 + kb) * 4096, 64, 0, 1.0f); }
    }
}

__device__ __forceinline__ void ph_attn(const Frame& F, int j) {
    const bf16_t* P = (const bf16_t*)(F.R1 + R1_P);
    LAS bf16_t* Ks = (LAS bf16_t*)F.lds;
    LAS bf16_t* Vt = (LAS bf16_t*)(F.lds + 9216);
    LAS float* rp_l = (LAS float*)(F.lds + 18432);
    const float* rpb = inp(F, 10) + (size_t)j * 8 * 465;
    const int g = F.lane >> 4, l15 = F.lane & 15;
    const int NLAT = NBAT * 8 * 64, NTASK = NLAT + NBAT * 8 * 2;
    for (int task = F.wg; task < NTASK; task += F.G) {
        const bool lat = task < NLAT;
        int b, h, rp = 0, half = 0;
        if (lat) { b = task >> 9; h = (task >> 6) & 7; rp = task & 63; } else { const int t2 = task - NLAT; b = t2 >> 4; h = (t2 >> 1) & 7; half = t2 & 1; }
        const int myr = 2 * rp + (F.wave >> 2), w0 = (F.wave & 3) * 16;
        const int r0 = min(max(myr - 4, 0), 120);
        const int rlo = min(max(2 * rp - 4, 0), 120), rhi = min(max(2 * rp + 1 - 4, 0), 120) + 7;
        const int nloc = lat ? (rhi - rlo + 1) : 0;
        const int qrow = lat ? (TC + b * SEQ + myr * 64 + w0 + l15) : (b * CTXL + half * 128 + F.wave * 16 + l15);
        bf16x8 qf[2];
        qf[0] = *(const bf16x8*)(P + (size_t)qrow * 4096 + h * 64 + g * 8);
        qf[1] = *(const bf16x8*)(P + (size_t)qrow * 4096 + h * 64 + 32 + g * 8);
        if (lat) for (int i = F.tid; i < 465; i += 512) rp_l[i] = rpb[h * 465 + i];
        f32x4 oacc[4];
#pragma unroll
        for (int dt = 0; dt < 4; ++dt) oacc[dt] = (f32x4){0.f, 0.f, 0.f, 0.f};
        float mrun = -1e30f, lrun = 0.f;
        const int wq = w0 + l15, c0 = min(max(wq - 8, 0), 48);
        u32x4 kv, vv;
        { const int key = F.tid >> 3, ds = (F.tid & 7) * 8; const bool loc0 = 0 < nloc;
          const int krow = loc0 ? (TC + b * SEQ + rlo * 64 + key) : (b * CTXL + key);
          kv = *(const u32x4*)(P + (size_t)krow * 4096 + 512 + h * 64 + ds); vv = *(const u32x4*)(P + (size_t)krow * 4096 + 1024 + h * 64 + ds); }
        for (int ch = 0; ch < nloc + 4; ++ch) {
            const bool loc = ch < nloc; const int kr = rlo + ch;
            { const int key = F.tid >> 3, ds = (F.tid & 7) * 8;
              __syncthreads();
              *(LAS u32x4*)(Ks + key * 72 + ds) = kv;
              Vt[(ds + 0) * 72 + key] = (bf16_t)(vv.x & 0xffff); Vt[(ds + 1) * 72 + key] = (bf16_t)(vv.x >> 16);
              Vt[(ds + 2) * 72 + key] = (bf16_t)(vv.y & 0xffff); Vt[(ds + 3) * 72 + key] = (bf16_t)(vv.y >> 16);
              Vt[(ds + 4) * 72 + key] = (bf16_t)(vv.z & 0xffff); Vt[(ds + 5) * 72 + key] = (bf16_t)(vv.z >> 16);
              Vt[(ds + 6) * 72 + key] = (bf16_t)(vv.w & 0xffff); Vt[(ds + 7) * 72 + key] = (bf16_t)(vv.w >> 16);
              if (ch + 1 < nloc + 4) { const bool locn = (ch + 1) < nloc;
                  const int krow = locn ? (TC + b * SEQ + (kr + 1) * 64 + key) : (b * CTXL + (ch + 1 - nloc) * 64 + key);
                  kv = *(const u32x4*)(P + (size_t)krow * 4096 + 512 + h * 64 + ds); vv = *(const u32x4*)(P + (size_t)krow * 4096 + 1024 + h * 64 + ds); }
              __syncthreads(); }
            const bool mine = loc ? (kr >= r0 && kr < r0 + 8) : true;
            if (mine) {
                f32x4 s[4];
#pragma unroll
                for (int kb = 0; kb < 4; ++kb) { s[kb] = (f32x4){0.f, 0.f, 0.f, 0.f};
#pragma unroll
                    for (int ks = 0; ks < 2; ++ks) { const bf16x8 a = *(const LAS bf16x8*)(Ks + (kb * 16 + l15) * 72 + ks * 32 + g * 8);
                        s[kb] = __builtin_amdgcn_mfma_f32_16x16x32_bf16(a, qf[ks], s[kb], 0, 0, 0); } }
                if (loc) {
#pragma unroll
                    for (int kb = 0; kb < 4; ++kb)
#pragma unroll
                        for (int i = 0; i < 4; ++i) { const int kc = kb * 16 + 4 * g + i; const bool valid = (kc >= c0) && (kc < c0 + 16);
                            const int bi = (kr - myr + 7) * 31 + min(max(kc - wq + 15, 0), 30);
                            s[kb][i] = valid ? s[kb][i] + rp_l[bi] : -1e30f; }
                }
                float cm = -1e30f;
#pragma unroll
                for (int kb = 0; kb < 4; ++kb)
#pragma unroll
                    for (int i = 0; i < 4; ++i) cm = fmaxf(cm, s[kb][i]);
                cm = fmaxf(cm, __shfl_xor(cm, 16)); cm = fmaxf(cm, __shfl_xor(cm, 32));
                const float mn = fmaxf(mrun, cm), sc = __expf(mrun - mn);
                mrun = mn; lrun *= sc;
#pragma unroll
                for (int dt = 0; dt < 4; ++dt) oacc[dt] *= sc;
                float p[4][4];
#pragma unroll
                for (int kb = 0; kb < 4; ++kb)
#pragma unroll
                    for (int i = 0; i < 4; ++i) { p[kb][i] = __expf(s[kb][i] - mn); lrun += p[kb][i]; }
#pragma unroll
                for (int kp = 0; kp < 2; ++kp) {
                    u32x4 pw; pw.x = cvt_pk_bf16(p[2 * kp][0], p[2 * kp][1]); pw.y = cvt_pk_bf16(p[2 * kp][2], p[2 * kp][3]);
                    pw.z = cvt_pk_bf16(p[2 * kp + 1][0], p[2 * kp + 1][1]); pw.w = cvt_pk_bf16(p[2 * kp + 1][2], p[2 * kp + 1][3]);
                    bf16x8 pf; __builtin_memcpy(&pf, &pw, 16);
#pragma unroll
                    for (int dt = 0; dt < 4; ++dt) {
                        const u32x2 v0 = *(const LAS u32x2*)(Vt + (dt * 16 + l15) * 72 + (2 * kp) * 16 + 4 * g);
                        const u32x2 v1 = *(const LAS u32x2*)(Vt + (dt * 16 + l15) * 72 + (2 * kp + 1) * 16 + 4 * g);
                        u32x4 vw; vw.x = v0.x; vw.y = v0.y; vw.z = v1.x; vw.w = v1.y; bf16x8 vf; __builtin_memcpy(&vf, &vw, 16);
                        oacc[dt] = __builtin_amdgcn_mfma_f32_16x16x32_bf16(vf, pf, oacc[dt], 0, 0, 0);
                    }
                }
            }
        }
        float lt = lrun; lt += __shfl_xor(lt, 16); lt += __shfl_xor(lt, 32);
        const float inv = 1.0f / lt;
#pragma unroll
        for (int dt = 0; dt < 4; ++dt) { const f32x4 o = oacc[dt] * inv; u32x2 w; w.x = cvt_pk_bf16(o[0], o[1]); w.y = cvt_pk_bf16(o[2], o[3]);
            *(u32x2*)(F.MIX + (size_t)qrow * DM + h * 64 + dt * 16 + 4 * g) = w; }
        __syncthreads();
    }
}

__device__ __forceinline__ int hg_unit(int nb, int dir) { return dir == 0 ? nb : (nb < 2 ? 1 - nb : 2 + (HG_NU - 3 - (nb - 2))); }
__device__ __forceinline__ int hg_row(int b, int nb, int t) { return nb < 2 ? b * CTXL + nb * HG_U + t : TC + b * SEQ + (nb - 2) * HG_U + t; }
template <int CTRL> __device__ __forceinline__ float dpp_add0(float x) { return x + dppf<CTRL>(0.0f, x); }
template <bool WITHO>
__device__ __forceinline__ void hg_pass(const Frame& F, const bf16_t* P, const float* lbh, int b, int h, int nb, int dir, f32x4 (&S)[4][4], float (&Gsum)[16],
                                        LAS bf16_t* Vl, LAS bf16_t* Kl, float* OF, const float* ngp) {
    const int tau = F.lane & 15, g = F.lane >> 4;
    const unsigned vaddr = (unsigned)(size_t)Vl + (unsigned)((4 * g + (tau >> 2)) * 128 + (tau & 3) * 8);
    const unsigned kaddr = (unsigned)(size_t)Kl + (unsigned)((4 * g + (tau >> 2)) * 128 + (tau & 3) * 8);
    u32x2 zr[4], vr[4], qr[4];
    { const int t = dir ? (HG_U - 1 - tau) : tau; const bf16_t* pr = P + (size_t)hg_row(b, nb, t) * 4096 + h * 64 + 4 * g;
#pragma unroll
      for (int m = 0; m < 4; ++m) { zr[m] = *(const u32x2*)(pr + (dir ? 2560 : 2048) + 16 * m); vr[m] = *(const u32x2*)(pr + 3072 + 16 * m); } }
    for (int ci = 0; ci < HG_U / 16; ++ci) {
        float kk[16], c[16];
        if (WITHO) { const int pos = ci * 16 + tau, t = dir ? (HG_U - 1 - pos) : pos; const bf16_t* pr = P + (size_t)hg_row(b, nb, t) * 4096 + h * 64 + 4 * g;
#pragma unroll
            for (int m = 0; m < 4; ++m) qr[m] = *(const u32x2*)(pr + 1536 + 16 * m); }
#pragma unroll
        for (int m = 0; m < 4; ++m) { const float z0 = __uint_as_float(zr[m].x << 16), z1 = __uint_as_float(zr[m].x & 0xffff0000u), z2 = __uint_as_float(zr[m].y << 16), z3 = __uint_as_float(zr[m].y & 0xffff0000u);
            const float zz[4] = {z0, z1, z2, z3};
            const f32x4 lb4 = *(const f32x4*)(lbh + 16 * m + 4 * g);
#pragma unroll
            for (int i = 0; i < 4; ++i) { const float lb = lb4[i]; const float f = fmaxf(lb + (1.0f - lb) * sigmoidf_(zz[i]), 1e-30f); kk[m * 4 + i] = 1.0f - f; c[m * 4 + i] = __logf(f); }
            *(LAS u32x2*)(Vl + tau * 64 + 16 * m + 4 * g) = vr[m];
 }
        if (ci + 1 < HG_U / 16) { const int pos = (ci + 1) * 16 + tau, t = dir ? (HG_U - 1 - pos) : pos; const bf16_t* pr = P + (size_t)hg_row(b, nb, t) * 4096 + h * 64 + 4 * g;
#pragma unroll
            for (int m = 0; m < 4; ++m) { zr[m] = *(const u32x2*)(pr + (dir ? 2560 : 2048) + 16 * m); vr[m] = *(const u32x2*)(pr + 3072 + 16 * m); } }
#pragma unroll
        for (int q = 0; q < 16; ++q) { c[q] = dpp_add0<0x111>(c[q]); c[q] = dpp_add0<0x112>(c[q]); c[q] = dpp_add0<0x114>(c[q]); c[q] = dpp_add0<0x118>(c[q]); }
        float G[16];
#pragma unroll
        for (int q = 0; q < 16; ++q) { G[q] = __shfl(c[q], (F.lane & 48) | 15); Gsum[q] += G[q]; }
#pragma unroll
        for (int m = 0; m < 4; ++m) { float kh[4];
#pragma unroll
            for (int i = 0; i < 4; ++i) kh[i] = kk[m * 4 + i] * __expf(G[m * 4 + i] - c[m * 4 + i]);
            u32x2 w; w.x = cvt_pk_bf16(kh[0], kh[1]); w.y = cvt_pk_bf16(kh[2], kh[3]);
            *(LAS u32x2*)(Kl + tau * 64 + 16 * m + 4 * g) = w; }
        float ofv[4][4], gtv[4][4]; int orow[4];
        if (WITHO) {
#pragma unroll
            for (int i = 0; i < 4; ++i) { const int p2 = ci * 16 + 4 * g + i, t2 = dir ? (HG_U - 1 - p2) : p2; orow[i] = hg_row(b, nb, t2); }
            if (dir) {
#pragma unroll
                for (int i = 0; i < 4; ++i)
#pragma unroll
                    for (int vt = 0; vt < 4; ++vt) { ofv[i][vt] = OF[(size_t)orow[i] * 512 + h * 64 + 16 * vt + tau]; gtv[i][vt] = bf2f(P[(size_t)orow[i] * 4096 + 3584 + h * 64 + 16 * vt + tau]); }
            }
        }
        asm volatile("s_waitcnt lgkmcnt(0)" ::: "memory");
        u32x2 vtr[4], ktr[4];
        asm volatile("ds_read_b64_tr_b16 %0, %8\n\tds_read_b64_tr_b16 %1, %8 offset:32\n\tds_read_b64_tr_b16 %2, %8 offset:64\n\tds_read_b64_tr_b16 %3, %8 offset:96\n\t"
                     "ds_read_b64_tr_b16 %4, %9\n\tds_read_b64_tr_b16 %5, %9 offset:32\n\tds_read_b64_tr_b16 %6, %9 offset:64\n\tds_read_b64_tr_b16 %7, %9 offset:96\n\ts_waitcnt lgkmcnt(0)"
                     : "=&v"(vtr[0]), "=&v"(vtr[1]), "=&v"(vtr[2]), "=&v"(vtr[3]), "=&v"(ktr[0]), "=&v"(ktr[1]), "=&v"(ktr[2]), "=&v"(ktr[3]) : "v"(vaddr), "v"(kaddr) : "memory");
        bf16x8 Vf[4], Kf[4];
#pragma unroll
        for (int q = 0; q < 4; ++q) { u32x4 w; w.x = vtr[q].x; w.y = vtr[q].y; w.z = 0u; w.w = 0u; __builtin_memcpy(&Vf[q], &w, 16); u32x4 w2; w2.x = ktr[q].x; w2.y = ktr[q].y; w2.z = 0u; w2.w = 0u; __builtin_memcpy(&Kf[q], &w2, 16); }
        if (WITHO) {
            bf16x8 Ktf[2], Qtf[2], Qhf[2];
#pragma unroll
            for (int ks = 0; ks < 2; ++ks) { float kt_[8], qt_[8], qh_[8];
#pragma unroll
                for (int mm = 0; mm < 2; ++mm) { const int m = 2 * ks + mm;
                    const float qq[4] = {__uint_as_float(qr[m].x << 16), __uint_as_float(qr[m].x & 0xffff0000u), __uint_as_float(qr[m].y << 16), __uint_as_float(qr[m].y & 0xffff0000u)};
#pragma unroll
                    for (int i = 0; i < 4; ++i) { const int q = m * 4 + i; const float qv = siluf_(qq[i]) * 0.125f; const float d = fminf(fmaxf(c[q] - 0.5f * G[q], -80.0f), 80.0f);
                        qt_[mm * 4 + i] = qv * __expf(d); kt_[mm * 4 + i] = kk[q] * __expf(-d); qh_[mm * 4 + i] = qv * __expf(c[q]); } }
                u32x4 w; w.x = cvt_pk_bf16(kt_[0], kt_[1]); w.y = cvt_pk_bf16(kt_[2], kt_[3]); w.z = cvt_pk_bf16(kt_[4], kt_[5]); w.w = cvt_pk_bf16(kt_[6], kt_[7]); __builtin_memcpy(&Ktf[ks], &w, 16);
                w.x = cvt_pk_bf16(qt_[0], qt_[1]); w.y = cvt_pk_bf16(qt_[2], qt_[3]); w.z = cvt_pk_bf16(qt_[4], qt_[5]); w.w = cvt_pk_bf16(qt_[6], qt_[7]); __builtin_memcpy(&Qtf[ks], &w, 16);
                w.x = cvt_pk_bf16(qh_[0], qh_[1]); w.y = cvt_pk_bf16(qh_[2], qh_[3]); w.z = cvt_pk_bf16(qh_[4], qh_[5]); w.w = cvt_pk_bf16(qh_[6], qh_[7]); __builtin_memcpy(&Qhf[ks], &w, 16); }
            f32x4 AT = (f32x4){0.f, 0.f, 0.f, 0.f};
            AT = __builtin_amdgcn_mfma_f32_16x16x32_bf16(Ktf[0], Qtf[0], AT, 0, 0, 0); AT = __builtin_amdgcn_mfma_f32_16x16x32_bf16(Ktf[1], Qtf[1], AT, 0, 0, 0);
#pragma unroll
            for (int i = 0; i < 4; ++i) AT[i] = (4 * g + i <= tau) ? AT[i] : 0.0f;
            bf16x8 Af; { u32x4 w; w.x = cvt_pk_bf16(AT[0], AT[1]); w.y = cvt_pk_bf16(AT[2], AT[3]); w.z = 0u; w.w = 0u; __builtin_memcpy(&Af, &w, 16); }
            f32x4 o[4];
#pragma unroll
            for (int vt = 0; vt < 4; ++vt) { o[vt] = __builtin_amdgcn_mfma_f32_16x16x32_bf16(Af, Vf[vt], (f32x4){0.f, 0.f, 0.f, 0.f}, 0, 0, 0);
#pragma unroll
                for (int ks = 0; ks < 2; ++ks) { u32x4 w; w.x = cvt_pk_bf16(S[2 * ks][vt][0], S[2 * ks][vt][1]); w.y = cvt_pk_bf16(S[2 * ks][vt][2], S[2 * ks][vt][3]);
                    w.z = cvt_pk_bf16(S[2 * ks + 1][vt][0], S[2 * ks + 1][vt][1]); w.w = cvt_pk_bf16(S[2 * ks + 1][vt][2], S[2 * ks + 1][vt][3]); bf16x8 Sf; __builtin_memcpy(&Sf, &w, 16);
                    o[vt] = __builtin_amdgcn_mfma_f32_16x16x32_bf16(Qhf[ks], Sf, o[vt], 0, 0, 0); } }
            if (dir == 0) {
#pragma unroll
                for (int i = 0; i < 4; ++i)
#pragma unroll
                    for (int vt = 0; vt < 4; ++vt) OF[(size_t)orow[i] * 512 + h * 64 + 16 * vt + tau] = o[vt][i];
            } else {
#pragma unroll
                for (int i = 0; i < 4; ++i) { float tot[4]; float sq = 0.f;
#pragma unroll
                    for (int vt = 0; vt < 4; ++vt) { tot[vt] = o[vt][i] + ofv[i][vt]; sq = fmaf(tot[vt], tot[vt], sq); }
                    sq += dppf<0xB1>(sq, sq); sq += dppf<0x4E>(sq, sq); sq += dppf<0x141>(sq, sq); sq += dppf<0x140>(sq, sq);
                    const float rs = rsqrtf(sq * (1.0f / 64.0f) + 1e-6f);
#pragma unroll
                    for (int vt = 0; vt < 4; ++vt) F.MIX[(size_t)orow[i] * DM + 512 + h * 64 + 16 * vt + tau] = f2bf(tot[vt] * rs * ngp[16 * vt + tau] * siluf_(gtv[i][vt])); }
            }
        }
#pragma unroll
        for (int kt = 0; kt < 4; ++kt) { f32x4 eg;
#pragma unroll
            for (int i = 0; i < 4; ++i) eg[i] = __expf(G[kt * 4 + i]);
#pragma unroll
            for (int vt = 0; vt < 4; ++vt) S[kt][vt] = __builtin_amdgcn_mfma_f32_16x16x32_bf16(Kf[kt], Vf[vt], S[kt][vt] * eg, 0, 0, 0); }
    }
}
__device__ __forceinline__ void ph_hg_a(const Frame& F, int j) {
    const bf16_t* P = (const bf16_t*)(F.R1 + R1_P);
    float* SLOC = (float*)(F.R1 + R1_SLOC); float* DL = (float*)(F.R1 + R1_DL);
    LAS bf16_t* Vl = (LAS bf16_t*)(F.lds + 32768 + F.wave * 4096); LAS bf16_t* Kl = Vl + 1024;
    const int gw = F.wg * 8 + F.wave, nw = F.G * 8;
    const int NT = NBAT * 8 * HG_NU * 2;
    for (int task = gw; task < NT; task += nw) {
        const int dir = task & 1, nb = (task >> 1) % HG_NU, bh = (task >> 1) / HG_NU, b = bh >> 3, h = bh & 7;
        const float* lbh = (const float*)(F.ws + OFF_LBT) + (j * 2 + dir) * 512 + h * 64;
        f32x4 S[4][4];
#pragma unroll
        for (int kt = 0; kt < 4; ++kt)
#pragma unroll
            for (int vt = 0; vt < 4; ++vt) S[kt][vt] = (f32x4){0.f, 0.f, 0.f, 0.f};
        float Gsum[16];
#pragma unroll
        for (int q = 0; q < 16; ++q) Gsum[q] = 0.f;
        hg_pass<false>(F, P, lbh, b, h, nb, dir, S, Gsum, Vl, Kl, nullptr, nullptr);
        const int seq = bh * 2 + dir, u = hg_unit(nb, dir);
        float* so = SLOC + ((size_t)seq * HG_NU + u) * 4096;
#pragma unroll
        for (int kt = 0; kt < 4; ++kt)
#pragma unroll
            for (int vt = 0; vt < 4; ++vt)
#pragma unroll
                for (int i = 0; i < 4; ++i) so[((kt * 4 + vt) * 4 + i) * 64 + F.lane] = S[kt][vt][i];
        if ((F.lane & 15) == 0) { float* dd = DL + ((size_t)seq * HG_NU + u) * 64;
#pragma unroll
            for (int m = 0; m < 4; ++m)
#pragma unroll
                for (int i = 0; i < 4; ++i) dd[16 * m + 4 * (F.lane >> 4) + i] = __expf(Gsum[m * 4 + i]); }
    }
}
__device__ __forceinline__ void ph_hg_b(const Frame& F) {
    const float* SLOC = (const float*)(F.R1 + R1_SLOC); const float* DL = (const float*)(F.R1 + R1_DL); float* SST = (float*)(F.R1 + R1_SST);
    for (int idx = F.wg * 512 + F.tid; idx < 64 * 4096; idx += F.G * 512) {
        const int seq = idx >> 12, e = idx & 4095, ln = e & 63, reg = e >> 6, i = reg & 3, kt = reg >> 4, k = 16 * kt + 4 * (ln >> 4) + i;
        float s = 0.f;
#pragma unroll 6
        for (int u = 0; u < HG_NU; ++u) { const size_t o = ((size_t)seq * HG_NU + u) * 4096 + e; SST[o] = s; s = DL[((size_t)seq * HG_NU + u) * 64 + k] * s + SLOC[o]; }
    }
}
__device__ __forceinline__ void ph_hg_c(const Frame& F, int j) {
    const bf16_t* P = (const bf16_t*)(F.R1 + R1_P);
    const float* SST = (const float*)(F.R1 + R1_SST); float* OF = (float*)(F.R1 + R1_OF);
    const float* ng = inp(F, 12) + j * 64;
    LAS bf16_t* Vl = (LAS bf16_t*)(F.lds + 32768 + F.wave * 4096); LAS bf16_t* Kl = Vl + 1024;
    const int gw = F.wg * 8 + F.wave, nw = F.G * 8;
    const int NT = NBAT * 8 * HG_NU;
    for (int task = gw; task < NT; task += nw) {
        const int nb = task % HG_NU, bh = task / HG_NU, b = bh >> 3, h = bh & 7;
        for (int dir = 0; dir < 2; ++dir) {
            const float* lbh = (const float*)(F.ws + OFF_LBT) + (j * 2 + dir) * 512 + h * 64;
            const int seq = bh * 2 + dir, u = hg_unit(nb, dir);
            const float* ss = SST + ((size_t)seq * HG_NU + u) * 4096;
            f32x4 S[4][4];
#pragma unroll
            for (int kt = 0; kt < 4; ++kt)
#pragma unroll
                for (int vt = 0; vt < 4; ++vt)
#pragma unroll
                    for (int i = 0; i < 4; ++i) S[kt][vt][i] = ss[((kt * 4 + vt) * 4 + i) * 64 + F.lane];
            float Gsum[16];
#pragma unroll
            for (int q = 0; q < 16; ++q) Gsum[q] = 0.f;
            hg_pass<true>(F, P, lbh, b, h, nb, dir, S, Gsum, Vl, Kl, OF, ng);
            asm volatile("s_waitcnt vmcnt(0)" ::: "memory");
        }
    }
}

__device__ __forceinline__ int lru_nat(int so, int dir) { return dir == 0 ? so : (so < 16 ? 15 - so : 16 + (LRU_NT - 1 - so)); }
__device__ __forceinline__ int lru_row(int b, int nt, int t) { return nt < 16 ? b * CTXL + nt * 16 + t : TC + b * SEQ + (nt - 16) * 16 + t; }
struct LruRaw { u32x4 a[4], b[4]; };
__device__ __forceinline__ void lru_load(const Frame& F, int b, int kb, int nt, LruRaw& R) {
    const bf16_t* P = (const bf16_t*)(F.R1 + R1_P);
    const int tk = F.lane & 15, g = F.lane >> 4;
    const int len = nt < 16 ? CTXL : SEQ, tpos = (nt < 16 ? nt * 16 : (nt - 16) * 16) + tk;
    const bf16_t* pbase = P + (size_t)((nt < 16 ? b * CTXL : TC + b * SEQ)) * 2048 + 1024 + kb * 64 + g * 16;
#pragma unroll
    for (int tap = 0; tap < 4; ++tap) { const int tp = tpos + tap - 2; const bool ok = (tp >= 0 && tp < len); const bf16_t* pr = pbase + (size_t)(ok ? tp : tpos) * 2048;
        R.a[tap] = *(const u32x4*)pr; R.b[tap] = *(const u32x4*)(pr + 8); if (!ok) { R.a[tap] = (u32x4){0u, 0u, 0u, 0u}; R.b[tap] = (u32x4){0u, 0u, 0u, 0u}; } }
}
__device__ __forceinline__ void lru_conv(const Frame& F, const LruRaw& R, const LAS float* CT, LAS float* ucb) {
    const int tk = F.lane & 15, g = F.lane >> 4;
    float acc[16];
#pragma unroll
    for (int q = 0; q < 4; ++q) { const f32x4 c4 = *(const LAS f32x4*)(CT + 4 * 64 + g * 16 + q * 4); acc[q * 4] = c4[0]; acc[q * 4 + 1] = c4[1]; acc[q * 4 + 2] = c4[2]; acc[q * 4 + 3] = c4[3]; }
#pragma unroll
    for (int tap = 0; tap < 4; ++tap) { float t0[8], t1[8]; unpack8(R.a[tap], t0); unpack8(R.b[tap], t1);
#pragma unroll
        for (int q = 0; q < 2; ++q) { const f32x4 w0 = *(const LAS f32x4*)(CT + tap * 64 + g * 16 + q * 4), w1 = *(const LAS f32x4*)(CT + tap * 64 + g * 16 + 8 + q * 4);
#pragma unroll
            for (int i = 0; i < 4; ++i) { acc[q * 4 + i] = fmaf(w0[i], t0[q * 4 + i], acc[q * 4 + i]); acc[8 + q * 4 + i] = fmaf(w1[i], t1[q * 4 + i], acc[8 + q * 4 + i]); } } }
#pragma unroll
    for (int q = 0; q < 4; ++q) *(LAS f32x4*)(ucb + tk * 64 + g * 16 + q * 4) = (f32x4){acc[q * 4], acc[q * 4 + 1], acc[q * 4 + 2], acc[q * 4 + 3]};
}
__device__ __forceinline__ void lru_gates(const Frame& F, LAS bf16_t* Wl, const LAS float* CT, LAS float* ucb, float (&av)[2][4][4], float (&xv)[2][4][4]) {
    const int tk = F.lane & 15, g = F.lane >> 4;
    bf16x8 bfr[2];
#pragma unroll
    for (int ks = 0; ks < 2; ++ks) { const f32x4 u0 = *(const LAS f32x4*)(ucb + tk * 64 + ks * 32 + g * 8), u1 = *(const LAS f32x4*)(ucb + tk * 64 + ks * 32 + g * 8 + 4);
        u32x4 w; w.x = cvt_pk_bf16(u0[0], u0[1]); w.y = cvt_pk_bf16(u0[2], u0[3]); w.z = cvt_pk_bf16(u1[0], u1[1]); w.w = cvt_pk_bf16(u1[2], u1[3]); __builtin_memcpy(&bfr[ks], &w, 16); }
#pragma unroll
    for (int d = 0; d < 2; ++d)
#pragma unroll
        for (int et = 0; et < 4; ++et) {
            f32x4 ra = (f32x4){0.f, 0.f, 0.f, 0.f}, ri = (f32x4){0.f, 0.f, 0.f, 0.f};
#pragma unroll
            for (int ks = 0; ks < 2; ++ks) {
                const bf16x8 wa = *(const LAS bf16x8*)(Wl + ((d * 2 + 0) * 64 + et * 16 + tk) * 64 + ks * 32 + g * 8);
                const bf16x8 wx = *(const LAS bf16x8*)(Wl + ((d * 2 + 1) * 64 + et * 16 + tk) * 64 + ks * 32 + g * 8);
                ra = __builtin_amdgcn_mfma_f32_16x16x32_bf16(wa, bfr[ks], ra, 0, 0, 0);
                ri = __builtin_amdgcn_mfma_f32_16x16x32_bf16(wx, bfr[ks], ri, 0, 0, 0);
            }
            const f32x4 ba4 = *(const LAS f32x4*)(CT + (5 + 3 * d) * 64 + et * 16 + 4 * g), bx4 = *(const LAS f32x4*)(CT + (6 + 3 * d) * 64 + et * 16 + 4 * g), cs4 = *(const LAS f32x4*)(CT + (7 + 3 * d) * 64 + et * 16 + 4 * g);
            const f32x4 u4 = *(const LAS f32x4*)(ucb + tk * 64 + et * 16 + 4 * g);
#pragma unroll
            for (int i = 0; i < 4; ++i) {
                const float r = sigmoidf_(ra[i] + ba4[i]), ig = sigmoidf_(ri[i] + bx4[i]);
                const float a = __expf(cs4[i] * r);
                av[d][et][i] = a; xv[d][et][i] = sqrtf(fmaxf(1.0f - a * a, 0.f)) * ig * u4[i]; }
        }
}
template <int S> __device__ __forceinline__ void lru_step_f(float& a, float& x) { const float ap = dppf<0x110 + S>(1.0f, a), xp = dppf<0x110 + S>(0.0f, x); x = fmaf(a, xp, x); a = a * ap; }
template <int S> __device__ __forceinline__ void lru_step_b(float& a, float& x) { const float ap = dppf<0x100 + S>(1.0f, a), xp = dppf<0x100 + S>(0.0f, x); x = fmaf(a, xp, x); a = a * ap; }
template <bool FINAL>
__device__ __forceinline__ void ph_lru_ac(const Frame& F, int jj) {
    LAS bf16_t* Wl = (LAS bf16_t*)F.lds;
    LAS float* ucb = (LAS float*)(F.lds + 32768 + F.wave * 4096);
    LAS float* CT = (LAS float*)(F.lds + 65536);
    const bf16_t* wsrc = (const bf16_t*)(F.WB + WB_LRU);
    float* AG = (float*)(F.R1 + R1_AG); const float* HST = (const float*)(F.R1 + R1_HST);
    const bf16_t* P = (const bf16_t*)(F.R1 + R1_P);
    const float* cw = inp(F, 14) + (size_t)jj * 4 * 1024; const float* cb = inp(F, 15) + (size_t)jj * 1024;
    const float* b_a = inp(F, 17) + (size_t)jj * 2 * 1024; const float* b_x = inp(F, 19) + (size_t)jj * 2 * 1024; const float* lam = inp(F, 20) + (size_t)jj * 2 * 1024;
    const int tk = F.lane & 15, g = F.lane >> 4;
    const int NTASK = NBAT * 16 * 11;
    for (int task = F.wg; task < NTASK; task += F.G) {
        const int grp = task % 11, kb = (task / 11) & 15, b = task / (11 * 16);
        __syncthreads();
        for (int i = F.tid; i < 4 * 4096 / 8; i += 512) { const int mg = i >> 9, r = i & 511;
            *(LAS u32x4*)(Wl + mg * 4096 + r * 8) = *(const u32x4*)(wsrc + ((size_t)mg * 16 + kb) * 4096 + r * 8); }
        for (int i = F.tid; i < 11 * 64; i += 512) { const int kind = i >> 6, ch = kb * 64 + (i & 63); float v;
            if (kind < 4) v = cw[kind * 1024 + ch]; else if (kind == 4) v = cb[ch];
            else { const int d = (kind - 5) / 3, w = (kind - 5) % 3; v = (w == 0) ? b_a[d * 1024 + ch] : (w == 1) ? b_x[d * 1024 + ch] : -8.0f * log1pf(__expf(-lam[d * 1024 + ch])); }
            CT[i] = v; }
        __syncthreads();
        const int nt0 = grp * 48;
        LruRaw raw; lru_load(F, b, kb, nt0 + F.wave, raw);
        for (int ti = F.wave; ti < 48; ti += 8) {
            const int nt = nt0 + ti;
            float av[2][4][4], xv[2][4][4];
            if (FINAL && ti != F.wave) lru_load(F, b, kb, nt, raw);
            lru_conv(F, raw, CT, ucb);
            if (!FINAL && ti + 8 < 48) lru_load(F, b, kb, nt + 8, raw);
            const int row = lru_row(b, nt, tk);
            lru_gates(F, Wl, CT, ucb, av, xv);
            u32x2 yw[4];
            if (FINAL) {
#pragma unroll
                for (int et = 0; et < 4; ++et) yw[et] = *(const u32x2*)(P + (size_t)row * 2048 + kb * 64 + et * 16 + 4 * g);
            }
#pragma unroll
            for (int et = 0; et < 4; ++et)
#pragma unroll
                for (int i = 0; i < 4; ++i) {
                    lru_step_f<1>(av[0][et][i], xv[0][et][i]); lru_step_f<2>(av[0][et][i], xv[0][et][i]); lru_step_f<4>(av[0][et][i], xv[0][et][i]); lru_step_f<8>(av[0][et][i], xv[0][et][i]);
                    lru_step_b<1>(av[1][et][i], xv[1][et][i]); lru_step_b<2>(av[1][et][i], xv[1][et][i]); lru_step_b<4>(av[1][et][i], xv[1][et][i]); lru_step_b<8>(av[1][et][i], xv[1][et][i]);
                }
            if (!FINAL) {
#pragma unroll
                for (int d = 0; d < 2; ++d) if (tk == (d ? 0 : 15)) {
                    float* ag = AG + (((size_t)(b * 2 + d) * LRU_NT + nt) * 2) * 1024 + kb * 64;
#pragma unroll
                    for (int et = 0; et < 4; ++et) { *(f32x4*)(ag + et * 16 + 4 * g) = (f32x4){av[d][et][0], av[d][et][1], av[d][et][2], av[d][et][3]};
                        *(f32x4*)(ag + 1024 + et * 16 + 4 * g) = (f32x4){xv[d][et][0], xv[d][et][1], xv[d][et][2], xv[d][et][3]}; }
                }
            } else {
                f32x4 hf[4], hb[4];
#pragma unroll
                for (int et = 0; et < 4; ++et) { const int ch = kb * 64 + et * 16 + 4 * g;
                    hf[et] = *(const f32x4*)(HST + ((size_t)(b * 2 + 0) * LRU_NT + nt) * 1024 + ch);
                    hb[et] = *(const f32x4*)(HST + ((size_t)(b * 2 + 1) * LRU_NT + nt) * 1024 + ch); }
#pragma unroll
                for (int et = 0; et < 4; ++et) {
                    const int ch = kb * 64 + et * 16 + 4 * g;
                    const float y0 = __uint_as_float(yw[et].x << 16), y1 = __uint_as_float(yw[et].x & 0xffff0000u), y2 = __uint_as_float(yw[et].y << 16), y3 = __uint_as_float(yw[et].y & 0xffff0000u);
                    float o[4];
#pragma unroll
                    for (int i = 0; i < 4; ++i) o[i] = fmaf(av[0][et][i], hf[et][i], xv[0][et][i]) + fmaf(av[1][et][i], hb[et][i], xv[1][et][i]);
                    o[0] *= gelu_tanh_(y0); o[1] *= gelu_tanh_(y1); o[2] *= gelu_tanh_(y2); o[3] *= gelu_tanh_(y3);
                    u32x2 w; w.x = cvt_pk_bf16(o[0], o[1]); w.y = cvt_pk_bf16(o[2], o[3]);
                    *(u32x2*)(F.MIX + (size_t)row * DM + ch) = w;
                }
            }
        }
    }
    __syncthreads();
}
__device__ __forceinline__ void ph_lru_b(const Frame& F) {
    const float* AG = (const float*)(F.R1 + R1_AG); float* HST = (float*)(F.R1 + R1_HST);
    LAS float* sa = (LAS float*)F.lds; LAS float* sx = sa + 512;
    for (int task = F.wg; task < NBAT * 2 * 32; task += F.G) {
        const int cgp = task & 31, d = (task >> 5) & 1, b = task >> 6;
        const int ch = cgp * 32 + (F.tid & 31), seg = F.tid >> 5;
        const float* ag = AG + ((size_t)(b * 2 + d) * LRU_NT) * 2048 + ch;
        float A = 1.0f, Xv = 0.f;
        for (int i = 0; i < 33; ++i) { const int nt = lru_nat(seg * 33 + i, d); const float a = ag[(size_t)nt * 2048], x = ag[(size_t)nt * 2048 + 1024]; Xv = fmaf(a, Xv, x); A *= a; }
        __syncthreads();
        sa[F.tid] = A; sx[F.tid] = Xv;
        __syncthreads();
        float h = 0.f;
        for (int s2 = 0; s2 < seg; ++s2) h = fmaf(sa[s2 * 32 + (F.tid & 31)], h, sx[s2 * 32 + (F.tid & 31)]);
        float* hs = HST + ((size_t)(b * 2 + d) * LRU_NT) * 1024 + ch;
        for (int i = 0; i < 33; ++i) { const int nt = lru_nat(seg * 33 + i, d); hs[(size_t)nt * 1024] = h; const float a = ag[(size_t)nt * 2048], x = ag[(size_t)nt * 2048 + 1024]; h = fmaf(a, h, x); }
    }
    __syncthreads();
}

__device__ __forceinline__ void topk_better(float& bk, int& be, float& bs, float ok, int oe, float os) { const bool t = (ok > bk) || (ok == bk && oe < be); bk = t ? ok : bk; be = t ? oe : be; bs = t ? os : bs; }
template <int CTRL> __device__ __forceinline__ void topk_step(float& bk, int& be, float& bs) {
    const float ok = dppf<CTRL>(bk, bk), os = dppf<CTRL>(bs, bs); const int oe = __builtin_amdgcn_update_dpp(be, be, CTRL, 0xf, 0xf, false); topk_better(bk, be, bs, ok, oe, os); }
__device__ __forceinline__ void ph_ln_router(const Frame& F, int l, bool dry = false) {
    const bf16_t* RW = (const bf16_t*)(F.WB + WB_RT);
    const float* rbias = inp(F, 23) + l * 64;
    LAS float* part = (LAS float*)F.lds;
    LAS float* LP = (LAS float*)(F.lds + 4096);
    LAS int* hist = (LAS int*)(F.lds + LDS_MISC + MISC_HIST); LAS int* hbase = (LAS int*)(F.lds + LDS_MISC + MISC_HBASE);
    int* tok_e = (int*)(F.ws + OFF_TOKE); int* tok_p = (int*)(F.ws + OFF_TOKP); float* tok_w = (float*)(F.ws + OFF_TOKW);
    int* stok = (int*)(F.ws + OFF_STOK); float* sw = (float*)(F.ws + OFF_SW);
    float* stats = (float*)(F.ws + OFF_STATS);
    unsigned* gcnt = (unsigned*)(F.ws + OFF_CTL + CTL_CNT) + l * 64;
    const int tk = F.lane & 15, g = F.lane >> 4;
    float rb[4];
#pragma unroll
    for (int q = 0; q < 4; ++q) rb[q] = rbias[tk + 16 * q];
    if (F.tid < 64) hist[F.tid] = 0;
    __syncthreads();
    const int NTILE = TT / 16;
    for (int tile = F.wg; tile < NTILE; tile += F.G) {
        const int row = tile * 16 + tk; const int s = slot_of_row(tile * 16);
        const float* ab = (const float*)(F.ws + OFF_AB) + (size_t)(l * 5 + s) * 2048;
        const float* xr = F.X + (size_t)row * DM + F.wave * 128 + g * 8;
        f32x4 v[4][2];
#pragma unroll
        for (int ks = 0; ks < 4; ++ks) { v[ks][0] = *(const f32x4*)(xr + ks * 32); v[ks][1] = *(const f32x4*)(xr + ks * 32 + 4); }
        float sum = 0.f, sq = 0.f;
#pragma unroll
        for (int ks = 0; ks < 4; ++ks)
#pragma unroll
            for (int hh = 0; hh < 2; ++hh) { const f32x4 a = v[ks][hh]; sum += (a[0] + a[1]) + (a[2] + a[3]); sq += (a[0] * a[0] + a[1] * a[1]) + (a[2] * a[2] + a[3] * a[3]); }
        sum += __shfl_xor(sum, 16); sum += __shfl_xor(sum, 32); sq += __shfl_xor(sq, 16); sq += __shfl_xor(sq, 32);
        if (g == 0) *(LAS f32x2*)(part + (F.wave * 16 + tk) * 2) = (f32x2){sum, sq};
        __syncthreads();
        float ts = 0.f, tq = 0.f;
#pragma unroll
        for (int w = 0; w < 8; ++w) { const f32x2 p = *(const LAS f32x2*)(part + (w * 16 + tk) * 2); ts += p.x; tq += p.y; }
        const float mean = ts * (1.0f / 1024.0f), var = fmaxf(tq * (1.0f / 1024.0f) - mean * mean, 0.f), rstd = rsqrtf(var + 1e-5f);
        if (F.wave == 0 && g == 0) *(f32x2*)(stats + (size_t)row * 2) = (f32x2){mean, rstd};
        f32x4 acc[4];
#pragma unroll
        for (int et = 0; et < 4; ++et) acc[et] = (f32x4){0.f, 0.f, 0.f, 0.f};
#pragma unroll
        for (int ks = 0; ks < 4; ++ks) { const int k = F.wave * 128 + ks * 32 + g * 8;
            const f32x4 a10 = *(const f32x4*)(ab + k), a11 = *(const f32x4*)(ab + k + 4), b10 = *(const f32x4*)(ab + 1024 + k), b11 = *(const f32x4*)(ab + 1024 + k + 4);
            const f32x4 h0 = (v[ks][0] - mean) * rstd * a10 + b10, h1 = (v[ks][1] - mean) * rstd * a11 + b11;
            u32x4 w; w.x = cvt_pk_bf16(h0[0], h0[1]); w.y = cvt_pk_bf16(h0[2], h0[3]); w.z = cvt_pk_bf16(h1[0], h1[1]); w.w = cvt_pk_bf16(h1[2], h1[3]);
            *(u32x4*)(F.HB + (size_t)row * DM + k) = w;
            bf16x8 af; __builtin_memcpy(&af, &w, 16);
#pragma unroll
            for (int et = 0; et < 4; ++et) { const bf16x8 bf = *(const bf16x8*)(RW + (size_t)(et * 16 + tk) * 1024 + k); acc[et] = __builtin_amdgcn_mfma_f32_16x16x32_bf16(af, bf, acc[et], 0, 0, 0); }
        }
#pragma unroll
        for (int et = 0; et < 4; ++et)
#pragma unroll
            for (int i = 0; i < 4; ++i) LP[(F.wave * 16 + 4 * g + i) * 64 + et * 16 + tk] = acc[et][i];
        __syncthreads();
        {
            const int t = 2 * F.wave + (g & 1), r2 = tile * 16 + t;
            float sc[4], key[4];
#pragma unroll
            for (int q = 0; q < 4; ++q) { float lgt = 0.f;
#pragma unroll
                for (int w = 0; w < 8; ++w) lgt += LP[(w * 16 + t) * 64 + tk + 16 * q];
                sc[q] = sigmoidf_(lgt); key[q] = sc[q] + rb[q]; }
            unsigned taken = 0u; int se[6]; float ss[6]; float tot = 0.f;
#pragma unroll
            for (int sel = 0; sel < 6; ++sel) {
                float bk = -1e30f, bs = 0.f; int be = 0;
#pragma unroll
                for (int q = 0; q < 4; ++q) if (!((taken >> q) & 1u) && key[q] > bk) { bk = key[q]; be = tk + 16 * q; bs = sc[q]; }
                topk_step<0xB1>(bk, be, bs); topk_step<0x4E>(bk, be, bs); topk_step<0x141>(bk, be, bs); topk_step<0x140>(bk, be, bs);
                if ((be & 15) == tk) taken |= 1u << (be >> 4);
                se[sel] = be; ss[sel] = bs; tot += bs;
            }
            const float sc2 = 2.5f / tot;
            if (tk < 6 && g < 2) {
                int e = se[0]; float w = ss[0];
#pragma unroll
                for (int q = 1; q < 6; ++q) if (tk == q) { e = se[q]; w = ss[q]; }
                tok_e[r2 * 8 + tk] = e; tok_w[r2 * 8 + tk] = w * sc2; if (!dry) tok_p[r2 * 8 + tk] = __hip_atomic_fetch_add(hist + e, 1, __ATOMIC_RELAXED, __HIP_MEMORY_SCOPE_WORKGROUP);
            }
        }
    }
    asm volatile("s_waitcnt vmcnt(0) lgkmcnt(0)" ::: "memory");
    __syncthreads();
    if (dry) return;
    if (F.tid < 64) hbase[F.tid] = (int)__hip_atomic_fetch_add(gcnt + F.tid, (unsigned)hist[F.tid], __ATOMIC_RELAXED, __HIP_MEMORY_SCOPE_AGENT);
    __syncthreads();
    for (int tile = F.wg; tile < NTILE; tile += F.G) {
        if (F.tid < 96) { const int row = tile * 16 + F.tid / 6, q = F.tid % 6; const int e = tok_e[row * 8 + q]; const int pos = hbase[e] + tok_p[row * 8 + q];
            tok_p[row * 8 + q] = pos; stok[(size_t)e * CAP + pos] = row; sw[(size_t)e * CAP + pos] = tok_w[row * 8 + q]; }
    }
    __syncthreads();
}

__device__ __forceinline__ int moe_tables(const Frame& F, int l) {
    LAS int* cnt = (LAS int*)(F.lds + LDS_MISC + MISC_CNT); LAS int* tst = (LAS int*)(F.lds + LDS_MISC + MISC_TST); LAS unsigned char* t2e = (LAS unsigned char*)(F.lds + LDS_MISC + MISC_T2E);
    const unsigned* gcnt = (const unsigned*)(F.ws + OFF_CTL + CTL_CNT) + l * 64;
    __syncthreads();
    if (F.tid < 64) cnt[F.tid] = (int)__hip_atomic_load(gcnt + F.tid, __ATOMIC_RELAXED, __HIP_MEMORY_SCOPE_AGENT);
    if (F.tid == 64) cnt[64] = TT;
    __syncthreads();
    if (F.tid == 0) { int s = 0; for (int e = 0; e < 65; ++e) { tst[e] = s; s += (cnt[e] + 255) >> 8; } tst[65] = s; }
    __syncthreads();
    const int ntiles = tst[65];
    for (int t = F.tid; t < ntiles; t += 512) { int e = 0; for (int q = 0; q < 65; ++q) if (t >= tst[q]) e = q; else break; t2e[t] = (unsigned char)e; }
    __syncthreads();
    return ntiles;
}

__device__ __forceinline__ void ph_combine(const Frame& F, int l, bool dry = false) {
    LAS int* tst = (LAS int*)(F.lds + LDS_MISC + MISC_TST);
    (void)moe_tables(F, l);
    const float* gam = inp(F, 6) + (size_t)(l * 2 + 1) * DM; const float* bet = inp(F, 7) + (size_t)(l * 2 + 1) * DM;
    const float* gam0 = inp(F, 6) + (size_t)(l * 2 + 0) * DM; const float* bet0 = inp(F, 7) + (size_t)(l * 2 + 0) * DM;
    const float* stats = (const float*)(F.ws + OFF_STATS);
    const bf16_t* Y = (const bf16_t*)(F.R1 + R1_Y);
    const int* tok_e = (const int*)(F.ws + OFF_TOKE); const int* tok_p = (const int*)(F.ws + OFF_TOKP);
    const int gw = F.wg * 8 + F.wave, nw = F.G * 8;
    const bool lastl = (l == 3);
    for (int row = gw; row < TT; row += nw) {
        const int s = slot_of_row(row);
        const float* m = F.mods + (size_t)(l * 5 + s) * 6144;
        const float* mn = F.mods + (size_t)((lastl ? l : l + 1) * 5 + s) * 6144;
        int srow[7];
#pragma unroll
        for (int q = 0; q < 6; ++q) { const int e = tok_e[row * 8 + q]; srow[q] = tst[e] * 256 + tok_p[row * 8 + q]; }
        srow[6] = tst[64] * 256 + row;
        float v[16];
#pragma unroll
        for (int hh = 0; hh < 2; ++hh) { const int k = hh * 512 + F.lane * 8;
            float y[8];
#pragma unroll
            for (int q = 0; q < 8; ++q) y[q] = 0.f;
#pragma unroll
            for (int q = 0; q < 7; ++q) { const u32x4 w = *(const u32x4*)(Y + (size_t)srow[q] * DM + k); float t[8]; unpack8(w, t);
#pragma unroll
                for (int i = 0; i < 8; ++i) y[i] += t[i]; }
            f32x4 x0 = *(const f32x4*)(F.X + (size_t)row * DM + k), x1 = *(const f32x4*)(F.X + (size_t)row * DM + k + 4);
            { const f32x2 st = *(const f32x2*)(stats + (size_t)row * 2); const f32x4 g0 = *(const f32x4*)(gam0 + k), g1 = *(const f32x4*)(gam0 + k + 4), b0 = *(const f32x4*)(bet0 + k), b1 = *(const f32x4*)(bet0 + k + 4);
              x0 = (x0 - st.x) * st.y * g0 + b0; x1 = (x1 - st.x) * st.y * g1 + b1; }
            const f32x4 m50 = *(const f32x4*)(m + 5 * 1024 + k), m51 = *(const f32x4*)(m + 5 * 1024 + k + 4);
#pragma unroll
            for (int i = 0; i < 4; ++i) { v[hh * 8 + i] = ALPHA * x0[i] + m50[i] * y[i]; v[hh * 8 + 4 + i] = ALPHA * x1[i] + m51[i] * y[4 + i]; }
        }
        float sum = 0.f;
#pragma unroll
        for (int i = 0; i < 16; ++i) sum += v[i];
        sum += __shfl_xor(sum, 1); sum += __shfl_xor(sum, 2); sum += __shfl_xor(sum, 4); sum += __shfl_xor(sum, 8); sum += __shfl_xor(sum, 16); sum += __shfl_xor(sum, 32);
        const float mean = sum * (1.0f / 1024.0f);
        float sq = 0.f;
#pragma unroll
        for (int i = 0; i < 16; ++i) { const float d = v[i] - mean; sq += d * d; }
        sq += __shfl_xor(sq, 1); sq += __shfl_xor(sq, 2); sq += __shfl_xor(sq, 4); sq += __shfl_xor(sq, 8); sq += __shfl_xor(sq, 16); sq += __shfl_xor(sq, 32);
        const float rstd = rsqrtf(sq * (1.0f / 1024.0f) + 1e-5f);
#pragma unroll
        for (int hh = 0; hh < 2; ++hh) { const int k = hh * 512 + F.lane * 8;
            float gm[8], bt[8], xn[8];
            *(f32x4*)&gm[0] = *(const f32x4*)(gam + k); *(f32x4*)&gm[4] = *(const f32x4*)(gam + k + 4);
            *(f32x4*)&bt[0] = *(const f32x4*)(bet + k); *(f32x4*)&bt[4] = *(const f32x4*)(bet + k + 4);
#pragma unroll
            for (int i = 0; i < 8; ++i) xn[i] = (v[hh * 8 + i] - mean) * rstd * gm[i] + bt[i];
            if (dry) { float acc_ = 0.f; for (int i = 0; i < 8; ++i) acc_ += xn[i]; asm volatile("" :: "v"(acc_)); }
            else if (lastl) { if (row >= TC) { float* o = F.out + (size_t)(row - TC) * DM + k; *(f32x4*)o = *(f32x4*)&xn[0]; *(f32x4*)(o + 4) = *(f32x4*)&xn[4]; } }
            else {
                *(f32x4*)(F.X + (size_t)row * DM + k) = *(f32x4*)&xn[0]; *(f32x4*)(F.X + (size_t)row * DM + k + 4) = *(f32x4*)&xn[4];
                float s1[8], b0[8];
                *(f32x4*)&s1[0] = *(const f32x4*)(mn + 1024 + k); *(f32x4*)&s1[4] = *(const f32x4*)(mn + 1024 + k + 4);
                *(f32x4*)&b0[0] = *(const f32x4*)(mn + k); *(f32x4*)&b0[4] = *(const f32x4*)(mn + k + 4);
                float hv[8];
#pragma unroll
                for (int i = 0; i < 8; ++i) hv[i] = xn[i] * (1.0f + s1[i]) + b0[i];
                u32x4 w; w.x = cvt_pk_bf16(hv[0], hv[1]); w.y = cvt_pk_bf16(hv[2], hv[3]); w.z = cvt_pk_bf16(hv[4], hv[5]); w.w = cvt_pk_bf16(hv[6], hv[7]);
                *(u32x4*)(F.HB + (size_t)row * DM + k) = w;
            }
        }
    }
}

constexpr int NPHASE = 2 + 4 * 10;
__global__ void __launch_bounds__(512, 2) mk_fwd(Args args) {
    extern __shared__ __attribute__((aligned(16))) unsigned char lds_raw[];
    Frame F;
    F.out = args.out; F.ws = args.ws; F.lds = (LAS unsigned char*)lds_raw;
    { const int t0 = threadIdx.x; F.wave = __builtin_amdgcn_readfirstlane(t0 >> 6); F.lane = t0 & 63; F.tid = t0; } F.G = gridDim.x; F.wg = blockIdx.x;
    F.mods = (float*)(args.ws + OFF_MODS); F.X = (float*)(args.ws + OFF_X); F.HB = (bf16_t*)(args.ws + OFF_HB); F.MIX = F.HB;
    F.WB = args.ws + OFF_WB; F.R1 = args.ws + OFF_R1;
    volatile LAS unsigned* xbw = (volatile LAS unsigned*)(F.lds + LDS_MISC);
    if (F.tid < 4) xbw[F.tid] = 0u;
    if (F.tid < 30) ((LAS unsigned long long*)(F.lds + LDS_MISC + MISC_INP))[F.tid] = (unsigned long long)args.in[F.tid];
    __syncthreads();
    const int lo = args.ph_lo, hi = args.ph_hi;
    XcdBarrier bar; bar.bar = (unsigned*)(args.ws + OFF_CTL); bar.x = 0; bar.st = xbw;
    if (hi - lo > 1) bar = xcd_barrier_post((unsigned*)(args.ws + OFF_CTL), xbw);
#define IN(k) (lo <= (k) && (k) < hi)
#define SEAM(k) do { if (IN(k) && IN((k) + 1)) xcd_barrier(bar); } while (0)
    if ((PHM & 1) && IN(0)) { ph_mods(fresh(F)); } SEAM(0);
    if ((PHM & 2) && IN(1)) { ph_init_x(fresh(F)); }
    for (int l = 0; l < 4; ++l) {
        const int pb = 2 + l * 10, j = l >> 1; const bool even = (l & 1) == 0;
        float* mods_l = F.mods + (size_t)l * 5 * 6144;
        if ((PHM & 4) && IN(pb + 0)) { for (int rep = 0; rep < ((REPM & 4) ? 2 : 1); ++rep) { ph_convert(fresh(F), l); __syncthreads(); } } SEAM(pb + 0);
        if ((PHM & 8) && IN(pb + 1)) {
            const int N = even ? 4096 : 2048;
            pg8::StaticOrder S; S.init(F.HB, F.WB + WB_IN, TT, N, 1024, F.G, F.wg);
            pg8::EpiStoreBf16 E{(bf16_t*)(F.R1 + R1_P), N};
            for (int rep = 0; rep < ((REPM & 8) ? 2 : 1); ++rep) pg8::gemm_phase(F.lds, 1024, S, E, F.wave);
        } SEAM(pb + 1);
        if (IN(pb + 2)) { if (even) { if (PHM & 16) for (int rep = 0; rep < ((REPM & 16) ? 2 : 1); ++rep) ph_attn(fresh(F), j); if (PHM & 32) for (int rep = 0; rep < ((REPM & 32) ? 2 : 1); ++rep) ph_hg_a(fresh(F), j); } else { if (PHM & 64) for (int rep = 0; rep < ((REPM & 64) ? 2 : 1); ++rep) ph_lru_ac<false>(fresh(F), j); } } SEAM(pb + 2);
        if (IN(pb + 3)) { if (even) { if (PHM & 128) for (int rep = 0; rep < ((REPM & 128) ? 2 : 1); ++rep) ph_hg_b(fresh(F)); } else { if (PHM & 256) for (int rep = 0; rep < ((REPM & 256) ? 2 : 1); ++rep) ph_lru_b(fresh(F)); } } SEAM(pb + 3);
        if (IN(pb + 4)) { if (even) { if (PHM & 512) for (int rep = 0; rep < ((REPM & 512) ? 2 : 1); ++rep) ph_hg_c(fresh(F), j); } else { if (PHM & 1024) for (int rep = 0; rep < ((REPM & 1024) ? 2 : 1); ++rep) ph_lru_ac<true>(fresh(F), j); } } SEAM(pb + 4);
        if ((PHM & 2048) && IN(pb + 5)) {
            pg8::StaticOrder S; S.init(F.MIX, F.WB + WB_OUT, TT, 1024, 1024, F.G, F.wg);
            pg8::EpiResid E{F.X, mods_l};
            pg8::gemm_phase(F.lds, 1024, S, E, F.wave);
        } SEAM(pb + 5);
        if ((PHM & 4096) && IN(pb + 6)) { if (REPM & 4096) ph_ln_router(fresh(F), l, true); ph_ln_router(fresh(F), l); } SEAM(pb + 6);
        if ((PHM & 8192) && IN(pb + 7)) {
            const int ntiles = moe_tables(fresh(F), l);
            pg8::MoeGU S; S.cnt = (const LAS int*)(F.lds + LDS_MISC + MISC_CNT); S.tst = (const LAS int*)(F.lds + LDS_MISC + MISC_TST); S.t2e = (const LAS unsigned char*)(F.lds + LDS_MISC + MISC_T2E);
            S.ntiles = ntiles; S.G = F.G; S.c = F.wg; S.A = (const char*)F.HB; S.Bt = (const char*)(F.WB + WB_GU); S.stok = (const int*)(F.ws + OFF_STOK);
            pg8::EpiSwiglu E{(bf16_t*)(F.R1 + R1_H)};
            for (int rep = 0; rep < ((REPM & 8192) ? 2 : 1); ++rep) pg8::gemm_phase(F.lds, 1024, S, E, F.wave);
        } SEAM(pb + 7);
        if ((PHM & 16384) && IN(pb + 8)) {
            const int ntiles = moe_tables(fresh(F), l);
            pg8::MoeDN S; S.cnt = (const LAS int*)(F.lds + LDS_MISC + MISC_CNT); S.tst = (const LAS int*)(F.lds + LDS_MISC + MISC_TST); S.t2e = (const LAS unsigned char*)(F.lds + LDS_MISC + MISC_T2E);
            S.ntiles = ntiles; S.G = F.G; S.c = F.wg; S.A = (const char*)(F.R1 + R1_H); S.Bt = (const char*)(F.WB + WB_DN);
            pg8::EpiDown E{(bf16_t*)(F.R1 + R1_Y), (const float*)(F.ws + OFF_SW), (const LAS int*)(F.lds + LDS_MISC + MISC_CNT)};
            for (int rep = 0; rep < ((REPM & 16384) ? 2 : 1); ++rep) pg8::gemm_phase(F.lds, 256, S, E, F.wave);
        } SEAM(pb + 8);
        if ((PHM & 32768) && IN(pb + 9)) { if (REPM & 32768) ph_combine(fresh(F), l, true); ph_combine(fresh(F), l); } SEAM(pb + 9);
    }
#undef IN
#undef SEAM
}

extern "C" void kernel_launch(void* const* d_in, const int* in_sizes, int n_in, void* d_out, int out_size, void* d_ws, size_t ws_size, hipStream_t stream) {
    static int grid = 0;
    if (grid == 0) {
        if (n_in != 30 || out_size != TX * DM || ws_size < WS_END) { fprintf(stderr, "kernel_launch: unexpected problem (n_in %d out %d ws %zu need %zu)\n", n_in, out_size, ws_size, (size_t)WS_END); grid = -1; return; }
        int dev = 0, cus = 0, per_cu = 0;
        if (hipGetDevice(&dev) != hipSuccess || hipDeviceGetAttribute(&cus, hipDeviceAttributeMultiprocessorCount, dev) != hipSuccess) { grid = -1; return; }
        if (hipFuncSetAttribute((const void*)mk_fwd, hipFuncAttributeMaxDynamicSharedMemorySize, LDS_BYTES) != hipSuccess) { fprintf(stderr, "kernel_launch: hipFuncSetAttribute failed\n"); grid = -1; return; }
        if (hipOccupancyMaxActiveBlocksPerMultiprocessor(&per_cu, (const void*)mk_fwd, 512, LDS_BYTES) != hipSuccess || per_cu < 1) { fprintf(stderr, "kernel_launch: occupancy query says %d\n", per_cu); }
        (void)hipGetLastError();
        grid = cus;
    }
    if (grid < 0) return;
    (void)hipMemsetAsync((char*)d_ws + OFF_CTL, 0, CTL_BYTES, stream);
    Args a{};
    for (int i = 0; i < 30; ++i) a.in[i] = (const float*)d_in[i];
    a.out = (float*)d_out; a.ws = (unsigned char*)d_ws;
#if MK_SPLIT
    for (int p = 0; p < NPHASE; ++p) { a.ph_lo = p; a.ph_hi = p + 1; hipLaunchKernelGGL(mk_fwd, dim3(grid), dim3(512), LDS_BYTES, stream, a); }
#else
    a.ph_lo = 0; a.ph_hi = NPHASE;
    hipLaunchKernelGGL(mk_fwd, dim3(grid), dim3(512), LDS_BYTES, stream, a);
#endif
}
```

```cpp
#include <hip/hip_runtime.h>
#include <cstdio>
#include <cstdint>

#ifndef PHM
#define PHM 0xFFFF
#endif
#ifndef REPM
#define REPM 0
#endif
#ifndef MK_SPLIT
#define MK_SPLIT 0
#endif

typedef unsigned short bf16_t;
typedef short bf16x8 __attribute__((ext_vector_type(8)));
typedef short bf16x4 __attribute__((ext_vector_type(4)));
typedef float f32x4 __attribute__((ext_vector_type(4)));
typedef float f32x2 __attribute__((ext_vector_type(2)));
typedef unsigned u32x4 __attribute__((ext_vector_type(4)));
typedef unsigned u32x2 __attribute__((ext_vector_type(2)));
#define LAS __attribute__((address_space(3)))

constexpr int DM = 1024, NBAT = 4, SEQ = 8192, CTXL = 256;
constexpr int TC = NBAT * CTXL, TX = NBAT * SEQ, TT = TC + TX;
constexpr int NEXP = 64, TOPK = 6;
constexpr int CAP = TT;
constexpr int MOE_ROUTED_ROWS = 6 * TT + 64 * 256;
constexpr int MOE_ROWS = MOE_ROUTED_ROWS + TT;
constexpr int MOE_MAXTILES = MOE_ROWS / 256;
constexpr float ALPHA = 1.681792830507429f;
constexpr int HG_U = 128, HG_NU = (CTXL + SEQ) / HG_U;
constexpr int LRU_NT = (CTXL + SEQ) / 16;

constexpr size_t OFF_CTL = 0, CTL_BYTES = 65536;
constexpr size_t CTL_CNT = 16384, CTL_DBG = 20480;
constexpr size_t OFF_MODS = 65536;
constexpr size_t OFF_LBT = OFF_MODS + 4 * 5 * 6144 * 4;
constexpr size_t OFF_STATS = OFF_LBT + 8192;
constexpr size_t OFF_AB = OFF_STATS + (size_t)TT * 8;
static_assert(OFF_AB + 4 * 5 * 2 * 1024 * 4 <= (1u << 20), "ctl map");
constexpr size_t OFF_TOKE = 1u << 20;
constexpr size_t OFF_TOKP = OFF_TOKE + (size_t)TT * 32;
constexpr size_t OFF_TOKW = OFF_TOKP + (size_t)TT * 32;
constexpr size_t OFF_STOK = OFF_TOKW + (size_t)TT * 32;
constexpr size_t OFF_SW = OFF_STOK + (size_t)64 * CAP * 4;
constexpr size_t OFF_X = OFF_SW + (size_t)64 * CAP * 4;
constexpr size_t OFF_HB = OFF_X + (size_t)TT * DM * 4;
constexpr size_t OFF_WB = OFF_HB + (size_t)TT * DM * 2;
constexpr size_t WB_IN = 0, WB_OUT = WB_IN + (size_t)4096 * 1024 * 2, WB_RT = WB_OUT + (size_t)1024 * 1024 * 2, WB_GU = WB_RT + (size_t)64 * 1024 * 2,
                 WB_DN = WB_GU + (size_t)65 * 512 * 1024 * 2, WB_LRU = WB_DN + (size_t)65 * 1024 * 256 * 2, WB_END = WB_LRU + (size_t)2 * 2 * 16 * 64 * 64 * 2;
constexpr size_t OFF_R1 = OFF_WB + WB_END;
constexpr size_t R1_P = 0;
constexpr size_t R1_OF = R1_P + (size_t)TT * 4096 * 2;
constexpr size_t R1_SLOC = R1_OF + (size_t)TT * 512 * 4;
constexpr size_t R1_SST = R1_SLOC + (size_t)64 * HG_NU * 4096 * 4;
constexpr size_t R1_DL = R1_SST + (size_t)64 * HG_NU * 4096 * 4;
constexpr size_t R1_AG = R1_OF;
constexpr size_t R1_HST = R1_AG + (size_t)4 * 2 * LRU_NT * 2 * 1024 * 4;
constexpr size_t R1_H = 0;
constexpr size_t R1_Y = R1_H + (size_t)MOE_ROWS * 256 * 2;
constexpr size_t R1_MOE_END = R1_Y + (size_t)MOE_ROWS * 1024 * 2;
constexpr size_t R1_MIX_END = R1_DL + (size_t)64 * HG_NU * 64 * 4;
constexpr size_t WS_END = OFF_R1 + (R1_MOE_END > R1_MIX_END ? R1_MOE_END : R1_MIX_END);

constexpr int LDS_STAGE = 131072;
constexpr int LDS_MISC = LDS_STAGE;
constexpr int MISC_CNT = 64;
constexpr int MISC_TST = MISC_CNT + 66 * 4 + 8;
constexpr int MISC_HIST = 640;
constexpr int MISC_HBASE = 896;
constexpr int MISC_T2E = 1152;
constexpr int MISC_INP = 2304;
constexpr int LDS_BYTES = 147456;

#define XB_TMO      128
#define XB_XCNT(j)  (256  + 64 * (j))
#define XB_XSUB(j)  (1280 + 64 * (j))
#define XB_XGEN(j)  (2304 + 64 * (j))
#define XB_TOP      3328
#define XB_TOPGEN   3392
#define XCD_BAR_WORDS 3456
#define XB_SPIN_CAP (1u << 22)
__device__ __forceinline__ unsigned xb_ld(unsigned* p)              { return __hip_atomic_load(p, __ATOMIC_RELAXED, __HIP_MEMORY_SCOPE_AGENT); }
__device__ __forceinline__ unsigned xb_add(unsigned* p, unsigned v) { return __hip_atomic_fetch_add(p, v, __ATOMIC_RELAXED, __HIP_MEMORY_SCOPE_AGENT); }
__device__ __forceinline__ unsigned xb_xcc_id() { return (unsigned)__builtin_amdgcn_s_getreg((3 << 11) | 20) & 0xFu; }
#define XB_SPIN(cond, bar) do { unsigned _sp = 0; while (cond) { __builtin_amdgcn_s_sleep(1); \
    if ((++_sp & 255u) == 0u) { if (xb_ld(&(bar)[XB_TMO])) break; if (_sp > XB_SPIN_CAP) { atomicAdd(&(bar)[XB_TMO], 1u); break; } } } } while (0)
struct XcdBarrier { unsigned* bar; unsigned x; volatile LAS unsigned* st; };
__device__ __forceinline__ XcdBarrier xcd_barrier_post(unsigned* bar, volatile LAS unsigned* st) {
    XcdBarrier b; b.bar = bar; b.x = xb_xcc_id(); b.st = st;
    if (threadIdx.x == 0) (void)xb_add(&bar[XB_XCNT(b.x)], 1u);
    return b;
}
__device__ __forceinline__ void xcd_barrier_complete(unsigned* bar, unsigned x, unsigned& nloc, unsigned& nx) {
    const unsigned G = gridDim.x * gridDim.y * gridDim.z;
    unsigned sum, cnt, mine, sp = 0u;
    for (;;) {
        sum = 0u; cnt = 0u; mine = 0u;
#pragma unroll
        for (unsigned j = 0; j < 16; ++j) { const unsigned c = xb_ld(&bar[XB_XCNT(j)]); sum += c; cnt += (c > 0u) ? 1u : 0u; mine = (j == x) ? c : mine; }
        if (sum == G) break;
        __builtin_amdgcn_s_sleep(1);
        if ((++sp & 255u) == 0u) { if (xb_ld(&bar[XB_TMO])) break; if (sp > XB_SPIN_CAP) { atomicAdd(&bar[XB_TMO], 1u); break; } }
    }
    nloc = mine > 0u ? mine : 1u; nx = cnt > 0u ? cnt : 1u;
}
__device__ __forceinline__ void xcd_barrier(const XcdBarrier& b) {
    asm volatile("s_waitcnt vmcnt(0)" ::: "memory");
    __syncthreads();
    if (threadIdx.x == 0) {
        unsigned* bar = b.bar;
        __builtin_amdgcn_s_waitcnt(0);
        unsigned nloc = b.st[0], nx = b.st[1];
        if (nloc == 0u) { xcd_barrier_complete(bar, b.x, nloc, nx); b.st[0] = nloc; b.st[1] = nx; }
        const unsigned old = xb_add(&bar[XB_XSUB(b.x)], 1u);
        const unsigned gen = old / nloc;
        if (old + 1u == (gen + 1u) * nloc) {
            __builtin_amdgcn_fence(__ATOMIC_RELEASE, "agent");
            asm volatile("s_waitcnt vmcnt(0)" ::: "memory");
            const unsigned og = xb_add(&bar[XB_TOP], 1u);
            const unsigned tg = og / nx;
            if (og + 1u == (tg + 1u) * nx) xb_add(&bar[XB_TOPGEN], 1u);
            else XB_SPIN(xb_ld(&bar[XB_TOPGEN]) == tg, bar);
            __builtin_amdgcn_fence(__ATOMIC_ACQUIRE, "agent");
            xb_add(&bar[XB_XGEN(b.x)], 1u);
            asm volatile("s_waitcnt vmcnt(0)" ::: "memory");
        } else {
            XB_SPIN(xb_ld(&bar[XB_XGEN(b.x)]) == gen, bar);
            __builtin_amdgcn_fence(__ATOMIC_ACQUIRE, "agent");
            asm volatile("s_waitcnt vmcnt(0)" ::: "memory");
        }
    }
    __syncthreads();
}

__device__ __forceinline__ float bf2f(unsigned short b) { return __uint_as_float(((unsigned)b) << 16); }
__device__ __forceinline__ unsigned cvt_pk_bf16(float lo, float hi) { unsigned r; asm volatile("v_cvt_pk_bf16_f32 %0, %1, %2" : "=v"(r) : "v"(lo), "v"(hi)); return r; }
__device__ __forceinline__ unsigned short f2bf(float f) { return (unsigned short)(cvt_pk_bf16(f, 0.f) & 0xffffu); }
__device__ __forceinline__ float sigmoidf_(float x) { return __builtin_amdgcn_rcpf(1.0f + __expf(-x)); }
__device__ __forceinline__ float siluf_(float x) { return x * sigmoidf_(x); }
__device__ __forceinline__ float gelu_tanh_(float x) { return x * sigmoidf_(1.5957691216057308f * (x + 0.044715f * x * x * x)); }
__device__ __forceinline__ int slot_of_row(int r) { return r < TC ? 4 : ((r - TC) >> 13); }
template <int CTRL> __device__ __forceinline__ float dppf(float oldv, float src) {
    return __int_as_float(__builtin_amdgcn_update_dpp(__float_as_int(oldv), __float_as_int(src), CTRL, 0xf, 0xf, false));
}
__device__ __forceinline__ void unpack8(const u32x4 w, float (&o)[8]) {
    o[0] = __uint_as_float(w.x << 16); o[1] = __uint_as_float(w.x & 0xffff0000u); o[2] = __uint_as_float(w.y << 16); o[3] = __uint_as_float(w.y & 0xffff0000u);
    o[4] = __uint_as_float(w.z << 16); o[5] = __uint_as_float(w.z & 0xffff0000u); o[6] = __uint_as_float(w.w << 16); o[7] = __uint_as_float(w.w & 0xffff0000u);
}

namespace pg8 {
constexpr int BM = 256, BK = 64, HALF = 128, HTB = HALF * BK * 2, STAGE_BYTES = 8 * HTB, NXCD = 8, WGM = 8;
__device__ __forceinline__ int lds_byte(int r, int c) { const int st = (r >> 4) * 2 + (c >> 5), rr = r & 15, cc = c & 31, ob = rr * 64 + cc * 2; return st * 1024 + (ob ^ (((ob >> 9) & 1) << 5)); }
__device__ __forceinline__ void stage_rc(int b, int& R, int& C) { const int st = b / 1024, sb = b % 1024, swz = sb ^ (((sb >> 9) & 1) << 5); R = (st >> 1) * 16 + swz / 64; C = (st & 1) * 32 + (swz % 64) / 2; }
__device__ __forceinline__ int perm32(int rho) { const int n = rho >> 4, i = rho & 15; return 8 * (i >> 2) + 4 * n + (i & 3); }
struct Unit { int pm, pn, e, ti; };

struct StaticOrder {
    const char* A; const char* Bt; int K;
    int nM, nN, nwg, G, c;
    __device__ __forceinline__ void init(const void* A_, const void* Bt_, int M, int N, int K_, int G_, int c_) { A = (const char*)A_; Bt = (const char*)Bt_; K = K_; nM = M / BM; nN = N / BM; nwg = nM * nN; G = G_; c = c_; }
    __device__ __forceinline__ bool next(int i, Unit& u) const {
        const long L = (long)i * G + c; if (L >= nwg) return false;
        int wgid = (int)L; { const int q = nwg / NXCD, r = nwg % NXCD, xcd = wgid % NXCD, off = wgid / NXCD; wgid = (xcd < r ? xcd * (q + 1) : r * (q + 1) + (xcd - r) * q) + off; }
        const int nig = WGM * nN, gid = wgid / nig, fm = gid * WGM, gsz = (nM - fm) < WGM ? (nM - fm) : WGM;
        u.pm = fm + ((wgid % nig) % gsz); u.pn = (wgid % nig) / gsz; u.e = 0; u.ti = 0; return true;
    }
    static constexpr bool GATHER = false;
    __device__ __forceinline__ const char* abase(const Unit& u) const { return A + (size_t)u.pm * BM * K * 2; }
    __device__ __forceinline__ const char* bbase(const Unit& u) const { return Bt + (size_t)u.pn * BM * K * 2; }
};

template <class Epi, class Sched>
__device__ __forceinline__ void gemm_phase(LAS unsigned char* lds, const int K_, const Sched& S, const Epi& E, const int wave_) {
    int Kl_ = K_; asm volatile("" : "+s"(Kl_)); const int K = Kl_;
    int tid_ = wave_ * 64 + (int)__builtin_amdgcn_mbcnt_hi(~0u, __builtin_amdgcn_mbcnt_lo(~0u, 0u)); asm volatile("" : "+v"(tid_));
    const int tid = tid_, wid = __builtin_amdgcn_readfirstlane(tid >> 6), lane = tid & 63, wr = wid >> 2, wc = wid & 3, fr = lane & 15, fq = lane >> 4;
    const int nt = K / BK;
    unsigned voffA[2], voffB[2];
#pragma unroll
    for (int i = 0; i < 2; ++i) { int R, C; stage_rc(tid * 16 + i * 8192, R, C); const int Rb = Epi::PERM ? ((R & ~31) + perm32(R & 31)) : R; voffA[i] = (unsigned)(R * K + C) * 2u; voffB[i] = (unsigned)(Rb * K + C) * 2u; }
    const size_t kstep = (size_t)(BK * 2);
    const size_t hstep = (size_t)HALF * K * 2;
    const unsigned ldsw = (unsigned)wid * 1024u;
    const int aoff = lds_byte(wr * 64 + fr, fq * 8), boff = lds_byte(wc * 32 + fr, fq * 8);
#define PG8_SA(b, h) (((b) * 2 + (h)) * HTB)
#define PG8_SB(b, h) ((4 + (b) * 2 + (h)) * HTB)
#define PG8_STAGE(bufoff, gbase, voff) do { _Pragma("unroll") for (int _i = 0; _i < 2; ++_i) \
        __builtin_amdgcn_global_load_lds((const unsigned*)((const char*)(gbase) + (voff)[_i]), (LAS unsigned*)(lds + (bufoff) + ldsw + _i * 8192), 16, 0, 0); } while (0)
#define PG8_STAGEA(bufoff, hh, kb, nx) do { if constexpr (Sched::GATHER) { unsigned _o[2]; _o[0] = (nx) ? vN[hh][0] : vC[hh][0]; _o[1] = (nx) ? vN[hh][1] : vC[hh][1]; PG8_STAGE(bufoff, cA + (kb), _o); } \
        else { PG8_STAGE(bufoff, ((nx) ? nA : cA) + (hh) * hstep + (kb), voffA); } } while (0)
#define PG8_LDA(dst, b, h) do { _Pragma("unroll") for (int m = 0; m < 4; ++m) _Pragma("unroll") for (int k = 0; k < 2; ++k) dst[m][k] = *(const LAS bf16x8*)(lds + PG8_SA(b, h) + aoff + m * 2048 + k * 1024); } while (0)
#define PG8_LDB(dst, b, h) do { _Pragma("unroll") for (int n = 0; n < 2; ++n) _Pragma("unroll") for (int k = 0; k < 2; ++k) dst[n][k] = *(const LAS bf16x8*)(lds + PG8_SB(b, h) + boff + n * 2048 + k * 1024); } while (0)
#define PG8_MMA(ai, bj, At, Bt) do { __builtin_amdgcn_s_setprio(1); _Pragma("unroll") for (int m = 0; m < 4; ++m) _Pragma("unroll") for (int n = 0; n < 2; ++n) _Pragma("unroll") for (int k = 0; k < 2; ++k) \
        acc[ai][bj][m][n] = __builtin_amdgcn_mfma_f32_16x16x32_bf16(Bt[n][k], At[m][k], acc[ai][bj][m][n], 0, 0, 0); __builtin_amdgcn_s_setprio(0); } while (0)
#define PG8_WAIT_V(n) asm volatile("s_waitcnt vmcnt(" #n ")" ::: "memory")
#define PG8_WAIT_L(n) asm volatile("s_waitcnt lgkmcnt(" #n ")" ::: "memory")
#define PG8_BAR __builtin_amdgcn_s_barrier()
#define PG8_SCHED __builtin_amdgcn_sched_barrier(0)
    Unit cur, nxt; int ui = 0;
    if (!S.next(0, cur)) return;
    f32x4 acc[2][2][4][2];
#pragma unroll
    for (int a = 0; a < 2; ++a)
#pragma unroll
        for (int b = 0; b < 2; ++b)
#pragma unroll
            for (int m = 0; m < 4; ++m)
#pragma unroll
                for (int n = 0; n < 2; ++n) acc[a][b][m][n] = (f32x4){0.f, 0.f, 0.f, 0.f};
    bf16x8 At[4][2], B0[2][2], B1[2][2];
    unsigned vC[2][2], vN[2][2];
    if constexpr (Sched::GATHER) S.aoff(cur, tid, vC);
    const char* cA = S.abase(cur);
    const char* cB = S.bbase(cur);
    const char* nA = cA;
    PG8_STAGE(PG8_SB(0, 0), cB, voffB); PG8_STAGEA(PG8_SA(0, 0), 0, 0, false); PG8_STAGE(PG8_SB(0, 1), cB + hstep, voffB); PG8_STAGEA(PG8_SA(0, 1), 1, 0, false);
    if (wr == 1) PG8_BAR;
    PG8_WAIT_V(4); PG8_BAR;
    PG8_STAGE(PG8_SB(1, 0), cB + kstep, voffB); PG8_STAGEA(PG8_SA(1, 0), 0, kstep, false); PG8_STAGE(PG8_SB(1, 1), cB + hstep + kstep, voffB);
    PG8_WAIT_V(6); PG8_BAR;
    for (;;) {
        const bool has_next = S.next(ui + 1, nxt);
        const char* nB = cB; nA = cA;
        if (has_next) { nB = S.bbase(nxt); nA = S.abase(nxt); if constexpr (Sched::GATHER) S.aoff(nxt, tid, vN); }
        else { if constexpr (Sched::GATHER) {
#pragma unroll
            for (int h = 0; h < 2; ++h)
#pragma unroll
                for (int i = 0; i < 2; ++i) vN[h][i] = vC[h][i]; } }
        for (int t = 0; t < nt; t += 2) {
            const bool last = (t == nt - 2);
            const size_t k1 = (size_t)(t + 1) * kstep, k2 = last ? 0 : (size_t)(t + 2) * kstep, k3 = k2 + kstep;
            const char* b2 = last ? nB : cB + (size_t)(t + 2) * kstep; const char* b3 = b2 + kstep;
            PG8_LDB(B0, 0, 0); PG8_SCHED; PG8_LDA(At, 0, 0); PG8_STAGEA(PG8_SA(1, 1), 1, k1, false);
            PG8_WAIT_L(8); PG8_BAR; PG8_WAIT_L(0); PG8_MMA(0, 0, At, B0); PG8_BAR; PG8_SCHED;
            PG8_LDB(B1, 0, 1); PG8_STAGE(PG8_SB(0, 0), b2, voffB);
            PG8_BAR; PG8_WAIT_L(0); PG8_MMA(0, 1, At, B1); PG8_BAR;
            PG8_LDA(At, 0, 1); PG8_STAGEA(PG8_SA(0, 0), 0, k2, last);
            PG8_BAR; PG8_WAIT_L(0); PG8_MMA(1, 0, At, B0); PG8_BAR; PG8_SCHED;
            PG8_STAGE(PG8_SB(0, 1), b2 + hstep, voffB);
            PG8_WAIT_V(6); PG8_BAR; PG8_MMA(1, 1, At, B1); PG8_BAR;
            PG8_LDB(B0, 1, 0); PG8_SCHED; PG8_LDA(At, 1, 0); PG8_STAGEA(PG8_SA(0, 1), 1, k2, last);
            PG8_WAIT_L(8); PG8_BAR; PG8_WAIT_L(0); PG8_MMA(0, 0, At, B0); PG8_BAR; PG8_SCHED;
            PG8_LDB(B1, 1, 1); PG8_STAGE(PG8_SB(1, 0), b3, voffB);
            PG8_BAR; PG8_WAIT_L(0); PG8_MMA(0, 1, At, B1); PG8_BAR;
            PG8_LDA(At, 1, 1); PG8_STAGEA(PG8_SA(1, 0), 0, k3, last);
            PG8_BAR; PG8_WAIT_L(0); PG8_MMA(1, 0, At, B0); PG8_BAR; PG8_SCHED;
            PG8_STAGE(PG8_SB(1, 1), b3 + hstep, voffB);
            PG8_WAIT_V(6); PG8_BAR; PG8_MMA(1, 1, At, B1); PG8_BAR;
        }
        E(acc, cur, wr, wc, fr, fq);
        if (!has_next) break;
#pragma unroll
        for (int a = 0; a < 2; ++a)
#pragma unroll
            for (int b = 0; b < 2; ++b)
#pragma unroll
                for (int m = 0; m < 4; ++m)
#pragma unroll
                    for (int n = 0; n < 2; ++n) acc[a][b][m][n] = (f32x4){0.f, 0.f, 0.f, 0.f};
        cur = nxt; cB = nB; cA = nA; ++ui;
        if constexpr (Sched::GATHER) {
#pragma unroll
            for (int h = 0; h < 2; ++h)
#pragma unroll
                for (int i = 0; i < 2; ++i) vC[h][i] = vN[h][i]; }
    }
    PG8_WAIT_V(0);
    if (wr == 0) PG8_BAR;
    PG8_BAR;
#undef PG8_SA
#undef PG8_SB
#undef PG8_STAGE
#undef PG8_STAGEA
#undef PG8_LDA
#undef PG8_LDB
#undef PG8_MMA
#undef PG8_WAIT_V
#undef PG8_WAIT_L
#undef PG8_BAR
#undef PG8_SCHED
}

struct EpiStoreBf16 {
    static constexpr bool PERM = true;
    bf16_t* O; int ldc;
    __device__ __forceinline__ void operator()(const f32x4 (&acc)[2][2][4][2], const Unit& u, int wr, int wc, int fr, int fq) const {
        const int row0 = u.pm * BM + wr * 64 + fr, col0 = u.pn * BM + wc * 32 + 8 * fq;
#pragma unroll
        for (int ai = 0; ai < 2; ++ai)
#pragma unroll
            for (int m = 0; m < 4; ++m) { bf16_t* rowp = O + (size_t)(row0 + ai * HALF + m * 16) * ldc + col0;
#pragma unroll
                for (int bj = 0; bj < 2; ++bj) { const f32x4 v0 = acc[ai][bj][m][0], v1 = acc[ai][bj][m][1];
                    u32x4 w; w.x = cvt_pk_bf16(v0[0], v0[1]); w.y = cvt_pk_bf16(v0[2], v0[3]); w.z = cvt_pk_bf16(v1[0], v1[1]); w.w = cvt_pk_bf16(v1[2], v1[3]);
                    *(u32x4*)(rowp + bj * HALF) = w; } }
    }
};
struct EpiResid {
    static constexpr bool PERM = false;
    float* X; const float* mods_l;
    __device__ __forceinline__ void operator()(const f32x4 (&acc)[2][2][4][2], const Unit& u, int wr, int wc, int fr, int fq) const {
        const int row0 = u.pm * BM + wr * 64 + fr, col0 = u.pn * BM + wc * 32 + 4 * fq;
        const float* m2 = mods_l + (size_t)(slot_of_row(u.pm * BM) * 6 + 2) * DM + col0;
        float* xb = X + (size_t)row0 * DM + col0;
#pragma unroll
        for (int bj = 0; bj < 2; ++bj)
#pragma unroll
            for (int n = 0; n < 2; ++n) { const f32x4 mv = *(const f32x4*)(m2 + bj * HALF + n * 16);
#pragma unroll
                for (int ai = 0; ai < 2; ++ai) {
#pragma unroll
                    for (int m = 0; m < 4; ++m) { float* p = xb + (size_t)(ai * HALF + m * 16) * DM + bj * HALF + n * 16; const f32x4 xv = *(const f32x4*)p; *(f32x4*)p = xv * ALPHA + mv * acc[ai][bj][m][n]; }
                    asm volatile("" ::: "memory"); } }
    }
};
struct EpiSwiglu {
    static constexpr bool PERM = true;
    bf16_t* H;
    __device__ __forceinline__ void operator()(const f32x4 (&acc)[2][2][4][2], const Unit& u, int wr, int wc, int fr, int fq) const {
        const int row0 = u.pm * BM + wr * 64 + fr, col0 = u.pn * HALF + wc * 32 + 8 * fq;
#pragma unroll
        for (int ai = 0; ai < 2; ++ai)
#pragma unroll
            for (int m = 0; m < 4; ++m) { bf16_t* rowp = H + (size_t)(row0 + ai * HALF + m * 16) * 256 + col0;
                float h[8];
#pragma unroll
                for (int n = 0; n < 2; ++n)
#pragma unroll
                    for (int j = 0; j < 4; ++j) h[n * 4 + j] = siluf_(acc[ai][0][m][n][j]) * acc[ai][1][m][n][j];
                u32x4 w; w.x = cvt_pk_bf16(h[0], h[1]); w.y = cvt_pk_bf16(h[2], h[3]); w.z = cvt_pk_bf16(h[4], h[5]); w.w = cvt_pk_bf16(h[6], h[7]);
                *(u32x4*)rowp = w; }
    }
};
struct EpiDown {
    static constexpr bool PERM = true;
    unsigned char* Y; const float* sw; const LAS int* cnt;
    __device__ __forceinline__ void operator()(const f32x4 (&acc)[2][2][4][2], const Unit& u, int wr, int wc, int fr, int fq) const {
        const int row0 = u.pm * BM + wr * 64 + fr, col0 = u.pn * BM + wc * 32 + 8 * fq;
        const int ce = (u.e < 64) ? cnt[u.e] : 0;
        const float* swe = sw + (size_t)(u.e < 64 ? u.e : 0) * CAP + u.ti * 256 + wr * 64 + fr;
        unsigned char* yb = Y + (size_t)row0 * DM + col0;
#pragma unroll
        for (int ai = 0; ai < 2; ++ai)
#pragma unroll
            for (int m = 0; m < 4; ++m) { const int rl = ai * HALF + m * 16, pos = u.ti * 256 + wr * 64 + fr + rl;
                float w = 32.0f; if (u.e < 64) w = (pos < ce) ? swe[rl] * 32.0f : 0.0f;
                unsigned char* rowp = yb + (size_t)rl * DM;
#pragma unroll
                for (int bj = 0; bj < 2; ++bj) { f32x4 v0 = acc[ai][bj][m][0] * w, v1 = acc[ai][bj][m][1] * w;
#pragma unroll
                    for (int j = 0; j < 4; ++j) { v0[j] = fminf(fmaxf(v0[j], -440.0f), 440.0f); v1[j] = fminf(fmaxf(v1[j], -440.0f), 440.0f); }
                    int p0 = __builtin_amdgcn_cvt_pk_fp8_f32(v0[0], v0[1], 0, false); p0 = __builtin_amdgcn_cvt_pk_fp8_f32(v0[2], v0[3], p0, true);
                    int p1 = __builtin_amdgcn_cvt_pk_fp8_f32(v1[0], v1[1], 0, false); p1 = __builtin_amdgcn_cvt_pk_fp8_f32(v1[2], v1[3], p1, true);
                    u32x2 ww; ww.x = (unsigned)p0; ww.y = (unsigned)p1;
                    *(u32x2*)(rowp + bj * HALF) = ww; }
                asm volatile("" ::: "memory"); }
    }
};
template <int NPN> struct MoeOrder {
    const LAS int* cnt; const LAS int* tst; const LAS unsigned char* t2e; int ntiles, G, c;
    __device__ __forceinline__ bool next(int i, Unit& u) const {
        const int L = i * G + c; if (L >= ntiles * NPN) return false;
        const int tau = L / NPN; u.pm = tau; u.pn = L % NPN; u.e = t2e[tau]; u.ti = tau - tst[u.e]; return true;
    }
};
struct MoeGU : MoeOrder<2> {
    static constexpr bool GATHER = true;
    const char* A; const char* Bt; const int* stok;
    __device__ __forceinline__ const char* abase(const Unit&) const { return A; }
    __device__ __forceinline__ const char* bbase(const Unit& u) const { return Bt + ((size_t)u.e * 512 + (size_t)u.pn * 256) * 1024 * 2; }
    __device__ __forceinline__ void aoff(const Unit& u, int tid, unsigned (&off)[2][2]) const {
        const int ce = cnt[u.e];
#pragma unroll
        for (int i = 0; i < 2; ++i) { int R, C; stage_rc(tid * 16 + i * 8192, R, C);
#pragma unroll
            for (int h = 0; h < 2; ++h) { const int pos = u.ti * 256 + h * HALF + R; int tok;
                if (u.e == 64) tok = pos; else tok = (pos < ce) ? stok[(size_t)u.e * CAP + pos] : 0;
                off[h][i] = (unsigned)(tok * 1024 + C) * 2u; } }
    }
};
struct MoeDN : MoeOrder<4> {
    static constexpr bool GATHER = false;
    const char* A; const char* Bt;
    __device__ __forceinline__ const char* abase(const Unit& u) const { return A + (size_t)u.pm * BM * 256 * 2; }
    __device__ __forceinline__ const char* bbase(const Unit& u) const { return Bt + ((size_t)u.e * 1024 + (size_t)u.pn * 256) * 256 * 2; }
};
}

struct Args { const float* in[30]; float* out; unsigned char* ws; int ph_lo, ph_hi; };

struct Frame {
    float* out; unsigned char* ws; LAS unsigned char* lds; int tid, lane, wave, G, wg;
    float* mods; float* X; bf16_t* HB; bf16_t* MIX; unsigned char* WB; unsigned char* R1;
};

__device__ __forceinline__ const float* inp(const Frame& F, int i) {
    const unsigned long long v = ((const LAS unsigned long long*)(F.lds + LDS_MISC + MISC_INP))[i];
    const unsigned lo = (unsigned)__builtin_amdgcn_readfirstlane((int)(unsigned)v), hi = (unsigned)__builtin_amdgcn_readfirstlane((int)(unsigned)(v >> 32));
    return (const float*)(((unsigned long long)hi << 32) | lo);
}
__device__ __forceinline__ int lane_id_() { return (int)__builtin_amdgcn_mbcnt_hi(~0u, __builtin_amdgcn_mbcnt_lo(~0u, 0u)); }
__device__ __forceinline__ Frame fresh(const Frame& F0) { Frame F = F0; int ln = lane_id_(); asm volatile("" : "+v"(ln)); F.lane = ln; F.tid = F0.wave * 64 + ln; return F; }

__device__ __forceinline__ void ph_mods(const Frame& F) {
    const float* c = inp(F, 1); const float* cc = inp(F, 3); const float* ada_w = inp(F, 4); const float* ada_b = inp(F, 5);
    LAS float* sv = (LAS float*)F.lds;
    LAS float* red = (LAS float*)(F.lds + 5 * 1024 * 4);
    for (int i = F.tid; i < 5 * 1024; i += 512) { const int s = i >> 10, k = i & 1023; const float v = (s < 4) ? c[s * 1024 + k] : cc[k]; sv[i] = siluf_(v); }
    __syncthreads();
    for (int task = F.wg; task < 4 * 48; task += F.G) {
        const int l = task / 48, cc0 = (task % 48) * 128;
        const int col = cc0 + (F.tid & 127), kg = F.tid >> 7;
        const float* w = ada_w + (size_t)l * 1024 * 6144 + col;
        float a0 = 0.f, a1 = 0.f, a2 = 0.f, a3 = 0.f, a4 = 0.f;
        for (int k = kg * 256; k < kg * 256 + 256; ++k) { const float wv = w[(size_t)k * 6144]; a0 += sv[k] * wv; a1 += sv[1024 + k] * wv; a2 += sv[2048 + k] * wv; a3 += sv[3072 + k] * wv; a4 += sv[4096 + k] * wv; }
        LAS float* r = red + (kg * 128 + (F.tid & 127)) * 5; r[0] = a0; r[1] = a1; r[2] = a2; r[3] = a3; r[4] = a4;
        __syncthreads();
        if (F.tid < 128) {
            const float b = ada_b[l * 6144 + col];
#pragma unroll
            for (int s = 0; s < 5; ++s) { const float v = ((red[(0 * 128 + F.tid) * 5 + s] + red[(1 * 128 + F.tid) * 5 + s]) + red[(2 * 128 + F.tid) * 5 + s]) + red[(3 * 128 + F.tid) * 5 + s];
                F.mods[(size_t)(l * 5 + s) * 6144 + col] = v + b; }
        }
        __syncthreads();
    }
    if (F.wg == F.G - 1) {
        const float* raw = inp(F, 11); float* lbt = (float*)(F.ws + OFF_LBT);
        for (int i = F.tid; i < 2 * 512; i += 512) { const int d = i >> 9, ch = i & 511; const float r0 = raw[(d * 2 + 0) * 512 + ch], r1 = raw[(d * 2 + 1) * 512 + ch];
            lbt[(0 * 2 + d) * 512 + ch] = 0.f; lbt[(1 * 2 + d) * 512 + ch] = sigmoidf_(r1 - r0); }
    }
}

__device__ __forceinline__ void ph_init_x(const Frame& F) {
    const float* x = inp(F, 0); const float* ctx = inp(F, 2);
    { const float* lg_ = inp(F, 6); const float* lb_ = inp(F, 7); float* AB = (float*)(F.ws + OFF_AB);
      for (int i = F.wg * 512 + F.tid; i < 4 * 5 * 1024; i += F.G * 512) { const int k = i & 1023, ls = i >> 10, l = ls / 5;
          const float* m = F.mods + (size_t)ls * 6144; const float g0 = lg_[(l * 2) * 1024 + k], b0 = lb_[(l * 2) * 1024 + k], m3 = m[3 * 1024 + k], m4 = m[4 * 1024 + k];
          AB[(size_t)ls * 2048 + k] = g0 * (1.0f + m4); AB[(size_t)ls * 2048 + 1024 + k] = b0 * (1.0f + m4) + m3; } }
    const int gw = F.wg * 8 + F.wave, nw = F.G * 8;
    for (int row = gw; row < TT; row += nw) {
        const float* src = row < TC ? ctx + (size_t)row * DM : x + (size_t)(row - TC) * DM;
        const float* m = F.mods + (size_t)(0 * 5 + slot_of_row(row)) * 6144;
#pragma unroll
        for (int hh = 0; hh < 2; ++hh) { const int k = hh * 512 + F.lane * 8;
            const f32x4 v0 = *(const f32x4*)(src + k), v1 = *(const f32x4*)(src + k + 4);
            *(f32x4*)(F.X + (size_t)row * DM + k) = v0; *(f32x4*)(F.X + (size_t)row * DM + k + 4) = v1;
            const f32x4 s0 = *(const f32x4*)(m + 1024 + k), s1 = *(const f32x4*)(m + 1024 + k + 4), b0 = *(const f32x4*)(m + k), b1 = *(const f32x4*)(m + k + 4);
            const f32x4 h0 = v0 * (s0 + 1.0f) + b0, h1 = v1 * (s1 + 1.0f) + b1;
            u32x4 w; w.x = cvt_pk_bf16(h0[0], h0[1]); w.y = cvt_pk_bf16(h0[2], h0[3]); w.z = cvt_pk_bf16(h1[0], h1[1]); w.w = cvt_pk_bf16(h1[2], h1[3]);
            *(u32x4*)(F.HB + (size_t)row * DM + k) = w; }
    }
}

__device__ __forceinline__ void cvt_tile(const Frame& F, const float* src, int sld, int k0, int n0, bf16_t* dst, int dld, int drow0, float scale) {
    LAS float* t = (LAS float*)F.lds;
    { const int i = F.tid >> 3, j0 = (F.tid & 7) * 8; const float* p = src + (size_t)(k0 + i) * sld + n0 + j0;
      const f32x4 a = *(const f32x4*)p, b = *(const f32x4*)(p + 4);
      LAS float* q = t + i * 65 + j0; q[0] = a[0]; q[1] = a[1]; q[2] = a[2]; q[3] = a[3]; q[4] = b[0]; q[5] = b[1]; q[6] = b[2]; q[7] = b[3]; }
    __syncthreads();
    { const int j = F.tid >> 3, i0 = (F.tid & 7) * 8; float v[8];
#pragma unroll
      for (int q = 0; q < 8; ++q) v[q] = t[(i0 + q) * 65 + j] * scale;
      u32x4 w; w.x = cvt_pk_bf16(v[0], v[1]); w.y = cvt_pk_bf16(v[2], v[3]); w.z = cvt_pk_bf16(v[4], v[5]); w.w = cvt_pk_bf16(v[6], v[7]);
      *(u32x4*)(dst + (size_t)(drow0 + j) * dld + k0 + i0) = w; }
    __syncthreads();
}
__device__ __forceinline__ void ph_convert(const Frame& F, int l) {
    const int j = l >> 1; const bool even = (l & 1) == 0;
    bf16_t* wIN = (bf16_t*)(F.WB + WB_IN); bf16_t* wOUT = (bf16_t*)(F.WB + WB_OUT); bf16_t* wRT = (bf16_t*)(F.WB + WB_RT);
    bf16_t* wGU = (bf16_t*)(F.WB + WB_GU); bf16_t* wDN = (bf16_t*)(F.WB + WB_DN); bf16_t* wLRU = (bf16_t*)(F.WB + WB_LRU);
    const int nIN = even ? 4096 : 2048;
    const int t_in = (nIN / 64) * 16, t_out = 256, t_rt = 16, t_gu = 65 * 2 * 64, t_dn = 65 * 64, t_lru = even ? 0 : 64;
    const int total = t_in + t_out + t_rt + t_gu + t_dn + t_lru;
    for (int task = F.wg; task < total; task += F.G) {
        int t = task;
        if (t < t_in) { const int nb = t >> 4, kb = t & 15; const float* src = even ? inp(F, 8) + (size_t)j * 1024 * 4096 : inp(F, 13) + (size_t)j * 1024 * 2048;
            cvt_tile(F, src, nIN, kb * 64, nb * 64, wIN, 1024, nb * 64, (even && nb < 8) ? 0.125f : 1.0f); continue; }
        t -= t_in;
        if (t < t_out) { const int nb = t >> 4, kb = t & 15; const float* src = even ? inp(F, 9) + (size_t)j * 1024 * 1024 : inp(F, 21) + (size_t)j * 1024 * 1024;
            cvt_tile(F, src, 1024, kb * 64, nb * 64, wOUT, 1024, nb * 64, 1.0f); continue; }
        t -= t_out;
        if (t < t_rt) { cvt_tile(F, inp(F, 22) + (size_t)l * 1024 * 64, 64, t * 64, 0, wRT, 1024, 0, 1.0f); continue; }
        t -= t_rt;
        if (t < t_gu) { const int e = t / 128, r = t % 128, which = r >> 6, q = r & 63, nb = q >> 4, kb = q & 15;
            const float* src = (e < 64) ? (which ? inp(F, 25) : inp(F, 24)) + ((size_t)l * 64 + e) * 1024 * 256 : (which ? inp(F, 28) : inp(F, 27)) + (size_t)l * 1024 * 256;
            const int n0 = nb * 64, drow0 = (n0 >> 7) * 256 + which * 128 + (n0 & 127);
            cvt_tile(F, src, 256, kb * 64, n0, wGU + (size_t)e * 512 * 1024, 1024, drow0, 1.0f); continue; }
        t -= t_gu;
        if (t < t_dn) { const int e = t >> 6, q = t & 63, nb = q >> 2, kb = q & 3;
            const float* src = (e < 64) ? inp(F, 26) + ((size_t)l * 64 + e) * 256 * 1024 : inp(F, 29) + (size_t)l * 256 * 1024;
            cvt_tile(F, src, 1024, kb * 64, nb * 64, wDN + (size_t)e * 1024 * 256, 256, nb * 64, 1.0f); continue; }
        t -= t_dn;
        { const int d = t >> 5, gt = (t >> 4) & 1, kb = t & 15;
          const float* src = (gt ? inp(F, 18) : inp(F, 16)) + (((size_t)j * 2 + d) * 16 + kb) * 4096;
          cvt_tile(F, src, 64, 0, 0, wLRU + (((size_t)d * 2 + gt) * 16 + kb) * 4096, 64, 0, 1.0f); }
    }
}

__device__ __forceinline__ void ph_attn(const Frame& F, int j) {
    const bf16_t* P = (const bf16_t*)(F.R1 + R1_P);
    LAS bf16_t* Ks = (LAS bf16_t*)F.lds;
    LAS bf16_t* Vt = (LAS bf16_t*)(F.lds + 9216);
    LAS float* rp_l = (LAS float*)(F.lds + 18432);
    const float* rpb = inp(F, 10) + (size_t)j * 8 * 465;
    const int g = F.lane >> 4, l15 = F.lane & 15;
    const int NLAT = NBAT * 8 * 64, NTASK = NLAT + NBAT * 8 * 2;
    for (int task = F.wg; task < NTASK; task += F.G) {
        const bool lat = task < NLAT;
        int b, h, rp = 0, half = 0;
        if (lat) { b = task >> 9; h = (task >> 6) & 7; rp = task & 63; } else { const int t2 = task - NLAT; b = t2 >> 4; h = (t2 >> 1) & 7; half = t2 & 1; }
        const int myr = 2 * rp + (F.wave >> 2), w0 = (F.wave & 3) * 16;
        const int r0 = min(max(myr - 4, 0), 120);
        const int rlo = min(max(2 * rp - 4, 0), 120), rhi = min(max(2 * rp + 1 - 4, 0), 120) + 7;
        const int nloc = lat ? (rhi - rlo + 1) : 0;
        const int qrow = lat ? (TC + b * SEQ + myr * 64 + w0 + l15) : (b * CTXL + half * 128 + F.wave * 16 + l15);
        bf16x8 qf[2];
        qf[0] = *(const bf16x8*)(P + (size_t)qrow * 4096 + h * 64 + g * 8);
        qf[1] = *(const bf16x8*)(P + (size_t)qrow * 4096 + h * 64 + 32 + g * 8);
        if (lat) for (int i = F.tid; i < 465; i += 512) rp_l[i] = rpb[h * 465 + i];
        f32x4 oacc[4];
#pragma unroll
        for (int dt = 0; dt < 4; ++dt) oacc[dt] = (f32x4){0.f, 0.f, 0.f, 0.f};
        float mrun = -1e30f, lrun = 0.f;
        const int wq = w0 + l15, c0 = min(max(wq - 8, 0), 48);
        u32x4 kv, vv;
        { const int key = F.tid >> 3, ds = (F.tid & 7) * 8; const bool loc0 = 0 < nloc;
          const int krow = loc0 ? (TC + b * SEQ + rlo * 64 + key) : (b * CTXL + key);
          kv = *(const u32x4*)(P + (size_t)krow * 4096 + 512 + h * 64 + ds); vv = *(const u32x4*)(P + (size_t)krow * 4096 + 1024 + h * 64 + ds); }
        for (int ch = 0; ch < nloc + 4; ++ch) {
            const bool loc = ch < nloc; const int kr = rlo + ch;
            { const int key = F.tid >> 3, ds = (F.tid & 7) * 8;
              __syncthreads();
              *(LAS u32x4*)(Ks + key * 72 + ds) = kv;
              Vt[(ds + 0) * 72 + key] = (bf16_t)(vv.x & 0xffff); Vt[(ds + 1) * 72 + key] = (bf16_t)(vv.x >> 16);
              Vt[(ds + 2) * 72 + key] = (bf16_t)(vv.y & 0xffff); Vt[(ds + 3) * 72 + key] = (bf16_t)(vv.y >> 16);
              Vt[(ds + 4) * 72 + key] = (bf16_t)(vv.z & 0xffff); Vt[(ds + 5) * 72 + key] = (bf16_t)(vv.z >> 16);
              Vt[(ds + 6) * 72 + key] = (bf16_t)(vv.w & 0xffff); Vt[(ds + 7) * 72 + key] = (bf16_t)(vv.w >> 16);
              if (ch + 1 < nloc + 4) { const bool locn = (ch + 1) < nloc;
                  const int krow = locn ? (TC + b * SEQ + (kr + 1) * 64 + key) : (b * CTXL + (ch + 1 - nloc) * 64 + key);
                  kv = *(const u32x4*)(P + (size_t)krow * 4096 + 512 + h * 64 + ds); vv = *(const u32x4*)(P + (size_t)krow * 4096 + 1024 + h * 64 + ds); }
              __syncthreads(); }
            const bool mine = loc ? (kr >= r0 && kr < r0 + 8) : true;
            if (mine) {
                f32x4 s[4];
#pragma unroll
                for (int kb = 0; kb < 4; ++kb) { s[kb] = (f32x4){0.f, 0.f, 0.f, 0.f};
#pragma unroll
                    for (int ks = 0; ks < 2; ++ks) { const bf16x8 a = *(const LAS bf16x8*)(Ks + (kb * 16 + l15) * 72 + ks * 32 + g * 8);
                        s[kb] = __builtin_amdgcn_mfma_f32_16x16x32_bf16(a, qf[ks], s[kb], 0, 0, 0); } }
                if (loc) {
#pragma unroll
                    for (int kb = 0; kb < 4; ++kb)
#pragma unroll
                        for (int i = 0; i < 4; ++i) { const int kc = kb * 16 + 4 * g + i; const bool valid = (kc >= c0) && (kc < c0 + 16);
                            const int bi = (kr - myr + 7) * 31 + min(max(kc - wq + 15, 0), 30);
                            s[kb][i] = valid ? s[kb][i] + rp_l[bi] : -1e30f; }
                }
                float cm = -1e30f;
#pragma unroll
                for (int kb = 0; kb < 4; ++kb)
#pragma unroll
                    for (int i = 0; i < 4; ++i) cm = fmaxf(cm, s[kb][i]);
                cm = fmaxf(cm, __shfl_xor(cm, 16)); cm = fmaxf(cm, __shfl_xor(cm, 32));
                const float mn = fmaxf(mrun, cm), sc = __expf(mrun - mn);
                mrun = mn; lrun *= sc;
#pragma unroll
                for (int dt = 0; dt < 4; ++dt) oacc[dt] *= sc;
                float p[4][4];
#pragma unroll
                for (int kb = 0; kb < 4; ++kb)
#pragma unroll
                    for (int i = 0; i < 4; ++i) { p[kb][i] = __expf(s[kb][i] - mn); lrun += p[kb][i]; }
#pragma unroll
                for (int kp = 0; kp < 2; ++kp) {
                    u32x4 pw; pw.x = cvt_pk_bf16(p[2 * kp][0], p[2 * kp][1]); pw.y = cvt_pk_bf16(p[2 * kp][2], p[2 * kp][3]);
                    pw.z = cvt_pk_bf16(p[2 * kp + 1][0], p[2 * kp + 1][1]); pw.w = cvt_pk_bf16(p[2 * kp + 1][2], p[2 * kp + 1][3]);
                    bf16x8 pf; __builtin_memcpy(&pf, &pw, 16);
#pragma unroll
                    for (int dt = 0; dt < 4; ++dt) {
                        const u32x2 v0 = *(const LAS u32x2*)(Vt + (dt * 16 + l15) * 72 + (2 * kp) * 16 + 4 * g);
                        const u32x2 v1 = *(const LAS u32x2*)(Vt + (dt * 16 + l15) * 72 + (2 * kp + 1) * 16 + 4 * g);
                        u32x4 vw; vw.x = v0.x; vw.y = v0.y; vw.z = v1.x; vw.w = v1.y; bf16x8 vf; __builtin_memcpy(&vf, &vw, 16);
                        oacc[dt] = __builtin_amdgcn_mfma_f32_16x16x32_bf16(vf, pf, oacc[dt], 0, 0, 0);
                    }
                }
            }
        }
        float lt = lrun; lt += __shfl_xor(lt, 16); lt += __shfl_xor(lt, 32);
        const float inv = 1.0f / lt;
#pragma unroll
        for (int dt = 0; dt < 4; ++dt) { const f32x4 o = oacc[dt] * inv; u32x2 w; w.x = cvt_pk_bf16(o[0], o[1]); w.y = cvt_pk_bf16(o[2], o[3]);
            *(u32x2*)(F.MIX + (size_t)qrow * DM + h * 64 + dt * 16 + 4 * g) = w; }
        __syncthreads();
    }
}

__device__ __forceinline__ int hg_unit(int nb, int dir) { return dir == 0 ? nb : (nb < 2 ? 1 - nb : 2 + (HG_NU - 3 - (nb - 2))); }
__device__ __forceinline__ int hg_row(int b, int nb, int t) { return nb < 2 ? b * CTXL + nb * HG_U + t : TC + b * SEQ + (nb - 2) * HG_U + t; }
template <int CTRL> __device__ __forceinline__ float dpp_add0(float x) { return x + dppf<CTRL>(0.0f, x); }
template <bool WITHO>
__device__ __forceinline__ void hg_pass(const Frame& F, const bf16_t* P, const float* lbh, int b, int h, int nb, int dir, f32x4 (&S)[4][4], float (&Gsum)[16],
                                        LAS bf16_t* Vl, LAS bf16_t* Kl, float* OF, const float* ngp) {
    const int tau = F.lane & 15, g = F.lane >> 4;
    const unsigned vaddr = (unsigned)(size_t)Vl + (unsigned)((4 * g + (tau >> 2)) * 128 + (tau & 3) * 8);
    const unsigned kaddr = (unsigned)(size_t)Kl + (unsigned)((4 * g + (tau >> 2)) * 128 + (tau & 3) * 8);
    u32x2 zr[4], vr[4], qr[4];
    { const int t = dir ? (HG_U - 1 - tau) : tau; const bf16_t* pr = P + (size_t)hg_row(b, nb, t) * 4096 + h * 64 + 4 * g;
#pragma unroll
      for (int m = 0; m < 4; ++m) { zr[m] = *(const u32x2*)(pr + (dir ? 2560 : 2048) + 16 * m); vr[m] = *(const u32x2*)(pr + 3072 + 16 * m); } }
    for (int ci = 0; ci < HG_U / 16; ++ci) {
        float kk[16], c[16];
        if (WITHO) { const int pos = ci * 16 + tau, t = dir ? (HG_U - 1 - pos) : pos; const bf16_t* pr = P + (size_t)hg_row(b, nb, t) * 4096 + h * 64 + 4 * g;
#pragma unroll
            for (int m = 0; m < 4; ++m) qr[m] = *(const u32x2*)(pr + 1536 + 16 * m); }
#pragma unroll
        for (int m = 0; m < 4; ++m) { const float z0 = __uint_as_float(zr[m].x << 16), z1 = __uint_as_float(zr[m].x & 0xffff0000u), z2 = __uint_as_float(zr[m].y << 16), z3 = __uint_as_float(zr[m].y & 0xffff0000u);
            const float zz[4] = {z0, z1, z2, z3};
            const f32x4 lb4 = *(const f32x4*)(lbh + 16 * m + 4 * g);
#pragma unroll
            for (int i = 0; i < 4; ++i) { const float lb = lb4[i]; const float f = fmaxf(lb + (1.0f - lb) * sigmoidf_(zz[i]), 1e-30f); kk[m * 4 + i] = 1.0f - f; c[m * 4 + i] = __logf(f); }
            *(LAS u32x2*)(Vl + tau * 64 + 16 * m + 4 * g) = vr[m];
 }
        if (ci + 1 < HG_U / 16) { const int pos = (ci + 1) * 16 + tau, t = dir ? (HG_U - 1 - pos) : pos; const bf16_t* pr = P + (size_t)hg_row(b, nb, t) * 4096 + h * 64 + 4 * g;
#pragma unroll
            for (int m = 0; m < 4; ++m) { zr[m] = *(const u32x2*)(pr + (dir ? 2560 : 2048) + 16 * m); vr[m] = *(const u32x2*)(pr + 3072 + 16 * m); } }
#pragma unroll
        for (int q = 0; q < 16; ++q) { c[q] = dpp_add0<0x111>(c[q]); c[q] = dpp_add0<0x112>(c[q]); c[q] = dpp_add0<0x114>(c[q]); c[q] = dpp_add0<0x118>(c[q]); }
        float G[16];
#pragma unroll
        for (int q = 0; q < 16; ++q) { G[q] = __shfl(c[q], (F.lane & 48) | 15); Gsum[q] += G[q]; }
#pragma unroll
        for (int m = 0; m < 4; ++m) { float kh[4];
#pragma unroll
            for (int i = 0; i < 4; ++i) kh[i] = kk[m * 4 + i] * __expf(G[m * 4 + i] - c[m * 4 + i]);
            u32x2 w; w.x = cvt_pk_bf16(kh[0], kh[1]); w.y = cvt_pk_bf16(kh[2], kh[3]);
            *(LAS u32x2*)(Kl + tau * 64 + 16 * m + 4 * g) = w; }
        float ofv[4][4], gtv[4][4]; int orow[4];
        if (WITHO) {
#pragma unroll
            for (int i = 0; i < 4; ++i) { const int p2 = ci * 16 + 4 * g + i, t2 = dir ? (HG_U - 1 - p2) : p2; orow[i] = hg_row(b, nb, t2); }
            if (dir) {
#pragma unroll
                for (int i = 0; i < 4; ++i)
#pragma unroll
                    for (int vt = 0; vt < 4; ++vt) { ofv[i][vt] = OF[(size_t)orow[i] * 512 + h * 64 + 16 * vt + tau]; gtv[i][vt] = bf2f(P[(size_t)orow[i] * 4096 + 3584 + h * 64 + 16 * vt + tau]); }
            }
        }
        asm volatile("s_waitcnt lgkmcnt(0)" ::: "memory");
        u32x2 vtr[4], ktr[4];
        asm volatile("ds_read_b64_tr_b16 %0, %8\n\tds_read_b64_tr_b16 %1, %8 offset:32\n\tds_read_b64_tr_b16 %2, %8 offset:64\n\tds_read_b64_tr_b16 %3, %8 offset:96\n\t"
                     "ds_read_b64_tr_b16 %4, %9\n\tds_read_b64_tr_b16 %5, %9 offset:32\n\tds_read_b64_tr_b16 %6, %9 offset:64\n\tds_read_b64_tr_b16 %7, %9 offset:96\n\ts_waitcnt lgkmcnt(0)"
                     : "=&v"(vtr[0]), "=&v"(vtr[1]), "=&v"(vtr[2]), "=&v"(vtr[3]), "=&v"(ktr[0]), "=&v"(ktr[1]), "=&v"(ktr[2]), "=&v"(ktr[3]) : "v"(vaddr), "v"(kaddr) : "memory");
        bf16x8 Vf[4], Kf[4];
#pragma unroll
        for (int q = 0; q < 4; ++q) { u32x4 w; w.x = vtr[q].x; w.y = vtr[q].y; w.z = 0u; w.w = 0u; __builtin_memcpy(&Vf[q], &w, 16); u32x4 w2; w2.x = ktr[q].x; w2.y = ktr[q].y; w2.z = 0u; w2.w = 0u; __builtin_memcpy(&Kf[q], &w2, 16); }
        if (WITHO) {
            bf16x8 Ktf[2], Qtf[2], Qhf[2];
#pragma unroll
            for (int ks = 0; ks < 2; ++ks) { float kt_[8], qt_[8], qh_[8];
#pragma unroll
                for (int mm = 0; mm < 2; ++mm) { const int m = 2 * ks + mm;
                    const float qq[4] = {__uint_as_float(qr[m].x << 16), __uint_as_float(qr[m].x & 0xffff0000u), __uint_as_float(qr[m].y << 16), __uint_as_float(qr[m].y & 0xffff0000u)};
#pragma unroll
                    for (int i = 0; i < 4; ++i) { const int q = m * 4 + i; const float qv = siluf_(qq[i]) * 0.125f; const float d = fminf(fmaxf(c[q] - 0.5f * G[q], -80.0f), 80.0f);
                        qt_[mm * 4 + i] = qv * __expf(d); kt_[mm * 4 + i] = kk[q] * __expf(-d); qh_[mm * 4 + i] = qv * __expf(c[q]); } }
                u32x4 w; w.x = cvt_pk_bf16(kt_[0], kt_[1]); w.y = cvt_pk_bf16(kt_[2], kt_[3]); w.z = cvt_pk_bf16(kt_[4], kt_[5]); w.w = cvt_pk_bf16(kt_[6], kt_[7]); __builtin_memcpy(&Ktf[ks], &w, 16);
                w.x = cvt_pk_bf16(qt_[0], qt_[1]); w.y = cvt_pk_bf16(qt_[2], qt_[3]); w.z = cvt_pk_bf16(qt_[4], qt_[5]); w.w = cvt_pk_bf16(qt_[6], qt_[7]); __builtin_memcpy(&Qtf[ks], &w, 16);
                w.x = cvt_pk_bf16(qh_[0], qh_[1]); w.y = cvt_pk_bf16(qh_[2], qh_[3]); w.z = cvt_pk_bf16(qh_[4], qh_[5]); w.w = cvt_pk_bf16(qh_[6], qh_[7]); __builtin_memcpy(&Qhf[ks], &w, 16); }
            f32x4 AT = (f32x4){0.f, 0.f, 0.f, 0.f};
            AT = __builtin_amdgcn_mfma_f32_16x16x32_bf16(Ktf[0], Qtf[0], AT, 0, 0, 0); AT = __builtin_amdgcn_mfma_f32_16x16x32_bf16(Ktf[1], Qtf[1], AT, 0, 0, 0);
#pragma unroll
            for (int i = 0; i < 4; ++i) AT[i] = (4 * g + i <= tau) ? AT[i] : 0.0f;
            bf16x8 Af; { u32x4 w; w.x = cvt_pk_bf16(AT[0], AT[1]); w.y = cvt_pk_bf16(AT[2], AT[3]); w.z = 0u; w.w = 0u; __builtin_memcpy(&Af, &w, 16); }
            f32x4 o[4];
#pragma unroll
            for (int vt = 0; vt < 4; ++vt) { o[vt] = __builtin_amdgcn_mfma_f32_16x16x32_bf16(Af, Vf[vt], (f32x4){0.f, 0.f, 0.f, 0.f}, 0, 0, 0);
#pragma unroll
                for (int ks = 0; ks < 2; ++ks) { u32x4 w; w.x = cvt_pk_bf16(S[2 * ks][vt][0], S[2 * ks][vt][1]); w.y = cvt_pk_bf16(S[2 * ks][vt][2], S[2 * ks][vt][3]);
                    w.z = cvt_pk_bf16(S[2 * ks + 1][vt][0], S[2 * ks + 1][vt][1]); w.w = cvt_pk_bf16(S[2 * ks + 1][vt][2], S[2 * ks + 1][vt][3]); bf16x8 Sf; __builtin_memcpy(&Sf, &w, 16);
                    o[vt] = __builtin_amdgcn_mfma_f32_16x16x32_bf16(Qhf[ks], Sf, o[vt], 0, 0, 0); } }
            if (dir == 0) {
#pragma unroll
                for (int i = 0; i < 4; ++i)
#pragma unroll
                    for (int vt = 0; vt < 4; ++vt) OF[(size_t)orow[i] * 512 + h * 64 + 16 * vt + tau] = o[vt][i];
            } else {
#pragma unroll
                for (int i = 0; i < 4; ++i) { float tot[4]; float sq = 0.f;
#pragma unroll
                    for (int vt = 0; vt < 4; ++vt) { tot[vt] = o[vt][i] + ofv[i][vt]; sq = fmaf(tot[vt], tot[vt], sq); }
                    sq += dppf<0xB1>(sq, sq); sq += dppf<0x4E>(sq, sq); sq += dppf<0x141>(sq, sq); sq += dppf<0x140>(sq, sq);
                    const float rs = rsqrtf(sq * (1.0f / 64.0f) + 1e-6f);
#pragma unroll
                    for (int vt = 0; vt < 4; ++vt) F.MIX[(size_t)orow[i] * DM + 512 + h * 64 + 16 * vt + tau] = f2bf(tot[vt] * rs * ngp[16 * vt + tau] * siluf_(gtv[i][vt])); }
            }
        }
#pragma unroll
        for (int kt = 0; kt < 4; ++kt) { f32x4 eg;
#pragma unroll
            for (int i = 0; i < 4; ++i) eg[i] = __expf(G[kt * 4 + i]);
#pragma unroll
            for (int vt = 0; vt < 4; ++vt) S[kt][vt] = __builtin_amdgcn_mfma_f32_16x16x32_bf16(Kf[kt], Vf[vt], S[kt][vt] * eg, 0, 0, 0); }
    }
}
__device__ __forceinline__ void ph_hg_a(const Frame& F, int j) {
    const bf16_t* P = (const bf16_t*)(F.R1 + R1_P);
    float* SLOC = (float*)(F.R1 + R1_SLOC); float* DL = (float*)(F.R1 + R1_DL);
    LAS bf16_t* Vl = (LAS bf16_t*)(F.lds + 32768 + F.wave * 4096); LAS bf16_t* Kl = Vl + 1024;
    const int gw = F.wg * 8 + F.wave, nw = F.G * 8;
    const int NT = NBAT * 8 * HG_NU * 2;
    for (int task = gw; task < NT; task += nw) {
        const int dir = task & 1, nb = (task >> 1) % HG_NU, bh = (task >> 1) / HG_NU, b = bh >> 3, h = bh & 7;
        const float* lbh = (const float*)(F.ws + OFF_LBT) + (j * 2 + dir) * 512 + h * 64;
        f32x4 S[4][4];
#pragma unroll
        for (int kt = 0; kt < 4; ++kt)
#pragma unroll
            for (int vt = 0; vt < 4; ++vt) S[kt][vt] = (f32x4){0.f, 0.f, 0.f, 0.f};
        float Gsum[16];
#pragma unroll
        for (int q = 0; q < 16; ++q) Gsum[q] = 0.f;
        hg_pass<false>(F, P, lbh, b, h, nb, dir, S, Gsum, Vl, Kl, nullptr, nullptr);
        const int seq = bh * 2 + dir, u = hg_unit(nb, dir);
        float* so = SLOC + ((size_t)seq * HG_NU + u) * 4096;
#pragma unroll
        for (int kt = 0; kt < 4; ++kt)
#pragma unroll
            for (int vt = 0; vt < 4; ++vt)
#pragma unroll
                for (int i = 0; i < 4; ++i) so[((kt * 4 + vt) * 4 + i) * 64 + F.lane] = S[kt][vt][i];
        if ((F.lane & 15) == 0) { float* dd = DL + ((size_t)seq * HG_NU + u) * 64;
#pragma unroll
            for (int m = 0; m < 4; ++m)
#pragma unroll
                for (int i = 0; i < 4; ++i) dd[16 * m + 4 * (F.lane >> 4) + i] = __expf(Gsum[m * 4 + i]); }
    }
}
__device__ __forceinline__ void ph_hg_b(const Frame& F) {
    const float* SLOC = (const float*)(F.R1 + R1_SLOC); const float* DL = (const float*)(F.R1 + R1_DL); float* SST = (float*)(F.R1 + R1_SST);
    for (int idx = F.wg * 512 + F.tid; idx < 64 * 4096; idx += F.G * 512) {
        const int seq = idx >> 12, e = idx & 4095, ln = e & 63, reg = e >> 6, i = reg & 3, kt = reg >> 4, k = 16 * kt + 4 * (ln >> 4) + i;
        float s = 0.f;
#pragma unroll 6
        for (int u = 0; u < HG_NU; ++u) { const size_t o = ((size_t)seq * HG_NU + u) * 4096 + e; SST[o] = s; s = DL[((size_t)seq * HG_NU + u) * 64 + k] * s + SLOC[o]; }
    }
}
__device__ __forceinline__ void ph_hg_c(const Frame& F, int j) {
    const bf16_t* P = (const bf16_t*)(F.R1 + R1_P);
    const float* SST = (const float*)(F.R1 + R1_SST); float* OF = (float*)(F.R1 + R1_OF);
    const float* ng = inp(F, 12) + j * 64;
    LAS bf16_t* Vl = (LAS bf16_t*)(F.lds + 32768 + F.wave * 4096); LAS bf16_t* Kl = Vl + 1024;
    const int gw = F.wg * 8 + F.wave, nw = F.G * 8;
    const int NT = NBAT * 8 * HG_NU;
    for (int task = gw; task < NT; task += nw) {
        const int nb = task % HG_NU, bh = task / HG_NU, b = bh >> 3, h = bh & 7;
        for (int dir = 0; dir < 2; ++dir) {
            const float* lbh = (const float*)(F.ws + OFF_LBT) + (j * 2 + dir) * 512 + h * 64;
            const int seq = bh * 2 + dir, u = hg_unit(nb, dir);
            const float* ss = SST + ((size_t)seq * HG_NU + u) * 4096;
            f32x4 S[4][4];
#pragma unroll
            for (int kt = 0; kt < 4; ++kt)
#pragma unroll
                for (int vt = 0; vt < 4; ++vt)
#pragma unroll
                    for (int i = 0; i < 4; ++i) S[kt][vt][i] = ss[((kt * 4 + vt) * 4 + i) * 64 + F.lane];
            float Gsum[16];
#pragma unroll
            for (int q = 0; q < 16; ++q) Gsum[q] = 0.f;
            hg_pass<true>(F, P, lbh, b, h, nb, dir, S, Gsum, Vl, Kl, OF, ng);
            asm volatile("s_waitcnt vmcnt(0)" ::: "memory");
        }
    }
}

__device__ __forceinline__ int lru_nat(int so, int dir) { return dir == 0 ? so : (so < 16 ? 15 - so : 16 + (LRU_NT - 1 - so)); }
__device__ __forceinline__ int lru_row(int b, int nt, int t) { return nt < 16 ? b * CTXL + nt * 16 + t : TC + b * SEQ + (nt - 16) * 16 + t; }
struct LruRaw { u32x4 a[4], b[4]; };
__device__ __forceinline__ void lru_load(const Frame& F, int b, int kb, int nt, LruRaw& R) {
    const bf16_t* P = (const bf16_t*)(F.R1 + R1_P);
    const int tk = F.lane & 15, g = F.lane >> 4;
    const int len = nt < 16 ? CTXL : SEQ, tpos = (nt < 16 ? nt * 16 : (nt - 16) * 16) + tk;
    const bf16_t* pbase = P + (size_t)((nt < 16 ? b * CTXL : TC + b * SEQ)) * 2048 + 1024 + kb * 64 + g * 16;
#pragma unroll
    for (int tap = 0; tap < 4; ++tap) { const int tp = tpos + tap - 2; const bool ok = (tp >= 0 && tp < len); const bf16_t* pr = pbase + (size_t)(ok ? tp : tpos) * 2048;
        R.a[tap] = *(const u32x4*)pr; R.b[tap] = *(const u32x4*)(pr + 8); if (!ok) { R.a[tap] = (u32x4){0u, 0u, 0u, 0u}; R.b[tap] = (u32x4){0u, 0u, 0u, 0u}; } }
}
__device__ __forceinline__ void lru_conv(const Frame& F, const LruRaw& R, const LAS float* CT, LAS float* ucb) {
    const int tk = F.lane & 15, g = F.lane >> 4;
    float acc[16];
#pragma unroll
    for (int q = 0; q < 4; ++q) { const f32x4 c4 = *(const LAS f32x4*)(CT + 4 * 64 + g * 16 + q * 4); acc[q * 4] = c4[0]; acc[q * 4 + 1] = c4[1]; acc[q * 4 + 2] = c4[2]; acc[q * 4 + 3] = c4[3]; }
#pragma unroll
    for (int tap = 0; tap < 4; ++tap) { float t0[8], t1[8]; unpack8(R.a[tap], t0); unpack8(R.b[tap], t1);
#pragma unroll
        for (int q = 0; q < 2; ++q) { const f32x4 w0 = *(const LAS f32x4*)(CT + tap * 64 + g * 16 + q * 4), w1 = *(const LAS f32x4*)(CT + tap * 64 + g * 16 + 8 + q * 4);
#pragma unroll
            for (int i = 0; i < 4; ++i) { acc[q * 4 + i] = fmaf(w0[i], t0[q * 4 + i], acc[q * 4 + i]); acc[8 + q * 4 + i] = fmaf(w1[i], t1[q * 4 + i], acc[8 + q * 4 + i]); } } }
#pragma unroll
    for (int q = 0; q < 4; ++q) *(LAS f32x4*)(ucb + tk * 64 + g * 16 + q * 4) = (f32x4){acc[q * 4], acc[q * 4 + 1], acc[q * 4 + 2], acc[q * 4 + 3]};
}
__device__ __forceinline__ void lru_gates(const Frame& F, LAS bf16_t* Wl, const LAS float* CT, LAS float* ucb, float (&av)[2][4][4], float (&xv)[2][4][4]) {
    const int tk = F.lane & 15, g = F.lane >> 4;
    bf16x8 bfr[2];
#pragma unroll
    for (int ks = 0; ks < 2; ++ks) { const f32x4 u0 = *(const LAS f32x4*)(ucb + tk * 64 + ks * 32 + g * 8), u1 = *(const LAS f32x4*)(ucb + tk * 64 + ks * 32 + g * 8 + 4);
        u32x4 w; w.x = cvt_pk_bf16(u0[0], u0[1]); w.y = cvt_pk_bf16(u0[2], u0[3]); w.z = cvt_pk_bf16(u1[0], u1[1]); w.w = cvt_pk_bf16(u1[2], u1[3]); __builtin_memcpy(&bfr[ks], &w, 16); }
#pragma unroll
    for (int d = 0; d < 2; ++d)
#pragma unroll
        for (int et = 0; et < 4; ++et) {
            f32x4 ra = (f32x4){0.f, 0.f, 0.f, 0.f}, ri = (f32x4){0.f, 0.f, 0.f, 0.f};
#pragma unroll
            for (int ks = 0; ks < 2; ++ks) {
                const bf16x8 wa = *(const LAS bf16x8*)(Wl + ((d * 2 + 0) * 64 + et * 16 + tk) * 64 + ks * 32 + g * 8);
                const bf16x8 wx = *(const LAS bf16x8*)(Wl + ((d * 2 + 1) * 64 + et * 16 + tk) * 64 + ks * 32 + g * 8);
                ra = __builtin_amdgcn_mfma_f32_16x16x32_bf16(wa, bfr[ks], ra, 0, 0, 0);
                ri = __builtin_amdgcn_mfma_f32_16x16x32_bf16(wx, bfr[ks], ri, 0, 0, 0);
            }
            const f32x4 ba4 = *(const LAS f32x4*)(CT + (5 + 3 * d) * 64 + et * 16 + 4 * g), bx4 = *(const LAS f32x4*)(CT + (6 + 3 * d) * 64 + et * 16 + 4 * g), cs4 = *(const LAS f32x4*)(CT + (7 + 3 * d) * 64 + et * 16 + 4 * g);
            const f32x4 u4 = *(const LAS f32x4*)(ucb + tk * 64 + et * 16 + 4 * g);
#pragma unroll
            for (int i = 0; i < 4; ++i) {
                const float r = sigmoidf_(ra[i] + ba4[i]), ig = sigmoidf_(ri[i] + bx4[i]);
                const float a = __expf(cs4[i] * r);
                av[d][et][i] = a; xv[d][et][i] = sqrtf(fmaxf(1.0f - a * a, 0.f)) * ig * u4[i]; }
        }
}
template <int S> __device__ __forceinline__ void lru_step_f(float& a, float& x) { const float ap = dppf<0x110 + S>(1.0f, a), xp = dppf<0x110 + S>(0.0f, x); x = fmaf(a, xp, x); a = a * ap; }
template <int S> __device__ __forceinline__ void lru_step_b(float& a, float& x) { const float ap = dppf<0x100 + S>(1.0f, a), xp = dppf<0x100 + S>(0.0f, x); x = fmaf(a, xp, x); a = a * ap; }
template <bool FINAL>
__device__ __forceinline__ void ph_lru_ac(const Frame& F, int jj) {
    LAS bf16_t* Wl = (LAS bf16_t*)F.lds;
    LAS float* ucb = (LAS float*)(F.lds + 32768 + F.wave * 4096);
    LAS float* CT = (LAS float*)(F.lds + 65536);
    const bf16_t* wsrc = (const bf16_t*)(F.WB + WB_LRU);
    float* AG = (float*)(F.R1 + R1_AG); const float* HST = (const float*)(F.R1 + R1_HST);
    const bf16_t* P = (const bf16_t*)(F.R1 + R1_P);
    const float* cw = inp(F, 14) + (size_t)jj * 4 * 1024; const float* cb = inp(F, 15) + (size_t)jj * 1024;
    const float* b_a = inp(F, 17) + (size_t)jj * 2 * 1024; const float* b_x = inp(F, 19) + (size_t)jj * 2 * 1024; const float* lam = inp(F, 20) + (size_t)jj * 2 * 1024;
    const int tk = F.lane & 15, g = F.lane >> 4;
    const int NTASK = NBAT * 16 * 11;
    for (int task = F.wg; task < NTASK; task += F.G) {
        const int grp = task % 11, kb = (task / 11) & 15, b = task / (11 * 16);
        __syncthreads();
        for (int i = F.tid; i < 4 * 4096 / 8; i += 512) { const int mg = i >> 9, r = i & 511;
            *(LAS u32x4*)(Wl + mg * 4096 + r * 8) = *(const u32x4*)(wsrc + ((size_t)mg * 16 + kb) * 4096 + r * 8); }
        for (int i = F.tid; i < 11 * 64; i += 512) { const int kind = i >> 6, ch = kb * 64 + (i & 63); float v;
            if (kind < 4) v = cw[kind * 1024 + ch]; else if (kind == 4) v = cb[ch];
            else { const int d = (kind - 5) / 3, w = (kind - 5) % 3; v = (w == 0) ? b_a[d * 1024 + ch] : (w == 1) ? b_x[d * 1024 + ch] : -8.0f * log1pf(__expf(-lam[d * 1024 + ch])); }
            CT[i] = v; }
        __syncthreads();
        const int nt0 = grp * 48;
        LruRaw raw; lru_load(F, b, kb, nt0 + F.wave, raw);
        for (int ti = F.wave; ti < 48; ti += 8) {
            const int nt = nt0 + ti;
            float av[2][4][4], xv[2][4][4];
            if (FINAL && ti != F.wave) lru_load(F, b, kb, nt, raw);
            lru_conv(F, raw, CT, ucb);
            if (!FINAL && ti + 8 < 48) lru_load(F, b, kb, nt + 8, raw);
            const int row = lru_row(b, nt, tk);
            lru_gates(F, Wl, CT, ucb, av, xv);
            u32x2 yw[4];
            if (FINAL) {
#pragma unroll
                for (int et = 0; et < 4; ++et) yw[et] = *(const u32x2*)(P + (size_t)row * 2048 + kb * 64 + et * 16 + 4 * g);
            }
#pragma unroll
            for (int et = 0; et < 4; ++et)
#pragma unroll
                for (int i = 0; i < 4; ++i) {
                    lru_step_f<1>(av[0][et][i], xv[0][et][i]); lru_step_f<2>(av[0][et][i], xv[0][et][i]); lru_step_f<4>(av[0][et][i], xv[0][et][i]); lru_step_f<8>(av[0][et][i], xv[0][et][i]);
                    lru_step_b<1>(av[1][et][i], xv[1][et][i]); lru_step_b<2>(av[1][et][i], xv[1][et][i]); lru_step_b<4>(av[1][et][i], xv[1][et][i]); lru_step_b<8>(av[1][et][i], xv[1][et][i]);
                }
            if (!FINAL) {
#pragma unroll
                for (int d = 0; d < 2; ++d) if (tk == (d ? 0 : 15)) {
                    float* ag = AG + (((size_t)(b * 2 + d) * LRU_NT + nt) * 2) * 1024 + kb * 64;
#pragma unroll
                    for (int et = 0; et < 4; ++et) { *(f32x4*)(ag + et * 16 + 4 * g) = (f32x4){av[d][et][0], av[d][et][1], av[d][et][2], av[d][et][3]};
                        *(f32x4*)(ag + 1024 + et * 16 + 4 * g) = (f32x4){xv[d][et][0], xv[d][et][1], xv[d][et][2], xv[d][et][3]}; }
                }
            } else {
                f32x4 hf[4], hb[4];
#pragma unroll
                for (int et = 0; et < 4; ++et) { const int ch = kb * 64 + et * 16 + 4 * g;
                    hf[et] = *(const f32x4*)(HST + ((size_t)(b * 2 + 0) * LRU_NT + nt) * 1024 + ch);
                    hb[et] = *(const f32x4*)(HST + ((size_t)(b * 2 + 1) * LRU_NT + nt) * 1024 + ch); }
#pragma unroll
                for (int et = 0; et < 4; ++et) {
                    const int ch = kb * 64 + et * 16 + 4 * g;
                    const float y0 = __uint_as_float(yw[et].x << 16), y1 = __uint_as_float(yw[et].x & 0xffff0000u), y2 = __uint_as_float(yw[et].y << 16), y3 = __uint_as_float(yw[et].y & 0xffff0000u);
                    float o[4];
#pragma unroll
                    for (int i = 0; i < 4; ++i) o[i] = fmaf(av[0][et][i], hf[et][i], xv[0][et][i]) + fmaf(av[1][et][i], hb[et][i], xv[1][et][i]);
                    o[0] *= gelu_tanh_(y0); o[1] *= gelu_tanh_(y1); o[2] *= gelu_tanh_(y2); o[3] *= gelu_tanh_(y3);
                    u32x2 w; w.x = cvt_pk_bf16(o[0], o[1]); w.y = cvt_pk_bf16(o[2], o[3]);
                    *(u32x2*)(F.MIX + (size_t)row * DM + ch) = w;
                }
            }
        }
    }
    __syncthreads();
}
__device__ __forceinline__ void ph_lru_b(const Frame& F) {
    const float* AG = (const float*)(F.R1 + R1_AG); float* HST = (float*)(F.R1 + R1_HST);
    LAS float* sa = (LAS float*)F.lds; LAS float* sx = sa + 512;
    for (int task = F.wg; task < NBAT * 2 * 32; task += F.G) {
        const int cgp = task & 31, d = (task >> 5) & 1, b = task >> 6;
        const int ch = cgp * 32 + (F.tid & 31), seg = F.tid >> 5;
        const float* ag = AG + ((size_t)(b * 2 + d) * LRU_NT) * 2048 + ch;
        float A = 1.0f, Xv = 0.f;
        for (int i = 0; i < 33; ++i) { const int nt = lru_nat(seg * 33 + i, d); const float a = ag[(size_t)nt * 2048], x = ag[(size_t)nt * 2048 + 1024]; Xv = fmaf(a, Xv, x); A *= a; }
        __syncthreads();
        sa[F.tid] = A; sx[F.tid] = Xv;
        __syncthreads();
        float h = 0.f;
        for (int s2 = 0; s2 < seg; ++s2) h = fmaf(sa[s2 * 32 + (F.tid & 31)], h, sx[s2 * 32 + (F.tid & 31)]);
        float* hs = HST + ((size_t)(b * 2 + d) * LRU_NT) * 1024 + ch;
        for (int i = 0; i < 33; ++i) { const int nt = lru_nat(seg * 33 + i, d); hs[(size_t)nt * 1024] = h; const float a = ag[(size_t)nt * 2048], x = ag[(size_t)nt * 2048 + 1024]; h = fmaf(a, h, x); }
    }
    __syncthreads();
}

__device__ __forceinline__ void topk_better(float& bk, int& be, float& bs, float ok, int oe, float os) { const bool t = (ok > bk) || (ok == bk && oe < be); bk = t ? ok : bk; be = t ? oe : be; bs = t ? os : bs; }
template <int CTRL> __device__ __forceinline__ void topk_step(float& bk, int& be, float& bs) {
    const float ok = dppf<CTRL>(bk, bk), os = dppf<CTRL>(bs, bs); const int oe = __builtin_amdgcn_update_dpp(be, be, CTRL, 0xf, 0xf, false); topk_better(bk, be, bs, ok, oe, os); }
__device__ __forceinline__ void ph_ln_router(const Frame& F, int l, bool dry = false) {
    const bf16_t* RW = (const bf16_t*)(F.WB + WB_RT);
    const float* rbias = inp(F, 23) + l * 64;
    LAS float* part = (LAS float*)F.lds;
    LAS float* LP = (LAS float*)(F.lds + 4096);
    LAS int* hist = (LAS int*)(F.lds + LDS_MISC + MISC_HIST); LAS int* hbase = (LAS int*)(F.lds + LDS_MISC + MISC_HBASE);
    int* tok_e = (int*)(F.ws + OFF_TOKE); int* tok_p = (int*)(F.ws + OFF_TOKP); float* tok_w = (float*)(F.ws + OFF_TOKW);
    int* stok = (int*)(F.ws + OFF_STOK); float* sw = (float*)(F.ws + OFF_SW);
    float* stats = (float*)(F.ws + OFF_STATS);
    unsigned* gcnt = (unsigned*)(F.ws + OFF_CTL + CTL_CNT) + l * 64;
    const int tk = F.lane & 15, g = F.lane >> 4;
    float rb[4];
#pragma unroll
    for (int q = 0; q < 4; ++q) rb[q] = rbias[tk + 16 * q];
    if (F.tid < 64) hist[F.tid] = 0;
    __syncthreads();
    const int NTILE = TT / 16;
    for (int tile = F.wg; tile < NTILE; tile += F.G) {
        const int row = tile * 16 + tk; const int s = slot_of_row(tile * 16);
        const float* ab = (const float*)(F.ws + OFF_AB) + (size_t)(l * 5 + s) * 2048;
        const float* xr = F.X + (size_t)row * DM + F.wave * 128 + g * 8;
        f32x4 v[4][2];
#pragma unroll
        for (int ks = 0; ks < 4; ++ks) { v[ks][0] = *(const f32x4*)(xr + ks * 32); v[ks][1] = *(const f32x4*)(xr + ks * 32 + 4); }
        float sum = 0.f, sq = 0.f;
#pragma unroll
        for (int ks = 0; ks < 4; ++ks)
#pragma unroll
            for (int hh = 0; hh < 2; ++hh) { const f32x4 a = v[ks][hh]; sum += (a[0] + a[1]) + (a[2] + a[3]); sq += (a[0] * a[0] + a[1] * a[1]) + (a[2] * a[2] + a[3] * a[3]); }
        sum += __shfl_xor(sum, 16); sum += __shfl_xor(sum, 32); sq += __shfl_xor(sq, 16); sq += __shfl_xor(sq, 32);
        if (g == 0) *(LAS f32x2*)(part + (F.wave * 16 + tk) * 2) = (f32x2){sum, sq};
        __syncthreads();
        float ts = 0.f, tq = 0.f;
#pragma unroll
        for (int w = 0; w < 8; ++w) { const f32x2 p = *(const LAS f32x2*)(part + (w * 16 + tk) * 2); ts += p.x; tq += p.y; }
        const float mean = ts * (1.0f / 1024.0f), var = fmaxf(tq * (1.0f / 1024.0f) - mean * mean, 0.f), rstd = rsqrtf(var + 1e-5f);
        if (F.wave == 0 && g == 0) *(f32x2*)(stats + (size_t)row * 2) = (f32x2){mean, rstd};
        f32x4 acc[4];
#pragma unroll
        for (int et = 0; et < 4; ++et) acc[et] = (f32x4){0.f, 0.f, 0.f, 0.f};
#pragma unroll
        for (int ks = 0; ks < 4; ++ks) { const int k = F.wave * 128 + ks * 32 + g * 8;
            const f32x4 a10 = *(const f32x4*)(ab + k), a11 = *(const f32x4*)(ab + k + 4), b10 = *(const f32x4*)(ab + 1024 + k), b11 = *(const f32x4*)(ab + 1024 + k + 4);
            const f32x4 h0 = (v[ks][0] - mean) * rstd * a10 + b10, h1 = (v[ks][1] - mean) * rstd * a11 + b11;
            u32x4 w; w.x = cvt_pk_bf16(h0[0], h0[1]); w.y = cvt_pk_bf16(h0[2], h0[3]); w.z = cvt_pk_bf16(h1[0], h1[1]); w.w = cvt_pk_bf16(h1[2], h1[3]);
            *(u32x4*)(F.HB + (size_t)row * DM + k) = w;
            bf16x8 af; __builtin_memcpy(&af, &w, 16);
#pragma unroll
            for (int et = 0; et < 4; ++et) { const bf16x8 bf = *(const bf16x8*)(RW + (size_t)(et * 16 + tk) * 1024 + k); acc[et] = __builtin_amdgcn_mfma_f32_16x16x32_bf16(af, bf, acc[et], 0, 0, 0); }
        }
#pragma unroll
        for (int et = 0; et < 4; ++et)
#pragma unroll
            for (int i = 0; i < 4; ++i) LP[(F.wave * 16 + 4 * g + i) * 64 + et * 16 + tk] = acc[et][i];
        __syncthreads();
        {
            const int t = 2 * F.wave + (g & 1), r2 = tile * 16 + t;
            float sc[4], key[4];
#pragma unroll
            for (int q = 0; q < 4; ++q) { float lgt = 0.f;
#pragma unroll
                for (int w = 0; w < 8; ++w) lgt += LP[(w * 16 + t) * 64 + tk + 16 * q];
                sc[q] = sigmoidf_(lgt); key[q] = sc[q] + rb[q]; }
            unsigned taken = 0u; int se[6]; float ss[6]; float tot = 0.f;
#pragma unroll
            for (int sel = 0; sel < 6; ++sel) {
                float bk = -1e30f, bs = 0.f; int be = 0;
#pragma unroll
                for (int q = 0; q < 4; ++q) if (!((taken >> q) & 1u) && key[q] > bk) { bk = key[q]; be = tk + 16 * q; bs = sc[q]; }
                topk_step<0xB1>(bk, be, bs); topk_step<0x4E>(bk, be, bs); topk_step<0x141>(bk, be, bs); topk_step<0x140>(bk, be, bs);
                if ((be & 15) == tk) taken |= 1u << (be >> 4);
                se[sel] = be; ss[sel] = bs; tot += bs;
            }
            const float sc2 = 2.5f / tot;
            if (tk < 6 && g < 2) {
                int e = se[0]; float w = ss[0];
#pragma unroll
                for (int q = 1; q < 6; ++q) if (tk == q) { e = se[q]; w = ss[q]; }
                tok_e[r2 * 8 + tk] = e; tok_w[r2 * 8 + tk] = w * sc2; if (!dry) tok_p[r2 * 8 + tk] = __hip_atomic_fetch_add(hist + e, 1, __ATOMIC_RELAXED, __HIP_MEMORY_SCOPE_WORKGROUP);
            }
        }
    }
    asm volatile("s_waitcnt vmcnt(0) lgkmcnt(0)" ::: "memory");
    __syncthreads();
    if (dry) return;
    if (F.tid < 64) hbase[F.tid] = (int)__hip_atomic_fetch_add(gcnt + F.tid, (unsigned)hist[F.tid], __ATOMIC_RELAXED, __HIP_MEMORY_SCOPE_AGENT);
    __syncthreads();
    for (int tile = F.wg; tile < NTILE; tile += F.G) {
        if (F.tid < 96) { const int row = tile * 16 + F.tid / 6, q = F.tid % 6; const int e = tok_e[row * 8 + q]; const int pos = hbase[e] + tok_p[row * 8 + q];
            tok_p[row * 8 + q] = pos; stok[(size_t)e * CAP + pos] = row; sw[(size_t)e * CAP + pos] = tok_w[row * 8 + q]; }
    }
    __syncthreads();
}

__device__ __forceinline__ int moe_tables(const Frame& F, int l) {
    LAS int* cnt = (LAS int*)(F.lds + LDS_MISC + MISC_CNT); LAS int* tst = (LAS int*)(F.lds + LDS_MISC + MISC_TST); LAS unsigned char* t2e = (LAS unsigned char*)(F.lds + LDS_MISC + MISC_T2E);
    const unsigned* gcnt = (const unsigned*)(F.ws + OFF_CTL + CTL_CNT) + l * 64;
    __syncthreads();
    if (F.tid < 64) cnt[F.tid] = (int)__hip_atomic_load(gcnt + F.tid, __ATOMIC_RELAXED, __HIP_MEMORY_SCOPE_AGENT);
    if (F.tid == 64) cnt[64] = TT;
    __syncthreads();
    if (F.tid == 0) { int s = 0; for (int e = 0; e < 65; ++e) { tst[e] = s; s += (cnt[e] + 255) >> 8; } tst[65] = s; }
    __syncthreads();
    const int ntiles = tst[65];
    for (int t = F.tid; t < ntiles; t += 512) { int e = 0; for (int q = 0; q < 65; ++q) if (t >= tst[q]) e = q; else break; t2e[t] = (unsigned char)e; }
    __syncthreads();
    return ntiles;
}

__device__ __forceinline__ void ph_combine(const Frame& F, int l, bool dry = false) {
    LAS int* tst = (LAS int*)(F.lds + LDS_MISC + MISC_TST);
    (void)moe_tables(F, l);
    const float* gam = inp(F, 6) + (size_t)(l * 2 + 1) * DM; const float* bet = inp(F, 7) + (size_t)(l * 2 + 1) * DM;
    const float* gam0 = inp(F, 6) + (size_t)(l * 2 + 0) * DM; const float* bet0 = inp(F, 7) + (size_t)(l * 2 + 0) * DM;
    const float* stats = (const float*)(F.ws + OFF_STATS);
    const unsigned char* Y = (const unsigned char*)(F.R1 + R1_Y);
    const int* tok_e = (const int*)(F.ws + OFF_TOKE); const int* tok_p = (const int*)(F.ws + OFF_TOKP);
    const int gw = F.wg * 8 + F.wave, nw = F.G * 8;
    const bool lastl = (l == 3);
    for (int row = gw; row < TT; row += nw) {
        const int s = slot_of_row(row);
        const float* m = F.mods + (size_t)(l * 5 + s) * 6144;
        const float* mn = F.mods + (size_t)((lastl ? l : l + 1) * 5 + s) * 6144;
        int srow[7];
#pragma unroll
        for (int q = 0; q < 6; ++q) { const int e = tok_e[row * 8 + q]; srow[q] = tst[e] * 256 + tok_p[row * 8 + q]; }
        srow[6] = tst[64] * 256 + row;
        float v[16];
#pragma unroll
        for (int hh = 0; hh < 2; ++hh) { const int k = hh * 512 + F.lane * 8;
            float y[8];
#pragma unroll
            for (int q = 0; q < 8; ++q) y[q] = 0.f;
#pragma unroll
            for (int q = 0; q < 7; ++q) { const u32x2 w = *(const u32x2*)(Y + (size_t)srow[q] * DM + k);
                const f32x2 t0 = __builtin_amdgcn_cvt_pk_f32_fp8((int)w.x, false), t1 = __builtin_amdgcn_cvt_pk_f32_fp8((int)w.x, true), t2 = __builtin_amdgcn_cvt_pk_f32_fp8((int)w.y, false), t3 = __builtin_amdgcn_cvt_pk_f32_fp8((int)w.y, true);
                y[0] += t0.x; y[1] += t0.y; y[2] += t1.x; y[3] += t1.y; y[4] += t2.x; y[5] += t2.y; y[6] += t3.x; y[7] += t3.y; }
#pragma unroll
            for (int i = 0; i < 8; ++i) y[i] *= (1.0f / 32.0f);
            f32x4 x0 = *(const f32x4*)(F.X + (size_t)row * DM + k), x1 = *(const f32x4*)(F.X + (size_t)row * DM + k + 4);
            { const f32x2 st = *(const f32x2*)(stats + (size_t)row * 2); const f32x4 g0 = *(const f32x4*)(gam0 + k), g1 = *(const f32x4*)(gam0 + k + 4), b0 = *(const f32x4*)(bet0 + k), b1 = *(const f32x4*)(bet0 + k + 4);
              x0 = (x0 - st.x) * st.y * g0 + b0; x1 = (x1 - st.x) * st.y * g1 + b1; }
            const f32x4 m50 = *(const f32x4*)(m + 5 * 1024 + k), m51 = *(const f32x4*)(m + 5 * 1024 + k + 4);
#pragma unroll
            for (int i = 0; i < 4; ++i) { v[hh * 8 + i] = ALPHA * x0[i] + m50[i] * y[i]; v[hh * 8 + 4 + i] = ALPHA * x1[i] + m51[i] * y[4 + i]; }
        }
        float sum = 0.f;
#pragma unroll
        for (int i = 0; i < 16; ++i) sum += v[i];
        sum += __shfl_xor(sum, 1); sum += __shfl_xor(sum, 2); sum += __shfl_xor(sum, 4); sum += __shfl_xor(sum, 8); sum += __shfl_xor(sum, 16); sum += __shfl_xor(sum, 32);
        const float mean = sum * (1.0f / 1024.0f);
        float sq = 0.f;
#pragma unroll
        for (int i = 0; i < 16; ++i) { const float d = v[i] - mean; sq += d * d; }
        sq += __shfl_xor(sq, 1); sq += __shfl_xor(sq, 2); sq += __shfl_xor(sq, 4); sq += __shfl_xor(sq, 8); sq += __shfl_xor(sq, 16); sq += __shfl_xor(sq, 32);
        const float rstd = rsqrtf(sq * (1.0f / 1024.0f) + 1e-5f);
#pragma unroll
        for (int hh = 0; hh < 2; ++hh) { const int k = hh * 512 + F.lane * 8;
            float gm[8], bt[8], xn[8];
            *(f32x4*)&gm[0] = *(const f32x4*)(gam + k); *(f32x4*)&gm[4] = *(const f32x4*)(gam + k + 4);
            *(f32x4*)&bt[0] = *(const f32x4*)(bet + k); *(f32x4*)&bt[4] = *(const f32x4*)(bet + k + 4);
#pragma unroll
            for (int i = 0; i < 8; ++i) xn[i] = (v[hh * 8 + i] - mean) * rstd * gm[i] + bt[i];
            if (dry) { float acc_ = 0.f; for (int i = 0; i < 8; ++i) acc_ += xn[i]; asm volatile("" :: "v"(acc_)); }
            else if (lastl) { if (row >= TC) { float* o = F.out + (size_t)(row - TC) * DM + k; *(f32x4*)o = *(f32x4*)&xn[0]; *(f32x4*)(o + 4) = *(f32x4*)&xn[4]; } }
            else {
                *(f32x4*)(F.X + (size_t)row * DM + k) = *(f32x4*)&xn[0]; *(f32x4*)(F.X + (size_t)row * DM + k + 4) = *(f32x4*)&xn[4];
                float s1[8], b0[8];
                *(f32x4*)&s1[0] = *(const f32x4*)(mn + 1024 + k); *(f32x4*)&s1[4] = *(const f32x4*)(mn + 1024 + k + 4);
                *(f32x4*)&b0[0] = *(const f32x4*)(mn + k); *(f32x4*)&b0[4] = *(const f32x4*)(mn + k + 4);
                float hv[8];
#pragma unroll
                for (int i = 0; i < 8; ++i) hv[i] = xn[i] * (1.0f + s1[i]) + b0[i];
                u32x4 w; w.x = cvt_pk_bf16(hv[0], hv[1]); w.y = cvt_pk_bf16(hv[2], hv[3]); w.z = cvt_pk_bf16(hv[4], hv[5]); w.w = cvt_pk_bf16(hv[6], hv[7]);
                *(u32x4*)(F.HB + (size_t)row * DM + k) = w;
            }
        }
    }
}

constexpr int NPHASE = 2 + 4 * 10;
__global__ void __launch_bounds__(512, 2) mk_fwd(Args args) {
    extern __shared__ __attribute__((aligned(16))) unsigned char lds_raw[];
    Frame F;
    F.out = args.out; F.ws = args.ws; F.lds = (LAS unsigned char*)lds_raw;
    { const int t0 = threadIdx.x; F.wave = __builtin_amdgcn_readfirstlane(t0 >> 6); F.lane = t0 & 63; F.tid = t0; } F.G = gridDim.x; F.wg = blockIdx.x;
    F.mods = (float*)(args.ws + OFF_MODS); F.X = (float*)(args.ws + OFF_X); F.HB = (bf16_t*)(args.ws + OFF_HB); F.MIX = F.HB;
    F.WB = args.ws + OFF_WB; F.R1 = args.ws + OFF_R1;
    volatile LAS unsigned* xbw = (volatile LAS unsigned*)(F.lds + LDS_MISC);
    if (F.tid < 4) xbw[F.tid] = 0u;
    if (F.tid < 30) ((LAS unsigned long long*)(F.lds + LDS_MISC + MISC_INP))[F.tid] = (unsigned long long)args.in[F.tid];
    __syncthreads();
    const int lo = args.ph_lo, hi = args.ph_hi;
    XcdBarrier bar; bar.bar = (unsigned*)(args.ws + OFF_CTL); bar.x = 0; bar.st = xbw;
    if (hi - lo > 1) bar = xcd_barrier_post((unsigned*)(args.ws + OFF_CTL), xbw);
#define IN(k) (lo <= (k) && (k) < hi)
#define SEAM(k) do { if (IN(k) && IN((k) + 1)) { xcd_barrier(bar); if (REPM & 1) xcd_barrier(bar); } } while (0)
    if ((PHM & 1) && IN(0)) { ph_mods(fresh(F)); } SEAM(0);
    if ((PHM & 2) && IN(1)) { ph_init_x(fresh(F)); }
    for (int l = 0; l < 4; ++l) {
        const int pb = 2 + l * 10, j = l >> 1; const bool even = (l & 1) == 0;
        float* mods_l = F.mods + (size_t)l * 5 * 6144;
        if ((PHM & 4) && IN(pb + 0)) { for (int rep = 0; rep < ((REPM & 4) ? 2 : 1); ++rep) { ph_convert(fresh(F), l); __syncthreads(); } } SEAM(pb + 0);
        if ((PHM & 8) && IN(pb + 1)) {
            const int N = even ? 4096 : 2048;
            pg8::StaticOrder S; S.init(F.HB, F.WB + WB_IN, TT, N, 1024, F.G, F.wg);
            pg8::EpiStoreBf16 E{(bf16_t*)(F.R1 + R1_P), N};
            for (int rep = 0; rep < ((REPM & 8) ? 2 : 1); ++rep) pg8::gemm_phase(F.lds, 1024, S, E, F.wave);
        } SEAM(pb + 1);
        if (IN(pb + 2)) { if (even) { if (PHM & 16) for (int rep = 0; rep < ((REPM & 16) ? 2 : 1); ++rep) ph_attn(fresh(F), j); if (PHM & 32) for (int rep = 0; rep < ((REPM & 32) ? 2 : 1); ++rep) ph_hg_a(fresh(F), j); } else { if (PHM & 64) for (int rep = 0; rep < ((REPM & 64) ? 2 : 1); ++rep) ph_lru_ac<false>(fresh(F), j); } } SEAM(pb + 2);
        if (IN(pb + 3)) { if (even) { if (PHM & 128) for (int rep = 0; rep < ((REPM & 128) ? 2 : 1); ++rep) ph_hg_b(fresh(F)); } else { if (PHM & 256) for (int rep = 0; rep < ((REPM & 256) ? 2 : 1); ++rep) ph_lru_b(fresh(F)); } } SEAM(pb + 3);
        if (IN(pb + 4)) { if (even) { if (PHM & 512) for (int rep = 0; rep < ((REPM & 512) ? 2 : 1); ++rep) ph_hg_c(fresh(F), j); } else { if (PHM & 1024) for (int rep = 0; rep < ((REPM & 1024) ? 2 : 1); ++rep) ph_lru_ac<true>(fresh(F), j); } } SEAM(pb + 4);
        if ((PHM & 2048) && IN(pb + 5)) {
            pg8::StaticOrder S; S.init(F.MIX, F.WB + WB_OUT, TT, 1024, 1024, F.G, F.wg);
            pg8::EpiResid E{F.X, mods_l};
            pg8::gemm_phase(F.lds, 1024, S, E, F.wave);
        } SEAM(pb + 5);
        if ((PHM & 4096) && IN(pb + 6)) { if (REPM & 4096) ph_ln_router(fresh(F), l, true); ph_ln_router(fresh(F), l); } SEAM(pb + 6);
        if ((PHM & 8192) && IN(pb + 7)) {
            const int ntiles = moe_tables(fresh(F), l);
            pg8::MoeGU S; S.cnt = (const LAS int*)(F.lds + LDS_MISC + MISC_CNT); S.tst = (const LAS int*)(F.lds + LDS_MISC + MISC_TST); S.t2e = (const LAS unsigned char*)(F.lds + LDS_MISC + MISC_T2E);
            S.ntiles = ntiles; S.G = F.G; S.c = F.wg; S.A = (const char*)F.HB; S.Bt = (const char*)(F.WB + WB_GU); S.stok = (const int*)(F.ws + OFF_STOK);
            pg8::EpiSwiglu E{(bf16_t*)(F.R1 + R1_H)};
            for (int rep = 0; rep < ((REPM & 8192) ? 2 : 1); ++rep) pg8::gemm_phase(F.lds, 1024, S, E, F.wave);
        } SEAM(pb + 7);
        if ((PHM & 16384) && IN(pb + 8)) {
            const int ntiles = moe_tables(fresh(F), l);
            pg8::MoeDN S; S.cnt = (const LAS int*)(F.lds + LDS_MISC + MISC_CNT); S.tst = (const LAS int*)(F.lds + LDS_MISC + MISC_TST); S.t2e = (const LAS unsigned char*)(F.lds + LDS_MISC + MISC_T2E);
            S.ntiles = ntiles; S.G = F.G; S.c = F.wg; S.A = (const char*)(F.R1 + R1_H); S.Bt = (const char*)(F.WB + WB_DN);
            pg8::EpiDown E{(unsigned char*)(F.R1 + R1_Y), (const float*)(F.ws + OFF_SW), (const LAS int*)(F.lds + LDS_MISC + MISC_CNT)};
            for (int rep = 0; rep < ((REPM & 16384) ? 2 : 1); ++rep) pg8::gemm_phase(F.lds, 256, S, E, F.wave);
        } SEAM(pb + 8);
        if ((PHM & 32768) && IN(pb + 9)) { if (REPM & 32768) ph_combine(fresh(F), l, true); ph_combine(fresh(F), l); } SEAM(pb + 9);
    }
#undef IN
#undef SEAM
}

extern "C" void kernel_launch(void* const* d_in, const int* in_sizes, int n_in, void* d_out, int out_size, void* d_ws, size_t ws_size, hipStream_t stream) {
    static int grid = 0;
    if (grid == 0) {
        if (n_in != 30 || out_size != TX * DM || ws_size < WS_END) { fprintf(stderr, "kernel_launch: unexpected problem (n_in %d out %d ws %zu need %zu)\n", n_in, out_size, ws_size, (size_t)WS_END); grid = -1; return; }
        int dev = 0, cus = 0, per_cu = 0;
        if (hipGetDevice(&dev) != hipSuccess || hipDeviceGetAttribute(&cus, hipDeviceAttributeMultiprocessorCount, dev) != hipSuccess) { grid = -1; return; }
        if (hipFuncSetAttribute((const void*)mk_fwd, hipFuncAttributeMaxDynamicSharedMemorySize, LDS_BYTES) != hipSuccess) { fprintf(stderr, "kernel_launch: hipFuncSetAttribute failed\n"); grid = -1; return; }
        if (hipOccupancyMaxActiveBlocksPerMultiprocessor(&per_cu, (const void*)mk_fwd, 512, LDS_BYTES) != hipSuccess || per_cu < 1) { fprintf(stderr, "kernel_launch: occupancy query says %d\n", per_cu); }
        (void)hipGetLastError();
        grid = cus;
    }
    if (grid < 0) return;
    (void)hipMemsetAsync((char*)d_ws + OFF_CTL, 0, CTL_BYTES, stream);
    Args a{};
    for (int i = 0; i < 30; ++i) a.in[i] = (const float*)d_in[i];
    a.out = (float*)d_out; a.ws = (unsigned char*)d_ws;
#if MK_SPLIT
    for (int p = 0; p < NPHASE; ++p) { a.ph_lo = p; a.ph_hi = p + 1; hipLaunchKernelGGL(mk_fwd, dim3(grid), dim3(512), LDS_BYTES, stream, a); }
#else
    a.ph_lo = 0; a.ph_hi = NPHASE;
    hipLaunchKernelGGL(mk_fwd, dim3(grid), dim3(512), LDS_BYTES, stream, a);
#endif
}
```

```cpp
#include <hip/hip_runtime.h>
#include <cstdio>
#include <cstdint>

#ifndef PHM
#define PHM 0xFFFF
#endif
#ifndef REPM
#define REPM 0
#endif
#ifndef MK_SPLIT
#define MK_SPLIT 0
#endif

typedef unsigned short bf16_t;
typedef short bf16x8 __attribute__((ext_vector_type(8)));
typedef short bf16x4 __attribute__((ext_vector_type(4)));
typedef float f32x4 __attribute__((ext_vector_type(4)));
typedef float f32x2 __attribute__((ext_vector_type(2)));
typedef unsigned u32x4 __attribute__((ext_vector_type(4)));
typedef unsigned u32x2 __attribute__((ext_vector_type(2)));
#define LAS __attribute__((address_space(3)))

constexpr int DM = 1024, NBAT = 4, SEQ = 8192, CTXL = 256;
constexpr int TC = NBAT * CTXL, TX = NBAT * SEQ, TT = TC + TX;
constexpr int NEXP = 64, TOPK = 6;
constexpr int CAP = TT;
constexpr int MOE_ROUTED_ROWS = 6 * TT + 64 * 256;
constexpr int MOE_ROWS = MOE_ROUTED_ROWS + TT;
constexpr int MOE_MAXTILES = MOE_ROWS / 256;
constexpr float ALPHA = 1.681792830507429f;
constexpr int HG_U = 128, HG_NU = (CTXL + SEQ) / HG_U;
constexpr int LRU_NT = (CTXL + SEQ) / 16;

constexpr size_t OFF_CTL = 0, CTL_BYTES = 65536;
constexpr size_t CTL_CNT = 16384, CTL_DBG = 20480;
constexpr size_t OFF_MODS = 65536;
constexpr size_t OFF_LBT = OFF_MODS + 4 * 5 * 6144 * 4;
constexpr size_t OFF_STATS = OFF_LBT + 8192;
constexpr size_t OFF_AB = OFF_STATS + (size_t)TT * 8;
static_assert(OFF_AB + 4 * 5 * 2 * 1024 * 4 <= (1u << 20), "ctl map");
constexpr size_t OFF_TOKE = 1u << 20;
constexpr size_t OFF_TOKP = OFF_TOKE + (size_t)TT * 32;
constexpr size_t OFF_TOKW = OFF_TOKP + (size_t)TT * 32;
constexpr size_t OFF_STOK = OFF_TOKW + (size_t)TT * 32;
constexpr size_t OFF_SW = OFF_STOK + (size_t)64 * CAP * 4;
constexpr size_t OFF_X = OFF_SW + (size_t)64 * CAP * 4;
constexpr size_t OFF_HB = OFF_X + (size_t)TT * DM * 4;
constexpr size_t OFF_WB = OFF_HB + (size_t)TT * DM * 2;
constexpr size_t WB_IN = 0, WB_OUT = WB_IN + (size_t)4096 * 1024 * 2, WB_RT = WB_OUT + (size_t)1024 * 1024 * 2, WB_GU = WB_RT + (size_t)64 * 1024 * 2,
                 WB_DN = WB_GU + (size_t)65 * 512 * 1024 * 2, WB_LRU = WB_DN + (size_t)65 * 1024 * 256 * 2, WB_END = WB_LRU + (size_t)2 * 2 * 16 * 64 * 64 * 2;
constexpr size_t OFF_R1 = OFF_WB + WB_END;
constexpr size_t R1_P = 0;
constexpr size_t R1_OF = R1_P + (size_t)TT * 4096 * 2;
constexpr size_t R1_SLOC = R1_OF + (size_t)TT * 512 * 4;
constexpr size_t R1_SST = R1_SLOC + (size_t)64 * HG_NU * 4096 * 4;
constexpr size_t R1_DL = R1_SST + (size_t)64 * HG_NU * 4096 * 4;
constexpr size_t R1_MOE_END_FWD = (size_t)MOE_ROWS * 256 * 2 + (size_t)MOE_ROWS * 1024 * 2;
constexpr size_t R1_AG = R1_OF;
constexpr size_t R1_HST = R1_AG + (size_t)4 * 2 * LRU_NT * 2 * 1024 * 4;
constexpr size_t R1_GX = R1_HST + (size_t)4 * 2 * LRU_NT * 1024 * 4;
static_assert(R1_GX + (size_t)TT * 2 * 1024 * 2 * 2 <= R1_MOE_END_FWD, "lru gx");
constexpr size_t R1_H = 0;
constexpr size_t R1_Y = R1_H + (size_t)MOE_ROWS * 256 * 2;
constexpr size_t R1_MOE_END = R1_Y + (size_t)MOE_ROWS * 1024 * 2;
constexpr size_t R1_MIX_END = R1_DL + (size_t)64 * HG_NU * 64 * 4;
constexpr size_t WS_END = OFF_R1 + (R1_MOE_END > R1_MIX_END ? R1_MOE_END : R1_MIX_END);

constexpr int LDS_STAGE = 131072;
constexpr int LDS_MISC = LDS_STAGE;
constexpr int MISC_CNT = 64;
constexpr int MISC_TST = MISC_CNT + 66 * 4 + 8;
constexpr int MISC_HIST = 640;
constexpr int MISC_HBASE = 896;
constexpr int MISC_T2E = 1152;
constexpr int MISC_INP = 2304;
constexpr int LDS_BYTES = 147456;

#define XB_TMO      128
#define XB_XCNT(j)  (256  + 64 * (j))
#define XB_XSUB(j)  (1280 + 64 * (j))
#define XB_XGEN(j)  (2304 + 64 * (j))
#define XB_TOP      3328
#define XB_TOPGEN   3392
#define XCD_BAR_WORDS 3456
#define XB_SPIN_CAP (1u << 22)
__device__ __forceinline__ unsigned xb_ld(unsigned* p)              { return __hip_atomic_load(p, __ATOMIC_RELAXED, __HIP_MEMORY_SCOPE_AGENT); }
__device__ __forceinline__ unsigned xb_add(unsigned* p, unsigned v) { return __hip_atomic_fetch_add(p, v, __ATOMIC_RELAXED, __HIP_MEMORY_SCOPE_AGENT); }
__device__ __forceinline__ unsigned xb_xcc_id() { return (unsigned)__builtin_amdgcn_s_getreg((3 << 11) | 20) & 0xFu; }
#define XB_SPIN(cond, bar) do { unsigned _sp = 0; while (cond) { __builtin_amdgcn_s_sleep(1); \
    if ((++_sp & 255u) == 0u) { if (xb_ld(&(bar)[XB_TMO])) break; if (_sp > XB_SPIN_CAP) { atomicAdd(&(bar)[XB_TMO], 1u); break; } } } } while (0)
struct XcdBarrier { unsigned* bar; unsigned x; volatile LAS unsigned* st; };
__device__ __forceinline__ XcdBarrier xcd_barrier_post(unsigned* bar, volatile LAS unsigned* st) {
    XcdBarrier b; b.bar = bar; b.x = xb_xcc_id(); b.st = st;
    if (threadIdx.x == 0) (void)xb_add(&bar[XB_XCNT(b.x)], 1u);
    return b;
}
__device__ __forceinline__ void xcd_barrier_complete(unsigned* bar, unsigned x, unsigned& nloc, unsigned& nx) {
    const unsigned G = gridDim.x * gridDim.y * gridDim.z;
    unsigned sum, cnt, mine, sp = 0u;
    for (;;) {
        sum = 0u; cnt = 0u; mine = 0u;
#pragma unroll
        for (unsigned j = 0; j < 16; ++j) { const unsigned c = xb_ld(&bar[XB_XCNT(j)]); sum += c; cnt += (c > 0u) ? 1u : 0u; mine = (j == x) ? c : mine; }
        if (sum == G) break;
        __builtin_amdgcn_s_sleep(1);
        if ((++sp & 255u) == 0u) { if (xb_ld(&bar[XB_TMO])) break; if (sp > XB_SPIN_CAP) { atomicAdd(&bar[XB_TMO], 1u); break; } }
    }
    nloc = mine > 0u ? mine : 1u; nx = cnt > 0u ? cnt : 1u;
}
__device__ __forceinline__ void xcd_barrier(const XcdBarrier& b) {
    asm volatile("s_waitcnt vmcnt(0)" ::: "memory");
    __syncthreads();
    if (threadIdx.x == 0) {
        unsigned* bar = b.bar;
        __builtin_amdgcn_s_waitcnt(0);
        unsigned nloc = b.st[0], nx = b.st[1];
        if (nloc == 0u) { xcd_barrier_complete(bar, b.x, nloc, nx); b.st[0] = nloc; b.st[1] = nx; }
        const unsigned old = xb_add(&bar[XB_XSUB(b.x)], 1u);
        const unsigned gen = old / nloc;
        if (old + 1u == (gen + 1u) * nloc) {
            __builtin_amdgcn_fence(__ATOMIC_RELEASE, "agent");
            asm volatile("s_waitcnt vmcnt(0)" ::: "memory");
            const unsigned og = xb_add(&bar[XB_TOP], 1u);
            const unsigned tg = og / nx;
            if (og + 1u == (tg + 1u) * nx) xb_add(&bar[XB_TOPGEN], 1u);
            else XB_SPIN(xb_ld(&bar[XB_TOPGEN]) == tg, bar);
            __builtin_amdgcn_fence(__ATOMIC_ACQUIRE, "agent");
            xb_add(&bar[XB_XGEN(b.x)], 1u);
            asm volatile("s_waitcnt vmcnt(0)" ::: "memory");
        } else {
            XB_SPIN(xb_ld(&bar[XB_XGEN(b.x)]) == gen, bar);
            __builtin_amdgcn_fence(__ATOMIC_ACQUIRE, "agent");
            asm volatile("s_waitcnt vmcnt(0)" ::: "memory");
        }
    }
    __syncthreads();
}

__device__ __forceinline__ float bf2f(unsigned short b) { return __uint_as_float(((unsigned)b) << 16); }
__device__ __forceinline__ unsigned cvt_pk_bf16(float lo, float hi) { unsigned r; asm volatile("v_cvt_pk_bf16_f32 %0, %1, %2" : "=v"(r) : "v"(lo), "v"(hi)); return r; }
__device__ __forceinline__ unsigned short f2bf(float f) { return (unsigned short)(cvt_pk_bf16(f, 0.f) & 0xffffu); }
__device__ __forceinline__ float sigmoidf_(float x) { return __builtin_amdgcn_rcpf(1.0f + __expf(-x)); }
__device__ __forceinline__ float siluf_(float x) { return x * sigmoidf_(x); }
__device__ __forceinline__ float gelu_tanh_(float x) { return x * sigmoidf_(1.5957691216057308f * (x + 0.044715f * x * x * x)); }
__device__ __forceinline__ int slot_of_row(int r) { return r < TC ? 4 : ((r - TC) >> 13); }
template <int CTRL> __device__ __forceinline__ float dppf(float oldv, float src) {
    return __int_as_float(__builtin_amdgcn_update_dpp(__float_as_int(oldv), __float_as_int(src), CTRL, 0xf, 0xf, false));
}
__device__ __forceinline__ void unpack8(const u32x4 w, float (&o)[8]) {
    o[0] = __uint_as_float(w.x << 16); o[1] = __uint_as_float(w.x & 0xffff0000u); o[2] = __uint_as_float(w.y << 16); o[3] = __uint_as_float(w.y & 0xffff0000u);
    o[4] = __uint_as_float(w.z << 16); o[5] = __uint_as_float(w.z & 0xffff0000u); o[6] = __uint_as_float(w.w << 16); o[7] = __uint_as_float(w.w & 0xffff0000u);
}

namespace pg8 {
constexpr int BM = 256, BK = 64, HALF = 128, HTB = HALF * BK * 2, STAGE_BYTES = 8 * HTB, NXCD = 8, WGM = 8;
__device__ __forceinline__ int lds_byte(int r, int c) { const int st = (r >> 4) * 2 + (c >> 5), rr = r & 15, cc = c & 31, ob = rr * 64 + cc * 2; return st * 1024 + (ob ^ (((ob >> 9) & 1) << 5)); }
__device__ __forceinline__ void stage_rc(int b, int& R, int& C) { const int st = b / 1024, sb = b % 1024, swz = sb ^ (((sb >> 9) & 1) << 5); R = (st >> 1) * 16 + swz / 64; C = (st & 1) * 32 + (swz % 64) / 2; }
__device__ __forceinline__ int perm32(int rho) { const int n = rho >> 4, i = rho & 15; return 8 * (i >> 2) + 4 * n + (i & 3); }
struct Unit { int pm, pn, e, ti; };

struct StaticOrder {
    const char* A; const char* Bt; int K;
    int nM, nN, nwg, G, c;
    __device__ __forceinline__ void init(const void* A_, const void* Bt_, int M, int N, int K_, int G_, int c_) { A = (const char*)A_; Bt = (const char*)Bt_; K = K_; nM = M / BM; nN = N / BM; nwg = nM * nN; G = G_; c = c_; }
    __device__ __forceinline__ bool next(int i, Unit& u) const {
        const long L = (long)i * G + c; if (L >= nwg) return false;
        int wgid = (int)L; { const int q = nwg / NXCD, r = nwg % NXCD, xcd = wgid % NXCD, off = wgid / NXCD; wgid = (xcd < r ? xcd * (q + 1) : r * (q + 1) + (xcd - r) * q) + off; }
        const int nig = WGM * nN, gid = wgid / nig, fm = gid * WGM, gsz = (nM - fm) < WGM ? (nM - fm) : WGM;
        u.pm = fm + ((wgid % nig) % gsz); u.pn = (wgid % nig) / gsz; u.e = 0; u.ti = 0; return true;
    }
    static constexpr bool GATHER = false;
    __device__ __forceinline__ const char* abase(const Unit& u) const { return A + (size_t)u.pm * BM * K * 2; }
    __device__ __forceinline__ const char* bbase(const Unit& u) const { return Bt + (size_t)u.pn * BM * K * 2; }
};

template <class Epi, class Sched>
__device__ __forceinline__ void gemm_phase(LAS unsigned char* lds, const int K_, const Sched& S, const Epi& E, const int wave_) {
    int Kl_ = K_; asm volatile("" : "+s"(Kl_)); const int K = Kl_;
    int tid_ = wave_ * 64 + (int)__builtin_amdgcn_mbcnt_hi(~0u, __builtin_amdgcn_mbcnt_lo(~0u, 0u)); asm volatile("" : "+v"(tid_));
    const int tid = tid_, wid = __builtin_amdgcn_readfirstlane(tid >> 6), lane = tid & 63, wr = wid >> 2, wc = wid & 3, fr = lane & 15, fq = lane >> 4;
    const int nt = K / BK;
    unsigned voffA[2], voffB[2];
#pragma unroll
    for (int i = 0; i < 2; ++i) { int R, C; stage_rc(tid * 16 + i * 8192, R, C); const int Rb = Epi::PERM ? ((R & ~31) + perm32(R & 31)) : R; voffA[i] = (unsigned)(R * K + C) * 2u; voffB[i] = (unsigned)(Rb * K + C) * 2u; }
    const size_t kstep = (size_t)(BK * 2);
    const size_t hstep = (size_t)HALF * K * 2;
    const unsigned ldsw = (unsigned)wid * 1024u;
    const int aoff = lds_byte(wr * 64 + fr, fq * 8), boff = lds_byte(wc * 32 + fr, fq * 8);
#define PG8_SA(b, h) (((b) * 2 + (h)) * HTB)
#define PG8_SB(b, h) ((4 + (b) * 2 + (h)) * HTB)
#define PG8_STAGE(bufoff, gbase, voff) do { _Pragma("unroll") for (int _i = 0; _i < 2; ++_i) \
        __builtin_amdgcn_global_load_lds((const unsigned*)((const char*)(gbase) + (voff)[_i]), (LAS unsigned*)(lds + (bufoff) + ldsw + _i * 8192), 16, 0, 0); } while (0)
#define PG8_STAGEA(bufoff, hh, kb, nx) do { if constexpr (Sched::GATHER) { unsigned _o[2]; _o[0] = (nx) ? vN[hh][0] : vC[hh][0]; _o[1] = (nx) ? vN[hh][1] : vC[hh][1]; PG8_STAGE(bufoff, cA + (kb), _o); } \
        else { PG8_STAGE(bufoff, ((nx) ? nA : cA) + (hh) * hstep + (kb), voffA); } } while (0)
#define PG8_LDA(dst, b, h) do { _Pragma("unroll") for (int m = 0; m < 4; ++m) _Pragma("unroll") for (int k = 0; k < 2; ++k) dst[m][k] = *(const LAS bf16x8*)(lds + PG8_SA(b, h) + aoff + m * 2048 + k * 1024); } while (0)
#define PG8_LDB(dst, b, h) do { _Pragma("unroll") for (int n = 0; n < 2; ++n) _Pragma("unroll") for (int k = 0; k < 2; ++k) dst[n][k] = *(const LAS bf16x8*)(lds + PG8_SB(b, h) + boff + n * 2048 + k * 1024); } while (0)
#define PG8_MMA(ai, bj, At, Bt) do { __builtin_amdgcn_s_setprio(1); _Pragma("unroll") for (int m = 0; m < 4; ++m) _Pragma("unroll") for (int n = 0; n < 2; ++n) _Pragma("unroll") for (int k = 0; k < 2; ++k) \
        acc[ai][bj][m][n] = __builtin_amdgcn_mfma_f32_16x16x32_bf16(Bt[n][k], At[m][k], acc[ai][bj][m][n], 0, 0, 0); __builtin_amdgcn_s_setprio(0); } while (0)
#define PG8_WAIT_V(n) asm volatile("s_waitcnt vmcnt(" #n ")" ::: "memory")
#define PG8_WAIT_L(n) asm volatile("s_waitcnt lgkmcnt(" #n ")" ::: "memory")
#define PG8_BAR __builtin_amdgcn_s_barrier()
#define PG8_SCHED __builtin_amdgcn_sched_barrier(0)
    Unit cur, nxt; int ui = 0;
    if (!S.next(0, cur)) return;
    f32x4 acc[2][2][4][2];
#pragma unroll
    for (int a = 0; a < 2; ++a)
#pragma unroll
        for (int b = 0; b < 2; ++b)
#pragma unroll
            for (int m = 0; m < 4; ++m)
#pragma unroll
                for (int n = 0; n < 2; ++n) acc[a][b][m][n] = (f32x4){0.f, 0.f, 0.f, 0.f};
    bf16x8 At[4][2], B0[2][2], B1[2][2];
    unsigned vC[2][2], vN[2][2];
    if constexpr (Sched::GATHER) S.aoff(cur, tid, vC);
    const char* cA = S.abase(cur);
    const char* cB = S.bbase(cur);
    const char* nA = cA;
    PG8_STAGE(PG8_SB(0, 0), cB, voffB); PG8_STAGEA(PG8_SA(0, 0), 0, 0, false); PG8_STAGE(PG8_SB(0, 1), cB + hstep, voffB); PG8_STAGEA(PG8_SA(0, 1), 1, 0, false);
    if (wr == 1) PG8_BAR;
    PG8_WAIT_V(4); PG8_BAR;
    PG8_STAGE(PG8_SB(1, 0), cB + kstep, voffB); PG8_STAGEA(PG8_SA(1, 0), 0, kstep, false); PG8_STAGE(PG8_SB(1, 1), cB + hstep + kstep, voffB);
    PG8_WAIT_V(6); PG8_BAR;
    for (;;) {
        const bool has_next = S.next(ui + 1, nxt);
        const char* nB = cB; nA = cA;
        if (has_next) { nB = S.bbase(nxt); nA = S.abase(nxt); if constexpr (Sched::GATHER) S.aoff(nxt, tid, vN); }
        else { if constexpr (Sched::GATHER) {
#pragma unroll
            for (int h = 0; h < 2; ++h)
#pragma unroll
                for (int i = 0; i < 2; ++i) vN[h][i] = vC[h][i]; } }
        for (int t = 0; t < nt; t += 2) {
            const bool last = (t == nt - 2);
            const size_t k1 = (size_t)(t + 1) * kstep, k2 = last ? 0 : (size_t)(t + 2) * kstep, k3 = k2 + kstep;
            const char* b2 = last ? nB : cB + (size_t)(t + 2) * kstep; const char* b3 = b2 + kstep;
            PG8_LDB(B0, 0, 0); PG8_SCHED; PG8_LDA(At, 0, 0); PG8_STAGEA(PG8_SA(1, 1), 1, k1, false);
            PG8_WAIT_L(8); PG8_BAR; PG8_WAIT_L(0); PG8_MMA(0, 0, At, B0); PG8_BAR; PG8_SCHED;
            PG8_LDB(B1, 0, 1); PG8_STAGE(PG8_SB(0, 0), b2, voffB);
            PG8_BAR; PG8_WAIT_L(0); PG8_MMA(0, 1, At, B1); PG8_BAR;
            PG8_LDA(At, 0, 1); PG8_STAGEA(PG8_SA(0, 0), 0, k2, last);
            PG8_BAR; PG8_WAIT_L(0); PG8_MMA(1, 0, At, B0); PG8_BAR; PG8_SCHED;
            PG8_STAGE(PG8_SB(0, 1), b2 + hstep, voffB);
            PG8_WAIT_V(6); PG8_BAR; PG8_MMA(1, 1, At, B1); PG8_BAR;
            PG8_LDB(B0, 1, 0); PG8_SCHED; PG8_LDA(At, 1, 0); PG8_STAGEA(PG8_SA(0, 1), 1, k2, last);
            PG8_WAIT_L(8); PG8_BAR; PG8_WAIT_L(0); PG8_MMA(0, 0, At, B0); PG8_BAR; PG8_SCHED;
            PG8_LDB(B1, 1, 1); PG8_STAGE(PG8_SB(1, 0), b3, voffB);
            PG8_BAR; PG8_WAIT_L(0); PG8_MMA(0, 1, At, B1); PG8_BAR;
            PG8_LDA(At, 1, 1); PG8_STAGEA(PG8_SA(1, 0), 0, k3, last);
            PG8_BAR; PG8_WAIT_L(0); PG8_MMA(1, 0, At, B0); PG8_BAR; PG8_SCHED;
            PG8_STAGE(PG8_SB(1, 1), b3 + hstep, voffB);
            PG8_WAIT_V(6); PG8_BAR; PG8_MMA(1, 1, At, B1); PG8_BAR;
        }
        E(acc, cur, wr, wc, fr, fq);
        if (!has_next) break;
#pragma unroll
        for (int a = 0; a < 2; ++a)
#pragma unroll
            for (int b = 0; b < 2; ++b)
#pragma unroll
                for (int m = 0; m < 4; ++m)
#pragma unroll
                    for (int n = 0; n < 2; ++n) acc[a][b][m][n] = (f32x4){0.f, 0.f, 0.f, 0.f};
        cur = nxt; cB = nB; cA = nA; ++ui;
        if constexpr (Sched::GATHER) {
#pragma unroll
            for (int h = 0; h < 2; ++h)
#pragma unroll
                for (int i = 0; i < 2; ++i) vC[h][i] = vN[h][i]; }
    }
    PG8_WAIT_V(0);
    if (wr == 0) PG8_BAR;
    PG8_BAR;
#undef PG8_SA
#undef PG8_SB
#undef PG8_STAGE
#undef PG8_STAGEA
#undef PG8_LDA
#undef PG8_LDB
#undef PG8_MMA
#undef PG8_WAIT_V
#undef PG8_WAIT_L
#undef PG8_BAR
#undef PG8_SCHED
}

struct EpiStoreBf16 {
    static constexpr bool PERM = true;
    bf16_t* O; int ldc;
    __device__ __forceinline__ void operator()(const f32x4 (&acc)[2][2][4][2], const Unit& u, int wr, int wc, int fr, int fq) const {
        const int row0 = u.pm * BM + wr * 64 + fr, col0 = u.pn * BM + wc * 32 + 8 * fq;
#pragma unroll
        for (int ai = 0; ai < 2; ++ai)
#pragma unroll
            for (int m = 0; m < 4; ++m) { bf16_t* rowp = O + (size_t)(row0 + ai * HALF + m * 16) * ldc + col0;
#pragma unroll
                for (int bj = 0; bj < 2; ++bj) { const f32x4 v0 = acc[ai][bj][m][0], v1 = acc[ai][bj][m][1];
                    u32x4 w; w.x = cvt_pk_bf16(v0[0], v0[1]); w.y = cvt_pk_bf16(v0[2], v0[3]); w.z = cvt_pk_bf16(v1[0], v1[1]); w.w = cvt_pk_bf16(v1[2], v1[3]);
                    *(u32x4*)(rowp + bj * HALF) = w; } }
    }
};
struct EpiResid {
    static constexpr bool PERM = false;
    float* X; const float* mods_l;
    __device__ __forceinline__ void operator()(const f32x4 (&acc)[2][2][4][2], const Unit& u, int wr, int wc, int fr, int fq) const {
        const int row0 = u.pm * BM + wr * 64 + fr, col0 = u.pn * BM + wc * 32 + 4 * fq;
        const float* m2 = mods_l + (size_t)(slot_of_row(u.pm * BM) * 6 + 2) * DM + col0;
        float* xb = X + (size_t)row0 * DM + col0;
#pragma unroll
        for (int bj = 0; bj < 2; ++bj)
#pragma unroll
            for (int n = 0; n < 2; ++n) { const f32x4 mv = *(const f32x4*)(m2 + bj * HALF + n * 16);
#pragma unroll
                for (int ai = 0; ai < 2; ++ai) {
#pragma unroll
                    for (int m = 0; m < 4; ++m) { float* p = xb + (size_t)(ai * HALF + m * 16) * DM + bj * HALF + n * 16; const f32x4 xv = *(const f32x4*)p; *(f32x4*)p = xv * ALPHA + mv * acc[ai][bj][m][n]; }
                    asm volatile("" ::: "memory"); } }
    }
};
struct EpiSwiglu {
    static constexpr bool PERM = true;
    bf16_t* H;
    __device__ __forceinline__ void operator()(const f32x4 (&acc)[2][2][4][2], const Unit& u, int wr, int wc, int fr, int fq) const {
        const int row0 = u.pm * BM + wr * 64 + fr, col0 = u.pn * HALF + wc * 32 + 8 * fq;
#pragma unroll
        for (int ai = 0; ai < 2; ++ai)
#pragma unroll
            for (int m = 0; m < 4; ++m) { bf16_t* rowp = H + (size_t)(row0 + ai * HALF + m * 16) * 256 + col0;
                float h[8];
#pragma unroll
                for (int n = 0; n < 2; ++n)
#pragma unroll
                    for (int j = 0; j < 4; ++j) h[n * 4 + j] = siluf_(acc[ai][0][m][n][j]) * acc[ai][1][m][n][j];
                u32x4 w; w.x = cvt_pk_bf16(h[0], h[1]); w.y = cvt_pk_bf16(h[2], h[3]); w.z = cvt_pk_bf16(h[4], h[5]); w.w = cvt_pk_bf16(h[6], h[7]);
                *(u32x4*)rowp = w; }
    }
};
struct EpiDown {
    static constexpr bool PERM = true;
    unsigned char* Y; const float* sw; const LAS int* cnt;
    __device__ __forceinline__ void operator()(const f32x4 (&acc)[2][2][4][2], const Unit& u, int wr, int wc, int fr, int fq) const {
        const int row0 = u.pm * BM + wr * 64 + fr, col0 = u.pn * BM + wc * 32 + 8 * fq;
        const int ce = (u.e < 64) ? cnt[u.e] : 0;
        const float* swe = sw + (size_t)(u.e < 64 ? u.e : 0) * CAP + u.ti * 256 + wr * 64 + fr;
        unsigned char* yb = Y + (size_t)row0 * DM + col0;
#pragma unroll
        for (int ai = 0; ai < 2; ++ai)
#pragma unroll
            for (int m = 0; m < 4; ++m) { const int rl = ai * HALF + m * 16, pos = u.ti * 256 + wr * 64 + fr + rl;
                float w = 32.0f; if (u.e < 64) w = (pos < ce) ? swe[rl] * 32.0f : 0.0f;
                unsigned char* rowp = yb + (size_t)rl * DM;
#pragma unroll
                for (int bj = 0; bj < 2; ++bj) { f32x4 v0 = acc[ai][bj][m][0] * w, v1 = acc[ai][bj][m][1] * w;
#pragma unroll
                    for (int j = 0; j < 4; ++j) { v0[j] = fminf(fmaxf(v0[j], -440.0f), 440.0f); v1[j] = fminf(fmaxf(v1[j], -440.0f), 440.0f); }
                    int p0 = __builtin_amdgcn_cvt_pk_fp8_f32(v0[0], v0[1], 0, false); p0 = __builtin_amdgcn_cvt_pk_fp8_f32(v0[2], v0[3], p0, true);
                    int p1 = __builtin_amdgcn_cvt_pk_fp8_f32(v1[0], v1[1], 0, false); p1 = __builtin_amdgcn_cvt_pk_fp8_f32(v1[2], v1[3], p1, true);
                    u32x2 ww; ww.x = (unsigned)p0; ww.y = (unsigned)p1;
                    *(u32x2*)(rowp + bj * HALF) = ww; }
                asm volatile("" ::: "memory"); }
    }
};
template <int NPN> struct MoeOrder {
    const LAS int* cnt; const LAS int* tst; const LAS unsigned char* t2e; int ntiles, G, c;
    __device__ __forceinline__ bool next(int i, Unit& u) const {
        const int L = i * G + c; if (L >= ntiles * NPN) return false;
        const int tau = L / NPN; u.pm = tau; u.pn = L % NPN; u.e = t2e[tau]; u.ti = tau - tst[u.e]; return true;
    }
};
struct MoeGU : MoeOrder<2> {
    static constexpr bool GATHER = true;
    const char* A; const char* Bt; const int* stok;
    __device__ __forceinline__ const char* abase(const Unit&) const { return A; }
    __device__ __forceinline__ const char* bbase(const Unit& u) const { return Bt + ((size_t)u.e * 512 + (size_t)u.pn * 256) * 1024 * 2; }
    __device__ __forceinline__ void aoff(const Unit& u, int tid, unsigned (&off)[2][2]) const {
        const int ce = cnt[u.e];
#pragma unroll
        for (int i = 0; i < 2; ++i) { int R, C; stage_rc(tid * 16 + i * 8192, R, C);
#pragma unroll
            for (int h = 0; h < 2; ++h) { const int pos = u.ti * 256 + h * HALF + R; int tok;
                if (u.e == 64) tok = pos; else tok = (pos < ce) ? stok[(size_t)u.e * CAP + pos] : 0;
                off[h][i] = (unsigned)(tok * 1024 + C) * 2u; } }
    }
};
struct MoeDN : MoeOrder<4> {
    static constexpr bool GATHER = false;
    const char* A; const char* Bt;
    __device__ __forceinline__ const char* abase(const Unit& u) const { return A + (size_t)u.pm * BM * 256 * 2; }
    __device__ __forceinline__ const char* bbase(const Unit& u) const { return Bt + ((size_t)u.e * 1024 + (size_t)u.pn * 256) * 256 * 2; }
};
}

struct Args { const float* in[30]; float* out; unsigned char* ws; int ph_lo, ph_hi; };

struct Frame {
    float* out; unsigned char* ws; LAS unsigned char* lds; int tid, lane, wave, G, wg;
    float* mods; float* X; bf16_t* HB; bf16_t* MIX; unsigned char* WB; unsigned char* R1;
};

__device__ __forceinline__ const float* inp(const Frame& F, int i) {
    const unsigned long long v = ((const LAS unsigned long long*)(F.lds + LDS_MISC + MISC_INP))[i];
    const unsigned lo = (unsigned)__builtin_amdgcn_readfirstlane((int)(unsigned)v), hi = (unsigned)__builtin_amdgcn_readfirstlane((int)(unsigned)(v >> 32));
    return (const float*)(((unsigned long long)hi << 32) | lo);
}
__device__ __forceinline__ int lane_id_() { return (int)__builtin_amdgcn_mbcnt_hi(~0u, __builtin_amdgcn_mbcnt_lo(~0u, 0u)); }
__device__ __forceinline__ Frame fresh(const Frame& F0) { Frame F = F0; int ln = lane_id_(); asm volatile("" : "+v"(ln)); F.lane = ln; F.tid = F0.wave * 64 + ln; return F; }

__device__ __forceinline__ void ph_mods(const Frame& F) {
    const float* c = inp(F, 1); const float* cc = inp(F, 3); const float* ada_w = inp(F, 4); const float* ada_b = inp(F, 5);
    LAS float* sv = (LAS float*)F.lds;
    LAS float* red = (LAS float*)(F.lds + 5 * 1024 * 4);
    for (int i = F.tid; i < 5 * 1024; i += 512) { const int s = i >> 10, k = i & 1023; const float v = (s < 4) ? c[s * 1024 + k] : cc[k]; sv[i] = siluf_(v); }
    __syncthreads();
    for (int task = F.wg; task < 4 * 48; task += F.G) {
        const int l = task / 48, cc0 = (task % 48) * 128;
        const int col = cc0 + (F.tid & 127), kg = F.tid >> 7;
        const float* w = ada_w + (size_t)l * 1024 * 6144 + col;
        float a0 = 0.f, a1 = 0.f, a2 = 0.f, a3 = 0.f, a4 = 0.f;
        for (int k = kg * 256; k < kg * 256 + 256; ++k) { const float wv = w[(size_t)k * 6144]; a0 += sv[k] * wv; a1 += sv[1024 + k] * wv; a2 += sv[2048 + k] * wv; a3 += sv[3072 + k] * wv; a4 += sv[4096 + k] * wv; }
        LAS float* r = red + (kg * 128 + (F.tid & 127)) * 5; r[0] = a0; r[1] = a1; r[2] = a2; r[3] = a3; r[4] = a4;
        __syncthreads();
        if (F.tid < 128) {
            const float b = ada_b[l * 6144 + col];
#pragma unroll
            for (int s = 0; s < 5; ++s) { const float v = ((red[(0 * 128 + F.tid) * 5 + s] + red[(1 * 128 + F.tid) * 5 + s]) + red[(2 * 128 + F.tid) * 5 + s]) + red[(3 * 128 + F.tid) * 5 + s];
                F.mods[(size_t)(l * 5 + s) * 6144 + col] = v + b; }
        }
        __syncthreads();
    }
    if (F.wg == F.G - 1) {
        const float* raw = inp(F, 11); float* lbt = (float*)(F.ws + OFF_LBT);
        for (int i = F.tid; i < 2 * 512; i += 512) { const int d = i >> 9, ch = i & 511; const float r0 = raw[(d * 2 + 0) * 512 + ch], r1 = raw[(d * 2 + 1) * 512 + ch];
            lbt[(0 * 2 + d) * 512 + ch] = 0.f; lbt[(1 * 2 + d) * 512 + ch] = sigmoidf_(r1 - r0); }
    }
}

__device__ __forceinline__ void ph_init_x(const Frame& F) {
    const float* x = inp(F, 0); const float* ctx = inp(F, 2);
    { const float* lg_ = inp(F, 6); const float* lb_ = inp(F, 7); float* AB = (float*)(F.ws + OFF_AB);
      for (int i = F.wg * 512 + F.tid; i < 4 * 5 * 1024; i += F.G * 512) { const int k = i & 1023, ls = i >> 10, l = ls / 5;
          const float* m = F.mods + (size_t)ls * 6144; const float g0 = lg_[(l * 2) * 1024 + k], b0 = lb_[(l * 2) * 1024 + k], m3 = m[3 * 1024 + k], m4 = m[4 * 1024 + k];
          AB[(size_t)ls * 2048 + k] = g0 * (1.0f + m4); AB[(size_t)ls * 2048 + 1024 + k] = b0 * (1.0f + m4) + m3; } }
    const int gw = F.wg * 8 + F.wave, nw = F.G * 8;
    for (int row = gw; row < TT; row += nw) {
        const float* src = row < TC ? ctx + (size_t)row * DM : x + (size_t)(row - TC) * DM;
        const float* m = F.mods + (size_t)(0 * 5 + slot_of_row(row)) * 6144;
#pragma unroll
        for (int hh = 0; hh < 2; ++hh) { const int k = hh * 512 + F.lane * 8;
            const f32x4 v0 = *(const f32x4*)(src + k), v1 = *(const f32x4*)(src + k + 4);
            *(f32x4*)(F.X + (size_t)row * DM + k) = v0; *(f32x4*)(F.X + (size_t)row * DM + k + 4) = v1;
            const f32x4 s0 = *(const f32x4*)(m + 1024 + k), s1 = *(const f32x4*)(m + 1024 + k + 4), b0 = *(const f32x4*)(m + k), b1 = *(const f32x4*)(m + k + 4);
            const f32x4 h0 = v0 * (s0 + 1.0f) + b0, h1 = v1 * (s1 + 1.0f) + b1;
            u32x4 w; w.x = cvt_pk_bf16(h0[0], h0[1]); w.y = cvt_pk_bf16(h0[2], h0[3]); w.z = cvt_pk_bf16(h1[0], h1[1]); w.w = cvt_pk_bf16(h1[2], h1[3]);
            *(u32x4*)(F.HB + (size_t)row * DM + k) = w; }
    }
}

__device__ __forceinline__ void cvt_tile(const Frame& F, const float* src, int sld, int k0, int n0, bf16_t* dst, int dld, int drow0, float scale) {
    LAS float* t = (LAS float*)F.lds;
    { const int i = F.tid >> 3, j0 = (F.tid & 7) * 8; const float* p = src + (size_t)(k0 + i) * sld + n0 + j0;
      const f32x4 a = *(const f32x4*)p, b = *(const f32x4*)(p + 4);
      LAS float* q = t + i * 65 + j0; q[0] = a[0]; q[1] = a[1]; q[2] = a[2]; q[3] = a[3]; q[4] = b[0]; q[5] = b[1]; q[6] = b[2]; q[7] = b[3]; }
    __syncthreads();
    { const int j = F.tid >> 3, i0 = (F.tid & 7) * 8; float v[8];
#pragma unroll
      for (int q = 0; q < 8; ++q) v[q] = t[(i0 + q) * 65 + j] * scale;
      u32x4 w; w.x = cvt_pk_bf16(v[0], v[1]); w.y = cvt_pk_bf16(v[2], v[3]); w.z = cvt_pk_bf16(v[4], v[5]); w.w = cvt_pk_bf16(v[6], v[7]);
      *(u32x4*)(dst + (size_t)(drow0 + j) * dld + k0 + i0) = w; }
    __syncthreads();
}
__device__ __forceinline__ void ph_convert(const Frame& F, int l) {
    const int j = l >> 1; const bool even = (l & 1) == 0;
    bf16_t* wIN = (bf16_t*)(F.WB + WB_IN); bf16_t* wOUT = (bf16_t*)(F.WB + WB_OUT); bf16_t* wRT = (bf16_t*)(F.WB + WB_RT);
    bf16_t* wGU = (bf16_t*)(F.WB + WB_GU); bf16_t* wDN = (bf16_t*)(F.WB + WB_DN); bf16_t* wLRU = (bf16_t*)(F.WB + WB_LRU);
    const int nIN = even ? 4096 : 2048;
    const int t_in = (nIN / 64) * 16, t_out = 256, t_rt = 16, t_gu = 65 * 2 * 64, t_dn = 65 * 64, t_lru = even ? 0 : 64;
    const int total = t_in + t_out + t_rt + t_gu + t_dn + t_lru;
    for (int task = F.wg; task < total; task += F.G) {
        int t = task;
        if (t < t_in) { const int nb = t >> 4, kb = t & 15; const float* src = even ? inp(F, 8) + (size_t)j * 1024 * 4096 : inp(F, 13) + (size_t)j * 1024 * 2048;
            cvt_tile(F, src, nIN, kb * 64, nb * 64, wIN, 1024, nb * 64, (even && nb < 8) ? 0.125f : 1.0f); continue; }
        t -= t_in;
        if (t < t_out) { const int nb = t >> 4, kb = t & 15; const float* src = even ? inp(F, 9) + (size_t)j * 1024 * 1024 : inp(F, 21) + (size_t)j * 1024 * 1024;
            cvt_tile(F, src, 1024, kb * 64, nb * 64, wOUT, 1024, nb * 64, 1.0f); continue; }
        t -= t_out;
        if (t < t_rt) { cvt_tile(F, inp(F, 22) + (size_t)l * 1024 * 64, 64, t * 64, 0, wRT, 1024, 0, 1.0f); continue; }
        t -= t_rt;
        if (t < t_gu) { const int e = t / 128, r = t % 128, which = r >> 6, q = r & 63, nb = q >> 4, kb = q & 15;
            const float* src = (e < 64) ? (which ? inp(F, 25) : inp(F, 24)) + ((size_t)l * 64 + e) * 1024 * 256 : (which ? inp(F, 28) : inp(F, 27)) + (size_t)l * 1024 * 256;
            const int n0 = nb * 64, drow0 = (n0 >> 7) * 256 + which * 128 + (n0 & 127);
            cvt_tile(F, src, 256, kb * 64, n0, wGU + (size_t)e * 512 * 1024, 1024, drow0, 1.0f); continue; }
        t -= t_gu;
        if (t < t_dn) { const int e = t >> 6, q = t & 63, nb = q >> 2, kb = q & 3;
            const float* src = (e < 64) ? inp(F, 26) + ((size_t)l * 64 + e) * 256 * 1024 : inp(F, 29) + (size_t)l * 256 * 1024;
            cvt_tile(F, src, 1024, kb * 64, nb * 64, wDN + (size_t)e * 1024 * 256, 256, nb * 64, 1.0f); continue; }
        t -= t_dn;
        { const int d = t >> 5, gt = (t >> 4) & 1, kb = t & 15;
          const float* src = (gt ? inp(F, 18) : inp(F, 16)) + (((size_t)j * 2 + d) * 16 + kb) * 4096;
          cvt_tile(F, src, 64, 0, 0, wLRU + (((size_t)d * 2 + gt) * 16 + kb) * 4096, 64, 0, 1.0f); }
    }
}

__device__ __forceinline__ void ph_attn(const Frame& F, int j) {
    const bf16_t* P = (const bf16_t*)(F.R1 + R1_P);
    LAS bf16_t* Ks = (LAS bf16_t*)F.lds;
    LAS bf16_t* Vt = (LAS bf16_t*)(F.lds + 9216);
    LAS float* rp_l = (LAS float*)(F.lds + 18432);
    const float* rpb = inp(F, 10) + (size_t)j * 8 * 465;
    const int g = F.lane >> 4, l15 = F.lane & 15;
    const int NLAT = NBAT * 8 * 64, NTASK = NLAT + NBAT * 8 * 2;
    for (int task = F.wg; task < NTASK; task += F.G) {
        const bool lat = task < NLAT;
        int b, h, rp = 0, half = 0;
        if (lat) { b = task >> 9; h = (task >> 6) & 7; rp = task & 63; } else { const int t2 = task - NLAT; b = t2 >> 4; h = (t2 >> 1) & 7; half = t2 & 1; }
        const int myr = 2 * rp + (F.wave >> 2), w0 = (F.wave & 3) * 16;
        const int r0 = min(max(myr - 4, 0), 120);
        const int rlo = min(max(2 * rp - 4, 0), 120), rhi = min(max(2 * rp + 1 - 4, 0), 120) + 7;
        const int nloc = lat ? (rhi - rlo + 1) : 0;
        const int qrow = lat ? (TC + b * SEQ + myr * 64 + w0 + l15) : (b * CTXL + half * 128 + F.wave * 16 + l15);
        bf16x8 qf[2];
        qf[0] = *(const bf16x8*)(P + (size_t)qrow * 4096 + h * 64 + g * 8);
        qf[1] = *(const bf16x8*)(P + (size_t)qrow * 4096 + h * 64 + 32 + g * 8);
        if (lat) for (int i = F.tid; i < 465; i += 512) rp_l[i] = rpb[h * 465 + i];
        f32x4 oacc[4];
#pragma unroll
        for (int dt = 0; dt < 4; ++dt) oacc[dt] = (f32x4){0.f, 0.f, 0.f, 0.f};
        float mrun = -1e30f, lrun = 0.f;
        const int wq = w0 + l15, c0 = min(max(wq - 8, 0), 48);
        u32x4 kv, vv;
        { const int key = F.tid >> 3, ds = (F.tid & 7) * 8; const bool loc0 = 0 < nloc;
          const int krow = loc0 ? (TC + b * SEQ + rlo * 64 + key) : (b * CTXL + key);
          kv = *(const u32x4*)(P + (size_t)krow * 4096 + 512 + h * 64 + ds); vv = *(const u32x4*)(P + (size_t)krow * 4096 + 1024 + h * 64 + ds); }
        for (int ch = 0; ch < nloc + 4; ++ch) {
            const bool loc = ch < nloc; const int kr = rlo + ch;
            { const int key = F.tid >> 3, ds = (F.tid & 7) * 8;
              __syncthreads();
              *(LAS u32x4*)(Ks + key * 72 + ds) = kv;
              Vt[(ds + 0) * 72 + key] = (bf16_t)(vv.x & 0xffff); Vt[(ds + 1) * 72 + key] = (bf16_t)(vv.x >> 16);
              Vt[(ds + 2) * 72 + key] = (bf16_t)(vv.y & 0xffff); Vt[(ds + 3) * 72 + key] = (bf16_t)(vv.y >> 16);
              Vt[(ds + 4) * 72 + key] = (bf16_t)(vv.z & 0xffff); Vt[(ds + 5) * 72 + key] = (bf16_t)(vv.z >> 16);
              Vt[(ds + 6) * 72 + key] = (bf16_t)(vv.w & 0xffff); Vt[(ds + 7) * 72 + key] = (bf16_t)(vv.w >> 16);
              if (ch + 1 < nloc + 4) { const bool locn = (ch + 1) < nloc;
                  const int krow = locn ? (TC + b * SEQ + (kr + 1) * 64 + key) : (b * CTXL + (ch + 1 - nloc) * 64 + key);
                  kv = *(const u32x4*)(P + (size_t)krow * 4096 + 512 + h * 64 + ds); vv = *(const u32x4*)(P + (size_t)krow * 4096 + 1024 + h * 64 + ds); }
              __syncthreads(); }
            const bool mine = loc ? (kr >= r0 && kr < r0 + 8) : true;
            if (mine) {
                f32x4 s[4];
#pragma unroll
                for (int kb = 0; kb < 4; ++kb) { s[kb] = (f32x4){0.f, 0.f, 0.f, 0.f};
#pragma unroll
                    for (int ks = 0; ks < 2; ++ks) { const bf16x8 a = *(const LAS bf16x8*)(Ks + (kb * 16 + l15) * 72 + ks * 32 + g * 8);
                        s[kb] = __builtin_amdgcn_mfma_f32_16x16x32_bf16(a, qf[ks], s[kb], 0, 0, 0); } }
                if (loc) {
#pragma unroll
                    for (int kb = 0; kb < 4; ++kb)
#pragma unroll
                        for (int i = 0; i < 4; ++i) { const int kc = kb * 16 + 4 * g + i; const bool valid = (kc >= c0) && (kc < c0 + 16);
                            const int bi = (kr - myr + 7) * 31 + min(max(kc - wq + 15, 0), 30);
                            s[kb][i] = valid ? s[kb][i] + rp_l[bi] : -1e30f; }
                }
                float cm = -1e30f;
#pragma unroll
                for (int kb = 0; kb < 4; ++kb)
#pragma unroll
                    for (int i = 0; i < 4; ++i) cm = fmaxf(cm, s[kb][i]);
                cm = fmaxf(cm, __shfl_xor(cm, 16)); cm = fmaxf(cm, __shfl_xor(cm, 32));
                const float mn = fmaxf(mrun, cm), sc = __expf(mrun - mn);
                mrun = mn; lrun *= sc;
#pragma unroll
                for (int dt = 0; dt < 4; ++dt) oacc[dt] *= sc;
                float p[4][4];
#pragma unroll
                for (int kb = 0; kb < 4; ++kb)
#pragma unroll
                    for (int i = 0; i < 4; ++i) { p[kb][i] = __expf(s[kb][i] - mn); lrun += p[kb][i]; }
#pragma unroll
                for (int kp = 0; kp < 2; ++kp) {
                    u32x4 pw; pw.x = cvt_pk_bf16(p[2 * kp][0], p[2 * kp][1]); pw.y = cvt_pk_bf16(p[2 * kp][2], p[2 * kp][3]);
                    pw.z = cvt_pk_bf16(p[2 * kp + 1][0], p[2 * kp + 1][1]); pw.w = cvt_pk_bf16(p[2 * kp + 1][2], p[2 * kp + 1][3]);
                    bf16x8 pf; __builtin_memcpy(&pf, &pw, 16);
#pragma unroll
                    for (int dt = 0; dt < 4; ++dt) {
                        const u32x2 v0 = *(const LAS u32x2*)(Vt + (dt * 16 + l15) * 72 + (2 * kp) * 16 + 4 * g);
                        const u32x2 v1 = *(const LAS u32x2*)(Vt + (dt * 16 + l15) * 72 + (2 * kp + 1) * 16 + 4 * g);
                        u32x4 vw; vw.x = v0.x; vw.y = v0.y; vw.z = v1.x; vw.w = v1.y; bf16x8 vf; __builtin_memcpy(&vf, &vw, 16);
                        oacc[dt] = __builtin_amdgcn_mfma_f32_16x16x32_bf16(vf, pf, oacc[dt], 0, 0, 0);
                    }
                }
            }
        }
        float lt = lrun; lt += __shfl_xor(lt, 16); lt += __shfl_xor(lt, 32);
        const float inv = 1.0f / lt;
#pragma unroll
        for (int dt = 0; dt < 4; ++dt) { const f32x4 o = oacc[dt] * inv; u32x2 w; w.x = cvt_pk_bf16(o[0], o[1]); w.y = cvt_pk_bf16(o[2], o[3]);
            *(u32x2*)(F.MIX + (size_t)qrow * DM + h * 64 + dt * 16 + 4 * g) = w; }
        __syncthreads();
    }
}

__device__ __forceinline__ int hg_unit(int nb, int dir) { return dir == 0 ? nb : (nb < 2 ? 1 - nb : 2 + (HG_NU - 3 - (nb - 2))); }
__device__ __forceinline__ int hg_row(int b, int nb, int t) { return nb < 2 ? b * CTXL + nb * HG_U + t : TC + b * SEQ + (nb - 2) * HG_U + t; }
template <int CTRL> __device__ __forceinline__ float dpp_add0(float x) { return x + dppf<CTRL>(0.0f, x); }
template <bool WITHO>
__device__ __forceinline__ void hg_pass(const Frame& F, const bf16_t* P, const float* lbh, int b, int h, int nb, int dir, f32x4 (&S)[4][4], float (&Gsum)[16],
                                        LAS bf16_t* Vl, LAS bf16_t* Kl, float* OF, const float* ngp) {
    const int tau = F.lane & 15, g = F.lane >> 4;
    const unsigned vaddr = (unsigned)(size_t)Vl + (unsigned)((4 * g + (tau >> 2)) * 128 + (tau & 3) * 8);
    const unsigned kaddr = (unsigned)(size_t)Kl + (unsigned)((4 * g + (tau >> 2)) * 128 + (tau & 3) * 8);
    u32x2 zr[4], vr[4], qr[4];
    { const int t = dir ? (HG_U - 1 - tau) : tau; const bf16_t* pr = P + (size_t)hg_row(b, nb, t) * 4096 + h * 64 + 4 * g;
#pragma unroll
      for (int m = 0; m < 4; ++m) { zr[m] = *(const u32x2*)(pr + (dir ? 2560 : 2048) + 16 * m); vr[m] = *(const u32x2*)(pr + 3072 + 16 * m); } }
    for (int ci = 0; ci < HG_U / 16; ++ci) {
        float kk[16], c[16];
        if (WITHO) { const int pos = ci * 16 + tau, t = dir ? (HG_U - 1 - pos) : pos; const bf16_t* pr = P + (size_t)hg_row(b, nb, t) * 4096 + h * 64 + 4 * g;
#pragma unroll
            for (int m = 0; m < 4; ++m) qr[m] = *(const u32x2*)(pr + 1536 + 16 * m); }
#pragma unroll
        for (int m = 0; m < 4; ++m) { const float z0 = __uint_as_float(zr[m].x << 16), z1 = __uint_as_float(zr[m].x & 0xffff0000u), z2 = __uint_as_float(zr[m].y << 16), z3 = __uint_as_float(zr[m].y & 0xffff0000u);
            const float zz[4] = {z0, z1, z2, z3};
            const f32x4 lb4 = *(const f32x4*)(lbh + 16 * m + 4 * g);
#pragma unroll
            for (int i = 0; i < 4; ++i) { const float lb = lb4[i]; const float f = fmaxf(lb + (1.0f - lb) * sigmoidf_(zz[i]), 1e-30f); kk[m * 4 + i] = 1.0f - f; c[m * 4 + i] = __logf(f); }
            *(LAS u32x2*)(Vl + tau * 64 + 16 * m + 4 * g) = vr[m];
 }
        if (ci + 1 < HG_U / 16) { const int pos = (ci + 1) * 16 + tau, t = dir ? (HG_U - 1 - pos) : pos; const bf16_t* pr = P + (size_t)hg_row(b, nb, t) * 4096 + h * 64 + 4 * g;
#pragma unroll
            for (int m = 0; m < 4; ++m) { zr[m] = *(const u32x2*)(pr + (dir ? 2560 : 2048) + 16 * m); vr[m] = *(const u32x2*)(pr + 3072 + 16 * m); } }
#pragma unroll
        for (int q = 0; q < 16; ++q) { c[q] = dpp_add0<0x111>(c[q]); c[q] = dpp_add0<0x112>(c[q]); c[q] = dpp_add0<0x114>(c[q]); c[q] = dpp_add0<0x118>(c[q]); }
        float G[16];
#pragma unroll
        for (int q = 0; q < 16; ++q) { G[q] = __shfl(c[q], (F.lane & 48) | 15); Gsum[q] += G[q]; }
#pragma unroll
        for (int m = 0; m < 4; ++m) { float kh[4];
#pragma unroll
            for (int i = 0; i < 4; ++i) kh[i] = kk[m * 4 + i] * __expf(G[m * 4 + i] - c[m * 4 + i]);
            u32x2 w; w.x = cvt_pk_bf16(kh[0], kh[1]); w.y = cvt_pk_bf16(kh[2], kh[3]);
            *(LAS u32x2*)(Kl + tau * 64 + 16 * m + 4 * g) = w; }
        float ofv[4][4], gtv[4][4]; int orow[4];
        if (WITHO) {
#pragma unroll
            for (int i = 0; i < 4; ++i) { const int p2 = ci * 16 + 4 * g + i, t2 = dir ? (HG_U - 1 - p2) : p2; orow[i] = hg_row(b, nb, t2); }
            if (dir) {
#pragma unroll
                for (int i = 0; i < 4; ++i)
#pragma unroll
                    for (int vt = 0; vt < 4; ++vt) { ofv[i][vt] = OF[(size_t)orow[i] * 512 + h * 64 + 16 * vt + tau]; gtv[i][vt] = bf2f(P[(size_t)orow[i] * 4096 + 3584 + h * 64 + 16 * vt + tau]); }
            }
        }
        asm volatile("s_waitcnt lgkmcnt(0)" ::: "memory");
        u32x2 vtr[4], ktr[4];
        asm volatile("ds_read_b64_tr_b16 %0, %8\n\tds_read_b64_tr_b16 %1, %8 offset:32\n\tds_read_b64_tr_b16 %2, %8 offset:64\n\tds_read_b64_tr_b16 %3, %8 offset:96\n\t"
                     "ds_read_b64_tr_b16 %4, %9\n\tds_read_b64_tr_b16 %5, %9 offset:32\n\tds_read_b64_tr_b16 %6, %9 offset:64\n\tds_read_b64_tr_b16 %7, %9 offset:96\n\ts_waitcnt lgkmcnt(0)"
                     : "=&v"(vtr[0]), "=&v"(vtr[1]), "=&v"(vtr[2]), "=&v"(vtr[3]), "=&v"(ktr[0]), "=&v"(ktr[1]), "=&v"(ktr[2]), "=&v"(ktr[3]) : "v"(vaddr), "v"(kaddr) : "memory");
        bf16x8 Vf[4], Kf[4];
#pragma unroll
        for (int q = 0; q < 4; ++q) { u32x4 w; w.x = vtr[q].x; w.y = vtr[q].y; w.z = 0u; w.w = 0u; __builtin_memcpy(&Vf[q], &w, 16); u32x4 w2; w2.x = ktr[q].x; w2.y = ktr[q].y; w2.z = 0u; w2.w = 0u; __builtin_memcpy(&Kf[q], &w2, 16); }
        if (WITHO) {
            bf16x8 Ktf[2], Qtf[2], Qhf[2];
#pragma unroll
            for (int ks = 0; ks < 2; ++ks) { float kt_[8], qt_[8], qh_[8];
#pragma unroll
                for (int mm = 0; mm < 2; ++mm) { const int m = 2 * ks + mm;
                    const float qq[4] = {__uint_as_float(qr[m].x << 16), __uint_as_float(qr[m].x & 0xffff0000u), __uint_as_float(qr[m].y << 16), __uint_as_float(qr[m].y & 0xffff0000u)};
#pragma unroll
                    for (int i = 0; i < 4; ++i) { const int q = m * 4 + i; const float qv = siluf_(qq[i]) * 0.125f; const float d = fminf(fmaxf(c[q] - 0.5f * G[q], -80.0f), 80.0f);
                        qt_[mm * 4 + i] = qv * __expf(d); kt_[mm * 4 + i] = kk[q] * __expf(-d); qh_[mm * 4 + i] = qv * __expf(c[q]); } }
                u32x4 w; w.x = cvt_pk_bf16(kt_[0], kt_[1]); w.y = cvt_pk_bf16(kt_[2], kt_[3]); w.z = cvt_pk_bf16(kt_[4], kt_[5]); w.w = cvt_pk_bf16(kt_[6], kt_[7]); __builtin_memcpy(&Ktf[ks], &w, 16);
                w.x = cvt_pk_bf16(qt_[0], qt_[1]); w.y = cvt_pk_bf16(qt_[2], qt_[3]); w.z = cvt_pk_bf16(qt_[4], qt_[5]); w.w = cvt_pk_bf16(qt_[6], qt_[7]); __builtin_memcpy(&Qtf[ks], &w, 16);
                w.x = cvt_pk_bf16(qh_[0], qh_[1]); w.y = cvt_pk_bf16(qh_[2], qh_[3]); w.z = cvt_pk_bf16(qh_[4], qh_[5]); w.w = cvt_pk_bf16(qh_[6], qh_[7]); __builtin_memcpy(&Qhf[ks], &w, 16); }
            f32x4 AT = (f32x4){0.f, 0.f, 0.f, 0.f};
            AT = __builtin_amdgcn_mfma_f32_16x16x32_bf16(Ktf[0], Qtf[0], AT, 0, 0, 0); AT = __builtin_amdgcn_mfma_f32_16x16x32_bf16(Ktf[1], Qtf[1], AT, 0, 0, 0);
#pragma unroll
            for (int i = 0; i < 4; ++i) AT[i] = (4 * g + i <= tau) ? AT[i] : 0.0f;
            bf16x8 Af; { u32x4 w; w.x = cvt_pk_bf16(AT[0], AT[1]); w.y = cvt_pk_bf16(AT[2], AT[3]); w.z = 0u; w.w = 0u; __builtin_memcpy(&Af, &w, 16); }
            f32x4 o[4];
#pragma unroll
            for (int vt = 0; vt < 4; ++vt) { o[vt] = __builtin_amdgcn_mfma_f32_16x16x32_bf16(Af, Vf[vt], (f32x4){0.f, 0.f, 0.f, 0.f}, 0, 0, 0);
#pragma unroll
                for (int ks = 0; ks < 2; ++ks) { u32x4 w; w.x = cvt_pk_bf16(S[2 * ks][vt][0], S[2 * ks][vt][1]); w.y = cvt_pk_bf16(S[2 * ks][vt][2], S[2 * ks][vt][3]);
                    w.z = cvt_pk_bf16(S[2 * ks + 1][vt][0], S[2 * ks + 1][vt][1]); w.w = cvt_pk_bf16(S[2 * ks + 1][vt][2], S[2 * ks + 1][vt][3]); bf16x8 Sf; __builtin_memcpy(&Sf, &w, 16);
                    o[vt] = __builtin_amdgcn_mfma_f32_16x16x32_bf16(Qhf[ks], Sf, o[vt], 0, 0, 0); } }
            if (dir == 0) {
#pragma unroll
                for (int i = 0; i < 4; ++i)
#pragma unroll
                    for (int vt = 0; vt < 4; ++vt) OF[(size_t)orow[i] * 512 + h * 64 + 16 * vt + tau] = o[vt][i];
            } else {
#pragma unroll
                for (int i = 0; i < 4; ++i) { float tot[4]; float sq = 0.f;
#pragma unroll
                    for (int vt = 0; vt < 4; ++vt) { tot[vt] = o[vt][i] + ofv[i][vt]; sq = fmaf(tot[vt], tot[vt], sq); }
                    sq += dppf<0xB1>(sq, sq); sq += dppf<0x4E>(sq, sq); sq += dppf<0x141>(sq, sq); sq += dppf<0x140>(sq, sq);
                    const float rs = rsqrtf(sq * (1.0f / 64.0f) + 1e-6f);
#pragma unroll
                    for (int vt = 0; vt < 4; ++vt) F.MIX[(size_t)orow[i] * DM + 512 + h * 64 + 16 * vt + tau] = f2bf(tot[vt] * rs * ngp[16 * vt + tau] * siluf_(gtv[i][vt])); }
            }
        }
#pragma unroll
        for (int kt = 0; kt < 4; ++kt) { f32x4 eg;
#pragma unroll
            for (int i = 0; i < 4; ++i) eg[i] = __expf(G[kt * 4 + i]);
#pragma unroll
            for (int vt = 0; vt < 4; ++vt) S[kt][vt] = __builtin_amdgcn_mfma_f32_16x16x32_bf16(Kf[kt], Vf[vt], S[kt][vt] * eg, 0, 0, 0); }
    }
}
__device__ __forceinline__ void ph_hg_a(const Frame& F, int j) {
    const bf16_t* P = (const bf16_t*)(F.R1 + R1_P);
    float* SLOC = (float*)(F.R1 + R1_SLOC); float* DL = (float*)(F.R1 + R1_DL);
    LAS bf16_t* Vl = (LAS bf16_t*)(F.lds + 32768 + F.wave * 4096); LAS bf16_t* Kl = Vl + 1024;
    const int gw = F.wg * 8 + F.wave, nw = F.G * 8;
    const int NT = NBAT * 8 * HG_NU * 2;
    for (int task = gw; task < NT; task += nw) {
        const int dir = task & 1, nb = (task >> 1) % HG_NU, bh = (task >> 1) / HG_NU, b = bh >> 3, h = bh & 7;
        const float* lbh = (const float*)(F.ws + OFF_LBT) + (j * 2 + dir) * 512 + h * 64;
        f32x4 S[4][4];
#pragma unroll
        for (int kt = 0; kt < 4; ++kt)
#pragma unroll
            for (int vt = 0; vt < 4; ++vt) S[kt][vt] = (f32x4){0.f, 0.f, 0.f, 0.f};
        float Gsum[16];
#pragma unroll
        for (int q = 0; q < 16; ++q) Gsum[q] = 0.f;
        hg_pass<false>(F, P, lbh, b, h, nb, dir, S, Gsum, Vl, Kl, nullptr, nullptr);
        const int seq = bh * 2 + dir, u = hg_unit(nb, dir);
        float* so = SLOC + ((size_t)seq * HG_NU + u) * 4096;
#pragma unroll
        for (int kt = 0; kt < 4; ++kt)
#pragma unroll
            for (int vt = 0; vt < 4; ++vt)
#pragma unroll
                for (int i = 0; i < 4; ++i) so[((kt * 4 + vt) * 4 + i) * 64 + F.lane] = S[kt][vt][i];
        if ((F.lane & 15) == 0) { float* dd = DL + ((size_t)seq * HG_NU + u) * 64;
#pragma unroll
            for (int m = 0; m < 4; ++m)
#pragma unroll
                for (int i = 0; i < 4; ++i) dd[16 * m + 4 * (F.lane >> 4) + i] = __expf(Gsum[m * 4 + i]); }
    }
}
__device__ __forceinline__ void ph_hg_b(const Frame& F) {
    const float* SLOC = (const float*)(F.R1 + R1_SLOC); const float* DL = (const float*)(F.R1 + R1_DL); float* SST = (float*)(F.R1 + R1_SST);
    for (int idx = F.wg * 512 + F.tid; idx < 64 * 4096; idx += F.G * 512) {
        const int seq = idx >> 12, e = idx & 4095, ln = e & 63, reg = e >> 6, i = reg & 3, kt = reg >> 4, k = 16 * kt + 4 * (ln >> 4) + i;
        float s = 0.f;
#pragma unroll 6
        for (int u = 0; u < HG_NU; ++u) { const size_t o = ((size_t)seq * HG_NU + u) * 4096 + e; SST[o] = s; s = DL[((size_t)seq * HG_NU + u) * 64 + k] * s + SLOC[o]; }
    }
}
__device__ __forceinline__ void ph_hg_c(const Frame& F, int j) {
    const bf16_t* P = (const bf16_t*)(F.R1 + R1_P);
    const float* SST = (const float*)(F.R1 + R1_SST); float* OF = (float*)(F.R1 + R1_OF);
    const float* ng = inp(F, 12) + j * 64;
    LAS bf16_t* Vl = (LAS bf16_t*)(F.lds + 32768 + F.wave * 4096); LAS bf16_t* Kl = Vl + 1024;
    const int gw = F.wg * 8 + F.wave, nw = F.G * 8;
    const int NT = NBAT * 8 * (HG_NU - 2);
    for (int task = gw; task < NT; task += nw) {
        const int nb = 2 + task % (HG_NU - 2), bh = task / (HG_NU - 2), b = bh >> 3, h = bh & 7;
        for (int dir = 0; dir < 2; ++dir) {
            const float* lbh = (const float*)(F.ws + OFF_LBT) + (j * 2 + dir) * 512 + h * 64;
            const int seq = bh * 2 + dir, u = hg_unit(nb, dir);
            const float* ss = SST + ((size_t)seq * HG_NU + u) * 4096;
            f32x4 S[4][4];
#pragma unroll
            for (int kt = 0; kt < 4; ++kt)
#pragma unroll
                for (int vt = 0; vt < 4; ++vt)
#pragma unroll
                    for (int i = 0; i < 4; ++i) S[kt][vt][i] = ss[((kt * 4 + vt) * 4 + i) * 64 + F.lane];
            float Gsum[16];
#pragma unroll
            for (int q = 0; q < 16; ++q) Gsum[q] = 0.f;
            hg_pass<true>(F, P, lbh, b, h, nb, dir, S, Gsum, Vl, Kl, OF, ng);
            asm volatile("s_waitcnt vmcnt(0)" ::: "memory");
        }
    }
}

__device__ __forceinline__ void ph_hg_c_ctx(const Frame& F, int j) {
    if (F.wg >= NBAT * 8 * 2 || F.wave != 0) return;
    const bf16_t* P = (const bf16_t*)(F.R1 + R1_P);
    const float* SLOC = (const float*)(F.R1 + R1_SLOC); float* OF = (float*)(F.R1 + R1_OF);
    const float* ng = inp(F, 12) + j * 64;
    LAS bf16_t* Vl = (LAS bf16_t*)(F.lds + 32768 + F.wave * 4096); LAS bf16_t* Kl = Vl + 1024;
    const int nb = F.wg & 1, bh = F.wg >> 1, b = bh >> 3, h = bh & 7;
    for (int dir = 0; dir < 2; ++dir) {
        const float* lbh = (const float*)(F.ws + OFF_LBT) + (j * 2 + dir) * 512 + h * 64;
        const int seq = bh * 2 + dir, u = hg_unit(nb, dir);
        const float* ss = SLOC + ((size_t)seq * HG_NU + 0) * 4096;
        f32x4 S[4][4];
#pragma unroll
        for (int kt = 0; kt < 4; ++kt)
#pragma unroll
            for (int vt = 0; vt < 4; ++vt)
#pragma unroll
                for (int i = 0; i < 4; ++i) S[kt][vt][i] = (u == 0) ? 0.0f : ss[((kt * 4 + vt) * 4 + i) * 64 + F.lane];
        float Gsum[16];
#pragma unroll
        for (int q = 0; q < 16; ++q) Gsum[q] = 0.f;
        hg_pass<true>(F, P, lbh, b, h, nb, dir, S, Gsum, Vl, Kl, OF, ng);
        asm volatile("s_waitcnt vmcnt(0)" ::: "memory");
    }
}

__device__ __forceinline__ int lru_nat(int so, int dir) { return dir == 0 ? so : (so < 16 ? 15 - so : 16 + (LRU_NT - 1 - so)); }
__device__ __forceinline__ int lru_row(int b, int nt, int t) { return nt < 16 ? b * CTXL + nt * 16 + t : TC + b * SEQ + (nt - 16) * 16 + t; }
struct LruRaw { u32x4 a[4], b[4]; };
__device__ __forceinline__ void lru_load(const Frame& F, int b, int kb, int nt, LruRaw& R) {
    const bf16_t* P = (const bf16_t*)(F.R1 + R1_P);
    const int tk = F.lane & 15, g = F.lane >> 4;
    const int len = nt < 16 ? CTXL : SEQ, tpos = (nt < 16 ? nt * 16 : (nt - 16) * 16) + tk;
    const bf16_t* pbase = P + (size_t)((nt < 16 ? b * CTXL : TC + b * SEQ)) * 2048 + 1024 + kb * 64 + g * 16;
#pragma unroll
    for (int tap = 0; tap < 4; ++tap) { const int tp = tpos + tap - 2; const bool ok = (tp >= 0 && tp < len); const bf16_t* pr = pbase + (size_t)(ok ? tp : tpos) * 2048;
        R.a[tap] = *(const u32x4*)pr; R.b[tap] = *(const u32x4*)(pr + 8); if (!ok) { R.a[tap] = (u32x4){0u, 0u, 0u, 0u}; R.b[tap] = (u32x4){0u, 0u, 0u, 0u}; } }
}
__device__ __forceinline__ void lru_conv(const Frame& F, const LruRaw& R, const LAS float* CT, LAS float* ucb) {
    const int tk = F.lane & 15, g = F.lane >> 4;
    float acc[16];
#pragma unroll
    for (int q = 0; q < 4; ++q) { const f32x4 c4 = *(const LAS f32x4*)(CT + 4 * 64 + g * 16 + q * 4); acc[q * 4] = c4[0]; acc[q * 4 + 1] = c4[1]; acc[q * 4 + 2] = c4[2]; acc[q * 4 + 3] = c4[3]; }
#pragma unroll
    for (int tap = 0; tap < 4; ++tap) { float t0[8], t1[8]; unpack8(R.a[tap], t0); unpack8(R.b[tap], t1);
#pragma unroll
        for (int q = 0; q < 2; ++q) { const f32x4 w0 = *(const LAS f32x4*)(CT + tap * 64 + g * 16 + q * 4), w1 = *(const LAS f32x4*)(CT + tap * 64 + g * 16 + 8 + q * 4);
#pragma unroll
            for (int i = 0; i < 4; ++i) { acc[q * 4 + i] = fmaf(w0[i], t0[q * 4 + i], acc[q * 4 + i]); acc[8 + q * 4 + i] = fmaf(w1[i], t1[q * 4 + i], acc[8 + q * 4 + i]); } } }
#pragma unroll
    for (int q = 0; q < 4; ++q) *(LAS f32x4*)(ucb + tk * 64 + g * 16 + q * 4) = (f32x4){acc[q * 4], acc[q * 4 + 1], acc[q * 4 + 2], acc[q * 4 + 3]};
}
__device__ __forceinline__ void lru_gates(const Frame& F, LAS bf16_t* Wl, const LAS float* CT, LAS float* ucb, float (&av)[2][4][4], float (&xv)[2][4][4]) {
    const int tk = F.lane & 15, g = F.lane >> 4;
    bf16x8 bfr[2];
#pragma unroll
    for (int ks = 0; ks < 2; ++ks) { const f32x4 u0 = *(const LAS f32x4*)(ucb + tk * 64 + ks * 32 + g * 8), u1 = *(const LAS f32x4*)(ucb + tk * 64 + ks * 32 + g * 8 + 4);
        u32x4 w; w.x = cvt_pk_bf16(u0[0], u0[1]); w.y = cvt_pk_bf16(u0[2], u0[3]); w.z = cvt_pk_bf16(u1[0], u1[1]); w.w = cvt_pk_bf16(u1[2], u1[3]); __builtin_memcpy(&bfr[ks], &w, 16); }
#pragma unroll
    for (int d = 0; d < 2; ++d)
#pragma unroll
        for (int et = 0; et < 4; ++et) {
            f32x4 ra = (f32x4){0.f, 0.f, 0.f, 0.f}, ri = (f32x4){0.f, 0.f, 0.f, 0.f};
#pragma unroll
            for (int ks = 0; ks < 2; ++ks) {
                const bf16x8 wa = *(const LAS bf16x8*)(Wl + ((d * 2 + 0) * 64 + et * 16 + tk) * 64 + ks * 32 + g * 8);
                const bf16x8 wx = *(const LAS bf16x8*)(Wl + ((d * 2 + 1) * 64 + et * 16 + tk) * 64 + ks * 32 + g * 8);
                ra = __builtin_amdgcn_mfma_f32_16x16x32_bf16(wa, bfr[ks], ra, 0, 0, 0);
                ri = __builtin_amdgcn_mfma_f32_16x16x32_bf16(wx, bfr[ks], ri, 0, 0, 0);
            }
            const f32x4 ba4 = *(const LAS f32x4*)(CT + (5 + 3 * d) * 64 + et * 16 + 4 * g), bx4 = *(const LAS f32x4*)(CT + (6 + 3 * d) * 64 + et * 16 + 4 * g), cs4 = *(const LAS f32x4*)(CT + (7 + 3 * d) * 64 + et * 16 + 4 * g);
            const f32x4 u4 = *(const LAS f32x4*)(ucb + tk * 64 + et * 16 + 4 * g);
#pragma unroll
            for (int i = 0; i < 4; ++i) {
                const float r = sigmoidf_(ra[i] + ba4[i]), ig = sigmoidf_(ri[i] + bx4[i]);
                const float la = cs4[i] * r, a = __expf(la);
                av[d][et][i] = la; xv[d][et][i] = sqrtf(fmaxf(1.0f - a * a, 0.f)) * ig * u4[i]; }
        }
}
template <int S> __device__ __forceinline__ void lru_step_f(float& a, float& x) { const float ap = dppf<0x110 + S>(1.0f, a), xp = dppf<0x110 + S>(0.0f, x); x = fmaf(a, xp, x); a = a * ap; }
template <int S> __device__ __forceinline__ void lru_step_b(float& a, float& x) { const float ap = dppf<0x100 + S>(1.0f, a), xp = dppf<0x100 + S>(0.0f, x); x = fmaf(a, xp, x); a = a * ap; }
#define LRU_SCANS(av, xv) do { _Pragma("unroll") for (int et = 0; et < 4; ++et) _Pragma("unroll") for (int i = 0; i < 4; ++i) { \
        lru_step_f<1>(av[0][et][i], xv[0][et][i]); lru_step_f<2>(av[0][et][i], xv[0][et][i]); lru_step_f<4>(av[0][et][i], xv[0][et][i]); lru_step_f<8>(av[0][et][i], xv[0][et][i]); \
        lru_step_b<1>(av[1][et][i], xv[1][et][i]); lru_step_b<2>(av[1][et][i], xv[1][et][i]); lru_step_b<4>(av[1][et][i], xv[1][et][i]); lru_step_b<8>(av[1][et][i], xv[1][et][i]); } } while (0)
__device__ __forceinline__ void ph_lru_a(const Frame& F, int jj) {
    LAS bf16_t* Wl = (LAS bf16_t*)F.lds;
    LAS float* ucb = (LAS float*)(F.lds + 32768 + F.wave * 4096);
    LAS float* CT = (LAS float*)(F.lds + 65536);
    const bf16_t* wsrc = (const bf16_t*)(F.WB + WB_LRU);
    float* AG = (float*)(F.R1 + R1_AG); bf16_t* GX = (bf16_t*)(F.R1 + R1_GX);
    const float* cw = inp(F, 14) + (size_t)jj * 4 * 1024; const float* cb = inp(F, 15) + (size_t)jj * 1024;
    const float* b_a = inp(F, 17) + (size_t)jj * 2 * 1024; const float* b_x = inp(F, 19) + (size_t)jj * 2 * 1024; const float* lam = inp(F, 20) + (size_t)jj * 2 * 1024;
    const int tk = F.lane & 15, g = F.lane >> 4;
    const int NTASK = NBAT * 16 * 11;
    for (int task = F.wg; task < NTASK; task += F.G) {
        const int grp = task % 11, kb = (task / 11) & 15, b = task / (11 * 16);
        __syncthreads();
        for (int i = F.tid; i < 4 * 4096 / 8; i += 512) { const int mg = i >> 9, r = i & 511;
            *(LAS u32x4*)(Wl + mg * 4096 + r * 8) = *(const u32x4*)(wsrc + ((size_t)mg * 16 + kb) * 4096 + r * 8); }
        for (int i = F.tid; i < 11 * 64; i += 512) { const int kind = i >> 6, ch = kb * 64 + (i & 63); float v;
            if (kind < 4) v = cw[kind * 1024 + ch]; else if (kind == 4) v = cb[ch];
            else { const int d = (kind - 5) / 3, w = (kind - 5) % 3; v = (w == 0) ? b_a[d * 1024 + ch] : (w == 1) ? b_x[d * 1024 + ch] : -8.0f * log1pf(__expf(-lam[d * 1024 + ch])); }
            CT[i] = v; }
        __syncthreads();
        const int nt0 = grp * 48;
        LruRaw raw; lru_load(F, b, kb, nt0 + F.wave, raw);
        for (int ti = F.wave; ti < 48; ti += 8) {
            const int nt = nt0 + ti;
            float av[2][4][4], xv[2][4][4];
            lru_conv(F, raw, CT, ucb);
            if (ti + 8 < 48) lru_load(F, b, kb, nt + 8, raw);
            lru_gates(F, Wl, CT, ucb, av, xv);
            const int row = lru_row(b, nt, tk);
#pragma unroll
            for (int d = 0; d < 2; ++d)
#pragma unroll
                for (int et = 0; et < 4; ++et) { u32x4 w; w.x = cvt_pk_bf16(av[d][et][0], xv[d][et][0]); w.y = cvt_pk_bf16(av[d][et][1], xv[d][et][1]); w.z = cvt_pk_bf16(av[d][et][2], xv[d][et][2]); w.w = cvt_pk_bf16(av[d][et][3], xv[d][et][3]);
                    *(u32x4*)(GX + (((size_t)row * 2 + d) * 1024 + kb * 64 + et * 16 + 4 * g) * 2) = w;
                    const unsigned ww[4] = {w.x, w.y, w.z, w.w};
#pragma unroll
                    for (int i = 0; i < 4; ++i) { av[d][et][i] = __expf(__uint_as_float(ww[i] << 16)); xv[d][et][i] = __uint_as_float(ww[i] & 0xffff0000u); } }
            LRU_SCANS(av, xv);
#pragma unroll
            for (int d = 0; d < 2; ++d) if (tk == (d ? 0 : 15)) {
                float* ag = AG + (((size_t)(b * 2 + d) * LRU_NT + nt) * 2) * 1024 + kb * 64;
#pragma unroll
                for (int et = 0; et < 4; ++et) { *(f32x4*)(ag + et * 16 + 4 * g) = (f32x4){av[d][et][0], av[d][et][1], av[d][et][2], av[d][et][3]};
                    *(f32x4*)(ag + 1024 + et * 16 + 4 * g) = (f32x4){xv[d][et][0], xv[d][et][1], xv[d][et][2], xv[d][et][3]}; }
            }
        }
    }
    __syncthreads();
}
__device__ __forceinline__ void ph_lru_c(const Frame& F) {
    const float* HST = (const float*)(F.R1 + R1_HST); const bf16_t* GX = (const bf16_t*)(F.R1 + R1_GX);
    const bf16_t* P = (const bf16_t*)(F.R1 + R1_P);
    const int tk = F.lane & 15, g = F.lane >> 4;
    const int gw = F.wg * 8 + F.wave, nw = F.G * 8;
    for (int task = gw; task < NBAT * LRU_NT * 16; task += nw) {
        const int kb = task & 15, nt = (task >> 4) % LRU_NT, b = (task >> 4) / LRU_NT;
        const int row = lru_row(b, nt, tk);
        u32x4 gx[2][4]; f32x4 hf[4], hb[4]; u32x2 yw[4];
#pragma unroll
        for (int d = 0; d < 2; ++d)
#pragma unroll
            for (int et = 0; et < 4; ++et) gx[d][et] = *(const u32x4*)(GX + (((size_t)row * 2 + d) * 1024 + kb * 64 + et * 16 + 4 * g) * 2);
#pragma unroll
        for (int et = 0; et < 4; ++et) { const int ch = kb * 64 + et * 16 + 4 * g;
            hf[et] = *(const f32x4*)(HST + ((size_t)(b * 2 + 0) * LRU_NT + nt) * 1024 + ch);
            hb[et] = *(const f32x4*)(HST + ((size_t)(b * 2 + 1) * LRU_NT + nt) * 1024 + ch);
            yw[et] = *(const u32x2*)(P + (size_t)row * 2048 + ch); }
        float av[2][4][4], xv[2][4][4];
#pragma unroll
        for (int d = 0; d < 2; ++d)
#pragma unroll
            for (int et = 0; et < 4; ++et) { const unsigned ww[4] = {gx[d][et].x, gx[d][et].y, gx[d][et].z, gx[d][et].w};
#pragma unroll
                for (int i = 0; i < 4; ++i) { av[d][et][i] = __expf(__uint_as_float(ww[i] << 16)); xv[d][et][i] = __uint_as_float(ww[i] & 0xffff0000u); } }
        LRU_SCANS(av, xv);
#pragma unroll
        for (int et = 0; et < 4; ++et) {
            const int ch = kb * 64 + et * 16 + 4 * g;
            const float y0 = __uint_as_float(yw[et].x << 16), y1 = __uint_as_float(yw[et].x & 0xffff0000u), y2 = __uint_as_float(yw[et].y << 16), y3 = __uint_as_float(yw[et].y & 0xffff0000u);
            float o[4];
#pragma unroll
            for (int i = 0; i < 4; ++i) o[i] = fmaf(av[0][et][i], hf[et][i], xv[0][et][i]) + fmaf(av[1][et][i], hb[et][i], xv[1][et][i]);
            o[0] *= gelu_tanh_(y0); o[1] *= gelu_tanh_(y1); o[2] *= gelu_tanh_(y2); o[3] *= gelu_tanh_(y3);
            u32x2 w; w.x = cvt_pk_bf16(o[0], o[1]); w.y = cvt_pk_bf16(o[2], o[3]);
            *(u32x2*)(F.MIX + (size_t)row * DM + ch) = w;
        }
    }
}
__device__ __forceinline__ void ph_lru_b(const Frame& F) {
    const float* AG = (const float*)(F.R1 + R1_AG); float* HST = (float*)(F.R1 + R1_HST);
    LAS float* sa = (LAS float*)F.lds; LAS float* sx = sa + 512;
    for (int task = F.wg; task < NBAT * 2 * 32; task += F.G) {
        const int cgp = task & 31, d = (task >> 5) & 1, b = task >> 6;
        const int ch = cgp * 32 + (F.tid & 31), seg = F.tid >> 5;
        const float* ag = AG + ((size_t)(b * 2 + d) * LRU_NT) * 2048 + ch;
        float A = 1.0f, Xv = 0.f;
        for (int i = 0; i < 33; ++i) { const int nt = lru_nat(seg * 33 + i, d); const float a = ag[(size_t)nt * 2048], x = ag[(size_t)nt * 2048 + 1024]; Xv = fmaf(a, Xv, x); A *= a; }
        __syncthreads();
        sa[F.tid] = A; sx[F.tid] = Xv;
        __syncthreads();
        float h = 0.f;
        for (int s2 = 0; s2 < seg; ++s2) h = fmaf(sa[s2 * 32 + (F.tid & 31)], h, sx[s2 * 32 + (F.tid & 31)]);
        float* hs = HST + ((size_t)(b * 2 + d) * LRU_NT) * 1024 + ch;
        for (int i = 0; i < 33; ++i) { const int nt = lru_nat(seg * 33 + i, d); hs[(size_t)nt * 1024] = h; const float a = ag[(size_t)nt * 2048], x = ag[(size_t)nt * 2048 + 1024]; h = fmaf(a, h, x); }
    }
    __syncthreads();
}

__device__ __forceinline__ void topk_better(float& bk, int& be, float& bs, float ok, int oe, float os) { const bool t = (ok > bk) || (ok == bk && oe < be); bk = t ? ok : bk; be = t ? oe : be; bs = t ? os : bs; }
template <int CTRL> __device__ __forceinline__ void topk_step(float& bk, int& be, float& bs) {
    const float ok = dppf<CTRL>(bk, bk), os = dppf<CTRL>(bs, bs); const int oe = __builtin_amdgcn_update_dpp(be, be, CTRL, 0xf, 0xf, false); topk_better(bk, be, bs, ok, oe, os); }
__device__ __forceinline__ void ph_ln_router(const Frame& F, int l, bool dry = false) {
    const bf16_t* RW = (const bf16_t*)(F.WB + WB_RT);
    const float* rbias = inp(F, 23) + l * 64;
    LAS float* part = (LAS float*)F.lds;
    LAS float* LP = (LAS float*)(F.lds + 4096);
    LAS int* hist = (LAS int*)(F.lds + LDS_MISC + MISC_HIST); LAS int* hbase = (LAS int*)(F.lds + LDS_MISC + MISC_HBASE);
    int* tok_e = (int*)(F.ws + OFF_TOKE); int* tok_p = (int*)(F.ws + OFF_TOKP); float* tok_w = (float*)(F.ws + OFF_TOKW);
    int* stok = (int*)(F.ws + OFF_STOK); float* sw = (float*)(F.ws + OFF_SW);
    float* stats = (float*)(F.ws + OFF_STATS);
    unsigned* gcnt = (unsigned*)(F.ws + OFF_CTL + CTL_CNT) + l * 64;
    const int tk = F.lane & 15, g = F.lane >> 4;
    float rb[4];
#pragma unroll
    for (int q = 0; q < 4; ++q) rb[q] = rbias[tk + 16 * q];
    if (F.tid < 64) hist[F.tid] = 0;
    __syncthreads();
    const int NTILE = TT / 16;
    for (int tile = F.wg; tile < NTILE; tile += F.G) {
        const int row = tile * 16 + tk; const int s = slot_of_row(tile * 16);
        const float* ab = (const float*)(F.ws + OFF_AB) + (size_t)(l * 5 + s) * 2048;
        const float* xr = F.X + (size_t)row * DM + F.wave * 128 + g * 8;
        f32x4 v[4][2];
#pragma unroll
        for (int ks = 0; ks < 4; ++ks) { v[ks][0] = *(const f32x4*)(xr + ks * 32); v[ks][1] = *(const f32x4*)(xr + ks * 32 + 4); }
        float sum = 0.f, sq = 0.f;
#pragma unroll
        for (int ks = 0; ks < 4; ++ks)
#pragma unroll
            for (int hh = 0; hh < 2; ++hh) { const f32x4 a = v[ks][hh]; sum += (a[0] + a[1]) + (a[2] + a[3]); sq += (a[0] * a[0] + a[1] * a[1]) + (a[2] * a[2] + a[3] * a[3]); }
        sum += __shfl_xor(sum, 16); sum += __shfl_xor(sum, 32); sq += __shfl_xor(sq, 16); sq += __shfl_xor(sq, 32);
        if (g == 0) *(LAS f32x2*)(part + (F.wave * 16 + tk) * 2) = (f32x2){sum, sq};
        __syncthreads();
        float ts = 0.f, tq = 0.f;
#pragma unroll
        for (int w = 0; w < 8; ++w) { const f32x2 p = *(const LAS f32x2*)(part + (w * 16 + tk) * 2); ts += p.x; tq += p.y; }
        const float mean = ts * (1.0f / 1024.0f), var = fmaxf(tq * (1.0f / 1024.0f) - mean * mean, 0.f), rstd = rsqrtf(var + 1e-5f);
        if (F.wave == 0 && g == 0) *(f32x2*)(stats + (size_t)row * 2) = (f32x2){mean, rstd};
        f32x4 acc[4];
#pragma unroll
        for (int et = 0; et < 4; ++et) acc[et] = (f32x4){0.f, 0.f, 0.f, 0.f};
#pragma unroll
        for (int ks = 0; ks < 4; ++ks) { const int k = F.wave * 128 + ks * 32 + g * 8;
            const f32x4 a10 = *(const f32x4*)(ab + k), a11 = *(const f32x4*)(ab + k + 4), b10 = *(const f32x4*)(ab + 1024 + k), b11 = *(const f32x4*)(ab + 1024 + k + 4);
            const f32x4 h0 = (v[ks][0] - mean) * rstd * a10 + b10, h1 = (v[ks][1] - mean) * rstd * a11 + b11;
            u32x4 w; w.x = cvt_pk_bf16(h0[0], h0[1]); w.y = cvt_pk_bf16(h0[2], h0[3]); w.z = cvt_pk_bf16(h1[0], h1[1]); w.w = cvt_pk_bf16(h1[2], h1[3]);
            *(u32x4*)(F.HB + (size_t)row * DM + k) = w;
            bf16x8 af; __builtin_memcpy(&af, &w, 16);
#pragma unroll
            for (int et = 0; et < 4; ++et) { const bf16x8 bf = *(const bf16x8*)(RW + (size_t)(et * 16 + tk) * 1024 + k); acc[et] = __builtin_amdgcn_mfma_f32_16x16x32_bf16(af, bf, acc[et], 0, 0, 0); }
        }
#pragma unroll
        for (int et = 0; et < 4; ++et)
#pragma unroll
            for (int i = 0; i < 4; ++i) LP[(F.wave * 16 + 4 * g + i) * 64 + et * 16 + tk] = acc[et][i];
        __syncthreads();
        {
            const int t = 2 * F.wave + (g & 1), r2 = tile * 16 + t;
            float sc[4], key[4];
#pragma unroll
            for (int q = 0; q < 4; ++q) { float lgt = 0.f;
#pragma unroll
                for (int w = 0; w < 8; ++w) lgt += LP[(w * 16 + t) * 64 + tk + 16 * q];
                sc[q] = sigmoidf_(lgt); key[q] = sc[q] + rb[q]; }
            unsigned taken = 0u; int se[6]; float ss[6]; float tot = 0.f;
#pragma unroll
            for (int sel = 0; sel < 6; ++sel) {
                float bk = -1e30f, bs = 0.f; int be = 0;
#pragma unroll
                for (int q = 0; q < 4; ++q) if (!((taken >> q) & 1u) && key[q] > bk) { bk = key[q]; be = tk + 16 * q; bs = sc[q]; }
                topk_step<0xB1>(bk, be, bs); topk_step<0x4E>(bk, be, bs); topk_step<0x141>(bk, be, bs); topk_step<0x140>(bk, be, bs);
                if ((be & 15) == tk) taken |= 1u << (be >> 4);
                se[sel] = be; ss[sel] = bs; tot += bs;
            }
            const float sc2 = 2.5f / tot;
            if (tk < 6 && g < 2) {
                int e = se[0]; float w = ss[0];
#pragma unroll
                for (int q = 1; q < 6; ++q) if (tk == q) { e = se[q]; w = ss[q]; }
                tok_e[r2 * 8 + tk] = e; tok_w[r2 * 8 + tk] = w * sc2; if (!dry) tok_p[r2 * 8 + tk] = __hip_atomic_fetch_add(hist + e, 1, __ATOMIC_RELAXED, __HIP_MEMORY_SCOPE_WORKGROUP);
            }
        }
    }
    asm volatile("s_waitcnt vmcnt(0) lgkmcnt(0)" ::: "memory");
    __syncthreads();
    if (dry) return;
    if (F.tid < 64) hbase[F.tid] = (int)__hip_atomic_fetch_add(gcnt + F.tid, (unsigned)hist[F.tid], __ATOMIC_RELAXED, __HIP_MEMORY_SCOPE_AGENT);
    __syncthreads();
    for (int tile = F.wg; tile < NTILE; tile += F.G) {
        if (F.tid < 96) { const int row = tile * 16 + F.tid / 6, q = F.tid % 6; const int e = tok_e[row * 8 + q]; const int pos = hbase[e] + tok_p[row * 8 + q];
            tok_p[row * 8 + q] = pos; stok[(size_t)e * CAP + pos] = row; sw[(size_t)e * CAP + pos] = tok_w[row * 8 + q]; }
    }
    __syncthreads();
}

__device__ __forceinline__ int moe_tables(const Frame& F, int l) {
    LAS int* cnt = (LAS int*)(F.lds + LDS_MISC + MISC_CNT); LAS int* tst = (LAS int*)(F.lds + LDS_MISC + MISC_TST); LAS unsigned char* t2e = (LAS unsigned char*)(F.lds + LDS_MISC + MISC_T2E);
    const unsigned* gcnt = (const unsigned*)(F.ws + OFF_CTL + CTL_CNT) + l * 64;
    __syncthreads();
    if (F.tid < 64) cnt[F.tid] = (int)__hip_atomic_load(gcnt + F.tid, __ATOMIC_RELAXED, __HIP_MEMORY_SCOPE_AGENT);
    if (F.tid == 64) cnt[64] = TT;
    __syncthreads();
    if (F.tid == 0) { int s = 0; for (int e = 0; e < 65; ++e) { tst[e] = s; s += (cnt[e] + 255) >> 8; } tst[65] = s; }
    __syncthreads();
    const int ntiles = tst[65];
    for (int t = F.tid; t < ntiles; t += 512) { int e = 0; for (int q = 0; q < 65; ++q) if (t >= tst[q]) e = q; else break; t2e[t] = (unsigned char)e; }
    __syncthreads();
    return ntiles;
}

__device__ __forceinline__ void ph_combine(const Frame& F, int l, bool dry = false) {
    LAS int* tst = (LAS int*)(F.lds + LDS_MISC + MISC_TST);
    (void)moe_tables(F, l);
    const float* gam = inp(F, 6) + (size_t)(l * 2 + 1) * DM; const float* bet = inp(F, 7) + (size_t)(l * 2 + 1) * DM;
    const float* gam0 = inp(F, 6) + (size_t)(l * 2 + 0) * DM; const float* bet0 = inp(F, 7) + (size_t)(l * 2 + 0) * DM;
    const float* stats = (const float*)(F.ws + OFF_STATS);
    const unsigned char* Y = (const unsigned char*)(F.R1 + R1_Y);
    const int* tok_e = (const int*)(F.ws + OFF_TOKE); const int* tok_p = (const int*)(F.ws + OFF_TOKP);
    const int gw = F.wg * 8 + F.wave, nw = F.G * 8;
    const bool lastl = (l == 3);
    for (int row = gw; row < TT; row += nw) {
        const int s = slot_of_row(row);
        const float* m = F.mods + (size_t)(l * 5 + s) * 6144;
        const float* mn = F.mods + (size_t)((lastl ? l : l + 1) * 5 + s) * 6144;
        int srow[7];
#pragma unroll
        for (int q = 0; q < 6; ++q) { const int e = tok_e[row * 8 + q]; srow[q] = tst[e] * 256 + tok_p[row * 8 + q]; }
        srow[6] = tst[64] * 256 + row;
        float v[16];
#pragma unroll
        for (int hh = 0; hh < 2; ++hh) { const int k = hh * 512 + F.lane * 8;
            float y[8];
#pragma unroll
            for (int q = 0; q < 8; ++q) y[q] = 0.f;
#pragma unroll
            for (int q = 0; q < 7; ++q) { const u32x2 w = *(const u32x2*)(Y + (size_t)srow[q] * DM + k);
                const f32x2 t0 = __builtin_amdgcn_cvt_pk_f32_fp8((int)w.x, false), t1 = __builtin_amdgcn_cvt_pk_f32_fp8((int)w.x, true), t2 = __builtin_amdgcn_cvt_pk_f32_fp8((int)w.y, false), t3 = __builtin_amdgcn_cvt_pk_f32_fp8((int)w.y, true);
                y[0] += t0.x; y[1] += t0.y; y[2] += t1.x; y[3] += t1.y; y[4] += t2.x; y[5] += t2.y; y[6] += t3.x; y[7] += t3.y; }
#pragma unroll
            for (int i = 0; i < 8; ++i) y[i] *= (1.0f / 32.0f);
            f32x4 x0 = *(const f32x4*)(F.X + (size_t)row * DM + k), x1 = *(const f32x4*)(F.X + (size_t)row * DM + k + 4);
            { const f32x2 st = *(const f32x2*)(stats + (size_t)row * 2); const f32x4 g0 = *(const f32x4*)(gam0 + k), g1 = *(const f32x4*)(gam0 + k + 4), b0 = *(const f32x4*)(bet0 + k), b1 = *(const f32x4*)(bet0 + k + 4);
              x0 = (x0 - st.x) * st.y * g0 + b0; x1 = (x1 - st.x) * st.y * g1 + b1; }
            const f32x4 m50 = *(const f32x4*)(m + 5 * 1024 + k), m51 = *(const f32x4*)(m + 5 * 1024 + k + 4);
#pragma unroll
            for (int i = 0; i < 4; ++i) { v[hh * 8 + i] = ALPHA * x0[i] + m50[i] * y[i]; v[hh * 8 + 4 + i] = ALPHA * x1[i] + m51[i] * y[4 + i]; }
        }
        float sum = 0.f;
#pragma unroll
        for (int i = 0; i < 16; ++i) sum += v[i];
        sum += __shfl_xor(sum, 1); sum += __shfl_xor(sum, 2); sum += __shfl_xor(sum, 4); sum += __shfl_xor(sum, 8); sum += __shfl_xor(sum, 16); sum += __shfl_xor(sum, 32);
        const float mean = sum * (1.0f / 1024.0f);
        float sq = 0.f;
#pragma unroll
        for (int i = 0; i < 16; ++i) { const float d = v[i] - mean; sq += d * d; }
        sq += __shfl_xor(sq, 1); sq += __shfl_xor(sq, 2); sq += __shfl_xor(sq, 4); sq += __shfl_xor(sq, 8); sq += __shfl_xor(sq, 16); sq += __shfl_xor(sq, 32);
        const float rstd = rsqrtf(sq * (1.0f / 1024.0f) + 1e-5f);
#pragma unroll
        for (int hh = 0; hh < 2; ++hh) { const int k = hh * 512 + F.lane * 8;
            float gm[8], bt[8], xn[8];
            *(f32x4*)&gm[0] = *(const f32x4*)(gam + k); *(f32x4*)&gm[4] = *(const f32x4*)(gam + k + 4);
            *(f32x4*)&bt[0] = *(const f32x4*)(bet + k); *(f32x4*)&bt[4] = *(const f32x4*)(bet + k + 4);
#pragma unroll
            for (int i = 0; i < 8; ++i) xn[i] = (v[hh * 8 + i] - mean) * rstd * gm[i] + bt[i];
            if (dry) { float acc_ = 0.f; for (int i = 0; i < 8; ++i) acc_ += xn[i]; asm volatile("" :: "v"(acc_)); }
            else if (lastl) { if (row >= TC) { float* o = F.out + (size_t)(row - TC) * DM + k; *(f32x4*)o = *(f32x4*)&xn[0]; *(f32x4*)(o + 4) = *(f32x4*)&xn[4]; } }
            else {
                *(f32x4*)(F.X + (size_t)row * DM + k) = *(f32x4*)&xn[0]; *(f32x4*)(F.X + (size_t)row * DM + k + 4) = *(f32x4*)&xn[4];
                float s1[8], b0[8];
                *(f32x4*)&s1[0] = *(const f32x4*)(mn + 1024 + k); *(f32x4*)&s1[4] = *(const f32x4*)(mn + 1024 + k + 4);
                *(f32x4*)&b0[0] = *(const f32x4*)(mn + k); *(f32x4*)&b0[4] = *(const f32x4*)(mn + k + 4);
                float hv[8];
#pragma unroll
                for (int i = 0; i < 8; ++i) hv[i] = xn[i] * (1.0f + s1[i]) + b0[i];
                u32x4 w; w.x = cvt_pk_bf16(hv[0], hv[1]); w.y = cvt_pk_bf16(hv[2], hv[3]); w.z = cvt_pk_bf16(hv[4], hv[5]); w.w = cvt_pk_bf16(hv[6], hv[7]);
                *(u32x4*)(F.HB + (size_t)row * DM + k) = w;
            }
        }
    }
}

constexpr int NPHASE = 2 + 4 * 10;
__global__ void __launch_bounds__(512, 2) mk_fwd(Args args) {
    extern __shared__ __attribute__((aligned(16))) unsigned char lds_raw[];
    Frame F;
    F.out = args.out; F.ws = args.ws; F.lds = (LAS unsigned char*)lds_raw;
    { const int t0 = threadIdx.x; F.wave = __builtin_amdgcn_readfirstlane(t0 >> 6); F.lane = t0 & 63; F.tid = t0; } F.G = gridDim.x; F.wg = blockIdx.x;
    F.mods = (float*)(args.ws + OFF_MODS); F.X = (float*)(args.ws + OFF_X); F.HB = (bf16_t*)(args.ws + OFF_HB); F.MIX = F.HB;
    F.WB = args.ws + OFF_WB; F.R1 = args.ws + OFF_R1;
    volatile LAS unsigned* xbw = (volatile LAS unsigned*)(F.lds + LDS_MISC);
    if (F.tid < 4) xbw[F.tid] = 0u;
    if (F.tid < 30) ((LAS unsigned long long*)(F.lds + LDS_MISC + MISC_INP))[F.tid] = (unsigned long long)args.in[F.tid];
    __syncthreads();
    const int lo = args.ph_lo, hi = args.ph_hi;
    XcdBarrier bar; bar.bar = (unsigned*)(args.ws + OFF_CTL); bar.x = 0; bar.st = xbw;
    if (hi - lo > 1) bar = xcd_barrier_post((unsigned*)(args.ws + OFF_CTL), xbw);
#define IN(k) (lo <= (k) && (k) < hi)
#define SEAM(k) do { if (IN(k) && IN((k) + 1)) { xcd_barrier(bar); if (REPM & 1) xcd_barrier(bar); } } while (0)
    if ((PHM & 1) && IN(0)) { ph_mods(fresh(F)); } SEAM(0);
    if ((PHM & 2) && IN(1)) { ph_init_x(fresh(F)); }
    for (int l = 0; l < 4; ++l) {
        const int pb = 2 + l * 10, j = l >> 1; const bool even = (l & 1) == 0;
        float* mods_l = F.mods + (size_t)l * 5 * 6144;
        if ((PHM & 4) && IN(pb + 0)) { for (int rep = 0; rep < ((REPM & 4) ? 2 : 1); ++rep) { ph_convert(fresh(F), l); __syncthreads(); } } SEAM(pb + 0);
        if ((PHM & 8) && IN(pb + 1)) {
            const int N = even ? 4096 : 2048;
            pg8::StaticOrder S; S.init(F.HB, F.WB + WB_IN, TT, N, 1024, F.G, F.wg);
            pg8::EpiStoreBf16 E{(bf16_t*)(F.R1 + R1_P), N};
            for (int rep = 0; rep < ((REPM & 8) ? 2 : 1); ++rep) pg8::gemm_phase(F.lds, 1024, S, E, F.wave);
        } SEAM(pb + 1);
        if (IN(pb + 2)) { if (even) { if (PHM & 16) for (int rep = 0; rep < ((REPM & 16) ? 2 : 1); ++rep) ph_attn(fresh(F), j); if (PHM & 32) for (int rep = 0; rep < ((REPM & 32) ? 2 : 1); ++rep) ph_hg_a(fresh(F), j); } else { if (PHM & 64) for (int rep = 0; rep < ((REPM & 64) ? 2 : 1); ++rep) ph_lru_a(fresh(F), j); } } SEAM(pb + 2);
        if (IN(pb + 3)) { if (even) { if (PHM & 128) for (int rep = 0; rep < ((REPM & 128) ? 2 : 1); ++rep) { ph_hg_b(fresh(F)); ph_hg_c_ctx(fresh(F), j); } } else { if (PHM & 256) for (int rep = 0; rep < ((REPM & 256) ? 2 : 1); ++rep) ph_lru_b(fresh(F)); } } SEAM(pb + 3);
        if (IN(pb + 4)) { if (even) { if (PHM & 512) for (int rep = 0; rep < ((REPM & 512) ? 2 : 1); ++rep) ph_hg_c(fresh(F), j); } else { if (PHM & 1024) for (int rep = 0; rep < ((REPM & 1024) ? 2 : 1); ++rep) ph_lru_c(fresh(F)); } } SEAM(pb + 4);
        if ((PHM & 2048) && IN(pb + 5)) {
            pg8::StaticOrder S; S.init(F.MIX, F.WB + WB_OUT, TT, 1024, 1024, F.G, F.wg);
            pg8::EpiResid E{F.X, mods_l};
            pg8::gemm_phase(F.lds, 1024, S, E, F.wave);
        } SEAM(pb + 5);
        if ((PHM & 4096) && IN(pb + 6)) { if (REPM & 4096) ph_ln_router(fresh(F), l, true); ph_ln_router(fresh(F), l); } SEAM(pb + 6);
        if ((PHM & 8192) && IN(pb + 7)) {
            const int ntiles = moe_tables(fresh(F), l);
            pg8::MoeGU S; S.cnt = (const LAS int*)(F.lds + LDS_MISC + MISC_CNT); S.tst = (const LAS int*)(F.lds + LDS_MISC + MISC_TST); S.t2e = (const LAS unsigned char*)(F.lds + LDS_MISC + MISC_T2E);
            S.ntiles = ntiles; S.G = F.G; S.c = F.wg; S.A = (const char*)F.HB; S.Bt = (const char*)(F.WB + WB_GU); S.stok = (const int*)(F.ws + OFF_STOK);
            pg8::EpiSwiglu E{(bf16_t*)(F.R1 + R1_H)};
            for (int rep = 0; rep < ((REPM & 8192) ? 2 : 1); ++rep) pg8::gemm_phase(F.lds, 1024, S, E, F.wave);
        } SEAM(pb + 7);
        if ((PHM & 16384) && IN(pb + 8)) {
            const int ntiles = moe_tables(fresh(F), l);
            pg8::MoeDN S; S.cnt = (const LAS int*)(F.lds + LDS_MISC + MISC_CNT); S.tst = (const LAS int*)(F.lds + LDS_MISC + MISC_TST); S.t2e = (const LAS unsigned char*)(F.lds + LDS_MISC + MISC_T2E);
            S.ntiles = ntiles; S.G = F.G; S.c = F.wg; S.A = (const char*)(F.R1 + R1_H); S.Bt = (const char*)(F.WB + WB_DN);
            pg8::EpiDown E{(unsigned char*)(F.R1 + R1_Y), (const float*)(F.ws + OFF_SW), (const LAS int*)(F.lds + LDS_MISC + MISC_CNT)};
            for (int rep = 0; rep < ((REPM & 16384) ? 2 : 1); ++rep) pg8::gemm_phase(F.lds, 256, S, E, F.wave);
        } SEAM(pb + 8);
        if ((PHM & 32768) && IN(pb + 9)) { if (REPM & 32768) ph_combine(fresh(F), l, true); ph_combine(fresh(F), l); } SEAM(pb + 9);
    }
#undef IN
#undef SEAM
}

extern "C" void kernel_launch(void* const* d_in, const int* in_sizes, int n_in, void* d_out, int out_size, void* d_ws, size_t ws_size, hipStream_t stream) {
    static int grid = 0;
    if (grid == 0) {
        if (n_in != 30 || out_size != TX * DM || ws_size < WS_END) { fprintf(stderr, "kernel_launch: unexpected problem (n_in %d out %d ws %zu need %zu)\n", n_in, out_size, ws_size, (size_t)WS_END); grid = -1; return; }
        int dev = 0, cus = 0, per_cu = 0;
        if (hipGetDevice(&dev) != hipSuccess || hipDeviceGetAttribute(&cus, hipDeviceAttributeMultiprocessorCount, dev) != hipSuccess) { grid = -1; return; }
        if (hipFuncSetAttribute((const void*)mk_fwd, hipFuncAttributeMaxDynamicSharedMemorySize, LDS_BYTES) != hipSuccess) { fprintf(stderr, "kernel_launch: hipFuncSetAttribute failed\n"); grid = -1; return; }
        if (hipOccupancyMaxActiveBlocksPerMultiprocessor(&per_cu, (const void*)mk_fwd, 512, LDS_BYTES) != hipSuccess || per_cu < 1) { fprintf(stderr, "kernel_launch: occupancy query says %d\n", per_cu); }
        (void)hipGetLastError();
        grid = cus;
    }
    if (grid < 0) return;
    (void)hipMemsetAsync((char*)d_ws + OFF_CTL, 0, CTL_BYTES, stream);
    Args a{};
    for (int i = 0; i < 30; ++i) a.in[i] = (const float*)d_in[i];
    a.out = (float*)d_out; a.ws = (unsigned char*)d_ws;
#if MK_SPLIT
    for (int p = 0; p < NPHASE; ++p) { a.ph_lo = p; a.ph_hi = p + 1; hipLaunchKernelGGL(mk_fwd, dim3(grid), dim3(512), LDS_BYTES, stream, a); }
#else
    a.ph_lo = 0; a.ph_hi = NPHASE;
    hipLaunchKernelGGL(mk_fwd, dim3(grid), dim3(512), LDS_BYTES, stream, a);
#endif
}
```

```cpp
#include <hip/hip_runtime.h>
#include <cstdio>
#include <cstdint>

#ifndef PHM
#define PHM 0xFFFF
#endif
#ifndef REPM
#define REPM 0
#endif
#ifndef MK_SPLIT
#define MK_SPLIT 0
#endif

typedef unsigned short bf16_t;
typedef short bf16x8 __attribute__((ext_vector_type(8)));
typedef short bf16x4 __attribute__((ext_vector_type(4)));
typedef float f32x4 __attribute__((ext_vector_type(4)));
typedef float f32x2 __attribute__((ext_vector_type(2)));
typedef unsigned u32x4 __attribute__((ext_vector_type(4)));
typedef unsigned u32x2 __attribute__((ext_vector_type(2)));
#define LAS __attribute__((address_space(3)))

constexpr int DM = 1024, NBAT = 4, SEQ = 8192, CTXL = 256;
constexpr int TC = NBAT * CTXL, TX = NBAT * SEQ, TT = TC + TX;
constexpr int NEXP = 64, TOPK = 6;
constexpr int CAP = TT;
constexpr int MOE_ROUTED_ROWS = 6 * TT + 64 * 256;
constexpr int MOE_ROWS = MOE_ROUTED_ROWS + TT;
constexpr int MOE_MAXTILES = MOE_ROWS / 256;
constexpr float ALPHA = 1.681792830507429f;
constexpr int HG_U = 128, HG_NU = (CTXL + SEQ) / HG_U;
constexpr int LRU_NT = (CTXL + SEQ) / 16;

constexpr size_t OFF_CTL = 0, CTL_BYTES = 65536;
constexpr size_t CTL_CNT = 16384, CTL_DBG = 20480;
constexpr size_t OFF_MODS = 65536;
constexpr size_t OFF_LBT = OFF_MODS + 4 * 5 * 6144 * 4;
constexpr size_t OFF_STATS = OFF_LBT + 8192;
constexpr size_t OFF_AB = OFF_STATS + (size_t)TT * 8;
static_assert(OFF_AB + 4 * 5 * 2 * 1024 * 4 <= (1u << 20), "ctl map");
constexpr size_t OFF_TOKE = 1u << 20;
constexpr size_t OFF_TOKP = OFF_TOKE + (size_t)TT * 32;
constexpr size_t OFF_TOKW = OFF_TOKP + (size_t)TT * 32;
constexpr size_t OFF_STOK = OFF_TOKW + (size_t)TT * 32;
constexpr size_t OFF_SW = OFF_STOK + (size_t)64 * CAP * 4;
constexpr size_t OFF_X = OFF_SW + (size_t)64 * CAP * 4;
constexpr size_t OFF_HB = OFF_X + (size_t)TT * DM * 4;
constexpr size_t OFF_WB = OFF_HB + (size_t)TT * DM * 2;
constexpr size_t WB_IN = 0, WB_OUT = WB_IN + (size_t)4096 * 1024 * 2, WB_RT = WB_OUT + (size_t)1024 * 1024 * 2, WB_GU = WB_RT + (size_t)64 * 1024 * 2,
                 WB_DN = WB_GU + (size_t)65 * 512 * 1024 * 2, WB_LRU = WB_DN + (size_t)65 * 1024 * 256 * 2, WB_END = WB_LRU + (size_t)2 * 2 * 16 * 64 * 64 * 2;
constexpr size_t OFF_R1 = OFF_WB + WB_END;
constexpr size_t R1_P = 0;
constexpr size_t R1_OF = R1_P + (size_t)TT * 4096 * 2;
constexpr size_t R1_SLOC = R1_OF + (size_t)TT * 512 * 4;
constexpr size_t R1_SST = R1_SLOC + (size_t)64 * HG_NU * 4096 * 4;
constexpr size_t R1_DL = R1_SST + (size_t)64 * HG_NU * 4096 * 4;
constexpr size_t R1_MOE_END_FWD = (size_t)MOE_ROWS * 256 * 2 + (size_t)MOE_ROWS * 1024 * 2;
constexpr size_t R1_AG = R1_OF;
constexpr size_t R1_HST = R1_AG + (size_t)4 * 2 * LRU_NT * 2 * 1024 * 4;
constexpr size_t R1_GX = R1_HST + (size_t)4 * 2 * LRU_NT * 1024 * 4;
static_assert(R1_GX + (size_t)TT * 2 * 1024 * 2 * 2 <= R1_MOE_END_FWD, "lru gx");
constexpr size_t R1_H = 0;
constexpr size_t R1_Y = R1_H + (size_t)MOE_ROWS * 256 * 2;
constexpr size_t R1_MOE_END = R1_Y + (size_t)MOE_ROWS * 1024 * 2;
constexpr size_t R1_MIX_END = R1_DL + (size_t)64 * HG_NU * 64 * 4;
constexpr size_t WS_END = OFF_R1 + (R1_MOE_END > R1_MIX_END ? R1_MOE_END : R1_MIX_END);

constexpr int LDS_STAGE = 131072;
constexpr int LDS_MISC = LDS_STAGE;
constexpr int MISC_CNT = 64;
constexpr int MISC_TST = MISC_CNT + 66 * 4 + 8;
constexpr int MISC_HIST = 640;
constexpr int MISC_HBASE = 896;
constexpr int MISC_T2E = 1152;
constexpr int MISC_INP = 2304;
constexpr int LDS_BYTES = 147456;

#define XB_TMO      128
#define XB_XCNT(j)  (256  + 64 * (j))
#define XB_XSUB(j)  (1280 + 64 * (j))
#define XB_XGEN(j)  (2304 + 64 * (j))
#define XB_TOP      3328
#define XB_TOPGEN   3392
#define XCD_BAR_WORDS 3456
#define XB_SPIN_CAP (1u << 22)
__device__ __forceinline__ unsigned xb_ld(unsigned* p)              { return __hip_atomic_load(p, __ATOMIC_RELAXED, __HIP_MEMORY_SCOPE_AGENT); }
__device__ __forceinline__ unsigned xb_add(unsigned* p, unsigned v) { return __hip_atomic_fetch_add(p, v, __ATOMIC_RELAXED, __HIP_MEMORY_SCOPE_AGENT); }
__device__ __forceinline__ unsigned xb_xcc_id() { return (unsigned)__builtin_amdgcn_s_getreg((3 << 11) | 20) & 0xFu; }
#define XB_SPIN(cond, bar) do { unsigned _sp = 0; while (cond) { __builtin_amdgcn_s_sleep(1); \
    if ((++_sp & 255u) == 0u) { if (xb_ld(&(bar)[XB_TMO])) break; if (_sp > XB_SPIN_CAP) { atomicAdd(&(bar)[XB_TMO], 1u); break; } } } } while (0)
struct XcdBarrier { unsigned* bar; unsigned x; volatile LAS unsigned* st; };
__device__ __forceinline__ XcdBarrier xcd_barrier_post(unsigned* bar, volatile LAS unsigned* st) {
    XcdBarrier b; b.bar = bar; b.x = xb_xcc_id(); b.st = st;
    if (threadIdx.x == 0) (void)xb_add(&bar[XB_XCNT(b.x)], 1u);
    return b;
}
__device__ __forceinline__ void xcd_barrier_complete(unsigned* bar, unsigned x, unsigned& nloc, unsigned& nx) {
    const unsigned G = gridDim.x * gridDim.y * gridDim.z;
    unsigned sum, cnt, mine, sp = 0u;
    for (;;) {
        sum = 0u; cnt = 0u; mine = 0u;
#pragma unroll
        for (unsigned j = 0; j < 16; ++j) { const unsigned c = xb_ld(&bar[XB_XCNT(j)]); sum += c; cnt += (c > 0u) ? 1u : 0u; mine = (j == x) ? c : mine; }
        if (sum == G) break;
        __builtin_amdgcn_s_sleep(1);
        if ((++sp & 255u) == 0u) { if (xb_ld(&bar[XB_TMO])) break; if (sp > XB_SPIN_CAP) { atomicAdd(&bar[XB_TMO], 1u); break; } }
    }
    nloc = mine > 0u ? mine : 1u; nx = cnt > 0u ? cnt : 1u;
}
__device__ __forceinline__ void xcd_barrier(const XcdBarrier& b) {
    asm volatile("s_waitcnt vmcnt(0)" ::: "memory");
    __syncthreads();
    if (threadIdx.x == 0) {
        unsigned* bar = b.bar;
        __builtin_amdgcn_s_waitcnt(0);
        unsigned nloc = b.st[0], nx = b.st[1];
        if (nloc == 0u) { xcd_barrier_complete(bar, b.x, nloc, nx); b.st[0] = nloc; b.st[1] = nx; }
        const unsigned old = xb_add(&bar[XB_XSUB(b.x)], 1u);
        const unsigned gen = old / nloc;
        if (old + 1u == (gen + 1u) * nloc) {
            __builtin_amdgcn_fence(__ATOMIC_RELEASE, "agent");
            asm volatile("s_waitcnt vmcnt(0)" ::: "memory");
            const unsigned og = xb_add(&bar[XB_TOP], 1u);
            const unsigned tg = og / nx;
            if (og + 1u == (tg + 1u) * nx) xb_add(&bar[XB_TOPGEN], 1u);
            else XB_SPIN(xb_ld(&bar[XB_TOPGEN]) == tg, bar);
            __builtin_amdgcn_fence(__ATOMIC_ACQUIRE, "agent");
            xb_add(&bar[XB_XGEN(b.x)], 1u);
            asm volatile("s_waitcnt vmcnt(0)" ::: "memory");
        } else {
            XB_SPIN(xb_ld(&bar[XB_XGEN(b.x)]) == gen, bar);
            __builtin_amdgcn_fence(__ATOMIC_ACQUIRE, "agent");
            asm volatile("s_waitcnt vmcnt(0)" ::: "memory");
        }
    }
    __syncthreads();
}

__device__ __forceinline__ float bf2f(unsigned short b) { return __uint_as_float(((unsigned)b) << 16); }
__device__ __forceinline__ unsigned cvt_pk_bf16(float lo, float hi) { unsigned r; asm volatile("v_cvt_pk_bf16_f32 %0, %1, %2" : "=v"(r) : "v"(lo), "v"(hi)); return r; }
__device__ __forceinline__ unsigned short f2bf(float f) { return (unsigned short)(cvt_pk_bf16(f, 0.f) & 0xffffu); }
__device__ __forceinline__ float sigmoidf_(float x) { return __builtin_amdgcn_rcpf(1.0f + __expf(-x)); }
__device__ __forceinline__ float siluf_(float x) { return x * sigmoidf_(x); }
__device__ __forceinline__ float gelu_tanh_(float x) { return x * sigmoidf_(1.5957691216057308f * (x + 0.044715f * x * x * x)); }
__device__ __forceinline__ int slot_of_row(int r) { return r < TC ? 4 : ((r - TC) >> 13); }
template <int CTRL> __device__ __forceinline__ float dppf(float oldv, float src) {
    return __int_as_float(__builtin_amdgcn_update_dpp(__float_as_int(oldv), __float_as_int(src), CTRL, 0xf, 0xf, false));
}
__device__ __forceinline__ void unpack8(const u32x4 w, float (&o)[8]) {
    o[0] = __uint_as_float(w.x << 16); o[1] = __uint_as_float(w.x & 0xffff0000u); o[2] = __uint_as_float(w.y << 16); o[3] = __uint_as_float(w.y & 0xffff0000u);
    o[4] = __uint_as_float(w.z << 16); o[5] = __uint_as_float(w.z & 0xffff0000u); o[6] = __uint_as_float(w.w << 16); o[7] = __uint_as_float(w.w & 0xffff0000u);
}

namespace pg8 {
constexpr int BM = 256, BK = 64, HALF = 128, HTB = HALF * BK * 2, STAGE_BYTES = 8 * HTB, NXCD = 8, WGM = 8;
__device__ __forceinline__ int lds_byte(int r, int c) { const int st = (r >> 4) * 2 + (c >> 5), rr = r & 15, cc = c & 31, ob = rr * 64 + cc * 2; return st * 1024 + (ob ^ (((ob >> 9) & 1) << 5)); }
__device__ __forceinline__ void stage_rc(int b, int& R, int& C) { const int st = b / 1024, sb = b % 1024, swz = sb ^ (((sb >> 9) & 1) << 5); R = (st >> 1) * 16 + swz / 64; C = (st & 1) * 32 + (swz % 64) / 2; }
__device__ __forceinline__ int perm32(int rho) { const int n = rho >> 4, i = rho & 15; return 8 * (i >> 2) + 4 * n + (i & 3); }
struct Unit { int pm, pn, e, ti; };

struct StaticOrder {
    const char* A; const char* Bt; int K;
    int nM, nN, nwg, G, c;
    __device__ __forceinline__ void init(const void* A_, const void* Bt_, int M, int N, int K_, int G_, int c_) { A = (const char*)A_; Bt = (const char*)Bt_; K = K_; nM = M / BM; nN = N / BM; nwg = nM * nN; G = G_; c = c_; }
    __device__ __forceinline__ bool next(int i, Unit& u) const {
        const long L = (long)i * G + c; if (L >= nwg) return false;
        int wgid = (int)L; { const int q = nwg / NXCD, r = nwg % NXCD, xcd = wgid % NXCD, off = wgid / NXCD; wgid = (xcd < r ? xcd * (q + 1) : r * (q + 1) + (xcd - r) * q) + off; }
        const int nig = WGM * nN, gid = wgid / nig, fm = gid * WGM, gsz = (nM - fm) < WGM ? (nM - fm) : WGM;
        u.pm = fm + ((wgid % nig) % gsz); u.pn = (wgid % nig) / gsz; u.e = 0; u.ti = 0; return true;
    }
    static constexpr bool GATHER = false;
    __device__ __forceinline__ const char* abase(const Unit& u) const { return A + (size_t)u.pm * BM * K * 2; }
    __device__ __forceinline__ const char* bbase(const Unit& u) const { return Bt + (size_t)u.pn * BM * K * 2; }
};

template <class Epi, class Sched>
__device__ __forceinline__ void gemm_phase(LAS unsigned char* lds, const int K_, const Sched& S, const Epi& E, const int wave_) {
    int Kl_ = K_; asm volatile("" : "+s"(Kl_)); const int K = Kl_;
    int tid_ = wave_ * 64 + (int)__builtin_amdgcn_mbcnt_hi(~0u, __builtin_amdgcn_mbcnt_lo(~0u, 0u)); asm volatile("" : "+v"(tid_));
    const int tid = tid_, wid = __builtin_amdgcn_readfirstlane(tid >> 6), lane = tid & 63, wr = wid >> 2, wc = wid & 3, fr = lane & 15, fq = lane >> 4;
    const int nt = K / BK;
    unsigned voffA[2], voffB[2];
#pragma unroll
    for (int i = 0; i < 2; ++i) { int R, C; stage_rc(tid * 16 + i * 8192, R, C); const int Rb = Epi::PERM ? ((R & ~31) + perm32(R & 31)) : R; voffA[i] = (unsigned)(R * K + C) * 2u; voffB[i] = (unsigned)(Rb * K + C) * 2u; }
    const size_t kstep = (size_t)(BK * 2);
    const size_t hstep = (size_t)HALF * K * 2;
    const unsigned ldsw = (unsigned)wid * 1024u;
    const int aoff = lds_byte(wr * 64 + fr, fq * 8), boff = lds_byte(wc * 32 + fr, fq * 8);
#define PG8_SA(b, h) (((b) * 2 + (h)) * HTB)
#define PG8_SB(b, h) ((4 + (b) * 2 + (h)) * HTB)
#define PG8_STAGE(bufoff, gbase, voff) do { _Pragma("unroll") for (int _i = 0; _i < 2; ++_i) \
        __builtin_amdgcn_global_load_lds((const unsigned*)((const char*)(gbase) + (voff)[_i]), (LAS unsigned*)(lds + (bufoff) + ldsw + _i * 8192), 16, 0, 0); } while (0)
#define PG8_STAGEA(bufoff, hh, kb, nx) do { if constexpr (Sched::GATHER) { unsigned _o[2]; _o[0] = (nx) ? vN[hh][0] : vC[hh][0]; _o[1] = (nx) ? vN[hh][1] : vC[hh][1]; PG8_STAGE(bufoff, cA + (kb), _o); } \
        else { PG8_STAGE(bufoff, ((nx) ? nA : cA) + (hh) * hstep + (kb), voffA); } } while (0)
#define PG8_LDA(dst, b, h) do { _Pragma("unroll") for (int m = 0; m < 4; ++m) _Pragma("unroll") for (int k = 0; k < 2; ++k) dst[m][k] = *(const LAS bf16x8*)(lds + PG8_SA(b, h) + aoff + m * 2048 + k * 1024); } while (0)
#define PG8_LDB(dst, b, h) do { _Pragma("unroll") for (int n = 0; n < 2; ++n) _Pragma("unroll") for (int k = 0; k < 2; ++k) dst[n][k] = *(const LAS bf16x8*)(lds + PG8_SB(b, h) + boff + n * 2048 + k * 1024); } while (0)
#define PG8_MMA(ai, bj, At, Bt) do { __builtin_amdgcn_s_setprio(1); _Pragma("unroll") for (int m = 0; m < 4; ++m) _Pragma("unroll") for (int n = 0; n < 2; ++n) _Pragma("unroll") for (int k = 0; k < 2; ++k) \
        acc[ai][bj][m][n] = __builtin_amdgcn_mfma_f32_16x16x32_bf16(Bt[n][k], At[m][k], acc[ai][bj][m][n], 0, 0, 0); __builtin_amdgcn_s_setprio(0); } while (0)
#define PG8_WAIT_V(n) asm volatile("s_waitcnt vmcnt(" #n ")" ::: "memory")
#define PG8_WAIT_L(n) asm volatile("s_waitcnt lgkmcnt(" #n ")" ::: "memory")
#define PG8_BAR __builtin_amdgcn_s_barrier()
#define PG8_SCHED __builtin_amdgcn_sched_barrier(0)
    Unit cur, nxt; int ui = 0;
    if (!S.next(0, cur)) return;
    f32x4 acc[2][2][4][2];
#pragma unroll
    for (int a = 0; a < 2; ++a)
#pragma unroll
        for (int b = 0; b < 2; ++b)
#pragma unroll
            for (int m = 0; m < 4; ++m)
#pragma unroll
                for (int n = 0; n < 2; ++n) acc[a][b][m][n] = (f32x4){0.f, 0.f, 0.f, 0.f};
    bf16x8 At[4][2], B0[2][2], B1[2][2];
    unsigned vC[2][2], vN[2][2];
    if constexpr (Sched::GATHER) S.aoff(cur, tid, vC);
    const char* cA = S.abase(cur);
    const char* cB = S.bbase(cur);
    const char* nA = cA;
    PG8_STAGE(PG8_SB(0, 0), cB, voffB); PG8_STAGEA(PG8_SA(0, 0), 0, 0, false); PG8_STAGE(PG8_SB(0, 1), cB + hstep, voffB); PG8_STAGEA(PG8_SA(0, 1), 1, 0, false);
    if (wr == 1) PG8_BAR;
    PG8_WAIT_V(4); PG8_BAR;
    PG8_STAGE(PG8_SB(1, 0), cB + kstep, voffB); PG8_STAGEA(PG8_SA(1, 0), 0, kstep, false); PG8_STAGE(PG8_SB(1, 1), cB + hstep + kstep, voffB);
    PG8_WAIT_V(6); PG8_BAR;
    for (;;) {
        const bool has_next = S.next(ui + 1, nxt);
        const char* nB = cB; nA = cA;
        if (has_next) { nB = S.bbase(nxt); nA = S.abase(nxt); if constexpr (Sched::GATHER) S.aoff(nxt, tid, vN); }
        else { if constexpr (Sched::GATHER) {
#pragma unroll
            for (int h = 0; h < 2; ++h)
#pragma unroll
                for (int i = 0; i < 2; ++i) vN[h][i] = vC[h][i]; } }
        for (int t = 0; t < nt; t += 2) {
            const bool last = (t == nt - 2);
            const size_t k1 = (size_t)(t + 1) * kstep, k2 = last ? 0 : (size_t)(t + 2) * kstep, k3 = k2 + kstep;
            const char* b2 = last ? nB : cB + (size_t)(t + 2) * kstep; const char* b3 = b2 + kstep;
            PG8_LDB(B0, 0, 0); PG8_SCHED; PG8_LDA(At, 0, 0); PG8_STAGEA(PG8_SA(1, 1), 1, k1, false);
            PG8_WAIT_L(8); PG8_BAR; PG8_WAIT_L(0); PG8_MMA(0, 0, At, B0); PG8_BAR; PG8_SCHED;
            PG8_LDB(B1, 0, 1); PG8_STAGE(PG8_SB(0, 0), b2, voffB);
            PG8_BAR; PG8_WAIT_L(0); PG8_MMA(0, 1, At, B1); PG8_BAR;
            PG8_LDA(At, 0, 1); PG8_STAGEA(PG8_SA(0, 0), 0, k2, last);
            PG8_BAR; PG8_WAIT_L(0); PG8_MMA(1, 0, At, B0); PG8_BAR; PG8_SCHED;
            PG8_STAGE(PG8_SB(0, 1), b2 + hstep, voffB);
            PG8_WAIT_V(6); PG8_BAR; PG8_MMA(1, 1, At, B1); PG8_BAR;
            PG8_LDB(B0, 1, 0); PG8_SCHED; PG8_LDA(At, 1, 0); PG8_STAGEA(PG8_SA(0, 1), 1, k2, last);
            PG8_WAIT_L(8); PG8_BAR; PG8_WAIT_L(0); PG8_MMA(0, 0, At, B0); PG8_BAR; PG8_SCHED;
            PG8_LDB(B1, 1, 1); PG8_STAGE(PG8_SB(1, 0), b3, voffB);
            PG8_BAR; PG8_WAIT_L(0); PG8_MMA(0, 1, At, B1); PG8_BAR;
            PG8_LDA(At, 1, 1); PG8_STAGEA(PG8_SA(1, 0), 0, k3, last);
            PG8_BAR; PG8_WAIT_L(0); PG8_MMA(1, 0, At, B0); PG8_BAR; PG8_SCHED;
            PG8_STAGE(PG8_SB(1, 1), b3 + hstep, voffB);
            PG8_WAIT_V(6); PG8_BAR; PG8_MMA(1, 1, At, B1); PG8_BAR;
        }
        E(acc, cur, wr, wc, fr, fq);
        if (!has_next) break;
#pragma unroll
        for (int a = 0; a < 2; ++a)
#pragma unroll
            for (int b = 0; b < 2; ++b)
#pragma unroll
                for (int m = 0; m < 4; ++m)
#pragma unroll
                    for (int n = 0; n < 2; ++n) acc[a][b][m][n] = (f32x4){0.f, 0.f, 0.f, 0.f};
        cur = nxt; cB = nB; cA = nA; ++ui;
        if constexpr (Sched::GATHER) {
#pragma unroll
            for (int h = 0; h < 2; ++h)
#pragma unroll
                for (int i = 0; i < 2; ++i) vC[h][i] = vN[h][i]; }
    }
    PG8_WAIT_V(0);
    if (wr == 0) PG8_BAR;
    PG8_BAR;
#undef PG8_SA
#undef PG8_SB
#undef PG8_STAGE
#undef PG8_STAGEA
#undef PG8_LDA
#undef PG8_LDB
#undef PG8_MMA
#undef PG8_WAIT_V
#undef PG8_WAIT_L
#undef PG8_BAR
#undef PG8_SCHED
}

struct EpiStoreBf16 {
    static constexpr bool PERM = true;
    bf16_t* O; int ldc;
    __device__ __forceinline__ void operator()(const f32x4 (&acc)[2][2][4][2], const Unit& u, int wr, int wc, int fr, int fq) const {
        const int row0 = u.pm * BM + wr * 64 + fr, col0 = u.pn * BM + wc * 32 + 8 * fq;
#pragma unroll
        for (int ai = 0; ai < 2; ++ai)
#pragma unroll
            for (int m = 0; m < 4; ++m) { bf16_t* rowp = O + (size_t)(row0 + ai * HALF + m * 16) * ldc + col0;
#pragma unroll
                for (int bj = 0; bj < 2; ++bj) { const f32x4 v0 = acc[ai][bj][m][0], v1 = acc[ai][bj][m][1];
                    u32x4 w; w.x = cvt_pk_bf16(v0[0], v0[1]); w.y = cvt_pk_bf16(v0[2], v0[3]); w.z = cvt_pk_bf16(v1[0], v1[1]); w.w = cvt_pk_bf16(v1[2], v1[3]);
                    *(u32x4*)(rowp + bj * HALF) = w; } }
    }
};
struct EpiResid {
    static constexpr bool PERM = false;
    float* X; const float* mods_l;
    __device__ __forceinline__ void operator()(const f32x4 (&acc)[2][2][4][2], const Unit& u, int wr, int wc, int fr, int fq) const {
        const int row0 = u.pm * BM + wr * 64 + fr, col0 = u.pn * BM + wc * 32 + 4 * fq;
        const float* m2 = mods_l + (size_t)(slot_of_row(u.pm * BM) * 6 + 2) * DM + col0;
        float* xb = X + (size_t)row0 * DM + col0;
#pragma unroll
        for (int bj = 0; bj < 2; ++bj)
#pragma unroll
            for (int n = 0; n < 2; ++n) { const f32x4 mv = *(const f32x4*)(m2 + bj * HALF + n * 16);
                f32x4 xv[8];
#pragma unroll
                for (int q = 0; q < 8; ++q) xv[q] = *(const f32x4*)(xb + (size_t)((q >> 2) * HALF + (q & 3) * 16) * DM + bj * HALF + n * 16);
#pragma unroll
                for (int q = 0; q < 8; ++q) *(f32x4*)(xb + (size_t)((q >> 2) * HALF + (q & 3) * 16) * DM + bj * HALF + n * 16) = xv[q] * ALPHA + mv * acc[q >> 2][bj][q & 3][n];
                asm volatile("" ::: "memory"); }
    }
};
struct EpiSwiglu {
    static constexpr bool PERM = true;
    bf16_t* H;
    __device__ __forceinline__ void operator()(const f32x4 (&acc)[2][2][4][2], const Unit& u, int wr, int wc, int fr, int fq) const {
        const int row0 = u.pm * BM + wr * 64 + fr, col0 = u.pn * HALF + wc * 32 + 8 * fq;
#pragma unroll
        for (int ai = 0; ai < 2; ++ai)
#pragma unroll
            for (int m = 0; m < 4; ++m) { bf16_t* rowp = H + (size_t)(row0 + ai * HALF + m * 16) * 256 + col0;
                float h[8];
#pragma unroll
                for (int n = 0; n < 2; ++n)
#pragma unroll
                    for (int j = 0; j < 4; ++j) h[n * 4 + j] = siluf_(acc[ai][0][m][n][j]) * acc[ai][1][m][n][j];
                u32x4 w; w.x = cvt_pk_bf16(h[0], h[1]); w.y = cvt_pk_bf16(h[2], h[3]); w.z = cvt_pk_bf16(h[4], h[5]); w.w = cvt_pk_bf16(h[6], h[7]);
                *(u32x4*)rowp = w; }
    }
};
struct EpiDown {
    static constexpr bool PERM = true;
    unsigned char* Y; const float* sw; const LAS int* cnt;
    __device__ __forceinline__ void operator()(const f32x4 (&acc)[2][2][4][2], const Unit& u, int wr, int wc, int fr, int fq) const {
        const int row0 = u.pm * BM + wr * 64 + fr, col0 = u.pn * BM + wc * 32 + 8 * fq;
        const int ce = (u.e < 64) ? cnt[u.e] : 0;
        const float* swe = sw + (size_t)(u.e < 64 ? u.e : 0) * CAP + u.ti * 256 + wr * 64 + fr;
        unsigned char* yb = Y + (size_t)row0 * DM + col0;
        float wv[8];
#pragma unroll
        for (int q = 0; q < 8; ++q) { const int rl = (q >> 2) * HALF + (q & 3) * 16, pos = u.ti * 256 + wr * 64 + fr + rl; wv[q] = 32.0f; if (u.e < 64) wv[q] = (pos < ce) ? swe[rl] * 32.0f : 0.0f; }
#pragma unroll
        for (int ai = 0; ai < 2; ++ai)
#pragma unroll
            for (int m = 0; m < 4; ++m) { const int rl = ai * HALF + m * 16; const float w = wv[ai * 4 + m];
                unsigned char* rowp = yb + (size_t)rl * DM;
#pragma unroll
                for (int bj = 0; bj < 2; ++bj) { f32x4 v0 = acc[ai][bj][m][0] * w, v1 = acc[ai][bj][m][1] * w;
#pragma unroll
                    for (int j = 0; j < 4; ++j) { v0[j] = __builtin_amdgcn_fmed3f(v0[j], -440.0f, 440.0f); v1[j] = __builtin_amdgcn_fmed3f(v1[j], -440.0f, 440.0f); }
                    int p0 = __builtin_amdgcn_cvt_pk_fp8_f32(v0[0], v0[1], 0, false); p0 = __builtin_amdgcn_cvt_pk_fp8_f32(v0[2], v0[3], p0, true);
                    int p1 = __builtin_amdgcn_cvt_pk_fp8_f32(v1[0], v1[1], 0, false); p1 = __builtin_amdgcn_cvt_pk_fp8_f32(v1[2], v1[3], p1, true);
                    u32x2 ww; ww.x = (unsigned)p0; ww.y = (unsigned)p1;
                    *(u32x2*)(rowp + bj * HALF) = ww; }
                asm volatile("" ::: "memory"); }
    }
};
template <int NPN> struct MoeOrder {
    const LAS int* cnt; const LAS int* tst; const LAS unsigned char* t2e; int ntiles, G, c;
    __device__ __forceinline__ bool next(int i, Unit& u) const {
        const int L = i * G + c; if (L >= ntiles * NPN) return false;
        const int tau = L / NPN; u.pm = tau; u.pn = L % NPN; u.e = t2e[tau]; u.ti = tau - tst[u.e]; return true;
    }
};
struct MoeGU : MoeOrder<2> {
    static constexpr bool GATHER = true;
    const char* A; const char* Bt; const int* stok;
    __device__ __forceinline__ const char* abase(const Unit&) const { return A; }
    __device__ __forceinline__ const char* bbase(const Unit& u) const { return Bt + ((size_t)u.e * 512 + (size_t)u.pn * 256) * 1024 * 2; }
    __device__ __forceinline__ void aoff(const Unit& u, int tid, unsigned (&off)[2][2]) const {
        const int ce = cnt[u.e];
#pragma unroll
        for (int i = 0; i < 2; ++i) { int R, C; stage_rc(tid * 16 + i * 8192, R, C);
#pragma unroll
            for (int h = 0; h < 2; ++h) { const int pos = u.ti * 256 + h * HALF + R; int tok;
                if (u.e == 64) tok = pos; else tok = (pos < ce) ? stok[(size_t)u.e * CAP + pos] : 0;
                off[h][i] = (unsigned)(tok * 1024 + C) * 2u; } }
    }
};
struct MoeDN : MoeOrder<4> {
    static constexpr bool GATHER = false;
    const char* A; const char* Bt;
    __device__ __forceinline__ const char* abase(const Unit& u) const { return A + (size_t)u.pm * BM * 256 * 2; }
    __device__ __forceinline__ const char* bbase(const Unit& u) const { return Bt + ((size_t)u.e * 1024 + (size_t)u.pn * 256) * 256 * 2; }
};
}

struct Args { const float* in[30]; float* out; unsigned char* ws; int ph_lo, ph_hi; };

struct Frame {
    float* out; unsigned char* ws; LAS unsigned char* lds; int tid, lane, wave, G, wg;
    float* mods; float* X; bf16_t* HB; bf16_t* MIX; unsigned char* WB; unsigned char* R1;
};

__device__ __forceinline__ const float* inp(const Frame& F, int i) {
    const unsigned long long v = ((const LAS unsigned long long*)(F.lds + LDS_MISC + MISC_INP))[i];
    const unsigned lo = (unsigned)__builtin_amdgcn_readfirstlane((int)(unsigned)v), hi = (unsigned)__builtin_amdgcn_readfirstlane((int)(unsigned)(v >> 32));
    return (const float*)(((unsigned long long)hi << 32) | lo);
}
__device__ __forceinline__ int lane_id_() { return (int)__builtin_amdgcn_mbcnt_hi(~0u, __builtin_amdgcn_mbcnt_lo(~0u, 0u)); }
__device__ __forceinline__ Frame fresh(const Frame& F0) { Frame F = F0; int ln = lane_id_(); asm volatile("" : "+v"(ln)); F.lane = ln; F.tid = F0.wave * 64 + ln; return F; }

__device__ __forceinline__ void ph_mods(const Frame& F) {
    const float* c = inp(F, 1); const float* cc = inp(F, 3); const float* ada_w = inp(F, 4); const float* ada_b = inp(F, 5);
    LAS float* sv = (LAS float*)F.lds;
    LAS float* red = (LAS float*)(F.lds + 5 * 1024 * 4);
    for (int i = F.tid; i < 5 * 1024; i += 512) { const int s = i >> 10, k = i & 1023; const float v = (s < 4) ? c[s * 1024 + k] : cc[k]; sv[i] = siluf_(v); }
    __syncthreads();
    for (int task = F.wg; task < 4 * 48; task += F.G) {
        const int l = task / 48, cc0 = (task % 48) * 128;
        const int col = cc0 + (F.tid & 127), kg = F.tid >> 7;
        const float* w = ada_w + (size_t)l * 1024 * 6144 + col;
        float a0 = 0.f, a1 = 0.f, a2 = 0.f, a3 = 0.f, a4 = 0.f;
        for (int k = kg * 256; k < kg * 256 + 256; ++k) { const float wv = w[(size_t)k * 6144]; a0 += sv[k] * wv; a1 += sv[1024 + k] * wv; a2 += sv[2048 + k] * wv; a3 += sv[3072 + k] * wv; a4 += sv[4096 + k] * wv; }
        LAS float* r = red + (kg * 128 + (F.tid & 127)) * 5; r[0] = a0; r[1] = a1; r[2] = a2; r[3] = a3; r[4] = a4;
        __syncthreads();
        if (F.tid < 128) {
            const float b = ada_b[l * 6144 + col];
#pragma unroll
            for (int s = 0; s < 5; ++s) { const float v = ((red[(0 * 128 + F.tid) * 5 + s] + red[(1 * 128 + F.tid) * 5 + s]) + red[(2 * 128 + F.tid) * 5 + s]) + red[(3 * 128 + F.tid) * 5 + s];
                F.mods[(size_t)(l * 5 + s) * 6144 + col] = v + b; }
        }
        __syncthreads();
    }
    if (F.wg == F.G - 1) {
        const float* raw = inp(F, 11); float* lbt = (float*)(F.ws + OFF_LBT);
        for (int i = F.tid; i < 2 * 512; i += 512) { const int d = i >> 9, ch = i & 511; const float r0 = raw[(d * 2 + 0) * 512 + ch], r1 = raw[(d * 2 + 1) * 512 + ch];
            lbt[(0 * 2 + d) * 512 + ch] = 0.f; lbt[(1 * 2 + d) * 512 + ch] = sigmoidf_(r1 - r0); }
    }
}

__device__ __forceinline__ void ph_init_x(const Frame& F) {
    const float* x = inp(F, 0); const float* ctx = inp(F, 2);
    { const float* lg_ = inp(F, 6); const float* lb_ = inp(F, 7); float* AB = (float*)(F.ws + OFF_AB);
      for (int i = F.wg * 512 + F.tid; i < 4 * 5 * 1024; i += F.G * 512) { const int k = i & 1023, ls = i >> 10, l = ls / 5;
          const float* m = F.mods + (size_t)ls * 6144; const float g0 = lg_[(l * 2) * 1024 + k], b0 = lb_[(l * 2) * 1024 + k], m3 = m[3 * 1024 + k], m4 = m[4 * 1024 + k];
          AB[(size_t)ls * 2048 + k] = g0 * (1.0f + m4); AB[(size_t)ls * 2048 + 1024 + k] = b0 * (1.0f + m4) + m3; } }
    const int gw = F.wg * 8 + F.wave, nw = F.G * 8;
    for (int row = gw; row < TT; row += nw) {
        const float* src = row < TC ? ctx + (size_t)row * DM : x + (size_t)(row - TC) * DM;
        const float* m = F.mods + (size_t)(0 * 5 + slot_of_row(row)) * 6144;
#pragma unroll
        for (int hh = 0; hh < 2; ++hh) { const int k = hh * 512 + F.lane * 8;
            const f32x4 v0 = *(const f32x4*)(src + k), v1 = *(const f32x4*)(src + k + 4);
            *(f32x4*)(F.X + (size_t)row * DM + k) = v0; *(f32x4*)(F.X + (size_t)row * DM + k + 4) = v1;
            const f32x4 s0 = *(const f32x4*)(m + 1024 + k), s1 = *(const f32x4*)(m + 1024 + k + 4), b0 = *(const f32x4*)(m + k), b1 = *(const f32x4*)(m + k + 4);
            const f32x4 h0 = v0 * (s0 + 1.0f) + b0, h1 = v1 * (s1 + 1.0f) + b1;
            u32x4 w; w.x = cvt_pk_bf16(h0[0], h0[1]); w.y = cvt_pk_bf16(h0[2], h0[3]); w.z = cvt_pk_bf16(h1[0], h1[1]); w.w = cvt_pk_bf16(h1[2], h1[3]);
            *(u32x4*)(F.HB + (size_t)row * DM + k) = w; }
    }
}

__device__ __forceinline__ void cvt_tile(const Frame& F, const float* src, int sld, int k0, int n0, bf16_t* dst, int dld, int drow0, float scale) {
    LAS float* t = (LAS float*)F.lds;
    { const int i = F.tid >> 3, j0 = (F.tid & 7) * 8; const float* p = src + (size_t)(k0 + i) * sld + n0 + j0;
      const f32x4 a = *(const f32x4*)p, b = *(const f32x4*)(p + 4);
      LAS float* q = t + i * 65 + j0; q[0] = a[0]; q[1] = a[1]; q[2] = a[2]; q[3] = a[3]; q[4] = b[0]; q[5] = b[1]; q[6] = b[2]; q[7] = b[3]; }
    __syncthreads();
    { const int j = F.tid >> 3, i0 = (F.tid & 7) * 8; float v[8];
#pragma unroll
      for (int q = 0; q < 8; ++q) v[q] = t[(i0 + q) * 65 + j] * scale;
      u32x4 w; w.x = cvt_pk_bf16(v[0], v[1]); w.y = cvt_pk_bf16(v[2], v[3]); w.z = cvt_pk_bf16(v[4], v[5]); w.w = cvt_pk_bf16(v[6], v[7]);
      *(u32x4*)(dst + (size_t)(drow0 + j) * dld + k0 + i0) = w; }
    __syncthreads();
}
__device__ __forceinline__ void ph_convert(const Frame& F, int l) {
    const int j = l >> 1; const bool even = (l & 1) == 0;
    bf16_t* wIN = (bf16_t*)(F.WB + WB_IN); bf16_t* wOUT = (bf16_t*)(F.WB + WB_OUT); bf16_t* wRT = (bf16_t*)(F.WB + WB_RT);
    bf16_t* wGU = (bf16_t*)(F.WB + WB_GU); bf16_t* wDN = (bf16_t*)(F.WB + WB_DN); bf16_t* wLRU = (bf16_t*)(F.WB + WB_LRU);
    const int nIN = even ? 4096 : 2048;
    const int t_in = (nIN / 64) * 16, t_out = 256, t_rt = 16, t_gu = 65 * 2 * 64, t_dn = 65 * 64, t_lru = even ? 0 : 64;
    const int total = t_in + t_out + t_rt + t_gu + t_dn + t_lru;
    for (int task = F.wg; task < total; task += F.G) {
        int t = task;
        if (t < t_in) { const int nb = t >> 4, kb = t & 15; const float* src = even ? inp(F, 8) + (size_t)j * 1024 * 4096 : inp(F, 13) + (size_t)j * 1024 * 2048;
            cvt_tile(F, src, nIN, kb * 64, nb * 64, wIN, 1024, nb * 64, (even && nb < 8) ? 0.125f : 1.0f); continue; }
        t -= t_in;
        if (t < t_out) { const int nb = t >> 4, kb = t & 15; const float* src = even ? inp(F, 9) + (size_t)j * 1024 * 1024 : inp(F, 21) + (size_t)j * 1024 * 1024;
            cvt_tile(F, src, 1024, kb * 64, nb * 64, wOUT, 1024, nb * 64, 1.0f); continue; }
        t -= t_out;
        if (t < t_rt) { cvt_tile(F, inp(F, 22) + (size_t)l * 1024 * 64, 64, t * 64, 0, wRT, 1024, 0, 1.0f); continue; }
        t -= t_rt;
        if (t < t_gu) { const int e = t / 128, r = t % 128, which = r >> 6, q = r & 63, nb = q >> 4, kb = q & 15;
            const float* src = (e < 64) ? (which ? inp(F, 25) : inp(F, 24)) + ((size_t)l * 64 + e) * 1024 * 256 : (which ? inp(F, 28) : inp(F, 27)) + (size_t)l * 1024 * 256;
            const int n0 = nb * 64, drow0 = (n0 >> 7) * 256 + which * 128 + (n0 & 127);
            cvt_tile(F, src, 256, kb * 64, n0, wGU + (size_t)e * 512 * 1024, 1024, drow0, 1.0f); continue; }
        t -= t_gu;
        if (t < t_dn) { const int e = t >> 6, q = t & 63, nb = q >> 2, kb = q & 3;
            const float* src = (e < 64) ? inp(F, 26) + ((size_t)l * 64 + e) * 256 * 1024 : inp(F, 29) + (size_t)l * 256 * 1024;
            cvt_tile(F, src, 1024, kb * 64, nb * 64, wDN + (size_t)e * 1024 * 256, 256, nb * 64, 1.0f); continue; }
        t -= t_dn;
        { const int d = t >> 5, gt = (t >> 4) & 1, kb = t & 15;
          const float* src = (gt ? inp(F, 18) : inp(F, 16)) + (((size_t)j * 2 + d) * 16 + kb) * 4096;
          cvt_tile(F, src, 64, 0, 0, wLRU + (((size_t)d * 2 + gt) * 16 + kb) * 4096, 64, 0, 1.0f); }
    }
}

__device__ __forceinline__ void ph_attn(const Frame& F, int j) {
    const bf16_t* P = (const bf16_t*)(F.R1 + R1_P);
    LAS bf16_t* Ks = (LAS bf16_t*)F.lds;
    LAS bf16_t* Vt = (LAS bf16_t*)(F.lds + 9216);
    LAS float* rp_l = (LAS float*)(F.lds + 18432);
    const float* rpb = inp(F, 10) + (size_t)j * 8 * 465;
    const int g = F.lane >> 4, l15 = F.lane & 15;
    const int NLAT = NBAT * 8 * 64, NTASK = NLAT + NBAT * 8 * 2;
    for (int task = F.wg; task < NTASK; task += F.G) {
        const bool lat = task < NLAT;
        int b, h, rp = 0, half = 0;
        if (lat) { b = task >> 9; h = (task >> 6) & 7; rp = task & 63; } else { const int t2 = task - NLAT; b = t2 >> 4; h = (t2 >> 1) & 7; half = t2 & 1; }
        const int myr = 2 * rp + (F.wave >> 2), w0 = (F.wave & 3) * 16;
        const int r0 = min(max(myr - 4, 0), 120);
        const int rlo = min(max(2 * rp - 4, 0), 120), rhi = min(max(2 * rp + 1 - 4, 0), 120) + 7;
        const int nloc = lat ? (rhi - rlo + 1) : 0;
        const int qrow = lat ? (TC + b * SEQ + myr * 64 + w0 + l15) : (b * CTXL + half * 128 + F.wave * 16 + l15);
        bf16x8 qf[2];
        qf[0] = *(const bf16x8*)(P + (size_t)qrow * 4096 + h * 64 + g * 8);
        qf[1] = *(const bf16x8*)(P + (size_t)qrow * 4096 + h * 64 + 32 + g * 8);
        if (lat) for (int i = F.tid; i < 465; i += 512) rp_l[i] = rpb[h * 465 + i];
        f32x4 oacc[4];
#pragma unroll
        for (int dt = 0; dt < 4; ++dt) oacc[dt] = (f32x4){0.f, 0.f, 0.f, 0.f};
        float mrun = -1e30f, lrun = 0.f;
        const int wq = w0 + l15, c0 = min(max(wq - 8, 0), 48);
        u32x4 kv, vv;
        { const int key = F.tid >> 3, ds = (F.tid & 7) * 8; const bool loc0 = 0 < nloc;
          const int krow = loc0 ? (TC + b * SEQ + rlo * 64 + key) : (b * CTXL + key);
          kv = *(const u32x4*)(P + (size_t)krow * 4096 + 512 + h * 64 + ds); vv = *(const u32x4*)(P + (size_t)krow * 4096 + 1024 + h * 64 + ds); }
        for (int ch = 0; ch < nloc + 4; ++ch) {
            const bool loc = ch < nloc; const int kr = rlo + ch;
            { const int key = F.tid >> 3, ds = (F.tid & 7) * 8;
              __syncthreads();
              *(LAS u32x4*)(Ks + key * 72 + ds) = kv;
              Vt[(ds + 0) * 72 + key] = (bf16_t)(vv.x & 0xffff); Vt[(ds + 1) * 72 + key] = (bf16_t)(vv.x >> 16);
              Vt[(ds + 2) * 72 + key] = (bf16_t)(vv.y & 0xffff); Vt[(ds + 3) * 72 + key] = (bf16_t)(vv.y >> 16);
              Vt[(ds + 4) * 72 + key] = (bf16_t)(vv.z & 0xffff); Vt[(ds + 5) * 72 + key] = (bf16_t)(vv.z >> 16);
              Vt[(ds + 6) * 72 + key] = (bf16_t)(vv.w & 0xffff); Vt[(ds + 7) * 72 + key] = (bf16_t)(vv.w >> 16);
              if (ch + 1 < nloc + 4) { const bool locn = (ch + 1) < nloc;
                  const int krow = locn ? (TC + b * SEQ + (kr + 1) * 64 + key) : (b * CTXL + (ch + 1 - nloc) * 64 + key);
                  kv = *(const u32x4*)(P + (size_t)krow * 4096 + 512 + h * 64 + ds); vv = *(const u32x4*)(P + (size_t)krow * 4096 + 1024 + h * 64 + ds); }
              __syncthreads(); }
            const bool mine = loc ? (kr >= r0 && kr < r0 + 8) : true;
            if (mine) {
                f32x4 s[4];
#pragma unroll
                for (int kb = 0; kb < 4; ++kb) { s[kb] = (f32x4){0.f, 0.f, 0.f, 0.f};
#pragma unroll
                    for (int ks = 0; ks < 2; ++ks) { const bf16x8 a = *(const LAS bf16x8*)(Ks + (kb * 16 + l15) * 72 + ks * 32 + g * 8);
                        s[kb] = __builtin_amdgcn_mfma_f32_16x16x32_bf16(a, qf[ks], s[kb], 0, 0, 0); } }
                if (loc) {
#pragma unroll
                    for (int kb = 0; kb < 4; ++kb)
#pragma unroll
                        for (int i = 0; i < 4; ++i) { const int kc = kb * 16 + 4 * g + i; const bool valid = (kc >= c0) && (kc < c0 + 16);
                            const int bi = (kr - myr + 7) * 31 + min(max(kc - wq + 15, 0), 30);
                            s[kb][i] = valid ? s[kb][i] + rp_l[bi] : -1e30f; }
                }
                float cm = -1e30f;
#pragma unroll
                for (int kb = 0; kb < 4; ++kb)
#pragma unroll
                    for (int i = 0; i < 4; ++i) cm = fmaxf(cm, s[kb][i]);
                cm = fmaxf(cm, __shfl_xor(cm, 16)); cm = fmaxf(cm, __shfl_xor(cm, 32));
                const float mn = fmaxf(mrun, cm), sc = __expf(mrun - mn);
                mrun = mn; lrun *= sc;
#pragma unroll
                for (int dt = 0; dt < 4; ++dt) oacc[dt] *= sc;
                float p[4][4];
#pragma unroll
                for (int kb = 0; kb < 4; ++kb)
#pragma unroll
                    for (int i = 0; i < 4; ++i) { p[kb][i] = __expf(s[kb][i] - mn); lrun += p[kb][i]; }
#pragma unroll
                for (int kp = 0; kp < 2; ++kp) {
                    u32x4 pw; pw.x = cvt_pk_bf16(p[2 * kp][0], p[2 * kp][1]); pw.y = cvt_pk_bf16(p[2 * kp][2], p[2 * kp][3]);
                    pw.z = cvt_pk_bf16(p[2 * kp + 1][0], p[2 * kp + 1][1]); pw.w = cvt_pk_bf16(p[2 * kp + 1][2], p[2 * kp + 1][3]);
                    bf16x8 pf; __builtin_memcpy(&pf, &pw, 16);
#pragma unroll
                    for (int dt = 0; dt < 4; ++dt) {
                        const u32x2 v0 = *(const LAS u32x2*)(Vt + (dt * 16 + l15) * 72 + (2 * kp) * 16 + 4 * g);
                        const u32x2 v1 = *(const LAS u32x2*)(Vt + (dt * 16 + l15) * 72 + (2 * kp + 1) * 16 + 4 * g);
                        u32x4 vw; vw.x = v0.x; vw.y = v0.y; vw.z = v1.x; vw.w = v1.y; bf16x8 vf; __builtin_memcpy(&vf, &vw, 16);
                        oacc[dt] = __builtin_amdgcn_mfma_f32_16x16x32_bf16(vf, pf, oacc[dt], 0, 0, 0);
                    }
                }
            }
        }
        float lt = lrun; lt += __shfl_xor(lt, 16); lt += __shfl_xor(lt, 32);
        const float inv = 1.0f / lt;
#pragma unroll
        for (int dt = 0; dt < 4; ++dt) { const f32x4 o = oacc[dt] * inv; u32x2 w; w.x = cvt_pk_bf16(o[0], o[1]); w.y = cvt_pk_bf16(o[2], o[3]);
            *(u32x2*)(F.MIX + (size_t)qrow * DM + h * 64 + dt * 16 + 4 * g) = w; }
        __syncthreads();
    }
}

__device__ __forceinline__ int hg_unit(int nb, int dir) { return dir == 0 ? nb : (nb < 2 ? 1 - nb : 2 + (HG_NU - 3 - (nb - 2))); }
__device__ __forceinline__ int hg_row(int b, int nb, int t) { return nb < 2 ? b * CTXL + nb * HG_U + t : TC + b * SEQ + (nb - 2) * HG_U + t; }
template <int CTRL> __device__ __forceinline__ float dpp_add0(float x) { return x + dppf<CTRL>(0.0f, x); }
template <bool WITHO>
__device__ __forceinline__ void hg_pass(const Frame& F, const bf16_t* P, const float* lbh, int b, int h, int nb, int dir, f32x4 (&S)[4][4], float (&Gsum)[16],
                                        LAS bf16_t* Vl, LAS bf16_t* Kl, float* OF, const float* ngp) {
    const int tau = F.lane & 15, g = F.lane >> 4;
    const unsigned vaddr = (unsigned)(size_t)Vl + (unsigned)((4 * g + (tau >> 2)) * 128 + (tau & 3) * 8);
    const unsigned kaddr = (unsigned)(size_t)Kl + (unsigned)((4 * g + (tau >> 2)) * 128 + (tau & 3) * 8);
    u32x2 zr[4], vr[4], qr[4];
    { const int t = dir ? (HG_U - 1 - tau) : tau; const bf16_t* pr = P + (size_t)hg_row(b, nb, t) * 4096 + h * 64 + 4 * g;
#pragma unroll
      for (int m = 0; m < 4; ++m) { zr[m] = *(const u32x2*)(pr + (dir ? 2560 : 2048) + 16 * m); vr[m] = *(const u32x2*)(pr + 3072 + 16 * m); } }
    for (int ci = 0; ci < HG_U / 16; ++ci) {
        float kk[16], c[16];
        if (WITHO) { const int pos = ci * 16 + tau, t = dir ? (HG_U - 1 - pos) : pos; const bf16_t* pr = P + (size_t)hg_row(b, nb, t) * 4096 + h * 64 + 4 * g;
#pragma unroll
            for (int m = 0; m < 4; ++m) qr[m] = *(const u32x2*)(pr + 1536 + 16 * m); }
#pragma unroll
        for (int m = 0; m < 4; ++m) { const float z0 = __uint_as_float(zr[m].x << 16), z1 = __uint_as_float(zr[m].x & 0xffff0000u), z2 = __uint_as_float(zr[m].y << 16), z3 = __uint_as_float(zr[m].y & 0xffff0000u);
            const float zz[4] = {z0, z1, z2, z3};
            const f32x4 lb4 = *(const f32x4*)(lbh + 16 * m + 4 * g);
#pragma unroll
            for (int i = 0; i < 4; ++i) { const float lb = lb4[i]; const float f = fmaxf(lb + (1.0f - lb) * sigmoidf_(zz[i]), 1e-30f); kk[m * 4 + i] = 1.0f - f; c[m * 4 + i] = __logf(f); }
            *(LAS u32x2*)(Vl + tau * 64 + 16 * m + 4 * g) = vr[m];
 }
        if (ci + 1 < HG_U / 16) { const int pos = (ci + 1) * 16 + tau, t = dir ? (HG_U - 1 - pos) : pos; const bf16_t* pr = P + (size_t)hg_row(b, nb, t) * 4096 + h * 64 + 4 * g;
#pragma unroll
            for (int m = 0; m < 4; ++m) { zr[m] = *(const u32x2*)(pr + (dir ? 2560 : 2048) + 16 * m); vr[m] = *(const u32x2*)(pr + 3072 + 16 * m); } }
#pragma unroll
        for (int q = 0; q < 16; ++q) { c[q] = dpp_add0<0x111>(c[q]); c[q] = dpp_add0<0x112>(c[q]); c[q] = dpp_add0<0x114>(c[q]); c[q] = dpp_add0<0x118>(c[q]); }
        float G[16];
#pragma unroll
        for (int q = 0; q < 16; ++q) { G[q] = __shfl(c[q], (F.lane & 48) | 15); Gsum[q] += G[q]; }
#pragma unroll
        for (int m = 0; m < 4; ++m) { float kh[4];
#pragma unroll
            for (int i = 0; i < 4; ++i) kh[i] = kk[m * 4 + i] * __expf(G[m * 4 + i] - c[m * 4 + i]);
            u32x2 w; w.x = cvt_pk_bf16(kh[0], kh[1]); w.y = cvt_pk_bf16(kh[2], kh[3]);
            *(LAS u32x2*)(Kl + tau * 64 + 16 * m + 4 * g) = w; }
        float ofv[4][4], gtv[4][4]; int orow[4];
        if (WITHO) {
#pragma unroll
            for (int i = 0; i < 4; ++i) { const int p2 = ci * 16 + 4 * g + i, t2 = dir ? (HG_U - 1 - p2) : p2; orow[i] = hg_row(b, nb, t2); }
            if (dir) {
#pragma unroll
                for (int i = 0; i < 4; ++i)
#pragma unroll
                    for (int vt = 0; vt < 4; ++vt) { ofv[i][vt] = OF[(size_t)orow[i] * 512 + h * 64 + 16 * vt + tau]; gtv[i][vt] = bf2f(P[(size_t)orow[i] * 4096 + 3584 + h * 64 + 16 * vt + tau]); }
            }
        }
        asm volatile("s_waitcnt lgkmcnt(0)" ::: "memory");
        u32x2 vtr[4], ktr[4];
        asm volatile("ds_read_b64_tr_b16 %0, %8\n\tds_read_b64_tr_b16 %1, %8 offset:32\n\tds_read_b64_tr_b16 %2, %8 offset:64\n\tds_read_b64_tr_b16 %3, %8 offset:96\n\t"
                     "ds_read_b64_tr_b16 %4, %9\n\tds_read_b64_tr_b16 %5, %9 offset:32\n\tds_read_b64_tr_b16 %6, %9 offset:64\n\tds_read_b64_tr_b16 %7, %9 offset:96\n\ts_waitcnt lgkmcnt(0)"
                     : "=&v"(vtr[0]), "=&v"(vtr[1]), "=&v"(vtr[2]), "=&v"(vtr[3]), "=&v"(ktr[0]), "=&v"(ktr[1]), "=&v"(ktr[2]), "=&v"(ktr[3]) : "v"(vaddr), "v"(kaddr) : "memory");
        bf16x8 Vf[4], Kf[4];
#pragma unroll
        for (int q = 0; q < 4; ++q) { u32x4 w; w.x = vtr[q].x; w.y = vtr[q].y; w.z = 0u; w.w = 0u; __builtin_memcpy(&Vf[q], &w, 16); u32x4 w2; w2.x = ktr[q].x; w2.y = ktr[q].y; w2.z = 0u; w2.w = 0u; __builtin_memcpy(&Kf[q], &w2, 16); }
        if (WITHO) {
            bf16x8 Ktf[2], Qtf[2], Qhf[2];
#pragma unroll
            for (int ks = 0; ks < 2; ++ks) { float kt_[8], qt_[8], qh_[8];
#pragma unroll
                for (int mm = 0; mm < 2; ++mm) { const int m = 2 * ks + mm;
                    const float qq[4] = {__uint_as_float(qr[m].x << 16), __uint_as_float(qr[m].x & 0xffff0000u), __uint_as_float(qr[m].y << 16), __uint_as_float(qr[m].y & 0xffff0000u)};
#pragma unroll
                    for (int i = 0; i < 4; ++i) { const int q = m * 4 + i; const float qv = siluf_(qq[i]) * 0.125f; const float d = fminf(fmaxf(c[q] - 0.5f * G[q], -80.0f), 80.0f);
                        qt_[mm * 4 + i] = qv * __expf(d); kt_[mm * 4 + i] = kk[q] * __expf(-d); qh_[mm * 4 + i] = qv * __expf(c[q]); } }
                u32x4 w; w.x = cvt_pk_bf16(kt_[0], kt_[1]); w.y = cvt_pk_bf16(kt_[2], kt_[3]); w.z = cvt_pk_bf16(kt_[4], kt_[5]); w.w = cvt_pk_bf16(kt_[6], kt_[7]); __builtin_memcpy(&Ktf[ks], &w, 16);
                w.x = cvt_pk_bf16(qt_[0], qt_[1]); w.y = cvt_pk_bf16(qt_[2], qt_[3]); w.z = cvt_pk_bf16(qt_[4], qt_[5]); w.w = cvt_pk_bf16(qt_[6], qt_[7]); __builtin_memcpy(&Qtf[ks], &w, 16);
                w.x = cvt_pk_bf16(qh_[0], qh_[1]); w.y = cvt_pk_bf16(qh_[2], qh_[3]); w.z = cvt_pk_bf16(qh_[4], qh_[5]); w.w = cvt_pk_bf16(qh_[6], qh_[7]); __builtin_memcpy(&Qhf[ks], &w, 16); }
            f32x4 AT = (f32x4){0.f, 0.f, 0.f, 0.f};
            AT = __builtin_amdgcn_mfma_f32_16x16x32_bf16(Ktf[0], Qtf[0], AT, 0, 0, 0); AT = __builtin_amdgcn_mfma_f32_16x16x32_bf16(Ktf[1], Qtf[1], AT, 0, 0, 0);
#pragma unroll
            for (int i = 0; i < 4; ++i) AT[i] = (4 * g + i <= tau) ? AT[i] : 0.0f;
            bf16x8 Af; { u32x4 w; w.x = cvt_pk_bf16(AT[0], AT[1]); w.y = cvt_pk_bf16(AT[2], AT[3]); w.z = 0u; w.w = 0u; __builtin_memcpy(&Af, &w, 16); }
            f32x4 o[4];
#pragma unroll
            for (int vt = 0; vt < 4; ++vt) { o[vt] = __builtin_amdgcn_mfma_f32_16x16x32_bf16(Af, Vf[vt], (f32x4){0.f, 0.f, 0.f, 0.f}, 0, 0, 0);
#pragma unroll
                for (int ks = 0; ks < 2; ++ks) { u32x4 w; w.x = cvt_pk_bf16(S[2 * ks][vt][0], S[2 * ks][vt][1]); w.y = cvt_pk_bf16(S[2 * ks][vt][2], S[2 * ks][vt][3]);
                    w.z = cvt_pk_bf16(S[2 * ks + 1][vt][0], S[2 * ks + 1][vt][1]); w.w = cvt_pk_bf16(S[2 * ks + 1][vt][2], S[2 * ks + 1][vt][3]); bf16x8 Sf; __builtin_memcpy(&Sf, &w, 16);
                    o[vt] = __builtin_amdgcn_mfma_f32_16x16x32_bf16(Qhf[ks], Sf, o[vt], 0, 0, 0); } }
            if (dir == 0) {
#pragma unroll
                for (int i = 0; i < 4; ++i)
#pragma unroll
                    for (int vt = 0; vt < 4; ++vt) OF[(size_t)orow[i] * 512 + h * 64 + 16 * vt + tau] = o[vt][i];
            } else {
#pragma unroll
                for (int i = 0; i < 4; ++i) { float tot[4]; float sq = 0.f;
#pragma unroll
                    for (int vt = 0; vt < 4; ++vt) { tot[vt] = o[vt][i] + ofv[i][vt]; sq = fmaf(tot[vt], tot[vt], sq); }
                    sq += dppf<0xB1>(sq, sq); sq += dppf<0x4E>(sq, sq); sq += dppf<0x141>(sq, sq); sq += dppf<0x140>(sq, sq);
                    const float rs = rsqrtf(sq * (1.0f / 64.0f) + 1e-6f);
#pragma unroll
                    for (int vt = 0; vt < 4; ++vt) F.MIX[(size_t)orow[i] * DM + 512 + h * 64 + 16 * vt + tau] = f2bf(tot[vt] * rs * ngp[16 * vt + tau] * siluf_(gtv[i][vt])); }
            }
        }
#pragma unroll
        for (int kt = 0; kt < 4; ++kt) { f32x4 eg;
#pragma unroll
            for (int i = 0; i < 4; ++i) eg[i] = __expf(G[kt * 4 + i]);
#pragma unroll
            for (int vt = 0; vt < 4; ++vt) S[kt][vt] = __builtin_amdgcn_mfma_f32_16x16x32_bf16(Kf[kt], Vf[vt], S[kt][vt] * eg, 0, 0, 0); }
    }
}
__device__ __forceinline__ void ph_hg_a(const Frame& F, int j) {
    const bf16_t* P = (const bf16_t*)(F.R1 + R1_P);
    float* SLOC = (float*)(F.R1 + R1_SLOC); float* DL = (float*)(F.R1 + R1_DL);
    LAS bf16_t* Vl = (LAS bf16_t*)(F.lds + 32768 + F.wave * 4096); LAS bf16_t* Kl = Vl + 1024;
    const int gw = F.wg * 8 + F.wave, nw = F.G * 8;
    const int NT = NBAT * 8 * HG_NU * 2;
    for (int task = gw; task < NT; task += nw) {
        const int dir = task & 1, nb = (task >> 1) % HG_NU, bh = (task >> 1) / HG_NU, b = bh >> 3, h = bh & 7;
        const float* lbh = (const float*)(F.ws + OFF_LBT) + (j * 2 + dir) * 512 + h * 64;
        f32x4 S[4][4];
#pragma unroll
        for (int kt = 0; kt < 4; ++kt)
#pragma unroll
            for (int vt = 0; vt < 4; ++vt) S[kt][vt] = (f32x4){0.f, 0.f, 0.f, 0.f};
        float Gsum[16];
#pragma unroll
        for (int q = 0; q < 16; ++q) Gsum[q] = 0.f;
        hg_pass<false>(F, P, lbh, b, h, nb, dir, S, Gsum, Vl, Kl, nullptr, nullptr);
        const int seq = bh * 2 + dir, u = hg_unit(nb, dir);
        float* so = SLOC + ((size_t)seq * HG_NU + u) * 4096;
#pragma unroll
        for (int kt = 0; kt < 4; ++kt)
#pragma unroll
            for (int vt = 0; vt < 4; ++vt)
#pragma unroll
                for (int i = 0; i < 4; ++i) so[((kt * 4 + vt) * 4 + i) * 64 + F.lane] = S[kt][vt][i];
        if ((F.lane & 15) == 0) { float* dd = DL + ((size_t)seq * HG_NU + u) * 64;
#pragma unroll
            for (int m = 0; m < 4; ++m)
#pragma unroll
                for (int i = 0; i < 4; ++i) dd[16 * m + 4 * (F.lane >> 4) + i] = __expf(Gsum[m * 4 + i]); }
    }
}
__device__ __forceinline__ void ph_hg_b(const Frame& F) {
    const float* SLOC = (const float*)(F.R1 + R1_SLOC); const float* DL = (const float*)(F.R1 + R1_DL); float* SST = (float*)(F.R1 + R1_SST);
    for (int idx = F.wg * 512 + F.tid; idx < 64 * 4096; idx += F.G * 512) {
        const int seq = idx >> 12, e = idx & 4095, ln = e & 63, reg = e >> 6, i = reg & 3, kt = reg >> 4, k = 16 * kt + 4 * (ln >> 4) + i;
        float s = 0.f;
#pragma unroll 6
        for (int u = 0; u < HG_NU; ++u) { const size_t o = ((size_t)seq * HG_NU + u) * 4096 + e; SST[o] = s; s = DL[((size_t)seq * HG_NU + u) * 64 + k] * s + SLOC[o]; }
    }
}
__device__ __forceinline__ void ph_hg_c(const Frame& F, int j) {
    const bf16_t* P = (const bf16_t*)(F.R1 + R1_P);
    const float* SST = (const float*)(F.R1 + R1_SST); float* OF = (float*)(F.R1 + R1_OF);
    const float* ng = inp(F, 12) + j * 64;
    LAS bf16_t* Vl = (LAS bf16_t*)(F.lds + 32768 + F.wave * 4096); LAS bf16_t* Kl = Vl + 1024;
    const int gw = F.wg * 8 + F.wave, nw = F.G * 8;
    const int NT = NBAT * 8 * (HG_NU - 2);
    for (int task = gw; task < NT; task += nw) {
        const int nb = 2 + task % (HG_NU - 2), bh = task / (HG_NU - 2), b = bh >> 3, h = bh & 7;
        for (int dir = 0; dir < 2; ++dir) {
            const float* lbh = (const float*)(F.ws + OFF_LBT) + (j * 2 + dir) * 512 + h * 64;
            const int seq = bh * 2 + dir, u = hg_unit(nb, dir);
            const float* ss = SST + ((size_t)seq * HG_NU + u) * 4096;
            f32x4 S[4][4];
#pragma unroll
            for (int kt = 0; kt < 4; ++kt)
#pragma unroll
                for (int vt = 0; vt < 4; ++vt)
#pragma unroll
                    for (int i = 0; i < 4; ++i) S[kt][vt][i] = ss[((kt * 4 + vt) * 4 + i) * 64 + F.lane];
            float Gsum[16];
#pragma unroll
            for (int q = 0; q < 16; ++q) Gsum[q] = 0.f;
            hg_pass<true>(F, P, lbh, b, h, nb, dir, S, Gsum, Vl, Kl, OF, ng);
            asm volatile("s_waitcnt vmcnt(0)" ::: "memory");
        }
    }
}

__device__ __forceinline__ void ph_hg_c_ctx(const Frame& F, int j) {
    if (F.wg >= NBAT * 8 * 2 || F.wave != 0) return;
    const bf16_t* P = (const bf16_t*)(F.R1 + R1_P);
    const float* SLOC = (const float*)(F.R1 + R1_SLOC); float* OF = (float*)(F.R1 + R1_OF);
    const float* ng = inp(F, 12) + j * 64;
    LAS bf16_t* Vl = (LAS bf16_t*)(F.lds + 32768 + F.wave * 4096); LAS bf16_t* Kl = Vl + 1024;
    const int nb = F.wg & 1, bh = F.wg >> 1, b = bh >> 3, h = bh & 7;
    for (int dir = 0; dir < 2; ++dir) {
        const float* lbh = (const float*)(F.ws + OFF_LBT) + (j * 2 + dir) * 512 + h * 64;
        const int seq = bh * 2 + dir, u = hg_unit(nb, dir);
        const float* ss = SLOC + ((size_t)seq * HG_NU + 0) * 4096;
        f32x4 S[4][4];
#pragma unroll
        for (int kt = 0; kt < 4; ++kt)
#pragma unroll
            for (int vt = 0; vt < 4; ++vt)
#pragma unroll
                for (int i = 0; i < 4; ++i) S[kt][vt][i] = (u == 0) ? 0.0f : ss[((kt * 4 + vt) * 4 + i) * 64 + F.lane];
        float Gsum[16];
#pragma unroll
        for (int q = 0; q < 16; ++q) Gsum[q] = 0.f;
        hg_pass<true>(F, P, lbh, b, h, nb, dir, S, Gsum, Vl, Kl, OF, ng);
        asm volatile("s_waitcnt vmcnt(0)" ::: "memory");
    }
}

__device__ __forceinline__ int lru_nat(int so, int dir) { return dir == 0 ? so : (so < 16 ? 15 - so : 16 + (LRU_NT - 1 - so)); }
__device__ __forceinline__ int lru_row(int b, int nt, int t) { return nt < 16 ? b * CTXL + nt * 16 + t : TC + b * SEQ + (nt - 16) * 16 + t; }
struct LruRaw { u32x4 a[4], b[4]; };
__device__ __forceinline__ void lru_load(const Frame& F, int b, int kb, int nt, LruRaw& R) {
    const bf16_t* P = (const bf16_t*)(F.R1 + R1_P);
    const int tk = F.lane & 15, g = F.lane >> 4;
    const int len = nt < 16 ? CTXL : SEQ, tpos = (nt < 16 ? nt * 16 : (nt - 16) * 16) + tk;
    const bf16_t* pbase = P + (size_t)((nt < 16 ? b * CTXL : TC + b * SEQ)) * 2048 + 1024 + kb * 64 + g * 16;
#pragma unroll
    for (int tap = 0; tap < 4; ++tap) { const int tp = tpos + tap - 2; const bool ok = (tp >= 0 && tp < len); const bf16_t* pr = pbase + (size_t)(ok ? tp : tpos) * 2048;
        R.a[tap] = *(const u32x4*)pr; R.b[tap] = *(const u32x4*)(pr + 8); if (!ok) { R.a[tap] = (u32x4){0u, 0u, 0u, 0u}; R.b[tap] = (u32x4){0u, 0u, 0u, 0u}; } }
}
__device__ __forceinline__ void lru_conv(const Frame& F, const LruRaw& R, const LAS float* CT, LAS float* ucb) {
    const int tk = F.lane & 15, g = F.lane >> 4;
    float acc[16];
#pragma unroll
    for (int q = 0; q < 4; ++q) { const f32x4 c4 = *(const LAS f32x4*)(CT + 4 * 64 + g * 16 + q * 4); acc[q * 4] = c4[0]; acc[q * 4 + 1] = c4[1]; acc[q * 4 + 2] = c4[2]; acc[q * 4 + 3] = c4[3]; }
#pragma unroll
    for (int tap = 0; tap < 4; ++tap) { float t0[8], t1[8]; unpack8(R.a[tap], t0); unpack8(R.b[tap], t1);
#pragma unroll
        for (int q = 0; q < 2; ++q) { const f32x4 w0 = *(const LAS f32x4*)(CT + tap * 64 + g * 16 + q * 4), w1 = *(const LAS f32x4*)(CT + tap * 64 + g * 16 + 8 + q * 4);
#pragma unroll
            for (int i = 0; i < 4; ++i) { acc[q * 4 + i] = fmaf(w0[i], t0[q * 4 + i], acc[q * 4 + i]); acc[8 + q * 4 + i] = fmaf(w1[i], t1[q * 4 + i], acc[8 + q * 4 + i]); } } }
#pragma unroll
    for (int q = 0; q < 4; ++q) *(LAS f32x4*)(ucb + tk * 64 + g * 16 + q * 4) = (f32x4){acc[q * 4], acc[q * 4 + 1], acc[q * 4 + 2], acc[q * 4 + 3]};
}
__device__ __forceinline__ void lru_gates(const Frame& F, LAS bf16_t* Wl, const LAS float* CT, LAS float* ucb, float (&av)[2][4][4], float (&xv)[2][4][4]) {
    const int tk = F.lane & 15, g = F.lane >> 4;
    bf16x8 bfr[2];
#pragma unroll
    for (int ks = 0; ks < 2; ++ks) { const f32x4 u0 = *(const LAS f32x4*)(ucb + tk * 64 + ks * 32 + g * 8), u1 = *(const LAS f32x4*)(ucb + tk * 64 + ks * 32 + g * 8 + 4);
        u32x4 w; w.x = cvt_pk_bf16(u0[0], u0[1]); w.y = cvt_pk_bf16(u0[2], u0[3]); w.z = cvt_pk_bf16(u1[0], u1[1]); w.w = cvt_pk_bf16(u1[2], u1[3]); __builtin_memcpy(&bfr[ks], &w, 16); }
#pragma unroll
    for (int d = 0; d < 2; ++d)
#pragma unroll
        for (int et = 0; et < 4; ++et) {
            f32x4 ra = (f32x4){0.f, 0.f, 0.f, 0.f}, ri = (f32x4){0.f, 0.f, 0.f, 0.f};
#pragma unroll
            for (int ks = 0; ks < 2; ++ks) {
                const bf16x8 wa = *(const LAS bf16x8*)(Wl + ((d * 2 + 0) * 64 + et * 16 + tk) * 64 + ks * 32 + g * 8);
                const bf16x8 wx = *(const LAS bf16x8*)(Wl + ((d * 2 + 1) * 64 + et * 16 + tk) * 64 + ks * 32 + g * 8);
                ra = __builtin_amdgcn_mfma_f32_16x16x32_bf16(wa, bfr[ks], ra, 0, 0, 0);
                ri = __builtin_amdgcn_mfma_f32_16x16x32_bf16(wx, bfr[ks], ri, 0, 0, 0);
            }
            const f32x4 ba4 = *(const LAS f32x4*)(CT + (5 + 3 * d) * 64 + et * 16 + 4 * g), bx4 = *(const LAS f32x4*)(CT + (6 + 3 * d) * 64 + et * 16 + 4 * g), cs4 = *(const LAS f32x4*)(CT + (7 + 3 * d) * 64 + et * 16 + 4 * g);
            const f32x4 u4 = *(const LAS f32x4*)(ucb + tk * 64 + et * 16 + 4 * g);
#pragma unroll
            for (int i = 0; i < 4; ++i) {
                const float r = sigmoidf_(ra[i] + ba4[i]), ig = sigmoidf_(ri[i] + bx4[i]);
                const float la = cs4[i] * r, a = __expf(la);
                av[d][et][i] = la; xv[d][et][i] = sqrtf(fmaxf(1.0f - a * a, 0.f)) * ig * u4[i]; }
        }
}
template <int S> __device__ __forceinline__ void lru_step_f(float& a, float& x) { const float ap = dppf<0x110 + S>(1.0f, a), xp = dppf<0x110 + S>(0.0f, x); x = fmaf(a, xp, x); a = a * ap; }
template <int S> __device__ __forceinline__ void lru_step_b(float& a, float& x) { const float ap = dppf<0x100 + S>(1.0f, a), xp = dppf<0x100 + S>(0.0f, x); x = fmaf(a, xp, x); a = a * ap; }
#define LRU_SCANS(av, xv) do { _Pragma("unroll") for (int et = 0; et < 4; ++et) _Pragma("unroll") for (int i = 0; i < 4; ++i) { \
        lru_step_f<1>(av[0][et][i], xv[0][et][i]); lru_step_f<2>(av[0][et][i], xv[0][et][i]); lru_step_f<4>(av[0][et][i], xv[0][et][i]); lru_step_f<8>(av[0][et][i], xv[0][et][i]); \
        lru_step_b<1>(av[1][et][i], xv[1][et][i]); lru_step_b<2>(av[1][et][i], xv[1][et][i]); lru_step_b<4>(av[1][et][i], xv[1][et][i]); lru_step_b<8>(av[1][et][i], xv[1][et][i]); } } while (0)
__device__ __forceinline__ void ph_lru_a(const Frame& F, int jj) {
    LAS bf16_t* Wl = (LAS bf16_t*)F.lds;
    LAS float* ucb = (LAS float*)(F.lds + 32768 + F.wave * 4096);
    LAS float* CT = (LAS float*)(F.lds + 65536);
    const bf16_t* wsrc = (const bf16_t*)(F.WB + WB_LRU);
    float* AG = (float*)(F.R1 + R1_AG); bf16_t* GX = (bf16_t*)(F.R1 + R1_GX);
    const float* cw = inp(F, 14) + (size_t)jj * 4 * 1024; const float* cb = inp(F, 15) + (size_t)jj * 1024;
    const float* b_a = inp(F, 17) + (size_t)jj * 2 * 1024; const float* b_x = inp(F, 19) + (size_t)jj * 2 * 1024; const float* lam = inp(F, 20) + (size_t)jj * 2 * 1024;
    const int tk = F.lane & 15, g = F.lane >> 4;
    const int NTASK = NBAT * 16 * 11;
    for (int task = F.wg; task < NTASK; task += F.G) {
        const int grp = task % 11, kb = (task / 11) & 15, b = task / (11 * 16);
        __syncthreads();
        for (int i = F.tid; i < 4 * 4096 / 8; i += 512) { const int mg = i >> 9, r = i & 511;
            *(LAS u32x4*)(Wl + mg * 4096 + r * 8) = *(const u32x4*)(wsrc + ((size_t)mg * 16 + kb) * 4096 + r * 8); }
        for (int i = F.tid; i < 11 * 64; i += 512) { const int kind = i >> 6, ch = kb * 64 + (i & 63); float v;
            if (kind < 4) v = cw[kind * 1024 + ch]; else if (kind == 4) v = cb[ch];
            else { const int d = (kind - 5) / 3, w = (kind - 5) % 3; v = (w == 0) ? b_a[d * 1024 + ch] : (w == 1) ? b_x[d * 1024 + ch] : -8.0f * log1pf(__expf(-lam[d * 1024 + ch])); }
            CT[i] = v; }
        __syncthreads();
        const int nt0 = grp * 48;
        LruRaw raw; lru_load(F, b, kb, nt0 + F.wave, raw);
        for (int ti = F.wave; ti < 48; ti += 8) {
            const int nt = nt0 + ti;
            float av[2][4][4], xv[2][4][4];
            lru_conv(F, raw, CT, ucb);
            if (ti + 8 < 48) lru_load(F, b, kb, nt + 8, raw);
            lru_gates(F, Wl, CT, ucb, av, xv);
            const int row = lru_row(b, nt, tk);
#pragma unroll
            for (int d = 0; d < 2; ++d)
#pragma unroll
                for (int et = 0; et < 4; ++et) { u32x4 w; w.x = cvt_pk_bf16(av[d][et][0], xv[d][et][0]); w.y = cvt_pk_bf16(av[d][et][1], xv[d][et][1]); w.z = cvt_pk_bf16(av[d][et][2], xv[d][et][2]); w.w = cvt_pk_bf16(av[d][et][3], xv[d][et][3]);
                    *(u32x4*)(GX + (((size_t)row * 2 + d) * 1024 + kb * 64 + et * 16 + 4 * g) * 2) = w;
                    const unsigned ww[4] = {w.x, w.y, w.z, w.w};
#pragma unroll
                    for (int i = 0; i < 4; ++i) { av[d][et][i] = __expf(__uint_as_float(ww[i] << 16)); xv[d][et][i] = __uint_as_float(ww[i] & 0xffff0000u); } }
            LRU_SCANS(av, xv);
#pragma unroll
            for (int d = 0; d < 2; ++d) if (tk == (d ? 0 : 15)) {
                float* ag = AG + (((size_t)(b * 2 + d) * LRU_NT + nt) * 2) * 1024 + kb * 64;
#pragma unroll
                for (int et = 0; et < 4; ++et) { *(f32x4*)(ag + et * 16 + 4 * g) = (f32x4){av[d][et][0], av[d][et][1], av[d][et][2], av[d][et][3]};
                    *(f32x4*)(ag + 1024 + et * 16 + 4 * g) = (f32x4){xv[d][et][0], xv[d][et][1], xv[d][et][2], xv[d][et][3]}; }
            }
        }
    }
    __syncthreads();
}
__device__ __forceinline__ void ph_lru_c(const Frame& F) {
    const float* HST = (const float*)(F.R1 + R1_HST); const bf16_t* GX = (const bf16_t*)(F.R1 + R1_GX);
    const bf16_t* P = (const bf16_t*)(F.R1 + R1_P);
    const int tk = F.lane & 15, g = F.lane >> 4;
    const int gw = F.wg * 8 + F.wave, nw = F.G * 8;
    for (int task = gw; task < NBAT * LRU_NT * 16; task += nw) {
        const int kb = task & 15, nt = (task >> 4) % LRU_NT, b = (task >> 4) / LRU_NT;
        const int row = lru_row(b, nt, tk);
        u32x4 gx[2][4]; f32x4 hf[4], hb[4]; u32x2 yw[4];
#pragma unroll
        for (int d = 0; d < 2; ++d)
#pragma unroll
            for (int et = 0; et < 4; ++et) gx[d][et] = *(const u32x4*)(GX + (((size_t)row * 2 + d) * 1024 + kb * 64 + et * 16 + 4 * g) * 2);
#pragma unroll
        for (int et = 0; et < 4; ++et) { const int ch = kb * 64 + et * 16 + 4 * g;
            hf[et] = *(const f32x4*)(HST + ((size_t)(b * 2 + 0) * LRU_NT + nt) * 1024 + ch);
            hb[et] = *(const f32x4*)(HST + ((size_t)(b * 2 + 1) * LRU_NT + nt) * 1024 + ch);
            yw[et] = *(const u32x2*)(P + (size_t)row * 2048 + ch); }
        float av[2][4][4], xv[2][4][4];
#pragma unroll
        for (int d = 0; d < 2; ++d)
#pragma unroll
            for (int et = 0; et < 4; ++et) { const unsigned ww[4] = {gx[d][et].x, gx[d][et].y, gx[d][et].z, gx[d][et].w};
#pragma unroll
                for (int i = 0; i < 4; ++i) { av[d][et][i] = __expf(__uint_as_float(ww[i] << 16)); xv[d][et][i] = __uint_as_float(ww[i] & 0xffff0000u); } }
        LRU_SCANS(av, xv);
#pragma unroll
        for (int et = 0; et < 4; ++et) {
            const int ch = kb * 64 + et * 16 + 4 * g;
            const float y0 = __uint_as_float(yw[et].x << 16), y1 = __uint_as_float(yw[et].x & 0xffff0000u), y2 = __uint_as_float(yw[et].y << 16), y3 = __uint_as_float(yw[et].y & 0xffff0000u);
            float o[4];
#pragma unroll
            for (int i = 0; i < 4; ++i) o[i] = fmaf(av[0][et][i], hf[et][i], xv[0][et][i]) + fmaf(av[1][et][i], hb[et][i], xv[1][et][i]);
            o[0] *= gelu_tanh_(y0); o[1] *= gelu_tanh_(y1); o[2] *= gelu_tanh_(y2); o[3] *= gelu_tanh_(y3);
            u32x2 w; w.x = cvt_pk_bf16(o[0], o[1]); w.y = cvt_pk_bf16(o[2], o[3]);
            *(u32x2*)(F.MIX + (size_t)row * DM + ch) = w;
        }
    }
}
__device__ __forceinline__ void ph_lru_b(const Frame& F) {
    const float* AG = (const float*)(F.R1 + R1_AG); float* HST = (float*)(F.R1 + R1_HST);
    LAS float* sa = (LAS float*)F.lds; LAS float* sx = sa + 512;
    for (int task = F.wg; task < NBAT * 2 * 32; task += F.G) {
        const int cgp = task & 31, d = (task >> 5) & 1, b = task >> 6;
        const int ch = cgp * 32 + (F.tid & 31), seg = F.tid >> 5;
        const float* ag = AG + ((size_t)(b * 2 + d) * LRU_NT) * 2048 + ch;
        float A = 1.0f, Xv = 0.f;
        for (int i = 0; i < 33; ++i) { const int nt = lru_nat(seg * 33 + i, d); const float a = ag[(size_t)nt * 2048], x = ag[(size_t)nt * 2048 + 1024]; Xv = fmaf(a, Xv, x); A *= a; }
        __syncthreads();
        sa[F.tid] = A; sx[F.tid] = Xv;
        __syncthreads();
        float h = 0.f;
        for (int s2 = 0; s2 < seg; ++s2) h = fmaf(sa[s2 * 32 + (F.tid & 31)], h, sx[s2 * 32 + (F.tid & 31)]);
        float* hs = HST + ((size_t)(b * 2 + d) * LRU_NT) * 1024 + ch;
        for (int i = 0; i < 33; ++i) { const int nt = lru_nat(seg * 33 + i, d); hs[(size_t)nt * 1024] = h; const float a = ag[(size_t)nt * 2048], x = ag[(size_t)nt * 2048 + 1024]; h = fmaf(a, h, x); }
    }
    __syncthreads();
}

__device__ __forceinline__ void topk_better(float& bk, int& be, float& bs, float ok, int oe, float os) { const bool t = (ok > bk) || (ok == bk && oe < be); bk = t ? ok : bk; be = t ? oe : be; bs = t ? os : bs; }
template <int CTRL> __device__ __forceinline__ void topk_step(float& bk, int& be, float& bs) {
    const float ok = dppf<CTRL>(bk, bk), os = dppf<CTRL>(bs, bs); const int oe = __builtin_amdgcn_update_dpp(be, be, CTRL, 0xf, 0xf, false); topk_better(bk, be, bs, ok, oe, os); }
__device__ __forceinline__ void ph_ln_router(const Frame& F, int l, bool dry = false) {
    const bf16_t* RW = (const bf16_t*)(F.WB + WB_RT);
    const float* rbias = inp(F, 23) + l * 64;
    LAS float* part = (LAS float*)F.lds;
    LAS float* LP = (LAS float*)(F.lds + 4096);
    LAS int* hist = (LAS int*)(F.lds + LDS_MISC + MISC_HIST); LAS int* hbase = (LAS int*)(F.lds + LDS_MISC + MISC_HBASE);
    int* tok_e = (int*)(F.ws + OFF_TOKE); int* tok_p = (int*)(F.ws + OFF_TOKP); float* tok_w = (float*)(F.ws + OFF_TOKW);
    int* stok = (int*)(F.ws + OFF_STOK); float* sw = (float*)(F.ws + OFF_SW);
    float* stats = (float*)(F.ws + OFF_STATS);
    unsigned* gcnt = (unsigned*)(F.ws + OFF_CTL + CTL_CNT) + l * 64;
    const int tk = F.lane & 15, g = F.lane >> 4;
    float rb[4];
#pragma unroll
    for (int q = 0; q < 4; ++q) rb[q] = rbias[tk + 16 * q];
    if (F.tid < 64) hist[F.tid] = 0;
    __syncthreads();
    const int NTILE = TT / 16;
    for (int tile = F.wg; tile < NTILE; tile += F.G) {
        const int row = tile * 16 + tk; const int s = slot_of_row(tile * 16);
        const float* ab = (const float*)(F.ws + OFF_AB) + (size_t)(l * 5 + s) * 2048;
        const float* xr = F.X + (size_t)row * DM + F.wave * 128 + g * 8;
        f32x4 v[4][2];
#pragma unroll
        for (int ks = 0; ks < 4; ++ks) { v[ks][0] = *(const f32x4*)(xr + ks * 32); v[ks][1] = *(const f32x4*)(xr + ks * 32 + 4); }
        float sum = 0.f, sq = 0.f;
#pragma unroll
        for (int ks = 0; ks < 4; ++ks)
#pragma unroll
            for (int hh = 0; hh < 2; ++hh) { const f32x4 a = v[ks][hh]; sum += (a[0] + a[1]) + (a[2] + a[3]); sq += (a[0] * a[0] + a[1] * a[1]) + (a[2] * a[2] + a[3] * a[3]); }
        sum += __shfl_xor(sum, 16); sum += __shfl_xor(sum, 32); sq += __shfl_xor(sq, 16); sq += __shfl_xor(sq, 32);
        if (g == 0) *(LAS f32x2*)(part + (F.wave * 16 + tk) * 2) = (f32x2){sum, sq};
        __syncthreads();
        float ts = 0.f, tq = 0.f;
#pragma unroll
        for (int w = 0; w < 8; ++w) { const f32x2 p = *(const LAS f32x2*)(part + (w * 16 + tk) * 2); ts += p.x; tq += p.y; }
        const float mean = ts * (1.0f / 1024.0f), var = fmaxf(tq * (1.0f / 1024.0f) - mean * mean, 0.f), rstd = rsqrtf(var + 1e-5f);
        if (F.wave == 0 && g == 0) *(f32x2*)(stats + (size_t)row * 2) = (f32x2){mean, rstd};
        f32x4 acc[4];
#pragma unroll
        for (int et = 0; et < 4; ++et) acc[et] = (f32x4){0.f, 0.f, 0.f, 0.f};
#pragma unroll
        for (int ks = 0; ks < 4; ++ks) { const int k = F.wave * 128 + ks * 32 + g * 8;
            const f32x4 a10 = *(const f32x4*)(ab + k), a11 = *(const f32x4*)(ab + k + 4), b10 = *(const f32x4*)(ab + 1024 + k), b11 = *(const f32x4*)(ab + 1024 + k + 4);
            const f32x4 h0 = (v[ks][0] - mean) * rstd * a10 + b10, h1 = (v[ks][1] - mean) * rstd * a11 + b11;
            u32x4 w; w.x = cvt_pk_bf16(h0[0], h0[1]); w.y = cvt_pk_bf16(h0[2], h0[3]); w.z = cvt_pk_bf16(h1[0], h1[1]); w.w = cvt_pk_bf16(h1[2], h1[3]);
            *(u32x4*)(F.HB + (size_t)row * DM + k) = w;
            bf16x8 af; __builtin_memcpy(&af, &w, 16);
#pragma unroll
            for (int et = 0; et < 4; ++et) { const bf16x8 bf = *(const bf16x8*)(RW + (size_t)(et * 16 + tk) * 1024 + k); acc[et] = __builtin_amdgcn_mfma_f32_16x16x32_bf16(af, bf, acc[et], 0, 0, 0); }
        }
#pragma unroll
        for (int et = 0; et < 4; ++et)
#pragma unroll
            for (int i = 0; i < 4; ++i) LP[(F.wave * 16 + 4 * g + i) * 64 + et * 16 + tk] = acc[et][i];
        __syncthreads();
        {
            const int t = 2 * F.wave + (g & 1), r2 = tile * 16 + t;
            float sc[4], key[4];
#pragma unroll
            for (int q = 0; q < 4; ++q) { float lgt = 0.f;
#pragma unroll
                for (int w = 0; w < 8; ++w) lgt += LP[(w * 16 + t) * 64 + tk + 16 * q];
                sc[q] = sigmoidf_(lgt); key[q] = sc[q] + rb[q]; }
            unsigned taken = 0u; int se[6]; float ss[6]; float tot = 0.f;
#pragma unroll
            for (int sel = 0; sel < 6; ++sel) {
                float bk = -1e30f, bs = 0.f; int be = 0;
#pragma unroll
                for (int q = 0; q < 4; ++q) if (!((taken >> q) & 1u) && key[q] > bk) { bk = key[q]; be = tk + 16 * q; bs = sc[q]; }
                topk_step<0xB1>(bk, be, bs); topk_step<0x4E>(bk, be, bs); topk_step<0x141>(bk, be, bs); topk_step<0x140>(bk, be, bs);
                if ((be & 15) == tk) taken |= 1u << (be >> 4);
                se[sel] = be; ss[sel] = bs; tot += bs;
            }
            const float sc2 = 2.5f / tot;
            if (tk < 6 && g < 2) {
                int e = se[0]; float w = ss[0];
#pragma unroll
                for (int q = 1; q < 6; ++q) if (tk == q) { e = se[q]; w = ss[q]; }
                tok_e[r2 * 8 + tk] = e; tok_w[r2 * 8 + tk] = w * sc2; if (!dry) tok_p[r2 * 8 + tk] = __hip_atomic_fetch_add(hist + e, 1, __ATOMIC_RELAXED, __HIP_MEMORY_SCOPE_WORKGROUP);
            }
        }
    }
    asm volatile("s_waitcnt vmcnt(0) lgkmcnt(0)" ::: "memory");
    __syncthreads();
    if (dry) return;
    if (F.tid < 64) hbase[F.tid] = (int)__hip_atomic_fetch_add(gcnt + F.tid, (unsigned)hist[F.tid], __ATOMIC_RELAXED, __HIP_MEMORY_SCOPE_AGENT);
    __syncthreads();
    for (int tile = F.wg; tile < NTILE; tile += F.G) {
        if (F.tid < 96) { const int row = tile * 16 + F.tid / 6, q = F.tid % 6; const int e = tok_e[row * 8 + q]; const int pos = hbase[e] + tok_p[row * 8 + q];
            tok_p[row * 8 + q] = pos; stok[(size_t)e * CAP + pos] = row; sw[(size_t)e * CAP + pos] = tok_w[row * 8 + q]; }
    }
    __syncthreads();
}

__device__ __forceinline__ int moe_tables(const Frame& F, int l) {
    LAS int* cnt = (LAS int*)(F.lds + LDS_MISC + MISC_CNT); LAS int* tst = (LAS int*)(F.lds + LDS_MISC + MISC_TST); LAS unsigned char* t2e = (LAS unsigned char*)(F.lds + LDS_MISC + MISC_T2E);
    const unsigned* gcnt = (const unsigned*)(F.ws + OFF_CTL + CTL_CNT) + l * 64;
    __syncthreads();
    if (F.tid < 64) cnt[F.tid] = (int)__hip_atomic_load(gcnt + F.tid, __ATOMIC_RELAXED, __HIP_MEMORY_SCOPE_AGENT);
    if (F.tid == 64) cnt[64] = TT;
    __syncthreads();
    if (F.tid == 0) { int s = 0; for (int e = 0; e < 65; ++e) { tst[e] = s; s += (cnt[e] + 255) >> 8; } tst[65] = s; }
    __syncthreads();
    const int ntiles = tst[65];
    for (int t = F.tid; t < ntiles; t += 512) { int e = 0; for (int q = 0; q < 65; ++q) if (t >= tst[q]) e = q; else break; t2e[t] = (unsigned char)e; }
    __syncthreads();
    return ntiles;
}

__device__ __forceinline__ void ph_combine(const Frame& F, int l, bool dry = false) {
    LAS int* tst = (LAS int*)(F.lds + LDS_MISC + MISC_TST);
    (void)moe_tables(F, l);
    const float* gam = inp(F, 6) + (size_t)(l * 2 + 1) * DM; const float* bet = inp(F, 7) + (size_t)(l * 2 + 1) * DM;
    const float* gam0 = inp(F, 6) + (size_t)(l * 2 + 0) * DM; const float* bet0 = inp(F, 7) + (size_t)(l * 2 + 0) * DM;
    const float* stats = (const float*)(F.ws + OFF_STATS);
    const unsigned char* Y = (const unsigned char*)(F.R1 + R1_Y);
    const int* tok_e = (const int*)(F.ws + OFF_TOKE); const int* tok_p = (const int*)(F.ws + OFF_TOKP);
    const int gw = F.wg * 8 + F.wave, nw = F.G * 8;
    const bool lastl = (l == 3);
    for (int row = gw; row < TT; row += nw) {
        const int s = slot_of_row(row);
        const float* m = F.mods + (size_t)(l * 5 + s) * 6144;
        const float* mn = F.mods + (size_t)((lastl ? l : l + 1) * 5 + s) * 6144;
        int srow[7];
#pragma unroll
        for (int q = 0; q < 6; ++q) { const int e = tok_e[row * 8 + q]; srow[q] = tst[e] * 256 + tok_p[row * 8 + q]; }
        srow[6] = tst[64] * 256 + row;
        float v[16];
#pragma unroll
        for (int hh = 0; hh < 2; ++hh) { const int k = hh * 512 + F.lane * 8;
            float y[8];
#pragma unroll
            for (int q = 0; q < 8; ++q) y[q] = 0.f;
#pragma unroll
            for (int q = 0; q < 7; ++q) { const u32x2 w = *(const u32x2*)(Y + (size_t)srow[q] * DM + k);
                const f32x2 t0 = __builtin_amdgcn_cvt_pk_f32_fp8((int)w.x, false), t1 = __builtin_amdgcn_cvt_pk_f32_fp8((int)w.x, true), t2 = __builtin_amdgcn_cvt_pk_f32_fp8((int)w.y, false), t3 = __builtin_amdgcn_cvt_pk_f32_fp8((int)w.y, true);
                y[0] += t0.x; y[1] += t0.y; y[2] += t1.x; y[3] += t1.y; y[4] += t2.x; y[5] += t2.y; y[6] += t3.x; y[7] += t3.y; }
#pragma unroll
            for (int i = 0; i < 8; ++i) y[i] *= (1.0f / 32.0f);
            f32x4 x0 = *(const f32x4*)(F.X + (size_t)row * DM + k), x1 = *(const f32x4*)(F.X + (size_t)row * DM + k + 4);
            { const f32x2 st = *(const f32x2*)(stats + (size_t)row * 2); const f32x4 g0 = *(const f32x4*)(gam0 + k), g1 = *(const f32x4*)(gam0 + k + 4), b0 = *(const f32x4*)(bet0 + k), b1 = *(const f32x4*)(bet0 + k + 4);
              x0 = (x0 - st.x) * st.y * g0 + b0; x1 = (x1 - st.x) * st.y * g1 + b1; }
            const f32x4 m50 = *(const f32x4*)(m + 5 * 1024 + k), m51 = *(const f32x4*)(m + 5 * 1024 + k + 4);
#pragma unroll
            for (int i = 0; i < 4; ++i) { v[hh * 8 + i] = ALPHA * x0[i] + m50[i] * y[i]; v[hh * 8 + 4 + i] = ALPHA * x1[i] + m51[i] * y[4 + i]; }
        }
        float sum = 0.f;
#pragma unroll
        for (int i = 0; i < 16; ++i) sum += v[i];
        sum += __shfl_xor(sum, 1); sum += __shfl_xor(sum, 2); sum += __shfl_xor(sum, 4); sum += __shfl_xor(sum, 8); sum += __shfl_xor(sum, 16); sum += __shfl_xor(sum, 32);
        const float mean = sum * (1.0f / 1024.0f);
        float sq = 0.f;
#pragma unroll
        for (int i = 0; i < 16; ++i) { const float d = v[i] - mean; sq += d * d; }
        sq += __shfl_xor(sq, 1); sq += __shfl_xor(sq, 2); sq += __shfl_xor(sq, 4); sq += __shfl_xor(sq, 8); sq += __shfl_xor(sq, 16); sq += __shfl_xor(sq, 32);
        const float rstd = rsqrtf(sq * (1.0f / 1024.0f) + 1e-5f);
#pragma unroll
        for (int hh = 0; hh < 2; ++hh) { const int k = hh * 512 + F.lane * 8;
            float gm[8], bt[8], xn[8];
            *(f32x4*)&gm[0] = *(const f32x4*)(gam + k); *(f32x4*)&gm[4] = *(const f32x4*)(gam + k + 4);
            *(f32x4*)&bt[0] = *(const f32x4*)(bet + k); *(f32x4*)&bt[4] = *(const f32x4*)(bet + k + 4);
#pragma unroll
            for (int i = 0; i < 8; ++i) xn[i] = (v[hh * 8 + i] - mean) * rstd * gm[i] + bt[i];
            if (dry) { float acc_ = 0.f; for (int i = 0; i < 8; ++i) acc_ += xn[i]; asm volatile("" :: "v"(acc_)); }
            else if (lastl) { if (row >= TC) { float* o = F.out + (size_t)(row - TC) * DM + k; *(f32x4*)o = *(f32x4*)&xn[0]; *(f32x4*)(o + 4) = *(f32x4*)&xn[4]; } }
            else {
                *(f32x4*)(F.X + (size_t)row * DM + k) = *(f32x4*)&xn[0]; *(f32x4*)(F.X + (size_t)row * DM + k + 4) = *(f32x4*)&xn[4];
                float s1[8], b0[8];
                *(f32x4*)&s1[0] = *(const f32x4*)(mn + 1024 + k); *(f32x4*)&s1[4] = *(const f32x4*)(mn + 1024 + k + 4);
                *(f32x4*)&b0[0] = *(const f32x4*)(mn + k); *(f32x4*)&b0[4] = *(const f32x4*)(mn + k + 4);
                float hv[8];
#pragma unroll
                for (int i = 0; i < 8; ++i) hv[i] = xn[i] * (1.0f + s1[i]) + b0[i];
                u32x4 w; w.x = cvt_pk_bf16(hv[0], hv[1]); w.y = cvt_pk_bf16(hv[2], hv[3]); w.z = cvt_pk_bf16(hv[4], hv[5]); w.w = cvt_pk_bf16(hv[6], hv[7]);
                *(u32x4*)(F.HB + (size_t)row * DM + k) = w;
            }
        }
    }
}

constexpr int NPHASE = 2 + 4 * 10;
__global__ void __launch_bounds__(512, 2) mk_fwd(Args args) {
    extern __shared__ __attribute__((aligned(16))) unsigned char lds_raw[];
    Frame F;
    F.out = args.out; F.ws = args.ws; F.lds = (LAS unsigned char*)lds_raw;
    { const int t0 = threadIdx.x; F.wave = __builtin_amdgcn_readfirstlane(t0 >> 6); F.lane = t0 & 63; F.tid = t0; } F.G = gridDim.x; F.wg = blockIdx.x;
    F.mods = (float*)(args.ws + OFF_MODS); F.X = (float*)(args.ws + OFF_X); F.HB = (bf16_t*)(args.ws + OFF_HB); F.MIX = F.HB;
    F.WB = args.ws + OFF_WB; F.R1 = args.ws + OFF_R1;
    volatile LAS unsigned* xbw = (volatile LAS unsigned*)(F.lds + LDS_MISC);
    if (F.tid < 4) xbw[F.tid] = 0u;
    if (F.tid < 30) ((LAS unsigned long long*)(F.lds + LDS_MISC + MISC_INP))[F.tid] = (unsigned long long)args.in[F.tid];
    __syncthreads();
    const int lo = args.ph_lo, hi = args.ph_hi;
    XcdBarrier bar; bar.bar = (unsigned*)(args.ws + OFF_CTL); bar.x = 0; bar.st = xbw;
    if (hi - lo > 1) bar = xcd_barrier_post((unsigned*)(args.ws + OFF_CTL), xbw);
#define IN(k) (lo <= (k) && (k) < hi)
#define SEAM(k) do { if (IN(k) && IN((k) + 1)) { xcd_barrier(bar); if (REPM & 1) xcd_barrier(bar); } } while (0)
    if ((PHM & 1) && IN(0)) { ph_mods(fresh(F)); } SEAM(0);
    if ((PHM & 2) && IN(1)) { ph_init_x(fresh(F)); }
    for (int l = 0; l < 4; ++l) {
        const int pb = 2 + l * 10, j = l >> 1; const bool even = (l & 1) == 0;
        float* mods_l = F.mods + (size_t)l * 5 * 6144;
        if ((PHM & 4) && IN(pb + 0)) { for (int rep = 0; rep < ((REPM & 4) ? 2 : 1); ++rep) { ph_convert(fresh(F), l); __syncthreads(); } } SEAM(pb + 0);
        if ((PHM & 8) && IN(pb + 1)) {
            const int N = even ? 4096 : 2048;
            pg8::StaticOrder S; S.init(F.HB, F.WB + WB_IN, TT, N, 1024, F.G, F.wg);
            pg8::EpiStoreBf16 E{(bf16_t*)(F.R1 + R1_P), N};
            for (int rep = 0; rep < ((REPM & 8) ? 2 : 1); ++rep) pg8::gemm_phase(F.lds, 1024, S, E, F.wave);
        } SEAM(pb + 1);
        if (IN(pb + 2)) { if (even) { if (PHM & 16) for (int rep = 0; rep < ((REPM & 16) ? 2 : 1); ++rep) ph_attn(fresh(F), j); if (PHM & 32) for (int rep = 0; rep < ((REPM & 32) ? 2 : 1); ++rep) ph_hg_a(fresh(F), j); } else { if (PHM & 64) for (int rep = 0; rep < ((REPM & 64) ? 2 : 1); ++rep) ph_lru_a(fresh(F), j); } } SEAM(pb + 2);
        if (IN(pb + 3)) { if (even) { if (PHM & 128) for (int rep = 0; rep < ((REPM & 128) ? 2 : 1); ++rep) { ph_hg_b(fresh(F)); ph_hg_c_ctx(fresh(F), j); } } else { if (PHM & 256) for (int rep = 0; rep < ((REPM & 256) ? 2 : 1); ++rep) ph_lru_b(fresh(F)); } } SEAM(pb + 3);
        if (IN(pb + 4)) { if (even) { if (PHM & 512) for (int rep = 0; rep < ((REPM & 512) ? 2 : 1); ++rep) ph_hg_c(fresh(F), j); } else { if (PHM & 1024) for (int rep = 0; rep < ((REPM & 1024) ? 2 : 1); ++rep) ph_lru_c(fresh(F)); } } SEAM(pb + 4);
        if ((PHM & 2048) && IN(pb + 5)) {
            pg8::StaticOrder S; S.init(F.MIX, F.WB + WB_OUT, TT, 1024, 1024, F.G, F.wg);
            pg8::EpiResid E{F.X, mods_l};
            pg8::gemm_phase(F.lds, 1024, S, E, F.wave);
        } SEAM(pb + 5);
        if ((PHM & 4096) && IN(pb + 6)) { if (REPM & 4096) ph_ln_router(fresh(F), l, true); ph_ln_router(fresh(F), l); } SEAM(pb + 6);
        if ((PHM & 8192) && IN(pb + 7)) {
            const int ntiles = moe_tables(fresh(F), l);
            pg8::MoeGU S; S.cnt = (const LAS int*)(F.lds + LDS_MISC + MISC_CNT); S.tst = (const LAS int*)(F.lds + LDS_MISC + MISC_TST); S.t2e = (const LAS unsigned char*)(F.lds + LDS_MISC + MISC_T2E);
            S.ntiles = ntiles; S.G = F.G; S.c = F.wg; S.A = (const char*)F.HB; S.Bt = (const char*)(F.WB + WB_GU); S.stok = (const int*)(F.ws + OFF_STOK);
            pg8::EpiSwiglu E{(bf16_t*)(F.R1 + R1_H)};
            for (int rep = 0; rep < ((REPM & 8192) ? 2 : 1); ++rep) pg8::gemm_phase(F.lds, 1024, S, E, F.wave);
        } SEAM(pb + 7);
        if ((PHM & 16384) && IN(pb + 8)) {
            const int ntiles = moe_tables(fresh(F), l);
            pg8::MoeDN S; S.cnt = (const LAS int*)(F.lds + LDS_MISC + MISC_CNT); S.tst = (const LAS int*)(F.lds + LDS_MISC + MISC_TST); S.t2e = (const LAS unsigned char*)(F.lds + LDS_MISC + MISC_T2E);
            S.ntiles = ntiles; S.G = F.G; S.c = F.wg; S.A = (const char*)(F.R1 + R1_H); S.Bt = (const char*)(F.WB + WB_DN);
            pg8::EpiDown E{(unsigned char*)(F.R1 + R1_Y), (const float*)(F.ws + OFF_SW), (const LAS int*)(F.lds + LDS_MISC + MISC_CNT)};
            for (int rep = 0; rep < ((REPM & 16384) ? 2 : 1); ++rep) pg8::gemm_phase(F.lds, 256, S, E, F.wave);
        } SEAM(pb + 8);
        if ((PHM & 32768) && IN(pb + 9)) { if (REPM & 32768) ph_combine(fresh(F), l, true); ph_combine(fresh(F), l); } SEAM(pb + 9);
    }
#undef IN
#undef SEAM
}

extern "C" void kernel_launch(void* const* d_in, const int* in_sizes, int n_in, void* d_out, int out_size, void* d_ws, size_t ws_size, hipStream_t stream) {
    static int grid = 0;
    if (grid == 0) {
        if (n_in != 30 || out_size != TX * DM || ws_size < WS_END) { fprintf(stderr, "kernel_launch: unexpected problem (n_in %d out %d ws %zu need %zu)\n", n_in, out_size, ws_size, (size_t)WS_END); grid = -1; return; }
        int dev = 0, cus = 0, per_cu = 0;
        if (hipGetDevice(&dev) != hipSuccess || hipDeviceGetAttribute(&cus, hipDeviceAttributeMultiprocessorCount, dev) != hipSuccess) { grid = -1; return; }
        if (hipFuncSetAttribute((const void*)mk_fwd, hipFuncAttributeMaxDynamicSharedMemorySize, LDS_BYTES) != hipSuccess) { fprintf(stderr, "kernel_launch: hipFuncSetAttribute failed\n"); grid = -1; return; }
        if (hipOccupancyMaxActiveBlocksPerMultiprocessor(&per_cu, (const void*)mk_fwd, 512, LDS_BYTES) != hipSuccess || per_cu < 1) { fprintf(stderr, "kernel_launch: occupancy query says %d\n", per_cu); }
        (void)hipGetLastError();
        grid = cus;
    }
    if (grid < 0) return;
    (void)hipMemsetAsync((char*)d_ws + OFF_CTL, 0, CTL_BYTES, stream);
    Args a{};
    for (int i = 0; i < 30; ++i) a.in[i] = (const float*)d_in[i];
    a.out = (float*)d_out; a.ws = (unsigned char*)d_ws;
#if MK_SPLIT
    for (int p = 0; p < NPHASE; ++p) { a.ph_lo = p; a.ph_hi = p + 1; hipLaunchKernelGGL(mk_fwd, dim3(grid), dim3(512), LDS_BYTES, stream, a); }
#else
    a.ph_lo = 0; a.ph_hi = NPHASE;
    hipLaunchKernelGGL(mk_fwd, dim3(grid), dim3(512), LDS_BYTES, stream, a);
#endif
}
```

```cpp
#include <hip/hip_runtime.h>
#include <cstdio>
#include <cstdint>

#ifndef PHM
#define PHM 0xFFFF
#endif
#ifndef REPM
#define REPM 0
#endif
#ifndef MK_SPLIT
#define MK_SPLIT 0
#endif

typedef unsigned short bf16_t;
typedef short bf16x8 __attribute__((ext_vector_type(8)));
typedef short bf16x4 __attribute__((ext_vector_type(4)));
typedef float f32x4 __attribute__((ext_vector_type(4)));
typedef float f32x2 __attribute__((ext_vector_type(2)));
typedef unsigned u32x4 __attribute__((ext_vector_type(4)));
typedef unsigned u32x2 __attribute__((ext_vector_type(2)));
#define LAS __attribute__((address_space(3)))

constexpr int DM = 1024, NBAT = 4, SEQ = 8192, CTXL = 256;
constexpr int TC = NBAT * CTXL, TX = NBAT * SEQ, TT = TC + TX;
constexpr int NEXP = 64, TOPK = 6;
constexpr int CAP = TT;
constexpr int MOE_ROUTED_ROWS = 6 * TT + 64 * 256;
constexpr int MOE_ROWS = MOE_ROUTED_ROWS + TT;
constexpr int MOE_MAXTILES = MOE_ROWS / 256;
constexpr float ALPHA = 1.681792830507429f;
constexpr int HG_U = 128, HG_NU = (CTXL + SEQ) / HG_U;
constexpr int LRU_NT = (CTXL + SEQ) / 16;

constexpr size_t OFF_CTL = 0, CTL_BYTES = 65536;
constexpr size_t CTL_CNT = 16384, CTL_DBG = 20480;
constexpr size_t OFF_MODS = 65536;
constexpr size_t OFF_LBT = OFF_MODS + 4 * 5 * 6144 * 4;
constexpr size_t OFF_STATS = OFF_LBT + 8192;
constexpr size_t OFF_AB = OFF_STATS + (size_t)TT * 8;
static_assert(OFF_AB + 4 * 5 * 2 * 1024 * 4 <= (1u << 20), "ctl map");
constexpr size_t OFF_TOKE = 1u << 20;
constexpr size_t OFF_TOKP = OFF_TOKE + (size_t)TT * 32;
constexpr size_t OFF_TOKW = OFF_TOKP + (size_t)TT * 32;
constexpr size_t OFF_STOK = OFF_TOKW + (size_t)TT * 32;
constexpr size_t OFF_SW = OFF_STOK + (size_t)64 * CAP * 4;
constexpr size_t OFF_X = OFF_SW + (size_t)64 * CAP * 4;
constexpr size_t OFF_HB = OFF_X + (size_t)TT * DM * 4;
constexpr size_t OFF_WB = OFF_HB + (size_t)TT * DM * 2;
constexpr size_t WB_IN = 0, WB_OUT = WB_IN + (size_t)4096 * 1024 * 2, WB_RT = WB_OUT + (size_t)1024 * 1024 * 2, WB_GU = WB_RT + (size_t)64 * 1024 * 2,
                 WB_DN = WB_GU + (size_t)65 * 512 * 1024 * 2, WB_LRU = WB_DN + (size_t)65 * 1024 * 256 * 2, WB_END = WB_LRU + (size_t)2 * 2 * 16 * 64 * 64 * 2;
constexpr size_t OFF_R1 = OFF_WB + WB_END;
constexpr size_t R1_P = 0;
constexpr size_t R1_OF = R1_P + (size_t)TT * 4096 * 2;
constexpr size_t R1_SLOC = R1_OF + (size_t)TT * 512 * 4;
constexpr size_t R1_SST = R1_SLOC + (size_t)64 * HG_NU * 4096 * 4;
constexpr size_t R1_DL = R1_SST + (size_t)64 * HG_NU * 4096 * 4;
constexpr size_t R1_MOE_END_FWD = (size_t)MOE_ROWS * 256 * 2 + (size_t)MOE_ROWS * 1024 * 2;
constexpr size_t R1_AG = R1_OF;
constexpr size_t R1_HST = R1_AG + (size_t)4 * 2 * LRU_NT * 2 * 1024 * 4;
constexpr size_t R1_GX = R1_HST + (size_t)4 * 2 * LRU_NT * 1024 * 4;
static_assert(R1_GX + (size_t)TT * 2 * 1024 * 2 * 2 <= R1_MOE_END_FWD, "lru gx");
constexpr size_t R1_H = 0;
constexpr size_t R1_Y = R1_H + (size_t)MOE_ROWS * 256 * 2;
constexpr size_t R1_MOE_END = R1_Y + (size_t)MOE_ROWS * 1024 * 2;
constexpr size_t R1_MIX_END = R1_DL + (size_t)64 * HG_NU * 64 * 4;
constexpr size_t WS_END = OFF_R1 + (R1_MOE_END > R1_MIX_END ? R1_MOE_END : R1_MIX_END);

constexpr int LDS_STAGE = 131072;
constexpr int LDS_MISC = LDS_STAGE;
constexpr int MISC_CNT = 64;
constexpr int MISC_TST = MISC_CNT + 66 * 4 + 8;
constexpr int MISC_HIST = 640;
constexpr int MISC_HBASE = 896;
constexpr int MISC_T2E = 1152;
constexpr int MISC_INP = 2304;
constexpr int LDS_BYTES = 147456;

#define XB_TMO      128
#define XB_XCNT(j)  (256  + 64 * (j))
#define XB_XSUB(j)  (1280 + 64 * (j))
#define XB_XGEN(j)  (2304 + 64 * (j))
#define XB_TOP      3328
#define XB_TOPGEN   3392
#define XCD_BAR_WORDS 3456
#define XB_SPIN_CAP (1u << 22)
__device__ __forceinline__ unsigned xb_ld(unsigned* p)              { return __hip_atomic_load(p, __ATOMIC_RELAXED, __HIP_MEMORY_SCOPE_AGENT); }
__device__ __forceinline__ unsigned xb_add(unsigned* p, unsigned v) { return __hip_atomic_fetch_add(p, v, __ATOMIC_RELAXED, __HIP_MEMORY_SCOPE_AGENT); }
__device__ __forceinline__ unsigned xb_xcc_id() { return (unsigned)__builtin_amdgcn_s_getreg((3 << 11) | 20) & 0xFu; }
#define XB_SPIN(cond, bar) do { unsigned _sp = 0; while (cond) { __builtin_amdgcn_s_sleep(1); \
    if ((++_sp & 255u) == 0u) { if (xb_ld(&(bar)[XB_TMO])) break; if (_sp > XB_SPIN_CAP) { atomicAdd(&(bar)[XB_TMO], 1u); break; } } } } while (0)
struct XcdBarrier { unsigned* bar; unsigned x; volatile LAS unsigned* st; };
__device__ __forceinline__ XcdBarrier xcd_barrier_post(unsigned* bar, volatile LAS unsigned* st) {
    XcdBarrier b; b.bar = bar; b.x = xb_xcc_id(); b.st = st;
    if (threadIdx.x == 0) (void)xb_add(&bar[XB_XCNT(b.x)], 1u);
    return b;
}
__device__ __forceinline__ void xcd_barrier_complete(unsigned* bar, unsigned x, unsigned& nloc, unsigned& nx) {
    const unsigned G = gridDim.x * gridDim.y * gridDim.z;
    unsigned sum, cnt, mine, sp = 0u;
    for (;;) {
        sum = 0u; cnt = 0u; mine = 0u;
#pragma unroll
        for (unsigned j = 0; j < 16; ++j) { const unsigned c = xb_ld(&bar[XB_XCNT(j)]); sum += c; cnt += (c > 0u) ? 1u : 0u; mine = (j == x) ? c : mine; }
        if (sum == G) break;
        __builtin_amdgcn_s_sleep(1);
        if ((++sp & 255u) == 0u) { if (xb_ld(&bar[XB_TMO])) break; if (sp > XB_SPIN_CAP) { atomicAdd(&bar[XB_TMO], 1u); break; } }
    }
    nloc = mine > 0u ? mine : 1u; nx = cnt > 0u ? cnt : 1u;
}
__device__ __forceinline__ void xcd_barrier(const XcdBarrier& b) {
    asm volatile("s_waitcnt vmcnt(0)" ::: "memory");
    __syncthreads();
    if (threadIdx.x == 0) {
        unsigned* bar = b.bar;
        __builtin_amdgcn_s_waitcnt(0);
        unsigned nloc = b.st[0], nx = b.st[1];
        if (nloc == 0u) { xcd_barrier_complete(bar, b.x, nloc, nx); b.st[0] = nloc; b.st[1] = nx; }
        const unsigned old = xb_add(&bar[XB_XSUB(b.x)], 1u);
        const unsigned gen = old / nloc;
        if (old + 1u == (gen + 1u) * nloc) {
            __builtin_amdgcn_fence(__ATOMIC_RELEASE, "agent");
            asm volatile("s_waitcnt vmcnt(0)" ::: "memory");
            const unsigned og = xb_add(&bar[XB_TOP], 1u);
            const unsigned tg = og / nx;
            if (og + 1u == (tg + 1u) * nx) xb_add(&bar[XB_TOPGEN], 1u);
            else XB_SPIN(xb_ld(&bar[XB_TOPGEN]) == tg, bar);
            __builtin_amdgcn_fence(__ATOMIC_ACQUIRE, "agent");
            xb_add(&bar[XB_XGEN(b.x)], 1u);
            asm volatile("s_waitcnt vmcnt(0)" ::: "memory");
        } else {
            XB_SPIN(xb_ld(&bar[XB_XGEN(b.x)]) == gen, bar);
            __builtin_amdgcn_fence(__ATOMIC_ACQUIRE, "agent");
            asm volatile("s_waitcnt vmcnt(0)" ::: "memory");
        }
    }
    __syncthreads();
}

__device__ __forceinline__ float bf2f(unsigned short b) { return __uint_as_float(((unsigned)b) << 16); }
__device__ __forceinline__ unsigned cvt_pk_bf16(float lo, float hi) { unsigned r; asm volatile("v_cvt_pk_bf16_f32 %0, %1, %2" : "=v"(r) : "v"(lo), "v"(hi)); return r; }
__device__ __forceinline__ unsigned short f2bf(float f) { return (unsigned short)(cvt_pk_bf16(f, 0.f) & 0xffffu); }
__device__ __forceinline__ float sigmoidf_(float x) { return __builtin_amdgcn_rcpf(1.0f + __expf(-x)); }
__device__ __forceinline__ float siluf_(float x) { return x * sigmoidf_(x); }
__device__ __forceinline__ float gelu_tanh_(float x) { return x * sigmoidf_(1.5957691216057308f * (x + 0.044715f * x * x * x)); }
__device__ __forceinline__ int slot_of_row(int r) { return r < TC ? 4 : ((r - TC) >> 13); }
template <int CTRL> __device__ __forceinline__ float dppf(float oldv, float src) {
    return __int_as_float(__builtin_amdgcn_update_dpp(__float_as_int(oldv), __float_as_int(src), CTRL, 0xf, 0xf, false));
}
__device__ __forceinline__ void unpack8(const u32x4 w, float (&o)[8]) {
    o[0] = __uint_as_float(w.x << 16); o[1] = __uint_as_float(w.x & 0xffff0000u); o[2] = __uint_as_float(w.y << 16); o[3] = __uint_as_float(w.y & 0xffff0000u);
    o[4] = __uint_as_float(w.z << 16); o[5] = __uint_as_float(w.z & 0xffff0000u); o[6] = __uint_as_float(w.w << 16); o[7] = __uint_as_float(w.w & 0xffff0000u);
}

namespace pg8 {
constexpr int BM = 256, BK = 64, HALF = 128, HTB = HALF * BK * 2, STAGE_BYTES = 8 * HTB, NXCD = 8, WGM = 8;
__device__ __forceinline__ int lds_byte(int r, int c) { const int st = (r >> 4) * 2 + (c >> 5), rr = r & 15, cc = c & 31, ob = rr * 64 + cc * 2; return st * 1024 + (ob ^ (((ob >> 9) & 1) << 5)); }
__device__ __forceinline__ void stage_rc(int b, int& R, int& C) { const int st = b / 1024, sb = b % 1024, swz = sb ^ (((sb >> 9) & 1) << 5); R = (st >> 1) * 16 + swz / 64; C = (st & 1) * 32 + (swz % 64) / 2; }
__device__ __forceinline__ int perm32(int rho) { const int n = rho >> 4, i = rho & 15; return 8 * (i >> 2) + 4 * n + (i & 3); }
struct Unit { int pm, pn, e, ti; };

struct StaticOrder {
    const char* A; const char* Bt; int K;
    int nM, nN, nwg, G, c;
    __device__ __forceinline__ void init(const void* A_, const void* Bt_, int M, int N, int K_, int G_, int c_) { A = (const char*)A_; Bt = (const char*)Bt_; K = K_; nM = M / BM; nN = N / BM; nwg = nM * nN; G = G_; c = c_; }
    __device__ __forceinline__ bool next(int i, Unit& u) const {
        const long L = (long)i * G + c; if (L >= nwg) return false;
        int wgid = (int)L; { const int q = nwg / NXCD, r = nwg % NXCD, xcd = wgid % NXCD, off = wgid / NXCD; wgid = (xcd < r ? xcd * (q + 1) : r * (q + 1) + (xcd - r) * q) + off; }
        const int nig = WGM * nN, gid = wgid / nig, fm = gid * WGM, gsz = (nM - fm) < WGM ? (nM - fm) : WGM;
        u.pm = fm + ((wgid % nig) % gsz); u.pn = (wgid % nig) / gsz; u.e = 0; u.ti = 0; return true;
    }
    static constexpr bool GATHER = false;
    __device__ __forceinline__ const char* abase(const Unit& u) const { return A + (size_t)u.pm * BM * K * 2; }
    __device__ __forceinline__ const char* bbase(const Unit& u) const { return Bt + (size_t)u.pn * BM * K * 2; }
};

template <class Epi, class Sched>
__device__ __forceinline__ void gemm_phase(LAS unsigned char* lds, const int K_, const Sched& S, const Epi& E, const int wave_) {
    int Kl_ = K_; asm volatile("" : "+s"(Kl_)); const int K = Kl_;
    int tid_ = wave_ * 64 + (int)__builtin_amdgcn_mbcnt_hi(~0u, __builtin_amdgcn_mbcnt_lo(~0u, 0u)); asm volatile("" : "+v"(tid_));
    const int tid = tid_, wid = __builtin_amdgcn_readfirstlane(tid >> 6), lane = tid & 63, wr = wid >> 2, wc = wid & 3, fr = lane & 15, fq = lane >> 4;
    const int nt = K / BK;
    unsigned voffA[2], voffB[2];
#pragma unroll
    for (int i = 0; i < 2; ++i) { int R, C; stage_rc(tid * 16 + i * 8192, R, C); const int Rb = Epi::PERM ? ((R & ~31) + perm32(R & 31)) : R; voffA[i] = (unsigned)(R * K + C) * 2u; voffB[i] = (unsigned)(Rb * K + C) * 2u; }
    const size_t kstep = (size_t)(BK * 2);
    const size_t hstep = (size_t)HALF * K * 2;
    const unsigned ldsw = (unsigned)wid * 1024u;
    const int aoff = lds_byte(wr * 64 + fr, fq * 8), boff = lds_byte(wc * 32 + fr, fq * 8);
#define PG8_SA(b, h) (((b) * 2 + (h)) * HTB)
#define PG8_SB(b, h) ((4 + (b) * 2 + (h)) * HTB)
#define PG8_STAGE(bufoff, gbase, voff) do { _Pragma("unroll") for (int _i = 0; _i < 2; ++_i) \
        __builtin_amdgcn_global_load_lds((const unsigned*)((const char*)(gbase) + (voff)[_i]), (LAS unsigned*)(lds + (bufoff) + ldsw + _i * 8192), 16, 0, 0); } while (0)
#define PG8_STAGEA(bufoff, hh, kb, nx) do { if constexpr (Sched::GATHER) { unsigned _o[2]; _o[0] = (nx) ? vN[hh][0] : vC[hh][0]; _o[1] = (nx) ? vN[hh][1] : vC[hh][1]; PG8_STAGE(bufoff, cA + (kb), _o); } \
        else { PG8_STAGE(bufoff, ((nx) ? nA : cA) + (hh) * hstep + (kb), voffA); } } while (0)
#define PG8_LDA(dst, b, h) do { _Pragma("unroll") for (int m = 0; m < 4; ++m) _Pragma("unroll") for (int k = 0; k < 2; ++k) dst[m][k] = *(const LAS bf16x8*)(lds + PG8_SA(b, h) + aoff + m * 2048 + k * 1024); } while (0)
#define PG8_LDB(dst, b, h) do { _Pragma("unroll") for (int n = 0; n < 2; ++n) _Pragma("unroll") for (int k = 0; k < 2; ++k) dst[n][k] = *(const LAS bf16x8*)(lds + PG8_SB(b, h) + boff + n * 2048 + k * 1024); } while (0)
#define PG8_MMA(ai, bj, At, Bt) do { __builtin_amdgcn_s_setprio(1); _Pragma("unroll") for (int m = 0; m < 4; ++m) _Pragma("unroll") for (int n = 0; n < 2; ++n) _Pragma("unroll") for (int k = 0; k < 2; ++k) \
        acc[ai][bj][m][n] = __builtin_amdgcn_mfma_f32_16x16x32_bf16(Bt[n][k], At[m][k], acc[ai][bj][m][n], 0, 0, 0); __builtin_amdgcn_s_setprio(0); } while (0)
#define PG8_WAIT_V(n) asm volatile("s_waitcnt vmcnt(" #n ")" ::: "memory")
#define PG8_WAIT_L(n) asm volatile("s_waitcnt lgkmcnt(" #n ")" ::: "memory")
#define PG8_BAR __builtin_amdgcn_s_barrier()
#define PG8_SCHED __builtin_amdgcn_sched_barrier(0)
    Unit cur, nxt; int ui = 0;
    if (!S.next(0, cur)) return;
    f32x4 acc[2][2][4][2];
#pragma unroll
    for (int a = 0; a < 2; ++a)
#pragma unroll
        for (int b = 0; b < 2; ++b)
#pragma unroll
            for (int m = 0; m < 4; ++m)
#pragma unroll
                for (int n = 0; n < 2; ++n) acc[a][b][m][n] = (f32x4){0.f, 0.f, 0.f, 0.f};
    bf16x8 At[4][2], B0[2][2], B1[2][2];
    unsigned vC[2][2], vN[2][2];
    if constexpr (Sched::GATHER) S.aoff(cur, tid, vC);
    const char* cA = S.abase(cur);
    const char* cB = S.bbase(cur);
    const char* nA = cA;
    PG8_STAGE(PG8_SB(0, 0), cB, voffB); PG8_STAGEA(PG8_SA(0, 0), 0, 0, false); PG8_STAGE(PG8_SB(0, 1), cB + hstep, voffB); PG8_STAGEA(PG8_SA(0, 1), 1, 0, false);
    if (wr == 1) PG8_BAR;
    PG8_WAIT_V(4); PG8_BAR;
    PG8_STAGE(PG8_SB(1, 0), cB + kstep, voffB); PG8_STAGEA(PG8_SA(1, 0), 0, kstep, false); PG8_STAGE(PG8_SB(1, 1), cB + hstep + kstep, voffB);
    PG8_WAIT_V(6); PG8_BAR;
    for (;;) {
        const bool has_next = S.next(ui + 1, nxt);
        const char* nB = cB; nA = cA;
        if (has_next) { nB = S.bbase(nxt); nA = S.abase(nxt); if constexpr (Sched::GATHER) S.aoff(nxt, tid, vN); }
        else { if constexpr (Sched::GATHER) {
#pragma unroll
            for (int h = 0; h < 2; ++h)
#pragma unroll
                for (int i = 0; i < 2; ++i) vN[h][i] = vC[h][i]; } }
        for (int t = 0; t < nt; t += 2) {
            const bool last = (t == nt - 2);
            const size_t k1 = (size_t)(t + 1) * kstep, k2 = last ? 0 : (size_t)(t + 2) * kstep, k3 = k2 + kstep;
            const char* b2 = last ? nB : cB + (size_t)(t + 2) * kstep; const char* b3 = b2 + kstep;
            PG8_LDB(B0, 0, 0); PG8_SCHED; PG8_LDA(At, 0, 0); PG8_STAGEA(PG8_SA(1, 1), 1, k1, false);
            PG8_WAIT_L(8); PG8_BAR; PG8_WAIT_L(0); PG8_MMA(0, 0, At, B0); PG8_BAR; PG8_SCHED;
            PG8_LDB(B1, 0, 1); PG8_STAGE(PG8_SB(0, 0), b2, voffB);
            PG8_BAR; PG8_WAIT_L(0); PG8_MMA(0, 1, At, B1); PG8_BAR;
            PG8_LDA(At, 0, 1); PG8_STAGEA(PG8_SA(0, 0), 0, k2, last);
            PG8_BAR; PG8_WAIT_L(0); PG8_MMA(1, 0, At, B0); PG8_BAR; PG8_SCHED;
            PG8_STAGE(PG8_SB(0, 1), b2 + hstep, voffB);
            PG8_WAIT_V(6); PG8_BAR; PG8_MMA(1, 1, At, B1); PG8_BAR;
            PG8_LDB(B0, 1, 0); PG8_SCHED; PG8_LDA(At, 1, 0); PG8_STAGEA(PG8_SA(0, 1), 1, k2, last);
            PG8_WAIT_L(8); PG8_BAR; PG8_WAIT_L(0); PG8_MMA(0, 0, At, B0); PG8_BAR; PG8_SCHED;
            PG8_LDB(B1, 1, 1); PG8_STAGE(PG8_SB(1, 0), b3, voffB);
            PG8_BAR; PG8_WAIT_L(0); PG8_MMA(0, 1, At, B1); PG8_BAR;
            PG8_LDA(At, 1, 1); PG8_STAGEA(PG8_SA(1, 0), 0, k3, last);
            PG8_BAR; PG8_WAIT_L(0); PG8_MMA(1, 0, At, B0); PG8_BAR; PG8_SCHED;
            PG8_STAGE(PG8_SB(1, 1), b3 + hstep, voffB);
            PG8_WAIT_V(6); PG8_BAR; PG8_MMA(1, 1, At, B1); PG8_BAR;
        }
        E(acc, cur, wr, wc, fr, fq);
        if (!has_next) break;
#pragma unroll
        for (int a = 0; a < 2; ++a)
#pragma unroll
            for (int b = 0; b < 2; ++b)
#pragma unroll
                for (int m = 0; m < 4; ++m)
#pragma unroll
                    for (int n = 0; n < 2; ++n) acc[a][b][m][n] = (f32x4){0.f, 0.f, 0.f, 0.f};
        cur = nxt; cB = nB; cA = nA; ++ui;
        if constexpr (Sched::GATHER) {
#pragma unroll
            for (int h = 0; h < 2; ++h)
#pragma unroll
                for (int i = 0; i < 2; ++i) vC[h][i] = vN[h][i]; }
    }
    PG8_WAIT_V(0);
    if (wr == 0) PG8_BAR;
    PG8_BAR;
#undef PG8_SA
#undef PG8_SB
#undef PG8_STAGE
#undef PG8_STAGEA
#undef PG8_LDA
#undef PG8_LDB
#undef PG8_MMA
#undef PG8_WAIT_V
#undef PG8_WAIT_L
#undef PG8_BAR
#undef PG8_SCHED
}

struct EpiStoreBf16 {
    static constexpr bool PERM = true;
    bf16_t* O; int ldc;
    __device__ __forceinline__ void operator()(const f32x4 (&acc)[2][2][4][2], const Unit& u, int wr, int wc, int fr, int fq) const {
        const int row0 = u.pm * BM + wr * 64 + fr, col0 = u.pn * BM + wc * 32 + 8 * fq;
#pragma unroll
        for (int ai = 0; ai < 2; ++ai)
#pragma unroll
            for (int m = 0; m < 4; ++m) { bf16_t* rowp = O + (size_t)(row0 + ai * HALF + m * 16) * ldc + col0;
#pragma unroll
                for (int bj = 0; bj < 2; ++bj) { const f32x4 v0 = acc[ai][bj][m][0], v1 = acc[ai][bj][m][1];
                    u32x4 w; w.x = cvt_pk_bf16(v0[0], v0[1]); w.y = cvt_pk_bf16(v0[2], v0[3]); w.z = cvt_pk_bf16(v1[0], v1[1]); w.w = cvt_pk_bf16(v1[2], v1[3]);
                    *(u32x4*)(rowp + bj * HALF) = w; } }
    }
};
struct EpiResid {
    static constexpr bool PERM = false;
    float* X; const float* mods_l;
    __device__ __forceinline__ void operator()(const f32x4 (&acc)[2][2][4][2], const Unit& u, int wr, int wc, int fr, int fq) const {
        const int row0 = u.pm * BM + wr * 64 + fr, col0 = u.pn * BM + wc * 32 + 4 * fq;
        const float* m2 = mods_l + (size_t)(slot_of_row(u.pm * BM) * 6 + 2) * DM + col0;
        float* xb = X + (size_t)row0 * DM + col0;
#pragma unroll
        for (int bj = 0; bj < 2; ++bj)
#pragma unroll
            for (int n = 0; n < 2; ++n) { const f32x4 mv = *(const f32x4*)(m2 + bj * HALF + n * 16);
                f32x4 xv[8];
#pragma unroll
                for (int q = 0; q < 8; ++q) xv[q] = *(const f32x4*)(xb + (size_t)((q >> 2) * HALF + (q & 3) * 16) * DM + bj * HALF + n * 16);
#pragma unroll
                for (int q = 0; q < 8; ++q) *(f32x4*)(xb + (size_t)((q >> 2) * HALF + (q & 3) * 16) * DM + bj * HALF + n * 16) = xv[q] * ALPHA + mv * acc[q >> 2][bj][q & 3][n];
                asm volatile("" ::: "memory"); }
    }
};
struct EpiSwiglu {
    static constexpr bool PERM = true;
    bf16_t* H;
    __device__ __forceinline__ void operator()(const f32x4 (&acc)[2][2][4][2], const Unit& u, int wr, int wc, int fr, int fq) const {
        const int row0 = u.pm * BM + wr * 64 + fr, col0 = u.pn * HALF + wc * 32 + 8 * fq;
#pragma unroll
        for (int ai = 0; ai < 2; ++ai)
#pragma unroll
            for (int m = 0; m < 4; ++m) { bf16_t* rowp = H + (size_t)(row0 + ai * HALF + m * 16) * 256 + col0;
                float h[8];
#pragma unroll
                for (int n = 0; n < 2; ++n)
#pragma unroll
                    for (int j = 0; j < 4; ++j) h[n * 4 + j] = siluf_(acc[ai][0][m][n][j]) * acc[ai][1][m][n][j];
                u32x4 w; w.x = cvt_pk_bf16(h[0], h[1]); w.y = cvt_pk_bf16(h[2], h[3]); w.z = cvt_pk_bf16(h[4], h[5]); w.w = cvt_pk_bf16(h[6], h[7]);
                *(u32x4*)rowp = w; }
    }
};
struct EpiDown {
    static constexpr bool PERM = true;
    unsigned char* Y; const float* sw; const LAS int* cnt;
    __device__ __forceinline__ void operator()(const f32x4 (&acc)[2][2][4][2], const Unit& u, int wr, int wc, int fr, int fq) const {
        const int row0 = u.pm * BM + wr * 64 + fr, col0 = u.pn * BM + wc * 32 + 8 * fq;
        const int ce = (u.e < 64) ? cnt[u.e] : 0;
        const float* swe = sw + (size_t)(u.e < 64 ? u.e : 0) * CAP + u.ti * 256 + wr * 64 + fr;
        unsigned char* yb = Y + (size_t)row0 * DM + col0;
        float wv[8];
#pragma unroll
        for (int q = 0; q < 8; ++q) { const int rl = (q >> 2) * HALF + (q & 3) * 16, pos = u.ti * 256 + wr * 64 + fr + rl; wv[q] = 32.0f; if (u.e < 64) wv[q] = (pos < ce) ? swe[rl] * 32.0f : 0.0f; }
#pragma unroll
        for (int ai = 0; ai < 2; ++ai)
#pragma unroll
            for (int m = 0; m < 4; ++m) { const int rl = ai * HALF + m * 16; const float w = wv[ai * 4 + m];
                unsigned char* rowp = yb + (size_t)rl * DM;
#pragma unroll
                for (int bj = 0; bj < 2; ++bj) { f32x4 v0 = acc[ai][bj][m][0] * w, v1 = acc[ai][bj][m][1] * w;
#pragma unroll
                    for (int j = 0; j < 4; ++j) { v0[j] = __builtin_amdgcn_fmed3f(v0[j], -440.0f, 440.0f); v1[j] = __builtin_amdgcn_fmed3f(v1[j], -440.0f, 440.0f); }
                    int p0 = __builtin_amdgcn_cvt_pk_fp8_f32(v0[0], v0[1], 0, false); p0 = __builtin_amdgcn_cvt_pk_fp8_f32(v0[2], v0[3], p0, true);
                    int p1 = __builtin_amdgcn_cvt_pk_fp8_f32(v1[0], v1[1], 0, false); p1 = __builtin_amdgcn_cvt_pk_fp8_f32(v1[2], v1[3], p1, true);
                    u32x2 ww; ww.x = (unsigned)p0; ww.y = (unsigned)p1;
                    *(u32x2*)(rowp + bj * HALF) = ww; }
                asm volatile("" ::: "memory"); }
    }
};
template <int NPN> struct MoeOrder {
    const LAS int* cnt; const LAS int* tst; const LAS unsigned char* t2e; int ntiles, G, c;
    __device__ __forceinline__ bool next(int i, Unit& u) const {
        const int cs = ((G & 7) == 0) ? (c & 7) * (G >> 3) + (c >> 3) : c;
        const int L = i * G + cs; if (L >= ntiles * NPN) return false;
        const int tau = L / NPN; u.pm = tau; u.pn = L % NPN; u.e = t2e[tau]; u.ti = tau - tst[u.e]; return true;
    }
};
struct MoeGU : MoeOrder<2> {
    static constexpr bool GATHER = true;
    const char* A; const char* Bt; const int* stok;
    __device__ __forceinline__ const char* abase(const Unit&) const { return A; }
    __device__ __forceinline__ const char* bbase(const Unit& u) const { return Bt + ((size_t)u.e * 512 + (size_t)u.pn * 256) * 1024 * 2; }
    __device__ __forceinline__ void aoff(const Unit& u, int tid, unsigned (&off)[2][2]) const {
        const int ce = cnt[u.e];
#pragma unroll
        for (int i = 0; i < 2; ++i) { int R, C; stage_rc(tid * 16 + i * 8192, R, C);
#pragma unroll
            for (int h = 0; h < 2; ++h) { const int pos = u.ti * 256 + h * HALF + R; int tok;
                if (u.e == 64) tok = pos; else tok = (pos < ce) ? stok[(size_t)u.e * CAP + pos] : 0;
                off[h][i] = (unsigned)(tok * 1024 + C) * 2u; } }
    }
};
struct MoeDN : MoeOrder<4> {
    static constexpr bool GATHER = false;
    const char* A; const char* Bt;
    __device__ __forceinline__ const char* abase(const Unit& u) const { return A + (size_t)u.pm * BM * 256 * 2; }
    __device__ __forceinline__ const char* bbase(const Unit& u) const { return Bt + ((size_t)u.e * 1024 + (size_t)u.pn * 256) * 256 * 2; }
};
}

struct Args { const float* in[30]; float* out; unsigned char* ws; int ph_lo, ph_hi; };

struct Frame {
    float* out; unsigned char* ws; LAS unsigned char* lds; int tid, lane, wave, G, wg;
    float* mods; float* X; bf16_t* HB; bf16_t* MIX; unsigned char* WB; unsigned char* R1;
};

__device__ __forceinline__ const float* inp(const Frame& F, int i) {
    const unsigned long long v = ((const LAS unsigned long long*)(F.lds + LDS_MISC + MISC_INP))[i];
    const unsigned lo = (unsigned)__builtin_amdgcn_readfirstlane((int)(unsigned)v), hi = (unsigned)__builtin_amdgcn_readfirstlane((int)(unsigned)(v >> 32));
    return (const float*)(((unsigned long long)hi << 32) | lo);
}
__device__ __forceinline__ int lane_id_() { return (int)__builtin_amdgcn_mbcnt_hi(~0u, __builtin_amdgcn_mbcnt_lo(~0u, 0u)); }
__device__ __forceinline__ Frame fresh(const Frame& F0) { Frame F = F0; int ln = lane_id_(); asm volatile("" : "+v"(ln)); F.lane = ln; F.tid = F0.wave * 64 + ln; return F; }

__device__ __forceinline__ void ph_mods(const Frame& F) {
    const float* c = inp(F, 1); const float* cc = inp(F, 3); const float* ada_w = inp(F, 4); const float* ada_b = inp(F, 5);
    LAS float* sv = (LAS float*)F.lds;
    LAS float* red = (LAS float*)(F.lds + 5 * 1024 * 4);
    for (int i = F.tid; i < 5 * 1024; i += 512) { const int s = i >> 10, k = i & 1023; const float v = (s < 4) ? c[s * 1024 + k] : cc[k]; sv[i] = siluf_(v); }
    __syncthreads();
    for (int task = F.wg; task < 4 * 48; task += F.G) {
        const int l = task / 48, cc0 = (task % 48) * 128;
        const int col = cc0 + (F.tid & 127), kg = F.tid >> 7;
        const float* w = ada_w + (size_t)l * 1024 * 6144 + col;
        float a0 = 0.f, a1 = 0.f, a2 = 0.f, a3 = 0.f, a4 = 0.f;
        for (int k = kg * 256; k < kg * 256 + 256; ++k) { const float wv = w[(size_t)k * 6144]; a0 += sv[k] * wv; a1 += sv[1024 + k] * wv; a2 += sv[2048 + k] * wv; a3 += sv[3072 + k] * wv; a4 += sv[4096 + k] * wv; }
        LAS float* r = red + (kg * 128 + (F.tid & 127)) * 5; r[0] = a0; r[1] = a1; r[2] = a2; r[3] = a3; r[4] = a4;
        __syncthreads();
        if (F.tid < 128) {
            const float b = ada_b[l * 6144 + col];
#pragma unroll
            for (int s = 0; s < 5; ++s) { const float v = ((red[(0 * 128 + F.tid) * 5 + s] + red[(1 * 128 + F.tid) * 5 + s]) + red[(2 * 128 + F.tid) * 5 + s]) + red[(3 * 128 + F.tid) * 5 + s];
                F.mods[(size_t)(l * 5 + s) * 6144 + col] = v + b; }
        }
        __syncthreads();
    }
    if (F.wg == F.G - 1) {
        const float* raw = inp(F, 11); float* lbt = (float*)(F.ws + OFF_LBT);
        for (int i = F.tid; i < 2 * 512; i += 512) { const int d = i >> 9, ch = i & 511; const float r0 = raw[(d * 2 + 0) * 512 + ch], r1 = raw[(d * 2 + 1) * 512 + ch];
            lbt[(0 * 2 + d) * 512 + ch] = 0.f; lbt[(1 * 2 + d) * 512 + ch] = sigmoidf_(r1 - r0); }
    }
}

__device__ __forceinline__ void ph_init_x(const Frame& F) {
    const float* x = inp(F, 0); const float* ctx = inp(F, 2);
    { const float* lg_ = inp(F, 6); const float* lb_ = inp(F, 7); float* AB = (float*)(F.ws + OFF_AB);
      for (int i = F.wg * 512 + F.tid; i < 4 * 5 * 1024; i += F.G * 512) { const int k = i & 1023, ls = i >> 10, l = ls / 5;
          const float* m = F.mods + (size_t)ls * 6144; const float g0 = lg_[(l * 2) * 1024 + k], b0 = lb_[(l * 2) * 1024 + k], m3 = m[3 * 1024 + k], m4 = m[4 * 1024 + k];
          AB[(size_t)ls * 2048 + k] = g0 * (1.0f + m4); AB[(size_t)ls * 2048 + 1024 + k] = b0 * (1.0f + m4) + m3; } }
    const int gw = F.wg * 8 + F.wave, nw = F.G * 8;
    for (int row = gw; row < TT; row += nw) {
        const float* src = row < TC ? ctx + (size_t)row * DM : x + (size_t)(row - TC) * DM;
        const float* m = F.mods + (size_t)(0 * 5 + slot_of_row(row)) * 6144;
#pragma unroll
        for (int hh = 0; hh < 2; ++hh) { const int k = hh * 512 + F.lane * 8;
            const f32x4 v0 = *(const f32x4*)(src + k), v1 = *(const f32x4*)(src + k + 4);
            *(f32x4*)(F.X + (size_t)row * DM + k) = v0; *(f32x4*)(F.X + (size_t)row * DM + k + 4) = v1;
            const f32x4 s0 = *(const f32x4*)(m + 1024 + k), s1 = *(const f32x4*)(m + 1024 + k + 4), b0 = *(const f32x4*)(m + k), b1 = *(const f32x4*)(m + k + 4);
            const f32x4 h0 = v0 * (s0 + 1.0f) + b0, h1 = v1 * (s1 + 1.0f) + b1;
            u32x4 w; w.x = cvt_pk_bf16(h0[0], h0[1]); w.y = cvt_pk_bf16(h0[2], h0[3]); w.z = cvt_pk_bf16(h1[0], h1[1]); w.w = cvt_pk_bf16(h1[2], h1[3]);
            *(u32x4*)(F.HB + (size_t)row * DM + k) = w; }
    }
}

__device__ __forceinline__ void cvt_tile(const Frame& F, const float* src, int sld, int k0, int n0, bf16_t* dst, int dld, int drow0, float scale) {
    LAS float* t = (LAS float*)F.lds;
    { const int i = F.tid >> 3, j0 = (F.tid & 7) * 8; const float* p = src + (size_t)(k0 + i) * sld + n0 + j0;
      const f32x4 a = *(const f32x4*)p, b = *(const f32x4*)(p + 4);
      LAS float* q = t + i * 65 + j0; q[0] = a[0]; q[1] = a[1]; q[2] = a[2]; q[3] = a[3]; q[4] = b[0]; q[5] = b[1]; q[6] = b[2]; q[7] = b[3]; }
    __syncthreads();
    { const int j = F.tid >> 3, i0 = (F.tid & 7) * 8; float v[8];
#pragma unroll
      for (int q = 0; q < 8; ++q) v[q] = t[(i0 + q) * 65 + j] * scale;
      u32x4 w; w.x = cvt_pk_bf16(v[0], v[1]); w.y = cvt_pk_bf16(v[2], v[3]); w.z = cvt_pk_bf16(v[4], v[5]); w.w = cvt_pk_bf16(v[6], v[7]);
      *(u32x4*)(dst + (size_t)(drow0 + j) * dld + k0 + i0) = w; }
    __syncthreads();
}
__device__ __forceinline__ void ph_convert(const Frame& F, int l) {
    const int j = l >> 1; const bool even = (l & 1) == 0;
    bf16_t* wIN = (bf16_t*)(F.WB + WB_IN); bf16_t* wOUT = (bf16_t*)(F.WB + WB_OUT); bf16_t* wRT = (bf16_t*)(F.WB + WB_RT);
    bf16_t* wGU = (bf16_t*)(F.WB + WB_GU); bf16_t* wDN = (bf16_t*)(F.WB + WB_DN); bf16_t* wLRU = (bf16_t*)(F.WB + WB_LRU);
    const int nIN = even ? 4096 : 2048;
    const int t_in = (nIN / 64) * 16, t_out = 256, t_rt = 16, t_gu = 65 * 2 * 64, t_dn = 65 * 64, t_lru = even ? 0 : 64;
    const int total = t_in + t_out + t_rt + t_gu + t_dn + t_lru;
    for (int task = F.wg; task < total; task += F.G) {
        int t = task;
        if (t < t_in) { const int nb = t >> 4, kb = t & 15; const float* src = even ? inp(F, 8) + (size_t)j * 1024 * 4096 : inp(F, 13) + (size_t)j * 1024 * 2048;
            cvt_tile(F, src, nIN, kb * 64, nb * 64, wIN, 1024, nb * 64, (even && nb < 8) ? 0.125f : 1.0f); continue; }
        t -= t_in;
        if (t < t_out) { const int nb = t >> 4, kb = t & 15; const float* src = even ? inp(F, 9) + (size_t)j * 1024 * 1024 : inp(F, 21) + (size_t)j * 1024 * 1024;
            cvt_tile(F, src, 1024, kb * 64, nb * 64, wOUT, 1024, nb * 64, 1.0f); continue; }
        t -= t_out;
        if (t < t_rt) { cvt_tile(F, inp(F, 22) + (size_t)l * 1024 * 64, 64, t * 64, 0, wRT, 1024, 0, 1.0f); continue; }
        t -= t_rt;
        if (t < t_gu) { const int e = t / 128, r = t % 128, which = r >> 6, q = r & 63, nb = q >> 4, kb = q & 15;
            const float* src = (e < 64) ? (which ? inp(F, 25) : inp(F, 24)) + ((size_t)l * 64 + e) * 1024 * 256 : (which ? inp(F, 28) : inp(F, 27)) + (size_t)l * 1024 * 256;
            const int n0 = nb * 64, drow0 = (n0 >> 7) * 256 + which * 128 + (n0 & 127);
            cvt_tile(F, src, 256, kb * 64, n0, wGU + (size_t)e * 512 * 1024, 1024, drow0, 1.0f); continue; }
        t -= t_gu;
        if (t < t_dn) { const int e = t >> 6, q = t & 63, nb = q >> 2, kb = q & 3;
            const float* src = (e < 64) ? inp(F, 26) + ((size_t)l * 64 + e) * 256 * 1024 : inp(F, 29) + (size_t)l * 256 * 1024;
            cvt_tile(F, src, 1024, kb * 64, nb * 64, wDN + (size_t)e * 1024 * 256, 256, nb * 64, 1.0f); continue; }
        t -= t_dn;
        { const int d = t >> 5, gt = (t >> 4) & 1, kb = t & 15;
          const float* src = (gt ? inp(F, 18) : inp(F, 16)) + (((size_t)j * 2 + d) * 16 + kb) * 4096;
          cvt_tile(F, src, 64, 0, 0, wLRU + (((size_t)d * 2 + gt) * 16 + kb) * 4096, 64, 0, 1.0f); }
    }
}

__device__ __forceinline__ void ph_attn(const Frame& F, int j) {
    const bf16_t* P = (const bf16_t*)(F.R1 + R1_P);
    LAS bf16_t* Ks = (LAS bf16_t*)F.lds;
    LAS bf16_t* Vt = (LAS bf16_t*)(F.lds + 9216);
    LAS float* rp_l = (LAS float*)(F.lds + 18432);
    const float* rpb = inp(F, 10) + (size_t)j * 8 * 465;
    const int g = F.lane >> 4, l15 = F.lane & 15;
    const int NLAT = NBAT * 8 * 64, NTASK = NLAT + NBAT * 8 * 2;
    const int wgs = ((F.G & 7) == 0) ? (F.wg & 7) * (F.G >> 3) + (F.wg >> 3) : F.wg;
    for (int task = wgs; task < NTASK; task += F.G) {
        const bool lat = task < NLAT;
        int b, h, rp = 0, half = 0;
        if (lat) { b = task >> 9; h = (task >> 6) & 7; rp = task & 63; } else { const int t2 = task - NLAT; b = t2 >> 4; h = (t2 >> 1) & 7; half = t2 & 1; }
        const int myr = 2 * rp + (F.wave >> 2), w0 = (F.wave & 3) * 16;
        const int r0 = min(max(myr - 4, 0), 120);
        const int rlo = min(max(2 * rp - 4, 0), 120), rhi = min(max(2 * rp + 1 - 4, 0), 120) + 7;
        const int nloc = lat ? (rhi - rlo + 1) : 0;
        const int qrow = lat ? (TC + b * SEQ + myr * 64 + w0 + l15) : (b * CTXL + half * 128 + F.wave * 16 + l15);
        bf16x8 qf[2];
        qf[0] = *(const bf16x8*)(P + (size_t)qrow * 4096 + h * 64 + g * 8);
        qf[1] = *(const bf16x8*)(P + (size_t)qrow * 4096 + h * 64 + 32 + g * 8);
        if (lat) for (int i = F.tid; i < 465; i += 512) rp_l[i] = rpb[h * 465 + i];
        f32x4 oacc[4];
#pragma unroll
        for (int dt = 0; dt < 4; ++dt) oacc[dt] = (f32x4){0.f, 0.f, 0.f, 0.f};
        float mrun = -1e30f, lrun = 0.f;
        const int wq = w0 + l15, c0 = min(max(wq - 8, 0), 48);
        u32x4 kv, vv;
        { const int key = F.tid >> 3, ds = (F.tid & 7) * 8; const bool loc0 = 0 < nloc;
          const int krow = loc0 ? (TC + b * SEQ + rlo * 64 + key) : (b * CTXL + key);
          kv = *(const u32x4*)(P + (size_t)krow * 4096 + 512 + h * 64 + ds); vv = *(const u32x4*)(P + (size_t)krow * 4096 + 1024 + h * 64 + ds); }
        for (int ch = 0; ch < nloc + 4; ++ch) {
            const bool loc = ch < nloc; const int kr = rlo + ch;
            { const int key = F.tid >> 3, ds = (F.tid & 7) * 8;
              __syncthreads();
              *(LAS u32x4*)(Ks + key * 72 + ds) = kv;
              Vt[(ds + 0) * 72 + key] = (bf16_t)(vv.x & 0xffff); Vt[(ds + 1) * 72 + key] = (bf16_t)(vv.x >> 16);
              Vt[(ds + 2) * 72 + key] = (bf16_t)(vv.y & 0xffff); Vt[(ds + 3) * 72 + key] = (bf16_t)(vv.y >> 16);
              Vt[(ds + 4) * 72 + key] = (bf16_t)(vv.z & 0xffff); Vt[(ds + 5) * 72 + key] = (bf16_t)(vv.z >> 16);
              Vt[(ds + 6) * 72 + key] = (bf16_t)(vv.w & 0xffff); Vt[(ds + 7) * 72 + key] = (bf16_t)(vv.w >> 16);
              if (ch + 1 < nloc + 4) { const bool locn = (ch + 1) < nloc;
                  const int krow = locn ? (TC + b * SEQ + (kr + 1) * 64 + key) : (b * CTXL + (ch + 1 - nloc) * 64 + key);
                  kv = *(const u32x4*)(P + (size_t)krow * 4096 + 512 + h * 64 + ds); vv = *(const u32x4*)(P + (size_t)krow * 4096 + 1024 + h * 64 + ds); }
              __syncthreads(); }
            const bool mine = loc ? (kr >= r0 && kr < r0 + 8) : true;
            if (mine) {
                f32x4 s[4];
#pragma unroll
                for (int kb = 0; kb < 4; ++kb) { s[kb] = (f32x4){0.f, 0.f, 0.f, 0.f};
#pragma unroll
                    for (int ks = 0; ks < 2; ++ks) { const bf16x8 a = *(const LAS bf16x8*)(Ks + (kb * 16 + l15) * 72 + ks * 32 + g * 8);
                        s[kb] = __builtin_amdgcn_mfma_f32_16x16x32_bf16(a, qf[ks], s[kb], 0, 0, 0); } }
                if (loc) {
#pragma unroll
                    for (int kb = 0; kb < 4; ++kb)
#pragma unroll
                        for (int i = 0; i < 4; ++i) { const int kc = kb * 16 + 4 * g + i; const bool valid = (kc >= c0) && (kc < c0 + 16);
                            const int bi = (kr - myr + 7) * 31 + min(max(kc - wq + 15, 0), 30);
                            s[kb][i] = valid ? s[kb][i] + rp_l[bi] : -1e30f; }
                }
                float cm = -1e30f;
#pragma unroll
                for (int kb = 0; kb < 4; ++kb)
#pragma unroll
                    for (int i = 0; i < 4; ++i) cm = fmaxf(cm, s[kb][i]);
                cm = fmaxf(cm, __shfl_xor(cm, 16)); cm = fmaxf(cm, __shfl_xor(cm, 32));
                const float mn = fmaxf(mrun, cm), sc = __expf(mrun - mn);
                mrun = mn; lrun *= sc;
#pragma unroll
                for (int dt = 0; dt < 4; ++dt) oacc[dt] *= sc;
                float p[4][4];
#pragma unroll
                for (int kb = 0; kb < 4; ++kb)
#pragma unroll
                    for (int i = 0; i < 4; ++i) { p[kb][i] = __expf(s[kb][i] - mn); lrun += p[kb][i]; }
#pragma unroll
                for (int kp = 0; kp < 2; ++kp) {
                    u32x4 pw; pw.x = cvt_pk_bf16(p[2 * kp][0], p[2 * kp][1]); pw.y = cvt_pk_bf16(p[2 * kp][2], p[2 * kp][3]);
                    pw.z = cvt_pk_bf16(p[2 * kp + 1][0], p[2 * kp + 1][1]); pw.w = cvt_pk_bf16(p[2 * kp + 1][2], p[2 * kp + 1][3]);
                    bf16x8 pf; __builtin_memcpy(&pf, &pw, 16);
#pragma unroll
                    for (int dt = 0; dt < 4; ++dt) {
                        const u32x2 v0 = *(const LAS u32x2*)(Vt + (dt * 16 + l15) * 72 + (2 * kp) * 16 + 4 * g);
                        const u32x2 v1 = *(const LAS u32x2*)(Vt + (dt * 16 + l15) * 72 + (2 * kp + 1) * 16 + 4 * g);
                        u32x4 vw; vw.x = v0.x; vw.y = v0.y; vw.z = v1.x; vw.w = v1.y; bf16x8 vf; __builtin_memcpy(&vf, &vw, 16);
                        oacc[dt] = __builtin_amdgcn_mfma_f32_16x16x32_bf16(vf, pf, oacc[dt], 0, 0, 0);
                    }
                }
            }
        }
        float lt = lrun; lt += __shfl_xor(lt, 16); lt += __shfl_xor(lt, 32);
        const float inv = 1.0f / lt;
#pragma unroll
        for (int dt = 0; dt < 4; ++dt) { const f32x4 o = oacc[dt] * inv; u32x2 w; w.x = cvt_pk_bf16(o[0], o[1]); w.y = cvt_pk_bf16(o[2], o[3]);
            *(u32x2*)(F.MIX + (size_t)qrow * DM + h * 64 + dt * 16 + 4 * g) = w; }
        __syncthreads();
    }
}

__device__ __forceinline__ int hg_unit(int nb, int dir) { return dir == 0 ? nb : (nb < 2 ? 1 - nb : 2 + (HG_NU - 3 - (nb - 2))); }
__device__ __forceinline__ int hg_row(int b, int nb, int t) { return nb < 2 ? b * CTXL + nb * HG_U + t : TC + b * SEQ + (nb - 2) * HG_U + t; }
template <int CTRL> __device__ __forceinline__ float dpp_add0(float x) { return x + dppf<CTRL>(0.0f, x); }
template <bool WITHO>
__device__ __forceinline__ void hg_pass(const Frame& F, const bf16_t* P, const float* lbh, int b, int h, int nb, int dir, f32x4 (&S)[4][4], float (&Gsum)[16],
                                        LAS bf16_t* Vl, LAS bf16_t* Kl, float* OF, const float* ngp) {
    const int tau = F.lane & 15, g = F.lane >> 4;
    const unsigned vaddr = (unsigned)(size_t)Vl + (unsigned)((4 * g + (tau >> 2)) * 128 + (tau & 3) * 8);
    const unsigned kaddr = (unsigned)(size_t)Kl + (unsigned)((4 * g + (tau >> 2)) * 128 + (tau & 3) * 8);
    u32x2 zr[4], vr[4], qr[4];
    { const int t = dir ? (HG_U - 1 - tau) : tau; const bf16_t* pr = P + (size_t)hg_row(b, nb, t) * 4096 + h * 64 + 4 * g;
#pragma unroll
      for (int m = 0; m < 4; ++m) { zr[m] = *(const u32x2*)(pr + (dir ? 2560 : 2048) + 16 * m); vr[m] = *(const u32x2*)(pr + 3072 + 16 * m); } }
    for (int ci = 0; ci < HG_U / 16; ++ci) {
        float kk[16], c[16];
        if (WITHO) { const int pos = ci * 16 + tau, t = dir ? (HG_U - 1 - pos) : pos; const bf16_t* pr = P + (size_t)hg_row(b, nb, t) * 4096 + h * 64 + 4 * g;
#pragma unroll
            for (int m = 0; m < 4; ++m) qr[m] = *(const u32x2*)(pr + 1536 + 16 * m); }
#pragma unroll
        for (int m = 0; m < 4; ++m) { const float z0 = __uint_as_float(zr[m].x << 16), z1 = __uint_as_float(zr[m].x & 0xffff0000u), z2 = __uint_as_float(zr[m].y << 16), z3 = __uint_as_float(zr[m].y & 0xffff0000u);
            const float zz[4] = {z0, z1, z2, z3};
            const f32x4 lb4 = *(const f32x4*)(lbh + 16 * m + 4 * g);
#pragma unroll
            for (int i = 0; i < 4; ++i) { const float lb = lb4[i]; const float f = fmaxf(lb + (1.0f - lb) * sigmoidf_(zz[i]), 1e-30f); kk[m * 4 + i] = 1.0f - f; c[m * 4 + i] = __logf(f); }
            *(LAS u32x2*)(Vl + tau * 64 + 16 * m + 4 * g) = vr[m];
 }
        if (ci + 1 < HG_U / 16) { const int pos = (ci + 1) * 16 + tau, t = dir ? (HG_U - 1 - pos) : pos; const bf16_t* pr = P + (size_t)hg_row(b, nb, t) * 4096 + h * 64 + 4 * g;
#pragma unroll
            for (int m = 0; m < 4; ++m) { zr[m] = *(const u32x2*)(pr + (dir ? 2560 : 2048) + 16 * m); vr[m] = *(const u32x2*)(pr + 3072 + 16 * m); } }
#pragma unroll
        for (int q = 0; q < 16; ++q) { c[q] = dpp_add0<0x111>(c[q]); c[q] = dpp_add0<0x112>(c[q]); c[q] = dpp_add0<0x114>(c[q]); c[q] = dpp_add0<0x118>(c[q]); }
        float G[16];
#pragma unroll
        for (int q = 0; q < 16; ++q) { G[q] = __shfl(c[q], (F.lane & 48) | 15); Gsum[q] += G[q]; }
#pragma unroll
        for (int m = 0; m < 4; ++m) { float kh[4];
#pragma unroll
            for (int i = 0; i < 4; ++i) kh[i] = kk[m * 4 + i] * __expf(G[m * 4 + i] - c[m * 4 + i]);
            u32x2 w; w.x = cvt_pk_bf16(kh[0], kh[1]); w.y = cvt_pk_bf16(kh[2], kh[3]);
            *(LAS u32x2*)(Kl + tau * 64 + 16 * m + 4 * g) = w; }
        float ofv[4][4], gtv[4][4]; int orow[4];
        if (WITHO) {
#pragma unroll
            for (int i = 0; i < 4; ++i) { const int p2 = ci * 16 + 4 * g + i, t2 = dir ? (HG_U - 1 - p2) : p2; orow[i] = hg_row(b, nb, t2); }
            if (dir) {
#pragma unroll
                for (int i = 0; i < 4; ++i)
#pragma unroll
                    for (int vt = 0; vt < 4; ++vt) { ofv[i][vt] = OF[(size_t)orow[i] * 512 + h * 64 + 16 * vt + tau]; gtv[i][vt] = bf2f(P[(size_t)orow[i] * 4096 + 3584 + h * 64 + 16 * vt + tau]); }
            }
        }
        asm volatile("s_waitcnt lgkmcnt(0)" ::: "memory");
        u32x2 vtr[4], ktr[4];
        asm volatile("ds_read_b64_tr_b16 %0, %8\n\tds_read_b64_tr_b16 %1, %8 offset:32\n\tds_read_b64_tr_b16 %2, %8 offset:64\n\tds_read_b64_tr_b16 %3, %8 offset:96\n\t"
                     "ds_read_b64_tr_b16 %4, %9\n\tds_read_b64_tr_b16 %5, %9 offset:32\n\tds_read_b64_tr_b16 %6, %9 offset:64\n\tds_read_b64_tr_b16 %7, %9 offset:96\n\ts_waitcnt lgkmcnt(0)"
                     : "=&v"(vtr[0]), "=&v"(vtr[1]), "=&v"(vtr[2]), "=&v"(vtr[3]), "=&v"(ktr[0]), "=&v"(ktr[1]), "=&v"(ktr[2]), "=&v"(ktr[3]) : "v"(vaddr), "v"(kaddr) : "memory");
        bf16x8 Vf[4], Kf[4];
#pragma unroll
        for (int q = 0; q < 4; ++q) { u32x4 w; w.x = vtr[q].x; w.y = vtr[q].y; w.z = 0u; w.w = 0u; __builtin_memcpy(&Vf[q], &w, 16); u32x4 w2; w2.x = ktr[q].x; w2.y = ktr[q].y; w2.z = 0u; w2.w = 0u; __builtin_memcpy(&Kf[q], &w2, 16); }
        if (WITHO) {
            bf16x8 Ktf[2], Qtf[2], Qhf[2];
#pragma unroll
            for (int ks = 0; ks < 2; ++ks) { float kt_[8], qt_[8], qh_[8];
#pragma unroll
                for (int mm = 0; mm < 2; ++mm) { const int m = 2 * ks + mm;
                    const float qq[4] = {__uint_as_float(qr[m].x << 16), __uint_as_float(qr[m].x & 0xffff0000u), __uint_as_float(qr[m].y << 16), __uint_as_float(qr[m].y & 0xffff0000u)};
#pragma unroll
                    for (int i = 0; i < 4; ++i) { const int q = m * 4 + i; const float qv = siluf_(qq[i]) * 0.125f; const float d = fminf(fmaxf(c[q] - 0.5f * G[q], -80.0f), 80.0f);
                        qt_[mm * 4 + i] = qv * __expf(d); kt_[mm * 4 + i] = kk[q] * __expf(-d); qh_[mm * 4 + i] = qv * __expf(c[q]); } }
                u32x4 w; w.x = cvt_pk_bf16(kt_[0], kt_[1]); w.y = cvt_pk_bf16(kt_[2], kt_[3]); w.z = cvt_pk_bf16(kt_[4], kt_[5]); w.w = cvt_pk_bf16(kt_[6], kt_[7]); __builtin_memcpy(&Ktf[ks], &w, 16);
                w.x = cvt_pk_bf16(qt_[0], qt_[1]); w.y = cvt_pk_bf16(qt_[2], qt_[3]); w.z = cvt_pk_bf16(qt_[4], qt_[5]); w.w = cvt_pk_bf16(qt_[6], qt_[7]); __builtin_memcpy(&Qtf[ks], &w, 16);
                w.x = cvt_pk_bf16(qh_[0], qh_[1]); w.y = cvt_pk_bf16(qh_[2], qh_[3]); w.z = cvt_pk_bf16(qh_[4], qh_[5]); w.w = cvt_pk_bf16(qh_[6], qh_[7]); __builtin_memcpy(&Qhf[ks], &w, 16); }
            f32x4 AT = (f32x4){0.f, 0.f, 0.f, 0.f};
            AT = __builtin_amdgcn_mfma_f32_16x16x32_bf16(Ktf[0], Qtf[0], AT, 0, 0, 0); AT = __builtin_amdgcn_mfma_f32_16x16x32_bf16(Ktf[1], Qtf[1], AT, 0, 0, 0);
#pragma unroll
            for (int i = 0; i < 4; ++i) AT[i] = (4 * g + i <= tau) ? AT[i] : 0.0f;
            bf16x8 Af; { u32x4 w; w.x = cvt_pk_bf16(AT[0], AT[1]); w.y = cvt_pk_bf16(AT[2], AT[3]); w.z = 0u; w.w = 0u; __builtin_memcpy(&Af, &w, 16); }
            f32x4 o[4];
#pragma unroll
            for (int vt = 0; vt < 4; ++vt) { o[vt] = __builtin_amdgcn_mfma_f32_16x16x32_bf16(Af, Vf[vt], (f32x4){0.f, 0.f, 0.f, 0.f}, 0, 0, 0);
#pragma unroll
                for (int ks = 0; ks < 2; ++ks) { u32x4 w; w.x = cvt_pk_bf16(S[2 * ks][vt][0], S[2 * ks][vt][1]); w.y = cvt_pk_bf16(S[2 * ks][vt][2], S[2 * ks][vt][3]);
                    w.z = cvt_pk_bf16(S[2 * ks + 1][vt][0], S[2 * ks + 1][vt][1]); w.w = cvt_pk_bf16(S[2 * ks + 1][vt][2], S[2 * ks + 1][vt][3]); bf16x8 Sf; __builtin_memcpy(&Sf, &w, 16);
                    o[vt] = __builtin_amdgcn_mfma_f32_16x16x32_bf16(Qhf[ks], Sf, o[vt], 0, 0, 0); } }
            if (dir == 0) {
#pragma unroll
                for (int i = 0; i < 4; ++i)
#pragma unroll
                    for (int vt = 0; vt < 4; ++vt) OF[(size_t)orow[i] * 512 + h * 64 + 16 * vt + tau] = o[vt][i];
            } else {
#pragma unroll
                for (int i = 0; i < 4; ++i) { float tot[4]; float sq = 0.f;
#pragma unroll
                    for (int vt = 0; vt < 4; ++vt) { tot[vt] = o[vt][i] + ofv[i][vt]; sq = fmaf(tot[vt], tot[vt], sq); }
                    sq += dppf<0xB1>(sq, sq); sq += dppf<0x4E>(sq, sq); sq += dppf<0x141>(sq, sq); sq += dppf<0x140>(sq, sq);
                    const float rs = rsqrtf(sq * (1.0f / 64.0f) + 1e-6f);
#pragma unroll
                    for (int vt = 0; vt < 4; ++vt) F.MIX[(size_t)orow[i] * DM + 512 + h * 64 + 16 * vt + tau] = f2bf(tot[vt] * rs * ngp[16 * vt + tau] * siluf_(gtv[i][vt])); }
            }
        }
#pragma unroll
        for (int kt = 0; kt < 4; ++kt) { f32x4 eg;
#pragma unroll
            for (int i = 0; i < 4; ++i) eg[i] = __expf(G[kt * 4 + i]);
#pragma unroll
            for (int vt = 0; vt < 4; ++vt) S[kt][vt] = __builtin_amdgcn_mfma_f32_16x16x32_bf16(Kf[kt], Vf[vt], S[kt][vt] * eg, 0, 0, 0); }
    }
}
__device__ __forceinline__ void ph_hg_a(const Frame& F, int j) {
    const bf16_t* P = (const bf16_t*)(F.R1 + R1_P);
    float* SLOC = (float*)(F.R1 + R1_SLOC); float* DL = (float*)(F.R1 + R1_DL);
    LAS bf16_t* Vl = (LAS bf16_t*)(F.lds + 32768 + F.wave * 4096); LAS bf16_t* Kl = Vl + 1024;
    const int gw = F.wg * 8 + F.wave, nw = F.G * 8;
    const int NT = NBAT * 8 * HG_NU * 2;
    for (int task = gw; task < NT; task += nw) {
        const int dir = task & 1, nb = (task >> 1) % HG_NU, bh = (task >> 1) / HG_NU, b = bh >> 3, h = bh & 7;
        const float* lbh = (const float*)(F.ws + OFF_LBT) + (j * 2 + dir) * 512 + h * 64;
        f32x4 S[4][4];
#pragma unroll
        for (int kt = 0; kt < 4; ++kt)
#pragma unroll
            for (int vt = 0; vt < 4; ++vt) S[kt][vt] = (f32x4){0.f, 0.f, 0.f, 0.f};
        float Gsum[16];
#pragma unroll
        for (int q = 0; q < 16; ++q) Gsum[q] = 0.f;
        hg_pass<false>(F, P, lbh, b, h, nb, dir, S, Gsum, Vl, Kl, nullptr, nullptr);
        const int seq = bh * 2 + dir, u = hg_unit(nb, dir);
        float* so = SLOC + ((size_t)seq * HG_NU + u) * 4096;
#pragma unroll
        for (int kt = 0; kt < 4; ++kt)
#pragma unroll
            for (int vt = 0; vt < 4; ++vt)
#pragma unroll
                for (int i = 0; i < 4; ++i) so[((kt * 4 + vt) * 4 + i) * 64 + F.lane] = S[kt][vt][i];
        if ((F.lane & 15) == 0) { float* dd = DL + ((size_t)seq * HG_NU + u) * 64;
#pragma unroll
            for (int m = 0; m < 4; ++m)
#pragma unroll
                for (int i = 0; i < 4; ++i) dd[16 * m + 4 * (F.lane >> 4) + i] = __expf(Gsum[m * 4 + i]); }
    }
}
__device__ __forceinline__ void ph_hg_b(const Frame& F) {
    const float* SLOC = (const float*)(F.R1 + R1_SLOC); const float* DL = (const float*)(F.R1 + R1_DL); float* SST = (float*)(F.R1 + R1_SST);
    for (int idx = F.wg * 512 + F.tid; idx < 64 * 4096; idx += F.G * 512) {
        const int seq = idx >> 12, e = idx & 4095, ln = e & 63, reg = e >> 6, i = reg & 3, kt = reg >> 4, k = 16 * kt + 4 * (ln >> 4) + i;
        float s = 0.f;
#pragma unroll 6
        for (int u = 0; u < HG_NU; ++u) { const size_t o = ((size_t)seq * HG_NU + u) * 4096 + e; SST[o] = s; s = DL[((size_t)seq * HG_NU + u) * 64 + k] * s + SLOC[o]; }
    }
}
__device__ __forceinline__ void ph_hg_c(const Frame& F, int j) {
    const bf16_t* P = (const bf16_t*)(F.R1 + R1_P);
    const float* SST = (const float*)(F.R1 + R1_SST); float* OF = (float*)(F.R1 + R1_OF);
    const float* ng = inp(F, 12) + j * 64;
    LAS bf16_t* Vl = (LAS bf16_t*)(F.lds + 32768 + F.wave * 4096); LAS bf16_t* Kl = Vl + 1024;
    const int gw = F.wg * 8 + F.wave, nw = F.G * 8;
    const int NT = NBAT * 8 * (HG_NU - 2);
    for (int task = gw; task < NT; task += nw) {
        const int nb = 2 + task % (HG_NU - 2), bh = task / (HG_NU - 2), b = bh >> 3, h = bh & 7;
        for (int dir = 0; dir < 2; ++dir) {
            const float* lbh = (const float*)(F.ws + OFF_LBT) + (j * 2 + dir) * 512 + h * 64;
            const int seq = bh * 2 + dir, u = hg_unit(nb, dir);
            const float* ss = SST + ((size_t)seq * HG_NU + u) * 4096;
            f32x4 S[4][4];
#pragma unroll
            for (int kt = 0; kt < 4; ++kt)
#pragma unroll
                for (int vt = 0; vt < 4; ++vt)
#pragma unroll
                    for (int i = 0; i < 4; ++i) S[kt][vt][i] = ss[((kt * 4 + vt) * 4 + i) * 64 + F.lane];
            float Gsum[16];
#pragma unroll
            for (int q = 0; q < 16; ++q) Gsum[q] = 0.f;
            hg_pass<true>(F, P, lbh, b, h, nb, dir, S, Gsum, Vl, Kl, OF, ng);
            asm volatile("s_waitcnt vmcnt(0)" ::: "memory");
        }
    }
}

__device__ __forceinline__ void ph_hg_c_ctx(const Frame& F, int j) {
    if (F.wg >= NBAT * 8 * 2 || F.wave != 0) return;
    const bf16_t* P = (const bf16_t*)(F.R1 + R1_P);
    const float* SLOC = (const float*)(F.R1 + R1_SLOC); float* OF = (float*)(F.R1 + R1_OF);
    const float* ng = inp(F, 12) + j * 64;
    LAS bf16_t* Vl = (LAS bf16_t*)(F.lds + 32768 + F.wave * 4096); LAS bf16_t* Kl = Vl + 1024;
    const int nb = F.wg & 1, bh = F.wg >> 1, b = bh >> 3, h = bh & 7;
    for (int dir = 0; dir < 2; ++dir) {
        const float* lbh = (const float*)(F.ws + OFF_LBT) + (j * 2 + dir) * 512 + h * 64;
        const int seq = bh * 2 + dir, u = hg_unit(nb, dir);
        const float* ss = SLOC + ((size_t)seq * HG_NU + 0) * 4096;
        f32x4 S[4][4];
#pragma unroll
        for (int kt = 0; kt < 4; ++kt)
#pragma unroll
            for (int vt = 0; vt < 4; ++vt)
#pragma unroll
                for (int i = 0; i < 4; ++i) S[kt][vt][i] = (u == 0) ? 0.0f : ss[((kt * 4 + vt) * 4 + i) * 64 + F.lane];
        float Gsum[16];
#pragma unroll
        for (int q = 0; q < 16; ++q) Gsum[q] = 0.f;
        hg_pass<true>(F, P, lbh, b, h, nb, dir, S, Gsum, Vl, Kl, OF, ng);
        asm volatile("s_waitcnt vmcnt(0)" ::: "memory");
    }
}

__device__ __forceinline__ int lru_nat(int so, int dir) { return dir == 0 ? so : (so < 16 ? 15 - so : 16 + (LRU_NT - 1 - so)); }
__device__ __forceinline__ int lru_row(int b, int nt, int t) { return nt < 16 ? b * CTXL + nt * 16 + t : TC + b * SEQ + (nt - 16) * 16 + t; }
struct LruRaw { u32x4 a[4], b[4]; };
__device__ __forceinline__ void lru_load(const Frame& F, int b, int kb, int nt, LruRaw& R) {
    const bf16_t* P = (const bf16_t*)(F.R1 + R1_P);
    const int tk = F.lane & 15, g = F.lane >> 4;
    const int len = nt < 16 ? CTXL : SEQ, tpos = (nt < 16 ? nt * 16 : (nt - 16) * 16) + tk;
    const bf16_t* pbase = P + (size_t)((nt < 16 ? b * CTXL : TC + b * SEQ)) * 2048 + 1024 + kb * 64 + g * 16;
#pragma unroll
    for (int tap = 0; tap < 4; ++tap) { const int tp = tpos + tap - 2; const bool ok = (tp >= 0 && tp < len); const bf16_t* pr = pbase + (size_t)(ok ? tp : tpos) * 2048;
        R.a[tap] = *(const u32x4*)pr; R.b[tap] = *(const u32x4*)(pr + 8); if (!ok) { R.a[tap] = (u32x4){0u, 0u, 0u, 0u}; R.b[tap] = (u32x4){0u, 0u, 0u, 0u}; } }
}
__device__ __forceinline__ void lru_conv(const Frame& F, const LruRaw& R, const LAS float* CT, LAS float* ucb) {
    const int tk = F.lane & 15, g = F.lane >> 4;
    float acc[16];
#pragma unroll
    for (int q = 0; q < 4; ++q) { const f32x4 c4 = *(const LAS f32x4*)(CT + 4 * 64 + g * 16 + q * 4); acc[q * 4] = c4[0]; acc[q * 4 + 1] = c4[1]; acc[q * 4 + 2] = c4[2]; acc[q * 4 + 3] = c4[3]; }
#pragma unroll
    for (int tap = 0; tap < 4; ++tap) { float t0[8], t1[8]; unpack8(R.a[tap], t0); unpack8(R.b[tap], t1);
#pragma unroll
        for (int q = 0; q < 2; ++q) { const f32x4 w0 = *(const LAS f32x4*)(CT + tap * 64 + g * 16 + q * 4), w1 = *(const LAS f32x4*)(CT + tap * 64 + g * 16 + 8 + q * 4);
#pragma unroll
            for (int i = 0; i < 4; ++i) { acc[q * 4 + i] = fmaf(w0[i], t0[q * 4 + i], acc[q * 4 + i]); acc[8 + q * 4 + i] = fmaf(w1[i], t1[q * 4 + i], acc[8 + q * 4 + i]); } } }
#pragma unroll
    for (int q = 0; q < 4; ++q) *(LAS f32x4*)(ucb + tk * 64 + g * 16 + q * 4) = (f32x4){acc[q * 4], acc[q * 4 + 1], acc[q * 4 + 2], acc[q * 4 + 3]};
}
__device__ __forceinline__ void lru_gates(const Frame& F, LAS bf16_t* Wl, const LAS float* CT, LAS float* ucb, float (&av)[2][4][4], float (&xv)[2][4][4]) {
    const int tk = F.lane & 15, g = F.lane >> 4;
    bf16x8 bfr[2];
#pragma unroll
    for (int ks = 0; ks < 2; ++ks) { const f32x4 u0 = *(const LAS f32x4*)(ucb + tk * 64 + ks * 32 + g * 8), u1 = *(const LAS f32x4*)(ucb + tk * 64 + ks * 32 + g * 8 + 4);
        u32x4 w; w.x = cvt_pk_bf16(u0[0], u0[1]); w.y = cvt_pk_bf16(u0[2], u0[3]); w.z = cvt_pk_bf16(u1[0], u1[1]); w.w = cvt_pk_bf16(u1[2], u1[3]); __builtin_memcpy(&bfr[ks], &w, 16); }
#pragma unroll
    for (int d = 0; d < 2; ++d)
#pragma unroll
        for (int et = 0; et < 4; ++et) {
            f32x4 ra = (f32x4){0.f, 0.f, 0.f, 0.f}, ri = (f32x4){0.f, 0.f, 0.f, 0.f};
#pragma unroll
            for (int ks = 0; ks < 2; ++ks) {
                const bf16x8 wa = *(const LAS bf16x8*)(Wl + ((d * 2 + 0) * 64 + et * 16 + tk) * 64 + ks * 32 + g * 8);
                const bf16x8 wx = *(const LAS bf16x8*)(Wl + ((d * 2 + 1) * 64 + et * 16 + tk) * 64 + ks * 32 + g * 8);
                ra = __builtin_amdgcn_mfma_f32_16x16x32_bf16(wa, bfr[ks], ra, 0, 0, 0);
                ri = __builtin_amdgcn_mfma_f32_16x16x32_bf16(wx, bfr[ks], ri, 0, 0, 0);
            }
            const f32x4 ba4 = *(const LAS f32x4*)(CT + (5 + 3 * d) * 64 + et * 16 + 4 * g), bx4 = *(const LAS f32x4*)(CT + (6 + 3 * d) * 64 + et * 16 + 4 * g), cs4 = *(const LAS f32x4*)(CT + (7 + 3 * d) * 64 + et * 16 + 4 * g);
            const f32x4 u4 = *(const LAS f32x4*)(ucb + tk * 64 + et * 16 + 4 * g);
#pragma unroll
            for (int i = 0; i < 4; ++i) {
                const float r = sigmoidf_(ra[i] + ba4[i]), ig = sigmoidf_(ri[i] + bx4[i]);
                const float la = cs4[i] * r, a = __expf(la);
                av[d][et][i] = la; xv[d][et][i] = sqrtf(fmaxf(1.0f - a * a, 0.f)) * ig * u4[i]; }
        }
}
template <int S> __device__ __forceinline__ void lru_step_f(float& a, float& x) { const float ap = dppf<0x110 + S>(1.0f, a), xp = dppf<0x110 + S>(0.0f, x); x = fmaf(a, xp, x); a = a * ap; }
template <int S> __device__ __forceinline__ void lru_step_b(float& a, float& x) { const float ap = dppf<0x100 + S>(1.0f, a), xp = dppf<0x100 + S>(0.0f, x); x = fmaf(a, xp, x); a = a * ap; }
#define LRU_SCANS(av, xv) do { _Pragma("unroll") for (int et = 0; et < 4; ++et) _Pragma("unroll") for (int i = 0; i < 4; ++i) { \
        lru_step_f<1>(av[0][et][i], xv[0][et][i]); lru_step_f<2>(av[0][et][i], xv[0][et][i]); lru_step_f<4>(av[0][et][i], xv[0][et][i]); lru_step_f<8>(av[0][et][i], xv[0][et][i]); \
        lru_step_b<1>(av[1][et][i], xv[1][et][i]); lru_step_b<2>(av[1][et][i], xv[1][et][i]); lru_step_b<4>(av[1][et][i], xv[1][et][i]); lru_step_b<8>(av[1][et][i], xv[1][et][i]); } } while (0)
__device__ __forceinline__ void ph_lru_a(const Frame& F, int jj) {
    LAS bf16_t* Wl = (LAS bf16_t*)F.lds;
    LAS float* ucb = (LAS float*)(F.lds + 32768 + F.wave * 4096);
    LAS float* CT = (LAS float*)(F.lds + 65536);
    const bf16_t* wsrc = (const bf16_t*)(F.WB + WB_LRU);
    float* AG = (float*)(F.R1 + R1_AG); bf16_t* GX = (bf16_t*)(F.R1 + R1_GX);
    const float* cw = inp(F, 14) + (size_t)jj * 4 * 1024; const float* cb = inp(F, 15) + (size_t)jj * 1024;
    const float* b_a = inp(F, 17) + (size_t)jj * 2 * 1024; const float* b_x = inp(F, 19) + (size_t)jj * 2 * 1024; const float* lam = inp(F, 20) + (size_t)jj * 2 * 1024;
    const int tk = F.lane & 15, g = F.lane >> 4;
    const int NTASK = NBAT * 16 * 11;
    for (int task = F.wg; task < NTASK; task += F.G) {
        const int grp = task % 11, kb = (task / 11) & 15, b = task / (11 * 16);
        __syncthreads();
        for (int i = F.tid; i < 4 * 4096 / 8; i += 512) { const int mg = i >> 9, r = i & 511;
            *(LAS u32x4*)(Wl + mg * 4096 + r * 8) = *(const u32x4*)(wsrc + ((size_t)mg * 16 + kb) * 4096 + r * 8); }
        for (int i = F.tid; i < 11 * 64; i += 512) { const int kind = i >> 6, ch = kb * 64 + (i & 63); float v;
            if (kind < 4) v = cw[kind * 1024 + ch]; else if (kind == 4) v = cb[ch];
            else { const int d = (kind - 5) / 3, w = (kind - 5) % 3; v = (w == 0) ? b_a[d * 1024 + ch] : (w == 1) ? b_x[d * 1024 + ch] : -8.0f * log1pf(__expf(-lam[d * 1024 + ch])); }
            CT[i] = v; }
        __syncthreads();
        const int nt0 = grp * 48;
        LruRaw raw; lru_load(F, b, kb, nt0 + F.wave, raw);
        for (int ti = F.wave; ti < 48; ti += 8) {
            const int nt = nt0 + ti;
            float av[2][4][4], xv[2][4][4];
            lru_conv(F, raw, CT, ucb);
            if (ti + 8 < 48) lru_load(F, b, kb, nt + 8, raw);
            lru_gates(F, Wl, CT, ucb, av, xv);
            const int row = lru_row(b, nt, tk);
#pragma unroll
            for (int d = 0; d < 2; ++d)
#pragma unroll
                for (int et = 0; et < 4; ++et) { u32x4 w; w.x = cvt_pk_bf16(av[d][et][0], xv[d][et][0]); w.y = cvt_pk_bf16(av[d][et][1], xv[d][et][1]); w.z = cvt_pk_bf16(av[d][et][2], xv[d][et][2]); w.w = cvt_pk_bf16(av[d][et][3], xv[d][et][3]);
                    *(u32x4*)(GX + (((size_t)row * 2 + d) * 1024 + kb * 64 + et * 16 + 4 * g) * 2) = w;
                    const unsigned ww[4] = {w.x, w.y, w.z, w.w};
#pragma unroll
                    for (int i = 0; i < 4; ++i) { av[d][et][i] = __expf(__uint_as_float(ww[i] << 16)); xv[d][et][i] = __uint_as_float(ww[i] & 0xffff0000u); } }
            LRU_SCANS(av, xv);
#pragma unroll
            for (int d = 0; d < 2; ++d) if (tk == (d ? 0 : 15)) {
                float* ag = AG + (((size_t)(b * 2 + d) * LRU_NT + nt) * 2) * 1024 + kb * 64;
#pragma unroll
                for (int et = 0; et < 4; ++et) { *(f32x4*)(ag + et * 16 + 4 * g) = (f32x4){av[d][et][0], av[d][et][1], av[d][et][2], av[d][et][3]};
                    *(f32x4*)(ag + 1024 + et * 16 + 4 * g) = (f32x4){xv[d][et][0], xv[d][et][1], xv[d][et][2], xv[d][et][3]}; }
            }
        }
    }
    __syncthreads();
}
__device__ __forceinline__ void ph_lru_c(const Frame& F) {
    const float* HST = (const float*)(F.R1 + R1_HST); const bf16_t* GX = (const bf16_t*)(F.R1 + R1_GX);
    const bf16_t* P = (const bf16_t*)(F.R1 + R1_P);
    const int tk = F.lane & 15, g = F.lane >> 4;
    const int gw = F.wg * 8 + F.wave, nw = F.G * 8;
    for (int task = gw; task < NBAT * LRU_NT * 16; task += nw) {
        const int kb = task & 15, nt = (task >> 4) % LRU_NT, b = (task >> 4) / LRU_NT;
        const int row = lru_row(b, nt, tk);
        u32x4 gx[2][4]; f32x4 hf[4], hb[4]; u32x2 yw[4];
#pragma unroll
        for (int d = 0; d < 2; ++d)
#pragma unroll
            for (int et = 0; et < 4; ++et) gx[d][et] = *(const u32x4*)(GX + (((size_t)row * 2 + d) * 1024 + kb * 64 + et * 16 + 4 * g) * 2);
#pragma unroll
        for (int et = 0; et < 4; ++et) { const int ch = kb * 64 + et * 16 + 4 * g;
            hf[et] = *(const f32x4*)(HST + ((size_t)(b * 2 + 0) * LRU_NT + nt) * 1024 + ch);
            hb[et] = *(const f32x4*)(HST + ((size_t)(b * 2 + 1) * LRU_NT + nt) * 1024 + ch);
            yw[et] = *(const u32x2*)(P + (size_t)row * 2048 + ch); }
        float av[2][4][4], xv[2][4][4];
#pragma unroll
        for (int d = 0; d < 2; ++d)
#pragma unroll
            for (int et = 0; et < 4; ++et) { const unsigned ww[4] = {gx[d][et].x, gx[d][et].y, gx[d][et].z, gx[d][et].w};
#pragma unroll
                for (int i = 0; i < 4; ++i) { av[d][et][i] = __expf(__uint_as_float(ww[i] << 16)); xv[d][et][i] = __uint_as_float(ww[i] & 0xffff0000u); } }
        LRU_SCANS(av, xv);
#pragma unroll
        for (int et = 0; et < 4; ++et) {
            const int ch = kb * 64 + et * 16 + 4 * g;
            const float y0 = __uint_as_float(yw[et].x << 16), y1 = __uint_as_float(yw[et].x & 0xffff0000u), y2 = __uint_as_float(yw[et].y << 16), y3 = __uint_as_float(yw[et].y & 0xffff0000u);
            float o[4];
#pragma unroll
            for (int i = 0; i < 4; ++i) o[i] = fmaf(av[0][et][i], hf[et][i], xv[0][et][i]) + fmaf(av[1][et][i], hb[et][i], xv[1][et][i]);
            o[0] *= gelu_tanh_(y0); o[1] *= gelu_tanh_(y1); o[2] *= gelu_tanh_(y2); o[3] *= gelu_tanh_(y3);
            u32x2 w; w.x = cvt_pk_bf16(o[0], o[1]); w.y = cvt_pk_bf16(o[2], o[3]);
            *(u32x2*)(F.MIX + (size_t)row * DM + ch) = w;
        }
    }
}
__device__ __forceinline__ void ph_lru_b(const Frame& F) {
    const float* AG = (const float*)(F.R1 + R1_AG); float* HST = (float*)(F.R1 + R1_HST);
    LAS float* sa = (LAS float*)F.lds; LAS float* sx = sa + 512;
    for (int task = F.wg; task < NBAT * 2 * 32; task += F.G) {
        const int cgp = task & 31, d = (task >> 5) & 1, b = task >> 6;
        const int ch = cgp * 32 + (F.tid & 31), seg = F.tid >> 5;
        const float* ag = AG + ((size_t)(b * 2 + d) * LRU_NT) * 2048 + ch;
        float A = 1.0f, Xv = 0.f;
        for (int i = 0; i < 33; ++i) { const int nt = lru_nat(seg * 33 + i, d); const float a = ag[(size_t)nt * 2048], x = ag[(size_t)nt * 2048 + 1024]; Xv = fmaf(a, Xv, x); A *= a; }
        __syncthreads();
        sa[F.tid] = A; sx[F.tid] = Xv;
        __syncthreads();
        float h = 0.f;
        for (int s2 = 0; s2 < seg; ++s2) h = fmaf(sa[s2 * 32 + (F.tid & 31)], h, sx[s2 * 32 + (F.tid & 31)]);
        float* hs = HST + ((size_t)(b * 2 + d) * LRU_NT) * 1024 + ch;
        for (int i = 0; i < 33; ++i) { const int nt = lru_nat(seg * 33 + i, d); hs[(size_t)nt * 1024] = h; const float a = ag[(size_t)nt * 2048], x = ag[(size_t)nt * 2048 + 1024]; h = fmaf(a, h, x); }
    }
    __syncthreads();
}

__device__ __forceinline__ void topk_better(float& bk, int& be, float& bs, float ok, int oe, float os) { const bool t = (ok > bk) || (ok == bk && oe < be); bk = t ? ok : bk; be = t ? oe : be; bs = t ? os : bs; }
template <int CTRL> __device__ __forceinline__ void topk_step(float& bk, int& be, float& bs) {
    const float ok = dppf<CTRL>(bk, bk), os = dppf<CTRL>(bs, bs); const int oe = __builtin_amdgcn_update_dpp(be, be, CTRL, 0xf, 0xf, false); topk_better(bk, be, bs, ok, oe, os); }
__device__ __forceinline__ void ph_ln_router(const Frame& F, int l, bool dry = false) {
    const bf16_t* RW = (const bf16_t*)(F.WB + WB_RT);
    const float* rbias = inp(F, 23) + l * 64;
    LAS float* part = (LAS float*)F.lds;
    LAS float* LP = (LAS float*)(F.lds + 4096);
    LAS int* hist = (LAS int*)(F.lds + LDS_MISC + MISC_HIST); LAS int* hbase = (LAS int*)(F.lds + LDS_MISC + MISC_HBASE);
    int* tok_e = (int*)(F.ws + OFF_TOKE); int* tok_p = (int*)(F.ws + OFF_TOKP); float* tok_w = (float*)(F.ws + OFF_TOKW);
    int* stok = (int*)(F.ws + OFF_STOK); float* sw = (float*)(F.ws + OFF_SW);
    float* stats = (float*)(F.ws + OFF_STATS);
    unsigned* gcnt = (unsigned*)(F.ws + OFF_CTL + CTL_CNT) + l * 64;
    const int tk = F.lane & 15, g = F.lane >> 4;
    float rb[4];
#pragma unroll
    for (int q = 0; q < 4; ++q) rb[q] = rbias[tk + 16 * q];
    if (F.tid < 64) hist[F.tid] = 0;
    __syncthreads();
    const int NTILE = TT / 16;
    bf16x8 rwf[4][4];
#pragma unroll
    for (int et = 0; et < 4; ++et)
#pragma unroll
        for (int ks = 0; ks < 4; ++ks) rwf[et][ks] = *(const bf16x8*)(RW + (size_t)(et * 16 + tk) * 1024 + F.wave * 128 + ks * 32 + g * 8);
    f32x4 vn[4][2];
    if (F.wg < NTILE) { const float* xr = F.X + (size_t)(F.wg * 16 + tk) * DM + F.wave * 128 + g * 8;
#pragma unroll
        for (int ks = 0; ks < 4; ++ks) { vn[ks][0] = *(const f32x4*)(xr + ks * 32); vn[ks][1] = *(const f32x4*)(xr + ks * 32 + 4); } }
    for (int tile = F.wg; tile < NTILE; tile += F.G) {
        const int row = tile * 16 + tk; const int s = slot_of_row(tile * 16);
        const float* ab = (const float*)(F.ws + OFF_AB) + (size_t)(l * 5 + s) * 2048;
        f32x4 v[4][2];
#pragma unroll
        for (int ks = 0; ks < 4; ++ks) { v[ks][0] = vn[ks][0]; v[ks][1] = vn[ks][1]; }
        if (tile + F.G < NTILE) { const float* xr = F.X + (size_t)((tile + F.G) * 16 + tk) * DM + F.wave * 128 + g * 8;
#pragma unroll
            for (int ks = 0; ks < 4; ++ks) { vn[ks][0] = *(const f32x4*)(xr + ks * 32); vn[ks][1] = *(const f32x4*)(xr + ks * 32 + 4); } }
        float sum = 0.f, sq = 0.f;
#pragma unroll
        for (int ks = 0; ks < 4; ++ks)
#pragma unroll
            for (int hh = 0; hh < 2; ++hh) { const f32x4 a = v[ks][hh]; sum += (a[0] + a[1]) + (a[2] + a[3]); sq += (a[0] * a[0] + a[1] * a[1]) + (a[2] * a[2] + a[3] * a[3]); }
        sum += __shfl_xor(sum, 16); sum += __shfl_xor(sum, 32); sq += __shfl_xor(sq, 16); sq += __shfl_xor(sq, 32);
        if (g == 0) *(LAS f32x2*)(part + (F.wave * 16 + tk) * 2) = (f32x2){sum, sq};
        __syncthreads();
        float ts = 0.f, tq = 0.f;
#pragma unroll
        for (int w = 0; w < 8; ++w) { const f32x2 p = *(const LAS f32x2*)(part + (w * 16 + tk) * 2); ts += p.x; tq += p.y; }
        const float mean = ts * (1.0f / 1024.0f), var = fmaxf(tq * (1.0f / 1024.0f) - mean * mean, 0.f), rstd = rsqrtf(var + 1e-5f);
        if (F.wave == 0 && g == 0) *(f32x2*)(stats + (size_t)row * 2) = (f32x2){mean, rstd};
        f32x4 acc[4];
#pragma unroll
        for (int et = 0; et < 4; ++et) acc[et] = (f32x4){0.f, 0.f, 0.f, 0.f};
#pragma unroll
        for (int ks = 0; ks < 4; ++ks) { const int k = F.wave * 128 + ks * 32 + g * 8;
            const f32x4 a10 = *(const f32x4*)(ab + k), a11 = *(const f32x4*)(ab + k + 4), b10 = *(const f32x4*)(ab + 1024 + k), b11 = *(const f32x4*)(ab + 1024 + k + 4);
            const f32x4 h0 = (v[ks][0] - mean) * rstd * a10 + b10, h1 = (v[ks][1] - mean) * rstd * a11 + b11;
            u32x4 w; w.x = cvt_pk_bf16(h0[0], h0[1]); w.y = cvt_pk_bf16(h0[2], h0[3]); w.z = cvt_pk_bf16(h1[0], h1[1]); w.w = cvt_pk_bf16(h1[2], h1[3]);
            *(u32x4*)(F.HB + (size_t)row * DM + k) = w;
            bf16x8 af; __builtin_memcpy(&af, &w, 16);
#pragma unroll
            for (int et = 0; et < 4; ++et) acc[et] = __builtin_amdgcn_mfma_f32_16x16x32_bf16(af, rwf[et][ks], acc[et], 0, 0, 0);
        }
#pragma unroll
        for (int et = 0; et < 4; ++et)
#pragma unroll
            for (int i = 0; i < 4; ++i) LP[(F.wave * 16 + 4 * g + i) * 64 + et * 16 + tk] = acc[et][i];
        __syncthreads();
        {
            const int t = 2 * F.wave + (g & 1), r2 = tile * 16 + t;
            float sc[4], key[4];
#pragma unroll
            for (int q = 0; q < 4; ++q) { float lgt = 0.f;
#pragma unroll
                for (int w = 0; w < 8; ++w) lgt += LP[(w * 16 + t) * 64 + tk + 16 * q];
                sc[q] = sigmoidf_(lgt); key[q] = sc[q] + rb[q]; }
            unsigned taken = 0u; int se[6]; float ss[6]; float tot = 0.f;
#pragma unroll
            for (int sel = 0; sel < 6; ++sel) {
                float bk = -1e30f, bs = 0.f; int be = 0;
#pragma unroll
                for (int q = 0; q < 4; ++q) if (!((taken >> q) & 1u) && key[q] > bk) { bk = key[q]; be = tk + 16 * q; bs = sc[q]; }
                topk_step<0xB1>(bk, be, bs); topk_step<0x4E>(bk, be, bs); topk_step<0x141>(bk, be, bs); topk_step<0x140>(bk, be, bs);
                if ((be & 15) == tk) taken |= 1u << (be >> 4);
                se[sel] = be; ss[sel] = bs; tot += bs;
            }
            const float sc2 = 2.5f / tot;
            if (tk < 6 && g < 2) {
                int e = se[0]; float w = ss[0];
#pragma unroll
                for (int q = 1; q < 6; ++q) if (tk == q) { e = se[q]; w = ss[q]; }
                tok_e[r2 * 8 + tk] = e; tok_w[r2 * 8 + tk] = w * sc2; if (!dry) tok_p[r2 * 8 + tk] = __hip_atomic_fetch_add(hist + e, 1, __ATOMIC_RELAXED, __HIP_MEMORY_SCOPE_WORKGROUP);
            }
        }
    }
    asm volatile("s_waitcnt vmcnt(0) lgkmcnt(0)" ::: "memory");
    __syncthreads();
    if (dry) return;
    if (F.tid < 64) hbase[F.tid] = (int)__hip_atomic_fetch_add(gcnt + F.tid, (unsigned)hist[F.tid], __ATOMIC_RELAXED, __HIP_MEMORY_SCOPE_AGENT);
    __syncthreads();
    for (int tile = F.wg; tile < NTILE; tile += F.G) {
        if (F.tid < 96) { const int row = tile * 16 + F.tid / 6, q = F.tid % 6; const int e = tok_e[row * 8 + q]; const int pos = hbase[e] + tok_p[row * 8 + q];
            tok_p[row * 8 + q] = pos; stok[(size_t)e * CAP + pos] = row; sw[(size_t)e * CAP + pos] = tok_w[row * 8 + q]; }
    }
    __syncthreads();
}

__device__ __forceinline__ int moe_tables(const Frame& F, int l) {
    LAS int* cnt = (LAS int*)(F.lds + LDS_MISC + MISC_CNT); LAS int* tst = (LAS int*)(F.lds + LDS_MISC + MISC_TST); LAS unsigned char* t2e = (LAS unsigned char*)(F.lds + LDS_MISC + MISC_T2E);
    const unsigned* gcnt = (const unsigned*)(F.ws + OFF_CTL + CTL_CNT) + l * 64;
    __syncthreads();
    if (F.tid < 64) cnt[F.tid] = (int)__hip_atomic_load(gcnt + F.tid, __ATOMIC_RELAXED, __HIP_MEMORY_SCOPE_AGENT);
    if (F.tid == 64) cnt[64] = TT;
    __syncthreads();
    if (F.tid == 0) { int s = 0; for (int e = 0; e < 65; ++e) { tst[e] = s; s += (cnt[e] + 255) >> 8; } tst[65] = s; }
    __syncthreads();
    const int ntiles = tst[65];
    for (int t = F.tid; t < ntiles; t += 512) { int e = 0; for (int q = 0; q < 65; ++q) if (t >= tst[q]) e = q; else break; t2e[t] = (unsigned char)e; }
    __syncthreads();
    return ntiles;
}

__device__ __forceinline__ void ph_combine(const Frame& F, int l, bool dry = false) {
    LAS int* tst = (LAS int*)(F.lds + LDS_MISC + MISC_TST);
    (void)moe_tables(F, l);
    const float* gam = inp(F, 6) + (size_t)(l * 2 + 1) * DM; const float* bet = inp(F, 7) + (size_t)(l * 2 + 1) * DM;
    const float* gam0 = inp(F, 6) + (size_t)(l * 2 + 0) * DM; const float* bet0 = inp(F, 7) + (size_t)(l * 2 + 0) * DM;
    const float* stats = (const float*)(F.ws + OFF_STATS);
    const unsigned char* Y = (const unsigned char*)(F.R1 + R1_Y);
    const int* tok_e = (const int*)(F.ws + OFF_TOKE); const int* tok_p = (const int*)(F.ws + OFF_TOKP);
    const int gw = F.wg * 8 + F.wave, nw = F.G * 8;
    const bool lastl = (l == 3);
    for (int row = gw; row < TT; row += nw) {
        const int s = slot_of_row(row);
        const float* m = F.mods + (size_t)(l * 5 + s) * 6144;
        const float* mn = F.mods + (size_t)((lastl ? l : l + 1) * 5 + s) * 6144;
        int srow[7];
#pragma unroll
        for (int q = 0; q < 6; ++q) { const int e = tok_e[row * 8 + q]; srow[q] = tst[e] * 256 + tok_p[row * 8 + q]; }
        srow[6] = tst[64] * 256 + row;
        float v[16];
#pragma unroll
        for (int hh = 0; hh < 2; ++hh) { const int k = hh * 512 + F.lane * 8;
            float y[8];
#pragma unroll
            for (int q = 0; q < 8; ++q) y[q] = 0.f;
#pragma unroll
            for (int q = 0; q < 7; ++q) { const u32x2 w = *(const u32x2*)(Y + (size_t)srow[q] * DM + k);
                const f32x2 t0 = __builtin_amdgcn_cvt_pk_f32_fp8((int)w.x, false), t1 = __builtin_amdgcn_cvt_pk_f32_fp8((int)w.x, true), t2 = __builtin_amdgcn_cvt_pk_f32_fp8((int)w.y, false), t3 = __builtin_amdgcn_cvt_pk_f32_fp8((int)w.y, true);
                y[0] += t0.x; y[1] += t0.y; y[2] += t1.x; y[3] += t1.y; y[4] += t2.x; y[5] += t2.y; y[6] += t3.x; y[7] += t3.y; }
#pragma unroll
            for (int i = 0; i < 8; ++i) y[i] *= (1.0f / 32.0f);
            f32x4 x0 = *(const f32x4*)(F.X + (size_t)row * DM + k), x1 = *(const f32x4*)(F.X + (size_t)row * DM + k + 4);
            { const f32x2 st = *(const f32x2*)(stats + (size_t)row * 2); const f32x4 g0 = *(const f32x4*)(gam0 + k), g1 = *(const f32x4*)(gam0 + k + 4), b0 = *(const f32x4*)(bet0 + k), b1 = *(const f32x4*)(bet0 + k + 4);
              x0 = (x0 - st.x) * st.y * g0 + b0; x1 = (x1 - st.x) * st.y * g1 + b1; }
            const f32x4 m50 = *(const f32x4*)(m + 5 * 1024 + k), m51 = *(const f32x4*)(m + 5 * 1024 + k + 4);
#pragma unroll
            for (int i = 0; i < 4; ++i) { v[hh * 8 + i] = ALPHA * x0[i] + m50[i] * y[i]; v[hh * 8 + 4 + i] = ALPHA * x1[i] + m51[i] * y[4 + i]; }
        }
        float sum = 0.f;
#pragma unroll
        for (int i = 0; i < 16; ++i) sum += v[i];
        sum += __shfl_xor(sum, 1); sum += __shfl_xor(sum, 2); sum += __shfl_xor(sum, 4); sum += __shfl_xor(sum, 8); sum += __shfl_xor(sum, 16); sum += __shfl_xor(sum, 32);
        const float mean = sum * (1.0f / 1024.0f);
        float sq = 0.f;
#pragma unroll
        for (int i = 0; i < 16; ++i) { const float d = v[i] - mean; sq += d * d; }
        sq += __shfl_xor(sq, 1); sq += __shfl_xor(sq, 2); sq += __shfl_xor(sq, 4); sq += __shfl_xor(sq, 8); sq += __shfl_xor(sq, 16); sq += __shfl_xor(sq, 32);
        const float rstd = rsqrtf(sq * (1.0f / 1024.0f) + 1e-5f);
#pragma unroll
        for (int hh = 0; hh < 2; ++hh) { const int k = hh * 512 + F.lane * 8;
            float gm[8], bt[8], xn[8];
            *(f32x4*)&gm[0] = *(const f32x4*)(gam + k); *(f32x4*)&gm[4] = *(const f32x4*)(gam + k + 4);
            *(f32x4*)&bt[0] = *(const f32x4*)(bet + k); *(f32x4*)&bt[4] = *(const f32x4*)(bet + k + 4);
#pragma unroll
            for (int i = 0; i < 8; ++i) xn[i] = (v[hh * 8 + i] - mean) * rstd * gm[i] + bt[i];
            if (dry) { float acc_ = 0.f; for (int i = 0; i < 8; ++i) acc_ += xn[i]; asm volatile("" :: "v"(acc_)); }
            else if (lastl) { if (row >= TC) { float* o = F.out + (size_t)(row - TC) * DM + k; *(f32x4*)o = *(f32x4*)&xn[0]; *(f32x4*)(o + 4) = *(f32x4*)&xn[4]; } }
            else {
                *(f32x4*)(F.X + (size_t)row * DM + k) = *(f32x4*)&xn[0]; *(f32x4*)(F.X + (size_t)row * DM + k + 4) = *(f32x4*)&xn[4];
                float s1[8], b0[8];
                *(f32x4*)&s1[0] = *(const f32x4*)(mn + 1024 + k); *(f32x4*)&s1[4] = *(const f32x4*)(mn + 1024 + k + 4);
                *(f32x4*)&b0[0] = *(const f32x4*)(mn + k); *(f32x4*)&b0[4] = *(const f32x4*)(mn + k + 4);
                float hv[8];
#pragma unroll
                for (int i = 0; i < 8; ++i) hv[i] = xn[i] * (1.0f + s1[i]) + b0[i];
                u32x4 w; w.x = cvt_pk_bf16(hv[0], hv[1]); w.y = cvt_pk_bf16(hv[2], hv[3]); w.z = cvt_pk_bf16(hv[4], hv[5]); w.w = cvt_pk_bf16(hv[6], hv[7]);
                *(u32x4*)(F.HB + (size_t)row * DM + k) = w;
            }
        }
    }
}

constexpr int NPHASE = 2 + 4 * 10;
__global__ void __launch_bounds__(512, 2) mk_fwd(Args args) {
    extern __shared__ __attribute__((aligned(16))) unsigned char lds_raw[];
    Frame F;
    F.out = args.out; F.ws = args.ws; F.lds = (LAS unsigned char*)lds_raw;
    { const int t0 = threadIdx.x; F.wave = __builtin_amdgcn_readfirstlane(t0 >> 6); F.lane = t0 & 63; F.tid = t0; } F.G = gridDim.x; F.wg = blockIdx.x;
    F.mods = (float*)(args.ws + OFF_MODS); F.X = (float*)(args.ws + OFF_X); F.HB = (bf16_t*)(args.ws + OFF_HB); F.MIX = F.HB;
    F.WB = args.ws + OFF_WB; F.R1 = args.ws + OFF_R1;
    volatile LAS unsigned* xbw = (volatile LAS unsigned*)(F.lds + LDS_MISC);
    if (F.tid < 4) xbw[F.tid] = 0u;
    if (F.tid < 30) ((LAS unsigned long long*)(F.lds + LDS_MISC + MISC_INP))[F.tid] = (unsigned long long)args.in[F.tid];
    __syncthreads();
    const int lo = args.ph_lo, hi = args.ph_hi;
    XcdBarrier bar; bar.bar = (unsigned*)(args.ws + OFF_CTL); bar.x = 0; bar.st = xbw;
    if (hi - lo > 1) bar = xcd_barrier_post((unsigned*)(args.ws + OFF_CTL), xbw);
#define IN(k) (lo <= (k) && (k) < hi)
#define SEAM(k) do { if (IN(k) && IN((k) + 1)) { xcd_barrier(bar); if (REPM & 1) xcd_barrier(bar); } } while (0)
    if ((PHM & 1) && IN(0)) { ph_mods(fresh(F)); } SEAM(0);
    if ((PHM & 2) && IN(1)) { ph_init_x(fresh(F)); }
    for (int l = 0; l < 4; ++l) {
        const int pb = 2 + l * 10, j = l >> 1; const bool even = (l & 1) == 0;
        float* mods_l = F.mods + (size_t)l * 5 * 6144;
        if ((PHM & 4) && IN(pb + 0)) { for (int rep = 0; rep < ((REPM & 4) ? 2 : 1); ++rep) { ph_convert(fresh(F), l); __syncthreads(); } } SEAM(pb + 0);
        if ((PHM & 8) && IN(pb + 1)) {
            const int N = even ? 4096 : 2048;
            pg8::StaticOrder S; S.init(F.HB, F.WB + WB_IN, TT, N, 1024, F.G, F.wg);
            pg8::EpiStoreBf16 E{(bf16_t*)(F.R1 + R1_P), N};
            for (int rep = 0; rep < ((REPM & 8) ? 2 : 1); ++rep) pg8::gemm_phase(F.lds, 1024, S, E, F.wave);
        } SEAM(pb + 1);
        if (IN(pb + 2)) { if (even) { if (PHM & 16) for (int rep = 0; rep < ((REPM & 16) ? 2 : 1); ++rep) ph_attn(fresh(F), j); if (PHM & 32) for (int rep = 0; rep < ((REPM & 32) ? 2 : 1); ++rep) ph_hg_a(fresh(F), j); } else { if (PHM & 64) for (int rep = 0; rep < ((REPM & 64) ? 2 : 1); ++rep) ph_lru_a(fresh(F), j); } } SEAM(pb + 2);
        if (IN(pb + 3)) { if (even) { if (PHM & 128) for (int rep = 0; rep < ((REPM & 128) ? 2 : 1); ++rep) { ph_hg_b(fresh(F)); ph_hg_c_ctx(fresh(F), j); } } else { if (PHM & 256) for (int rep = 0; rep < ((REPM & 256) ? 2 : 1); ++rep) ph_lru_b(fresh(F)); } } SEAM(pb + 3);
        if (IN(pb + 4)) { if (even) { if (PHM & 512) for (int rep = 0; rep < ((REPM & 512) ? 2 : 1); ++rep) ph_hg_c(fresh(F), j); } else { if (PHM & 1024) for (int rep = 0; rep < ((REPM & 1024) ? 2 : 1); ++rep) ph_lru_c(fresh(F)); } } SEAM(pb + 4);
        if ((PHM & 2048) && IN(pb + 5)) {
            pg8::StaticOrder S; S.init(F.MIX, F.WB + WB_OUT, TT, 1024, 1024, F.G, F.wg);
            pg8::EpiResid E{F.X, mods_l};
            pg8::gemm_phase(F.lds, 1024, S, E, F.wave);
        } SEAM(pb + 5);
        if ((PHM & 4096) && IN(pb + 6)) { if (REPM & 4096) ph_ln_router(fresh(F), l, true); ph_ln_router(fresh(F), l); } SEAM(pb + 6);
        if ((PHM & 8192) && IN(pb + 7)) {
            const int ntiles = moe_tables(fresh(F), l);
            pg8::MoeGU S; S.cnt = (const LAS int*)(F.lds + LDS_MISC + MISC_CNT); S.tst = (const LAS int*)(F.lds + LDS_MISC + MISC_TST); S.t2e = (const LAS unsigned char*)(F.lds + LDS_MISC + MISC_T2E);
            S.ntiles = ntiles; S.G = F.G; S.c = F.wg; S.A = (const char*)F.HB; S.Bt = (const char*)(F.WB + WB_GU); S.stok = (const int*)(F.ws + OFF_STOK);
            pg8::EpiSwiglu E{(bf16_t*)(F.R1 + R1_H)};
            for (int rep = 0; rep < ((REPM & 8192) ? 2 : 1); ++rep) pg8::gemm_phase(F.lds, 1024, S, E, F.wave);
        } SEAM(pb + 7);
        if ((PHM & 16384) && IN(pb + 8)) {
            const int ntiles = moe_tables(fresh(F), l);
            pg8::MoeDN S; S.cnt = (const LAS int*)(F.lds + LDS_MISC + MISC_CNT); S.tst = (const LAS int*)(F.lds + LDS_MISC + MISC_TST); S.t2e = (const LAS unsigned char*)(F.lds + LDS_MISC + MISC_T2E);
            S.ntiles = ntiles; S.G = F.G; S.c = F.wg; S.A = (const char*)(F.R1 + R1_H); S.Bt = (const char*)(F.WB + WB_DN);
            pg8::EpiDown E{(unsigned char*)(F.R1 + R1_Y), (const float*)(F.ws + OFF_SW), (const LAS int*)(F.lds + LDS_MISC + MISC_CNT)};
            for (int rep = 0; rep < ((REPM & 16384) ? 2 : 1); ++rep) pg8::gemm_phase(F.lds, 256, S, E, F.wave);
        } SEAM(pb + 8);
        if ((PHM & 32768) && IN(pb + 9)) { if (REPM & 32768) ph_combine(fresh(F), l, true); ph_combine(fresh(F), l); } SEAM(pb + 9);
    }
#undef IN
#undef SEAM
}

extern "C" void kernel_launch(void* const* d_in, const int* in_sizes, int n_in, void* d_out, int out_size, void* d_ws, size_t ws_size, hipStream_t stream) {
    static int grid = 0;
    if (grid == 0) {
        if (n_in != 30 || out_size != TX * DM || ws_size < WS_END) { fprintf(stderr, "kernel_launch: unexpected problem (n_in %d out %d ws %zu need %zu)\n", n_in, out_size, ws_size, (size_t)WS_END); grid = -1; return; }
        int dev = 0, cus = 0, per_cu = 0;
        if (hipGetDevice(&dev) != hipSuccess || hipDeviceGetAttribute(&cus, hipDeviceAttributeMultiprocessorCount, dev) != hipSuccess) { grid = -1; return; }
        if (hipFuncSetAttribute((const void*)mk_fwd, hipFuncAttributeMaxDynamicSharedMemorySize, LDS_BYTES) != hipSuccess) { fprintf(stderr, "kernel_launch: hipFuncSetAttribute failed\n"); grid = -1; return; }
        if (hipOccupancyMaxActiveBlocksPerMultiprocessor(&per_cu, (const void*)mk_fwd, 512, LDS_BYTES) != hipSuccess || per_cu < 1) { fprintf(stderr, "kernel_launch: occupancy query says %d\n", per_cu); }
        (void)hipGetLastError();
        grid = cus;
    }
    if (grid < 0) return;
    (void)hipMemsetAsync((char*)d_ws + OFF_CTL, 0, CTL_BYTES, stream);
    Args a{};
    for (int i = 0; i < 30; ++i) a.in[i] = (const float*)d_in[i];
    a.out = (float*)d_out; a.ws = (unsigned char*)d_ws;
#if MK_SPLIT
    for (int p = 0; p < NPHASE; ++p) { a.ph_lo = p; a.ph_hi = p + 1; hipLaunchKernelGGL(mk_fwd, dim3(grid), dim3(512), LDS_BYTES, stream, a); }
#else
    a.ph_lo = 0; a.ph_hi = NPHASE;
    hipLaunchKernelGGL(mk_fwd, dim3(grid), dim3(512), LDS_BYTES, stream, a);
#endif
}
```

```cpp
#include <hip/hip_runtime.h>
#include <cstdio>
#include <cstdint>

#ifndef PHM
#define PHM 0xFFFF
#endif
#ifndef REPM
#define REPM 0
#endif
#ifndef MK_SPLIT
#define MK_SPLIT 0
#endif

typedef unsigned short bf16_t;
typedef short bf16x8 __attribute__((ext_vector_type(8)));
typedef short bf16x4 __attribute__((ext_vector_type(4)));
typedef float f32x4 __attribute__((ext_vector_type(4)));
typedef float f32x2 __attribute__((ext_vector_type(2)));
typedef unsigned u32x4 __attribute__((ext_vector_type(4)));
typedef unsigned u32x2 __attribute__((ext_vector_type(2)));
#define LAS __attribute__((address_space(3)))

constexpr int DM = 1024, NBAT = 4, SEQ = 8192, CTXL = 256;
constexpr int TC = NBAT * CTXL, TX = NBAT * SEQ, TT = TC + TX;
constexpr int NEXP = 64, TOPK = 6;
constexpr int CAP = TT;
constexpr int MOE_ROUTED_ROWS = 6 * TT + 64 * 256;
constexpr int MOE_ROWS = MOE_ROUTED_ROWS + TT;
constexpr int MOE_MAXTILES = MOE_ROWS / 256;
constexpr float ALPHA = 1.681792830507429f;
constexpr int HG_U = 128, HG_NU = (CTXL + SEQ) / HG_U;
constexpr int LRU_NT = (CTXL + SEQ) / 16;

constexpr size_t OFF_CTL = 0, CTL_BYTES = 65536;
constexpr size_t CTL_CNT = 16384, CTL_DBG = 20480;
constexpr size_t OFF_MODS = 65536;
constexpr size_t OFF_LBT = OFF_MODS + 4 * 5 * 6144 * 4;
constexpr size_t OFF_STATS = OFF_LBT + 8192;
constexpr size_t OFF_AB = OFF_STATS + (size_t)TT * 8;
static_assert(OFF_AB + 4 * 5 * 2 * 1024 * 4 <= (1u << 20), "ctl map");
constexpr size_t OFF_TOKE = 1u << 20;
constexpr size_t OFF_TOKP = OFF_TOKE + (size_t)TT * 32;
constexpr size_t OFF_TOKW = OFF_TOKP + (size_t)TT * 32;
constexpr size_t OFF_STOK = OFF_TOKW + (size_t)TT * 32;
constexpr size_t OFF_SW = OFF_STOK + (size_t)64 * CAP * 4;
constexpr size_t OFF_X = OFF_SW + (size_t)64 * CAP * 4;
constexpr size_t OFF_HB = OFF_X + (size_t)TT * DM * 4;
constexpr size_t OFF_WB = OFF_HB + (size_t)TT * DM * 2;
constexpr size_t WB_IN = 0, WB_OUT = WB_IN + (size_t)4096 * 1024 * 2, WB_RT = WB_OUT + (size_t)1024 * 1024 * 2, WB_GU = WB_RT + (size_t)64 * 1024 * 2,
                 WB_DN = WB_GU + (size_t)65 * 512 * 1024 * 2, WB_LRU = WB_DN + (size_t)65 * 1024 * 256 * 2, WB_END = WB_LRU + (size_t)2 * 2 * 16 * 64 * 64 * 2;
constexpr size_t OFF_R1 = OFF_WB + 2 * WB_END;
constexpr size_t R1_P = 0;
constexpr size_t R1_OF = R1_P + (size_t)TT * 4096 * 2;
constexpr size_t R1_SLOC = R1_OF + (size_t)TT * 512 * 4;
constexpr size_t R1_SST = R1_SLOC + (size_t)64 * HG_NU * 4096 * 4;
constexpr size_t R1_DL = R1_SST + (size_t)64 * HG_NU * 4096 * 4;
constexpr size_t R1_AG = (size_t)TT * 2048 * 2;
constexpr size_t R1_HST = R1_AG + (size_t)4 * 2 * LRU_NT * 2 * 1024 * 4;
constexpr size_t R1_GX = R1_HST + (size_t)4 * 2 * LRU_NT * 1024 * 4;
constexpr size_t R1_LRU_END = R1_GX + (size_t)TT * 2 * 1024 * 2 * 2;
constexpr size_t R1_H = 0;
constexpr size_t R1_Y = R1_H + (size_t)MOE_ROWS * 256 * 2;
constexpr size_t R1_MOE_END = R1_Y + (size_t)MOE_ROWS * 1024;
constexpr size_t R1_MIX_END = R1_DL + (size_t)64 * HG_NU * 64 * 4;
constexpr size_t R1_END_ = (R1_MOE_END > R1_MIX_END ? R1_MOE_END : R1_MIX_END);
constexpr size_t WS_END = OFF_R1 + (R1_END_ > R1_LRU_END ? R1_END_ : R1_LRU_END);

constexpr int LDS_STAGE = 131072;
constexpr int LDS_MISC = LDS_STAGE;
constexpr int MISC_CNT = 64;
constexpr int MISC_TST = MISC_CNT + 66 * 4 + 8;
constexpr int MISC_HIST = 640;
constexpr int MISC_HBASE = 896;
constexpr int MISC_T2E = 1152;
constexpr int MISC_INP = 2304;
constexpr int LDS_BYTES = 147456;

#define XB_TMO      128
#define XB_XCNT(j)  (256  + 64 * (j))
#define XB_XSUB(j)  (1280 + 64 * (j))
#define XB_XGEN(j)  (2304 + 64 * (j))
#define XB_TOP      3328
#define XB_TOPGEN   3392
#define XCD_BAR_WORDS 3456
#define XB_SPIN_CAP (1u << 22)
__device__ __forceinline__ unsigned xb_ld(unsigned* p)              { return __hip_atomic_load(p, __ATOMIC_RELAXED, __HIP_MEMORY_SCOPE_AGENT); }
__device__ __forceinline__ unsigned xb_add(unsigned* p, unsigned v) { return __hip_atomic_fetch_add(p, v, __ATOMIC_RELAXED, __HIP_MEMORY_SCOPE_AGENT); }
__device__ __forceinline__ unsigned xb_xcc_id() { return (unsigned)__builtin_amdgcn_s_getreg((3 << 11) | 20) & 0xFu; }
#define XB_SPIN(cond, bar) do { unsigned _sp = 0; while (cond) { __builtin_amdgcn_s_sleep(1); \
    if ((++_sp & 255u) == 0u) { if (xb_ld(&(bar)[XB_TMO])) break; if (_sp > XB_SPIN_CAP) { atomicAdd(&(bar)[XB_TMO], 1u); break; } } } } while (0)
struct XcdBarrier { unsigned* bar; unsigned x; volatile LAS unsigned* st; };
__device__ __forceinline__ XcdBarrier xcd_barrier_post(unsigned* bar, volatile LAS unsigned* st) {
    XcdBarrier b; b.bar = bar; b.x = xb_xcc_id(); b.st = st;
    if (threadIdx.x == 0) (void)xb_add(&bar[XB_XCNT(b.x)], 1u);
    return b;
}
__device__ __forceinline__ void xcd_barrier_complete(unsigned* bar, unsigned x, unsigned& nloc, unsigned& nx) {
    const unsigned G = gridDim.x * gridDim.y * gridDim.z;
    unsigned sum, cnt, mine, sp = 0u;
    for (;;) {
        sum = 0u; cnt = 0u; mine = 0u;
#pragma unroll
        for (unsigned j = 0; j < 16; ++j) { const unsigned c = xb_ld(&bar[XB_XCNT(j)]); sum += c; cnt += (c > 0u) ? 1u : 0u; mine = (j == x) ? c : mine; }
        if (sum == G) break;
        __builtin_amdgcn_s_sleep(1);
        if ((++sp & 255u) == 0u) { if (xb_ld(&bar[XB_TMO])) break; if (sp > XB_SPIN_CAP) { atomicAdd(&bar[XB_TMO], 1u); break; } }
    }
    nloc = mine > 0u ? mine : 1u; nx = cnt > 0u ? cnt : 1u;
}
__device__ __forceinline__ void xcd_barrier(const XcdBarrier& b) {
    asm volatile("s_waitcnt vmcnt(0)" ::: "memory");
    __syncthreads();
    if (threadIdx.x == 0) {
        unsigned* bar = b.bar;
        __builtin_amdgcn_s_waitcnt(0);
        unsigned nloc = b.st[0], nx = b.st[1];
        if (nloc == 0u) { xcd_barrier_complete(bar, b.x, nloc, nx); b.st[0] = nloc; b.st[1] = nx; }
        const unsigned old = xb_add(&bar[XB_XSUB(b.x)], 1u);
        const unsigned gen = old / nloc;
        if (old + 1u == (gen + 1u) * nloc) {
            __builtin_amdgcn_fence(__ATOMIC_RELEASE, "agent");
            asm volatile("s_waitcnt vmcnt(0)" ::: "memory");
            const unsigned og = xb_add(&bar[XB_TOP], 1u);
            const unsigned tg = og / nx;
            if (og + 1u == (tg + 1u) * nx) xb_add(&bar[XB_TOPGEN], 1u);
            else XB_SPIN(xb_ld(&bar[XB_TOPGEN]) == tg, bar);
            __builtin_amdgcn_fence(__ATOMIC_ACQUIRE, "agent");
            xb_add(&bar[XB_XGEN(b.x)], 1u);
            asm volatile("s_waitcnt vmcnt(0)" ::: "memory");
        } else {
            XB_SPIN(xb_ld(&bar[XB_XGEN(b.x)]) == gen, bar);
            __builtin_amdgcn_fence(__ATOMIC_ACQUIRE, "agent");
            asm volatile("s_waitcnt vmcnt(0)" ::: "memory");
        }
    }
    __syncthreads();
}

__device__ __forceinline__ float bf2f(unsigned short b) { return __uint_as_float(((unsigned)b) << 16); }
__device__ __forceinline__ unsigned cvt_pk_bf16(float lo, float hi) { unsigned r; asm volatile("v_cvt_pk_bf16_f32 %0, %1, %2" : "=v"(r) : "v"(lo), "v"(hi)); return r; }
__device__ __forceinline__ unsigned short f2bf(float f) { return (unsigned short)(cvt_pk_bf16(f, 0.f) & 0xffffu); }
__device__ __forceinline__ float sigmoidf_(float x) { return __builtin_amdgcn_rcpf(1.0f + __expf(-x)); }
__device__ __forceinline__ float siluf_(float x) { return x * sigmoidf_(x); }
__device__ __forceinline__ float gelu_tanh_(float x) { return x * sigmoidf_(1.5957691216057308f * (x + 0.044715f * x * x * x)); }
__device__ __forceinline__ int slot_of_row(int r) { return r < TC ? 4 : ((r - TC) >> 13); }
template <int CTRL> __device__ __forceinline__ float dppf(float oldv, float src) {
    return __int_as_float(__builtin_amdgcn_update_dpp(__float_as_int(oldv), __float_as_int(src), CTRL, 0xf, 0xf, false));
}
__device__ __forceinline__ void unpack8(const u32x4 w, float (&o)[8]) {
    o[0] = __uint_as_float(w.x << 16); o[1] = __uint_as_float(w.x & 0xffff0000u); o[2] = __uint_as_float(w.y << 16); o[3] = __uint_as_float(w.y & 0xffff0000u);
    o[4] = __uint_as_float(w.z << 16); o[5] = __uint_as_float(w.z & 0xffff0000u); o[6] = __uint_as_float(w.w << 16); o[7] = __uint_as_float(w.w & 0xffff0000u);
}

namespace pg8 {
constexpr int BM = 256, BK = 64, HALF = 128, HTB = HALF * BK * 2, STAGE_BYTES = 8 * HTB, NXCD = 8, WGM = 8;
__device__ __forceinline__ int lds_byte(int r, int c) { const int st = (r >> 4) * 2 + (c >> 5), rr = r & 15, cc = c & 31, ob = rr * 64 + cc * 2; return st * 1024 + (ob ^ (((ob >> 9) & 1) << 5)); }
__device__ __forceinline__ void stage_rc(int b, int& R, int& C) { const int st = b / 1024, sb = b % 1024, swz = sb ^ (((sb >> 9) & 1) << 5); R = (st >> 1) * 16 + swz / 64; C = (st & 1) * 32 + (swz % 64) / 2; }
__device__ __forceinline__ int perm32(int rho) { const int n = rho >> 4, i = rho & 15; return 8 * (i >> 2) + 4 * n + (i & 3); }
struct Unit { int pm, pn, e, ti; };

struct StaticOrder {
    const char* A; const char* Bt; int K;
    int nM, nN, nwg, G, c;
    __device__ __forceinline__ void init(const void* A_, const void* Bt_, int M, int N, int K_, int G_, int c_) { A = (const char*)A_; Bt = (const char*)Bt_; K = K_; nM = M / BM; nN = N / BM; nwg = nM * nN; G = G_; c = c_; }
    __device__ __forceinline__ bool next(int i, Unit& u) const {
        const long L = (long)i * G + c; if (L >= nwg) return false;
        int wgid = (int)L; { const int q = nwg / NXCD, r = nwg % NXCD, xcd = wgid % NXCD, off = wgid / NXCD; wgid = (xcd < r ? xcd * (q + 1) : r * (q + 1) + (xcd - r) * q) + off; }
        const int nig = WGM * nN, gid = wgid / nig, fm = gid * WGM, gsz = (nM - fm) < WGM ? (nM - fm) : WGM;
        u.pm = fm + ((wgid % nig) % gsz); u.pn = (wgid % nig) / gsz; u.e = 0; u.ti = 0; return true;
    }
    static constexpr bool GATHER = false;
    __device__ __forceinline__ const char* abase(const Unit& u) const { return A + (size_t)u.pm * BM * K * 2; }
    __device__ __forceinline__ const char* bbase(const Unit& u) const { return Bt + (size_t)u.pn * BM * K * 2; }
};

template <class Epi, class Sched>
__device__ __forceinline__ void gemm_phase(LAS unsigned char* lds, const int K_, const Sched& S, const Epi& E, const int wave_) {
    int Kl_ = K_; asm volatile("" : "+s"(Kl_)); const int K = Kl_;
    int tid_ = wave_ * 64 + (int)__builtin_amdgcn_mbcnt_hi(~0u, __builtin_amdgcn_mbcnt_lo(~0u, 0u)); asm volatile("" : "+v"(tid_));
    const int tid = tid_, wid = __builtin_amdgcn_readfirstlane(tid >> 6), lane = tid & 63, wr = wid >> 2, wc = wid & 3, fr = lane & 15, fq = lane >> 4;
    const int nt = K / BK;
    unsigned voffA[2], voffB[2];
#pragma unroll
    for (int i = 0; i < 2; ++i) { int R, C; stage_rc(tid * 16 + i * 8192, R, C);
        const int Rb = Epi::PERM == 1 ? ((R & ~31) + perm32(R & 31)) : Epi::PERM == 2 ? (64 * (R >> 5) + 16 * ((R & 15) >> 2) + 4 * ((R >> 4) & 1) + (R & 3)) : R;
        voffA[i] = (unsigned)(R * K + C) * 2u; voffB[i] = (unsigned)(Rb * K + C) * 2u; }
    const size_t kstep = (size_t)(BK * 2);
    const size_t hstep = (size_t)HALF * K * 2;
    const size_t hstepB = Epi::PERM == 2 ? (size_t)8 * K * 2 : hstep;
    const unsigned ldsw = (unsigned)wid * 1024u;
    const int aoff = lds_byte(wr * 64 + fr, fq * 8), boff = lds_byte(wc * 32 + fr, fq * 8);
#define PG8_SA(b, h) (((b) * 2 + (h)) * HTB)
#define PG8_SB(b, h) ((4 + (b) * 2 + (h)) * HTB)
#define PG8_STAGE(bufoff, gbase, voff) do { _Pragma("unroll") for (int _i = 0; _i < 2; ++_i) \
        __builtin_amdgcn_global_load_lds((const unsigned*)((const char*)(gbase) + (voff)[_i]), (LAS unsigned*)(lds + (bufoff) + ldsw + _i * 8192), 16, 0, 0); } while (0)
#define PG8_STAGEA(bufoff, hh, kb, nx) do { if constexpr (Sched::GATHER) { unsigned _o[2]; _o[0] = (nx) ? vN[hh][0] : vC[hh][0]; _o[1] = (nx) ? vN[hh][1] : vC[hh][1]; PG8_STAGE(bufoff, cA + (kb), _o); } \
        else { PG8_STAGE(bufoff, ((nx) ? nA : cA) + (hh) * hstep + (kb), voffA); } } while (0)
#define PG8_LDA(dst, b, h) do { _Pragma("unroll") for (int m = 0; m < 4; ++m) _Pragma("unroll") for (int k = 0; k < 2; ++k) dst[m][k] = *(const LAS bf16x8*)(lds + PG8_SA(b, h) + aoff + m * 2048 + k * 1024); } while (0)
#define PG8_LDB(dst, b, h) do { _Pragma("unroll") for (int n = 0; n < 2; ++n) _Pragma("unroll") for (int k = 0; k < 2; ++k) dst[n][k] = *(const LAS bf16x8*)(lds + PG8_SB(b, h) + boff + n * 2048 + k * 1024); } while (0)
#define PG8_MMA(ai, bj, At, Bt) do { __builtin_amdgcn_s_setprio(1); _Pragma("unroll") for (int m = 0; m < 4; ++m) _Pragma("unroll") for (int n = 0; n < 2; ++n) _Pragma("unroll") for (int k = 0; k < 2; ++k) \
        acc[ai][bj][m][n] = __builtin_amdgcn_mfma_f32_16x16x32_bf16(Bt[n][k], At[m][k], acc[ai][bj][m][n], 0, 0, 0); __builtin_amdgcn_s_setprio(0); } while (0)
#define PG8_WAIT_V(n) asm volatile("s_waitcnt vmcnt(" #n ")" ::: "memory")
#define PG8_WAIT_L(n) asm volatile("s_waitcnt lgkmcnt(" #n ")" ::: "memory")
#define PG8_BAR __builtin_amdgcn_s_barrier()
#define PG8_SCHED __builtin_amdgcn_sched_barrier(0)
    Unit cur, nxt; int ui = 0;
    if (!S.next(0, cur)) return;
    f32x4 acc[2][2][4][2];
#pragma unroll
    for (int a = 0; a < 2; ++a)
#pragma unroll
        for (int b = 0; b < 2; ++b)
#pragma unroll
            for (int m = 0; m < 4; ++m)
#pragma unroll
                for (int n = 0; n < 2; ++n) acc[a][b][m][n] = (f32x4){0.f, 0.f, 0.f, 0.f};
    bf16x8 At[4][2], B0[2][2], B1[2][2];
    unsigned vC[2][2], vN[2][2];
    if constexpr (Sched::GATHER) S.aoff(cur, tid, vC);
    const char* cA = S.abase(cur);
    const char* cB = S.bbase(cur);
    const char* nA = cA;
    PG8_STAGE(PG8_SB(0, 0), cB, voffB); PG8_STAGEA(PG8_SA(0, 0), 0, 0, false); PG8_STAGE(PG8_SB(0, 1), cB + hstepB, voffB); PG8_STAGEA(PG8_SA(0, 1), 1, 0, false);
    if (wr == 1) PG8_BAR;
    PG8_WAIT_V(4); PG8_BAR;
    PG8_STAGE(PG8_SB(1, 0), cB + kstep, voffB); PG8_STAGEA(PG8_SA(1, 0), 0, kstep, false); PG8_STAGE(PG8_SB(1, 1), cB + hstepB + kstep, voffB);
    PG8_WAIT_V(6); PG8_BAR;
    for (;;) {
        const bool has_next = S.next(ui + 1, nxt);
        const char* nB = cB; nA = cA;
        if (has_next) { nB = S.bbase(nxt); nA = S.abase(nxt); if constexpr (Sched::GATHER) S.aoff(nxt, tid, vN); }
        else { if constexpr (Sched::GATHER) {
#pragma unroll
            for (int h = 0; h < 2; ++h)
#pragma unroll
                for (int i = 0; i < 2; ++i) vN[h][i] = vC[h][i]; } }
        for (int t = 0; t < nt; t += 2) {
            const bool last = (t == nt - 2);
            const size_t k1 = (size_t)(t + 1) * kstep, k2 = last ? 0 : (size_t)(t + 2) * kstep, k3 = k2 + kstep;
            const char* b2 = last ? nB : cB + (size_t)(t + 2) * kstep; const char* b3 = b2 + kstep;
            PG8_LDB(B0, 0, 0); PG8_SCHED; PG8_LDA(At, 0, 0); PG8_STAGEA(PG8_SA(1, 1), 1, k1, false);
            PG8_WAIT_L(8); PG8_BAR; PG8_WAIT_L(0); PG8_MMA(0, 0, At, B0); PG8_BAR; PG8_SCHED;
            PG8_LDB(B1, 0, 1); PG8_STAGE(PG8_SB(0, 0), b2, voffB);
            PG8_BAR; PG8_WAIT_L(0); PG8_MMA(0, 1, At, B1); PG8_BAR;
            PG8_LDA(At, 0, 1); PG8_STAGEA(PG8_SA(0, 0), 0, k2, last);
            PG8_BAR; PG8_WAIT_L(0); PG8_MMA(1, 0, At, B0); PG8_BAR; PG8_SCHED;
            PG8_STAGE(PG8_SB(0, 1), b2 + hstepB, voffB);
            PG8_WAIT_V(6); PG8_BAR; PG8_MMA(1, 1, At, B1); PG8_BAR;
            PG8_LDB(B0, 1, 0); PG8_SCHED; PG8_LDA(At, 1, 0); PG8_STAGEA(PG8_SA(0, 1), 1, k2, last);
            PG8_WAIT_L(8); PG8_BAR; PG8_WAIT_L(0); PG8_MMA(0, 0, At, B0); PG8_BAR; PG8_SCHED;
            PG8_LDB(B1, 1, 1); PG8_STAGE(PG8_SB(1, 0), b3, voffB);
            PG8_BAR; PG8_WAIT_L(0); PG8_MMA(0, 1, At, B1); PG8_BAR;
            PG8_LDA(At, 1, 1); PG8_STAGEA(PG8_SA(1, 0), 0, k3, last);
            PG8_BAR; PG8_WAIT_L(0); PG8_MMA(1, 0, At, B0); PG8_BAR; PG8_SCHED;
            PG8_STAGE(PG8_SB(1, 1), b3 + hstepB, voffB);
            PG8_WAIT_V(6); PG8_BAR; PG8_MMA(1, 1, At, B1); PG8_BAR;
        }
        E(acc, cur, wr, wc, fr, fq);
        if (!has_next) break;
#pragma unroll
        for (int a = 0; a < 2; ++a)
#pragma unroll
            for (int b = 0; b < 2; ++b)
#pragma unroll
                for (int m = 0; m < 4; ++m)
#pragma unroll
                    for (int n = 0; n < 2; ++n) acc[a][b][m][n] = (f32x4){0.f, 0.f, 0.f, 0.f};
        cur = nxt; cB = nB; cA = nA; ++ui;
        if constexpr (Sched::GATHER) {
#pragma unroll
            for (int h = 0; h < 2; ++h)
#pragma unroll
                for (int i = 0; i < 2; ++i) vC[h][i] = vN[h][i]; }
    }
    PG8_WAIT_V(0);
    if (wr == 0) PG8_BAR;
    PG8_BAR;
#undef PG8_SA
#undef PG8_SB
#undef PG8_STAGE
#undef PG8_STAGEA
#undef PG8_LDA
#undef PG8_LDB
#undef PG8_MMA
#undef PG8_WAIT_V
#undef PG8_WAIT_L
#undef PG8_BAR
#undef PG8_SCHED
}

struct EpiStoreBf16 {
    static constexpr int PERM = 2;
    bf16_t* O; int ldc;
    __device__ __forceinline__ void operator()(const f32x4 (&acc)[2][2][4][2], const Unit& u, int wr, int wc, int fr, int fq) const {
        const int row0 = u.pm * BM + wr * 64 + fr, col0 = u.pn * BM + wc * 64 + 16 * fq;
#pragma unroll
        for (int ai = 0; ai < 2; ++ai)
#pragma unroll
            for (int m = 0; m < 4; ++m) { bf16_t* rowp = O + (size_t)(row0 + ai * HALF + m * 16) * ldc + col0;
#pragma unroll
                for (int bj = 0; bj < 2; ++bj) { const f32x4 v0 = acc[ai][bj][m][0], v1 = acc[ai][bj][m][1];
                    u32x4 w; w.x = cvt_pk_bf16(v0[0], v0[1]); w.y = cvt_pk_bf16(v0[2], v0[3]); w.z = cvt_pk_bf16(v1[0], v1[1]); w.w = cvt_pk_bf16(v1[2], v1[3]);
                    *(u32x4*)(rowp + bj * 8) = w; } }
    }
};
struct EpiResid {
    static constexpr int PERM = 0;
    float* X; const float* mods_l; int rbase;
    __device__ __forceinline__ void operator()(const f32x4 (&acc)[2][2][4][2], const Unit& u, int wr, int wc, int fr, int fq) const {
        const int row0 = u.pm * BM + wr * 64 + fr, col0 = u.pn * BM + wc * 32 + 4 * fq;
        const float* m2 = mods_l + (size_t)(slot_of_row(rbase + u.pm * BM) * 6 + 2) * DM + col0;
        float* xb = X + (size_t)row0 * DM + col0;
#pragma unroll
        for (int bj = 0; bj < 2; ++bj)
#pragma unroll
            for (int n = 0; n < 2; ++n) { const f32x4 mv = *(const f32x4*)(m2 + bj * HALF + n * 16);
                f32x4 xv[8];
#pragma unroll
                for (int q = 0; q < 8; ++q) xv[q] = *(const f32x4*)(xb + (size_t)((q >> 2) * HALF + (q & 3) * 16) * DM + bj * HALF + n * 16);
#pragma unroll
                for (int q = 0; q < 8; ++q) *(f32x4*)(xb + (size_t)((q >> 2) * HALF + (q & 3) * 16) * DM + bj * HALF + n * 16) = xv[q] * ALPHA + mv * acc[q >> 2][bj][q & 3][n];
                asm volatile("" ::: "memory"); }
    }
};
struct EpiSwiglu {
    static constexpr int PERM = 1;
    bf16_t* H;
    __device__ __forceinline__ void operator()(const f32x4 (&acc)[2][2][4][2], const Unit& u, int wr, int wc, int fr, int fq) const {
        const int row0 = u.pm * BM + wr * 64 + fr, col0 = u.pn * HALF + wc * 32 + 8 * fq;
#pragma unroll
        for (int ai = 0; ai < 2; ++ai)
#pragma unroll
            for (int m = 0; m < 4; ++m) { bf16_t* rowp = H + (size_t)(row0 + ai * HALF + m * 16) * 256 + col0;
                float h[8];
#pragma unroll
                for (int n = 0; n < 2; ++n)
#pragma unroll
                    for (int j = 0; j < 4; ++j) h[n * 4 + j] = siluf_(acc[ai][0][m][n][j]) * acc[ai][1][m][n][j];
                u32x4 w; w.x = cvt_pk_bf16(h[0], h[1]); w.y = cvt_pk_bf16(h[2], h[3]); w.z = cvt_pk_bf16(h[4], h[5]); w.w = cvt_pk_bf16(h[6], h[7]);
                *(u32x4*)rowp = w; }
    }
};
struct EpiDown {
    static constexpr int PERM = 2;
    unsigned char* Y; const float* sw; const LAS int* cnt;
    __device__ __forceinline__ void operator()(const f32x4 (&acc)[2][2][4][2], const Unit& u, int wr, int wc, int fr, int fq) const {
        const int row0 = u.pm * BM + wr * 64 + fr, col0 = u.pn * BM + wc * 64 + 16 * fq;
        const int ce = (u.e < 64) ? cnt[u.e] : 0;
        const float* swe = sw + (size_t)(u.e < 64 ? u.e : 0) * CAP + u.ti * 256 + wr * 64 + fr;
        unsigned char* yb = Y + (size_t)row0 * DM + col0;
        float wv[8];
#pragma unroll
        for (int q = 0; q < 8; ++q) { const int rl = (q >> 2) * HALF + (q & 3) * 16, pos = u.ti * 256 + wr * 64 + fr + rl; wv[q] = 32.0f; if (u.e < 64) wv[q] = (pos < ce) ? swe[rl] * 32.0f : 0.0f; }
#pragma unroll
        for (int ai = 0; ai < 2; ++ai)
#pragma unroll
            for (int m = 0; m < 4; ++m) { const int rl = ai * HALF + m * 16; const float w = wv[ai * 4 + m];
                u32x4 ww; unsigned pk[4];
#pragma unroll
                for (int bj = 0; bj < 2; ++bj)
#pragma unroll
                    for (int n = 0; n < 2; ++n) { f32x4 v = acc[ai][bj][m][n] * w;
#pragma unroll
                        for (int j = 0; j < 4; ++j) v[j] = __builtin_amdgcn_fmed3f(v[j], -440.0f, 440.0f);
                        int p = __builtin_amdgcn_cvt_pk_fp8_f32(v[0], v[1], 0, false); p = __builtin_amdgcn_cvt_pk_fp8_f32(v[2], v[3], p, true); pk[bj * 2 + n] = (unsigned)p; }
                ww.x = pk[0]; ww.y = pk[1]; ww.z = pk[2]; ww.w = pk[3];
                __builtin_nontemporal_store(ww, (u32x4*)(yb + (size_t)rl * DM));
                asm volatile("" ::: "memory"); }
    }
};
struct EpiNull {
    static constexpr int PERM = 1;
    __device__ __forceinline__ void operator()(const f32x4 (&acc)[2][2][4][2], const Unit&, int, int, int, int) const {
#pragma unroll
        for (int ai = 0; ai < 2; ++ai)
#pragma unroll
            for (int bj = 0; bj < 2; ++bj)
#pragma unroll
                for (int m = 0; m < 4; ++m)
#pragma unroll
                    for (int n = 0; n < 2; ++n) asm volatile("" :: "v"(acc[ai][bj][m][n]));
    }
};
template <int NPN> struct MoeOrder {
    const LAS int* cnt; const LAS int* tst; const LAS unsigned char* t2e; int ntiles, G, c;
    __device__ __forceinline__ bool next(int i, Unit& u) const {
        const int cs = ((G & 7) == 0) ? (c & 7) * (G >> 3) + (c >> 3) : c;
        const int L = i * G + cs; if (L >= ntiles * NPN) return false;
        const int tau = L / NPN; u.pm = tau; u.pn = L % NPN; u.e = t2e[tau]; u.ti = tau - tst[u.e]; return true;
    }
};
struct MoeGU : MoeOrder<2> {
    static constexpr bool GATHER = true;
    const char* A; const char* Bt; const int* stok; int t0;
    __device__ __forceinline__ const char* abase(const Unit&) const { return A; }
    __device__ __forceinline__ const char* bbase(const Unit& u) const { return Bt + ((size_t)u.e * 512 + (size_t)u.pn * 256) * 1024 * 2; }
    __device__ __forceinline__ void aoff(const Unit& u, int tid, unsigned (&off)[2][2]) const {
        const int ce = cnt[u.e];
#pragma unroll
        for (int i = 0; i < 2; ++i) { int R, C; stage_rc(tid * 16 + i * 8192, R, C);
#pragma unroll
            for (int h = 0; h < 2; ++h) { const int pos = u.ti * 256 + h * HALF + R; int tok;
                if (u.e == 64) tok = t0 + pos; else tok = (pos < ce) ? stok[(size_t)u.e * CAP + pos] : 0;
                off[h][i] = (unsigned)(tok * 1024 + C) * 2u; } }
    }
};
struct MoeDN : MoeOrder<4> {
    static constexpr bool GATHER = false;
    const char* A; const char* Bt;
    __device__ __forceinline__ const char* abase(const Unit& u) const { return A + (size_t)u.pm * BM * 256 * 2; }
    __device__ __forceinline__ const char* bbase(const Unit& u) const { return Bt + ((size_t)u.e * 1024 + (size_t)u.pn * 256) * 256 * 2; }
};
}

struct Args { const float* in[30]; float* out; unsigned char* ws; int ph_lo, ph_hi; };

struct Frame {
    float* out; unsigned char* ws; LAS unsigned char* lds; int tid, lane, wave, G, wg;
    float* mods; float* X; bf16_t* HB; bf16_t* MIX; unsigned char* WB; unsigned char* R1;
};

__device__ __forceinline__ const float* inp(const Frame& F, int i) {
    const unsigned long long v = ((const LAS unsigned long long*)(F.lds + LDS_MISC + MISC_INP))[i];
    const unsigned lo = (unsigned)__builtin_amdgcn_readfirstlane((int)(unsigned)v), hi = (unsigned)__builtin_amdgcn_readfirstlane((int)(unsigned)(v >> 32));
    return (const float*)(((unsigned long long)hi << 32) | lo);
}
__device__ __forceinline__ int lane_id_() { return (int)__builtin_amdgcn_mbcnt_hi(~0u, __builtin_amdgcn_mbcnt_lo(~0u, 0u)); }
__device__ __forceinline__ Frame fresh(const Frame& F0) { Frame F = F0; int ln = lane_id_(); asm volatile("" : "+v"(ln)); F.lane = ln; F.tid = F0.wave * 64 + ln; return F; }

__device__ __forceinline__ void ph_mods(const Frame& F) {
    const float* c = inp(F, 1); const float* cc = inp(F, 3); const float* ada_w = inp(F, 4); const float* ada_b = inp(F, 5);
    LAS float* sv = (LAS float*)F.lds;
    LAS float* red = (LAS float*)(F.lds + 5 * 1024 * 4);
    for (int i = F.tid; i < 5 * 1024; i += 512) { const int s = i >> 10, k = i & 1023; const float v = (s < 4) ? c[s * 1024 + k] : cc[k]; sv[i] = siluf_(v); }
    __syncthreads();
    for (int task = F.wg; task < 4 * 48; task += F.G) {
        const int l = task / 48, cc0 = (task % 48) * 128;
        const int cg = F.tid & 31, kg = F.tid >> 5;
        const float* w = ada_w + (size_t)l * 1024 * 6144 + cc0 + cg * 4;
        f32x4 acc[5];
#pragma unroll
        for (int s = 0; s < 5; ++s) acc[s] = (f32x4){0.f, 0.f, 0.f, 0.f};
#pragma unroll 8
        for (int kk = 0; kk < 64; ++kk) { const int k = kg * 64 + kk; const f32x4 wv = *(const f32x4*)(w + (size_t)k * 6144);
#pragma unroll
            for (int s = 0; s < 5; ++s) acc[s] += wv * sv[s * 1024 + k]; }
#pragma unroll
        for (int s = 0; s < 5; ++s)
#pragma unroll
            for (int q = 0; q < 4; ++q) red[((kg * 128) + cg * 4 + q) * 5 + s] = acc[s][q];
        __syncthreads();
        if (F.tid < 128) {
            const int col = cc0 + F.tid; const float bsv = ada_b[l * 6144 + col];
#pragma unroll
            for (int s = 0; s < 5; ++s) { float v = 0.f;
#pragma unroll
                for (int g2 = 0; g2 < 16; ++g2) v += red[((g2 * 128) + F.tid) * 5 + s];
                F.mods[(size_t)(l * 5 + s) * 6144 + col] = v + bsv; }
        }
        __syncthreads();
    }
    if (F.wg == F.G - 1) {
        const float* raw = inp(F, 11); float* lbt = (float*)(F.ws + OFF_LBT);
        for (int i = F.tid; i < 2 * 512; i += 512) { const int d = i >> 9, ch = i & 511; const float r0 = raw[(d * 2 + 0) * 512 + ch], r1 = raw[(d * 2 + 1) * 512 + ch];
            lbt[(0 * 2 + d) * 512 + ch] = 0.f; lbt[(1 * 2 + d) * 512 + ch] = sigmoidf_(r1 - r0); }
    }
}

__device__ __forceinline__ void ph_init_x(const Frame& F) {
    const float* x = inp(F, 0); const float* ctx = inp(F, 2);
    { const float* lg_ = inp(F, 6); const float* lb_ = inp(F, 7); float* AB = (float*)(F.ws + OFF_AB);
      for (int i = F.wg * 512 + F.tid; i < 4 * 5 * 1024; i += F.G * 512) { const int k = i & 1023, ls = i >> 10, l = ls / 5;
          const float* m = F.mods + (size_t)ls * 6144; const float g0 = lg_[(l * 2) * 1024 + k], b0 = lb_[(l * 2) * 1024 + k], m3 = m[3 * 1024 + k], m4 = m[4 * 1024 + k];
          AB[(size_t)ls * 2048 + k] = g0 * (1.0f + m4); AB[(size_t)ls * 2048 + 1024 + k] = b0 * (1.0f + m4) + m3; } }
    const int gw = F.wg * 8 + F.wave, nw = F.G * 8;
    for (int row = gw; row < TT; row += nw) {
        const float* src = row < TC ? ctx + (size_t)row * DM : x + (size_t)(row - TC) * DM;
        const float* m = F.mods + (size_t)(0 * 5 + slot_of_row(row)) * 6144;
#pragma unroll
        for (int hh = 0; hh < 2; ++hh) { const int k = hh * 512 + F.lane * 8;
            const f32x4 v0 = *(const f32x4*)(src + k), v1 = *(const f32x4*)(src + k + 4);
            *(f32x4*)(F.X + (size_t)row * DM + k) = v0; *(f32x4*)(F.X + (size_t)row * DM + k + 4) = v1;
            const f32x4 s0 = *(const f32x4*)(m + 1024 + k), s1 = *(const f32x4*)(m + 1024 + k + 4), b0 = *(const f32x4*)(m + k), b1 = *(const f32x4*)(m + k + 4);
            const f32x4 h0 = v0 * (s0 + 1.0f) + b0, h1 = v1 * (s1 + 1.0f) + b1;
            u32x4 w; w.x = cvt_pk_bf16(h0[0], h0[1]); w.y = cvt_pk_bf16(h0[2], h0[3]); w.z = cvt_pk_bf16(h1[0], h1[1]); w.w = cvt_pk_bf16(h1[2], h1[3]);
            *(u32x4*)(F.HB + (size_t)row * DM + k) = w; }
    }
}

__device__ __forceinline__ void cvt_tile(const Frame& F, const float* src, int sld, int k0, int n0, bf16_t* dst, int dld, int drow0, float scale) {
    LAS float* t = (LAS float*)F.lds;
    { const int i = F.tid >> 3, j0 = (F.tid & 7) * 8; const float* p = src + (size_t)(k0 + i) * sld + n0 + j0;
      const f32x4 a = *(const f32x4*)p, b = *(const f32x4*)(p + 4);
      LAS float* q = t + i * 65 + j0; q[0] = a[0]; q[1] = a[1]; q[2] = a[2]; q[3] = a[3]; q[4] = b[0]; q[5] = b[1]; q[6] = b[2]; q[7] = b[3]; }
    __syncthreads();
    { const int j = F.tid >> 3, i0 = (F.tid & 7) * 8; float v[8];
#pragma unroll
      for (int q = 0; q < 8; ++q) v[q] = t[(i0 + q) * 65 + j] * scale;
      u32x4 w; w.x = cvt_pk_bf16(v[0], v[1]); w.y = cvt_pk_bf16(v[2], v[3]); w.z = cvt_pk_bf16(v[4], v[5]); w.w = cvt_pk_bf16(v[6], v[7]);
      *(u32x4*)(dst + (size_t)(drow0 + j) * dld + k0 + i0) = w; }
    __syncthreads();
}
__device__ __forceinline__ void ph_convert(const Frame& F, int l) {
    const int j = l >> 1; const bool even = (l & 1) == 0;
    bf16_t* wIN = (bf16_t*)(F.WB + WB_IN); bf16_t* wOUT = (bf16_t*)(F.WB + WB_OUT); bf16_t* wRT = (bf16_t*)(F.WB + WB_RT);
    bf16_t* wGU = (bf16_t*)(F.WB + WB_GU); bf16_t* wDN = (bf16_t*)(F.WB + WB_DN); bf16_t* wLRU = (bf16_t*)(F.WB + WB_LRU);
    const int nIN = even ? 4096 : 2048;
    const int t_in = (nIN / 64) * 16, t_out = 256, t_rt = 16, t_gu = 65 * 2 * 64, t_dn = 65 * 64, t_lru = even ? 0 : 64;
    const int total = t_in + t_out + t_rt + t_gu + t_dn + t_lru;
    for (int task = F.wg; task < total; task += F.G) {
        int t = task;
        if (t < t_in) { const int nb = t >> 4, kb = t & 15; const float* src = even ? inp(F, 8) + (size_t)j * 1024 * 4096 : inp(F, 13) + (size_t)j * 1024 * 2048;
            cvt_tile(F, src, nIN, kb * 64, nb * 64, wIN, 1024, nb * 64, (even && nb < 8) ? 0.125f : 1.0f); continue; }
        t -= t_in;
        if (t < t_out) { const int nb = t >> 4, kb = t & 15; const float* src = even ? inp(F, 9) + (size_t)j * 1024 * 1024 : inp(F, 21) + (size_t)j * 1024 * 1024;
            cvt_tile(F, src, 1024, kb * 64, nb * 64, wOUT, 1024, nb * 64, 1.0f); continue; }
        t -= t_out;
        if (t < t_rt) { cvt_tile(F, inp(F, 22) + (size_t)l * 1024 * 64, 64, t * 64, 0, wRT, 1024, 0, 1.0f); continue; }
        t -= t_rt;
        if (t < t_gu) { const int e = t / 128, r = t % 128, which = r >> 6, q = r & 63, nb = q >> 4, kb = q & 15;
            const float* src = (e < 64) ? (which ? inp(F, 25) : inp(F, 24)) + ((size_t)l * 64 + e) * 1024 * 256 : (which ? inp(F, 28) : inp(F, 27)) + (size_t)l * 1024 * 256;
            const int n0 = nb * 64, drow0 = (n0 >> 7) * 256 + which * 128 + (n0 & 127);
            cvt_tile(F, src, 256, kb * 64, n0, wGU + (size_t)e * 512 * 1024, 1024, drow0, 1.0f); continue; }
        t -= t_gu;
        if (t < t_dn) { const int e = t >> 6, q = t & 63, nb = q >> 2, kb = q & 3;
            const float* src = (e < 64) ? inp(F, 26) + ((size_t)l * 64 + e) * 256 * 1024 : inp(F, 29) + (size_t)l * 256 * 1024;
            cvt_tile(F, src, 1024, kb * 64, nb * 64, wDN + (size_t)e * 1024 * 256, 256, nb * 64, 1.0f); continue; }
        t -= t_dn;
        { const int d = t >> 5, gt = (t >> 4) & 1, kb = t & 15;
          const float* src = (gt ? inp(F, 18) : inp(F, 16)) + (((size_t)j * 2 + d) * 16 + kb) * 4096;
          cvt_tile(F, src, 64, 0, 0, wLRU + (((size_t)d * 2 + gt) * 16 + kb) * 4096, 64, 0, 1.0f); }
    }
}

__device__ __forceinline__ void ph_attn(const Frame& F, int j) {
    const bf16_t* P = (const bf16_t*)(F.R1 + R1_P);
    LAS bf16_t* Ks0 = (LAS bf16_t*)F.lds;
    LAS float* rp_l = (LAS float*)(F.lds + 36864);
    const float* rpb = inp(F, 10) + (size_t)j * 8 * 465;
    const int g = F.lane >> 4, l15 = F.lane & 15;
    const int NLAT = NBAT * 8 * 64, NTASK = NLAT + NBAT * 8 * 2;
    const int wgs = ((F.G & 7) == 0) ? (F.wg & 7) * (F.G >> 3) + (F.wg >> 3) : F.wg;
    int cidx[4][4];
    { const int wq_ = (F.wave & 3) * 16 + l15, c0_ = min(max(wq_ - 8, 0), 48);
#pragma unroll
      for (int kb = 0; kb < 4; ++kb)
#pragma unroll
          for (int i = 0; i < 4; ++i) { const int kc = kb * 16 + 4 * g + i; cidx[kb][i] = (kc >= c0_ && kc < c0_ + 16) ? (kc - wq_ + 15) : 31; } }
    for (int task = wgs; task < NTASK; task += F.G) {
        const bool lat = task < NLAT;
        int b, h, rp = 0, half = 0;
        if (lat) { b = task >> 9; h = (task >> 6) & 7; rp = task & 63; } else { const int t2 = task - NLAT; b = t2 >> 4; h = (t2 >> 1) & 7; half = t2 & 1; }
        const int myr = 2 * rp + (F.wave >> 2), w0 = (F.wave & 3) * 16;
        const int r0 = min(max(myr - 4, 0), 120);
        const int rlo = min(max(2 * rp - 4, 0), 120), rhi = min(max(2 * rp + 1 - 4, 0), 120) + 7;
        const int nloc = lat ? (rhi - rlo + 1) : 0;
        const int qrow = lat ? (TC + b * SEQ + myr * 64 + w0 + l15) : (b * CTXL + half * 128 + F.wave * 16 + l15);
        bf16x8 qf[2];
        qf[0] = *(const bf16x8*)(P + (size_t)qrow * 4096 + h * 64 + g * 8);
        qf[1] = *(const bf16x8*)(P + (size_t)qrow * 4096 + h * 64 + 32 + g * 8);
        if (lat) for (int i = F.tid; i < 480; i += 512) { const int rr = i >> 5, cc = i & 31; rp_l[i] = (cc < 31) ? rpb[h * 465 + rr * 31 + cc] : -1e30f; }
        f32x4 oacc[4];
#pragma unroll
        for (int dt = 0; dt < 4; ++dt) oacc[dt] = (f32x4){0.f, 0.f, 0.f, 0.f};
        float mrun = -1e30f, lrun = 0.f;
        const int wq = w0 + l15, c0 = min(max(wq - 8, 0), 48);
        u32x4 kv, vv;
        { const int key = F.tid >> 3, ds = (F.tid & 7) * 8; const bool loc0 = 0 < nloc;
          const int krow = loc0 ? (TC + b * SEQ + rlo * 64 + key) : (b * CTXL + key);
          kv = *(const u32x4*)(P + (size_t)krow * 4096 + 512 + h * 64 + ds); vv = *(const u32x4*)(P + (size_t)krow * 4096 + 1024 + h * 64 + ds); }
#define ATT_STAGE(buf_, c_) do { const int key = F.tid >> 3, ds = (F.tid & 7) * 8; LAS bf16_t* Kd = Ks0 + (buf_) * 9216; LAS bf16_t* Vd = Kd + 4608; \
            *(LAS u32x4*)(Kd + key * 72 + ds) = kv; *(LAS u32x4*)(Vd + key * 72 + ds) = vv;     \
            if ((c_) + 1 < nloc + 4) { const bool locn = ((c_) + 1) < nloc; \
                const int krow = locn ? (TC + b * SEQ + (rlo + (c_) + 1) * 64 + key) : (b * CTXL + ((c_) + 1 - nloc) * 64 + key); \
                kv = *(const u32x4*)(P + (size_t)krow * 4096 + 512 + h * 64 + ds); vv = *(const u32x4*)(P + (size_t)krow * 4096 + 1024 + h * 64 + ds); } } while (0)
        __syncthreads();
        ATT_STAGE(0, 0);
        __syncthreads();
        for (int ch = 0; ch < nloc + 4; ++ch) {
            const bool loc = ch < nloc; const int kr = rlo + ch;
            if (ch + 1 < nloc + 4) ATT_STAGE((ch + 1) & 1, ch + 1);
            const LAS bf16_t* Ks = Ks0 + (ch & 1) * 9216; const LAS bf16_t* Vt = Ks + 4608;
            const bool mine = loc ? (kr >= r0 && kr < r0 + 8) : true;
            if (mine) {
                f32x4 s[4];
                const LAS float* rrow = rp_l + (loc ? (kr - myr + 7) * 32 : 0);
#pragma unroll
                for (int kb = 0; kb < 4; ++kb) {
                    if (loc) {
#pragma unroll
                        for (int i = 0; i < 4; ++i) s[kb][i] = rrow[cidx[kb][i]];
                    } else s[kb] = (f32x4){0.f, 0.f, 0.f, 0.f};
#pragma unroll
                    for (int ks = 0; ks < 2; ++ks) { const bf16x8 a = *(const LAS bf16x8*)(Ks + (kb * 16 + l15) * 72 + ks * 32 + g * 8);
                        s[kb] = __builtin_amdgcn_mfma_f32_16x16x32_bf16(a, qf[ks], s[kb], 0, 0, 0); } }
                float cm = -1e30f;
#pragma unroll
                for (int kb = 0; kb < 4; ++kb)
#pragma unroll
                    for (int i = 0; i < 4; ++i) cm = fmaxf(cm, s[kb][i]);
                cm = fmaxf(cm, __shfl_xor(cm, 16)); cm = fmaxf(cm, __shfl_xor(cm, 32));
                const float mn = fmaxf(mrun, cm), sc = __expf(mrun - mn);
                mrun = mn; lrun *= sc;
#pragma unroll
                for (int dt = 0; dt < 4; ++dt) oacc[dt] *= sc;
                float p[4][4];
#pragma unroll
                for (int kb = 0; kb < 4; ++kb)
#pragma unroll
                    for (int i = 0; i < 4; ++i) { p[kb][i] = __expf(s[kb][i] - mn); lrun += p[kb][i]; }
#pragma unroll
                for (int kp = 0; kp < 2; ++kp) {
                    u32x4 pw; pw.x = cvt_pk_bf16(p[2 * kp][0], p[2 * kp][1]); pw.y = cvt_pk_bf16(p[2 * kp][2], p[2 * kp][3]);
                    pw.z = cvt_pk_bf16(p[2 * kp + 1][0], p[2 * kp + 1][1]); pw.w = cvt_pk_bf16(p[2 * kp + 1][2], p[2 * kp + 1][3]);
                    bf16x8 pf; __builtin_memcpy(&pf, &pw, 16);
                    const unsigned va = (unsigned)(size_t)Vt + (unsigned)((32 * kp + 4 * g + (l15 >> 2)) * 144 + (l15 & 3) * 8);
                    u32x2 t0[4], t1[4];
                    asm volatile("ds_read_b64_tr_b16 %0, %8\n\tds_read_b64_tr_b16 %1, %8 offset:32\n\tds_read_b64_tr_b16 %2, %8 offset:64\n\tds_read_b64_tr_b16 %3, %8 offset:96\n\t"
                                 "ds_read_b64_tr_b16 %4, %8 offset:2304\n\tds_read_b64_tr_b16 %5, %8 offset:2336\n\tds_read_b64_tr_b16 %6, %8 offset:2368\n\tds_read_b64_tr_b16 %7, %8 offset:2400\n\ts_waitcnt lgkmcnt(0)"
                                 : "=&v"(t0[0]), "=&v"(t0[1]), "=&v"(t0[2]), "=&v"(t0[3]), "=&v"(t1[0]), "=&v"(t1[1]), "=&v"(t1[2]), "=&v"(t1[3]) : "v"(va) : "memory");
#pragma unroll
                    for (int dt = 0; dt < 4; ++dt) {
                        u32x4 vw; vw.x = t0[dt].x; vw.y = t0[dt].y; vw.z = t1[dt].x; vw.w = t1[dt].y; bf16x8 vf; __builtin_memcpy(&vf, &vw, 16);
                        oacc[dt] = __builtin_amdgcn_mfma_f32_16x16x32_bf16(vf, pf, oacc[dt], 0, 0, 0);
                    }
                }
            }
            __syncthreads();
        }
#undef ATT_STAGE
        float lt = lrun; lt += __shfl_xor(lt, 16); lt += __shfl_xor(lt, 32);
        const float inv = 1.0f / lt;
#pragma unroll
        for (int dt = 0; dt < 4; ++dt) { const f32x4 o = oacc[dt] * inv; u32x2 w; w.x = cvt_pk_bf16(o[0], o[1]); w.y = cvt_pk_bf16(o[2], o[3]);
            *(u32x2*)(F.MIX + (size_t)qrow * DM + h * 64 + dt * 16 + 4 * g) = w; }
        __syncthreads();
    }
}

__device__ __forceinline__ int hg_unit(int nb, int dir) { return dir == 0 ? nb : (nb < 2 ? 1 - nb : 2 + (HG_NU - 3 - (nb - 2))); }
__device__ __forceinline__ int hg_row(int b, int nb, int t) { return nb < 2 ? b * CTXL + nb * HG_U + t : TC + b * SEQ + (nb - 2) * HG_U + t; }
template <int CTRL> __device__ __forceinline__ float dpp_add0(float x) { return x + dppf<CTRL>(0.0f, x); }
#define ROW_ALLREDUCE4(v0, v1, v2, v3) asm volatile("s_nop 1\n\t" \
    "v_add_f32_dpp %0, %0, %0 quad_perm:[1,0,3,2] row_mask:0xf bank_mask:0xf\n\tv_add_f32_dpp %1, %1, %1 quad_perm:[1,0,3,2] row_mask:0xf bank_mask:0xf\n\t" \
    "v_add_f32_dpp %2, %2, %2 quad_perm:[1,0,3,2] row_mask:0xf bank_mask:0xf\n\tv_add_f32_dpp %3, %3, %3 quad_perm:[1,0,3,2] row_mask:0xf bank_mask:0xf\n\t" \
    "v_add_f32_dpp %0, %0, %0 quad_perm:[2,3,0,1] row_mask:0xf bank_mask:0xf\n\tv_add_f32_dpp %1, %1, %1 quad_perm:[2,3,0,1] row_mask:0xf bank_mask:0xf\n\t" \
    "v_add_f32_dpp %2, %2, %2 quad_perm:[2,3,0,1] row_mask:0xf bank_mask:0xf\n\tv_add_f32_dpp %3, %3, %3 quad_perm:[2,3,0,1] row_mask:0xf bank_mask:0xf\n\t" \
    "v_add_f32_dpp %0, %0, %0 row_half_mirror row_mask:0xf bank_mask:0xf\n\tv_add_f32_dpp %1, %1, %1 row_half_mirror row_mask:0xf bank_mask:0xf\n\t" \
    "v_add_f32_dpp %2, %2, %2 row_half_mirror row_mask:0xf bank_mask:0xf\n\tv_add_f32_dpp %3, %3, %3 row_half_mirror row_mask:0xf bank_mask:0xf\n\t" \
    "v_add_f32_dpp %0, %0, %0 row_mirror row_mask:0xf bank_mask:0xf\n\tv_add_f32_dpp %1, %1, %1 row_mirror row_mask:0xf bank_mask:0xf\n\t" \
    "v_add_f32_dpp %2, %2, %2 row_mirror row_mask:0xf bank_mask:0xf\n\tv_add_f32_dpp %3, %3, %3 row_mirror row_mask:0xf bank_mask:0xf" \
    : "+v"(v0), "+v"(v1), "+v"(v2), "+v"(v3))
template <bool WITHO>
__device__ __forceinline__ void hg_pass(const Frame& F, const bf16_t* P, const float* lbh, int b, int h, int nb, int dir, f32x4 (&S)[4][4], float (&Gsum)[16],
                                        LAS bf16_t* Vl, LAS bf16_t* Kl, float* OF, const float* ngp) {
    const int tau = F.lane & 15, g = F.lane >> 4;
    const unsigned vaddr = (unsigned)(size_t)Vl + (unsigned)((4 * g + (tau >> 2)) * 128 + (tau & 3) * 8);
    const unsigned kaddr = (unsigned)(size_t)Kl + (unsigned)((4 * g + (tau >> 2)) * 128 + (tau & 3) * 8);
    u32x2 zr[4], vr[4], qr[4];
    { const int t = dir ? (HG_U - 1 - tau) : tau; const bf16_t* pr = P + (size_t)hg_row(b, nb, t) * 4096 + h * 64 + 4 * g;
#pragma unroll
      for (int m = 0; m < 4; ++m) { zr[m] = *(const u32x2*)(pr + (dir ? 2560 : 2048) + 16 * m); vr[m] = *(const u32x2*)(pr + 3072 + 16 * m); } }
    for (int ci = 0; ci < HG_U / 16; ++ci) {
        float kk[16], c[16];
        if (WITHO) { const int pos = ci * 16 + tau, t = dir ? (HG_U - 1 - pos) : pos; const bf16_t* pr = P + (size_t)hg_row(b, nb, t) * 4096 + h * 64 + 4 * g;
#pragma unroll
            for (int m = 0; m < 4; ++m) qr[m] = *(const u32x2*)(pr + 1536 + 16 * m); }
#pragma unroll
        for (int m = 0; m < 4; ++m) { const float z0 = __uint_as_float(zr[m].x << 16), z1 = __uint_as_float(zr[m].x & 0xffff0000u), z2 = __uint_as_float(zr[m].y << 16), z3 = __uint_as_float(zr[m].y & 0xffff0000u);
            const float zz[4] = {z0, z1, z2, z3};
            const f32x4 lb4 = *(const f32x4*)(lbh + 16 * m + 4 * g);
#pragma unroll
            for (int i = 0; i < 4; ++i) { const float lb = lb4[i]; const float f = fmaxf(lb + (1.0f - lb) * sigmoidf_(zz[i]), 1e-30f); kk[m * 4 + i] = 1.0f - f; c[m * 4 + i] = __logf(f); }
            *(LAS u32x2*)(Vl + tau * 64 + 16 * m + 4 * g) = vr[m];
 }
        if (ci + 1 < HG_U / 16) { const int pos = (ci + 1) * 16 + tau, t = dir ? (HG_U - 1 - pos) : pos; const bf16_t* pr = P + (size_t)hg_row(b, nb, t) * 4096 + h * 64 + 4 * g;
#pragma unroll
            for (int m = 0; m < 4; ++m) { zr[m] = *(const u32x2*)(pr + (dir ? 2560 : 2048) + 16 * m); vr[m] = *(const u32x2*)(pr + 3072 + 16 * m); } }
        float G[16];
#pragma unroll
        for (int q = 0; q < 16; ++q) G[q] = c[q];
#pragma unroll
        for (int q = 0; q < 16; q += 4) ROW_ALLREDUCE4(G[q], G[q + 1], G[q + 2], G[q + 3]);
#pragma unroll
        for (int q = 0; q < 16; ++q) { c[q] = dpp_add0<0x111>(c[q]); c[q] = dpp_add0<0x112>(c[q]); c[q] = dpp_add0<0x114>(c[q]); c[q] = dpp_add0<0x118>(c[q]); }
#pragma unroll
        for (int q = 0; q < 16; ++q) Gsum[q] += G[q];
#pragma unroll
        for (int m = 0; m < 4; ++m) { float kh[4];
#pragma unroll
            for (int i = 0; i < 4; ++i) kh[i] = kk[m * 4 + i] * __expf(G[m * 4 + i] - c[m * 4 + i]);
            u32x2 w; w.x = cvt_pk_bf16(kh[0], kh[1]); w.y = cvt_pk_bf16(kh[2], kh[3]);
            *(LAS u32x2*)(Kl + tau * 64 + 16 * m + 4 * g) = w; }
        float ofv[4][4], gtv[4][4]; int orow[4];
        if (WITHO) {
#pragma unroll
            for (int i = 0; i < 4; ++i) { const int p2 = ci * 16 + 4 * g + i, t2 = dir ? (HG_U - 1 - p2) : p2; orow[i] = hg_row(b, nb, t2); }
            if (dir) {
#pragma unroll
                for (int i = 0; i < 4; ++i)
#pragma unroll
                    for (int vt = 0; vt < 4; ++vt) { ofv[i][vt] = OF[(size_t)orow[i] * 512 + h * 64 + 16 * vt + tau]; gtv[i][vt] = bf2f(P[(size_t)orow[i] * 4096 + 3584 + h * 64 + 16 * vt + tau]); }
            }
        }
        asm volatile("s_waitcnt lgkmcnt(0)" ::: "memory");
        u32x2 vtr[4], ktr[4];
        asm volatile("ds_read_b64_tr_b16 %0, %8\n\tds_read_b64_tr_b16 %1, %8 offset:32\n\tds_read_b64_tr_b16 %2, %8 offset:64\n\tds_read_b64_tr_b16 %3, %8 offset:96\n\t"
                     "ds_read_b64_tr_b16 %4, %9\n\tds_read_b64_tr_b16 %5, %9 offset:32\n\tds_read_b64_tr_b16 %6, %9 offset:64\n\tds_read_b64_tr_b16 %7, %9 offset:96\n\ts_waitcnt lgkmcnt(0)"
                     : "=&v"(vtr[0]), "=&v"(vtr[1]), "=&v"(vtr[2]), "=&v"(vtr[3]), "=&v"(ktr[0]), "=&v"(ktr[1]), "=&v"(ktr[2]), "=&v"(ktr[3]) : "v"(vaddr), "v"(kaddr) : "memory");
        bf16x8 Vf[4], Kf[4];
#pragma unroll
        for (int q = 0; q < 4; ++q) { u32x4 w; w.x = vtr[q].x; w.y = vtr[q].y; w.z = 0u; w.w = 0u; __builtin_memcpy(&Vf[q], &w, 16); u32x4 w2; w2.x = ktr[q].x; w2.y = ktr[q].y; w2.z = 0u; w2.w = 0u; __builtin_memcpy(&Kf[q], &w2, 16); }
        if (WITHO) {
            bf16x8 Ktf[2], Qtf[2], Qhf[2];
#pragma unroll
            for (int ks = 0; ks < 2; ++ks) { float kt_[8], qt_[8], qh_[8];
#pragma unroll
                for (int mm = 0; mm < 2; ++mm) { const int m = 2 * ks + mm;
                    const float qq[4] = {__uint_as_float(qr[m].x << 16), __uint_as_float(qr[m].x & 0xffff0000u), __uint_as_float(qr[m].y << 16), __uint_as_float(qr[m].y & 0xffff0000u)};
#pragma unroll
                    for (int i = 0; i < 4; ++i) { const int q = m * 4 + i; const float qv = siluf_(qq[i]) * 0.125f; const float d = fminf(fmaxf(c[q] - 0.5f * G[q], -80.0f), 80.0f);
                        qt_[mm * 4 + i] = qv * __expf(d); kt_[mm * 4 + i] = kk[q] * __expf(-d); qh_[mm * 4 + i] = qv * __expf(c[q]); } }
                u32x4 w; w.x = cvt_pk_bf16(kt_[0], kt_[1]); w.y = cvt_pk_bf16(kt_[2], kt_[3]); w.z = cvt_pk_bf16(kt_[4], kt_[5]); w.w = cvt_pk_bf16(kt_[6], kt_[7]); __builtin_memcpy(&Ktf[ks], &w, 16);
                w.x = cvt_pk_bf16(qt_[0], qt_[1]); w.y = cvt_pk_bf16(qt_[2], qt_[3]); w.z = cvt_pk_bf16(qt_[4], qt_[5]); w.w = cvt_pk_bf16(qt_[6], qt_[7]); __builtin_memcpy(&Qtf[ks], &w, 16);
                w.x = cvt_pk_bf16(qh_[0], qh_[1]); w.y = cvt_pk_bf16(qh_[2], qh_[3]); w.z = cvt_pk_bf16(qh_[4], qh_[5]); w.w = cvt_pk_bf16(qh_[6], qh_[7]); __builtin_memcpy(&Qhf[ks], &w, 16); }
            f32x4 AT = (f32x4){0.f, 0.f, 0.f, 0.f};
            AT = __builtin_amdgcn_mfma_f32_16x16x32_bf16(Ktf[0], Qtf[0], AT, 0, 0, 0); AT = __builtin_amdgcn_mfma_f32_16x16x32_bf16(Ktf[1], Qtf[1], AT, 0, 0, 0);
#pragma unroll
            for (int i = 0; i < 4; ++i) AT[i] = (4 * g + i <= tau) ? AT[i] : 0.0f;
            bf16x8 Af; { u32x4 w; w.x = cvt_pk_bf16(AT[0], AT[1]); w.y = cvt_pk_bf16(AT[2], AT[3]); w.z = 0u; w.w = 0u; __builtin_memcpy(&Af, &w, 16); }
            f32x4 o[4];
#pragma unroll
            for (int vt = 0; vt < 4; ++vt) { o[vt] = __builtin_amdgcn_mfma_f32_16x16x32_bf16(Af, Vf[vt], (f32x4){0.f, 0.f, 0.f, 0.f}, 0, 0, 0);
#pragma unroll
                for (int ks = 0; ks < 2; ++ks) { u32x4 w; w.x = cvt_pk_bf16(S[2 * ks][vt][0], S[2 * ks][vt][1]); w.y = cvt_pk_bf16(S[2 * ks][vt][2], S[2 * ks][vt][3]);
                    w.z = cvt_pk_bf16(S[2 * ks + 1][vt][0], S[2 * ks + 1][vt][1]); w.w = cvt_pk_bf16(S[2 * ks + 1][vt][2], S[2 * ks + 1][vt][3]); bf16x8 Sf; __builtin_memcpy(&Sf, &w, 16);
                    o[vt] = __builtin_amdgcn_mfma_f32_16x16x32_bf16(Qhf[ks], Sf, o[vt], 0, 0, 0); } }
            if (dir == 0) {
#pragma unroll
                for (int i = 0; i < 4; ++i)
#pragma unroll
                    for (int vt = 0; vt < 4; ++vt) OF[(size_t)orow[i] * 512 + h * 64 + 16 * vt + tau] = o[vt][i];
            } else {
                { float tot[4][4], sq[4];
#pragma unroll
                for (int i = 0; i < 4; ++i) { sq[i] = 0.f;
#pragma unroll
                    for (int vt = 0; vt < 4; ++vt) { tot[i][vt] = o[vt][i] + ofv[i][vt]; sq[i] = fmaf(tot[i][vt], tot[i][vt], sq[i]); } }
                ROW_ALLREDUCE4(sq[0], sq[1], sq[2], sq[3]);
#pragma unroll
                for (int i = 0; i < 4; ++i) { const float rs = rsqrtf(sq[i] * (1.0f / 64.0f) + 1e-6f);
#pragma unroll
                    for (int vt = 0; vt < 4; ++vt) F.MIX[(size_t)orow[i] * DM + 512 + h * 64 + 16 * vt + tau] = f2bf(tot[i][vt] * rs * ngp[16 * vt + tau] * siluf_(gtv[i][vt])); } }
            }
        }
#pragma unroll
        for (int kt = 0; kt < 4; ++kt) { f32x4 eg;
#pragma unroll
            for (int i = 0; i < 4; ++i) eg[i] = __expf(G[kt * 4 + i]);
#pragma unroll
            for (int vt = 0; vt < 4; ++vt) S[kt][vt] = __builtin_amdgcn_mfma_f32_16x16x32_bf16(Kf[kt], Vf[vt], S[kt][vt] * eg, 0, 0, 0); }
    }
}
__device__ __forceinline__ void ph_hg_a(const Frame& F, int j) {
    const bf16_t* P = (const bf16_t*)(F.R1 + R1_P);
    float* SLOC = (float*)(F.R1 + R1_SLOC); float* DL = (float*)(F.R1 + R1_DL);
    LAS bf16_t* Vl = (LAS bf16_t*)(F.lds + 32768 + F.wave * 4096); LAS bf16_t* Kl = Vl + 1024;
    const int gw = F.wg * 8 + F.wave, nw = F.G * 8;
    const int NT = NBAT * 8 * (HG_NU - 2) * 2;
    for (int task = gw; task < NT; task += nw) {
        const int dir = task & 1, nb = 2 + (task >> 1) % (HG_NU - 2), bh = (task >> 1) / (HG_NU - 2), b = bh >> 3, h = bh & 7;
        const float* lbh = (const float*)(F.ws + OFF_LBT) + (j * 2 + dir) * 512 + h * 64;
        f32x4 S[4][4];
#pragma unroll
        for (int kt = 0; kt < 4; ++kt)
#pragma unroll
            for (int vt = 0; vt < 4; ++vt) S[kt][vt] = (f32x4){0.f, 0.f, 0.f, 0.f};
        float Gsum[16];
#pragma unroll
        for (int q = 0; q < 16; ++q) Gsum[q] = 0.f;
        hg_pass<false>(F, P, lbh, b, h, nb, dir, S, Gsum, Vl, Kl, nullptr, nullptr);
        const int seq = bh * 2 + dir, u = hg_unit(nb, dir);
        float* so = SLOC + ((size_t)seq * HG_NU + u) * 4096;
#pragma unroll
        for (int kt = 0; kt < 4; ++kt)
#pragma unroll
            for (int vt = 0; vt < 4; ++vt)
#pragma unroll
                for (int i = 0; i < 4; ++i) so[((kt * 4 + vt) * 4 + i) * 64 + F.lane] = S[kt][vt][i];
        if ((F.lane & 15) == 0) { float* dd = DL + ((size_t)seq * HG_NU + u) * 64;
#pragma unroll
            for (int m = 0; m < 4; ++m)
#pragma unroll
                for (int i = 0; i < 4; ++i) dd[16 * m + 4 * (F.lane >> 4) + i] = __expf(Gsum[m * 4 + i]); }
    }
}
__device__ __forceinline__ void ph_hg_b(const Frame& F) {
    const float* SLOC = (const float*)(F.R1 + R1_SLOC); const float* DL = (const float*)(F.R1 + R1_DL); float* SST = (float*)(F.R1 + R1_SST);
    for (int idx = F.wg * 512 + F.tid; idx < 64 * 4096; idx += F.G * 512) {
        const int seq = idx >> 12, e = idx & 4095, ln = e & 63, reg = e >> 6, i = reg & 3, kt = reg >> 4, k = 16 * kt + 4 * (ln >> 4) + i;
        float s = 0.f;
#pragma unroll 6
        for (int u = 0; u < HG_NU; ++u) { const size_t o = ((size_t)seq * HG_NU + u) * 4096 + e; SST[o] = s; s = DL[((size_t)seq * HG_NU + u) * 64 + k] * s + SLOC[o]; }
    }
}
__device__ __forceinline__ void ph_hg_c(const Frame& F, int j) {
    const bf16_t* P = (const bf16_t*)(F.R1 + R1_P);
    const float* SST = (const float*)(F.R1 + R1_SST); float* OF = (float*)(F.R1 + R1_OF);
    const float* ng = inp(F, 12) + j * 64;
    LAS bf16_t* Vl = (LAS bf16_t*)(F.lds + 32768 + F.wave * 4096); LAS bf16_t* Kl = Vl + 1024;
    const int gw = F.wg * 8 + F.wave, nw = F.G * 8;
    const int NT = NBAT * 8 * (HG_NU - 2);
    for (int task = gw; task < NT; task += nw) {
        const int nb = 2 + task % (HG_NU - 2), bh = task / (HG_NU - 2), b = bh >> 3, h = bh & 7;
        for (int dir = 0; dir < 2; ++dir) {
            const float* lbh = (const float*)(F.ws + OFF_LBT) + (j * 2 + dir) * 512 + h * 64;
            const int seq = bh * 2 + dir, u = hg_unit(nb, dir);
            const float* ss = SST + ((size_t)seq * HG_NU + u) * 4096;
            f32x4 S[4][4];
#pragma unroll
            for (int kt = 0; kt < 4; ++kt)
#pragma unroll
                for (int vt = 0; vt < 4; ++vt)
#pragma unroll
                    for (int i = 0; i < 4; ++i) S[kt][vt][i] = ss[((kt * 4 + vt) * 4 + i) * 64 + F.lane];
            float Gsum[16];
#pragma unroll
            for (int q = 0; q < 16; ++q) Gsum[q] = 0.f;
            hg_pass<true>(F, P, lbh, b, h, nb, dir, S, Gsum, Vl, Kl, OF, ng);
            asm volatile("s_waitcnt vmcnt(0)" ::: "memory");
        }
    }
}

__device__ __forceinline__ void ph_hg_ctx(const Frame& F, int j) {
    if (F.wave >= 4) return;
    const bf16_t* P = (const bf16_t*)(F.R1 + R1_P);
    float* SLOC = (float*)(F.R1 + R1_SLOC); float* DL = (float*)(F.R1 + R1_DL); float* OF = (float*)(F.R1 + R1_OF);
    const float* ng = inp(F, 12) + j * 64;
    LAS bf16_t* Vl = (LAS bf16_t*)(F.lds + 32768 + F.wave * 4096); LAS bf16_t* Kl = Vl + 1024;
    const int bh = F.wg * 4 + F.wave, b = bh >> 3, h = bh & 7;
    for (int dir = 0; dir < 2; ++dir) {
        const float* lbh = (const float*)(F.ws + OFF_LBT) + (j * 2 + dir) * 512 + h * 64;
        const int seq = bh * 2 + dir;
        f32x4 S[4][4];
#pragma unroll
        for (int kt = 0; kt < 4; ++kt)
#pragma unroll
            for (int vt = 0; vt < 4; ++vt) S[kt][vt] = (f32x4){0.f, 0.f, 0.f, 0.f};
        for (int u = 0; u < 2; ++u) {
            const int nb = dir ? 1 - u : u;
            float Gsum[16];
#pragma unroll
            for (int q = 0; q < 16; ++q) Gsum[q] = 0.f;
            hg_pass<true>(F, P, lbh, b, h, nb, dir, S, Gsum, Vl, Kl, OF, ng);
            float* so = SLOC + ((size_t)seq * HG_NU + u) * 4096;
#pragma unroll
            for (int kt = 0; kt < 4; ++kt)
#pragma unroll
                for (int vt = 0; vt < 4; ++vt)
#pragma unroll
                    for (int i = 0; i < 4; ++i) so[((kt * 4 + vt) * 4 + i) * 64 + F.lane] = S[kt][vt][i];
            if ((F.lane & 15) == 0) { float* dd = DL + ((size_t)seq * HG_NU + u) * 64;
#pragma unroll
                for (int q = 0; q < 16; ++q) dd[16 * (q >> 2) + 4 * (F.lane >> 4) + (q & 3)] = 0.0f; }
        }
        asm volatile("s_waitcnt vmcnt(0)" ::: "memory");
    }
}

__device__ __forceinline__ int lru_nat(int so, int dir) { return dir == 0 ? so : (so < 16 ? 15 - so : 16 + (LRU_NT - 1 - so)); }
__device__ __forceinline__ int lru_row(int b, int nt, int t) { return nt < 16 ? b * CTXL + nt * 16 + t : TC + b * SEQ + (nt - 16) * 16 + t; }
struct LruRaw { u32x4 a[4], b[4]; };
__device__ __forceinline__ void lru_load(const Frame& F, int b, int kb, int nt, LruRaw& R) {
    const bf16_t* P = (const bf16_t*)(F.R1 + R1_P);
    const int tk = F.lane & 15, g = F.lane >> 4;
    const int len = nt < 16 ? CTXL : SEQ, tpos = (nt < 16 ? nt * 16 : (nt - 16) * 16) + tk;
    const bf16_t* pbase = P + (size_t)((nt < 16 ? b * CTXL : TC + b * SEQ)) * 2048 + 1024 + kb * 64 + g * 16;
#pragma unroll
    for (int tap = 0; tap < 4; ++tap) { const int tp = tpos + tap - 2; const bool ok = (tp >= 0 && tp < len); const bf16_t* pr = pbase + (size_t)(ok ? tp : tpos) * 2048;
        R.a[tap] = *(const u32x4*)pr; R.b[tap] = *(const u32x4*)(pr + 8); if (!ok) { R.a[tap] = (u32x4){0u, 0u, 0u, 0u}; R.b[tap] = (u32x4){0u, 0u, 0u, 0u}; } }
}
__device__ __forceinline__ void lru_conv(const Frame& F, const LruRaw& R, const LAS float* CT, LAS float* ucb) {
    const int tk = F.lane & 15, g = F.lane >> 4;
    float acc[16];
#pragma unroll
    for (int q = 0; q < 4; ++q) { const f32x4 c4 = *(const LAS f32x4*)(CT + 4 * 64 + g * 16 + q * 4); acc[q * 4] = c4[0]; acc[q * 4 + 1] = c4[1]; acc[q * 4 + 2] = c4[2]; acc[q * 4 + 3] = c4[3]; }
#pragma unroll
    for (int tap = 0; tap < 4; ++tap) { float t0[8], t1[8]; unpack8(R.a[tap], t0); unpack8(R.b[tap], t1);
#pragma unroll
        for (int q = 0; q < 2; ++q) { const f32x4 w0 = *(const LAS f32x4*)(CT + tap * 64 + g * 16 + q * 4), w1 = *(const LAS f32x4*)(CT + tap * 64 + g * 16 + 8 + q * 4);
#pragma unroll
            for (int i = 0; i < 4; ++i) { acc[q * 4 + i] = fmaf(w0[i], t0[q * 4 + i], acc[q * 4 + i]); acc[8 + q * 4 + i] = fmaf(w1[i], t1[q * 4 + i], acc[8 + q * 4 + i]); } } }
#pragma unroll
    for (int q = 0; q < 4; ++q) *(LAS f32x4*)(ucb + tk * 68 + g * 16 + q * 4) = (f32x4){acc[q * 4], acc[q * 4 + 1], acc[q * 4 + 2], acc[q * 4 + 3]};
}
__device__ __forceinline__ void lru_gates(const Frame& F, LAS bf16_t* Wl, const LAS float* CT, LAS float* ucb, float (&av)[2][4][4], float (&xv)[2][4][4]) {
    const int tk = F.lane & 15, g = F.lane >> 4;
    bf16x8 bfr[2];
#pragma unroll
    for (int ks = 0; ks < 2; ++ks) { const f32x4 u0 = *(const LAS f32x4*)(ucb + tk * 68 + ks * 32 + g * 8), u1 = *(const LAS f32x4*)(ucb + tk * 68 + ks * 32 + g * 8 + 4);
        u32x4 w; w.x = cvt_pk_bf16(u0[0], u0[1]); w.y = cvt_pk_bf16(u0[2], u0[3]); w.z = cvt_pk_bf16(u1[0], u1[1]); w.w = cvt_pk_bf16(u1[2], u1[3]); __builtin_memcpy(&bfr[ks], &w, 16); }
#pragma unroll
    for (int d = 0; d < 2; ++d)
#pragma unroll
        for (int et = 0; et < 4; ++et) {
            f32x4 ra = (f32x4){0.f, 0.f, 0.f, 0.f}, ri = (f32x4){0.f, 0.f, 0.f, 0.f};
#pragma unroll
            for (int ks = 0; ks < 2; ++ks) {
                const bf16x8 wa = *(const LAS bf16x8*)(Wl + ((d * 2 + 0) * 64 + et * 16 + tk) * 72 + ks * 32 + g * 8);
                const bf16x8 wx = *(const LAS bf16x8*)(Wl + ((d * 2 + 1) * 64 + et * 16 + tk) * 72 + ks * 32 + g * 8);
                ra = __builtin_amdgcn_mfma_f32_16x16x32_bf16(wa, bfr[ks], ra, 0, 0, 0);
                ri = __builtin_amdgcn_mfma_f32_16x16x32_bf16(wx, bfr[ks], ri, 0, 0, 0);
            }
            const f32x4 ba4 = *(const LAS f32x4*)(CT + (5 + 3 * d) * 64 + et * 16 + 4 * g), bx4 = *(const LAS f32x4*)(CT + (6 + 3 * d) * 64 + et * 16 + 4 * g), cs4 = *(const LAS f32x4*)(CT + (7 + 3 * d) * 64 + et * 16 + 4 * g);
            const f32x4 u4 = *(const LAS f32x4*)(ucb + tk * 68 + et * 16 + 4 * g);
#pragma unroll
            for (int i = 0; i < 4; ++i) {
                const float r = sigmoidf_(ra[i] + ba4[i]), ig = sigmoidf_(ri[i] + bx4[i]);
                const float la = cs4[i] * r, a = __expf(la);
                av[d][et][i] = la; xv[d][et][i] = __builtin_amdgcn_sqrtf(fmaxf(1.0f - a * a, 0.f)) * ig * u4[i]; }
        }
}
template <int S> __device__ __forceinline__ void lru_step_f(float& a, float& x) { const float ap = dppf<0x110 + S>(1.0f, a), xp = dppf<0x110 + S>(0.0f, x); x = fmaf(a, xp, x); a = a * ap; }
template <int S> __device__ __forceinline__ void lru_step_b(float& a, float& x) { const float ap = dppf<0x100 + S>(1.0f, a), xp = dppf<0x100 + S>(0.0f, x); x = fmaf(a, xp, x); a = a * ap; }
#define LRU_DPP_STEP(SH, x_, a_) asm volatile("s_nop 1\n\t" \
    "v_fmac_f32_dpp %0, %0, %4 " SH " row_mask:0xf bank_mask:0xf\n\tv_fmac_f32_dpp %1, %1, %5 " SH " row_mask:0xf bank_mask:0xf\n\t" \
    "v_fmac_f32_dpp %2, %2, %6 " SH " row_mask:0xf bank_mask:0xf\n\tv_fmac_f32_dpp %3, %3, %7 " SH " row_mask:0xf bank_mask:0xf\n\t" \
    "v_mul_f32_dpp %4, %4, %4 " SH " row_mask:0xf bank_mask:0xf\n\tv_mul_f32_dpp %5, %5, %5 " SH " row_mask:0xf bank_mask:0xf\n\t" \
    "v_mul_f32_dpp %6, %6, %6 " SH " row_mask:0xf bank_mask:0xf\n\tv_mul_f32_dpp %7, %7, %7 " SH " row_mask:0xf bank_mask:0xf" \
    : "+v"(x_[0]), "+v"(x_[1]), "+v"(x_[2]), "+v"(x_[3]), "+v"(a_[0]), "+v"(a_[1]), "+v"(a_[2]), "+v"(a_[3]))
#define LRU_SCANS(av, xv) do { _Pragma("unroll") for (int et = 0; et < 4; ++et) { \
        LRU_DPP_STEP("row_shr:1", xv[0][et], av[0][et]); LRU_DPP_STEP("row_shl:1", xv[1][et], av[1][et]); } \
    _Pragma("unroll") for (int et = 0; et < 4; ++et) { LRU_DPP_STEP("row_shr:2", xv[0][et], av[0][et]); LRU_DPP_STEP("row_shl:2", xv[1][et], av[1][et]); } \
    _Pragma("unroll") for (int et = 0; et < 4; ++et) { LRU_DPP_STEP("row_shr:4", xv[0][et], av[0][et]); LRU_DPP_STEP("row_shl:4", xv[1][et], av[1][et]); } \
    _Pragma("unroll") for (int et = 0; et < 4; ++et) { LRU_DPP_STEP("row_shr:8", xv[0][et], av[0][et]); LRU_DPP_STEP("row_shl:8", xv[1][et], av[1][et]); } } while (0)
__device__ __forceinline__ void ph_lru_a(const Frame& F, int jj) {
    LAS bf16_t* Wl = (LAS bf16_t*)F.lds;
    LAS float* ucb = (LAS float*)(F.lds + 36864 + F.wave * 4352);
    LAS float* CT = (LAS float*)(F.lds + 36864 + 8 * 4352);
    const bf16_t* wsrc = (const bf16_t*)(F.WB + WB_LRU);
    float* AG = (float*)(F.R1 + R1_AG); bf16_t* GX = (bf16_t*)(F.R1 + R1_GX);
    const float* cw = inp(F, 14) + (size_t)jj * 4 * 1024; const float* cb = inp(F, 15) + (size_t)jj * 1024;
    const float* b_a = inp(F, 17) + (size_t)jj * 2 * 1024; const float* b_x = inp(F, 19) + (size_t)jj * 2 * 1024; const float* lam = inp(F, 20) + (size_t)jj * 2 * 1024;
    const int tk = F.lane & 15, g = F.lane >> 4;
    const int NTASK = NBAT * 16 * 11;
    for (int task = F.wg; task < NTASK; task += F.G) {
        const int grp = task % 11, kb = (task / 11) & 15, b = task / (11 * 16);
        __syncthreads();
        for (int i = F.tid; i < 4 * 4096 / 8; i += 512) { const int mg = i >> 9, r = i & 511;
            *(LAS u32x4*)(Wl + (mg * 64 + (r >> 3)) * 72 + (r & 7) * 8) = *(const u32x4*)(wsrc + ((size_t)mg * 16 + kb) * 4096 + r * 8); }
        for (int i = F.tid; i < 11 * 64; i += 512) { const int kind = i >> 6, ch = kb * 64 + (i & 63); float v;
            if (kind < 4) v = cw[kind * 1024 + ch]; else if (kind == 4) v = cb[ch];
            else { const int d = (kind - 5) / 3, w = (kind - 5) % 3; v = (w == 0) ? b_a[d * 1024 + ch] : (w == 1) ? b_x[d * 1024 + ch] : -8.0f * log1pf(__expf(-lam[d * 1024 + ch])); }
            CT[i] = v; }
        __syncthreads();
        const int nt0 = grp * 48;
        LruRaw raw; lru_load(F, b, kb, nt0 + F.wave, raw);
        for (int ti = F.wave; ti < 48; ti += 8) {
            const int nt = nt0 + ti;
            float av[2][4][4], xv[2][4][4];
            lru_conv(F, raw, CT, ucb);
            if (ti + 8 < 48) lru_load(F, b, kb, nt + 8, raw);
            lru_gates(F, Wl, CT, ucb, av, xv);
            const int row = lru_row(b, nt, tk);
#pragma unroll
            for (int d = 0; d < 2; ++d)
#pragma unroll
                for (int et = 0; et < 4; ++et) { u32x4 w; w.x = cvt_pk_bf16(av[d][et][0], xv[d][et][0]); w.y = cvt_pk_bf16(av[d][et][1], xv[d][et][1]); w.z = cvt_pk_bf16(av[d][et][2], xv[d][et][2]); w.w = cvt_pk_bf16(av[d][et][3], xv[d][et][3]);
                    __builtin_nontemporal_store(w, (u32x4*)(GX + (((size_t)row * 2 + d) * 1024 + kb * 64 + et * 16 + 4 * g) * 2));
                    const unsigned ww[4] = {w.x, w.y, w.z, w.w};
#pragma unroll
                    for (int i = 0; i < 4; ++i) { av[d][et][i] = __expf(__uint_as_float(ww[i] << 16)); xv[d][et][i] = __uint_as_float(ww[i] & 0xffff0000u); } }
            LRU_SCANS(av, xv);
#pragma unroll
            for (int d = 0; d < 2; ++d) if (tk == (d ? 0 : 15)) {
                float* ag = AG + (((size_t)(b * 2 + d) * LRU_NT + nt) * 2) * 1024 + kb * 64;
#pragma unroll
                for (int et = 0; et < 4; ++et) { *(f32x4*)(ag + et * 16 + 4 * g) = (f32x4){av[d][et][0], av[d][et][1], av[d][et][2], av[d][et][3]};
                    *(f32x4*)(ag + 1024 + et * 16 + 4 * g) = (f32x4){xv[d][et][0], xv[d][et][1], xv[d][et][2], xv[d][et][3]}; }
            }
        }
    }
    __syncthreads();
}
__device__ __forceinline__ void ph_lru_c(const Frame& F) {
    const float* HST = (const float*)(F.R1 + R1_HST); const bf16_t* GX = (const bf16_t*)(F.R1 + R1_GX);
    const bf16_t* P = (const bf16_t*)(F.R1 + R1_P);
    const int tk = F.lane & 15, g = F.lane >> 4;
    const int gw = F.wg * 8 + F.wave, nw = F.G * 8;
    for (int task = gw; task < NBAT * LRU_NT * 16; task += nw) {
        const int kb = task & 15, nt = (task >> 4) % LRU_NT, b = (task >> 4) / LRU_NT;
        const int row = lru_row(b, nt, tk);
        u32x4 gx[2][4]; f32x4 hf[4], hb[4]; u32x2 yw[4];
#pragma unroll
        for (int d = 0; d < 2; ++d)
#pragma unroll
            for (int et = 0; et < 4; ++et) gx[d][et] = *(const u32x4*)(GX + (((size_t)row * 2 + d) * 1024 + kb * 64 + et * 16 + 4 * g) * 2);
#pragma unroll
        for (int et = 0; et < 4; ++et) { const int ch = kb * 64 + et * 16 + 4 * g;
            hf[et] = *(const f32x4*)(HST + ((size_t)(b * 2 + 0) * LRU_NT + nt) * 1024 + ch);
            hb[et] = *(const f32x4*)(HST + ((size_t)(b * 2 + 1) * LRU_NT + nt) * 1024 + ch);
            yw[et] = *(const u32x2*)(P + (size_t)row * 2048 + ch); }
        float av[2][4][4], xv[2][4][4];
#pragma unroll
        for (int d = 0; d < 2; ++d)
#pragma unroll
            for (int et = 0; et < 4; ++et) { const unsigned ww[4] = {gx[d][et].x, gx[d][et].y, gx[d][et].z, gx[d][et].w};
#pragma unroll
                for (int i = 0; i < 4; ++i) { av[d][et][i] = __expf(__uint_as_float(ww[i] << 16)); xv[d][et][i] = __uint_as_float(ww[i] & 0xffff0000u); } }
        LRU_SCANS(av, xv);
#pragma unroll
        for (int et = 0; et < 4; ++et) {
            const int ch = kb * 64 + et * 16 + 4 * g;
            const float y0 = __uint_as_float(yw[et].x << 16), y1 = __uint_as_float(yw[et].x & 0xffff0000u), y2 = __uint_as_float(yw[et].y << 16), y3 = __uint_as_float(yw[et].y & 0xffff0000u);
            float o[4];
#pragma unroll
            for (int i = 0; i < 4; ++i) o[i] = fmaf(av[0][et][i], hf[et][i], xv[0][et][i]) + fmaf(av[1][et][i], hb[et][i], xv[1][et][i]);
            o[0] *= gelu_tanh_(y0); o[1] *= gelu_tanh_(y1); o[2] *= gelu_tanh_(y2); o[3] *= gelu_tanh_(y3);
            u32x2 w; w.x = cvt_pk_bf16(o[0], o[1]); w.y = cvt_pk_bf16(o[2], o[3]);
            *(u32x2*)(F.MIX + (size_t)row * DM + ch) = w;
        }
    }
}
__device__ __forceinline__ void ph_lru_b(const Frame& F) {
    const float* AG = (const float*)(F.R1 + R1_AG); float* HST = (float*)(F.R1 + R1_HST);
    LAS float* sa = (LAS float*)F.lds; LAS float* sx = sa + 512;
    for (int task = F.wg; task < NBAT * 2 * 32; task += F.G) {
        const int cgp = task & 31, d = (task >> 5) & 1, b = task >> 6;
        const int ch = cgp * 32 + (F.tid & 31), seg = F.tid >> 5;
        const float* ag = AG + ((size_t)(b * 2 + d) * LRU_NT) * 2048 + ch;
        float A = 1.0f, Xv = 0.f;
        for (int i = 0; i < 33; ++i) { const int nt = lru_nat(seg * 33 + i, d); const float a = ag[(size_t)nt * 2048], x = ag[(size_t)nt * 2048 + 1024]; Xv = fmaf(a, Xv, x); A *= a; }
        __syncthreads();
        sa[F.tid] = A; sx[F.tid] = Xv;
        __syncthreads();
        float h = 0.f;
        for (int s2 = 0; s2 < seg; ++s2) h = fmaf(sa[s2 * 32 + (F.tid & 31)], h, sx[s2 * 32 + (F.tid & 31)]);
        float* hs = HST + ((size_t)(b * 2 + d) * LRU_NT) * 1024 + ch;
        for (int i = 0; i < 33; ++i) { const int nt = lru_nat(seg * 33 + i, d); hs[(size_t)nt * 1024] = h; const float a = ag[(size_t)nt * 2048], x = ag[(size_t)nt * 2048 + 1024]; h = fmaf(a, h, x); }
    }
    __syncthreads();
}

__device__ __forceinline__ void topk_better(float& bk, int& be, float& bs, float ok, int oe, float os) { const bool t = (ok > bk) || (ok == bk && oe < be); bk = t ? ok : bk; be = t ? oe : be; bs = t ? os : bs; }
template <int CTRL> __device__ __forceinline__ void topk_step(float& bk, int& be, float& bs) {
    const float ok = dppf<CTRL>(bk, bk), os = dppf<CTRL>(bs, bs); const int oe = __builtin_amdgcn_update_dpp(be, be, CTRL, 0xf, 0xf, false); topk_better(bk, be, bs, ok, oe, os); }
__device__ __forceinline__ void ph_ln_router(const Frame& F, int l, bool dry = false) {
    const bf16_t* RW = (const bf16_t*)(F.WB + WB_RT);
    const float* rbias = inp(F, 23) + l * 64;
    LAS float* part = (LAS float*)F.lds;
    LAS float* LP = (LAS float*)(F.lds + 4096);
    LAS int* hist = (LAS int*)(F.lds + LDS_MISC + MISC_HIST); LAS int* hbase = (LAS int*)(F.lds + LDS_MISC + MISC_HBASE);
    int* tok_e = (int*)(F.ws + OFF_TOKE); int* tok_p = (int*)(F.ws + OFF_TOKP); float* tok_w = (float*)(F.ws + OFF_TOKW);
    int* stok = (int*)(F.ws + OFF_STOK); float* sw = (float*)(F.ws + OFF_SW);
    float* stats = (float*)(F.ws + OFF_STATS);
    unsigned* gcnt = (unsigned*)(F.ws + OFF_CTL + CTL_CNT) + l * 64;
    const int tk = F.lane & 15, g = F.lane >> 4;
    float rb[4];
#pragma unroll
    for (int q = 0; q < 4; ++q) rb[q] = rbias[tk + 16 * q];
    if (F.tid < 64) hist[F.tid] = 0;
    __syncthreads();
    const int NTILE = TT / 16, TILE0 = (l == 3) ? TC / 16 : 0;
    bf16x8 rwf[4][4];
#pragma unroll
    for (int et = 0; et < 4; ++et)
#pragma unroll
        for (int ks = 0; ks < 4; ++ks) rwf[et][ks] = *(const bf16x8*)(RW + (size_t)(et * 16 + tk) * 1024 + F.wave * 128 + ks * 32 + g * 8);
    f32x4 vn[4][2];
    if (TILE0 + F.wg < NTILE) { const float* xr = F.X + (size_t)((TILE0 + F.wg) * 16 + tk) * DM + F.wave * 128 + g * 8;
#pragma unroll
        for (int ks = 0; ks < 4; ++ks) { vn[ks][0] = *(const f32x4*)(xr + ks * 32); vn[ks][1] = *(const f32x4*)(xr + ks * 32 + 4); } }
    for (int tile = TILE0 + F.wg; tile < NTILE; tile += F.G) {
        const int row = tile * 16 + tk; const int s = slot_of_row(tile * 16);
        const float* ab = (const float*)(F.ws + OFF_AB) + (size_t)(l * 5 + s) * 2048;
        f32x4 v[4][2];
#pragma unroll
        for (int ks = 0; ks < 4; ++ks) { v[ks][0] = vn[ks][0]; v[ks][1] = vn[ks][1]; }
        if (tile + F.G < NTILE) { const float* xr = F.X + (size_t)((tile + F.G) * 16 + tk) * DM + F.wave * 128 + g * 8;
#pragma unroll
            for (int ks = 0; ks < 4; ++ks) { vn[ks][0] = *(const f32x4*)(xr + ks * 32); vn[ks][1] = *(const f32x4*)(xr + ks * 32 + 4); } }
        float sum = 0.f, sq = 0.f;
#pragma unroll
        for (int ks = 0; ks < 4; ++ks)
#pragma unroll
            for (int hh = 0; hh < 2; ++hh) { const f32x4 a = v[ks][hh]; sum += (a[0] + a[1]) + (a[2] + a[3]); sq += (a[0] * a[0] + a[1] * a[1]) + (a[2] * a[2] + a[3] * a[3]); }
        sum += __shfl_xor(sum, 16); sum += __shfl_xor(sum, 32); sq += __shfl_xor(sq, 16); sq += __shfl_xor(sq, 32);
        if (g == 0) *(LAS f32x2*)(part + (F.wave * 16 + tk) * 2) = (f32x2){sum, sq};
        __syncthreads();
        float ts = 0.f, tq = 0.f;
#pragma unroll
        for (int w = 0; w < 8; ++w) { const f32x2 p = *(const LAS f32x2*)(part + (w * 16 + tk) * 2); ts += p.x; tq += p.y; }
        const float mean = ts * (1.0f / 1024.0f), var = fmaxf(tq * (1.0f / 1024.0f) - mean * mean, 0.f), rstd = rsqrtf(var + 1e-5f);
        if (F.wave == 0 && g == 0) *(f32x2*)(stats + (size_t)row * 2) = (f32x2){mean, rstd};
        f32x4 acc[4];
#pragma unroll
        for (int et = 0; et < 4; ++et) acc[et] = (f32x4){0.f, 0.f, 0.f, 0.f};
#pragma unroll
        for (int ks = 0; ks < 4; ++ks) { const int k = F.wave * 128 + ks * 32 + g * 8;
            const f32x4 a10 = *(const f32x4*)(ab + k), a11 = *(const f32x4*)(ab + k + 4), b10 = *(const f32x4*)(ab + 1024 + k), b11 = *(const f32x4*)(ab + 1024 + k + 4);
            const f32x4 h0 = (v[ks][0] - mean) * rstd * a10 + b10, h1 = (v[ks][1] - mean) * rstd * a11 + b11;
            u32x4 w; w.x = cvt_pk_bf16(h0[0], h0[1]); w.y = cvt_pk_bf16(h0[2], h0[3]); w.z = cvt_pk_bf16(h1[0], h1[1]); w.w = cvt_pk_bf16(h1[2], h1[3]);
            *(u32x4*)(F.HB + (size_t)row * DM + k) = w;
            bf16x8 af; __builtin_memcpy(&af, &w, 16);
#pragma unroll
            for (int et = 0; et < 4; ++et) acc[et] = __builtin_amdgcn_mfma_f32_16x16x32_bf16(af, rwf[et][ks], acc[et], 0, 0, 0);
        }
#pragma unroll
        for (int et = 0; et < 4; ++et)
#pragma unroll
            for (int i = 0; i < 4; ++i) LP[(F.wave * 16 + 4 * g + i) * 64 + et * 16 + tk] = acc[et][i];
        __syncthreads();
        {
            const int t = 2 * F.wave + (g & 1), r2 = tile * 16 + t;
            float sc[4], key[4];
#pragma unroll
            for (int q = 0; q < 4; ++q) { float lgt = 0.f;
#pragma unroll
                for (int w = 0; w < 8; ++w) lgt += LP[(w * 16 + t) * 64 + tk + 16 * q];
                sc[q] = sigmoidf_(lgt); key[q] = sc[q] + rb[q]; }
            unsigned taken = 0u; int se[6]; float ss[6]; float tot = 0.f;
#pragma unroll
            for (int sel = 0; sel < 6; ++sel) {
                float bk = -1e30f, bs = 0.f; int be = 0;
#pragma unroll
                for (int q = 0; q < 4; ++q) if (!((taken >> q) & 1u) && key[q] > bk) { bk = key[q]; be = tk + 16 * q; bs = sc[q]; }
                topk_step<0xB1>(bk, be, bs); topk_step<0x4E>(bk, be, bs); topk_step<0x141>(bk, be, bs); topk_step<0x140>(bk, be, bs);
                if ((be & 15) == tk) taken |= 1u << (be >> 4);
                se[sel] = be; ss[sel] = bs; tot += bs;
            }
            const float sc2 = 2.5f / tot;
            if (tk < 6 && g < 2) {
                int e = se[0]; float w = ss[0];
#pragma unroll
                for (int q = 1; q < 6; ++q) if (tk == q) { e = se[q]; w = ss[q]; }
                tok_e[r2 * 8 + tk] = e; tok_w[r2 * 8 + tk] = w * sc2; if (!dry) tok_p[r2 * 8 + tk] = __hip_atomic_fetch_add(hist + e, 1, __ATOMIC_RELAXED, __HIP_MEMORY_SCOPE_WORKGROUP);
            }
        }
    }
    asm volatile("s_waitcnt vmcnt(0) lgkmcnt(0)" ::: "memory");
    __syncthreads();
    if (dry) return;
    if (F.tid < 64) hbase[F.tid] = (int)__hip_atomic_fetch_add(gcnt + F.tid, (unsigned)hist[F.tid], __ATOMIC_RELAXED, __HIP_MEMORY_SCOPE_AGENT);
    __syncthreads();
    for (int tile = TILE0 + F.wg; tile < NTILE; tile += F.G) {
        if (F.tid < 96) { const int row = tile * 16 + F.tid / 6, q = F.tid % 6; const int e = tok_e[row * 8 + q]; const int pos = hbase[e] + tok_p[row * 8 + q];
            tok_p[row * 8 + q] = pos; stok[(size_t)e * CAP + pos] = row; sw[(size_t)e * CAP + pos] = tok_w[row * 8 + q]; }
    }
    __syncthreads();
}

__device__ __forceinline__ int moe_tables(const Frame& F, int l) {
    const int t0 = (l == 3) ? TC : 0;
    LAS int* cnt = (LAS int*)(F.lds + LDS_MISC + MISC_CNT); LAS int* tst = (LAS int*)(F.lds + LDS_MISC + MISC_TST); LAS unsigned char* t2e = (LAS unsigned char*)(F.lds + LDS_MISC + MISC_T2E);
    const unsigned* gcnt = (const unsigned*)(F.ws + OFF_CTL + CTL_CNT) + l * 64;
    __syncthreads();
    if (F.tid < 64) cnt[F.tid] = (int)__hip_atomic_load(gcnt + F.tid, __ATOMIC_RELAXED, __HIP_MEMORY_SCOPE_AGENT);
    if (F.tid == 64) cnt[64] = TT - t0;
    __syncthreads();
    if (F.tid == 0) { int s = 0; for (int e = 0; e < 65; ++e) { tst[e] = s; s += (cnt[e] + 255) >> 8; } tst[65] = s; }
    __syncthreads();
    const int ntiles = tst[65];
    for (int t = F.tid; t < ntiles; t += 512) { int e = 0; for (int q = 0; q < 65; ++q) if (t >= tst[q]) e = q; else break; t2e[t] = (unsigned char)e; }
    __syncthreads();
    return ntiles;
}

__device__ __forceinline__ void ph_combine(const Frame& F, int l, bool dry = false) {
    LAS int* tst = (LAS int*)(F.lds + LDS_MISC + MISC_TST);
    (void)moe_tables(F, l);
    const float* gam = inp(F, 6) + (size_t)(l * 2 + 1) * DM; const float* bet = inp(F, 7) + (size_t)(l * 2 + 1) * DM;
    const float* gam0 = inp(F, 6) + (size_t)(l * 2 + 0) * DM; const float* bet0 = inp(F, 7) + (size_t)(l * 2 + 0) * DM;
    const float* stats = (const float*)(F.ws + OFF_STATS);
    const unsigned char* Y = (const unsigned char*)(F.R1 + R1_Y);
    const int* tok_e = (const int*)(F.ws + OFF_TOKE); const int* tok_p = (const int*)(F.ws + OFF_TOKP);
    const int gw = F.wg * 8 + F.wave, nw = F.G * 8;
    const bool lastl = (l == 3);
    const int t0 = lastl ? TC : 0;
    for (int row = t0 + gw; row < TT; row += nw) {
        const int s = slot_of_row(row);
        const float* m = F.mods + (size_t)(l * 5 + s) * 6144;
        const float* mn = F.mods + (size_t)((lastl ? l : l + 1) * 5 + s) * 6144;
        int srow[7];
#pragma unroll
        for (int q = 0; q < 6; ++q) { const int e = tok_e[row * 8 + q]; srow[q] = tst[e] * 256 + tok_p[row * 8 + q]; }
        srow[6] = tst[64] * 256 + (row - t0);
        float v[16];
#pragma unroll
        for (int hh = 0; hh < 2; ++hh) { const int k = hh * 512 + F.lane * 8;
            float y[8];
#pragma unroll
            for (int q = 0; q < 8; ++q) y[q] = 0.f;
#pragma unroll
            for (int q = 0; q < 7; ++q) { const u32x2 w = *(const u32x2*)(Y + (size_t)srow[q] * DM + k);
                const f32x2 t0 = __builtin_amdgcn_cvt_pk_f32_fp8((int)w.x, false), t1 = __builtin_amdgcn_cvt_pk_f32_fp8((int)w.x, true), t2 = __builtin_amdgcn_cvt_pk_f32_fp8((int)w.y, false), t3 = __builtin_amdgcn_cvt_pk_f32_fp8((int)w.y, true);
                y[0] += t0.x; y[1] += t0.y; y[2] += t1.x; y[3] += t1.y; y[4] += t2.x; y[5] += t2.y; y[6] += t3.x; y[7] += t3.y; }
#pragma unroll
            for (int i = 0; i < 8; ++i) y[i] *= (1.0f / 32.0f);
            f32x4 x0 = *(const f32x4*)(F.X + (size_t)row * DM + k), x1 = *(const f32x4*)(F.X + (size_t)row * DM + k + 4);
            { const f32x2 st = *(const f32x2*)(stats + (size_t)row * 2); const f32x4 g0 = *(const f32x4*)(gam0 + k), g1 = *(const f32x4*)(gam0 + k + 4), b0 = *(const f32x4*)(bet0 + k), b1 = *(const f32x4*)(bet0 + k + 4);
              x0 = (x0 - st.x) * st.y * g0 + b0; x1 = (x1 - st.x) * st.y * g1 + b1; }
            const f32x4 m50 = *(const f32x4*)(m + 5 * 1024 + k), m51 = *(const f32x4*)(m + 5 * 1024 + k + 4);
#pragma unroll
            for (int i = 0; i < 4; ++i) { v[hh * 8 + i] = ALPHA * x0[i] + m50[i] * y[i]; v[hh * 8 + 4 + i] = ALPHA * x1[i] + m51[i] * y[4 + i]; }
        }
        float sum = 0.f;
#pragma unroll
        for (int i = 0; i < 16; ++i) sum += v[i];
        sum += __shfl_xor(sum, 1); sum += __shfl_xor(sum, 2); sum += __shfl_xor(sum, 4); sum += __shfl_xor(sum, 8); sum += __shfl_xor(sum, 16); sum += __shfl_xor(sum, 32);
        const float mean = sum * (1.0f / 1024.0f);
        float sq = 0.f;
#pragma unroll
        for (int i = 0; i < 16; ++i) { const float d = v[i] - mean; sq += d * d; }
        sq += __shfl_xor(sq, 1); sq += __shfl_xor(sq, 2); sq += __shfl_xor(sq, 4); sq += __shfl_xor(sq, 8); sq += __shfl_xor(sq, 16); sq += __shfl_xor(sq, 32);
        const float rstd = rsqrtf(sq * (1.0f / 1024.0f) + 1e-5f);
#pragma unroll
        for (int hh = 0; hh < 2; ++hh) { const int k = hh * 512 + F.lane * 8;
            float gm[8], bt[8], xn[8];
            *(f32x4*)&gm[0] = *(const f32x4*)(gam + k); *(f32x4*)&gm[4] = *(const f32x4*)(gam + k + 4);
            *(f32x4*)&bt[0] = *(const f32x4*)(bet + k); *(f32x4*)&bt[4] = *(const f32x4*)(bet + k + 4);
#pragma unroll
            for (int i = 0; i < 8; ++i) xn[i] = (v[hh * 8 + i] - mean) * rstd * gm[i] + bt[i];
            if (dry) { float acc_ = 0.f; for (int i = 0; i < 8; ++i) acc_ += xn[i]; asm volatile("" :: "v"(acc_)); }
            else if (lastl) { if (row >= TC) { float* o = F.out + (size_t)(row - TC) * DM + k; *(f32x4*)o = *(f32x4*)&xn[0]; *(f32x4*)(o + 4) = *(f32x4*)&xn[4]; } }
            else {
                *(f32x4*)(F.X + (size_t)row * DM + k) = *(f32x4*)&xn[0]; *(f32x4*)(F.X + (size_t)row * DM + k + 4) = *(f32x4*)&xn[4];
                float s1[8], b0[8];
                *(f32x4*)&s1[0] = *(const f32x4*)(mn + 1024 + k); *(f32x4*)&s1[4] = *(const f32x4*)(mn + 1024 + k + 4);
                *(f32x4*)&b0[0] = *(const f32x4*)(mn + k); *(f32x4*)&b0[4] = *(const f32x4*)(mn + k + 4);
                float hv[8];
#pragma unroll
                for (int i = 0; i < 8; ++i) hv[i] = xn[i] * (1.0f + s1[i]) + b0[i];
                u32x4 w; w.x = cvt_pk_bf16(hv[0], hv[1]); w.y = cvt_pk_bf16(hv[2], hv[3]); w.z = cvt_pk_bf16(hv[4], hv[5]); w.w = cvt_pk_bf16(hv[6], hv[7]);
                *(u32x4*)(F.HB + (size_t)row * DM + k) = w;
            }
        }
    }
}

constexpr int NPHASE = 2 + 4 * 10;
__global__ void __launch_bounds__(512, 2) mk_fwd(Args args) {
    extern __shared__ __attribute__((aligned(16))) unsigned char lds_raw[];
    Frame F;
    F.out = args.out; F.ws = args.ws; F.lds = (LAS unsigned char*)lds_raw;
    { const int t0 = threadIdx.x; F.wave = __builtin_amdgcn_readfirstlane(t0 >> 6); F.lane = t0 & 63; F.tid = t0; } F.G = gridDim.x; F.wg = blockIdx.x;
    F.mods = (float*)(args.ws + OFF_MODS); F.X = (float*)(args.ws + OFF_X); F.HB = (bf16_t*)(args.ws + OFF_HB); F.MIX = F.HB;
    F.WB = args.ws + OFF_WB; F.R1 = args.ws + OFF_R1;
    volatile LAS unsigned* xbw = (volatile LAS unsigned*)(F.lds + LDS_MISC);
    if (F.tid < 4) xbw[F.tid] = 0u;
    if (F.tid < 30) ((LAS unsigned long long*)(F.lds + LDS_MISC + MISC_INP))[F.tid] = (unsigned long long)args.in[F.tid];
    __syncthreads();
    const int lo = args.ph_lo, hi = args.ph_hi;
    XcdBarrier bar; bar.bar = (unsigned*)(args.ws + OFF_CTL); bar.x = 0; bar.st = xbw;
    if (hi - lo > 1) bar = xcd_barrier_post((unsigned*)(args.ws + OFF_CTL), xbw);
#define IN(k) (lo <= (k) && (k) < hi)
#define SEAM(k) do { if (IN(k) && IN((k) + 1)) { xcd_barrier(bar); if (REPM & 1) xcd_barrier(bar); } } while (0)
    if ((PHM & 1) && IN(0)) { ph_mods(fresh(F)); if (REPM & 65536) { __syncthreads(); ph_mods(fresh(F)); } } SEAM(0);
    if ((PHM & 2) && IN(1)) { ph_init_x(fresh(F)); if (REPM & 131072) ph_init_x(fresh(F)); }
    for (int l = 0; l < 4; ++l) {
        const int pb = 2 + l * 10, j = l >> 1; const bool even = (l & 1) == 0;
        float* mods_l = F.mods + (size_t)l * 5 * 6144;
        F.WB = args.ws + OFF_WB + (size_t)(l & 1) * WB_END;
        if ((PHM & 4) && IN(pb + 0) && !(l & 1)) { for (int rep = 0; rep < ((REPM & 4) ? 2 : 1); ++rep) { ph_convert(fresh(F), l); __syncthreads(); } }
        if (!(l & 1)) SEAM(pb + 0);
        if ((PHM & 8) && IN(pb + 1)) {
            const int N = even ? 4096 : 2048;
            pg8::StaticOrder S; S.init(F.HB, F.WB + WB_IN, TT, N, 1024, F.G, F.wg);
            pg8::EpiStoreBf16 E{(bf16_t*)(F.R1 + R1_P), N};
            for (int rep = 0; rep < ((REPM & 8) ? 2 : 1); ++rep) pg8::gemm_phase(F.lds, 1024, S, E, F.wave);
        } SEAM(pb + 1);
        if (IN(pb + 2)) { if (even) { if (F.wg < 8 && F.G > 16) { ph_hg_ctx(fresh(F), j); } else if (PHM & 16) for (int rep = 0; rep < ((REPM & 16) ? 2 : 1); ++rep) { Frame Fa = fresh(F); if (F.G > 16) { Fa.wg = F.wg - 8; Fa.G = F.G - 8; } ph_attn(Fa, j); } if (PHM & 32) for (int rep = 0; rep < ((REPM & 32) ? 2 : 1); ++rep) ph_hg_a(fresh(F), j); } else { if (PHM & 64) for (int rep = 0; rep < ((REPM & 64) ? 2 : 1); ++rep) ph_lru_a(fresh(F), j); } } SEAM(pb + 2);
        if (IN(pb + 3)) { if (even) { if (PHM & 128) for (int rep = 0; rep < ((REPM & 128) ? 2 : 1); ++rep) { ph_hg_b(fresh(F));
                { Frame Fc = fresh(F); Fc.WB = args.ws + OFF_WB + (size_t)((l + 1) & 1) * WB_END; ph_convert(Fc, l + 1); } } } else { if (PHM & 256) for (int rep = 0; rep < ((REPM & 256) ? 2 : 1); ++rep) ph_lru_b(fresh(F)); } } SEAM(pb + 3);
        if (IN(pb + 4)) { if (even) { if (PHM & 512) for (int rep = 0; rep < ((REPM & 512) ? 2 : 1); ++rep) ph_hg_c(fresh(F), j); } else { if (PHM & 1024) for (int rep = 0; rep < ((REPM & 1024) ? 2 : 1); ++rep) ph_lru_c(fresh(F)); } } SEAM(pb + 4);
        if ((PHM & 2048) && IN(pb + 5)) {
            const int t0 = (l == 3) ? TC : 0;
            pg8::StaticOrder S; S.init(F.MIX + (size_t)t0 * DM, F.WB + WB_OUT, TT - t0, 1024, 1024, F.G, F.wg);
            pg8::EpiResid E{F.X + (size_t)t0 * DM, mods_l, t0};
            pg8::gemm_phase(F.lds, 1024, S, E, F.wave);
        } SEAM(pb + 5);
        if ((PHM & 4096) && IN(pb + 6)) { if (REPM & 4096) ph_ln_router(fresh(F), l, true); ph_ln_router(fresh(F), l); } SEAM(pb + 6);
        if ((PHM & 8192) && IN(pb + 7)) {
            const int ntiles = moe_tables(fresh(F), l);
            pg8::MoeGU S; S.cnt = (const LAS int*)(F.lds + LDS_MISC + MISC_CNT); S.tst = (const LAS int*)(F.lds + LDS_MISC + MISC_TST); S.t2e = (const LAS unsigned char*)(F.lds + LDS_MISC + MISC_T2E);
            S.ntiles = ntiles; S.G = F.G; S.c = F.wg; S.A = (const char*)F.HB; S.Bt = (const char*)(F.WB + WB_GU); S.stok = (const int*)(F.ws + OFF_STOK); S.t0 = (l == 3) ? TC : 0;
            pg8::EpiSwiglu E{(bf16_t*)(F.R1 + R1_H)};
            for (int rep = 0; rep < ((REPM & 8192) ? 2 : 1); ++rep) pg8::gemm_phase(F.lds, 1024, S, E, F.wave);
        } SEAM(pb + 7);
        if ((PHM & 16384) && IN(pb + 8)) {
            const int ntiles = moe_tables(fresh(F), l);
            pg8::MoeDN S; S.cnt = (const LAS int*)(F.lds + LDS_MISC + MISC_CNT); S.tst = (const LAS int*)(F.lds + LDS_MISC + MISC_TST); S.t2e = (const LAS unsigned char*)(F.lds + LDS_MISC + MISC_T2E);
            S.ntiles = ntiles; S.G = F.G; S.c = F.wg; S.A = (const char*)(F.R1 + R1_H); S.Bt = (const char*)(F.WB + WB_DN);
            pg8::EpiDown E{(unsigned char*)(F.R1 + R1_Y), (const float*)(F.ws + OFF_SW), (const LAS int*)(F.lds + LDS_MISC + MISC_CNT)};
            if (REPM & 2) { pg8::EpiNull EN; pg8::gemm_phase(F.lds, 256, S, EN, F.wave); }
            for (int rep = 0; rep < ((REPM & 16384) ? 2 : 1); ++rep) pg8::gemm_phase(F.lds, 256, S, E, F.wave);
        } SEAM(pb + 8);
        if ((PHM & 32768) && IN(pb + 9)) { if (REPM & 32768) ph_combine(fresh(F), l, true); ph_combine(fresh(F), l); } SEAM(pb + 9);
    }
#undef IN
#undef SEAM
}

extern "C" void kernel_launch(void* const* d_in, const int* in_sizes, int n_in, void* d_out, int out_size, void* d_ws, size_t ws_size, hipStream_t stream) {
    static int grid = 0;
    if (grid == 0) {
        if (n_in != 30 || out_size != TX * DM || ws_size < WS_END) { fprintf(stderr, "kernel_launch: unexpected problem (n_in %d out %d ws %zu need %zu)\n", n_in, out_size, ws_size, (size_t)WS_END); grid = -1; return; }
        int dev = 0, cus = 0, per_cu = 0;
        if (hipGetDevice(&dev) != hipSuccess || hipDeviceGetAttribute(&cus, hipDeviceAttributeMultiprocessorCount, dev) != hipSuccess) { grid = -1; return; }
        if (hipFuncSetAttribute((const void*)mk_fwd, hipFuncAttributeMaxDynamicSharedMemorySize, LDS_BYTES) != hipSuccess) { fprintf(stderr, "kernel_launch: hipFuncSetAttribute failed\n"); grid = -1; return; }
        if (hipOccupancyMaxActiveBlocksPerMultiprocessor(&per_cu, (const void*)mk_fwd, 512, LDS_BYTES) != hipSuccess || per_cu < 1) { fprintf(stderr, "kernel_launch: occupancy query says %d\n", per_cu); }
        (void)hipGetLastError();
        grid = cus;
    }
    if (grid < 0) return;
    (void)hipMemsetAsync((char*)d_ws + OFF_CTL, 0, CTL_BYTES, stream);
    Args a{};
    for (int i = 0; i < 30; ++i) a.in[i] = (const float*)d_in[i];
    a.out = (float*)d_out; a.ws = (unsigned char*)d_ws;
#if MK_SPLIT
    for (int p = 0; p < NPHASE; ++p) { a.ph_lo = p; a.ph_hi = p + 1; hipLaunchKernelGGL(mk_fwd, dim3(grid), dim3(512), LDS_BYTES, stream, a); }
#else
    a.ph_lo = 0; a.ph_hi = NPHASE;
    hipLaunchKernelGGL(mk_fwd, dim3(grid), dim3(512), LDS_BYTES, stream, a);
#endif
}
```

```cpp
#include <hip/hip_runtime.h>
#include <cstdio>
#include <cstdint>

#ifndef PHM
#define PHM 0xFFFF
#endif
#ifndef REPM
#define REPM 0
#endif
#ifndef MK_SPLIT
#define MK_SPLIT 0
#endif

typedef unsigned short bf16_t;
typedef short bf16x8 __attribute__((ext_vector_type(8)));
typedef short bf16x4 __attribute__((ext_vector_type(4)));
typedef float f32x4 __attribute__((ext_vector_type(4)));
typedef float f32x2 __attribute__((ext_vector_type(2)));
typedef unsigned u32x4 __attribute__((ext_vector_type(4)));
typedef unsigned u32x2 __attribute__((ext_vector_type(2)));
#define LAS __attribute__((address_space(3)))

constexpr int DM = 1024, NBAT = 4, SEQ = 8192, CTXL = 256;
constexpr int TC = NBAT * CTXL, TX = NBAT * SEQ, TT = TC + TX;
constexpr int NEXP = 64, TOPK = 6;
constexpr int CAP = TT;
constexpr int MOE_ROUTED_ROWS = 6 * TT + 64 * 256;
constexpr int MOE_ROWS = MOE_ROUTED_ROWS + TT;
constexpr int MOE_MAXTILES = MOE_ROWS / 256;
constexpr float ALPHA = 1.681792830507429f;
constexpr int HG_U = 128, HG_NU = (CTXL + SEQ) / HG_U;
constexpr int LRU_NT = (CTXL + SEQ) / 16;

constexpr size_t OFF_CTL = 0, CTL_BYTES = 65536;
constexpr size_t CTL_CNT = 16384, CTL_DBG = 20480;
constexpr size_t OFF_MODS = 65536;
constexpr size_t OFF_LBT = OFF_MODS + 4 * 5 * 6144 * 4;
constexpr size_t OFF_STATS = OFF_LBT + 8192;
constexpr size_t OFF_AB = OFF_STATS + (size_t)TT * 8;
static_assert(OFF_AB + 4 * 5 * 2 * 1024 * 4 <= (1u << 20), "ctl map");
constexpr size_t OFF_TOKE = 1u << 20;
constexpr size_t OFF_TOKP = OFF_TOKE + (size_t)TT * 32;
constexpr size_t OFF_TOKW = OFF_TOKP + (size_t)TT * 32;
constexpr size_t OFF_STOK = OFF_TOKW + (size_t)TT * 32;
constexpr size_t OFF_SW = OFF_STOK + (size_t)64 * CAP * 4;
constexpr size_t OFF_X = OFF_SW + (size_t)64 * CAP * 4;
constexpr size_t OFF_HB = OFF_X + (size_t)TT * DM * 4;
constexpr size_t OFF_WB = OFF_HB + (size_t)TT * DM * 2;
constexpr size_t WB_IN = 0, WB_OUT = WB_IN + (size_t)4096 * 1024 * 2, WB_RT = WB_OUT + (size_t)1024 * 1024 * 2, WB_GU = WB_RT + (size_t)64 * 1024 * 2,
                 WB_DN = WB_GU + (size_t)65 * 512 * 1024 * 2, WB_LRU = WB_DN + (size_t)65 * 1024 * 256 * 2, WB_END = WB_LRU + (size_t)2 * 2 * 16 * 64 * 64 * 2;
constexpr size_t OFF_R1 = OFF_WB + 2 * WB_END;
constexpr size_t R1_P = 0;
constexpr size_t R1_OF = R1_P + (size_t)TT * 4096 * 2;
constexpr size_t R1_SLOC = R1_OF + (size_t)TT * 512 * 4;
constexpr size_t R1_SST = R1_SLOC + (size_t)64 * HG_NU * 4096 * 4;
constexpr size_t R1_DL = R1_SST + (size_t)64 * HG_NU * 4096 * 4;
constexpr size_t R1_AG = (size_t)TT * 2048 * 2;
constexpr size_t R1_HST = R1_AG + (size_t)4 * 2 * LRU_NT * 2 * 1024 * 4;
constexpr size_t R1_GX = R1_HST + (size_t)4 * 2 * LRU_NT * 1024 * 4;
constexpr size_t R1_LRU_END = R1_GX + (size_t)TT * 2 * 1024 * 2 * 2;
constexpr size_t R1_H = 0;
constexpr size_t R1_Y = R1_H + (size_t)MOE_ROWS * 256 * 2;
constexpr size_t R1_MOE_END = R1_Y + (size_t)MOE_ROWS * 1024;
constexpr size_t R1_MIX_END = R1_DL + (size_t)64 * HG_NU * 64 * 4;
constexpr size_t R1_END_ = (R1_MOE_END > R1_MIX_END ? R1_MOE_END : R1_MIX_END);
constexpr size_t WS_END = OFF_R1 + (R1_END_ > R1_LRU_END ? R1_END_ : R1_LRU_END);

constexpr int LDS_STAGE = 131072;
constexpr int LDS_MISC = LDS_STAGE;
constexpr int MISC_CNT = 64;
constexpr int MISC_TST = MISC_CNT + 66 * 4 + 8;
constexpr int MISC_HIST = 640;
constexpr int MISC_HBASE = 896;
constexpr int MISC_T2E = 1152;
constexpr int MISC_INP = 2304;
constexpr int LDS_BYTES = 147456;

#define XB_TMO      128
#define XB_XCNT(j)  (256  + 64 * (j))
#define XB_XSUB(j)  (1280 + 64 * (j))
#define XB_XGEN(j)  (2304 + 64 * (j))
#define XB_TOP      3328
#define XB_TOPGEN   3392
#define XCD_BAR_WORDS 3456
#define XB_SPIN_CAP (1u << 22)
__device__ __forceinline__ unsigned xb_ld(unsigned* p)              { return __hip_atomic_load(p, __ATOMIC_RELAXED, __HIP_MEMORY_SCOPE_AGENT); }
__device__ __forceinline__ unsigned xb_add(unsigned* p, unsigned v) { return __hip_atomic_fetch_add(p, v, __ATOMIC_RELAXED, __HIP_MEMORY_SCOPE_AGENT); }
__device__ __forceinline__ unsigned xb_xcc_id() { return (unsigned)__builtin_amdgcn_s_getreg((3 << 11) | 20) & 0xFu; }
#define XB_SPIN(cond, bar) do { unsigned _sp = 0; while (cond) { __builtin_amdgcn_s_sleep(1); \
    if ((++_sp & 255u) == 0u) { if (xb_ld(&(bar)[XB_TMO])) break; if (_sp > XB_SPIN_CAP) { atomicAdd(&(bar)[XB_TMO], 1u); break; } } } } while (0)
struct XcdBarrier { unsigned* bar; unsigned x; volatile LAS unsigned* st; };
__device__ __forceinline__ XcdBarrier xcd_barrier_post(unsigned* bar, volatile LAS unsigned* st) {
    XcdBarrier b; b.bar = bar; b.x = xb_xcc_id(); b.st = st;
    if (threadIdx.x == 0) (void)xb_add(&bar[XB_XCNT(b.x)], 1u);
    return b;
}
__device__ __forceinline__ void xcd_barrier_complete(unsigned* bar, unsigned x, unsigned& nloc, unsigned& nx) {
    const unsigned G = gridDim.x * gridDim.y * gridDim.z;
    unsigned sum, cnt, mine, sp = 0u;
    for (;;) {
        sum = 0u; cnt = 0u; mine = 0u;
#pragma unroll
        for (unsigned j = 0; j < 16; ++j) { const unsigned c = xb_ld(&bar[XB_XCNT(j)]); sum += c; cnt += (c > 0u) ? 1u : 0u; mine = (j == x) ? c : mine; }
        if (sum == G) break;
        __builtin_amdgcn_s_sleep(1);
        if ((++sp & 255u) == 0u) { if (xb_ld(&bar[XB_TMO])) break; if (sp > XB_SPIN_CAP) { atomicAdd(&bar[XB_TMO], 1u); break; } }
    }
    nloc = mine > 0u ? mine : 1u; nx = cnt > 0u ? cnt : 1u;
}
__device__ __forceinline__ void xcd_barrier(const XcdBarrier& b) {
    asm volatile("s_waitcnt vmcnt(0)" ::: "memory");
    __syncthreads();
    if (threadIdx.x == 0) {
        unsigned* bar = b.bar;
        __builtin_amdgcn_s_waitcnt(0);
        unsigned nloc = b.st[0], nx = b.st[1];
        if (nloc == 0u) { xcd_barrier_complete(bar, b.x, nloc, nx); b.st[0] = nloc; b.st[1] = nx; }
        const unsigned old = xb_add(&bar[XB_XSUB(b.x)], 1u);
        const unsigned gen = old / nloc;
        if (old + 1u == (gen + 1u) * nloc) {
            __builtin_amdgcn_fence(__ATOMIC_RELEASE, "agent");
            asm volatile("s_waitcnt vmcnt(0)" ::: "memory");
            const unsigned og = xb_add(&bar[XB_TOP], 1u);
            const unsigned tg = og / nx;
            if (og + 1u == (tg + 1u) * nx) xb_add(&bar[XB_TOPGEN], 1u);
            else XB_SPIN(xb_ld(&bar[XB_TOPGEN]) == tg, bar);
            __builtin_amdgcn_fence(__ATOMIC_ACQUIRE, "agent");
            xb_add(&bar[XB_XGEN(b.x)], 1u);
            asm volatile("s_waitcnt vmcnt(0)" ::: "memory");
        } else {
            XB_SPIN(xb_ld(&bar[XB_XGEN(b.x)]) == gen, bar);
            __builtin_amdgcn_fence(__ATOMIC_ACQUIRE, "agent");
            asm volatile("s_waitcnt vmcnt(0)" ::: "memory");
        }
    }
    __syncthreads();
}

__device__ __forceinline__ float bf2f(unsigned short b) { return __uint_as_float(((unsigned)b) << 16); }
__device__ __forceinline__ unsigned cvt_pk_bf16(float lo, float hi) { unsigned r; asm volatile("v_cvt_pk_bf16_f32 %0, %1, %2" : "=v"(r) : "v"(lo), "v"(hi)); return r; }
__device__ __forceinline__ unsigned short f2bf(float f) { return (unsigned short)(cvt_pk_bf16(f, 0.f) & 0xffffu); }
__device__ __forceinline__ float sigmoidf_(float x) { return __builtin_amdgcn_rcpf(1.0f + __expf(-x)); }
__device__ __forceinline__ float siluf_(float x) { return x * sigmoidf_(x); }
__device__ __forceinline__ float gelu_tanh_(float x) { return x * sigmoidf_(1.5957691216057308f * (x + 0.044715f * x * x * x)); }
__device__ __forceinline__ int slot_of_row(int r) { return r < TC ? 4 : ((r - TC) >> 13); }
template <int CTRL> __device__ __forceinline__ float dppf(float oldv, float src) {
    return __int_as_float(__builtin_amdgcn_update_dpp(__float_as_int(oldv), __float_as_int(src), CTRL, 0xf, 0xf, false));
}
__device__ __forceinline__ void unpack8(const u32x4 w, float (&o)[8]) {
    o[0] = __uint_as_float(w.x << 16); o[1] = __uint_as_float(w.x & 0xffff0000u); o[2] = __uint_as_float(w.y << 16); o[3] = __uint_as_float(w.y & 0xffff0000u);
    o[4] = __uint_as_float(w.z << 16); o[5] = __uint_as_float(w.z & 0xffff0000u); o[6] = __uint_as_float(w.w << 16); o[7] = __uint_as_float(w.w & 0xffff0000u);
}

namespace pg8 {
constexpr int BM = 256, BK = 64, HALF = 128, HTB = HALF * BK * 2, STAGE_BYTES = 8 * HTB, NXCD = 8, WGM = 8;
__device__ __forceinline__ int lds_byte(int r, int c) { const int st = (r >> 4) * 2 + (c >> 5), rr = r & 15, cc = c & 31, ob = rr * 64 + cc * 2; return st * 1024 + (ob ^ (((ob >> 9) & 1) << 5)); }
__device__ __forceinline__ void stage_rc(int b, int& R, int& C) { const int st = b / 1024, sb = b % 1024, swz = sb ^ (((sb >> 9) & 1) << 5); R = (st >> 1) * 16 + swz / 64; C = (st & 1) * 32 + (swz % 64) / 2; }
__device__ __forceinline__ int perm32(int rho) { const int n = rho >> 4, i = rho & 15; return 8 * (i >> 2) + 4 * n + (i & 3); }
struct Unit { int pm, pn, e, ti; };

struct StaticOrder {
    const char* A; const char* Bt; int K;
    int nM, nN, nwg, G, c;
    __device__ __forceinline__ void init(const void* A_, const void* Bt_, int M, int N, int K_, int G_, int c_) { A = (const char*)A_; Bt = (const char*)Bt_; K = K_; nM = M / BM; nN = N / BM; nwg = nM * nN; G = G_; c = c_; }
    __device__ __forceinline__ bool next(int i, Unit& u) const {
        const long L = (long)i * G + c; if (L >= nwg) return false;
        int wgid = (int)L; { const int q = nwg / NXCD, r = nwg % NXCD, xcd = wgid % NXCD, off = wgid / NXCD; wgid = (xcd < r ? xcd * (q + 1) : r * (q + 1) + (xcd - r) * q) + off; }
        const int nig = WGM * nN, gid = wgid / nig, fm = gid * WGM, gsz = (nM - fm) < WGM ? (nM - fm) : WGM;
        u.pm = fm + ((wgid % nig) % gsz); u.pn = (wgid % nig) / gsz; u.e = 0; u.ti = 0; return true;
    }
    static constexpr bool GATHER = false;
    __device__ __forceinline__ const char* abase(const Unit& u) const { return A + (size_t)u.pm * BM * K * 2; }
    __device__ __forceinline__ const char* bbase(const Unit& u) const { return Bt + (size_t)u.pn * BM * K * 2; }
};

template <class Epi, class Sched>
__device__ __forceinline__ void gemm_phase(LAS unsigned char* lds, const int K_, const Sched& S, const Epi& E, const int wave_) {
    int Kl_ = K_; asm volatile("" : "+s"(Kl_)); const int K = Kl_;
    int tid_ = wave_ * 64 + (int)__builtin_amdgcn_mbcnt_hi(~0u, __builtin_amdgcn_mbcnt_lo(~0u, 0u)); asm volatile("" : "+v"(tid_));
    const int tid = tid_, wid = __builtin_amdgcn_readfirstlane(tid >> 6), lane = tid & 63, wr = wid >> 2, wc = wid & 3, fr = lane & 15, fq = lane >> 4;
    const int nt = K / BK;
    unsigned voffA[2], voffB[2];
#pragma unroll
    for (int i = 0; i < 2; ++i) { int R, C; stage_rc(tid * 16 + i * 8192, R, C);
        const int Rb = Epi::PERM == 1 ? ((R & ~31) + perm32(R & 31)) : Epi::PERM == 2 ? (64 * (R >> 5) + 16 * ((R & 15) >> 2) + 4 * ((R >> 4) & 1) + (R & 3)) : R;
        voffA[i] = (unsigned)(R * K + C) * 2u; voffB[i] = (unsigned)(Rb * K + C) * 2u; }
    const size_t kstep = (size_t)(BK * 2);
    const size_t hstep = (size_t)HALF * K * 2;
    const size_t hstepB = Epi::PERM == 2 ? (size_t)8 * K * 2 : hstep;
    const unsigned ldsw = (unsigned)wid * 1024u;
    const int aoff = lds_byte(wr * 64 + fr, fq * 8), boff = lds_byte(wc * 32 + fr, fq * 8);
#define PG8_SA(b, h) (((b) * 2 + (h)) * HTB)
#define PG8_SB(b, h) ((4 + (b) * 2 + (h)) * HTB)
#define PG8_STAGE(bufoff, gbase, voff) do { _Pragma("unroll") for (int _i = 0; _i < 2; ++_i) \
        __builtin_amdgcn_global_load_lds((const unsigned*)((const char*)(gbase) + (voff)[_i]), (LAS unsigned*)(lds + (bufoff) + ldsw + _i * 8192), 16, 0, 0); } while (0)
#define PG8_STAGEA(bufoff, hh, kb, nx) do { if constexpr (Sched::GATHER) { unsigned _o[2]; _o[0] = (nx) ? vN[hh][0] : vC[hh][0]; _o[1] = (nx) ? vN[hh][1] : vC[hh][1]; PG8_STAGE(bufoff, cA + (kb), _o); } \
        else { PG8_STAGE(bufoff, ((nx) ? nA : cA) + (hh) * hstep + (kb), voffA); } } while (0)
#define PG8_LDA(dst, b, h) do { _Pragma("unroll") for (int m = 0; m < 4; ++m) _Pragma("unroll") for (int k = 0; k < 2; ++k) dst[m][k] = *(const LAS bf16x8*)(lds + PG8_SA(b, h) + aoff + m * 2048 + k * 1024); } while (0)
#define PG8_LDB(dst, b, h) do { _Pragma("unroll") for (int n = 0; n < 2; ++n) _Pragma("unroll") for (int k = 0; k < 2; ++k) dst[n][k] = *(const LAS bf16x8*)(lds + PG8_SB(b, h) + boff + n * 2048 + k * 1024); } while (0)
#define PG8_MMA(ai, bj, At, Bt) do { __builtin_amdgcn_s_setprio(1); _Pragma("unroll") for (int m = 0; m < 4; ++m) _Pragma("unroll") for (int n = 0; n < 2; ++n) _Pragma("unroll") for (int k = 0; k < 2; ++k) \
        acc[ai][bj][m][n] = __builtin_amdgcn_mfma_f32_16x16x32_bf16(Bt[n][k], At[m][k], acc[ai][bj][m][n], 0, 0, 0); __builtin_amdgcn_s_setprio(0); } while (0)
#define PG8_WAIT_V(n) asm volatile("s_waitcnt vmcnt(" #n ")" ::: "memory")
#define PG8_WAIT_L(n) asm volatile("s_waitcnt lgkmcnt(" #n ")" ::: "memory")
#define PG8_BAR __builtin_amdgcn_s_barrier()
#define PG8_SCHED __builtin_amdgcn_sched_barrier(0)
    Unit cur, nxt; int ui = 0;
    if (!S.next(0, cur)) return;
    f32x4 acc[2][2][4][2];
#pragma unroll
    for (int a = 0; a < 2; ++a)
#pragma unroll
        for (int b = 0; b < 2; ++b)
#pragma unroll
            for (int m = 0; m < 4; ++m)
#pragma unroll
                for (int n = 0; n < 2; ++n) acc[a][b][m][n] = (f32x4){0.f, 0.f, 0.f, 0.f};
    bf16x8 At[4][2], B0[2][2], B1[2][2];
    unsigned vC[2][2], vN[2][2];
    if constexpr (Sched::GATHER) S.aoff(cur, tid, vC);
    const char* cA = S.abase(cur);
    const char* cB = S.bbase(cur);
    const char* nA = cA;
    PG8_STAGE(PG8_SB(0, 0), cB, voffB); PG8_STAGEA(PG8_SA(0, 0), 0, 0, false); PG8_STAGE(PG8_SB(0, 1), cB + hstepB, voffB); PG8_STAGEA(PG8_SA(0, 1), 1, 0, false);
    if (wr == 1) PG8_BAR;
    PG8_WAIT_V(4); PG8_BAR;
    PG8_STAGE(PG8_SB(1, 0), cB + kstep, voffB); PG8_STAGEA(PG8_SA(1, 0), 0, kstep, false); PG8_STAGE(PG8_SB(1, 1), cB + hstepB + kstep, voffB);
    PG8_WAIT_V(6); PG8_BAR;
    for (;;) {
        const bool has_next = S.next(ui + 1, nxt);
        const char* nB = cB; nA = cA;
        if (has_next) { nB = S.bbase(nxt); nA = S.abase(nxt); if constexpr (Sched::GATHER) S.aoff(nxt, tid, vN); }
        else { if constexpr (Sched::GATHER) {
#pragma unroll
            for (int h = 0; h < 2; ++h)
#pragma unroll
                for (int i = 0; i < 2; ++i) vN[h][i] = vC[h][i]; } }
        for (int t = 0; t < nt; t += 2) {
            const bool last = (t == nt - 2);
            const size_t k1 = (size_t)(t + 1) * kstep, k2 = last ? 0 : (size_t)(t + 2) * kstep, k3 = k2 + kstep;
            const char* b2 = last ? nB : cB + (size_t)(t + 2) * kstep; const char* b3 = b2 + kstep;
            PG8_LDB(B0, 0, 0); PG8_SCHED; PG8_LDA(At, 0, 0); PG8_STAGEA(PG8_SA(1, 1), 1, k1, false);
            PG8_WAIT_L(8); PG8_BAR; PG8_WAIT_L(0); PG8_MMA(0, 0, At, B0); PG8_BAR; PG8_SCHED;
            PG8_LDB(B1, 0, 1); PG8_STAGE(PG8_SB(0, 0), b2, voffB);
            PG8_BAR; PG8_WAIT_L(0); PG8_MMA(0, 1, At, B1); PG8_BAR;
            PG8_LDA(At, 0, 1); PG8_STAGEA(PG8_SA(0, 0), 0, k2, last);
            PG8_BAR; PG8_WAIT_L(0); PG8_MMA(1, 0, At, B0); PG8_BAR; PG8_SCHED;
            PG8_STAGE(PG8_SB(0, 1), b2 + hstepB, voffB);
            PG8_WAIT_V(6); PG8_BAR; PG8_MMA(1, 1, At, B1); PG8_BAR;
            PG8_LDB(B0, 1, 0); PG8_SCHED; PG8_LDA(At, 1, 0); PG8_STAGEA(PG8_SA(0, 1), 1, k2, last);
            PG8_WAIT_L(8); PG8_BAR; PG8_WAIT_L(0); PG8_MMA(0, 0, At, B0); PG8_BAR; PG8_SCHED;
            PG8_LDB(B1, 1, 1); PG8_STAGE(PG8_SB(1, 0), b3, voffB);
            PG8_BAR; PG8_WAIT_L(0); PG8_MMA(0, 1, At, B1); PG8_BAR;
            PG8_LDA(At, 1, 1); PG8_STAGEA(PG8_SA(1, 0), 0, k3, last);
            PG8_BAR; PG8_WAIT_L(0); PG8_MMA(1, 0, At, B0); PG8_BAR; PG8_SCHED;
            PG8_STAGE(PG8_SB(1, 1), b3 + hstepB, voffB);
            PG8_WAIT_V(6); PG8_BAR; PG8_MMA(1, 1, At, B1); PG8_BAR;
        }
        E(acc, cur, wr, wc, fr, fq);
        if (!has_next) break;
#pragma unroll
        for (int a = 0; a < 2; ++a)
#pragma unroll
            for (int b = 0; b < 2; ++b)
#pragma unroll
                for (int m = 0; m < 4; ++m)
#pragma unroll
                    for (int n = 0; n < 2; ++n) acc[a][b][m][n] = (f32x4){0.f, 0.f, 0.f, 0.f};
        cur = nxt; cB = nB; cA = nA; ++ui;
        if constexpr (Sched::GATHER) {
#pragma unroll
            for (int h = 0; h < 2; ++h)
#pragma unroll
                for (int i = 0; i < 2; ++i) vC[h][i] = vN[h][i]; }
    }
    PG8_WAIT_V(0);
    if (wr == 0) PG8_BAR;
    PG8_BAR;
#undef PG8_SA
#undef PG8_SB
#undef PG8_STAGE
#undef PG8_STAGEA
#undef PG8_LDA
#undef PG8_LDB
#undef PG8_MMA
#undef PG8_WAIT_V
#undef PG8_WAIT_L
#undef PG8_BAR
#undef PG8_SCHED
}

struct EpiStoreBf16 {
    static constexpr int PERM = 2;
    bf16_t* O; int ldc;
    __device__ __forceinline__ void operator()(const f32x4 (&acc)[2][2][4][2], const Unit& u, int wr, int wc, int fr, int fq) const {
        const int row0 = u.pm * BM + wr * 64 + fr, col0 = u.pn * BM + wc * 64 + 16 * fq;
#pragma unroll
        for (int ai = 0; ai < 2; ++ai)
#pragma unroll
            for (int m = 0; m < 4; ++m) { bf16_t* rowp = O + (size_t)(row0 + ai * HALF + m * 16) * ldc + col0;
#pragma unroll
                for (int bj = 0; bj < 2; ++bj) { const f32x4 v0 = acc[ai][bj][m][0], v1 = acc[ai][bj][m][1];
                    u32x4 w; w.x = cvt_pk_bf16(v0[0], v0[1]); w.y = cvt_pk_bf16(v0[2], v0[3]); w.z = cvt_pk_bf16(v1[0], v1[1]); w.w = cvt_pk_bf16(v1[2], v1[3]);
                    *(u32x4*)(rowp + bj * 8) = w; } }
    }
};
struct EpiResid {
    static constexpr int PERM = 0;
    float* X; const float* mods_l; int rbase;
    __device__ __forceinline__ void operator()(const f32x4 (&acc)[2][2][4][2], const Unit& u, int wr, int wc, int fr, int fq) const {
        const int row0 = u.pm * BM + wr * 64 + fr, col0 = u.pn * BM + wc * 32 + 4 * fq;
        const float* m2 = mods_l + (size_t)(slot_of_row(rbase + u.pm * BM) * 6 + 2) * DM + col0;
        float* xb = X + (size_t)row0 * DM + col0;
#pragma unroll
        for (int bj = 0; bj < 2; ++bj)
#pragma unroll
            for (int n = 0; n < 2; ++n) { const f32x4 mv = *(const f32x4*)(m2 + bj * HALF + n * 16);
                f32x4 xv[8];
#pragma unroll
                for (int q = 0; q < 8; ++q) xv[q] = *(const f32x4*)(xb + (size_t)((q >> 2) * HALF + (q & 3) * 16) * DM + bj * HALF + n * 16);
#pragma unroll
                for (int q = 0; q < 8; ++q) *(f32x4*)(xb + (size_t)((q >> 2) * HALF + (q & 3) * 16) * DM + bj * HALF + n * 16) = xv[q] * ALPHA + mv * acc[q >> 2][bj][q & 3][n];
                asm volatile("" ::: "memory"); }
    }
};
struct EpiSwiglu {
    static constexpr int PERM = 1;
    bf16_t* H;
    __device__ __forceinline__ void operator()(const f32x4 (&acc)[2][2][4][2], const Unit& u, int wr, int wc, int fr, int fq) const {
        const int row0 = u.pm * BM + wr * 64 + fr, col0 = u.pn * HALF + wc * 32 + 8 * fq;
#pragma unroll
        for (int ai = 0; ai < 2; ++ai)
#pragma unroll
            for (int m = 0; m < 4; ++m) { bf16_t* rowp = H + (size_t)(row0 + ai * HALF + m * 16) * 256 + col0;
                float h[8];
#pragma unroll
                for (int n = 0; n < 2; ++n)
#pragma unroll
                    for (int j = 0; j < 4; ++j) h[n * 4 + j] = siluf_(acc[ai][0][m][n][j]) * acc[ai][1][m][n][j];
                u32x4 w; w.x = cvt_pk_bf16(h[0], h[1]); w.y = cvt_pk_bf16(h[2], h[3]); w.z = cvt_pk_bf16(h[4], h[5]); w.w = cvt_pk_bf16(h[6], h[7]);
                *(u32x4*)rowp = w; }
    }
};
struct EpiDown {
    static constexpr int PERM = 2;
    unsigned char* Y; const float* sw; const LAS int* cnt;
    __device__ __forceinline__ void operator()(const f32x4 (&acc)[2][2][4][2], const Unit& u, int wr, int wc, int fr, int fq) const {
        const int row0 = u.pm * BM + wr * 64 + fr, col0 = u.pn * BM + wc * 64 + 16 * fq;
        const int ce = (u.e < 64) ? cnt[u.e] : 0;
        const float* swe = sw + (size_t)(u.e < 64 ? u.e : 0) * CAP + u.ti * 256 + wr * 64 + fr;
        unsigned char* yb = Y + (size_t)row0 * DM + col0;
        float wv[8];
#pragma unroll
        for (int q = 0; q < 8; ++q) { const int rl = (q >> 2) * HALF + (q & 3) * 16, pos = u.ti * 256 + wr * 64 + fr + rl; wv[q] = 32.0f; if (u.e < 64) wv[q] = (pos < ce) ? swe[rl] * 32.0f : 0.0f; }
#pragma unroll
        for (int ai = 0; ai < 2; ++ai)
#pragma unroll
            for (int m = 0; m < 4; ++m) { const int rl = ai * HALF + m * 16; const float w = wv[ai * 4 + m];
                u32x4 ww; unsigned pk[4];
#pragma unroll
                for (int bj = 0; bj < 2; ++bj)
#pragma unroll
                    for (int n = 0; n < 2; ++n) { f32x4 v = acc[ai][bj][m][n] * w;
#pragma unroll
                        for (int j = 0; j < 4; ++j) v[j] = __builtin_amdgcn_fmed3f(v[j], -440.0f, 440.0f);
                        int p = __builtin_amdgcn_cvt_pk_fp8_f32(v[0], v[1], 0, false); p = __builtin_amdgcn_cvt_pk_fp8_f32(v[2], v[3], p, true); pk[bj * 2 + n] = (unsigned)p; }
                ww.x = pk[0]; ww.y = pk[1]; ww.z = pk[2]; ww.w = pk[3];
                __builtin_nontemporal_store(ww, (u32x4*)(yb + (size_t)rl * DM));
                asm volatile("" ::: "memory"); }
    }
};
struct EpiNull {
    static constexpr int PERM = 1;
    __device__ __forceinline__ void operator()(const f32x4 (&acc)[2][2][4][2], const Unit&, int, int, int, int) const {
#pragma unroll
        for (int ai = 0; ai < 2; ++ai)
#pragma unroll
            for (int bj = 0; bj < 2; ++bj)
#pragma unroll
                for (int m = 0; m < 4; ++m)
#pragma unroll
                    for (int n = 0; n < 2; ++n) asm volatile("" :: "v"(acc[ai][bj][m][n]));
    }
};
template <int NPN> struct MoeOrder {
    const LAS int* cnt; const LAS int* tst; const LAS unsigned char* t2e; int ntiles, G, c;
    __device__ __forceinline__ bool next(int i, Unit& u) const {
        const int cs = ((G & 7) == 0) ? (c & 7) * (G >> 3) + (c >> 3) : c;
        const int L = i * G + cs; if (L >= ntiles * NPN) return false;
        const int tau = L / NPN; u.pm = tau; u.pn = L % NPN; u.e = t2e[tau]; u.ti = tau - tst[u.e]; return true;
    }
};
struct MoeGU : MoeOrder<2> {
    static constexpr bool GATHER = true;
    const char* A; const char* Bt; const int* stok; int t0;
    __device__ __forceinline__ const char* abase(const Unit&) const { return A; }
    __device__ __forceinline__ const char* bbase(const Unit& u) const { return Bt + ((size_t)u.e * 512 + (size_t)u.pn * 256) * 1024 * 2; }
    __device__ __forceinline__ void aoff(const Unit& u, int tid, unsigned (&off)[2][2]) const {
        const int ce = cnt[u.e];
#pragma unroll
        for (int i = 0; i < 2; ++i) { int R, C; stage_rc(tid * 16 + i * 8192, R, C);
#pragma unroll
            for (int h = 0; h < 2; ++h) { const int pos = u.ti * 256 + h * HALF + R; int tok;
                if (u.e == 64) tok = t0 + pos; else tok = (pos < ce) ? stok[(size_t)u.e * CAP + pos] : 0;
                off[h][i] = (unsigned)(tok * 1024 + C) * 2u; } }
    }
};
struct MoeDN : MoeOrder<4> {
    static constexpr bool GATHER = false;
    const char* A; const char* Bt;
    __device__ __forceinline__ const char* abase(const Unit& u) const { return A + (size_t)u.pm * BM * 256 * 2; }
    __device__ __forceinline__ const char* bbase(const Unit& u) const { return Bt + ((size_t)u.e * 1024 + (size_t)u.pn * 256) * 256 * 2; }
};
}

struct Args { const float* in[30]; float* out; unsigned char* ws; int ph_lo, ph_hi; };

struct Frame {
    float* out; unsigned char* ws; LAS unsigned char* lds; int tid, lane, wave, G, wg;
    float* mods; float* X; bf16_t* HB; bf16_t* MIX; unsigned char* WB; unsigned char* R1;
};

__device__ __forceinline__ const float* inp(const Frame& F, int i) {
    const unsigned long long v = ((const LAS unsigned long long*)(F.lds + LDS_MISC + MISC_INP))[i];
    const unsigned lo = (unsigned)__builtin_amdgcn_readfirstlane((int)(unsigned)v), hi = (unsigned)__builtin_amdgcn_readfirstlane((int)(unsigned)(v >> 32));
    return (const float*)(((unsigned long long)hi << 32) | lo);
}
__device__ __forceinline__ int lane_id_() { return (int)__builtin_amdgcn_mbcnt_hi(~0u, __builtin_amdgcn_mbcnt_lo(~0u, 0u)); }
__device__ __forceinline__ Frame fresh(const Frame& F0) { Frame F = F0; int ln = lane_id_(); asm volatile("" : "+v"(ln)); F.lane = ln; F.tid = F0.wave * 64 + ln; return F; }

__device__ __forceinline__ void ph_mods(const Frame& F) {
    const float* c = inp(F, 1); const float* cc = inp(F, 3); const float* ada_w = inp(F, 4); const float* ada_b = inp(F, 5);
    LAS float* sv = (LAS float*)F.lds;
    LAS float* red = (LAS float*)(F.lds + 5 * 1024 * 4);
    for (int i = F.tid; i < 5 * 1024; i += 512) { const int s = i >> 10, k = i & 1023; const float v = (s < 4) ? c[s * 1024 + k] : cc[k]; sv[i] = siluf_(v); }
    __syncthreads();
    for (int task = F.wg; task < 4 * 48; task += F.G) {
        const int l = task / 48, cc0 = (task % 48) * 128;
        const int cg = F.tid & 31, kg = F.tid >> 5;
        const float* w = ada_w + (size_t)l * 1024 * 6144 + cc0 + cg * 4;
        f32x4 acc[5];
#pragma unroll
        for (int s = 0; s < 5; ++s) acc[s] = (f32x4){0.f, 0.f, 0.f, 0.f};
#pragma unroll 8
        for (int kk = 0; kk < 64; ++kk) { const int k = kg * 64 + kk; const f32x4 wv = *(const f32x4*)(w + (size_t)k * 6144);
#pragma unroll
            for (int s = 0; s < 5; ++s) acc[s] += wv * sv[s * 1024 + k]; }
#pragma unroll
        for (int s = 0; s < 5; ++s)
#pragma unroll
            for (int q = 0; q < 4; ++q) red[((kg * 128) + cg * 4 + q) * 5 + s] = acc[s][q];
        __syncthreads();
        if (F.tid < 128) {
            const int col = cc0 + F.tid; const float bsv = ada_b[l * 6144 + col];
#pragma unroll
            for (int s = 0; s < 5; ++s) { float v = 0.f;
#pragma unroll
                for (int g2 = 0; g2 < 16; ++g2) v += red[((g2 * 128) + F.tid) * 5 + s];
                F.mods[(size_t)(l * 5 + s) * 6144 + col] = v + bsv; }
        }
        __syncthreads();
    }
    if (F.wg == F.G - 1) {
        const float* raw = inp(F, 11); float* lbt = (float*)(F.ws + OFF_LBT);
        for (int i = F.tid; i < 2 * 512; i += 512) { const int d = i >> 9, ch = i & 511; const float r0 = raw[(d * 2 + 0) * 512 + ch], r1 = raw[(d * 2 + 1) * 512 + ch];
            lbt[(0 * 2 + d) * 512 + ch] = 0.f; lbt[(1 * 2 + d) * 512 + ch] = sigmoidf_(r1 - r0); }
    }
}

__device__ __forceinline__ void ph_init_x(const Frame& F) {
    const float* x = inp(F, 0); const float* ctx = inp(F, 2);
    { const float* lg_ = inp(F, 6); const float* lb_ = inp(F, 7); float* AB = (float*)(F.ws + OFF_AB);
      for (int i = F.wg * 512 + F.tid; i < 4 * 5 * 1024; i += F.G * 512) { const int k = i & 1023, ls = i >> 10, l = ls / 5;
          const float* m = F.mods + (size_t)ls * 6144; const float g0 = lg_[(l * 2) * 1024 + k], b0 = lb_[(l * 2) * 1024 + k], m3 = m[3 * 1024 + k], m4 = m[4 * 1024 + k];
          AB[(size_t)ls * 2048 + k] = g0 * (1.0f + m4); AB[(size_t)ls * 2048 + 1024 + k] = b0 * (1.0f + m4) + m3; } }
    const int gw = F.wg * 8 + F.wave, nw = F.G * 8;
    for (int row = gw; row < TT; row += nw) {
        const float* src = row < TC ? ctx + (size_t)row * DM : x + (size_t)(row - TC) * DM;
        const float* m = F.mods + (size_t)(0 * 5 + slot_of_row(row)) * 6144;
#pragma unroll
        for (int hh = 0; hh < 2; ++hh) { const int k = hh * 512 + F.lane * 8;
            const f32x4 v0 = *(const f32x4*)(src + k), v1 = *(const f32x4*)(src + k + 4);
            *(f32x4*)(F.X + (size_t)row * DM + k) = v0; *(f32x4*)(F.X + (size_t)row * DM + k + 4) = v1;
            const f32x4 s0 = *(const f32x4*)(m + 1024 + k), s1 = *(const f32x4*)(m + 1024 + k + 4), b0 = *(const f32x4*)(m + k), b1 = *(const f32x4*)(m + k + 4);
            const f32x4 h0 = v0 * (s0 + 1.0f) + b0, h1 = v1 * (s1 + 1.0f) + b1;
            u32x4 w; w.x = cvt_pk_bf16(h0[0], h0[1]); w.y = cvt_pk_bf16(h0[2], h0[3]); w.z = cvt_pk_bf16(h1[0], h1[1]); w.w = cvt_pk_bf16(h1[2], h1[3]);
            *(u32x4*)(F.HB + (size_t)row * DM + k) = w; }
    }
}

__device__ __forceinline__ void cvt_tile(const Frame& F, const float* src, int sld, int k0, int n0, bf16_t* dst, int dld, int drow0, float scale) {
    LAS float* t = (LAS float*)F.lds;
    { const int i = F.tid >> 3, j0 = (F.tid & 7) * 8; const float* p = src + (size_t)(k0 + i) * sld + n0 + j0;
      const f32x4 a = *(const f32x4*)p, b = *(const f32x4*)(p + 4);
      LAS float* q = t + i * 65 + j0; q[0] = a[0]; q[1] = a[1]; q[2] = a[2]; q[3] = a[3]; q[4] = b[0]; q[5] = b[1]; q[6] = b[2]; q[7] = b[3]; }
    __syncthreads();
    { const int j = F.tid >> 3, i0 = (F.tid & 7) * 8; float v[8];
#pragma unroll
      for (int q = 0; q < 8; ++q) v[q] = t[(i0 + q) * 65 + j] * scale;
      u32x4 w; w.x = cvt_pk_bf16(v[0], v[1]); w.y = cvt_pk_bf16(v[2], v[3]); w.z = cvt_pk_bf16(v[4], v[5]); w.w = cvt_pk_bf16(v[6], v[7]);
      *(u32x4*)(dst + (size_t)(drow0 + j) * dld + k0 + i0) = w; }
    __syncthreads();
}
__device__ __forceinline__ void ph_convert(const Frame& F, int l) {
    const int j = l >> 1; const bool even = (l & 1) == 0;
    bf16_t* wIN = (bf16_t*)(F.WB + WB_IN); bf16_t* wOUT = (bf16_t*)(F.WB + WB_OUT); bf16_t* wRT = (bf16_t*)(F.WB + WB_RT);
    bf16_t* wGU = (bf16_t*)(F.WB + WB_GU); bf16_t* wDN = (bf16_t*)(F.WB + WB_DN); bf16_t* wLRU = (bf16_t*)(F.WB + WB_LRU);
    const int nIN = even ? 4096 : 2048;
    const int t_in = (nIN / 64) * 16, t_out = 256, t_rt = 16, t_gu = 65 * 2 * 64, t_dn = 65 * 64, t_lru = even ? 0 : 64;
    const int total = t_in + t_out + t_rt + t_gu + t_dn + t_lru;
    for (int task = F.wg; task < total; task += F.G) {
        int t = task;
        if (t < t_in) { const int nb = t >> 4, kb = t & 15; const float* src = even ? inp(F, 8) + (size_t)j * 1024 * 4096 : inp(F, 13) + (size_t)j * 1024 * 2048;
            cvt_tile(F, src, nIN, kb * 64, nb * 64, wIN, 1024, nb * 64, (even && nb < 8) ? 0.125f * 1.4426950408889634f : 1.0f); continue; }
        t -= t_in;
        if (t < t_out) { const int nb = t >> 4, kb = t & 15; const float* src = even ? inp(F, 9) + (size_t)j * 1024 * 1024 : inp(F, 21) + (size_t)j * 1024 * 1024;
            cvt_tile(F, src, 1024, kb * 64, nb * 64, wOUT, 1024, nb * 64, 1.0f); continue; }
        t -= t_out;
        if (t < t_rt) { cvt_tile(F, inp(F, 22) + (size_t)l * 1024 * 64, 64, t * 64, 0, wRT, 1024, 0, 1.0f); continue; }
        t -= t_rt;
        if (t < t_gu) { const int e = t / 128, r = t % 128, which = r >> 6, q = r & 63, nb = q >> 4, kb = q & 15;
            const float* src = (e < 64) ? (which ? inp(F, 25) : inp(F, 24)) + ((size_t)l * 64 + e) * 1024 * 256 : (which ? inp(F, 28) : inp(F, 27)) + (size_t)l * 1024 * 256;
            const int n0 = nb * 64, drow0 = (n0 >> 7) * 256 + which * 128 + (n0 & 127);
            cvt_tile(F, src, 256, kb * 64, n0, wGU + (size_t)e * 512 * 1024, 1024, drow0, 1.0f); continue; }
        t -= t_gu;
        if (t < t_dn) { const int e = t >> 6, q = t & 63, nb = q >> 2, kb = q & 3;
            const float* src = (e < 64) ? inp(F, 26) + ((size_t)l * 64 + e) * 256 * 1024 : inp(F, 29) + (size_t)l * 256 * 1024;
            cvt_tile(F, src, 1024, kb * 64, nb * 64, wDN + (size_t)e * 1024 * 256, 256, nb * 64, 1.0f); continue; }
        t -= t_dn;
        { const int d = t >> 5, gt = (t >> 4) & 1, kb = t & 15;
          const float* src = (gt ? inp(F, 18) : inp(F, 16)) + (((size_t)j * 2 + d) * 16 + kb) * 4096;
          cvt_tile(F, src, 64, 0, 0, wLRU + (((size_t)d * 2 + gt) * 16 + kb) * 4096, 64, 0, 1.0f); }
    }
}

__device__ __forceinline__ void ph_attn(const Frame& F, int j) {
    const bf16_t* P = (const bf16_t*)(F.R1 + R1_P);
    LAS bf16_t* Ks0 = (LAS bf16_t*)F.lds;
    LAS float* rp_l = (LAS float*)(F.lds + 36864);
    const float* rpb = inp(F, 10) + (size_t)j * 8 * 465;
    const int g = F.lane >> 4, l15 = F.lane & 15;
    const int NLAT = NBAT * 8 * 64, NTASK = NLAT + NBAT * 8 * 2;
    const int wgs = ((F.G & 7) == 0) ? (F.wg & 7) * (F.G >> 3) + (F.wg >> 3) : F.wg;
    int cidx[4][4];
    { const int wq_ = (F.wave & 3) * 16 + l15, c0_ = min(max(wq_ - 8, 0), 48);
#pragma unroll
      for (int kb = 0; kb < 4; ++kb)
#pragma unroll
          for (int i = 0; i < 4; ++i) { const int kc = kb * 16 + 4 * g + i; cidx[kb][i] = (kc >= c0_ && kc < c0_ + 16) ? (kc - wq_ + 15) : 31; } }
    for (int task = wgs; task < NTASK; task += F.G) {
        const bool lat = task < NLAT;
        int b, h, rp = 0, half = 0;
        if (lat) { b = task >> 9; h = (task >> 6) & 7; rp = task & 63; } else { const int t2 = task - NLAT; b = t2 >> 4; h = (t2 >> 1) & 7; half = t2 & 1; }
        const int myr = 2 * rp + (F.wave >> 2), w0 = (F.wave & 3) * 16;
        const int r0 = min(max(myr - 4, 0), 120);
        const int rlo = min(max(2 * rp - 4, 0), 120), rhi = min(max(2 * rp + 1 - 4, 0), 120) + 7;
        const int nloc = lat ? (rhi - rlo + 1) : 0;
        const int qrow = lat ? (TC + b * SEQ + myr * 64 + w0 + l15) : (b * CTXL + half * 128 + F.wave * 16 + l15);
        bf16x8 qf[2];
        qf[0] = *(const bf16x8*)(P + (size_t)qrow * 4096 + h * 64 + g * 8);
        qf[1] = *(const bf16x8*)(P + (size_t)qrow * 4096 + h * 64 + 32 + g * 8);
        if (lat) for (int i = F.tid; i < 480; i += 512) { const int rr = i >> 5, cc = i & 31; rp_l[i] = (cc < 31) ? rpb[h * 465 + rr * 31 + cc] * 1.4426950408889634f : -1e30f; }
        f32x4 oacc[4];
#pragma unroll
        for (int dt = 0; dt < 4; ++dt) oacc[dt] = (f32x4){0.f, 0.f, 0.f, 0.f};
        float mrun = -1e30f, lrun = 0.f;
        const int wq = w0 + l15, c0 = min(max(wq - 8, 0), 48);
        u32x4 kv, vv;
        { const int key = F.tid >> 3, ds = (F.tid & 7) * 8; const bool loc0 = 0 < nloc;
          const int krow = loc0 ? (TC + b * SEQ + rlo * 64 + key) : (b * CTXL + key);
          kv = *(const u32x4*)(P + (size_t)krow * 4096 + 512 + h * 64 + ds); vv = *(const u32x4*)(P + (size_t)krow * 4096 + 1024 + h * 64 + ds); }
#define ATT_STAGE(buf_, c_) do { const int key = F.tid >> 3, ds = (F.tid & 7) * 8; LAS bf16_t* Kd = Ks0 + (buf_) * 9216; LAS bf16_t* Vd = Kd + 4608; \
            *(LAS u32x4*)(Kd + key * 72 + ds) = kv; *(LAS u32x4*)(Vd + key * 72 + ds) = vv;     \
            if ((c_) + 1 < nloc + 4) { const bool locn = ((c_) + 1) < nloc; \
                const int krow = locn ? (TC + b * SEQ + (rlo + (c_) + 1) * 64 + key) : (b * CTXL + ((c_) + 1 - nloc) * 64 + key); \
                kv = *(const u32x4*)(P + (size_t)krow * 4096 + 512 + h * 64 + ds); vv = *(const u32x4*)(P + (size_t)krow * 4096 + 1024 + h * 64 + ds); } } while (0)
        __syncthreads();
        ATT_STAGE(0, 0);
        __syncthreads();
        for (int ch = 0; ch < nloc + 4; ++ch) {
            const bool loc = ch < nloc; const int kr = rlo + ch;
            if (ch + 1 < nloc + 4) ATT_STAGE((ch + 1) & 1, ch + 1);
            const LAS bf16_t* Ks = Ks0 + (ch & 1) * 9216; const LAS bf16_t* Vt = Ks + 4608;
            const bool mine = loc ? (kr >= r0 && kr < r0 + 8) : true;
            if (mine) {
                f32x4 s[4];
                const LAS float* rrow = rp_l + (loc ? (kr - myr + 7) * 32 : 0);
#pragma unroll
                for (int kb = 0; kb < 4; ++kb) {
                    if (loc) {
#pragma unroll
                        for (int i = 0; i < 4; ++i) s[kb][i] = rrow[cidx[kb][i]];
                    } else s[kb] = (f32x4){0.f, 0.f, 0.f, 0.f};
#pragma unroll
                    for (int ks = 0; ks < 2; ++ks) { const bf16x8 a = *(const LAS bf16x8*)(Ks + (kb * 16 + l15) * 72 + ks * 32 + g * 8);
                        s[kb] = __builtin_amdgcn_mfma_f32_16x16x32_bf16(a, qf[ks], s[kb], 0, 0, 0); } }
                float cm = -1e30f;
#pragma unroll
                for (int kb = 0; kb < 4; ++kb)
#pragma unroll
                    for (int i = 0; i < 4; ++i) cm = fmaxf(cm, s[kb][i]);
                cm = fmaxf(cm, __shfl_xor(cm, 16)); cm = fmaxf(cm, __shfl_xor(cm, 32));
                const float mn = fmaxf(mrun, cm), sc = __builtin_amdgcn_exp2f(mrun - mn);
                mrun = mn; lrun *= sc;
#pragma unroll
                for (int dt = 0; dt < 4; ++dt) oacc[dt] *= sc;
                float p[4][4];
#pragma unroll
                for (int kb = 0; kb < 4; ++kb)
#pragma unroll
                    for (int i = 0; i < 4; ++i) { p[kb][i] = __builtin_amdgcn_exp2f(s[kb][i] - mn); lrun += p[kb][i]; }
#pragma unroll
                for (int kp = 0; kp < 2; ++kp) {
                    u32x4 pw; pw.x = cvt_pk_bf16(p[2 * kp][0], p[2 * kp][1]); pw.y = cvt_pk_bf16(p[2 * kp][2], p[2 * kp][3]);
                    pw.z = cvt_pk_bf16(p[2 * kp + 1][0], p[2 * kp + 1][1]); pw.w = cvt_pk_bf16(p[2 * kp + 1][2], p[2 * kp + 1][3]);
                    bf16x8 pf; __builtin_memcpy(&pf, &pw, 16);
                    const unsigned va = (unsigned)(size_t)Vt + (unsigned)((32 * kp + 4 * g + (l15 >> 2)) * 144 + (l15 & 3) * 8);
                    u32x2 t0[4], t1[4];
                    asm volatile("ds_read_b64_tr_b16 %0, %8\n\tds_read_b64_tr_b16 %1, %8 offset:32\n\tds_read_b64_tr_b16 %2, %8 offset:64\n\tds_read_b64_tr_b16 %3, %8 offset:96\n\t"
                                 "ds_read_b64_tr_b16 %4, %8 offset:2304\n\tds_read_b64_tr_b16 %5, %8 offset:2336\n\tds_read_b64_tr_b16 %6, %8 offset:2368\n\tds_read_b64_tr_b16 %7, %8 offset:2400\n\ts_waitcnt lgkmcnt(0)"
                                 : "=&v"(t0[0]), "=&v"(t0[1]), "=&v"(t0[2]), "=&v"(t0[3]), "=&v"(t1[0]), "=&v"(t1[1]), "=&v"(t1[2]), "=&v"(t1[3]) : "v"(va) : "memory");
#pragma unroll
                    for (int dt = 0; dt < 4; ++dt) {
                        u32x4 vw; vw.x = t0[dt].x; vw.y = t0[dt].y; vw.z = t1[dt].x; vw.w = t1[dt].y; bf16x8 vf; __builtin_memcpy(&vf, &vw, 16);
                        oacc[dt] = __builtin_amdgcn_mfma_f32_16x16x32_bf16(vf, pf, oacc[dt], 0, 0, 0);
                    }
                }
            }
            __syncthreads();
        }
#undef ATT_STAGE
        float lt = lrun; lt += __shfl_xor(lt, 16); lt += __shfl_xor(lt, 32);
        const float inv = 1.0f / lt;
#pragma unroll
        for (int dt = 0; dt < 4; ++dt) { const f32x4 o = oacc[dt] * inv; u32x2 w; w.x = cvt_pk_bf16(o[0], o[1]); w.y = cvt_pk_bf16(o[2], o[3]);
            *(u32x2*)(F.MIX + (size_t)qrow * DM + h * 64 + dt * 16 + 4 * g) = w; }
        __syncthreads();
    }
}

__device__ __forceinline__ int hg_unit(int nb, int dir) { return dir == 0 ? nb : (nb < 2 ? 1 - nb : 2 + (HG_NU - 3 - (nb - 2))); }
__device__ __forceinline__ int hg_row(int b, int nb, int t) { return nb < 2 ? b * CTXL + nb * HG_U + t : TC + b * SEQ + (nb - 2) * HG_U + t; }
template <int CTRL> __device__ __forceinline__ float dpp_add0(float x) { return x + dppf<CTRL>(0.0f, x); }
#define ROW_ALLREDUCE4(v0, v1, v2, v3) asm volatile("s_nop 1\n\t" \
    "v_add_f32_dpp %0, %0, %0 quad_perm:[1,0,3,2] row_mask:0xf bank_mask:0xf\n\tv_add_f32_dpp %1, %1, %1 quad_perm:[1,0,3,2] row_mask:0xf bank_mask:0xf\n\t" \
    "v_add_f32_dpp %2, %2, %2 quad_perm:[1,0,3,2] row_mask:0xf bank_mask:0xf\n\tv_add_f32_dpp %3, %3, %3 quad_perm:[1,0,3,2] row_mask:0xf bank_mask:0xf\n\t" \
    "v_add_f32_dpp %0, %0, %0 quad_perm:[2,3,0,1] row_mask:0xf bank_mask:0xf\n\tv_add_f32_dpp %1, %1, %1 quad_perm:[2,3,0,1] row_mask:0xf bank_mask:0xf\n\t" \
    "v_add_f32_dpp %2, %2, %2 quad_perm:[2,3,0,1] row_mask:0xf bank_mask:0xf\n\tv_add_f32_dpp %3, %3, %3 quad_perm:[2,3,0,1] row_mask:0xf bank_mask:0xf\n\t" \
    "v_add_f32_dpp %0, %0, %0 row_half_mirror row_mask:0xf bank_mask:0xf\n\tv_add_f32_dpp %1, %1, %1 row_half_mirror row_mask:0xf bank_mask:0xf\n\t" \
    "v_add_f32_dpp %2, %2, %2 row_half_mirror row_mask:0xf bank_mask:0xf\n\tv_add_f32_dpp %3, %3, %3 row_half_mirror row_mask:0xf bank_mask:0xf\n\t" \
    "v_add_f32_dpp %0, %0, %0 row_mirror row_mask:0xf bank_mask:0xf\n\tv_add_f32_dpp %1, %1, %1 row_mirror row_mask:0xf bank_mask:0xf\n\t" \
    "v_add_f32_dpp %2, %2, %2 row_mirror row_mask:0xf bank_mask:0xf\n\tv_add_f32_dpp %3, %3, %3 row_mirror row_mask:0xf bank_mask:0xf" \
    : "+v"(v0), "+v"(v1), "+v"(v2), "+v"(v3))
template <bool WITHO>
__device__ __forceinline__ void hg_pass(const Frame& F, const bf16_t* P, const float* lbh, int b, int h, int nb, int dir, f32x4 (&S)[4][4], float (&Gsum)[16],
                                        LAS bf16_t* Vl, LAS bf16_t* Kl, float* OF, const float* ngp) {
    const int tau = F.lane & 15, g = F.lane >> 4;
    const unsigned vaddr = (unsigned)(size_t)Vl + (unsigned)((4 * g + (tau >> 2)) * 128 + (tau & 3) * 8);
    const unsigned kaddr = (unsigned)(size_t)Kl + (unsigned)((4 * g + (tau >> 2)) * 128 + (tau & 3) * 8);
    u32x2 zr[4], vr[4], qr[4];
    { const int t = dir ? (HG_U - 1 - tau) : tau; const bf16_t* pr = P + (size_t)hg_row(b, nb, t) * 4096 + h * 64 + 4 * g;
#pragma unroll
      for (int m = 0; m < 4; ++m) { zr[m] = *(const u32x2*)(pr + (dir ? 2560 : 2048) + 16 * m); vr[m] = *(const u32x2*)(pr + 3072 + 16 * m); } }
    for (int ci = 0; ci < HG_U / 16; ++ci) {
        float kk[16], c[16];
        if (WITHO) { const int pos = ci * 16 + tau, t = dir ? (HG_U - 1 - pos) : pos; const bf16_t* pr = P + (size_t)hg_row(b, nb, t) * 4096 + h * 64 + 4 * g;
#pragma unroll
            for (int m = 0; m < 4; ++m) qr[m] = *(const u32x2*)(pr + 1536 + 16 * m); }
#pragma unroll
        for (int m = 0; m < 4; ++m) { const float z0 = __uint_as_float(zr[m].x << 16), z1 = __uint_as_float(zr[m].x & 0xffff0000u), z2 = __uint_as_float(zr[m].y << 16), z3 = __uint_as_float(zr[m].y & 0xffff0000u);
            const float zz[4] = {z0, z1, z2, z3};
            const f32x4 lb4 = *(const f32x4*)(lbh + 16 * m + 4 * g);
#pragma unroll
            for (int i = 0; i < 4; ++i) { const float lb = lb4[i]; const float f = fmaxf(lb + (1.0f - lb) * sigmoidf_(zz[i]), 1e-30f); kk[m * 4 + i] = 1.0f - f; c[m * 4 + i] = __logf(f); }
            *(LAS u32x2*)(Vl + tau * 64 + 16 * m + 4 * g) = vr[m];
 }
        if (ci + 1 < HG_U / 16) { const int pos = (ci + 1) * 16 + tau, t = dir ? (HG_U - 1 - pos) : pos; const bf16_t* pr = P + (size_t)hg_row(b, nb, t) * 4096 + h * 64 + 4 * g;
#pragma unroll
            for (int m = 0; m < 4; ++m) { zr[m] = *(const u32x2*)(pr + (dir ? 2560 : 2048) + 16 * m); vr[m] = *(const u32x2*)(pr + 3072 + 16 * m); } }
        float G[16];
#pragma unroll
        for (int q = 0; q < 16; ++q) G[q] = c[q];
#pragma unroll
        for (int q = 0; q < 16; q += 4) ROW_ALLREDUCE4(G[q], G[q + 1], G[q + 2], G[q + 3]);
#pragma unroll
        for (int q = 0; q < 16; ++q) { c[q] = dpp_add0<0x111>(c[q]); c[q] = dpp_add0<0x112>(c[q]); c[q] = dpp_add0<0x114>(c[q]); c[q] = dpp_add0<0x118>(c[q]); }
#pragma unroll
        for (int q = 0; q < 16; ++q) Gsum[q] += G[q];
#pragma unroll
        for (int m = 0; m < 4; ++m) { float kh[4];
#pragma unroll
            for (int i = 0; i < 4; ++i) kh[i] = kk[m * 4 + i] * __expf(G[m * 4 + i] - c[m * 4 + i]);
            u32x2 w; w.x = cvt_pk_bf16(kh[0], kh[1]); w.y = cvt_pk_bf16(kh[2], kh[3]);
            *(LAS u32x2*)(Kl + tau * 64 + 16 * m + 4 * g) = w; }
        float ofv[4][4], gtv[4][4]; int orow[4];
        if (WITHO) {
#pragma unroll
            for (int i = 0; i < 4; ++i) { const int p2 = ci * 16 + 4 * g + i, t2 = dir ? (HG_U - 1 - p2) : p2; orow[i] = hg_row(b, nb, t2); }
            if (dir) {
#pragma unroll
                for (int i = 0; i < 4; ++i)
#pragma unroll
                    for (int vt = 0; vt < 4; ++vt) { ofv[i][vt] = OF[(size_t)orow[i] * 512 + h * 64 + 16 * vt + tau]; gtv[i][vt] = bf2f(P[(size_t)orow[i] * 4096 + 3584 + h * 64 + 16 * vt + tau]); }
            }
        }
        asm volatile("s_waitcnt lgkmcnt(0)" ::: "memory");
        u32x2 vtr[4], ktr[4];
        asm volatile("ds_read_b64_tr_b16 %0, %8\n\tds_read_b64_tr_b16 %1, %8 offset:32\n\tds_read_b64_tr_b16 %2, %8 offset:64\n\tds_read_b64_tr_b16 %3, %8 offset:96\n\t"
                     "ds_read_b64_tr_b16 %4, %9\n\tds_read_b64_tr_b16 %5, %9 offset:32\n\tds_read_b64_tr_b16 %6, %9 offset:64\n\tds_read_b64_tr_b16 %7, %9 offset:96\n\ts_waitcnt lgkmcnt(0)"
                     : "=&v"(vtr[0]), "=&v"(vtr[1]), "=&v"(vtr[2]), "=&v"(vtr[3]), "=&v"(ktr[0]), "=&v"(ktr[1]), "=&v"(ktr[2]), "=&v"(ktr[3]) : "v"(vaddr), "v"(kaddr) : "memory");
        bf16x8 Vf[4], Kf[4];
#pragma unroll
        for (int q = 0; q < 4; ++q) { u32x4 w; w.x = vtr[q].x; w.y = vtr[q].y; w.z = 0u; w.w = 0u; __builtin_memcpy(&Vf[q], &w, 16); u32x4 w2; w2.x = ktr[q].x; w2.y = ktr[q].y; w2.z = 0u; w2.w = 0u; __builtin_memcpy(&Kf[q], &w2, 16); }
        if (WITHO) {
            bf16x8 Ktf[2], Qtf[2], Qhf[2];
#pragma unroll
            for (int ks = 0; ks < 2; ++ks) { float kt_[8], qt_[8], qh_[8];
#pragma unroll
                for (int mm = 0; mm < 2; ++mm) { const int m = 2 * ks + mm;
                    const float qq[4] = {__uint_as_float(qr[m].x << 16), __uint_as_float(qr[m].x & 0xffff0000u), __uint_as_float(qr[m].y << 16), __uint_as_float(qr[m].y & 0xffff0000u)};
#pragma unroll
                    for (int i = 0; i < 4; ++i) { const int q = m * 4 + i; const float qv = siluf_(qq[i]) * 0.125f; const float d = fminf(fmaxf(c[q] - 0.5f * G[q], -80.0f), 80.0f);
                        qt_[mm * 4 + i] = qv * __expf(d); kt_[mm * 4 + i] = kk[q] * __expf(-d); qh_[mm * 4 + i] = qv * __expf(c[q]); } }
                u32x4 w; w.x = cvt_pk_bf16(kt_[0], kt_[1]); w.y = cvt_pk_bf16(kt_[2], kt_[3]); w.z = cvt_pk_bf16(kt_[4], kt_[5]); w.w = cvt_pk_bf16(kt_[6], kt_[7]); __builtin_memcpy(&Ktf[ks], &w, 16);
                w.x = cvt_pk_bf16(qt_[0], qt_[1]); w.y = cvt_pk_bf16(qt_[2], qt_[3]); w.z = cvt_pk_bf16(qt_[4], qt_[5]); w.w = cvt_pk_bf16(qt_[6], qt_[7]); __builtin_memcpy(&Qtf[ks], &w, 16);
                w.x = cvt_pk_bf16(qh_[0], qh_[1]); w.y = cvt_pk_bf16(qh_[2], qh_[3]); w.z = cvt_pk_bf16(qh_[4], qh_[5]); w.w = cvt_pk_bf16(qh_[6], qh_[7]); __builtin_memcpy(&Qhf[ks], &w, 16); }
            f32x4 AT = (f32x4){0.f, 0.f, 0.f, 0.f};
            AT = __builtin_amdgcn_mfma_f32_16x16x32_bf16(Ktf[0], Qtf[0], AT, 0, 0, 0); AT = __builtin_amdgcn_mfma_f32_16x16x32_bf16(Ktf[1], Qtf[1], AT, 0, 0, 0);
#pragma unroll
            for (int i = 0; i < 4; ++i) AT[i] = (4 * g + i <= tau) ? AT[i] : 0.0f;
            bf16x8 Af; { u32x4 w; w.x = cvt_pk_bf16(AT[0], AT[1]); w.y = cvt_pk_bf16(AT[2], AT[3]); w.z = 0u; w.w = 0u; __builtin_memcpy(&Af, &w, 16); }
            f32x4 o[4];
#pragma unroll
            for (int vt = 0; vt < 4; ++vt) { o[vt] = __builtin_amdgcn_mfma_f32_16x16x32_bf16(Af, Vf[vt], (f32x4){0.f, 0.f, 0.f, 0.f}, 0, 0, 0);
#pragma unroll
                for (int ks = 0; ks < 2; ++ks) { u32x4 w; w.x = cvt_pk_bf16(S[2 * ks][vt][0], S[2 * ks][vt][1]); w.y = cvt_pk_bf16(S[2 * ks][vt][2], S[2 * ks][vt][3]);
                    w.z = cvt_pk_bf16(S[2 * ks + 1][vt][0], S[2 * ks + 1][vt][1]); w.w = cvt_pk_bf16(S[2 * ks + 1][vt][2], S[2 * ks + 1][vt][3]); bf16x8 Sf; __builtin_memcpy(&Sf, &w, 16);
                    o[vt] = __builtin_amdgcn_mfma_f32_16x16x32_bf16(Qhf[ks], Sf, o[vt], 0, 0, 0); } }
            if (dir == 0) {
#pragma unroll
                for (int i = 0; i < 4; ++i)
#pragma unroll
                    for (int vt = 0; vt < 4; ++vt) OF[(size_t)orow[i] * 512 + h * 64 + 16 * vt + tau] = o[vt][i];
            } else {
                { float tot[4][4], sq[4];
#pragma unroll
                for (int i = 0; i < 4; ++i) { sq[i] = 0.f;
#pragma unroll
                    for (int vt = 0; vt < 4; ++vt) { tot[i][vt] = o[vt][i] + ofv[i][vt]; sq[i] = fmaf(tot[i][vt], tot[i][vt], sq[i]); } }
                ROW_ALLREDUCE4(sq[0], sq[1], sq[2], sq[3]);
#pragma unroll
                for (int i = 0; i < 4; ++i) { const float rs = rsqrtf(sq[i] * (1.0f / 64.0f) + 1e-6f);
#pragma unroll
                    for (int vt = 0; vt < 4; ++vt) F.MIX[(size_t)orow[i] * DM + 512 + h * 64 + 16 * vt + tau] = f2bf(tot[i][vt] * rs * ngp[16 * vt + tau] * siluf_(gtv[i][vt])); } }
            }
        }
#pragma unroll
        for (int kt = 0; kt < 4; ++kt) { f32x4 eg;
#pragma unroll
            for (int i = 0; i < 4; ++i) eg[i] = __expf(G[kt * 4 + i]);
#pragma unroll
            for (int vt = 0; vt < 4; ++vt) S[kt][vt] = __builtin_amdgcn_mfma_f32_16x16x32_bf16(Kf[kt], Vf[vt], S[kt][vt] * eg, 0, 0, 0); }
    }
}
__device__ __forceinline__ void ph_hg_a(const Frame& F, int j) {
    const bf16_t* P = (const bf16_t*)(F.R1 + R1_P);
    float* SLOC = (float*)(F.R1 + R1_SLOC); float* DL = (float*)(F.R1 + R1_DL);
    LAS bf16_t* Vl = (LAS bf16_t*)(F.lds + 32768 + F.wave * 4096); LAS bf16_t* Kl = Vl + 1024;
    const int gw = F.wg * 8 + F.wave, nw = F.G * 8;
    const int NT = NBAT * 8 * (HG_NU - 2) * 2;
    for (int task = gw; task < NT; task += nw) {
        const int dir = task & 1, nb = 2 + (task >> 1) % (HG_NU - 2), bh = (task >> 1) / (HG_NU - 2), b = bh >> 3, h = bh & 7;
        const float* lbh = (const float*)(F.ws + OFF_LBT) + (j * 2 + dir) * 512 + h * 64;
        f32x4 S[4][4];
#pragma unroll
        for (int kt = 0; kt < 4; ++kt)
#pragma unroll
            for (int vt = 0; vt < 4; ++vt) S[kt][vt] = (f32x4){0.f, 0.f, 0.f, 0.f};
        float Gsum[16];
#pragma unroll
        for (int q = 0; q < 16; ++q) Gsum[q] = 0.f;
        hg_pass<false>(F, P, lbh, b, h, nb, dir, S, Gsum, Vl, Kl, nullptr, nullptr);
        const int seq = bh * 2 + dir, u = hg_unit(nb, dir);
        float* so = SLOC + ((size_t)seq * HG_NU + u) * 4096;
#pragma unroll
        for (int kt = 0; kt < 4; ++kt)
#pragma unroll
            for (int vt = 0; vt < 4; ++vt)
#pragma unroll
                for (int i = 0; i < 4; ++i) so[((kt * 4 + vt) * 4 + i) * 64 + F.lane] = S[kt][vt][i];
        if ((F.lane & 15) == 0) { float* dd = DL + ((size_t)seq * HG_NU + u) * 64;
#pragma unroll
            for (int m = 0; m < 4; ++m)
#pragma unroll
                for (int i = 0; i < 4; ++i) dd[16 * m + 4 * (F.lane >> 4) + i] = __expf(Gsum[m * 4 + i]); }
    }
}
__device__ __forceinline__ void ph_hg_b(const Frame& F) {
    const float* SLOC = (const float*)(F.R1 + R1_SLOC); const float* DL = (const float*)(F.R1 + R1_DL); float* SST = (float*)(F.R1 + R1_SST);
    for (int idx = F.wg * 512 + F.tid; idx < 64 * 4096; idx += F.G * 512) {
        const int seq = idx >> 12, e = idx & 4095, ln = e & 63, reg = e >> 6, i = reg & 3, kt = reg >> 4, k = 16 * kt + 4 * (ln >> 4) + i;
        float s = 0.f;
#pragma unroll 6
        for (int u = 0; u < HG_NU; ++u) { const size_t o = ((size_t)seq * HG_NU + u) * 4096 + e; SST[o] = s; s = DL[((size_t)seq * HG_NU + u) * 64 + k] * s + SLOC[o]; }
    }
}
__device__ __forceinline__ void ph_hg_c(const Frame& F, int j) {
    const bf16_t* P = (const bf16_t*)(F.R1 + R1_P);
    const float* SST = (const float*)(F.R1 + R1_SST); float* OF = (float*)(F.R1 + R1_OF);
    const float* ng = inp(F, 12) + j * 64;
    LAS bf16_t* Vl = (LAS bf16_t*)(F.lds + 32768 + F.wave * 4096); LAS bf16_t* Kl = Vl + 1024;
    const int gw = F.wg * 8 + F.wave, nw = F.G * 8;
    const int NT = NBAT * 8 * (HG_NU - 2);
    for (int task = gw; task < NT; task += nw) {
        const int nb = 2 + task % (HG_NU - 2), bh = task / (HG_NU - 2), b = bh >> 3, h = bh & 7;
        for (int dir = 0; dir < 2; ++dir) {
            const float* lbh = (const float*)(F.ws + OFF_LBT) + (j * 2 + dir) * 512 + h * 64;
            const int seq = bh * 2 + dir, u = hg_unit(nb, dir);
            const float* ss = SST + ((size_t)seq * HG_NU + u) * 4096;
            f32x4 S[4][4];
#pragma unroll
            for (int kt = 0; kt < 4; ++kt)
#pragma unroll
                for (int vt = 0; vt < 4; ++vt)
#pragma unroll
                    for (int i = 0; i < 4; ++i) S[kt][vt][i] = ss[((kt * 4 + vt) * 4 + i) * 64 + F.lane];
            float Gsum[16];
#pragma unroll
            for (int q = 0; q < 16; ++q) Gsum[q] = 0.f;
            hg_pass<true>(F, P, lbh, b, h, nb, dir, S, Gsum, Vl, Kl, OF, ng);
            asm volatile("s_waitcnt vmcnt(0)" ::: "memory");
        }
    }
}

__device__ __forceinline__ void ph_hg_ctx(const Frame& F, int j) {
    if (F.wave >= 4) return;
    const bf16_t* P = (const bf16_t*)(F.R1 + R1_P);
    float* SLOC = (float*)(F.R1 + R1_SLOC); float* DL = (float*)(F.R1 + R1_DL); float* OF = (float*)(F.R1 + R1_OF);
    const float* ng = inp(F, 12) + j * 64;
    LAS bf16_t* Vl = (LAS bf16_t*)(F.lds + 32768 + F.wave * 4096); LAS bf16_t* Kl = Vl + 1024;
    const int bh = F.wg * 4 + F.wave, b = bh >> 3, h = bh & 7;
    for (int dir = 0; dir < 2; ++dir) {
        const float* lbh = (const float*)(F.ws + OFF_LBT) + (j * 2 + dir) * 512 + h * 64;
        const int seq = bh * 2 + dir;
        f32x4 S[4][4];
#pragma unroll
        for (int kt = 0; kt < 4; ++kt)
#pragma unroll
            for (int vt = 0; vt < 4; ++vt) S[kt][vt] = (f32x4){0.f, 0.f, 0.f, 0.f};
        for (int u = 0; u < 2; ++u) {
            const int nb = dir ? 1 - u : u;
            float Gsum[16];
#pragma unroll
            for (int q = 0; q < 16; ++q) Gsum[q] = 0.f;
            hg_pass<true>(F, P, lbh, b, h, nb, dir, S, Gsum, Vl, Kl, OF, ng);
            float* so = SLOC + ((size_t)seq * HG_NU + u) * 4096;
#pragma unroll
            for (int kt = 0; kt < 4; ++kt)
#pragma unroll
                for (int vt = 0; vt < 4; ++vt)
#pragma unroll
                    for (int i = 0; i < 4; ++i) so[((kt * 4 + vt) * 4 + i) * 64 + F.lane] = S[kt][vt][i];
            if ((F.lane & 15) == 0) { float* dd = DL + ((size_t)seq * HG_NU + u) * 64;
#pragma unroll
                for (int q = 0; q < 16; ++q) dd[16 * (q >> 2) + 4 * (F.lane >> 4) + (q & 3)] = 0.0f; }
        }
        asm volatile("s_waitcnt vmcnt(0)" ::: "memory");
    }
}

__device__ __forceinline__ int lru_nat(int so, int dir) { return dir == 0 ? so : (so < 16 ? 15 - so : 16 + (LRU_NT - 1 - so)); }
__device__ __forceinline__ int lru_row(int b, int nt, int t) { return nt < 16 ? b * CTXL + nt * 16 + t : TC + b * SEQ + (nt - 16) * 16 + t; }
struct LruRaw { u32x4 a[4], b[4]; };
__device__ __forceinline__ void lru_load(const Frame& F, int b, int kb, int nt, LruRaw& R) {
    const bf16_t* P = (const bf16_t*)(F.R1 + R1_P);
    const int tk = F.lane & 15, g = F.lane >> 4;
    const int len = nt < 16 ? CTXL : SEQ, tpos = (nt < 16 ? nt * 16 : (nt - 16) * 16) + tk;
    const bf16_t* pbase = P + (size_t)((nt < 16 ? b * CTXL : TC + b * SEQ)) * 2048 + 1024 + kb * 64 + g * 16;
#pragma unroll
    for (int tap = 0; tap < 4; ++tap) { const int tp = tpos + tap - 2; const bool ok = (tp >= 0 && tp < len); const bf16_t* pr = pbase + (size_t)(ok ? tp : tpos) * 2048;
        R.a[tap] = *(const u32x4*)pr; R.b[tap] = *(const u32x4*)(pr + 8); if (!ok) { R.a[tap] = (u32x4){0u, 0u, 0u, 0u}; R.b[tap] = (u32x4){0u, 0u, 0u, 0u}; } }
}
__device__ __forceinline__ void lru_conv(const Frame& F, const LruRaw& R, const LAS float* CT, LAS float* ucb) {
    const int tk = F.lane & 15, g = F.lane >> 4;
    float acc[16];
#pragma unroll
    for (int q = 0; q < 4; ++q) { const f32x4 c4 = *(const LAS f32x4*)(CT + 4 * 64 + g * 16 + q * 4); acc[q * 4] = c4[0]; acc[q * 4 + 1] = c4[1]; acc[q * 4 + 2] = c4[2]; acc[q * 4 + 3] = c4[3]; }
#pragma unroll
    for (int tap = 0; tap < 4; ++tap) { float t0[8], t1[8]; unpack8(R.a[tap], t0); unpack8(R.b[tap], t1);
#pragma unroll
        for (int q = 0; q < 2; ++q) { const f32x4 w0 = *(const LAS f32x4*)(CT + tap * 64 + g * 16 + q * 4), w1 = *(const LAS f32x4*)(CT + tap * 64 + g * 16 + 8 + q * 4);
#pragma unroll
            for (int i = 0; i < 4; ++i) { acc[q * 4 + i] = fmaf(w0[i], t0[q * 4 + i], acc[q * 4 + i]); acc[8 + q * 4 + i] = fmaf(w1[i], t1[q * 4 + i], acc[8 + q * 4 + i]); } } }
#pragma unroll
    for (int q = 0; q < 4; ++q) *(LAS f32x4*)(ucb + tk * 68 + g * 16 + q * 4) = (f32x4){acc[q * 4], acc[q * 4 + 1], acc[q * 4 + 2], acc[q * 4 + 3]};
}
__device__ __forceinline__ void lru_gates(const Frame& F, LAS bf16_t* Wl, const LAS float* CT, LAS float* ucb, float (&av)[2][4][4], float (&xv)[2][4][4]) {
    const int tk = F.lane & 15, g = F.lane >> 4;
    bf16x8 bfr[2];
#pragma unroll
    for (int ks = 0; ks < 2; ++ks) { const f32x4 u0 = *(const LAS f32x4*)(ucb + tk * 68 + ks * 32 + g * 8), u1 = *(const LAS f32x4*)(ucb + tk * 68 + ks * 32 + g * 8 + 4);
        u32x4 w; w.x = cvt_pk_bf16(u0[0], u0[1]); w.y = cvt_pk_bf16(u0[2], u0[3]); w.z = cvt_pk_bf16(u1[0], u1[1]); w.w = cvt_pk_bf16(u1[2], u1[3]); __builtin_memcpy(&bfr[ks], &w, 16); }
#pragma unroll
    for (int d = 0; d < 2; ++d)
#pragma unroll
        for (int et = 0; et < 4; ++et) {
            f32x4 ra = (f32x4){0.f, 0.f, 0.f, 0.f}, ri = (f32x4){0.f, 0.f, 0.f, 0.f};
#pragma unroll
            for (int ks = 0; ks < 2; ++ks) {
                const bf16x8 wa = *(const LAS bf16x8*)(Wl + ((d * 2 + 0) * 64 + et * 16 + tk) * 72 + ks * 32 + g * 8);
                const bf16x8 wx = *(const LAS bf16x8*)(Wl + ((d * 2 + 1) * 64 + et * 16 + tk) * 72 + ks * 32 + g * 8);
                ra = __builtin_amdgcn_mfma_f32_16x16x32_bf16(wa, bfr[ks], ra, 0, 0, 0);
                ri = __builtin_amdgcn_mfma_f32_16x16x32_bf16(wx, bfr[ks], ri, 0, 0, 0);
            }
            const f32x4 ba4 = *(const LAS f32x4*)(CT + (5 + 3 * d) * 64 + et * 16 + 4 * g), bx4 = *(const LAS f32x4*)(CT + (6 + 3 * d) * 64 + et * 16 + 4 * g), cs4 = *(const LAS f32x4*)(CT + (7 + 3 * d) * 64 + et * 16 + 4 * g);
            const f32x4 u4 = *(const LAS f32x4*)(ucb + tk * 68 + et * 16 + 4 * g);
#pragma unroll
            for (int i = 0; i < 4; ++i) {
                const float r = sigmoidf_(ra[i] + ba4[i]), ig = sigmoidf_(ri[i] + bx4[i]);
                const float la = cs4[i] * r, a = __expf(la);
                av[d][et][i] = la; xv[d][et][i] = __builtin_amdgcn_sqrtf(fmaxf(1.0f - a * a, 0.f)) * ig * u4[i]; }
        }
}
template <int S> __device__ __forceinline__ void lru_step_f(float& a, float& x) { const float ap = dppf<0x110 + S>(1.0f, a), xp = dppf<0x110 + S>(0.0f, x); x = fmaf(a, xp, x); a = a * ap; }
template <int S> __device__ __forceinline__ void lru_step_b(float& a, float& x) { const float ap = dppf<0x100 + S>(1.0f, a), xp = dppf<0x100 + S>(0.0f, x); x = fmaf(a, xp, x); a = a * ap; }
#define LRU_DPP_STEP(SH, x_, a_) asm volatile("s_nop 1\n\t" \
    "v_fmac_f32_dpp %0, %0, %4 " SH " row_mask:0xf bank_mask:0xf\n\tv_fmac_f32_dpp %1, %1, %5 " SH " row_mask:0xf bank_mask:0xf\n\t" \
    "v_fmac_f32_dpp %2, %2, %6 " SH " row_mask:0xf bank_mask:0xf\n\tv_fmac_f32_dpp %3, %3, %7 " SH " row_mask:0xf bank_mask:0xf\n\t" \
    "v_mul_f32_dpp %4, %4, %4 " SH " row_mask:0xf bank_mask:0xf\n\tv_mul_f32_dpp %5, %5, %5 " SH " row_mask:0xf bank_mask:0xf\n\t" \
    "v_mul_f32_dpp %6, %6, %6 " SH " row_mask:0xf bank_mask:0xf\n\tv_mul_f32_dpp %7, %7, %7 " SH " row_mask:0xf bank_mask:0xf" \
    : "+v"(x_[0]), "+v"(x_[1]), "+v"(x_[2]), "+v"(x_[3]), "+v"(a_[0]), "+v"(a_[1]), "+v"(a_[2]), "+v"(a_[3]))
#define LRU_SCANS(av, xv) do { _Pragma("unroll") for (int et = 0; et < 4; ++et) { \
        LRU_DPP_STEP("row_shr:1", xv[0][et], av[0][et]); LRU_DPP_STEP("row_shl:1", xv[1][et], av[1][et]); } \
    _Pragma("unroll") for (int et = 0; et < 4; ++et) { LRU_DPP_STEP("row_shr:2", xv[0][et], av[0][et]); LRU_DPP_STEP("row_shl:2", xv[1][et], av[1][et]); } \
    _Pragma("unroll") for (int et = 0; et < 4; ++et) { LRU_DPP_STEP("row_shr:4", xv[0][et], av[0][et]); LRU_DPP_STEP("row_shl:4", xv[1][et], av[1][et]); } \
    _Pragma("unroll") for (int et = 0; et < 4; ++et) { LRU_DPP_STEP("row_shr:8", xv[0][et], av[0][et]); LRU_DPP_STEP("row_shl:8", xv[1][et], av[1][et]); } } while (0)
__device__ __forceinline__ void ph_lru_a(const Frame& F, int jj) {
    LAS bf16_t* Wl = (LAS bf16_t*)F.lds;
    LAS float* ucb = (LAS float*)(F.lds + 36864 + F.wave * 4352);
    LAS float* CT = (LAS float*)(F.lds + 36864 + 8 * 4352);
    const bf16_t* wsrc = (const bf16_t*)(F.WB + WB_LRU);
    float* AG = (float*)(F.R1 + R1_AG); bf16_t* GX = (bf16_t*)(F.R1 + R1_GX);
    const float* cw = inp(F, 14) + (size_t)jj * 4 * 1024; const float* cb = inp(F, 15) + (size_t)jj * 1024;
    const float* b_a = inp(F, 17) + (size_t)jj * 2 * 1024; const float* b_x = inp(F, 19) + (size_t)jj * 2 * 1024; const float* lam = inp(F, 20) + (size_t)jj * 2 * 1024;
    const int tk = F.lane & 15, g = F.lane >> 4;
    const int NTASK = NBAT * 16 * 11;
    for (int task = F.wg; task < NTASK; task += F.G) {
        const int grp = task % 11, kb = (task / 11) & 15, b = task / (11 * 16);
        __syncthreads();
        for (int i = F.tid; i < 4 * 4096 / 8; i += 512) { const int mg = i >> 9, r = i & 511;
            *(LAS u32x4*)(Wl + (mg * 64 + (r >> 3)) * 72 + (r & 7) * 8) = *(const u32x4*)(wsrc + ((size_t)mg * 16 + kb) * 4096 + r * 8); }
        for (int i = F.tid; i < 11 * 64; i += 512) { const int kind = i >> 6, ch = kb * 64 + (i & 63); float v;
            if (kind < 4) v = cw[kind * 1024 + ch]; else if (kind == 4) v = cb[ch];
            else { const int d = (kind - 5) / 3, w = (kind - 5) % 3; v = (w == 0) ? b_a[d * 1024 + ch] : (w == 1) ? b_x[d * 1024 + ch] : -8.0f * log1pf(__expf(-lam[d * 1024 + ch])); }
            CT[i] = v; }
        __syncthreads();
        const int nt0 = grp * 48;
        LruRaw raw; lru_load(F, b, kb, nt0 + F.wave, raw);
        for (int ti = F.wave; ti < 48; ti += 8) {
            const int nt = nt0 + ti;
            float av[2][4][4], xv[2][4][4];
            lru_conv(F, raw, CT, ucb);
            if (ti + 8 < 48) lru_load(F, b, kb, nt + 8, raw);
            lru_gates(F, Wl, CT, ucb, av, xv);
            const int row = lru_row(b, nt, tk);
#pragma unroll
            for (int d = 0; d < 2; ++d)
#pragma unroll
                for (int et = 0; et < 4; ++et) { u32x4 w; w.x = cvt_pk_bf16(av[d][et][0], xv[d][et][0]); w.y = cvt_pk_bf16(av[d][et][1], xv[d][et][1]); w.z = cvt_pk_bf16(av[d][et][2], xv[d][et][2]); w.w = cvt_pk_bf16(av[d][et][3], xv[d][et][3]);
                    __builtin_nontemporal_store(w, (u32x4*)(GX + (((size_t)row * 2 + d) * 1024 + kb * 64 + et * 16 + 4 * g) * 2));
                    const unsigned ww[4] = {w.x, w.y, w.z, w.w};
#pragma unroll
                    for (int i = 0; i < 4; ++i) { av[d][et][i] = __expf(__uint_as_float(ww[i] << 16)); xv[d][et][i] = __uint_as_float(ww[i] & 0xffff0000u); } }
            LRU_SCANS(av, xv);
#pragma unroll
            for (int d = 0; d < 2; ++d) if (tk == (d ? 0 : 15)) {
                float* ag = AG + (((size_t)(b * 2 + d) * LRU_NT + nt) * 2) * 1024 + kb * 64;
#pragma unroll
                for (int et = 0; et < 4; ++et) { *(f32x4*)(ag + et * 16 + 4 * g) = (f32x4){av[d][et][0], av[d][et][1], av[d][et][2], av[d][et][3]};
                    *(f32x4*)(ag + 1024 + et * 16 + 4 * g) = (f32x4){xv[d][et][0], xv[d][et][1], xv[d][et][2], xv[d][et][3]}; }
            }
        }
    }
    __syncthreads();
}
__device__ __forceinline__ void ph_lru_c(const Frame& F) {
    const float* HST = (const float*)(F.R1 + R1_HST); const bf16_t* GX = (const bf16_t*)(F.R1 + R1_GX);
    const bf16_t* P = (const bf16_t*)(F.R1 + R1_P);
    const int tk = F.lane & 15, g = F.lane >> 4;
    const int gw = F.wg * 8 + F.wave, nw = F.G * 8;
    for (int task = gw; task < NBAT * LRU_NT * 16; task += nw) {
        const int kb = task & 15, nt = (task >> 4) % LRU_NT, b = (task >> 4) / LRU_NT;
        const int row = lru_row(b, nt, tk);
        u32x4 gx[2][4]; f32x4 hf[4], hb[4]; u32x2 yw[4];
#pragma unroll
        for (int d = 0; d < 2; ++d)
#pragma unroll
            for (int et = 0; et < 4; ++et) gx[d][et] = *(const u32x4*)(GX + (((size_t)row * 2 + d) * 1024 + kb * 64 + et * 16 + 4 * g) * 2);
#pragma unroll
        for (int et = 0; et < 4; ++et) { const int ch = kb * 64 + et * 16 + 4 * g;
            hf[et] = *(const f32x4*)(HST + ((size_t)(b * 2 + 0) * LRU_NT + nt) * 1024 + ch);
            hb[et] = *(const f32x4*)(HST + ((size_t)(b * 2 + 1) * LRU_NT + nt) * 1024 + ch);
            yw[et] = *(const u32x2*)(P + (size_t)row * 2048 + ch); }
        float av[2][4][4], xv[2][4][4];
#pragma unroll
        for (int d = 0; d < 2; ++d)
#pragma unroll
            for (int et = 0; et < 4; ++et) { const unsigned ww[4] = {gx[d][et].x, gx[d][et].y, gx[d][et].z, gx[d][et].w};
#pragma unroll
                for (int i = 0; i < 4; ++i) { av[d][et][i] = __expf(__uint_as_float(ww[i] << 16)); xv[d][et][i] = __uint_as_float(ww[i] & 0xffff0000u); } }
        LRU_SCANS(av, xv);
#pragma unroll
        for (int et = 0; et < 4; ++et) {
            const int ch = kb * 64 + et * 16 + 4 * g;
            const float y0 = __uint_as_float(yw[et].x << 16), y1 = __uint_as_float(yw[et].x & 0xffff0000u), y2 = __uint_as_float(yw[et].y << 16), y3 = __uint_as_float(yw[et].y & 0xffff0000u);
            float o[4];
#pragma unroll
            for (int i = 0; i < 4; ++i) o[i] = fmaf(av[0][et][i], hf[et][i], xv[0][et][i]) + fmaf(av[1][et][i], hb[et][i], xv[1][et][i]);
            o[0] *= gelu_tanh_(y0); o[1] *= gelu_tanh_(y1); o[2] *= gelu_tanh_(y2); o[3] *= gelu_tanh_(y3);
            u32x2 w; w.x = cvt_pk_bf16(o[0], o[1]); w.y = cvt_pk_bf16(o[2], o[3]);
            *(u32x2*)(F.MIX + (size_t)row * DM + ch) = w;
        }
    }
}
__device__ __forceinline__ void ph_lru_b(const Frame& F) {
    const float* AG = (const float*)(F.R1 + R1_AG); float* HST = (float*)(F.R1 + R1_HST);
    LAS float* sa = (LAS float*)F.lds; LAS float* sx = sa + 512;
    for (int task = F.wg; task < NBAT * 2 * 32; task += F.G) {
        const int cgp = task & 31, d = (task >> 5) & 1, b = task >> 6;
        const int ch = cgp * 32 + (F.tid & 31), seg = F.tid >> 5;
        const float* ag = AG + ((size_t)(b * 2 + d) * LRU_NT) * 2048 + ch;
        float A = 1.0f, Xv = 0.f;
        for (int i = 0; i < 33; ++i) { const int nt = lru_nat(seg * 33 + i, d); const float a = ag[(size_t)nt * 2048], x = ag[(size_t)nt * 2048 + 1024]; Xv = fmaf(a, Xv, x); A *= a; }
        __syncthreads();
        sa[F.tid] = A; sx[F.tid] = Xv;
        __syncthreads();
        float h = 0.f;
        for (int s2 = 0; s2 < seg; ++s2) h = fmaf(sa[s2 * 32 + (F.tid & 31)], h, sx[s2 * 32 + (F.tid & 31)]);
        float* hs = HST + ((size_t)(b * 2 + d) * LRU_NT) * 1024 + ch;
        for (int i = 0; i < 33; ++i) { const int nt = lru_nat(seg * 33 + i, d); hs[(size_t)nt * 1024] = h; const float a = ag[(size_t)nt * 2048], x = ag[(size_t)nt * 2048 + 1024]; h = fmaf(a, h, x); }
    }
    __syncthreads();
}

__device__ __forceinline__ void topk_better(float& bk, int& be, float& bs, float ok, int oe, float os) { const bool t = (ok > bk) || (ok == bk && oe < be); bk = t ? ok : bk; be = t ? oe : be; bs = t ? os : bs; }
template <int CTRL> __device__ __forceinline__ void topk_step(float& bk, int& be, float& bs) {
    const float ok = dppf<CTRL>(bk, bk), os = dppf<CTRL>(bs, bs); const int oe = __builtin_amdgcn_update_dpp(be, be, CTRL, 0xf, 0xf, false); topk_better(bk, be, bs, ok, oe, os); }
__device__ __forceinline__ void ph_ln_router(const Frame& F, int l, bool dry = false) {
    const bf16_t* RW = (const bf16_t*)(F.WB + WB_RT);
    const float* rbias = inp(F, 23) + l * 64;
    LAS float* part = (LAS float*)F.lds;
    LAS float* LP = (LAS float*)(F.lds + 4096);
    LAS int* hist = (LAS int*)(F.lds + LDS_MISC + MISC_HIST); LAS int* hbase = (LAS int*)(F.lds + LDS_MISC + MISC_HBASE);
    int* tok_e = (int*)(F.ws + OFF_TOKE); int* tok_p = (int*)(F.ws + OFF_TOKP); float* tok_w = (float*)(F.ws + OFF_TOKW);
    int* stok = (int*)(F.ws + OFF_STOK); float* sw = (float*)(F.ws + OFF_SW);
    float* stats = (float*)(F.ws + OFF_STATS);
    unsigned* gcnt = (unsigned*)(F.ws + OFF_CTL + CTL_CNT) + l * 64;
    const int tk = F.lane & 15, g = F.lane >> 4;
    float rb[4];
#pragma unroll
    for (int q = 0; q < 4; ++q) rb[q] = rbias[tk + 16 * q];
    if (F.tid < 64) hist[F.tid] = 0;
    __syncthreads();
    const int NTILE = TT / 16, TILE0 = (l == 3) ? TC / 16 : 0;
    bf16x8 rwf[4][4];
#pragma unroll
    for (int et = 0; et < 4; ++et)
#pragma unroll
        for (int ks = 0; ks < 4; ++ks) rwf[et][ks] = *(const bf16x8*)(RW + (size_t)(et * 16 + tk) * 1024 + F.wave * 128 + ks * 32 + g * 8);
    f32x4 vn[4][2];
    if (TILE0 + F.wg < NTILE) { const float* xr = F.X + (size_t)((TILE0 + F.wg) * 16 + tk) * DM + F.wave * 128 + g * 8;
#pragma unroll
        for (int ks = 0; ks < 4; ++ks) { vn[ks][0] = *(const f32x4*)(xr + ks * 32); vn[ks][1] = *(const f32x4*)(xr + ks * 32 + 4); } }
    for (int tile = TILE0 + F.wg; tile < NTILE; tile += F.G) {
        const int row = tile * 16 + tk; const int s = slot_of_row(tile * 16);
        const float* ab = (const float*)(F.ws + OFF_AB) + (size_t)(l * 5 + s) * 2048;
        f32x4 v[4][2];
#pragma unroll
        for (int ks = 0; ks < 4; ++ks) { v[ks][0] = vn[ks][0]; v[ks][1] = vn[ks][1]; }
        if (tile + F.G < NTILE) { const float* xr = F.X + (size_t)((tile + F.G) * 16 + tk) * DM + F.wave * 128 + g * 8;
#pragma unroll
            for (int ks = 0; ks < 4; ++ks) { vn[ks][0] = *(const f32x4*)(xr + ks * 32); vn[ks][1] = *(const f32x4*)(xr + ks * 32 + 4); } }
        float sum = 0.f, sq = 0.f;
#pragma unroll
        for (int ks = 0; ks < 4; ++ks)
#pragma unroll
            for (int hh = 0; hh < 2; ++hh) { const f32x4 a = v[ks][hh]; sum += (a[0] + a[1]) + (a[2] + a[3]); sq += (a[0] * a[0] + a[1] * a[1]) + (a[2] * a[2] + a[3] * a[3]); }
        sum += __shfl_xor(sum, 16); sum += __shfl_xor(sum, 32); sq += __shfl_xor(sq, 16); sq += __shfl_xor(sq, 32);
        if (g == 0) *(LAS f32x2*)(part + (F.wave * 16 + tk) * 2) = (f32x2){sum, sq};
        __syncthreads();
        float ts = 0.f, tq = 0.f;
#pragma unroll
        for (int w = 0; w < 8; ++w) { const f32x2 p = *(const LAS f32x2*)(part + (w * 16 + tk) * 2); ts += p.x; tq += p.y; }
        const float mean = ts * (1.0f / 1024.0f), var = fmaxf(tq * (1.0f / 1024.0f) - mean * mean, 0.f), rstd = rsqrtf(var + 1e-5f);
        if (F.wave == 0 && g == 0) *(f32x2*)(stats + (size_t)row * 2) = (f32x2){mean, rstd};
        f32x4 acc[4];
#pragma unroll
        for (int et = 0; et < 4; ++et) acc[et] = (f32x4){0.f, 0.f, 0.f, 0.f};
#pragma unroll
        for (int ks = 0; ks < 4; ++ks) { const int k = F.wave * 128 + ks * 32 + g * 8;
            const f32x4 a10 = *(const f32x4*)(ab + k), a11 = *(const f32x4*)(ab + k + 4), b10 = *(const f32x4*)(ab + 1024 + k), b11 = *(const f32x4*)(ab + 1024 + k + 4);
            const f32x4 h0 = (v[ks][0] - mean) * rstd * a10 + b10, h1 = (v[ks][1] - mean) * rstd * a11 + b11;
            u32x4 w; w.x = cvt_pk_bf16(h0[0], h0[1]); w.y = cvt_pk_bf16(h0[2], h0[3]); w.z = cvt_pk_bf16(h1[0], h1[1]); w.w = cvt_pk_bf16(h1[2], h1[3]);
            *(u32x4*)(F.HB + (size_t)row * DM + k) = w;
            bf16x8 af; __builtin_memcpy(&af, &w, 16);
#pragma unroll
            for (int et = 0; et < 4; ++et) acc[et] = __builtin_amdgcn_mfma_f32_16x16x32_bf16(af, rwf[et][ks], acc[et], 0, 0, 0);
        }
#pragma unroll
        for (int et = 0; et < 4; ++et)
#pragma unroll
            for (int i = 0; i < 4; ++i) LP[(F.wave * 16 + 4 * g + i) * 64 + et * 16 + tk] = acc[et][i];
        __syncthreads();
        {
            const int t = 2 * F.wave + (g & 1), r2 = tile * 16 + t;
            float sc[4], key[4];
#pragma unroll
            for (int q = 0; q < 4; ++q) { float lgt = 0.f;
#pragma unroll
                for (int w = 0; w < 8; ++w) lgt += LP[(w * 16 + t) * 64 + tk + 16 * q];
                sc[q] = sigmoidf_(lgt); key[q] = sc[q] + rb[q]; }
            unsigned taken = 0u; int se[6]; float ss[6]; float tot = 0.f;
#pragma unroll
            for (int sel = 0; sel < 6; ++sel) {
                float bk = -1e30f, bs = 0.f; int be = 0;
#pragma unroll
                for (int q = 0; q < 4; ++q) if (!((taken >> q) & 1u) && key[q] > bk) { bk = key[q]; be = tk + 16 * q; bs = sc[q]; }
                topk_step<0xB1>(bk, be, bs); topk_step<0x4E>(bk, be, bs); topk_step<0x141>(bk, be, bs); topk_step<0x140>(bk, be, bs);
                if ((be & 15) == tk) taken |= 1u << (be >> 4);
                se[sel] = be; ss[sel] = bs; tot += bs;
            }
            const float sc2 = 2.5f / tot;
            if (tk < 6 && g < 2) {
                int e = se[0]; float w = ss[0];
#pragma unroll
                for (int q = 1; q < 6; ++q) if (tk == q) { e = se[q]; w = ss[q]; }
                tok_e[r2 * 8 + tk] = e; tok_w[r2 * 8 + tk] = w * sc2; if (!dry) tok_p[r2 * 8 + tk] = __hip_atomic_fetch_add(hist + e, 1, __ATOMIC_RELAXED, __HIP_MEMORY_SCOPE_WORKGROUP);
            }
        }
    }
    asm volatile("s_waitcnt vmcnt(0) lgkmcnt(0)" ::: "memory");
    __syncthreads();
    if (dry) return;
    if (F.tid < 64) hbase[F.tid] = (int)__hip_atomic_fetch_add(gcnt + F.tid, (unsigned)hist[F.tid], __ATOMIC_RELAXED, __HIP_MEMORY_SCOPE_AGENT);
    __syncthreads();
    for (int tile = TILE0 + F.wg; tile < NTILE; tile += F.G) {
        if (F.tid < 96) { const int row = tile * 16 + F.tid / 6, q = F.tid % 6; const int e = tok_e[row * 8 + q]; const int pos = hbase[e] + tok_p[row * 8 + q];
            tok_p[row * 8 + q] = pos; stok[(size_t)e * CAP + pos] = row; sw[(size_t)e * CAP + pos] = tok_w[row * 8 + q]; }
    }
    __syncthreads();
}

__device__ __forceinline__ int moe_tables(const Frame& F, int l) {
    const int t0 = (l == 3) ? TC : 0;
    LAS int* cnt = (LAS int*)(F.lds + LDS_MISC + MISC_CNT); LAS int* tst = (LAS int*)(F.lds + LDS_MISC + MISC_TST); LAS unsigned char* t2e = (LAS unsigned char*)(F.lds + LDS_MISC + MISC_T2E);
    const unsigned* gcnt = (const unsigned*)(F.ws + OFF_CTL + CTL_CNT) + l * 64;
    __syncthreads();
    if (F.tid < 64) cnt[F.tid] = (int)__hip_atomic_load(gcnt + F.tid, __ATOMIC_RELAXED, __HIP_MEMORY_SCOPE_AGENT);
    if (F.tid == 64) cnt[64] = TT - t0;
    __syncthreads();
    if (F.tid == 0) { int s = 0; for (int e = 0; e < 65; ++e) { tst[e] = s; s += (cnt[e] + 255) >> 8; } tst[65] = s; }
    __syncthreads();
    const int ntiles = tst[65];
    for (int t = F.tid; t < ntiles; t += 512) { int e = 0; for (int q = 0; q < 65; ++q) if (t >= tst[q]) e = q; else break; t2e[t] = (unsigned char)e; }
    __syncthreads();
    return ntiles;
}

__device__ __forceinline__ void ph_combine(const Frame& F, int l, bool dry = false) {
    LAS int* tst = (LAS int*)(F.lds + LDS_MISC + MISC_TST);
    (void)moe_tables(F, l);
    const float* gam = inp(F, 6) + (size_t)(l * 2 + 1) * DM; const float* bet = inp(F, 7) + (size_t)(l * 2 + 1) * DM;
    const float* gam0 = inp(F, 6) + (size_t)(l * 2 + 0) * DM; const float* bet0 = inp(F, 7) + (size_t)(l * 2 + 0) * DM;
    const float* stats = (const float*)(F.ws + OFF_STATS);
    const unsigned char* Y = (const unsigned char*)(F.R1 + R1_Y);
    const int* tok_e = (const int*)(F.ws + OFF_TOKE); const int* tok_p = (const int*)(F.ws + OFF_TOKP);
    const int gw = F.wg * 8 + F.wave, nw = F.G * 8;
    const bool lastl = (l == 3);
    const int t0 = lastl ? TC : 0;
    for (int row = t0 + gw; row < TT; row += nw) {
        const int s = slot_of_row(row);
        const float* m = F.mods + (size_t)(l * 5 + s) * 6144;
        const float* mn = F.mods + (size_t)((lastl ? l : l + 1) * 5 + s) * 6144;
        int srow[7];
#pragma unroll
        for (int q = 0; q < 6; ++q) { const int e = tok_e[row * 8 + q]; srow[q] = tst[e] * 256 + tok_p[row * 8 + q]; }
        srow[6] = tst[64] * 256 + (row - t0);
        float v[16];
#pragma unroll
        for (int hh = 0; hh < 2; ++hh) { const int k = hh * 512 + F.lane * 8;
            float y[8];
#pragma unroll
            for (int q = 0; q < 8; ++q) y[q] = 0.f;
#pragma unroll
            for (int q = 0; q < 7; ++q) { const u32x2 w = *(const u32x2*)(Y + (size_t)srow[q] * DM + k);
                const f32x2 t0 = __builtin_amdgcn_cvt_pk_f32_fp8((int)w.x, false), t1 = __builtin_amdgcn_cvt_pk_f32_fp8((int)w.x, true), t2 = __builtin_amdgcn_cvt_pk_f32_fp8((int)w.y, false), t3 = __builtin_amdgcn_cvt_pk_f32_fp8((int)w.y, true);
                y[0] += t0.x; y[1] += t0.y; y[2] += t1.x; y[3] += t1.y; y[4] += t2.x; y[5] += t2.y; y[6] += t3.x; y[7] += t3.y; }
#pragma unroll
            for (int i = 0; i < 8; ++i) y[i] *= (1.0f / 32.0f);
            f32x4 x0 = *(const f32x4*)(F.X + (size_t)row * DM + k), x1 = *(const f32x4*)(F.X + (size_t)row * DM + k + 4);
            { const f32x2 st = *(const f32x2*)(stats + (size_t)row * 2); const f32x4 g0 = *(const f32x4*)(gam0 + k), g1 = *(const f32x4*)(gam0 + k + 4), b0 = *(const f32x4*)(bet0 + k), b1 = *(const f32x4*)(bet0 + k + 4);
              x0 = (x0 - st.x) * st.y * g0 + b0; x1 = (x1 - st.x) * st.y * g1 + b1; }
            const f32x4 m50 = *(const f32x4*)(m + 5 * 1024 + k), m51 = *(const f32x4*)(m + 5 * 1024 + k + 4);
#pragma unroll
            for (int i = 0; i < 4; ++i) { v[hh * 8 + i] = ALPHA * x0[i] + m50[i] * y[i]; v[hh * 8 + 4 + i] = ALPHA * x1[i] + m51[i] * y[4 + i]; }
        }
        float sum = 0.f;
#pragma unroll
        for (int i = 0; i < 16; ++i) sum += v[i];
        sum += __shfl_xor(sum, 1); sum += __shfl_xor(sum, 2); sum += __shfl_xor(sum, 4); sum += __shfl_xor(sum, 8); sum += __shfl_xor(sum, 16); sum += __shfl_xor(sum, 32);
        const float mean = sum * (1.0f / 1024.0f);
        float sq = 0.f;
#pragma unroll
        for (int i = 0; i < 16; ++i) { const float d = v[i] - mean; sq += d * d; }
        sq += __shfl_xor(sq, 1); sq += __shfl_xor(sq, 2); sq += __shfl_xor(sq, 4); sq += __shfl_xor(sq, 8); sq += __shfl_xor(sq, 16); sq += __shfl_xor(sq, 32);
        const float rstd = rsqrtf(sq * (1.0f / 1024.0f) + 1e-5f);
#pragma unroll
        for (int hh = 0; hh < 2; ++hh) { const int k = hh * 512 + F.lane * 8;
            float gm[8], bt[8], xn[8];
            *(f32x4*)&gm[0] = *(const f32x4*)(gam + k); *(f32x4*)&gm[4] = *(const f32x4*)(gam + k + 4);
            *(f32x4*)&bt[0] = *(const f32x4*)(bet + k); *(f32x4*)&bt[4] = *(const f32x4*)(bet + k + 4);
#pragma unroll
            for (int i = 0; i < 8; ++i) xn[i] = (v[hh * 8 + i] - mean) * rstd * gm[i] + bt[i];
            if (dry) { float acc_ = 0.f; for (int i = 0; i < 8; ++i) acc_ += xn[i]; asm volatile("" :: "v"(acc_)); }
            else if (lastl) { if (row >= TC) { float* o = F.out + (size_t)(row - TC) * DM + k; *(f32x4*)o = *(f32x4*)&xn[0]; *(f32x4*)(o + 4) = *(f32x4*)&xn[4]; } }
            else {
                *(f32x4*)(F.X + (size_t)row * DM + k) = *(f32x4*)&xn[0]; *(f32x4*)(F.X + (size_t)row * DM + k + 4) = *(f32x4*)&xn[4];
                float s1[8], b0[8];
                *(f32x4*)&s1[0] = *(const f32x4*)(mn + 1024 + k); *(f32x4*)&s1[4] = *(const f32x4*)(mn + 1024 + k + 4);
                *(f32x4*)&b0[0] = *(const f32x4*)(mn + k); *(f32x4*)&b0[4] = *(const f32x4*)(mn + k + 4);
                float hv[8];
#pragma unroll
                for (int i = 0; i < 8; ++i) hv[i] = xn[i] * (1.0f + s1[i]) + b0[i];
                u32x4 w; w.x = cvt_pk_bf16(hv[0], hv[1]); w.y = cvt_pk_bf16(hv[2], hv[3]); w.z = cvt_pk_bf16(hv[4], hv[5]); w.w = cvt_pk_bf16(hv[6], hv[7]);
                *(u32x4*)(F.HB + (size_t)row * DM + k) = w;
            }
        }
    }
}

constexpr int NPHASE = 2 + 4 * 10;
__global__ void __launch_bounds__(512, 2) mk_fwd(Args args) {
    extern __shared__ __attribute__((aligned(16))) unsigned char lds_raw[];
    Frame F;
    F.out = args.out; F.ws = args.ws; F.lds = (LAS unsigned char*)lds_raw;
    { const int t0 = threadIdx.x; F.wave = __builtin_amdgcn_readfirstlane(t0 >> 6); F.lane = t0 & 63; F.tid = t0; } F.G = gridDim.x; F.wg = blockIdx.x;
    F.mods = (float*)(args.ws + OFF_MODS); F.X = (float*)(args.ws + OFF_X); F.HB = (bf16_t*)(args.ws + OFF_HB); F.MIX = F.HB;
    F.WB = args.ws + OFF_WB; F.R1 = args.ws + OFF_R1;
    volatile LAS unsigned* xbw = (volatile LAS unsigned*)(F.lds + LDS_MISC);
    if (F.tid < 4) xbw[F.tid] = 0u;
    if (F.tid < 30) ((LAS unsigned long long*)(F.lds + LDS_MISC + MISC_INP))[F.tid] = (unsigned long long)args.in[F.tid];
    __syncthreads();
    const int lo = args.ph_lo, hi = args.ph_hi;
    XcdBarrier bar; bar.bar = (unsigned*)(args.ws + OFF_CTL); bar.x = 0; bar.st = xbw;
    if (hi - lo > 1) bar = xcd_barrier_post((unsigned*)(args.ws + OFF_CTL), xbw);
#define IN(k) (lo <= (k) && (k) < hi)
#define SEAM(k) do { if (IN(k) && IN((k) + 1)) { xcd_barrier(bar); if (REPM & 1) xcd_barrier(bar); } } while (0)
    if ((PHM & 1) && IN(0)) { ph_mods(fresh(F)); if (REPM & 65536) { __syncthreads(); ph_mods(fresh(F)); } } SEAM(0);
    if ((PHM & 2) && IN(1)) { ph_init_x(fresh(F)); if (REPM & 131072) ph_init_x(fresh(F)); }
    for (int l = 0; l < 4; ++l) {
        const int pb = 2 + l * 10, j = l >> 1; const bool even = (l & 1) == 0;
        float* mods_l = F.mods + (size_t)l * 5 * 6144;
        F.WB = args.ws + OFF_WB + (size_t)(l & 1) * WB_END;
        if ((PHM & 4) && IN(pb + 0) && !(l & 1)) { for (int rep = 0; rep < ((REPM & 4) ? 2 : 1); ++rep) { ph_convert(fresh(F), l); __syncthreads(); } }
        if (!(l & 1)) SEAM(pb + 0);
        if ((PHM & 8) && IN(pb + 1)) {
            const int N = even ? 4096 : 2048;
            pg8::StaticOrder S; S.init(F.HB, F.WB + WB_IN, TT, N, 1024, F.G, F.wg);
            pg8::EpiStoreBf16 E{(bf16_t*)(F.R1 + R1_P), N};
            for (int rep = 0; rep < ((REPM & 8) ? 2 : 1); ++rep) pg8::gemm_phase(F.lds, 1024, S, E, F.wave);
        } SEAM(pb + 1);
        if (IN(pb + 2)) { if (even) { if (F.wg < 8 && F.G > 16) { ph_hg_ctx(fresh(F), j); } else if (PHM & 16) for (int rep = 0; rep < ((REPM & 16) ? 2 : 1); ++rep) { Frame Fa = fresh(F); if (F.G > 16) { Fa.wg = F.wg - 8; Fa.G = F.G - 8; } ph_attn(Fa, j); } if (PHM & 32) for (int rep = 0; rep < ((REPM & 32) ? 2 : 1); ++rep) ph_hg_a(fresh(F), j); } else { if (PHM & 64) for (int rep = 0; rep < ((REPM & 64) ? 2 : 1); ++rep) ph_lru_a(fresh(F), j); } } SEAM(pb + 2);
        if (IN(pb + 3)) { if (even) { if (PHM & 128) for (int rep = 0; rep < ((REPM & 128) ? 2 : 1); ++rep) { ph_hg_b(fresh(F));
                { Frame Fc = fresh(F); Fc.WB = args.ws + OFF_WB + (size_t)((l + 1) & 1) * WB_END; ph_convert(Fc, l + 1); } } } else { if (PHM & 256) for (int rep = 0; rep < ((REPM & 256) ? 2 : 1); ++rep) ph_lru_b(fresh(F)); } } SEAM(pb + 3);
        if (IN(pb + 4)) { if (even) { if (PHM & 512) for (int rep = 0; rep < ((REPM & 512) ? 2 : 1); ++rep) ph_hg_c(fresh(F), j); } else { if (PHM & 1024) for (int rep = 0; rep < ((REPM & 1024) ? 2 : 1); ++rep) ph_lru_c(fresh(F)); } } SEAM(pb + 4);
        if ((PHM & 2048) && IN(pb + 5)) {
            const int t0 = (l == 3) ? TC : 0;
            pg8::StaticOrder S; S.init(F.MIX + (size_t)t0 * DM, F.WB + WB_OUT, TT - t0, 1024, 1024, F.G, F.wg);
            pg8::EpiResid E{F.X + (size_t)t0 * DM, mods_l, t0};
            pg8::gemm_phase(F.lds, 1024, S, E, F.wave);
        } SEAM(pb + 5);
        if ((PHM & 4096) && IN(pb + 6)) { if (REPM & 4096) ph_ln_router(fresh(F), l, true); ph_ln_router(fresh(F), l); } SEAM(pb + 6);
        if ((PHM & 8192) && IN(pb + 7)) {
            const int ntiles = moe_tables(fresh(F), l);
            pg8::MoeGU S; S.cnt = (const LAS int*)(F.lds + LDS_MISC + MISC_CNT); S.tst = (const LAS int*)(F.lds + LDS_MISC + MISC_TST); S.t2e = (const LAS unsigned char*)(F.lds + LDS_MISC + MISC_T2E);
            S.ntiles = ntiles; S.G = F.G; S.c = F.wg; S.A = (const char*)F.HB; S.Bt = (const char*)(F.WB + WB_GU); S.stok = (const int*)(F.ws + OFF_STOK); S.t0 = (l == 3) ? TC : 0;
            pg8::EpiSwiglu E{(bf16_t*)(F.R1 + R1_H)};
            for (int rep = 0; rep < ((REPM & 8192) ? 2 : 1); ++rep) pg8::gemm_phase(F.lds, 1024, S, E, F.wave);
        } SEAM(pb + 7);
        if ((PHM & 16384) && IN(pb + 8)) {
            const int ntiles = moe_tables(fresh(F), l);
            pg8::MoeDN S; S.cnt = (const LAS int*)(F.lds + LDS_MISC + MISC_CNT); S.tst = (const LAS int*)(F.lds + LDS_MISC + MISC_TST); S.t2e = (const LAS unsigned char*)(F.lds + LDS_MISC + MISC_T2E);
            S.ntiles = ntiles; S.G = F.G; S.c = F.wg; S.A = (const char*)(F.R1 + R1_H); S.Bt = (const char*)(F.WB + WB_DN);
            pg8::EpiDown E{(unsigned char*)(F.R1 + R1_Y), (const float*)(F.ws + OFF_SW), (const LAS int*)(F.lds + LDS_MISC + MISC_CNT)};
            if (REPM & 2) { pg8::EpiNull EN; pg8::gemm_phase(F.lds, 256, S, EN, F.wave); }
            for (int rep = 0; rep < ((REPM & 16384) ? 2 : 1); ++rep) pg8::gemm_phase(F.lds, 256, S, E, F.wave);
        } SEAM(pb + 8);
        if ((PHM & 32768) && IN(pb + 9)) { if (REPM & 32768) ph_combine(fresh(F), l, true); ph_combine(fresh(F), l); } SEAM(pb + 9);
    }
#undef IN
#undef SEAM
}

extern "C" void kernel_launch(void* const* d_in, const int* in_sizes, int n_in, void* d_out, int out_size, void* d_ws, size_t ws_size, hipStream_t stream) {
    static int grid = 0;
    if (grid == 0) {
        if (n_in != 30 || out_size != TX * DM || ws_size < WS_END) { fprintf(stderr, "kernel_launch: unexpected problem (n_in %d out %d ws %zu need %zu)\n", n_in, out_size, ws_size, (size_t)WS_END); grid = -1; return; }
        int dev = 0, cus = 0, per_cu = 0;
        if (hipGetDevice(&dev) != hipSuccess || hipDeviceGetAttribute(&cus, hipDeviceAttributeMultiprocessorCount, dev) != hipSuccess) { grid = -1; return; }
        if (hipFuncSetAttribute((const void*)mk_fwd, hipFuncAttributeMaxDynamicSharedMemorySize, LDS_BYTES) != hipSuccess) { fprintf(stderr, "kernel_launch: hipFuncSetAttribute failed\n"); grid = -1; return; }
        if (hipOccupancyMaxActiveBlocksPerMultiprocessor(&per_cu, (const void*)mk_fwd, 512, LDS_BYTES) != hipSuccess || per_cu < 1) { fprintf(stderr, "kernel_launch: occupancy query says %d\n", per_cu); }
        (void)hipGetLastError();
        grid = cus;
    }
    if (grid < 0) return;
    (void)hipMemsetAsync((char*)d_ws + OFF_CTL, 0, CTL_BYTES, stream);
    Args a{};
    for (int i = 0; i < 30; ++i) a.in[i] = (const float*)d_in[i];
    a.out = (float*)d_out; a.ws = (unsigned char*)d_ws;
#if MK_SPLIT
    for (int p = 0; p < NPHASE; ++p) { a.ph_lo = p; a.ph_hi = p + 1; hipLaunchKernelGGL(mk_fwd, dim3(grid), dim3(512), LDS_BYTES, stream, a); }
#else
    a.ph_lo = 0; a.ph_hi = NPHASE;
    hipLaunchKernelGGL(mk_fwd, dim3(grid), dim3(512), LDS_BYTES, stream, a);
#endif
}
```

```cpp
#include <hip/hip_runtime.h>
#include <cstdio>
#include <cstdint>

#ifndef PHM
#define PHM 0xFFFF
#endif
#ifndef REPM
#define REPM 0
#endif
#ifndef MK_SPLIT
#define MK_SPLIT 0
#endif

typedef unsigned short bf16_t;
typedef short bf16x8 __attribute__((ext_vector_type(8)));
typedef short bf16x4 __attribute__((ext_vector_type(4)));
typedef float f32x4 __attribute__((ext_vector_type(4)));
typedef float f32x2 __attribute__((ext_vector_type(2)));
typedef unsigned u32x4 __attribute__((ext_vector_type(4)));
typedef unsigned u32x2 __attribute__((ext_vector_type(2)));
#define LAS __attribute__((address_space(3)))

constexpr int DM = 1024, NBAT = 4, SEQ = 8192, CTXL = 256;
constexpr int TC = NBAT * CTXL, TX = NBAT * SEQ, TT = TC + TX;
constexpr int NEXP = 64, TOPK = 6;
constexpr int CAP = TT;
constexpr int MOE_ROUTED_ROWS = 6 * TT + 64 * 256;
constexpr int MOE_ROWS = MOE_ROUTED_ROWS + TT;
constexpr int MOE_MAXTILES = MOE_ROWS / 256;
constexpr float ALPHA = 1.681792830507429f;
constexpr int HG_U = 128, HG_NU = (CTXL + SEQ) / HG_U;
constexpr int LRU_NT = (CTXL + SEQ) / 16;

constexpr size_t OFF_CTL = 0, CTL_BYTES = 65536;
constexpr size_t CTL_CNT = 16384, CTL_DBG = 20480;
constexpr size_t OFF_MODS = 65536;
constexpr size_t OFF_LBT = OFF_MODS + 4 * 5 * 6144 * 4;
constexpr size_t OFF_STATS = OFF_LBT + 8192;
constexpr size_t OFF_AB = OFF_STATS + (size_t)TT * 8;
static_assert(OFF_AB + 4 * 5 * 2 * 1024 * 4 <= (1u << 20), "ctl map");
constexpr size_t OFF_TOKE = 1u << 20;
constexpr size_t OFF_TOKP = OFF_TOKE + (size_t)TT * 32;
constexpr size_t OFF_TOKW = OFF_TOKP + (size_t)TT * 32;
constexpr size_t OFF_STOK = OFF_TOKW + (size_t)TT * 32;
constexpr size_t OFF_SW = OFF_STOK + (size_t)64 * CAP * 4;
constexpr size_t OFF_X = OFF_SW + (size_t)64 * CAP * 4;
constexpr size_t OFF_HB = OFF_X + (size_t)TT * DM * 4;
constexpr size_t OFF_WB = OFF_HB + (size_t)TT * DM * 2;
constexpr size_t WB_IN = 0, WB_OUT = WB_IN + (size_t)4096 * 1024 * 2, WB_RT = WB_OUT + (size_t)1024 * 1024 * 2, WB_GU = WB_RT + (size_t)64 * 1024 * 2,
                 WB_DN = WB_GU + (size_t)65 * 512 * 1024 * 2, WB_LRU = WB_DN + (size_t)65 * 1024 * 256 * 2, WB_END = WB_LRU + (size_t)2 * 2 * 16 * 64 * 64 * 2;
constexpr size_t OFF_R1 = OFF_WB + 2 * WB_END;
constexpr size_t R1_P = 0;
constexpr size_t R1_OF = R1_P + (size_t)TT * 4096 * 2;
constexpr size_t R1_SLOC = R1_OF + (size_t)TT * 512 * 4;
constexpr size_t R1_SST = R1_SLOC + (size_t)64 * HG_NU * 4096 * 4;
constexpr size_t R1_DL = R1_SST + (size_t)64 * HG_NU * 4096 * 4;
constexpr size_t R1_AG = (size_t)TT * 2048 * 2;
constexpr size_t R1_HST = R1_AG + (size_t)4 * 2 * LRU_NT * 2 * 1024 * 4;
constexpr size_t R1_GX = R1_HST + (size_t)4 * 2 * LRU_NT * 1024 * 4;
constexpr size_t R1_LRU_END = R1_GX + (size_t)TT * 2 * 1024 * 2 * 2;
constexpr size_t R1_H = 0;
constexpr size_t R1_Y = R1_H + (size_t)MOE_ROWS * 256 * 2;
constexpr size_t R1_MOE_END = R1_Y + (size_t)MOE_ROWS * 1024;
constexpr size_t R1_MIX_END = R1_DL + (size_t)64 * HG_NU * 64 * 4;
constexpr size_t R1_END_ = (R1_MOE_END > R1_MIX_END ? R1_MOE_END : R1_MIX_END);
constexpr size_t WS_END = OFF_R1 + (R1_END_ > R1_LRU_END ? R1_END_ : R1_LRU_END);

constexpr int LDS_STAGE = 131072;
constexpr int LDS_MISC = LDS_STAGE;
constexpr int MISC_CNT = 64;
constexpr int MISC_TST = MISC_CNT + 66 * 4 + 8;
constexpr int MISC_HIST = 640;
constexpr int MISC_HBASE = 896;
constexpr int MISC_T2E = 1152;
constexpr int MISC_INP = 2304;
constexpr int LDS_BYTES = 147456;

#define XB_TMO      128
#define XB_XCNT(j)  (256  + 64 * (j))
#define XB_XSUB(j)  (1280 + 64 * (j))
#define XB_XGEN(j)  (2304 + 64 * (j))
#define XB_TOP      3328
#define XB_TOPGEN   3392
#define XCD_BAR_WORDS 3456
#define XB_SPIN_CAP (1u << 22)
__device__ __forceinline__ unsigned xb_ld(unsigned* p)              { return __hip_atomic_load(p, __ATOMIC_RELAXED, __HIP_MEMORY_SCOPE_AGENT); }
__device__ __forceinline__ unsigned xb_add(unsigned* p, unsigned v) { return __hip_atomic_fetch_add(p, v, __ATOMIC_RELAXED, __HIP_MEMORY_SCOPE_AGENT); }
__device__ __forceinline__ unsigned xb_xcc_id() { return (unsigned)__builtin_amdgcn_s_getreg((3 << 11) | 20) & 0xFu; }
#define XB_SPIN(cond, bar) do { unsigned _sp = 0; while (cond) { __builtin_amdgcn_s_sleep(1); \
    if ((++_sp & 255u) == 0u) { if (xb_ld(&(bar)[XB_TMO])) break; if (_sp > XB_SPIN_CAP) { atomicAdd(&(bar)[XB_TMO], 1u); break; } } } } while (0)
struct XcdBarrier { unsigned* bar; unsigned x; volatile LAS unsigned* st; };
__device__ __forceinline__ XcdBarrier xcd_barrier_post(unsigned* bar, volatile LAS unsigned* st) {
    XcdBarrier b; b.bar = bar; b.x = xb_xcc_id(); b.st = st;
    if (threadIdx.x == 0) (void)xb_add(&bar[XB_XCNT(b.x)], 1u);
    return b;
}
__device__ __forceinline__ void xcd_barrier_complete(unsigned* bar, unsigned x, unsigned& nloc, unsigned& nx) {
    const unsigned G = gridDim.x * gridDim.y * gridDim.z;
    unsigned sum, cnt, mine, sp = 0u;
    for (;;) {
        sum = 0u; cnt = 0u; mine = 0u;
#pragma unroll
        for (unsigned j = 0; j < 16; ++j) { const unsigned c = xb_ld(&bar[XB_XCNT(j)]); sum += c; cnt += (c > 0u) ? 1u : 0u; mine = (j == x) ? c : mine; }
        if (sum == G) break;
        __builtin_amdgcn_s_sleep(1);
        if ((++sp & 255u) == 0u) { if (xb_ld(&bar[XB_TMO])) break; if (sp > XB_SPIN_CAP) { atomicAdd(&bar[XB_TMO], 1u); break; } }
    }
    nloc = mine > 0u ? mine : 1u; nx = cnt > 0u ? cnt : 1u;
}
__device__ __forceinline__ void xcd_barrier(const XcdBarrier& b) {
    asm volatile("s_waitcnt vmcnt(0)" ::: "memory");
    __syncthreads();
    if (threadIdx.x == 0) {
        unsigned* bar = b.bar;
        __builtin_amdgcn_s_waitcnt(0);
        unsigned nloc = b.st[0], nx = b.st[1];
        if (nloc == 0u) { xcd_barrier_complete(bar, b.x, nloc, nx); b.st[0] = nloc; b.st[1] = nx; }
        const unsigned old = xb_add(&bar[XB_XSUB(b.x)], 1u);
        const unsigned gen = old / nloc;
        if (old + 1u == (gen + 1u) * nloc) {
            __builtin_amdgcn_fence(__ATOMIC_RELEASE, "agent");
            asm volatile("s_waitcnt vmcnt(0)" ::: "memory");
            const unsigned og = xb_add(&bar[XB_TOP], 1u);
            const unsigned tg = og / nx;
            if (og + 1u == (tg + 1u) * nx) xb_add(&bar[XB_TOPGEN], 1u);
            else XB_SPIN(xb_ld(&bar[XB_TOPGEN]) == tg, bar);
            __builtin_amdgcn_fence(__ATOMIC_ACQUIRE, "agent");
            xb_add(&bar[XB_XGEN(b.x)], 1u);
            asm volatile("s_waitcnt vmcnt(0)" ::: "memory");
        } else {
            XB_SPIN(xb_ld(&bar[XB_XGEN(b.x)]) == gen, bar);
            __builtin_amdgcn_fence(__ATOMIC_ACQUIRE, "agent");
            asm volatile("s_waitcnt vmcnt(0)" ::: "memory");
        }
    }
    __syncthreads();
}

__device__ __forceinline__ float bf2f(unsigned short b) { return __uint_as_float(((unsigned)b) << 16); }
__device__ __forceinline__ unsigned cvt_pk_bf16(float lo, float hi) { unsigned r; asm volatile("v_cvt_pk_bf16_f32 %0, %1, %2" : "=v"(r) : "v"(lo), "v"(hi)); return r; }
__device__ __forceinline__ unsigned short f2bf(float f) { return (unsigned short)(cvt_pk_bf16(f, 0.f) & 0xffffu); }
__device__ __forceinline__ float sigmoidf_(float x) { return __builtin_amdgcn_rcpf(1.0f + __expf(-x)); }
__device__ __forceinline__ float siluf_(float x) { return x * sigmoidf_(x); }
__device__ __forceinline__ float gelu_tanh_(float x) { return x * sigmoidf_(1.5957691216057308f * (x + 0.044715f * x * x * x)); }
__device__ __forceinline__ int slot_of_row(int r) { return r < TC ? 4 : ((r - TC) >> 13); }
template <int CTRL> __device__ __forceinline__ float dppf(float oldv, float src) {
    return __int_as_float(__builtin_amdgcn_update_dpp(__float_as_int(oldv), __float_as_int(src), CTRL, 0xf, 0xf, false));
}
__device__ __forceinline__ void unpack8(const u32x4 w, float (&o)[8]) {
    o[0] = __uint_as_float(w.x << 16); o[1] = __uint_as_float(w.x & 0xffff0000u); o[2] = __uint_as_float(w.y << 16); o[3] = __uint_as_float(w.y & 0xffff0000u);
    o[4] = __uint_as_float(w.z << 16); o[5] = __uint_as_float(w.z & 0xffff0000u); o[6] = __uint_as_float(w.w << 16); o[7] = __uint_as_float(w.w & 0xffff0000u);
}

namespace pg8 {
constexpr int BM = 256, BK = 64, HALF = 128, HTB = HALF * BK * 2, STAGE_BYTES = 8 * HTB, NXCD = 8, WGM = 8;
__device__ __forceinline__ int lds_byte(int r, int c) { const int st = (r >> 4) * 2 + (c >> 5), rr = r & 15, cc = c & 31, ob = rr * 64 + cc * 2; return st * 1024 + (ob ^ (((ob >> 9) & 1) << 5)); }
__device__ __forceinline__ void stage_rc(int b, int& R, int& C) { const int st = b / 1024, sb = b % 1024, swz = sb ^ (((sb >> 9) & 1) << 5); R = (st >> 1) * 16 + swz / 64; C = (st & 1) * 32 + (swz % 64) / 2; }
__device__ __forceinline__ int perm32(int rho) { const int n = rho >> 4, i = rho & 15; return 8 * (i >> 2) + 4 * n + (i & 3); }
struct Unit { int pm, pn, e, ti; };

struct StaticOrder {
    const char* A; const char* Bt; int K;
    int nM, nN, nwg, G, c;
    __device__ __forceinline__ void init(const void* A_, const void* Bt_, int M, int N, int K_, int G_, int c_) { A = (const char*)A_; Bt = (const char*)Bt_; K = K_; nM = M / BM; nN = N / BM; nwg = nM * nN; G = G_; c = c_; }
    __device__ __forceinline__ bool next(int i, Unit& u) const {
        const long L = (long)i * G + c; if (L >= nwg) return false;
        int wgid = (int)L; { const int q = nwg / NXCD, r = nwg % NXCD, xcd = wgid % NXCD, off = wgid / NXCD; wgid = (xcd < r ? xcd * (q + 1) : r * (q + 1) + (xcd - r) * q) + off; }
        const int nig = WGM * nN, gid = wgid / nig, fm = gid * WGM, gsz = (nM - fm) < WGM ? (nM - fm) : WGM;
        u.pm = fm + ((wgid % nig) % gsz); u.pn = (wgid % nig) / gsz; u.e = 0; u.ti = 0; return true;
    }
    static constexpr bool GATHER = false;
    __device__ __forceinline__ const char* abase(const Unit& u) const { return A + (size_t)u.pm * BM * K * 2; }
    __device__ __forceinline__ const char* bbase(const Unit& u) const { return Bt + (size_t)u.pn * BM * K * 2; }
};

template <class Epi, class Sched>
__device__ __forceinline__ void gemm_phase(LAS unsigned char* lds, const int K_, const Sched& S, const Epi& E, const int wave_) {
    int Kl_ = K_; asm volatile("" : "+s"(Kl_)); const int K = Kl_;
    int tid_ = wave_ * 64 + (int)__builtin_amdgcn_mbcnt_hi(~0u, __builtin_amdgcn_mbcnt_lo(~0u, 0u)); asm volatile("" : "+v"(tid_));
    const int tid = tid_, wid = __builtin_amdgcn_readfirstlane(tid >> 6), lane = tid & 63, wr = wid >> 2, wc = wid & 3, fr = lane & 15, fq = lane >> 4;
    const int nt = K / BK;
    unsigned voffA[2], voffB[2];
#pragma unroll
    for (int i = 0; i < 2; ++i) { int R, C; stage_rc(tid * 16 + i * 8192, R, C);
        const int Rb = Epi::PERM == 1 ? ((R & ~31) + perm32(R & 31)) : Epi::PERM == 2 ? (64 * (R >> 5) + 16 * ((R & 15) >> 2) + 4 * ((R >> 4) & 1) + (R & 3)) : R;
        voffA[i] = (unsigned)(R * K + C) * 2u; voffB[i] = (unsigned)(Rb * K + C) * 2u; }
    const size_t kstep = (size_t)(BK * 2);
    const size_t hstep = (size_t)HALF * K * 2;
    const size_t hstepB = Epi::PERM == 2 ? (size_t)8 * K * 2 : hstep;
    const unsigned ldsw = (unsigned)wid * 1024u;
    const int aoff = lds_byte(wr * 64 + fr, fq * 8), boff = lds_byte(wc * 32 + fr, fq * 8);
#define PG8_SA(b, h) (((b) * 2 + (h)) * HTB)
#define PG8_SB(b, h) ((4 + (b) * 2 + (h)) * HTB)
#define PG8_STAGE(bufoff, gbase, voff) do { _Pragma("unroll") for (int _i = 0; _i < 2; ++_i) \
        __builtin_amdgcn_global_load_lds((const unsigned*)((const char*)(gbase) + (voff)[_i]), (LAS unsigned*)(lds + (bufoff) + ldsw + _i * 8192), 16, 0, 0); } while (0)
#define PG8_STAGEA(bufoff, hh, kb, nx) do { if constexpr (Sched::GATHER) { unsigned _o[2]; _o[0] = (nx) ? vN[hh][0] : vC[hh][0]; _o[1] = (nx) ? vN[hh][1] : vC[hh][1]; PG8_STAGE(bufoff, cA + (kb), _o); } \
        else { PG8_STAGE(bufoff, ((nx) ? nA : cA) + (hh) * hstep + (kb), voffA); } } while (0)
#define PG8_LDA(dst, b, h) do { _Pragma("unroll") for (int m = 0; m < 4; ++m) _Pragma("unroll") for (int k = 0; k < 2; ++k) dst[m][k] = *(const LAS bf16x8*)(lds + PG8_SA(b, h) + aoff + m * 2048 + k * 1024); } while (0)
#define PG8_LDB(dst, b, h) do { _Pragma("unroll") for (int n = 0; n < 2; ++n) _Pragma("unroll") for (int k = 0; k < 2; ++k) dst[n][k] = *(const LAS bf16x8*)(lds + PG8_SB(b, h) + boff + n * 2048 + k * 1024); } while (0)
#define PG8_MMA(ai, bj, At, Bt) do { __builtin_amdgcn_s_setprio(1); _Pragma("unroll") for (int m = 0; m < 4; ++m) _Pragma("unroll") for (int n = 0; n < 2; ++n) _Pragma("unroll") for (int k = 0; k < 2; ++k) \
        acc[ai][bj][m][n] = __builtin_amdgcn_mfma_f32_16x16x32_bf16(Bt[n][k], At[m][k], acc[ai][bj][m][n], 0, 0, 0); __builtin_amdgcn_s_setprio(0); } while (0)
#define PG8_WAIT_V(n) asm volatile("s_waitcnt vmcnt(" #n ")" ::: "memory")
#define PG8_WAIT_L(n) asm volatile("s_waitcnt lgkmcnt(" #n ")" ::: "memory")
#define PG8_BAR __builtin_amdgcn_s_barrier()
#define PG8_SCHED __builtin_amdgcn_sched_barrier(0)
    Unit cur, nxt; int ui = 0;
    if (!S.next(0, cur)) return;
    f32x4 acc[2][2][4][2];
#pragma unroll
    for (int a = 0; a < 2; ++a)
#pragma unroll
        for (int b = 0; b < 2; ++b)
#pragma unroll
            for (int m = 0; m < 4; ++m)
#pragma unroll
                for (int n = 0; n < 2; ++n) acc[a][b][m][n] = (f32x4){0.f, 0.f, 0.f, 0.f};
    bf16x8 At[4][2], B0[2][2], B1[2][2];
    unsigned vC[2][2], vN[2][2];
    if constexpr (Sched::GATHER) S.aoff(cur, tid, vC);
    const char* cA = S.abase(cur);
    const char* cB = S.bbase(cur);
    const char* nA = cA;
    PG8_STAGE(PG8_SB(0, 0), cB, voffB); PG8_STAGEA(PG8_SA(0, 0), 0, 0, false); PG8_STAGE(PG8_SB(0, 1), cB + hstepB, voffB); PG8_STAGEA(PG8_SA(0, 1), 1, 0, false);
    if (wr == 1) PG8_BAR;
    PG8_WAIT_V(4); PG8_BAR;
    PG8_STAGE(PG8_SB(1, 0), cB + kstep, voffB); PG8_STAGEA(PG8_SA(1, 0), 0, kstep, false); PG8_STAGE(PG8_SB(1, 1), cB + hstepB + kstep, voffB);
    PG8_WAIT_V(6); PG8_BAR;
    for (;;) {
        const bool has_next = S.next(ui + 1, nxt);
        const char* nB = cB; nA = cA;
        if (has_next) { nB = S.bbase(nxt); nA = S.abase(nxt); if constexpr (Sched::GATHER) S.aoff(nxt, tid, vN); }
        else { if constexpr (Sched::GATHER) {
#pragma unroll
            for (int h = 0; h < 2; ++h)
#pragma unroll
                for (int i = 0; i < 2; ++i) vN[h][i] = vC[h][i]; } }
        for (int t = 0; t < nt; t += 2) {
            const bool last = (t == nt - 2);
            const size_t k1 = (size_t)(t + 1) * kstep, k2 = last ? 0 : (size_t)(t + 2) * kstep, k3 = k2 + kstep;
            const char* b2 = last ? nB : cB + (size_t)(t + 2) * kstep; const char* b3 = b2 + kstep;
            PG8_LDB(B0, 0, 0); PG8_SCHED; PG8_LDA(At, 0, 0); PG8_STAGEA(PG8_SA(1, 1), 1, k1, false);
            PG8_WAIT_L(8); PG8_BAR; PG8_WAIT_L(0); PG8_MMA(0, 0, At, B0); PG8_BAR; PG8_SCHED;
            PG8_LDB(B1, 0, 1); PG8_STAGE(PG8_SB(0, 0), b2, voffB);
            PG8_BAR; PG8_WAIT_L(0); PG8_MMA(0, 1, At, B1); PG8_BAR;
            PG8_LDA(At, 0, 1); PG8_STAGEA(PG8_SA(0, 0), 0, k2, last);
            PG8_BAR; PG8_WAIT_L(0); PG8_MMA(1, 0, At, B0); PG8_BAR; PG8_SCHED;
            PG8_STAGE(PG8_SB(0, 1), b2 + hstepB, voffB);
            PG8_WAIT_V(6); PG8_BAR; PG8_MMA(1, 1, At, B1); PG8_BAR;
            PG8_LDB(B0, 1, 0); PG8_SCHED; PG8_LDA(At, 1, 0); PG8_STAGEA(PG8_SA(0, 1), 1, k2, last);
            PG8_WAIT_L(8); PG8_BAR; PG8_WAIT_L(0); PG8_MMA(0, 0, At, B0); PG8_BAR; PG8_SCHED;
            PG8_LDB(B1, 1, 1); PG8_STAGE(PG8_SB(1, 0), b3, voffB);
            PG8_BAR; PG8_WAIT_L(0); PG8_MMA(0, 1, At, B1); PG8_BAR;
            PG8_LDA(At, 1, 1); PG8_STAGEA(PG8_SA(1, 0), 0, k3, last);
            PG8_BAR; PG8_WAIT_L(0); PG8_MMA(1, 0, At, B0); PG8_BAR; PG8_SCHED;
            PG8_STAGE(PG8_SB(1, 1), b3 + hstepB, voffB);
            PG8_WAIT_V(6); PG8_BAR; PG8_MMA(1, 1, At, B1); PG8_BAR;
        }
        E(acc, cur, wr, wc, fr, fq);
        if (!has_next) break;
#pragma unroll
        for (int a = 0; a < 2; ++a)
#pragma unroll
            for (int b = 0; b < 2; ++b)
#pragma unroll
                for (int m = 0; m < 4; ++m)
#pragma unroll
                    for (int n = 0; n < 2; ++n) acc[a][b][m][n] = (f32x4){0.f, 0.f, 0.f, 0.f};
        cur = nxt; cB = nB; cA = nA; ++ui;
        if constexpr (Sched::GATHER) {
#pragma unroll
            for (int h = 0; h < 2; ++h)
#pragma unroll
                for (int i = 0; i < 2; ++i) vC[h][i] = vN[h][i]; }
    }
    PG8_WAIT_V(0);
    if (wr == 0) PG8_BAR;
    PG8_BAR;
#undef PG8_SA
#undef PG8_SB
#undef PG8_STAGE
#undef PG8_STAGEA
#undef PG8_LDA
#undef PG8_LDB
#undef PG8_MMA
#undef PG8_WAIT_V
#undef PG8_WAIT_L
#undef PG8_BAR
#undef PG8_SCHED
}

struct EpiStoreBf16 {
    static constexpr int PERM = 2;
    bf16_t* O; int ldc;
    __device__ __forceinline__ void operator()(const f32x4 (&acc)[2][2][4][2], const Unit& u, int wr, int wc, int fr, int fq) const {
        const int row0 = u.pm * BM + wr * 64 + fr, col0 = u.pn * BM + wc * 64 + 16 * fq;
#pragma unroll
        for (int ai = 0; ai < 2; ++ai)
#pragma unroll
            for (int m = 0; m < 4; ++m) { bf16_t* rowp = O + (size_t)(row0 + ai * HALF + m * 16) * ldc + col0;
#pragma unroll
                for (int bj = 0; bj < 2; ++bj) { const f32x4 v0 = acc[ai][bj][m][0], v1 = acc[ai][bj][m][1];
                    u32x4 w; w.x = cvt_pk_bf16(v0[0], v0[1]); w.y = cvt_pk_bf16(v0[2], v0[3]); w.z = cvt_pk_bf16(v1[0], v1[1]); w.w = cvt_pk_bf16(v1[2], v1[3]);
                    *(u32x4*)(rowp + bj * 8) = w; } }
    }
};
struct EpiResid {
    static constexpr int PERM = 0;
    float* X; const float* mods_l; int rbase;
    __device__ __forceinline__ void operator()(const f32x4 (&acc)[2][2][4][2], const Unit& u, int wr, int wc, int fr, int fq) const {
        const int row0 = u.pm * BM + wr * 64 + fr, col0 = u.pn * BM + wc * 32 + 4 * fq;
        const float* m2 = mods_l + (size_t)(slot_of_row(rbase + u.pm * BM) * 6 + 2) * DM + col0;
        float* xb = X + (size_t)row0 * DM + col0;
#pragma unroll
        for (int bj = 0; bj < 2; ++bj)
#pragma unroll
            for (int n = 0; n < 2; ++n) { const f32x4 mv = *(const f32x4*)(m2 + bj * HALF + n * 16);
                f32x4 xv[8];
#pragma unroll
                for (int q = 0; q < 8; ++q) xv[q] = *(const f32x4*)(xb + (size_t)((q >> 2) * HALF + (q & 3) * 16) * DM + bj * HALF + n * 16);
#pragma unroll
                for (int q = 0; q < 8; ++q) *(f32x4*)(xb + (size_t)((q >> 2) * HALF + (q & 3) * 16) * DM + bj * HALF + n * 16) = xv[q] * ALPHA + mv * acc[q >> 2][bj][q & 3][n];
                asm volatile("" ::: "memory"); }
    }
};
struct EpiSwiglu {
    static constexpr int PERM = 1;
    bf16_t* H;
    __device__ __forceinline__ void operator()(const f32x4 (&acc)[2][2][4][2], const Unit& u, int wr, int wc, int fr, int fq) const {
        const int row0 = u.pm * BM + wr * 64 + fr, col0 = u.pn * HALF + wc * 32 + 8 * fq;
#pragma unroll
        for (int ai = 0; ai < 2; ++ai)
#pragma unroll
            for (int m = 0; m < 4; ++m) { bf16_t* rowp = H + (size_t)(row0 + ai * HALF + m * 16) * 256 + col0;
                float h[8];
#pragma unroll
                for (int n = 0; n < 2; ++n)
#pragma unroll
                    for (int j = 0; j < 4; ++j) h[n * 4 + j] = siluf_(acc[ai][0][m][n][j]) * acc[ai][1][m][n][j];
                u32x4 w; w.x = cvt_pk_bf16(h[0], h[1]); w.y = cvt_pk_bf16(h[2], h[3]); w.z = cvt_pk_bf16(h[4], h[5]); w.w = cvt_pk_bf16(h[6], h[7]);
                *(u32x4*)rowp = w; }
    }
};
struct EpiDown {
    static constexpr int PERM = 2;
    unsigned char* Y; const float* sw; const LAS int* cnt;
    __device__ __forceinline__ void operator()(const f32x4 (&acc)[2][2][4][2], const Unit& u, int wr, int wc, int fr, int fq) const {
        const int row0 = u.pm * BM + wr * 64 + fr, col0 = u.pn * BM + wc * 64 + 16 * fq;
        const int ce = (u.e < 64) ? cnt[u.e] : 0;
        const float* swe = sw + (size_t)(u.e < 64 ? u.e : 0) * CAP + u.ti * 256 + wr * 64 + fr;
        unsigned char* yb = Y + (size_t)row0 * DM + col0;
        float wv[8];
#pragma unroll
        for (int q = 0; q < 8; ++q) { const int rl = (q >> 2) * HALF + (q & 3) * 16, pos = u.ti * 256 + wr * 64 + fr + rl; wv[q] = 32.0f; if (u.e < 64) wv[q] = (pos < ce) ? swe[rl] * 32.0f : 0.0f; }
#pragma unroll
        for (int ai = 0; ai < 2; ++ai)
#pragma unroll
            for (int m = 0; m < 4; ++m) { const int rl = ai * HALF + m * 16; const float w = wv[ai * 4 + m];
                u32x4 ww; unsigned pk[4];
#pragma unroll
                for (int bj = 0; bj < 2; ++bj)
#pragma unroll
                    for (int n = 0; n < 2; ++n) { f32x4 v = acc[ai][bj][m][n] * w;
#pragma unroll
                        for (int j = 0; j < 4; ++j) v[j] = __builtin_amdgcn_fmed3f(v[j], -440.0f, 440.0f);
                        int p = __builtin_amdgcn_cvt_pk_fp8_f32(v[0], v[1], 0, false); p = __builtin_amdgcn_cvt_pk_fp8_f32(v[2], v[3], p, true); pk[bj * 2 + n] = (unsigned)p; }
                ww.x = pk[0]; ww.y = pk[1]; ww.z = pk[2]; ww.w = pk[3];
                __builtin_nontemporal_store(ww, (u32x4*)(yb + (size_t)rl * DM));
                asm volatile("" ::: "memory"); }
    }
};
struct EpiNull {
    static constexpr int PERM = 1;
    __device__ __forceinline__ void operator()(const f32x4 (&acc)[2][2][4][2], const Unit&, int, int, int, int) const {
#pragma unroll
        for (int ai = 0; ai < 2; ++ai)
#pragma unroll
            for (int bj = 0; bj < 2; ++bj)
#pragma unroll
                for (int m = 0; m < 4; ++m)
#pragma unroll
                    for (int n = 0; n < 2; ++n) asm volatile("" :: "v"(acc[ai][bj][m][n]));
    }
};
template <int NPN> struct MoeOrder {
    const LAS int* cnt; const LAS int* tst; const LAS unsigned char* t2e; int ntiles, G, c;
    __device__ __forceinline__ bool next(int i, Unit& u) const {
        const int cs = ((G & 7) == 0) ? (c & 7) * (G >> 3) + (c >> 3) : c;
        const int L = i * G + cs; if (L >= ntiles * NPN) return false;
        const int tau = L / NPN; u.pm = tau; u.pn = L % NPN; u.e = t2e[tau]; u.ti = tau - tst[u.e]; return true;
    }
};
struct MoeGU : MoeOrder<2> {
    static constexpr bool GATHER = true;
    const char* A; const char* Bt; const int* stok; int t0;
    __device__ __forceinline__ const char* abase(const Unit&) const { return A; }
    __device__ __forceinline__ const char* bbase(const Unit& u) const { return Bt + ((size_t)u.e * 512 + (size_t)u.pn * 256) * 1024 * 2; }
    __device__ __forceinline__ void aoff(const Unit& u, int tid, unsigned (&off)[2][2]) const {
        const int ce = cnt[u.e];
#pragma unroll
        for (int i = 0; i < 2; ++i) { int R, C; stage_rc(tid * 16 + i * 8192, R, C);
#pragma unroll
            for (int h = 0; h < 2; ++h) { const int pos = u.ti * 256 + h * HALF + R; int tok;
                if (u.e == 64) tok = t0 + pos; else tok = (pos < ce) ? stok[(size_t)u.e * CAP + pos] : 0;
                off[h][i] = (unsigned)(tok * 1024 + C) * 2u; } }
    }
};
struct MoeDN : MoeOrder<4> {
    static constexpr bool GATHER = false;
    const char* A; const char* Bt;
    __device__ __forceinline__ const char* abase(const Unit& u) const { return A + (size_t)u.pm * BM * 256 * 2; }
    __device__ __forceinline__ const char* bbase(const Unit& u) const { return Bt + ((size_t)u.e * 1024 + (size_t)u.pn * 256) * 256 * 2; }
};
}

struct Args { const float* in[30]; float* out; unsigned char* ws; int ph_lo, ph_hi; };

struct Frame {
    float* out; unsigned char* ws; LAS unsigned char* lds; int tid, lane, wave, G, wg;
    float* mods; float* X; bf16_t* HB; bf16_t* MIX; unsigned char* WB; unsigned char* R1;
};

__device__ __forceinline__ const float* inp(const Frame& F, int i) {
    const unsigned long long v = ((const LAS unsigned long long*)(F.lds + LDS_MISC + MISC_INP))[i];
    const unsigned lo = (unsigned)__builtin_amdgcn_readfirstlane((int)(unsigned)v), hi = (unsigned)__builtin_amdgcn_readfirstlane((int)(unsigned)(v >> 32));
    return (const float*)(((unsigned long long)hi << 32) | lo);
}
__device__ __forceinline__ int lane_id_() { return (int)__builtin_amdgcn_mbcnt_hi(~0u, __builtin_amdgcn_mbcnt_lo(~0u, 0u)); }
__device__ __forceinline__ Frame fresh(const Frame& F0) { Frame F = F0; int ln = lane_id_(); asm volatile("" : "+v"(ln)); F.lane = ln; F.tid = F0.wave * 64 + ln; return F; }

__device__ __forceinline__ void ph_mods(const Frame& F) {
    const float* c = inp(F, 1); const float* cc = inp(F, 3); const float* ada_w = inp(F, 4); const float* ada_b = inp(F, 5);
    LAS float* sv = (LAS float*)F.lds;
    LAS float* red = (LAS float*)(F.lds + 5 * 1024 * 4);
    for (int i = F.tid; i < 5 * 1024; i += 512) { const int s = i >> 10, k = i & 1023; const float v = (s < 4) ? c[s * 1024 + k] : cc[k]; sv[i] = siluf_(v); }
    __syncthreads();
    for (int task = F.wg; task < 4 * 48; task += F.G) {
        const int l = task / 48, cc0 = (task % 48) * 128;
        const int cg = F.tid & 31, kg = F.tid >> 5;
        const float* w = ada_w + (size_t)l * 1024 * 6144 + cc0 + cg * 4;
        f32x4 acc[5];
#pragma unroll
        for (int s = 0; s < 5; ++s) acc[s] = (f32x4){0.f, 0.f, 0.f, 0.f};
#pragma unroll 8
        for (int kk = 0; kk < 64; ++kk) { const int k = kg * 64 + kk; const f32x4 wv = *(const f32x4*)(w + (size_t)k * 6144);
#pragma unroll
            for (int s = 0; s < 5; ++s) acc[s] += wv * sv[s * 1024 + k]; }
#pragma unroll
        for (int s = 0; s < 5; ++s)
#pragma unroll
            for (int q = 0; q < 4; ++q) red[((kg * 128) + cg * 4 + q) * 5 + s] = acc[s][q];
        __syncthreads();
        if (F.tid < 128) {
            const int col = cc0 + F.tid; const float bsv = ada_b[l * 6144 + col];
#pragma unroll
            for (int s = 0; s < 5; ++s) { float v = 0.f;
#pragma unroll
                for (int g2 = 0; g2 < 16; ++g2) v += red[((g2 * 128) + F.tid) * 5 + s];
                F.mods[(size_t)(l * 5 + s) * 6144 + col] = v + bsv; }
        }
        __syncthreads();
    }
    if (F.wg == F.G - 1) {
        const float* raw = inp(F, 11); float* lbt = (float*)(F.ws + OFF_LBT);
        for (int i = F.tid; i < 2 * 512; i += 512) { const int d = i >> 9, ch = i & 511; const float r0 = raw[(d * 2 + 0) * 512 + ch], r1 = raw[(d * 2 + 1) * 512 + ch];
            lbt[(0 * 2 + d) * 512 + ch] = 0.f; lbt[(1 * 2 + d) * 512 + ch] = sigmoidf_(r1 - r0); }
    }
}

__device__ __forceinline__ void ph_init_x(const Frame& F) {
    const float* x = inp(F, 0); const float* ctx = inp(F, 2);
    { const float* lg_ = inp(F, 6); const float* lb_ = inp(F, 7); float* AB = (float*)(F.ws + OFF_AB);
      for (int i = F.wg * 512 + F.tid; i < 4 * 5 * 1024; i += F.G * 512) { const int k = i & 1023, ls = i >> 10, l = ls / 5;
          const float* m = F.mods + (size_t)ls * 6144; const float g0 = lg_[(l * 2) * 1024 + k], b0 = lb_[(l * 2) * 1024 + k], m3 = m[3 * 1024 + k], m4 = m[4 * 1024 + k];
          AB[(size_t)ls * 2048 + k] = g0 * (1.0f + m4); AB[(size_t)ls * 2048 + 1024 + k] = b0 * (1.0f + m4) + m3; } }
    const int gw = F.wg * 8 + F.wave, nw = F.G * 8;
    for (int row = gw; row < TT; row += nw) {
        const float* src = row < TC ? ctx + (size_t)row * DM : x + (size_t)(row - TC) * DM;
        const float* m = F.mods + (size_t)(0 * 5 + slot_of_row(row)) * 6144;
#pragma unroll
        for (int hh = 0; hh < 2; ++hh) { const int k = hh * 512 + F.lane * 8;
            const f32x4 v0 = *(const f32x4*)(src + k), v1 = *(const f32x4*)(src + k + 4);
            *(f32x4*)(F.X + (size_t)row * DM + k) = v0; *(f32x4*)(F.X + (size_t)row * DM + k + 4) = v1;
            const f32x4 s0 = *(const f32x4*)(m + 1024 + k), s1 = *(const f32x4*)(m + 1024 + k + 4), b0 = *(const f32x4*)(m + k), b1 = *(const f32x4*)(m + k + 4);
            const f32x4 h0 = v0 * (s0 + 1.0f) + b0, h1 = v1 * (s1 + 1.0f) + b1;
            u32x4 w; w.x = cvt_pk_bf16(h0[0], h0[1]); w.y = cvt_pk_bf16(h0[2], h0[3]); w.z = cvt_pk_bf16(h1[0], h1[1]); w.w = cvt_pk_bf16(h1[2], h1[3]);
            *(u32x4*)(F.HB + (size_t)row * DM + k) = w; }
    }
}

__device__ __forceinline__ void cvt_tile(const Frame& F, const float* src, int sld, int k0, int n0, bf16_t* dst, int dld, int drow0, float scale) {
    LAS float* t = (LAS float*)F.lds;
    { const int i = F.tid >> 3, j0 = (F.tid & 7) * 8; const float* p = src + (size_t)(k0 + i) * sld + n0 + j0;
      const f32x4 a = *(const f32x4*)p, b = *(const f32x4*)(p + 4);
      LAS float* q = t + i * 65 + j0; q[0] = a[0]; q[1] = a[1]; q[2] = a[2]; q[3] = a[3]; q[4] = b[0]; q[5] = b[1]; q[6] = b[2]; q[7] = b[3]; }
    __syncthreads();
    { const int j = F.tid >> 3, i0 = (F.tid & 7) * 8; float v[8];
#pragma unroll
      for (int q = 0; q < 8; ++q) v[q] = t[(i0 + q) * 65 + j] * scale;
      u32x4 w; w.x = cvt_pk_bf16(v[0], v[1]); w.y = cvt_pk_bf16(v[2], v[3]); w.z = cvt_pk_bf16(v[4], v[5]); w.w = cvt_pk_bf16(v[6], v[7]);
      *(u32x4*)(dst + (size_t)(drow0 + j) * dld + k0 + i0) = w; }
    __syncthreads();
}
__device__ __forceinline__ void ph_convert(const Frame& F, int l) {
    const int j = l >> 1; const bool even = (l & 1) == 0;
    bf16_t* wIN = (bf16_t*)(F.WB + WB_IN); bf16_t* wOUT = (bf16_t*)(F.WB + WB_OUT); bf16_t* wRT = (bf16_t*)(F.WB + WB_RT);
    bf16_t* wGU = (bf16_t*)(F.WB + WB_GU); bf16_t* wDN = (bf16_t*)(F.WB + WB_DN); bf16_t* wLRU = (bf16_t*)(F.WB + WB_LRU);
    const int nIN = even ? 4096 : 2048;
    const int t_in = (nIN / 64) * 16, t_out = 256, t_rt = 16, t_gu = 65 * 2 * 64, t_dn = 65 * 64, t_lru = even ? 0 : 64;
    const int total = t_in + t_out + t_rt + t_gu + t_dn + t_lru;
    for (int task = F.wg; task < total; task += F.G) {
        int t = task;
        if (t < t_in) { const int nb = t >> 4, kb = t & 15; const float* src = even ? inp(F, 8) + (size_t)j * 1024 * 4096 : inp(F, 13) + (size_t)j * 1024 * 2048;
            cvt_tile(F, src, nIN, kb * 64, nb * 64, wIN, 1024, nb * 64, (even && nb < 8) ? 0.125f * 1.4426950408889634f : 1.0f); continue; }
        t -= t_in;
        if (t < t_out) { const int nb = t >> 4, kb = t & 15; const float* src = even ? inp(F, 9) + (size_t)j * 1024 * 1024 : inp(F, 21) + (size_t)j * 1024 * 1024;
            cvt_tile(F, src, 1024, kb * 64, nb * 64, wOUT, 1024, nb * 64, 1.0f); continue; }
        t -= t_out;
        if (t < t_rt) { cvt_tile(F, inp(F, 22) + (size_t)l * 1024 * 64, 64, t * 64, 0, wRT, 1024, 0, 1.0f); continue; }
        t -= t_rt;
        if (t < t_gu) { const int e = t / 128, r = t % 128, which = r >> 6, q = r & 63, nb = q >> 4, kb = q & 15;
            const float* src = (e < 64) ? (which ? inp(F, 25) : inp(F, 24)) + ((size_t)l * 64 + e) * 1024 * 256 : (which ? inp(F, 28) : inp(F, 27)) + (size_t)l * 1024 * 256;
            const int n0 = nb * 64, drow0 = (n0 >> 7) * 256 + which * 128 + (n0 & 127);
            cvt_tile(F, src, 256, kb * 64, n0, wGU + (size_t)e * 512 * 1024, 1024, drow0, 1.0f); continue; }
        t -= t_gu;
        if (t < t_dn) { const int e = t >> 6, q = t & 63, nb = q >> 2, kb = q & 3;
            const float* src = (e < 64) ? inp(F, 26) + ((size_t)l * 64 + e) * 256 * 1024 : inp(F, 29) + (size_t)l * 256 * 1024;
            cvt_tile(F, src, 1024, kb * 64, nb * 64, wDN + (size_t)e * 1024 * 256, 256, nb * 64, 1.0f); continue; }
        t -= t_dn;
        { const int d = t >> 5, gt = (t >> 4) & 1, kb = t & 15;
          const float* src = (gt ? inp(F, 18) : inp(F, 16)) + (((size_t)j * 2 + d) * 16 + kb) * 4096;
          cvt_tile(F, src, 64, 0, 0, wLRU + (((size_t)d * 2 + gt) * 16 + kb) * 4096, 64, 0, 1.0f); }
    }
}

__device__ __forceinline__ void ph_attn(const Frame& F, int j) {
    const bf16_t* P = (const bf16_t*)(F.R1 + R1_P);
    LAS bf16_t* Ks0 = (LAS bf16_t*)F.lds;
    LAS float* rp_l = (LAS float*)(F.lds + 36864);
    const float* rpb = inp(F, 10) + (size_t)j * 8 * 465;
    const int g = F.lane >> 4, l15 = F.lane & 15;
    const int NLAT = NBAT * 8 * 64, NTASK = NLAT + NBAT * 8 * 2;
    const int wgs = ((F.G & 7) == 0) ? (F.wg & 7) * (F.G >> 3) + (F.wg >> 3) : F.wg;
    int cidx[4][4];
    { const int wq_ = (F.wave & 3) * 16 + l15, c0_ = min(max(wq_ - 8, 0), 48);
#pragma unroll
      for (int kb = 0; kb < 4; ++kb)
#pragma unroll
          for (int i = 0; i < 4; ++i) { const int kc = kb * 16 + 4 * g + i; cidx[kb][i] = (kc >= c0_ && kc < c0_ + 16) ? (kc - wq_ + 15) : 31; } }
    for (int task = wgs; task < NTASK; task += F.G) {
        const bool lat = task < NLAT;
        int b, h, rp = 0, half = 0;
        if (lat) { b = task >> 9; h = (task >> 6) & 7; rp = task & 63; } else { const int t2 = task - NLAT; b = t2 >> 4; h = (t2 >> 1) & 7; half = t2 & 1; }
        const int myr = 2 * rp + (F.wave >> 2), w0 = (F.wave & 3) * 16;
        const int r0 = min(max(myr - 4, 0), 120);
        const int rlo = min(max(2 * rp - 4, 0), 120), rhi = min(max(2 * rp + 1 - 4, 0), 120) + 7;
        const int nloc = lat ? (rhi - rlo + 1) : 0;
        const int qrow = lat ? (TC + b * SEQ + myr * 64 + w0 + l15) : (b * CTXL + half * 128 + F.wave * 16 + l15);
        bf16x8 qf[2];
        qf[0] = *(const bf16x8*)(P + (size_t)qrow * 4096 + h * 64 + g * 8);
        qf[1] = *(const bf16x8*)(P + (size_t)qrow * 4096 + h * 64 + 32 + g * 8);
        if (lat) for (int i = F.tid; i < 480; i += 512) { const int rr = i >> 5, cc = i & 31; rp_l[i] = (cc < 31) ? rpb[h * 465 + rr * 31 + cc] * 1.4426950408889634f : -1e30f; }
        f32x4 oacc[4];
#pragma unroll
        for (int dt = 0; dt < 4; ++dt) oacc[dt] = (f32x4){0.f, 0.f, 0.f, 0.f};
        float mrun = -1e30f, lrun = 0.f;
        const int wq = w0 + l15, c0 = min(max(wq - 8, 0), 48);
        u32x4 kv, vv;
        { const int key = F.tid >> 3, ds = (F.tid & 7) * 8; const bool loc0 = 0 < nloc;
          const int krow = loc0 ? (TC + b * SEQ + rlo * 64 + key) : (b * CTXL + key);
          kv = *(const u32x4*)(P + (size_t)krow * 4096 + 512 + h * 64 + ds); vv = *(const u32x4*)(P + (size_t)krow * 4096 + 1024 + h * 64 + ds); }
#define ATT_STAGE(buf_, c_) do { const int key = F.tid >> 3, ds = (F.tid & 7) * 8; LAS bf16_t* Kd = Ks0 + (buf_) * 9216; LAS bf16_t* Vd = Kd + 4608; \
            *(LAS u32x4*)(Kd + key * 72 + ds) = kv; *(LAS u32x4*)(Vd + key * 72 + ds) = vv;     \
            if ((c_) + 1 < nloc + 4) { const bool locn = ((c_) + 1) < nloc; \
                const int krow = locn ? (TC + b * SEQ + (rlo + (c_) + 1) * 64 + key) : (b * CTXL + ((c_) + 1 - nloc) * 64 + key); \
                kv = *(const u32x4*)(P + (size_t)krow * 4096 + 512 + h * 64 + ds); vv = *(const u32x4*)(P + (size_t)krow * 4096 + 1024 + h * 64 + ds); } } while (0)
        __syncthreads();
        ATT_STAGE(0, 0);
        __syncthreads();
        for (int ch = 0; ch < nloc + 4; ++ch) {
            const bool loc = ch < nloc; const int kr = rlo + ch;
            if (ch + 1 < nloc + 4) ATT_STAGE((ch + 1) & 1, ch + 1);
            const LAS bf16_t* Ks = Ks0 + (ch & 1) * 9216; const LAS bf16_t* Vt = Ks + 4608;
            const bool mine = loc ? (kr >= r0 && kr < r0 + 8) : true;
            if (mine) {
                f32x4 s[4];
                const LAS float* rrow = rp_l + (loc ? (kr - myr + 7) * 32 : 0);
#pragma unroll
                for (int kb = 0; kb < 4; ++kb) {
                    if (loc) {
#pragma unroll
                        for (int i = 0; i < 4; ++i) s[kb][i] = rrow[cidx[kb][i]];
                    } else s[kb] = (f32x4){0.f, 0.f, 0.f, 0.f};
#pragma unroll
                    for (int ks = 0; ks < 2; ++ks) { const bf16x8 a = *(const LAS bf16x8*)(Ks + (kb * 16 + l15) * 72 + ks * 32 + g * 8);
                        s[kb] = __builtin_amdgcn_mfma_f32_16x16x32_bf16(a, qf[ks], s[kb], 0, 0, 0); } }
                float cm = -1e30f;
#pragma unroll
                for (int kb = 0; kb < 4; ++kb)
#pragma unroll
                    for (int i = 0; i < 4; ++i) cm = fmaxf(cm, s[kb][i]);
                cm = fmaxf(cm, __shfl_xor(cm, 16)); cm = fmaxf(cm, __shfl_xor(cm, 32));
                const float mn = fmaxf(mrun, cm), sc = __builtin_amdgcn_exp2f(mrun - mn);
                mrun = mn; lrun *= sc;
#pragma unroll
                for (int dt = 0; dt < 4; ++dt) oacc[dt] *= sc;
                float p[4][4];
#pragma unroll
                for (int kb = 0; kb < 4; ++kb)
#pragma unroll
                    for (int i = 0; i < 4; ++i) { p[kb][i] = __builtin_amdgcn_exp2f(s[kb][i] - mn); lrun += p[kb][i]; }
#pragma unroll
                for (int kp = 0; kp < 2; ++kp) {
                    u32x4 pw; pw.x = cvt_pk_bf16(p[2 * kp][0], p[2 * kp][1]); pw.y = cvt_pk_bf16(p[2 * kp][2], p[2 * kp][3]);
                    pw.z = cvt_pk_bf16(p[2 * kp + 1][0], p[2 * kp + 1][1]); pw.w = cvt_pk_bf16(p[2 * kp + 1][2], p[2 * kp + 1][3]);
                    bf16x8 pf; __builtin_memcpy(&pf, &pw, 16);
                    const unsigned va = (unsigned)(size_t)Vt + (unsigned)((32 * kp + 4 * g + (l15 >> 2)) * 144 + (l15 & 3) * 8);
                    u32x2 t0[4], t1[4];
                    asm volatile("ds_read_b64_tr_b16 %0, %8\n\tds_read_b64_tr_b16 %1, %8 offset:32\n\tds_read_b64_tr_b16 %2, %8 offset:64\n\tds_read_b64_tr_b16 %3, %8 offset:96\n\t"
                                 "ds_read_b64_tr_b16 %4, %8 offset:2304\n\tds_read_b64_tr_b16 %5, %8 offset:2336\n\tds_read_b64_tr_b16 %6, %8 offset:2368\n\tds_read_b64_tr_b16 %7, %8 offset:2400\n\ts_waitcnt lgkmcnt(0)"
                                 : "=&v"(t0[0]), "=&v"(t0[1]), "=&v"(t0[2]), "=&v"(t0[3]), "=&v"(t1[0]), "=&v"(t1[1]), "=&v"(t1[2]), "=&v"(t1[3]) : "v"(va) : "memory");
#pragma unroll
                    for (int dt = 0; dt < 4; ++dt) {
                        u32x4 vw; vw.x = t0[dt].x; vw.y = t0[dt].y; vw.z = t1[dt].x; vw.w = t1[dt].y; bf16x8 vf; __builtin_memcpy(&vf, &vw, 16);
                        oacc[dt] = __builtin_amdgcn_mfma_f32_16x16x32_bf16(vf, pf, oacc[dt], 0, 0, 0);
                    }
                }
            }
            __syncthreads();
        }
#undef ATT_STAGE
        float lt = lrun; lt += __shfl_xor(lt, 16); lt += __shfl_xor(lt, 32);
        const float inv = 1.0f / lt;
#pragma unroll
        for (int dt = 0; dt < 4; ++dt) { const f32x4 o = oacc[dt] * inv; u32x2 w; w.x = cvt_pk_bf16(o[0], o[1]); w.y = cvt_pk_bf16(o[2], o[3]);
            *(u32x2*)(F.MIX + (size_t)qrow * DM + h * 64 + dt * 16 + 4 * g) = w; }
        __syncthreads();
    }
}

__device__ __forceinline__ int hg_unit(int nb, int dir) { return dir == 0 ? nb : (nb < 2 ? 1 - nb : 2 + (HG_NU - 3 - (nb - 2))); }
__device__ __forceinline__ int hg_row(int b, int nb, int t) { return nb < 2 ? b * CTXL + nb * HG_U + t : TC + b * SEQ + (nb - 2) * HG_U + t; }
template <int CTRL> __device__ __forceinline__ float dpp_add0(float x) { return x + dppf<CTRL>(0.0f, x); }
#define ROW_ALLREDUCE4(v0, v1, v2, v3) asm volatile("s_nop 1\n\t" \
    "v_add_f32_dpp %0, %0, %0 quad_perm:[1,0,3,2] row_mask:0xf bank_mask:0xf\n\tv_add_f32_dpp %1, %1, %1 quad_perm:[1,0,3,2] row_mask:0xf bank_mask:0xf\n\t" \
    "v_add_f32_dpp %2, %2, %2 quad_perm:[1,0,3,2] row_mask:0xf bank_mask:0xf\n\tv_add_f32_dpp %3, %3, %3 quad_perm:[1,0,3,2] row_mask:0xf bank_mask:0xf\n\t" \
    "v_add_f32_dpp %0, %0, %0 quad_perm:[2,3,0,1] row_mask:0xf bank_mask:0xf\n\tv_add_f32_dpp %1, %1, %1 quad_perm:[2,3,0,1] row_mask:0xf bank_mask:0xf\n\t" \
    "v_add_f32_dpp %2, %2, %2 quad_perm:[2,3,0,1] row_mask:0xf bank_mask:0xf\n\tv_add_f32_dpp %3, %3, %3 quad_perm:[2,3,0,1] row_mask:0xf bank_mask:0xf\n\t" \
    "v_add_f32_dpp %0, %0, %0 row_half_mirror row_mask:0xf bank_mask:0xf\n\tv_add_f32_dpp %1, %1, %1 row_half_mirror row_mask:0xf bank_mask:0xf\n\t" \
    "v_add_f32_dpp %2, %2, %2 row_half_mirror row_mask:0xf bank_mask:0xf\n\tv_add_f32_dpp %3, %3, %3 row_half_mirror row_mask:0xf bank_mask:0xf\n\t" \
    "v_add_f32_dpp %0, %0, %0 row_mirror row_mask:0xf bank_mask:0xf\n\tv_add_f32_dpp %1, %1, %1 row_mirror row_mask:0xf bank_mask:0xf\n\t" \
    "v_add_f32_dpp %2, %2, %2 row_mirror row_mask:0xf bank_mask:0xf\n\tv_add_f32_dpp %3, %3, %3 row_mirror row_mask:0xf bank_mask:0xf" \
    : "+v"(v0), "+v"(v1), "+v"(v2), "+v"(v3))
template <bool WITHO>
__device__ __forceinline__ void hg_pass(const Frame& F, const bf16_t* P, const float* lbh, int b, int h, int nb, int dir, f32x4 (&S)[4][4], float (&Gsum)[16],
                                        LAS bf16_t* Vl, LAS bf16_t* Kl, float* OF, const float* ngp) {
    const int tau = F.lane & 15, g = F.lane >> 4;
    const unsigned vaddr = (unsigned)(size_t)Vl + (unsigned)((4 * g + (tau >> 2)) * 128 + (tau & 3) * 8);
    const unsigned kaddr = (unsigned)(size_t)Kl + (unsigned)((4 * g + (tau >> 2)) * 128 + (tau & 3) * 8);
    u32x2 zr[4], vr[4], qr[4];
    { const int t = dir ? (HG_U - 1 - tau) : tau; const bf16_t* pr = P + (size_t)hg_row(b, nb, t) * 4096 + h * 64 + 4 * g;
#pragma unroll
      for (int m = 0; m < 4; ++m) { zr[m] = *(const u32x2*)(pr + (dir ? 2560 : 2048) + 16 * m); vr[m] = *(const u32x2*)(pr + 3072 + 16 * m); } }
    for (int ci = 0; ci < HG_U / 16; ++ci) {
        float kk[16], c[16];
        if (WITHO) { const int pos = ci * 16 + tau, t = dir ? (HG_U - 1 - pos) : pos; const bf16_t* pr = P + (size_t)hg_row(b, nb, t) * 4096 + h * 64 + 4 * g;
#pragma unroll
            for (int m = 0; m < 4; ++m) qr[m] = *(const u32x2*)(pr + 1536 + 16 * m); }
#pragma unroll
        for (int m = 0; m < 4; ++m) { const float z0 = __uint_as_float(zr[m].x << 16), z1 = __uint_as_float(zr[m].x & 0xffff0000u), z2 = __uint_as_float(zr[m].y << 16), z3 = __uint_as_float(zr[m].y & 0xffff0000u);
            const float zz[4] = {z0, z1, z2, z3};
            const f32x4 lb4 = *(const f32x4*)(lbh + 16 * m + 4 * g);
#pragma unroll
            for (int i = 0; i < 4; ++i) { const float lb = lb4[i]; const float f = fmaxf(lb + (1.0f - lb) * sigmoidf_(zz[i]), 1e-30f); kk[m * 4 + i] = 1.0f - f; c[m * 4 + i] = __logf(f); }
            *(LAS u32x2*)(Vl + tau * 64 + 16 * m + 4 * g) = vr[m];
 }
        if (ci + 1 < HG_U / 16) { const int pos = (ci + 1) * 16 + tau, t = dir ? (HG_U - 1 - pos) : pos; const bf16_t* pr = P + (size_t)hg_row(b, nb, t) * 4096 + h * 64 + 4 * g;
#pragma unroll
            for (int m = 0; m < 4; ++m) { zr[m] = *(const u32x2*)(pr + (dir ? 2560 : 2048) + 16 * m); vr[m] = *(const u32x2*)(pr + 3072 + 16 * m); } }
        float G[16];
#pragma unroll
        for (int q = 0; q < 16; ++q) G[q] = c[q];
#pragma unroll
        for (int q = 0; q < 16; q += 4) ROW_ALLREDUCE4(G[q], G[q + 1], G[q + 2], G[q + 3]);
#pragma unroll
        for (int q = 0; q < 16; ++q) { c[q] = dpp_add0<0x111>(c[q]); c[q] = dpp_add0<0x112>(c[q]); c[q] = dpp_add0<0x114>(c[q]); c[q] = dpp_add0<0x118>(c[q]); }
#pragma unroll
        for (int q = 0; q < 16; ++q) Gsum[q] += G[q];
#pragma unroll
        for (int m = 0; m < 4; ++m) { float kh[4];
#pragma unroll
            for (int i = 0; i < 4; ++i) kh[i] = kk[m * 4 + i] * __expf(G[m * 4 + i] - c[m * 4 + i]);
            u32x2 w; w.x = cvt_pk_bf16(kh[0], kh[1]); w.y = cvt_pk_bf16(kh[2], kh[3]);
            *(LAS u32x2*)(Kl + tau * 64 + 16 * m + 4 * g) = w; }
        float ofv[4][4], gtv[4][4]; int orow[4];
        if (WITHO) {
#pragma unroll
            for (int i = 0; i < 4; ++i) { const int p2 = ci * 16 + 4 * g + i, t2 = dir ? (HG_U - 1 - p2) : p2; orow[i] = hg_row(b, nb, t2); }
            if (dir) {
#pragma unroll
                for (int i = 0; i < 4; ++i)
#pragma unroll
                    for (int vt = 0; vt < 4; ++vt) { ofv[i][vt] = OF[(size_t)orow[i] * 512 + h * 64 + 16 * vt + tau]; gtv[i][vt] = bf2f(P[(size_t)orow[i] * 4096 + 3584 + h * 64 + 16 * vt + tau]); }
            }
        }
        asm volatile("s_waitcnt lgkmcnt(0)" ::: "memory");
        u32x2 vtr[4], ktr[4];
        asm volatile("ds_read_b64_tr_b16 %0, %8\n\tds_read_b64_tr_b16 %1, %8 offset:32\n\tds_read_b64_tr_b16 %2, %8 offset:64\n\tds_read_b64_tr_b16 %3, %8 offset:96\n\t"
                     "ds_read_b64_tr_b16 %4, %9\n\tds_read_b64_tr_b16 %5, %9 offset:32\n\tds_read_b64_tr_b16 %6, %9 offset:64\n\tds_read_b64_tr_b16 %7, %9 offset:96\n\ts_waitcnt lgkmcnt(0)"
                     : "=&v"(vtr[0]), "=&v"(vtr[1]), "=&v"(vtr[2]), "=&v"(vtr[3]), "=&v"(ktr[0]), "=&v"(ktr[1]), "=&v"(ktr[2]), "=&v"(ktr[3]) : "v"(vaddr), "v"(kaddr) : "memory");
        bf16x8 Vf[4], Kf[4];
#pragma unroll
        for (int q = 0; q < 4; ++q) { u32x4 w; w.x = vtr[q].x; w.y = vtr[q].y; w.z = 0u; w.w = 0u; __builtin_memcpy(&Vf[q], &w, 16); u32x4 w2; w2.x = ktr[q].x; w2.y = ktr[q].y; w2.z = 0u; w2.w = 0u; __builtin_memcpy(&Kf[q], &w2, 16); }
        if (WITHO) {
            bf16x8 Ktf[2], Qtf[2], Qhf[2];
#pragma unroll
            for (int ks = 0; ks < 2; ++ks) { float kt_[8], qt_[8], qh_[8];
#pragma unroll
                for (int mm = 0; mm < 2; ++mm) { const int m = 2 * ks + mm;
                    const float qq[4] = {__uint_as_float(qr[m].x << 16), __uint_as_float(qr[m].x & 0xffff0000u), __uint_as_float(qr[m].y << 16), __uint_as_float(qr[m].y & 0xffff0000u)};
#pragma unroll
                    for (int i = 0; i < 4; ++i) { const int q = m * 4 + i; const float qv = siluf_(qq[i]) * 0.125f; const float d = fminf(fmaxf(c[q] - 0.5f * G[q], -80.0f), 80.0f);
                        qt_[mm * 4 + i] = qv * __expf(d); kt_[mm * 4 + i] = kk[q] * __expf(-d); qh_[mm * 4 + i] = qv * __expf(c[q]); } }
                u32x4 w; w.x = cvt_pk_bf16(kt_[0], kt_[1]); w.y = cvt_pk_bf16(kt_[2], kt_[3]); w.z = cvt_pk_bf16(kt_[4], kt_[5]); w.w = cvt_pk_bf16(kt_[6], kt_[7]); __builtin_memcpy(&Ktf[ks], &w, 16);
                w.x = cvt_pk_bf16(qt_[0], qt_[1]); w.y = cvt_pk_bf16(qt_[2], qt_[3]); w.z = cvt_pk_bf16(qt_[4], qt_[5]); w.w = cvt_pk_bf16(qt_[6], qt_[7]); __builtin_memcpy(&Qtf[ks], &w, 16);
                w.x = cvt_pk_bf16(qh_[0], qh_[1]); w.y = cvt_pk_bf16(qh_[2], qh_[3]); w.z = cvt_pk_bf16(qh_[4], qh_[5]); w.w = cvt_pk_bf16(qh_[6], qh_[7]); __builtin_memcpy(&Qhf[ks], &w, 16); }
            f32x4 AT = (f32x4){0.f, 0.f, 0.f, 0.f};
            AT = __builtin_amdgcn_mfma_f32_16x16x32_bf16(Ktf[0], Qtf[0], AT, 0, 0, 0); AT = __builtin_amdgcn_mfma_f32_16x16x32_bf16(Ktf[1], Qtf[1], AT, 0, 0, 0);
#pragma unroll
            for (int i = 0; i < 4; ++i) AT[i] = (4 * g + i <= tau) ? AT[i] : 0.0f;
            bf16x8 Af; { u32x4 w; w.x = cvt_pk_bf16(AT[0], AT[1]); w.y = cvt_pk_bf16(AT[2], AT[3]); w.z = 0u; w.w = 0u; __builtin_memcpy(&Af, &w, 16); }
            f32x4 o[4];
#pragma unroll
            for (int vt = 0; vt < 4; ++vt) { o[vt] = __builtin_amdgcn_mfma_f32_16x16x32_bf16(Af, Vf[vt], (f32x4){0.f, 0.f, 0.f, 0.f}, 0, 0, 0);
#pragma unroll
                for (int ks = 0; ks < 2; ++ks) { u32x4 w; w.x = cvt_pk_bf16(S[2 * ks][vt][0], S[2 * ks][vt][1]); w.y = cvt_pk_bf16(S[2 * ks][vt][2], S[2 * ks][vt][3]);
                    w.z = cvt_pk_bf16(S[2 * ks + 1][vt][0], S[2 * ks + 1][vt][1]); w.w = cvt_pk_bf16(S[2 * ks + 1][vt][2], S[2 * ks + 1][vt][3]); bf16x8 Sf; __builtin_memcpy(&Sf, &w, 16);
                    o[vt] = __builtin_amdgcn_mfma_f32_16x16x32_bf16(Qhf[ks], Sf, o[vt], 0, 0, 0); } }
            if (dir == 0) {
#pragma unroll
                for (int i = 0; i < 4; ++i)
#pragma unroll
                    for (int vt = 0; vt < 4; ++vt) OF[(size_t)orow[i] * 512 + h * 64 + 16 * vt + tau] = o[vt][i];
            } else {
                { float tot[4][4], sq[4];
#pragma unroll
                for (int i = 0; i < 4; ++i) { sq[i] = 0.f;
#pragma unroll
                    for (int vt = 0; vt < 4; ++vt) { tot[i][vt] = o[vt][i] + ofv[i][vt]; sq[i] = fmaf(tot[i][vt], tot[i][vt], sq[i]); } }
                ROW_ALLREDUCE4(sq[0], sq[1], sq[2], sq[3]);
#pragma unroll
                for (int i = 0; i < 4; ++i) { const float rs = rsqrtf(sq[i] * (1.0f / 64.0f) + 1e-6f);
#pragma unroll
                    for (int vt = 0; vt < 4; ++vt) F.MIX[(size_t)orow[i] * DM + 512 + h * 64 + 16 * vt + tau] = f2bf(tot[i][vt] * rs * ngp[16 * vt + tau] * siluf_(gtv[i][vt])); } }
            }
        }
#pragma unroll
        for (int kt = 0; kt < 4; ++kt) { f32x4 eg;
#pragma unroll
            for (int i = 0; i < 4; ++i) eg[i] = __expf(G[kt * 4 + i]);
#pragma unroll
            for (int vt = 0; vt < 4; ++vt) S[kt][vt] = __builtin_amdgcn_mfma_f32_16x16x32_bf16(Kf[kt], Vf[vt], S[kt][vt] * eg, 0, 0, 0); }
    }
}
__device__ __forceinline__ void ph_hg_a(const Frame& F, int j) {
    const bf16_t* P = (const bf16_t*)(F.R1 + R1_P);
    float* SLOC = (float*)(F.R1 + R1_SLOC); float* DL = (float*)(F.R1 + R1_DL);
    LAS bf16_t* Vl = (LAS bf16_t*)(F.lds + 32768 + F.wave * 4096); LAS bf16_t* Kl = Vl + 1024;
    const int gw = F.wg * 8 + F.wave, nw = F.G * 8;
    const int NT = NBAT * 8 * (HG_NU - 2) * 2;
    for (int task = gw; task < NT; task += nw) {
        const int dir = task & 1, nb = 2 + (task >> 1) % (HG_NU - 2), bh = (task >> 1) / (HG_NU - 2), b = bh >> 3, h = bh & 7;
        const float* lbh = (const float*)(F.ws + OFF_LBT) + (j * 2 + dir) * 512 + h * 64;
        f32x4 S[4][4];
#pragma unroll
        for (int kt = 0; kt < 4; ++kt)
#pragma unroll
            for (int vt = 0; vt < 4; ++vt) S[kt][vt] = (f32x4){0.f, 0.f, 0.f, 0.f};
        float Gsum[16];
#pragma unroll
        for (int q = 0; q < 16; ++q) Gsum[q] = 0.f;
        hg_pass<false>(F, P, lbh, b, h, nb, dir, S, Gsum, Vl, Kl, nullptr, nullptr);
        const int seq = bh * 2 + dir, u = hg_unit(nb, dir);
        float* so = SLOC + ((size_t)seq * HG_NU + u) * 4096;
#pragma unroll
        for (int kt = 0; kt < 4; ++kt)
#pragma unroll
            for (int vt = 0; vt < 4; ++vt)
#pragma unroll
                for (int i = 0; i < 4; ++i) so[((kt * 4 + vt) * 4 + i) * 64 + F.lane] = S[kt][vt][i];
        if ((F.lane & 15) == 0) { float* dd = DL + ((size_t)seq * HG_NU + u) * 64;
#pragma unroll
            for (int m = 0; m < 4; ++m)
#pragma unroll
                for (int i = 0; i < 4; ++i) dd[16 * m + 4 * (F.lane >> 4) + i] = __expf(Gsum[m * 4 + i]); }
    }
}
__device__ __forceinline__ void ph_hg_b(const Frame& F) {
    const float* SLOC = (const float*)(F.R1 + R1_SLOC); const float* DL = (const float*)(F.R1 + R1_DL); float* SST = (float*)(F.R1 + R1_SST);
    for (int idx = F.wg * 512 + F.tid; idx < 64 * 4096; idx += F.G * 512) {
        const int seq = idx >> 12, e = idx & 4095, ln = e & 63, reg = e >> 6, i = reg & 3, kt = reg >> 4, k = 16 * kt + 4 * (ln >> 4) + i;
        float s = 0.f;
#pragma unroll 6
        for (int u = 0; u < HG_NU; ++u) { const size_t o = ((size_t)seq * HG_NU + u) * 4096 + e; SST[o] = s; s = DL[((size_t)seq * HG_NU + u) * 64 + k] * s + SLOC[o]; }
    }
}
__device__ __forceinline__ void ph_hg_c(const Frame& F, int j) {
    const bf16_t* P = (const bf16_t*)(F.R1 + R1_P);
    const float* SST = (const float*)(F.R1 + R1_SST); float* OF = (float*)(F.R1 + R1_OF);
    const float* ng = inp(F, 12) + j * 64;
    LAS bf16_t* Vl = (LAS bf16_t*)(F.lds + 32768 + F.wave * 4096); LAS bf16_t* Kl = Vl + 1024;
    const int gw = F.wg * 8 + F.wave, nw = F.G * 8;
    const int NT = NBAT * 8 * (HG_NU - 2);
    for (int task = gw; task < NT; task += nw) {
        const int nb = 2 + task % (HG_NU - 2), bh = task / (HG_NU - 2), b = bh >> 3, h = bh & 7;
        for (int dir = 0; dir < 2; ++dir) {
            const float* lbh = (const float*)(F.ws + OFF_LBT) + (j * 2 + dir) * 512 + h * 64;
            const int seq = bh * 2 + dir, u = hg_unit(nb, dir);
            const float* ss = SST + ((size_t)seq * HG_NU + u) * 4096;
            f32x4 S[4][4];
#pragma unroll
            for (int kt = 0; kt < 4; ++kt)
#pragma unroll
                for (int vt = 0; vt < 4; ++vt)
#pragma unroll
                    for (int i = 0; i < 4; ++i) S[kt][vt][i] = ss[((kt * 4 + vt) * 4 + i) * 64 + F.lane];
            float Gsum[16];
#pragma unroll
            for (int q = 0; q < 16; ++q) Gsum[q] = 0.f;
            hg_pass<true>(F, P, lbh, b, h, nb, dir, S, Gsum, Vl, Kl, OF, ng);
            asm volatile("s_waitcnt vmcnt(0)" ::: "memory");
        }
    }
}

__device__ __forceinline__ void ph_hg_ctx(const Frame& F, int j) {
    if (F.wave >= 4) return;
    const bf16_t* P = (const bf16_t*)(F.R1 + R1_P);
    float* SLOC = (float*)(F.R1 + R1_SLOC); float* DL = (float*)(F.R1 + R1_DL); float* OF = (float*)(F.R1 + R1_OF);
    const float* ng = inp(F, 12) + j * 64;
    LAS bf16_t* Vl = (LAS bf16_t*)(F.lds + 32768 + F.wave * 4096); LAS bf16_t* Kl = Vl + 1024;
    const int bh = F.wg * 4 + F.wave, b = bh >> 3, h = bh & 7;
    for (int dir = 0; dir < 2; ++dir) {
        const float* lbh = (const float*)(F.ws + OFF_LBT) + (j * 2 + dir) * 512 + h * 64;
        const int seq = bh * 2 + dir;
        f32x4 S[4][4];
#pragma unroll
        for (int kt = 0; kt < 4; ++kt)
#pragma unroll
            for (int vt = 0; vt < 4; ++vt) S[kt][vt] = (f32x4){0.f, 0.f, 0.f, 0.f};
        for (int u = 0; u < 2; ++u) {
            const int nb = dir ? 1 - u : u;
            float Gsum[16];
#pragma unroll
            for (int q = 0; q < 16; ++q) Gsum[q] = 0.f;
            hg_pass<true>(F, P, lbh, b, h, nb, dir, S, Gsum, Vl, Kl, OF, ng);
            float* so = SLOC + ((size_t)seq * HG_NU + u) * 4096;
#pragma unroll
            for (int kt = 0; kt < 4; ++kt)
#pragma unroll
                for (int vt = 0; vt < 4; ++vt)
#pragma unroll
                    for (int i = 0; i < 4; ++i) so[((kt * 4 + vt) * 4 + i) * 64 + F.lane] = S[kt][vt][i];
            if ((F.lane & 15) == 0) { float* dd = DL + ((size_t)seq * HG_NU + u) * 64;
#pragma unroll
                for (int q = 0; q < 16; ++q) dd[16 * (q >> 2) + 4 * (F.lane >> 4) + (q & 3)] = 0.0f; }
        }
        asm volatile("s_waitcnt vmcnt(0)" ::: "memory");
    }
}

__device__ __forceinline__ int lru_nat(int so, int dir) { return dir == 0 ? so : (so < 16 ? 15 - so : 16 + (LRU_NT - 1 - so)); }
__device__ __forceinline__ int lru_row(int b, int nt, int t) { return nt < 16 ? b * CTXL + nt * 16 + t : TC + b * SEQ + (nt - 16) * 16 + t; }
struct LruRaw { u32x4 a[4], b[4]; };
__device__ __forceinline__ void lru_load(const Frame& F, int b, int kb, int nt, LruRaw& R) {
    const bf16_t* P = (const bf16_t*)(F.R1 + R1_P);
    const int tk = F.lane & 15, g = F.lane >> 4;
    const int len = nt < 16 ? CTXL : SEQ, tpos = (nt < 16 ? nt * 16 : (nt - 16) * 16) + tk;
    const bf16_t* pbase = P + (size_t)((nt < 16 ? b * CTXL : TC + b * SEQ)) * 2048 + 1024 + kb * 64 + g * 16;
#pragma unroll
    for (int tap = 0; tap < 4; ++tap) { const int tp = tpos + tap - 2; const bool ok = (tp >= 0 && tp < len); const bf16_t* pr = pbase + (size_t)(ok ? tp : tpos) * 2048;
        R.a[tap] = *(const u32x4*)pr; R.b[tap] = *(const u32x4*)(pr + 8); if (!ok) { R.a[tap] = (u32x4){0u, 0u, 0u, 0u}; R.b[tap] = (u32x4){0u, 0u, 0u, 0u}; } }
}
__device__ __forceinline__ void lru_conv(const Frame& F, const LruRaw& R, const LAS float* CT, LAS float* ucb) {
    const int tk = F.lane & 15, g = F.lane >> 4;
    float acc[16];
#pragma unroll
    for (int q = 0; q < 4; ++q) { const f32x4 c4 = *(const LAS f32x4*)(CT + 4 * 64 + g * 16 + q * 4); acc[q * 4] = c4[0]; acc[q * 4 + 1] = c4[1]; acc[q * 4 + 2] = c4[2]; acc[q * 4 + 3] = c4[3]; }
#pragma unroll
    for (int tap = 0; tap < 4; ++tap) { float t0[8], t1[8]; unpack8(R.a[tap], t0); unpack8(R.b[tap], t1);
#pragma unroll
        for (int q = 0; q < 2; ++q) { const f32x4 w0 = *(const LAS f32x4*)(CT + tap * 64 + g * 16 + q * 4), w1 = *(const LAS f32x4*)(CT + tap * 64 + g * 16 + 8 + q * 4);
#pragma unroll
            for (int i = 0; i < 4; ++i) { acc[q * 4 + i] = fmaf(w0[i], t0[q * 4 + i], acc[q * 4 + i]); acc[8 + q * 4 + i] = fmaf(w1[i], t1[q * 4 + i], acc[8 + q * 4 + i]); } } }
#pragma unroll
    for (int q = 0; q < 4; ++q) *(LAS f32x4*)(ucb + tk * 68 + g * 16 + q * 4) = (f32x4){acc[q * 4], acc[q * 4 + 1], acc[q * 4 + 2], acc[q * 4 + 3]};
}
__device__ __forceinline__ void lru_gates(const Frame& F, LAS bf16_t* Wl, const LAS float* CT, LAS float* ucb, float (&av)[2][4][4], float (&xv)[2][4][4]) {
    const int tk = F.lane & 15, g = F.lane >> 4;
    bf16x8 bfr[2];
#pragma unroll
    for (int ks = 0; ks < 2; ++ks) { const f32x4 u0 = *(const LAS f32x4*)(ucb + tk * 68 + ks * 32 + g * 8), u1 = *(const LAS f32x4*)(ucb + tk * 68 + ks * 32 + g * 8 + 4);
        u32x4 w; w.x = cvt_pk_bf16(u0[0], u0[1]); w.y = cvt_pk_bf16(u0[2], u0[3]); w.z = cvt_pk_bf16(u1[0], u1[1]); w.w = cvt_pk_bf16(u1[2], u1[3]); __builtin_memcpy(&bfr[ks], &w, 16); }
#pragma unroll
    for (int d = 0; d < 2; ++d)
#pragma unroll
        for (int et = 0; et < 4; ++et) {
            f32x4 ra = (f32x4){0.f, 0.f, 0.f, 0.f}, ri = (f32x4){0.f, 0.f, 0.f, 0.f};
#pragma unroll
            for (int ks = 0; ks < 2; ++ks) {
                const bf16x8 wa = *(const LAS bf16x8*)(Wl + ((d * 2 + 0) * 64 + et * 16 + tk) * 72 + ks * 32 + g * 8);
                const bf16x8 wx = *(const LAS bf16x8*)(Wl + ((d * 2 + 1) * 64 + et * 16 + tk) * 72 + ks * 32 + g * 8);
                ra = __builtin_amdgcn_mfma_f32_16x16x32_bf16(wa, bfr[ks], ra, 0, 0, 0);
                ri = __builtin_amdgcn_mfma_f32_16x16x32_bf16(wx, bfr[ks], ri, 0, 0, 0);
            }
            const f32x4 ba4 = *(const LAS f32x4*)(CT + (5 + 3 * d) * 64 + et * 16 + 4 * g), bx4 = *(const LAS f32x4*)(CT + (6 + 3 * d) * 64 + et * 16 + 4 * g), cs4 = *(const LAS f32x4*)(CT + (7 + 3 * d) * 64 + et * 16 + 4 * g);
            const f32x4 u4 = *(const LAS f32x4*)(ucb + tk * 68 + et * 16 + 4 * g);
#pragma unroll
            for (int i = 0; i < 4; ++i) {
                const float r = sigmoidf_(ra[i] + ba4[i]), ig = sigmoidf_(ri[i] + bx4[i]);
                const float la = cs4[i] * r, a = __expf(la);
                av[d][et][i] = la; xv[d][et][i] = __builtin_amdgcn_sqrtf(fmaxf(1.0f - a * a, 0.f)) * ig * u4[i]; }
        }
}
template <int S> __device__ __forceinline__ void lru_step_f(float& a, float& x) { const float ap = dppf<0x110 + S>(1.0f, a), xp = dppf<0x110 + S>(0.0f, x); x = fmaf(a, xp, x); a = a * ap; }
template <int S> __device__ __forceinline__ void lru_step_b(float& a, float& x) { const float ap = dppf<0x100 + S>(1.0f, a), xp = dppf<0x100 + S>(0.0f, x); x = fmaf(a, xp, x); a = a * ap; }
#define LRU_DPP_STEP(SH, x_, a_) asm volatile("s_nop 1\n\t" \
    "v_fmac_f32_dpp %0, %0, %4 " SH " row_mask:0xf bank_mask:0xf\n\tv_fmac_f32_dpp %1, %1, %5 " SH " row_mask:0xf bank_mask:0xf\n\t" \
    "v_fmac_f32_dpp %2, %2, %6 " SH " row_mask:0xf bank_mask:0xf\n\tv_fmac_f32_dpp %3, %3, %7 " SH " row_mask:0xf bank_mask:0xf\n\t" \
    "v_mul_f32_dpp %4, %4, %4 " SH " row_mask:0xf bank_mask:0xf\n\tv_mul_f32_dpp %5, %5, %5 " SH " row_mask:0xf bank_mask:0xf\n\t" \
    "v_mul_f32_dpp %6, %6, %6 " SH " row_mask:0xf bank_mask:0xf\n\tv_mul_f32_dpp %7, %7, %7 " SH " row_mask:0xf bank_mask:0xf" \
    : "+v"(x_[0]), "+v"(x_[1]), "+v"(x_[2]), "+v"(x_[3]), "+v"(a_[0]), "+v"(a_[1]), "+v"(a_[2]), "+v"(a_[3]))
#define LRU_SCANS(av, xv) do { _Pragma("unroll") for (int et = 0; et < 4; ++et) { \
        LRU_DPP_STEP("row_shr:1", xv[0][et], av[0][et]); LRU_DPP_STEP("row_shl:1", xv[1][et], av[1][et]); } \
    _Pragma("unroll") for (int et = 0; et < 4; ++et) { LRU_DPP_STEP("row_shr:2", xv[0][et], av[0][et]); LRU_DPP_STEP("row_shl:2", xv[1][et], av[1][et]); } \
    _Pragma("unroll") for (int et = 0; et < 4; ++et) { LRU_DPP_STEP("row_shr:4", xv[0][et], av[0][et]); LRU_DPP_STEP("row_shl:4", xv[1][et], av[1][et]); } \
    _Pragma("unroll") for (int et = 0; et < 4; ++et) { LRU_DPP_STEP("row_shr:8", xv[0][et], av[0][et]); LRU_DPP_STEP("row_shl:8", xv[1][et], av[1][et]); } } while (0)
__device__ __forceinline__ void ph_lru_a(const Frame& F, int jj) {
    LAS bf16_t* Wl = (LAS bf16_t*)F.lds;
    LAS float* ucb = (LAS float*)(F.lds + 36864 + F.wave * 4352);
    LAS float* CT = (LAS float*)(F.lds + 36864 + 8 * 4352);
    const bf16_t* wsrc = (const bf16_t*)(F.WB + WB_LRU);
    float* AG = (float*)(F.R1 + R1_AG); bf16_t* GX = (bf16_t*)(F.R1 + R1_GX);
    const float* cw = inp(F, 14) + (size_t)jj * 4 * 1024; const float* cb = inp(F, 15) + (size_t)jj * 1024;
    const float* b_a = inp(F, 17) + (size_t)jj * 2 * 1024; const float* b_x = inp(F, 19) + (size_t)jj * 2 * 1024; const float* lam = inp(F, 20) + (size_t)jj * 2 * 1024;
    const int tk = F.lane & 15, g = F.lane >> 4;
    const int NTASK = NBAT * 16 * 11;
    for (int task = F.wg; task < NTASK; task += F.G) {
        const int grp = task % 11, kb = (task / 11) & 15, b = task / (11 * 16);
        __syncthreads();
        for (int i = F.tid; i < 4 * 4096 / 8; i += 512) { const int mg = i >> 9, r = i & 511;
            *(LAS u32x4*)(Wl + (mg * 64 + (r >> 3)) * 72 + (r & 7) * 8) = *(const u32x4*)(wsrc + ((size_t)mg * 16 + kb) * 4096 + r * 8); }
        for (int i = F.tid; i < 11 * 64; i += 512) { const int kind = i >> 6, ch = kb * 64 + (i & 63); float v;
            if (kind < 4) v = cw[kind * 1024 + ch]; else if (kind == 4) v = cb[ch];
            else { const int d = (kind - 5) / 3, w = (kind - 5) % 3; v = (w == 0) ? b_a[d * 1024 + ch] : (w == 1) ? b_x[d * 1024 + ch] : -8.0f * log1pf(__expf(-lam[d * 1024 + ch])); }
            CT[i] = v; }
        __syncthreads();
        const int nt0 = grp * 48;
        LruRaw raw; lru_load(F, b, kb, nt0 + F.wave, raw);
        for (int ti = F.wave; ti < 48; ti += 8) {
            const int nt = nt0 + ti;
            float av[2][4][4], xv[2][4][4];
            lru_conv(F, raw, CT, ucb);
            if (ti + 8 < 48) lru_load(F, b, kb, nt + 8, raw);
            lru_gates(F, Wl, CT, ucb, av, xv);
            const int row = lru_row(b, nt, tk);
#pragma unroll
            for (int d = 0; d < 2; ++d)
#pragma unroll
                for (int et = 0; et < 4; ++et) { u32x4 w; w.x = cvt_pk_bf16(av[d][et][0], xv[d][et][0]); w.y = cvt_pk_bf16(av[d][et][1], xv[d][et][1]); w.z = cvt_pk_bf16(av[d][et][2], xv[d][et][2]); w.w = cvt_pk_bf16(av[d][et][3], xv[d][et][3]);
                    __builtin_nontemporal_store(w, (u32x4*)(GX + (((size_t)row * 2 + d) * 1024 + kb * 64 + et * 16 + 4 * g) * 2));
                    const unsigned ww[4] = {w.x, w.y, w.z, w.w};
#pragma unroll
                    for (int i = 0; i < 4; ++i) { av[d][et][i] = __expf(__uint_as_float(ww[i] << 16)); xv[d][et][i] = __uint_as_float(ww[i] & 0xffff0000u); } }
            LRU_SCANS(av, xv);
#pragma unroll
            for (int d = 0; d < 2; ++d) if (tk == (d ? 0 : 15)) {
                float* ag = AG + (((size_t)(b * 2 + d) * LRU_NT + nt) * 2) * 1024 + kb * 64;
#pragma unroll
                for (int et = 0; et < 4; ++et) { *(f32x4*)(ag + et * 16 + 4 * g) = (f32x4){av[d][et][0], av[d][et][1], av[d][et][2], av[d][et][3]};
                    *(f32x4*)(ag + 1024 + et * 16 + 4 * g) = (f32x4){xv[d][et][0], xv[d][et][1], xv[d][et][2], xv[d][et][3]}; }
            }
        }
    }
    __syncthreads();
}
__device__ __forceinline__ void ph_lru_c(const Frame& F) {
    const float* HST = (const float*)(F.R1 + R1_HST); const bf16_t* GX = (const bf16_t*)(F.R1 + R1_GX);
    const bf16_t* P = (const bf16_t*)(F.R1 + R1_P);
    const int tk = F.lane & 15, g = F.lane >> 4;
    const int gw = F.wg * 8 + F.wave, nw = F.G * 8;
    for (int task = gw; task < NBAT * LRU_NT * 16; task += nw) {
        const int kb = task & 15, nt = (task >> 4) % LRU_NT, b = (task >> 4) / LRU_NT;
        const int row = lru_row(b, nt, tk);
        u32x4 gx[2][4]; f32x4 hf[4], hb[4]; u32x2 yw[4];
#pragma unroll
        for (int d = 0; d < 2; ++d)
#pragma unroll
            for (int et = 0; et < 4; ++et) gx[d][et] = *(const u32x4*)(GX + (((size_t)row * 2 + d) * 1024 + kb * 64 + et * 16 + 4 * g) * 2);
#pragma unroll
        for (int et = 0; et < 4; ++et) { const int ch = kb * 64 + et * 16 + 4 * g;
            hf[et] = *(const f32x4*)(HST + ((size_t)(b * 2 + 0) * LRU_NT + nt) * 1024 + ch);
            hb[et] = *(const f32x4*)(HST + ((size_t)(b * 2 + 1) * LRU_NT + nt) * 1024 + ch);
            yw[et] = *(const u32x2*)(P + (size_t)row * 2048 + ch); }
        float av[2][4][4], xv[2][4][4];
#pragma unroll
        for (int d = 0; d < 2; ++d)
#pragma unroll
            for (int et = 0; et < 4; ++et) { const unsigned ww[4] = {gx[d][et].x, gx[d][et].y, gx[d][et].z, gx[d][et].w};
#pragma unroll
                for (int i = 0; i < 4; ++i) { av[d][et][i] = __expf(__uint_as_float(ww[i] << 16)); xv[d][et][i] = __uint_as_float(ww[i] & 0xffff0000u); } }
        LRU_SCANS(av, xv);
#pragma unroll
        for (int et = 0; et < 4; ++et) {
            const int ch = kb * 64 + et * 16 + 4 * g;
            const float y0 = __uint_as_float(yw[et].x << 16), y1 = __uint_as_float(yw[et].x & 0xffff0000u), y2 = __uint_as_float(yw[et].y << 16), y3 = __uint_as_float(yw[et].y & 0xffff0000u);
            float o[4];
#pragma unroll
            for (int i = 0; i < 4; ++i) o[i] = fmaf(av[0][et][i], hf[et][i], xv[0][et][i]) + fmaf(av[1][et][i], hb[et][i], xv[1][et][i]);
            o[0] *= gelu_tanh_(y0); o[1] *= gelu_tanh_(y1); o[2] *= gelu_tanh_(y2); o[3] *= gelu_tanh_(y3);
            u32x2 w; w.x = cvt_pk_bf16(o[0], o[1]); w.y = cvt_pk_bf16(o[2], o[3]);
            *(u32x2*)(F.MIX + (size_t)row * DM + ch) = w;
        }
    }
}
__device__ __forceinline__ void ph_lru_b(const Frame& F) {
    const float* AG = (const float*)(F.R1 + R1_AG); float* HST = (float*)(F.R1 + R1_HST);
    LAS float* sa = (LAS float*)F.lds; LAS float* sx = sa + 512;
    for (int task = F.wg; task < NBAT * 2 * 32; task += F.G) {
        const int cgp = task & 31, d = (task >> 5) & 1, b = task >> 6;
        const int ch = cgp * 32 + (F.tid & 31), seg = F.tid >> 5;
        const float* ag = AG + ((size_t)(b * 2 + d) * LRU_NT) * 2048 + ch;
        float A = 1.0f, Xv = 0.f;
        for (int i = 0; i < 33; ++i) { const int nt = lru_nat(seg * 33 + i, d); const float a = ag[(size_t)nt * 2048], x = ag[(size_t)nt * 2048 + 1024]; Xv = fmaf(a, Xv, x); A *= a; }
        __syncthreads();
        sa[F.tid] = A; sx[F.tid] = Xv;
        __syncthreads();
        float h = 0.f;
        for (int s2 = 0; s2 < seg; ++s2) h = fmaf(sa[s2 * 32 + (F.tid & 31)], h, sx[s2 * 32 + (F.tid & 31)]);
        float* hs = HST + ((size_t)(b * 2 + d) * LRU_NT) * 1024 + ch;
        for (int i = 0; i < 33; ++i) { const int nt = lru_nat(seg * 33 + i, d); hs[(size_t)nt * 1024] = h; const float a = ag[(size_t)nt * 2048], x = ag[(size_t)nt * 2048 + 1024]; h = fmaf(a, h, x); }
    }
    __syncthreads();
}

__device__ __forceinline__ void topk_better(float& bk, int& be, float& bs, float ok, int oe, float os) { const bool t = (ok > bk) || (ok == bk && oe < be); bk = t ? ok : bk; be = t ? oe : be; bs = t ? os : bs; }
template <int CTRL> __device__ __forceinline__ void topk_step(float& bk, int& be, float& bs) {
    const float ok = dppf<CTRL>(bk, bk), os = dppf<CTRL>(bs, bs); const int oe = __builtin_amdgcn_update_dpp(be, be, CTRL, 0xf, 0xf, false); topk_better(bk, be, bs, ok, oe, os); }
__device__ __forceinline__ void ph_ln_router(const Frame& F, int l, bool dry = false) {
    const bf16_t* RW = (const bf16_t*)(F.WB + WB_RT);
    const float* rbias = inp(F, 23) + l * 64;
    LAS float* part = (LAS float*)F.lds;
    LAS float* LP = (LAS float*)(F.lds + 4096);
    LAS int* hist = (LAS int*)(F.lds + LDS_MISC + MISC_HIST); LAS int* hbase = (LAS int*)(F.lds + LDS_MISC + MISC_HBASE);
    int* tok_e = (int*)(F.ws + OFF_TOKE); int* tok_p = (int*)(F.ws + OFF_TOKP); float* tok_w = (float*)(F.ws + OFF_TOKW);
    int* stok = (int*)(F.ws + OFF_STOK); float* sw = (float*)(F.ws + OFF_SW);
    float* stats = (float*)(F.ws + OFF_STATS);
    unsigned* gcnt = (unsigned*)(F.ws + OFF_CTL + CTL_CNT) + l * 64;
    const int tk = F.lane & 15, g = F.lane >> 4;
    float rb[4];
#pragma unroll
    for (int q = 0; q < 4; ++q) rb[q] = rbias[tk + 16 * q];
    if (F.tid < 64) hist[F.tid] = 0;
    __syncthreads();
    const int NTILE = TT / 16, TILE0 = (l == 3) ? TC / 16 : 0;
    bf16x8 rwf[4][4];
#pragma unroll
    for (int et = 0; et < 4; ++et)
#pragma unroll
        for (int ks = 0; ks < 4; ++ks) rwf[et][ks] = *(const bf16x8*)(RW + (size_t)(et * 16 + tk) * 1024 + F.wave * 128 + ks * 32 + g * 8);
    f32x4 vn[4][2];
    if (TILE0 + F.wg < NTILE) { const float* xr = F.X + (size_t)((TILE0 + F.wg) * 16 + tk) * DM + F.wave * 128 + g * 8;
#pragma unroll
        for (int ks = 0; ks < 4; ++ks) { vn[ks][0] = *(const f32x4*)(xr + ks * 32); vn[ks][1] = *(const f32x4*)(xr + ks * 32 + 4); } }
    for (int tile = TILE0 + F.wg; tile < NTILE; tile += F.G) {
        const int row = tile * 16 + tk; const int s = slot_of_row(tile * 16);
        const float* ab = (const float*)(F.ws + OFF_AB) + (size_t)(l * 5 + s) * 2048;
        f32x4 v[4][2];
#pragma unroll
        for (int ks = 0; ks < 4; ++ks) { v[ks][0] = vn[ks][0]; v[ks][1] = vn[ks][1]; }
        if (tile + F.G < NTILE) { const float* xr = F.X + (size_t)((tile + F.G) * 16 + tk) * DM + F.wave * 128 + g * 8;
#pragma unroll
            for (int ks = 0; ks < 4; ++ks) { vn[ks][0] = *(const f32x4*)(xr + ks * 32); vn[ks][1] = *(const f32x4*)(xr + ks * 32 + 4); } }
        float sum = 0.f, sq = 0.f;
#pragma unroll
        for (int ks = 0; ks < 4; ++ks)
#pragma unroll
            for (int hh = 0; hh < 2; ++hh) { const f32x4 a = v[ks][hh]; sum += (a[0] + a[1]) + (a[2] + a[3]); sq += (a[0] * a[0] + a[1] * a[1]) + (a[2] * a[2] + a[3] * a[3]); }
        sum += __shfl_xor(sum, 16); sum += __shfl_xor(sum, 32); sq += __shfl_xor(sq, 16); sq += __shfl_xor(sq, 32);
        if (g == 0) *(LAS f32x2*)(part + (F.wave * 16 + tk) * 2) = (f32x2){sum, sq};
        __syncthreads();
        float ts = 0.f, tq = 0.f;
#pragma unroll
        for (int w = 0; w < 8; ++w) { const f32x2 p = *(const LAS f32x2*)(part + (w * 16 + tk) * 2); ts += p.x; tq += p.y; }
        const float mean = ts * (1.0f / 1024.0f), var = fmaxf(tq * (1.0f / 1024.0f) - mean * mean, 0.f), rstd = rsqrtf(var + 1e-5f);
        if (F.wave == 0 && g == 0) *(f32x2*)(stats + (size_t)row * 2) = (f32x2){mean, rstd};
        f32x4 acc[4];
#pragma unroll
        for (int et = 0; et < 4; ++et) acc[et] = (f32x4){0.f, 0.f, 0.f, 0.f};
#pragma unroll
        for (int ks = 0; ks < 4; ++ks) { const int k = F.wave * 128 + ks * 32 + g * 8;
            const f32x4 a10 = *(const f32x4*)(ab + k), a11 = *(const f32x4*)(ab + k + 4), b10 = *(const f32x4*)(ab + 1024 + k), b11 = *(const f32x4*)(ab + 1024 + k + 4);
            const f32x4 h0 = (v[ks][0] - mean) * rstd * a10 + b10, h1 = (v[ks][1] - mean) * rstd * a11 + b11;
            u32x4 w; w.x = cvt_pk_bf16(h0[0], h0[1]); w.y = cvt_pk_bf16(h0[2], h0[3]); w.z = cvt_pk_bf16(h1[0], h1[1]); w.w = cvt_pk_bf16(h1[2], h1[3]);
            *(u32x4*)(F.HB + (size_t)row * DM + k) = w;
            bf16x8 af; __builtin_memcpy(&af, &w, 16);
#pragma unroll
            for (int et = 0; et < 4; ++et) acc[et] = __builtin_amdgcn_mfma_f32_16x16x32_bf16(af, rwf[et][ks], acc[et], 0, 0, 0);
        }
#pragma unroll
        for (int et = 0; et < 4; ++et)
#pragma unroll
            for (int i = 0; i < 4; ++i) LP[(F.wave * 16 + 4 * g + i) * 64 + et * 16 + tk] = acc[et][i];
        __syncthreads();
        {
            const int t = 2 * F.wave + (g & 1), r2 = tile * 16 + t;
            float sc[4], key[4];
#pragma unroll
            for (int q = 0; q < 4; ++q) { float lgt = 0.f;
#pragma unroll
                for (int w = 0; w < 8; ++w) lgt += LP[(w * 16 + t) * 64 + tk + 16 * q];
                sc[q] = sigmoidf_(lgt); key[q] = sc[q] + rb[q]; }
            unsigned taken = 0u; int se[6]; float ss[6]; float tot = 0.f;
#pragma unroll
            for (int sel = 0; sel < 6; ++sel) {
                float bk = -1e30f, bs = 0.f; int be = 0;
#pragma unroll
                for (int q = 0; q < 4; ++q) if (!((taken >> q) & 1u) && key[q] > bk) { bk = key[q]; be = tk + 16 * q; bs = sc[q]; }
                topk_step<0xB1>(bk, be, bs); topk_step<0x4E>(bk, be, bs); topk_step<0x141>(bk, be, bs); topk_step<0x140>(bk, be, bs);
                if ((be & 15) == tk) taken |= 1u << (be >> 4);
                se[sel] = be; ss[sel] = bs; tot += bs;
            }
            const float sc2 = 2.5f / tot;
            if (tk < 6 && g < 2) {
                int e = se[0]; float w = ss[0];
#pragma unroll
                for (int q = 1; q < 6; ++q) if (tk == q) { e = se[q]; w = ss[q]; }
                tok_e[r2 * 8 + tk] = e; tok_w[r2 * 8 + tk] = w * sc2; if (!dry) tok_p[r2 * 8 + tk] = __hip_atomic_fetch_add(hist + e, 1, __ATOMIC_RELAXED, __HIP_MEMORY_SCOPE_WORKGROUP);
            }
        }
    }
    asm volatile("s_waitcnt vmcnt(0) lgkmcnt(0)" ::: "memory");
    __syncthreads();
    if (dry) return;
    if (F.tid < 64) hbase[F.tid] = (int)__hip_atomic_fetch_add(gcnt + F.tid, (unsigned)hist[F.tid], __ATOMIC_RELAXED, __HIP_MEMORY_SCOPE_AGENT);
    __syncthreads();
    for (int tile = TILE0 + F.wg; tile < NTILE; tile += F.G) {
        if (F.tid < 96) { const int row = tile * 16 + F.tid / 6, q = F.tid % 6; const int e = tok_e[row * 8 + q]; const int pos = hbase[e] + tok_p[row * 8 + q];
            tok_p[row * 8 + q] = pos; stok[(size_t)e * CAP + pos] = row; sw[(size_t)e * CAP + pos] = tok_w[row * 8 + q]; }
    }
    __syncthreads();
}

__device__ __forceinline__ int moe_tables(const Frame& F, int l) {
    const int t0 = (l == 3) ? TC : 0;
    LAS int* cnt = (LAS int*)(F.lds + LDS_MISC + MISC_CNT); LAS int* tst = (LAS int*)(F.lds + LDS_MISC + MISC_TST); LAS unsigned char* t2e = (LAS unsigned char*)(F.lds + LDS_MISC + MISC_T2E);
    const unsigned* gcnt = (const unsigned*)(F.ws + OFF_CTL + CTL_CNT) + l * 64;
    __syncthreads();
    if (F.tid < 64) cnt[F.tid] = (int)__hip_atomic_load(gcnt + F.tid, __ATOMIC_RELAXED, __HIP_MEMORY_SCOPE_AGENT);
    if (F.tid == 64) cnt[64] = TT - t0;
    __syncthreads();
    if (F.tid == 0) { int s = 0; for (int e = 0; e < 65; ++e) { tst[e] = s; s += (cnt[e] + 255) >> 8; } tst[65] = s; }
    __syncthreads();
    const int ntiles = tst[65];
    for (int t = F.tid; t < ntiles; t += 512) { int e = 0; for (int q = 0; q < 65; ++q) if (t >= tst[q]) e = q; else break; t2e[t] = (unsigned char)e; }
    __syncthreads();
    return ntiles;
}

template <int CTRL> __device__ __forceinline__ float dpp_f(float x) { return __builtin_bit_cast(float, __builtin_amdgcn_update_dpp(0, __builtin_bit_cast(int, x), CTRL, 0xF, 0xF, true)); }
#define WAVE_SUM64(x) do { x += dpp_f<0xB1>(x); x += dpp_f<0x4E>(x); x += dpp_f<0x141>(x); x += dpp_f<0x140>(x); \
    x = __builtin_bit_cast(float, __builtin_amdgcn_readlane(__builtin_bit_cast(int, x), 0)) + __builtin_bit_cast(float, __builtin_amdgcn_readlane(__builtin_bit_cast(int, x), 16)) \
      + __builtin_bit_cast(float, __builtin_amdgcn_readlane(__builtin_bit_cast(int, x), 32)) + __builtin_bit_cast(float, __builtin_amdgcn_readlane(__builtin_bit_cast(int, x), 48)); } while (0)
template <bool lastl> __device__ __forceinline__ void ph_combine_t(const Frame& F, int l, bool dry) {
    LAS int* tst = (LAS int*)(F.lds + LDS_MISC + MISC_TST);
    (void)moe_tables(F, l);
    const int t0 = lastl ? TC : 0;
    LAS float* CT = (LAS float*)F.lds;
    {
        const float* gam = inp(F, 6) + (size_t)(l * 2 + 1) * DM; const float* bet = inp(F, 7) + (size_t)(l * 2 + 1) * DM;
        const float* gam0 = inp(F, 6) + (size_t)(l * 2 + 0) * DM; const float* bet0 = inp(F, 7) + (size_t)(l * 2 + 0) * DM;
        for (int k = F.tid; k < 1024; k += 512) {
            CT[k] = ALPHA * gam0[k]; CT[1024 + k] = ALPHA * bet0[k]; CT[2048 + k] = gam[k]; CT[3072 + k] = bet[k];
#pragma unroll
            for (int s = 0; s < 5; ++s) {
                const float* m = F.mods + (size_t)(l * 5 + s) * 6144; const float* mn = F.mods + (size_t)((lastl ? l : l + 1) * 5 + s) * 6144;
                CT[(4 + s * 3) * 1024 + k] = m[5 * 1024 + k] * (1.0f / 32.0f); CT[(5 + s * 3) * 1024 + k] = 1.0f + mn[1024 + k]; CT[(6 + s * 3) * 1024 + k] = mn[k];
            }
        }
        __syncthreads();
    }
    const float* stats = (const float*)(F.ws + OFF_STATS);
    const unsigned char* Y = (const unsigned char*)(F.R1 + R1_Y);
    const int* tok_e = (const int*)(F.ws + OFF_TOKE); const int* tok_p = (const int*)(F.ws + OFF_TOKP);
    const int gw = F.wg * 8 + F.wave, nw = F.G * 8;
    const int l4 = F.lane * 4, q8 = F.lane & 7;
    const int sh0 = __builtin_amdgcn_readfirstlane(tst[64]) * 256 - t0;
#define CMB_IDX(E_, P_, row_) do { E_ = tok_e[(row_) * 8 + q8]; P_ = tok_p[(row_) * 8 + q8]; } while (0)
#define CMB_ISSUE(Yb, Xb, Sb, E_, P_, row_) do { \
        const int sl_ = tst[(E_) & 63] * 256 + (P_); \
        _Pragma("unroll") for (int q = 0; q < 7; ++q) { const int sr_ = (q < 6) ? __builtin_amdgcn_readlane(sl_, q) : (sh0 + (row_)); \
            const unsigned char* yp_ = Y + (size_t)sr_ * DM + l4; \
            _Pragma("unroll") for (int c = 0; c < 4; ++c) Yb[q * 4 + c] = *(const unsigned*)(yp_ + c * 256); } \
        _Pragma("unroll") for (int c = 0; c < 4; ++c) Xb[c] = *(const f32x4*)(F.X + (size_t)(row_) * DM + c * 256 + l4); \
        Sb = *(const f32x2*)(stats + (size_t)(row_) * 2); } while (0)
#define CMB_COMPUTE(Yb, Xb, Sb, row_) do { \
        LAS const float* cs_ = CT + (4 + slot_of_row(row_) * 3) * 1024 + l4; \
        float v[16]; \
        _Pragma("unroll") for (int c = 0; c < 4; ++c) { \
            const f32x4 ag = *(LAS const f32x4*)(CT + c * 256 + l4), ab = *(LAS const f32x4*)(CT + 1024 + c * 256 + l4), m5 = *(LAS const f32x4*)(cs_ + c * 256); \
            f32x2 ya = (f32x2){0.f, 0.f}, yb = ya; \
            _Pragma("unroll") for (int q = 0; q < 7; ++q) { ya += __builtin_amdgcn_cvt_pk_f32_fp8((int)Yb[q * 4 + c], false); yb += __builtin_amdgcn_cvt_pk_f32_fp8((int)Yb[q * 4 + c], true); } \
            const f32x4 xh = (Xb[c] - Sb.x) * Sb.y; \
            v[c * 4 + 0] = xh[0] * ag[0] + ab[0] + m5[0] * ya.x; v[c * 4 + 1] = xh[1] * ag[1] + ab[1] + m5[1] * ya.y; \
            v[c * 4 + 2] = xh[2] * ag[2] + ab[2] + m5[2] * yb.x; v[c * 4 + 3] = xh[3] * ag[3] + ab[3] + m5[3] * yb.y; } \
        float sum = 0.f; \
        _Pragma("unroll") for (int i = 0; i < 16; ++i) sum += v[i]; \
        WAVE_SUM64(sum); \
        const float mean = sum * (1.0f / 1024.0f); \
        float sq = 0.f; \
        _Pragma("unroll") for (int i = 0; i < 16; ++i) { const float d = v[i] - mean; sq += d * d; } \
        WAVE_SUM64(sq); \
        const float rstd = rsqrtf(sq * (1.0f / 1024.0f) + 1e-5f); \
        _Pragma("unroll") for (int c = 0; c < 4; ++c) { \
            const f32x4 g = *(LAS const f32x4*)(CT + 2048 + c * 256 + l4), b = *(LAS const f32x4*)(CT + 3072 + c * 256 + l4); \
            f32x4 xn; \
            _Pragma("unroll") for (int i = 0; i < 4; ++i) xn[i] = (v[c * 4 + i] - mean) * rstd * g[i] + b[i]; \
            if (dry) { const float acc_ = xn[0] + xn[1] + xn[2] + xn[3]; asm volatile("" :: "v"(acc_)); } \
            else if (lastl) { *(f32x4*)(F.out + (size_t)((row_) - TC) * DM + c * 256 + l4) = xn; } \
            else { \
                *(f32x4*)(F.X + (size_t)(row_) * DM + c * 256 + l4) = xn; \
                const f32x4 s1 = *(LAS const f32x4*)(cs_ + 1024 + c * 256), b0 = *(LAS const f32x4*)(cs_ + 2048 + c * 256); \
                const f32x4 hv = xn * s1 + b0; \
                u32x2 w; w.x = cvt_pk_bf16(hv[0], hv[1]); w.y = cvt_pk_bf16(hv[2], hv[3]); \
                *(u32x2*)(F.HB + (size_t)(row_) * DM + c * 256 + l4) = w; } } } while (0)
    unsigned yA[28], yB[28]; f32x4 xA[4], xB[4]; f32x2 sA, sB; int eN = 0, pN = 0, eNN = 0, pNN = 0;
    const int row0 = t0 + gw;
    CMB_IDX(eNN, pNN, row0);
    if (row0 + nw < TT) CMB_IDX(eN, pN, row0 + nw);
    CMB_ISSUE(yA, xA, sA, eNN, pNN, row0);
    int row = row0;
    for (; row + 3 * nw < TT; row += 2 * nw) {
        const int r1 = row + nw, r2 = row + 2 * nw, r3 = row + 3 * nw;
        CMB_IDX(eNN, pNN, r2);
        CMB_ISSUE(yB, xB, sB, eN, pN, r1);
        CMB_COMPUTE(yA, xA, sA, row);
        CMB_IDX(eN, pN, r3);
        CMB_ISSUE(yA, xA, sA, eNN, pNN, r2);
        CMB_COMPUTE(yB, xB, sB, r1);
    }
    for (; row < TT; row += 2 * nw) {
        const int r1 = row + nw, r2 = row + 2 * nw, r3 = row + 3 * nw;
        if (r2 < TT) CMB_IDX(eNN, pNN, r2);
        if (r1 < TT) CMB_ISSUE(yB, xB, sB, eN, pN, r1);
        CMB_COMPUTE(yA, xA, sA, row);
        if (r1 < TT) {
            if (r3 < TT) CMB_IDX(eN, pN, r3);
            if (r2 < TT) CMB_ISSUE(yA, xA, sA, eNN, pNN, r2);
            CMB_COMPUTE(yB, xB, sB, r1);
        }
    }
#undef CMB_IDX
#undef CMB_ISSUE
#undef CMB_COMPUTE
}
__device__ __forceinline__ void ph_combine(const Frame& F, int l, bool dry = false) { if (l == 3) ph_combine_t<true>(F, l, dry); else ph_combine_t<false>(F, l, dry); }

constexpr int NPHASE = 2 + 4 * 10;
__global__ void __launch_bounds__(512, 2) mk_fwd(Args args) {
    extern __shared__ __attribute__((aligned(16))) unsigned char lds_raw[];
    Frame F;
    F.out = args.out; F.ws = args.ws; F.lds = (LAS unsigned char*)lds_raw;
    { const int t0 = threadIdx.x; F.wave = __builtin_amdgcn_readfirstlane(t0 >> 6); F.lane = t0 & 63; F.tid = t0; } F.G = gridDim.x; F.wg = blockIdx.x;
    F.mods = (float*)(args.ws + OFF_MODS); F.X = (float*)(args.ws + OFF_X); F.HB = (bf16_t*)(args.ws + OFF_HB); F.MIX = F.HB;
    F.WB = args.ws + OFF_WB; F.R1 = args.ws + OFF_R1;
    volatile LAS unsigned* xbw = (volatile LAS unsigned*)(F.lds + LDS_MISC);
    if (F.tid < 4) xbw[F.tid] = 0u;
    if (F.tid < 30) ((LAS unsigned long long*)(F.lds + LDS_MISC + MISC_INP))[F.tid] = (unsigned long long)args.in[F.tid];
    __syncthreads();
    const int lo = args.ph_lo, hi = args.ph_hi;
    XcdBarrier bar; bar.bar = (unsigned*)(args.ws + OFF_CTL); bar.x = 0; bar.st = xbw;
    if (hi - lo > 1) bar = xcd_barrier_post((unsigned*)(args.ws + OFF_CTL), xbw);
#define IN(k) (lo <= (k) && (k) < hi)
#define SEAM(k) do { if (IN(k) && IN((k) + 1)) { xcd_barrier(bar); if (REPM & 1) xcd_barrier(bar); } } while (0)
    if ((PHM & 1) && IN(0)) { ph_mods(fresh(F)); if (REPM & 65536) { __syncthreads(); ph_mods(fresh(F)); } } SEAM(0);
    if ((PHM & 2) && IN(1)) { ph_init_x(fresh(F)); if (REPM & 131072) ph_init_x(fresh(F)); }
    for (int l = 0; l < 4; ++l) {
        const int pb = 2 + l * 10, j = l >> 1; const bool even = (l & 1) == 0;
        float* mods_l = F.mods + (size_t)l * 5 * 6144;
        F.WB = args.ws + OFF_WB + (size_t)(l & 1) * WB_END;
        if ((PHM & 4) && IN(pb + 0) && !(l & 1)) { for (int rep = 0; rep < ((REPM & 4) ? 2 : 1); ++rep) { ph_convert(fresh(F), l); __syncthreads(); } }
        if (!(l & 1)) SEAM(pb + 0);
        if ((PHM & 8) && IN(pb + 1)) {
            const int N = even ? 4096 : 2048;
            pg8::StaticOrder S; S.init(F.HB, F.WB + WB_IN, TT, N, 1024, F.G, F.wg);
            pg8::EpiStoreBf16 E{(bf16_t*)(F.R1 + R1_P), N};
            for (int rep = 0; rep < ((REPM & 8) ? 2 : 1); ++rep) pg8::gemm_phase(F.lds, 1024, S, E, F.wave);
        } SEAM(pb + 1);
        if (IN(pb + 2)) { if (even) { if (F.wg < 8 && F.G > 16) { ph_hg_ctx(fresh(F), j); } else if (PHM & 16) for (int rep = 0; rep < ((REPM & 16) ? 2 : 1); ++rep) { Frame Fa = fresh(F); if (F.G > 16) { Fa.wg = F.wg - 8; Fa.G = F.G - 8; } ph_attn(Fa, j); } if (PHM & 32) for (int rep = 0; rep < ((REPM & 32) ? 2 : 1); ++rep) ph_hg_a(fresh(F), j); } else { if (PHM & 64) for (int rep = 0; rep < ((REPM & 64) ? 2 : 1); ++rep) ph_lru_a(fresh(F), j); } } SEAM(pb + 2);
        if (IN(pb + 3)) { if (even) { if (PHM & 128) for (int rep = 0; rep < ((REPM & 128) ? 2 : 1); ++rep) { ph_hg_b(fresh(F));
                { Frame Fc = fresh(F); Fc.WB = args.ws + OFF_WB + (size_t)((l + 1) & 1) * WB_END; ph_convert(Fc, l + 1); } } } else { if (PHM & 256) for (int rep = 0; rep < ((REPM & 256) ? 2 : 1); ++rep) ph_lru_b(fresh(F)); } } SEAM(pb + 3);
        if (IN(pb + 4)) { if (even) { if (PHM & 512) for (int rep = 0; rep < ((REPM & 512) ? 2 : 1); ++rep) ph_hg_c(fresh(F), j); } else { if (PHM & 1024) for (int rep = 0; rep < ((REPM & 1024) ? 2 : 1); ++rep) ph_lru_c(fresh(F)); } } SEAM(pb + 4);
        if ((PHM & 2048) && IN(pb + 5)) {
            const int t0 = (l == 3) ? TC : 0;
            pg8::StaticOrder S; S.init(F.MIX + (size_t)t0 * DM, F.WB + WB_OUT, TT - t0, 1024, 1024, F.G, F.wg);
            pg8::EpiResid E{F.X + (size_t)t0 * DM, mods_l, t0};
            pg8::gemm_phase(F.lds, 1024, S, E, F.wave);
        } SEAM(pb + 5);
        if ((PHM & 4096) && IN(pb + 6)) { if (REPM & 4096) ph_ln_router(fresh(F), l, true); ph_ln_router(fresh(F), l); } SEAM(pb + 6);
        if ((PHM & 8192) && IN(pb + 7)) {
            const int ntiles = moe_tables(fresh(F), l);
            pg8::MoeGU S; S.cnt = (const LAS int*)(F.lds + LDS_MISC + MISC_CNT); S.tst = (const LAS int*)(F.lds + LDS_MISC + MISC_TST); S.t2e = (const LAS unsigned char*)(F.lds + LDS_MISC + MISC_T2E);
            S.ntiles = ntiles; S.G = F.G; S.c = F.wg; S.A = (const char*)F.HB; S.Bt = (const char*)(F.WB + WB_GU); S.stok = (const int*)(F.ws + OFF_STOK); S.t0 = (l == 3) ? TC : 0;
            pg8::EpiSwiglu E{(bf16_t*)(F.R1 + R1_H)};
            for (int rep = 0; rep < ((REPM & 8192) ? 2 : 1); ++rep) pg8::gemm_phase(F.lds, 1024, S, E, F.wave);
        } SEAM(pb + 7);
        if ((PHM & 16384) && IN(pb + 8)) {
            const int ntiles = moe_tables(fresh(F), l);
            pg8::MoeDN S; S.cnt = (const LAS int*)(F.lds + LDS_MISC + MISC_CNT); S.tst = (const LAS int*)(F.lds + LDS_MISC + MISC_TST); S.t2e = (const LAS unsigned char*)(F.lds + LDS_MISC + MISC_T2E);
            S.ntiles = ntiles; S.G = F.G; S.c = F.wg; S.A = (const char*)(F.R1 + R1_H); S.Bt = (const char*)(F.WB + WB_DN);
            pg8::EpiDown E{(unsigned char*)(F.R1 + R1_Y), (const float*)(F.ws + OFF_SW), (const LAS int*)(F.lds + LDS_MISC + MISC_CNT)};
            if (REPM & 2) { pg8::EpiNull EN; pg8::gemm_phase(F.lds, 256, S, EN, F.wave); }
            for (int rep = 0; rep < ((REPM & 16384) ? 2 : 1); ++rep) pg8::gemm_phase(F.lds, 256, S, E, F.wave);
        } SEAM(pb + 8);
        if ((PHM & 32768) && IN(pb + 9)) { if (REPM & 32768) ph_combine(fresh(F), l, true); ph_combine(fresh(F), l); } SEAM(pb + 9);
    }
#undef IN
#undef SEAM
}

extern "C" void kernel_launch(void* const* d_in, const int* in_sizes, int n_in, void* d_out, int out_size, void* d_ws, size_t ws_size, hipStream_t stream) {
    static int grid = 0;
    if (grid == 0) {
        if (n_in != 30 || out_size != TX * DM || ws_size < WS_END) { fprintf(stderr, "kernel_launch: unexpected problem (n_in %d out %d ws %zu need %zu)\n", n_in, out_size, ws_size, (size_t)WS_END); grid = -1; return; }
        int dev = 0, cus = 0, per_cu = 0;
        if (hipGetDevice(&dev) != hipSuccess || hipDeviceGetAttribute(&cus, hipDeviceAttributeMultiprocessorCount, dev) != hipSuccess) { grid = -1; return; }
        if (hipFuncSetAttribute((const void*)mk_fwd, hipFuncAttributeMaxDynamicSharedMemorySize, LDS_BYTES) != hipSuccess) { fprintf(stderr, "kernel_launch: hipFuncSetAttribute failed\n"); grid = -1; return; }
        if (hipOccupancyMaxActiveBlocksPerMultiprocessor(&per_cu, (const void*)mk_fwd, 512, LDS_BYTES) != hipSuccess || per_cu < 1) { fprintf(stderr, "kernel_launch: occupancy query says %d\n", per_cu); }
        (void)hipGetLastError();
        grid = cus;
    }
    if (grid < 0) return;
    (void)hipMemsetAsync((char*)d_ws + OFF_CTL, 0, CTL_BYTES, stream);
    Args a{};
    for (int i = 0; i < 30; ++i) a.in[i] = (const float*)d_in[i];
    a.out = (float*)d_out; a.ws = (unsigned char*)d_ws;
#if MK_SPLIT
    for (int p = 0; p < NPHASE; ++p) { a.ph_lo = p; a.ph_hi = p + 1; hipLaunchKernelGGL(mk_fwd, dim3(grid), dim3(512), LDS_BYTES, stream, a); }
#else
    a.ph_lo = 0; a.ph_hi = NPHASE;
    hipLaunchKernelGGL(mk_fwd, dim3(grid), dim3(512), LDS_BYTES, stream, a);
#endif
}
```

```cpp
#include <hip/hip_runtime.h>
#include <cstdio>
#include <cstdint>

#ifndef PHM
#define PHM 0xFFFF
#endif
#ifndef REPM
#define REPM 0
#endif
#ifndef MK_SPLIT
#define MK_SPLIT 0
#endif

typedef unsigned short bf16_t;
typedef short bf16x8 __attribute__((ext_vector_type(8)));
typedef short bf16x4 __attribute__((ext_vector_type(4)));
typedef float f32x4 __attribute__((ext_vector_type(4)));
typedef float f32x2 __attribute__((ext_vector_type(2)));
typedef unsigned u32x4 __attribute__((ext_vector_type(4)));
typedef unsigned u32x2 __attribute__((ext_vector_type(2)));
#define LAS __attribute__((address_space(3)))

constexpr int DM = 1024, NBAT = 4, SEQ = 8192, CTXL = 256;
constexpr int TC = NBAT * CTXL, TX = NBAT * SEQ, TT = TC + TX;
constexpr int NEXP = 64, TOPK = 6;
constexpr int CAP = TT;
constexpr int MOE_ROUTED_ROWS = 6 * TT + 64 * 256;
constexpr int MOE_ROWS = MOE_ROUTED_ROWS + TT;
constexpr int MOE_MAXTILES = MOE_ROWS / 256;
constexpr float ALPHA = 1.681792830507429f;
constexpr int HG_U = 128, HG_NU = (CTXL + SEQ) / HG_U;
constexpr int LRU_NT = (CTXL + SEQ) / 16;

constexpr size_t OFF_CTL = 0, CTL_BYTES = 65536;
constexpr size_t CTL_CNT = 16384, CTL_DBG = 20480;
constexpr size_t OFF_MODS = 65536;
constexpr size_t OFF_LBT = OFF_MODS + 4 * 5 * 6144 * 4;
constexpr size_t OFF_STATS = OFF_LBT + 8192;
constexpr size_t OFF_AB = OFF_STATS + (size_t)TT * 8;
static_assert(OFF_AB + 4 * 5 * 2 * 1024 * 4 <= (1u << 20), "ctl map");
constexpr size_t OFF_TOKE = 1u << 20;
constexpr size_t OFF_TOKP = OFF_TOKE + (size_t)TT * 32;
constexpr size_t OFF_TOKW = OFF_TOKP + (size_t)TT * 32;
constexpr size_t OFF_STOK = OFF_TOKW + (size_t)TT * 32;
constexpr size_t OFF_SW = OFF_STOK + (size_t)64 * CAP * 4;
constexpr size_t OFF_X = OFF_SW + (size_t)64 * CAP * 4;
constexpr size_t OFF_HB = OFF_X + (size_t)TT * DM * 4;
constexpr size_t OFF_WB = OFF_HB + (size_t)TT * DM * 2;
constexpr size_t WB_IN = 0, WB_OUT = WB_IN + (size_t)4096 * 1024 * 2, WB_RT = WB_OUT + (size_t)1024 * 1024 * 2, WB_GU = WB_RT + (size_t)64 * 1024 * 2,
                 WB_DN = WB_GU + (size_t)65 * 512 * 1024 * 2, WB_LRU = WB_DN + (size_t)65 * 1024 * 256 * 2, WB_END = WB_LRU + (size_t)2 * 2 * 16 * 64 * 64 * 2;
constexpr size_t OFF_R1 = OFF_WB + 2 * WB_END;
constexpr size_t R1_P = 0;
constexpr size_t R1_OF = R1_P + (size_t)TT * 4096 * 2;
constexpr size_t R1_SLOC = R1_OF + (size_t)TT * 512 * 4;
constexpr size_t R1_SST = R1_SLOC + (size_t)64 * HG_NU * 4096 * 4;
constexpr size_t R1_DL = R1_SST + (size_t)64 * HG_NU * 4096 * 4;
constexpr size_t R1_AG = (size_t)TT * 2048 * 2;
constexpr size_t R1_HST = R1_AG + (size_t)4 * 2 * LRU_NT * 2 * 1024 * 4;
constexpr size_t R1_GX = R1_HST + (size_t)4 * 2 * LRU_NT * 1024 * 4;
constexpr size_t R1_LRU_END = R1_GX + (size_t)TT * 2 * 1024 * 2 * 2;
constexpr size_t R1_H = 0;
constexpr size_t R1_Y = R1_H + (size_t)MOE_ROWS * 256 * 2;
constexpr size_t R1_MOE_END = R1_Y + (size_t)MOE_ROWS * 1024;
constexpr size_t R1_MIX_END = R1_DL + (size_t)64 * HG_NU * 64 * 4;
constexpr size_t R1_END_ = (R1_MOE_END > R1_MIX_END ? R1_MOE_END : R1_MIX_END);
constexpr size_t WS_END = OFF_R1 + (R1_END_ > R1_LRU_END ? R1_END_ : R1_LRU_END);

constexpr int LDS_STAGE = 131072;
constexpr int LDS_MISC = LDS_STAGE;
constexpr int MISC_CNT = 64;
constexpr int MISC_TST = MISC_CNT + 66 * 4 + 8;
constexpr int MISC_HIST = 640;
constexpr int MISC_HBASE = 896;
constexpr int MISC_T2E = 1152;
constexpr int MISC_INP = 2304;
constexpr int LDS_BYTES = 147456;

#define XB_TMO      128
#define XB_XCNT(j)  (256  + 64 * (j))
#define XB_XSUB(j)  (1280 + 64 * (j))
#define XB_XGEN(j)  (2304 + 64 * (j))
#define XB_TOP      3328
#define XB_TOPGEN   3392
#define XCD_BAR_WORDS 3456
#define XB_SPIN_CAP (1u << 22)
__device__ __forceinline__ unsigned xb_ld(unsigned* p)              { return __hip_atomic_load(p, __ATOMIC_RELAXED, __HIP_MEMORY_SCOPE_AGENT); }
__device__ __forceinline__ unsigned xb_add(unsigned* p, unsigned v) { return __hip_atomic_fetch_add(p, v, __ATOMIC_RELAXED, __HIP_MEMORY_SCOPE_AGENT); }
__device__ __forceinline__ unsigned xb_xcc_id() { return (unsigned)__builtin_amdgcn_s_getreg((3 << 11) | 20) & 0xFu; }
#define XB_SPIN(cond, bar) do { unsigned _sp = 0; while (cond) { __builtin_amdgcn_s_sleep(1); \
    if ((++_sp & 255u) == 0u) { if (xb_ld(&(bar)[XB_TMO])) break; if (_sp > XB_SPIN_CAP) { atomicAdd(&(bar)[XB_TMO], 1u); break; } } } } while (0)
struct XcdBarrier { unsigned* bar; unsigned x; volatile LAS unsigned* st; };
__device__ __forceinline__ XcdBarrier xcd_barrier_post(unsigned* bar, volatile LAS unsigned* st) {
    XcdBarrier b; b.bar = bar; b.x = xb_xcc_id(); b.st = st;
    if (threadIdx.x == 0) (void)xb_add(&bar[XB_XCNT(b.x)], 1u);
    return b;
}
__device__ __forceinline__ void xcd_barrier_complete(unsigned* bar, unsigned x, unsigned& nloc, unsigned& nx) {
    const unsigned G = gridDim.x * gridDim.y * gridDim.z;
    unsigned sum, cnt, mine, sp = 0u;
    for (;;) {
        sum = 0u; cnt = 0u; mine = 0u;
#pragma unroll
        for (unsigned j = 0; j < 16; ++j) { const unsigned c = xb_ld(&bar[XB_XCNT(j)]); sum += c; cnt += (c > 0u) ? 1u : 0u; mine = (j == x) ? c : mine; }
        if (sum == G) break;
        __builtin_amdgcn_s_sleep(1);
        if ((++sp & 255u) == 0u) { if (xb_ld(&bar[XB_TMO])) break; if (sp > XB_SPIN_CAP) { atomicAdd(&bar[XB_TMO], 1u); break; } }
    }
    nloc = mine > 0u ? mine : 1u; nx = cnt > 0u ? cnt : 1u;
}
__device__ __forceinline__ void xcd_barrier(const XcdBarrier& b) {
    asm volatile("s_waitcnt vmcnt(0)" ::: "memory");
    __syncthreads();
    if (threadIdx.x == 0) {
        unsigned* bar = b.bar;
        __builtin_amdgcn_s_waitcnt(0);
        unsigned nloc = b.st[0], nx = b.st[1];
        if (nloc == 0u) { xcd_barrier_complete(bar, b.x, nloc, nx); b.st[0] = nloc; b.st[1] = nx; }
        const unsigned old = xb_add(&bar[XB_XSUB(b.x)], 1u);
        const unsigned gen = old / nloc;
        if (old + 1u == (gen + 1u) * nloc) {
            __builtin_amdgcn_fence(__ATOMIC_RELEASE, "agent");
            asm volatile("s_waitcnt vmcnt(0)" ::: "memory");
            const unsigned og = xb_add(&bar[XB_TOP], 1u);
            const unsigned tg = og / nx;
            if (og + 1u == (tg + 1u) * nx) xb_add(&bar[XB_TOPGEN], 1u);
            else XB_SPIN(xb_ld(&bar[XB_TOPGEN]) == tg, bar);
            __builtin_amdgcn_fence(__ATOMIC_ACQUIRE, "agent");
            xb_add(&bar[XB_XGEN(b.x)], 1u);
            asm volatile("s_waitcnt vmcnt(0)" ::: "memory");
        } else {
            XB_SPIN(xb_ld(&bar[XB_XGEN(b.x)]) == gen, bar);
            __builtin_amdgcn_fence(__ATOMIC_ACQUIRE, "agent");
            asm volatile("s_waitcnt vmcnt(0)" ::: "memory");
        }
    }
    __syncthreads();
}

__device__ __forceinline__ float bf2f(unsigned short b) { return __uint_as_float(((unsigned)b) << 16); }
__device__ __forceinline__ unsigned cvt_pk_bf16(float lo, float hi) { unsigned r; asm volatile("v_cvt_pk_bf16_f32 %0, %1, %2" : "=v"(r) : "v"(lo), "v"(hi)); return r; }
__device__ __forceinline__ unsigned short f2bf(float f) { return (unsigned short)(cvt_pk_bf16(f, 0.f) & 0xffffu); }
__device__ __forceinline__ float sigmoidf_(float x) { return __builtin_amdgcn_rcpf(1.0f + __expf(-x)); }
__device__ __forceinline__ float siluf_(float x) { return x * sigmoidf_(x); }
__device__ __forceinline__ float gelu_tanh_(float x) { return x * sigmoidf_(1.5957691216057308f * (x + 0.044715f * x * x * x)); }
__device__ __forceinline__ int slot_of_row(int r) { return r < TC ? 4 : ((r - TC) >> 13); }
template <int CTRL> __device__ __forceinline__ float dppf(float oldv, float src) {
    return __int_as_float(__builtin_amdgcn_update_dpp(__float_as_int(oldv), __float_as_int(src), CTRL, 0xf, 0xf, false));
}
__device__ __forceinline__ void unpack8(const u32x4 w, float (&o)[8]) {
    o[0] = __uint_as_float(w.x << 16); o[1] = __uint_as_float(w.x & 0xffff0000u); o[2] = __uint_as_float(w.y << 16); o[3] = __uint_as_float(w.y & 0xffff0000u);
    o[4] = __uint_as_float(w.z << 16); o[5] = __uint_as_float(w.z & 0xffff0000u); o[6] = __uint_as_float(w.w << 16); o[7] = __uint_as_float(w.w & 0xffff0000u);
}

namespace pg8 {
constexpr int BM = 256, BK = 64, HALF = 128, HTB = HALF * BK * 2, STAGE_BYTES = 8 * HTB, NXCD = 8, WGM = 8;
__device__ __forceinline__ int lds_byte(int r, int c) { const int st = (r >> 4) * 2 + (c >> 5), rr = r & 15, cc = c & 31, ob = rr * 64 + cc * 2; return st * 1024 + (ob ^ (((ob >> 9) & 1) << 5)); }
__device__ __forceinline__ void stage_rc(int b, int& R, int& C) { const int st = b / 1024, sb = b % 1024, swz = sb ^ (((sb >> 9) & 1) << 5); R = (st >> 1) * 16 + swz / 64; C = (st & 1) * 32 + (swz % 64) / 2; }
__device__ __forceinline__ int perm32(int rho) { const int n = rho >> 4, i = rho & 15; return 8 * (i >> 2) + 4 * n + (i & 3); }
struct Unit { int pm, pn, e, ti; };

struct StaticOrder {
    const char* A; const char* Bt; int K;
    int nM, nN, nwg, G, c;
    __device__ __forceinline__ void init(const void* A_, const void* Bt_, int M, int N, int K_, int G_, int c_) { A = (const char*)A_; Bt = (const char*)Bt_; K = K_; nM = M / BM; nN = N / BM; nwg = nM * nN; G = G_; c = c_; }
    __device__ __forceinline__ bool next(int i, Unit& u) const {
        const long L = (long)i * G + c; if (L >= nwg) return false;
        int wgid = (int)L; { const int q = nwg / NXCD, r = nwg % NXCD, xcd = wgid % NXCD, off = wgid / NXCD; wgid = (xcd < r ? xcd * (q + 1) : r * (q + 1) + (xcd - r) * q) + off; }
        const int nig = WGM * nN, gid = wgid / nig, fm = gid * WGM, gsz = (nM - fm) < WGM ? (nM - fm) : WGM;
        u.pm = fm + ((wgid % nig) % gsz); u.pn = (wgid % nig) / gsz; u.e = 0; u.ti = 0; return true;
    }
    static constexpr bool GATHER = false;
    __device__ __forceinline__ const char* abase(const Unit& u) const { return A + (size_t)u.pm * BM * K * 2; }
    __device__ __forceinline__ const char* bbase(const Unit& u) const { return Bt + (size_t)u.pn * BM * K * 2; }
};

template <class Epi, class Sched>
__device__ __forceinline__ void gemm_phase(LAS unsigned char* lds, const int K_, const Sched& S, const Epi& E, const int wave_) {
    int Kl_ = K_; asm volatile("" : "+s"(Kl_)); const int K = Kl_;
    int tid_ = wave_ * 64 + (int)__builtin_amdgcn_mbcnt_hi(~0u, __builtin_amdgcn_mbcnt_lo(~0u, 0u)); asm volatile("" : "+v"(tid_));
    const int tid = tid_, wid = __builtin_amdgcn_readfirstlane(tid >> 6), lane = tid & 63, wr = wid >> 2, wc = wid & 3, fr = lane & 15, fq = lane >> 4;
    const int nt = K / BK;
    unsigned voffA[2], voffB[2];
#pragma unroll
    for (int i = 0; i < 2; ++i) { int R, C; stage_rc(tid * 16 + i * 8192, R, C);
        const int Rb = Epi::PERM == 1 ? ((R & ~31) + perm32(R & 31)) : Epi::PERM == 2 ? (64 * (R >> 5) + 16 * ((R & 15) >> 2) + 4 * ((R >> 4) & 1) + (R & 3)) : R;
        voffA[i] = (unsigned)(R * K + C) * 2u; voffB[i] = (unsigned)(Rb * K + C) * 2u; }
    const size_t kstep = (size_t)(BK * 2);
    const size_t hstep = (size_t)HALF * K * 2;
    const size_t hstepB = Epi::PERM == 2 ? (size_t)8 * K * 2 : hstep;
    const unsigned ldsw = (unsigned)wid * 1024u;
    const int aoff = lds_byte(wr * 64 + fr, fq * 8), boff = lds_byte(wc * 32 + fr, fq * 8);
#define PG8_SA(b, h) (((b) * 2 + (h)) * HTB)
#define PG8_SB(b, h) ((4 + (b) * 2 + (h)) * HTB)
#define PG8_STAGE(bufoff, gbase, voff) do { _Pragma("unroll") for (int _i = 0; _i < 2; ++_i) \
        __builtin_amdgcn_global_load_lds((const unsigned*)((const char*)(gbase) + (voff)[_i]), (LAS unsigned*)(lds + (bufoff) + ldsw + _i * 8192), 16, 0, 0); } while (0)
#define PG8_STAGEA(bufoff, hh, kb, nx) do { if constexpr (Sched::GATHER) { unsigned _o[2]; _o[0] = (nx) ? vN[hh][0] : vC[hh][0]; _o[1] = (nx) ? vN[hh][1] : vC[hh][1]; PG8_STAGE(bufoff, cA + (kb), _o); } \
        else { PG8_STAGE(bufoff, ((nx) ? nA : cA) + (hh) * hstep + (kb), voffA); } } while (0)
#define PG8_LDA(dst, b, h) do { _Pragma("unroll") for (int m = 0; m < 4; ++m) _Pragma("unroll") for (int k = 0; k < 2; ++k) dst[m][k] = *(const LAS bf16x8*)(lds + PG8_SA(b, h) + aoff + m * 2048 + k * 1024); } while (0)
#define PG8_LDB(dst, b, h) do { _Pragma("unroll") for (int n = 0; n < 2; ++n) _Pragma("unroll") for (int k = 0; k < 2; ++k) dst[n][k] = *(const LAS bf16x8*)(lds + PG8_SB(b, h) + boff + n * 2048 + k * 1024); } while (0)
#define PG8_MMA(ai, bj, At, Bt) do { __builtin_amdgcn_s_setprio(1); _Pragma("unroll") for (int m = 0; m < 4; ++m) _Pragma("unroll") for (int n = 0; n < 2; ++n) _Pragma("unroll") for (int k = 0; k < 2; ++k) \
        acc[ai][bj][m][n] = __builtin_amdgcn_mfma_f32_16x16x32_bf16(Bt[n][k], At[m][k], acc[ai][bj][m][n], 0, 0, 0); __builtin_amdgcn_s_setprio(0); } while (0)
#define PG8_WAIT_V(n) asm volatile("s_waitcnt vmcnt(" #n ")" ::: "memory")
#define PG8_WAIT_L(n) asm volatile("s_waitcnt lgkmcnt(" #n ")" ::: "memory")
#define PG8_BAR __builtin_amdgcn_s_barrier()
#define PG8_SCHED __builtin_amdgcn_sched_barrier(0)
    Unit cur, nxt; int ui = 0;
    if (!S.next(0, cur)) return;
    f32x4 acc[2][2][4][2];
#pragma unroll
    for (int a = 0; a < 2; ++a)
#pragma unroll
        for (int b = 0; b < 2; ++b)
#pragma unroll
            for (int m = 0; m < 4; ++m)
#pragma unroll
                for (int n = 0; n < 2; ++n) acc[a][b][m][n] = (f32x4){0.f, 0.f, 0.f, 0.f};
    bf16x8 At[4][2], B0[2][2], B1[2][2];
    unsigned vC[2][2], vN[2][2];
    if constexpr (Sched::GATHER) S.aoff(cur, tid, vC);
    const char* cA = S.abase(cur);
    const char* cB = S.bbase(cur);
    const char* nA = cA;
    PG8_STAGE(PG8_SB(0, 0), cB, voffB); PG8_STAGEA(PG8_SA(0, 0), 0, 0, false); PG8_STAGE(PG8_SB(0, 1), cB + hstepB, voffB); PG8_STAGEA(PG8_SA(0, 1), 1, 0, false);
    if (wr == 1) PG8_BAR;
    PG8_WAIT_V(4); PG8_BAR;
    PG8_STAGE(PG8_SB(1, 0), cB + kstep, voffB); PG8_STAGEA(PG8_SA(1, 0), 0, kstep, false); PG8_STAGE(PG8_SB(1, 1), cB + hstepB + kstep, voffB);
    PG8_WAIT_V(6); PG8_BAR;
    for (;;) {
        const bool has_next = S.next(ui + 1, nxt);
        const char* nB = cB; nA = cA;
        if (has_next) { nB = S.bbase(nxt); nA = S.abase(nxt); if constexpr (Sched::GATHER) S.aoff(nxt, tid, vN); }
        else { if constexpr (Sched::GATHER) {
#pragma unroll
            for (int h = 0; h < 2; ++h)
#pragma unroll
                for (int i = 0; i < 2; ++i) vN[h][i] = vC[h][i]; } }
        for (int t = 0; t < nt; t += 2) {
            const bool last = (t == nt - 2);
            const size_t k1 = (size_t)(t + 1) * kstep, k2 = last ? 0 : (size_t)(t + 2) * kstep, k3 = k2 + kstep;
            const char* b2 = last ? nB : cB + (size_t)(t + 2) * kstep; const char* b3 = b2 + kstep;
            PG8_LDB(B0, 0, 0); PG8_SCHED; PG8_LDA(At, 0, 0); PG8_STAGEA(PG8_SA(1, 1), 1, k1, false);
            PG8_WAIT_L(8); PG8_BAR; PG8_WAIT_L(0); PG8_MMA(0, 0, At, B0); PG8_BAR; PG8_SCHED;
            PG8_LDB(B1, 0, 1); PG8_STAGE(PG8_SB(0, 0), b2, voffB);
            PG8_BAR; PG8_WAIT_L(0); PG8_MMA(0, 1, At, B1); PG8_BAR;
            PG8_LDA(At, 0, 1); PG8_STAGEA(PG8_SA(0, 0), 0, k2, last);
            PG8_BAR; PG8_WAIT_L(0); PG8_MMA(1, 0, At, B0); PG8_BAR; PG8_SCHED;
            PG8_STAGE(PG8_SB(0, 1), b2 + hstepB, voffB);
            PG8_WAIT_V(6); PG8_BAR; PG8_MMA(1, 1, At, B1); PG8_BAR;
            PG8_LDB(B0, 1, 0); PG8_SCHED; PG8_LDA(At, 1, 0); PG8_STAGEA(PG8_SA(0, 1), 1, k2, last);
            PG8_WAIT_L(8); PG8_BAR; PG8_WAIT_L(0); PG8_MMA(0, 0, At, B0); PG8_BAR; PG8_SCHED;
            PG8_LDB(B1, 1, 1); PG8_STAGE(PG8_SB(1, 0), b3, voffB);
            PG8_BAR; PG8_WAIT_L(0); PG8_MMA(0, 1, At, B1); PG8_BAR;
            PG8_LDA(At, 1, 1); PG8_STAGEA(PG8_SA(1, 0), 0, k3, last);
            PG8_BAR; PG8_WAIT_L(0); PG8_MMA(1, 0, At, B0); PG8_BAR; PG8_SCHED;
            PG8_STAGE(PG8_SB(1, 1), b3 + hstepB, voffB);
            PG8_WAIT_V(6); PG8_BAR; PG8_MMA(1, 1, At, B1); PG8_BAR;
        }
        E(acc, cur, wr, wc, fr, fq);
        if (!has_next) break;
#pragma unroll
        for (int a = 0; a < 2; ++a)
#pragma unroll
            for (int b = 0; b < 2; ++b)
#pragma unroll
                for (int m = 0; m < 4; ++m)
#pragma unroll
                    for (int n = 0; n < 2; ++n) acc[a][b][m][n] = (f32x4){0.f, 0.f, 0.f, 0.f};
        cur = nxt; cB = nB; cA = nA; ++ui;
        if constexpr (Sched::GATHER) {
#pragma unroll
            for (int h = 0; h < 2; ++h)
#pragma unroll
                for (int i = 0; i < 2; ++i) vC[h][i] = vN[h][i]; }
    }
    PG8_WAIT_V(0);
    if (wr == 0) PG8_BAR;
    PG8_BAR;
#undef PG8_SA
#undef PG8_SB
#undef PG8_STAGE
#undef PG8_STAGEA
#undef PG8_LDA
#undef PG8_LDB
#undef PG8_MMA
#undef PG8_WAIT_V
#undef PG8_WAIT_L
#undef PG8_BAR
#undef PG8_SCHED
}

struct EpiStoreBf16 {
    static constexpr int PERM = 2;
    bf16_t* O; int ldc;
    __device__ __forceinline__ void operator()(const f32x4 (&acc)[2][2][4][2], const Unit& u, int wr, int wc, int fr, int fq) const {
        const int row0 = u.pm * BM + wr * 64 + fr, col0 = u.pn * BM + wc * 64 + 16 * fq;
#pragma unroll
        for (int ai = 0; ai < 2; ++ai)
#pragma unroll
            for (int m = 0; m < 4; ++m) { bf16_t* rowp = O + (size_t)(row0 + ai * HALF + m * 16) * ldc + col0;
#pragma unroll
                for (int bj = 0; bj < 2; ++bj) { const f32x4 v0 = acc[ai][bj][m][0], v1 = acc[ai][bj][m][1];
                    u32x4 w; w.x = cvt_pk_bf16(v0[0], v0[1]); w.y = cvt_pk_bf16(v0[2], v0[3]); w.z = cvt_pk_bf16(v1[0], v1[1]); w.w = cvt_pk_bf16(v1[2], v1[3]);
                    *(u32x4*)(rowp + bj * 8) = w; } }
    }
};
struct EpiResid {
    static constexpr int PERM = 0;
    float* X; const float* mods_l; int rbase;
    __device__ __forceinline__ void operator()(const f32x4 (&acc)[2][2][4][2], const Unit& u, int wr, int wc, int fr, int fq) const {
        const int row0 = u.pm * BM + wr * 64 + fr, col0 = u.pn * BM + wc * 32 + 4 * fq;
        const float* m2 = mods_l + (size_t)(slot_of_row(rbase + u.pm * BM) * 6 + 2) * DM + col0;
        float* xb = X + (size_t)row0 * DM + col0;
#pragma unroll
        for (int bj = 0; bj < 2; ++bj)
#pragma unroll
            for (int n = 0; n < 2; ++n) { const f32x4 mv = *(const f32x4*)(m2 + bj * HALF + n * 16);
                f32x4 xv[8];
#pragma unroll
                for (int q = 0; q < 8; ++q) xv[q] = *(const f32x4*)(xb + (size_t)((q >> 2) * HALF + (q & 3) * 16) * DM + bj * HALF + n * 16);
#pragma unroll
                for (int q = 0; q < 8; ++q) *(f32x4*)(xb + (size_t)((q >> 2) * HALF + (q & 3) * 16) * DM + bj * HALF + n * 16) = xv[q] * ALPHA + mv * acc[q >> 2][bj][q & 3][n];
                asm volatile("" ::: "memory"); }
    }
};
struct EpiSwiglu {
    static constexpr int PERM = 1;
    bf16_t* H;
    __device__ __forceinline__ void operator()(const f32x4 (&acc)[2][2][4][2], const Unit& u, int wr, int wc, int fr, int fq) const {
        const int row0 = u.pm * BM + wr * 64 + fr, col0 = u.pn * HALF + wc * 32 + 8 * fq;
#pragma unroll
        for (int ai = 0; ai < 2; ++ai)
#pragma unroll
            for (int m = 0; m < 4; ++m) { bf16_t* rowp = H + (size_t)(row0 + ai * HALF + m * 16) * 256 + col0;
                float h[8];
#pragma unroll
                for (int n = 0; n < 2; ++n)
#pragma unroll
                    for (int j = 0; j < 4; ++j) h[n * 4 + j] = siluf_(acc[ai][0][m][n][j]) * acc[ai][1][m][n][j];
                u32x4 w; w.x = cvt_pk_bf16(h[0], h[1]); w.y = cvt_pk_bf16(h[2], h[3]); w.z = cvt_pk_bf16(h[4], h[5]); w.w = cvt_pk_bf16(h[6], h[7]);
                *(u32x4*)rowp = w; }
    }
};
struct EpiDown {
    static constexpr int PERM = 2;
    unsigned char* Y;
    __device__ __forceinline__ void operator()(const f32x4 (&acc)[2][2][4][2], const Unit& u, int wr, int wc, int fr, int fq) const {
        const int row0 = u.pm * BM + wr * 64 + fr, col0 = u.pn * BM + wc * 64 + 16 * fq;
        unsigned char* yb = Y + (size_t)row0 * DM + col0;
#pragma unroll
        for (int ai = 0; ai < 2; ++ai)
#pragma unroll
            for (int m = 0; m < 4; ++m) { const int rl = ai * HALF + m * 16;
                u32x4 ww; unsigned pk[4];
#pragma unroll
                for (int bj = 0; bj < 2; ++bj)
#pragma unroll
                    for (int n = 0; n < 2; ++n) { f32x4 v = acc[ai][bj][m][n] * 16.0f;
#pragma unroll
                        for (int j = 0; j < 4; ++j) v[j] = __builtin_amdgcn_fmed3f(v[j], -440.0f, 440.0f);
                        int p = __builtin_amdgcn_cvt_pk_fp8_f32(v[0], v[1], 0, false); p = __builtin_amdgcn_cvt_pk_fp8_f32(v[2], v[3], p, true); pk[bj * 2 + n] = (unsigned)p; }
                ww.x = pk[0]; ww.y = pk[1]; ww.z = pk[2]; ww.w = pk[3];
                __builtin_nontemporal_store(ww, (u32x4*)(yb + (size_t)rl * DM));
                asm volatile("" ::: "memory"); }
    }
};
template <int MODE> struct EpiDownProbe {
    static constexpr int PERM = 2;
    unsigned char* Y; const float* sw; const LAS int* cnt;
    __device__ __forceinline__ void operator()(const f32x4 (&acc)[2][2][4][2], const Unit& u, int wr, int wc, int fr, int fq) const {
        const int hsh = (u.pm * 4 + u.pn) & 2047;
        unsigned char* yb = (MODE == 1) ? Y + ((size_t)(hsh * 8 + wr * 4 + wc) * 8) * 1024 + (fq * 16 + fr) * 16
                                        : Y + (size_t)((u.pm & 511) * BM + wr * 64 + fr) * DM + u.pn * BM + wc * 64 + 16 * fq;
#pragma unroll
        for (int ai = 0; ai < 2; ++ai)
#pragma unroll
            for (int m = 0; m < 4; ++m) { const int rl = ai * HALF + m * 16; const float w = 32.0f;
                u32x4 ww; unsigned pk[4];
#pragma unroll
                for (int bj = 0; bj < 2; ++bj)
#pragma unroll
                    for (int n = 0; n < 2; ++n) { f32x4 v = acc[ai][bj][m][n] * w;
#pragma unroll
                        for (int j = 0; j < 4; ++j) v[j] = __builtin_amdgcn_fmed3f(v[j], -440.0f, 440.0f);
                        int p = __builtin_amdgcn_cvt_pk_fp8_f32(v[0], v[1], 0, false); p = __builtin_amdgcn_cvt_pk_fp8_f32(v[2], v[3], p, true); pk[bj * 2 + n] = (unsigned)p; }
                ww.x = pk[0]; ww.y = pk[1]; ww.z = pk[2]; ww.w = pk[3];
                if (MODE == 1) __builtin_nontemporal_store(ww, (u32x4*)(yb + (size_t)(ai * 4 + m) * 1024));
                else if (MODE == 2) __builtin_nontemporal_store(ww, (u32x4*)(yb + (size_t)rl * DM));
                else *(u32x4*)(yb + (size_t)rl * DM) = ww;
                asm volatile("" ::: "memory"); }
    }
};
struct EpiNull {
    static constexpr int PERM = 1;
    __device__ __forceinline__ void operator()(const f32x4 (&acc)[2][2][4][2], const Unit&, int, int, int, int) const {
#pragma unroll
        for (int ai = 0; ai < 2; ++ai)
#pragma unroll
            for (int bj = 0; bj < 2; ++bj)
#pragma unroll
                for (int m = 0; m < 4; ++m)
#pragma unroll
                    for (int n = 0; n < 2; ++n) asm volatile("" :: "v"(acc[ai][bj][m][n]));
    }
};
template <int NPN> struct MoeOrder {
    const LAS int* cnt; const LAS int* tst; const LAS unsigned char* t2e; int ntiles, G, c;
    __device__ __forceinline__ bool next(int i, Unit& u) const {
        const int cs = ((G & 7) == 0) ? (c & 7) * (G >> 3) + (c >> 3) : c;
        const int L = i * G + cs; if (L >= ntiles * NPN) return false;
        const int tau = L / NPN; u.pm = tau; u.pn = L % NPN; u.e = t2e[tau]; u.ti = tau - tst[u.e]; return true;
    }
};
struct MoeGU : MoeOrder<2> {
    static constexpr bool GATHER = true;
    const char* A; const char* Bt; const int* stok; int t0;
    __device__ __forceinline__ const char* abase(const Unit&) const { return A; }
    __device__ __forceinline__ const char* bbase(const Unit& u) const { return Bt + ((size_t)u.e * 512 + (size_t)u.pn * 256) * 1024 * 2; }
    __device__ __forceinline__ void aoff(const Unit& u, int tid, unsigned (&off)[2][2]) const {
        const int ce = cnt[u.e];
#pragma unroll
        for (int i = 0; i < 2; ++i) { int R, C; stage_rc(tid * 16 + i * 8192, R, C);
#pragma unroll
            for (int h = 0; h < 2; ++h) { const int pos = u.ti * 256 + h * HALF + R; int tok;
                if (u.e == 64) tok = t0 + pos; else tok = (pos < ce) ? stok[(size_t)u.e * CAP + pos] : 0;
                off[h][i] = (unsigned)(tok * 1024 + C) * 2u; } }
    }
};
struct MoeDN : MoeOrder<4> {
    static constexpr bool GATHER = false;
    const char* A; const char* Bt;
    __device__ __forceinline__ const char* abase(const Unit& u) const { return A + (size_t)u.pm * BM * 256 * 2; }
    __device__ __forceinline__ const char* bbase(const Unit& u) const { return Bt + ((size_t)u.e * 1024 + (size_t)u.pn * 256) * 256 * 2; }
};
}

struct Args { const float* in[30]; float* out; unsigned char* ws; int ph_lo, ph_hi; };

struct Frame {
    float* out; unsigned char* ws; LAS unsigned char* lds; int tid, lane, wave, G, wg;
    float* mods; float* X; bf16_t* HB; bf16_t* MIX; unsigned char* WB; unsigned char* R1;
};

__device__ __forceinline__ const float* inp(const Frame& F, int i) {
    const unsigned long long v = ((const LAS unsigned long long*)(F.lds + LDS_MISC + MISC_INP))[i];
    const unsigned lo = (unsigned)__builtin_amdgcn_readfirstlane((int)(unsigned)v), hi = (unsigned)__builtin_amdgcn_readfirstlane((int)(unsigned)(v >> 32));
    return (const float*)(((unsigned long long)hi << 32) | lo);
}
__device__ __forceinline__ int lane_id_() { return (int)__builtin_amdgcn_mbcnt_hi(~0u, __builtin_amdgcn_mbcnt_lo(~0u, 0u)); }
__device__ __forceinline__ Frame fresh(const Frame& F0) { Frame F = F0; int ln = lane_id_(); asm volatile("" : "+v"(ln)); F.lane = ln; F.tid = F0.wave * 64 + ln; return F; }

__device__ __forceinline__ void ph_mods(const Frame& F) {
    const float* c = inp(F, 1); const float* cc = inp(F, 3); const float* ada_w = inp(F, 4); const float* ada_b = inp(F, 5);
    LAS float* sv = (LAS float*)F.lds;
    LAS float* red = (LAS float*)(F.lds + 5 * 1024 * 4);
    for (int i = F.tid; i < 5 * 1024; i += 512) { const int s = i >> 10, k = i & 1023; const float v = (s < 4) ? c[s * 1024 + k] : cc[k]; sv[i] = siluf_(v); }
    __syncthreads();
    for (int task = F.wg; task < 4 * 48; task += F.G) {
        const int l = task / 48, cc0 = (task % 48) * 128;
        const int cg = F.tid & 31, kg = F.tid >> 5;
        const float* w = ada_w + (size_t)l * 1024 * 6144 + cc0 + cg * 4;
        f32x4 acc[5];
#pragma unroll
        for (int s = 0; s < 5; ++s) acc[s] = (f32x4){0.f, 0.f, 0.f, 0.f};
#pragma unroll 8
        for (int kk = 0; kk < 64; ++kk) { const int k = kg * 64 + kk; const f32x4 wv = *(const f32x4*)(w + (size_t)k * 6144);
#pragma unroll
            for (int s = 0; s < 5; ++s) acc[s] += wv * sv[s * 1024 + k]; }
#pragma unroll
        for (int s = 0; s < 5; ++s)
#pragma unroll
            for (int q = 0; q < 4; ++q) red[((kg * 128) + cg * 4 + q) * 5 + s] = acc[s][q];
        __syncthreads();
        if (F.tid < 128) {
            const int col = cc0 + F.tid; const float bsv = ada_b[l * 6144 + col];
#pragma unroll
            for (int s = 0; s < 5; ++s) { float v = 0.f;
#pragma unroll
                for (int g2 = 0; g2 < 16; ++g2) v += red[((g2 * 128) + F.tid) * 5 + s];
                F.mods[(size_t)(l * 5 + s) * 6144 + col] = v + bsv; }
        }
        __syncthreads();
    }
    if (F.wg == F.G - 1) {
        const float* raw = inp(F, 11); float* lbt = (float*)(F.ws + OFF_LBT);
        for (int i = F.tid; i < 2 * 512; i += 512) { const int d = i >> 9, ch = i & 511; const float r0 = raw[(d * 2 + 0) * 512 + ch], r1 = raw[(d * 2 + 1) * 512 + ch];
            lbt[(0 * 2 + d) * 512 + ch] = 0.f; lbt[(1 * 2 + d) * 512 + ch] = sigmoidf_(r1 - r0); }
    }
}

__device__ __forceinline__ void ph_init_x(const Frame& F) {
    const float* x = inp(F, 0); const float* ctx = inp(F, 2);
    { const float* lg_ = inp(F, 6); const float* lb_ = inp(F, 7); float* AB = (float*)(F.ws + OFF_AB);
      for (int i = F.wg * 512 + F.tid; i < 4 * 5 * 1024; i += F.G * 512) { const int k = i & 1023, ls = i >> 10, l = ls / 5;
          const float* m = F.mods + (size_t)ls * 6144; const float g0 = lg_[(l * 2) * 1024 + k], b0 = lb_[(l * 2) * 1024 + k], m3 = m[3 * 1024 + k], m4 = m[4 * 1024 + k];
          AB[(size_t)ls * 2048 + k] = g0 * (1.0f + m4); AB[(size_t)ls * 2048 + 1024 + k] = b0 * (1.0f + m4) + m3; } }
    const int gw = F.wg * 8 + F.wave, nw = F.G * 8;
    for (int row = gw; row < TT; row += nw) {
        const float* src = row < TC ? ctx + (size_t)row * DM : x + (size_t)(row - TC) * DM;
        const float* m = F.mods + (size_t)(0 * 5 + slot_of_row(row)) * 6144;
#pragma unroll
        for (int hh = 0; hh < 2; ++hh) { const int k = hh * 512 + F.lane * 8;
            const f32x4 v0 = *(const f32x4*)(src + k), v1 = *(const f32x4*)(src + k + 4);
            *(f32x4*)(F.X + (size_t)row * DM + k) = v0; *(f32x4*)(F.X + (size_t)row * DM + k + 4) = v1;
            const f32x4 s0 = *(const f32x4*)(m + 1024 + k), s1 = *(const f32x4*)(m + 1024 + k + 4), b0 = *(const f32x4*)(m + k), b1 = *(const f32x4*)(m + k + 4);
            const f32x4 h0 = v0 * (s0 + 1.0f) + b0, h1 = v1 * (s1 + 1.0f) + b1;
            u32x4 w; w.x = cvt_pk_bf16(h0[0], h0[1]); w.y = cvt_pk_bf16(h0[2], h0[3]); w.z = cvt_pk_bf16(h1[0], h1[1]); w.w = cvt_pk_bf16(h1[2], h1[3]);
            *(u32x4*)(F.HB + (size_t)row * DM + k) = w; }
    }
}

__device__ __forceinline__ void cvt_tile(const Frame& F, const float* src, int sld, int k0, int n0, bf16_t* dst, int dld, int drow0, float scale) {
    LAS float* t = (LAS float*)F.lds;
    { const int i = F.tid >> 3, j0 = (F.tid & 7) * 8; const float* p = src + (size_t)(k0 + i) * sld + n0 + j0;
      const f32x4 a = *(const f32x4*)p, b = *(const f32x4*)(p + 4);
      LAS float* q = t + i * 65 + j0; q[0] = a[0]; q[1] = a[1]; q[2] = a[2]; q[3] = a[3]; q[4] = b[0]; q[5] = b[1]; q[6] = b[2]; q[7] = b[3]; }
    __syncthreads();
    { const int j = F.tid >> 3, i0 = (F.tid & 7) * 8; float v[8];
#pragma unroll
      for (int q = 0; q < 8; ++q) v[q] = t[(i0 + q) * 65 + j] * scale;
      u32x4 w; w.x = cvt_pk_bf16(v[0], v[1]); w.y = cvt_pk_bf16(v[2], v[3]); w.z = cvt_pk_bf16(v[4], v[5]); w.w = cvt_pk_bf16(v[6], v[7]);
      *(u32x4*)(dst + (size_t)(drow0 + j) * dld + k0 + i0) = w; }
    __syncthreads();
}
__device__ __forceinline__ void ph_convert(const Frame& F, int l) {
    const int j = l >> 1; const bool even = (l & 1) == 0;
    bf16_t* wIN = (bf16_t*)(F.WB + WB_IN); bf16_t* wOUT = (bf16_t*)(F.WB + WB_OUT); bf16_t* wRT = (bf16_t*)(F.WB + WB_RT);
    bf16_t* wGU = (bf16_t*)(F.WB + WB_GU); bf16_t* wDN = (bf16_t*)(F.WB + WB_DN); bf16_t* wLRU = (bf16_t*)(F.WB + WB_LRU);
    const int nIN = even ? 4096 : 2048;
    const int t_in = (nIN / 64) * 16, t_out = 256, t_rt = 16, t_gu = 65 * 2 * 64, t_dn = 65 * 64, t_lru = even ? 0 : 64;
    const int total = t_in + t_out + t_rt + t_gu + t_dn + t_lru;
    for (int task = F.wg; task < total; task += F.G) {
        int t = task;
        if (t < t_in) { const int nb = t >> 4, kb = t & 15; const float* src = even ? inp(F, 8) + (size_t)j * 1024 * 4096 : inp(F, 13) + (size_t)j * 1024 * 2048;
            cvt_tile(F, src, nIN, kb * 64, nb * 64, wIN, 1024, nb * 64, (even && nb < 8) ? 0.125f * 1.4426950408889634f : 1.0f); continue; }
        t -= t_in;
        if (t < t_out) { const int nb = t >> 4, kb = t & 15; const float* src = even ? inp(F, 9) + (size_t)j * 1024 * 1024 : inp(F, 21) + (size_t)j * 1024 * 1024;
            cvt_tile(F, src, 1024, kb * 64, nb * 64, wOUT, 1024, nb * 64, 1.0f); continue; }
        t -= t_out;
        if (t < t_rt) { cvt_tile(F, inp(F, 22) + (size_t)l * 1024 * 64, 64, t * 64, 0, wRT, 1024, 0, 1.0f); continue; }
        t -= t_rt;
        if (t < t_gu) { const int e = t / 128, r = t % 128, which = r >> 6, q = r & 63, nb = q >> 4, kb = q & 15;
            const float* src = (e < 64) ? (which ? inp(F, 25) : inp(F, 24)) + ((size_t)l * 64 + e) * 1024 * 256 : (which ? inp(F, 28) : inp(F, 27)) + (size_t)l * 1024 * 256;
            const int n0 = nb * 64, drow0 = (n0 >> 7) * 256 + which * 128 + (n0 & 127);
            cvt_tile(F, src, 256, kb * 64, n0, wGU + (size_t)e * 512 * 1024, 1024, drow0, 1.0f); continue; }
        t -= t_gu;
        if (t < t_dn) { const int e = t >> 6, q = t & 63, nb = q >> 2, kb = q & 3;
            const float* src = (e < 64) ? inp(F, 26) + ((size_t)l * 64 + e) * 256 * 1024 : inp(F, 29) + (size_t)l * 256 * 1024;
            cvt_tile(F, src, 1024, kb * 64, nb * 64, wDN + (size_t)e * 1024 * 256, 256, nb * 64, 1.0f); continue; }
        t -= t_dn;
        { const int d = t >> 5, gt = (t >> 4) & 1, kb = t & 15;
          const float* src = (gt ? inp(F, 18) : inp(F, 16)) + (((size_t)j * 2 + d) * 16 + kb) * 4096;
          cvt_tile(F, src, 64, 0, 0, wLRU + (((size_t)d * 2 + gt) * 16 + kb) * 4096, 64, 0, 1.0f); }
    }
}

__device__ __forceinline__ void ph_attn(const Frame& F, int j) {
    const bf16_t* P = (const bf16_t*)(F.R1 + R1_P);
    LAS bf16_t* Ks0 = (LAS bf16_t*)F.lds;
    LAS float* rp_l = (LAS float*)(F.lds + 36864);
    const float* rpb = inp(F, 10) + (size_t)j * 8 * 465;
    const int g = F.lane >> 4, l15 = F.lane & 15;
    const int NLAT = NBAT * 8 * 64, NTASK = NLAT + NBAT * 8 * 2;
    const int wgs = ((F.G & 7) == 0) ? (F.wg & 7) * (F.G >> 3) + (F.wg >> 3) : F.wg;
    int cidx[4][4];
    { const int wq_ = (F.wave & 3) * 16 + l15, c0_ = min(max(wq_ - 8, 0), 48);
#pragma unroll
      for (int kb = 0; kb < 4; ++kb)
#pragma unroll
          for (int i = 0; i < 4; ++i) { const int kc = kb * 16 + 4 * g + i; cidx[kb][i] = (kc >= c0_ && kc < c0_ + 16) ? (kc - wq_ + 15) : 31; } }
    for (int task = wgs; task < NTASK; task += F.G) {
        const bool lat = task < NLAT;
        int b, h, rp = 0, half = 0;
        if (lat) { b = task >> 9; h = (task >> 6) & 7; rp = task & 63; } else { const int t2 = task - NLAT; b = t2 >> 4; h = (t2 >> 1) & 7; half = t2 & 1; }
        const int myr = 2 * rp + (F.wave >> 2), w0 = (F.wave & 3) * 16;
        const int r0 = min(max(myr - 4, 0), 120);
        const int rlo = min(max(2 * rp - 4, 0), 120), rhi = min(max(2 * rp + 1 - 4, 0), 120) + 7;
        const int nloc = lat ? (rhi - rlo + 1) : 0;
        const int qrow = lat ? (TC + b * SEQ + myr * 64 + w0 + l15) : (b * CTXL + half * 128 + F.wave * 16 + l15);
        bf16x8 qf[2];
        qf[0] = *(const bf16x8*)(P + (size_t)qrow * 4096 + h * 64 + g * 8);
        qf[1] = *(const bf16x8*)(P + (size_t)qrow * 4096 + h * 64 + 32 + g * 8);
        if (lat) for (int i = F.tid; i < 480; i += 512) { const int rr = i >> 5, cc = i & 31; rp_l[i] = (cc < 31) ? rpb[h * 465 + rr * 31 + cc] * 1.4426950408889634f : -1e30f; }
        f32x4 oacc[4];
#pragma unroll
        for (int dt = 0; dt < 4; ++dt) oacc[dt] = (f32x4){0.f, 0.f, 0.f, 0.f};
        float mrun = -1e30f, lrun = 0.f;
        const int wq = w0 + l15, c0 = min(max(wq - 8, 0), 48);
        u32x4 kv, vv;
        { const int key = F.tid >> 3, ds = (F.tid & 7) * 8; const bool loc0 = 0 < nloc;
          const int krow = loc0 ? (TC + b * SEQ + rlo * 64 + key) : (b * CTXL + key);
          kv = *(const u32x4*)(P + (size_t)krow * 4096 + 512 + h * 64 + ds); vv = *(const u32x4*)(P + (size_t)krow * 4096 + 1024 + h * 64 + ds); }
#define ATT_STAGE(buf_, c_) do { const int key = F.tid >> 3, ds = (F.tid & 7) * 8; LAS bf16_t* Kd = Ks0 + (buf_) * 9216; LAS bf16_t* Vd = Kd + 4608; \
            *(LAS u32x4*)(Kd + key * 72 + ds) = kv; *(LAS u32x4*)(Vd + key * 72 + ds) = vv;     \
            if ((c_) + 1 < nloc + 4) { const bool locn = ((c_) + 1) < nloc; \
                const int krow = locn ? (TC + b * SEQ + (rlo + (c_) + 1) * 64 + key) : (b * CTXL + ((c_) + 1 - nloc) * 64 + key); \
                kv = *(const u32x4*)(P + (size_t)krow * 4096 + 512 + h * 64 + ds); vv = *(const u32x4*)(P + (size_t)krow * 4096 + 1024 + h * 64 + ds); } } while (0)
        __syncthreads();
        ATT_STAGE(0, 0);
        __syncthreads();
        for (int ch = 0; ch < nloc + 4; ++ch) {
            const bool loc = ch < nloc; const int kr = rlo + ch;
            if (ch + 1 < nloc + 4) ATT_STAGE((ch + 1) & 1, ch + 1);
            const LAS bf16_t* Ks = Ks0 + (ch & 1) * 9216; const LAS bf16_t* Vt = Ks + 4608;
            const bool mine = loc ? (kr >= r0 && kr < r0 + 8) : true;
            if (mine) {
                f32x4 s[4];
                const LAS float* rrow = rp_l + (loc ? (kr - myr + 7) * 32 : 0);
#pragma unroll
                for (int kb = 0; kb < 4; ++kb) {
                    if (loc) {
#pragma unroll
                        for (int i = 0; i < 4; ++i) s[kb][i] = rrow[cidx[kb][i]];
                    } else s[kb] = (f32x4){0.f, 0.f, 0.f, 0.f};
#pragma unroll
                    for (int ks = 0; ks < 2; ++ks) { const bf16x8 a = *(const LAS bf16x8*)(Ks + (kb * 16 + l15) * 72 + ks * 32 + g * 8);
                        s[kb] = __builtin_amdgcn_mfma_f32_16x16x32_bf16(a, qf[ks], s[kb], 0, 0, 0); } }
                float cm = -1e30f;
#pragma unroll
                for (int kb = 0; kb < 4; ++kb)
#pragma unroll
                    for (int i = 0; i < 4; ++i) cm = fmaxf(cm, s[kb][i]);
                cm = fmaxf(cm, __shfl_xor(cm, 16)); cm = fmaxf(cm, __shfl_xor(cm, 32));
                const float mn = fmaxf(mrun, cm), sc = __builtin_amdgcn_exp2f(mrun - mn);
                mrun = mn; lrun *= sc;
#pragma unroll
                for (int dt = 0; dt < 4; ++dt) oacc[dt] *= sc;
                float p[4][4];
#pragma unroll
                for (int kb = 0; kb < 4; ++kb)
#pragma unroll
                    for (int i = 0; i < 4; ++i) { p[kb][i] = __builtin_amdgcn_exp2f(s[kb][i] - mn); lrun += p[kb][i]; }
#pragma unroll
                for (int kp = 0; kp < 2; ++kp) {
                    u32x4 pw; pw.x = cvt_pk_bf16(p[2 * kp][0], p[2 * kp][1]); pw.y = cvt_pk_bf16(p[2 * kp][2], p[2 * kp][3]);
                    pw.z = cvt_pk_bf16(p[2 * kp + 1][0], p[2 * kp + 1][1]); pw.w = cvt_pk_bf16(p[2 * kp + 1][2], p[2 * kp + 1][3]);
                    bf16x8 pf; __builtin_memcpy(&pf, &pw, 16);
                    const unsigned va = (unsigned)(size_t)Vt + (unsigned)((32 * kp + 4 * g + (l15 >> 2)) * 144 + (l15 & 3) * 8);
                    u32x2 t0[4], t1[4];
                    asm volatile("ds_read_b64_tr_b16 %0, %8\n\tds_read_b64_tr_b16 %1, %8 offset:32\n\tds_read_b64_tr_b16 %2, %8 offset:64\n\tds_read_b64_tr_b16 %3, %8 offset:96\n\t"
                                 "ds_read_b64_tr_b16 %4, %8 offset:2304\n\tds_read_b64_tr_b16 %5, %8 offset:2336\n\tds_read_b64_tr_b16 %6, %8 offset:2368\n\tds_read_b64_tr_b16 %7, %8 offset:2400\n\ts_waitcnt lgkmcnt(0)"
                                 : "=&v"(t0[0]), "=&v"(t0[1]), "=&v"(t0[2]), "=&v"(t0[3]), "=&v"(t1[0]), "=&v"(t1[1]), "=&v"(t1[2]), "=&v"(t1[3]) : "v"(va) : "memory");
#pragma unroll
                    for (int dt = 0; dt < 4; ++dt) {
                        u32x4 vw; vw.x = t0[dt].x; vw.y = t0[dt].y; vw.z = t1[dt].x; vw.w = t1[dt].y; bf16x8 vf; __builtin_memcpy(&vf, &vw, 16);
                        oacc[dt] = __builtin_amdgcn_mfma_f32_16x16x32_bf16(vf, pf, oacc[dt], 0, 0, 0);
                    }
                }
            }
            __syncthreads();
        }
#undef ATT_STAGE
        float lt = lrun; lt += __shfl_xor(lt, 16); lt += __shfl_xor(lt, 32);
        const float inv = 1.0f / lt;
#pragma unroll
        for (int dt = 0; dt < 4; ++dt) { const f32x4 o = oacc[dt] * inv; u32x2 w; w.x = cvt_pk_bf16(o[0], o[1]); w.y = cvt_pk_bf16(o[2], o[3]);
            *(u32x2*)(F.MIX + (size_t)qrow * DM + h * 64 + dt * 16 + 4 * g) = w; }
        __syncthreads();
    }
}

__device__ __forceinline__ int hg_unit(int nb, int dir) { return dir == 0 ? nb : (nb < 2 ? 1 - nb : 2 + (HG_NU - 3 - (nb - 2))); }
__device__ __forceinline__ int hg_row(int b, int nb, int t) { return nb < 2 ? b * CTXL + nb * HG_U + t : TC + b * SEQ + (nb - 2) * HG_U + t; }
template <int CTRL> __device__ __forceinline__ float dpp_add0(float x) { return x + dppf<CTRL>(0.0f, x); }
#define ROW_ALLREDUCE4(v0, v1, v2, v3) asm volatile("s_nop 1\n\t" \
    "v_add_f32_dpp %0, %0, %0 quad_perm:[1,0,3,2] row_mask:0xf bank_mask:0xf\n\tv_add_f32_dpp %1, %1, %1 quad_perm:[1,0,3,2] row_mask:0xf bank_mask:0xf\n\t" \
    "v_add_f32_dpp %2, %2, %2 quad_perm:[1,0,3,2] row_mask:0xf bank_mask:0xf\n\tv_add_f32_dpp %3, %3, %3 quad_perm:[1,0,3,2] row_mask:0xf bank_mask:0xf\n\t" \
    "v_add_f32_dpp %0, %0, %0 quad_perm:[2,3,0,1] row_mask:0xf bank_mask:0xf\n\tv_add_f32_dpp %1, %1, %1 quad_perm:[2,3,0,1] row_mask:0xf bank_mask:0xf\n\t" \
    "v_add_f32_dpp %2, %2, %2 quad_perm:[2,3,0,1] row_mask:0xf bank_mask:0xf\n\tv_add_f32_dpp %3, %3, %3 quad_perm:[2,3,0,1] row_mask:0xf bank_mask:0xf\n\t" \
    "v_add_f32_dpp %0, %0, %0 row_half_mirror row_mask:0xf bank_mask:0xf\n\tv_add_f32_dpp %1, %1, %1 row_half_mirror row_mask:0xf bank_mask:0xf\n\t" \
    "v_add_f32_dpp %2, %2, %2 row_half_mirror row_mask:0xf bank_mask:0xf\n\tv_add_f32_dpp %3, %3, %3 row_half_mirror row_mask:0xf bank_mask:0xf\n\t" \
    "v_add_f32_dpp %0, %0, %0 row_mirror row_mask:0xf bank_mask:0xf\n\tv_add_f32_dpp %1, %1, %1 row_mirror row_mask:0xf bank_mask:0xf\n\t" \
    "v_add_f32_dpp %2, %2, %2 row_mirror row_mask:0xf bank_mask:0xf\n\tv_add_f32_dpp %3, %3, %3 row_mirror row_mask:0xf bank_mask:0xf" \
    : "+v"(v0), "+v"(v1), "+v"(v2), "+v"(v3))
template <bool WITHO>
__device__ __forceinline__ void hg_pass(const Frame& F, const bf16_t* P, const float* lbh, int b, int h, int nb, int dir, f32x4 (&S)[4][4], float (&Gsum)[16],
                                        LAS bf16_t* Vl, LAS bf16_t* Kl, float* OF, const float* ngp) {
    const int tau = F.lane & 15, g = F.lane >> 4;
    const unsigned vaddr = (unsigned)(size_t)Vl + (unsigned)((4 * g + (tau >> 2)) * 128 + (tau & 3) * 8);
    const unsigned kaddr = (unsigned)(size_t)Kl + (unsigned)((4 * g + (tau >> 2)) * 128 + (tau & 3) * 8);
    u32x2 zr[4], vr[4], qr[4];
    { const int t = dir ? (HG_U - 1 - tau) : tau; const bf16_t* pr = P + (size_t)hg_row(b, nb, t) * 4096 + h * 64 + 4 * g;
#pragma unroll
      for (int m = 0; m < 4; ++m) { zr[m] = *(const u32x2*)(pr + (dir ? 2560 : 2048) + 16 * m); vr[m] = *(const u32x2*)(pr + 3072 + 16 * m); } }
    for (int ci = 0; ci < HG_U / 16; ++ci) {
        float kk[16], c[16];
        if (WITHO) { const int pos = ci * 16 + tau, t = dir ? (HG_U - 1 - pos) : pos; const bf16_t* pr = P + (size_t)hg_row(b, nb, t) * 4096 + h * 64 + 4 * g;
#pragma unroll
            for (int m = 0; m < 4; ++m) qr[m] = *(const u32x2*)(pr + 1536 + 16 * m); }
#pragma unroll
        for (int m = 0; m < 4; ++m) { const float z0 = __uint_as_float(zr[m].x << 16), z1 = __uint_as_float(zr[m].x & 0xffff0000u), z2 = __uint_as_float(zr[m].y << 16), z3 = __uint_as_float(zr[m].y & 0xffff0000u);
            const float zz[4] = {z0, z1, z2, z3};
            const f32x4 lb4 = *(const f32x4*)(lbh + 16 * m + 4 * g);
#pragma unroll
            for (int i = 0; i < 4; ++i) { const float lb = lb4[i]; const float f = fmaxf(lb + (1.0f - lb) * sigmoidf_(zz[i]), 1e-30f); kk[m * 4 + i] = 1.0f - f; c[m * 4 + i] = __logf(f); }
            *(LAS u32x2*)(Vl + tau * 64 + 16 * m + 4 * g) = vr[m];
 }
        if (ci + 1 < HG_U / 16) { const int pos = (ci + 1) * 16 + tau, t = dir ? (HG_U - 1 - pos) : pos; const bf16_t* pr = P + (size_t)hg_row(b, nb, t) * 4096 + h * 64 + 4 * g;
#pragma unroll
            for (int m = 0; m < 4; ++m) { zr[m] = *(const u32x2*)(pr + (dir ? 2560 : 2048) + 16 * m); vr[m] = *(const u32x2*)(pr + 3072 + 16 * m); } }
        float G[16];
#pragma unroll
        for (int q = 0; q < 16; ++q) G[q] = c[q];
#pragma unroll
        for (int q = 0; q < 16; q += 4) ROW_ALLREDUCE4(G[q], G[q + 1], G[q + 2], G[q + 3]);
#pragma unroll
        for (int q = 0; q < 16; ++q) { c[q] = dpp_add0<0x111>(c[q]); c[q] = dpp_add0<0x112>(c[q]); c[q] = dpp_add0<0x114>(c[q]); c[q] = dpp_add0<0x118>(c[q]); }
#pragma unroll
        for (int q = 0; q < 16; ++q) Gsum[q] += G[q];
#pragma unroll
        for (int m = 0; m < 4; ++m) { float kh[4];
#pragma unroll
            for (int i = 0; i < 4; ++i) kh[i] = kk[m * 4 + i] * __expf(G[m * 4 + i] - c[m * 4 + i]);
            u32x2 w; w.x = cvt_pk_bf16(kh[0], kh[1]); w.y = cvt_pk_bf16(kh[2], kh[3]);
            *(LAS u32x2*)(Kl + tau * 64 + 16 * m + 4 * g) = w; }
        float ofv[4][4], gtv[4][4]; int orow[4];
        if (WITHO) {
#pragma unroll
            for (int i = 0; i < 4; ++i) { const int p2 = ci * 16 + 4 * g + i, t2 = dir ? (HG_U - 1 - p2) : p2; orow[i] = hg_row(b, nb, t2); }
            if (dir) {
#pragma unroll
                for (int i = 0; i < 4; ++i)
#pragma unroll
                    for (int vt = 0; vt < 4; ++vt) { ofv[i][vt] = OF[(size_t)orow[i] * 512 + h * 64 + 16 * vt + tau]; gtv[i][vt] = bf2f(P[(size_t)orow[i] * 4096 + 3584 + h * 64 + 16 * vt + tau]); }
            }
        }
        asm volatile("s_waitcnt lgkmcnt(0)" ::: "memory");
        u32x2 vtr[4], ktr[4];
        asm volatile("ds_read_b64_tr_b16 %0, %8\n\tds_read_b64_tr_b16 %1, %8 offset:32\n\tds_read_b64_tr_b16 %2, %8 offset:64\n\tds_read_b64_tr_b16 %3, %8 offset:96\n\t"
                     "ds_read_b64_tr_b16 %4, %9\n\tds_read_b64_tr_b16 %5, %9 offset:32\n\tds_read_b64_tr_b16 %6, %9 offset:64\n\tds_read_b64_tr_b16 %7, %9 offset:96\n\ts_waitcnt lgkmcnt(0)"
                     : "=&v"(vtr[0]), "=&v"(vtr[1]), "=&v"(vtr[2]), "=&v"(vtr[3]), "=&v"(ktr[0]), "=&v"(ktr[1]), "=&v"(ktr[2]), "=&v"(ktr[3]) : "v"(vaddr), "v"(kaddr) : "memory");
        bf16x8 Vf[4], Kf[4];
#pragma unroll
        for (int q = 0; q < 4; ++q) { u32x4 w; w.x = vtr[q].x; w.y = vtr[q].y; w.z = 0u; w.w = 0u; __builtin_memcpy(&Vf[q], &w, 16); u32x4 w2; w2.x = ktr[q].x; w2.y = ktr[q].y; w2.z = 0u; w2.w = 0u; __builtin_memcpy(&Kf[q], &w2, 16); }
        if (WITHO) {
            bf16x8 Ktf[2], Qtf[2], Qhf[2];
#pragma unroll
            for (int ks = 0; ks < 2; ++ks) { float kt_[8], qt_[8], qh_[8];
#pragma unroll
                for (int mm = 0; mm < 2; ++mm) { const int m = 2 * ks + mm;
                    const float qq[4] = {__uint_as_float(qr[m].x << 16), __uint_as_float(qr[m].x & 0xffff0000u), __uint_as_float(qr[m].y << 16), __uint_as_float(qr[m].y & 0xffff0000u)};
#pragma unroll
                    for (int i = 0; i < 4; ++i) { const int q = m * 4 + i; const float qv = siluf_(qq[i]) * 0.125f; const float d = fminf(fmaxf(c[q] - 0.5f * G[q], -80.0f), 80.0f);
                        qt_[mm * 4 + i] = qv * __expf(d); kt_[mm * 4 + i] = kk[q] * __expf(-d); qh_[mm * 4 + i] = qv * __expf(c[q]); } }
                u32x4 w; w.x = cvt_pk_bf16(kt_[0], kt_[1]); w.y = cvt_pk_bf16(kt_[2], kt_[3]); w.z = cvt_pk_bf16(kt_[4], kt_[5]); w.w = cvt_pk_bf16(kt_[6], kt_[7]); __builtin_memcpy(&Ktf[ks], &w, 16);
                w.x = cvt_pk_bf16(qt_[0], qt_[1]); w.y = cvt_pk_bf16(qt_[2], qt_[3]); w.z = cvt_pk_bf16(qt_[4], qt_[5]); w.w = cvt_pk_bf16(qt_[6], qt_[7]); __builtin_memcpy(&Qtf[ks], &w, 16);
                w.x = cvt_pk_bf16(qh_[0], qh_[1]); w.y = cvt_pk_bf16(qh_[2], qh_[3]); w.z = cvt_pk_bf16(qh_[4], qh_[5]); w.w = cvt_pk_bf16(qh_[6], qh_[7]); __builtin_memcpy(&Qhf[ks], &w, 16); }
            f32x4 AT = (f32x4){0.f, 0.f, 0.f, 0.f};
            AT = __builtin_amdgcn_mfma_f32_16x16x32_bf16(Ktf[0], Qtf[0], AT, 0, 0, 0); AT = __builtin_amdgcn_mfma_f32_16x16x32_bf16(Ktf[1], Qtf[1], AT, 0, 0, 0);
#pragma unroll
            for (int i = 0; i < 4; ++i) AT[i] = (4 * g + i <= tau) ? AT[i] : 0.0f;
            bf16x8 Af; { u32x4 w; w.x = cvt_pk_bf16(AT[0], AT[1]); w.y = cvt_pk_bf16(AT[2], AT[3]); w.z = 0u; w.w = 0u; __builtin_memcpy(&Af, &w, 16); }
            f32x4 o[4];
#pragma unroll
            for (int vt = 0; vt < 4; ++vt) { o[vt] = __builtin_amdgcn_mfma_f32_16x16x32_bf16(Af, Vf[vt], (f32x4){0.f, 0.f, 0.f, 0.f}, 0, 0, 0);
#pragma unroll
                for (int ks = 0; ks < 2; ++ks) { u32x4 w; w.x = cvt_pk_bf16(S[2 * ks][vt][0], S[2 * ks][vt][1]); w.y = cvt_pk_bf16(S[2 * ks][vt][2], S[2 * ks][vt][3]);
                    w.z = cvt_pk_bf16(S[2 * ks + 1][vt][0], S[2 * ks + 1][vt][1]); w.w = cvt_pk_bf16(S[2 * ks + 1][vt][2], S[2 * ks + 1][vt][3]); bf16x8 Sf; __builtin_memcpy(&Sf, &w, 16);
                    o[vt] = __builtin_amdgcn_mfma_f32_16x16x32_bf16(Qhf[ks], Sf, o[vt], 0, 0, 0); } }
            if (dir == 0) {
#pragma unroll
                for (int i = 0; i < 4; ++i)
#pragma unroll
                    for (int vt = 0; vt < 4; ++vt) OF[(size_t)orow[i] * 512 + h * 64 + 16 * vt + tau] = o[vt][i];
            } else {
                { float tot[4][4], sq[4];
#pragma unroll
                for (int i = 0; i < 4; ++i) { sq[i] = 0.f;
#pragma unroll
                    for (int vt = 0; vt < 4; ++vt) { tot[i][vt] = o[vt][i] + ofv[i][vt]; sq[i] = fmaf(tot[i][vt], tot[i][vt], sq[i]); } }
                ROW_ALLREDUCE4(sq[0], sq[1], sq[2], sq[3]);
#pragma unroll
                for (int i = 0; i < 4; ++i) { const float rs = rsqrtf(sq[i] * (1.0f / 64.0f) + 1e-6f);
#pragma unroll
                    for (int vt = 0; vt < 4; ++vt) F.MIX[(size_t)orow[i] * DM + 512 + h * 64 + 16 * vt + tau] = f2bf(tot[i][vt] * rs * ngp[16 * vt + tau] * siluf_(gtv[i][vt])); } }
            }
        }
#pragma unroll
        for (int kt = 0; kt < 4; ++kt) { f32x4 eg;
#pragma unroll
            for (int i = 0; i < 4; ++i) eg[i] = __expf(G[kt * 4 + i]);
#pragma unroll
            for (int vt = 0; vt < 4; ++vt) S[kt][vt] = __builtin_amdgcn_mfma_f32_16x16x32_bf16(Kf[kt], Vf[vt], S[kt][vt] * eg, 0, 0, 0); }
    }
}
__device__ __forceinline__ void ph_hg_a(const Frame& F, int j) {
    const bf16_t* P = (const bf16_t*)(F.R1 + R1_P);
    float* SLOC = (float*)(F.R1 + R1_SLOC); float* DL = (float*)(F.R1 + R1_DL);
    LAS bf16_t* Vl = (LAS bf16_t*)(F.lds + 32768 + F.wave * 4096); LAS bf16_t* Kl = Vl + 1024;
    const int gw = F.wg * 8 + F.wave, nw = F.G * 8;
    const int NT = NBAT * 8 * (HG_NU - 2) * 2;
    for (int task = gw; task < NT; task += nw) {
        const int dir = task & 1, nb = 2 + (task >> 1) % (HG_NU - 2), bh = (task >> 1) / (HG_NU - 2), b = bh >> 3, h = bh & 7;
        const float* lbh = (const float*)(F.ws + OFF_LBT) + (j * 2 + dir) * 512 + h * 64;
        f32x4 S[4][4];
#pragma unroll
        for (int kt = 0; kt < 4; ++kt)
#pragma unroll
            for (int vt = 0; vt < 4; ++vt) S[kt][vt] = (f32x4){0.f, 0.f, 0.f, 0.f};
        float Gsum[16];
#pragma unroll
        for (int q = 0; q < 16; ++q) Gsum[q] = 0.f;
        hg_pass<false>(F, P, lbh, b, h, nb, dir, S, Gsum, Vl, Kl, nullptr, nullptr);
        const int seq = bh * 2 + dir, u = hg_unit(nb, dir);
        float* so = SLOC + ((size_t)seq * HG_NU + u) * 4096;
#pragma unroll
        for (int kt = 0; kt < 4; ++kt)
#pragma unroll
            for (int vt = 0; vt < 4; ++vt)
#pragma unroll
                for (int i = 0; i < 4; ++i) so[((kt * 4 + vt) * 4 + i) * 64 + F.lane] = S[kt][vt][i];
        if ((F.lane & 15) == 0) { float* dd = DL + ((size_t)seq * HG_NU + u) * 64;
#pragma unroll
            for (int m = 0; m < 4; ++m)
#pragma unroll
                for (int i = 0; i < 4; ++i) dd[16 * m + 4 * (F.lane >> 4) + i] = __expf(Gsum[m * 4 + i]); }
    }
}
__device__ __forceinline__ void ph_hg_b(const Frame& F) {
    const float* SLOC = (const float*)(F.R1 + R1_SLOC); const float* DL = (const float*)(F.R1 + R1_DL); float* SST = (float*)(F.R1 + R1_SST);
    for (int idx = F.wg * 512 + F.tid; idx < 64 * 4096; idx += F.G * 512) {
        const int seq = idx >> 12, e = idx & 4095, ln = e & 63, reg = e >> 6, i = reg & 3, kt = reg >> 4, k = 16 * kt + 4 * (ln >> 4) + i;
        float s = 0.f;
#pragma unroll 6
        for (int u = 0; u < HG_NU; ++u) { const size_t o = ((size_t)seq * HG_NU + u) * 4096 + e; SST[o] = s; s = DL[((size_t)seq * HG_NU + u) * 64 + k] * s + SLOC[o]; }
    }
}
__device__ __forceinline__ void ph_hg_c(const Frame& F, int j) {
    const bf16_t* P = (const bf16_t*)(F.R1 + R1_P);
    const float* SST = (const float*)(F.R1 + R1_SST); float* OF = (float*)(F.R1 + R1_OF);
    const float* ng = inp(F, 12) + j * 64;
    LAS bf16_t* Vl = (LAS bf16_t*)(F.lds + 32768 + F.wave * 4096); LAS bf16_t* Kl = Vl + 1024;
    const int gw = F.wg * 8 + F.wave, nw = F.G * 8;
    const int NT = NBAT * 8 * (HG_NU - 2);
    for (int task = gw; task < NT; task += nw) {
        const int nb = 2 + task % (HG_NU - 2), bh = task / (HG_NU - 2), b = bh >> 3, h = bh & 7;
        for (int dir = 0; dir < 2; ++dir) {
            const float* lbh = (const float*)(F.ws + OFF_LBT) + (j * 2 + dir) * 512 + h * 64;
            const int seq = bh * 2 + dir, u = hg_unit(nb, dir);
            const float* ss = SST + ((size_t)seq * HG_NU + u) * 4096;
            f32x4 S[4][4];
#pragma unroll
            for (int kt = 0; kt < 4; ++kt)
#pragma unroll
                for (int vt = 0; vt < 4; ++vt)
#pragma unroll
                    for (int i = 0; i < 4; ++i) S[kt][vt][i] = ss[((kt * 4 + vt) * 4 + i) * 64 + F.lane];
            float Gsum[16];
#pragma unroll
            for (int q = 0; q < 16; ++q) Gsum[q] = 0.f;
            hg_pass<true>(F, P, lbh, b, h, nb, dir, S, Gsum, Vl, Kl, OF, ng);
            asm volatile("s_waitcnt vmcnt(0)" ::: "memory");
        }
    }
}

__device__ __forceinline__ void ph_hg_ctx(const Frame& F, int j) {
    if (F.wave >= 4) return;
    const bf16_t* P = (const bf16_t*)(F.R1 + R1_P);
    float* SLOC = (float*)(F.R1 + R1_SLOC); float* DL = (float*)(F.R1 + R1_DL); float* OF = (float*)(F.R1 + R1_OF);
    const float* ng = inp(F, 12) + j * 64;
    LAS bf16_t* Vl = (LAS bf16_t*)(F.lds + 32768 + F.wave * 4096); LAS bf16_t* Kl = Vl + 1024;
    const int bh = F.wg * 4 + F.wave, b = bh >> 3, h = bh & 7;
    for (int dir = 0; dir < 2; ++dir) {
        const float* lbh = (const float*)(F.ws + OFF_LBT) + (j * 2 + dir) * 512 + h * 64;
        const int seq = bh * 2 + dir;
        f32x4 S[4][4];
#pragma unroll
        for (int kt = 0; kt < 4; ++kt)
#pragma unroll
            for (int vt = 0; vt < 4; ++vt) S[kt][vt] = (f32x4){0.f, 0.f, 0.f, 0.f};
        for (int u = 0; u < 2; ++u) {
            const int nb = dir ? 1 - u : u;
            float Gsum[16];
#pragma unroll
            for (int q = 0; q < 16; ++q) Gsum[q] = 0.f;
            hg_pass<true>(F, P, lbh, b, h, nb, dir, S, Gsum, Vl, Kl, OF, ng);
            float* so = SLOC + ((size_t)seq * HG_NU + u) * 4096;
#pragma unroll
            for (int kt = 0; kt < 4; ++kt)
#pragma unroll
                for (int vt = 0; vt < 4; ++vt)
#pragma unroll
                    for (int i = 0; i < 4; ++i) so[((kt * 4 + vt) * 4 + i) * 64 + F.lane] = S[kt][vt][i];
            if ((F.lane & 15) == 0) { float* dd = DL + ((size_t)seq * HG_NU + u) * 64;
#pragma unroll
                for (int q = 0; q < 16; ++q) dd[16 * (q >> 2) + 4 * (F.lane >> 4) + (q & 3)] = 0.0f; }
        }
        asm volatile("s_waitcnt vmcnt(0)" ::: "memory");
    }
}

__device__ __forceinline__ int lru_nat(int so, int dir) { return dir == 0 ? so : (so < 16 ? 15 - so : 16 + (LRU_NT - 1 - so)); }
__device__ __forceinline__ int lru_row(int b, int nt, int t) { return nt < 16 ? b * CTXL + nt * 16 + t : TC + b * SEQ + (nt - 16) * 16 + t; }
struct LruRaw { u32x4 a[4], b[4]; };
__device__ __forceinline__ void lru_load(const Frame& F, int b, int kb, int nt, LruRaw& R) {
    const bf16_t* P = (const bf16_t*)(F.R1 + R1_P);
    const int tk = F.lane & 15, g = F.lane >> 4;
    const int len = nt < 16 ? CTXL : SEQ, tpos = (nt < 16 ? nt * 16 : (nt - 16) * 16) + tk;
    const bf16_t* pbase = P + (size_t)((nt < 16 ? b * CTXL : TC + b * SEQ)) * 2048 + 1024 + kb * 64 + g * 16;
#pragma unroll
    for (int tap = 0; tap < 4; ++tap) { const int tp = tpos + tap - 2; const bool ok = (tp >= 0 && tp < len); const bf16_t* pr = pbase + (size_t)(ok ? tp : tpos) * 2048;
        R.a[tap] = *(const u32x4*)pr; R.b[tap] = *(const u32x4*)(pr + 8); if (!ok) { R.a[tap] = (u32x4){0u, 0u, 0u, 0u}; R.b[tap] = (u32x4){0u, 0u, 0u, 0u}; } }
}
__device__ __forceinline__ void lru_conv(const Frame& F, const LruRaw& R, const LAS float* CT, LAS float* ucb) {
    const int tk = F.lane & 15, g = F.lane >> 4;
    float acc[16];
#pragma unroll
    for (int q = 0; q < 4; ++q) { const f32x4 c4 = *(const LAS f32x4*)(CT + 4 * 64 + g * 16 + q * 4); acc[q * 4] = c4[0]; acc[q * 4 + 1] = c4[1]; acc[q * 4 + 2] = c4[2]; acc[q * 4 + 3] = c4[3]; }
#pragma unroll
    for (int tap = 0; tap < 4; ++tap) { float t0[8], t1[8]; unpack8(R.a[tap], t0); unpack8(R.b[tap], t1);
#pragma unroll
        for (int q = 0; q < 2; ++q) { const f32x4 w0 = *(const LAS f32x4*)(CT + tap * 64 + g * 16 + q * 4), w1 = *(const LAS f32x4*)(CT + tap * 64 + g * 16 + 8 + q * 4);
#pragma unroll
            for (int i = 0; i < 4; ++i) { acc[q * 4 + i] = fmaf(w0[i], t0[q * 4 + i], acc[q * 4 + i]); acc[8 + q * 4 + i] = fmaf(w1[i], t1[q * 4 + i], acc[8 + q * 4 + i]); } } }
#pragma unroll
    for (int q = 0; q < 4; ++q) *(LAS f32x4*)(ucb + tk * 68 + g * 16 + q * 4) = (f32x4){acc[q * 4], acc[q * 4 + 1], acc[q * 4 + 2], acc[q * 4 + 3]};
}
__device__ __forceinline__ void lru_gates(const Frame& F, LAS bf16_t* Wl, const LAS float* CT, LAS float* ucb, float (&av)[2][4][4], float (&xv)[2][4][4]) {
    const int tk = F.lane & 15, g = F.lane >> 4;
    bf16x8 bfr[2];
#pragma unroll
    for (int ks = 0; ks < 2; ++ks) { const f32x4 u0 = *(const LAS f32x4*)(ucb + tk * 68 + ks * 32 + g * 8), u1 = *(const LAS f32x4*)(ucb + tk * 68 + ks * 32 + g * 8 + 4);
        u32x4 w; w.x = cvt_pk_bf16(u0[0], u0[1]); w.y = cvt_pk_bf16(u0[2], u0[3]); w.z = cvt_pk_bf16(u1[0], u1[1]); w.w = cvt_pk_bf16(u1[2], u1[3]); __builtin_memcpy(&bfr[ks], &w, 16); }
#pragma unroll
    for (int d = 0; d < 2; ++d)
#pragma unroll
        for (int et = 0; et < 4; ++et) {
            f32x4 ra = (f32x4){0.f, 0.f, 0.f, 0.f}, ri = (f32x4){0.f, 0.f, 0.f, 0.f};
#pragma unroll
            for (int ks = 0; ks < 2; ++ks) {
                const bf16x8 wa = *(const LAS bf16x8*)(Wl + ((d * 2 + 0) * 64 + et * 16 + tk) * 72 + ks * 32 + g * 8);
                const bf16x8 wx = *(const LAS bf16x8*)(Wl + ((d * 2 + 1) * 64 + et * 16 + tk) * 72 + ks * 32 + g * 8);
                ra = __builtin_amdgcn_mfma_f32_16x16x32_bf16(wa, bfr[ks], ra, 0, 0, 0);
                ri = __builtin_amdgcn_mfma_f32_16x16x32_bf16(wx, bfr[ks], ri, 0, 0, 0);
            }
            const f32x4 ba4 = *(const LAS f32x4*)(CT + (5 + 3 * d) * 64 + et * 16 + 4 * g), bx4 = *(const LAS f32x4*)(CT + (6 + 3 * d) * 64 + et * 16 + 4 * g), cs4 = *(const LAS f32x4*)(CT + (7 + 3 * d) * 64 + et * 16 + 4 * g);
            const f32x4 u4 = *(const LAS f32x4*)(ucb + tk * 68 + et * 16 + 4 * g);
#pragma unroll
            for (int i = 0; i < 4; ++i) {
                const float r = sigmoidf_(ra[i] + ba4[i]), ig = sigmoidf_(ri[i] + bx4[i]);
                const float la = cs4[i] * r, a = __expf(la);
                av[d][et][i] = la; xv[d][et][i] = __builtin_amdgcn_sqrtf(fmaxf(1.0f - a * a, 0.f)) * ig * u4[i]; }
        }
}
template <int S> __device__ __forceinline__ void lru_step_f(float& a, float& x) { const float ap = dppf<0x110 + S>(1.0f, a), xp = dppf<0x110 + S>(0.0f, x); x = fmaf(a, xp, x); a = a * ap; }
template <int S> __device__ __forceinline__ void lru_step_b(float& a, float& x) { const float ap = dppf<0x100 + S>(1.0f, a), xp = dppf<0x100 + S>(0.0f, x); x = fmaf(a, xp, x); a = a * ap; }
#define LRU_DPP_STEP(SH, x_, a_) asm volatile("s_nop 1\n\t" \
    "v_fmac_f32_dpp %0, %0, %4 " SH " row_mask:0xf bank_mask:0xf\n\tv_fmac_f32_dpp %1, %1, %5 " SH " row_mask:0xf bank_mask:0xf\n\t" \
    "v_fmac_f32_dpp %2, %2, %6 " SH " row_mask:0xf bank_mask:0xf\n\tv_fmac_f32_dpp %3, %3, %7 " SH " row_mask:0xf bank_mask:0xf\n\t" \
    "v_mul_f32_dpp %4, %4, %4 " SH " row_mask:0xf bank_mask:0xf\n\tv_mul_f32_dpp %5, %5, %5 " SH " row_mask:0xf bank_mask:0xf\n\t" \
    "v_mul_f32_dpp %6, %6, %6 " SH " row_mask:0xf bank_mask:0xf\n\tv_mul_f32_dpp %7, %7, %7 " SH " row_mask:0xf bank_mask:0xf" \
    : "+v"(x_[0]), "+v"(x_[1]), "+v"(x_[2]), "+v"(x_[3]), "+v"(a_[0]), "+v"(a_[1]), "+v"(a_[2]), "+v"(a_[3]))
#define LRU_SCANS(av, xv) do { _Pragma("unroll") for (int et = 0; et < 4; ++et) { \
        LRU_DPP_STEP("row_shr:1", xv[0][et], av[0][et]); LRU_DPP_STEP("row_shl:1", xv[1][et], av[1][et]); } \
    _Pragma("unroll") for (int et = 0; et < 4; ++et) { LRU_DPP_STEP("row_shr:2", xv[0][et], av[0][et]); LRU_DPP_STEP("row_shl:2", xv[1][et], av[1][et]); } \
    _Pragma("unroll") for (int et = 0; et < 4; ++et) { LRU_DPP_STEP("row_shr:4", xv[0][et], av[0][et]); LRU_DPP_STEP("row_shl:4", xv[1][et], av[1][et]); } \
    _Pragma("unroll") for (int et = 0; et < 4; ++et) { LRU_DPP_STEP("row_shr:8", xv[0][et], av[0][et]); LRU_DPP_STEP("row_shl:8", xv[1][et], av[1][et]); } } while (0)
__device__ __forceinline__ void ph_lru_a(const Frame& F, int jj) {
    LAS bf16_t* Wl = (LAS bf16_t*)F.lds;
    LAS float* ucb = (LAS float*)(F.lds + 36864 + F.wave * 4352);
    LAS float* CT = (LAS float*)(F.lds + 36864 + 8 * 4352);
    const bf16_t* wsrc = (const bf16_t*)(F.WB + WB_LRU);
    float* AG = (float*)(F.R1 + R1_AG); bf16_t* GX = (bf16_t*)(F.R1 + R1_GX);
    const float* cw = inp(F, 14) + (size_t)jj * 4 * 1024; const float* cb = inp(F, 15) + (size_t)jj * 1024;
    const float* b_a = inp(F, 17) + (size_t)jj * 2 * 1024; const float* b_x = inp(F, 19) + (size_t)jj * 2 * 1024; const float* lam = inp(F, 20) + (size_t)jj * 2 * 1024;
    const int tk = F.lane & 15, g = F.lane >> 4;
    const int NTASK = NBAT * 16 * 11;
    for (int task = F.wg; task < NTASK; task += F.G) {
        const int grp = task % 11, kb = (task / 11) & 15, b = task / (11 * 16);
        __syncthreads();
        for (int i = F.tid; i < 4 * 4096 / 8; i += 512) { const int mg = i >> 9, r = i & 511;
            *(LAS u32x4*)(Wl + (mg * 64 + (r >> 3)) * 72 + (r & 7) * 8) = *(const u32x4*)(wsrc + ((size_t)mg * 16 + kb) * 4096 + r * 8); }
        for (int i = F.tid; i < 11 * 64; i += 512) { const int kind = i >> 6, ch = kb * 64 + (i & 63); float v;
            if (kind < 4) v = cw[kind * 1024 + ch]; else if (kind == 4) v = cb[ch];
            else { const int d = (kind - 5) / 3, w = (kind - 5) % 3; v = (w == 0) ? b_a[d * 1024 + ch] : (w == 1) ? b_x[d * 1024 + ch] : -8.0f * log1pf(__expf(-lam[d * 1024 + ch])); }
            CT[i] = v; }
        __syncthreads();
        const int nt0 = grp * 48;
        LruRaw raw; lru_load(F, b, kb, nt0 + F.wave, raw);
        for (int ti = F.wave; ti < 48; ti += 8) {
            const int nt = nt0 + ti;
            float av[2][4][4], xv[2][4][4];
            lru_conv(F, raw, CT, ucb);
            if (ti + 8 < 48) lru_load(F, b, kb, nt + 8, raw);
            lru_gates(F, Wl, CT, ucb, av, xv);
            const int row = lru_row(b, nt, tk);
#pragma unroll
            for (int d = 0; d < 2; ++d)
#pragma unroll
                for (int et = 0; et < 4; ++et) { u32x4 w; w.x = cvt_pk_bf16(av[d][et][0], xv[d][et][0]); w.y = cvt_pk_bf16(av[d][et][1], xv[d][et][1]); w.z = cvt_pk_bf16(av[d][et][2], xv[d][et][2]); w.w = cvt_pk_bf16(av[d][et][3], xv[d][et][3]);
                    __builtin_nontemporal_store(w, (u32x4*)(GX + (((size_t)row * 2 + d) * 1024 + kb * 64 + et * 16 + 4 * g) * 2));
                    const unsigned ww[4] = {w.x, w.y, w.z, w.w};
#pragma unroll
                    for (int i = 0; i < 4; ++i) { av[d][et][i] = __expf(__uint_as_float(ww[i] << 16)); xv[d][et][i] = __uint_as_float(ww[i] & 0xffff0000u); } }
            LRU_SCANS(av, xv);
#pragma unroll
            for (int d = 0; d < 2; ++d) if (tk == (d ? 0 : 15)) {
                float* ag = AG + (((size_t)(b * 2 + d) * LRU_NT + nt) * 2) * 1024 + kb * 64;
#pragma unroll
                for (int et = 0; et < 4; ++et) { *(f32x4*)(ag + et * 16 + 4 * g) = (f32x4){av[d][et][0], av[d][et][1], av[d][et][2], av[d][et][3]};
                    *(f32x4*)(ag + 1024 + et * 16 + 4 * g) = (f32x4){xv[d][et][0], xv[d][et][1], xv[d][et][2], xv[d][et][3]}; }
            }
        }
    }
    __syncthreads();
}
__device__ __forceinline__ void ph_lru_c(const Frame& F) {
    const float* HST = (const float*)(F.R1 + R1_HST); const bf16_t* GX = (const bf16_t*)(F.R1 + R1_GX);
    const bf16_t* P = (const bf16_t*)(F.R1 + R1_P);
    const int tk = F.lane & 15, g = F.lane >> 4;
    const int gw = F.wg * 8 + F.wave, nw = F.G * 8;
    for (int task = gw; task < NBAT * LRU_NT * 16; task += nw) {
        const int kb = task & 15, nt = (task >> 4) % LRU_NT, b = (task >> 4) / LRU_NT;
        const int row = lru_row(b, nt, tk);
        u32x4 gx[2][4]; f32x4 hf[4], hb[4]; u32x2 yw[4];
#pragma unroll
        for (int d = 0; d < 2; ++d)
#pragma unroll
            for (int et = 0; et < 4; ++et) gx[d][et] = *(const u32x4*)(GX + (((size_t)row * 2 + d) * 1024 + kb * 64 + et * 16 + 4 * g) * 2);
#pragma unroll
        for (int et = 0; et < 4; ++et) { const int ch = kb * 64 + et * 16 + 4 * g;
            hf[et] = *(const f32x4*)(HST + ((size_t)(b * 2 + 0) * LRU_NT + nt) * 1024 + ch);
            hb[et] = *(const f32x4*)(HST + ((size_t)(b * 2 + 1) * LRU_NT + nt) * 1024 + ch);
            yw[et] = *(const u32x2*)(P + (size_t)row * 2048 + ch); }
        float av[2][4][4], xv[2][4][4];
#pragma unroll
        for (int d = 0; d < 2; ++d)
#pragma unroll
            for (int et = 0; et < 4; ++et) { const unsigned ww[4] = {gx[d][et].x, gx[d][et].y, gx[d][et].z, gx[d][et].w};
#pragma unroll
                for (int i = 0; i < 4; ++i) { av[d][et][i] = __expf(__uint_as_float(ww[i] << 16)); xv[d][et][i] = __uint_as_float(ww[i] & 0xffff0000u); } }
        LRU_SCANS(av, xv);
#pragma unroll
        for (int et = 0; et < 4; ++et) {
            const int ch = kb * 64 + et * 16 + 4 * g;
            const float y0 = __uint_as_float(yw[et].x << 16), y1 = __uint_as_float(yw[et].x & 0xffff0000u), y2 = __uint_as_float(yw[et].y << 16), y3 = __uint_as_float(yw[et].y & 0xffff0000u);
            float o[4];
#pragma unroll
            for (int i = 0; i < 4; ++i) o[i] = fmaf(av[0][et][i], hf[et][i], xv[0][et][i]) + fmaf(av[1][et][i], hb[et][i], xv[1][et][i]);
            o[0] *= gelu_tanh_(y0); o[1] *= gelu_tanh_(y1); o[2] *= gelu_tanh_(y2); o[3] *= gelu_tanh_(y3);
            u32x2 w; w.x = cvt_pk_bf16(o[0], o[1]); w.y = cvt_pk_bf16(o[2], o[3]);
            *(u32x2*)(F.MIX + (size_t)row * DM + ch) = w;
        }
    }
}
__device__ __forceinline__ void ph_lru_b(const Frame& F) {
    const float* AG = (const float*)(F.R1 + R1_AG); float* HST = (float*)(F.R1 + R1_HST);
    LAS float* sa = (LAS float*)F.lds; LAS float* sx = sa + 512;
    for (int task = F.wg; task < NBAT * 2 * 32; task += F.G) {
        const int cgp = task & 31, d = (task >> 5) & 1, b = task >> 6;
        const int ch = cgp * 32 + (F.tid & 31), seg = F.tid >> 5;
        const float* ag = AG + ((size_t)(b * 2 + d) * LRU_NT) * 2048 + ch;
        float A = 1.0f, Xv = 0.f;
        for (int i = 0; i < 33; ++i) { const int nt = lru_nat(seg * 33 + i, d); const float a = ag[(size_t)nt * 2048], x = ag[(size_t)nt * 2048 + 1024]; Xv = fmaf(a, Xv, x); A *= a; }
        __syncthreads();
        sa[F.tid] = A; sx[F.tid] = Xv;
        __syncthreads();
        float h = 0.f;
        for (int s2 = 0; s2 < seg; ++s2) h = fmaf(sa[s2 * 32 + (F.tid & 31)], h, sx[s2 * 32 + (F.tid & 31)]);
        float* hs = HST + ((size_t)(b * 2 + d) * LRU_NT) * 1024 + ch;
        for (int i = 0; i < 33; ++i) { const int nt = lru_nat(seg * 33 + i, d); hs[(size_t)nt * 1024] = h; const float a = ag[(size_t)nt * 2048], x = ag[(size_t)nt * 2048 + 1024]; h = fmaf(a, h, x); }
    }
    __syncthreads();
}

__device__ __forceinline__ void topk_better(float& bk, int& be, float& bs, float ok, int oe, float os) { const bool t = (ok > bk) || (ok == bk && oe < be); bk = t ? ok : bk; be = t ? oe : be; bs = t ? os : bs; }
template <int CTRL> __device__ __forceinline__ void topk_step(float& bk, int& be, float& bs) {
    const float ok = dppf<CTRL>(bk, bk), os = dppf<CTRL>(bs, bs); const int oe = __builtin_amdgcn_update_dpp(be, be, CTRL, 0xf, 0xf, false); topk_better(bk, be, bs, ok, oe, os); }
__device__ __forceinline__ void ph_ln_router(const Frame& F, int l, bool dry = false) {
    const bf16_t* RW = (const bf16_t*)(F.WB + WB_RT);
    const float* rbias = inp(F, 23) + l * 64;
    LAS float* part = (LAS float*)F.lds;
    LAS float* LP = (LAS float*)(F.lds + 4096);
    LAS int* hist = (LAS int*)(F.lds + LDS_MISC + MISC_HIST); LAS int* hbase = (LAS int*)(F.lds + LDS_MISC + MISC_HBASE);
    int* tok_e = (int*)(F.ws + OFF_TOKE); int* tok_p = (int*)(F.ws + OFF_TOKP); float* tok_w = (float*)(F.ws + OFF_TOKW);
    int* stok = (int*)(F.ws + OFF_STOK); float* sw = (float*)(F.ws + OFF_SW);
    float* stats = (float*)(F.ws + OFF_STATS);
    unsigned* gcnt = (unsigned*)(F.ws + OFF_CTL + CTL_CNT) + l * 64;
    const int tk = F.lane & 15, g = F.lane >> 4;
    float rb[4];
#pragma unroll
    for (int q = 0; q < 4; ++q) rb[q] = rbias[tk + 16 * q];
    if (F.tid < 64) hist[F.tid] = 0;
    __syncthreads();
    const int NTILE = TT / 16, TILE0 = (l == 3) ? TC / 16 : 0;
    bf16x8 rwf[4][4];
#pragma unroll
    for (int et = 0; et < 4; ++et)
#pragma unroll
        for (int ks = 0; ks < 4; ++ks) rwf[et][ks] = *(const bf16x8*)(RW + (size_t)(et * 16 + tk) * 1024 + F.wave * 128 + ks * 32 + g * 8);
    f32x4 vn[4][2];
    if (TILE0 + F.wg < NTILE) { const float* xr = F.X + (size_t)((TILE0 + F.wg) * 16 + tk) * DM + F.wave * 128 + g * 8;
#pragma unroll
        for (int ks = 0; ks < 4; ++ks) { vn[ks][0] = *(const f32x4*)(xr + ks * 32); vn[ks][1] = *(const f32x4*)(xr + ks * 32 + 4); } }
    for (int tile = TILE0 + F.wg; tile < NTILE; tile += F.G) {
        const int row = tile * 16 + tk; const int s = slot_of_row(tile * 16);
        const float* ab = (const float*)(F.ws + OFF_AB) + (size_t)(l * 5 + s) * 2048;
        f32x4 v[4][2];
#pragma unroll
        for (int ks = 0; ks < 4; ++ks) { v[ks][0] = vn[ks][0]; v[ks][1] = vn[ks][1]; }
        if (tile + F.G < NTILE) { const float* xr = F.X + (size_t)((tile + F.G) * 16 + tk) * DM + F.wave * 128 + g * 8;
#pragma unroll
            for (int ks = 0; ks < 4; ++ks) { vn[ks][0] = *(const f32x4*)(xr + ks * 32); vn[ks][1] = *(const f32x4*)(xr + ks * 32 + 4); } }
        float sum = 0.f, sq = 0.f;
#pragma unroll
        for (int ks = 0; ks < 4; ++ks)
#pragma unroll
            for (int hh = 0; hh < 2; ++hh) { const f32x4 a = v[ks][hh]; sum += (a[0] + a[1]) + (a[2] + a[3]); sq += (a[0] * a[0] + a[1] * a[1]) + (a[2] * a[2] + a[3] * a[3]); }
        sum += __shfl_xor(sum, 16); sum += __shfl_xor(sum, 32); sq += __shfl_xor(sq, 16); sq += __shfl_xor(sq, 32);
        if (g == 0) *(LAS f32x2*)(part + (F.wave * 16 + tk) * 2) = (f32x2){sum, sq};
        __syncthreads();
        float ts = 0.f, tq = 0.f;
#pragma unroll
        for (int w = 0; w < 8; ++w) { const f32x2 p = *(const LAS f32x2*)(part + (w * 16 + tk) * 2); ts += p.x; tq += p.y; }
        const float mean = ts * (1.0f / 1024.0f), var = fmaxf(tq * (1.0f / 1024.0f) - mean * mean, 0.f), rstd = rsqrtf(var + 1e-5f);
        if (F.wave == 0 && g == 0) *(f32x2*)(stats + (size_t)row * 2) = (f32x2){mean, rstd};
        f32x4 acc[4];
#pragma unroll
        for (int et = 0; et < 4; ++et) acc[et] = (f32x4){0.f, 0.f, 0.f, 0.f};
#pragma unroll
        for (int ks = 0; ks < 4; ++ks) { const int k = F.wave * 128 + ks * 32 + g * 8;
            const f32x4 a10 = *(const f32x4*)(ab + k), a11 = *(const f32x4*)(ab + k + 4), b10 = *(const f32x4*)(ab + 1024 + k), b11 = *(const f32x4*)(ab + 1024 + k + 4);
            const f32x4 h0 = (v[ks][0] - mean) * rstd * a10 + b10, h1 = (v[ks][1] - mean) * rstd * a11 + b11;
            u32x4 w; w.x = cvt_pk_bf16(h0[0], h0[1]); w.y = cvt_pk_bf16(h0[2], h0[3]); w.z = cvt_pk_bf16(h1[0], h1[1]); w.w = cvt_pk_bf16(h1[2], h1[3]);
            *(u32x4*)(F.HB + (size_t)row * DM + k) = w;
            bf16x8 af; __builtin_memcpy(&af, &w, 16);
#pragma unroll
            for (int et = 0; et < 4; ++et) acc[et] = __builtin_amdgcn_mfma_f32_16x16x32_bf16(af, rwf[et][ks], acc[et], 0, 0, 0);
        }
#pragma unroll
        for (int et = 0; et < 4; ++et)
#pragma unroll
            for (int i = 0; i < 4; ++i) LP[(F.wave * 16 + 4 * g + i) * 64 + et * 16 + tk] = acc[et][i];
        __syncthreads();
        {
            const int t = 2 * F.wave + (g & 1), r2 = tile * 16 + t;
            float sc[4], key[4];
#pragma unroll
            for (int q = 0; q < 4; ++q) { float lgt = 0.f;
#pragma unroll
                for (int w = 0; w < 8; ++w) lgt += LP[(w * 16 + t) * 64 + tk + 16 * q];
                sc[q] = sigmoidf_(lgt); key[q] = sc[q] + rb[q]; }
            unsigned taken = 0u; int se[6]; float ss[6]; float tot = 0.f;
#pragma unroll
            for (int sel = 0; sel < 6; ++sel) {
                float bk = -1e30f, bs = 0.f; int be = 0;
#pragma unroll
                for (int q = 0; q < 4; ++q) if (!((taken >> q) & 1u) && key[q] > bk) { bk = key[q]; be = tk + 16 * q; bs = sc[q]; }
                topk_step<0xB1>(bk, be, bs); topk_step<0x4E>(bk, be, bs); topk_step<0x141>(bk, be, bs); topk_step<0x140>(bk, be, bs);
                if ((be & 15) == tk) taken |= 1u << (be >> 4);
                se[sel] = be; ss[sel] = bs; tot += bs;
            }
            const float sc2 = 2.5f / tot;
            if (tk < 6 && g < 2) {
                int e = se[0]; float w = ss[0];
#pragma unroll
                for (int q = 1; q < 6; ++q) if (tk == q) { e = se[q]; w = ss[q]; }
                tok_e[r2 * 8 + tk] = e; tok_w[r2 * 8 + tk] = w * sc2; if (!dry) tok_p[r2 * 8 + tk] = __hip_atomic_fetch_add(hist + e, 1, __ATOMIC_RELAXED, __HIP_MEMORY_SCOPE_WORKGROUP);
            }
        }
    }
    asm volatile("s_waitcnt vmcnt(0) lgkmcnt(0)" ::: "memory");
    __syncthreads();
    if (dry) return;
    if (F.tid < 64) hbase[F.tid] = (int)__hip_atomic_fetch_add(gcnt + F.tid, (unsigned)hist[F.tid], __ATOMIC_RELAXED, __HIP_MEMORY_SCOPE_AGENT);
    __syncthreads();
    for (int tile = TILE0 + F.wg; tile < NTILE; tile += F.G) {
        if (F.tid < 96) { const int row = tile * 16 + F.tid / 6, q = F.tid % 6; const int e = tok_e[row * 8 + q]; const int pos = hbase[e] + tok_p[row * 8 + q];
            tok_p[row * 8 + q] = pos; stok[(size_t)e * CAP + pos] = row; sw[(size_t)e * CAP + pos] = tok_w[row * 8 + q]; }
    }
    __syncthreads();
}

__device__ __forceinline__ int moe_tables(const Frame& F, int l) {
    const int t0 = (l == 3) ? TC : 0;
    LAS int* cnt = (LAS int*)(F.lds + LDS_MISC + MISC_CNT); LAS int* tst = (LAS int*)(F.lds + LDS_MISC + MISC_TST); LAS unsigned char* t2e = (LAS unsigned char*)(F.lds + LDS_MISC + MISC_T2E);
    const unsigned* gcnt = (const unsigned*)(F.ws + OFF_CTL + CTL_CNT) + l * 64;
    __syncthreads();
    if (F.tid < 64) cnt[F.tid] = (int)__hip_atomic_load(gcnt + F.tid, __ATOMIC_RELAXED, __HIP_MEMORY_SCOPE_AGENT);
    if (F.tid == 64) cnt[64] = TT - t0;
    __syncthreads();
    if (F.tid == 0) { int s = 0; for (int e = 0; e < 65; ++e) { tst[e] = s; s += (cnt[e] + 255) >> 8; } tst[65] = s; }
    __syncthreads();
    const int ntiles = tst[65];
    for (int t = F.tid; t < ntiles; t += 512) { int e = 0; for (int q = 0; q < 65; ++q) if (t >= tst[q]) e = q; else break; t2e[t] = (unsigned char)e; }
    __syncthreads();
    return ntiles;
}

template <int CTRL> __device__ __forceinline__ float dpp_f(float x) { return __builtin_bit_cast(float, __builtin_amdgcn_update_dpp(0, __builtin_bit_cast(int, x), CTRL, 0xF, 0xF, true)); }
#define WAVE_SUM64(x) do { x += dpp_f<0xB1>(x); x += dpp_f<0x4E>(x); x += dpp_f<0x141>(x); x += dpp_f<0x140>(x); \
    x = __builtin_bit_cast(float, __builtin_amdgcn_readlane(__builtin_bit_cast(int, x), 0)) + __builtin_bit_cast(float, __builtin_amdgcn_readlane(__builtin_bit_cast(int, x), 16)) \
      + __builtin_bit_cast(float, __builtin_amdgcn_readlane(__builtin_bit_cast(int, x), 32)) + __builtin_bit_cast(float, __builtin_amdgcn_readlane(__builtin_bit_cast(int, x), 48)); } while (0)
template <bool lastl> __device__ __forceinline__ void ph_combine_t(const Frame& F, int l, bool dry) {
    LAS int* tst = (LAS int*)(F.lds + LDS_MISC + MISC_TST);
    (void)moe_tables(F, l);
    const int t0 = lastl ? TC : 0;
    LAS float* CT = (LAS float*)F.lds;
    {
        const float* gam = inp(F, 6) + (size_t)(l * 2 + 1) * DM; const float* bet = inp(F, 7) + (size_t)(l * 2 + 1) * DM;
        const float* gam0 = inp(F, 6) + (size_t)(l * 2 + 0) * DM; const float* bet0 = inp(F, 7) + (size_t)(l * 2 + 0) * DM;
        for (int k = F.tid; k < 1024; k += 512) {
            CT[k] = ALPHA * gam0[k]; CT[1024 + k] = ALPHA * bet0[k]; CT[2048 + k] = gam[k]; CT[3072 + k] = bet[k];
#pragma unroll
            for (int s = 0; s < 5; ++s) {
                const float* m = F.mods + (size_t)(l * 5 + s) * 6144; const float* mn = F.mods + (size_t)((lastl ? l : l + 1) * 5 + s) * 6144;
                CT[(4 + s * 3) * 1024 + k] = m[5 * 1024 + k]; CT[(5 + s * 3) * 1024 + k] = 1.0f + mn[1024 + k]; CT[(6 + s * 3) * 1024 + k] = mn[k];
            }
        }
        __syncthreads();
    }
    const float* stats = (const float*)(F.ws + OFF_STATS);
    const unsigned char* Y = (const unsigned char*)(F.R1 + R1_Y);
    const int* tok_e = (const int*)(F.ws + OFF_TOKE); const int* tok_p = (const int*)(F.ws + OFF_TOKP); const float* tok_w = (const float*)(F.ws + OFF_TOKW);
    const int gw = F.wg * 8 + F.wave, nw = F.G * 8;
    const int l4 = F.lane * 4, q8 = F.lane & 7;
    const int sh0 = __builtin_amdgcn_readfirstlane(tst[64]) * 256 - t0;
#define CMB_IDX(E_, P_, W_, row_) do { E_ = tok_e[(row_) * 8 + q8]; P_ = tok_p[(row_) * 8 + q8]; W_ = tok_w[(row_) * 8 + q8]; } while (0)
#define CMB_ISSUE(Yb, Xb, Sb, Wb, E_, P_, W_, row_) do { \
        const int sl_ = tst[(E_) & 63] * 256 + (P_); \
        _Pragma("unroll") for (int q = 0; q < 6; ++q) Wb[q] = __builtin_bit_cast(float, __builtin_amdgcn_readlane(__builtin_bit_cast(int, W_), q)) * (1.0f / 16.0f); \
        _Pragma("unroll") for (int q = 0; q < 7; ++q) { const int sr_ = (q < 6) ? __builtin_amdgcn_readlane(sl_, q) : (sh0 + (row_)); \
            const unsigned char* yp_ = Y + (size_t)sr_ * DM + l4; \
            _Pragma("unroll") for (int c = 0; c < 4; ++c) Yb[q * 4 + c] = *(const unsigned*)(yp_ + c * 256); } \
        _Pragma("unroll") for (int c = 0; c < 4; ++c) Xb[c] = *(const f32x4*)(F.X + (size_t)(row_) * DM + c * 256 + l4); \
        Sb = *(const f32x2*)(stats + (size_t)(row_) * 2); } while (0)
#define CMB_COMPUTE(Yb, Xb, Sb, Wb, row_) do { \
        LAS const float* cs_ = CT + (4 + slot_of_row(row_) * 3) * 1024 + l4; \
        float v[16]; \
        _Pragma("unroll") for (int c = 0; c < 4; ++c) { \
            const f32x4 ag = *(LAS const f32x4*)(CT + c * 256 + l4), ab = *(LAS const f32x4*)(CT + 1024 + c * 256 + l4), m5 = *(LAS const f32x4*)(cs_ + c * 256); \
            f32x2 ya = (f32x2){0.f, 0.f}, yb = ya; \
            _Pragma("unroll") for (int q = 0; q < 7; ++q) { const float wq_ = (q < 6) ? Wb[q] : (1.0f / 16.0f); ya += __builtin_amdgcn_cvt_pk_f32_fp8((int)Yb[q * 4 + c], false) * wq_; yb += __builtin_amdgcn_cvt_pk_f32_fp8((int)Yb[q * 4 + c], true) * wq_; } \
            const f32x4 xh = (Xb[c] - Sb.x) * Sb.y; \
            v[c * 4 + 0] = xh[0] * ag[0] + ab[0] + m5[0] * ya.x; v[c * 4 + 1] = xh[1] * ag[1] + ab[1] + m5[1] * ya.y; \
            v[c * 4 + 2] = xh[2] * ag[2] + ab[2] + m5[2] * yb.x; v[c * 4 + 3] = xh[3] * ag[3] + ab[3] + m5[3] * yb.y; } \
        float sum = 0.f; \
        _Pragma("unroll") for (int i = 0; i < 16; ++i) sum += v[i]; \
        WAVE_SUM64(sum); \
        const float mean = sum * (1.0f / 1024.0f); \
        float sq = 0.f; \
        _Pragma("unroll") for (int i = 0; i < 16; ++i) { const float d = v[i] - mean; sq += d * d; } \
        WAVE_SUM64(sq); \
        const float rstd = rsqrtf(sq * (1.0f / 1024.0f) + 1e-5f); \
        _Pragma("unroll") for (int c = 0; c < 4; ++c) { \
            const f32x4 g = *(LAS const f32x4*)(CT + 2048 + c * 256 + l4), b = *(LAS const f32x4*)(CT + 3072 + c * 256 + l4); \
            f32x4 xn; \
            _Pragma("unroll") for (int i = 0; i < 4; ++i) xn[i] = (v[c * 4 + i] - mean) * rstd * g[i] + b[i]; \
            if (dry) { const float acc_ = xn[0] + xn[1] + xn[2] + xn[3]; asm volatile("" :: "v"(acc_)); } \
            else if (lastl) { *(f32x4*)(F.out + (size_t)((row_) - TC) * DM + c * 256 + l4) = xn; } \
            else { \
                *(f32x4*)(F.X + (size_t)(row_) * DM + c * 256 + l4) = xn; \
                const f32x4 s1 = *(LAS const f32x4*)(cs_ + 1024 + c * 256), b0 = *(LAS const f32x4*)(cs_ + 2048 + c * 256); \
                const f32x4 hv = xn * s1 + b0; \
                u32x2 w; w.x = cvt_pk_bf16(hv[0], hv[1]); w.y = cvt_pk_bf16(hv[2], hv[3]); \
                *(u32x2*)(F.HB + (size_t)(row_) * DM + c * 256 + l4) = w; } } } while (0)
    unsigned yA[28], yB[28]; f32x4 xA[4], xB[4]; f32x2 sA, sB; float wA[6], wB[6]; int eN = 0, pN = 0, eNN = 0, pNN = 0; float wN = 0.f, wNN = 0.f;
    const int row0 = t0 + gw;
    CMB_IDX(eNN, pNN, wNN, row0);
    if (row0 + nw < TT) CMB_IDX(eN, pN, wN, row0 + nw);
    CMB_ISSUE(yA, xA, sA, wA, eNN, pNN, wNN, row0);
    int row = row0;
    for (; row + 3 * nw < TT; row += 2 * nw) {
        const int r1 = row + nw, r2 = row + 2 * nw, r3 = row + 3 * nw;
        CMB_IDX(eNN, pNN, wNN, r2);
        CMB_ISSUE(yB, xB, sB, wB, eN, pN, wN, r1);
        CMB_COMPUTE(yA, xA, sA, wA, row);
        CMB_IDX(eN, pN, wN, r3);
        CMB_ISSUE(yA, xA, sA, wA, eNN, pNN, wNN, r2);
        CMB_COMPUTE(yB, xB, sB, wB, r1);
    }
    for (; row < TT; row += 2 * nw) {
        const int r1 = row + nw, r2 = row + 2 * nw, r3 = row + 3 * nw;
        if (r2 < TT) CMB_IDX(eNN, pNN, wNN, r2);
        if (r1 < TT) CMB_ISSUE(yB, xB, sB, wB, eN, pN, wN, r1);
        CMB_COMPUTE(yA, xA, sA, wA, row);
        if (r1 < TT) {
            if (r3 < TT) CMB_IDX(eN, pN, wN, r3);
            if (r2 < TT) CMB_ISSUE(yA, xA, sA, wA, eNN, pNN, wNN, r2);
            CMB_COMPUTE(yB, xB, sB, wB, r1);
        }
    }
#undef CMB_IDX
#undef CMB_ISSUE
#undef CMB_COMPUTE
}
__device__ __forceinline__ void ph_combine(const Frame& F, int l, bool dry = false) { if (l == 3) ph_combine_t<true>(F, l, dry); else ph_combine_t<false>(F, l, dry); }

constexpr int NPHASE = 2 + 4 * 10;
__global__ void __launch_bounds__(512, 2) mk_fwd(Args args) {
    extern __shared__ __attribute__((aligned(16))) unsigned char lds_raw[];
    Frame F;
    F.out = args.out; F.ws = args.ws; F.lds = (LAS unsigned char*)lds_raw;
    { const int t0 = threadIdx.x; F.wave = __builtin_amdgcn_readfirstlane(t0 >> 6); F.lane = t0 & 63; F.tid = t0; } F.G = gridDim.x; F.wg = blockIdx.x;
    F.mods = (float*)(args.ws + OFF_MODS); F.X = (float*)(args.ws + OFF_X); F.HB = (bf16_t*)(args.ws + OFF_HB); F.MIX = F.HB;
    F.WB = args.ws + OFF_WB; F.R1 = args.ws + OFF_R1;
    volatile LAS unsigned* xbw = (volatile LAS unsigned*)(F.lds + LDS_MISC);
    if (F.tid < 4) xbw[F.tid] = 0u;
    if (F.tid < 30) ((LAS unsigned long long*)(F.lds + LDS_MISC + MISC_INP))[F.tid] = (unsigned long long)args.in[F.tid];
    __syncthreads();
    const int lo = args.ph_lo, hi = args.ph_hi;
    XcdBarrier bar; bar.bar = (unsigned*)(args.ws + OFF_CTL); bar.x = 0; bar.st = xbw;
    if (hi - lo > 1) bar = xcd_barrier_post((unsigned*)(args.ws + OFF_CTL), xbw);
#define IN(k) (lo <= (k) && (k) < hi)
#define SEAM(k) do { if (IN(k) && IN((k) + 1)) { xcd_barrier(bar); if (REPM & 1) xcd_barrier(bar); } } while (0)
    if ((PHM & 1) && IN(0)) { ph_mods(fresh(F)); if (REPM & 65536) { __syncthreads(); ph_mods(fresh(F)); } } SEAM(0);
    if ((PHM & 2) && IN(1)) { ph_init_x(fresh(F)); if (REPM & 131072) ph_init_x(fresh(F)); }
    for (int l = 0; l < 4; ++l) {
        const int pb = 2 + l * 10, j = l >> 1; const bool even = (l & 1) == 0;
        float* mods_l = F.mods + (size_t)l * 5 * 6144;
        F.WB = args.ws + OFF_WB + (size_t)(l & 1) * WB_END;
        if ((PHM & 4) && IN(pb + 0) && !(l & 1)) { for (int rep = 0; rep < ((REPM & 4) ? 2 : 1); ++rep) { ph_convert(fresh(F), l); __syncthreads(); } }
        if (!(l & 1)) SEAM(pb + 0);
        if ((PHM & 8) && IN(pb + 1)) {
            const int N = even ? 4096 : 2048;
            pg8::StaticOrder S; S.init(F.HB, F.WB + WB_IN, TT, N, 1024, F.G, F.wg);
            pg8::EpiStoreBf16 E{(bf16_t*)(F.R1 + R1_P), N};
            for (int rep = 0; rep < ((REPM & 8) ? 2 : 1); ++rep) pg8::gemm_phase(F.lds, 1024, S, E, F.wave);
        } SEAM(pb + 1);
        if (IN(pb + 2)) { if (even) { if (F.wg < 8 && F.G > 16) { ph_hg_ctx(fresh(F), j); } else if (PHM & 16) for (int rep = 0; rep < ((REPM & 16) ? 2 : 1); ++rep) { Frame Fa = fresh(F); if (F.G > 16) { Fa.wg = F.wg - 8; Fa.G = F.G - 8; } ph_attn(Fa, j); } if (PHM & 32) for (int rep = 0; rep < ((REPM & 32) ? 2 : 1); ++rep) ph_hg_a(fresh(F), j); } else { if (PHM & 64) for (int rep = 0; rep < ((REPM & 64) ? 2 : 1); ++rep) ph_lru_a(fresh(F), j); } } SEAM(pb + 2);
        if (IN(pb + 3)) { if (even) { if (PHM & 128) for (int rep = 0; rep < ((REPM & 128) ? 2 : 1); ++rep) { ph_hg_b(fresh(F));
                { Frame Fc = fresh(F); Fc.WB = args.ws + OFF_WB + (size_t)((l + 1) & 1) * WB_END; ph_convert(Fc, l + 1); } } } else { if (PHM & 256) for (int rep = 0; rep < ((REPM & 256) ? 2 : 1); ++rep) ph_lru_b(fresh(F)); } } SEAM(pb + 3);
        if (IN(pb + 4)) { if (even) { if (PHM & 512) for (int rep = 0; rep < ((REPM & 512) ? 2 : 1); ++rep) ph_hg_c(fresh(F), j); } else { if (PHM & 1024) for (int rep = 0; rep < ((REPM & 1024) ? 2 : 1); ++rep) ph_lru_c(fresh(F)); } } SEAM(pb + 4);
        if ((PHM & 2048) && IN(pb + 5)) {
            const int t0 = (l == 3) ? TC : 0;
            pg8::StaticOrder S; S.init(F.MIX + (size_t)t0 * DM, F.WB + WB_OUT, TT - t0, 1024, 1024, F.G, F.wg);
            pg8::EpiResid E{F.X + (size_t)t0 * DM, mods_l, t0};
            pg8::gemm_phase(F.lds, 1024, S, E, F.wave);
        } SEAM(pb + 5);
        if ((PHM & 4096) && IN(pb + 6)) { if (REPM & 4096) ph_ln_router(fresh(F), l, true); ph_ln_router(fresh(F), l); } SEAM(pb + 6);
        if ((PHM & 8192) && IN(pb + 7)) {
            const int ntiles = moe_tables(fresh(F), l);
            pg8::MoeGU S; S.cnt = (const LAS int*)(F.lds + LDS_MISC + MISC_CNT); S.tst = (const LAS int*)(F.lds + LDS_MISC + MISC_TST); S.t2e = (const LAS unsigned char*)(F.lds + LDS_MISC + MISC_T2E);
            S.ntiles = ntiles; S.G = F.G; S.c = F.wg; S.A = (const char*)F.HB; S.Bt = (const char*)(F.WB + WB_GU); S.stok = (const int*)(F.ws + OFF_STOK); S.t0 = (l == 3) ? TC : 0;
            pg8::EpiSwiglu E{(bf16_t*)(F.R1 + R1_H)};
            for (int rep = 0; rep < ((REPM & 8192) ? 2 : 1); ++rep) pg8::gemm_phase(F.lds, 1024, S, E, F.wave);
        } SEAM(pb + 7);
        if ((PHM & 16384) && IN(pb + 8)) {
            const int ntiles = moe_tables(fresh(F), l);
            pg8::MoeDN S; S.cnt = (const LAS int*)(F.lds + LDS_MISC + MISC_CNT); S.tst = (const LAS int*)(F.lds + LDS_MISC + MISC_TST); S.t2e = (const LAS unsigned char*)(F.lds + LDS_MISC + MISC_T2E);
            S.ntiles = ntiles; S.G = F.G; S.c = F.wg; S.A = (const char*)(F.R1 + R1_H); S.Bt = (const char*)(F.WB + WB_DN);
            pg8::EpiDown E{(unsigned char*)(F.R1 + R1_Y)};
            if (REPM & 2) { pg8::EpiNull EN; pg8::gemm_phase(F.lds, 256, S, EN, F.wave); }
            if (REPM & (1 << 21)) { pg8::EpiDownProbe<1> EN{(unsigned char*)F.out, nullptr, nullptr}; pg8::gemm_phase(F.lds, 256, S, EN, F.wave); }
            if (REPM & (1 << 22)) { pg8::EpiDownProbe<2> EN{(unsigned char*)F.out, nullptr, nullptr}; pg8::gemm_phase(F.lds, 256, S, EN, F.wave); }
            if (REPM & (1 << 23)) { pg8::EpiDownProbe<3> EN{(unsigned char*)F.out, nullptr, nullptr}; pg8::gemm_phase(F.lds, 256, S, EN, F.wave); }
            for (int rep = 0; rep < ((REPM & 16384) ? 2 : 1); ++rep) pg8::gemm_phase(F.lds, 256, S, E, F.wave);
        } SEAM(pb + 8);
        if ((PHM & 32768) && IN(pb + 9)) { if (REPM & 32768) ph_combine(fresh(F), l, true); ph_combine(fresh(F), l); } SEAM(pb + 9);
    }
#undef IN
#undef SEAM
}

extern "C" void kernel_launch(void* const* d_in, const int* in_sizes, int n_in, void* d_out, int out_size, void* d_ws, size_t ws_size, hipStream_t stream) {
    static int grid = 0;
    if (grid == 0) {
        if (n_in != 30 || out_size != TX * DM || ws_size < WS_END) { fprintf(stderr, "kernel_launch: unexpected problem (n_in %d out %d ws %zu need %zu)\n", n_in, out_size, ws_size, (size_t)WS_END); grid = -1; return; }
        int dev = 0, cus = 0, per_cu = 0;
        if (hipGetDevice(&dev) != hipSuccess || hipDeviceGetAttribute(&cus, hipDeviceAttributeMultiprocessorCount, dev) != hipSuccess) { grid = -1; return; }
        if (hipFuncSetAttribute((const void*)mk_fwd, hipFuncAttributeMaxDynamicSharedMemorySize, LDS_BYTES) != hipSuccess) { fprintf(stderr, "kernel_launch: hipFuncSetAttribute failed\n"); grid = -1; return; }
        if (hipOccupancyMaxActiveBlocksPerMultiprocessor(&per_cu, (const void*)mk_fwd, 512, LDS_BYTES) != hipSuccess || per_cu < 1) { fprintf(stderr, "kernel_launch: occupancy query says %d\n", per_cu); }
        (void)hipGetLastError();
        grid = cus;
    }
    if (grid < 0) return;
    (void)hipMemsetAsync((char*)d_ws + OFF_CTL, 0, CTL_BYTES, stream);
    Args a{};
    for (int i = 0; i < 30; ++i) a.in[i] = (const float*)d_in[i];
    a.out = (float*)d_out; a.ws = (unsigned char*)d_ws;
#if MK_SPLIT
    for (int p = 0; p < NPHASE; ++p) { a.ph_lo = p; a.ph_hi = p + 1; hipLaunchKernelGGL(mk_fwd, dim3(grid), dim3(512), LDS_BYTES, stream, a); }
#else
    a.ph_lo = 0; a.ph_hi = NPHASE;
    hipLaunchKernelGGL(mk_fwd, dim3(grid), dim3(512), LDS_BYTES, stream, a);
#endif
}
```

```cpp
#include <hip/hip_runtime.h>
#include <cstdio>
#include <cstdint>

#ifndef PHM
#define PHM 0xFFFF
#endif
#ifndef REPM
#define REPM 0
#endif
#ifndef MK_SPLIT
#define MK_SPLIT 0
#endif

typedef unsigned short bf16_t;
typedef short bf16x8 __attribute__((ext_vector_type(8)));
typedef short bf16x4 __attribute__((ext_vector_type(4)));
typedef float f32x4 __attribute__((ext_vector_type(4)));
typedef float f32x2 __attribute__((ext_vector_type(2)));
typedef unsigned u32x4 __attribute__((ext_vector_type(4)));
typedef unsigned u32x2 __attribute__((ext_vector_type(2)));
#define LAS __attribute__((address_space(3)))

constexpr int DM = 1024, NBAT = 4, SEQ = 8192, CTXL = 256;
constexpr int TC = NBAT * CTXL, TX = NBAT * SEQ, TT = TC + TX;
constexpr int NEXP = 64, TOPK = 6;
constexpr int CAP = TT;
constexpr int MOE_ROUTED_ROWS = 6 * TT + 64 * 256;
constexpr int MOE_ROWS = MOE_ROUTED_ROWS + TT;
constexpr int MOE_MAXTILES = MOE_ROWS / 256;
constexpr float ALPHA = 1.681792830507429f;
constexpr int HG_U = 128, HG_NU = (CTXL + SEQ) / HG_U;
constexpr int LRU_NT = (CTXL + SEQ) / 16;

constexpr size_t OFF_CTL = 0, CTL_BYTES = 65536;
constexpr size_t CTL_CNT = 16384, CTL_DBG = 20480;
constexpr size_t OFF_MODS = 65536;
constexpr size_t OFF_LBT = OFF_MODS + 4 * 5 * 6144 * 4;
constexpr size_t OFF_STATS = OFF_LBT + 8192;
constexpr size_t OFF_AB = OFF_STATS + (size_t)TT * 8;
static_assert(OFF_AB + 4 * 5 * 2 * 1024 * 4 <= (1u << 20), "ctl map");
constexpr size_t OFF_TOKE = 1u << 20;
constexpr size_t OFF_TOKP = OFF_TOKE + (size_t)TT * 32;
constexpr size_t OFF_TOKW = OFF_TOKP + (size_t)TT * 32;
constexpr size_t OFF_STOK = OFF_TOKW + (size_t)TT * 32;
constexpr size_t OFF_SW = OFF_STOK + (size_t)64 * CAP * 4;
constexpr size_t OFF_X = OFF_SW + (size_t)64 * CAP * 4;
constexpr size_t OFF_HB = OFF_X + (size_t)TT * DM * 4;
constexpr size_t OFF_WB = OFF_HB + (size_t)TT * DM * 2;
constexpr size_t WB_IN = 0, WB_OUT = WB_IN + (size_t)4096 * 1024 * 2, WB_RT = WB_OUT + (size_t)1024 * 1024 * 2, WB_GU = WB_RT + (size_t)64 * 1024 * 2,
                 WB_DN = WB_GU + (size_t)65 * 512 * 1024 * 2, WB_LRU = WB_DN + (size_t)65 * 1024 * 256 * 2, WB_END = WB_LRU + (size_t)2 * 2 * 16 * 64 * 64 * 2;
constexpr size_t OFF_R1 = OFF_WB + 2 * WB_END;
constexpr size_t R1_P = 0;
constexpr size_t R1_OF = R1_P + (size_t)TT * 4096 * 2;
constexpr size_t R1_SLOC = R1_OF + (size_t)TT * 512 * 4;
constexpr size_t R1_SST = R1_SLOC + (size_t)64 * HG_NU * 4096 * 4;
constexpr size_t R1_DL = R1_SST + (size_t)64 * HG_NU * 4096 * 4;
constexpr size_t R1_AG = (size_t)TT * 2048 * 2;
constexpr size_t R1_HST = R1_AG + (size_t)4 * 2 * LRU_NT * 2 * 1024 * 4;
constexpr size_t R1_GX = R1_HST + (size_t)4 * 2 * LRU_NT * 1024 * 4;
constexpr size_t R1_LRU_END = R1_GX + (size_t)TT * 2 * 1024 * 2 * 2;
constexpr size_t R1_H = 0;
constexpr size_t R1_Y = R1_H + (size_t)MOE_ROWS * 256 * 2;
constexpr size_t R1_MOE_END = R1_Y + (size_t)MOE_ROWS * 1024;
constexpr size_t R1_MIX_END = R1_DL + (size_t)64 * HG_NU * 64 * 4;
constexpr size_t R1_END_ = (R1_MOE_END > R1_MIX_END ? R1_MOE_END : R1_MIX_END);
constexpr size_t WS_END = OFF_R1 + (R1_END_ > R1_LRU_END ? R1_END_ : R1_LRU_END);

constexpr int LDS_STAGE = 131072;
constexpr int LDS_MISC = LDS_STAGE;
constexpr int MISC_CNT = 64;
constexpr int MISC_TST = MISC_CNT + 66 * 4 + 8;
constexpr int MISC_HIST = 640;
constexpr int MISC_HBASE = 896;
constexpr int MISC_T2E = 1152;
constexpr int MISC_INP = 2304;
constexpr int LDS_BYTES = 147456;

#define XB_TMO      128
#define XB_XCNT(j)  (256  + 64 * (j))
#define XB_XSUB(j)  (1280 + 64 * (j))
#define XB_XGEN(j)  (2304 + 64 * (j))
#define XB_TOP      3328
#define XB_TOPGEN   3392
#define XCD_BAR_WORDS 3456
#define XB_SPIN_CAP (1u << 22)
__device__ __forceinline__ unsigned xb_ld(unsigned* p)              { return __hip_atomic_load(p, __ATOMIC_RELAXED, __HIP_MEMORY_SCOPE_AGENT); }
__device__ __forceinline__ unsigned xb_add(unsigned* p, unsigned v) { return __hip_atomic_fetch_add(p, v, __ATOMIC_RELAXED, __HIP_MEMORY_SCOPE_AGENT); }
__device__ __forceinline__ unsigned xb_xcc_id() { return (unsigned)__builtin_amdgcn_s_getreg((3 << 11) | 20) & 0xFu; }
#define XB_SPIN(cond, bar) do { unsigned _sp = 0; while (cond) { __builtin_amdgcn_s_sleep(1); \
    if ((++_sp & 255u) == 0u) { if (xb_ld(&(bar)[XB_TMO])) break; if (_sp > XB_SPIN_CAP) { atomicAdd(&(bar)[XB_TMO], 1u); break; } } } } while (0)
struct XcdBarrier { unsigned* bar; unsigned x; volatile LAS unsigned* st; };
__device__ __forceinline__ XcdBarrier xcd_barrier_post(unsigned* bar, volatile LAS unsigned* st) {
    XcdBarrier b; b.bar = bar; b.x = xb_xcc_id(); b.st = st;
    if (threadIdx.x == 0) (void)xb_add(&bar[XB_XCNT(b.x)], 1u);
    return b;
}
__device__ __forceinline__ void xcd_barrier_complete(unsigned* bar, unsigned x, unsigned& nloc, unsigned& nx) {
    const unsigned G = gridDim.x * gridDim.y * gridDim.z;
    unsigned sum, cnt, mine, sp = 0u;
    for (;;) {
        sum = 0u; cnt = 0u; mine = 0u;
#pragma unroll
        for (unsigned j = 0; j < 16; ++j) { const unsigned c = xb_ld(&bar[XB_XCNT(j)]); sum += c; cnt += (c > 0u) ? 1u : 0u; mine = (j == x) ? c : mine; }
        if (sum == G) break;
        __builtin_amdgcn_s_sleep(1);
        if ((++sp & 255u) == 0u) { if (xb_ld(&bar[XB_TMO])) break; if (sp > XB_SPIN_CAP) { atomicAdd(&bar[XB_TMO], 1u); break; } }
    }
    nloc = mine > 0u ? mine : 1u; nx = cnt > 0u ? cnt : 1u;
}
__device__ __forceinline__ void xcd_barrier(const XcdBarrier& b) {
    asm volatile("s_waitcnt vmcnt(0)" ::: "memory");
    __syncthreads();
    if (threadIdx.x == 0) {
        unsigned* bar = b.bar;
        __builtin_amdgcn_s_waitcnt(0);
        unsigned nloc = b.st[0], nx = b.st[1];
        if (nloc == 0u) { xcd_barrier_complete(bar, b.x, nloc, nx); b.st[0] = nloc; b.st[1] = nx; }
        const unsigned old = xb_add(&bar[XB_XSUB(b.x)], 1u);
        const unsigned gen = old / nloc;
        if (old + 1u == (gen + 1u) * nloc) {
            __builtin_amdgcn_fence(__ATOMIC_RELEASE, "agent");
            asm volatile("s_waitcnt vmcnt(0)" ::: "memory");
            const unsigned og = xb_add(&bar[XB_TOP], 1u);
            const unsigned tg = og / nx;
            if (og + 1u == (tg + 1u) * nx) xb_add(&bar[XB_TOPGEN], 1u);
            else XB_SPIN(xb_ld(&bar[XB_TOPGEN]) == tg, bar);
            __builtin_amdgcn_fence(__ATOMIC_ACQUIRE, "agent");
            xb_add(&bar[XB_XGEN(b.x)], 1u);
            asm volatile("s_waitcnt vmcnt(0)" ::: "memory");
        } else {
            XB_SPIN(xb_ld(&bar[XB_XGEN(b.x)]) == gen, bar);
            __builtin_amdgcn_fence(__ATOMIC_ACQUIRE, "agent");
            asm volatile("s_waitcnt vmcnt(0)" ::: "memory");
        }
    }
    __syncthreads();
}

__device__ __forceinline__ float bf2f(unsigned short b) { return __uint_as_float(((unsigned)b) << 16); }
__device__ __forceinline__ unsigned cvt_pk_bf16(float lo, float hi) { unsigned r; asm volatile("v_cvt_pk_bf16_f32 %0, %1, %2" : "=v"(r) : "v"(lo), "v"(hi)); return r; }
__device__ __forceinline__ unsigned short f2bf(float f) { return (unsigned short)(cvt_pk_bf16(f, 0.f) & 0xffffu); }
__device__ __forceinline__ float sigmoidf_(float x) { return __builtin_amdgcn_rcpf(1.0f + __expf(-x)); }
__device__ __forceinline__ float siluf_(float x) { return x * sigmoidf_(x); }
__device__ __forceinline__ float gelu_tanh_(float x) { return x * sigmoidf_(1.5957691216057308f * (x + 0.044715f * x * x * x)); }
__device__ __forceinline__ int slot_of_row(int r) { return r < TC ? 4 : ((r - TC) >> 13); }
template <int CTRL> __device__ __forceinline__ float dppf(float oldv, float src) {
    return __int_as_float(__builtin_amdgcn_update_dpp(__float_as_int(oldv), __float_as_int(src), CTRL, 0xf, 0xf, false));
}
__device__ __forceinline__ void unpack8(const u32x4 w, float (&o)[8]) {
    o[0] = __uint_as_float(w.x << 16); o[1] = __uint_as_float(w.x & 0xffff0000u); o[2] = __uint_as_float(w.y << 16); o[3] = __uint_as_float(w.y & 0xffff0000u);
    o[4] = __uint_as_float(w.z << 16); o[5] = __uint_as_float(w.z & 0xffff0000u); o[6] = __uint_as_float(w.w << 16); o[7] = __uint_as_float(w.w & 0xffff0000u);
}

namespace pg8 {
constexpr int BM = 256, BK = 64, HALF = 128, HTB = HALF * BK * 2, STAGE_BYTES = 8 * HTB, NXCD = 8, WGM = 8;
__device__ __forceinline__ int lds_byte(int r, int c) { const int st = (r >> 4) * 2 + (c >> 5), rr = r & 15, cc = c & 31, ob = rr * 64 + cc * 2; return st * 1024 + (ob ^ (((ob >> 9) & 1) << 5)); }
__device__ __forceinline__ void stage_rc(int b, int& R, int& C) { const int st = b / 1024, sb = b % 1024, swz = sb ^ (((sb >> 9) & 1) << 5); R = (st >> 1) * 16 + swz / 64; C = (st & 1) * 32 + (swz % 64) / 2; }
__device__ __forceinline__ int perm32(int rho) { const int n = rho >> 4, i = rho & 15; return 8 * (i >> 2) + 4 * n + (i & 3); }
struct Unit { int pm, pn, e, ti; };

struct StaticOrder {
    const char* A; const char* Bt; int K;
    int nM, nN, nwg, G, c;
    __device__ __forceinline__ void init(const void* A_, const void* Bt_, int M, int N, int K_, int G_, int c_) { A = (const char*)A_; Bt = (const char*)Bt_; K = K_; nM = M / BM; nN = N / BM; nwg = nM * nN; G = G_; c = c_; }
    __device__ __forceinline__ bool next(int i, Unit& u) const {
        const long L = (long)i * G + c; if (L >= nwg) return false;
        int wgid = (int)L; { const int q = nwg / NXCD, r = nwg % NXCD, xcd = wgid % NXCD, off = wgid / NXCD; wgid = (xcd < r ? xcd * (q + 1) : r * (q + 1) + (xcd - r) * q) + off; }
        const int nig = WGM * nN, gid = wgid / nig, fm = gid * WGM, gsz = (nM - fm) < WGM ? (nM - fm) : WGM;
        u.pm = fm + ((wgid % nig) % gsz); u.pn = (wgid % nig) / gsz; u.e = 0; u.ti = 0; return true;
    }
    static constexpr bool GATHER = false;
    __device__ __forceinline__ const char* abase(const Unit& u) const { return A + (size_t)u.pm * BM * K * 2; }
    __device__ __forceinline__ const char* bbase(const Unit& u) const { return Bt + (size_t)u.pn * BM * K * 2; }
};

template <class Epi, class Sched>
__device__ __forceinline__ void gemm_phase(LAS unsigned char* lds, const int K_, const Sched& S, const Epi& E, const int wave_) {
    int Kl_ = K_; asm volatile("" : "+s"(Kl_)); const int K = Kl_;
    int tid_ = wave_ * 64 + (int)__builtin_amdgcn_mbcnt_hi(~0u, __builtin_amdgcn_mbcnt_lo(~0u, 0u)); asm volatile("" : "+v"(tid_));
    const int tid = tid_, wid = __builtin_amdgcn_readfirstlane(tid >> 6), lane = tid & 63, wr = wid >> 2, wc = wid & 3, fr = lane & 15, fq = lane >> 4;
    const int nt = K / BK;
    unsigned voffA[2], voffB[2];
#pragma unroll
    for (int i = 0; i < 2; ++i) { int R, C; stage_rc(tid * 16 + i * 8192, R, C);
        const int Rb = Epi::PERM == 1 ? ((R & ~31) + perm32(R & 31)) : Epi::PERM == 2 ? (64 * (R >> 5) + 16 * ((R & 15) >> 2) + 4 * ((R >> 4) & 1) + (R & 3)) : R;
        voffA[i] = (unsigned)(R * K + C) * 2u; voffB[i] = (unsigned)(Rb * K + C) * 2u; }
    const size_t kstep = (size_t)(BK * 2);
    const size_t hstep = (size_t)HALF * K * 2;
    const size_t hstepB = Epi::PERM == 2 ? (size_t)8 * K * 2 : hstep;
    const unsigned ldsw = (unsigned)wid * 1024u;
    const int aoff = lds_byte(wr * 64 + fr, fq * 8), boff = lds_byte(wc * 32 + fr, fq * 8);
#define PG8_SA(b, h) (((b) * 2 + (h)) * HTB)
#define PG8_SB(b, h) ((4 + (b) * 2 + (h)) * HTB)
#define PG8_STAGE(bufoff, gbase, voff) do { _Pragma("unroll") for (int _i = 0; _i < 2; ++_i) \
        __builtin_amdgcn_global_load_lds((const unsigned*)((const char*)(gbase) + (voff)[_i]), (LAS unsigned*)(lds + (bufoff) + ldsw + _i * 8192), 16, 0, 0); } while (0)
#define PG8_STAGEA(bufoff, hh, kb, nx) do { if constexpr (Sched::GATHER) { unsigned _o[2]; _o[0] = (nx) ? vN[hh][0] : vC[hh][0]; _o[1] = (nx) ? vN[hh][1] : vC[hh][1]; PG8_STAGE(bufoff, cA + (kb), _o); } \
        else { PG8_STAGE(bufoff, ((nx) ? nA : cA) + (hh) * hstep + (kb), voffA); } } while (0)
#define PG8_LDA(dst, b, h) do { _Pragma("unroll") for (int m = 0; m < 4; ++m) _Pragma("unroll") for (int k = 0; k < 2; ++k) dst[m][k] = *(const LAS bf16x8*)(lds + PG8_SA(b, h) + aoff + m * 2048 + k * 1024); } while (0)
#define PG8_LDB(dst, b, h) do { _Pragma("unroll") for (int n = 0; n < 2; ++n) _Pragma("unroll") for (int k = 0; k < 2; ++k) dst[n][k] = *(const LAS bf16x8*)(lds + PG8_SB(b, h) + boff + n * 2048 + k * 1024); } while (0)
#define PG8_MMA(ai, bj, At, Bt) do { __builtin_amdgcn_s_setprio(1); _Pragma("unroll") for (int m = 0; m < 4; ++m) _Pragma("unroll") for (int n = 0; n < 2; ++n) _Pragma("unroll") for (int k = 0; k < 2; ++k) \
        acc[ai][bj][m][n] = __builtin_amdgcn_mfma_f32_16x16x32_bf16(Bt[n][k], At[m][k], acc[ai][bj][m][n], 0, 0, 0); __builtin_amdgcn_s_setprio(0); } while (0)
#define PG8_WAIT_V(n) asm volatile("s_waitcnt vmcnt(" #n ")" ::: "memory")
#define PG8_WAIT_L(n) asm volatile("s_waitcnt lgkmcnt(" #n ")" ::: "memory")
#define PG8_BAR __builtin_amdgcn_s_barrier()
#define PG8_SCHED __builtin_amdgcn_sched_barrier(0)
    Unit cur, nxt; int ui = 0;
    if (!S.next(0, cur)) return;
    f32x4 acc[2][2][4][2];
#pragma unroll
    for (int a = 0; a < 2; ++a)
#pragma unroll
        for (int b = 0; b < 2; ++b)
#pragma unroll
            for (int m = 0; m < 4; ++m)
#pragma unroll
                for (int n = 0; n < 2; ++n) acc[a][b][m][n] = (f32x4){0.f, 0.f, 0.f, 0.f};
    bf16x8 At[4][2], B0[2][2], B1[2][2];
    unsigned vC[2][2], vN[2][2];
    if constexpr (Sched::GATHER) S.aoff(cur, tid, vC);
    const char* cA = S.abase(cur);
    const char* cB = S.bbase(cur);
    const char* nA = cA;
    PG8_STAGE(PG8_SB(0, 0), cB, voffB); PG8_STAGEA(PG8_SA(0, 0), 0, 0, false); PG8_STAGE(PG8_SB(0, 1), cB + hstepB, voffB); PG8_STAGEA(PG8_SA(0, 1), 1, 0, false);
    if (wr == 1) PG8_BAR;
    PG8_WAIT_V(4); PG8_BAR;
    PG8_STAGE(PG8_SB(1, 0), cB + kstep, voffB); PG8_STAGEA(PG8_SA(1, 0), 0, kstep, false); PG8_STAGE(PG8_SB(1, 1), cB + hstepB + kstep, voffB);
    PG8_WAIT_V(6); PG8_BAR;
    for (;;) {
        const bool has_next = S.next(ui + 1, nxt);
        const char* nB = cB; nA = cA;
        if (has_next) { nB = S.bbase(nxt); nA = S.abase(nxt); if constexpr (Sched::GATHER) S.aoff(nxt, tid, vN); }
        else { if constexpr (Sched::GATHER) {
#pragma unroll
            for (int h = 0; h < 2; ++h)
#pragma unroll
                for (int i = 0; i < 2; ++i) vN[h][i] = vC[h][i]; } }
        for (int t = 0; t < nt; t += 2) {
            const bool last = (t == nt - 2);
            const size_t k1 = (size_t)(t + 1) * kstep, k2 = last ? 0 : (size_t)(t + 2) * kstep, k3 = k2 + kstep;
            const char* b2 = last ? nB : cB + (size_t)(t + 2) * kstep; const char* b3 = b2 + kstep;
            PG8_LDB(B0, 0, 0); PG8_SCHED; PG8_LDA(At, 0, 0); PG8_STAGEA(PG8_SA(1, 1), 1, k1, false);
            PG8_WAIT_L(8); PG8_BAR; PG8_WAIT_L(0); PG8_MMA(0, 0, At, B0); PG8_BAR; PG8_SCHED;
            PG8_LDB(B1, 0, 1); PG8_STAGE(PG8_SB(0, 0), b2, voffB);
            PG8_BAR; PG8_WAIT_L(0); PG8_MMA(0, 1, At, B1); PG8_BAR;
            PG8_LDA(At, 0, 1); PG8_STAGEA(PG8_SA(0, 0), 0, k2, last);
            PG8_BAR; PG8_WAIT_L(0); PG8_MMA(1, 0, At, B0); PG8_BAR; PG8_SCHED;
            PG8_STAGE(PG8_SB(0, 1), b2 + hstepB, voffB);
            PG8_WAIT_V(6); PG8_BAR; PG8_MMA(1, 1, At, B1); PG8_BAR;
            PG8_LDB(B0, 1, 0); PG8_SCHED; PG8_LDA(At, 1, 0); PG8_STAGEA(PG8_SA(0, 1), 1, k2, last);
            PG8_WAIT_L(8); PG8_BAR; PG8_WAIT_L(0); PG8_MMA(0, 0, At, B0); PG8_BAR; PG8_SCHED;
            PG8_LDB(B1, 1, 1); PG8_STAGE(PG8_SB(1, 0), b3, voffB);
            PG8_BAR; PG8_WAIT_L(0); PG8_MMA(0, 1, At, B1); PG8_BAR;
            PG8_LDA(At, 1, 1); PG8_STAGEA(PG8_SA(1, 0), 0, k3, last);
            PG8_BAR; PG8_WAIT_L(0); PG8_MMA(1, 0, At, B0); PG8_BAR; PG8_SCHED;
            PG8_STAGE(PG8_SB(1, 1), b3 + hstepB, voffB);
            PG8_WAIT_V(6); PG8_BAR; PG8_MMA(1, 1, At, B1); PG8_BAR;
        }
        E(acc, cur, wr, wc, fr, fq);
        if (!has_next) break;
#pragma unroll
        for (int a = 0; a < 2; ++a)
#pragma unroll
            for (int b = 0; b < 2; ++b)
#pragma unroll
                for (int m = 0; m < 4; ++m)
#pragma unroll
                    for (int n = 0; n < 2; ++n) acc[a][b][m][n] = (f32x4){0.f, 0.f, 0.f, 0.f};
        cur = nxt; cB = nB; cA = nA; ++ui;
        if constexpr (Sched::GATHER) {
#pragma unroll
            for (int h = 0; h < 2; ++h)
#pragma unroll
                for (int i = 0; i < 2; ++i) vC[h][i] = vN[h][i]; }
    }
    PG8_WAIT_V(0);
    if (wr == 0) PG8_BAR;
    PG8_BAR;
#undef PG8_SA
#undef PG8_SB
#undef PG8_STAGE
#undef PG8_STAGEA
#undef PG8_LDA
#undef PG8_LDB
#undef PG8_MMA
#undef PG8_WAIT_V
#undef PG8_WAIT_L
#undef PG8_BAR
#undef PG8_SCHED
}

struct EpiStoreBf16 {
    static constexpr int PERM = 2;
    bf16_t* O; int ldc;
    __device__ __forceinline__ void operator()(const f32x4 (&acc)[2][2][4][2], const Unit& u, int wr, int wc, int fr, int fq) const {
        const int row0 = u.pm * BM + wr * 64 + fr, col0 = u.pn * BM + wc * 64 + 16 * fq;
#pragma unroll
        for (int ai = 0; ai < 2; ++ai)
#pragma unroll
            for (int m = 0; m < 4; ++m) { bf16_t* rowp = O + (size_t)(row0 + ai * HALF + m * 16) * ldc + col0;
#pragma unroll
                for (int bj = 0; bj < 2; ++bj) { const f32x4 v0 = acc[ai][bj][m][0], v1 = acc[ai][bj][m][1];
                    u32x4 w; w.x = cvt_pk_bf16(v0[0], v0[1]); w.y = cvt_pk_bf16(v0[2], v0[3]); w.z = cvt_pk_bf16(v1[0], v1[1]); w.w = cvt_pk_bf16(v1[2], v1[3]);
                    *(u32x4*)(rowp + bj * 8) = w; } }
    }
};
struct EpiResid {
    static constexpr int PERM = 0;
    float* X; const float* mods_l; int rbase;
    __device__ __forceinline__ void operator()(const f32x4 (&acc)[2][2][4][2], const Unit& u, int wr, int wc, int fr, int fq) const {
        const int row0 = u.pm * BM + wr * 64 + fr, col0 = u.pn * BM + wc * 32 + 4 * fq;
        const float* m2 = mods_l + (size_t)(slot_of_row(rbase + u.pm * BM) * 6 + 2) * DM + col0;
        float* xb = X + (size_t)row0 * DM + col0;
        f32x4 mv[4], xv[2][8];
#pragma unroll
        for (int g = 0; g < 4; ++g) mv[g] = *(const f32x4*)(m2 + (g >> 1) * HALF + (g & 1) * 16);
#pragma unroll
        for (int q = 0; q < 8; ++q) xv[0][q] = *(const f32x4*)(xb + (size_t)((q >> 2) * HALF + (q & 3) * 16) * DM);
        asm volatile("" ::: "memory"); __builtin_amdgcn_sched_barrier(0);
#pragma unroll
        for (int g = 0; g < 4; ++g) { const int bj = g >> 1, n = g & 1;
            if (g < 3) { const int bj1 = (g + 1) >> 1, n1 = (g + 1) & 1;
#pragma unroll
                for (int q = 0; q < 8; ++q) xv[(g + 1) & 1][q] = *(const f32x4*)(xb + (size_t)((q >> 2) * HALF + (q & 3) * 16) * DM + bj1 * HALF + n1 * 16);
                asm volatile("" ::: "memory"); __builtin_amdgcn_sched_barrier(0); }
#pragma unroll
            for (int q = 0; q < 8; ++q) *(f32x4*)(xb + (size_t)((q >> 2) * HALF + (q & 3) * 16) * DM + bj * HALF + n * 16) = xv[g & 1][q] * ALPHA + mv[g] * acc[q >> 2][bj][q & 3][n];
            asm volatile("" ::: "memory"); __builtin_amdgcn_sched_barrier(0); }
    }
};
struct EpiSwiglu {
    static constexpr int PERM = 1;
    bf16_t* H;
    __device__ __forceinline__ void operator()(const f32x4 (&acc)[2][2][4][2], const Unit& u, int wr, int wc, int fr, int fq) const {
        const int row0 = u.pm * BM + wr * 64 + fr, col0 = u.pn * HALF + wc * 32 + 8 * fq;
#pragma unroll
        for (int ai = 0; ai < 2; ++ai)
#pragma unroll
            for (int m = 0; m < 4; ++m) { bf16_t* rowp = H + (size_t)(row0 + ai * HALF + m * 16) * 256 + col0;
                float h[8];
#pragma unroll
                for (int n = 0; n < 2; ++n)
#pragma unroll
                    for (int j = 0; j < 4; ++j) h[n * 4 + j] = siluf_(acc[ai][0][m][n][j]) * acc[ai][1][m][n][j];
                u32x4 w; w.x = cvt_pk_bf16(h[0], h[1]); w.y = cvt_pk_bf16(h[2], h[3]); w.z = cvt_pk_bf16(h[4], h[5]); w.w = cvt_pk_bf16(h[6], h[7]);
                *(u32x4*)rowp = w; }
    }
};
struct EpiDown {
    static constexpr int PERM = 2;
    unsigned char* Y;
    __device__ __forceinline__ void operator()(const f32x4 (&acc)[2][2][4][2], const Unit& u, int wr, int wc, int fr, int fq) const {
        const int row0 = u.pm * BM + wr * 64 + fr, col0 = u.pn * BM + wc * 64 + 16 * fq;
        unsigned char* yb = Y + (size_t)row0 * DM + col0;
#pragma unroll
        for (int ai = 0; ai < 2; ++ai)
#pragma unroll
            for (int m = 0; m < 4; ++m) { const int rl = ai * HALF + m * 16;
                u32x4 ww; unsigned pk[4];
#pragma unroll
                for (int bj = 0; bj < 2; ++bj)
#pragma unroll
                    for (int n = 0; n < 2; ++n) { f32x4 v = acc[ai][bj][m][n] * 16.0f;
#pragma unroll
                        for (int j = 0; j < 4; ++j) v[j] = __builtin_amdgcn_fmed3f(v[j], -440.0f, 440.0f);
                        int p = __builtin_amdgcn_cvt_pk_fp8_f32(v[0], v[1], 0, false); p = __builtin_amdgcn_cvt_pk_fp8_f32(v[2], v[3], p, true); pk[bj * 2 + n] = (unsigned)p; }
                ww.x = pk[0]; ww.y = pk[1]; ww.z = pk[2]; ww.w = pk[3];
                __builtin_nontemporal_store(ww, (u32x4*)(yb + (size_t)rl * DM));
                asm volatile("" ::: "memory"); }
    }
};
template <int MODE> struct EpiDownProbe {
    static constexpr int PERM = 2;
    unsigned char* Y; const float* sw; const LAS int* cnt;
    __device__ __forceinline__ void operator()(const f32x4 (&acc)[2][2][4][2], const Unit& u, int wr, int wc, int fr, int fq) const {
        const int hsh = (u.pm * 4 + u.pn) & 2047;
        unsigned char* yb = (MODE == 1) ? Y + ((size_t)(hsh * 8 + wr * 4 + wc) * 8) * 1024 + (fq * 16 + fr) * 16
                                        : Y + (size_t)((u.pm & 511) * BM + wr * 64 + fr) * DM + u.pn * BM + wc * 64 + 16 * fq;
#pragma unroll
        for (int ai = 0; ai < 2; ++ai)
#pragma unroll
            for (int m = 0; m < 4; ++m) { const int rl = ai * HALF + m * 16; const float w = 32.0f;
                u32x4 ww; unsigned pk[4];
#pragma unroll
                for (int bj = 0; bj < 2; ++bj)
#pragma unroll
                    for (int n = 0; n < 2; ++n) { f32x4 v = acc[ai][bj][m][n] * w;
#pragma unroll
                        for (int j = 0; j < 4; ++j) v[j] = __builtin_amdgcn_fmed3f(v[j], -440.0f, 440.0f);
                        int p = __builtin_amdgcn_cvt_pk_fp8_f32(v[0], v[1], 0, false); p = __builtin_amdgcn_cvt_pk_fp8_f32(v[2], v[3], p, true); pk[bj * 2 + n] = (unsigned)p; }
                ww.x = pk[0]; ww.y = pk[1]; ww.z = pk[2]; ww.w = pk[3];
                if (MODE == 1) __builtin_nontemporal_store(ww, (u32x4*)(yb + (size_t)(ai * 4 + m) * 1024));
                else if (MODE == 2) __builtin_nontemporal_store(ww, (u32x4*)(yb + (size_t)rl * DM));
                else *(u32x4*)(yb + (size_t)rl * DM) = ww;
                asm volatile("" ::: "memory"); }
    }
};
struct EpiNull {
    static constexpr int PERM = 1;
    __device__ __forceinline__ void operator()(const f32x4 (&acc)[2][2][4][2], const Unit&, int, int, int, int) const {
#pragma unroll
        for (int ai = 0; ai < 2; ++ai)
#pragma unroll
            for (int bj = 0; bj < 2; ++bj)
#pragma unroll
                for (int m = 0; m < 4; ++m)
#pragma unroll
                    for (int n = 0; n < 2; ++n) asm volatile("" :: "v"(acc[ai][bj][m][n]));
    }
};
template <int NPN> struct MoeOrder {
    const LAS int* cnt; const LAS int* tst; const LAS unsigned char* t2e; int ntiles, G, c;
    __device__ __forceinline__ bool next(int i, Unit& u) const {
        const int cs = ((G & 7) == 0) ? (c & 7) * (G >> 3) + (c >> 3) : c;
        const int L = i * G + cs; if (L >= ntiles * NPN) return false;
        const int tau = L / NPN; u.pm = tau; u.pn = L % NPN; u.e = t2e[tau]; u.ti = tau - tst[u.e]; return true;
    }
};
struct MoeGU : MoeOrder<2> {
    static constexpr bool GATHER = true;
    const char* A; const char* Bt; const int* stok; int t0;
    __device__ __forceinline__ const char* abase(const Unit&) const { return A; }
    __device__ __forceinline__ const char* bbase(const Unit& u) const { return Bt + ((size_t)u.e * 512 + (size_t)u.pn * 256) * 1024 * 2; }
    __device__ __forceinline__ void aoff(const Unit& u, int tid, unsigned (&off)[2][2]) const {
        const int ce = cnt[u.e];
#pragma unroll
        for (int i = 0; i < 2; ++i) { int R, C; stage_rc(tid * 16 + i * 8192, R, C);
#pragma unroll
            for (int h = 0; h < 2; ++h) { const int pos = u.ti * 256 + h * HALF + R; int tok;
                if (u.e == 64) tok = t0 + pos; else tok = (pos < ce) ? stok[(size_t)u.e * CAP + pos] : 0;
                off[h][i] = (unsigned)(tok * 1024 + C) * 2u; } }
    }
};
struct MoeDN : MoeOrder<4> {
    static constexpr bool GATHER = false;
    const char* A; const char* Bt;
    __device__ __forceinline__ const char* abase(const Unit& u) const { return A + (size_t)u.pm * BM * 256 * 2; }
    __device__ __forceinline__ const char* bbase(const Unit& u) const { return Bt + ((size_t)u.e * 1024 + (size_t)u.pn * 256) * 256 * 2; }
};
}

struct Args { const float* in[30]; float* out; unsigned char* ws; int ph_lo, ph_hi; };

struct Frame {
    float* out; unsigned char* ws; LAS unsigned char* lds; int tid, lane, wave, G, wg;
    float* mods; float* X; bf16_t* HB; bf16_t* MIX; unsigned char* WB; unsigned char* R1;
};

__device__ __forceinline__ const float* inp(const Frame& F, int i) {
    const unsigned long long v = ((const LAS unsigned long long*)(F.lds + LDS_MISC + MISC_INP))[i];
    const unsigned lo = (unsigned)__builtin_amdgcn_readfirstlane((int)(unsigned)v), hi = (unsigned)__builtin_amdgcn_readfirstlane((int)(unsigned)(v >> 32));
    return (const float*)(((unsigned long long)hi << 32) | lo);
}
__device__ __forceinline__ int lane_id_() { return (int)__builtin_amdgcn_mbcnt_hi(~0u, __builtin_amdgcn_mbcnt_lo(~0u, 0u)); }
__device__ __forceinline__ Frame fresh(const Frame& F0) { Frame F = F0; int ln = lane_id_(); asm volatile("" : "+v"(ln)); F.lane = ln; F.tid = F0.wave * 64 + ln; return F; }

__device__ __forceinline__ void ph_mods(const Frame& F) {
    const float* c = inp(F, 1); const float* cc = inp(F, 3); const float* ada_w = inp(F, 4); const float* ada_b = inp(F, 5);
    LAS float* sv = (LAS float*)F.lds;
    LAS float* red = (LAS float*)(F.lds + 5 * 1024 * 4);
    for (int i = F.tid; i < 5 * 1024; i += 512) { const int s = i >> 10, k = i & 1023; const float v = (s < 4) ? c[s * 1024 + k] : cc[k]; sv[i] = siluf_(v); }
    __syncthreads();
    for (int task = F.wg; task < 4 * 48; task += F.G) {
        const int l = task / 48, cc0 = (task % 48) * 128;
        const int cg = F.tid & 31, kg = F.tid >> 5;
        const float* w = ada_w + (size_t)l * 1024 * 6144 + cc0 + cg * 4;
        f32x4 acc[5];
#pragma unroll
        for (int s = 0; s < 5; ++s) acc[s] = (f32x4){0.f, 0.f, 0.f, 0.f};
#pragma unroll 8
        for (int kk = 0; kk < 64; ++kk) { const int k = kg * 64 + kk; const f32x4 wv = *(const f32x4*)(w + (size_t)k * 6144);
#pragma unroll
            for (int s = 0; s < 5; ++s) acc[s] += wv * sv[s * 1024 + k]; }
#pragma unroll
        for (int s = 0; s < 5; ++s)
#pragma unroll
            for (int q = 0; q < 4; ++q) red[((kg * 128) + cg * 4 + q) * 5 + s] = acc[s][q];
        __syncthreads();
        if (F.tid < 128) {
            const int col = cc0 + F.tid; const float bsv = ada_b[l * 6144 + col];
#pragma unroll
            for (int s = 0; s < 5; ++s) { float v = 0.f;
#pragma unroll
                for (int g2 = 0; g2 < 16; ++g2) v += red[((g2 * 128) + F.tid) * 5 + s];
                F.mods[(size_t)(l * 5 + s) * 6144 + col] = v + bsv; }
        }
        __syncthreads();
    }
    if (F.wg == F.G - 1) {
        const float* raw = inp(F, 11); float* lbt = (float*)(F.ws + OFF_LBT);
        for (int i = F.tid; i < 2 * 512; i += 512) { const int d = i >> 9, ch = i & 511; const float r0 = raw[(d * 2 + 0) * 512 + ch], r1 = raw[(d * 2 + 1) * 512 + ch];
            lbt[(0 * 2 + d) * 512 + ch] = 0.f; lbt[(1 * 2 + d) * 512 + ch] = sigmoidf_(r1 - r0); }
    }
}

__device__ __forceinline__ void ph_init_x(const Frame& F) {
    const float* x = inp(F, 0); const float* ctx = inp(F, 2);
    { const float* lg_ = inp(F, 6); const float* lb_ = inp(F, 7); float* AB = (float*)(F.ws + OFF_AB);
      for (int i = F.wg * 512 + F.tid; i < 4 * 5 * 1024; i += F.G * 512) { const int k = i & 1023, ls = i >> 10, l = ls / 5;
          const float* m = F.mods + (size_t)ls * 6144; const float g0 = lg_[(l * 2) * 1024 + k], b0 = lb_[(l * 2) * 1024 + k], m3 = m[3 * 1024 + k], m4 = m[4 * 1024 + k];
          AB[(size_t)ls * 2048 + k] = g0 * (1.0f + m4); AB[(size_t)ls * 2048 + 1024 + k] = b0 * (1.0f + m4) + m3; } }
    const int gw = F.wg * 8 + F.wave, nw = F.G * 8;
    for (int row = gw; row < TT; row += nw) {
        const float* src = row < TC ? ctx + (size_t)row * DM : x + (size_t)(row - TC) * DM;
        const float* m = F.mods + (size_t)(0 * 5 + slot_of_row(row)) * 6144;
#pragma unroll
        for (int hh = 0; hh < 2; ++hh) { const int k = hh * 512 + F.lane * 8;
            const f32x4 v0 = *(const f32x4*)(src + k), v1 = *(const f32x4*)(src + k + 4);
            *(f32x4*)(F.X + (size_t)row * DM + k) = v0; *(f32x4*)(F.X + (size_t)row * DM + k + 4) = v1;
            const f32x4 s0 = *(const f32x4*)(m + 1024 + k), s1 = *(const f32x4*)(m + 1024 + k + 4), b0 = *(const f32x4*)(m + k), b1 = *(const f32x4*)(m + k + 4);
            const f32x4 h0 = v0 * (s0 + 1.0f) + b0, h1 = v1 * (s1 + 1.0f) + b1;
            u32x4 w; w.x = cvt_pk_bf16(h0[0], h0[1]); w.y = cvt_pk_bf16(h0[2], h0[3]); w.z = cvt_pk_bf16(h1[0], h1[1]); w.w = cvt_pk_bf16(h1[2], h1[3]);
            *(u32x4*)(F.HB + (size_t)row * DM + k) = w; }
    }
}

__device__ __forceinline__ void cvt_tile(const Frame& F, const float* src, int sld, int k0, int n0, bf16_t* dst, int dld, int drow0, float scale) {
    LAS float* t = (LAS float*)F.lds;
    { const int i = F.tid >> 3, j0 = (F.tid & 7) * 8; const float* p = src + (size_t)(k0 + i) * sld + n0 + j0;
      const f32x4 a = *(const f32x4*)p, b = *(const f32x4*)(p + 4);
      LAS float* q = t + i * 65 + j0; q[0] = a[0]; q[1] = a[1]; q[2] = a[2]; q[3] = a[3]; q[4] = b[0]; q[5] = b[1]; q[6] = b[2]; q[7] = b[3]; }
    __syncthreads();
    { const int j = F.tid >> 3, i0 = (F.tid & 7) * 8; float v[8];
#pragma unroll
      for (int q = 0; q < 8; ++q) v[q] = t[(i0 + q) * 65 + j] * scale;
      u32x4 w; w.x = cvt_pk_bf16(v[0], v[1]); w.y = cvt_pk_bf16(v[2], v[3]); w.z = cvt_pk_bf16(v[4], v[5]); w.w = cvt_pk_bf16(v[6], v[7]);
      *(u32x4*)(dst + (size_t)(drow0 + j) * dld + k0 + i0) = w; }
    __syncthreads();
}
__device__ __forceinline__ void ph_convert(const Frame& F, int l) {
    const int j = l >> 1; const bool even = (l & 1) == 0;
    bf16_t* wIN = (bf16_t*)(F.WB + WB_IN); bf16_t* wOUT = (bf16_t*)(F.WB + WB_OUT); bf16_t* wRT = (bf16_t*)(F.WB + WB_RT);
    bf16_t* wGU = (bf16_t*)(F.WB + WB_GU); bf16_t* wDN = (bf16_t*)(F.WB + WB_DN); bf16_t* wLRU = (bf16_t*)(F.WB + WB_LRU);
    const int nIN = even ? 4096 : 2048;
    const int t_in = (nIN / 64) * 16, t_out = 256, t_rt = 16, t_gu = 65 * 2 * 64, t_dn = 65 * 64, t_lru = even ? 0 : 64;
    const int total = t_in + t_out + t_rt + t_gu + t_dn + t_lru;
    for (int task = F.wg; task < total; task += F.G) {
        int t = task;
        if (t < t_in) { const int nb = t >> 4, kb = t & 15; const float* src = even ? inp(F, 8) + (size_t)j * 1024 * 4096 : inp(F, 13) + (size_t)j * 1024 * 2048;
            cvt_tile(F, src, nIN, kb * 64, nb * 64, wIN, 1024, nb * 64, (even && nb < 8) ? 0.125f * 1.4426950408889634f : 1.0f); continue; }
        t -= t_in;
        if (t < t_out) { const int nb = t >> 4, kb = t & 15; const float* src = even ? inp(F, 9) + (size_t)j * 1024 * 1024 : inp(F, 21) + (size_t)j * 1024 * 1024;
            cvt_tile(F, src, 1024, kb * 64, nb * 64, wOUT, 1024, nb * 64, 1.0f); continue; }
        t -= t_out;
        if (t < t_rt) { cvt_tile(F, inp(F, 22) + (size_t)l * 1024 * 64, 64, t * 64, 0, wRT, 1024, 0, 1.0f); continue; }
        t -= t_rt;
        if (t < t_gu) { const int e = t / 128, r = t % 128, which = r >> 6, q = r & 63, nb = q >> 4, kb = q & 15;
            const float* src = (e < 64) ? (which ? inp(F, 25) : inp(F, 24)) + ((size_t)l * 64 + e) * 1024 * 256 : (which ? inp(F, 28) : inp(F, 27)) + (size_t)l * 1024 * 256;
            const int n0 = nb * 64, drow0 = (n0 >> 7) * 256 + which * 128 + (n0 & 127);
            cvt_tile(F, src, 256, kb * 64, n0, wGU + (size_t)e * 512 * 1024, 1024, drow0, 1.0f); continue; }
        t -= t_gu;
        if (t < t_dn) { const int e = t >> 6, q = t & 63, nb = q >> 2, kb = q & 3;
            const float* src = (e < 64) ? inp(F, 26) + ((size_t)l * 64 + e) * 256 * 1024 : inp(F, 29) + (size_t)l * 256 * 1024;
            cvt_tile(F, src, 1024, kb * 64, nb * 64, wDN + (size_t)e * 1024 * 256, 256, nb * 64, 1.0f); continue; }
        t -= t_dn;
        { const int d = t >> 5, gt = (t >> 4) & 1, kb = t & 15;
          const float* src = (gt ? inp(F, 18) : inp(F, 16)) + (((size_t)j * 2 + d) * 16 + kb) * 4096;
          cvt_tile(F, src, 64, 0, 0, wLRU + (((size_t)d * 2 + gt) * 16 + kb) * 4096, 64, 0, 1.0f); }
    }
}

__device__ __forceinline__ void ph_attn(const Frame& F, int j) {
    const bf16_t* P = (const bf16_t*)(F.R1 + R1_P);
    LAS bf16_t* Ks0 = (LAS bf16_t*)F.lds;
    LAS float* rp_l = (LAS float*)(F.lds + 36864);
    const float* rpb = inp(F, 10) + (size_t)j * 8 * 465;
    const int g = F.lane >> 4, l15 = F.lane & 15;
    const int NLAT = NBAT * 8 * 64, NTASK = NLAT + NBAT * 8 * 2;
    const int wgs = ((F.G & 7) == 0) ? (F.wg & 7) * (F.G >> 3) + (F.wg >> 3) : F.wg;
    int cidx[4][4];
    { const int wq_ = (F.wave & 3) * 16 + l15, c0_ = min(max(wq_ - 8, 0), 48);
#pragma unroll
      for (int kb = 0; kb < 4; ++kb)
#pragma unroll
          for (int i = 0; i < 4; ++i) { const int kc = kb * 16 + 4 * g + i; cidx[kb][i] = (kc >= c0_ && kc < c0_ + 16) ? (kc - wq_ + 15) : 31; } }
    for (int task = wgs; task < NTASK; task += F.G) {
        const bool lat = task < NLAT;
        int b, h, rp = 0, half = 0;
        if (lat) { b = task >> 9; h = (task >> 6) & 7; rp = task & 63; } else { const int t2 = task - NLAT; b = t2 >> 4; h = (t2 >> 1) & 7; half = t2 & 1; }
        const int myr = 2 * rp + (F.wave >> 2), w0 = (F.wave & 3) * 16;
        const int r0 = min(max(myr - 4, 0), 120);
        const int rlo = min(max(2 * rp - 4, 0), 120), rhi = min(max(2 * rp + 1 - 4, 0), 120) + 7;
        const int nloc = lat ? (rhi - rlo + 1) : 0;
        const int qrow = lat ? (TC + b * SEQ + myr * 64 + w0 + l15) : (b * CTXL + half * 128 + F.wave * 16 + l15);
        bf16x8 qf[2];
        qf[0] = *(const bf16x8*)(P + (size_t)qrow * 4096 + h * 64 + g * 8);
        qf[1] = *(const bf16x8*)(P + (size_t)qrow * 4096 + h * 64 + 32 + g * 8);
        if (lat) for (int i = F.tid; i < 480; i += 512) { const int rr = i >> 5, cc = i & 31; rp_l[i] = (cc < 31) ? rpb[h * 465 + rr * 31 + cc] * 1.4426950408889634f : -1e30f; }
        f32x4 oacc[4];
#pragma unroll
        for (int dt = 0; dt < 4; ++dt) oacc[dt] = (f32x4){0.f, 0.f, 0.f, 0.f};
        float mrun = -1e30f, lrun = 0.f;
        const int wq = w0 + l15, c0 = min(max(wq - 8, 0), 48);
        u32x4 kv, vv;
        { const int key = F.tid >> 3, ds = (F.tid & 7) * 8; const bool loc0 = 0 < nloc;
          const int krow = loc0 ? (TC + b * SEQ + rlo * 64 + key) : (b * CTXL + key);
          kv = *(const u32x4*)(P + (size_t)krow * 4096 + 512 + h * 64 + ds); vv = *(const u32x4*)(P + (size_t)krow * 4096 + 1024 + h * 64 + ds); }
#define ATT_STAGE(buf_, c_) do { const int key = F.tid >> 3, ds = (F.tid & 7) * 8; LAS bf16_t* Kd = Ks0 + (buf_) * 9216; LAS bf16_t* Vd = Kd + 4608; \
            *(LAS u32x4*)(Kd + key * 72 + ds) = kv; *(LAS u32x4*)(Vd + key * 72 + ds) = vv;     \
            if ((c_) + 1 < nloc + 4) { const bool locn = ((c_) + 1) < nloc; \
                const int krow = locn ? (TC + b * SEQ + (rlo + (c_) + 1) * 64 + key) : (b * CTXL + ((c_) + 1 - nloc) * 64 + key); \
                kv = *(const u32x4*)(P + (size_t)krow * 4096 + 512 + h * 64 + ds); vv = *(const u32x4*)(P + (size_t)krow * 4096 + 1024 + h * 64 + ds); } } while (0)
        __syncthreads();
        ATT_STAGE(0, 0);
        __syncthreads();
        for (int ch = 0; ch < nloc + 4; ++ch) {
            const bool loc = ch < nloc; const int kr = rlo + ch;
            if (ch + 1 < nloc + 4) ATT_STAGE((ch + 1) & 1, ch + 1);
            const LAS bf16_t* Ks = Ks0 + (ch & 1) * 9216; const LAS bf16_t* Vt = Ks + 4608;
            const bool mine = loc ? (kr >= r0 && kr < r0 + 8) : true;
            if (mine) {
                f32x4 s[4];
                const LAS float* rrow = rp_l + (loc ? (kr - myr + 7) * 32 : 0);
#pragma unroll
                for (int kb = 0; kb < 4; ++kb) {
                    if (loc) {
#pragma unroll
                        for (int i = 0; i < 4; ++i) s[kb][i] = rrow[cidx[kb][i]];
                    } else s[kb] = (f32x4){0.f, 0.f, 0.f, 0.f};
#pragma unroll
                    for (int ks = 0; ks < 2; ++ks) { const bf16x8 a = *(const LAS bf16x8*)(Ks + (kb * 16 + l15) * 72 + ks * 32 + g * 8);
                        s[kb] = __builtin_amdgcn_mfma_f32_16x16x32_bf16(a, qf[ks], s[kb], 0, 0, 0); } }
                float cm = -1e30f;
#pragma unroll
                for (int kb = 0; kb < 4; ++kb)
#pragma unroll
                    for (int i = 0; i < 4; ++i) cm = fmaxf(cm, s[kb][i]);
                cm = fmaxf(cm, __shfl_xor(cm, 16)); cm = fmaxf(cm, __shfl_xor(cm, 32));
                const float mn = fmaxf(mrun, cm), sc = __builtin_amdgcn_exp2f(mrun - mn);
                mrun = mn; lrun *= sc;
#pragma unroll
                for (int dt = 0; dt < 4; ++dt) oacc[dt] *= sc;
                float p[4][4];
#pragma unroll
                for (int kb = 0; kb < 4; ++kb)
#pragma unroll
                    for (int i = 0; i < 4; ++i) { p[kb][i] = __builtin_amdgcn_exp2f(s[kb][i] - mn); lrun += p[kb][i]; }
#pragma unroll
                for (int kp = 0; kp < 2; ++kp) {
                    u32x4 pw; pw.x = cvt_pk_bf16(p[2 * kp][0], p[2 * kp][1]); pw.y = cvt_pk_bf16(p[2 * kp][2], p[2 * kp][3]);
                    pw.z = cvt_pk_bf16(p[2 * kp + 1][0], p[2 * kp + 1][1]); pw.w = cvt_pk_bf16(p[2 * kp + 1][2], p[2 * kp + 1][3]);
                    bf16x8 pf; __builtin_memcpy(&pf, &pw, 16);
                    const unsigned va = (unsigned)(size_t)Vt + (unsigned)((32 * kp + 4 * g + (l15 >> 2)) * 144 + (l15 & 3) * 8);
                    u32x2 t0[4], t1[4];
                    asm volatile("ds_read_b64_tr_b16 %0, %8\n\tds_read_b64_tr_b16 %1, %8 offset:32\n\tds_read_b64_tr_b16 %2, %8 offset:64\n\tds_read_b64_tr_b16 %3, %8 offset:96\n\t"
                                 "ds_read_b64_tr_b16 %4, %8 offset:2304\n\tds_read_b64_tr_b16 %5, %8 offset:2336\n\tds_read_b64_tr_b16 %6, %8 offset:2368\n\tds_read_b64_tr_b16 %7, %8 offset:2400\n\ts_waitcnt lgkmcnt(0)"
                                 : "=&v"(t0[0]), "=&v"(t0[1]), "=&v"(t0[2]), "=&v"(t0[3]), "=&v"(t1[0]), "=&v"(t1[1]), "=&v"(t1[2]), "=&v"(t1[3]) : "v"(va) : "memory");
#pragma unroll
                    for (int dt = 0; dt < 4; ++dt) {
                        u32x4 vw; vw.x = t0[dt].x; vw.y = t0[dt].y; vw.z = t1[dt].x; vw.w = t1[dt].y; bf16x8 vf; __builtin_memcpy(&vf, &vw, 16);
                        oacc[dt] = __builtin_amdgcn_mfma_f32_16x16x32_bf16(vf, pf, oacc[dt], 0, 0, 0);
                    }
                }
            }
            __syncthreads();
        }
#undef ATT_STAGE
        float lt = lrun; lt += __shfl_xor(lt, 16); lt += __shfl_xor(lt, 32);
        const float inv = 1.0f / lt;
#pragma unroll
        for (int dt = 0; dt < 4; ++dt) { const f32x4 o = oacc[dt] * inv; u32x2 w; w.x = cvt_pk_bf16(o[0], o[1]); w.y = cvt_pk_bf16(o[2], o[3]);
            *(u32x2*)(F.MIX + (size_t)qrow * DM + h * 64 + dt * 16 + 4 * g) = w; }
        __syncthreads();
    }
}

__device__ __forceinline__ int hg_unit(int nb, int dir) { return dir == 0 ? nb : (nb < 2 ? 1 - nb : 2 + (HG_NU - 3 - (nb - 2))); }
__device__ __forceinline__ int hg_row(int b, int nb, int t) { return nb < 2 ? b * CTXL + nb * HG_U + t : TC + b * SEQ + (nb - 2) * HG_U + t; }
template <int CTRL> __device__ __forceinline__ float dpp_add0(float x) { return x + dppf<CTRL>(0.0f, x); }
#define ROW_ALLREDUCE4(v0, v1, v2, v3) asm volatile("s_nop 1\n\t" \
    "v_add_f32_dpp %0, %0, %0 quad_perm:[1,0,3,2] row_mask:0xf bank_mask:0xf\n\tv_add_f32_dpp %1, %1, %1 quad_perm:[1,0,3,2] row_mask:0xf bank_mask:0xf\n\t" \
    "v_add_f32_dpp %2, %2, %2 quad_perm:[1,0,3,2] row_mask:0xf bank_mask:0xf\n\tv_add_f32_dpp %3, %3, %3 quad_perm:[1,0,3,2] row_mask:0xf bank_mask:0xf\n\t" \
    "v_add_f32_dpp %0, %0, %0 quad_perm:[2,3,0,1] row_mask:0xf bank_mask:0xf\n\tv_add_f32_dpp %1, %1, %1 quad_perm:[2,3,0,1] row_mask:0xf bank_mask:0xf\n\t" \
    "v_add_f32_dpp %2, %2, %2 quad_perm:[2,3,0,1] row_mask:0xf bank_mask:0xf\n\tv_add_f32_dpp %3, %3, %3 quad_perm:[2,3,0,1] row_mask:0xf bank_mask:0xf\n\t" \
    "v_add_f32_dpp %0, %0, %0 row_half_mirror row_mask:0xf bank_mask:0xf\n\tv_add_f32_dpp %1, %1, %1 row_half_mirror row_mask:0xf bank_mask:0xf\n\t" \
    "v_add_f32_dpp %2, %2, %2 row_half_mirror row_mask:0xf bank_mask:0xf\n\tv_add_f32_dpp %3, %3, %3 row_half_mirror row_mask:0xf bank_mask:0xf\n\t" \
    "v_add_f32_dpp %0, %0, %0 row_mirror row_mask:0xf bank_mask:0xf\n\tv_add_f32_dpp %1, %1, %1 row_mirror row_mask:0xf bank_mask:0xf\n\t" \
    "v_add_f32_dpp %2, %2, %2 row_mirror row_mask:0xf bank_mask:0xf\n\tv_add_f32_dpp %3, %3, %3 row_mirror row_mask:0xf bank_mask:0xf" \
    : "+v"(v0), "+v"(v1), "+v"(v2), "+v"(v3))
template <bool WITHO>
__device__ __forceinline__ void hg_pass(const Frame& F, const bf16_t* P, const float* lbh, int b, int h, int nb, int dir, f32x4 (&S)[4][4], float (&Gsum)[16],
                                        LAS bf16_t* Vl, LAS bf16_t* Kl, float* OF, const float* ngp) {
    const int tau = F.lane & 15, g = F.lane >> 4;
    const unsigned vaddr = (unsigned)(size_t)Vl + (unsigned)((4 * g + (tau >> 2)) * 128 + (tau & 3) * 8);
    const unsigned kaddr = (unsigned)(size_t)Kl + (unsigned)((4 * g + (tau >> 2)) * 128 + (tau & 3) * 8);
    u32x2 zr[4], vr[4], qr[4];
    { const int t = dir ? (HG_U - 1 - tau) : tau; const bf16_t* pr = P + (size_t)hg_row(b, nb, t) * 4096 + h * 64 + 4 * g;
#pragma unroll
      for (int m = 0; m < 4; ++m) { zr[m] = *(const u32x2*)(pr + (dir ? 2560 : 2048) + 16 * m); vr[m] = *(const u32x2*)(pr + 3072 + 16 * m); } }
    for (int ci = 0; ci < HG_U / 16; ++ci) {
        float kk[16], c[16];
        if (WITHO) { const int pos = ci * 16 + tau, t = dir ? (HG_U - 1 - pos) : pos; const bf16_t* pr = P + (size_t)hg_row(b, nb, t) * 4096 + h * 64 + 4 * g;
#pragma unroll
            for (int m = 0; m < 4; ++m) qr[m] = *(const u32x2*)(pr + 1536 + 16 * m); }
#pragma unroll
        for (int m = 0; m < 4; ++m) { const float z0 = __uint_as_float(zr[m].x << 16), z1 = __uint_as_float(zr[m].x & 0xffff0000u), z2 = __uint_as_float(zr[m].y << 16), z3 = __uint_as_float(zr[m].y & 0xffff0000u);
            const float zz[4] = {z0, z1, z2, z3};
            const f32x4 lb4 = *(const f32x4*)(lbh + 16 * m + 4 * g);
#pragma unroll
            for (int i = 0; i < 4; ++i) { const float lb = lb4[i]; const float f = fmaxf(lb + (1.0f - lb) * sigmoidf_(zz[i]), 1e-30f); kk[m * 4 + i] = 1.0f - f; c[m * 4 + i] = __logf(f); }
            *(LAS u32x2*)(Vl + tau * 64 + 16 * m + 4 * g) = vr[m];
 }
        if (ci + 1 < HG_U / 16) { const int pos = (ci + 1) * 16 + tau, t = dir ? (HG_U - 1 - pos) : pos; const bf16_t* pr = P + (size_t)hg_row(b, nb, t) * 4096 + h * 64 + 4 * g;
#pragma unroll
            for (int m = 0; m < 4; ++m) { zr[m] = *(const u32x2*)(pr + (dir ? 2560 : 2048) + 16 * m); vr[m] = *(const u32x2*)(pr + 3072 + 16 * m); } }
        float G[16];
#pragma unroll
        for (int q = 0; q < 16; ++q) G[q] = c[q];
#pragma unroll
        for (int q = 0; q < 16; q += 4) ROW_ALLREDUCE4(G[q], G[q + 1], G[q + 2], G[q + 3]);
#pragma unroll
        for (int q = 0; q < 16; ++q) { c[q] = dpp_add0<0x111>(c[q]); c[q] = dpp_add0<0x112>(c[q]); c[q] = dpp_add0<0x114>(c[q]); c[q] = dpp_add0<0x118>(c[q]); }
#pragma unroll
        for (int q = 0; q < 16; ++q) Gsum[q] += G[q];
#pragma unroll
        for (int m = 0; m < 4; ++m) { float kh[4];
#pragma unroll
            for (int i = 0; i < 4; ++i) kh[i] = kk[m * 4 + i] * __expf(G[m * 4 + i] - c[m * 4 + i]);
            u32x2 w; w.x = cvt_pk_bf16(kh[0], kh[1]); w.y = cvt_pk_bf16(kh[2], kh[3]);
            *(LAS u32x2*)(Kl + tau * 64 + 16 * m + 4 * g) = w; }
        float ofv[4][4], gtv[4][4]; int orow[4];
        if (WITHO) {
#pragma unroll
            for (int i = 0; i < 4; ++i) { const int p2 = ci * 16 + 4 * g + i, t2 = dir ? (HG_U - 1 - p2) : p2; orow[i] = hg_row(b, nb, t2); }
            if (dir) {
#pragma unroll
                for (int i = 0; i < 4; ++i)
#pragma unroll
                    for (int vt = 0; vt < 4; ++vt) { ofv[i][vt] = OF[(size_t)orow[i] * 512 + h * 64 + 16 * vt + tau]; gtv[i][vt] = bf2f(P[(size_t)orow[i] * 4096 + 3584 + h * 64 + 16 * vt + tau]); }
            }
        }
        asm volatile("s_waitcnt lgkmcnt(0)" ::: "memory");
        u32x2 vtr[4], ktr[4];
        asm volatile("ds_read_b64_tr_b16 %0, %8\n\tds_read_b64_tr_b16 %1, %8 offset:32\n\tds_read_b64_tr_b16 %2, %8 offset:64\n\tds_read_b64_tr_b16 %3, %8 offset:96\n\t"
                     "ds_read_b64_tr_b16 %4, %9\n\tds_read_b64_tr_b16 %5, %9 offset:32\n\tds_read_b64_tr_b16 %6, %9 offset:64\n\tds_read_b64_tr_b16 %7, %9 offset:96\n\ts_waitcnt lgkmcnt(0)"
                     : "=&v"(vtr[0]), "=&v"(vtr[1]), "=&v"(vtr[2]), "=&v"(vtr[3]), "=&v"(ktr[0]), "=&v"(ktr[1]), "=&v"(ktr[2]), "=&v"(ktr[3]) : "v"(vaddr), "v"(kaddr) : "memory");
        bf16x8 Vf[4], Kf[4];
#pragma unroll
        for (int q = 0; q < 4; ++q) { u32x4 w; w.x = vtr[q].x; w.y = vtr[q].y; w.z = 0u; w.w = 0u; __builtin_memcpy(&Vf[q], &w, 16); u32x4 w2; w2.x = ktr[q].x; w2.y = ktr[q].y; w2.z = 0u; w2.w = 0u; __builtin_memcpy(&Kf[q], &w2, 16); }
        if (WITHO) {
            bf16x8 Ktf[2], Qtf[2], Qhf[2];
#pragma unroll
            for (int ks = 0; ks < 2; ++ks) { float kt_[8], qt_[8], qh_[8];
#pragma unroll
                for (int mm = 0; mm < 2; ++mm) { const int m = 2 * ks + mm;
                    const float qq[4] = {__uint_as_float(qr[m].x << 16), __uint_as_float(qr[m].x & 0xffff0000u), __uint_as_float(qr[m].y << 16), __uint_as_float(qr[m].y & 0xffff0000u)};
#pragma unroll
                    for (int i = 0; i < 4; ++i) { const int q = m * 4 + i; const float qv = siluf_(qq[i]) * 0.125f; const float d = fminf(fmaxf(c[q] - 0.5f * G[q], -80.0f), 80.0f);
                        qt_[mm * 4 + i] = qv * __expf(d); kt_[mm * 4 + i] = kk[q] * __expf(-d); qh_[mm * 4 + i] = qv * __expf(c[q]); } }
                u32x4 w; w.x = cvt_pk_bf16(kt_[0], kt_[1]); w.y = cvt_pk_bf16(kt_[2], kt_[3]); w.z = cvt_pk_bf16(kt_[4], kt_[5]); w.w = cvt_pk_bf16(kt_[6], kt_[7]); __builtin_memcpy(&Ktf[ks], &w, 16);
                w.x = cvt_pk_bf16(qt_[0], qt_[1]); w.y = cvt_pk_bf16(qt_[2], qt_[3]); w.z = cvt_pk_bf16(qt_[4], qt_[5]); w.w = cvt_pk_bf16(qt_[6], qt_[7]); __builtin_memcpy(&Qtf[ks], &w, 16);
                w.x = cvt_pk_bf16(qh_[0], qh_[1]); w.y = cvt_pk_bf16(qh_[2], qh_[3]); w.z = cvt_pk_bf16(qh_[4], qh_[5]); w.w = cvt_pk_bf16(qh_[6], qh_[7]); __builtin_memcpy(&Qhf[ks], &w, 16); }
            f32x4 AT = (f32x4){0.f, 0.f, 0.f, 0.f};
            AT = __builtin_amdgcn_mfma_f32_16x16x32_bf16(Ktf[0], Qtf[0], AT, 0, 0, 0); AT = __builtin_amdgcn_mfma_f32_16x16x32_bf16(Ktf[1], Qtf[1], AT, 0, 0, 0);
#pragma unroll
            for (int i = 0; i < 4; ++i) AT[i] = (4 * g + i <= tau) ? AT[i] : 0.0f;
            bf16x8 Af; { u32x4 w; w.x = cvt_pk_bf16(AT[0], AT[1]); w.y = cvt_pk_bf16(AT[2], AT[3]); w.z = 0u; w.w = 0u; __builtin_memcpy(&Af, &w, 16); }
            f32x4 o[4];
#pragma unroll
            for (int vt = 0; vt < 4; ++vt) { o[vt] = __builtin_amdgcn_mfma_f32_16x16x32_bf16(Af, Vf[vt], (f32x4){0.f, 0.f, 0.f, 0.f}, 0, 0, 0);
#pragma unroll
                for (int ks = 0; ks < 2; ++ks) { u32x4 w; w.x = cvt_pk_bf16(S[2 * ks][vt][0], S[2 * ks][vt][1]); w.y = cvt_pk_bf16(S[2 * ks][vt][2], S[2 * ks][vt][3]);
                    w.z = cvt_pk_bf16(S[2 * ks + 1][vt][0], S[2 * ks + 1][vt][1]); w.w = cvt_pk_bf16(S[2 * ks + 1][vt][2], S[2 * ks + 1][vt][3]); bf16x8 Sf; __builtin_memcpy(&Sf, &w, 16);
                    o[vt] = __builtin_amdgcn_mfma_f32_16x16x32_bf16(Qhf[ks], Sf, o[vt], 0, 0, 0); } }
            if (dir == 0) {
#pragma unroll
                for (int i = 0; i < 4; ++i)
#pragma unroll
                    for (int vt = 0; vt < 4; ++vt) OF[(size_t)orow[i] * 512 + h * 64 + 16 * vt + tau] = o[vt][i];
            } else {
                { float tot[4][4], sq[4];
#pragma unroll
                for (int i = 0; i < 4; ++i) { sq[i] = 0.f;
#pragma unroll
                    for (int vt = 0; vt < 4; ++vt) { tot[i][vt] = o[vt][i] + ofv[i][vt]; sq[i] = fmaf(tot[i][vt], tot[i][vt], sq[i]); } }
                ROW_ALLREDUCE4(sq[0], sq[1], sq[2], sq[3]);
#pragma unroll
                for (int i = 0; i < 4; ++i) { const float rs = rsqrtf(sq[i] * (1.0f / 64.0f) + 1e-6f);
#pragma unroll
                    for (int vt = 0; vt < 4; ++vt) F.MIX[(size_t)orow[i] * DM + 512 + h * 64 + 16 * vt + tau] = f2bf(tot[i][vt] * rs * ngp[16 * vt + tau] * siluf_(gtv[i][vt])); } }
            }
        }
#pragma unroll
        for (int kt = 0; kt < 4; ++kt) { f32x4 eg;
#pragma unroll
            for (int i = 0; i < 4; ++i) eg[i] = __expf(G[kt * 4 + i]);
#pragma unroll
            for (int vt = 0; vt < 4; ++vt) S[kt][vt] = __builtin_amdgcn_mfma_f32_16x16x32_bf16(Kf[kt], Vf[vt], S[kt][vt] * eg, 0, 0, 0); }
    }
}
__device__ __forceinline__ void ph_hg_a(const Frame& F, int j) {
    const bf16_t* P = (const bf16_t*)(F.R1 + R1_P);
    float* SLOC = (float*)(F.R1 + R1_SLOC); float* DL = (float*)(F.R1 + R1_DL);
    LAS bf16_t* Vl = (LAS bf16_t*)(F.lds + 32768 + F.wave * 4096); LAS bf16_t* Kl = Vl + 1024;
    const int gw = F.wg * 8 + F.wave, nw = F.G * 8;
    const int NT = NBAT * 8 * (HG_NU - 2) * 2;
    for (int task = gw; task < NT; task += nw) {
        const int dir = task & 1, nb = 2 + (task >> 1) % (HG_NU - 2), bh = (task >> 1) / (HG_NU - 2), b = bh >> 3, h = bh & 7;
        const float* lbh = (const float*)(F.ws + OFF_LBT) + (j * 2 + dir) * 512 + h * 64;
        f32x4 S[4][4];
#pragma unroll
        for (int kt = 0; kt < 4; ++kt)
#pragma unroll
            for (int vt = 0; vt < 4; ++vt) S[kt][vt] = (f32x4){0.f, 0.f, 0.f, 0.f};
        float Gsum[16];
#pragma unroll
        for (int q = 0; q < 16; ++q) Gsum[q] = 0.f;
        hg_pass<false>(F, P, lbh, b, h, nb, dir, S, Gsum, Vl, Kl, nullptr, nullptr);
        const int seq = bh * 2 + dir, u = hg_unit(nb, dir);
        float* so = SLOC + ((size_t)seq * HG_NU + u) * 4096;
#pragma unroll
        for (int kt = 0; kt < 4; ++kt)
#pragma unroll
            for (int vt = 0; vt < 4; ++vt)
#pragma unroll
                for (int i = 0; i < 4; ++i) so[((kt * 4 + vt) * 4 + i) * 64 + F.lane] = S[kt][vt][i];
        if ((F.lane & 15) == 0) { float* dd = DL + ((size_t)seq * HG_NU + u) * 64;
#pragma unroll
            for (int m = 0; m < 4; ++m)
#pragma unroll
                for (int i = 0; i < 4; ++i) dd[16 * m + 4 * (F.lane >> 4) + i] = __expf(Gsum[m * 4 + i]); }
    }
}
__device__ __forceinline__ void ph_hg_b(const Frame& F) {
    const float* SLOC = (const float*)(F.R1 + R1_SLOC); const float* DL = (const float*)(F.R1 + R1_DL); float* SST = (float*)(F.R1 + R1_SST);
    for (int idx = F.wg * 512 + F.tid; idx < 64 * 4096; idx += F.G * 512) {
        const int seq = idx >> 12, e = idx & 4095, ln = e & 63, reg = e >> 6, i = reg & 3, kt = reg >> 4, k = 16 * kt + 4 * (ln >> 4) + i;
        float s = 0.f;
#pragma unroll 6
        for (int u = 0; u < HG_NU; ++u) { const size_t o = ((size_t)seq * HG_NU + u) * 4096 + e; SST[o] = s; s = DL[((size_t)seq * HG_NU + u) * 64 + k] * s + SLOC[o]; }
    }
}
__device__ __forceinline__ void ph_hg_c(const Frame& F, int j) {
    const bf16_t* P = (const bf16_t*)(F.R1 + R1_P);
    const float* SST = (const float*)(F.R1 + R1_SST); float* OF = (float*)(F.R1 + R1_OF);
    const float* ng = inp(F, 12) + j * 64;
    LAS bf16_t* Vl = (LAS bf16_t*)(F.lds + 32768 + F.wave * 4096); LAS bf16_t* Kl = Vl + 1024;
    const int gw = F.wg * 8 + F.wave, nw = F.G * 8;
    const int NT = NBAT * 8 * (HG_NU - 2);
    for (int task = gw; task < NT; task += nw) {
        const int nb = 2 + task % (HG_NU - 2), bh = task / (HG_NU - 2), b = bh >> 3, h = bh & 7;
        for (int dir = 0; dir < 2; ++dir) {
            const float* lbh = (const float*)(F.ws + OFF_LBT) + (j * 2 + dir) * 512 + h * 64;
            const int seq = bh * 2 + dir, u = hg_unit(nb, dir);
            const float* ss = SST + ((size_t)seq * HG_NU + u) * 4096;
            f32x4 S[4][4];
#pragma unroll
            for (int kt = 0; kt < 4; ++kt)
#pragma unroll
                for (int vt = 0; vt < 4; ++vt)
#pragma unroll
                    for (int i = 0; i < 4; ++i) S[kt][vt][i] = ss[((kt * 4 + vt) * 4 + i) * 64 + F.lane];
            float Gsum[16];
#pragma unroll
            for (int q = 0; q < 16; ++q) Gsum[q] = 0.f;
            hg_pass<true>(F, P, lbh, b, h, nb, dir, S, Gsum, Vl, Kl, OF, ng);
            asm volatile("s_waitcnt vmcnt(0)" ::: "memory");
        }
    }
}

__device__ __forceinline__ void ph_hg_ctx(const Frame& F, int j) {
    if (F.wave >= 4) return;
    const bf16_t* P = (const bf16_t*)(F.R1 + R1_P);
    float* SLOC = (float*)(F.R1 + R1_SLOC); float* DL = (float*)(F.R1 + R1_DL); float* OF = (float*)(F.R1 + R1_OF);
    const float* ng = inp(F, 12) + j * 64;
    LAS bf16_t* Vl = (LAS bf16_t*)(F.lds + 32768 + F.wave * 4096); LAS bf16_t* Kl = Vl + 1024;
    const int bh = F.wg * 4 + F.wave, b = bh >> 3, h = bh & 7;
    for (int dir = 0; dir < 2; ++dir) {
        const float* lbh = (const float*)(F.ws + OFF_LBT) + (j * 2 + dir) * 512 + h * 64;
        const int seq = bh * 2 + dir;
        f32x4 S[4][4];
#pragma unroll
        for (int kt = 0; kt < 4; ++kt)
#pragma unroll
            for (int vt = 0; vt < 4; ++vt) S[kt][vt] = (f32x4){0.f, 0.f, 0.f, 0.f};
        for (int u = 0; u < 2; ++u) {
            const int nb = dir ? 1 - u : u;
            float Gsum[16];
#pragma unroll
            for (int q = 0; q < 16; ++q) Gsum[q] = 0.f;
            hg_pass<true>(F, P, lbh, b, h, nb, dir, S, Gsum, Vl, Kl, OF, ng);
            float* so = SLOC + ((size_t)seq * HG_NU + u) * 4096;
#pragma unroll
            for (int kt = 0; kt < 4; ++kt)
#pragma unroll
                for (int vt = 0; vt < 4; ++vt)
#pragma unroll
                    for (int i = 0; i < 4; ++i) so[((kt * 4 + vt) * 4 + i) * 64 + F.lane] = S[kt][vt][i];
            if ((F.lane & 15) == 0) { float* dd = DL + ((size_t)seq * HG_NU + u) * 64;
#pragma unroll
                for (int q = 0; q < 16; ++q) dd[16 * (q >> 2) + 4 * (F.lane >> 4) + (q & 3)] = 0.0f; }
        }
        asm volatile("s_waitcnt vmcnt(0)" ::: "memory");
    }
}

__device__ __forceinline__ int lru_nat(int so, int dir) { return dir == 0 ? so : (so < 16 ? 15 - so : 16 + (LRU_NT - 1 - so)); }
__device__ __forceinline__ int lru_row(int b, int nt, int t) { return nt < 16 ? b * CTXL + nt * 16 + t : TC + b * SEQ + (nt - 16) * 16 + t; }
struct LruRaw { u32x4 a[4], b[4]; };
__device__ __forceinline__ void lru_load(const Frame& F, int b, int kb, int nt, LruRaw& R) {
    const bf16_t* P = (const bf16_t*)(F.R1 + R1_P);
    const int tk = F.lane & 15, g = F.lane >> 4;
    const int len = nt < 16 ? CTXL : SEQ, tpos = (nt < 16 ? nt * 16 : (nt - 16) * 16) + tk;
    const bf16_t* pbase = P + (size_t)((nt < 16 ? b * CTXL : TC + b * SEQ)) * 2048 + 1024 + kb * 64 + g * 16;
#pragma unroll
    for (int tap = 0; tap < 4; ++tap) { const int tp = tpos + tap - 2; const bool ok = (tp >= 0 && tp < len); const bf16_t* pr = pbase + (size_t)(ok ? tp : tpos) * 2048;
        R.a[tap] = *(const u32x4*)pr; R.b[tap] = *(const u32x4*)(pr + 8); if (!ok) { R.a[tap] = (u32x4){0u, 0u, 0u, 0u}; R.b[tap] = (u32x4){0u, 0u, 0u, 0u}; } }
}
__device__ __forceinline__ void lru_conv(const Frame& F, const LruRaw& R, const LAS float* CT, LAS float* ucb) {
    const int tk = F.lane & 15, g = F.lane >> 4;
    float acc[16];
#pragma unroll
    for (int q = 0; q < 4; ++q) { const f32x4 c4 = *(const LAS f32x4*)(CT + 4 * 64 + g * 16 + q * 4); acc[q * 4] = c4[0]; acc[q * 4 + 1] = c4[1]; acc[q * 4 + 2] = c4[2]; acc[q * 4 + 3] = c4[3]; }
#pragma unroll
    for (int tap = 0; tap < 4; ++tap) { float t0[8], t1[8]; unpack8(R.a[tap], t0); unpack8(R.b[tap], t1);
#pragma unroll
        for (int q = 0; q < 2; ++q) { const f32x4 w0 = *(const LAS f32x4*)(CT + tap * 64 + g * 16 + q * 4), w1 = *(const LAS f32x4*)(CT + tap * 64 + g * 16 + 8 + q * 4);
#pragma unroll
            for (int i = 0; i < 4; ++i) { acc[q * 4 + i] = fmaf(w0[i], t0[q * 4 + i], acc[q * 4 + i]); acc[8 + q * 4 + i] = fmaf(w1[i], t1[q * 4 + i], acc[8 + q * 4 + i]); } } }
#pragma unroll
    for (int q = 0; q < 4; ++q) *(LAS f32x4*)(ucb + tk * 68 + g * 16 + q * 4) = (f32x4){acc[q * 4], acc[q * 4 + 1], acc[q * 4 + 2], acc[q * 4 + 3]};
}
__device__ __forceinline__ void lru_gates(const Frame& F, LAS bf16_t* Wl, const LAS float* CT, LAS float* ucb, float (&av)[2][4][4], float (&xv)[2][4][4]) {
    const int tk = F.lane & 15, g = F.lane >> 4;
    bf16x8 bfr[2];
#pragma unroll
    for (int ks = 0; ks < 2; ++ks) { const f32x4 u0 = *(const LAS f32x4*)(ucb + tk * 68 + ks * 32 + g * 8), u1 = *(const LAS f32x4*)(ucb + tk * 68 + ks * 32 + g * 8 + 4);
        u32x4 w; w.x = cvt_pk_bf16(u0[0], u0[1]); w.y = cvt_pk_bf16(u0[2], u0[3]); w.z = cvt_pk_bf16(u1[0], u1[1]); w.w = cvt_pk_bf16(u1[2], u1[3]); __builtin_memcpy(&bfr[ks], &w, 16); }
#pragma unroll
    for (int d = 0; d < 2; ++d)
#pragma unroll
        for (int et = 0; et < 4; ++et) {
            f32x4 ra = (f32x4){0.f, 0.f, 0.f, 0.f}, ri = (f32x4){0.f, 0.f, 0.f, 0.f};
#pragma unroll
            for (int ks = 0; ks < 2; ++ks) {
                const bf16x8 wa = *(const LAS bf16x8*)(Wl + ((d * 2 + 0) * 64 + et * 16 + tk) * 72 + ks * 32 + g * 8);
                const bf16x8 wx = *(const LAS bf16x8*)(Wl + ((d * 2 + 1) * 64 + et * 16 + tk) * 72 + ks * 32 + g * 8);
                ra = __builtin_amdgcn_mfma_f32_16x16x32_bf16(wa, bfr[ks], ra, 0, 0, 0);
                ri = __builtin_amdgcn_mfma_f32_16x16x32_bf16(wx, bfr[ks], ri, 0, 0, 0);
            }
            const f32x4 ba4 = *(const LAS f32x4*)(CT + (5 + 3 * d) * 64 + et * 16 + 4 * g), bx4 = *(const LAS f32x4*)(CT + (6 + 3 * d) * 64 + et * 16 + 4 * g), cs4 = *(const LAS f32x4*)(CT + (7 + 3 * d) * 64 + et * 16 + 4 * g);
            const f32x4 u4 = *(const LAS f32x4*)(ucb + tk * 68 + et * 16 + 4 * g);
#pragma unroll
            for (int i = 0; i < 4; ++i) {
                const float r = sigmoidf_(ra[i] + ba4[i]), ig = sigmoidf_(ri[i] + bx4[i]);
                const float la = cs4[i] * r, a = __expf(la);
                av[d][et][i] = la; xv[d][et][i] = __builtin_amdgcn_sqrtf(fmaxf(1.0f - a * a, 0.f)) * ig * u4[i]; }
        }
}
template <int S> __device__ __forceinline__ void lru_step_f(float& a, float& x) { const float ap = dppf<0x110 + S>(1.0f, a), xp = dppf<0x110 + S>(0.0f, x); x = fmaf(a, xp, x); a = a * ap; }
template <int S> __device__ __forceinline__ void lru_step_b(float& a, float& x) { const float ap = dppf<0x100 + S>(1.0f, a), xp = dppf<0x100 + S>(0.0f, x); x = fmaf(a, xp, x); a = a * ap; }
#define LRU_DPP_STEP(SH, x_, a_) asm volatile("s_nop 1\n\t" \
    "v_fmac_f32_dpp %0, %0, %4 " SH " row_mask:0xf bank_mask:0xf\n\tv_fmac_f32_dpp %1, %1, %5 " SH " row_mask:0xf bank_mask:0xf\n\t" \
    "v_fmac_f32_dpp %2, %2, %6 " SH " row_mask:0xf bank_mask:0xf\n\tv_fmac_f32_dpp %3, %3, %7 " SH " row_mask:0xf bank_mask:0xf\n\t" \
    "v_mul_f32_dpp %4, %4, %4 " SH " row_mask:0xf bank_mask:0xf\n\tv_mul_f32_dpp %5, %5, %5 " SH " row_mask:0xf bank_mask:0xf\n\t" \
    "v_mul_f32_dpp %6, %6, %6 " SH " row_mask:0xf bank_mask:0xf\n\tv_mul_f32_dpp %7, %7, %7 " SH " row_mask:0xf bank_mask:0xf" \
    : "+v"(x_[0]), "+v"(x_[1]), "+v"(x_[2]), "+v"(x_[3]), "+v"(a_[0]), "+v"(a_[1]), "+v"(a_[2]), "+v"(a_[3]))
#define LRU_SCANS(av, xv) do { _Pragma("unroll") for (int et = 0; et < 4; ++et) { \
        LRU_DPP_STEP("row_shr:1", xv[0][et], av[0][et]); LRU_DPP_STEP("row_shl:1", xv[1][et], av[1][et]); } \
    _Pragma("unroll") for (int et = 0; et < 4; ++et) { LRU_DPP_STEP("row_shr:2", xv[0][et], av[0][et]); LRU_DPP_STEP("row_shl:2", xv[1][et], av[1][et]); } \
    _Pragma("unroll") for (int et = 0; et < 4; ++et) { LRU_DPP_STEP("row_shr:4", xv[0][et], av[0][et]); LRU_DPP_STEP("row_shl:4", xv[1][et], av[1][et]); } \
    _Pragma("unroll") for (int et = 0; et < 4; ++et) { LRU_DPP_STEP("row_shr:8", xv[0][et], av[0][et]); LRU_DPP_STEP("row_shl:8", xv[1][et], av[1][et]); } } while (0)
__device__ __forceinline__ void ph_lru_a(const Frame& F, int jj) {
    LAS bf16_t* Wl = (LAS bf16_t*)F.lds;
    LAS float* ucb = (LAS float*)(F.lds + 36864 + F.wave * 4352);
    LAS float* CT = (LAS float*)(F.lds + 36864 + 8 * 4352);
    const bf16_t* wsrc = (const bf16_t*)(F.WB + WB_LRU);
    float* AG = (float*)(F.R1 + R1_AG); bf16_t* GX = (bf16_t*)(F.R1 + R1_GX);
    const float* cw = inp(F, 14) + (size_t)jj * 4 * 1024; const float* cb = inp(F, 15) + (size_t)jj * 1024;
    const float* b_a = inp(F, 17) + (size_t)jj * 2 * 1024; const float* b_x = inp(F, 19) + (size_t)jj * 2 * 1024; const float* lam = inp(F, 20) + (size_t)jj * 2 * 1024;
    const int tk = F.lane & 15, g = F.lane >> 4;
    const int NTASK = NBAT * 16 * 11;
    for (int task = F.wg; task < NTASK; task += F.G) {
        const int grp = task % 11, kb = (task / 11) & 15, b = task / (11 * 16);
        __syncthreads();
        for (int i = F.tid; i < 4 * 4096 / 8; i += 512) { const int mg = i >> 9, r = i & 511;
            *(LAS u32x4*)(Wl + (mg * 64 + (r >> 3)) * 72 + (r & 7) * 8) = *(const u32x4*)(wsrc + ((size_t)mg * 16 + kb) * 4096 + r * 8); }
        for (int i = F.tid; i < 11 * 64; i += 512) { const int kind = i >> 6, ch = kb * 64 + (i & 63); float v;
            if (kind < 4) v = cw[kind * 1024 + ch]; else if (kind == 4) v = cb[ch];
            else { const int d = (kind - 5) / 3, w = (kind - 5) % 3; v = (w == 0) ? b_a[d * 1024 + ch] : (w == 1) ? b_x[d * 1024 + ch] : -8.0f * log1pf(__expf(-lam[d * 1024 + ch])); }
            CT[i] = v; }
        __syncthreads();
        const int nt0 = grp * 48;
        LruRaw raw; lru_load(F, b, kb, nt0 + F.wave, raw);
        for (int ti = F.wave; ti < 48; ti += 8) {
            const int nt = nt0 + ti;
            float av[2][4][4], xv[2][4][4];
            lru_conv(F, raw, CT, ucb);
            if (ti + 8 < 48) lru_load(F, b, kb, nt + 8, raw);
            lru_gates(F, Wl, CT, ucb, av, xv);
            const int row = lru_row(b, nt, tk);
#pragma unroll
            for (int d = 0; d < 2; ++d)
#pragma unroll
                for (int et = 0; et < 4; ++et) { u32x4 w; w.x = cvt_pk_bf16(av[d][et][0], xv[d][et][0]); w.y = cvt_pk_bf16(av[d][et][1], xv[d][et][1]); w.z = cvt_pk_bf16(av[d][et][2], xv[d][et][2]); w.w = cvt_pk_bf16(av[d][et][3], xv[d][et][3]);
                    __builtin_nontemporal_store(w, (u32x4*)(GX + (((size_t)row * 2 + d) * 1024 + kb * 64 + et * 16 + 4 * g) * 2));
                    const unsigned ww[4] = {w.x, w.y, w.z, w.w};
#pragma unroll
                    for (int i = 0; i < 4; ++i) { av[d][et][i] = __expf(__uint_as_float(ww[i] << 16)); xv[d][et][i] = __uint_as_float(ww[i] & 0xffff0000u); } }
            LRU_SCANS(av, xv);
#pragma unroll
            for (int d = 0; d < 2; ++d) if (tk == (d ? 0 : 15)) {
                float* ag = AG + (((size_t)(b * 2 + d) * LRU_NT + nt) * 2) * 1024 + kb * 64;
#pragma unroll
                for (int et = 0; et < 4; ++et) { *(f32x4*)(ag + et * 16 + 4 * g) = (f32x4){av[d][et][0], av[d][et][1], av[d][et][2], av[d][et][3]};
                    *(f32x4*)(ag + 1024 + et * 16 + 4 * g) = (f32x4){xv[d][et][0], xv[d][et][1], xv[d][et][2], xv[d][et][3]}; }
            }
        }
    }
    __syncthreads();
}
__device__ __forceinline__ void ph_lru_c(const Frame& F) {
    const float* HST = (const float*)(F.R1 + R1_HST); const bf16_t* GX = (const bf16_t*)(F.R1 + R1_GX);
    const bf16_t* P = (const bf16_t*)(F.R1 + R1_P);
    const int tk = F.lane & 15, g = F.lane >> 4;
    const int gw = F.wg * 8 + F.wave, nw = F.G * 8;
    for (int task = gw; task < NBAT * LRU_NT * 16; task += nw) {
        const int kb = task & 15, nt = (task >> 4) % LRU_NT, b = (task >> 4) / LRU_NT;
        const int row = lru_row(b, nt, tk);
        u32x4 gx[2][4]; f32x4 hf[4], hb[4]; u32x2 yw[4];
#pragma unroll
        for (int d = 0; d < 2; ++d)
#pragma unroll
            for (int et = 0; et < 4; ++et) gx[d][et] = *(const u32x4*)(GX + (((size_t)row * 2 + d) * 1024 + kb * 64 + et * 16 + 4 * g) * 2);
#pragma unroll
        for (int et = 0; et < 4; ++et) { const int ch = kb * 64 + et * 16 + 4 * g;
            hf[et] = *(const f32x4*)(HST + ((size_t)(b * 2 + 0) * LRU_NT + nt) * 1024 + ch);
            hb[et] = *(const f32x4*)(HST + ((size_t)(b * 2 + 1) * LRU_NT + nt) * 1024 + ch);
            yw[et] = *(const u32x2*)(P + (size_t)row * 2048 + ch); }
        float av[2][4][4], xv[2][4][4];
#pragma unroll
        for (int d = 0; d < 2; ++d)
#pragma unroll
            for (int et = 0; et < 4; ++et) { const unsigned ww[4] = {gx[d][et].x, gx[d][et].y, gx[d][et].z, gx[d][et].w};
#pragma unroll
                for (int i = 0; i < 4; ++i) { av[d][et][i] = __expf(__uint_as_float(ww[i] << 16)); xv[d][et][i] = __uint_as_float(ww[i] & 0xffff0000u); } }
        LRU_SCANS(av, xv);
#pragma unroll
        for (int et = 0; et < 4; ++et) {
            const int ch = kb * 64 + et * 16 + 4 * g;
            const float y0 = __uint_as_float(yw[et].x << 16), y1 = __uint_as_float(yw[et].x & 0xffff0000u), y2 = __uint_as_float(yw[et].y << 16), y3 = __uint_as_float(yw[et].y & 0xffff0000u);
            float o[4];
#pragma unroll
            for (int i = 0; i < 4; ++i) o[i] = fmaf(av[0][et][i], hf[et][i], xv[0][et][i]) + fmaf(av[1][et][i], hb[et][i], xv[1][et][i]);
            o[0] *= gelu_tanh_(y0); o[1] *= gelu_tanh_(y1); o[2] *= gelu_tanh_(y2); o[3] *= gelu_tanh_(y3);
            u32x2 w; w.x = cvt_pk_bf16(o[0], o[1]); w.y = cvt_pk_bf16(o[2], o[3]);
            *(u32x2*)(F.MIX + (size_t)row * DM + ch) = w;
        }
    }
}
__device__ __forceinline__ void ph_lru_b(const Frame& F) {
    const float* AG = (const float*)(F.R1 + R1_AG); float* HST = (float*)(F.R1 + R1_HST);
    LAS float* sa = (LAS float*)F.lds; LAS float* sx = sa + 512;
    for (int task = F.wg; task < NBAT * 2 * 32; task += F.G) {
        const int cgp = task & 31, d = (task >> 5) & 1, b = task >> 6;
        const int ch = cgp * 32 + (F.tid & 31), seg = F.tid >> 5;
        const float* ag = AG + ((size_t)(b * 2 + d) * LRU_NT) * 2048 + ch;
        float A = 1.0f, Xv = 0.f;
        for (int i = 0; i < 33; ++i) { const int nt = lru_nat(seg * 33 + i, d); const float a = ag[(size_t)nt * 2048], x = ag[(size_t)nt * 2048 + 1024]; Xv = fmaf(a, Xv, x); A *= a; }
        __syncthreads();
        sa[F.tid] = A; sx[F.tid] = Xv;
        __syncthreads();
        float h = 0.f;
        for (int s2 = 0; s2 < seg; ++s2) h = fmaf(sa[s2 * 32 + (F.tid & 31)], h, sx[s2 * 32 + (F.tid & 31)]);
        float* hs = HST + ((size_t)(b * 2 + d) * LRU_NT) * 1024 + ch;
        for (int i = 0; i < 33; ++i) { const int nt = lru_nat(seg * 33 + i, d); hs[(size_t)nt * 1024] = h; const float a = ag[(size_t)nt * 2048], x = ag[(size_t)nt * 2048 + 1024]; h = fmaf(a, h, x); }
    }
    __syncthreads();
}

__device__ __forceinline__ void topk_better(float& bk, int& be, float& bs, float ok, int oe, float os) { const bool t = (ok > bk) || (ok == bk && oe < be); bk = t ? ok : bk; be = t ? oe : be; bs = t ? os : bs; }
template <int CTRL> __device__ __forceinline__ void topk_step(float& bk, int& be, float& bs) {
    const float ok = dppf<CTRL>(bk, bk), os = dppf<CTRL>(bs, bs); const int oe = __builtin_amdgcn_update_dpp(be, be, CTRL, 0xf, 0xf, false); topk_better(bk, be, bs, ok, oe, os); }
__device__ __forceinline__ void ph_ln_router(const Frame& F, int l, bool dry = false) {
    const bf16_t* RW = (const bf16_t*)(F.WB + WB_RT);
    const float* rbias = inp(F, 23) + l * 64;
    LAS float* part = (LAS float*)F.lds;
    LAS float* LP = (LAS float*)(F.lds + 4096);
    LAS int* hist = (LAS int*)(F.lds + LDS_MISC + MISC_HIST); LAS int* hbase = (LAS int*)(F.lds + LDS_MISC + MISC_HBASE);
    int* tok_e = (int*)(F.ws + OFF_TOKE); int* tok_p = (int*)(F.ws + OFF_TOKP); float* tok_w = (float*)(F.ws + OFF_TOKW);
    int* stok = (int*)(F.ws + OFF_STOK); float* sw = (float*)(F.ws + OFF_SW);
    float* stats = (float*)(F.ws + OFF_STATS);
    unsigned* gcnt = (unsigned*)(F.ws + OFF_CTL + CTL_CNT) + l * 64;
    const int tk = F.lane & 15, g = F.lane >> 4;
    float rb[4];
#pragma unroll
    for (int q = 0; q < 4; ++q) rb[q] = rbias[tk + 16 * q];
    if (F.tid < 64) hist[F.tid] = 0;
    __syncthreads();
    const int NTILE = TT / 16, TILE0 = (l == 3) ? TC / 16 : 0;
    bf16x8 rwf[4][4];
#pragma unroll
    for (int et = 0; et < 4; ++et)
#pragma unroll
        for (int ks = 0; ks < 4; ++ks) rwf[et][ks] = *(const bf16x8*)(RW + (size_t)(et * 16 + tk) * 1024 + F.wave * 128 + ks * 32 + g * 8);
    f32x4 vn[4][2];
    if (TILE0 + F.wg < NTILE) { const float* xr = F.X + (size_t)((TILE0 + F.wg) * 16 + tk) * DM + F.wave * 128 + g * 8;
#pragma unroll
        for (int ks = 0; ks < 4; ++ks) { vn[ks][0] = *(const f32x4*)(xr + ks * 32); vn[ks][1] = *(const f32x4*)(xr + ks * 32 + 4); } }
    for (int tile = TILE0 + F.wg; tile < NTILE; tile += F.G) {
        const int row = tile * 16 + tk; const int s = slot_of_row(tile * 16);
        const float* ab = (const float*)(F.ws + OFF_AB) + (size_t)(l * 5 + s) * 2048;
        f32x4 v[4][2];
#pragma unroll
        for (int ks = 0; ks < 4; ++ks) { v[ks][0] = vn[ks][0]; v[ks][1] = vn[ks][1]; }
        if (tile + F.G < NTILE) { const float* xr = F.X + (size_t)((tile + F.G) * 16 + tk) * DM + F.wave * 128 + g * 8;
#pragma unroll
            for (int ks = 0; ks < 4; ++ks) { vn[ks][0] = *(const f32x4*)(xr + ks * 32); vn[ks][1] = *(const f32x4*)(xr + ks * 32 + 4); } }
        float sum = 0.f, sq = 0.f;
#pragma unroll
        for (int ks = 0; ks < 4; ++ks)
#pragma unroll
            for (int hh = 0; hh < 2; ++hh) { const f32x4 a = v[ks][hh]; sum += (a[0] + a[1]) + (a[2] + a[3]); sq += (a[0] * a[0] + a[1] * a[1]) + (a[2] * a[2] + a[3] * a[3]); }
        sum += __shfl_xor(sum, 16); sum += __shfl_xor(sum, 32); sq += __shfl_xor(sq, 16); sq += __shfl_xor(sq, 32);
        if (g == 0) *(LAS f32x2*)(part + (F.wave * 16 + tk) * 2) = (f32x2){sum, sq};
        __syncthreads();
        float ts = 0.f, tq = 0.f;
#pragma unroll
        for (int w = 0; w < 8; ++w) { const f32x2 p = *(const LAS f32x2*)(part + (w * 16 + tk) * 2); ts += p.x; tq += p.y; }
        const float mean = ts * (1.0f / 1024.0f), var = fmaxf(tq * (1.0f / 1024.0f) - mean * mean, 0.f), rstd = rsqrtf(var + 1e-5f);
        if (F.wave == 0 && g == 0) *(f32x2*)(stats + (size_t)row * 2) = (f32x2){mean, rstd};
        f32x4 acc[4];
#pragma unroll
        for (int et = 0; et < 4; ++et) acc[et] = (f32x4){0.f, 0.f, 0.f, 0.f};
#pragma unroll
        for (int ks = 0; ks < 4; ++ks) { const int k = F.wave * 128 + ks * 32 + g * 8;
            const f32x4 a10 = *(const f32x4*)(ab + k), a11 = *(const f32x4*)(ab + k + 4), b10 = *(const f32x4*)(ab + 1024 + k), b11 = *(const f32x4*)(ab + 1024 + k + 4);
            const f32x4 h0 = (v[ks][0] - mean) * rstd * a10 + b10, h1 = (v[ks][1] - mean) * rstd * a11 + b11;
            u32x4 w; w.x = cvt_pk_bf16(h0[0], h0[1]); w.y = cvt_pk_bf16(h0[2], h0[3]); w.z = cvt_pk_bf16(h1[0], h1[1]); w.w = cvt_pk_bf16(h1[2], h1[3]);
            *(u32x4*)(F.HB + (size_t)row * DM + k) = w;
            bf16x8 af; __builtin_memcpy(&af, &w, 16);
#pragma unroll
            for (int et = 0; et < 4; ++et) acc[et] = __builtin_amdgcn_mfma_f32_16x16x32_bf16(af, rwf[et][ks], acc[et], 0, 0, 0);
        }
#pragma unroll
        for (int et = 0; et < 4; ++et)
#pragma unroll
            for (int i = 0; i < 4; ++i) LP[(F.wave * 16 + 4 * g + i) * 64 + et * 16 + tk] = acc[et][i];
        __syncthreads();
        {
            const int t = 2 * F.wave + (g & 1), r2 = tile * 16 + t;
            float sc[4], key[4];
#pragma unroll
            for (int q = 0; q < 4; ++q) { float lgt = 0.f;
#pragma unroll
                for (int w = 0; w < 8; ++w) lgt += LP[(w * 16 + t) * 64 + tk + 16 * q];
                sc[q] = sigmoidf_(lgt); key[q] = sc[q] + rb[q]; }
            unsigned taken = 0u; int se[6]; float ss[6]; float tot = 0.f;
#pragma unroll
            for (int sel = 0; sel < 6; ++sel) {
                float bk = -1e30f, bs = 0.f; int be = 0;
#pragma unroll
                for (int q = 0; q < 4; ++q) if (!((taken >> q) & 1u) && key[q] > bk) { bk = key[q]; be = tk + 16 * q; bs = sc[q]; }
                topk_step<0xB1>(bk, be, bs); topk_step<0x4E>(bk, be, bs); topk_step<0x141>(bk, be, bs); topk_step<0x140>(bk, be, bs);
                if ((be & 15) == tk) taken |= 1u << (be >> 4);
                se[sel] = be; ss[sel] = bs; tot += bs;
            }
            const float sc2 = 2.5f / tot;
            if (tk < 6 && g < 2) {
                int e = se[0]; float w = ss[0];
#pragma unroll
                for (int q = 1; q < 6; ++q) if (tk == q) { e = se[q]; w = ss[q]; }
                tok_e[r2 * 8 + tk] = e; tok_w[r2 * 8 + tk] = w * sc2; if (!dry) tok_p[r2 * 8 + tk] = __hip_atomic_fetch_add(hist + e, 1, __ATOMIC_RELAXED, __HIP_MEMORY_SCOPE_WORKGROUP);
            }
        }
    }
    asm volatile("s_waitcnt vmcnt(0) lgkmcnt(0)" ::: "memory");
    __syncthreads();
    if (dry) return;
    if (F.tid < 64) hbase[F.tid] = (int)__hip_atomic_fetch_add(gcnt + F.tid, (unsigned)hist[F.tid], __ATOMIC_RELAXED, __HIP_MEMORY_SCOPE_AGENT);
    __syncthreads();
    for (int tile = TILE0 + F.wg; tile < NTILE; tile += F.G) {
        if (F.tid < 96) { const int row = tile * 16 + F.tid / 6, q = F.tid % 6; const int e = tok_e[row * 8 + q]; const int pos = hbase[e] + tok_p[row * 8 + q];
            tok_p[row * 8 + q] = pos; stok[(size_t)e * CAP + pos] = row; sw[(size_t)e * CAP + pos] = tok_w[row * 8 + q]; }
    }
    __syncthreads();
}

__device__ __forceinline__ int moe_tables(const Frame& F, int l) {
    const int t0 = (l == 3) ? TC : 0;
    LAS int* cnt = (LAS int*)(F.lds + LDS_MISC + MISC_CNT); LAS int* tst = (LAS int*)(F.lds + LDS_MISC + MISC_TST); LAS unsigned char* t2e = (LAS unsigned char*)(F.lds + LDS_MISC + MISC_T2E);
    const unsigned* gcnt = (const unsigned*)(F.ws + OFF_CTL + CTL_CNT) + l * 64;
    __syncthreads();
    if (F.tid < 64) cnt[F.tid] = (int)__hip_atomic_load(gcnt + F.tid, __ATOMIC_RELAXED, __HIP_MEMORY_SCOPE_AGENT);
    if (F.tid == 64) cnt[64] = TT - t0;
    __syncthreads();
    if (F.tid == 0) { int s = 0; for (int e = 0; e < 65; ++e) { tst[e] = s; s += (cnt[e] + 255) >> 8; } tst[65] = s; }
    __syncthreads();
    const int ntiles = tst[65];
    for (int t = F.tid; t < ntiles; t += 512) { int e = 0; for (int q = 0; q < 65; ++q) if (t >= tst[q]) e = q; else break; t2e[t] = (unsigned char)e; }
    __syncthreads();
    return ntiles;
}

template <int CTRL> __device__ __forceinline__ float dpp_f(float x) { return __builtin_bit_cast(float, __builtin_amdgcn_update_dpp(0, __builtin_bit_cast(int, x), CTRL, 0xF, 0xF, true)); }
#define WAVE_SUM64(x) do { x += dpp_f<0xB1>(x); x += dpp_f<0x4E>(x); x += dpp_f<0x141>(x); x += dpp_f<0x140>(x); \
    x = __builtin_bit_cast(float, __builtin_amdgcn_readlane(__builtin_bit_cast(int, x), 0)) + __builtin_bit_cast(float, __builtin_amdgcn_readlane(__builtin_bit_cast(int, x), 16)) \
      + __builtin_bit_cast(float, __builtin_amdgcn_readlane(__builtin_bit_cast(int, x), 32)) + __builtin_bit_cast(float, __builtin_amdgcn_readlane(__builtin_bit_cast(int, x), 48)); } while (0)
template <bool lastl> __device__ __forceinline__ void ph_combine_t(const Frame& F, int l, bool dry) {
    LAS int* tst = (LAS int*)(F.lds + LDS_MISC + MISC_TST);
    (void)moe_tables(F, l);
    const int t0 = lastl ? TC : 0;
    LAS float* CT = (LAS float*)F.lds;
    {
        const float* gam = inp(F, 6) + (size_t)(l * 2 + 1) * DM; const float* bet = inp(F, 7) + (size_t)(l * 2 + 1) * DM;
        const float* gam0 = inp(F, 6) + (size_t)(l * 2 + 0) * DM; const float* bet0 = inp(F, 7) + (size_t)(l * 2 + 0) * DM;
        for (int k = F.tid; k < 1024; k += 512) {
            CT[k] = ALPHA * gam0[k]; CT[1024 + k] = ALPHA * bet0[k]; CT[2048 + k] = gam[k]; CT[3072 + k] = bet[k];
#pragma unroll
            for (int s = 0; s < 5; ++s) {
                const float* m = F.mods + (size_t)(l * 5 + s) * 6144; const float* mn = F.mods + (size_t)((lastl ? l : l + 1) * 5 + s) * 6144;
                CT[(4 + s * 3) * 1024 + k] = m[5 * 1024 + k]; CT[(5 + s * 3) * 1024 + k] = 1.0f + mn[1024 + k]; CT[(6 + s * 3) * 1024 + k] = mn[k];
            }
        }
        __syncthreads();
    }
    const float* stats = (const float*)(F.ws + OFF_STATS);
    const unsigned char* Y = (const unsigned char*)(F.R1 + R1_Y);
    const int* tok_e = (const int*)(F.ws + OFF_TOKE); const int* tok_p = (const int*)(F.ws + OFF_TOKP); const float* tok_w = (const float*)(F.ws + OFF_TOKW);
    const int gw = F.wg * 8 + F.wave, nw = F.G * 8;
    const int l4 = F.lane * 4, q8 = F.lane & 7;
    const int sh0 = __builtin_amdgcn_readfirstlane(tst[64]) * 256 - t0;
#define CMB_IDX(E_, P_, W_, row_) do { E_ = tok_e[(row_) * 8 + q8]; P_ = tok_p[(row_) * 8 + q8]; W_ = tok_w[(row_) * 8 + q8]; } while (0)
#define CMB_ISSUE(Yb, Xb, Sb, Wb, E_, P_, W_, row_) do { \
        const int sl_ = tst[(E_) & 63] * 256 + (P_); \
        _Pragma("unroll") for (int q = 0; q < 6; ++q) Wb[q] = __builtin_bit_cast(float, __builtin_amdgcn_readlane(__builtin_bit_cast(int, W_), q)) * (1.0f / 16.0f); \
        _Pragma("unroll") for (int q = 0; q < 7; ++q) { const int sr_ = (q < 6) ? __builtin_amdgcn_readlane(sl_, q) : (sh0 + (row_)); \
            const unsigned char* yp_ = Y + (size_t)sr_ * DM + l4; \
            _Pragma("unroll") for (int c = 0; c < 4; ++c) Yb[q * 4 + c] = *(const unsigned*)(yp_ + c * 256); } \
        _Pragma("unroll") for (int c = 0; c < 4; ++c) Xb[c] = *(const f32x4*)(F.X + (size_t)(row_) * DM + c * 256 + l4); \
        Sb = *(const f32x2*)(stats + (size_t)(row_) * 2); } while (0)
#define CMB_COMPUTE(Yb, Xb, Sb, Wb, row_) do { \
        LAS const float* cs_ = CT + (4 + slot_of_row(row_) * 3) * 1024 + l4; \
        float v[16]; \
        _Pragma("unroll") for (int c = 0; c < 4; ++c) { \
            const f32x4 ag = *(LAS const f32x4*)(CT + c * 256 + l4), ab = *(LAS const f32x4*)(CT + 1024 + c * 256 + l4), m5 = *(LAS const f32x4*)(cs_ + c * 256); \
            f32x2 ya = (f32x2){0.f, 0.f}, yb = ya; \
            _Pragma("unroll") for (int q = 0; q < 7; ++q) { const float wq_ = (q < 6) ? Wb[q] : (1.0f / 16.0f); ya += __builtin_amdgcn_cvt_pk_f32_fp8((int)Yb[q * 4 + c], false) * wq_; yb += __builtin_amdgcn_cvt_pk_f32_fp8((int)Yb[q * 4 + c], true) * wq_; } \
            const f32x4 xh = (Xb[c] - Sb.x) * Sb.y; \
            v[c * 4 + 0] = xh[0] * ag[0] + ab[0] + m5[0] * ya.x; v[c * 4 + 1] = xh[1] * ag[1] + ab[1] + m5[1] * ya.y; \
            v[c * 4 + 2] = xh[2] * ag[2] + ab[2] + m5[2] * yb.x; v[c * 4 + 3] = xh[3] * ag[3] + ab[3] + m5[3] * yb.y; } \
        float sum = 0.f; \
        _Pragma("unroll") for (int i = 0; i < 16; ++i) sum += v[i]; \
        WAVE_SUM64(sum); \
        const float mean = sum * (1.0f / 1024.0f); \
        float sq = 0.f; \
        _Pragma("unroll") for (int i = 0; i < 16; ++i) { const float d = v[i] - mean; sq += d * d; } \
        WAVE_SUM64(sq); \
        const float rstd = rsqrtf(sq * (1.0f / 1024.0f) + 1e-5f); \
        _Pragma("unroll") for (int c = 0; c < 4; ++c) { \
            const f32x4 g = *(LAS const f32x4*)(CT + 2048 + c * 256 + l4), b = *(LAS const f32x4*)(CT + 3072 + c * 256 + l4); \
            f32x4 xn; \
            _Pragma("unroll") for (int i = 0; i < 4; ++i) xn[i] = (v[c * 4 + i] - mean) * rstd * g[i] + b[i]; \
            if (dry) { const float acc_ = xn[0] + xn[1] + xn[2] + xn[3]; asm volatile("" :: "v"(acc_)); } \
            else if (lastl) { *(f32x4*)(F.out + (size_t)((row_) - TC) * DM + c * 256 + l4) = xn; } \
            else { \
                *(f32x4*)(F.X + (size_t)(row_) * DM + c * 256 + l4) = xn; \
                const f32x4 s1 = *(LAS const f32x4*)(cs_ + 1024 + c * 256), b0 = *(LAS const f32x4*)(cs_ + 2048 + c * 256); \
                const f32x4 hv = xn * s1 + b0; \
                u32x2 w; w.x = cvt_pk_bf16(hv[0], hv[1]); w.y = cvt_pk_bf16(hv[2], hv[3]); \
                *(u32x2*)(F.HB + (size_t)(row_) * DM + c * 256 + l4) = w; } } } while (0)
    unsigned yA[28], yB[28]; f32x4 xA[4], xB[4]; f32x2 sA, sB; float wA[6], wB[6]; int eN = 0, pN = 0, eNN = 0, pNN = 0; float wN = 0.f, wNN = 0.f;
    const int row0 = t0 + gw;
    CMB_IDX(eNN, pNN, wNN, row0);
    if (row0 + nw < TT) CMB_IDX(eN, pN, wN, row0 + nw);
    CMB_ISSUE(yA, xA, sA, wA, eNN, pNN, wNN, row0);
    int row = row0;
    for (; row + 3 * nw < TT; row += 2 * nw) {
        const int r1 = row + nw, r2 = row + 2 * nw, r3 = row + 3 * nw;
        CMB_IDX(eNN, pNN, wNN, r2);
        CMB_ISSUE(yB, xB, sB, wB, eN, pN, wN, r1);
        CMB_COMPUTE(yA, xA, sA, wA, row);
        CMB_IDX(eN, pN, wN, r3);
        CMB_ISSUE(yA, xA, sA, wA, eNN, pNN, wNN, r2);
        CMB_COMPUTE(yB, xB, sB, wB, r1);
    }
    for (; row < TT; row += 2 * nw) {
        const int r1 = row + nw, r2 = row + 2 * nw, r3 = row + 3 * nw;
        if (r2 < TT) CMB_IDX(eNN, pNN, wNN, r2);
        if (r1 < TT) CMB_ISSUE(yB, xB, sB, wB, eN, pN, wN, r1);
        CMB_COMPUTE(yA, xA, sA, wA, row);
        if (r1 < TT) {
            if (r3 < TT) CMB_IDX(eN, pN, wN, r3);
            if (r2 < TT) CMB_ISSUE(yA, xA, sA, wA, eNN, pNN, wNN, r2);
            CMB_COMPUTE(yB, xB, sB, wB, r1);
        }
    }
#undef CMB_IDX
#undef CMB_ISSUE
#undef CMB_COMPUTE
}
__device__ __forceinline__ void ph_combine(const Frame& F, int l, bool dry = false) { if (l == 3) ph_combine_t<true>(F, l, dry); else ph_combine_t<false>(F, l, dry); }

constexpr int NPHASE = 2 + 4 * 10;
__global__ void __launch_bounds__(512, 2) mk_fwd(Args args) {
    extern __shared__ __attribute__((aligned(16))) unsigned char lds_raw[];
    Frame F;
    F.out = args.out; F.ws = args.ws; F.lds = (LAS unsigned char*)lds_raw;
    { const int t0 = threadIdx.x; F.wave = __builtin_amdgcn_readfirstlane(t0 >> 6); F.lane = t0 & 63; F.tid = t0; } F.G = gridDim.x; F.wg = blockIdx.x;
    F.mods = (float*)(args.ws + OFF_MODS); F.X = (float*)(args.ws + OFF_X); F.HB = (bf16_t*)(args.ws + OFF_HB); F.MIX = F.HB;
    F.WB = args.ws + OFF_WB; F.R1 = args.ws + OFF_R1;
    volatile LAS unsigned* xbw = (volatile LAS unsigned*)(F.lds + LDS_MISC);
    if (F.tid < 4) xbw[F.tid] = 0u;
    if (F.tid < 30) ((LAS unsigned long long*)(F.lds + LDS_MISC + MISC_INP))[F.tid] = (unsigned long long)args.in[F.tid];
    __syncthreads();
    const int lo = args.ph_lo, hi = args.ph_hi;
    XcdBarrier bar; bar.bar = (unsigned*)(args.ws + OFF_CTL); bar.x = 0; bar.st = xbw;
    if (hi - lo > 1) bar = xcd_barrier_post((unsigned*)(args.ws + OFF_CTL), xbw);
#define IN(k) (lo <= (k) && (k) < hi)
#define SEAM(k) do { if (IN(k) && IN((k) + 1)) { xcd_barrier(bar); if (REPM & 1) xcd_barrier(bar); } } while (0)
    if ((PHM & 1) && IN(0)) { ph_mods(fresh(F)); if (REPM & 65536) { __syncthreads(); ph_mods(fresh(F)); } } SEAM(0);
    if ((PHM & 2) && IN(1)) { ph_init_x(fresh(F)); if (REPM & 131072) ph_init_x(fresh(F)); }
    for (int l = 0; l < 4; ++l) {
        const int pb = 2 + l * 10, j = l >> 1; const bool even = (l & 1) == 0;
        float* mods_l = F.mods + (size_t)l * 5 * 6144;
        F.WB = args.ws + OFF_WB + (size_t)(l & 1) * WB_END;
        if ((PHM & 4) && IN(pb + 0) && !(l & 1)) { for (int rep = 0; rep < ((REPM & 4) ? 2 : 1); ++rep) { ph_convert(fresh(F), l); __syncthreads(); } }
        if (!(l & 1)) SEAM(pb + 0);
        if ((PHM & 8) && IN(pb + 1)) {
            const int N = even ? 4096 : 2048;
            pg8::StaticOrder S; S.init(F.HB, F.WB + WB_IN, TT, N, 1024, F.G, F.wg);
            pg8::EpiStoreBf16 E{(bf16_t*)(F.R1 + R1_P), N};
            for (int rep = 0; rep < ((REPM & 8) ? 2 : 1); ++rep) pg8::gemm_phase(F.lds, 1024, S, E, F.wave);
        } SEAM(pb + 1);
        if (IN(pb + 2)) { if (even) { if (F.wg < 8 && F.G > 16) { ph_hg_ctx(fresh(F), j); } else if (PHM & 16) for (int rep = 0; rep < ((REPM & 16) ? 2 : 1); ++rep) { Frame Fa = fresh(F); if (F.G > 16) { Fa.wg = F.wg - 8; Fa.G = F.G - 8; } ph_attn(Fa, j); } if (PHM & 32) for (int rep = 0; rep < ((REPM & 32) ? 2 : 1); ++rep) ph_hg_a(fresh(F), j); } else { if (PHM & 64) for (int rep = 0; rep < ((REPM & 64) ? 2 : 1); ++rep) ph_lru_a(fresh(F), j); } } SEAM(pb + 2);
        if (IN(pb + 3)) { if (even) { if (PHM & 128) for (int rep = 0; rep < ((REPM & 128) ? 2 : 1); ++rep) { ph_hg_b(fresh(F));
                { Frame Fc = fresh(F); Fc.WB = args.ws + OFF_WB + (size_t)((l + 1) & 1) * WB_END; ph_convert(Fc, l + 1); } } } else { if (PHM & 256) for (int rep = 0; rep < ((REPM & 256) ? 2 : 1); ++rep) ph_lru_b(fresh(F)); } } SEAM(pb + 3);
        if (IN(pb + 4)) { if (even) { if (PHM & 512) for (int rep = 0; rep < ((REPM & 512) ? 2 : 1); ++rep) ph_hg_c(fresh(F), j); } else { if (PHM & 1024) for (int rep = 0; rep < ((REPM & 1024) ? 2 : 1); ++rep) ph_lru_c(fresh(F)); } } SEAM(pb + 4);
        if ((PHM & 2048) && IN(pb + 5)) {
            const int t0 = (l == 3) ? TC : 0;
            pg8::StaticOrder S; S.init(F.MIX + (size_t)t0 * DM, F.WB + WB_OUT, TT - t0, 1024, 1024, F.G, F.wg);
            pg8::EpiResid E{F.X + (size_t)t0 * DM, mods_l, t0};
            pg8::gemm_phase(F.lds, 1024, S, E, F.wave);
        } SEAM(pb + 5);
        if ((PHM & 4096) && IN(pb + 6)) { if (REPM & 4096) ph_ln_router(fresh(F), l, true); ph_ln_router(fresh(F), l); } SEAM(pb + 6);
        if ((PHM & 8192) && IN(pb + 7)) {
            const int ntiles = moe_tables(fresh(F), l);
            pg8::MoeGU S; S.cnt = (const LAS int*)(F.lds + LDS_MISC + MISC_CNT); S.tst = (const LAS int*)(F.lds + LDS_MISC + MISC_TST); S.t2e = (const LAS unsigned char*)(F.lds + LDS_MISC + MISC_T2E);
            S.ntiles = ntiles; S.G = F.G; S.c = F.wg; S.A = (const char*)F.HB; S.Bt = (const char*)(F.WB + WB_GU); S.stok = (const int*)(F.ws + OFF_STOK); S.t0 = (l == 3) ? TC : 0;
            pg8::EpiSwiglu E{(bf16_t*)(F.R1 + R1_H)};
            for (int rep = 0; rep < ((REPM & 8192) ? 2 : 1); ++rep) pg8::gemm_phase(F.lds, 1024, S, E, F.wave);
        } SEAM(pb + 7);
        if ((PHM & 16384) && IN(pb + 8)) {
            const int ntiles = moe_tables(fresh(F), l);
            pg8::MoeDN S; S.cnt = (const LAS int*)(F.lds + LDS_MISC + MISC_CNT); S.tst = (const LAS int*)(F.lds + LDS_MISC + MISC_TST); S.t2e = (const LAS unsigned char*)(F.lds + LDS_MISC + MISC_T2E);
            S.ntiles = ntiles; S.G = F.G; S.c = F.wg; S.A = (const char*)(F.R1 + R1_H); S.Bt = (const char*)(F.WB + WB_DN);
            pg8::EpiDown E{(unsigned char*)(F.R1 + R1_Y)};
            if (REPM & 2) { pg8::EpiNull EN; pg8::gemm_phase(F.lds, 256, S, EN, F.wave); }
            if (REPM & (1 << 21)) { pg8::EpiDownProbe<1> EN{(unsigned char*)F.out, nullptr, nullptr}; pg8::gemm_phase(F.lds, 256, S, EN, F.wave); }
            if (REPM & (1 << 22)) { pg8::EpiDownProbe<2> EN{(unsigned char*)F.out, nullptr, nullptr}; pg8::gemm_phase(F.lds, 256, S, EN, F.wave); }
            if (REPM & (1 << 23)) { pg8::EpiDownProbe<3> EN{(unsigned char*)F.out, nullptr, nullptr}; pg8::gemm_phase(F.lds, 256, S, EN, F.wave); }
            for (int rep = 0; rep < ((REPM & 16384) ? 2 : 1); ++rep) pg8::gemm_phase(F.lds, 256, S, E, F.wave);
        } SEAM(pb + 8);
        if ((PHM & 32768) && IN(pb + 9)) { if (REPM & 32768) ph_combine(fresh(F), l, true); ph_combine(fresh(F), l); } SEAM(pb + 9);
    }
#undef IN
#undef SEAM
}

extern "C" void kernel_launch(void* const* d_in, const int* in_sizes, int n_in, void* d_out, int out_size, void* d_ws, size_t ws_size, hipStream_t stream) {
    static int grid = 0;
    if (grid == 0) {
        if (n_in != 30 || out_size != TX * DM || ws_size < WS_END) { fprintf(stderr, "kernel_launch: unexpected problem (n_in %d out %d ws %zu need %zu)\n", n_in, out_size, ws_size, (size_t)WS_END); grid = -1; return; }
        int dev = 0, cus = 0, per_cu = 0;
        if (hipGetDevice(&dev) != hipSuccess || hipDeviceGetAttribute(&cus, hipDeviceAttributeMultiprocessorCount, dev) != hipSuccess) { grid = -1; return; }
        if (hipFuncSetAttribute((const void*)mk_fwd, hipFuncAttributeMaxDynamicSharedMemorySize, LDS_BYTES) != hipSuccess) { fprintf(stderr, "kernel_launch: hipFuncSetAttribute failed\n"); grid = -1; return; }
        if (hipOccupancyMaxActiveBlocksPerMultiprocessor(&per_cu, (const void*)mk_fwd, 512, LDS_BYTES) != hipSuccess || per_cu < 1) { fprintf(stderr, "kernel_launch: occupancy query says %d\n", per_cu); }
        (void)hipGetLastError();
        grid = cus;
    }
    if (grid < 0) return;
    (void)hipMemsetAsync((char*)d_ws + OFF_CTL, 0, CTL_BYTES, stream);
    Args a{};
    for (int i = 0; i < 30; ++i) a.in[i] = (const float*)d_in[i];
    a.out = (float*)d_out; a.ws = (unsigned char*)d_ws;
#if MK_SPLIT
    for (int p = 0; p < NPHASE; ++p) { a.ph_lo = p; a.ph_hi = p + 1; hipLaunchKernelGGL(mk_fwd, dim3(grid), dim3(512), LDS_BYTES, stream, a); }
#else
    a.ph_lo = 0; a.ph_hi = NPHASE;
    hipLaunchKernelGGL(mk_fwd, dim3(grid), dim3(512), LDS_BYTES, stream, a);
#endif
}
```

```cpp
#include <hip/hip_runtime.h>
#include <cstdio>
#include <cstdint>

#ifndef PHM
#define PHM 0xFFFF
#endif
#ifndef REPM
#define REPM 0
#endif
#ifndef MK_SPLIT
#define MK_SPLIT 0
#endif

typedef unsigned short bf16_t;
typedef short bf16x8 __attribute__((ext_vector_type(8)));
typedef short bf16x4 __attribute__((ext_vector_type(4)));
typedef float f32x4 __attribute__((ext_vector_type(4)));
typedef float f32x2 __attribute__((ext_vector_type(2)));
typedef unsigned u32x4 __attribute__((ext_vector_type(4)));
typedef unsigned u32x2 __attribute__((ext_vector_type(2)));
#define LAS __attribute__((address_space(3)))

constexpr int DM = 1024, NBAT = 4, SEQ = 8192, CTXL = 256;
constexpr int TC = NBAT * CTXL, TX = NBAT * SEQ, TT = TC + TX;
constexpr int NEXP = 64, TOPK = 6;
constexpr int CAP = TT;
constexpr int MOE_ROUTED_ROWS = 6 * TT + 64 * 256;
constexpr int MOE_ROWS = MOE_ROUTED_ROWS + TT;
constexpr int MOE_MAXTILES = MOE_ROWS / 256;
constexpr float ALPHA = 1.681792830507429f;
constexpr int HG_U = 128, HG_NU = (CTXL + SEQ) / HG_U;
constexpr int LRU_NT = (CTXL + SEQ) / 16;

constexpr size_t OFF_CTL = 0, CTL_BYTES = 65536;
constexpr size_t CTL_CNT = 16384, CTL_DBG = 20480;
constexpr size_t OFF_MODS = 65536;
constexpr size_t OFF_LBT = OFF_MODS + 4 * 5 * 6144 * 4;
constexpr size_t OFF_STATS = OFF_LBT + 8192;
constexpr size_t OFF_AB = OFF_STATS + (size_t)TT * 8;
static_assert(OFF_AB + 4 * 5 * 2 * 1024 * 4 <= (1u << 20), "ctl map");
constexpr size_t OFF_TOKE = 1u << 20;
constexpr size_t OFF_TOKP = OFF_TOKE + (size_t)TT * 32;
constexpr size_t OFF_TOKW = OFF_TOKP + (size_t)TT * 32;
constexpr size_t OFF_STOK = OFF_TOKW + (size_t)TT * 32;
constexpr size_t OFF_SW = OFF_STOK + (size_t)64 * CAP * 4;
constexpr size_t OFF_X = OFF_SW + (size_t)64 * CAP * 4;
constexpr size_t OFF_HB = OFF_X + (size_t)TT * DM * 4;
constexpr size_t OFF_WB = OFF_HB + (size_t)TT * DM * 2;
constexpr size_t WB_IN = 0, WB_OUT = WB_IN + (size_t)4096 * 1024 * 2, WB_RT = WB_OUT + (size_t)1024 * 1024 * 2, WB_GU = WB_RT + (size_t)64 * 1024 * 2,
                 WB_DN = WB_GU + (size_t)65 * 512 * 1024 * 2, WB_LRU = WB_DN + (size_t)65 * 1024 * 256 * 2, WB_END = WB_LRU + (size_t)2 * 2 * 16 * 64 * 64 * 2;
constexpr size_t OFF_R1 = OFF_WB + 2 * WB_END;
constexpr size_t R1_P = 0;
constexpr size_t R1_OF = R1_P + (size_t)TT * 4096 * 2;
constexpr size_t R1_SLOC = R1_OF + (size_t)TT * 512 * 4;
constexpr size_t R1_SST = R1_SLOC + (size_t)64 * HG_NU * 4096 * 4;
constexpr size_t R1_DL = R1_SST + (size_t)64 * HG_NU * 4096 * 4;
constexpr size_t R1_AG = (size_t)TT * 2048 * 2;
constexpr size_t R1_HST = R1_AG + (size_t)4 * 2 * LRU_NT * 2 * 1024 * 4;
constexpr size_t R1_GX = R1_HST + (size_t)4 * 2 * LRU_NT * 1024 * 4;
constexpr size_t R1_LRU_END = R1_GX + (size_t)TT * 2 * 1024 * 2 * 2;
constexpr size_t R1_H = 0;
constexpr size_t R1_Y = R1_H + (size_t)MOE_ROWS * 256 * 2;
constexpr size_t R1_MOE_END = R1_Y + (size_t)MOE_ROWS * 1024;
constexpr size_t R1_MIX_END = R1_DL + (size_t)64 * HG_NU * 64 * 4;
constexpr size_t R1_END_ = (R1_MOE_END > R1_MIX_END ? R1_MOE_END : R1_MIX_END);
constexpr size_t WS_END = OFF_R1 + (R1_END_ > R1_LRU_END ? R1_END_ : R1_LRU_END);

constexpr int LDS_STAGE = 131072;
constexpr int LDS_MISC = LDS_STAGE;
constexpr int MISC_CNT = 64;
constexpr int MISC_TST = MISC_CNT + 66 * 4 + 8;
constexpr int MISC_HIST = 640;
constexpr int MISC_HBASE = 896;
constexpr int MISC_T2E = 1152;
constexpr int MISC_INP = 2304;
constexpr int LDS_BYTES = 147456;

#define XB_TMO      128
#define XB_XCNT(j)  (256  + 64 * (j))
#define XB_XSUB(j)  (1280 + 64 * (j))
#define XB_XGEN(j)  (2304 + 64 * (j))
#define XB_TOP      3328
#define XB_TOPGEN   3392
#define XCD_BAR_WORDS 3456
#define XB_SPIN_CAP (1u << 22)
__device__ __forceinline__ unsigned xb_ld(unsigned* p)              { return __hip_atomic_load(p, __ATOMIC_RELAXED, __HIP_MEMORY_SCOPE_AGENT); }
__device__ __forceinline__ unsigned xb_add(unsigned* p, unsigned v) { return __hip_atomic_fetch_add(p, v, __ATOMIC_RELAXED, __HIP_MEMORY_SCOPE_AGENT); }
__device__ __forceinline__ unsigned xb_xcc_id() { return (unsigned)__builtin_amdgcn_s_getreg((3 << 11) | 20) & 0xFu; }
#define XB_SPIN(cond, bar) do { unsigned _sp = 0; while (cond) { __builtin_amdgcn_s_sleep(1); \
    if ((++_sp & 255u) == 0u) { if (xb_ld(&(bar)[XB_TMO])) break; if (_sp > XB_SPIN_CAP) { atomicAdd(&(bar)[XB_TMO], 1u); break; } } } } while (0)
struct XcdBarrier { unsigned* bar; unsigned x; volatile LAS unsigned* st; };
__device__ __forceinline__ XcdBarrier xcd_barrier_post(unsigned* bar, volatile LAS unsigned* st) {
    XcdBarrier b; b.bar = bar; b.x = xb_xcc_id(); b.st = st;
    if (threadIdx.x == 0) (void)xb_add(&bar[XB_XCNT(b.x)], 1u);
    return b;
}
__device__ __forceinline__ void xcd_barrier_complete(unsigned* bar, unsigned x, unsigned& nloc, unsigned& nx) {
    const unsigned G = gridDim.x * gridDim.y * gridDim.z;
    unsigned sum, cnt, mine, sp = 0u;
    for (;;) {
        sum = 0u; cnt = 0u; mine = 0u;
#pragma unroll
        for (unsigned j = 0; j < 16; ++j) { const unsigned c = xb_ld(&bar[XB_XCNT(j)]); sum += c; cnt += (c > 0u) ? 1u : 0u; mine = (j == x) ? c : mine; }
        if (sum == G) break;
        __builtin_amdgcn_s_sleep(1);
        if ((++sp & 255u) == 0u) { if (xb_ld(&bar[XB_TMO])) break; if (sp > XB_SPIN_CAP) { atomicAdd(&bar[XB_TMO], 1u); break; } }
    }
    nloc = mine > 0u ? mine : 1u; nx = cnt > 0u ? cnt : 1u;
}
__device__ __forceinline__ void xcd_barrier(const XcdBarrier& b) {
    asm volatile("s_waitcnt vmcnt(0)" ::: "memory");
    __syncthreads();
    if (threadIdx.x == 0) {
        unsigned* bar = b.bar;
        __builtin_amdgcn_s_waitcnt(0);
        unsigned nloc = b.st[0], nx = b.st[1];
        if (nloc == 0u) { xcd_barrier_complete(bar, b.x, nloc, nx); b.st[0] = nloc; b.st[1] = nx; }
        const unsigned old = xb_add(&bar[XB_XSUB(b.x)], 1u);
        const unsigned gen = old / nloc;
        if (old + 1u == (gen + 1u) * nloc) {
            __builtin_amdgcn_fence(__ATOMIC_RELEASE, "agent");
            asm volatile("s_waitcnt vmcnt(0)" ::: "memory");
            const unsigned og = xb_add(&bar[XB_TOP], 1u);
            const unsigned tg = og / nx;
            if (og + 1u == (tg + 1u) * nx) xb_add(&bar[XB_TOPGEN], 1u);
            else XB_SPIN(xb_ld(&bar[XB_TOPGEN]) == tg, bar);
            __builtin_amdgcn_fence(__ATOMIC_ACQUIRE, "agent");
            xb_add(&bar[XB_XGEN(b.x)], 1u);
            asm volatile("s_waitcnt vmcnt(0)" ::: "memory");
        } else {
            XB_SPIN(xb_ld(&bar[XB_XGEN(b.x)]) == gen, bar);
            __builtin_amdgcn_fence(__ATOMIC_ACQUIRE, "agent");
            asm volatile("s_waitcnt vmcnt(0)" ::: "memory");
        }
    }
    __syncthreads();
}

__device__ __forceinline__ float bf2f(unsigned short b) { return __uint_as_float(((unsigned)b) << 16); }
__device__ __forceinline__ unsigned cvt_pk_bf16(float lo, float hi) { unsigned r; asm volatile("v_cvt_pk_bf16_f32 %0, %1, %2" : "=v"(r) : "v"(lo), "v"(hi)); return r; }
__device__ __forceinline__ unsigned short f2bf(float f) { return (unsigned short)(cvt_pk_bf16(f, 0.f) & 0xffffu); }
__device__ __forceinline__ float sigmoidf_(float x) { return __builtin_amdgcn_rcpf(1.0f + __expf(-x)); }
__device__ __forceinline__ float siluf_(float x) { return x * sigmoidf_(x); }
__device__ __forceinline__ float gelu_tanh_(float x) { return x * sigmoidf_(1.5957691216057308f * (x + 0.044715f * x * x * x)); }
__device__ __forceinline__ int slot_of_row(int r) { return r < TC ? 4 : ((r - TC) >> 13); }
template <int CTRL> __device__ __forceinline__ float dppf(float oldv, float src) {
    return __int_as_float(__builtin_amdgcn_update_dpp(__float_as_int(oldv), __float_as_int(src), CTRL, 0xf, 0xf, false));
}
__device__ __forceinline__ void unpack8(const u32x4 w, float (&o)[8]) {
    o[0] = __uint_as_float(w.x << 16); o[1] = __uint_as_float(w.x & 0xffff0000u); o[2] = __uint_as_float(w.y << 16); o[3] = __uint_as_float(w.y & 0xffff0000u);
    o[4] = __uint_as_float(w.z << 16); o[5] = __uint_as_float(w.z & 0xffff0000u); o[6] = __uint_as_float(w.w << 16); o[7] = __uint_as_float(w.w & 0xffff0000u);
}

namespace pg8 {
constexpr int BM = 256, BK = 64, HALF = 128, HTB = HALF * BK * 2, STAGE_BYTES = 8 * HTB, NXCD = 8, WGM = 8;
__device__ __forceinline__ int lds_byte(int r, int c) { const int st = (r >> 4) * 2 + (c >> 5), rr = r & 15, cc = c & 31, ob = rr * 64 + cc * 2; return st * 1024 + (ob ^ (((ob >> 9) & 1) << 5)); }
__device__ __forceinline__ void stage_rc(int b, int& R, int& C) { const int st = b / 1024, sb = b % 1024, swz = sb ^ (((sb >> 9) & 1) << 5); R = (st >> 1) * 16 + swz / 64; C = (st & 1) * 32 + (swz % 64) / 2; }
__device__ __forceinline__ int perm32(int rho) { const int n = rho >> 4, i = rho & 15; return 8 * (i >> 2) + 4 * n + (i & 3); }
struct Unit { int pm, pn, e, ti; };

struct StaticOrder {
    const char* A; const char* Bt; int K;
    int nM, nN, nwg, G, c;
    __device__ __forceinline__ void init(const void* A_, const void* Bt_, int M, int N, int K_, int G_, int c_) { A = (const char*)A_; Bt = (const char*)Bt_; K = K_; nM = M / BM; nN = N / BM; nwg = nM * nN; G = G_; c = c_; }
    __device__ __forceinline__ bool next(int i, Unit& u) const {
        const long L = (long)i * G + c; if (L >= nwg) return false;
        int wgid = (int)L; { const int q = nwg / NXCD, r = nwg % NXCD, xcd = wgid % NXCD, off = wgid / NXCD; wgid = (xcd < r ? xcd * (q + 1) : r * (q + 1) + (xcd - r) * q) + off; }
        const int nig = WGM * nN, gid = wgid / nig, fm = gid * WGM, gsz = (nM - fm) < WGM ? (nM - fm) : WGM;
        u.pm = fm + ((wgid % nig) % gsz); u.pn = (wgid % nig) / gsz; u.e = 0; u.ti = 0; return true;
    }
    static constexpr bool GATHER = false;
    __device__ __forceinline__ const char* abase(const Unit& u) const { return A + (size_t)u.pm * BM * K * 2; }
    __device__ __forceinline__ const char* bbase(const Unit& u) const { return Bt + (size_t)u.pn * BM * K * 2; }
};

template <class Epi, class Sched>
__device__ __forceinline__ void gemm_phase(LAS unsigned char* lds, const int K_, const Sched& S, const Epi& E, const int wave_) {
    int Kl_ = K_; asm volatile("" : "+s"(Kl_)); const int K = Kl_;
    int tid_ = wave_ * 64 + (int)__builtin_amdgcn_mbcnt_hi(~0u, __builtin_amdgcn_mbcnt_lo(~0u, 0u)); asm volatile("" : "+v"(tid_));
    const int tid = tid_, wid = __builtin_amdgcn_readfirstlane(tid >> 6), lane = tid & 63, wr = wid >> 2, wc = wid & 3, fr = lane & 15, fq = lane >> 4;
    const int nt = K / BK;
    unsigned voffA[2], voffB[2];
#pragma unroll
    for (int i = 0; i < 2; ++i) { int R, C; stage_rc(tid * 16 + i * 8192, R, C);
        const int Rb = Epi::PERM == 1 ? ((R & ~31) + perm32(R & 31)) : Epi::PERM == 2 ? (64 * (R >> 5) + 16 * ((R & 15) >> 2) + 4 * ((R >> 4) & 1) + (R & 3)) : R;
        voffA[i] = (unsigned)(R * K + C) * 2u; voffB[i] = (unsigned)(Rb * K + C) * 2u; }
    const size_t kstep = (size_t)(BK * 2);
    const size_t hstep = (size_t)HALF * K * 2;
    const size_t hstepB = Epi::PERM == 2 ? (size_t)8 * K * 2 : hstep;
    const unsigned ldsw = (unsigned)wid * 1024u;
    const int aoff = lds_byte(wr * 64 + fr, fq * 8), boff = lds_byte(wc * 32 + fr, fq * 8);
#define PG8_SA(b, h) (((b) * 2 + (h)) * HTB)
#define PG8_SB(b, h) ((4 + (b) * 2 + (h)) * HTB)
#define PG8_STAGE(bufoff, gbase, voff) do { const char* _gb = (const char*)(gbase); asm volatile("" : "+s"(_gb)); _Pragma("unroll") for (int _i = 0; _i < 2; ++_i) { \
        unsigned _v = (voff)[_i]; asm volatile("" : "+v"(_v));     \
        __builtin_amdgcn_global_load_lds((const unsigned*)(_gb + _v), (LAS unsigned*)(lds + (bufoff) + ldsw + _i * 8192), 16, 0, 0); } } while (0)
#define PG8_STAGEA(bufoff, hh, kb, nx) do { if constexpr (Sched::GATHER) { unsigned _o[2]; _o[0] = (nx) ? vN[hh][0] : vC[hh][0]; _o[1] = (nx) ? vN[hh][1] : vC[hh][1]; PG8_STAGE(bufoff, cA + (kb), _o); } \
        else { PG8_STAGE(bufoff, ((nx) ? nA : cA) + (hh) * hstep + (kb), voffA); } } while (0)
#define PG8_LDA(dst, b, h) do { _Pragma("unroll") for (int m = 0; m < 4; ++m) _Pragma("unroll") for (int k = 0; k < 2; ++k) dst[m][k] = *(const LAS bf16x8*)(lds + PG8_SA(b, h) + aoff + m * 2048 + k * 1024); } while (0)
#define PG8_LDB(dst, b, h) do { _Pragma("unroll") for (int n = 0; n < 2; ++n) _Pragma("unroll") for (int k = 0; k < 2; ++k) dst[n][k] = *(const LAS bf16x8*)(lds + PG8_SB(b, h) + boff + n * 2048 + k * 1024); } while (0)
#define PG8_MMA(ai, bj, At, Bt) do { __builtin_amdgcn_s_setprio(1); _Pragma("unroll") for (int m = 0; m < 4; ++m) _Pragma("unroll") for (int n = 0; n < 2; ++n) _Pragma("unroll") for (int k = 0; k < 2; ++k) \
        acc[ai][bj][m][n] = __builtin_amdgcn_mfma_f32_16x16x32_bf16(Bt[n][k], At[m][k], acc[ai][bj][m][n], 0, 0, 0); __builtin_amdgcn_s_setprio(0); } while (0)
#define PG8_WAIT_V(n) asm volatile("s_waitcnt vmcnt(" #n ")" ::: "memory")
#define PG8_WAIT_VN(n) asm volatile("s_waitcnt vmcnt(%0)" :: "n"(n) : "memory")
#define PG8_WAIT_L(n) asm volatile("s_waitcnt lgkmcnt(" #n ")" ::: "memory")
#define PG8_BAR __builtin_amdgcn_s_barrier()
#define PG8_SCHED __builtin_amdgcn_sched_barrier(0)
#define PG8_BODY(H_) do { \
            const bool last = (t == nt - 2); \
            const size_t k1 = (size_t)(t + 1) * kstep, k2 = last ? 0 : (size_t)(t + 2) * kstep, k3 = k2 + kstep; \
            const char* b2 = last ? nB : cB + (size_t)(t + 2) * kstep; const char* b3 = b2 + kstep; \
            PG8_LDB(B0, 0, 0); PG8_SCHED; PG8_LDA(At, 0, 0); if (!(H_)) PG8_STAGEA(PG8_SA(1, 1), 1, k1, false); \
            PG8_WAIT_L(8); PG8_BAR; PG8_WAIT_L(0); PG8_MMA(0, 0, At, B0); PG8_BAR; PG8_SCHED; \
            PG8_LDB(B1, 0, 1); PG8_STAGE(PG8_SB(0, 0), b2, voffB); \
            PG8_BAR; PG8_WAIT_L(0); PG8_MMA(0, 1, At, B1); PG8_BAR; \
            PG8_LDA(At, 0, 1); PG8_STAGEA(PG8_SA(0, 0), 0, k2, last); \
            PG8_BAR; PG8_WAIT_L(0); PG8_MMA(1, 0, At, B0); PG8_BAR; PG8_SCHED; \
            PG8_STAGE(PG8_SB(0, 1), b2 + hstepB, voffB); \
            if (H_) PG8_WAIT_VN(6 + Epi::NSTORE); else PG8_WAIT_V(6);  \
            PG8_BAR; PG8_MMA(1, 1, At, B1); PG8_BAR; \
            PG8_LDB(B0, 1, 0); PG8_SCHED; PG8_LDA(At, 1, 0); PG8_STAGEA(PG8_SA(0, 1), 1, k2, last); \
            PG8_WAIT_L(8); PG8_BAR; PG8_WAIT_L(0); PG8_MMA(0, 0, At, B0); PG8_BAR; PG8_SCHED; \
            PG8_LDB(B1, 1, 1); PG8_STAGE(PG8_SB(1, 0), b3, voffB); \
            PG8_BAR; PG8_WAIT_L(0); PG8_MMA(0, 1, At, B1); PG8_BAR; \
            PG8_LDA(At, 1, 1); PG8_STAGEA(PG8_SA(1, 0), 0, k3, last); \
            PG8_BAR; PG8_WAIT_L(0); PG8_MMA(1, 0, At, B0); PG8_BAR; PG8_SCHED; \
            PG8_STAGE(PG8_SB(1, 1), b3 + hstepB, voffB); \
            PG8_WAIT_V(6); PG8_BAR; PG8_MMA(1, 1, At, B1); PG8_BAR; \
        } while (0)
    Unit cur, nxt; int ui = 0; bool hoisted = false;
    if (!S.next(0, cur)) return;
    f32x4 acc[2][2][4][2];
#pragma unroll
    for (int a = 0; a < 2; ++a)
#pragma unroll
        for (int b = 0; b < 2; ++b)
#pragma unroll
            for (int m = 0; m < 4; ++m)
#pragma unroll
                for (int n = 0; n < 2; ++n) acc[a][b][m][n] = (f32x4){0.f, 0.f, 0.f, 0.f};
    bf16x8 At[4][2], B0[2][2], B1[2][2];
    unsigned vC[2][2], vN[2][2];
    if constexpr (Sched::GATHER) S.aoff(cur, tid, vC);
    const char* cA = S.abase(cur);
    const char* cB = S.bbase(cur);
    const char* nA = cA;
    PG8_STAGE(PG8_SB(0, 0), cB, voffB); PG8_STAGEA(PG8_SA(0, 0), 0, 0, false); PG8_STAGE(PG8_SB(0, 1), cB + hstepB, voffB); PG8_STAGEA(PG8_SA(0, 1), 1, 0, false);
    if (wr == 1) PG8_BAR;
    PG8_WAIT_V(4); PG8_BAR;
    PG8_STAGE(PG8_SB(1, 0), cB + kstep, voffB); PG8_STAGEA(PG8_SA(1, 0), 0, kstep, false); PG8_STAGE(PG8_SB(1, 1), cB + hstepB + kstep, voffB);
    PG8_WAIT_V(6); PG8_BAR;
    for (;;) {
        const bool has_next = S.next(ui + 1, nxt);
        const char* nB = cB; nA = cA;
        if (has_next) { nB = S.bbase(nxt); nA = S.abase(nxt); if constexpr (Sched::GATHER) S.aoff(nxt, tid, vN); }
        else { if constexpr (Sched::GATHER) {
#pragma unroll
            for (int h = 0; h < 2; ++h)
#pragma unroll
                for (int i = 0; i < 2; ++i) vN[h][i] = vC[h][i]; } }
        int t = 0;
        if (Epi::NSTORE > 0 && hoisted) { PG8_BODY(true); t = 2; }
        for (; t < nt; t += 2) { PG8_BODY(false); }
        hoisted = false;
        if constexpr (Epi::NSTORE > 0) { if (has_next) { PG8_STAGEA(PG8_SA(1, 1), 1, kstep, true); hoisted = true; } }
        asm volatile("" ::: "memory");
        E(acc, cur, wr, wc, fr, fq);
        asm volatile("" ::: "memory");
        if (!has_next) break;
#pragma unroll
        for (int a = 0; a < 2; ++a)
#pragma unroll
            for (int b = 0; b < 2; ++b)
#pragma unroll
                for (int m = 0; m < 4; ++m)
#pragma unroll
                    for (int n = 0; n < 2; ++n) { acc[a][b][m][n] = (f32x4){0.f, 0.f, 0.f, 0.f}; asm volatile("" : "+v"(acc[a][b][m][n])); }
        cur = nxt; cB = nB; cA = nA; ++ui;
        if constexpr (Sched::GATHER) {
#pragma unroll
            for (int h = 0; h < 2; ++h)
#pragma unroll
                for (int i = 0; i < 2; ++i) vC[h][i] = vN[h][i]; }
    }
    PG8_WAIT_V(0);
    if (wr == 0) PG8_BAR;
    PG8_BAR;
#undef PG8_SA
#undef PG8_SB
#undef PG8_STAGE
#undef PG8_STAGEA
#undef PG8_LDA
#undef PG8_LDB
#undef PG8_MMA
#undef PG8_WAIT_V
#undef PG8_WAIT_VN
#undef PG8_BODY
#undef PG8_WAIT_L
#undef PG8_BAR
#undef PG8_SCHED
}

struct EpiStoreBf16 {
    static constexpr int PERM = 2, NSTORE = 16;
    bf16_t* O; int ldc;
    __device__ __forceinline__ void operator()(const f32x4 (&acc)[2][2][4][2], const Unit& u, int wr, int wc, int fr, int fq) const {
        const int row0 = u.pm * BM + wr * 64 + fr, col0 = u.pn * BM + wc * 64 + 16 * fq;
#pragma unroll
        for (int ai = 0; ai < 2; ++ai)
#pragma unroll
            for (int m = 0; m < 4; ++m) { bf16_t* rowp = O + (size_t)(row0 + ai * HALF + m * 16) * ldc + col0;
#pragma unroll
                for (int bj = 0; bj < 2; ++bj) { const f32x4 v0 = acc[ai][bj][m][0], v1 = acc[ai][bj][m][1];
                    u32x4 w; w.x = cvt_pk_bf16(v0[0], v0[1]); w.y = cvt_pk_bf16(v0[2], v0[3]); w.z = cvt_pk_bf16(v1[0], v1[1]); w.w = cvt_pk_bf16(v1[2], v1[3]);
                    *(u32x4*)(rowp + bj * 8) = w; } }
    }
};
struct EpiResid {
    static constexpr int PERM = 0, NSTORE = 0;
    float* X; const float* mods_l; int rbase;
    __device__ __forceinline__ void operator()(const f32x4 (&acc)[2][2][4][2], const Unit& u, int wr, int wc, int fr, int fq) const {
        const int row0 = u.pm * BM + wr * 64 + fr, col0 = u.pn * BM + wc * 32 + 4 * fq;
        const float* m2 = mods_l + (size_t)(slot_of_row(rbase + u.pm * BM) * 6 + 2) * DM + col0;
        float* xb = X + (size_t)row0 * DM + col0;
        f32x4 mv[4], xv[2][8];
#pragma unroll
        for (int g = 0; g < 4; ++g) mv[g] = *(const f32x4*)(m2 + (g >> 1) * HALF + (g & 1) * 16);
#pragma unroll
        for (int q = 0; q < 8; ++q) xv[0][q] = *(const f32x4*)(xb + (size_t)((q >> 2) * HALF + (q & 3) * 16) * DM);
        asm volatile("" ::: "memory"); __builtin_amdgcn_sched_barrier(0);
#pragma unroll
        for (int g = 0; g < 4; ++g) { const int bj = g >> 1, n = g & 1;
            if (g < 3) { const int bj1 = (g + 1) >> 1, n1 = (g + 1) & 1;
#pragma unroll
                for (int q = 0; q < 8; ++q) xv[(g + 1) & 1][q] = *(const f32x4*)(xb + (size_t)((q >> 2) * HALF + (q & 3) * 16) * DM + bj1 * HALF + n1 * 16);
                asm volatile("" ::: "memory"); __builtin_amdgcn_sched_barrier(0); }
#pragma unroll
            for (int q = 0; q < 8; ++q) *(f32x4*)(xb + (size_t)((q >> 2) * HALF + (q & 3) * 16) * DM + bj * HALF + n * 16) = xv[g & 1][q] * ALPHA + mv[g] * acc[q >> 2][bj][q & 3][n];
            asm volatile("" ::: "memory"); __builtin_amdgcn_sched_barrier(0); }
    }
};
struct EpiSwiglu {
    static constexpr int PERM = 1, NSTORE = 8;
    bf16_t* H;
    __device__ __forceinline__ void operator()(const f32x4 (&acc)[2][2][4][2], const Unit& u, int wr, int wc, int fr, int fq) const {
        const int row0 = u.pm * BM + wr * 64 + fr, col0 = u.pn * HALF + wc * 32 + 8 * fq;
#pragma unroll
        for (int ai = 0; ai < 2; ++ai)
#pragma unroll
            for (int m = 0; m < 4; ++m) { bf16_t* rowp = H + (size_t)(row0 + ai * HALF + m * 16) * 256 + col0;
                float h[8];
#pragma unroll
                for (int n = 0; n < 2; ++n)
#pragma unroll
                    for (int j = 0; j < 4; ++j) h[n * 4 + j] = siluf_(acc[ai][0][m][n][j]) * acc[ai][1][m][n][j];
                u32x4 w; w.x = cvt_pk_bf16(h[0], h[1]); w.y = cvt_pk_bf16(h[2], h[3]); w.z = cvt_pk_bf16(h[4], h[5]); w.w = cvt_pk_bf16(h[6], h[7]);
                *(u32x4*)rowp = w; }
    }
};
struct EpiDown {
    static constexpr int PERM = 2, NSTORE = 8;
    unsigned char* Y;
    __device__ __forceinline__ void operator()(const f32x4 (&acc)[2][2][4][2], const Unit& u, int wr, int wc, int fr, int fq) const {
        const int row0 = u.pm * BM + wr * 64 + fr, col0 = u.pn * BM + wc * 64 + 16 * fq;
        unsigned char* yb = Y + (size_t)row0 * DM + col0;
#pragma unroll
        for (int ai = 0; ai < 2; ++ai)
#pragma unroll
            for (int m = 0; m < 4; ++m) { const int rl = ai * HALF + m * 16;
                u32x4 ww; unsigned pk[4];
#pragma unroll
                for (int bj = 0; bj < 2; ++bj)
#pragma unroll
                    for (int n = 0; n < 2; ++n) { f32x4 v = acc[ai][bj][m][n] * 16.0f;
#pragma unroll
                        for (int j = 0; j < 4; ++j) v[j] = __builtin_amdgcn_fmed3f(v[j], -440.0f, 440.0f);
                        int p = __builtin_amdgcn_cvt_pk_fp8_f32(v[0], v[1], 0, false); p = __builtin_amdgcn_cvt_pk_fp8_f32(v[2], v[3], p, true); pk[bj * 2 + n] = (unsigned)p; }
                ww.x = pk[0]; ww.y = pk[1]; ww.z = pk[2]; ww.w = pk[3];
                __builtin_nontemporal_store(ww, (u32x4*)(yb + (size_t)rl * DM));
                asm volatile("" ::: "memory"); }
    }
};
template <int MODE> struct EpiDownProbe {
    static constexpr int PERM = 2, NSTORE = 0;
    unsigned char* Y; const float* sw; const LAS int* cnt;
    __device__ __forceinline__ void operator()(const f32x4 (&acc)[2][2][4][2], const Unit& u, int wr, int wc, int fr, int fq) const {
        const int hsh = (u.pm * 4 + u.pn) & 2047;
        unsigned char* yb = (MODE == 1) ? Y + ((size_t)(hsh * 8 + wr * 4 + wc) * 8) * 1024 + (fq * 16 + fr) * 16
                                        : Y + (size_t)((u.pm & 511) * BM + wr * 64 + fr) * DM + u.pn * BM + wc * 64 + 16 * fq;
#pragma unroll
        for (int ai = 0; ai < 2; ++ai)
#pragma unroll
            for (int m = 0; m < 4; ++m) { const int rl = ai * HALF + m * 16; const float w = 32.0f;
                u32x4 ww; unsigned pk[4];
#pragma unroll
                for (int bj = 0; bj < 2; ++bj)
#pragma unroll
                    for (int n = 0; n < 2; ++n) { f32x4 v = acc[ai][bj][m][n] * w;
#pragma unroll
                        for (int j = 0; j < 4; ++j) v[j] = __builtin_amdgcn_fmed3f(v[j], -440.0f, 440.0f);
                        int p = __builtin_amdgcn_cvt_pk_fp8_f32(v[0], v[1], 0, false); p = __builtin_amdgcn_cvt_pk_fp8_f32(v[2], v[3], p, true); pk[bj * 2 + n] = (unsigned)p; }
                ww.x = pk[0]; ww.y = pk[1]; ww.z = pk[2]; ww.w = pk[3];
                if (MODE == 1) __builtin_nontemporal_store(ww, (u32x4*)(yb + (size_t)(ai * 4 + m) * 1024));
                else if (MODE == 2) __builtin_nontemporal_store(ww, (u32x4*)(yb + (size_t)rl * DM));
                else *(u32x4*)(yb + (size_t)rl * DM) = ww;
                asm volatile("" ::: "memory"); }
    }
};
struct EpiNull {
    static constexpr int PERM = 1, NSTORE = 0;
    __device__ __forceinline__ void operator()(const f32x4 (&acc)[2][2][4][2], const Unit&, int, int, int, int) const {
#pragma unroll
        for (int ai = 0; ai < 2; ++ai)
#pragma unroll
            for (int bj = 0; bj < 2; ++bj)
#pragma unroll
                for (int m = 0; m < 4; ++m)
#pragma unroll
                    for (int n = 0; n < 2; ++n) asm volatile("" :: "v"(acc[ai][bj][m][n]));
    }
};
template <int NPN> struct MoeOrder {
    const LAS int* cnt; const LAS int* tst; const LAS unsigned char* t2e; int ntiles, G, c;
    __device__ __forceinline__ bool next(int i, Unit& u) const {
        const int cs = ((G & 7) == 0) ? (c & 7) * (G >> 3) + (c >> 3) : c;
        const int L = i * G + cs; if (L >= ntiles * NPN) return false;
        const int tau = L / NPN; u.pm = tau; u.pn = L % NPN; u.e = t2e[tau]; u.ti = tau - tst[u.e]; return true;
    }
};
struct MoeGU : MoeOrder<2> {
    static constexpr bool GATHER = true;
    const char* A; const char* Bt; const int* stok; int t0;
    __device__ __forceinline__ const char* abase(const Unit&) const { return A; }
    __device__ __forceinline__ const char* bbase(const Unit& u) const { return Bt + ((size_t)u.e * 512 + (size_t)u.pn * 256) * 1024 * 2; }
    __device__ __forceinline__ void aoff(const Unit& u, int tid, unsigned (&off)[2][2]) const {
        const int ce = cnt[u.e];
#pragma unroll
        for (int i = 0; i < 2; ++i) { int R, C; stage_rc(tid * 16 + i * 8192, R, C);
#pragma unroll
            for (int h = 0; h < 2; ++h) { const int pos = u.ti * 256 + h * HALF + R; int tok;
                if (u.e == 64) tok = t0 + pos; else tok = (pos < ce) ? stok[(size_t)u.e * CAP + pos] : 0;
                off[h][i] = (unsigned)(tok * 1024 + C) * 2u; } }
    }
};
struct MoeDN : MoeOrder<4> {
    static constexpr bool GATHER = false;
    const char* A; const char* Bt;
    __device__ __forceinline__ const char* abase(const Unit& u) const { return A + (size_t)u.pm * BM * 256 * 2; }
    __device__ __forceinline__ const char* bbase(const Unit& u) const { return Bt + ((size_t)u.e * 1024 + (size_t)u.pn * 256) * 256 * 2; }
};
}

struct Args { const float* in[30]; float* out; unsigned char* ws; int ph_lo, ph_hi; };

struct Frame {
    float* out; unsigned char* ws; LAS unsigned char* lds; int tid, lane, wave, G, wg;
    float* mods; float* X; bf16_t* HB; bf16_t* MIX; unsigned char* WB; unsigned char* R1;
};

__device__ __forceinline__ const float* inp(const Frame& F, int i) {
    const unsigned long long v = ((const LAS unsigned long long*)(F.lds + LDS_MISC + MISC_INP))[i];
    const unsigned lo = (unsigned)__builtin_amdgcn_readfirstlane((int)(unsigned)v), hi = (unsigned)__builtin_amdgcn_readfirstlane((int)(unsigned)(v >> 32));
    return (const float*)(((unsigned long long)hi << 32) | lo);
}
__device__ __forceinline__ int lane_id_() { return (int)__builtin_amdgcn_mbcnt_hi(~0u, __builtin_amdgcn_mbcnt_lo(~0u, 0u)); }
__device__ __forceinline__ Frame fresh(const Frame& F0) { Frame F = F0; int ln = lane_id_(); asm volatile("" : "+v"(ln)); F.lane = ln; F.tid = F0.wave * 64 + ln; return F; }

__device__ __forceinline__ void ph_mods(const Frame& F) {
    const float* c = inp(F, 1); const float* cc = inp(F, 3); const float* ada_w = inp(F, 4); const float* ada_b = inp(F, 5);
    LAS float* sv = (LAS float*)F.lds;
    LAS float* red = (LAS float*)(F.lds + 5 * 1024 * 4);
    for (int i = F.tid; i < 5 * 1024; i += 512) { const int s = i >> 10, k = i & 1023; const float v = (s < 4) ? c[s * 1024 + k] : cc[k]; sv[i] = siluf_(v); }
    __syncthreads();
    for (int task = F.wg; task < 4 * 48; task += F.G) {
        const int l = task / 48, cc0 = (task % 48) * 128;
        const int cg = F.tid & 31, kg = F.tid >> 5;
        const float* w = ada_w + (size_t)l * 1024 * 6144 + cc0 + cg * 4;
        f32x4 acc[5];
#pragma unroll
        for (int s = 0; s < 5; ++s) acc[s] = (f32x4){0.f, 0.f, 0.f, 0.f};
#pragma unroll 8
        for (int kk = 0; kk < 64; ++kk) { const int k = kg * 64 + kk; const f32x4 wv = *(const f32x4*)(w + (size_t)k * 6144);
#pragma unroll
            for (int s = 0; s < 5; ++s) acc[s] += wv * sv[s * 1024 + k]; }
#pragma unroll
        for (int s = 0; s < 5; ++s)
#pragma unroll
            for (int q = 0; q < 4; ++q) red[((kg * 128) + cg * 4 + q) * 5 + s] = acc[s][q];
        __syncthreads();
        if (F.tid < 128) {
            const int col = cc0 + F.tid; const float bsv = ada_b[l * 6144 + col];
#pragma unroll
            for (int s = 0; s < 5; ++s) { float v = 0.f;
#pragma unroll
                for (int g2 = 0; g2 < 16; ++g2) v += red[((g2 * 128) + F.tid) * 5 + s];
                F.mods[(size_t)(l * 5 + s) * 6144 + col] = v + bsv; }
        }
        __syncthreads();
    }
    if (F.wg == F.G - 1) {
        const float* raw = inp(F, 11); float* lbt = (float*)(F.ws + OFF_LBT);
        for (int i = F.tid; i < 2 * 512; i += 512) { const int d = i >> 9, ch = i & 511; const float r0 = raw[(d * 2 + 0) * 512 + ch], r1 = raw[(d * 2 + 1) * 512 + ch];
            lbt[(0 * 2 + d) * 512 + ch] = 0.f; lbt[(1 * 2 + d) * 512 + ch] = sigmoidf_(r1 - r0); }
    }
}

__device__ __forceinline__ void ph_init_x(const Frame& F) {
    const float* x = inp(F, 0); const float* ctx = inp(F, 2);
    { const float* lg_ = inp(F, 6); const float* lb_ = inp(F, 7); float* AB = (float*)(F.ws + OFF_AB);
      for (int i = F.wg * 512 + F.tid; i < 4 * 5 * 1024; i += F.G * 512) { const int k = i & 1023, ls = i >> 10, l = ls / 5;
          const float* m = F.mods + (size_t)ls * 6144; const float g0 = lg_[(l * 2) * 1024 + k], b0 = lb_[(l * 2) * 1024 + k], m3 = m[3 * 1024 + k], m4 = m[4 * 1024 + k];
          AB[(size_t)ls * 2048 + k] = g0 * (1.0f + m4); AB[(size_t)ls * 2048 + 1024 + k] = b0 * (1.0f + m4) + m3; } }
    const int gw = F.wg * 8 + F.wave, nw = F.G * 8;
    for (int row = gw; row < TT; row += nw) {
        const float* src = row < TC ? ctx + (size_t)row * DM : x + (size_t)(row - TC) * DM;
        const float* m = F.mods + (size_t)(0 * 5 + slot_of_row(row)) * 6144;
#pragma unroll
        for (int hh = 0; hh < 2; ++hh) { const int k = hh * 512 + F.lane * 8;
            const f32x4 v0 = *(const f32x4*)(src + k), v1 = *(const f32x4*)(src + k + 4);
            *(f32x4*)(F.X + (size_t)row * DM + k) = v0; *(f32x4*)(F.X + (size_t)row * DM + k + 4) = v1;
            const f32x4 s0 = *(const f32x4*)(m + 1024 + k), s1 = *(const f32x4*)(m + 1024 + k + 4), b0 = *(const f32x4*)(m + k), b1 = *(const f32x4*)(m + k + 4);
            const f32x4 h0 = v0 * (s0 + 1.0f) + b0, h1 = v1 * (s1 + 1.0f) + b1;
            u32x4 w; w.x = cvt_pk_bf16(h0[0], h0[1]); w.y = cvt_pk_bf16(h0[2], h0[3]); w.z = cvt_pk_bf16(h1[0], h1[1]); w.w = cvt_pk_bf16(h1[2], h1[3]);
            *(u32x4*)(F.HB + (size_t)row * DM + k) = w; }
    }
}

__device__ __forceinline__ void cvt_tile(const Frame& F, const float* src, int sld, int k0, int n0, bf16_t* dst, int dld, int drow0, float scale) {
    LAS float* t = (LAS float*)F.lds;
    { const int i = F.tid >> 3, j0 = (F.tid & 7) * 8; const float* p = src + (size_t)(k0 + i) * sld + n0 + j0;
      const f32x4 a = *(const f32x4*)p, b = *(const f32x4*)(p + 4);
      LAS float* q = t + i * 65 + j0; q[0] = a[0]; q[1] = a[1]; q[2] = a[2]; q[3] = a[3]; q[4] = b[0]; q[5] = b[1]; q[6] = b[2]; q[7] = b[3]; }
    __syncthreads();
    { const int j = F.tid >> 3, i0 = (F.tid & 7) * 8; float v[8];
#pragma unroll
      for (int q = 0; q < 8; ++q) v[q] = t[(i0 + q) * 65 + j] * scale;
      u32x4 w; w.x = cvt_pk_bf16(v[0], v[1]); w.y = cvt_pk_bf16(v[2], v[3]); w.z = cvt_pk_bf16(v[4], v[5]); w.w = cvt_pk_bf16(v[6], v[7]);
      *(u32x4*)(dst + (size_t)(drow0 + j) * dld + k0 + i0) = w; }
    __syncthreads();
}
__device__ __forceinline__ void ph_convert(const Frame& F, int l) {
    const int j = l >> 1; const bool even = (l & 1) == 0;
    bf16_t* wIN = (bf16_t*)(F.WB + WB_IN); bf16_t* wOUT = (bf16_t*)(F.WB + WB_OUT); bf16_t* wRT = (bf16_t*)(F.WB + WB_RT);
    bf16_t* wGU = (bf16_t*)(F.WB + WB_GU); bf16_t* wDN = (bf16_t*)(F.WB + WB_DN); bf16_t* wLRU = (bf16_t*)(F.WB + WB_LRU);
    const int nIN = even ? 4096 : 2048;
    const int t_in = (nIN / 64) * 16, t_out = 256, t_rt = 16, t_gu = 65 * 2 * 64, t_dn = 65 * 64, t_lru = even ? 0 : 64;
    const int total = t_in + t_out + t_rt + t_gu + t_dn + t_lru;
    for (int task = F.wg; task < total; task += F.G) {
        int t = task;
        if (t < t_in) { const int nb = t >> 4, kb = t & 15; const float* src = even ? inp(F, 8) + (size_t)j * 1024 * 4096 : inp(F, 13) + (size_t)j * 1024 * 2048;
            cvt_tile(F, src, nIN, kb * 64, nb * 64, wIN, 1024, nb * 64, (even && nb < 8) ? 0.125f * 1.4426950408889634f : 1.0f); continue; }
        t -= t_in;
        if (t < t_out) { const int nb = t >> 4, kb = t & 15; const float* src = even ? inp(F, 9) + (size_t)j * 1024 * 1024 : inp(F, 21) + (size_t)j * 1024 * 1024;
            cvt_tile(F, src, 1024, kb * 64, nb * 64, wOUT, 1024, nb * 64, 1.0f); continue; }
        t -= t_out;
        if (t < t_rt) { cvt_tile(F, inp(F, 22) + (size_t)l * 1024 * 64, 64, t * 64, 0, wRT, 1024, 0, 1.0f); continue; }
        t -= t_rt;
        if (t < t_gu) { const int e = t / 128, r = t % 128, which = r >> 6, q = r & 63, nb = q >> 4, kb = q & 15;
            const float* src = (e < 64) ? (which ? inp(F, 25) : inp(F, 24)) + ((size_t)l * 64 + e) * 1024 * 256 : (which ? inp(F, 28) : inp(F, 27)) + (size_t)l * 1024 * 256;
            const int n0 = nb * 64, drow0 = (n0 >> 7) * 256 + which * 128 + (n0 & 127);
            cvt_tile(F, src, 256, kb * 64, n0, wGU + (size_t)e * 512 * 1024, 1024, drow0, 1.0f); continue; }
        t -= t_gu;
        if (t < t_dn) { const int e = t >> 6, q = t & 63, nb = q >> 2, kb = q & 3;
            const float* src = (e < 64) ? inp(F, 26) + ((size_t)l * 64 + e) * 256 * 1024 : inp(F, 29) + (size_t)l * 256 * 1024;
            cvt_tile(F, src, 1024, kb * 64, nb * 64, wDN + (size_t)e * 1024 * 256, 256, nb * 64, 1.0f); continue; }
        t -= t_dn;
        { const int d = t >> 5, gt = (t >> 4) & 1, kb = t & 15;
          const float* src = (gt ? inp(F, 18) : inp(F, 16)) + (((size_t)j * 2 + d) * 16 + kb) * 4096;
          cvt_tile(F, src, 64, 0, 0, wLRU + (((size_t)d * 2 + gt) * 16 + kb) * 4096, 64, 0, 1.0f); }
    }
}

__device__ __forceinline__ void ph_attn(const Frame& F, int j) {
    const bf16_t* P = (const bf16_t*)(F.R1 + R1_P);
    LAS bf16_t* Ks0 = (LAS bf16_t*)F.lds;
    LAS float* rp_l = (LAS float*)(F.lds + 36864);
    const float* rpb = inp(F, 10) + (size_t)j * 8 * 465;
    const int g = F.lane >> 4, l15 = F.lane & 15;
    const int NLAT = NBAT * 8 * 64, NTASK = NLAT + NBAT * 8 * 2;
    const int wgs = ((F.G & 7) == 0) ? (F.wg & 7) * (F.G >> 3) + (F.wg >> 3) : F.wg;
    int cidx[4][4];
    { const int wq_ = (F.wave & 3) * 16 + l15, c0_ = min(max(wq_ - 8, 0), 48);
#pragma unroll
      for (int kb = 0; kb < 4; ++kb)
#pragma unroll
          for (int i = 0; i < 4; ++i) { const int kc = kb * 16 + 4 * g + i; cidx[kb][i] = (kc >= c0_ && kc < c0_ + 16) ? (kc - wq_ + 15) : 31; } }
    for (int task = wgs; task < NTASK; task += F.G) {
        const bool lat = task < NLAT;
        int b, h, rp = 0, half = 0;
        if (lat) { b = task >> 9; h = (task >> 6) & 7; rp = task & 63; } else { const int t2 = task - NLAT; b = t2 >> 4; h = (t2 >> 1) & 7; half = t2 & 1; }
        const int myr = 2 * rp + (F.wave >> 2), w0 = (F.wave & 3) * 16;
        const int r0 = min(max(myr - 4, 0), 120);
        const int rlo = min(max(2 * rp - 4, 0), 120), rhi = min(max(2 * rp + 1 - 4, 0), 120) + 7;
        const int nloc = lat ? (rhi - rlo + 1) : 0;
        const int qrow = lat ? (TC + b * SEQ + myr * 64 + w0 + l15) : (b * CTXL + half * 128 + F.wave * 16 + l15);
        bf16x8 qf[2];
        qf[0] = *(const bf16x8*)(P + (size_t)qrow * 4096 + h * 64 + g * 8);
        qf[1] = *(const bf16x8*)(P + (size_t)qrow * 4096 + h * 64 + 32 + g * 8);
        if (lat) for (int i = F.tid; i < 480; i += 512) { const int rr = i >> 5, cc = i & 31; rp_l[i] = (cc < 31) ? rpb[h * 465 + rr * 31 + cc] * 1.4426950408889634f : -1e30f; }
        f32x4 oacc[4];
#pragma unroll
        for (int dt = 0; dt < 4; ++dt) oacc[dt] = (f32x4){0.f, 0.f, 0.f, 0.f};
        float mrun = -1e30f, lrun = 0.f;
        const int wq = w0 + l15, c0 = min(max(wq - 8, 0), 48);
        u32x4 kv, vv;
        { const int key = F.tid >> 3, ds = (F.tid & 7) * 8; const bool loc0 = 0 < nloc;
          const int krow = loc0 ? (TC + b * SEQ + rlo * 64 + key) : (b * CTXL + key);
          kv = *(const u32x4*)(P + (size_t)krow * 4096 + 512 + h * 64 + ds); vv = *(const u32x4*)(P + (size_t)krow * 4096 + 1024 + h * 64 + ds); }
#define ATT_STAGE(buf_, c_) do { const int key = F.tid >> 3, ds = (F.tid & 7) * 8; LAS bf16_t* Kd = Ks0 + (buf_) * 9216; LAS bf16_t* Vd = Kd + 4608; \
            *(LAS u32x4*)(Kd + key * 72 + ds) = kv; *(LAS u32x4*)(Vd + key * 72 + ds) = vv;     \
            if ((c_) + 1 < nloc + 4) { const bool locn = ((c_) + 1) < nloc; \
                const int krow = locn ? (TC + b * SEQ + (rlo + (c_) + 1) * 64 + key) : (b * CTXL + ((c_) + 1 - nloc) * 64 + key); \
                kv = *(const u32x4*)(P + (size_t)krow * 4096 + 512 + h * 64 + ds); vv = *(const u32x4*)(P + (size_t)krow * 4096 + 1024 + h * 64 + ds); } } while (0)
        __syncthreads();
        ATT_STAGE(0, 0);
        __syncthreads();
        for (int ch = 0; ch < nloc + 4; ++ch) {
            const bool loc = ch < nloc; const int kr = rlo + ch;
            if (ch + 1 < nloc + 4) ATT_STAGE((ch + 1) & 1, ch + 1);
            const LAS bf16_t* Ks = Ks0 + (ch & 1) * 9216; const LAS bf16_t* Vt = Ks + 4608;
            const bool mine = loc ? (kr >= r0 && kr < r0 + 8) : true;
            if (mine) {
                f32x4 s[4];
                const LAS float* rrow = rp_l + (loc ? (kr - myr + 7) * 32 : 0);
#pragma unroll
                for (int kb = 0; kb < 4; ++kb) {
                    if (loc) {
#pragma unroll
                        for (int i = 0; i < 4; ++i) s[kb][i] = rrow[cidx[kb][i]];
                    } else s[kb] = (f32x4){0.f, 0.f, 0.f, 0.f};
#pragma unroll
                    for (int ks = 0; ks < 2; ++ks) { const bf16x8 a = *(const LAS bf16x8*)(Ks + (kb * 16 + l15) * 72 + ks * 32 + g * 8);
                        s[kb] = __builtin_amdgcn_mfma_f32_16x16x32_bf16(a, qf[ks], s[kb], 0, 0, 0); } }
                float cm = -1e30f;
#pragma unroll
                for (int kb = 0; kb < 4; ++kb)
#pragma unroll
                    for (int i = 0; i < 4; ++i) cm = fmaxf(cm, s[kb][i]);
                cm = fmaxf(cm, __shfl_xor(cm, 16)); cm = fmaxf(cm, __shfl_xor(cm, 32));
                const float mn = fmaxf(mrun, cm), sc = __builtin_amdgcn_exp2f(mrun - mn);
                mrun = mn; lrun *= sc;
#pragma unroll
                for (int dt = 0; dt < 4; ++dt) oacc[dt] *= sc;
                float p[4][4];
#pragma unroll
                for (int kb = 0; kb < 4; ++kb)
#pragma unroll
                    for (int i = 0; i < 4; ++i) { p[kb][i] = __builtin_amdgcn_exp2f(s[kb][i] - mn); lrun += p[kb][i]; }
#pragma unroll
                for (int kp = 0; kp < 2; ++kp) {
                    u32x4 pw; pw.x = cvt_pk_bf16(p[2 * kp][0], p[2 * kp][1]); pw.y = cvt_pk_bf16(p[2 * kp][2], p[2 * kp][3]);
                    pw.z = cvt_pk_bf16(p[2 * kp + 1][0], p[2 * kp + 1][1]); pw.w = cvt_pk_bf16(p[2 * kp + 1][2], p[2 * kp + 1][3]);
                    bf16x8 pf; __builtin_memcpy(&pf, &pw, 16);
                    const unsigned va = (unsigned)(size_t)Vt + (unsigned)((32 * kp + 4 * g + (l15 >> 2)) * 144 + (l15 & 3) * 8);
                    u32x2 t0[4], t1[4];
                    asm volatile("ds_read_b64_tr_b16 %0, %8\n\tds_read_b64_tr_b16 %1, %8 offset:32\n\tds_read_b64_tr_b16 %2, %8 offset:64\n\tds_read_b64_tr_b16 %3, %8 offset:96\n\t"
                                 "ds_read_b64_tr_b16 %4, %8 offset:2304\n\tds_read_b64_tr_b16 %5, %8 offset:2336\n\tds_read_b64_tr_b16 %6, %8 offset:2368\n\tds_read_b64_tr_b16 %7, %8 offset:2400\n\ts_waitcnt lgkmcnt(0)"
                                 : "=&v"(t0[0]), "=&v"(t0[1]), "=&v"(t0[2]), "=&v"(t0[3]), "=&v"(t1[0]), "=&v"(t1[1]), "=&v"(t1[2]), "=&v"(t1[3]) : "v"(va) : "memory");
#pragma unroll
                    for (int dt = 0; dt < 4; ++dt) {
                        u32x4 vw; vw.x = t0[dt].x; vw.y = t0[dt].y; vw.z = t1[dt].x; vw.w = t1[dt].y; bf16x8 vf; __builtin_memcpy(&vf, &vw, 16);
                        oacc[dt] = __builtin_amdgcn_mfma_f32_16x16x32_bf16(vf, pf, oacc[dt], 0, 0, 0);
                    }
                }
            }
            __syncthreads();
        }
#undef ATT_STAGE
        float lt = lrun; lt += __shfl_xor(lt, 16); lt += __shfl_xor(lt, 32);
        const float inv = 1.0f / lt;
#pragma unroll
        for (int dt = 0; dt < 4; ++dt) { const f32x4 o = oacc[dt] * inv; u32x2 w; w.x = cvt_pk_bf16(o[0], o[1]); w.y = cvt_pk_bf16(o[2], o[3]);
            *(u32x2*)(F.MIX + (size_t)qrow * DM + h * 64 + dt * 16 + 4 * g) = w; }
        __syncthreads();
    }
}

__device__ __forceinline__ int hg_unit(int nb, int dir) { return dir == 0 ? nb : (nb < 2 ? 1 - nb : 2 + (HG_NU - 3 - (nb - 2))); }
__device__ __forceinline__ int hg_row(int b, int nb, int t) { return nb < 2 ? b * CTXL + nb * HG_U + t : TC + b * SEQ + (nb - 2) * HG_U + t; }
template <int CTRL> __device__ __forceinline__ float dpp_add0(float x) { return x + dppf<CTRL>(0.0f, x); }
#define ROW_ALLREDUCE4(v0, v1, v2, v3) asm volatile("s_nop 1\n\t" \
    "v_add_f32_dpp %0, %0, %0 quad_perm:[1,0,3,2] row_mask:0xf bank_mask:0xf\n\tv_add_f32_dpp %1, %1, %1 quad_perm:[1,0,3,2] row_mask:0xf bank_mask:0xf\n\t" \
    "v_add_f32_dpp %2, %2, %2 quad_perm:[1,0,3,2] row_mask:0xf bank_mask:0xf\n\tv_add_f32_dpp %3, %3, %3 quad_perm:[1,0,3,2] row_mask:0xf bank_mask:0xf\n\t" \
    "v_add_f32_dpp %0, %0, %0 quad_perm:[2,3,0,1] row_mask:0xf bank_mask:0xf\n\tv_add_f32_dpp %1, %1, %1 quad_perm:[2,3,0,1] row_mask:0xf bank_mask:0xf\n\t" \
    "v_add_f32_dpp %2, %2, %2 quad_perm:[2,3,0,1] row_mask:0xf bank_mask:0xf\n\tv_add_f32_dpp %3, %3, %3 quad_perm:[2,3,0,1] row_mask:0xf bank_mask:0xf\n\t" \
    "v_add_f32_dpp %0, %0, %0 row_half_mirror row_mask:0xf bank_mask:0xf\n\tv_add_f32_dpp %1, %1, %1 row_half_mirror row_mask:0xf bank_mask:0xf\n\t" \
    "v_add_f32_dpp %2, %2, %2 row_half_mirror row_mask:0xf bank_mask:0xf\n\tv_add_f32_dpp %3, %3, %3 row_half_mirror row_mask:0xf bank_mask:0xf\n\t" \
    "v_add_f32_dpp %0, %0, %0 row_mirror row_mask:0xf bank_mask:0xf\n\tv_add_f32_dpp %1, %1, %1 row_mirror row_mask:0xf bank_mask:0xf\n\t" \
    "v_add_f32_dpp %2, %2, %2 row_mirror row_mask:0xf bank_mask:0xf\n\tv_add_f32_dpp %3, %3, %3 row_mirror row_mask:0xf bank_mask:0xf" \
    : "+v"(v0), "+v"(v1), "+v"(v2), "+v"(v3))
template <bool WITHO>
__device__ __forceinline__ void hg_pass(const Frame& F, const bf16_t* P, const float* lbh, int b, int h, int nb, int dir, f32x4 (&S)[4][4], float (&Gsum)[16],
                                        LAS bf16_t* Vl, LAS bf16_t* Kl, float* OF, const float* ngp) {
    const int tau = F.lane & 15, g = F.lane >> 4;
    const unsigned vaddr = (unsigned)(size_t)Vl + (unsigned)((4 * g + (tau >> 2)) * 128 + (tau & 3) * 8);
    const unsigned kaddr = (unsigned)(size_t)Kl + (unsigned)((4 * g + (tau >> 2)) * 128 + (tau & 3) * 8);
    u32x2 zr[4], vr[4], qr[4];
    { const int t = dir ? (HG_U - 1 - tau) : tau; const bf16_t* pr = P + (size_t)hg_row(b, nb, t) * 4096 + h * 64 + 4 * g;
#pragma unroll
      for (int m = 0; m < 4; ++m) { zr[m] = *(const u32x2*)(pr + (dir ? 2560 : 2048) + 16 * m); vr[m] = *(const u32x2*)(pr + 3072 + 16 * m); } }
    for (int ci = 0; ci < HG_U / 16; ++ci) {
        float kk[16], c[16];
        if (WITHO) { const int pos = ci * 16 + tau, t = dir ? (HG_U - 1 - pos) : pos; const bf16_t* pr = P + (size_t)hg_row(b, nb, t) * 4096 + h * 64 + 4 * g;
#pragma unroll
            for (int m = 0; m < 4; ++m) qr[m] = *(const u32x2*)(pr + 1536 + 16 * m); }
#pragma unroll
        for (int m = 0; m < 4; ++m) { const float z0 = __uint_as_float(zr[m].x << 16), z1 = __uint_as_float(zr[m].x & 0xffff0000u), z2 = __uint_as_float(zr[m].y << 16), z3 = __uint_as_float(zr[m].y & 0xffff0000u);
            const float zz[4] = {z0, z1, z2, z3};
            const f32x4 lb4 = *(const f32x4*)(lbh + 16 * m + 4 * g);
#pragma unroll
            for (int i = 0; i < 4; ++i) { const float lb = lb4[i]; const float f = fmaxf(lb + (1.0f - lb) * sigmoidf_(zz[i]), 1e-30f); kk[m * 4 + i] = 1.0f - f; c[m * 4 + i] = __logf(f); }
            *(LAS u32x2*)(Vl + tau * 64 + 16 * m + 4 * g) = vr[m];
 }
        if (ci + 1 < HG_U / 16) { const int pos = (ci + 1) * 16 + tau, t = dir ? (HG_U - 1 - pos) : pos; const bf16_t* pr = P + (size_t)hg_row(b, nb, t) * 4096 + h * 64 + 4 * g;
#pragma unroll
            for (int m = 0; m < 4; ++m) { zr[m] = *(const u32x2*)(pr + (dir ? 2560 : 2048) + 16 * m); vr[m] = *(const u32x2*)(pr + 3072 + 16 * m); } }
        float G[16];
#pragma unroll
        for (int q = 0; q < 16; ++q) G[q] = c[q];
#pragma unroll
        for (int q = 0; q < 16; q += 4) ROW_ALLREDUCE4(G[q], G[q + 1], G[q + 2], G[q + 3]);
#pragma unroll
        for (int q = 0; q < 16; ++q) { c[q] = dpp_add0<0x111>(c[q]); c[q] = dpp_add0<0x112>(c[q]); c[q] = dpp_add0<0x114>(c[q]); c[q] = dpp_add0<0x118>(c[q]); }
#pragma unroll
        for (int q = 0; q < 16; ++q) Gsum[q] += G[q];
#pragma unroll
        for (int m = 0; m < 4; ++m) { float kh[4];
#pragma unroll
            for (int i = 0; i < 4; ++i) kh[i] = kk[m * 4 + i] * __expf(G[m * 4 + i] - c[m * 4 + i]);
            u32x2 w; w.x = cvt_pk_bf16(kh[0], kh[1]); w.y = cvt_pk_bf16(kh[2], kh[3]);
            *(LAS u32x2*)(Kl + tau * 64 + 16 * m + 4 * g) = w; }
        float ofv[4][4], gtv[4][4]; int orow[4];
        if (WITHO) {
#pragma unroll
            for (int i = 0; i < 4; ++i) { const int p2 = ci * 16 + 4 * g + i, t2 = dir ? (HG_U - 1 - p2) : p2; orow[i] = hg_row(b, nb, t2); }
            if (dir) {
#pragma unroll
                for (int i = 0; i < 4; ++i)
#pragma unroll
                    for (int vt = 0; vt < 4; ++vt) { ofv[i][vt] = OF[(size_t)orow[i] * 512 + h * 64 + 16 * vt + tau]; gtv[i][vt] = bf2f(P[(size_t)orow[i] * 4096 + 3584 + h * 64 + 16 * vt + tau]); }
            }
        }
        asm volatile("s_waitcnt lgkmcnt(0)" ::: "memory");
        u32x2 vtr[4], ktr[4];
        asm volatile("ds_read_b64_tr_b16 %0, %8\n\tds_read_b64_tr_b16 %1, %8 offset:32\n\tds_read_b64_tr_b16 %2, %8 offset:64\n\tds_read_b64_tr_b16 %3, %8 offset:96\n\t"
                     "ds_read_b64_tr_b16 %4, %9\n\tds_read_b64_tr_b16 %5, %9 offset:32\n\tds_read_b64_tr_b16 %6, %9 offset:64\n\tds_read_b64_tr_b16 %7, %9 offset:96\n\ts_waitcnt lgkmcnt(0)"
                     : "=&v"(vtr[0]), "=&v"(vtr[1]), "=&v"(vtr[2]), "=&v"(vtr[3]), "=&v"(ktr[0]), "=&v"(ktr[1]), "=&v"(ktr[2]), "=&v"(ktr[3]) : "v"(vaddr), "v"(kaddr) : "memory");
        bf16x8 Vf[4], Kf[4];
#pragma unroll
        for (int q = 0; q < 4; ++q) { u32x4 w; w.x = vtr[q].x; w.y = vtr[q].y; w.z = 0u; w.w = 0u; __builtin_memcpy(&Vf[q], &w, 16); u32x4 w2; w2.x = ktr[q].x; w2.y = ktr[q].y; w2.z = 0u; w2.w = 0u; __builtin_memcpy(&Kf[q], &w2, 16); }
        if (WITHO) {
            bf16x8 Ktf[2], Qtf[2], Qhf[2];
#pragma unroll
            for (int ks = 0; ks < 2; ++ks) { float kt_[8], qt_[8], qh_[8];
#pragma unroll
                for (int mm = 0; mm < 2; ++mm) { const int m = 2 * ks + mm;
                    const float qq[4] = {__uint_as_float(qr[m].x << 16), __uint_as_float(qr[m].x & 0xffff0000u), __uint_as_float(qr[m].y << 16), __uint_as_float(qr[m].y & 0xffff0000u)};
#pragma unroll
                    for (int i = 0; i < 4; ++i) { const int q = m * 4 + i; const float qv = siluf_(qq[i]) * 0.125f; const float d = fminf(fmaxf(c[q] - 0.5f * G[q], -80.0f), 80.0f);
                        qt_[mm * 4 + i] = qv * __expf(d); kt_[mm * 4 + i] = kk[q] * __expf(-d); qh_[mm * 4 + i] = qv * __expf(c[q]); } }
                u32x4 w; w.x = cvt_pk_bf16(kt_[0], kt_[1]); w.y = cvt_pk_bf16(kt_[2], kt_[3]); w.z = cvt_pk_bf16(kt_[4], kt_[5]); w.w = cvt_pk_bf16(kt_[6], kt_[7]); __builtin_memcpy(&Ktf[ks], &w, 16);
                w.x = cvt_pk_bf16(qt_[0], qt_[1]); w.y = cvt_pk_bf16(qt_[2], qt_[3]); w.z = cvt_pk_bf16(qt_[4], qt_[5]); w.w = cvt_pk_bf16(qt_[6], qt_[7]); __builtin_memcpy(&Qtf[ks], &w, 16);
                w.x = cvt_pk_bf16(qh_[0], qh_[1]); w.y = cvt_pk_bf16(qh_[2], qh_[3]); w.z = cvt_pk_bf16(qh_[4], qh_[5]); w.w = cvt_pk_bf16(qh_[6], qh_[7]); __builtin_memcpy(&Qhf[ks], &w, 16); }
            f32x4 AT = (f32x4){0.f, 0.f, 0.f, 0.f};
            AT = __builtin_amdgcn_mfma_f32_16x16x32_bf16(Ktf[0], Qtf[0], AT, 0, 0, 0); AT = __builtin_amdgcn_mfma_f32_16x16x32_bf16(Ktf[1], Qtf[1], AT, 0, 0, 0);
#pragma unroll
            for (int i = 0; i < 4; ++i) AT[i] = (4 * g + i <= tau) ? AT[i] : 0.0f;
            bf16x8 Af; { u32x4 w; w.x = cvt_pk_bf16(AT[0], AT[1]); w.y = cvt_pk_bf16(AT[2], AT[3]); w.z = 0u; w.w = 0u; __builtin_memcpy(&Af, &w, 16); }
            f32x4 o[4];
#pragma unroll
            for (int vt = 0; vt < 4; ++vt) { o[vt] = __builtin_amdgcn_mfma_f32_16x16x32_bf16(Af, Vf[vt], (f32x4){0.f, 0.f, 0.f, 0.f}, 0, 0, 0);
#pragma unroll
                for (int ks = 0; ks < 2; ++ks) { u32x4 w; w.x = cvt_pk_bf16(S[2 * ks][vt][0], S[2 * ks][vt][1]); w.y = cvt_pk_bf16(S[2 * ks][vt][2], S[2 * ks][vt][3]);
                    w.z = cvt_pk_bf16(S[2 * ks + 1][vt][0], S[2 * ks + 1][vt][1]); w.w = cvt_pk_bf16(S[2 * ks + 1][vt][2], S[2 * ks + 1][vt][3]); bf16x8 Sf; __builtin_memcpy(&Sf, &w, 16);
                    o[vt] = __builtin_amdgcn_mfma_f32_16x16x32_bf16(Qhf[ks], Sf, o[vt], 0, 0, 0); } }
            if (dir == 0) {
#pragma unroll
                for (int i = 0; i < 4; ++i)
#pragma unroll
                    for (int vt = 0; vt < 4; ++vt) OF[(size_t)orow[i] * 512 + h * 64 + 16 * vt + tau] = o[vt][i];
            } else {
                { float tot[4][4], sq[4];
#pragma unroll
                for (int i = 0; i < 4; ++i) { sq[i] = 0.f;
#pragma unroll
                    for (int vt = 0; vt < 4; ++vt) { tot[i][vt] = o[vt][i] + ofv[i][vt]; sq[i] = fmaf(tot[i][vt], tot[i][vt], sq[i]); } }
                ROW_ALLREDUCE4(sq[0], sq[1], sq[2], sq[3]);
#pragma unroll
                for (int i = 0; i < 4; ++i) { const float rs = rsqrtf(sq[i] * (1.0f / 64.0f) + 1e-6f);
#pragma unroll
                    for (int vt = 0; vt < 4; ++vt) F.MIX[(size_t)orow[i] * DM + 512 + h * 64 + 16 * vt + tau] = f2bf(tot[i][vt] * rs * ngp[16 * vt + tau] * siluf_(gtv[i][vt])); } }
            }
        }
#pragma unroll
        for (int kt = 0; kt < 4; ++kt) { f32x4 eg;
#pragma unroll
            for (int i = 0; i < 4; ++i) eg[i] = __expf(G[kt * 4 + i]);
#pragma unroll
            for (int vt = 0; vt < 4; ++vt) S[kt][vt] = __builtin_amdgcn_mfma_f32_16x16x32_bf16(Kf[kt], Vf[vt], S[kt][vt] * eg, 0, 0, 0); }
    }
}
__device__ __forceinline__ void ph_hg_a(const Frame& F, int j) {
    const bf16_t* P = (const bf16_t*)(F.R1 + R1_P);
    float* SLOC = (float*)(F.R1 + R1_SLOC); float* DL = (float*)(F.R1 + R1_DL);
    LAS bf16_t* Vl = (LAS bf16_t*)(F.lds + 32768 + F.wave * 4096); LAS bf16_t* Kl = Vl + 1024;
    const int gw = F.wg * 8 + F.wave, nw = F.G * 8;
    const int NT = NBAT * 8 * (HG_NU - 2) * 2;
    for (int task = gw; task < NT; task += nw) {
        const int dir = task & 1, nb = 2 + (task >> 1) % (HG_NU - 2), bh = (task >> 1) / (HG_NU - 2), b = bh >> 3, h = bh & 7;
        const float* lbh = (const float*)(F.ws + OFF_LBT) + (j * 2 + dir) * 512 + h * 64;
        f32x4 S[4][4];
#pragma unroll
        for (int kt = 0; kt < 4; ++kt)
#pragma unroll
            for (int vt = 0; vt < 4; ++vt) S[kt][vt] = (f32x4){0.f, 0.f, 0.f, 0.f};
        float Gsum[16];
#pragma unroll
        for (int q = 0; q < 16; ++q) Gsum[q] = 0.f;
        hg_pass<false>(F, P, lbh, b, h, nb, dir, S, Gsum, Vl, Kl, nullptr, nullptr);
        const int seq = bh * 2 + dir, u = hg_unit(nb, dir);
        float* so = SLOC + ((size_t)seq * HG_NU + u) * 4096;
#pragma unroll
        for (int kt = 0; kt < 4; ++kt)
#pragma unroll
            for (int vt = 0; vt < 4; ++vt)
#pragma unroll
                for (int i = 0; i < 4; ++i) so[((kt * 4 + vt) * 4 + i) * 64 + F.lane] = S[kt][vt][i];
        if ((F.lane & 15) == 0) { float* dd = DL + ((size_t)seq * HG_NU + u) * 64;
#pragma unroll
            for (int m = 0; m < 4; ++m)
#pragma unroll
                for (int i = 0; i < 4; ++i) dd[16 * m + 4 * (F.lane >> 4) + i] = __expf(Gsum[m * 4 + i]); }
    }
}
__device__ __forceinline__ void ph_hg_b(const Frame& F) {
    const float* SLOC = (const float*)(F.R1 + R1_SLOC); const float* DL = (const float*)(F.R1 + R1_DL); float* SST = (float*)(F.R1 + R1_SST);
    for (int idx = F.wg * 512 + F.tid; idx < 64 * 4096; idx += F.G * 512) {
        const int seq = idx >> 12, e = idx & 4095, ln = e & 63, reg = e >> 6, i = reg & 3, kt = reg >> 4, k = 16 * kt + 4 * (ln >> 4) + i;
        float s = 0.f;
#pragma unroll 6
        for (int u = 0; u < HG_NU; ++u) { const size_t o = ((size_t)seq * HG_NU + u) * 4096 + e; SST[o] = s; s = DL[((size_t)seq * HG_NU + u) * 64 + k] * s + SLOC[o]; }
    }
}
__device__ __forceinline__ void ph_hg_c(const Frame& F, int j) {
    const bf16_t* P = (const bf16_t*)(F.R1 + R1_P);
    const float* SST = (const float*)(F.R1 + R1_SST); float* OF = (float*)(F.R1 + R1_OF);
    const float* ng = inp(F, 12) + j * 64;
    LAS bf16_t* Vl = (LAS bf16_t*)(F.lds + 32768 + F.wave * 4096); LAS bf16_t* Kl = Vl + 1024;
    const int gw = F.wg * 8 + F.wave, nw = F.G * 8;
    const int NT = NBAT * 8 * (HG_NU - 2);
    for (int task = gw; task < NT; task += nw) {
        const int nb = 2 + task % (HG_NU - 2), bh = task / (HG_NU - 2), b = bh >> 3, h = bh & 7;
        for (int dir = 0; dir < 2; ++dir) {
            const float* lbh = (const float*)(F.ws + OFF_LBT) + (j * 2 + dir) * 512 + h * 64;
            const int seq = bh * 2 + dir, u = hg_unit(nb, dir);
            const float* ss = SST + ((size_t)seq * HG_NU + u) * 4096;
            f32x4 S[4][4];
#pragma unroll
            for (int kt = 0; kt < 4; ++kt)
#pragma unroll
                for (int vt = 0; vt < 4; ++vt)
#pragma unroll
                    for (int i = 0; i < 4; ++i) S[kt][vt][i] = ss[((kt * 4 + vt) * 4 + i) * 64 + F.lane];
            float Gsum[16];
#pragma unroll
            for (int q = 0; q < 16; ++q) Gsum[q] = 0.f;
            hg_pass<true>(F, P, lbh, b, h, nb, dir, S, Gsum, Vl, Kl, OF, ng);
            asm volatile("s_waitcnt vmcnt(0)" ::: "memory");
        }
    }
}

__device__ __forceinline__ void ph_hg_ctx(const Frame& F, int j) {
    if (F.wave >= 4) return;
    const bf16_t* P = (const bf16_t*)(F.R1 + R1_P);
    float* SLOC = (float*)(F.R1 + R1_SLOC); float* DL = (float*)(F.R1 + R1_DL); float* OF = (float*)(F.R1 + R1_OF);
    const float* ng = inp(F, 12) + j * 64;
    LAS bf16_t* Vl = (LAS bf16_t*)(F.lds + 32768 + F.wave * 4096); LAS bf16_t* Kl = Vl + 1024;
    const int bh = F.wg * 4 + F.wave, b = bh >> 3, h = bh & 7;
    for (int dir = 0; dir < 2; ++dir) {
        const float* lbh = (const float*)(F.ws + OFF_LBT) + (j * 2 + dir) * 512 + h * 64;
        const int seq = bh * 2 + dir;
        f32x4 S[4][4];
#pragma unroll
        for (int kt = 0; kt < 4; ++kt)
#pragma unroll
            for (int vt = 0; vt < 4; ++vt) S[kt][vt] = (f32x4){0.f, 0.f, 0.f, 0.f};
        for (int u = 0; u < 2; ++u) {
            const int nb = dir ? 1 - u : u;
            float Gsum[16];
#pragma unroll
            for (int q = 0; q < 16; ++q) Gsum[q] = 0.f;
            hg_pass<true>(F, P, lbh, b, h, nb, dir, S, Gsum, Vl, Kl, OF, ng);
            float* so = SLOC + ((size_t)seq * HG_NU + u) * 4096;
#pragma unroll
            for (int kt = 0; kt < 4; ++kt)
#pragma unroll
                for (int vt = 0; vt < 4; ++vt)
#pragma unroll
                    for (int i = 0; i < 4; ++i) so[((kt * 4 + vt) * 4 + i) * 64 + F.lane] = S[kt][vt][i];
            if ((F.lane & 15) == 0) { float* dd = DL + ((size_t)seq * HG_NU + u) * 64;
#pragma unroll
                for (int q = 0; q < 16; ++q) dd[16 * (q >> 2) + 4 * (F.lane >> 4) + (q & 3)] = 0.0f; }
        }
        asm volatile("s_waitcnt vmcnt(0)" ::: "memory");
    }
}

__device__ __forceinline__ int lru_nat(int so, int dir) { return dir == 0 ? so : (so < 16 ? 15 - so : 16 + (LRU_NT - 1 - so)); }
__device__ __forceinline__ int lru_row(int b, int nt, int t) { return nt < 16 ? b * CTXL + nt * 16 + t : TC + b * SEQ + (nt - 16) * 16 + t; }
struct LruRaw { u32x4 a[4], b[4]; };
__device__ __forceinline__ void lru_load(const Frame& F, int b, int kb, int nt, LruRaw& R) {
    const bf16_t* P = (const bf16_t*)(F.R1 + R1_P);
    const int tk = F.lane & 15, g = F.lane >> 4;
    const int len = nt < 16 ? CTXL : SEQ, tpos = (nt < 16 ? nt * 16 : (nt - 16) * 16) + tk;
    const bf16_t* pbase = P + (size_t)((nt < 16 ? b * CTXL : TC + b * SEQ)) * 2048 + 1024 + kb * 64 + g * 16;
#pragma unroll
    for (int tap = 0; tap < 4; ++tap) { const int tp = tpos + tap - 2; const bool ok = (tp >= 0 && tp < len); const bf16_t* pr = pbase + (size_t)(ok ? tp : tpos) * 2048;
        R.a[tap] = *(const u32x4*)pr; R.b[tap] = *(const u32x4*)(pr + 8); if (!ok) { R.a[tap] = (u32x4){0u, 0u, 0u, 0u}; R.b[tap] = (u32x4){0u, 0u, 0u, 0u}; } }
}
__device__ __forceinline__ void lru_conv(const Frame& F, const LruRaw& R, const LAS float* CT, LAS float* ucb) {
    const int tk = F.lane & 15, g = F.lane >> 4;
    float acc[16];
#pragma unroll
    for (int q = 0; q < 4; ++q) { const f32x4 c4 = *(const LAS f32x4*)(CT + 4 * 64 + g * 16 + q * 4); acc[q * 4] = c4[0]; acc[q * 4 + 1] = c4[1]; acc[q * 4 + 2] = c4[2]; acc[q * 4 + 3] = c4[3]; }
#pragma unroll
    for (int tap = 0; tap < 4; ++tap) { float t0[8], t1[8]; unpack8(R.a[tap], t0); unpack8(R.b[tap], t1);
#pragma unroll
        for (int q = 0; q < 2; ++q) { const f32x4 w0 = *(const LAS f32x4*)(CT + tap * 64 + g * 16 + q * 4), w1 = *(const LAS f32x4*)(CT + tap * 64 + g * 16 + 8 + q * 4);
#pragma unroll
            for (int i = 0; i < 4; ++i) { acc[q * 4 + i] = fmaf(w0[i], t0[q * 4 + i], acc[q * 4 + i]); acc[8 + q * 4 + i] = fmaf(w1[i], t1[q * 4 + i], acc[8 + q * 4 + i]); } } }
#pragma unroll
    for (int q = 0; q < 4; ++q) *(LAS f32x4*)(ucb + tk * 68 + g * 16 + q * 4) = (f32x4){acc[q * 4], acc[q * 4 + 1], acc[q * 4 + 2], acc[q * 4 + 3]};
}
__device__ __forceinline__ void lru_gates(const Frame& F, LAS bf16_t* Wl, const LAS float* CT, LAS float* ucb, float (&av)[2][4][4], float (&xv)[2][4][4]) {
    const int tk = F.lane & 15, g = F.lane >> 4;
    bf16x8 bfr[2];
#pragma unroll
    for (int ks = 0; ks < 2; ++ks) { const f32x4 u0 = *(const LAS f32x4*)(ucb + tk * 68 + ks * 32 + g * 8), u1 = *(const LAS f32x4*)(ucb + tk * 68 + ks * 32 + g * 8 + 4);
        u32x4 w; w.x = cvt_pk_bf16(u0[0], u0[1]); w.y = cvt_pk_bf16(u0[2], u0[3]); w.z = cvt_pk_bf16(u1[0], u1[1]); w.w = cvt_pk_bf16(u1[2], u1[3]); __builtin_memcpy(&bfr[ks], &w, 16); }
#pragma unroll
    for (int d = 0; d < 2; ++d)
#pragma unroll
        for (int et = 0; et < 4; ++et) {
            f32x4 ra = (f32x4){0.f, 0.f, 0.f, 0.f}, ri = (f32x4){0.f, 0.f, 0.f, 0.f};
#pragma unroll
            for (int ks = 0; ks < 2; ++ks) {
                const bf16x8 wa = *(const LAS bf16x8*)(Wl + ((d * 2 + 0) * 64 + et * 16 + tk) * 72 + ks * 32 + g * 8);
                const bf16x8 wx = *(const LAS bf16x8*)(Wl + ((d * 2 + 1) * 64 + et * 16 + tk) * 72 + ks * 32 + g * 8);
                ra = __builtin_amdgcn_mfma_f32_16x16x32_bf16(wa, bfr[ks], ra, 0, 0, 0);
                ri = __builtin_amdgcn_mfma_f32_16x16x32_bf16(wx, bfr[ks], ri, 0, 0, 0);
            }
            const f32x4 ba4 = *(const LAS f32x4*)(CT + (5 + 3 * d) * 64 + et * 16 + 4 * g), bx4 = *(const LAS f32x4*)(CT + (6 + 3 * d) * 64 + et * 16 + 4 * g), cs4 = *(const LAS f32x4*)(CT + (7 + 3 * d) * 64 + et * 16 + 4 * g);
            const f32x4 u4 = *(const LAS f32x4*)(ucb + tk * 68 + et * 16 + 4 * g);
#pragma unroll
            for (int i = 0; i < 4; ++i) {
                const float r = sigmoidf_(ra[i] + ba4[i]), ig = sigmoidf_(ri[i] + bx4[i]);
                const float la = cs4[i] * r, a = __expf(la);
                av[d][et][i] = la; xv[d][et][i] = __builtin_amdgcn_sqrtf(fmaxf(1.0f - a * a, 0.f)) * ig * u4[i]; }
        }
}
template <int S> __device__ __forceinline__ void lru_step_f(float& a, float& x) { const float ap = dppf<0x110 + S>(1.0f, a), xp = dppf<0x110 + S>(0.0f, x); x = fmaf(a, xp, x); a = a * ap; }
template <int S> __device__ __forceinline__ void lru_step_b(float& a, float& x) { const float ap = dppf<0x100 + S>(1.0f, a), xp = dppf<0x100 + S>(0.0f, x); x = fmaf(a, xp, x); a = a * ap; }
#define LRU_DPP_STEP(SH, x_, a_) asm volatile("s_nop 1\n\t" \
    "v_fmac_f32_dpp %0, %0, %4 " SH " row_mask:0xf bank_mask:0xf\n\tv_fmac_f32_dpp %1, %1, %5 " SH " row_mask:0xf bank_mask:0xf\n\t" \
    "v_fmac_f32_dpp %2, %2, %6 " SH " row_mask:0xf bank_mask:0xf\n\tv_fmac_f32_dpp %3, %3, %7 " SH " row_mask:0xf bank_mask:0xf\n\t" \
    "v_mul_f32_dpp %4, %4, %4 " SH " row_mask:0xf bank_mask:0xf\n\tv_mul_f32_dpp %5, %5, %5 " SH " row_mask:0xf bank_mask:0xf\n\t" \
    "v_mul_f32_dpp %6, %6, %6 " SH " row_mask:0xf bank_mask:0xf\n\tv_mul_f32_dpp %7, %7, %7 " SH " row_mask:0xf bank_mask:0xf" \
    : "+v"(x_[0]), "+v"(x_[1]), "+v"(x_[2]), "+v"(x_[3]), "+v"(a_[0]), "+v"(a_[1]), "+v"(a_[2]), "+v"(a_[3]))
#define LRU_SCANS(av, xv) do { _Pragma("unroll") for (int et = 0; et < 4; ++et) { \
        LRU_DPP_STEP("row_shr:1", xv[0][et], av[0][et]); LRU_DPP_STEP("row_shl:1", xv[1][et], av[1][et]); } \
    _Pragma("unroll") for (int et = 0; et < 4; ++et) { LRU_DPP_STEP("row_shr:2", xv[0][et], av[0][et]); LRU_DPP_STEP("row_shl:2", xv[1][et], av[1][et]); } \
    _Pragma("unroll") for (int et = 0; et < 4; ++et) { LRU_DPP_STEP("row_shr:4", xv[0][et], av[0][et]); LRU_DPP_STEP("row_shl:4", xv[1][et], av[1][et]); } \
    _Pragma("unroll") for (int et = 0; et < 4; ++et) { LRU_DPP_STEP("row_shr:8", xv[0][et], av[0][et]); LRU_DPP_STEP("row_shl:8", xv[1][et], av[1][et]); } } while (0)
__device__ __forceinline__ void ph_lru_a(const Frame& F, int jj) {
    LAS bf16_t* Wl = (LAS bf16_t*)F.lds;
    LAS float* ucb = (LAS float*)(F.lds + 36864 + F.wave * 4352);
    LAS float* CT = (LAS float*)(F.lds + 36864 + 8 * 4352);
    const bf16_t* wsrc = (const bf16_t*)(F.WB + WB_LRU);
    float* AG = (float*)(F.R1 + R1_AG); bf16_t* GX = (bf16_t*)(F.R1 + R1_GX);
    const float* cw = inp(F, 14) + (size_t)jj * 4 * 1024; const float* cb = inp(F, 15) + (size_t)jj * 1024;
    const float* b_a = inp(F, 17) + (size_t)jj * 2 * 1024; const float* b_x = inp(F, 19) + (size_t)jj * 2 * 1024; const float* lam = inp(F, 20) + (size_t)jj * 2 * 1024;
    const int tk = F.lane & 15, g = F.lane >> 4;
    const int NTASK = NBAT * 16 * 11;
    for (int task = F.wg; task < NTASK; task += F.G) {
        const int grp = task % 11, kb = (task / 11) & 15, b = task / (11 * 16);
        __syncthreads();
        for (int i = F.tid; i < 4 * 4096 / 8; i += 512) { const int mg = i >> 9, r = i & 511;
            *(LAS u32x4*)(Wl + (mg * 64 + (r >> 3)) * 72 + (r & 7) * 8) = *(const u32x4*)(wsrc + ((size_t)mg * 16 + kb) * 4096 + r * 8); }
        for (int i = F.tid; i < 11 * 64; i += 512) { const int kind = i >> 6, ch = kb * 64 + (i & 63); float v;
            if (kind < 4) v = cw[kind * 1024 + ch]; else if (kind == 4) v = cb[ch];
            else { const int d = (kind - 5) / 3, w = (kind - 5) % 3; v = (w == 0) ? b_a[d * 1024 + ch] : (w == 1) ? b_x[d * 1024 + ch] : -8.0f * log1pf(__expf(-lam[d * 1024 + ch])); }
            CT[i] = v; }
        __syncthreads();
        const int nt0 = grp * 48;
        LruRaw raw; lru_load(F, b, kb, nt0 + F.wave, raw);
        for (int ti = F.wave; ti < 48; ti += 8) {
            const int nt = nt0 + ti;
            float av[2][4][4], xv[2][4][4];
            lru_conv(F, raw, CT, ucb);
            if (ti + 8 < 48) lru_load(F, b, kb, nt + 8, raw);
            lru_gates(F, Wl, CT, ucb, av, xv);
            const int row = lru_row(b, nt, tk);
#pragma unroll
            for (int d = 0; d < 2; ++d)
#pragma unroll
                for (int et = 0; et < 4; ++et) { u32x4 w; w.x = cvt_pk_bf16(av[d][et][0], xv[d][et][0]); w.y = cvt_pk_bf16(av[d][et][1], xv[d][et][1]); w.z = cvt_pk_bf16(av[d][et][2], xv[d][et][2]); w.w = cvt_pk_bf16(av[d][et][3], xv[d][et][3]);
                    __builtin_nontemporal_store(w, (u32x4*)(GX + (((size_t)row * 2 + d) * 1024 + kb * 64 + et * 16 + 4 * g) * 2));
                    const unsigned ww[4] = {w.x, w.y, w.z, w.w};
#pragma unroll
                    for (int i = 0; i < 4; ++i) { av[d][et][i] = __expf(__uint_as_float(ww[i] << 16)); xv[d][et][i] = __uint_as_float(ww[i] & 0xffff0000u); } }
            LRU_SCANS(av, xv);
#pragma unroll
            for (int d = 0; d < 2; ++d) if (tk == (d ? 0 : 15)) {
                float* ag = AG + (((size_t)(b * 2 + d) * LRU_NT + nt) * 2) * 1024 + kb * 64;
#pragma unroll
                for (int et = 0; et < 4; ++et) { *(f32x4*)(ag + et * 16 + 4 * g) = (f32x4){av[d][et][0], av[d][et][1], av[d][et][2], av[d][et][3]};
                    *(f32x4*)(ag + 1024 + et * 16 + 4 * g) = (f32x4){xv[d][et][0], xv[d][et][1], xv[d][et][2], xv[d][et][3]}; }
            }
        }
    }
    __syncthreads();
}
__device__ __forceinline__ void ph_lru_c(const Frame& F) {
    const float* HST = (const float*)(F.R1 + R1_HST); const bf16_t* GX = (const bf16_t*)(F.R1 + R1_GX);
    const bf16_t* P = (const bf16_t*)(F.R1 + R1_P);
    const int tk = F.lane & 15, g = F.lane >> 4;
    const int gw = F.wg * 8 + F.wave, nw = F.G * 8;
    for (int task = gw; task < NBAT * LRU_NT * 16; task += nw) {
        const int kb = task & 15, nt = (task >> 4) % LRU_NT, b = (task >> 4) / LRU_NT;
        const int row = lru_row(b, nt, tk);
        u32x4 gx[2][4]; f32x4 hf[4], hb[4]; u32x2 yw[4];
#pragma unroll
        for (int d = 0; d < 2; ++d)
#pragma unroll
            for (int et = 0; et < 4; ++et) gx[d][et] = *(const u32x4*)(GX + (((size_t)row * 2 + d) * 1024 + kb * 64 + et * 16 + 4 * g) * 2);
#pragma unroll
        for (int et = 0; et < 4; ++et) { const int ch = kb * 64 + et * 16 + 4 * g;
            hf[et] = *(const f32x4*)(HST + ((size_t)(b * 2 + 0) * LRU_NT + nt) * 1024 + ch);
            hb[et] = *(const f32x4*)(HST + ((size_t)(b * 2 + 1) * LRU_NT + nt) * 1024 + ch);
            yw[et] = *(const u32x2*)(P + (size_t)row * 2048 + ch); }
        float av[2][4][4], xv[2][4][4];
#pragma unroll
        for (int d = 0; d < 2; ++d)
#pragma unroll
            for (int et = 0; et < 4; ++et) { const unsigned ww[4] = {gx[d][et].x, gx[d][et].y, gx[d][et].z, gx[d][et].w};
#pragma unroll
                for (int i = 0; i < 4; ++i) { av[d][et][i] = __expf(__uint_as_float(ww[i] << 16)); xv[d][et][i] = __uint_as_float(ww[i] & 0xffff0000u); } }
        LRU_SCANS(av, xv);
#pragma unroll
        for (int et = 0; et < 4; ++et) {
            const int ch = kb * 64 + et * 16 + 4 * g;
            const float y0 = __uint_as_float(yw[et].x << 16), y1 = __uint_as_float(yw[et].x & 0xffff0000u), y2 = __uint_as_float(yw[et].y << 16), y3 = __uint_as_float(yw[et].y & 0xffff0000u);
            float o[4];
#pragma unroll
            for (int i = 0; i < 4; ++i) o[i] = fmaf(av[0][et][i], hf[et][i], xv[0][et][i]) + fmaf(av[1][et][i], hb[et][i], xv[1][et][i]);
            o[0] *= gelu_tanh_(y0); o[1] *= gelu_tanh_(y1); o[2] *= gelu_tanh_(y2); o[3] *= gelu_tanh_(y3);
            u32x2 w; w.x = cvt_pk_bf16(o[0], o[1]); w.y = cvt_pk_bf16(o[2], o[3]);
            *(u32x2*)(F.MIX + (size_t)row * DM + ch) = w;
        }
    }
}
__device__ __forceinline__ void ph_lru_b(const Frame& F) {
    const float* AG = (const float*)(F.R1 + R1_AG); float* HST = (float*)(F.R1 + R1_HST);
    LAS float* sa = (LAS float*)F.lds; LAS float* sx = sa + 512;
    for (int task = F.wg; task < NBAT * 2 * 32; task += F.G) {
        const int cgp = task & 31, d = (task >> 5) & 1, b = task >> 6;
        const int ch = cgp * 32 + (F.tid & 31), seg = F.tid >> 5;
        const float* ag = AG + ((size_t)(b * 2 + d) * LRU_NT) * 2048 + ch;
        float A = 1.0f, Xv = 0.f;
        for (int i = 0; i < 33; ++i) { const int nt = lru_nat(seg * 33 + i, d); const float a = ag[(size_t)nt * 2048], x = ag[(size_t)nt * 2048 + 1024]; Xv = fmaf(a, Xv, x); A *= a; }
        __syncthreads();
        sa[F.tid] = A; sx[F.tid] = Xv;
        __syncthreads();
        float h = 0.f;
        for (int s2 = 0; s2 < seg; ++s2) h = fmaf(sa[s2 * 32 + (F.tid & 31)], h, sx[s2 * 32 + (F.tid & 31)]);
        float* hs = HST + ((size_t)(b * 2 + d) * LRU_NT) * 1024 + ch;
        for (int i = 0; i < 33; ++i) { const int nt = lru_nat(seg * 33 + i, d); hs[(size_t)nt * 1024] = h; const float a = ag[(size_t)nt * 2048], x = ag[(size_t)nt * 2048 + 1024]; h = fmaf(a, h, x); }
    }
    __syncthreads();
}

__device__ __forceinline__ void topk_better(float& bk, int& be, float& bs, float ok, int oe, float os) { const bool t = (ok > bk) || (ok == bk && oe < be); bk = t ? ok : bk; be = t ? oe : be; bs = t ? os : bs; }
template <int CTRL> __device__ __forceinline__ void topk_step(float& bk, int& be, float& bs) {
    const float ok = dppf<CTRL>(bk, bk), os = dppf<CTRL>(bs, bs); const int oe = __builtin_amdgcn_update_dpp(be, be, CTRL, 0xf, 0xf, false); topk_better(bk, be, bs, ok, oe, os); }
__device__ __forceinline__ void ph_ln_router(const Frame& F, int l, bool dry = false) {
    const bf16_t* RW = (const bf16_t*)(F.WB + WB_RT);
    const float* rbias = inp(F, 23) + l * 64;
    LAS float* part = (LAS float*)F.lds;
    LAS float* LP = (LAS float*)(F.lds + 4096);
    LAS int* hist = (LAS int*)(F.lds + LDS_MISC + MISC_HIST); LAS int* hbase = (LAS int*)(F.lds + LDS_MISC + MISC_HBASE);
    int* tok_e = (int*)(F.ws + OFF_TOKE); int* tok_p = (int*)(F.ws + OFF_TOKP); float* tok_w = (float*)(F.ws + OFF_TOKW);
    int* stok = (int*)(F.ws + OFF_STOK); float* sw = (float*)(F.ws + OFF_SW);
    float* stats = (float*)(F.ws + OFF_STATS);
    unsigned* gcnt = (unsigned*)(F.ws + OFF_CTL + CTL_CNT) + l * 64;
    const int tk = F.lane & 15, g = F.lane >> 4;
    float rb[4];
#pragma unroll
    for (int q = 0; q < 4; ++q) rb[q] = rbias[tk + 16 * q];
    if (F.tid < 64) hist[F.tid] = 0;
    __syncthreads();
    const int NTILE = TT / 16, TILE0 = (l == 3) ? TC / 16 : 0;
    bf16x8 rwf[4][4];
#pragma unroll
    for (int et = 0; et < 4; ++et)
#pragma unroll
        for (int ks = 0; ks < 4; ++ks) rwf[et][ks] = *(const bf16x8*)(RW + (size_t)(et * 16 + tk) * 1024 + F.wave * 128 + ks * 32 + g * 8);
    f32x4 vn[4][2];
    if (TILE0 + F.wg < NTILE) { const float* xr = F.X + (size_t)((TILE0 + F.wg) * 16 + tk) * DM + F.wave * 128 + g * 8;
#pragma unroll
        for (int ks = 0; ks < 4; ++ks) { vn[ks][0] = *(const f32x4*)(xr + ks * 32); vn[ks][1] = *(const f32x4*)(xr + ks * 32 + 4); } }
    for (int tile = TILE0 + F.wg; tile < NTILE; tile += F.G) {
        const int row = tile * 16 + tk; const int s = slot_of_row(tile * 16);
        const float* ab = (const float*)(F.ws + OFF_AB) + (size_t)(l * 5 + s) * 2048;
        f32x4 v[4][2];
#pragma unroll
        for (int ks = 0; ks < 4; ++ks) { v[ks][0] = vn[ks][0]; v[ks][1] = vn[ks][1]; }
        if (tile + F.G < NTILE) { const float* xr = F.X + (size_t)((tile + F.G) * 16 + tk) * DM + F.wave * 128 + g * 8;
#pragma unroll
            for (int ks = 0; ks < 4; ++ks) { vn[ks][0] = *(const f32x4*)(xr + ks * 32); vn[ks][1] = *(const f32x4*)(xr + ks * 32 + 4); } }
        float sum = 0.f, sq = 0.f;
#pragma unroll
        for (int ks = 0; ks < 4; ++ks)
#pragma unroll
            for (int hh = 0; hh < 2; ++hh) { const f32x4 a = v[ks][hh]; sum += (a[0] + a[1]) + (a[2] + a[3]); sq += (a[0] * a[0] + a[1] * a[1]) + (a[2] * a[2] + a[3] * a[3]); }
        sum += __shfl_xor(sum, 16); sum += __shfl_xor(sum, 32); sq += __shfl_xor(sq, 16); sq += __shfl_xor(sq, 32);
        if (g == 0) *(LAS f32x2*)(part + (F.wave * 16 + tk) * 2) = (f32x2){sum, sq};
        __syncthreads();
        float ts = 0.f, tq = 0.f;
#pragma unroll
        for (int w = 0; w < 8; ++w) { const f32x2 p = *(const LAS f32x2*)(part + (w * 16 + tk) * 2); ts += p.x; tq += p.y; }
        const float mean = ts * (1.0f / 1024.0f), var = fmaxf(tq * (1.0f / 1024.0f) - mean * mean, 0.f), rstd = rsqrtf(var + 1e-5f);
        if (F.wave == 0 && g == 0) *(f32x2*)(stats + (size_t)row * 2) = (f32x2){mean, rstd};
        f32x4 acc[4];
#pragma unroll
        for (int et = 0; et < 4; ++et) acc[et] = (f32x4){0.f, 0.f, 0.f, 0.f};
#pragma unroll
        for (int ks = 0; ks < 4; ++ks) { const int k = F.wave * 128 + ks * 32 + g * 8;
            const f32x4 a10 = *(const f32x4*)(ab + k), a11 = *(const f32x4*)(ab + k + 4), b10 = *(const f32x4*)(ab + 1024 + k), b11 = *(const f32x4*)(ab + 1024 + k + 4);
            const f32x4 h0 = (v[ks][0] - mean) * rstd * a10 + b10, h1 = (v[ks][1] - mean) * rstd * a11 + b11;
            u32x4 w; w.x = cvt_pk_bf16(h0[0], h0[1]); w.y = cvt_pk_bf16(h0[2], h0[3]); w.z = cvt_pk_bf16(h1[0], h1[1]); w.w = cvt_pk_bf16(h1[2], h1[3]);
            *(u32x4*)(F.HB + (size_t)row * DM + k) = w;
            bf16x8 af; __builtin_memcpy(&af, &w, 16);
#pragma unroll
            for (int et = 0; et < 4; ++et) acc[et] = __builtin_amdgcn_mfma_f32_16x16x32_bf16(af, rwf[et][ks], acc[et], 0, 0, 0);
        }
#pragma unroll
        for (int et = 0; et < 4; ++et)
#pragma unroll
            for (int i = 0; i < 4; ++i) LP[(F.wave * 16 + 4 * g + i) * 64 + et * 16 + tk] = acc[et][i];
        __syncthreads();
        {
            const int t = 2 * F.wave + (g & 1), r2 = tile * 16 + t;
            float sc[4], key[4];
#pragma unroll
            for (int q = 0; q < 4; ++q) { float lgt = 0.f;
#pragma unroll
                for (int w = 0; w < 8; ++w) lgt += LP[(w * 16 + t) * 64 + tk + 16 * q];
                sc[q] = sigmoidf_(lgt); key[q] = sc[q] + rb[q]; }
            unsigned taken = 0u; int se[6]; float ss[6]; float tot = 0.f;
#pragma unroll
            for (int sel = 0; sel < 6; ++sel) {
                float bk = -1e30f, bs = 0.f; int be = 0;
#pragma unroll
                for (int q = 0; q < 4; ++q) if (!((taken >> q) & 1u) && key[q] > bk) { bk = key[q]; be = tk + 16 * q; bs = sc[q]; }
                topk_step<0xB1>(bk, be, bs); topk_step<0x4E>(bk, be, bs); topk_step<0x141>(bk, be, bs); topk_step<0x140>(bk, be, bs);
                if ((be & 15) == tk) taken |= 1u << (be >> 4);
                se[sel] = be; ss[sel] = bs; tot += bs;
            }
            const float sc2 = 2.5f / tot;
            if (tk < 6 && g < 2) {
                int e = se[0]; float w = ss[0];
#pragma unroll
                for (int q = 1; q < 6; ++q) if (tk == q) { e = se[q]; w = ss[q]; }
                tok_e[r2 * 8 + tk] = e; tok_w[r2 * 8 + tk] = w * sc2; if (!dry) tok_p[r2 * 8 + tk] = __hip_atomic_fetch_add(hist + e, 1, __ATOMIC_RELAXED, __HIP_MEMORY_SCOPE_WORKGROUP);
            }
        }
    }
    asm volatile("s_waitcnt vmcnt(0) lgkmcnt(0)" ::: "memory");
    __syncthreads();
    if (dry) return;
    if (F.tid < 64) hbase[F.tid] = (int)__hip_atomic_fetch_add(gcnt + F.tid, (unsigned)hist[F.tid], __ATOMIC_RELAXED, __HIP_MEMORY_SCOPE_AGENT);
    __syncthreads();
    for (int tile = TILE0 + F.wg; tile < NTILE; tile += F.G) {
        if (F.tid < 96) { const int row = tile * 16 + F.tid / 6, q = F.tid % 6; const int e = tok_e[row * 8 + q]; const int pos = hbase[e] + tok_p[row * 8 + q];
            tok_p[row * 8 + q] = pos; stok[(size_t)e * CAP + pos] = row; sw[(size_t)e * CAP + pos] = tok_w[row * 8 + q]; }
    }
    __syncthreads();
}

__device__ __forceinline__ int moe_tables(const Frame& F, int l) {
    const int t0 = (l == 3) ? TC : 0;
    LAS int* cnt = (LAS int*)(F.lds + LDS_MISC + MISC_CNT); LAS int* tst = (LAS int*)(F.lds + LDS_MISC + MISC_TST); LAS unsigned char* t2e = (LAS unsigned char*)(F.lds + LDS_MISC + MISC_T2E);
    const unsigned* gcnt = (const unsigned*)(F.ws + OFF_CTL + CTL_CNT) + l * 64;
    __syncthreads();
    if (F.tid < 64) cnt[F.tid] = (int)__hip_atomic_load(gcnt + F.tid, __ATOMIC_RELAXED, __HIP_MEMORY_SCOPE_AGENT);
    if (F.tid == 64) cnt[64] = TT - t0;
    __syncthreads();
    if (F.tid == 0) { int s = 0; for (int e = 0; e < 65; ++e) { tst[e] = s; s += (cnt[e] + 255) >> 8; } tst[65] = s; }
    __syncthreads();
    const int ntiles = tst[65];
    for (int t = F.tid; t < ntiles; t += 512) { int e = 0; for (int q = 0; q < 65; ++q) if (t >= tst[q]) e = q; else break; t2e[t] = (unsigned char)e; }
    __syncthreads();
    return ntiles;
}

template <int CTRL> __device__ __forceinline__ float dpp_f(float x) { return __builtin_bit_cast(float, __builtin_amdgcn_update_dpp(0, __builtin_bit_cast(int, x), CTRL, 0xF, 0xF, true)); }
#define WAVE_SUM64(x) do { x += dpp_f<0xB1>(x); x += dpp_f<0x4E>(x); x += dpp_f<0x141>(x); x += dpp_f<0x140>(x); \
    x = __builtin_bit_cast(float, __builtin_amdgcn_readlane(__builtin_bit_cast(int, x), 0)) + __builtin_bit_cast(float, __builtin_amdgcn_readlane(__builtin_bit_cast(int, x), 16)) \
      + __builtin_bit_cast(float, __builtin_amdgcn_readlane(__builtin_bit_cast(int, x), 32)) + __builtin_bit_cast(float, __builtin_amdgcn_readlane(__builtin_bit_cast(int, x), 48)); } while (0)
template <bool lastl> __device__ __forceinline__ void ph_combine_t(const Frame& F, int l, bool dry) {
    LAS int* tst = (LAS int*)(F.lds + LDS_MISC + MISC_TST);
    (void)moe_tables(F, l);
    const int t0 = lastl ? TC : 0;
    LAS float* CT = (LAS float*)F.lds;
    {
        const float* gam = inp(F, 6) + (size_t)(l * 2 + 1) * DM; const float* bet = inp(F, 7) + (size_t)(l * 2 + 1) * DM;
        const float* gam0 = inp(F, 6) + (size_t)(l * 2 + 0) * DM; const float* bet0 = inp(F, 7) + (size_t)(l * 2 + 0) * DM;
        for (int k = F.tid; k < 1024; k += 512) {
            CT[k] = ALPHA * gam0[k]; CT[1024 + k] = ALPHA * bet0[k]; CT[2048 + k] = gam[k]; CT[3072 + k] = bet[k];
#pragma unroll
            for (int s = 0; s < 5; ++s) {
                const float* m = F.mods + (size_t)(l * 5 + s) * 6144; const float* mn = F.mods + (size_t)((lastl ? l : l + 1) * 5 + s) * 6144;
                CT[(4 + s * 3) * 1024 + k] = m[5 * 1024 + k]; CT[(5 + s * 3) * 1024 + k] = 1.0f + mn[1024 + k]; CT[(6 + s * 3) * 1024 + k] = mn[k];
            }
        }
        __syncthreads();
    }
    const float* stats = (const float*)(F.ws + OFF_STATS);
    const unsigned char* Y = (const unsigned char*)(F.R1 + R1_Y);
    const int* tok_e = (const int*)(F.ws + OFF_TOKE); const int* tok_p = (const int*)(F.ws + OFF_TOKP); const float* tok_w = (const float*)(F.ws + OFF_TOKW);
    const int gw = F.wg * 8 + F.wave, nw = F.G * 8;
    const int l4 = F.lane * 4, q8 = F.lane & 7;
    const int sh0 = __builtin_amdgcn_readfirstlane(tst[64]) * 256 - t0;
#define CMB_IDX(E_, P_, W_, row_) do { E_ = tok_e[(row_) * 8 + q8]; P_ = tok_p[(row_) * 8 + q8]; W_ = tok_w[(row_) * 8 + q8]; } while (0)
#define CMB_ISSUE(Yb, Xb, Sb, Wb, E_, P_, W_, row_) do { \
        const int sl_ = tst[(E_) & 63] * 256 + (P_); \
        _Pragma("unroll") for (int q = 0; q < 6; ++q) Wb[q] = __builtin_bit_cast(float, __builtin_amdgcn_readlane(__builtin_bit_cast(int, W_), q)) * (1.0f / 16.0f); \
        _Pragma("unroll") for (int q = 0; q < 7; ++q) { const int sr_ = (q < 6) ? __builtin_amdgcn_readlane(sl_, q) : (sh0 + (row_)); \
            const unsigned char* yp_ = Y + (size_t)sr_ * DM + l4; \
            _Pragma("unroll") for (int c = 0; c < 4; ++c) Yb[q * 4 + c] = *(const unsigned*)(yp_ + c * 256); } \
        _Pragma("unroll") for (int c = 0; c < 4; ++c) Xb[c] = *(const f32x4*)(F.X + (size_t)(row_) * DM + c * 256 + l4); \
        Sb = *(const f32x2*)(stats + (size_t)(row_) * 2); } while (0)
#define CMB_COMPUTE(Yb, Xb, Sb, Wb, row_) do { \
        LAS const float* cs_ = CT + (4 + slot_of_row(row_) * 3) * 1024 + l4; \
        float v[16]; \
        _Pragma("unroll") for (int c = 0; c < 4; ++c) { \
            const f32x4 ag = *(LAS const f32x4*)(CT + c * 256 + l4), ab = *(LAS const f32x4*)(CT + 1024 + c * 256 + l4), m5 = *(LAS const f32x4*)(cs_ + c * 256); \
            f32x2 ya = (f32x2){0.f, 0.f}, yb = ya; \
            _Pragma("unroll") for (int q = 0; q < 7; ++q) { const float wq_ = (q < 6) ? Wb[q] : (1.0f / 16.0f); ya += __builtin_amdgcn_cvt_pk_f32_fp8((int)Yb[q * 4 + c], false) * wq_; yb += __builtin_amdgcn_cvt_pk_f32_fp8((int)Yb[q * 4 + c], true) * wq_; } \
            const f32x4 xh = (Xb[c] - Sb.x) * Sb.y; \
            v[c * 4 + 0] = xh[0] * ag[0] + ab[0] + m5[0] * ya.x; v[c * 4 + 1] = xh[1] * ag[1] + ab[1] + m5[1] * ya.y; \
            v[c * 4 + 2] = xh[2] * ag[2] + ab[2] + m5[2] * yb.x; v[c * 4 + 3] = xh[3] * ag[3] + ab[3] + m5[3] * yb.y; } \
        float sum = 0.f; \
        _Pragma("unroll") for (int i = 0; i < 16; ++i) sum += v[i]; \
        WAVE_SUM64(sum); \
        const float mean = sum * (1.0f / 1024.0f); \
        float sq = 0.f; \
        _Pragma("unroll") for (int i = 0; i < 16; ++i) { const float d = v[i] - mean; sq += d * d; } \
        WAVE_SUM64(sq); \
        const float rstd = rsqrtf(sq * (1.0f / 1024.0f) + 1e-5f); \
        _Pragma("unroll") for (int c = 0; c < 4; ++c) { \
            const f32x4 g = *(LAS const f32x4*)(CT + 2048 + c * 256 + l4), b = *(LAS const f32x4*)(CT + 3072 + c * 256 + l4); \
            f32x4 xn; \
            _Pragma("unroll") for (int i = 0; i < 4; ++i) xn[i] = (v[c * 4 + i] - mean) * rstd * g[i] + b[i]; \
            if (dry) { const float acc_ = xn[0] + xn[1] + xn[2] + xn[3]; asm volatile("" :: "v"(acc_)); } \
            else if (lastl) { *(f32x4*)(F.out + (size_t)((row_) - TC) * DM + c * 256 + l4) = xn; } \
            else { \
                *(f32x4*)(F.X + (size_t)(row_) * DM + c * 256 + l4) = xn; \
                const f32x4 s1 = *(LAS const f32x4*)(cs_ + 1024 + c * 256), b0 = *(LAS const f32x4*)(cs_ + 2048 + c * 256); \
                const f32x4 hv = xn * s1 + b0; \
                u32x2 w; w.x = cvt_pk_bf16(hv[0], hv[1]); w.y = cvt_pk_bf16(hv[2], hv[3]); \
                *(u32x2*)(F.HB + (size_t)(row_) * DM + c * 256 + l4) = w; } } } while (0)
    unsigned yA[28], yB[28]; f32x4 xA[4], xB[4]; f32x2 sA, sB; float wA[6], wB[6]; int eN = 0, pN = 0, eNN = 0, pNN = 0; float wN = 0.f, wNN = 0.f;
    const int row0 = t0 + gw;
    CMB_IDX(eNN, pNN, wNN, row0);
    if (row0 + nw < TT) CMB_IDX(eN, pN, wN, row0 + nw);
    CMB_ISSUE(yA, xA, sA, wA, eNN, pNN, wNN, row0);
    int row = row0;
    for (; row + 3 * nw < TT; row += 2 * nw) {
        const int r1 = row + nw, r2 = row + 2 * nw, r3 = row + 3 * nw;
        CMB_IDX(eNN, pNN, wNN, r2);
        CMB_ISSUE(yB, xB, sB, wB, eN, pN, wN, r1);
        CMB_COMPUTE(yA, xA, sA, wA, row);
        CMB_IDX(eN, pN, wN, r3);
        CMB_ISSUE(yA, xA, sA, wA, eNN, pNN, wNN, r2);
        CMB_COMPUTE(yB, xB, sB, wB, r1);
    }
    for (; row < TT; row += 2 * nw) {
        const int r1 = row + nw, r2 = row + 2 * nw, r3 = row + 3 * nw;
        if (r2 < TT) CMB_IDX(eNN, pNN, wNN, r2);
        if (r1 < TT) CMB_ISSUE(yB, xB, sB, wB, eN, pN, wN, r1);
        CMB_COMPUTE(yA, xA, sA, wA, row);
        if (r1 < TT) {
            if (r3 < TT) CMB_IDX(eN, pN, wN, r3);
            if (r2 < TT) CMB_ISSUE(yA, xA, sA, wA, eNN, pNN, wNN, r2);
            CMB_COMPUTE(yB, xB, sB, wB, r1);
        }
    }
#undef CMB_IDX
#undef CMB_ISSUE
#undef CMB_COMPUTE
}
__device__ __forceinline__ void ph_combine(const Frame& F, int l, bool dry = false) { if (l == 3) ph_combine_t<true>(F, l, dry); else ph_combine_t<false>(F, l, dry); }

constexpr int NPHASE = 2 + 4 * 10;
__global__ void __launch_bounds__(512, 2) mk_fwd(Args args) {
    extern __shared__ __attribute__((aligned(16))) unsigned char lds_raw[];
    Frame F;
    F.out = args.out; F.ws = args.ws; F.lds = (LAS unsigned char*)lds_raw;
    { const int t0 = threadIdx.x; F.wave = __builtin_amdgcn_readfirstlane(t0 >> 6); F.lane = t0 & 63; F.tid = t0; } F.G = gridDim.x; F.wg = blockIdx.x;
    F.mods = (float*)(args.ws + OFF_MODS); F.X = (float*)(args.ws + OFF_X); F.HB = (bf16_t*)(args.ws + OFF_HB); F.MIX = F.HB;
    F.WB = args.ws + OFF_WB; F.R1 = args.ws + OFF_R1;
    volatile LAS unsigned* xbw = (volatile LAS unsigned*)(F.lds + LDS_MISC);
    if (F.tid < 4) xbw[F.tid] = 0u;
    if (F.tid < 30) ((LAS unsigned long long*)(F.lds + LDS_MISC + MISC_INP))[F.tid] = (unsigned long long)args.in[F.tid];
    __syncthreads();
    const int lo = args.ph_lo, hi = args.ph_hi;
    XcdBarrier bar; bar.bar = (unsigned*)(args.ws + OFF_CTL); bar.x = 0; bar.st = xbw;
    if (hi - lo > 1) bar = xcd_barrier_post((unsigned*)(args.ws + OFF_CTL), xbw);
#define IN(k) (lo <= (k) && (k) < hi)
#define SEAM(k) do { if (IN(k) && IN((k) + 1)) { xcd_barrier(bar); if (REPM & 1) xcd_barrier(bar); } } while (0)
    if ((PHM & 1) && IN(0)) { ph_mods(fresh(F)); if (REPM & 65536) { __syncthreads(); ph_mods(fresh(F)); } } SEAM(0);
    if ((PHM & 2) && IN(1)) { ph_init_x(fresh(F)); if (REPM & 131072) ph_init_x(fresh(F)); }
    for (int l = 0; l < 4; ++l) {
        const int pb = 2 + l * 10, j = l >> 1; const bool even = (l & 1) == 0;
        float* mods_l = F.mods + (size_t)l * 5 * 6144;
        F.WB = args.ws + OFF_WB + (size_t)(l & 1) * WB_END;
        if ((PHM & 4) && IN(pb + 0) && !(l & 1)) { for (int rep = 0; rep < ((REPM & 4) ? 2 : 1); ++rep) { ph_convert(fresh(F), l); __syncthreads(); } }
        if (!(l & 1)) SEAM(pb + 0);
        if ((PHM & 8) && IN(pb + 1)) {
            const int N = even ? 4096 : 2048;
            pg8::StaticOrder S; S.init(F.HB, F.WB + WB_IN, TT, N, 1024, F.G, F.wg);
            pg8::EpiStoreBf16 E{(bf16_t*)(F.R1 + R1_P), N};
            for (int rep = 0; rep < ((REPM & 8) ? 2 : 1); ++rep) pg8::gemm_phase(F.lds, 1024, S, E, F.wave);
        } SEAM(pb + 1);
        if (IN(pb + 2)) { if (even) { if (F.wg < 8 && F.G > 16) { ph_hg_ctx(fresh(F), j); } else if (PHM & 16) for (int rep = 0; rep < ((REPM & 16) ? 2 : 1); ++rep) { Frame Fa = fresh(F); if (F.G > 16) { Fa.wg = F.wg - 8; Fa.G = F.G - 8; } ph_attn(Fa, j); } if (PHM & 32) for (int rep = 0; rep < ((REPM & 32) ? 2 : 1); ++rep) ph_hg_a(fresh(F), j); } else { if (PHM & 64) for (int rep = 0; rep < ((REPM & 64) ? 2 : 1); ++rep) ph_lru_a(fresh(F), j); } } SEAM(pb + 2);
        if (IN(pb + 3)) { if (even) { if (PHM & 128) for (int rep = 0; rep < ((REPM & 128) ? 2 : 1); ++rep) { ph_hg_b(fresh(F));
                { Frame Fc = fresh(F); Fc.WB = args.ws + OFF_WB + (size_t)((l + 1) & 1) * WB_END; ph_convert(Fc, l + 1); } } } else { if (PHM & 256) for (int rep = 0; rep < ((REPM & 256) ? 2 : 1); ++rep) ph_lru_b(fresh(F)); } } SEAM(pb + 3);
        if (IN(pb + 4)) { if (even) { if (PHM & 512) for (int rep = 0; rep < ((REPM & 512) ? 2 : 1); ++rep) ph_hg_c(fresh(F), j); } else { if (PHM & 1024) for (int rep = 0; rep < ((REPM & 1024) ? 2 : 1); ++rep) ph_lru_c(fresh(F)); } } SEAM(pb + 4);
        if ((PHM & 2048) && IN(pb + 5)) {
            const int t0 = (l == 3) ? TC : 0;
            pg8::StaticOrder S; S.init(F.MIX + (size_t)t0 * DM, F.WB + WB_OUT, TT - t0, 1024, 1024, F.G, F.wg);
            pg8::EpiResid E{F.X + (size_t)t0 * DM, mods_l, t0};
            pg8::gemm_phase(F.lds, 1024, S, E, F.wave);
        } SEAM(pb + 5);
        if ((PHM & 4096) && IN(pb + 6)) { if (REPM & 4096) ph_ln_router(fresh(F), l, true); ph_ln_router(fresh(F), l); } SEAM(pb + 6);
        if ((PHM & 8192) && IN(pb + 7)) {
            const int ntiles = moe_tables(fresh(F), l);
            pg8::MoeGU S; S.cnt = (const LAS int*)(F.lds + LDS_MISC + MISC_CNT); S.tst = (const LAS int*)(F.lds + LDS_MISC + MISC_TST); S.t2e = (const LAS unsigned char*)(F.lds + LDS_MISC + MISC_T2E);
            S.ntiles = ntiles; S.G = F.G; S.c = F.wg; S.A = (const char*)F.HB; S.Bt = (const char*)(F.WB + WB_GU); S.stok = (const int*)(F.ws + OFF_STOK); S.t0 = (l == 3) ? TC : 0;
            pg8::EpiSwiglu E{(bf16_t*)(F.R1 + R1_H)};
            for (int rep = 0; rep < ((REPM & 8192) ? 2 : 1); ++rep) pg8::gemm_phase(F.lds, 1024, S, E, F.wave);
        } SEAM(pb + 7);
        if ((PHM & 16384) && IN(pb + 8)) {
            const int ntiles = moe_tables(fresh(F), l);
            pg8::MoeDN S; S.cnt = (const LAS int*)(F.lds + LDS_MISC + MISC_CNT); S.tst = (const LAS int*)(F.lds + LDS_MISC + MISC_TST); S.t2e = (const LAS unsigned char*)(F.lds + LDS_MISC + MISC_T2E);
            S.ntiles = ntiles; S.G = F.G; S.c = F.wg; S.A = (const char*)(F.R1 + R1_H); S.Bt = (const char*)(F.WB + WB_DN);
            pg8::EpiDown E{(unsigned char*)(F.R1 + R1_Y)};
            if (REPM & 2) { pg8::EpiNull EN; pg8::gemm_phase(F.lds, 256, S, EN, F.wave); }
            if (REPM & (1 << 21)) { pg8::EpiDownProbe<1> EN{(unsigned char*)F.out, nullptr, nullptr}; pg8::gemm_phase(F.lds, 256, S, EN, F.wave); }
            if (REPM & (1 << 22)) { pg8::EpiDownProbe<2> EN{(unsigned char*)F.out, nullptr, nullptr}; pg8::gemm_phase(F.lds, 256, S, EN, F.wave); }
            if (REPM & (1 << 23)) { pg8::EpiDownProbe<3> EN{(unsigned char*)F.out, nullptr, nullptr}; pg8::gemm_phase(F.lds, 256, S, EN, F.wave); }
            for (int rep = 0; rep < ((REPM & 16384) ? 2 : 1); ++rep) pg8::gemm_phase(F.lds, 256, S, E, F.wave);
        } SEAM(pb + 8);
        if ((PHM & 32768) && IN(pb + 9)) { if (REPM & 32768) ph_combine(fresh(F), l, true); ph_combine(fresh(F), l); } SEAM(pb + 9);
    }
#undef IN
#undef SEAM
}

extern "C" void kernel_launch(void* const* d_in, const int* in_sizes, int n_in, void* d_out, int out_size, void* d_ws, size_t ws_size, hipStream_t stream) {
    static int grid = 0;
    if (grid == 0) {
        if (n_in != 30 || out_size != TX * DM || ws_size < WS_END) { fprintf(stderr, "kernel_launch: unexpected problem (n_in %d out %d ws %zu need %zu)\n", n_in, out_size, ws_size, (size_t)WS_END); grid = -1; return; }
        int dev = 0, cus = 0, per_cu = 0;
        if (hipGetDevice(&dev) != hipSuccess || hipDeviceGetAttribute(&cus, hipDeviceAttributeMultiprocessorCount, dev) != hipSuccess) { grid = -1; return; }
        if (hipFuncSetAttribute((const void*)mk_fwd, hipFuncAttributeMaxDynamicSharedMemorySize, LDS_BYTES) != hipSuccess) { fprintf(stderr, "kernel_launch: hipFuncSetAttribute failed\n"); grid = -1; return; }
        if (hipOccupancyMaxActiveBlocksPerMultiprocessor(&per_cu, (const void*)mk_fwd, 512, LDS_BYTES) != hipSuccess || per_cu < 1) { fprintf(stderr, "kernel_launch: occupancy query says %d\n", per_cu); }
        (void)hipGetLastError();
        grid = cus;
    }
    if (grid < 0) return;
    (void)hipMemsetAsync((char*)d_ws + OFF_CTL, 0, CTL_BYTES, stream);
    Args a{};
    for (int i = 0; i < 30; ++i) a.in[i] = (const float*)d_in[i];
    a.out = (float*)d_out; a.ws = (unsigned char*)d_ws;
#if MK_SPLIT
    for (int p = 0; p < NPHASE; ++p) { a.ph_lo = p; a.ph_hi = p + 1; hipLaunchKernelGGL(mk_fwd, dim3(grid), dim3(512), LDS_BYTES, stream, a); }
#else
    a.ph_lo = 0; a.ph_hi = NPHASE;
    hipLaunchKernelGGL(mk_fwd, dim3(grid), dim3(512), LDS_BYTES, stream, a);
#endif
}
```

```cpp
#include <hip/hip_runtime.h>
#include <cstdio>
#include <cstdint>

#ifndef PHM
#define PHM 0xFFFF
#endif
#ifndef REPM
#define REPM 0
#endif
#ifndef MK_SPLIT
#define MK_SPLIT 0
#endif

typedef unsigned short bf16_t;
typedef short bf16x8 __attribute__((ext_vector_type(8)));
typedef short s16x4 __attribute__((ext_vector_type(4)));
typedef short bf16x4 __attribute__((ext_vector_type(4)));
typedef float f32x4 __attribute__((ext_vector_type(4)));
typedef float f32x2 __attribute__((ext_vector_type(2)));
typedef unsigned u32x4 __attribute__((ext_vector_type(4)));
typedef unsigned u32x2 __attribute__((ext_vector_type(2)));
#define LAS __attribute__((address_space(3)))

constexpr int DM = 1024, NBAT = 4, SEQ = 8192, CTXL = 256;
constexpr int TC = NBAT * CTXL, TX = NBAT * SEQ, TT = TC + TX;
constexpr int NEXP = 64, TOPK = 6;
constexpr int CAP = TT;
constexpr int MOE_ROUTED_ROWS = 6 * TT + 64 * 256;
constexpr int MOE_ROWS = MOE_ROUTED_ROWS + TT;
constexpr int MOE_MAXTILES = MOE_ROWS / 256;
constexpr float ALPHA = 1.681792830507429f;
constexpr int HG_U = 128, HG_NU = (CTXL + SEQ) / HG_U;
constexpr int LRU_NT = (CTXL + SEQ) / 16;

constexpr size_t OFF_CTL = 0, CTL_BYTES = 65536;
constexpr size_t CTL_CNT = 16384, CTL_DBG = 20480;
constexpr size_t OFF_MODS = 65536;
constexpr size_t OFF_LBT = OFF_MODS + 4 * 5 * 6144 * 4;
constexpr size_t OFF_STATS = OFF_LBT + 8192;
constexpr size_t OFF_AB = OFF_STATS + (size_t)TT * 8;
static_assert(OFF_AB + 4 * 5 * 2 * 1024 * 4 <= (1u << 20), "ctl map");
constexpr size_t OFF_TOKE = 1u << 20;
constexpr size_t OFF_TOKP = OFF_TOKE + (size_t)TT * 32;
constexpr size_t OFF_TOKW = OFF_TOKP + (size_t)TT * 32;
constexpr size_t OFF_STOK = OFF_TOKW + (size_t)TT * 32;
constexpr size_t OFF_SW = OFF_STOK + (size_t)64 * CAP * 4;
constexpr size_t OFF_X = OFF_SW + (size_t)64 * CAP * 4;
constexpr size_t OFF_HB = OFF_X + (size_t)TT * DM * 4;
constexpr size_t OFF_WB = OFF_HB + (size_t)TT * DM * 2;
constexpr size_t WB_IN = 0, WB_OUT = WB_IN + (size_t)4096 * 1024 * 2, WB_RT = WB_OUT + (size_t)1024 * 1024 * 2, WB_GU = WB_RT + (size_t)64 * 1024 * 2,
                 WB_DN = WB_GU + (size_t)65 * 512 * 1024 * 2, WB_LRU = WB_DN + (size_t)65 * 1024 * 256 * 2, WB_END = WB_LRU + (size_t)2 * 2 * 16 * 64 * 64 * 2;
constexpr size_t OFF_R1 = OFF_WB + 2 * WB_END;
constexpr size_t R1_P = 0;
constexpr size_t R1_OF = R1_P + (size_t)TT * 4096 * 2;
constexpr size_t R1_SLOC = R1_OF + (size_t)TT * 512 * 4;
constexpr size_t R1_SST = R1_SLOC + (size_t)64 * HG_NU * 4096 * 4;
constexpr size_t R1_DL = R1_SST + (size_t)64 * HG_NU * 4096 * 4;
constexpr size_t R1_AG = (size_t)TT * 2048 * 2;
constexpr size_t R1_HST = R1_AG + (size_t)4 * 2 * LRU_NT * 2 * 1024 * 4;
constexpr size_t R1_GX = R1_HST + (size_t)4 * 2 * LRU_NT * 1024 * 4;
constexpr size_t R1_LRU_END = R1_GX + (size_t)TT * 2 * 1024 * 2 * 2;
constexpr size_t R1_H = 0;
constexpr size_t R1_Y = R1_H + (size_t)MOE_ROWS * 256 * 2;
constexpr size_t R1_MOE_END = R1_Y + (size_t)MOE_ROWS * 1024;
constexpr size_t R1_MIX_END = R1_DL + (size_t)64 * HG_NU * 64 * 4;
constexpr size_t R1_END_ = (R1_MOE_END > R1_MIX_END ? R1_MOE_END : R1_MIX_END);
constexpr size_t WS_END = OFF_R1 + (R1_END_ > R1_LRU_END ? R1_END_ : R1_LRU_END);

constexpr int LDS_STAGE = 131072;
constexpr int LDS_MISC = LDS_STAGE;
constexpr int MISC_CNT = 64;
constexpr int MISC_TST = MISC_CNT + 66 * 4 + 8;
constexpr int MISC_HIST = 640;
constexpr int MISC_HBASE = 896;
constexpr int MISC_T2E = 1152;
constexpr int MISC_INP = 2304;
constexpr int LDS_BYTES = 147456;

#define XB_TMO      128
#define XB_XCNT(j)  (256  + 64 * (j))
#define XB_XSUB(j)  (1280 + 64 * (j))
#define XB_XGEN(j)  (2304 + 64 * (j))
#define XB_TOP      3328
#define XB_TOPGEN   3392
#define XCD_BAR_WORDS 3456
#define XB_SPIN_CAP (1u << 22)
__device__ __forceinline__ unsigned xb_ld(unsigned* p)              { return __hip_atomic_load(p, __ATOMIC_RELAXED, __HIP_MEMORY_SCOPE_AGENT); }
__device__ __forceinline__ unsigned xb_add(unsigned* p, unsigned v) { return __hip_atomic_fetch_add(p, v, __ATOMIC_RELAXED, __HIP_MEMORY_SCOPE_AGENT); }
__device__ __forceinline__ unsigned xb_xcc_id() { return (unsigned)__builtin_amdgcn_s_getreg((3 << 11) | 20) & 0xFu; }
#define XB_SPIN(cond, bar) do { unsigned _sp = 0; while (cond) { __builtin_amdgcn_s_sleep(1); \
    if ((++_sp & 255u) == 0u) { if (xb_ld(&(bar)[XB_TMO])) break; if (_sp > XB_SPIN_CAP) { atomicAdd(&(bar)[XB_TMO], 1u); break; } } } } while (0)
struct XcdBarrier { unsigned* bar; unsigned x; volatile LAS unsigned* st; };
__device__ __forceinline__ XcdBarrier xcd_barrier_post(unsigned* bar, volatile LAS unsigned* st) {
    XcdBarrier b; b.bar = bar; b.x = xb_xcc_id(); b.st = st;
    if (threadIdx.x == 0) (void)xb_add(&bar[XB_XCNT(b.x)], 1u);
    return b;
}
__device__ __forceinline__ void xcd_barrier_complete(unsigned* bar, unsigned x, unsigned& nloc, unsigned& nx) {
    const unsigned G = gridDim.x * gridDim.y * gridDim.z;
    unsigned sum, cnt, mine, sp = 0u;
    for (;;) {
        sum = 0u; cnt = 0u; mine = 0u;
#pragma unroll
        for (unsigned j = 0; j < 16; ++j) { const unsigned c = xb_ld(&bar[XB_XCNT(j)]); sum += c; cnt += (c > 0u) ? 1u : 0u; mine = (j == x) ? c : mine; }
        if (sum == G) break;
        __builtin_amdgcn_s_sleep(1);
        if ((++sp & 255u) == 0u) { if (xb_ld(&bar[XB_TMO])) break; if (sp > XB_SPIN_CAP) { atomicAdd(&bar[XB_TMO], 1u); break; } }
    }
    nloc = mine > 0u ? mine : 1u; nx = cnt > 0u ? cnt : 1u;
}
__device__ __forceinline__ void xcd_barrier(const XcdBarrier& b) {
    asm volatile("s_waitcnt vmcnt(0)" ::: "memory");
    __syncthreads();
    if (threadIdx.x == 0) {
        unsigned* bar = b.bar;
        __builtin_amdgcn_s_waitcnt(0);
        unsigned nloc = b.st[0], nx = b.st[1];
        if (nloc == 0u) { xcd_barrier_complete(bar, b.x, nloc, nx); b.st[0] = nloc; b.st[1] = nx; }
        const unsigned old = xb_add(&bar[XB_XSUB(b.x)], 1u);
        const unsigned gen = old / nloc;
        if (old + 1u == (gen + 1u) * nloc) {
            __builtin_amdgcn_fence(__ATOMIC_RELEASE, "agent");
            asm volatile("s_waitcnt vmcnt(0)" ::: "memory");
            const unsigned og = xb_add(&bar[XB_TOP], 1u);
            const unsigned tg = og / nx;
            if (og + 1u == (tg + 1u) * nx) xb_add(&bar[XB_TOPGEN], 1u);
            else XB_SPIN(xb_ld(&bar[XB_TOPGEN]) == tg, bar);
            __builtin_amdgcn_fence(__ATOMIC_ACQUIRE, "agent");
            xb_add(&bar[XB_XGEN(b.x)], 1u);
            asm volatile("s_waitcnt vmcnt(0)" ::: "memory");
        } else {
            XB_SPIN(xb_ld(&bar[XB_XGEN(b.x)]) == gen, bar);
            __builtin_amdgcn_fence(__ATOMIC_ACQUIRE, "agent");
            asm volatile("s_waitcnt vmcnt(0)" ::: "memory");
        }
    }
    __syncthreads();
}

__device__ __forceinline__ float rows_max(float x) {
    auto a = __builtin_amdgcn_permlane32_swap(__float_as_uint(x), __float_as_uint(x), false, false); x = fmaxf(__uint_as_float(a[0]), __uint_as_float(a[1]));
    auto b = __builtin_amdgcn_permlane16_swap(__float_as_uint(x), __float_as_uint(x), false, false); return fmaxf(__uint_as_float(b[0]), __uint_as_float(b[1])); }
__device__ __forceinline__ float rows_sum(float x) {
    auto a = __builtin_amdgcn_permlane32_swap(__float_as_uint(x), __float_as_uint(x), false, false); x = __uint_as_float(a[0]) + __uint_as_float(a[1]);
    auto b = __builtin_amdgcn_permlane16_swap(__float_as_uint(x), __float_as_uint(x), false, false); return __uint_as_float(b[0]) + __uint_as_float(b[1]); }
__device__ __forceinline__ void lds_barrier() { asm volatile("s_waitcnt lgkmcnt(0)\n\ts_barrier" ::: "memory"); }
__device__ __forceinline__ float bf2f(unsigned short b) { return __uint_as_float(((unsigned)b) << 16); }
__device__ __forceinline__ unsigned cvt_pk_bf16(float lo, float hi) { unsigned r; asm volatile("v_cvt_pk_bf16_f32 %0, %1, %2" : "=v"(r) : "v"(lo), "v"(hi)); return r; }
__device__ __forceinline__ unsigned short f2bf(float f) { return (unsigned short)(cvt_pk_bf16(f, 0.f) & 0xffffu); }
__device__ __forceinline__ float sigmoidf_(float x) { return __builtin_amdgcn_rcpf(1.0f + __expf(-x)); }
__device__ __forceinline__ float siluf_(float x) { return x * sigmoidf_(x); }
__device__ __forceinline__ float gelu_tanh_(float x) { return x * sigmoidf_(1.5957691216057308f * (x + 0.044715f * x * x * x)); }
__device__ __forceinline__ int slot_of_row(int r) { return r < TC ? 4 : ((r - TC) >> 13); }
template <int CTRL> __device__ __forceinline__ float dppf(float oldv, float src) {
    return __int_as_float(__builtin_amdgcn_update_dpp(__float_as_int(oldv), __float_as_int(src), CTRL, 0xf, 0xf, false));
}
__device__ __forceinline__ void unpack8(const u32x4 w, float (&o)[8]) {
    o[0] = __uint_as_float(w.x << 16); o[1] = __uint_as_float(w.x & 0xffff0000u); o[2] = __uint_as_float(w.y << 16); o[3] = __uint_as_float(w.y & 0xffff0000u);
    o[4] = __uint_as_float(w.z << 16); o[5] = __uint_as_float(w.z & 0xffff0000u); o[6] = __uint_as_float(w.w << 16); o[7] = __uint_as_float(w.w & 0xffff0000u);
}

namespace pg8 {
constexpr int BM = 256, BK = 64, HALF = 128, HTB = HALF * BK * 2, STAGE_BYTES = 8 * HTB, NXCD = 8, WGM = 8;
__device__ __forceinline__ int lds_byte(int r, int c) { const int st = (r >> 4) * 2 + (c >> 5), rr = r & 15, cc = c & 31, ob = rr * 64 + cc * 2; return st * 1024 + (ob ^ (((ob >> 9) & 1) << 5)); }
__device__ __forceinline__ void stage_rc(int b, int& R, int& C) { const int st = b / 1024, sb = b % 1024, swz = sb ^ (((sb >> 9) & 1) << 5); R = (st >> 1) * 16 + swz / 64; C = (st & 1) * 32 + (swz % 64) / 2; }
__device__ __forceinline__ int perm32(int rho) { const int n = rho >> 4, i = rho & 15; return 8 * (i >> 2) + 4 * n + (i & 3); }
struct Unit { int pm, pn, e, ti; };

struct StaticOrder {
    const char* A; const char* Bt; int K;
    int nM, nN, nwg, G, c, lim;
    __device__ __forceinline__ void init(const void* A_, const void* Bt_, int M, int N, int K_, int G_, int c_) { A = (const char*)A_; Bt = (const char*)Bt_; K = K_; nM = M / BM; nN = N / BM; nwg = nM * nN; G = G_; c = c_; lim = (nwg / G_) * G_; }
    __device__ __forceinline__ void map(int L, Unit& u) const {
        int wgid = L; { const int q = nwg / NXCD, r = nwg % NXCD, xcd = wgid % NXCD, off = wgid / NXCD; wgid = (xcd < r ? xcd * (q + 1) : r * (q + 1) + (xcd - r) * q) + off; }
        const int nig = WGM * nN, gid = wgid / nig, fm = gid * WGM, gsz = (nM - fm) < WGM ? (nM - fm) : WGM;
        u.pm = fm + ((wgid % nig) % gsz); u.pn = (wgid % nig) / gsz; u.e = 0; u.ti = 0;
    }
    __device__ __forceinline__ bool next(int i, Unit& u) const {
        const long L = (long)i * G + c; if (L >= lim) return false;
        map((int)L, u); return true;
    }
    static constexpr bool GATHER = false;
    __device__ __forceinline__ const char* abase(const Unit& u) const { return A + (size_t)u.pm * BM * K * 2; }
    __device__ __forceinline__ const char* bbase(const Unit& u) const { return Bt + (size_t)u.pn * BM * K * 2; }
};

template <class Epi, class Sched>
__device__ __forceinline__ void gemm_phase(LAS unsigned char* lds, const int K_, const Sched& S, const Epi& E, const int wave_) {
    int Kl_ = K_; asm volatile("" : "+s"(Kl_)); const int K = Kl_;
    int tid_ = wave_ * 64 + (int)__builtin_amdgcn_mbcnt_hi(~0u, __builtin_amdgcn_mbcnt_lo(~0u, 0u)); asm volatile("" : "+v"(tid_));
    const int tid = tid_, wid = __builtin_amdgcn_readfirstlane(tid >> 6), lane = tid & 63, wr = wid >> 2, wc = wid & 3, fr = lane & 15, fq = lane >> 4;
    const int nt = K / BK;
    unsigned voffA[2], voffB[2];
#pragma unroll
    for (int i = 0; i < 2; ++i) { int R, C; stage_rc(tid * 16 + i * 8192, R, C);
        const int Rb = Epi::PERM == 1 ? ((R & ~31) + perm32(R & 31)) : Epi::PERM == 2 ? (64 * (R >> 5) + 16 * ((R & 15) >> 2) + 4 * ((R >> 4) & 1) + (R & 3)) : R;
        voffA[i] = (unsigned)(R * K + C) * 2u; voffB[i] = (unsigned)(Rb * K + C) * 2u; }
    const size_t kstep = (size_t)(BK * 2);
    const size_t hstep = (size_t)HALF * K * 2;
    const size_t hstepB = Epi::PERM == 2 ? (size_t)8 * K * 2 : hstep;
    const unsigned ldsw = (unsigned)wid * 1024u;
    const int aoff = lds_byte(wr * 64 + fr, fq * 8), boff = lds_byte(wc * 32 + fr, fq * 8);
#define PG8_SA(b, h) (((b) * 2 + (h)) * HTB)
#define PG8_SB(b, h) ((4 + (b) * 2 + (h)) * HTB)
#define PG8_STAGE(bufoff, gbase, voff) do { const char* _gb = (const char*)(gbase); asm volatile("" : "+s"(_gb)); _Pragma("unroll") for (int _i = 0; _i < 2; ++_i) { \
        unsigned _v = (voff)[_i]; asm volatile("" : "+v"(_v));     \
        __builtin_amdgcn_global_load_lds((const unsigned*)(_gb + _v), (LAS unsigned*)(lds + (bufoff) + ldsw + _i * 8192), 16, 0, 0); } } while (0)
#define PG8_STAGEA(bufoff, hh, kb, nx) do { if constexpr (Sched::GATHER) { unsigned _o[2]; _o[0] = (nx) ? vN[hh][0] : vC[hh][0]; _o[1] = (nx) ? vN[hh][1] : vC[hh][1]; PG8_STAGE(bufoff, cA + (kb), _o); } \
        else { PG8_STAGE(bufoff, ((nx) ? nA : cA) + (hh) * hstep + (kb), voffA); } } while (0)
#define PG8_LDA(dst, b, h) do { _Pragma("unroll") for (int m = 0; m < 4; ++m) _Pragma("unroll") for (int k = 0; k < 2; ++k) dst[m][k] = *(const LAS bf16x8*)(lds + PG8_SA(b, h) + aoff + m * 2048 + k * 1024); } while (0)
#define PG8_LDB(dst, b, h) do { _Pragma("unroll") for (int n = 0; n < 2; ++n) _Pragma("unroll") for (int k = 0; k < 2; ++k) dst[n][k] = *(const LAS bf16x8*)(lds + PG8_SB(b, h) + boff + n * 2048 + k * 1024); } while (0)
#define PG8_MMA(ai, bj, At, Bt) do { __builtin_amdgcn_s_setprio(1); _Pragma("unroll") for (int m = 0; m < 4; ++m) _Pragma("unroll") for (int n = 0; n < 2; ++n) _Pragma("unroll") for (int k = 0; k < 2; ++k) \
        acc[ai][bj][m][n] = __builtin_amdgcn_mfma_f32_16x16x32_bf16(Bt[n][k], At[m][k], acc[ai][bj][m][n], 0, 0, 0); __builtin_amdgcn_s_setprio(0); } while (0)
#define PG8_WAIT_V(n) asm volatile("s_waitcnt vmcnt(" #n ")" ::: "memory")
#define PG8_WAIT_VN(n) asm volatile("s_waitcnt vmcnt(%0)" :: "n"(n) : "memory")
#define PG8_WAIT_L(n) asm volatile("s_waitcnt lgkmcnt(" #n ")" ::: "memory")
#define PG8_BAR __builtin_amdgcn_s_barrier()
#define PG8_SCHED __builtin_amdgcn_sched_barrier(0)
#define PG8_BODY(H_) do { \
            const bool last = (t == nt - 2); \
            const size_t k1 = (size_t)(t + 1) * kstep, k2 = last ? 0 : (size_t)(t + 2) * kstep, k3 = k2 + kstep; \
            const char* b2 = last ? nB : cB + (size_t)(t + 2) * kstep; const char* b3 = b2 + kstep; \
            PG8_LDB(B0, 0, 0); PG8_SCHED; PG8_LDA(At, 0, 0); if (!(H_)) PG8_STAGEA(PG8_SA(1, 1), 1, k1, false); \
            PG8_WAIT_L(8); PG8_BAR; PG8_WAIT_L(0); PG8_MMA(0, 0, At, B0); PG8_BAR; PG8_SCHED; \
            PG8_LDB(B1, 0, 1); PG8_STAGE(PG8_SB(0, 0), b2, voffB); \
            PG8_BAR; PG8_WAIT_L(0); PG8_MMA(0, 1, At, B1); PG8_BAR; \
            PG8_LDA(At, 0, 1); PG8_STAGEA(PG8_SA(0, 0), 0, k2, last); \
            PG8_BAR; PG8_WAIT_L(0); PG8_MMA(1, 0, At, B0); PG8_BAR; PG8_SCHED; \
            PG8_STAGE(PG8_SB(0, 1), b2 + hstepB, voffB); \
            if (H_) PG8_WAIT_VN(6 + Epi::NSTORE); else PG8_WAIT_V(6);  \
            PG8_BAR; PG8_MMA(1, 1, At, B1); PG8_BAR; \
            PG8_LDB(B0, 1, 0); PG8_SCHED; PG8_LDA(At, 1, 0); PG8_STAGEA(PG8_SA(0, 1), 1, k2, last); \
            PG8_WAIT_L(8); PG8_BAR; PG8_WAIT_L(0); PG8_MMA(0, 0, At, B0); PG8_BAR; PG8_SCHED; \
            PG8_LDB(B1, 1, 1); PG8_STAGE(PG8_SB(1, 0), b3, voffB); \
            PG8_BAR; PG8_WAIT_L(0); PG8_MMA(0, 1, At, B1); PG8_BAR; \
            PG8_LDA(At, 1, 1); PG8_STAGEA(PG8_SA(1, 0), 0, k3, last); \
            PG8_BAR; PG8_WAIT_L(0); PG8_MMA(1, 0, At, B0); PG8_BAR; PG8_SCHED; \
            PG8_STAGE(PG8_SB(1, 1), b3 + hstepB, voffB); \
            PG8_WAIT_V(6); PG8_BAR; PG8_MMA(1, 1, At, B1); PG8_BAR; \
        } while (0)
    Unit cur, nxt; int ui = 0; bool hoisted = false;
    if (!S.next(0, cur)) return;
    f32x4 acc[2][2][4][2];
#pragma unroll
    for (int a = 0; a < 2; ++a)
#pragma unroll
        for (int b = 0; b < 2; ++b)
#pragma unroll
            for (int m = 0; m < 4; ++m)
#pragma unroll
                for (int n = 0; n < 2; ++n) acc[a][b][m][n] = (f32x4){0.f, 0.f, 0.f, 0.f};
    bf16x8 At[4][2], B0[2][2], B1[2][2];
    unsigned vC[2][2], vN[2][2];
    if constexpr (Sched::GATHER) S.aoff(cur, tid, vC);
    const char* cA = S.abase(cur);
    const char* cB = S.bbase(cur);
    const char* nA = cA;
    PG8_STAGE(PG8_SB(0, 0), cB, voffB); PG8_STAGEA(PG8_SA(0, 0), 0, 0, false); PG8_STAGE(PG8_SB(0, 1), cB + hstepB, voffB); PG8_STAGEA(PG8_SA(0, 1), 1, 0, false);
    if (wr == 1) PG8_BAR;
    PG8_WAIT_V(4); PG8_BAR;
    PG8_STAGE(PG8_SB(1, 0), cB + kstep, voffB); PG8_STAGEA(PG8_SA(1, 0), 0, kstep, false); PG8_STAGE(PG8_SB(1, 1), cB + hstepB + kstep, voffB);
    PG8_WAIT_V(6); PG8_BAR;
    for (;;) {
        const bool has_next = S.next(ui + 1, nxt);
        const char* nB = cB; nA = cA;
        if (has_next) { nB = S.bbase(nxt); nA = S.abase(nxt); if constexpr (Sched::GATHER) S.aoff(nxt, tid, vN); }
        else { if constexpr (Sched::GATHER) {
#pragma unroll
            for (int h = 0; h < 2; ++h)
#pragma unroll
                for (int i = 0; i < 2; ++i) vN[h][i] = vC[h][i]; } }
        int t = 0;
        if (Epi::NSTORE > 0 && hoisted) { PG8_BODY(true); t = 2; }
        for (; t < nt; t += 2) { PG8_BODY(false); }
        hoisted = false;
        if constexpr (Epi::NSTORE > 0) { if (has_next) { PG8_STAGEA(PG8_SA(1, 1), 1, kstep, true); hoisted = true; } }
        asm volatile("" ::: "memory");
        E(acc, cur, wr, wc, fr, fq);
        asm volatile("" ::: "memory");
        if (!has_next) break;
#pragma unroll
        for (int a = 0; a < 2; ++a)
#pragma unroll
            for (int b = 0; b < 2; ++b)
#pragma unroll
                for (int m = 0; m < 4; ++m)
#pragma unroll
                    for (int n = 0; n < 2; ++n) { acc[a][b][m][n] = (f32x4){0.f, 0.f, 0.f, 0.f}; asm volatile("" : "+v"(acc[a][b][m][n])); }
        cur = nxt; cB = nB; cA = nA; ++ui;
        if constexpr (Sched::GATHER) {
#pragma unroll
            for (int h = 0; h < 2; ++h)
#pragma unroll
                for (int i = 0; i < 2; ++i) vC[h][i] = vN[h][i]; }
    }
    PG8_WAIT_V(0);
    if (wr == 0) PG8_BAR;
    PG8_BAR;
#undef PG8_SA
#undef PG8_SB
#undef PG8_STAGE
#undef PG8_STAGEA
#undef PG8_LDA
#undef PG8_LDB
#undef PG8_MMA
#undef PG8_WAIT_V
#undef PG8_WAIT_VN
#undef PG8_BODY
#undef PG8_WAIT_L
#undef PG8_BAR
#undef PG8_SCHED
}

struct EpiStoreBf16 {
    static constexpr int PERM = 2, NSTORE = 16;
    bf16_t* O; int ldc;
    __device__ __forceinline__ void operator()(const f32x4 (&acc)[2][2][4][2], const Unit& u, int wr, int wc, int fr, int fq) const {
        const int row0 = u.pm * BM + wr * 64 + fr, col0 = u.pn * BM + wc * 64 + 16 * fq;
#pragma unroll
        for (int ai = 0; ai < 2; ++ai)
#pragma unroll
            for (int m = 0; m < 4; ++m) { bf16_t* rowp = O + (size_t)(row0 + ai * HALF + m * 16) * ldc + col0;
#pragma unroll
                for (int bj = 0; bj < 2; ++bj) { const f32x4 v0 = acc[ai][bj][m][0], v1 = acc[ai][bj][m][1];
                    u32x4 w; w.x = cvt_pk_bf16(v0[0], v0[1]); w.y = cvt_pk_bf16(v0[2], v0[3]); w.z = cvt_pk_bf16(v1[0], v1[1]); w.w = cvt_pk_bf16(v1[2], v1[3]);
                    *(u32x4*)(rowp + bj * 8) = w; } }
    }
};
struct EpiResid {
    static constexpr int PERM = 0, NSTORE = 0;
    float* X; const float* mods_l; int rbase;
    __device__ __forceinline__ void operator()(const f32x4 (&acc)[2][2][4][2], const Unit& u, int wr, int wc, int fr, int fq) const {
        const int row0 = u.pm * BM + wr * 64 + fr, col0 = u.pn * BM + wc * 32 + 4 * fq;
        const float* m2 = mods_l + (size_t)(slot_of_row(rbase + u.pm * BM) * 6 + 2) * DM + col0;
        float* xb = X + (size_t)row0 * DM + col0;
        f32x4 mv[4], xv[2][8];
#pragma unroll
        for (int g = 0; g < 4; ++g) mv[g] = *(const f32x4*)(m2 + (g >> 1) * HALF + (g & 1) * 16);
#pragma unroll
        for (int q = 0; q < 8; ++q) xv[0][q] = *(const f32x4*)(xb + (size_t)((q >> 2) * HALF + (q & 3) * 16) * DM);
        asm volatile("" ::: "memory"); __builtin_amdgcn_sched_barrier(0);
#pragma unroll
        for (int g = 0; g < 4; ++g) { const int bj = g >> 1, n = g & 1;
            if (g < 3) { const int bj1 = (g + 1) >> 1, n1 = (g + 1) & 1;
#pragma unroll
                for (int q = 0; q < 8; ++q) xv[(g + 1) & 1][q] = *(const f32x4*)(xb + (size_t)((q >> 2) * HALF + (q & 3) * 16) * DM + bj1 * HALF + n1 * 16);
                asm volatile("" ::: "memory"); __builtin_amdgcn_sched_barrier(0); }
#pragma unroll
            for (int q = 0; q < 8; ++q) *(f32x4*)(xb + (size_t)((q >> 2) * HALF + (q & 3) * 16) * DM + bj * HALF + n * 16) = xv[g & 1][q] * ALPHA + mv[g] * acc[q >> 2][bj][q & 3][n];
            asm volatile("" ::: "memory"); __builtin_amdgcn_sched_barrier(0); }
    }
};
struct EpiSwiglu {
    static constexpr int PERM = 1, NSTORE = 8;
    bf16_t* H;
    __device__ __forceinline__ void operator()(const f32x4 (&acc)[2][2][4][2], const Unit& u, int wr, int wc, int fr, int fq) const {
        const int row0 = u.pm * BM + wr * 64 + fr, col0 = u.pn * HALF + wc * 32 + 8 * fq;
#pragma unroll
        for (int ai = 0; ai < 2; ++ai)
#pragma unroll
            for (int m = 0; m < 4; ++m) { bf16_t* rowp = H + (size_t)(row0 + ai * HALF + m * 16) * 256 + col0;
                float h[8];
#pragma unroll
                for (int n = 0; n < 2; ++n)
#pragma unroll
                    for (int j = 0; j < 4; ++j) h[n * 4 + j] = siluf_(acc[ai][0][m][n][j]) * acc[ai][1][m][n][j];
                u32x4 w; w.x = cvt_pk_bf16(h[0], h[1]); w.y = cvt_pk_bf16(h[2], h[3]); w.z = cvt_pk_bf16(h[4], h[5]); w.w = cvt_pk_bf16(h[6], h[7]);
                *(u32x4*)rowp = w; }
    }
};
struct EpiDown {
    static constexpr int PERM = 2, NSTORE = 8;
    unsigned char* Y;
    __device__ __forceinline__ void operator()(const f32x4 (&acc)[2][2][4][2], const Unit& u, int wr, int wc, int fr, int fq) const {
        const int row0 = u.pm * BM + wr * 64 + fr, col0 = u.pn * BM + wc * 64 + 16 * fq;
        unsigned char* yb = Y + (size_t)row0 * DM + col0;
#pragma unroll
        for (int ai = 0; ai < 2; ++ai)
#pragma unroll
            for (int m = 0; m < 4; ++m) { const int rl = ai * HALF + m * 16;
                u32x4 ww; unsigned pk[4];
#pragma unroll
                for (int bj = 0; bj < 2; ++bj)
#pragma unroll
                    for (int n = 0; n < 2; ++n) { f32x4 v = acc[ai][bj][m][n] * 16.0f;
#pragma unroll
                        for (int j = 0; j < 4; ++j) v[j] = __builtin_amdgcn_fmed3f(v[j], -440.0f, 440.0f);
                        int p = __builtin_amdgcn_cvt_pk_fp8_f32(v[0], v[1], 0, false); p = __builtin_amdgcn_cvt_pk_fp8_f32(v[2], v[3], p, true); pk[bj * 2 + n] = (unsigned)p; }
                ww.x = pk[0]; ww.y = pk[1]; ww.z = pk[2]; ww.w = pk[3];
                *(u32x4*)(yb + (size_t)rl * DM) = ww;
                asm volatile("" ::: "memory"); }
    }
};
template <int MODE> struct EpiDownProbe {
    static constexpr int PERM = 2, NSTORE = 0;
    unsigned char* Y; const float* sw; const LAS int* cnt;
    __device__ __forceinline__ void operator()(const f32x4 (&acc)[2][2][4][2], const Unit& u, int wr, int wc, int fr, int fq) const {
        const int hsh = (u.pm * 4 + u.pn) & 2047;
        unsigned char* yb = (MODE == 1) ? Y + ((size_t)(hsh * 8 + wr * 4 + wc) * 8) * 1024 + (fq * 16 + fr) * 16
                                        : Y + (size_t)((u.pm & 511) * BM + wr * 64 + fr) * DM + u.pn * BM + wc * 64 + 16 * fq;
#pragma unroll
        for (int ai = 0; ai < 2; ++ai)
#pragma unroll
            for (int m = 0; m < 4; ++m) { const int rl = ai * HALF + m * 16; const float w = 32.0f;
                u32x4 ww; unsigned pk[4];
#pragma unroll
                for (int bj = 0; bj < 2; ++bj)
#pragma unroll
                    for (int n = 0; n < 2; ++n) { f32x4 v = acc[ai][bj][m][n] * w;
#pragma unroll
                        for (int j = 0; j < 4; ++j) v[j] = __builtin_amdgcn_fmed3f(v[j], -440.0f, 440.0f);
                        int p = __builtin_amdgcn_cvt_pk_fp8_f32(v[0], v[1], 0, false); p = __builtin_amdgcn_cvt_pk_fp8_f32(v[2], v[3], p, true); pk[bj * 2 + n] = (unsigned)p; }
                ww.x = pk[0]; ww.y = pk[1]; ww.z = pk[2]; ww.w = pk[3];
                if (MODE == 1) __builtin_nontemporal_store(ww, (u32x4*)(yb + (size_t)(ai * 4 + m) * 1024));
                else if (MODE == 2) __builtin_nontemporal_store(ww, (u32x4*)(yb + (size_t)rl * DM));
                else *(u32x4*)(yb + (size_t)rl * DM) = ww;
                asm volatile("" ::: "memory"); }
    }
};
struct EpiNull {
    static constexpr int PERM = 1, NSTORE = 0;
    __device__ __forceinline__ void operator()(const f32x4 (&acc)[2][2][4][2], const Unit&, int, int, int, int) const {
#pragma unroll
        for (int ai = 0; ai < 2; ++ai)
#pragma unroll
            for (int bj = 0; bj < 2; ++bj)
#pragma unroll
                for (int m = 0; m < 4; ++m)
#pragma unroll
                    for (int n = 0; n < 2; ++n) asm volatile("" :: "v"(acc[ai][bj][m][n]));
    }
};
struct TailStoreBf16 { bf16_t* O; int ldc;
    __device__ __forceinline__ void operator()(const f32x4 v, int row, int col) const { u32x2 w; w.x = cvt_pk_bf16(v[0], v[1]); w.y = cvt_pk_bf16(v[2], v[3]); *(u32x2*)(O + (size_t)row * ldc + col) = w; } };
struct TailResid { float* X; const float* mods_l; int rbase;
    __device__ __forceinline__ void operator()(const f32x4 v, int row, int col) const {
        const f32x4 mv = *(const f32x4*)(mods_l + (size_t)(slot_of_row(rbase + row) * 6 + 2) * DM + col);
        float* xp = X + (size_t)row * DM + col; *(f32x4*)xp = *(const f32x4*)xp * ALPHA + mv * v; } };
template <int NW, class EpiT>
__device__ __forceinline__ void gemm_tail(LAS unsigned char* lds, const StaticOrder& S, const EpiT& E, const int wave_) {
    const int nleft = S.nwg - S.lim; if (nleft <= 0) return;
    int tid_ = wave_ * 64 + (int)__builtin_amdgcn_mbcnt_hi(~0u, __builtin_amdgcn_mbcnt_lo(~0u, 0u)); asm volatile("" : "+v"(tid_));
    const int tid = tid_, wid = __builtin_amdgcn_readfirstlane(tid >> 6), lane = tid & 63, fr = lane & 15, fq = lane >> 4;
    constexpr int SUB = 256 / NW, NB = NW / 16, RS = 2064;
    const bf16_t* Ag = (const bf16_t*)S.A; const bf16_t* Bg = (const bf16_t*)S.Bt;
    const bool xs = ((S.G & 7) == 0) && ((nleft & 7) == 0);
    const int j0 = xs ? (S.c >> 3) : S.c, jstep = xs ? (S.G >> 3) : S.G, jend = xs ? (nleft >> 3) * SUB : nleft * SUB;
    for (int j = j0; j < jend; j += jstep) {
        Unit u; S.map(S.lim + (xs ? (j / SUB) * 8 + (S.c & 7) : j / SUB), u);
        const int row0 = u.pm * BM, col0 = u.pn * BM + (j % SUB) * NW;
        const bf16_t* ap = Ag + (size_t)(row0 + 32 * wid + fr) * 1024 + 8 * fq;
        bf16x8 a0[2][8], a1[2][8];
#define TL_LOADA(buf, kb) do { _Pragma("unroll") for (int mb = 0; mb < 2; ++mb) _Pragma("unroll") for (int ks = 0; ks < 8; ++ks) buf[mb][ks] = *(const bf16x8*)(ap + (size_t)mb * 16 * 1024 + ((kb) * 8 + ks) * 32); } while (0)
        TL_LOADA(a0, 0);
        __syncthreads();
        { u32x4 bs[NW * 128 / 512];
#pragma unroll
          for (int i = 0; i < NW * 128 / 512; ++i) { const int idx = i * 512 + tid, n = idx >> 7, c = idx & 127; bs[i] = *(const u32x4*)(Bg + (size_t)(col0 + n) * 1024 + c * 8); }
          __builtin_amdgcn_sched_barrier(0);
#pragma unroll
          for (int i = 0; i < NW * 128 / 512; ++i) { const int idx = i * 512 + tid, n = idx >> 7, c = idx & 127; *(LAS u32x4*)(lds + n * RS + c * 16) = bs[i]; } }
        __syncthreads();
        f32x4 acc[2][NB];
#pragma unroll
        for (int mb = 0; mb < 2; ++mb)
#pragma unroll
            for (int nb = 0; nb < NB; ++nb) acc[mb][nb] = (f32x4){0.f, 0.f, 0.f, 0.f};
        const LAS unsigned char* bl = lds + fr * RS + fq * 16;
#define TL_COMPUTE(buf, kb) do { _Pragma("unroll") for (int ks = 0; ks < 8; ++ks) _Pragma("unroll") for (int nb = 0; nb < NB; ++nb) { \
            const bf16x8 bf = *(const LAS bf16x8*)(bl + nb * 16 * RS + ((kb) * 8 + ks) * 64); \
            _Pragma("unroll") for (int mb = 0; mb < 2; ++mb) acc[mb][nb] = __builtin_amdgcn_mfma_f32_16x16x32_bf16(bf, buf[mb][ks], acc[mb][nb], 0, 0, 0); } } while (0)
        __builtin_amdgcn_sched_barrier(0);
        TL_LOADA(a1, 1); __builtin_amdgcn_sched_barrier(0); TL_COMPUTE(a0, 0); __builtin_amdgcn_sched_barrier(0);
        TL_LOADA(a0, 2); __builtin_amdgcn_sched_barrier(0); TL_COMPUTE(a1, 1); __builtin_amdgcn_sched_barrier(0);
        TL_LOADA(a1, 3); __builtin_amdgcn_sched_barrier(0); TL_COMPUTE(a0, 2); __builtin_amdgcn_sched_barrier(0);
        TL_COMPUTE(a1, 3);
#pragma unroll
        for (int mb = 0; mb < 2; ++mb)
#pragma unroll
            for (int nb = 0; nb < NB; ++nb) asm volatile("s_nop 15\n\ts_nop 15" : "+v"(acc[mb][nb]));
#undef TL_LOADA
#undef TL_COMPUTE
#pragma unroll
        for (int mb = 0; mb < 2; ++mb)
#pragma unroll
            for (int nb = 0; nb < NB; ++nb) E(acc[mb][nb], row0 + 32 * wid + 16 * mb + fr, col0 + 16 * nb + 4 * fq);
    }
    __syncthreads();
}
template <int NPN> struct MoeOrder {
    const LAS int* cnt; const LAS int* tst; const LAS unsigned char* t2e; int ntiles, G, c;
    __device__ __forceinline__ bool next(int i, Unit& u) const {
        const int cs = ((G & 7) == 0) ? (c & 7) * (G >> 3) + (c >> 3) : c;
        const int L = i * G + cs; if (L >= ntiles * NPN) return false;
        const int tau = L / NPN; u.pm = tau; u.pn = L % NPN; u.e = t2e[tau]; u.ti = tau - tst[u.e]; return true;
    }
};
struct MoeGU : MoeOrder<2> {
    static constexpr bool GATHER = true;
    const char* A; const char* Bt; const int* stok; int t0;
    __device__ __forceinline__ const char* abase(const Unit&) const { return A; }
    __device__ __forceinline__ const char* bbase(const Unit& u) const { return Bt + ((size_t)u.e * 512 + (size_t)u.pn * 256) * 1024 * 2; }
    __device__ __forceinline__ void aoff(const Unit& u, int tid, unsigned (&off)[2][2]) const {
        const int ce = cnt[u.e];
#pragma unroll
        for (int i = 0; i < 2; ++i) { int R, C; stage_rc(tid * 16 + i * 8192, R, C);
#pragma unroll
            for (int h = 0; h < 2; ++h) { const int pos = u.ti * 256 + h * HALF + R; int tok;
                if (u.e == 64) tok = t0 + pos; else tok = (pos < ce) ? stok[(size_t)u.e * CAP + pos] : 0;
                off[h][i] = (unsigned)(tok * 1024 + C) * 2u; } }
    }
};
struct MoeDN : MoeOrder<4> {
    static constexpr bool GATHER = false;
    const char* A; const char* Bt;
    __device__ __forceinline__ const char* abase(const Unit& u) const { return A + (size_t)u.pm * BM * 256 * 2; }
    __device__ __forceinline__ const char* bbase(const Unit& u) const { return Bt + ((size_t)u.e * 1024 + (size_t)u.pn * 256) * 256 * 2; }
};
}

struct Args { const float* in[30]; float* out; unsigned char* ws; int ph_lo, ph_hi; };

struct Frame {
    float* out; unsigned char* ws; LAS unsigned char* lds; int tid, lane, wave, G, wg;
    float* mods; float* X; bf16_t* HB; bf16_t* MIX; unsigned char* WB; unsigned char* R1;
};

__device__ __forceinline__ const float* inp(const Frame& F, int i) {
    const unsigned long long v = ((const LAS unsigned long long*)(F.lds + LDS_MISC + MISC_INP))[i];
    const unsigned lo = (unsigned)__builtin_amdgcn_readfirstlane((int)(unsigned)v), hi = (unsigned)__builtin_amdgcn_readfirstlane((int)(unsigned)(v >> 32));
    return (const float*)(((unsigned long long)hi << 32) | lo);
}
__device__ __forceinline__ int lane_id_() { return (int)__builtin_amdgcn_mbcnt_hi(~0u, __builtin_amdgcn_mbcnt_lo(~0u, 0u)); }
__device__ __forceinline__ Frame fresh(const Frame& F0) { Frame F = F0; int ln = lane_id_(); asm volatile("" : "+v"(ln)); F.lane = ln; F.tid = F0.wave * 64 + ln; return F; }

__device__ __forceinline__ void ph_mods(const Frame& F) {
    const float* c = inp(F, 1); const float* cc = inp(F, 3); const float* ada_w = inp(F, 4); const float* ada_b = inp(F, 5);
    LAS float* sv = (LAS float*)F.lds;
    LAS float* red = (LAS float*)(F.lds + 5 * 1024 * 4);
    for (int i = F.tid; i < 5 * 1024; i += 512) { const int s = i >> 10, k = i & 1023; const float v = (s < 4) ? c[s * 1024 + k] : cc[k]; sv[i] = siluf_(v); }
    __syncthreads();
    for (int task = F.wg; task < 4 * 48; task += F.G) {
        const int l = task / 48, cc0 = (task % 48) * 128;
        const int cg = F.tid & 31, kg = F.tid >> 5;
        const float* w = ada_w + (size_t)l * 1024 * 6144 + cc0 + cg * 4;
        f32x4 acc[5];
#pragma unroll
        for (int s = 0; s < 5; ++s) acc[s] = (f32x4){0.f, 0.f, 0.f, 0.f};
#pragma unroll 8
        for (int kk = 0; kk < 64; ++kk) { const int k = kg * 64 + kk; const f32x4 wv = *(const f32x4*)(w + (size_t)k * 6144);
#pragma unroll
            for (int s = 0; s < 5; ++s) acc[s] += wv * sv[s * 1024 + k]; }
#pragma unroll
        for (int s = 0; s < 5; ++s)
#pragma unroll
            for (int q = 0; q < 4; ++q) red[((kg * 128) + cg * 4 + q) * 5 + s] = acc[s][q];
        __syncthreads();
        if (F.tid < 128) {
            const int col = cc0 + F.tid; const float bsv = ada_b[l * 6144 + col];
#pragma unroll
            for (int s = 0; s < 5; ++s) { float v = 0.f;
#pragma unroll
                for (int g2 = 0; g2 < 16; ++g2) v += red[((g2 * 128) + F.tid) * 5 + s];
                F.mods[(size_t)(l * 5 + s) * 6144 + col] = v + bsv; }
        }
        __syncthreads();
    }
    if (F.wg == F.G - 1) {
        const float* raw = inp(F, 11); float* lbt = (float*)(F.ws + OFF_LBT);
        for (int i = F.tid; i < 2 * 512; i += 512) { const int d = i >> 9, ch = i & 511; const float r0 = raw[(d * 2 + 0) * 512 + ch], r1 = raw[(d * 2 + 1) * 512 + ch];
            lbt[(0 * 2 + d) * 512 + ch] = 0.f; lbt[(1 * 2 + d) * 512 + ch] = sigmoidf_(r1 - r0); }
    }
}

__device__ __forceinline__ void ph_init_x(const Frame& F) {
    const float* x = inp(F, 0); const float* ctx = inp(F, 2);
    { const float* lg_ = inp(F, 6); const float* lb_ = inp(F, 7); float* AB = (float*)(F.ws + OFF_AB);
      for (int i = F.wg * 512 + F.tid; i < 4 * 5 * 1024; i += F.G * 512) { const int k = i & 1023, ls = i >> 10, l = ls / 5;
          const float* m = F.mods + (size_t)ls * 6144; const float g0 = lg_[(l * 2) * 1024 + k], b0 = lb_[(l * 2) * 1024 + k], m3 = m[3 * 1024 + k], m4 = m[4 * 1024 + k];
          AB[(size_t)ls * 2048 + k] = g0 * (1.0f + m4); AB[(size_t)ls * 2048 + 1024 + k] = b0 * (1.0f + m4) + m3; } }
    const int gw = F.wg * 8 + F.wave, nw = F.G * 8;
    for (int row = gw; row < TT; row += nw) {
        const float* src = row < TC ? ctx + (size_t)row * DM : x + (size_t)(row - TC) * DM;
        const float* m = F.mods + (size_t)(0 * 5 + slot_of_row(row)) * 6144;
#pragma unroll
        for (int hh = 0; hh < 2; ++hh) { const int k = hh * 512 + F.lane * 8;
            const f32x4 v0 = *(const f32x4*)(src + k), v1 = *(const f32x4*)(src + k + 4);
            *(f32x4*)(F.X + (size_t)row * DM + k) = v0; *(f32x4*)(F.X + (size_t)row * DM + k + 4) = v1;
            const f32x4 s0 = *(const f32x4*)(m + 1024 + k), s1 = *(const f32x4*)(m + 1024 + k + 4), b0 = *(const f32x4*)(m + k), b1 = *(const f32x4*)(m + k + 4);
            const f32x4 h0 = v0 * (s0 + 1.0f) + b0, h1 = v1 * (s1 + 1.0f) + b1;
            u32x4 w; w.x = cvt_pk_bf16(h0[0], h0[1]); w.y = cvt_pk_bf16(h0[2], h0[3]); w.z = cvt_pk_bf16(h1[0], h1[1]); w.w = cvt_pk_bf16(h1[2], h1[3]);
            *(u32x4*)(F.HB + (size_t)row * DM + k) = w; }
    }
}

struct CvtP { const float* src; int sld, k0, n0; bf16_t* dst; int dld, drow0; float scale; };
__device__ __forceinline__ CvtP cvt_decode(const Frame& F, int l, int task) {
    const int j = l >> 1; const bool even = (l & 1) == 0;
    bf16_t* wIN = (bf16_t*)(F.WB + WB_IN); bf16_t* wOUT = (bf16_t*)(F.WB + WB_OUT); bf16_t* wRT = (bf16_t*)(F.WB + WB_RT);
    bf16_t* wGU = (bf16_t*)(F.WB + WB_GU); bf16_t* wDN = (bf16_t*)(F.WB + WB_DN); bf16_t* wLRU = (bf16_t*)(F.WB + WB_LRU);
    const int nIN = even ? 4096 : 2048;
    const int t_in = (nIN / 64) * 16, t_out = 256, t_rt = 16, t_gu = 65 * 2 * 64, t_dn = 65 * 64;
    CvtP p; int t = task;
    if (t < t_in) { const int nb = t >> 4, kb = t & 15; p.src = even ? inp(F, 8) + (size_t)j * 1024 * 4096 : inp(F, 13) + (size_t)j * 1024 * 2048;
        p.sld = nIN; p.k0 = kb * 64; p.n0 = nb * 64; p.dst = wIN; p.dld = 1024; p.drow0 = nb * 64; p.scale = (even && nb < 8) ? 0.125f * 1.4426950408889634f : 1.0f; return p; }
    t -= t_in;
    if (t < t_out) { const int nb = t >> 4, kb = t & 15; p.src = even ? inp(F, 9) + (size_t)j * 1024 * 1024 : inp(F, 21) + (size_t)j * 1024 * 1024;
        p.sld = 1024; p.k0 = kb * 64; p.n0 = nb * 64; p.dst = wOUT; p.dld = 1024; p.drow0 = nb * 64; p.scale = 1.0f; return p; }
    t -= t_out;
    if (t < t_rt) { p.src = inp(F, 22) + (size_t)l * 1024 * 64; p.sld = 64; p.k0 = t * 64; p.n0 = 0; p.dst = wRT; p.dld = 1024; p.drow0 = 0; p.scale = 1.0f; return p; }
    t -= t_rt;
    if (t < t_gu) { const int e = t / 128, r = t % 128, which = r >> 6, q = r & 63, nb = q >> 4, kb = q & 15;
        p.src = (e < 64) ? (which ? inp(F, 25) : inp(F, 24)) + ((size_t)l * 64 + e) * 1024 * 256 : (which ? inp(F, 28) : inp(F, 27)) + (size_t)l * 1024 * 256;
        const int n0 = nb * 64; p.sld = 256; p.k0 = kb * 64; p.n0 = n0; p.dst = wGU + (size_t)e * 512 * 1024; p.dld = 1024; p.drow0 = (n0 >> 7) * 256 + which * 128 + (n0 & 127); p.scale = 1.0f; return p; }
    t -= t_gu;
    if (t < t_dn) { const int e = t >> 6, q = t & 63, nb = q >> 2, kb = q & 3;
        p.src = (e < 64) ? inp(F, 26) + ((size_t)l * 64 + e) * 256 * 1024 : inp(F, 29) + (size_t)l * 256 * 1024;
        p.sld = 1024; p.k0 = kb * 64; p.n0 = nb * 64; p.dst = wDN + (size_t)e * 1024 * 256; p.dld = 256; p.drow0 = nb * 64; p.scale = 1.0f; return p; }
    t -= t_dn;
    { const int d = t >> 5, gt = (t >> 4) & 1, kb = t & 15;
      p.src = (gt ? inp(F, 18) : inp(F, 16)) + (((size_t)j * 2 + d) * 16 + kb) * 4096;
      p.sld = 64; p.k0 = 0; p.n0 = 0; p.dst = wLRU + (((size_t)d * 2 + gt) * 16 + kb) * 4096; p.dld = 64; p.drow0 = 0; p.scale = 1.0f; }
    return p;
}
__device__ __forceinline__ void ph_convert(const Frame& F, int l) {
    const bool even = (l & 1) == 0;
    const int nIN = even ? 4096 : 2048;
    const int total = (nIN / 64) * 16 + 256 + 16 + 65 * 2 * 64 + 65 * 64 + (even ? 0 : 64);
    LAS float* t = (LAS float*)F.lds;
    const int li = F.tid >> 3, lj0 = (F.tid & 7) * 8;
    for (int task = F.wg; task < total; task += 4 * F.G) {
        f32x4 a[4], b[4];
#pragma unroll
        for (int q = 0; q < 4; ++q) { const int tq = task + q * F.G; if (tq < total) { const CvtP c = cvt_decode(F, l, tq);
            const float* p = c.src + (size_t)(c.k0 + li) * c.sld + c.n0 + lj0; a[q] = *(const f32x4*)p; b[q] = *(const f32x4*)(p + 4); } }
        lds_barrier();
#pragma unroll
        for (int q = 0; q < 4; ++q) { if (task + q * F.G < total) { LAS float* w = t + q * 4160 + li * 65 + lj0;
            w[0] = a[q][0]; w[1] = a[q][1]; w[2] = a[q][2]; w[3] = a[q][3]; w[4] = b[q][0]; w[5] = b[q][1]; w[6] = b[q][2]; w[7] = b[q][3]; } }
        lds_barrier();
#pragma unroll
        for (int q = 0; q < 4; ++q) { const int tq = task + q * F.G; if (tq < total) { const CvtP c = cvt_decode(F, l, tq);
            float v[8];
#pragma unroll
            for (int i = 0; i < 8; ++i) v[i] = t[q * 4160 + (lj0 + i) * 65 + li] * c.scale;
            u32x4 w; w.x = cvt_pk_bf16(v[0], v[1]); w.y = cvt_pk_bf16(v[2], v[3]); w.z = cvt_pk_bf16(v[4], v[5]); w.w = cvt_pk_bf16(v[6], v[7]);
            *(u32x4*)(c.dst + (size_t)(c.drow0 + li) * c.dld + c.k0 + lj0) = w; } }
    }
    lds_barrier();
}

__device__ __forceinline__ void ph_attn(const Frame& F, int j) {
    const bf16_t* P = (const bf16_t*)(F.R1 + R1_P);
    LAS bf16_t* Ks0 = (LAS bf16_t*)F.lds;
    LAS float* rp_l = (LAS float*)(F.lds + 36864);
    const float* rpb = inp(F, 10) + (size_t)j * 8 * 465;
    const int g = F.lane >> 4, l15 = F.lane & 15;
    const int NLAT = NBAT * 8 * 32, NTASK = NLAT + NBAT * 8;
    const int wgs = ((F.G & 7) == 0) ? (F.wg & 7) * (F.G >> 3) + (F.wg >> 3) : F.wg;
    int cidx[4][4];
    { const int wq_ = (F.wave & 3) * 16 + l15, c0_ = min(max(wq_ - 8, 0), 48);
#pragma unroll
      for (int kb = 0; kb < 4; ++kb)
#pragma unroll
          for (int i = 0; i < 4; ++i) { const int kc = kb * 16 + 4 * g + i; cidx[kb][i] = (kc >= c0_ && kc < c0_ + 16) ? (kc - wq_ + 15) : 31; } }
    for (int task = wgs; task < NTASK; task += F.G) {
        const bool lat = task < NLAT;
        int b, h, rp4 = 0;
        if (lat) { b = task >> 8; h = (task >> 5) & 7; rp4 = task & 31; } else { const int t2 = task - NLAT; b = t2 >> 3; h = t2 & 7; }
        const int w0 = (F.wave & 3) * 16, myr0 = 4 * rp4 + 2 * (F.wave >> 2);
        const int rlo = min(max(4 * rp4 - 4, 0), 120), rhi = min(max(4 * rp4 + 3 - 4, 0), 120) + 7;
        const int nloc = lat ? (rhi - rlo + 1) : 0;
        int qrow[2], r0t[2];
        bf16x8 qf[2][2];
#pragma unroll
        for (int T = 0; T < 2; ++T) { r0t[T] = min(max(myr0 + T - 4, 0), 120);
            qrow[T] = lat ? (TC + b * SEQ + (myr0 + T) * 64 + w0 + l15) : (b * CTXL + (2 * F.wave + T) * 16 + l15);
            qf[T][0] = *(const bf16x8*)(P + (size_t)qrow[T] * 4096 + h * 64 + g * 8);
            qf[T][1] = *(const bf16x8*)(P + (size_t)qrow[T] * 4096 + h * 64 + 32 + g * 8); }
        if (lat) for (int i = F.tid; i < 480; i += 512) { const int rr = i >> 5, cc = i & 31; rp_l[i] = (cc < 31) ? rpb[h * 465 + rr * 31 + cc] * 1.4426950408889634f : -1e30f; }
        f32x4 oacc[2][4];
#pragma unroll
        for (int T = 0; T < 2; ++T)
#pragma unroll
            for (int dt = 0; dt < 4; ++dt) oacc[T][dt] = (f32x4){0.f, 0.f, 0.f, 0.f};
        float mrun[2] = {-1e30f, -1e30f}, lrun[2] = {0.f, 0.f};
        const int nch = nloc + 4;
        u32x4 k0, v0, k1, v1, k2, v2, k3, v3;
#define ATT_LOAD(kq_, vq_, c_) do { const int cc_ = min((c_), nch - 1); const int key = F.tid >> 3, ds = (F.tid & 7) * 8;     \
            const int krow = (cc_ < nloc) ? (TC + b * SEQ + (rlo + cc_) * 64 + key) : (b * CTXL + (cc_ - nloc) * 64 + key); \
            kq_ = *(const u32x4*)(P + (size_t)krow * 4096 + 512 + h * 64 + ds); vq_ = *(const u32x4*)(P + (size_t)krow * 4096 + 1024 + h * 64 + ds); } while (0)
#define ATT_WRITE(buf_, kq_, vq_) do { const int key = F.tid >> 3, ds = (F.tid & 7) * 8; LAS bf16_t* Kd = Ks0 + (buf_) * 9216; LAS bf16_t* Vd = Kd + 4608; \
            *(LAS u32x4*)(Kd + key * 72 + ds) = kq_; *(LAS u32x4*)(Vd + key * 72 + ds) = vq_; } while (0)
#define ATT_COMPUTE(TM_) do { \
            f32x4 s[2][4]; \
            _Pragma("unroll") for (int T = 0; T < 2; ++T) { if (!((TM_) >> T & 1)) continue; \
                const LAS float* rrow = rp_l + (loc ? (kr - (myr0 + T) + 7) * 32 : 0); \
                _Pragma("unroll") for (int kb = 0; kb < 4; ++kb) { \
                    if (loc) { _Pragma("unroll") for (int i = 0; i < 4; ++i) s[T][kb][i] = rrow[cidx[kb][i]]; } else s[T][kb] = (f32x4){0.f, 0.f, 0.f, 0.f}; } } \
            _Pragma("unroll") for (int kb = 0; kb < 4; ++kb) _Pragma("unroll") for (int ks = 0; ks < 2; ++ks) { const bf16x8 a = *(const LAS bf16x8*)(Ks + (kb * 16 + l15) * 72 + ks * 32 + g * 8); \
                _Pragma("unroll") for (int T = 0; T < 2; ++T) if ((TM_) >> T & 1) s[T][kb] = __builtin_amdgcn_mfma_f32_16x16x32_bf16(a, qf[T][ks], s[T][kb], 0, 0, 0); } \
            bf16x8 pf[2][2]; \
            _Pragma("unroll") for (int T = 0; T < 2; ++T) { if (!((TM_) >> T & 1)) continue; \
                float cm = fmaxf(fmaxf(fmaxf(s[T][0][0], s[T][0][1]), fmaxf(s[T][0][2], s[T][0][3])), fmaxf(fmaxf(s[T][1][0], s[T][1][1]), fmaxf(s[T][1][2], s[T][1][3]))); \
                cm = fmaxf(cm, fmaxf(fmaxf(fmaxf(s[T][2][0], s[T][2][1]), fmaxf(s[T][2][2], s[T][2][3])), fmaxf(fmaxf(s[T][3][0], s[T][3][1]), fmaxf(s[T][3][2], s[T][3][3])))); \
                cm = rows_max(cm); \
                const float mn = fmaxf(mrun[T], cm), sc = __builtin_amdgcn_exp2f(mrun[T] - mn); \
                mrun[T] = mn; \
                _Pragma("unroll") for (int dt = 0; dt < 4; ++dt) oacc[T][dt] *= sc; \
                float p[4][4]; f32x4 ps = (f32x4){0.f, 0.f, 0.f, 0.f}; \
                _Pragma("unroll") for (int kb = 0; kb < 4; ++kb) _Pragma("unroll") for (int i = 0; i < 4; ++i) { p[kb][i] = __builtin_amdgcn_exp2f(s[T][kb][i] - mn); ps[i] += p[kb][i]; } \
                lrun[T] = lrun[T] * sc + ((ps[0] + ps[1]) + (ps[2] + ps[3])); \
                _Pragma("unroll") for (int kp = 0; kp < 2; ++kp) { u32x4 pw; pw.x = cvt_pk_bf16(p[2 * kp][0], p[2 * kp][1]); pw.y = cvt_pk_bf16(p[2 * kp][2], p[2 * kp][3]); \
                    pw.z = cvt_pk_bf16(p[2 * kp + 1][0], p[2 * kp + 1][1]); pw.w = cvt_pk_bf16(p[2 * kp + 1][2], p[2 * kp + 1][3]); __builtin_memcpy(&pf[T][kp], &pw, 16); } } \
              \
            _Pragma("unroll") for (int kp = 0; kp < 2; ++kp) { const LAS unsigned char* vp = (const LAS unsigned char*)Vt + ((32 * kp + 4 * g + (l15 >> 2)) * 144 + (l15 & 3) * 8); \
                _Pragma("unroll") for (int dt = 0; dt < 4; ++dt) { \
                    const s16x4 ta = __builtin_amdgcn_ds_read_tr16_b64_v4i16((LAS s16x4*)(vp + dt * 32)), tb = __builtin_amdgcn_ds_read_tr16_b64_v4i16((LAS s16x4*)(vp + 2304 + dt * 32)); \
                    const bf16x8 vf = __builtin_shufflevector(ta, tb, 0, 1, 2, 3, 4, 5, 6, 7); \
                    _Pragma("unroll") for (int T = 0; T < 2; ++T) if ((TM_) >> T & 1) oacc[T][dt] = __builtin_amdgcn_mfma_f32_16x16x32_bf16(vf, pf[T][kp], oacc[T][dt], 0, 0, 0); } } } while (0)
        ATT_LOAD(k0, v0, 0); ATT_LOAD(k1, v1, 1); ATT_LOAD(k2, v2, 2); ATT_LOAD(k3, v3, 3);
        lds_barrier();
        ATT_WRITE(0, k0, v0);
        lds_barrier();
        auto chunk = [&](const int ch, u32x4& kw, u32x4& vw, u32x4& kl, u32x4& vl) __attribute__((always_inline)) {
            const bool loc = ch < nloc; const int kr = rlo + ch;
            ATT_WRITE((ch + 1) & 1, kw, vw);
            ATT_LOAD(kl, vl, ch + 4);
            const LAS bf16_t* Ks = Ks0 + (ch & 1) * 9216; const LAS bf16_t* Vt = Ks + 4608;
            const bool m0 = (ch < nch) && (loc ? (kr >= r0t[0] && kr < r0t[0] + 8) : true);
            const bool m1 = (ch < nch) && (loc ? (kr >= r0t[1] && kr < r0t[1] + 8) : true);
            if (m0 && m1) ATT_COMPUTE(3); else if (m0) ATT_COMPUTE(1); else if (m1) ATT_COMPUTE(2);
            lds_barrier();
        };
        for (int ch = 0; ch < nch; ch += 4) {
            chunk(ch, k1, v1, k0, v0); chunk(ch + 1, k2, v2, k1, v1); chunk(ch + 2, k3, v3, k2, v2); chunk(ch + 3, k0, v0, k3, v3);
        }
#undef ATT_LOAD
#undef ATT_WRITE
#undef ATT_COMPUTE
#pragma unroll
        for (int T = 0; T < 2; ++T) {
            const float lt = rows_sum(lrun[T]);
            const float inv = 1.0f / lt;
#pragma unroll
            for (int dt = 0; dt < 4; ++dt) { const f32x4 o = oacc[T][dt] * inv; u32x2 w; w.x = cvt_pk_bf16(o[0], o[1]); w.y = cvt_pk_bf16(o[2], o[3]);
                *(u32x2*)(F.MIX + (size_t)qrow[T] * DM + h * 64 + dt * 16 + 4 * g) = w; }
        }
        lds_barrier();
    }
}

__device__ __forceinline__ int hg_unit(int nb, int dir) { return dir == 0 ? nb : (nb < 2 ? 1 - nb : 2 + (HG_NU - 3 - (nb - 2))); }
__device__ __forceinline__ int hg_row(int b, int nb, int t) { return nb < 2 ? b * CTXL + nb * HG_U + t : TC + b * SEQ + (nb - 2) * HG_U + t; }
template <int CTRL> __device__ __forceinline__ float dpp_add0(float x) { return x + dppf<CTRL>(0.0f, x); }
#define ROW_ALLREDUCE4(v0, v1, v2, v3) asm volatile("s_nop 1\n\t" \
    "v_add_f32_dpp %0, %0, %0 quad_perm:[1,0,3,2] row_mask:0xf bank_mask:0xf\n\tv_add_f32_dpp %1, %1, %1 quad_perm:[1,0,3,2] row_mask:0xf bank_mask:0xf\n\t" \
    "v_add_f32_dpp %2, %2, %2 quad_perm:[1,0,3,2] row_mask:0xf bank_mask:0xf\n\tv_add_f32_dpp %3, %3, %3 quad_perm:[1,0,3,2] row_mask:0xf bank_mask:0xf\n\t" \
    "v_add_f32_dpp %0, %0, %0 quad_perm:[2,3,0,1] row_mask:0xf bank_mask:0xf\n\tv_add_f32_dpp %1, %1, %1 quad_perm:[2,3,0,1] row_mask:0xf bank_mask:0xf\n\t" \
    "v_add_f32_dpp %2, %2, %2 quad_perm:[2,3,0,1] row_mask:0xf bank_mask:0xf\n\tv_add_f32_dpp %3, %3, %3 quad_perm:[2,3,0,1] row_mask:0xf bank_mask:0xf\n\t" \
    "v_add_f32_dpp %0, %0, %0 row_half_mirror row_mask:0xf bank_mask:0xf\n\tv_add_f32_dpp %1, %1, %1 row_half_mirror row_mask:0xf bank_mask:0xf\n\t" \
    "v_add_f32_dpp %2, %2, %2 row_half_mirror row_mask:0xf bank_mask:0xf\n\tv_add_f32_dpp %3, %3, %3 row_half_mirror row_mask:0xf bank_mask:0xf\n\t" \
    "v_add_f32_dpp %0, %0, %0 row_mirror row_mask:0xf bank_mask:0xf\n\tv_add_f32_dpp %1, %1, %1 row_mirror row_mask:0xf bank_mask:0xf\n\t" \
    "v_add_f32_dpp %2, %2, %2 row_mirror row_mask:0xf bank_mask:0xf\n\tv_add_f32_dpp %3, %3, %3 row_mirror row_mask:0xf bank_mask:0xf" \
    : "+v"(v0), "+v"(v1), "+v"(v2), "+v"(v3))
template <bool WITHO, bool RAW = false>
__device__ __forceinline__ void hg_pass(const Frame& F, const bf16_t* P, const float* lbh, int b, int h, int nb, int dir, f32x4 (&S)[4][4], float (&Gsum)[16],
                                        LAS bf16_t* Vl, LAS bf16_t* Kl, float* OF, const float* ngp) {
    const int tau = F.lane & 15, g = F.lane >> 4;
    const unsigned vaddr = (unsigned)(size_t)Vl + (unsigned)((4 * g + (tau >> 2)) * 128 + (tau & 3) * 8);
    const unsigned kaddr = (unsigned)(size_t)Kl + (unsigned)((4 * g + (tau >> 2)) * 128 + (tau & 3) * 8);
    u32x2 zr[4], vr[4], qr[4];
    float ngv[4] = {0.f, 0.f, 0.f, 0.f};
    if (WITHO && !RAW && dir) {
#pragma unroll
        for (int vt = 0; vt < 4; ++vt) ngv[vt] = ngp[16 * vt + tau]; }
    { const int t = dir ? (HG_U - 1 - tau) : tau; const bf16_t* pr = P + (size_t)hg_row(b, nb, t) * 4096 + h * 64 + 4 * g;
#pragma unroll
      for (int m = 0; m < 4; ++m) { zr[m] = *(const u32x2*)(pr + (dir ? 2560 : 2048) + 16 * m); vr[m] = *(const u32x2*)(pr + 3072 + 16 * m); } }
    for (int ci = 0; ci < HG_U / 16; ++ci) {
        float kk[16], c[16];
        if (WITHO) { const int pos = ci * 16 + tau, t = dir ? (HG_U - 1 - pos) : pos; const bf16_t* pr = P + (size_t)hg_row(b, nb, t) * 4096 + h * 64 + 4 * g;
#pragma unroll
            for (int m = 0; m < 4; ++m) qr[m] = *(const u32x2*)(pr + 1536 + 16 * m); }
#pragma unroll
        for (int m = 0; m < 4; ++m) { const float z0 = __uint_as_float(zr[m].x << 16), z1 = __uint_as_float(zr[m].x & 0xffff0000u), z2 = __uint_as_float(zr[m].y << 16), z3 = __uint_as_float(zr[m].y & 0xffff0000u);
            const float zz[4] = {z0, z1, z2, z3};
            const f32x4 lb4 = *(const f32x4*)(lbh + 16 * m + 4 * g);
#pragma unroll
            for (int i = 0; i < 4; ++i) { const float lb = lb4[i]; const float f = fmaxf(lb + (1.0f - lb) * sigmoidf_(zz[i]), 1e-30f); kk[m * 4 + i] = 1.0f - f; c[m * 4 + i] = __logf(f); }
            *(LAS u32x2*)(Vl + tau * 64 + 16 * m + 4 * g) = vr[m];
 }
        if (ci + 1 < HG_U / 16) { const int pos = (ci + 1) * 16 + tau, t = dir ? (HG_U - 1 - pos) : pos; const bf16_t* pr = P + (size_t)hg_row(b, nb, t) * 4096 + h * 64 + 4 * g;
#pragma unroll
            for (int m = 0; m < 4; ++m) { zr[m] = *(const u32x2*)(pr + (dir ? 2560 : 2048) + 16 * m); vr[m] = *(const u32x2*)(pr + 3072 + 16 * m); } }
        float G[16];
#pragma unroll
        for (int q = 0; q < 16; ++q) G[q] = c[q];
#pragma unroll
        for (int q = 0; q < 16; q += 4) ROW_ALLREDUCE4(G[q], G[q + 1], G[q + 2], G[q + 3]);
#pragma unroll
        for (int q = 0; q < 16; ++q) { c[q] = dpp_add0<0x111>(c[q]); c[q] = dpp_add0<0x112>(c[q]); c[q] = dpp_add0<0x114>(c[q]); c[q] = dpp_add0<0x118>(c[q]); }
#pragma unroll
        for (int q = 0; q < 16; ++q) Gsum[q] += G[q];
#pragma unroll
        for (int m = 0; m < 4; ++m) { float kh[4];
#pragma unroll
            for (int i = 0; i < 4; ++i) kh[i] = kk[m * 4 + i] * __expf(G[m * 4 + i] - c[m * 4 + i]);
            u32x2 w; w.x = cvt_pk_bf16(kh[0], kh[1]); w.y = cvt_pk_bf16(kh[2], kh[3]);
            *(LAS u32x2*)(Kl + tau * 64 + 16 * m + 4 * g) = w; }
        float ofv[4][4], gtv[4][4]; int orow[4];
        if (WITHO) {
#pragma unroll
            for (int i = 0; i < 4; ++i) { const int p2 = ci * 16 + 4 * g + i, t2 = dir ? (HG_U - 1 - p2) : p2; orow[i] = hg_row(b, nb, t2); }
            if (dir && !RAW) {
#pragma unroll
                for (int i = 0; i < 4; ++i)
#pragma unroll
                    for (int vt = 0; vt < 4; ++vt) { ofv[i][vt] = OF[(size_t)orow[i] * 512 + h * 64 + 16 * vt + tau]; gtv[i][vt] = bf2f(P[(size_t)orow[i] * 4096 + 3584 + h * 64 + 16 * vt + tau]); }
            }
        }
        asm volatile("s_waitcnt lgkmcnt(0)" ::: "memory");
        u32x2 vtr[4], ktr[4];
        asm volatile("ds_read_b64_tr_b16 %0, %8\n\tds_read_b64_tr_b16 %1, %8 offset:32\n\tds_read_b64_tr_b16 %2, %8 offset:64\n\tds_read_b64_tr_b16 %3, %8 offset:96\n\t"
                     "ds_read_b64_tr_b16 %4, %9\n\tds_read_b64_tr_b16 %5, %9 offset:32\n\tds_read_b64_tr_b16 %6, %9 offset:64\n\tds_read_b64_tr_b16 %7, %9 offset:96\n\ts_waitcnt lgkmcnt(0)"
                     : "=&v"(vtr[0]), "=&v"(vtr[1]), "=&v"(vtr[2]), "=&v"(vtr[3]), "=&v"(ktr[0]), "=&v"(ktr[1]), "=&v"(ktr[2]), "=&v"(ktr[3]) : "v"(vaddr), "v"(kaddr) : "memory");
        bf16x8 Vf[4], Kf[4];
#pragma unroll
        for (int q = 0; q < 4; ++q) { u32x4 w; w.x = vtr[q].x; w.y = vtr[q].y; w.z = 0u; w.w = 0u; __builtin_memcpy(&Vf[q], &w, 16); u32x4 w2; w2.x = ktr[q].x; w2.y = ktr[q].y; w2.z = 0u; w2.w = 0u; __builtin_memcpy(&Kf[q], &w2, 16); }
        if (WITHO) {
            bf16x8 Ktf[2], Qtf[2], Qhf[2];
#pragma unroll
            for (int ks = 0; ks < 2; ++ks) { float kt_[8], qt_[8], qh_[8];
#pragma unroll
                for (int mm = 0; mm < 2; ++mm) { const int m = 2 * ks + mm;
                    const float qq[4] = {__uint_as_float(qr[m].x << 16), __uint_as_float(qr[m].x & 0xffff0000u), __uint_as_float(qr[m].y << 16), __uint_as_float(qr[m].y & 0xffff0000u)};
#pragma unroll
                    for (int i = 0; i < 4; ++i) { const int q = m * 4 + i; const float qv = siluf_(qq[i]) * 0.125f; const float d = fminf(fmaxf(c[q] - 0.5f * G[q], -80.0f), 80.0f);
                        qt_[mm * 4 + i] = qv * __expf(d); kt_[mm * 4 + i] = kk[q] * __expf(-d); qh_[mm * 4 + i] = qv * __expf(c[q]); } }
                u32x4 w; w.x = cvt_pk_bf16(kt_[0], kt_[1]); w.y = cvt_pk_bf16(kt_[2], kt_[3]); w.z = cvt_pk_bf16(kt_[4], kt_[5]); w.w = cvt_pk_bf16(kt_[6], kt_[7]); __builtin_memcpy(&Ktf[ks], &w, 16);
                w.x = cvt_pk_bf16(qt_[0], qt_[1]); w.y = cvt_pk_bf16(qt_[2], qt_[3]); w.z = cvt_pk_bf16(qt_[4], qt_[5]); w.w = cvt_pk_bf16(qt_[6], qt_[7]); __builtin_memcpy(&Qtf[ks], &w, 16);
                w.x = cvt_pk_bf16(qh_[0], qh_[1]); w.y = cvt_pk_bf16(qh_[2], qh_[3]); w.z = cvt_pk_bf16(qh_[4], qh_[5]); w.w = cvt_pk_bf16(qh_[6], qh_[7]); __builtin_memcpy(&Qhf[ks], &w, 16); }
            f32x4 AT = (f32x4){0.f, 0.f, 0.f, 0.f};
            AT = __builtin_amdgcn_mfma_f32_16x16x32_bf16(Ktf[0], Qtf[0], AT, 0, 0, 0); AT = __builtin_amdgcn_mfma_f32_16x16x32_bf16(Ktf[1], Qtf[1], AT, 0, 0, 0);
#pragma unroll
            for (int i = 0; i < 4; ++i) AT[i] = (4 * g + i <= tau) ? AT[i] : 0.0f;
            bf16x8 Af; { u32x4 w; w.x = cvt_pk_bf16(AT[0], AT[1]); w.y = cvt_pk_bf16(AT[2], AT[3]); w.z = 0u; w.w = 0u; __builtin_memcpy(&Af, &w, 16); }
            f32x4 o[4];
#pragma unroll
            for (int vt = 0; vt < 4; ++vt) { o[vt] = __builtin_amdgcn_mfma_f32_16x16x32_bf16(Af, Vf[vt], (f32x4){0.f, 0.f, 0.f, 0.f}, 0, 0, 0);
#pragma unroll
                for (int ks = 0; ks < 2; ++ks) { u32x4 w; w.x = cvt_pk_bf16(S[2 * ks][vt][0], S[2 * ks][vt][1]); w.y = cvt_pk_bf16(S[2 * ks][vt][2], S[2 * ks][vt][3]);
                    w.z = cvt_pk_bf16(S[2 * ks + 1][vt][0], S[2 * ks + 1][vt][1]); w.w = cvt_pk_bf16(S[2 * ks + 1][vt][2], S[2 * ks + 1][vt][3]); bf16x8 Sf; __builtin_memcpy(&Sf, &w, 16);
                    o[vt] = __builtin_amdgcn_mfma_f32_16x16x32_bf16(Qhf[ks], Sf, o[vt], 0, 0, 0); } }
            if (dir == 0 || RAW) {
#pragma unroll
                for (int i = 0; i < 4; ++i)
#pragma unroll
                    for (int vt = 0; vt < 4; ++vt) OF[(size_t)orow[i] * 512 + h * 64 + 16 * vt + tau] = o[vt][i];
            } else {
                { float tot[4][4], sq[4];
#pragma unroll
                for (int i = 0; i < 4; ++i) { sq[i] = 0.f;
#pragma unroll
                    for (int vt = 0; vt < 4; ++vt) { tot[i][vt] = o[vt][i] + ofv[i][vt]; sq[i] = fmaf(tot[i][vt], tot[i][vt], sq[i]); } }
                ROW_ALLREDUCE4(sq[0], sq[1], sq[2], sq[3]);
#pragma unroll
                for (int i = 0; i < 4; ++i) { const float rs = rsqrtf(sq[i] * (1.0f / 64.0f) + 1e-6f);
#pragma unroll
                    for (int vt = 0; vt < 4; ++vt) F.MIX[(size_t)orow[i] * DM + 512 + h * 64 + 16 * vt + tau] = f2bf(tot[i][vt] * rs * ngv[vt] * siluf_(gtv[i][vt])); } }
            }
        }
#pragma unroll
        for (int kt = 0; kt < 4; ++kt) { f32x4 eg;
#pragma unroll
            for (int i = 0; i < 4; ++i) eg[i] = __expf(G[kt * 4 + i]);
#pragma unroll
            for (int vt = 0; vt < 4; ++vt) S[kt][vt] = __builtin_amdgcn_mfma_f32_16x16x32_bf16(Kf[kt], Vf[vt], S[kt][vt] * eg, 0, 0, 0); }
    }
}
__device__ __forceinline__ void ph_hg_a(const Frame& F, int j) {
    const bf16_t* P = (const bf16_t*)(F.R1 + R1_P);
    float* SLOC = (float*)(F.R1 + R1_SLOC); float* DL = (float*)(F.R1 + R1_DL);
    LAS bf16_t* Vl = (LAS bf16_t*)(F.lds + 32768 + F.wave * 4096); LAS bf16_t* Kl = Vl + 1024;
    const int gw = F.wg * 8 + F.wave, nw = F.G * 8;
    const int NT = NBAT * 8 * (HG_NU - 2) * 2;
    for (int task = gw; task < NT; task += nw) {
        const int dir = task & 1, nb = 2 + (task >> 1) % (HG_NU - 2), bh = (task >> 1) / (HG_NU - 2), b = bh >> 3, h = bh & 7;
        const float* lbh = (const float*)(F.ws + OFF_LBT) + (j * 2 + dir) * 512 + h * 64;
        f32x4 S[4][4];
#pragma unroll
        for (int kt = 0; kt < 4; ++kt)
#pragma unroll
            for (int vt = 0; vt < 4; ++vt) S[kt][vt] = (f32x4){0.f, 0.f, 0.f, 0.f};
        float Gsum[16];
#pragma unroll
        for (int q = 0; q < 16; ++q) Gsum[q] = 0.f;
        hg_pass<false>(F, P, lbh, b, h, nb, dir, S, Gsum, Vl, Kl, nullptr, nullptr);
        const int seq = bh * 2 + dir, u = hg_unit(nb, dir);
        float* so = SLOC + ((size_t)seq * HG_NU + u) * 4096;
#pragma unroll
        for (int kt = 0; kt < 4; ++kt)
#pragma unroll
            for (int vt = 0; vt < 4; ++vt)
#pragma unroll
                for (int i = 0; i < 4; ++i) so[((kt * 4 + vt) * 4 + i) * 64 + F.lane] = S[kt][vt][i];
        if ((F.lane & 15) == 0) { float* dd = DL + ((size_t)seq * HG_NU + u) * 64;
#pragma unroll
            for (int m = 0; m < 4; ++m)
#pragma unroll
                for (int i = 0; i < 4; ++i) dd[16 * m + 4 * (F.lane >> 4) + i] = __expf(Gsum[m * 4 + i]); }
    }
}
__device__ __forceinline__ void ph_hg_b(const Frame& F) {
    const float* SLOC = (const float*)(F.R1 + R1_SLOC); const float* DL = (const float*)(F.R1 + R1_DL); float* SST = (float*)(F.R1 + R1_SST);
    for (int idx = F.wg * 512 + F.tid; idx < 64 * 4096; idx += F.G * 512) {
        const int seq = idx >> 12, e = idx & 4095, ln = e & 63, reg = e >> 6, i = reg & 3, kt = reg >> 4, k = 16 * kt + 4 * (ln >> 4) + i;
        float s = 0.f;
        for (int u0 = 0; u0 < HG_NU; u0 += 11) {
            float sl[11], dl[11];
#pragma unroll
            for (int q = 0; q < 11; ++q) { sl[q] = SLOC[((size_t)seq * HG_NU + u0 + q) * 4096 + e]; dl[q] = DL[((size_t)seq * HG_NU + u0 + q) * 64 + k]; }
            asm volatile("" ::: "memory"); __builtin_amdgcn_sched_barrier(0);
#pragma unroll
            for (int q = 0; q < 11; ++q) { SST[((size_t)seq * HG_NU + u0 + q) * 4096 + e] = s; s = dl[q] * s + sl[q]; }
        }
    }
}
__device__ __forceinline__ void ph_hg_c(const Frame& F, int j) {
    const bf16_t* P = (const bf16_t*)(F.R1 + R1_P);
    const float* SST = (const float*)(F.R1 + R1_SST); float* OF = (float*)(F.R1 + R1_OF);
    const float* ng = inp(F, 12) + j * 64;
    LAS bf16_t* Vl = (LAS bf16_t*)(F.lds + 32768 + F.wave * 4096); LAS bf16_t* Kl = Vl + 1024;
    const int gw = F.wg * 8 + F.wave, nw = F.G * 8;
    const int NT = NBAT * 8 * (HG_NU - 2);
    for (int task = gw; task < NT; task += nw) {
        const int nb = 2 + task % (HG_NU - 2), bh = task / (HG_NU - 2), b = bh >> 3, h = bh & 7;
        for (int dir = 0; dir < 2; ++dir) {
            const float* lbh = (const float*)(F.ws + OFF_LBT) + (j * 2 + dir) * 512 + h * 64;
            const int seq = bh * 2 + dir, u = hg_unit(nb, dir);
            const float* ss = SST + ((size_t)seq * HG_NU + u) * 4096;
            f32x4 S[4][4];
#pragma unroll
            for (int kt = 0; kt < 4; ++kt)
#pragma unroll
                for (int vt = 0; vt < 4; ++vt)
#pragma unroll
                    for (int i = 0; i < 4; ++i) S[kt][vt][i] = ss[((kt * 4 + vt) * 4 + i) * 64 + F.lane];
            float Gsum[16];
#pragma unroll
            for (int q = 0; q < 16; ++q) Gsum[q] = 0.f;
            hg_pass<true>(F, P, lbh, b, h, nb, dir, S, Gsum, Vl, Kl, OF, ng);
            asm volatile("s_waitcnt vmcnt(0)" ::: "memory");
        }
    }
}

__device__ __forceinline__ void ph_hg_ctx(const Frame& F, int j) {
    const bf16_t* P = (const bf16_t*)(F.R1 + R1_P);
    float* SLOC = (float*)(F.R1 + R1_SLOC); float* DL = (float*)(F.R1 + R1_DL); float* OF = (float*)(F.R1 + R1_OF);
    float* OB = OF + (size_t)TC * 512;
    const float* ng = inp(F, 12) + j * 64;
    LAS bf16_t* Vl = (LAS bf16_t*)(F.lds + 32768 + F.wave * 4096); LAS bf16_t* Kl = Vl + 1024;
    const int bh = F.wg * 4 + (F.wave & 3), b = bh >> 3, h = bh & 7, dir = F.wave >> 2;
    {
        const float* lbh = (const float*)(F.ws + OFF_LBT) + (j * 2 + dir) * 512 + h * 64;
        const int seq = bh * 2 + dir;
        f32x4 S[4][4];
#pragma unroll
        for (int kt = 0; kt < 4; ++kt)
#pragma unroll
            for (int vt = 0; vt < 4; ++vt) S[kt][vt] = (f32x4){0.f, 0.f, 0.f, 0.f};
        for (int u = 0; u < 2; ++u) {
            const int nb = dir ? 1 - u : u;
            float Gsum[16];
#pragma unroll
            for (int q = 0; q < 16; ++q) Gsum[q] = 0.f;
            hg_pass<true, true>(F, P, lbh, b, h, nb, dir, S, Gsum, Vl, Kl, dir ? OB : OF, ng);
            float* so = SLOC + ((size_t)seq * HG_NU + u) * 4096;
#pragma unroll
            for (int kt = 0; kt < 4; ++kt)
#pragma unroll
                for (int vt = 0; vt < 4; ++vt)
#pragma unroll
                    for (int i = 0; i < 4; ++i) so[((kt * 4 + vt) * 4 + i) * 64 + F.lane] = S[kt][vt][i];
            if ((F.lane & 15) == 0) { float* dd = DL + ((size_t)seq * HG_NU + u) * 64;
#pragma unroll
                for (int q = 0; q < 16; ++q) dd[16 * (q >> 2) + 4 * (F.lane >> 4) + (q & 3)] = 0.0f; }
        }
    }
    __syncthreads();
    {
        const int half = F.wave >> 2, ts = F.lane >> 4, v4 = (F.lane & 15) * 4;
        const f32x4 ng4 = *(const f32x4*)(ng + v4);
        for (int it = 0; it < 32; it += 4) {
            f32x4 tot[4]; u32x2 gw[4]; float sq[4]; int row[4];
#pragma unroll
            for (int q = 0; q < 4; ++q) { row[q] = b * CTXL + half * 128 + (it + q) * 4 + ts;
                tot[q] = *(const f32x4*)(OF + (size_t)row[q] * 512 + h * 64 + v4) + *(const f32x4*)(OB + (size_t)row[q] * 512 + h * 64 + v4);
                gw[q] = *(const u32x2*)(P + (size_t)row[q] * 4096 + 3584 + h * 64 + v4); }
#pragma unroll
            for (int q = 0; q < 4; ++q) sq[q] = tot[q][0] * tot[q][0] + tot[q][1] * tot[q][1] + tot[q][2] * tot[q][2] + tot[q][3] * tot[q][3];
            ROW_ALLREDUCE4(sq[0], sq[1], sq[2], sq[3]);
#pragma unroll
            for (int q = 0; q < 4; ++q) { const float rs = rsqrtf(sq[q] * (1.0f / 64.0f) + 1e-6f);
                const float g0 = __uint_as_float(gw[q].x << 16), g1 = __uint_as_float(gw[q].x & 0xffff0000u), g2 = __uint_as_float(gw[q].y << 16), g3 = __uint_as_float(gw[q].y & 0xffff0000u);
                u32x2 w; w.x = cvt_pk_bf16(tot[q][0] * rs * ng4[0] * siluf_(g0), tot[q][1] * rs * ng4[1] * siluf_(g1));
                w.y = cvt_pk_bf16(tot[q][2] * rs * ng4[2] * siluf_(g2), tot[q][3] * rs * ng4[3] * siluf_(g3));
                *(u32x2*)(F.MIX + (size_t)row[q] * DM + 512 + h * 64 + v4) = w; }
        }
    }
}

__device__ __forceinline__ int lru_nat(int so, int dir) { return dir == 0 ? so : (so < 16 ? 15 - so : 16 + (LRU_NT - 1 - so)); }
__device__ __forceinline__ int lru_row(int b, int nt, int t) { return nt < 16 ? b * CTXL + nt * 16 + t : TC + b * SEQ + (nt - 16) * 16 + t; }
struct LruRaw { u32x4 a[4], b[4]; unsigned ok; };
__device__ __forceinline__ void lru_load(const Frame& F, int b, int kb, int nt, LruRaw& R) {
    const bf16_t* P = (const bf16_t*)(F.R1 + R1_P);
    const int tk = F.lane & 15, g = F.lane >> 4;
    const int len = nt < 16 ? CTXL : SEQ, tpos = (nt < 16 ? nt * 16 : (nt - 16) * 16) + tk;
    const bf16_t* pbase = P + (size_t)((nt < 16 ? b * CTXL : TC + b * SEQ)) * 2048 + 1024 + kb * 64 + g * 16;
    unsigned okm = 0u;
#pragma unroll
    for (int tap = 0; tap < 4; ++tap) { const int tp = tpos + tap - 2; const bool ok = (tp >= 0 && tp < len); const bf16_t* pr = pbase + (size_t)(ok ? tp : tpos) * 2048;
        okm |= ok ? (1u << tap) : 0u;
        R.a[tap] = *(const u32x4*)pr; R.b[tap] = *(const u32x4*)(pr + 8); }
    R.ok = okm;
}
__device__ __forceinline__ void lru_conv(const Frame& F, const LruRaw& R, const LAS float* CT, LAS float* ucb) {
    const int tk = F.lane & 15, g = F.lane >> 4;
    float acc[16];
#pragma unroll
    for (int q = 0; q < 4; ++q) { const f32x4 c4 = *(const LAS f32x4*)(CT + 4 * 64 + g * 16 + q * 4); acc[q * 4] = c4[0]; acc[q * 4 + 1] = c4[1]; acc[q * 4 + 2] = c4[2]; acc[q * 4 + 3] = c4[3]; }
#pragma unroll
    for (int tap = 0; tap < 4; ++tap) { float t0[8], t1[8]; const bool ok = (R.ok >> tap) & 1u; const u32x4 z4 = (u32x4){0u, 0u, 0u, 0u};
        unpack8(ok ? R.a[tap] : z4, t0); unpack8(ok ? R.b[tap] : z4, t1);
#pragma unroll
        for (int q = 0; q < 2; ++q) { const f32x4 w0 = *(const LAS f32x4*)(CT + tap * 64 + g * 16 + q * 4), w1 = *(const LAS f32x4*)(CT + tap * 64 + g * 16 + 8 + q * 4);
#pragma unroll
            for (int i = 0; i < 4; ++i) { acc[q * 4 + i] = fmaf(w0[i], t0[q * 4 + i], acc[q * 4 + i]); acc[8 + q * 4 + i] = fmaf(w1[i], t1[q * 4 + i], acc[8 + q * 4 + i]); } } }
#pragma unroll
    for (int q = 0; q < 4; ++q) *(LAS f32x4*)(ucb + tk * 68 + g * 16 + q * 4) = (f32x4){acc[q * 4], acc[q * 4 + 1], acc[q * 4 + 2], acc[q * 4 + 3]};
}
__device__ __forceinline__ void lru_gates(const Frame& F, LAS bf16_t* Wl, const LAS float* CT, LAS float* ucb, float (&av)[2][4][4], unsigned (&pw)[2][4][4]) {
    const int tk = F.lane & 15, g = F.lane >> 4;
    bf16x8 bfr[2];
#pragma unroll
    for (int ks = 0; ks < 2; ++ks) { const f32x4 u0 = *(const LAS f32x4*)(ucb + tk * 68 + ks * 32 + g * 8), u1 = *(const LAS f32x4*)(ucb + tk * 68 + ks * 32 + g * 8 + 4);
        u32x4 w; w.x = cvt_pk_bf16(u0[0], u0[1]); w.y = cvt_pk_bf16(u0[2], u0[3]); w.z = cvt_pk_bf16(u1[0], u1[1]); w.w = cvt_pk_bf16(u1[2], u1[3]); __builtin_memcpy(&bfr[ks], &w, 16); }
#pragma unroll
    for (int d = 0; d < 2; ++d)
#pragma unroll
        for (int et = 0; et < 4; ++et) {
            f32x4 ra = (f32x4){0.f, 0.f, 0.f, 0.f}, ri = (f32x4){0.f, 0.f, 0.f, 0.f};
#pragma unroll
            for (int ks = 0; ks < 2; ++ks) {
                const bf16x8 wa = *(const LAS bf16x8*)(Wl + ((d * 2 + 0) * 64 + et * 16 + tk) * 72 + ks * 32 + g * 8);
                const bf16x8 wx = *(const LAS bf16x8*)(Wl + ((d * 2 + 1) * 64 + et * 16 + tk) * 72 + ks * 32 + g * 8);
                ra = __builtin_amdgcn_mfma_f32_16x16x32_bf16(wa, bfr[ks], ra, 0, 0, 0);
                ri = __builtin_amdgcn_mfma_f32_16x16x32_bf16(wx, bfr[ks], ri, 0, 0, 0);
            }
            const f32x4 ba4 = *(const LAS f32x4*)(CT + (5 + 3 * d) * 64 + et * 16 + 4 * g), bx4 = *(const LAS f32x4*)(CT + (6 + 3 * d) * 64 + et * 16 + 4 * g), cs4 = *(const LAS f32x4*)(CT + (7 + 3 * d) * 64 + et * 16 + 4 * g);
            const f32x4 u4 = *(const LAS f32x4*)(ucb + tk * 68 + et * 16 + 4 * g);
#pragma unroll
            for (int i = 0; i < 4; ++i) {
                const float r = sigmoidf_(ra[i] + ba4[i]), ig = sigmoidf_(ri[i] + bx4[i]);
                const float la = __uint_as_float(cvt_pk_bf16(cs4[i] * r, 0.f) << 16), a = __expf(la);
                av[d][et][i] = a; pw[d][et][i] = cvt_pk_bf16(la, __builtin_amdgcn_sqrtf(fmaxf(1.0f - a * a, 0.f)) * ig * u4[i]); }
        }
}
template <int S> __device__ __forceinline__ void lru_step_f(float& a, float& x) { const float ap = dppf<0x110 + S>(1.0f, a), xp = dppf<0x110 + S>(0.0f, x); x = fmaf(a, xp, x); a = a * ap; }
template <int S> __device__ __forceinline__ void lru_step_b(float& a, float& x) { const float ap = dppf<0x100 + S>(1.0f, a), xp = dppf<0x100 + S>(0.0f, x); x = fmaf(a, xp, x); a = a * ap; }
#define LRU_DPP_STEP(SH, x_, a_) asm volatile("s_nop 1\n\t" \
    "v_fmac_f32_dpp %0, %0, %4 " SH " row_mask:0xf bank_mask:0xf\n\tv_fmac_f32_dpp %1, %1, %5 " SH " row_mask:0xf bank_mask:0xf\n\t" \
    "v_fmac_f32_dpp %2, %2, %6 " SH " row_mask:0xf bank_mask:0xf\n\tv_fmac_f32_dpp %3, %3, %7 " SH " row_mask:0xf bank_mask:0xf\n\t" \
    "v_mul_f32_dpp %4, %4, %4 " SH " row_mask:0xf bank_mask:0xf\n\tv_mul_f32_dpp %5, %5, %5 " SH " row_mask:0xf bank_mask:0xf\n\t" \
    "v_mul_f32_dpp %6, %6, %6 " SH " row_mask:0xf bank_mask:0xf\n\tv_mul_f32_dpp %7, %7, %7 " SH " row_mask:0xf bank_mask:0xf" \
    : "+v"(x_[0]), "+v"(x_[1]), "+v"(x_[2]), "+v"(x_[3]), "+v"(a_[0]), "+v"(a_[1]), "+v"(a_[2]), "+v"(a_[3]))
#define LRU_SCANS(av, xv) do { _Pragma("unroll") for (int et = 0; et < 4; ++et) { \
        LRU_DPP_STEP("row_shr:1", xv[0][et], av[0][et]); LRU_DPP_STEP("row_shl:1", xv[1][et], av[1][et]); } \
    _Pragma("unroll") for (int et = 0; et < 4; ++et) { LRU_DPP_STEP("row_shr:2", xv[0][et], av[0][et]); LRU_DPP_STEP("row_shl:2", xv[1][et], av[1][et]); } \
    _Pragma("unroll") for (int et = 0; et < 4; ++et) { LRU_DPP_STEP("row_shr:4", xv[0][et], av[0][et]); LRU_DPP_STEP("row_shl:4", xv[1][et], av[1][et]); } \
    _Pragma("unroll") for (int et = 0; et < 4; ++et) { LRU_DPP_STEP("row_shr:8", xv[0][et], av[0][et]); LRU_DPP_STEP("row_shl:8", xv[1][et], av[1][et]); } } while (0)
__device__ __forceinline__ void ph_lru_a(const Frame& F, int jj) {
    LAS bf16_t* Wl = (LAS bf16_t*)F.lds;
    LAS float* ucb = (LAS float*)(F.lds + 36864 + F.wave * 4352);
    LAS float* CT = (LAS float*)(F.lds + 36864 + 8 * 4352);
    const bf16_t* wsrc = (const bf16_t*)(F.WB + WB_LRU);
    float* AG = (float*)(F.R1 + R1_AG); bf16_t* GX = (bf16_t*)(F.R1 + R1_GX);
    const float* cw = inp(F, 14) + (size_t)jj * 4 * 1024; const float* cb = inp(F, 15) + (size_t)jj * 1024;
    const float* b_a = inp(F, 17) + (size_t)jj * 2 * 1024; const float* b_x = inp(F, 19) + (size_t)jj * 2 * 1024; const float* lam = inp(F, 20) + (size_t)jj * 2 * 1024;
    const int tk = F.lane & 15, g = F.lane >> 4;
    const int NTASK = NBAT * 16 * 11;
    for (int task = F.wg; task < NTASK; task += F.G) {
        const int grp = task % 11, kb = (task / 11) & 15, b = task / (11 * 16);
        __syncthreads();
        for (int i = F.tid; i < 4 * 4096 / 8; i += 512) { const int mg = i >> 9, r = i & 511;
            *(LAS u32x4*)(Wl + (mg * 64 + (r >> 3)) * 72 + (r & 7) * 8) = *(const u32x4*)(wsrc + ((size_t)mg * 16 + kb) * 4096 + r * 8); }
        for (int i = F.tid; i < 11 * 64; i += 512) { const int kind = i >> 6, ch = kb * 64 + (i & 63); float v;
            if (kind < 4) v = cw[kind * 1024 + ch]; else if (kind == 4) v = cb[ch];
            else { const int d = (kind - 5) / 3, w = (kind - 5) % 3; v = (w == 0) ? b_a[d * 1024 + ch] : (w == 1) ? b_x[d * 1024 + ch] : -8.0f * log1pf(__expf(-lam[d * 1024 + ch])); }
            CT[i] = v; }
        __syncthreads();
        const int nt0 = grp * 48;
        LruRaw raw; lru_load(F, b, kb, nt0 + F.wave, raw);
        for (int ti = F.wave; ti < 48; ti += 8) {
            const int nt = nt0 + ti;
            float av[2][4][4], xv[2][4][4]; unsigned pw[2][4][4];
            lru_conv(F, raw, CT, ucb);
            lru_load(F, b, kb, nt0 + min(ti + 8, 40 + F.wave), raw);
            lru_gates(F, Wl, CT, ucb, av, pw);
            const int row = lru_row(b, nt, tk);
#pragma unroll
            for (int d = 0; d < 2; ++d)
#pragma unroll
                for (int et = 0; et < 4; ++et) { u32x4 w; w.x = pw[d][et][0]; w.y = pw[d][et][1]; w.z = pw[d][et][2]; w.w = pw[d][et][3];
                    __builtin_nontemporal_store(w, (u32x4*)(GX + (((size_t)row * 2 + d) * 1024 + kb * 64 + et * 16 + 4 * g) * 2));
#pragma unroll
                    for (int i = 0; i < 4; ++i) xv[d][et][i] = __uint_as_float(pw[d][et][i] & 0xffff0000u); }
            LRU_SCANS(av, xv);
#pragma unroll
            for (int d = 0; d < 2; ++d) if (tk == (d ? 0 : 15)) {
                float* ag = AG + (((size_t)(b * 2 + d) * LRU_NT + nt) * 2) * 1024 + kb * 64;
#pragma unroll
                for (int et = 0; et < 4; ++et) { *(f32x4*)(ag + et * 16 + 4 * g) = (f32x4){av[d][et][0], av[d][et][1], av[d][et][2], av[d][et][3]};
                    *(f32x4*)(ag + 1024 + et * 16 + 4 * g) = (f32x4){xv[d][et][0], xv[d][et][1], xv[d][et][2], xv[d][et][3]}; }
            }
        }
    }
    __syncthreads();
}
__device__ __forceinline__ void ph_lru_c(const Frame& F) {
    const float* HST = (const float*)(F.R1 + R1_HST); const bf16_t* GX = (const bf16_t*)(F.R1 + R1_GX);
    const bf16_t* P = (const bf16_t*)(F.R1 + R1_P);
    const int tk = F.lane & 15, g = F.lane >> 4;
    const int gw = F.wg * 8 + F.wave, nw = F.G * 8;
    for (int task = gw; task < NBAT * LRU_NT * 16; task += nw) {
        const int kb = task & 15, nt = (task >> 4) % LRU_NT, b = (task >> 4) / LRU_NT;
        const int row = lru_row(b, nt, tk);
        u32x4 gx[2][4]; f32x4 hf[4], hb[4]; u32x2 yw[4];
#pragma unroll
        for (int d = 0; d < 2; ++d)
#pragma unroll
            for (int et = 0; et < 4; ++et) gx[d][et] = *(const u32x4*)(GX + (((size_t)row * 2 + d) * 1024 + kb * 64 + et * 16 + 4 * g) * 2);
#pragma unroll
        for (int et = 0; et < 4; ++et) { const int ch = kb * 64 + et * 16 + 4 * g;
            hf[et] = *(const f32x4*)(HST + ((size_t)(b * 2 + 0) * LRU_NT + nt) * 1024 + ch);
            hb[et] = *(const f32x4*)(HST + ((size_t)(b * 2 + 1) * LRU_NT + nt) * 1024 + ch);
            yw[et] = *(const u32x2*)(P + (size_t)row * 2048 + ch); }
        float av[2][4][4], xv[2][4][4];
#pragma unroll
        for (int d = 0; d < 2; ++d)
#pragma unroll
            for (int et = 0; et < 4; ++et) { const unsigned ww[4] = {gx[d][et].x, gx[d][et].y, gx[d][et].z, gx[d][et].w};
#pragma unroll
                for (int i = 0; i < 4; ++i) { av[d][et][i] = __expf(__uint_as_float(ww[i] << 16)); xv[d][et][i] = __uint_as_float(ww[i] & 0xffff0000u); } }
        LRU_SCANS(av, xv);
#pragma unroll
        for (int et = 0; et < 4; ++et) {
            const int ch = kb * 64 + et * 16 + 4 * g;
            const float y0 = __uint_as_float(yw[et].x << 16), y1 = __uint_as_float(yw[et].x & 0xffff0000u), y2 = __uint_as_float(yw[et].y << 16), y3 = __uint_as_float(yw[et].y & 0xffff0000u);
            float o[4];
#pragma unroll
            for (int i = 0; i < 4; ++i) o[i] = fmaf(av[0][et][i], hf[et][i], xv[0][et][i]) + fmaf(av[1][et][i], hb[et][i], xv[1][et][i]);
            o[0] *= gelu_tanh_(y0); o[1] *= gelu_tanh_(y1); o[2] *= gelu_tanh_(y2); o[3] *= gelu_tanh_(y3);
            u32x2 w; w.x = cvt_pk_bf16(o[0], o[1]); w.y = cvt_pk_bf16(o[2], o[3]);
            *(u32x2*)(F.MIX + (size_t)row * DM + ch) = w;
        }
    }
}
__device__ __forceinline__ void ph_lru_b(const Frame& F) {
    const float* AG = (const float*)(F.R1 + R1_AG); float* HST = (float*)(F.R1 + R1_HST);
    LAS float* sa = (LAS float*)F.lds; LAS float* sx = sa + 512;
    for (int task = F.wg; task < NBAT * 2 * 32; task += F.G) {
        const int cgp = task & 31, d = (task >> 5) & 1, b = task >> 6;
        const int ch = cgp * 32 + (F.tid & 31), seg = F.tid >> 5;
        const float* ag = AG + ((size_t)(b * 2 + d) * LRU_NT) * 2048 + ch;
        float A = 1.0f, Xv = 0.f;
#pragma unroll 11
        for (int i = 0; i < 33; ++i) { const int nt = lru_nat(seg * 33 + i, d); const float a = ag[(size_t)nt * 2048], x = ag[(size_t)nt * 2048 + 1024]; Xv = fmaf(a, Xv, x); A *= a; }
        __syncthreads();
        sa[F.tid] = A; sx[F.tid] = Xv;
        __syncthreads();
        float h = 0.f;
        for (int s2 = 0; s2 < seg; ++s2) h = fmaf(sa[s2 * 32 + (F.tid & 31)], h, sx[s2 * 32 + (F.tid & 31)]);
        float* hs = HST + ((size_t)(b * 2 + d) * LRU_NT) * 1024 + ch;
        for (int i0 = 0; i0 < 33; i0 += 11) {
            float aa[11], xx[11];
#pragma unroll
            for (int q = 0; q < 11; ++q) { const int nt = lru_nat(seg * 33 + i0 + q, d); aa[q] = ag[(size_t)nt * 2048]; xx[q] = ag[(size_t)nt * 2048 + 1024]; }
            asm volatile("" ::: "memory"); __builtin_amdgcn_sched_barrier(0);
#pragma unroll
            for (int q = 0; q < 11; ++q) { const int nt = lru_nat(seg * 33 + i0 + q, d); hs[(size_t)nt * 1024] = h; h = fmaf(aa[q], h, xx[q]); }
        }
    }
    __syncthreads();
}

__device__ __forceinline__ void topk_better(float& bk, int& be, float& bs, float ok, int oe, float os) { const bool t = (ok > bk) || (ok == bk && oe < be); bk = t ? ok : bk; be = t ? oe : be; bs = t ? os : bs; }
template <int CTRL> __device__ __forceinline__ void topk_step(float& bk, int& be, float& bs) {
    const float ok = dppf<CTRL>(bk, bk), os = dppf<CTRL>(bs, bs); const int oe = __builtin_amdgcn_update_dpp(be, be, CTRL, 0xf, 0xf, false); topk_better(bk, be, bs, ok, oe, os); }
__device__ __forceinline__ void ph_ln_router(const Frame& F, int l, bool dry = false) {
    const bf16_t* RW = (const bf16_t*)(F.WB + WB_RT);
    const float* rbias = inp(F, 23) + l * 64;
    LAS float* part = (LAS float*)F.lds;
    LAS float* LP = (LAS float*)(F.lds + 4096);
    LAS int* hist = (LAS int*)(F.lds + LDS_MISC + MISC_HIST); LAS int* hbase = (LAS int*)(F.lds + LDS_MISC + MISC_HBASE);
    int* tok_e = (int*)(F.ws + OFF_TOKE); int* tok_p = (int*)(F.ws + OFF_TOKP); float* tok_w = (float*)(F.ws + OFF_TOKW);
    int* stok = (int*)(F.ws + OFF_STOK);
    float* stats = (float*)(F.ws + OFF_STATS);
    unsigned* gcnt = (unsigned*)(F.ws + OFF_CTL + CTL_CNT) + l * 64;
    const int tk = F.lane & 15, g = F.lane >> 4;
    float rb[4];
#pragma unroll
    for (int q = 0; q < 4; ++q) rb[q] = rbias[tk + 16 * q];
    if (F.tid < 64) hist[F.tid] = 0;
    __syncthreads();
    const int NTILE = TT / 16, TILE0 = (l == 3) ? TC / 16 : 0;
    bf16x8 rwf[4][4];
#pragma unroll
    for (int et = 0; et < 4; ++et)
#pragma unroll
        for (int ks = 0; ks < 4; ++ks) rwf[et][ks] = *(const bf16x8*)(RW + (size_t)(et * 16 + tk) * 1024 + F.wave * 128 + ks * 32 + g * 8);
    f32x4 vn[4][2];
    if (TILE0 + F.wg < NTILE) { const float* xr = F.X + (size_t)((TILE0 + F.wg) * 16 + tk) * DM + F.wave * 128 + g * 8;
#pragma unroll
        for (int ks = 0; ks < 4; ++ks) { vn[ks][0] = *(const f32x4*)(xr + ks * 32); vn[ks][1] = *(const f32x4*)(xr + ks * 32 + 4); } }
    for (int tile = TILE0 + F.wg; tile < NTILE; tile += F.G) {
        const int row = tile * 16 + tk; const int s = slot_of_row(tile * 16);
        const float* ab = (const float*)(F.ws + OFF_AB) + (size_t)(l * 5 + s) * 2048;
        f32x4 v[4][2];
#pragma unroll
        for (int ks = 0; ks < 4; ++ks) { v[ks][0] = vn[ks][0]; v[ks][1] = vn[ks][1]; }
        if (tile + F.G < NTILE) { const float* xr = F.X + (size_t)((tile + F.G) * 16 + tk) * DM + F.wave * 128 + g * 8;
#pragma unroll
            for (int ks = 0; ks < 4; ++ks) { vn[ks][0] = *(const f32x4*)(xr + ks * 32); vn[ks][1] = *(const f32x4*)(xr + ks * 32 + 4); } }
        float sum = 0.f, sq = 0.f;
#pragma unroll
        for (int ks = 0; ks < 4; ++ks)
#pragma unroll
            for (int hh = 0; hh < 2; ++hh) { const f32x4 a = v[ks][hh]; sum += (a[0] + a[1]) + (a[2] + a[3]); sq += (a[0] * a[0] + a[1] * a[1]) + (a[2] * a[2] + a[3] * a[3]); }
        sum = rows_sum(sum); sq = rows_sum(sq);
        if (g == 0) *(LAS f32x2*)(part + (F.wave * 16 + tk) * 2) = (f32x2){sum, sq};
        lds_barrier();
        float ts = 0.f, tq = 0.f;
#pragma unroll
        for (int w = 0; w < 8; ++w) { const f32x2 p = *(const LAS f32x2*)(part + (w * 16 + tk) * 2); ts += p.x; tq += p.y; }
        const float mean = ts * (1.0f / 1024.0f), var = fmaxf(tq * (1.0f / 1024.0f) - mean * mean, 0.f), rstd = rsqrtf(var + 1e-5f);
        if (F.wave == 0 && g == 0) *(f32x2*)(stats + (size_t)row * 2) = (f32x2){mean, rstd};
        f32x4 acc[4];
#pragma unroll
        for (int et = 0; et < 4; ++et) acc[et] = (f32x4){0.f, 0.f, 0.f, 0.f};
#pragma unroll
        for (int ks = 0; ks < 4; ++ks) { const int k = F.wave * 128 + ks * 32 + g * 8;
            const f32x4 a10 = *(const f32x4*)(ab + k), a11 = *(const f32x4*)(ab + k + 4), b10 = *(const f32x4*)(ab + 1024 + k), b11 = *(const f32x4*)(ab + 1024 + k + 4);
            const f32x4 h0 = (v[ks][0] - mean) * rstd * a10 + b10, h1 = (v[ks][1] - mean) * rstd * a11 + b11;
            u32x4 w; w.x = cvt_pk_bf16(h0[0], h0[1]); w.y = cvt_pk_bf16(h0[2], h0[3]); w.z = cvt_pk_bf16(h1[0], h1[1]); w.w = cvt_pk_bf16(h1[2], h1[3]);
            *(u32x4*)(F.HB + (size_t)row * DM + k) = w;
            bf16x8 af; __builtin_memcpy(&af, &w, 16);
#pragma unroll
            for (int et = 0; et < 4; ++et) acc[et] = __builtin_amdgcn_mfma_f32_16x16x32_bf16(af, rwf[et][ks], acc[et], 0, 0, 0);
        }
#pragma unroll
        for (int et = 0; et < 4; ++et)
#pragma unroll
            for (int i = 0; i < 4; ++i) LP[(F.wave * 16 + 4 * g + i) * 64 + et * 16 + tk] = acc[et][i];
        lds_barrier();
        {
            const int t = 2 * F.wave + (g & 1), r2 = tile * 16 + t;
            float sc[4], key[4];
#pragma unroll
            for (int q = 0; q < 4; ++q) { float lgt = 0.f;
#pragma unroll
                for (int w = 0; w < 8; ++w) lgt += LP[(w * 16 + t) * 64 + tk + 16 * q];
                sc[q] = sigmoidf_(lgt); key[q] = sc[q] + rb[q]; }
            unsigned taken = 0u; int se[6]; float ss[6]; float tot = 0.f;
#pragma unroll
            for (int sel = 0; sel < 6; ++sel) {
                float bk = -1e30f, bs = 0.f; int be = 0;
#pragma unroll
                for (int q = 0; q < 4; ++q) if (!((taken >> q) & 1u) && key[q] > bk) { bk = key[q]; be = tk + 16 * q; bs = sc[q]; }
                topk_step<0xB1>(bk, be, bs); topk_step<0x4E>(bk, be, bs); topk_step<0x141>(bk, be, bs); topk_step<0x140>(bk, be, bs);
                if ((be & 15) == tk) taken |= 1u << (be >> 4);
                se[sel] = be; ss[sel] = bs; tot += bs;
            }
            const float sc2 = 2.5f / tot;
            if (tk < 6 && g < 2) {
                int e = se[0]; float w = ss[0];
#pragma unroll
                for (int q = 1; q < 6; ++q) if (tk == q) { e = se[q]; w = ss[q]; }
                tok_e[r2 * 8 + tk] = e; tok_w[r2 * 8 + tk] = w * sc2; if (!dry) tok_p[r2 * 8 + tk] = __hip_atomic_fetch_add(hist + e, 1, __ATOMIC_RELAXED, __HIP_MEMORY_SCOPE_WORKGROUP);
            }
        }
    }
    asm volatile("s_waitcnt vmcnt(0) lgkmcnt(0)" ::: "memory");
    __syncthreads();
    if (dry) return;
    if (F.tid < 64) hbase[F.tid] = (int)__hip_atomic_fetch_add(gcnt + F.tid, (unsigned)hist[F.tid], __ATOMIC_RELAXED, __HIP_MEMORY_SCOPE_AGENT);
    __syncthreads();
    {
        const int myt = (NTILE - TILE0 - F.wg + F.G - 1) / F.G;
        for (int idx = F.tid; idx < myt * 96; idx += 512) { const int ti = idx / 96, rem = idx - ti * 96, tile = TILE0 + F.wg + ti * F.G;
            const int row = tile * 16 + rem / 6, q = rem % 6; const int e = tok_e[row * 8 + q]; const int pos = hbase[e] + tok_p[row * 8 + q];
            tok_p[row * 8 + q] = pos; stok[(size_t)e * CAP + pos] = row; }
    }
    __syncthreads();
}

__device__ __forceinline__ int moe_tables(const Frame& F, int l, const bool reuse = false) {
    if (reuse) { __syncthreads(); return ((LAS int*)(F.lds + LDS_MISC + MISC_TST))[65]; }
    const int t0 = (l == 3) ? TC : 0;
    LAS int* cnt = (LAS int*)(F.lds + LDS_MISC + MISC_CNT); LAS int* tst = (LAS int*)(F.lds + LDS_MISC + MISC_TST); LAS unsigned char* t2e = (LAS unsigned char*)(F.lds + LDS_MISC + MISC_T2E);
    const unsigned* gcnt = (const unsigned*)(F.ws + OFF_CTL + CTL_CNT) + l * 64;
    __syncthreads();
    if (F.tid < 64) cnt[F.tid] = (int)__hip_atomic_load(gcnt + F.tid, __ATOMIC_RELAXED, __HIP_MEMORY_SCOPE_AGENT);
    if (F.tid == 64) cnt[64] = TT - t0;
    __syncthreads();
    if (F.tid < 66) { int s = 0; for (int e = 0; e < F.tid; ++e) s += (cnt[e] + 255) >> 8; tst[F.tid] = s; }
    __syncthreads();
    const int ntiles = tst[65];
    for (int t = F.tid; t < ntiles; t += 512) { int lo = 0, hi = 64;
#pragma unroll
        for (int it = 0; it < 7; ++it) { const int mid = (lo + hi + 1) >> 1; if (tst[mid] <= t) lo = mid; else hi = mid - 1; }
        t2e[t] = (unsigned char)lo; }
    __syncthreads();
    return ntiles;
}

template <int CTRL> __device__ __forceinline__ float dpp_f(float x) { return __builtin_bit_cast(float, __builtin_amdgcn_update_dpp(0, __builtin_bit_cast(int, x), CTRL, 0xF, 0xF, true)); }
#define WAVE_SUM64(x) do { x += dpp_f<0xB1>(x); x += dpp_f<0x4E>(x); x += dpp_f<0x141>(x); x += dpp_f<0x140>(x); \
    x = __builtin_bit_cast(float, __builtin_amdgcn_readlane(__builtin_bit_cast(int, x), 0)) + __builtin_bit_cast(float, __builtin_amdgcn_readlane(__builtin_bit_cast(int, x), 16)) \
      + __builtin_bit_cast(float, __builtin_amdgcn_readlane(__builtin_bit_cast(int, x), 32)) + __builtin_bit_cast(float, __builtin_amdgcn_readlane(__builtin_bit_cast(int, x), 48)); } while (0)
template <bool lastl> __device__ __forceinline__ void ph_combine_t(const Frame& F, int l, bool dry) {
    LAS int* tst = (LAS int*)(F.lds + LDS_MISC + MISC_TST);
    (void)moe_tables(F, l, (PHM & 8192) != 0 && !MK_SPLIT);
    const int t0 = lastl ? TC : 0;
    LAS float* CT = (LAS float*)F.lds;
    {
        const float* gam = inp(F, 6) + (size_t)(l * 2 + 1) * DM; const float* bet = inp(F, 7) + (size_t)(l * 2 + 1) * DM;
        const float* gam0 = inp(F, 6) + (size_t)(l * 2 + 0) * DM; const float* bet0 = inp(F, 7) + (size_t)(l * 2 + 0) * DM;
        float tv[2][19];
#pragma unroll
        for (int kk = 0; kk < 2; ++kk) { const int k = F.tid + kk * 512;
            tv[kk][0] = gam0[k]; tv[kk][1] = bet0[k]; tv[kk][2] = gam[k]; tv[kk][3] = bet[k];
#pragma unroll
            for (int s = 0; s < 5; ++s) {
                const float* m = F.mods + (size_t)(l * 5 + s) * 6144; const float* mn = F.mods + (size_t)((lastl ? l : l + 1) * 5 + s) * 6144;
                tv[kk][4 + s * 3] = m[5 * 1024 + k]; tv[kk][5 + s * 3] = mn[1024 + k]; tv[kk][6 + s * 3] = mn[k];
            } }
        asm volatile("" ::: "memory");
#pragma unroll
        for (int kk = 0; kk < 2; ++kk) { const int k = F.tid + kk * 512;
            CT[k] = ALPHA * tv[kk][0]; CT[1024 + k] = ALPHA * tv[kk][1]; CT[2048 + k] = tv[kk][2]; CT[3072 + k] = tv[kk][3];
#pragma unroll
            for (int s = 0; s < 5; ++s) { CT[(4 + s * 3) * 1024 + k] = tv[kk][4 + s * 3]; CT[(5 + s * 3) * 1024 + k] = 1.0f + tv[kk][5 + s * 3]; CT[(6 + s * 3) * 1024 + k] = tv[kk][6 + s * 3]; } }
        __syncthreads();
    }
    const float* stats = (const float*)(F.ws + OFF_STATS);
    const unsigned char* Y = (const unsigned char*)(F.R1 + R1_Y);
    const int* tok_e = (const int*)(F.ws + OFF_TOKE); const int* tok_p = (const int*)(F.ws + OFF_TOKP); const float* tok_w = (const float*)(F.ws + OFF_TOKW);
    const int gw = F.wg * 8 + F.wave, nw = F.G * 8;
    const int l4 = F.lane * 4, q8 = F.lane & 7;
    const int sh0 = __builtin_amdgcn_readfirstlane(tst[64]) * 256 - t0;
#define CMB_IDX(E_, P_, W_, row_) do { E_ = tok_e[(row_) * 8 + q8]; P_ = tok_p[(row_) * 8 + q8]; W_ = tok_w[(row_) * 8 + q8]; } while (0)
#define CMB_ISSUE(Yb, Xb, Sb, Wb, E_, P_, W_, row_) do { \
        const int sl_ = tst[(E_) & 63] * 256 + (P_); \
        _Pragma("unroll") for (int q = 0; q < 6; ++q) Wb[q] = __builtin_bit_cast(float, __builtin_amdgcn_readlane(__builtin_bit_cast(int, W_), q)) * (1.0f / 16.0f); \
        _Pragma("unroll") for (int q = 0; q < 7; ++q) { const int sr_ = (q < 6) ? __builtin_amdgcn_readlane(sl_, q) : (sh0 + (row_)); \
            const unsigned char* yp_ = Y + (size_t)sr_ * DM + l4; \
            _Pragma("unroll") for (int c = 0; c < 4; ++c) Yb[q * 4 + c] = *(const unsigned*)(yp_ + c * 256); } \
        _Pragma("unroll") for (int c = 0; c < 4; ++c) Xb[c] = __builtin_nontemporal_load((const f32x4*)(F.X + (size_t)(row_) * DM + c * 256 + l4)); \
        Sb = *(const f32x2*)(stats + (size_t)(row_) * 2); } while (0)
#define CMB_COMPUTE(Yb, Xb, Sb, Wb, row_) do { \
        LAS const float* cs_ = CT + (4 + slot_of_row(row_) * 3) * 1024 + l4; \
        float v[16]; \
        _Pragma("unroll") for (int c = 0; c < 4; ++c) { \
            const f32x4 ag = *(LAS const f32x4*)(CT + c * 256 + l4), ab = *(LAS const f32x4*)(CT + 1024 + c * 256 + l4), m5 = *(LAS const f32x4*)(cs_ + c * 256); \
            f32x2 ya = (f32x2){0.f, 0.f}, yb = ya; \
            _Pragma("unroll") for (int q = 0; q < 7; ++q) { const float wq_ = (q < 6) ? Wb[q] : (1.0f / 16.0f); ya += __builtin_amdgcn_cvt_pk_f32_fp8((int)Yb[q * 4 + c], false) * wq_; yb += __builtin_amdgcn_cvt_pk_f32_fp8((int)Yb[q * 4 + c], true) * wq_; } \
            const f32x4 xh = (Xb[c] - Sb.x) * Sb.y; \
            v[c * 4 + 0] = xh[0] * ag[0] + ab[0] + m5[0] * ya.x; v[c * 4 + 1] = xh[1] * ag[1] + ab[1] + m5[1] * ya.y; \
            v[c * 4 + 2] = xh[2] * ag[2] + ab[2] + m5[2] * yb.x; v[c * 4 + 3] = xh[3] * ag[3] + ab[3] + m5[3] * yb.y; } \
        float sum = 0.f; \
        _Pragma("unroll") for (int i = 0; i < 16; ++i) sum += v[i]; \
        WAVE_SUM64(sum); \
        const float mean = sum * (1.0f / 1024.0f); \
        float sq = 0.f; \
        _Pragma("unroll") for (int i = 0; i < 16; ++i) { const float d = v[i] - mean; sq += d * d; } \
        WAVE_SUM64(sq); \
        const float rstd = rsqrtf(sq * (1.0f / 1024.0f) + 1e-5f); \
        _Pragma("unroll") for (int c = 0; c < 4; ++c) { \
            const f32x4 g = *(LAS const f32x4*)(CT + 2048 + c * 256 + l4), b = *(LAS const f32x4*)(CT + 3072 + c * 256 + l4); \
            f32x4 xn; \
            _Pragma("unroll") for (int i = 0; i < 4; ++i) xn[i] = (v[c * 4 + i] - mean) * rstd * g[i] + b[i]; \
            if (dry) { const float acc_ = xn[0] + xn[1] + xn[2] + xn[3]; asm volatile("" :: "v"(acc_)); } \
            else if (lastl) { *(f32x4*)(F.out + (size_t)((row_) - TC) * DM + c * 256 + l4) = xn; } \
            else { \
                __builtin_nontemporal_store(xn, (f32x4*)(F.X + (size_t)(row_) * DM + c * 256 + l4)); \
                const f32x4 s1 = *(LAS const f32x4*)(cs_ + 1024 + c * 256), b0 = *(LAS const f32x4*)(cs_ + 2048 + c * 256); \
                const f32x4 hv = xn * s1 + b0; \
                u32x2 w; w.x = cvt_pk_bf16(hv[0], hv[1]); w.y = cvt_pk_bf16(hv[2], hv[3]); \
                *(u32x2*)(F.HB + (size_t)(row_) * DM + c * 256 + l4) = w; } } } while (0)
    unsigned yA[28], yB[28]; f32x4 xA[4], xB[4]; f32x2 sA, sB; float wA[6], wB[6]; int eN = 0, pN = 0, eNN = 0, pNN = 0; float wN = 0.f, wNN = 0.f;
    const int row0 = t0 + gw;
    CMB_IDX(eNN, pNN, wNN, row0);
    if (row0 + nw < TT) CMB_IDX(eN, pN, wN, row0 + nw);
    CMB_ISSUE(yA, xA, sA, wA, eNN, pNN, wNN, row0);
    int row = row0;
    for (; row + 3 * nw < TT; row += 2 * nw) {
        const int r1 = row + nw, r2 = row + 2 * nw, r3 = row + 3 * nw;
        CMB_IDX(eNN, pNN, wNN, r2);
        CMB_ISSUE(yB, xB, sB, wB, eN, pN, wN, r1);
        CMB_COMPUTE(yA, xA, sA, wA, row);
        CMB_IDX(eN, pN, wN, r3);
        CMB_ISSUE(yA, xA, sA, wA, eNN, pNN, wNN, r2);
        CMB_COMPUTE(yB, xB, sB, wB, r1);
    }
    for (; row < TT; row += 2 * nw) {
        const int r1 = row + nw, r2 = row + 2 * nw, r3 = row + 3 * nw;
        if (r2 < TT) CMB_IDX(eNN, pNN, wNN, r2);
        if (r1 < TT) CMB_ISSUE(yB, xB, sB, wB, eN, pN, wN, r1);
        CMB_COMPUTE(yA, xA, sA, wA, row);
        if (r1 < TT) {
            if (r3 < TT) CMB_IDX(eN, pN, wN, r3);
            if (r2 < TT) CMB_ISSUE(yA, xA, sA, wA, eNN, pNN, wNN, r2);
            CMB_COMPUTE(yB, xB, sB, wB, r1);
        }
    }
#undef CMB_IDX
#undef CMB_ISSUE
#undef CMB_COMPUTE
}
__device__ __forceinline__ void ph_combine(const Frame& F, int l, bool dry = false) { if (l == 3) ph_combine_t<true>(F, l, dry); else ph_combine_t<false>(F, l, dry); }

constexpr int NPHASE = 2 + 4 * 10;
__global__ void __launch_bounds__(512, 2) mk_fwd(Args args) {
    extern __shared__ __attribute__((aligned(16))) unsigned char lds_raw[];
    Frame F;
    F.out = args.out; F.ws = args.ws; F.lds = (LAS unsigned char*)lds_raw;
    { const int t0 = threadIdx.x; F.wave = __builtin_amdgcn_readfirstlane(t0 >> 6); F.lane = t0 & 63; F.tid = t0; } F.G = gridDim.x; F.wg = blockIdx.x;
    F.mods = (float*)(args.ws + OFF_MODS); F.X = (float*)(args.ws + OFF_X); F.HB = (bf16_t*)(args.ws + OFF_HB); F.MIX = F.HB;
    F.WB = args.ws + OFF_WB; F.R1 = args.ws + OFF_R1;
    volatile LAS unsigned* xbw = (volatile LAS unsigned*)(F.lds + LDS_MISC);
    if (F.tid < 4) xbw[F.tid] = 0u;
    if (F.tid < 30) ((LAS unsigned long long*)(F.lds + LDS_MISC + MISC_INP))[F.tid] = (unsigned long long)args.in[F.tid];
    __syncthreads();
    const int lo = args.ph_lo, hi = args.ph_hi;
    XcdBarrier bar; bar.bar = (unsigned*)(args.ws + OFF_CTL); bar.x = 0; bar.st = xbw;
    if (hi - lo > 1) bar = xcd_barrier_post((unsigned*)(args.ws + OFF_CTL), xbw);
#define IN(k) (lo <= (k) && (k) < hi)
#define SEAM(k) do { if (IN(k) && IN((k) + 1)) { xcd_barrier(bar); if (REPM & 1) xcd_barrier(bar); } } while (0)
    if ((PHM & 1) && IN(0)) { ph_mods(fresh(F)); if (REPM & 65536) { __syncthreads(); ph_mods(fresh(F)); } } SEAM(0);
    if ((PHM & 2) && IN(1)) { ph_init_x(fresh(F)); if (REPM & 131072) ph_init_x(fresh(F)); }
    for (int l = 0; l < 4; ++l) {
        const int pb = 2 + l * 10, j = l >> 1; const bool even = (l & 1) == 0;
        float* mods_l = F.mods + (size_t)l * 5 * 6144;
        F.WB = args.ws + OFF_WB + (size_t)(l & 1) * WB_END;
        if ((PHM & 4) && IN(pb + 0) && !(l & 1)) { for (int rep = 0; rep < ((REPM & 4) ? 2 : 1); ++rep) { ph_convert(fresh(F), l); __syncthreads(); } }
        if (!(l & 1)) SEAM(pb + 0);
        if ((PHM & 8) && IN(pb + 1)) {
            const int N = even ? 4096 : 2048;
            pg8::StaticOrder S; S.init(F.HB, F.WB + WB_IN, TT, N, 1024, F.G, F.wg);
            S.lim = S.nwg;
            pg8::EpiStoreBf16 E{(bf16_t*)(F.R1 + R1_P), N};
            for (int rep = 0; rep < ((REPM & 8) ? 2 : 1); ++rep) pg8::gemm_phase(F.lds, 1024, S, E, F.wave);
        } SEAM(pb + 1);
        if (IN(pb + 2)) { if (even) { if (F.wg < 8 && F.G > 16) { ph_hg_ctx(fresh(F), j); } else if (PHM & 16) for (int rep = 0; rep < ((REPM & 16) ? 2 : 1); ++rep) { Frame Fa = fresh(F); if (F.G > 16) { Fa.wg = F.wg - 8; Fa.G = F.G - 8; } ph_attn(Fa, j); } if (PHM & 32) for (int rep = 0; rep < ((REPM & 32) ? 2 : 1); ++rep) ph_hg_a(fresh(F), j); } else { if (PHM & 64) for (int rep = 0; rep < ((REPM & 64) ? 2 : 1); ++rep) ph_lru_a(fresh(F), j); } } SEAM(pb + 2);
        if (IN(pb + 3)) { if (even) { if (PHM & 128) for (int rep = 0; rep < ((REPM & 128) ? 2 : 1); ++rep) { ph_hg_b(fresh(F));
                { Frame Fc = fresh(F); Fc.WB = args.ws + OFF_WB + (size_t)((l + 1) & 1) * WB_END; ph_convert(Fc, l + 1); } } } else { if (PHM & 256) for (int rep = 0; rep < ((REPM & 256) ? 2 : 1); ++rep) ph_lru_b(fresh(F)); } } SEAM(pb + 3);
        if (IN(pb + 4)) { if (even) { if (PHM & 512) for (int rep = 0; rep < ((REPM & 512) ? 2 : 1); ++rep) ph_hg_c(fresh(F), j); } else { if (PHM & 1024) for (int rep = 0; rep < ((REPM & 1024) ? 2 : 1); ++rep) ph_lru_c(fresh(F)); } } SEAM(pb + 4);
        if ((PHM & 2048) && IN(pb + 5)) {
            const int t0 = (l == 3) ? TC : 0;
            pg8::StaticOrder S; S.init(F.MIX + (size_t)t0 * DM, F.WB + WB_OUT, TT - t0, 1024, 1024, F.G, F.wg);
            pg8::EpiResid E{F.X + (size_t)t0 * DM, mods_l, t0};
            pg8::gemm_phase(F.lds, 1024, S, E, F.wave);
            { pg8::TailResid ET{F.X + (size_t)t0 * DM, mods_l, t0}; pg8::gemm_tail<16>(F.lds, S, ET, F.wave); }
        } SEAM(pb + 5);
        if ((PHM & 4096) && IN(pb + 6)) { if (REPM & 4096) ph_ln_router(fresh(F), l, true); ph_ln_router(fresh(F), l); } SEAM(pb + 6);
        if ((PHM & 8192) && IN(pb + 7)) {
            const int ntiles = moe_tables(fresh(F), l);
            pg8::MoeGU S; S.cnt = (const LAS int*)(F.lds + LDS_MISC + MISC_CNT); S.tst = (const LAS int*)(F.lds + LDS_MISC + MISC_TST); S.t2e = (const LAS unsigned char*)(F.lds + LDS_MISC + MISC_T2E);
            S.ntiles = ntiles; S.G = F.G; S.c = F.wg; S.A = (const char*)F.HB; S.Bt = (const char*)(F.WB + WB_GU); S.stok = (const int*)(F.ws + OFF_STOK); S.t0 = (l == 3) ? TC : 0;
            pg8::EpiSwiglu E{(bf16_t*)(F.R1 + R1_H)};
            for (int rep = 0; rep < ((REPM & 8192) ? 2 : 1); ++rep) pg8::gemm_phase(F.lds, 1024, S, E, F.wave);
        } SEAM(pb + 7);
        if ((PHM & 16384) && IN(pb + 8)) {
            const int ntiles = moe_tables(fresh(F), l, (PHM & 8192) != 0 && !MK_SPLIT);
            pg8::MoeDN S; S.cnt = (const LAS int*)(F.lds + LDS_MISC + MISC_CNT); S.tst = (const LAS int*)(F.lds + LDS_MISC + MISC_TST); S.t2e = (const LAS unsigned char*)(F.lds + LDS_MISC + MISC_T2E);
            S.ntiles = ntiles; S.G = F.G; S.c = F.wg; S.A = (const char*)(F.R1 + R1_H); S.Bt = (const char*)(F.WB + WB_DN);
            pg8::EpiDown E{(unsigned char*)(F.R1 + R1_Y)};
            if (REPM & 2) { pg8::EpiNull EN; pg8::gemm_phase(F.lds, 256, S, EN, F.wave); }
            if (REPM & (1 << 21)) { pg8::EpiDownProbe<1> EN{(unsigned char*)F.out, nullptr, nullptr}; pg8::gemm_phase(F.lds, 256, S, EN, F.wave); }
            if (REPM & (1 << 22)) { pg8::EpiDownProbe<2> EN{(unsigned char*)F.out, nullptr, nullptr}; pg8::gemm_phase(F.lds, 256, S, EN, F.wave); }
            if (REPM & (1 << 23)) { pg8::EpiDownProbe<3> EN{(unsigned char*)F.out, nullptr, nullptr}; pg8::gemm_phase(F.lds, 256, S, EN, F.wave); }
            for (int rep = 0; rep < ((REPM & 16384) ? 2 : 1); ++rep) pg8::gemm_phase(F.lds, 256, S, E, F.wave);
        } SEAM(pb + 8);
        if ((PHM & 32768) && IN(pb + 9)) { if (REPM & 32768) ph_combine(fresh(F), l, true); ph_combine(fresh(F), l); } SEAM(pb + 9);
    }
#undef IN
#undef SEAM
}

extern "C" void kernel_launch(void* const* d_in, const int* in_sizes, int n_in, void* d_out, int out_size, void* d_ws, size_t ws_size, hipStream_t stream) {
    static int grid = 0;
    if (grid == 0) {
        if (n_in != 30 || out_size != TX * DM || ws_size < WS_END) { fprintf(stderr, "kernel_launch: unexpected problem (n_in %d out %d ws %zu need %zu)\n", n_in, out_size, ws_size, (size_t)WS_END); grid = -1; return; }
        int dev = 0, cus = 0, per_cu = 0;
        if (hipGetDevice(&dev) != hipSuccess || hipDeviceGetAttribute(&cus, hipDeviceAttributeMultiprocessorCount, dev) != hipSuccess) { grid = -1; return; }
        if (hipFuncSetAttribute((const void*)mk_fwd, hipFuncAttributeMaxDynamicSharedMemorySize, LDS_BYTES) != hipSuccess) { fprintf(stderr, "kernel_launch: hipFuncSetAttribute failed\n"); grid = -1; return; }
        if (hipOccupancyMaxActiveBlocksPerMultiprocessor(&per_cu, (const void*)mk_fwd, 512, LDS_BYTES) != hipSuccess || per_cu < 1) { fprintf(stderr, "kernel_launch: occupancy query says %d\n", per_cu); }
        (void)hipGetLastError();
        grid = cus;
    }
    if (grid < 0) return;
    (void)hipMemsetAsync((char*)d_ws + OFF_CTL, 0, CTL_BYTES, stream);
    Args a{};
    for (int i = 0; i < 30; ++i) a.in[i] = (const float*)d_in[i];
    a.out = (float*)d_out; a.ws = (unsigned char*)d_ws;
#if MK_SPLIT
    for (int p = 0; p < NPHASE; ++p) { a.ph_lo = p; a.ph_hi = p + 1; hipLaunchKernelGGL(mk_fwd, dim3(grid), dim3(512), LDS_BYTES, stream, a); }
#else
    a.ph_lo = 0; a.ph_hi = NPHASE;
    hipLaunchKernelGGL(mk_fwd, dim3(grid), dim3(512), LDS_BYTES, stream, a);
#endif
}
```
